# Optimizing an MI355X kernel written in HIP

```python
import math
import jax, jax.numpy as jnp
from jax import lax
import numpy as np

D_MODEL = 1024
BATCH = 2
SEQ = 8192
DEPTH = 2

HEAD_DIM = 64
MIX_WIDTH = D_MODEL
ATTN_HEADS = 6
ATTN_KV_HEADS = 2
ATTN_GROUP = ATTN_HEADS // ATTN_KV_HEADS
ATTN_WIDTH = ATTN_HEADS * HEAD_DIM
ATTN_KV_WIDTH = ATTN_KV_HEADS * HEAD_DIM
WINDOW = 128
BLOCK_Q = 128
N_BUCKETS = 32
MAX_EXACT = N_BUCKETS // 2
MAX_DISTANCE = WINDOW
RWKV_HEADS = 6
RWKV_HEAD_DIM = 64
RWKV_WIDTH = RWKV_HEADS * RWKV_HEAD_DIM
D_DECAY_LORA = 32
D_AAA_LORA = 32
D_MV_LORA = 16
D_GATE_LORA = 64
RWKV_SHIFT_COLS = 3 * RWKV_WIDTH + D_DECAY_LORA + D_AAA_LORA + D_GATE_LORA
MEM_TOKENS = 256
MEM_HEADS = 4
MEM_WIDTH = MIX_WIDTH - ATTN_WIDTH - RWKV_WIDTH
IN_BASE = ATTN_WIDTH + 2 * ATTN_KV_WIDTH + RWKV_SHIFT_COLS + MEM_WIDTH
D_FF = 2816
CONV_WIDTH = 3
EPS = 1e-6
GN_EPS = 64e-5
L2_EPS = 1e-12

kernel_name = "hybrid_swa_rwkv7_memory_convffn"


def split_cols(t, sizes):
    return jnp.split(t, [int(c) for c in np.cumsum(sizes)[:-1]], axis=-1)


def rms_norm(x, g):
    xf = x.astype(jnp.float32)
    y = xf * lax.rsqrt(jnp.mean(xf * xf, axis=-1, keepdims=True) + EPS)
    return (y * g.astype(jnp.float32)).astype(x.dtype)


def token_shift(p, mu):
    prev = jnp.pad(p, ((0, 0), (1, 0), (0, 0)))[:, :-1]
    return p + mu * (prev - p)


def t5_causal_bucket(dist):
    is_small = dist < MAX_EXACT
    d = jnp.maximum(dist, 1).astype(jnp.float32)
    large = MAX_EXACT + (jnp.log(d / MAX_EXACT) / math.log(MAX_DISTANCE / MAX_EXACT)
                         * (N_BUCKETS - MAX_EXACT)).astype(jnp.int32)
    large = jnp.minimum(large, N_BUCKETS - 1)
    return jnp.where(is_small, dist, large)


def sliding_window_attention(q, k, v, sinks, rel_bias):
    b, s = q.shape[0], q.shape[1]
    nb = s // BLOCK_Q
    qb = q.reshape(b, nb, BLOCK_Q, ATTN_KV_HEADS, ATTN_GROUP, HEAD_DIM)

    def band(t):
        tb = t.reshape(b, nb, BLOCK_Q, ATTN_KV_HEADS, HEAD_DIM)
        prev = jnp.concatenate([jnp.zeros_like(tb[:, :1]), tb[:, :-1]], axis=1)
        return jnp.concatenate([prev, tb], axis=2)

    kw, vw = band(k), band(v)
    logits = jnp.einsum('bnqhgd,bnkhd->bnhgqk', qb, kw,
                        preferred_element_type=jnp.float32) * (HEAD_DIM ** -0.5)
    qi = jnp.arange(BLOCK_Q)[:, None]
    kj = jnp.arange(2 * BLOCK_Q)[None, :]
    dist = qi + BLOCK_Q - kj
    in_band = (dist >= 0) & (dist < WINDOW)
    key_pos = jnp.arange(nb)[:, None, None] * BLOCK_Q - BLOCK_Q + kj[None]
    valid = in_band[None] & (key_pos >= 0)
    bucket = t5_causal_bucket(jnp.maximum(dist, 0))
    bias = rel_bias.astype(jnp.float32)[bucket]
    bias = bias.transpose(2, 0, 1).reshape(ATTN_KV_HEADS, ATTN_GROUP, BLOCK_Q, 2 * BLOCK_Q)
    logits = jnp.where(valid[None, :, None, None], logits + bias, -jnp.inf)
    sink = sinks.astype(jnp.float32).reshape(ATTN_KV_HEADS, ATTN_GROUP)[None, None, :, :, None, None]
    m = jnp.maximum(jnp.max(logits, axis=-1, keepdims=True), sink)
    e = jnp.exp(logits - m)
    p = e / (jnp.sum(e, axis=-1, keepdims=True) + jnp.exp(sink - m))
    out = jnp.einsum('bnhgqk,bnkhd->bnqhgd', p.astype(v.dtype), vw)
    return out.reshape(b, s, ATTN_WIDTH)


def rwkv7_scan(r, w, k, v, a, bvec):
    bsz = r.shape[0]
    decay = jnp.exp(-jnp.exp(w))

    def step(state, inp):
        r_t, d_t, k_t, v_t, a_t, b_t = inp
        sa = jnp.einsum('bhvk,bhk->bhv', state, a_t)
        state = (state * d_t[:, :, None, :] + sa[..., None] * b_t[:, :, None, :]
                 + v_t[..., None] * k_t[:, :, None, :])
        return state, jnp.einsum('bhvk,bhk->bhv', state, r_t)

    xs = tuple(jnp.moveaxis(t, 1, 0) for t in (r, decay, k, v, a, bvec))
    s0 = jnp.zeros((bsz, RWKV_HEADS, RWKV_HEAD_DIM, RWKV_HEAD_DIM), jnp.float32)
    _, y = lax.scan(step, s0, xs)
    return jnp.moveaxis(y, 0, 1)


def rwkv7_mixer(pb, value_residual, w0, w2, a0, a2, g2, k_k, k_a, r_k, ln_w, ln_b):
    out_dtype = pb.dtype
    f32 = lambda t: t.astype(jnp.float32)
    r, k, v, wd, ad, gd = split_cols(f32(pb), [RWKV_WIDTH, RWKV_WIDTH, RWKV_WIDTH,
                                               D_DECAY_LORA, D_AAA_LORA, D_GATE_LORA])
    w = -jax.nn.softplus(-(f32(w0) + jnp.tanh(wd) @ f32(w2))) - 0.5
    a = jax.nn.sigmoid(f32(a0) + ad @ f32(a2))
    g = jax.nn.sigmoid(gd) @ f32(g2)
    if value_residual is not None:
        v_first, v_down, v0, v2 = value_residual
        v = v + (f32(v_first) - v) * jax.nn.sigmoid(f32(v0) + f32(v_down) @ f32(v2))
    v_out = v
    b, s = pb.shape[0], pb.shape[1]
    heads = lambda t: t.reshape(b, s, RWKV_HEADS, RWKV_HEAD_DIM)
    kk = heads(k * f32(k_k))
    kk = kk / jnp.maximum(jnp.sqrt(jnp.sum(kk * kk, axis=-1, keepdims=True)), L2_EPS)
    k = k * (1.0 + (a - 1.0) * f32(k_a))
    rh, kh, vh, ah = heads(r), heads(k), heads(v), heads(a)
    y = rwkv7_scan(rh, heads(w), kh, vh, -kk, kk * ah)
    mu = jnp.mean(y, axis=-1, keepdims=True)
    var = jnp.mean(jnp.square(y - mu), axis=-1, keepdims=True)
    y = ((y - mu) * lax.rsqrt(var + GN_EPS)).reshape(b, s, RWKV_WIDTH) * f32(ln_w) + f32(ln_b)
    bonus = jnp.sum(rh * kh * f32(r_k), axis=-1, keepdims=True) * vh
    y = (y + bonus.reshape(b, s, RWKV_WIDTH)) * g
    return y.astype(out_dtype), v_out


def memory_attention(q, mk, mv):
    logits = jnp.einsum('bshd,bmhd->bhsm', q, mk,
                        preferred_element_type=jnp.float32) * (HEAD_DIM ** -0.5)
    p = jax.nn.softmax(logits, axis=-1)
    out = jnp.einsum('bhsm,bmhd->bshd', p.astype(mv.dtype), mv)
    return out.reshape(q.shape[0], q.shape[1], MEM_WIDTH)


def conv_ffn(h, w_up, conv_w, conv_b, w_down):
    u = h @ w_up
    s = u.shape[1]
    up_pad = jnp.pad(u, ((0, 0), (CONV_WIDTH - 1, 0), (0, 0)))
    uc = conv_b + sum(conv_w[i] * up_pad[:, i:i + s] for i in range(CONV_WIDTH))
    gate, val = jnp.split(uc, 2, axis=-1)
    return (jax.nn.silu(gate) * val) @ w_down


def setup_inputs(seed: int = 0) -> dict:
    key = jax.random.key(seed)
    ks = iter(jax.random.split(key, 40))
    n = lambda shape: jax.random.normal(next(ks), shape, jnp.float32)
    L, Lv = DEPTH, DEPTH - 1
    C = RWKV_WIDTH
    return {
        "x": n((BATCH, SEQ, D_MODEL)),
        "mem": n((BATCH, MEM_TOKENS, D_MODEL)),
        "rel_bias": 0.5 * n((N_BUCKETS, ATTN_HEADS)),
        "mix_norm_g": 1.0 + 0.1 * n((L, D_MODEL)),
        "w_in": n((L, D_MODEL, IN_BASE)) * D_MODEL ** -0.5,
        "w_in_vres": n((Lv, D_MODEL, D_MV_LORA)) * D_MODEL ** -0.5,
        "attn_q_norm": 1.0 + 0.1 * n((L, HEAD_DIM)),
        "attn_k_norm": 1.0 + 0.1 * n((L, HEAD_DIM)),
        "attn_sinks": n((L, ATTN_HEADS)),
        "rwkv_mu": jax.random.uniform(next(ks), (L, RWKV_SHIFT_COLS), jnp.float32),
        "rwkv_mu_vres": jax.random.uniform(next(ks), (Lv, D_MV_LORA), jnp.float32),
        "rwkv_w0": -2.0 + 0.5 * n((L, C)),
        "rwkv_w2": 0.5 * n((L, D_DECAY_LORA, C)) * D_DECAY_LORA ** -0.5,
        "rwkv_a0": 0.5 * n((L, C)),
        "rwkv_a2": 0.5 * n((L, D_AAA_LORA, C)) * D_AAA_LORA ** -0.5,
        "rwkv_v0": 0.5 * n((Lv, C)),
        "rwkv_v2": 0.5 * n((Lv, D_MV_LORA, C)) * D_MV_LORA ** -0.5,
        "rwkv_g2": n((L, D_GATE_LORA, C)) * D_GATE_LORA ** -0.5,
        "rwkv_k_k": 0.85 + 0.1 * n((L, C)),
        "rwkv_k_a": 1.0 + 0.1 * n((L, C)),
        "rwkv_r_k": 0.1 * n((L, RWKV_HEADS, RWKV_HEAD_DIM)),
        "rwkv_ln_w": 1.0 + 0.1 * n((L, C)),
        "rwkv_ln_b": 0.02 * n((L, C)),
        "mem_norm_g": 1.0 + 0.1 * n((L, D_MODEL)),
        "w_mem_kv": n((L, D_MODEL, 2 * MEM_WIDTH)) * D_MODEL ** -0.5,
        "mem_q_norm": 1.0 + 0.1 * n((L, HEAD_DIM)),
        "mem_k_norm": 1.0 + 0.1 * n((L, HEAD_DIM)),
        "w_out": n((L, MIX_WIDTH, D_MODEL)) * MIX_WIDTH ** -0.5,
        "ffn_norm_g": 1.0 + 0.1 * n((L, D_MODEL)),
        "w_up": n((L, D_MODEL, 2 * D_FF)) * D_MODEL ** -0.5,
        "conv_w": n((L, CONV_WIDTH, 2 * D_FF)) * CONV_WIDTH ** -0.5,
        "conv_b": 0.02 * n((L, 2 * D_FF)),
        "w_down": n((L, D_FF, D_MODEL)) * D_FF ** -0.5,
    }


def reference(x, mem, rel_bias, mix_norm_g, w_in, w_in_vres, attn_q_norm, attn_k_norm, attn_sinks,
              rwkv_mu, rwkv_mu_vres, rwkv_w0, rwkv_w2, rwkv_a0, rwkv_a2, rwkv_v0, rwkv_v2, rwkv_g2,
              rwkv_k_k, rwkv_k_a, rwkv_r_k, rwkv_ln_w, rwkv_ln_b, mem_norm_g, w_mem_kv,
              mem_q_norm, mem_k_norm, w_out, ffn_norm_g, w_up, conv_w, conv_b, w_down):
    b, s = x.shape[0], x.shape[1]
    m_tok = mem.shape[1]
    v_first = None
    for l in range(DEPTH):
        h = rms_norm(x, mix_norm_g[l])
        w_l = w_in[l] if l == 0 else jnp.concatenate([w_in[l], w_in_vres[l - 1]], axis=1)
        proj = h @ w_l
        sizes = [ATTN_WIDTH, ATTN_KV_WIDTH, ATTN_KV_WIDTH, RWKV_SHIFT_COLS, MEM_WIDTH]
        if l > 0:
            sizes = sizes + [D_MV_LORA]
        parts = split_cols(proj, sizes)
        qa, ka, va, pb, qm = parts[:5]

        qa = rms_norm(qa.reshape(b, s, ATTN_HEADS, HEAD_DIM), attn_q_norm[l])
        ka = rms_norm(ka.reshape(b, s, ATTN_KV_HEADS, HEAD_DIM), attn_k_norm[l])
        va = va.reshape(b, s, ATTN_KV_HEADS, HEAD_DIM)
        out_a = sliding_window_attention(qa, ka, va, attn_sinks[l], rel_bias)

        pb = token_shift(pb, rwkv_mu[l])
        if l == 0:
            vres = None
        else:
            v_down = token_shift(parts[5], rwkv_mu_vres[l - 1])
            vres = (v_first, v_down, rwkv_v0[l - 1], rwkv_v2[l - 1])
        out_b, v_l = rwkv7_mixer(pb, vres, rwkv_w0[l], rwkv_w2[l], rwkv_a0[l], rwkv_a2[l],
                                 rwkv_g2[l], rwkv_k_k[l], rwkv_k_a[l], rwkv_r_k[l],
                                 rwkv_ln_w[l], rwkv_ln_b[l])
        if l == 0:
            v_first = v_l

        mkv = rms_norm(mem, mem_norm_g[l]) @ w_mem_kv[l]
        mk, mv = jnp.split(mkv, 2, axis=-1)
        mk = rms_norm(mk.reshape(b, m_tok, MEM_HEADS, HEAD_DIM), mem_k_norm[l])
        mv = mv.reshape(b, m_tok, MEM_HEADS, HEAD_DIM)
        qm = rms_norm(qm.reshape(b, s, MEM_HEADS, HEAD_DIM), mem_q_norm[l])
        out_m = memory_attention(qm, mk, mv)

        x = x + jnp.concatenate([out_a, out_b, out_m], axis=-1) @ w_out[l]

        x = x + conv_ffn(rms_norm(x, ffn_norm_g[l]), w_up[l], conv_w[l], conv_b[l], w_down[l])
    return x
```

```cpp
#ifndef HOST_SIM
#include <hip/hip_runtime.h>
#include <cstdio>
#include <cstdint>
#endif
#ifndef SEQ_LEN
#define SEQ_LEN 8192
#endif
typedef unsigned short bf16_t;
constexpr int BATCH = 2, SEQ = SEQ_LEN, DM = 1024, MTOK = BATCH * SEQ, DFF = 2816, LDP = 2304  ;
constexpr float EPS = 1e-6f, GN_EPS = 64e-5f;
__host__ __device__ __forceinline__ float bf2f(bf16_t h) { unsigned u = (unsigned)h << 16; return __builtin_bit_cast(float, u); }
__host__ __device__ __forceinline__ bf16_t f2bf(float f) { unsigned u = __builtin_bit_cast(unsigned, f); return (bf16_t)((u + 0x7fffu + ((u >> 16) & 1u)) >> 16); }
__host__ __device__ __forceinline__ int t5_bucket(int dist) {
    if (dist < 16) return dist;
    const float v = logf((float)dist / 16.0f) / 2.0794415416798357f * 16.0f;
    int large = 16 + (int)v; return large < 31 ? large : 31;
}
namespace sk {

__global__ void k_wt(const float* W, const float* g, bf16_t* Wt, int K, int N, int Npad) {
    const long total = (long)Npad * K;
    for (long idx = (long)blockIdx.x * blockDim.x + threadIdx.x; idx < total; idx += (long)gridDim.x * blockDim.x) {
        const int n = (int)(idx / K), k = (int)(idx % K);
        float v = 0.f;
        if (n < N) { v = W[(long)k * N + n]; if (g) v *= g[k]; }
        Wt[idx] = f2bf(v);
    }
}
__global__ void k_rowprep(const float* x, bf16_t* xb, float* ssq, int rows) {
    for (int r = blockIdx.x * blockDim.x + threadIdx.x; r < rows; r += gridDim.x * blockDim.x) {
        const float* xr = x + (long)r * DM; bf16_t* o = xb + (long)r * DM; float s = 0.f;
        for (int c = 0; c < DM; ++c) { const float v = xr[c]; s += v * v; o[c] = f2bf(v); }
        ssq[r] = s;
    }
}
__global__ void k_biastab(const float* rel_bias, float* tab) {
    const int i = blockIdx.x * blockDim.x + threadIdx.x;
    if (i < 128 * 6) { const int dist = i / 6, hq = i % 6; tab[i] = rel_bias[t5_bucket(dist) * 6 + hq]; }
}
__global__ void k_qknorm(bf16_t* P, int rows, int ld, const float* gq, const float* gk, const float* gm, int mode) {
    const int nj = mode == 0 ? 12 : 4;
    const long total = (long)rows * nj;
    for (long idx = (long)blockIdx.x * blockDim.x + threadIdx.x; idx < total; idx += (long)gridDim.x * blockDim.x) {
        const int row = (int)(idx / nj), j = (int)(idx % nj);
        int col; const float* g;
        if (mode == 0) { if (j < 6) { col = 64 * j; g = gq; } else if (j < 8) { col = 384 + 64 * (j - 6); g = gk; } else { col = 1920 + 64 * (j - 8); g = gm; } }
        else { col = 64 * j; g = gm; }
        bf16_t* p = P + (long)row * ld + col; float s = 0.f;
        for (int d = 0; d < 64; ++d) { const float v = bf2f(p[d]); s += v * v; }
        const float rs = 1.0f / sqrtf(s * (1.0f / 64.0f) + EPS);
        for (int d = 0; d < 64; ++d) p[d] = f2bf(bf2f(p[d]) * rs * g[d]);
    }
}
__global__ __launch_bounds__(256) void k_swa(const bf16_t* P, bf16_t* MIX, const float* biastab, const float* sinks) {
    const long total = (long)MTOK * 6;
    for (long idx = (long)blockIdx.x * blockDim.x + threadIdx.x; idx < total; idx += (long)gridDim.x * blockDim.x) {
        const int tok = (int)(idx / 6), hq = (int)(idx % 6), hkv = hq / 3, t = tok % SEQ;
        float q[64], o[64];
#pragma unroll
        for (int d = 0; d < 64; ++d) { q[d] = bf2f(P[(long)tok * LDP + 64 * hq + d]) * 0.125f; o[d] = 0.f; }
        float m = sinks[hq], l = 1.0f;
        const int j0 = t - 127 < 0 ? 0 : t - 127;
        for (int j = j0; j <= t; ++j) {
            const bf16_t* kr = P + (long)(tok - (t - j)) * LDP + 384 + 64 * hkv; const bf16_t* vr = kr + 128;
            float s = 0.f;
#pragma unroll
            for (int d = 0; d < 64; ++d) s += q[d] * bf2f(kr[d]);
            s += biastab[(t - j) * 6 + hq];
            const float mn = fmaxf(m, s), f = expf(m - mn), e = expf(s - mn);
            l = l * f + e; m = mn;
#pragma unroll
            for (int d = 0; d < 64; ++d) o[d] = o[d] * f + e * bf2f(vr[d]);
        }
        const float inv = 1.0f / l;
#pragma unroll
        for (int d = 0; d < 64; ++d) MIX[(long)tok * DM + 64 * hq + d] = f2bf(o[d] * inv);
    }
}
__global__ __launch_bounds__(256) void k_memattn(const bf16_t* P, const bf16_t* MKV, bf16_t* MIX) {
    const long total = (long)MTOK * 4;
    for (long idx = (long)blockIdx.x * blockDim.x + threadIdx.x; idx < total; idx += (long)gridDim.x * blockDim.x) {
        const int tok = (int)(idx / 4), h = (int)(idx % 4), b = tok / SEQ;
        float q[64], o[64];
#pragma unroll
        for (int d = 0; d < 64; ++d) { q[d] = bf2f(P[(long)tok * LDP + 1920 + 64 * h + d]) * 0.125f; o[d] = 0.f; }
        float m = -1e30f, l = 0.f;
        for (int j = 0; j < 256; ++j) {
            const bf16_t* kr = MKV + (long)(b * 256 + j) * 512 + 64 * h; const bf16_t* vr = kr + 256;
            float s = 0.f;
#pragma unroll
            for (int d = 0; d < 64; ++d) s += q[d] * bf2f(kr[d]);
            const float mn = fmaxf(m, s), f = expf(m - mn), e = expf(s - mn);
            l = l * f + e; m = mn;
#pragma unroll
            for (int d = 0; d < 64; ++d) o[d] = o[d] * f + e * bf2f(vr[d]);
        }
        const float inv = 1.0f / l;
#pragma unroll
        for (int d = 0; d < 64; ++d) MIX[(long)tok * DM + 768 + 64 * h + d] = f2bf(o[d] * inv);
    }
}
__device__ __forceinline__ float shifted(const bf16_t* P, int tok, int col, float mu) {
    const float p = bf2f(P[(long)tok * LDP + col]);
    const float prev = (tok % SEQ) == 0 ? 0.f : bf2f(P[(long)(tok - 1) * LDP + col]);
    return p + mu * (prev - p);
}
struct RwkvW { const float *mu, *mu_v, *w0, *w2, *a0, *a2, *v0, *v2, *g2, *k_k, *k_a, *r_k, *ln_w, *ln_b; };
__global__ void k_rwkv_prep(const bf16_t* P, RwkvW W, int layer, bf16_t* VFIRST, bf16_t* R, bf16_t* K, bf16_t* V, bf16_t* KK, bf16_t* B, bf16_t* LOGD) {
    const long total = (long)MTOK * 6;
    for (long idx = (long)blockIdx.x * blockDim.x + threadIdx.x; idx < total; idx += (long)gridDim.x * blockDim.x) {
        const int tok = (int)(idx / 6), h = (int)(idx % 6);
        float nrm = 0.f;
        for (int c = 0; c < 64; ++c) { const int hc = 64 * h + c; const float kc = shifted(P, tok, 640 + 384 + hc, W.mu[384 + hc]) * W.k_k[hc]; nrm += kc * kc; }
        const float rn = 1.0f / fmaxf(sqrtf(nrm), 1e-12f);
        for (int c = 0; c < 64; ++c) {
            const int hc = 64 * h + c; const long o = (long)tok * 384 + hc;
            const float r = shifted(P, tok, 640 + hc, W.mu[hc]);
            const float k = shifted(P, tok, 640 + 384 + hc, W.mu[384 + hc]);
            float v = shifted(P, tok, 640 + 768 + hc, W.mu[768 + hc]);
            float wp = W.w0[hc], ap = W.a0[hc];
            for (int j = 0; j < 32; ++j) {
                wp += tanhf(shifted(P, tok, 640 + 1152 + j, W.mu[1152 + j])) * W.w2[j * 384 + hc];
                ap += shifted(P, tok, 640 + 1184 + j, W.mu[1184 + j]) * W.a2[j * 384 + hc];
            }
            const float z = -wp; const float sp = fmaxf(z, 0.f) + log1pf(expf(-fabsf(z)));
            const float w = -sp - 0.5f;
            const float a = 1.0f / (1.0f + expf(-ap));
            if (layer > 0) {
                float vp = W.v0[hc];
                for (int j = 0; j < 16; ++j) vp += shifted(P, tok, 2176 + j, W.mu_v[j]) * W.v2[j * 384 + hc];
                const float vf = bf2f(VFIRST[o]);
                v = v + (vf - v) * (1.0f / (1.0f + expf(-vp)));
            } else VFIRST[o] = f2bf(v);
            const float kk = k * W.k_k[hc] * rn;
            R[o] = f2bf(r); K[o] = f2bf(k * (1.0f + (a - 1.0f) * W.k_a[hc])); V[o] = f2bf(v);
            KK[o] = f2bf(kk); B[o] = f2bf(kk * a); LOGD[o] = f2bf(-expf(w));
        }
    }
}
__global__ void k_rwkv_scan(const bf16_t* R, const bf16_t* K, const bf16_t* V, const bf16_t* KK, const bf16_t* B, const bf16_t* LOGD, bf16_t* MIX) {
    const int bh = blockIdx.x, b = bh / 6, h = bh % 6, i = threadIdx.x;
    float s[64];
#pragma unroll
    for (int k = 0; k < 64; ++k) s[k] = 0.f;
    for (int t = 0; t < SEQ; ++t) {
        const long o = (long)(b * SEQ + t) * 384 + 64 * h;
        float sa = 0.f;
#pragma unroll
        for (int k = 0; k < 64; ++k) sa -= s[k] * bf2f(KK[o + k]);
        const float v = bf2f(V[o + i]); float y = 0.f;
#pragma unroll
        for (int k = 0; k < 64; ++k) { s[k] = s[k] * expf(bf2f(LOGD[o + k])) + sa * bf2f(B[o + k]) + v * bf2f(K[o + k]); y += s[k] * bf2f(R[o + k]); }
        MIX[(long)(b * SEQ + t) * DM + 384 + 64 * h + i] = f2bf(y);
    }
}
__global__ void k_rwkv_fin(const bf16_t* P, RwkvW W, const bf16_t* R, const bf16_t* K, const bf16_t* V, bf16_t* MIX) {
    const long total = (long)MTOK * 6;
    for (long idx = (long)blockIdx.x * blockDim.x + threadIdx.x; idx < total; idx += (long)gridDim.x * blockDim.x) {
        const int tok = (int)(idx / 6), h = (int)(idx % 6);
        bf16_t* y = MIX + (long)tok * DM + 384 + 64 * h; const long o = (long)tok * 384 + 64 * h;
        float mean = 0.f, dot = 0.f;
        for (int c = 0; c < 64; ++c) { mean += bf2f(y[c]); dot += bf2f(R[o + c]) * bf2f(K[o + c]) * W.r_k[64 * h + c]; }
        mean *= (1.0f / 64.0f); float var = 0.f;
        for (int c = 0; c < 64; ++c) { const float d = bf2f(y[c]) - mean; var += d * d; }
        const float rstd = 1.0f / sqrtf(var * (1.0f / 64.0f) + GN_EPS);
        for (int c = 0; c < 64; ++c) {
            const int hc = 64 * h + c; float g = 0.f;
            for (int j = 0; j < 64; ++j) g += (1.0f / (1.0f + expf(-shifted(P, tok, 640 + 1216 + j, W.mu[1216 + j])))) * W.g2[j * 384 + hc];
            const float yn = (bf2f(y[c]) - mean) * rstd * W.ln_w[hc] + W.ln_b[hc];
            y[c] = f2bf((yn + dot * bf2f(V[o + c])) * g);
        }
    }
}
__global__ void k_conv_act(const bf16_t* U, const float* cw, const float* cb, bf16_t* ACT, int rows) {
    const long total = (long)rows * DFF;
    for (long idx = (long)blockIdx.x * blockDim.x + threadIdx.x; idx < total; idx += (long)gridDim.x * blockDim.x) {
        const int t = (int)(idx / DFF), c = (int)(idx % DFF);
        float gate = cb[c], val = cb[DFF + c];
#pragma unroll
        for (int i = 0; i < 3; ++i) { const int tt = t - 2 + i; if (tt >= 0) { gate += cw[i * 2 * DFF + c] * bf2f(U[(long)tt * 2 * DFF + c]); val += cw[i * 2 * DFF + DFF + c] * bf2f(U[(long)tt * 2 * DFF + DFF + c]); } }
        ACT[(long)t * DFF + c] = f2bf(gate / (1.0f + expf(-gate)) * val);
    }
}
}
namespace sk {
#ifndef HOST_SIM
typedef short bf16x8_t __attribute__((ext_vector_type(8)));
typedef float f32x4_t __attribute__((ext_vector_type(4)));
template <int MODE> __global__ __launch_bounds__(256) void k_gemm(const bf16_t* A, const bf16_t* Bt, int M, int N, int K, void* out, int ldc, const float* ssq, const float* base) {
    __shared__ __attribute__((aligned(16))) bf16_t sA[64 * 40], sB[64 * 40];
    const int tid = threadIdx.x, wave = tid >> 6, lane = tid & 63, wr = wave >> 1, wc = wave & 1, fr = lane & 15, fq = lane >> 4;
    const int row0 = blockIdx.y * 64, col0 = blockIdx.x * 64;
    const int lr = tid >> 2, lk = (tid & 3) * 8;
    f32x4_t acc[2][2];
#pragma unroll
    for (int i = 0; i < 2; ++i)
#pragma unroll
        for (int j = 0; j < 2; ++j) acc[i][j] = (f32x4_t){0.f, 0.f, 0.f, 0.f};
    for (int k0 = 0; k0 < K; k0 += 32) {
        const uint4 va = *(const uint4*)(A + (long)(row0 + lr) * K + k0 + lk);
        const uint4 vb = *(const uint4*)(Bt + (long)(col0 + lr) * K + k0 + lk);
        *(uint4*)(sA + lr * 40 + lk) = va; *(uint4*)(sB + lr * 40 + lk) = vb;
        __syncthreads();
        bf16x8_t a[2], b[2];
#pragma unroll
        for (int i = 0; i < 2; ++i) { a[i] = *(const bf16x8_t*)(sA + (32 * wr + 16 * i + fr) * 40 + 8 * fq); b[i] = *(const bf16x8_t*)(sB + (32 * wc + 16 * i + fr) * 40 + 8 * fq); }
#pragma unroll
        for (int i = 0; i < 2; ++i)
#pragma unroll
            for (int j = 0; j < 2; ++j) acc[i][j] = __builtin_amdgcn_mfma_f32_16x16x32_bf16(a[i], b[j], acc[i][j], 0, 0, 0);
        __syncthreads();
    }
#pragma unroll
    for (int i = 0; i < 2; ++i)
#pragma unroll
        for (int j = 0; j < 2; ++j)
#pragma unroll
            for (int r = 0; r < 4; ++r) {
                const int row = row0 + 32 * wr + 16 * i + 4 * fq + r, col = col0 + 32 * wc + 16 * j + fr;
                if (MODE == 0) ((bf16_t*)out)[(long)row * ldc + col] = f2bf(acc[i][j][r] * (1.0f / sqrtf(ssq[row] * (1.0f / 1024.0f) + EPS)));
                else ((float*)out)[(long)row * ldc + col] = base[(long)row * ldc + col] + acc[i][j][r];
            }
}
#endif
template <int MODE> void gemm(hipStream_t stream, const bf16_t* A, const bf16_t* Bt, int M, int N, int K, void* out, int ldc, const float* ssq, const float* base) {
#ifndef HOST_SIM
    hipLaunchKernelGGL(k_gemm<MODE>, dim3(N / 64, M / 64), dim3(256), 0, stream, A, Bt, M, N, K, out, ldc, ssq, base);
#else
    #pragma omp parallel for
    for (int row = 0; row < M; ++row) for (int col = 0; col < N; ++col) {
        float acc = 0.f; for (int k = 0; k < K; ++k) acc += bf2f(A[(long)row * K + k]) * bf2f(Bt[(long)col * K + k]);
        if (MODE == 0) ((bf16_t*)out)[(long)row * ldc + col] = f2bf(acc * (1.0f / sqrtf(ssq[row] * (1.0f / 1024.0f) + EPS)));
        else ((float*)out)[(long)row * ldc + col] = base[(long)row * ldc + col] + acc;
    }
#endif
}
}
#ifndef HOST_SIM
#define LAUNCH(k, g, b, ...) hipLaunchKernelGGL(k, dim3(g), dim3(b), 0, stream, __VA_ARGS__)
#endif
constexpr size_t MiB = 1u << 20;
enum { I_X = 0, I_MEM, I_RELB, I_MIXG, I_WIN, I_WINV, I_AQN, I_AKN, I_SINK, I_MU, I_MUV, I_W0, I_W2, I_A0, I_A2, I_V0, I_V2, I_G2, I_KK, I_KA, I_RK, I_LNW, I_LNB, I_MEMG, I_WMKV, I_MQN, I_MKN, I_WOUT, I_FFNG, I_WUP, I_CW, I_CB, I_WDOWN, N_IN };
namespace simple {
constexpr size_t WS_SMALL = 0, WS_WT = 2 * MiB, WS_XB = 26 * MiB, WS_VF = 58 * MiB, WS_PROJ = 70 * MiB, WS_MIX = 142 * MiB, WS_PREP = 174 * MiB, WS_U = 70 * MiB, WS_ACT = 158 * MiB;
constexpr size_t SM_SSQ = 0, SM_SSQM = 64 * 1024, SM_BIAS = 68 * 1024, SM_MKV = 128 * 1024, SM_MEMB = 1024 * 1024;
constexpr size_t WT_IN = 0, WT_OUT = 4718592, WT_UP = WT_OUT + 2 * MiB, WT_DOWN = WT_UP + 11 * MiB, WT_MKV = WT_DOWN + 5767168;
static_assert(WT_MKV + MiB <= 24 * MiB, "weights");
static void run(void* const* d_in, float* out, unsigned char* ws, hipStream_t stream) {
    const float* const* in = (const float* const*)d_in;
    float* ssq = (float*)(ws + WS_SMALL + SM_SSQ); float* ssqm = (float*)(ws + WS_SMALL + SM_SSQM); float* biastab = (float*)(ws + WS_SMALL + SM_BIAS);
    bf16_t* MKV = (bf16_t*)(ws + WS_SMALL + SM_MKV); bf16_t* MEMB = (bf16_t*)(ws + WS_SMALL + SM_MEMB);
    bf16_t* Wt_in = (bf16_t*)(ws + WS_WT + WT_IN); bf16_t* Wt_out = (bf16_t*)(ws + WS_WT + WT_OUT); bf16_t* Wt_up = (bf16_t*)(ws + WS_WT + WT_UP);
    bf16_t* Wt_down = (bf16_t*)(ws + WS_WT + WT_DOWN); bf16_t* Wt_mkv = (bf16_t*)(ws + WS_WT + WT_MKV);
    bf16_t* XB = (bf16_t*)(ws + WS_XB); bf16_t* VF = (bf16_t*)(ws + WS_VF); bf16_t* PROJ = (bf16_t*)(ws + WS_PROJ); bf16_t* MIX = (bf16_t*)(ws + WS_MIX);
    bf16_t* U = (bf16_t*)(ws + WS_U); bf16_t* ACT = (bf16_t*)(ws + WS_ACT);
    const size_t PA = (size_t)MTOK * 384;
    bf16_t* pR = (bf16_t*)(ws + WS_PREP); bf16_t* pK = pR + PA; bf16_t* pV = pK + PA; bf16_t* pKK = pV + PA; bf16_t* pB = pKK + PA; bf16_t* pLD = pB + PA;
    LAUNCH(sk::k_biastab, 3, 256, in[I_RELB], biastab);
    LAUNCH(sk::k_rowprep, 2, 256, in[I_MEM], MEMB, ssqm, 512);
    for (int l = 0; l < 2; ++l) {
        const float* xin = l == 0 ? in[I_X] : out;
        LAUNCH(sk::k_wt, 2048, 256, in[I_WIN] + (size_t)l * 1024 * 2176, in[I_MIXG] + l * 1024, Wt_in, 1024, 2176, 2304);
        if (l > 0) LAUNCH(sk::k_wt, 64, 256, in[I_WINV], in[I_MIXG] + l * 1024, Wt_in + (size_t)2176 * 1024, 1024, 16, 16);
        LAUNCH(sk::k_wt, 2048, 256, in[I_WOUT] + (size_t)l * 1024 * 1024, (const float*)nullptr, Wt_out, 1024, 1024, 1024);
        LAUNCH(sk::k_wt, 2048, 256, in[I_WUP] + (size_t)l * 1024 * 5632, in[I_FFNG] + l * 1024, Wt_up, 1024, 5632, 5632);
        LAUNCH(sk::k_wt, 2048, 256, in[I_WDOWN] + (size_t)l * 2816 * 1024, (const float*)nullptr, Wt_down, 2816, 1024, 1024);
        LAUNCH(sk::k_wt, 2048, 256, in[I_WMKV] + (size_t)l * 1024 * 512, in[I_MEMG] + l * 1024, Wt_mkv, 1024, 512, 512);
        LAUNCH(sk::k_rowprep, (MTOK + 63) / 64, 64, xin, XB, ssq, MTOK);
        sk::gemm<0>(stream, XB, Wt_in, MTOK, 2304, 1024, PROJ, LDP, ssq, nullptr);
        sk::gemm<0>(stream, MEMB, Wt_mkv, 512, 512, 1024, MKV, 512, ssqm, nullptr);
        LAUNCH(sk::k_qknorm, 1024, 256, PROJ, MTOK, LDP, in[I_AQN] + l * 64, in[I_AKN] + l * 64, in[I_MQN] + l * 64, 0);
        LAUNCH(sk::k_qknorm, 8, 256, MKV, 512, 512, (const float*)nullptr, (const float*)nullptr, in[I_MKN] + l * 64, 1);
        LAUNCH(sk::k_swa, (MTOK * 6 + 255) / 256, 256, PROJ, MIX, biastab, in[I_SINK] + l * 6);
        LAUNCH(sk::k_memattn, (MTOK * 4 + 255) / 256, 256, PROJ, MKV, MIX);
        sk::RwkvW W{in[I_MU] + l * 1280, in[I_MUV], in[I_W0] + l * 384, in[I_W2] + l * 32 * 384, in[I_A0] + l * 384, in[I_A2] + l * 32 * 384, in[I_V0], in[I_V2],
                    in[I_G2] + l * 64 * 384, in[I_KK] + l * 384, in[I_KA] + l * 384, in[I_RK] + l * 384, in[I_LNW] + l * 384, in[I_LNB] + l * 384};
        LAUNCH(sk::k_rwkv_prep, (MTOK * 6 + 255) / 256, 256, PROJ, W, l, VF, pR, pK, pV, pKK, pB, pLD);
        LAUNCH(sk::k_rwkv_scan, BATCH * 6, 64, pR, pK, pV, pKK, pB, pLD, MIX);
        LAUNCH(sk::k_rwkv_fin, (MTOK * 6 + 255) / 256, 256, PROJ, W, pR, pK, pV, MIX);
        sk::gemm<1>(stream, MIX, Wt_out, MTOK, 1024, 1024, out, 1024, nullptr, xin);
        LAUNCH(sk::k_rowprep, (MTOK + 63) / 64, 64, out, XB, ssq, MTOK);
        for (int b = 0; b < BATCH; ++b) {
            sk::gemm<0>(stream, XB + (size_t)b * SEQ * 1024, Wt_up, SEQ, 5632, 1024, U, 5632, ssq + b * SEQ, nullptr);
            LAUNCH(sk::k_conv_act, 4096, 256, U, in[I_CW] + (size_t)l * 3 * 5632, in[I_CB] + (size_t)l * 5632, ACT + (size_t)b * SEQ * DFF, SEQ);
        }
        sk::gemm<1>(stream, ACT, Wt_down, MTOK, 1024, 2816, out, 1024, nullptr, out);
    }
}
}
extern "C" void kernel_launch(void* const* d_in, const int* in_sizes, int n_in, void* d_out, int out_size, void* d_ws, size_t ws_size, hipStream_t stream) {
    simple::run(d_in, (float*)d_out, (unsigned char*)d_ws, stream);
}
```

```cpp
#define MK_BUILD 1
#ifndef HOST_SIM
#include <hip/hip_runtime.h>
#include <cstdio>
#include <cstdint>
#endif
#ifndef SEQ_LEN
#define SEQ_LEN 8192
#endif
typedef unsigned short bf16_t;
constexpr int BATCH = 2, SEQ = SEQ_LEN, DM = 1024, MTOK = BATCH * SEQ, DFF = 2816, LDP = 2304  ;
constexpr float EPS = 1e-6f, GN_EPS = 64e-5f;
__host__ __device__ __forceinline__ float bf2f(bf16_t h) { unsigned u = (unsigned)h << 16; return __builtin_bit_cast(float, u); }
__host__ __device__ __forceinline__ bf16_t f2bf(float f) { unsigned u = __builtin_bit_cast(unsigned, f); return (bf16_t)((u + 0x7fffu + ((u >> 16) & 1u)) >> 16); }
__host__ __device__ __forceinline__ int t5_bucket(int dist) {
    if (dist < 16) return dist;
    const float v = logf((float)dist / 16.0f) / 2.0794415416798357f * 16.0f;
    int large = 16 + (int)v; return large < 31 ? large : 31;
}
constexpr size_t MiB = 1u << 20;
enum { I_X = 0, I_MEM, I_RELB, I_MIXG, I_WIN, I_WINV, I_AQN, I_AKN, I_SINK, I_MU, I_MUV, I_W0, I_W2, I_A0, I_A2, I_V0, I_V2, I_G2, I_KK, I_KA, I_RK, I_LNW, I_LNB, I_MEMG, I_WMKV, I_MQN, I_MKN, I_WOUT, I_FFNG, I_WUP, I_CW, I_CB, I_WDOWN, N_IN };
namespace sk {

__device__ __forceinline__ void d_wt(const float* W, const float* g, bf16_t* Wt, int K, int N, int Npad, long gtid, long gsize) {
    const long total = (long)Npad * K;
    for (long idx = gtid; idx < total; idx += gsize) {
        const int n = (int)(idx / K), k = (int)(idx % K);
        float v = 0.f;
        if (n < N) { v = W[(long)k * N + n]; if (g) v *= g[k]; }
        Wt[idx] = f2bf(v);
    }
}
#ifndef MK_BUILD
__global__ void k_wt(const float* W, const float* g, bf16_t* Wt, int K, int N, int Npad) { d_wt(W, g, Wt, K, N, Npad, (long)blockIdx.x * blockDim.x + threadIdx.x, (long)gridDim.x * blockDim.x); }
#endif
__device__ __forceinline__ void d_rowprep(const float* x, bf16_t* xb, float* ssq, int rows, long gtid, long gsize) {
    for (long r = gtid; r < rows; r += gsize) {
        const float* xr = x + (long)r * DM; bf16_t* o = xb + (long)r * DM; float s = 0.f;
        for (int c = 0; c < DM; ++c) { const float v = xr[c]; s += v * v; o[c] = f2bf(v); }
        ssq[r] = s;
    }
}
#ifndef MK_BUILD
__global__ void k_rowprep(const float* x, bf16_t* xb, float* ssq, int rows) { d_rowprep(x, xb, ssq, rows, (long)blockIdx.x * blockDim.x + threadIdx.x, (long)gridDim.x * blockDim.x); }
#endif
__device__ __forceinline__ void d_biastab(const float* rel_bias, float* tab, long gtid, long gsize) {
        for (long i = gtid; i < 128 * 6; i += gsize) { const int dist = i / 6, hq = i % 6; tab[i] = rel_bias[t5_bucket(dist) * 6 + hq]; }
}
#ifndef MK_BUILD
__global__ void k_biastab(const float* rel_bias, float* tab) { d_biastab(rel_bias, tab, (long)blockIdx.x * blockDim.x + threadIdx.x, (long)gridDim.x * blockDim.x); }
#endif
__device__ __forceinline__ void d_qknorm(bf16_t* P, int rows, int ld, const float* gq, const float* gk, const float* gm, int mode, long gtid, long gsize) {
    const int nj = mode == 0 ? 12 : 4;
    const long total = (long)rows * nj;
    for (long idx = gtid; idx < total; idx += gsize) {
        const int row = (int)(idx / nj), j = (int)(idx % nj);
        int col; const float* g;
        if (mode == 0) { if (j < 6) { col = 64 * j; g = gq; } else if (j < 8) { col = 384 + 64 * (j - 6); g = gk; } else { col = 1920 + 64 * (j - 8); g = gm; } }
        else { col = 64 * j; g = gm; }
        bf16_t* p = P + (long)row * ld + col; float s = 0.f;
        for (int d = 0; d < 64; ++d) { const float v = bf2f(p[d]); s += v * v; }
        const float rs = 1.0f / sqrtf(s * (1.0f / 64.0f) + EPS);
        for (int d = 0; d < 64; ++d) p[d] = f2bf(bf2f(p[d]) * rs * g[d]);
    }
}
#ifndef MK_BUILD
__global__ void k_qknorm(bf16_t* P, int rows, int ld, const float* gq, const float* gk, const float* gm, int mode) { d_qknorm(P, rows, ld, gq, gk, gm, mode, (long)blockIdx.x * blockDim.x + threadIdx.x, (long)gridDim.x * blockDim.x); }
#endif
__device__ __forceinline__ void d_swa(const bf16_t* P, bf16_t* MIX, const float* biastab, const float* sinks, long gtid, long gsize) {
    const long total = (long)MTOK * 6;
    for (long idx = gtid; idx < total; idx += gsize) {
        const int tok = (int)(idx / 6), hq = (int)(idx % 6), hkv = hq / 3, t = tok % SEQ;
        float q[64], o[64];
#pragma unroll
        for (int d = 0; d < 64; ++d) { q[d] = bf2f(P[(long)tok * LDP + 64 * hq + d]) * 0.125f; o[d] = 0.f; }
        float m = sinks[hq], l = 1.0f;
        const int j0 = t - 127 < 0 ? 0 : t - 127;
        for (int j = j0; j <= t; ++j) {
            const bf16_t* kr = P + (long)(tok - (t - j)) * LDP + 384 + 64 * hkv; const bf16_t* vr = kr + 128;
            float s = 0.f;
#pragma unroll
            for (int d = 0; d < 64; ++d) s += q[d] * bf2f(kr[d]);
            s += biastab[(t - j) * 6 + hq];
            const float mn = fmaxf(m, s), f = expf(m - mn), e = expf(s - mn);
            l = l * f + e; m = mn;
#pragma unroll
            for (int d = 0; d < 64; ++d) o[d] = o[d] * f + e * bf2f(vr[d]);
        }
        const float inv = 1.0f / l;
#pragma unroll
        for (int d = 0; d < 64; ++d) MIX[(long)tok * DM + 64 * hq + d] = f2bf(o[d] * inv);
    }
}
#ifndef MK_BUILD
__global__ __launch_bounds__(256) void k_swa(const bf16_t* P, bf16_t* MIX, const float* biastab, const float* sinks) { d_swa(P, MIX, biastab, sinks, (long)blockIdx.x * blockDim.x + threadIdx.x, (long)gridDim.x * blockDim.x); }
#endif
__device__ __forceinline__ void d_memattn(const bf16_t* P, const bf16_t* MKV, bf16_t* MIX, long gtid, long gsize) {
    const long total = (long)MTOK * 4;
    for (long idx = gtid; idx < total; idx += gsize) {
        const int tok = (int)(idx / 4), h = (int)(idx % 4), b = tok / SEQ;
        float q[64], o[64];
#pragma unroll
        for (int d = 0; d < 64; ++d) { q[d] = bf2f(P[(long)tok * LDP + 1920 + 64 * h + d]) * 0.125f; o[d] = 0.f; }
        float m = -1e30f, l = 0.f;
        for (int j = 0; j < 256; ++j) {
            const bf16_t* kr = MKV + (long)(b * 256 + j) * 512 + 64 * h; const bf16_t* vr = kr + 256;
            float s = 0.f;
#pragma unroll
            for (int d = 0; d < 64; ++d) s += q[d] * bf2f(kr[d]);
            const float mn = fmaxf(m, s), f = expf(m - mn), e = expf(s - mn);
            l = l * f + e; m = mn;
#pragma unroll
            for (int d = 0; d < 64; ++d) o[d] = o[d] * f + e * bf2f(vr[d]);
        }
        const float inv = 1.0f / l;
#pragma unroll
        for (int d = 0; d < 64; ++d) MIX[(long)tok * DM + 768 + 64 * h + d] = f2bf(o[d] * inv);
    }
}
#ifndef MK_BUILD
__global__ __launch_bounds__(256) void k_memattn(const bf16_t* P, const bf16_t* MKV, bf16_t* MIX) { d_memattn(P, MKV, MIX, (long)blockIdx.x * blockDim.x + threadIdx.x, (long)gridDim.x * blockDim.x); }
#endif
__device__ __forceinline__ float shifted(const bf16_t* P, int tok, int col, float mu) {
    const float p = bf2f(P[(long)tok * LDP + col]);
    const float prev = (tok % SEQ) == 0 ? 0.f : bf2f(P[(long)(tok - 1) * LDP + col]);
    return p + mu * (prev - p);
}
struct RwkvW { const float *mu, *mu_v, *w0, *w2, *a0, *a2, *v0, *v2, *g2, *k_k, *k_a, *r_k, *ln_w, *ln_b; };
__device__ __forceinline__ void d_rwkv_prep(const bf16_t* P, RwkvW W, int layer, bf16_t* VFIRST, bf16_t* R, bf16_t* K, bf16_t* V, bf16_t* KK, bf16_t* B, bf16_t* LOGD, long gtid, long gsize) {
    const long total = (long)MTOK * 6;
    for (long idx = gtid; idx < total; idx += gsize) {
        const int tok = (int)(idx / 6), h = (int)(idx % 6);
        float nrm = 0.f;
        for (int c = 0; c < 64; ++c) { const int hc = 64 * h + c; const float kc = shifted(P, tok, 640 + 384 + hc, W.mu[384 + hc]) * W.k_k[hc]; nrm += kc * kc; }
        const float rn = 1.0f / fmaxf(sqrtf(nrm), 1e-12f);
        for (int c = 0; c < 64; ++c) {
            const int hc = 64 * h + c; const long o = (long)tok * 384 + hc;
            const float r = shifted(P, tok, 640 + hc, W.mu[hc]);
            const float k = shifted(P, tok, 640 + 384 + hc, W.mu[384 + hc]);
            float v = shifted(P, tok, 640 + 768 + hc, W.mu[768 + hc]);
            float wp = W.w0[hc], ap = W.a0[hc];
            for (int j = 0; j < 32; ++j) {
                wp += tanhf(shifted(P, tok, 640 + 1152 + j, W.mu[1152 + j])) * W.w2[j * 384 + hc];
                ap += shifted(P, tok, 640 + 1184 + j, W.mu[1184 + j]) * W.a2[j * 384 + hc];
            }
            const float z = -wp; const float sp = fmaxf(z, 0.f) + log1pf(expf(-fabsf(z)));
            const float w = -sp - 0.5f;
            const float a = 1.0f / (1.0f + expf(-ap));
            if (layer > 0) {
                float vp = W.v0[hc];
                for (int j = 0; j < 16; ++j) vp += shifted(P, tok, 2176 + j, W.mu_v[j]) * W.v2[j * 384 + hc];
                const float vf = bf2f(VFIRST[o]);
                v = v + (vf - v) * (1.0f / (1.0f + expf(-vp)));
            } else VFIRST[o] = f2bf(v);
            const float kk = k * W.k_k[hc] * rn;
            R[o] = f2bf(r); K[o] = f2bf(k * (1.0f + (a - 1.0f) * W.k_a[hc])); V[o] = f2bf(v);
            KK[o] = f2bf(kk); B[o] = f2bf(kk * a); LOGD[o] = f2bf(-expf(w));
        }
    }
}
#ifndef MK_BUILD
__global__ void k_rwkv_prep(const bf16_t* P, RwkvW W, int layer, bf16_t* VFIRST, bf16_t* R, bf16_t* K, bf16_t* V, bf16_t* KK, bf16_t* B, bf16_t* LOGD) { d_rwkv_prep(P, W, layer, VFIRST, R, K, V, KK, B, LOGD, (long)blockIdx.x * blockDim.x + threadIdx.x, (long)gridDim.x * blockDim.x); }
#endif
__device__ __forceinline__ void d_rwkv_scan(const bf16_t* R, const bf16_t* K, const bf16_t* V, const bf16_t* KK, const bf16_t* B, const bf16_t* LOGD, bf16_t* MIX, int bh, int i) {
    const int b = bh / 6, h = bh % 6;
    float s[64];
#pragma unroll
    for (int k = 0; k < 64; ++k) s[k] = 0.f;
    for (int t = 0; t < SEQ; ++t) {
        const long o = (long)(b * SEQ + t) * 384 + 64 * h;
        float sa = 0.f;
#pragma unroll
        for (int k = 0; k < 64; ++k) sa -= s[k] * bf2f(KK[o + k]);
        const float v = bf2f(V[o + i]); float y = 0.f;
#pragma unroll
        for (int k = 0; k < 64; ++k) { s[k] = s[k] * expf(bf2f(LOGD[o + k])) + sa * bf2f(B[o + k]) + v * bf2f(K[o + k]); y += s[k] * bf2f(R[o + k]); }
        MIX[(long)(b * SEQ + t) * DM + 384 + 64 * h + i] = f2bf(y);
    }
}
#ifndef MK_BUILD
__global__ void k_rwkv_scan(const bf16_t* R, const bf16_t* K, const bf16_t* V, const bf16_t* KK, const bf16_t* B, const bf16_t* LOGD, bf16_t* MIX) { d_rwkv_scan(R, K, V, KK, B, LOGD, MIX, blockIdx.x, threadIdx.x); }
#endif
__device__ __forceinline__ void d_rwkv_fin(const bf16_t* P, RwkvW W, const bf16_t* R, const bf16_t* K, const bf16_t* V, bf16_t* MIX, long gtid, long gsize) {
    const long total = (long)MTOK * 6;
    for (long idx = gtid; idx < total; idx += gsize) {
        const int tok = (int)(idx / 6), h = (int)(idx % 6);
        bf16_t* y = MIX + (long)tok * DM + 384 + 64 * h; const long o = (long)tok * 384 + 64 * h;
        float mean = 0.f, dot = 0.f;
        for (int c = 0; c < 64; ++c) { mean += bf2f(y[c]); dot += bf2f(R[o + c]) * bf2f(K[o + c]) * W.r_k[64 * h + c]; }
        mean *= (1.0f / 64.0f); float var = 0.f;
        for (int c = 0; c < 64; ++c) { const float d = bf2f(y[c]) - mean; var += d * d; }
        const float rstd = 1.0f / sqrtf(var * (1.0f / 64.0f) + GN_EPS);
        for (int c = 0; c < 64; ++c) {
            const int hc = 64 * h + c; float g = 0.f;
            for (int j = 0; j < 64; ++j) g += (1.0f / (1.0f + expf(-shifted(P, tok, 640 + 1216 + j, W.mu[1216 + j])))) * W.g2[j * 384 + hc];
            const float yn = (bf2f(y[c]) - mean) * rstd * W.ln_w[hc] + W.ln_b[hc];
            y[c] = f2bf((yn + dot * bf2f(V[o + c])) * g);
        }
    }
}
#ifndef MK_BUILD
__global__ void k_rwkv_fin(const bf16_t* P, RwkvW W, const bf16_t* R, const bf16_t* K, const bf16_t* V, bf16_t* MIX) { d_rwkv_fin(P, W, R, K, V, MIX, (long)blockIdx.x * blockDim.x + threadIdx.x, (long)gridDim.x * blockDim.x); }
#endif
__device__ __forceinline__ void d_conv_act(const bf16_t* U, const float* cw, const float* cb, bf16_t* ACT, int rows, long gtid, long gsize) {
    const long total = (long)rows * DFF;
    for (long idx = gtid; idx < total; idx += gsize) {
        const int t = (int)(idx / DFF), c = (int)(idx % DFF);
        float gate = cb[c], val = cb[DFF + c];
#pragma unroll
        for (int i = 0; i < 3; ++i) { const int tt = t - 2 + i; if (tt >= 0) { gate += cw[i * 2 * DFF + c] * bf2f(U[(long)tt * 2 * DFF + c]); val += cw[i * 2 * DFF + DFF + c] * bf2f(U[(long)tt * 2 * DFF + DFF + c]); } }
        ACT[(long)t * DFF + c] = f2bf(gate / (1.0f + expf(-gate)) * val);
    }
}
#ifndef MK_BUILD
__global__ void k_conv_act(const bf16_t* U, const float* cw, const float* cb, bf16_t* ACT, int rows) { d_conv_act(U, cw, cb, ACT, rows, (long)blockIdx.x * blockDim.x + threadIdx.x, (long)gridDim.x * blockDim.x); }
#endif
}
namespace pg8 {
#define PG8_LAS __attribute__((address_space(3)))
typedef unsigned short bf16_t;
typedef short bf16x8 __attribute__((ext_vector_type(8)));
typedef float f32x4 __attribute__((ext_vector_type(4)));
typedef unsigned u32x4 __attribute__((ext_vector_type(4)));
constexpr int BM = 256, BK = 64, HALF = 128, HTB = HALF * BK * 2  , STAGE_BYTES = 8 * HTB, NXCD = 8, WGM = 8;

__host__ __device__ __forceinline__ int lds_byte(int r, int c) { const int st = (r >> 4) * 2 + (c >> 5), rr = r & 15, cc = c & 31, ob = rr * 64 + cc * 2; return st * 1024 + (ob ^ (((ob >> 9) & 1) << 5)); }
__host__ __device__ __forceinline__ void stage_rc(int b, int& R, int& C) { const int st = b / 1024, sb = b % 1024, swz = sb ^ (((sb >> 9) & 1) << 5); R = (st >> 1) * 16 + swz / 64; C = (st & 1) * 32 + (swz % 64) / 2; }
__host__ __device__ __forceinline__ int perm32(int rho) { const int n = rho >> 4, i = rho & 15; return 8 * (i >> 2) + 4 * n + (i & 3); }

struct Unit { int pm, pn; };
struct Gemm { const bf16_t* A; const bf16_t* Bt; int M, N, K; };

struct StaticOrder {
    int nM, nN, nwg, G, c;
    __host__ __device__ void init(int M, int N, int G_, int c_) { nM = M / BM; nN = N / BM; nwg = nM * nN; G = G_; c = c_; }
    __host__ __device__ bool next(int i, Unit& u) const {
        const long L = (long)i * G + c; if (L >= nwg) return false;
        int wgid = (int)L; { const int q = nwg / NXCD, r = nwg % NXCD, xcd = wgid % NXCD, off = wgid / NXCD; wgid = (xcd < r ? xcd * (q + 1) : r * (q + 1) + (xcd - r) * q) + off; }
        const int nig = WGM * nN, gid = wgid / nig, fm = gid * WGM, gsz = (nM - fm) < WGM ? (nM - fm) : WGM;
        u.pm = fm + ((wgid % nig) % gsz); u.pn = (wgid % nig) / gsz; return true;
    }
    __device__ __forceinline__ void a_ready(const Unit&) const {}
    __device__ __forceinline__ void done(const Unit&) const {}
};

__device__ __forceinline__ unsigned cvt_pk_bf16(float lo, float hi) { unsigned r; asm volatile("v_cvt_pk_bf16_f32 %0, %1, %2" : "=v"(r) : "v"(lo), "v"(hi)); return r; }
struct EpiScaleBf16 {
    static constexpr bool PERM = true, AFTER_DRAIN = false;
    bf16_t* O; int ldc; const float* ssq;
    __device__ __forceinline__ void operator()(const f32x4 (&acc)[2][2][4][2], const Unit& u, int wr, int wc, int fr, int fq) const {
        const int row0 = u.pm * BM + wr * 64 + fr, col0 = u.pn * BM + wc * 32 + 8 * fq;
#pragma unroll
        for (int ai = 0; ai < 2; ++ai)
#pragma unroll
            for (int m = 0; m < 4; ++m) { const int row = row0 + ai * HALF + m * 16; const float sc = 1.0f / sqrtf(ssq[row] * (1.0f / 1024.0f) + 1e-6f);
                bf16_t* rowp = O + (size_t)row * ldc + col0;
#pragma unroll
                for (int bj = 0; bj < 2; ++bj) { const f32x4 v0 = acc[ai][bj][m][0] * sc, v1 = acc[ai][bj][m][1] * sc;
                    u32x4 w; w.x = cvt_pk_bf16(v0[0], v0[1]); w.y = cvt_pk_bf16(v0[2], v0[3]); w.z = cvt_pk_bf16(v1[0], v1[1]); w.w = cvt_pk_bf16(v1[2], v1[3]);
                    *(u32x4*)(rowp + bj * HALF) = w; } }
    }
};
struct EpiResid {
    static constexpr bool PERM = false, AFTER_DRAIN = false;
    const float* base; float* out; bf16_t* xb; float* ssq; int ldc;
    __device__ __forceinline__ void operator()(const f32x4 (&acc)[2][2][4][2], const Unit& u, int wr, int wc, int fr, int fq) const {
        typedef unsigned u32x2v __attribute__((ext_vector_type(2)));
        const int col0 = u.pn * BM + wc * 32 + 4 * fq;
#pragma unroll
        for (int ai = 0; ai < 2; ++ai)
#pragma unroll
            for (int m = 0; m < 4; ++m) { const int row = u.pm * BM + ai * HALF + wr * 64 + m * 16 + fr; const size_t off = (size_t)row * ldc + col0; float sq = 0.f;
#pragma unroll
                for (int bj = 0; bj < 2; ++bj)
#pragma unroll
                    for (int n = 0; n < 2; ++n) { const f32x4 o = *(const f32x4*)(base + off + bj * HALF + n * 16) + acc[ai][bj][m][n];
                        *(f32x4*)(out + off + bj * HALF + n * 16) = o; sq += (o[0] * o[0] + o[1] * o[1]) + (o[2] * o[2] + o[3] * o[3]);
                        u32x2v w; w.x = cvt_pk_bf16(o[0], o[1]); w.y = cvt_pk_bf16(o[2], o[3]); *(u32x2v*)(xb + off + bj * HALF + n * 16) = w; }
                sq += __shfl_xor(sq, 16); sq += __shfl_xor(sq, 32);
                if (fq == 0) atomicAdd(ssq + row, sq); }
    }
};
template <class Epi, class Sched, bool ALIGN_EPI = false, bool SP2 = false>
__device__ __forceinline__ void gemm_phase(PG8_LAS unsigned char* lds, const Gemm g, const Sched& S, const Epi& E) {
    int tid = threadIdx.x; asm volatile("" : "+v"(tid));
    const int wid = __builtin_amdgcn_readfirstlane(tid >> 6), lane = tid & 63, wr = wid >> 2, wc = wid & 3, fr = lane & 15, fq = lane >> 4;
    const int K = g.K, nt = K / BK;
    unsigned voffA[2], voffB[2];
#pragma unroll
    for (int i = 0; i < 2; ++i) { int R, C; stage_rc(tid * 16 + i * 8192, R, C); const int Rb = Epi::PERM ? ((R & ~31) + perm32(R & 31)) : R;
        voffA[i] = (unsigned)(R * K + C) * 2u; voffB[i] = (unsigned)(Rb * K + C) * 2u; }
    const size_t kstep = (size_t)(BK * 2);
    const size_t hstep = (size_t)HALF * K * 2;
    const size_t tstep = 2 * hstep;
    const unsigned ldsw = (unsigned)wid * 1024u;
    const int aoff = lds_byte(wr * 64 + fr, fq * 8), boff = lds_byte(wc * 32 + fr, fq * 8);
#define PG8_SA(b, h) (((b) * 2 + (h)) * HTB)
#define PG8_SB(b, h) ((4 + (b) * 2 + (h)) * HTB)
#define PG8_STAGE(bufoff, gbase, voff) do { _Pragma("unroll") for (int _i = 0; _i < 2; ++_i) \
        __builtin_amdgcn_global_load_lds((const unsigned*)((const char*)(gbase) + (voff)[_i]), (PG8_LAS unsigned*)(lds + (bufoff) + ldsw + _i * 8192), 16, 0, 0); } while (0)
#define PG8_LDA(dst, b, h) do { _Pragma("unroll") for (int m = 0; m < 4; ++m) _Pragma("unroll") for (int k = 0; k < 2; ++k) dst[m][k] = *(const PG8_LAS bf16x8*)(lds + PG8_SA(b, h) + aoff + m * 2048 + k * 1024); } while (0)
#define PG8_LDB(dst, b, h) do { _Pragma("unroll") for (int n = 0; n < 2; ++n) _Pragma("unroll") for (int k = 0; k < 2; ++k) dst[n][k] = *(const PG8_LAS bf16x8*)(lds + PG8_SB(b, h) + boff + n * 2048 + k * 1024); } while (0)
#define PG8_MMA(ai, bj, At, Bt) do { __builtin_amdgcn_s_setprio(1); _Pragma("unroll") for (int m = 0; m < 4; ++m) _Pragma("unroll") for (int n = 0; n < 2; ++n) _Pragma("unroll") for (int k = 0; k < 2; ++k) \
        acc[ai][bj][m][n] = __builtin_amdgcn_mfma_f32_16x16x32_bf16(Bt[n][k], At[m][k], acc[ai][bj][m][n], 0, 0, 0); __builtin_amdgcn_s_setprio(0); } while (0)
#define PG8_WAIT_V(n) asm volatile("s_waitcnt vmcnt(" #n ")" ::: "memory")
#define PG8_WAIT_L(n) asm volatile("s_waitcnt lgkmcnt(" #n ")" ::: "memory")
#define PG8_BAR __builtin_amdgcn_s_barrier()
#define PG8_SCHED __builtin_amdgcn_sched_barrier(0)
    Unit cur, nxt; int ui = 0;
    if (!S.next(0, cur)) return;
    f32x4 acc[2][2][4][2];
#pragma unroll
    for (int a = 0; a < 2; ++a)
#pragma unroll
        for (int b = 0; b < 2; ++b)
#pragma unroll
            for (int m = 0; m < 4; ++m)
#pragma unroll
                for (int n = 0; n < 2; ++n) acc[a][b][m][n] = (f32x4){0.f, 0.f, 0.f, 0.f};
    bf16x8 At[4][2], B0[2][2], B1[2][2];
    const char* cA = (const char*)g.A + (size_t)cur.pm * tstep; const char* cB = (const char*)g.Bt + (size_t)cur.pn * tstep;
    S.a_ready(cur);
    if constexpr (SP2) {
        PG8_STAGE(PG8_SB(0, 0), cB, voffB); PG8_STAGE(PG8_SB(0, 1), cB + hstep, voffB); PG8_STAGE(PG8_SA(0, 0), cA, voffA); PG8_STAGE(PG8_SA(0, 1), cA + hstep, voffA);
        if (wr == 1) PG8_BAR;
        PG8_WAIT_V(2); PG8_BAR;
        PG8_STAGE(PG8_SB(1, 0), cB + kstep, voffB); PG8_STAGE(PG8_SA(1, 0), cA + kstep, voffA); PG8_STAGE(PG8_SB(1, 1), cB + hstep + kstep, voffB);
        PG8_WAIT_V(6); PG8_BAR;
    } else {
        PG8_STAGE(PG8_SB(0, 0), cB, voffB); PG8_STAGE(PG8_SA(0, 0), cA, voffA); PG8_STAGE(PG8_SB(0, 1), cB + hstep, voffB); PG8_STAGE(PG8_SA(0, 1), cA + hstep, voffA);
        if (wr == 1) PG8_BAR;
        PG8_WAIT_V(4); PG8_BAR;
        PG8_STAGE(PG8_SB(1, 0), cB + kstep, voffB); PG8_STAGE(PG8_SA(1, 0), cA + kstep, voffA); PG8_STAGE(PG8_SB(1, 1), cB + hstep + kstep, voffB);
        PG8_WAIT_V(6); PG8_BAR;
    }
    for (;;) {
        const bool has_next = S.next(ui + 1, nxt);
        const char* nA = has_next ? (const char*)g.A + (size_t)nxt.pm * tstep : cA; const char* nB = has_next ? (const char*)g.Bt + (size_t)nxt.pn * tstep : cB;
        for (int t = 0; t < nt; t += 2) {
            const bool last = (t == nt - 2);
            const char* a1 = cA + (size_t)(t + 1) * kstep;
            const char* a2 = last ? nA : cA + (size_t)(t + 2) * kstep; const char* b2 = last ? nB : cB + (size_t)(t + 2) * kstep;
            const char* a3 = a2 + kstep; const char* b3 = b2 + kstep;
            if (last && has_next) S.a_ready(nxt);
            if constexpr (SP2) {
            PG8_LDB(B0, 0, 0); PG8_LDB(B1, 0, 1); PG8_SCHED; PG8_LDA(At, 0, 0); PG8_STAGE(PG8_SA(1, 1), a1 + hstep, voffA);
            PG8_WAIT_V(8); PG8_WAIT_L(0); PG8_BAR; PG8_MMA(0, 0, At, B0); PG8_MMA(0, 1, At, B1); PG8_BAR; PG8_SCHED;
            PG8_LDA(At, 0, 1); PG8_STAGE(PG8_SB(0, 0), b2, voffB); PG8_STAGE(PG8_SB(0, 1), b2 + hstep, voffB); PG8_STAGE(PG8_SA(0, 0), a2, voffA);
            PG8_WAIT_V(8); PG8_WAIT_L(0); PG8_BAR; PG8_MMA(1, 0, At, B0); PG8_MMA(1, 1, At, B1); PG8_BAR; PG8_SCHED;
            PG8_LDB(B0, 1, 0); PG8_LDB(B1, 1, 1); PG8_SCHED; PG8_LDA(At, 1, 0); PG8_STAGE(PG8_SA(0, 1), a2 + hstep, voffA);
            PG8_WAIT_V(8); PG8_WAIT_L(0); PG8_BAR; PG8_MMA(0, 0, At, B0); PG8_MMA(0, 1, At, B1); PG8_BAR; PG8_SCHED;
            PG8_LDA(At, 1, 1); PG8_STAGE(PG8_SB(1, 0), b3, voffB); PG8_STAGE(PG8_SB(1, 1), b3 + hstep, voffB); PG8_STAGE(PG8_SA(1, 0), a3, voffA);
            PG8_WAIT_V(8); PG8_WAIT_L(0); PG8_BAR; PG8_MMA(1, 0, At, B0); PG8_MMA(1, 1, At, B1); PG8_BAR; PG8_SCHED;
            } else {
            PG8_LDB(B0, 0, 0); PG8_SCHED; PG8_LDA(At, 0, 0); PG8_STAGE(PG8_SA(1, 1), a1 + hstep, voffA);
            PG8_WAIT_L(8); PG8_BAR; PG8_WAIT_L(0); PG8_MMA(0, 0, At, B0); PG8_BAR; PG8_SCHED;
            PG8_LDB(B1, 0, 1); PG8_STAGE(PG8_SB(0, 0), b2, voffB);
            PG8_BAR; PG8_WAIT_L(0); PG8_MMA(0, 1, At, B1); PG8_BAR;
            PG8_LDA(At, 0, 1); PG8_STAGE(PG8_SA(0, 0), a2, voffA);
            PG8_BAR; PG8_WAIT_L(0); PG8_MMA(1, 0, At, B0); PG8_BAR; PG8_SCHED;
            PG8_STAGE(PG8_SB(0, 1), b2 + hstep, voffB);
            PG8_WAIT_V(6); PG8_BAR; PG8_MMA(1, 1, At, B1); PG8_BAR;
            PG8_LDB(B0, 1, 0); PG8_SCHED; PG8_LDA(At, 1, 0); PG8_STAGE(PG8_SA(0, 1), a2 + hstep, voffA);
            PG8_WAIT_L(8); PG8_BAR; PG8_WAIT_L(0); PG8_MMA(0, 0, At, B0); PG8_BAR; PG8_SCHED;
            PG8_LDB(B1, 1, 1); PG8_STAGE(PG8_SB(1, 0), b3, voffB);
            PG8_BAR; PG8_WAIT_L(0); PG8_MMA(0, 1, At, B1); PG8_BAR;
            PG8_LDA(At, 1, 1); PG8_STAGE(PG8_SA(1, 0), a3, voffA);
            PG8_BAR; PG8_WAIT_L(0); PG8_MMA(1, 0, At, B0); PG8_BAR; PG8_SCHED;
            PG8_STAGE(PG8_SB(1, 1), b3 + hstep, voffB);
            PG8_WAIT_V(6); PG8_BAR; PG8_MMA(1, 1, At, B1); PG8_BAR;
            }
        }
        if constexpr (ALIGN_EPI) { if (wr == 0) PG8_BAR; }
        if constexpr (!Epi::AFTER_DRAIN) { E(acc, cur, wr, wc, fr, fq); S.done(cur); }
        if (!has_next) break;
#pragma unroll
        for (int a = 0; a < 2; ++a)
#pragma unroll
            for (int b = 0; b < 2; ++b)
#pragma unroll
                for (int m = 0; m < 4; ++m)
#pragma unroll
                    for (int n = 0; n < 2; ++n) acc[a][b][m][n] = (f32x4){0.f, 0.f, 0.f, 0.f};
        cur = nxt; cA = nA; cB = nB; ++ui;
        if constexpr (ALIGN_EPI) { if (wr == 1) PG8_BAR; }
    }
    PG8_WAIT_V(0);
    if constexpr (!ALIGN_EPI) { if (wr == 0) PG8_BAR; }
    PG8_BAR;
    if constexpr (Epi::AFTER_DRAIN) { E.fused(acc, cur, wr, wc, fr, fq, lds, wid, lane); S.done(cur); }
#undef PG8_SA
#undef PG8_SB
#undef PG8_STAGE
#undef PG8_LDA
#undef PG8_LDB
#undef PG8_MMA
#undef PG8_WAIT_V
#undef PG8_WAIT_L
#undef PG8_BAR
#undef PG8_SCHED
}
}

#ifndef PG8_SP2
#define PG8_SP2 true
#endif
#ifndef PG8_ALIGN
#define PG8_ALIGN true
#endif
#define GAS __attribute__((address_space(1)))
#define LAS __attribute__((address_space(3)))
typedef unsigned short bf16;
typedef unsigned v4u __attribute__((ext_vector_type(4)));
typedef float f32x4 __attribute__((ext_vector_type(4)));
typedef short bf16x8 __attribute__((ext_vector_type(8)));
typedef GAS unsigned gu32;
typedef GAS unsigned long long gu64;
#define RLX_AGENT __ATOMIC_RELAXED, __HIP_MEMORY_SCOPE_AGENT
#define LDS_WAIT() asm volatile("s_waitcnt lgkmcnt(0)" ::: "memory")
#define VM_WAIT() asm volatile("s_waitcnt vmcnt(0)" ::: "memory")
__device__ __forceinline__ unsigned long long rt() { return __builtin_amdgcn_s_memrealtime(); }

#define XB_TMO      128
#define XB_XCNT(j)  (256  + 64 * (j))
#define XB_XSUB(j)  (1280 + 64 * (j))
#define XB_XGEN(j)  (2304 + 64 * (j))
#define XB_TOP      3328
#define XB_TOPGEN   3392
#define XCD_BAR_WORDS 3456
#define XB_SPIN_CAP (1u << 20)

__device__ __forceinline__ unsigned xb_ld(unsigned* p)              { return __hip_atomic_load(p, __ATOMIC_RELAXED, __HIP_MEMORY_SCOPE_AGENT); }
__device__ __forceinline__ unsigned xb_add(unsigned* p, unsigned v) { return __hip_atomic_fetch_add(p, v, __ATOMIC_RELAXED, __HIP_MEMORY_SCOPE_AGENT); }
__device__ __forceinline__ unsigned xb_xcc_id() { return (unsigned)__builtin_amdgcn_s_getreg((3 << 11) | 20) & 0xFu; }
#define XB_SPIN(cond, bar) do { unsigned _sp = 0; while (cond) { __builtin_amdgcn_s_sleep(1); \
    if ((++_sp & 255u) == 0u) { if (xb_ld(&(bar)[XB_TMO])) break; if (_sp > XB_SPIN_CAP) { atomicAdd(&(bar)[XB_TMO], 1u); break; } } } } while (0)

struct XcdBarrier {
    unsigned* bar; unsigned x;
    volatile LAS unsigned* st;
};

__device__ __forceinline__ XcdBarrier xcd_barrier_post(unsigned* bar, volatile LAS unsigned* st) {
    XcdBarrier b; b.bar = bar; b.x = xb_xcc_id(); b.st = st;
    if (threadIdx.x == 0) (void)xb_add(&bar[XB_XCNT(b.x)], 1u);
    return b;
}
__device__ __forceinline__ void xcd_barrier_complete(unsigned* bar, unsigned x, unsigned& nloc, unsigned& nx) {
    const unsigned G = gridDim.x * gridDim.y * gridDim.z;
    unsigned sum, cnt, mine, sp = 0u;
    for (;;) {
        sum = 0u; cnt = 0u; mine = 0u;
#pragma unroll
        for (unsigned j = 0; j < 16; ++j) { const unsigned c = xb_ld(&bar[XB_XCNT(j)]); sum += c; cnt += (c > 0u) ? 1u : 0u; mine = (j == x) ? c : mine; }
        if (sum == G) break;
        __builtin_amdgcn_s_sleep(1);
        if ((++sp & 255u) == 0u) { if (xb_ld(&bar[XB_TMO])) break; if (sp > XB_SPIN_CAP) { atomicAdd(&bar[XB_TMO], 1u); break; } }
    }
    nloc = mine > 0u ? mine : 1u; nx = cnt > 0u ? cnt : 1u;
}

__device__ __forceinline__ void xcd_barrier(const XcdBarrier& b) {
    asm volatile("s_waitcnt vmcnt(0)" ::: "memory");
    __syncthreads();
    if (threadIdx.x == 0) {
        unsigned* bar = b.bar;
        __builtin_amdgcn_s_waitcnt(0);
        unsigned nloc = b.st[0], nx = b.st[1];
        if (nloc == 0u) { xcd_barrier_complete(bar, b.x, nloc, nx); b.st[0] = nloc; b.st[1] = nx; }
        const unsigned old = xb_add(&bar[XB_XSUB(b.x)], 1u);
        const unsigned gen = old / nloc;
        if (old + 1u == (gen + 1u) * nloc) {
            __builtin_amdgcn_fence(__ATOMIC_RELEASE, "agent");
            asm volatile("s_waitcnt vmcnt(0)" ::: "memory");
            const unsigned og = xb_add(&bar[XB_TOP], 1u);
            const unsigned tg = og / nx;
            if (og + 1u == (tg + 1u) * nx) xb_add(&bar[XB_TOPGEN], 1u);
            else XB_SPIN(xb_ld(&bar[XB_TOPGEN]) == tg, bar);
            __builtin_amdgcn_fence(__ATOMIC_ACQUIRE, "agent");
            xb_add(&bar[XB_XGEN(b.x)], 1u);
            asm volatile("s_waitcnt vmcnt(0)" ::: "memory");
        } else {
            XB_SPIN(xb_ld(&bar[XB_XGEN(b.x)]) == gen, bar);
            __builtin_amdgcn_fence(__ATOMIC_ACQUIRE, "agent");
            asm volatile("s_waitcnt vmcnt(0)" ::: "memory");
        }
    }
    __syncthreads();
}

constexpr int NWAVES = 8;
namespace mk {
constexpr size_t WS_CTL = 0, CTL_ZERO_BYTES = 1 * MiB;
constexpr size_t CTL_SSQ = 512 * 1024;
constexpr size_t WS_SMALL = 1 * MiB, SM_BIAS = 0, SM_SSQM = 4096, SM_MKV = 512 * 1024;
constexpr size_t WS_MEMB = 2 * MiB, WS_WT = 3 * MiB, WS_XB = 28 * MiB, WS_VF = 60 * MiB, WS_PROJ = 72 * MiB, WS_MIX = 144 * MiB, WS_PREP = 176 * MiB, WS_U = 72 * MiB, WS_ACT = 160 * MiB, WS_END = 248 * MiB;
constexpr size_t WT_IN = 0, WT_OUT = 4718592, WT_UP = WT_OUT + 2 * MiB, WT_DOWN = WT_UP + 11 * MiB, WT_MKV = WT_DOWN + 5767168;
constexpr int CW_TMO = 0, CW_BAR = 4096;
constexpr int RING_BYTES = 131072, LDSCTL_OFF = RING_BYTES, MISC_OFF = LDSCTL_OFF + 320, LDS_BYTES = 147456;

struct Args { const float* in[N_IN]; float* out; unsigned char* ws; int ph_lo, ph_hi; };

__device__ __forceinline__ unsigned pk2(float lo, float hi) { return (unsigned)f2bf(lo) | ((unsigned)f2bf(hi) << 16); }
__device__ __forceinline__ float wave_sum(float v) {
#pragma unroll
    for (int o = 1; o < 64; o <<= 1) v += __shfl_xor(v, o);
    return v;
}
__device__ __forceinline__ void transpose_item(const float* W, const float* g, int K, int N, bf16_t* WT, LAS float* scr, int item, int lane) {
    const int nblk = N / 32, kb = item / nblk, nb = item % nblk, k0 = 64 * kb, n0 = 32 * nb;
#pragma unroll 8
    for (int i = 0; i < 32; ++i) { const int kk = 2 * i + (lane >> 5); float v = W[(size_t)(k0 + kk) * N + n0 + (lane & 31)]; if (g) v *= g[k0 + kk]; scr[kk * 33 + (lane & 31)] = v; }
    LDS_WAIT(); asm volatile("" ::: "memory");
    const int c = lane & 7;
#pragma unroll
    for (int j = 0; j < 4; ++j) { const int n = (lane >> 3) + 8 * j; const LAS float* s = scr + (8 * c) * 33 + n;
        v4u o; o.x = pk2(s[0 * 33], s[1 * 33]); o.y = pk2(s[2 * 33], s[3 * 33]); o.z = pk2(s[4 * 33], s[5 * 33]); o.w = pk2(s[6 * 33], s[7 * 33]);
        *(GAS v4u*)(WT + (size_t)(n0 + n) * K + k0 + 8 * c) = o; }
    LDS_WAIT(); asm volatile("" ::: "memory");
}
__device__ __forceinline__ void row_to_bf16(const float* xrow, bf16_t* orow, float* ssq_out, int lane) {
    const GAS f32x4* xr = (const GAS f32x4*)xrow + lane; f32x4 v[4]; float s = 0.f;
#pragma unroll
    for (int j = 0; j < 4; ++j) { v[j] = xr[64 * j]; s += (v[j].x * v[j].x + v[j].y * v[j].y) + (v[j].z * v[j].z + v[j].w * v[j].w); }
    s = wave_sum(s);
    GAS unsigned long long* o8 = (GAS unsigned long long*)orow + lane;
#pragma unroll
    for (int j = 0; j < 4; ++j) o8[64 * j] = (unsigned long long)pk2(v[j].x, v[j].y) | ((unsigned long long)pk2(v[j].z, v[j].w) << 32);
    if (lane == 0) *ssq_out = s;
}

__global__ void __launch_bounds__(NWAVES * 64, 2) mk_fwd(Args args) {
    extern __shared__ __attribute__((aligned(16))) unsigned char lds[];
    LAS unsigned char* L = (LAS unsigned char*)lds;
    volatile LAS unsigned* MISC = (volatile LAS unsigned*)(L + MISC_OFF);
    const int tid0 = threadIdx.x;
    const int G = gridDim.x;
    unsigned char* ws = args.ws;
    gu32* ctl = (gu32*)(ws + WS_CTL);
    for (int u = tid0; u < (LDS_BYTES - LDSCTL_OFF) / 4; u += NWAVES * 64) ((LAS unsigned*)(L + LDSCTL_OFF))[u] = 0u;
    __syncthreads();
    XcdBarrier bar = xcd_barrier_post((unsigned*)(ctl + CW_BAR), MISC + 8);
    const int lo = args.ph_lo, hi = args.ph_hi;
    int ph = 0;
#define PH_BEGIN if (lo <= ph && ph < hi) { unsigned char* wsp = args.ws; asm volatile("" : "+s"(wsp)); int tid = tid0; asm volatile("" : "+v"(tid)); const int lane = tid & 63, wave = __builtin_amdgcn_readfirstlane(tid >> 6); const long gtid = (long)blockIdx.x * (NWAVES * 64) + tid; const int gw = blockIdx.x * NWAVES + wave; LAS float* scr = (LAS float*)(L + wave * 16384); (void)lane; (void)gtid; (void)gw; (void)scr;
#define PH_END   if (ph + 1 < hi) xcd_barrier(bar); } ++ph;
    float* out = args.out;
#define SSQ_A ((float*)(wsp + WS_CTL + CTL_SSQ))
#define SSQ_B (SSQ_A + 3 * MTOK)
#define biastab ((float*)(wsp + WS_SMALL + SM_BIAS))
#define ssqm ((float*)(wsp + WS_SMALL + SM_SSQM))
#define MKV ((bf16_t*)(wsp + WS_SMALL + SM_MKV))
#define MEMB ((bf16_t*)(wsp + WS_MEMB))
#define Wt_in ((bf16_t*)(wsp + WS_WT + WT_IN))
#define Wt_out ((bf16_t*)(wsp + WS_WT + WT_OUT))
#define Wt_up ((bf16_t*)(wsp + WS_WT + WT_UP))
#define Wt_down ((bf16_t*)(wsp + WS_WT + WT_DOWN))
#define Wt_mkv ((bf16_t*)(wsp + WS_WT + WT_MKV))
#define XB ((bf16_t*)(wsp + WS_XB))
#define VF ((bf16_t*)(wsp + WS_VF))
#define PROJ ((bf16_t*)(wsp + WS_PROJ))
#define MIX ((bf16_t*)(wsp + WS_MIX))
#define U ((bf16_t*)(wsp + WS_U))
#define ACT ((bf16_t*)(wsp + WS_ACT))
#define PA ((size_t)MTOK * 384)
#define pR ((bf16_t*)(wsp + WS_PREP))
#define pK (pR + PA)
#define pV (pR + 2 * PA)
#define pKK (pR + 3 * PA)
#define pB (pR + 4 * PA)
#define pLD (pR + 5 * PA)
    const long gsize = (long)G * (NWAVES * 64);
    const int NGW = G * NWAVES;

    for (int l = 0; l < 2; ++l) {
        const float* xin = l == 0 ? args.in[I_X] : out;
        PH_BEGIN
            const int I_IN = 16 * 68, I_OUT = 16 * 32, I_UP = 16 * 176, I_DN = 44 * 32, I_KV = 16 * 16, NIT = I_IN + I_OUT + I_UP + I_DN + I_KV;
            for (int it = gw; it < NIT; it += NGW) {
                int r = it;
                if (r < I_IN) { transpose_item(args.in[I_WIN] + (size_t)l * 1024 * 2176, args.in[I_MIXG] + l * 1024, 1024, 2176, Wt_in, scr, r, lane); continue; } r -= I_IN;
                if (r < I_OUT) { transpose_item(args.in[I_WOUT] + (size_t)l * 1024 * 1024, nullptr, 1024, 1024, Wt_out, scr, r, lane); continue; } r -= I_OUT;
                if (r < I_UP) { transpose_item(args.in[I_WUP] + (size_t)l * 1024 * 5632, args.in[I_FFNG] + l * 1024, 1024, 5632, Wt_up, scr, r, lane); continue; } r -= I_UP;
                if (r < I_DN) { transpose_item(args.in[I_WDOWN] + (size_t)l * 2816 * 1024, nullptr, 2816, 1024, Wt_down, scr, r, lane); continue; } r -= I_DN;
                transpose_item(args.in[I_WMKV] + (size_t)l * 1024 * 512, args.in[I_MEMG] + l * 1024, 1024, 512, Wt_mkv, scr, r, lane);
            }
            for (long i = gtid; i < 128 * 1024; i += gsize) { const int n = (int)(i >> 10), k = (int)(i & 1023); float v = 0.f;
                if (l > 0 && n < 16) v = args.in[I_WINV][k * 16 + n] * args.in[I_MIXG][l * 1024 + k];
                Wt_in[(size_t)(2176 + n) * 1024 + k] = f2bf(v); }
            if (l == 0) {
                for (int m = gw; m < MTOK; m += NGW) row_to_bf16(args.in[I_X] + (size_t)m * DM, XB + (size_t)m * DM, SSQ_A + m, lane);
                for (int m = gw; m < 512; m += NGW) row_to_bf16(args.in[I_MEM] + (size_t)m * DM, MEMB + (size_t)m * DM, ssqm + m, lane);
                sk::d_biastab(args.in[I_RELB], biastab, gtid, gsize);
            }
        PH_END
        PH_BEGIN
            { pg8::Gemm g{XB, Wt_in, MTOK, 2304, 1024}; pg8::StaticOrder S; S.init(MTOK, 2304, G, (int)blockIdx.x);
              pg8::EpiScaleBf16 E{PROJ, LDP, SSQ_A + (size_t)l * MTOK};
              pg8::gemm_phase<pg8::EpiScaleBf16, pg8::StaticOrder, true, true>(L, g, S, E); }
            { pg8::Gemm g{MEMB, Wt_mkv, 512, 512, 1024}; pg8::StaticOrder S; S.init(512, 512, G, (int)((blockIdx.x + 192) % G));
              pg8::EpiScaleBf16 E{MKV, 512, ssqm};
              pg8::gemm_phase<pg8::EpiScaleBf16, pg8::StaticOrder, true, true>(L, g, S, E); }
        PH_END
        sk::RwkvW W{args.in[I_MU] + l * 1280, args.in[I_MUV], args.in[I_W0] + l * 384, args.in[I_W2] + l * 32 * 384, args.in[I_A0] + l * 384, args.in[I_A2] + l * 32 * 384, args.in[I_V0], args.in[I_V2],
                    args.in[I_G2] + l * 64 * 384, args.in[I_KK] + l * 384, args.in[I_KA] + l * 384, args.in[I_RK] + l * 384, args.in[I_LNW] + l * 384, args.in[I_LNB] + l * 384};
        PH_BEGIN
            sk::d_qknorm(PROJ, MTOK, LDP, args.in[I_AQN] + l * 64, args.in[I_AKN] + l * 64, args.in[I_MQN] + l * 64, 0, gtid, gsize);
            sk::d_qknorm(MKV, 512, 512, nullptr, nullptr, args.in[I_MKN] + l * 64, 1, gtid, gsize);
            sk::d_rwkv_prep(PROJ, W, l, VF, pR, pK, pV, pKK, pB, pLD, gtid, gsize);
        PH_END
        PH_BEGIN
            if (blockIdx.x < BATCH * 6) { if (wave == 0) sk::d_rwkv_scan(pR, pK, pV, pKK, pB, pLD, MIX, (int)blockIdx.x, lane); }
            else {
                const long gt2 = (long)(blockIdx.x - BATCH * 6) * (NWAVES * 64) + tid, gs2 = (long)(G - BATCH * 6) * (NWAVES * 64);
                sk::d_swa(PROJ, MIX, biastab, args.in[I_SINK] + l * 6, gt2, gs2);
                sk::d_memattn(PROJ, MKV, MIX, gt2, gs2);
            }
        PH_END
        PH_BEGIN
            sk::d_rwkv_fin(PROJ, W, pR, pK, pV, MIX, gtid, gsize);
        PH_END
        PH_BEGIN
            pg8::Gemm g{MIX, Wt_out, MTOK, 1024, 1024}; pg8::StaticOrder S; S.init(MTOK, 1024, G, (int)blockIdx.x);
            pg8::EpiResid E{xin, out, XB, SSQ_B + (size_t)l * MTOK, 1024};
            pg8::gemm_phase<pg8::EpiResid, pg8::StaticOrder, true, true>(L, g, S, E);
        PH_END
        for (int b = 0; b < BATCH; ++b) {
            PH_BEGIN
                pg8::Gemm g{XB + (size_t)b * SEQ * 1024, Wt_up, SEQ, 5632, 1024}; pg8::StaticOrder S; S.init(SEQ, 5632, G, (int)blockIdx.x);
                pg8::EpiScaleBf16 E{U, 5632, SSQ_B + (size_t)l * MTOK + (size_t)b * SEQ};
                pg8::gemm_phase<pg8::EpiScaleBf16, pg8::StaticOrder, true, true>(L, g, S, E);
            PH_END
            PH_BEGIN
                sk::d_conv_act(U, args.in[I_CW] + (size_t)l * 3 * 5632, args.in[I_CB] + (size_t)l * 5632, ACT + (size_t)b * SEQ * DFF, SEQ, gtid, gsize);
            PH_END
        }
        PH_BEGIN
            pg8::Gemm g{ACT, Wt_down, MTOK, 1024, 2816}; pg8::StaticOrder S; S.init(MTOK, 1024, G, (int)blockIdx.x);
            pg8::EpiResid E{out, out, XB, SSQ_A + (size_t)(l + 1) * MTOK, 1024};
            pg8::gemm_phase<pg8::EpiResid, pg8::StaticOrder, true, true>(L, g, S, E);
        PH_END
    }
#undef PH_BEGIN
#undef PH_END
}
constexpr int N_PHASES = 2 * 11;
}

#ifndef MK_PER_PHASE
#define MK_PER_PHASE 0
#endif
extern "C" void kernel_launch(void* const* d_in, const int* in_sizes, int n_in, void* d_out, int out_size, void* d_ws, size_t ws_size, hipStream_t stream) {
    static int grid = 0;
    if (grid == 0) {
        if (n_in != N_IN || out_size != MTOK * DM || ws_size < mk::WS_END) { fprintf(stderr, "kernel_launch: unexpected shapes (n_in %d out %d ws %zu)\n", n_in, out_size, ws_size); grid = -1; return; }
        int dev = 0, cus = 0, per_cu = 0;
        if (hipGetDevice(&dev) != hipSuccess || hipDeviceGetAttribute(&cus, hipDeviceAttributeMultiprocessorCount, dev) != hipSuccess) { grid = -1; return; }
        if (hipFuncSetAttribute((const void*)mk::mk_fwd, hipFuncAttributeMaxDynamicSharedMemorySize, mk::LDS_BYTES) != hipSuccess) { fprintf(stderr, "kernel_launch: hipFuncSetAttribute failed\n"); grid = -1; return; }
        if (hipOccupancyMaxActiveBlocksPerMultiprocessor(&per_cu, (const void*)mk::mk_fwd, NWAVES * 64, mk::LDS_BYTES) != hipSuccess || per_cu < 1) { fprintf(stderr, "kernel_launch: occupancy query says %d blocks per CU\n", per_cu); }
        (void)hipGetLastError();
        grid = cus;
    }
    if (grid < 0) return;
    if (hipMemsetAsync((char*)d_ws + mk::WS_CTL, 0, mk::CTL_ZERO_BYTES, stream) != hipSuccess) return;
    mk::Args a{};
    for (int i = 0; i < N_IN; ++i) a.in[i] = (const float*)d_in[i];
    a.out = (float*)d_out; a.ws = (unsigned char*)d_ws;
#if MK_PER_PHASE
    for (int p = 0; p < mk::N_PHASES; ++p) { a.ph_lo = p; a.ph_hi = p + 1; hipLaunchKernelGGL(mk::mk_fwd, dim3(grid), dim3(NWAVES * 64), mk::LDS_BYTES, stream, a); }
#else
    a.ph_lo = 0; a.ph_hi = mk::N_PHASES;
    hipLaunchKernelGGL(mk::mk_fwd, dim3(grid), dim3(NWAVES * 64), mk::LDS_BYTES, stream, a);
#endif
}
```

```cpp
#define MK_BUILD 1
#ifndef HOST_SIM
#include <hip/hip_runtime.h>
#include <cstdio>
#include <cstdint>
#endif
#ifndef SEQ_LEN
#define SEQ_LEN 8192
#endif
typedef unsigned short bf16_t;
constexpr int BATCH = 2, SEQ = SEQ_LEN, DM = 1024, MTOK = BATCH * SEQ, DFF = 2816, LDP = 2304  ;
constexpr float EPS = 1e-6f, GN_EPS = 64e-5f;
__host__ __device__ __forceinline__ float bf2f(bf16_t h) { unsigned u = (unsigned)h << 16; return __builtin_bit_cast(float, u); }
__host__ __device__ __forceinline__ bf16_t f2bf(float f) { unsigned u = __builtin_bit_cast(unsigned, f); return (bf16_t)((u + 0x7fffu + ((u >> 16) & 1u)) >> 16); }
__host__ __device__ __forceinline__ int t5_bucket(int dist) {
    if (dist < 16) return dist;
    const float v = logf((float)dist / 16.0f) / 2.0794415416798357f * 16.0f;
    int large = 16 + (int)v; return large < 31 ? large : 31;
}
constexpr size_t MiB = 1u << 20;
enum { I_X = 0, I_MEM, I_RELB, I_MIXG, I_WIN, I_WINV, I_AQN, I_AKN, I_SINK, I_MU, I_MUV, I_W0, I_W2, I_A0, I_A2, I_V0, I_V2, I_G2, I_KK, I_KA, I_RK, I_LNW, I_LNB, I_MEMG, I_WMKV, I_MQN, I_MKN, I_WOUT, I_FFNG, I_WUP, I_CW, I_CB, I_WDOWN, N_IN };
namespace sk {

__device__ __forceinline__ void d_wt(const float* W, const float* g, bf16_t* Wt, int K, int N, int Npad, long gtid, long gsize) {
    const long total = (long)Npad * K;
    for (long idx = gtid; idx < total; idx += gsize) {
        const int n = (int)(idx / K), k = (int)(idx % K);
        float v = 0.f;
        if (n < N) { v = W[(long)k * N + n]; if (g) v *= g[k]; }
        Wt[idx] = f2bf(v);
    }
}
#ifndef MK_BUILD
__global__ void k_wt(const float* W, const float* g, bf16_t* Wt, int K, int N, int Npad) { d_wt(W, g, Wt, K, N, Npad, (long)blockIdx.x * blockDim.x + threadIdx.x, (long)gridDim.x * blockDim.x); }
#endif
__device__ __forceinline__ void d_rowprep(const float* x, bf16_t* xb, float* ssq, int rows, long gtid, long gsize) {
    for (long r = gtid; r < rows; r += gsize) {
        const float* xr = x + (long)r * DM; bf16_t* o = xb + (long)r * DM; float s = 0.f;
        for (int c = 0; c < DM; ++c) { const float v = xr[c]; s += v * v; o[c] = f2bf(v); }
        ssq[r] = s;
    }
}
#ifndef MK_BUILD
__global__ void k_rowprep(const float* x, bf16_t* xb, float* ssq, int rows) { d_rowprep(x, xb, ssq, rows, (long)blockIdx.x * blockDim.x + threadIdx.x, (long)gridDim.x * blockDim.x); }
#endif
__device__ __forceinline__ void d_biastab(const float* rel_bias, float* tab, long gtid, long gsize) {
        for (long i = gtid; i < 128 * 6; i += gsize) { const int dist = i / 6, hq = i % 6; tab[i] = rel_bias[t5_bucket(dist) * 6 + hq]; }
}
#ifndef MK_BUILD
__global__ void k_biastab(const float* rel_bias, float* tab) { d_biastab(rel_bias, tab, (long)blockIdx.x * blockDim.x + threadIdx.x, (long)gridDim.x * blockDim.x); }
#endif
__device__ __forceinline__ void d_qknorm(bf16_t* P, int rows, int ld, const float* gq, const float* gk, const float* gm, int mode, long gtid, long gsize) {
    const int nj = mode == 0 ? 12 : 4;
    const long total = (long)rows * nj;
    for (long idx = gtid; idx < total; idx += gsize) {
        const int row = (int)(idx / nj), j = (int)(idx % nj);
        int col; const float* g;
        if (mode == 0) { if (j < 6) { col = 64 * j; g = gq; } else if (j < 8) { col = 384 + 64 * (j - 6); g = gk; } else { col = 1920 + 64 * (j - 8); g = gm; } }
        else { col = 64 * j; g = gm; }
        bf16_t* p = P + (long)row * ld + col; float s = 0.f;
        for (int d = 0; d < 64; ++d) { const float v = bf2f(p[d]); s += v * v; }
        const float rs = 1.0f / sqrtf(s * (1.0f / 64.0f) + EPS);
        for (int d = 0; d < 64; ++d) p[d] = f2bf(bf2f(p[d]) * rs * g[d]);
    }
}
#ifndef MK_BUILD
__global__ void k_qknorm(bf16_t* P, int rows, int ld, const float* gq, const float* gk, const float* gm, int mode) { d_qknorm(P, rows, ld, gq, gk, gm, mode, (long)blockIdx.x * blockDim.x + threadIdx.x, (long)gridDim.x * blockDim.x); }
#endif
__device__ __forceinline__ void d_swa(const bf16_t* P, bf16_t* MIX, const float* biastab, const float* sinks, long gtid, long gsize) {
    const long total = (long)MTOK * 6;
    for (long idx = gtid; idx < total; idx += gsize) {
        const int tok = (int)(idx / 6), hq = (int)(idx % 6), hkv = hq / 3, t = tok % SEQ;
        float q[64], o[64];
#pragma unroll
        for (int d = 0; d < 64; ++d) { q[d] = bf2f(P[(long)tok * LDP + 64 * hq + d]) * 0.125f; o[d] = 0.f; }
        float m = sinks[hq], l = 1.0f;
        const int j0 = t - 127 < 0 ? 0 : t - 127;
        for (int j = j0; j <= t; ++j) {
            const bf16_t* kr = P + (long)(tok - (t - j)) * LDP + 384 + 64 * hkv; const bf16_t* vr = kr + 128;
            float s = 0.f;
#pragma unroll
            for (int d = 0; d < 64; ++d) s += q[d] * bf2f(kr[d]);
            s += biastab[(t - j) * 6 + hq];
            const float mn = fmaxf(m, s), f = expf(m - mn), e = expf(s - mn);
            l = l * f + e; m = mn;
#pragma unroll
            for (int d = 0; d < 64; ++d) o[d] = o[d] * f + e * bf2f(vr[d]);
        }
        const float inv = 1.0f / l;
#pragma unroll
        for (int d = 0; d < 64; ++d) MIX[(long)tok * DM + 64 * hq + d] = f2bf(o[d] * inv);
    }
}
#ifndef MK_BUILD
__global__ __launch_bounds__(256) void k_swa(const bf16_t* P, bf16_t* MIX, const float* biastab, const float* sinks) { d_swa(P, MIX, biastab, sinks, (long)blockIdx.x * blockDim.x + threadIdx.x, (long)gridDim.x * blockDim.x); }
#endif
__device__ __forceinline__ void d_memattn(const bf16_t* P, const bf16_t* MKV, bf16_t* MIX, long gtid, long gsize) {
    const long total = (long)MTOK * 4;
    for (long idx = gtid; idx < total; idx += gsize) {
        const int tok = (int)(idx / 4), h = (int)(idx % 4), b = tok / SEQ;
        float q[64], o[64];
#pragma unroll
        for (int d = 0; d < 64; ++d) { q[d] = bf2f(P[(long)tok * LDP + 1920 + 64 * h + d]) * 0.125f; o[d] = 0.f; }
        float m = -1e30f, l = 0.f;
        for (int j = 0; j < 256; ++j) {
            const bf16_t* kr = MKV + (long)(b * 256 + j) * 512 + 64 * h; const bf16_t* vr = kr + 256;
            float s = 0.f;
#pragma unroll
            for (int d = 0; d < 64; ++d) s += q[d] * bf2f(kr[d]);
            const float mn = fmaxf(m, s), f = expf(m - mn), e = expf(s - mn);
            l = l * f + e; m = mn;
#pragma unroll
            for (int d = 0; d < 64; ++d) o[d] = o[d] * f + e * bf2f(vr[d]);
        }
        const float inv = 1.0f / l;
#pragma unroll
        for (int d = 0; d < 64; ++d) MIX[(long)tok * DM + 768 + 64 * h + d] = f2bf(o[d] * inv);
    }
}
#ifndef MK_BUILD
__global__ __launch_bounds__(256) void k_memattn(const bf16_t* P, const bf16_t* MKV, bf16_t* MIX) { d_memattn(P, MKV, MIX, (long)blockIdx.x * blockDim.x + threadIdx.x, (long)gridDim.x * blockDim.x); }
#endif
__device__ __forceinline__ float shifted(const bf16_t* P, int tok, int col, float mu) {
    const float p = bf2f(P[(long)tok * LDP + col]);
    const float prev = (tok % SEQ) == 0 ? 0.f : bf2f(P[(long)(tok - 1) * LDP + col]);
    return p + mu * (prev - p);
}
struct RwkvW { const float *mu, *mu_v, *w0, *w2, *a0, *a2, *v0, *v2, *g2, *k_k, *k_a, *r_k, *ln_w, *ln_b; };
__device__ __forceinline__ void d_rwkv_prep(const bf16_t* P, RwkvW W, int layer, bf16_t* VFIRST, bf16_t* R, bf16_t* K, bf16_t* V, bf16_t* KK, bf16_t* B, bf16_t* LOGD, long gtid, long gsize) {
    const long total = (long)MTOK * 6;
    for (long idx = gtid; idx < total; idx += gsize) {
        const int tok = (int)(idx / 6), h = (int)(idx % 6);
        float nrm = 0.f;
        for (int c = 0; c < 64; ++c) { const int hc = 64 * h + c; const float kc = shifted(P, tok, 640 + 384 + hc, W.mu[384 + hc]) * W.k_k[hc]; nrm += kc * kc; }
        const float rn = 1.0f / fmaxf(sqrtf(nrm), 1e-12f);
        for (int c = 0; c < 64; ++c) {
            const int hc = 64 * h + c; const long o = (long)tok * 384 + hc;
            const float r = shifted(P, tok, 640 + hc, W.mu[hc]);
            const float k = shifted(P, tok, 640 + 384 + hc, W.mu[384 + hc]);
            float v = shifted(P, tok, 640 + 768 + hc, W.mu[768 + hc]);
            float wp = W.w0[hc], ap = W.a0[hc];
            for (int j = 0; j < 32; ++j) {
                wp += tanhf(shifted(P, tok, 640 + 1152 + j, W.mu[1152 + j])) * W.w2[j * 384 + hc];
                ap += shifted(P, tok, 640 + 1184 + j, W.mu[1184 + j]) * W.a2[j * 384 + hc];
            }
            const float z = -wp; const float sp = fmaxf(z, 0.f) + log1pf(expf(-fabsf(z)));
            const float w = -sp - 0.5f;
            const float a = 1.0f / (1.0f + expf(-ap));
            if (layer > 0) {
                float vp = W.v0[hc];
                for (int j = 0; j < 16; ++j) vp += shifted(P, tok, 2176 + j, W.mu_v[j]) * W.v2[j * 384 + hc];
                const float vf = bf2f(VFIRST[o]);
                v = v + (vf - v) * (1.0f / (1.0f + expf(-vp)));
            } else VFIRST[o] = f2bf(v);
            const float kk = k * W.k_k[hc] * rn;
            R[o] = f2bf(r); K[o] = f2bf(k * (1.0f + (a - 1.0f) * W.k_a[hc])); V[o] = f2bf(v);
            KK[o] = f2bf(kk); B[o] = f2bf(kk * a); LOGD[o] = f2bf(-expf(w));
        }
    }
}
#ifndef MK_BUILD
__global__ void k_rwkv_prep(const bf16_t* P, RwkvW W, int layer, bf16_t* VFIRST, bf16_t* R, bf16_t* K, bf16_t* V, bf16_t* KK, bf16_t* B, bf16_t* LOGD) { d_rwkv_prep(P, W, layer, VFIRST, R, K, V, KK, B, LOGD, (long)blockIdx.x * blockDim.x + threadIdx.x, (long)gridDim.x * blockDim.x); }
#endif
__device__ __forceinline__ void d_rwkv_scan(const bf16_t* R, const bf16_t* K, const bf16_t* V, const bf16_t* KK, const bf16_t* B, const bf16_t* LOGD, bf16_t* MIX, int bh, int i) {
    const int b = bh / 6, h = bh % 6;
    float s[64];
#pragma unroll
    for (int k = 0; k < 64; ++k) s[k] = 0.f;
    for (int t = 0; t < SEQ; ++t) {
        const long o = (long)(b * SEQ + t) * 384 + 64 * h;
        float sa = 0.f;
#pragma unroll
        for (int k = 0; k < 64; ++k) sa -= s[k] * bf2f(KK[o + k]);
        const float v = bf2f(V[o + i]); float y = 0.f;
#pragma unroll
        for (int k = 0; k < 64; ++k) { s[k] = s[k] * expf(bf2f(LOGD[o + k])) + sa * bf2f(B[o + k]) + v * bf2f(K[o + k]); y += s[k] * bf2f(R[o + k]); }
        MIX[(long)(b * SEQ + t) * DM + 384 + 64 * h + i] = f2bf(y);
    }
}
#ifndef MK_BUILD
__global__ void k_rwkv_scan(const bf16_t* R, const bf16_t* K, const bf16_t* V, const bf16_t* KK, const bf16_t* B, const bf16_t* LOGD, bf16_t* MIX) { d_rwkv_scan(R, K, V, KK, B, LOGD, MIX, blockIdx.x, threadIdx.x); }
#endif
__device__ __forceinline__ void d_rwkv_fin(const bf16_t* P, RwkvW W, const bf16_t* R, const bf16_t* K, const bf16_t* V, bf16_t* MIX, long gtid, long gsize) {
    const long total = (long)MTOK * 6;
    for (long idx = gtid; idx < total; idx += gsize) {
        const int tok = (int)(idx / 6), h = (int)(idx % 6);
        bf16_t* y = MIX + (long)tok * DM + 384 + 64 * h; const long o = (long)tok * 384 + 64 * h;
        float mean = 0.f, dot = 0.f;
        for (int c = 0; c < 64; ++c) { mean += bf2f(y[c]); dot += bf2f(R[o + c]) * bf2f(K[o + c]) * W.r_k[64 * h + c]; }
        mean *= (1.0f / 64.0f); float var = 0.f;
        for (int c = 0; c < 64; ++c) { const float d = bf2f(y[c]) - mean; var += d * d; }
        const float rstd = 1.0f / sqrtf(var * (1.0f / 64.0f) + GN_EPS);
        for (int c = 0; c < 64; ++c) {
            const int hc = 64 * h + c; float g = 0.f;
            for (int j = 0; j < 64; ++j) g += (1.0f / (1.0f + expf(-shifted(P, tok, 640 + 1216 + j, W.mu[1216 + j])))) * W.g2[j * 384 + hc];
            const float yn = (bf2f(y[c]) - mean) * rstd * W.ln_w[hc] + W.ln_b[hc];
            y[c] = f2bf((yn + dot * bf2f(V[o + c])) * g);
        }
    }
}
#ifndef MK_BUILD
__global__ void k_rwkv_fin(const bf16_t* P, RwkvW W, const bf16_t* R, const bf16_t* K, const bf16_t* V, bf16_t* MIX) { d_rwkv_fin(P, W, R, K, V, MIX, (long)blockIdx.x * blockDim.x + threadIdx.x, (long)gridDim.x * blockDim.x); }
#endif
__device__ __forceinline__ void d_conv_act(const bf16_t* U, const float* cw, const float* cb, bf16_t* ACT, int rows, long gtid, long gsize) {
    const long total = (long)rows * DFF;
    for (long idx = gtid; idx < total; idx += gsize) {
        const int t = (int)(idx / DFF), c = (int)(idx % DFF);
        float gate = cb[c], val = cb[DFF + c];
#pragma unroll
        for (int i = 0; i < 3; ++i) { const int tt = t - 2 + i; if (tt >= 0) { gate += cw[i * 2 * DFF + c] * bf2f(U[(long)tt * 2 * DFF + c]); val += cw[i * 2 * DFF + DFF + c] * bf2f(U[(long)tt * 2 * DFF + DFF + c]); } }
        ACT[(long)t * DFF + c] = f2bf(gate / (1.0f + expf(-gate)) * val);
    }
}
#ifndef MK_BUILD
__global__ void k_conv_act(const bf16_t* U, const float* cw, const float* cb, bf16_t* ACT, int rows) { d_conv_act(U, cw, cb, ACT, rows, (long)blockIdx.x * blockDim.x + threadIdx.x, (long)gridDim.x * blockDim.x); }
#endif
}
namespace pg8 {
#define PG8_LAS __attribute__((address_space(3)))
typedef unsigned short bf16_t;
typedef short bf16x8 __attribute__((ext_vector_type(8)));
typedef float f32x4 __attribute__((ext_vector_type(4)));
typedef unsigned u32x4 __attribute__((ext_vector_type(4)));
constexpr int BM = 256, BK = 64, HALF = 128, HTB = HALF * BK * 2  , STAGE_BYTES = 8 * HTB, NXCD = 8, WGM = 8;

__host__ __device__ __forceinline__ int lds_byte(int r, int c) { const int st = (r >> 4) * 2 + (c >> 5), rr = r & 15, cc = c & 31, ob = rr * 64 + cc * 2; return st * 1024 + (ob ^ (((ob >> 9) & 1) << 5)); }
__host__ __device__ __forceinline__ void stage_rc(int b, int& R, int& C) { const int st = b / 1024, sb = b % 1024, swz = sb ^ (((sb >> 9) & 1) << 5); R = (st >> 1) * 16 + swz / 64; C = (st & 1) * 32 + (swz % 64) / 2; }
__host__ __device__ __forceinline__ int perm32(int rho) { const int n = rho >> 4, i = rho & 15; return 8 * (i >> 2) + 4 * n + (i & 3); }

struct Unit { int pm, pn; };
struct Gemm { const bf16_t* A; const bf16_t* Bt; int M, N, K; };

struct StaticOrder {
    int nM, nN, nwg, G, c;
    __host__ __device__ void init(int M, int N, int G_, int c_) { nM = M / BM; nN = N / BM; nwg = nM * nN; G = G_; c = c_; }
    __host__ __device__ bool next(int i, Unit& u) const {
        const long L = (long)i * G + c; if (L >= nwg) return false;
        int wgid = (int)L; { const int q = nwg / NXCD, r = nwg % NXCD, xcd = wgid % NXCD, off = wgid / NXCD; wgid = (xcd < r ? xcd * (q + 1) : r * (q + 1) + (xcd - r) * q) + off; }
        const int nig = WGM * nN, gid = wgid / nig, fm = gid * WGM, gsz = (nM - fm) < WGM ? (nM - fm) : WGM;
        u.pm = fm + ((wgid % nig) % gsz); u.pn = (wgid % nig) / gsz; return true;
    }
    __device__ __forceinline__ void a_ready(const Unit&) const {}
    __device__ __forceinline__ void done(const Unit&) const {}
};

__device__ __forceinline__ unsigned cvt_pk_bf16(float lo, float hi) { unsigned r; asm volatile("v_cvt_pk_bf16_f32 %0, %1, %2" : "=v"(r) : "v"(lo), "v"(hi)); return r; }
struct EpiScaleBf16 {
    static constexpr bool PERM = true, AFTER_DRAIN = false;
    bf16_t* O; int ldc; const float* ssq;
    __device__ __forceinline__ void operator()(const f32x4 (&acc)[2][2][4][2], const Unit& u, int wr, int wc, int fr, int fq) const {
        const int row0 = u.pm * BM + wr * 64 + fr, col0 = u.pn * BM + wc * 32 + 8 * fq;
#pragma unroll
        for (int ai = 0; ai < 2; ++ai)
#pragma unroll
            for (int m = 0; m < 4; ++m) { const int row = row0 + ai * HALF + m * 16; const float sc = 1.0f / sqrtf(ssq[row] * (1.0f / 1024.0f) + 1e-6f);
                bf16_t* rowp = O + (size_t)row * ldc + col0;
#pragma unroll
                for (int bj = 0; bj < 2; ++bj) { const f32x4 v0 = acc[ai][bj][m][0] * sc, v1 = acc[ai][bj][m][1] * sc;
                    u32x4 w; w.x = cvt_pk_bf16(v0[0], v0[1]); w.y = cvt_pk_bf16(v0[2], v0[3]); w.z = cvt_pk_bf16(v1[0], v1[1]); w.w = cvt_pk_bf16(v1[2], v1[3]);
                    *(u32x4*)(rowp + bj * HALF) = w; } }
    }
};
struct EpiResid {
    static constexpr bool PERM = false, AFTER_DRAIN = false;
    const float* base; float* out; bf16_t* xb; float* ssq; int ldc;
    __device__ __forceinline__ void operator()(const f32x4 (&acc)[2][2][4][2], const Unit& u, int wr, int wc, int fr, int fq) const {
        typedef unsigned u32x2v __attribute__((ext_vector_type(2)));
        const int col0 = u.pn * BM + wc * 32 + 4 * fq;
#pragma unroll
        for (int ai = 0; ai < 2; ++ai)
#pragma unroll
            for (int m = 0; m < 4; ++m) { const int row = u.pm * BM + ai * HALF + wr * 64 + m * 16 + fr; const size_t off = (size_t)row * ldc + col0; float sq = 0.f;
#pragma unroll
                for (int bj = 0; bj < 2; ++bj)
#pragma unroll
                    for (int n = 0; n < 2; ++n) { const f32x4 o = *(const f32x4*)(base + off + bj * HALF + n * 16) + acc[ai][bj][m][n];
                        *(f32x4*)(out + off + bj * HALF + n * 16) = o; sq += (o[0] * o[0] + o[1] * o[1]) + (o[2] * o[2] + o[3] * o[3]);
                        u32x2v w; w.x = cvt_pk_bf16(o[0], o[1]); w.y = cvt_pk_bf16(o[2], o[3]); *(u32x2v*)(xb + off + bj * HALF + n * 16) = w; }
                sq += __shfl_xor(sq, 16); sq += __shfl_xor(sq, 32);
                if (fq == 0) atomicAdd(ssq + row, sq); }
    }
};
template <class Epi, class Sched, bool ALIGN_EPI = false, bool SP2 = false>
__device__ __forceinline__ void gemm_phase(PG8_LAS unsigned char* lds, const Gemm g, const Sched& S, const Epi& E) {
    int tid = threadIdx.x; asm volatile("" : "+v"(tid));
    const int wid = __builtin_amdgcn_readfirstlane(tid >> 6), lane = tid & 63, wr = wid >> 2, wc = wid & 3, fr = lane & 15, fq = lane >> 4;
    const int K = g.K, nt = K / BK;
    unsigned voffA[2], voffB[2];
#pragma unroll
    for (int i = 0; i < 2; ++i) { int R, C; stage_rc(tid * 16 + i * 8192, R, C); const int Rb = Epi::PERM ? ((R & ~31) + perm32(R & 31)) : R;
        voffA[i] = (unsigned)(R * K + C) * 2u; voffB[i] = (unsigned)(Rb * K + C) * 2u; }
    const size_t kstep = (size_t)(BK * 2);
    const size_t hstep = (size_t)HALF * K * 2;
    const size_t tstep = 2 * hstep;
    const unsigned ldsw = (unsigned)wid * 1024u;
    const int aoff = lds_byte(wr * 64 + fr, fq * 8), boff = lds_byte(wc * 32 + fr, fq * 8);
#define PG8_SA(b, h) (((b) * 2 + (h)) * HTB)
#define PG8_SB(b, h) ((4 + (b) * 2 + (h)) * HTB)
#define PG8_STAGE(bufoff, gbase, voff) do { _Pragma("unroll") for (int _i = 0; _i < 2; ++_i) \
        __builtin_amdgcn_global_load_lds((const unsigned*)((const char*)(gbase) + (voff)[_i]), (PG8_LAS unsigned*)(lds + (bufoff) + ldsw + _i * 8192), 16, 0, 0); } while (0)
#define PG8_LDA(dst, b, h) do { _Pragma("unroll") for (int m = 0; m < 4; ++m) _Pragma("unroll") for (int k = 0; k < 2; ++k) dst[m][k] = *(const PG8_LAS bf16x8*)(lds + PG8_SA(b, h) + aoff + m * 2048 + k * 1024); } while (0)
#define PG8_LDB(dst, b, h) do { _Pragma("unroll") for (int n = 0; n < 2; ++n) _Pragma("unroll") for (int k = 0; k < 2; ++k) dst[n][k] = *(const PG8_LAS bf16x8*)(lds + PG8_SB(b, h) + boff + n * 2048 + k * 1024); } while (0)
#define PG8_MMA(ai, bj, At, Bt) do { __builtin_amdgcn_s_setprio(1); _Pragma("unroll") for (int m = 0; m < 4; ++m) _Pragma("unroll") for (int n = 0; n < 2; ++n) _Pragma("unroll") for (int k = 0; k < 2; ++k) \
        acc[ai][bj][m][n] = __builtin_amdgcn_mfma_f32_16x16x32_bf16(Bt[n][k], At[m][k], acc[ai][bj][m][n], 0, 0, 0); __builtin_amdgcn_s_setprio(0); } while (0)
#define PG8_WAIT_V(n) asm volatile("s_waitcnt vmcnt(" #n ")" ::: "memory")
#define PG8_WAIT_L(n) asm volatile("s_waitcnt lgkmcnt(" #n ")" ::: "memory")
#define PG8_BAR __builtin_amdgcn_s_barrier()
#define PG8_SCHED __builtin_amdgcn_sched_barrier(0)
    Unit cur, nxt; int ui = 0;
    if (!S.next(0, cur)) return;
    f32x4 acc[2][2][4][2];
#pragma unroll
    for (int a = 0; a < 2; ++a)
#pragma unroll
        for (int b = 0; b < 2; ++b)
#pragma unroll
            for (int m = 0; m < 4; ++m)
#pragma unroll
                for (int n = 0; n < 2; ++n) acc[a][b][m][n] = (f32x4){0.f, 0.f, 0.f, 0.f};
    bf16x8 At[4][2], B0[2][2], B1[2][2];
    const char* cA = (const char*)g.A + (size_t)cur.pm * tstep; const char* cB = (const char*)g.Bt + (size_t)cur.pn * tstep;
    S.a_ready(cur);
    if constexpr (SP2) {
        PG8_STAGE(PG8_SB(0, 0), cB, voffB); PG8_STAGE(PG8_SB(0, 1), cB + hstep, voffB); PG8_STAGE(PG8_SA(0, 0), cA, voffA); PG8_STAGE(PG8_SA(0, 1), cA + hstep, voffA);
        if (wr == 1) PG8_BAR;
        PG8_WAIT_V(2); PG8_BAR;
        PG8_STAGE(PG8_SB(1, 0), cB + kstep, voffB); PG8_STAGE(PG8_SA(1, 0), cA + kstep, voffA); PG8_STAGE(PG8_SB(1, 1), cB + hstep + kstep, voffB);
        PG8_WAIT_V(6); PG8_BAR;
    } else {
        PG8_STAGE(PG8_SB(0, 0), cB, voffB); PG8_STAGE(PG8_SA(0, 0), cA, voffA); PG8_STAGE(PG8_SB(0, 1), cB + hstep, voffB); PG8_STAGE(PG8_SA(0, 1), cA + hstep, voffA);
        if (wr == 1) PG8_BAR;
        PG8_WAIT_V(4); PG8_BAR;
        PG8_STAGE(PG8_SB(1, 0), cB + kstep, voffB); PG8_STAGE(PG8_SA(1, 0), cA + kstep, voffA); PG8_STAGE(PG8_SB(1, 1), cB + hstep + kstep, voffB);
        PG8_WAIT_V(6); PG8_BAR;
    }
    for (;;) {
        const bool has_next = S.next(ui + 1, nxt);
        const char* nA = has_next ? (const char*)g.A + (size_t)nxt.pm * tstep : cA; const char* nB = has_next ? (const char*)g.Bt + (size_t)nxt.pn * tstep : cB;
        for (int t = 0; t < nt; t += 2) {
            const bool last = (t == nt - 2);
            const char* a1 = cA + (size_t)(t + 1) * kstep;
            const char* a2 = last ? nA : cA + (size_t)(t + 2) * kstep; const char* b2 = last ? nB : cB + (size_t)(t + 2) * kstep;
            const char* a3 = a2 + kstep; const char* b3 = b2 + kstep;
            if (last && has_next) S.a_ready(nxt);
            if constexpr (SP2) {
            PG8_LDB(B0, 0, 0); PG8_LDB(B1, 0, 1); PG8_SCHED; PG8_LDA(At, 0, 0); PG8_STAGE(PG8_SA(1, 1), a1 + hstep, voffA);
            PG8_WAIT_V(8); PG8_WAIT_L(0); PG8_BAR; PG8_MMA(0, 0, At, B0); PG8_MMA(0, 1, At, B1); PG8_BAR; PG8_SCHED;
            PG8_LDA(At, 0, 1); PG8_STAGE(PG8_SB(0, 0), b2, voffB); PG8_STAGE(PG8_SB(0, 1), b2 + hstep, voffB); PG8_STAGE(PG8_SA(0, 0), a2, voffA);
            PG8_WAIT_V(8); PG8_WAIT_L(0); PG8_BAR; PG8_MMA(1, 0, At, B0); PG8_MMA(1, 1, At, B1); PG8_BAR; PG8_SCHED;
            PG8_LDB(B0, 1, 0); PG8_LDB(B1, 1, 1); PG8_SCHED; PG8_LDA(At, 1, 0); PG8_STAGE(PG8_SA(0, 1), a2 + hstep, voffA);
            PG8_WAIT_V(8); PG8_WAIT_L(0); PG8_BAR; PG8_MMA(0, 0, At, B0); PG8_MMA(0, 1, At, B1); PG8_BAR; PG8_SCHED;
            PG8_LDA(At, 1, 1); PG8_STAGE(PG8_SB(1, 0), b3, voffB); PG8_STAGE(PG8_SB(1, 1), b3 + hstep, voffB); PG8_STAGE(PG8_SA(1, 0), a3, voffA);
            PG8_WAIT_V(8); PG8_WAIT_L(0); PG8_BAR; PG8_MMA(1, 0, At, B0); PG8_MMA(1, 1, At, B1); PG8_BAR; PG8_SCHED;
            } else {
            PG8_LDB(B0, 0, 0); PG8_SCHED; PG8_LDA(At, 0, 0); PG8_STAGE(PG8_SA(1, 1), a1 + hstep, voffA);
            PG8_WAIT_L(8); PG8_BAR; PG8_WAIT_L(0); PG8_MMA(0, 0, At, B0); PG8_BAR; PG8_SCHED;
            PG8_LDB(B1, 0, 1); PG8_STAGE(PG8_SB(0, 0), b2, voffB);
            PG8_BAR; PG8_WAIT_L(0); PG8_MMA(0, 1, At, B1); PG8_BAR;
            PG8_LDA(At, 0, 1); PG8_STAGE(PG8_SA(0, 0), a2, voffA);
            PG8_BAR; PG8_WAIT_L(0); PG8_MMA(1, 0, At, B0); PG8_BAR; PG8_SCHED;
            PG8_STAGE(PG8_SB(0, 1), b2 + hstep, voffB);
            PG8_WAIT_V(6); PG8_BAR; PG8_MMA(1, 1, At, B1); PG8_BAR;
            PG8_LDB(B0, 1, 0); PG8_SCHED; PG8_LDA(At, 1, 0); PG8_STAGE(PG8_SA(0, 1), a2 + hstep, voffA);
            PG8_WAIT_L(8); PG8_BAR; PG8_WAIT_L(0); PG8_MMA(0, 0, At, B0); PG8_BAR; PG8_SCHED;
            PG8_LDB(B1, 1, 1); PG8_STAGE(PG8_SB(1, 0), b3, voffB);
            PG8_BAR; PG8_WAIT_L(0); PG8_MMA(0, 1, At, B1); PG8_BAR;
            PG8_LDA(At, 1, 1); PG8_STAGE(PG8_SA(1, 0), a3, voffA);
            PG8_BAR; PG8_WAIT_L(0); PG8_MMA(1, 0, At, B0); PG8_BAR; PG8_SCHED;
            PG8_STAGE(PG8_SB(1, 1), b3 + hstep, voffB);
            PG8_WAIT_V(6); PG8_BAR; PG8_MMA(1, 1, At, B1); PG8_BAR;
            }
        }
        if constexpr (ALIGN_EPI) { if (wr == 0) PG8_BAR; }
        if constexpr (!Epi::AFTER_DRAIN) { E(acc, cur, wr, wc, fr, fq); S.done(cur); }
        if (!has_next) break;
#pragma unroll
        for (int a = 0; a < 2; ++a)
#pragma unroll
            for (int b = 0; b < 2; ++b)
#pragma unroll
                for (int m = 0; m < 4; ++m)
#pragma unroll
                    for (int n = 0; n < 2; ++n) acc[a][b][m][n] = (f32x4){0.f, 0.f, 0.f, 0.f};
        cur = nxt; cA = nA; cB = nB; ++ui;
        if constexpr (ALIGN_EPI) { if (wr == 1) PG8_BAR; }
    }
    PG8_WAIT_V(0);
    if constexpr (!ALIGN_EPI) { if (wr == 0) PG8_BAR; }
    PG8_BAR;
    if constexpr (Epi::AFTER_DRAIN) { E.fused(acc, cur, wr, wc, fr, fq, lds, wid, lane); S.done(cur); }
#undef PG8_SA
#undef PG8_SB
#undef PG8_STAGE
#undef PG8_LDA
#undef PG8_LDB
#undef PG8_MMA
#undef PG8_WAIT_V
#undef PG8_WAIT_L
#undef PG8_BAR
#undef PG8_SCHED
}
}

#ifndef PG8_SP2
#define PG8_SP2 true
#endif
#ifndef PG8_ALIGN
#define PG8_ALIGN true
#endif
#define GAS __attribute__((address_space(1)))
#define LAS __attribute__((address_space(3)))
typedef unsigned short bf16;
typedef unsigned v4u __attribute__((ext_vector_type(4)));
typedef float f32x4 __attribute__((ext_vector_type(4)));
typedef short bf16x8 __attribute__((ext_vector_type(8)));
typedef GAS unsigned gu32;
typedef GAS unsigned long long gu64;
#define RLX_AGENT __ATOMIC_RELAXED, __HIP_MEMORY_SCOPE_AGENT
#define LDS_WAIT() asm volatile("s_waitcnt lgkmcnt(0)" ::: "memory")
#define VM_WAIT() asm volatile("s_waitcnt vmcnt(0)" ::: "memory")
__device__ __forceinline__ unsigned long long rt() { return __builtin_amdgcn_s_memrealtime(); }

#define XB_TMO      128
#define XB_XCNT(j)  (256  + 64 * (j))
#define XB_XSUB(j)  (1280 + 64 * (j))
#define XB_XGEN(j)  (2304 + 64 * (j))
#define XB_TOP      3328
#define XB_TOPGEN   3392
#define XCD_BAR_WORDS 3456
#define XB_SPIN_CAP (1u << 20)

__device__ __forceinline__ unsigned xb_ld(unsigned* p)              { return __hip_atomic_load(p, __ATOMIC_RELAXED, __HIP_MEMORY_SCOPE_AGENT); }
__device__ __forceinline__ unsigned xb_add(unsigned* p, unsigned v) { return __hip_atomic_fetch_add(p, v, __ATOMIC_RELAXED, __HIP_MEMORY_SCOPE_AGENT); }
__device__ __forceinline__ unsigned xb_xcc_id() { return (unsigned)__builtin_amdgcn_s_getreg((3 << 11) | 20) & 0xFu; }
#define XB_SPIN(cond, bar) do { unsigned _sp = 0; while (cond) { __builtin_amdgcn_s_sleep(1); \
    if ((++_sp & 255u) == 0u) { if (xb_ld(&(bar)[XB_TMO])) break; if (_sp > XB_SPIN_CAP) { atomicAdd(&(bar)[XB_TMO], 1u); break; } } } } while (0)

struct XcdBarrier {
    unsigned* bar; unsigned x;
    volatile LAS unsigned* st;
};

__device__ __forceinline__ XcdBarrier xcd_barrier_post(unsigned* bar, volatile LAS unsigned* st) {
    XcdBarrier b; b.bar = bar; b.x = xb_xcc_id(); b.st = st;
    if (threadIdx.x == 0) (void)xb_add(&bar[XB_XCNT(b.x)], 1u);
    return b;
}
__device__ __forceinline__ void xcd_barrier_complete(unsigned* bar, unsigned x, unsigned& nloc, unsigned& nx) {
    const unsigned G = gridDim.x * gridDim.y * gridDim.z;
    unsigned sum, cnt, mine, sp = 0u;
    for (;;) {
        sum = 0u; cnt = 0u; mine = 0u;
#pragma unroll
        for (unsigned j = 0; j < 16; ++j) { const unsigned c = xb_ld(&bar[XB_XCNT(j)]); sum += c; cnt += (c > 0u) ? 1u : 0u; mine = (j == x) ? c : mine; }
        if (sum == G) break;
        __builtin_amdgcn_s_sleep(1);
        if ((++sp & 255u) == 0u) { if (xb_ld(&bar[XB_TMO])) break; if (sp > XB_SPIN_CAP) { atomicAdd(&bar[XB_TMO], 1u); break; } }
    }
    nloc = mine > 0u ? mine : 1u; nx = cnt > 0u ? cnt : 1u;
}

__device__ __forceinline__ void xcd_barrier(const XcdBarrier& b) {
    asm volatile("s_waitcnt vmcnt(0)" ::: "memory");
    __syncthreads();
    if (threadIdx.x == 0) {
        unsigned* bar = b.bar;
        __builtin_amdgcn_s_waitcnt(0);
        unsigned nloc = b.st[0], nx = b.st[1];
        if (nloc == 0u) { xcd_barrier_complete(bar, b.x, nloc, nx); b.st[0] = nloc; b.st[1] = nx; }
        const unsigned old = xb_add(&bar[XB_XSUB(b.x)], 1u);
        const unsigned gen = old / nloc;
        if (old + 1u == (gen + 1u) * nloc) {
            __builtin_amdgcn_fence(__ATOMIC_RELEASE, "agent");
            asm volatile("s_waitcnt vmcnt(0)" ::: "memory");
            const unsigned og = xb_add(&bar[XB_TOP], 1u);
            const unsigned tg = og / nx;
            if (og + 1u == (tg + 1u) * nx) xb_add(&bar[XB_TOPGEN], 1u);
            else XB_SPIN(xb_ld(&bar[XB_TOPGEN]) == tg, bar);
            __builtin_amdgcn_fence(__ATOMIC_ACQUIRE, "agent");
            xb_add(&bar[XB_XGEN(b.x)], 1u);
            asm volatile("s_waitcnt vmcnt(0)" ::: "memory");
        } else {
            XB_SPIN(xb_ld(&bar[XB_XGEN(b.x)]) == gen, bar);
            __builtin_amdgcn_fence(__ATOMIC_ACQUIRE, "agent");
            asm volatile("s_waitcnt vmcnt(0)" ::: "memory");
        }
    }
    __syncthreads();
}

namespace rw {
constexpr int LD = 72;
constexpr int MATB = 64 * LD * 2;
constexpr int OFF_F0 = 12 * MATB  , OFF_TMP = OFF_F0 + 64 * 65 * 4  ;
constexpr int OFF_TW = 8 * MATB  , OFF_TA = OFF_TW + 5120, OFF_TV = OFF_TA + 5120, OFF_WP = OFF_TV + 5120  , OFF_AP = OFF_WP + 16640, OFF_VP = OFF_AP + 16640;
constexpr int OFF_TOT = 139264, OFF_GC = OFF_TOT + 2048, OFF_RN = OFF_GC + 256, OFF_END = OFF_RN + 256;
constexpr int NITEMS = BATCH * 6 * (SEQ / 64);
__device__ __forceinline__ int sigpos(int c) { return (c & 32) + 8 * ((c >> 2) & 3) + 4 * ((c >> 4) & 1) + (c & 3); }
#define RW_BAR() do { asm volatile("s_waitcnt vmcnt(0) lgkmcnt(0)" ::: "memory"); __builtin_amdgcn_s_barrier(); asm volatile("" ::: "memory"); } while (0)
__device__ __forceinline__ f32x4 mm_tile(const LAS bf16_t* A, const LAS bf16_t* Bt, int ti, int tj, int fr, int fq, f32x4 acc) {
#pragma unroll
    for (int kk = 0; kk < 2; ++kk) {
        const bf16x8 a = *(const LAS bf16x8*)(A + (16 * ti + fr) * LD + 32 * kk + 8 * fq);
        const bf16x8 b = *(const LAS bf16x8*)(Bt + (16 * tj + fr) * LD + 32 * kk + 8 * fq);
        acc = __builtin_amdgcn_mfma_f32_16x16x32_bf16(a, b, acc, 0, 0, 0);
    }
    return acc;
}
__device__ __forceinline__ unsigned pk2(float lo, float hi) { return (unsigned)f2bf(lo) | ((unsigned)f2bf(hi) << 16); }
struct ChunkBufs { bf16_t* PT; bf16_t* G; float* Z; float* YV; bf16_t* S0; bf16_t* VOUT; float* DOT; const bf16_t *W2T, *A2T, *V2T, *G2T; };

#define RW_LANES() int lt_ = tid_in; asm volatile("" : "+v"(lt_)); const int tid = lt_, lane = lt_ & 63, fr = lane & 15, fq = lane >> 4; (void)tid; (void)fr; (void)fq
__device__ __forceinline__ void chunk_phase(LAS unsigned char* L, const bf16_t* P, const sk::RwkvW W, int layer, const bf16_t* VFIRST, const ChunkBufs cb, int tid_in, int first, int stride) {
    const int w = __builtin_amdgcn_readfirstlane(tid_in >> 6);
    LAS bf16_t* B0 = (LAS bf16_t*)(L + 0 * MATB); LAS bf16_t* B1 = (LAS bf16_t*)(L + 1 * MATB); LAS bf16_t* B2 = (LAS bf16_t*)(L + 2 * MATB); LAS bf16_t* B3 = (LAS bf16_t*)(L + 3 * MATB);
    LAS bf16_t* B4 = (LAS bf16_t*)(L + 4 * MATB); LAS bf16_t* B5 = (LAS bf16_t*)(L + 5 * MATB); LAS bf16_t* B6 = (LAS bf16_t*)(L + 6 * MATB); LAS bf16_t* B7 = (LAS bf16_t*)(L + 7 * MATB);
    LAS bf16_t* B8 = (LAS bf16_t*)(L + 8 * MATB); LAS bf16_t* B9 = (LAS bf16_t*)(L + 9 * MATB); LAS bf16_t* B10 = (LAS bf16_t*)(L + 10 * MATB); LAS bf16_t* B11 = (LAS bf16_t*)(L + 11 * MATB);
    LAS float* F0 = (LAS float*)(L + OFF_F0); LAS float* TMP = (LAS float*)(L + OFF_TMP);
    LAS bf16_t* TW = (LAS bf16_t*)(L + OFF_TW); LAS bf16_t* TA = (LAS bf16_t*)(L + OFF_TA); LAS bf16_t* TV = (LAS bf16_t*)(L + OFF_TV);
    LAS float* WP = (LAS float*)(L + OFF_WP); LAS float* AP = (LAS float*)(L + OFF_AP); LAS float* VP = (LAS float*)(L + OFF_VP);
    LAS float* TOT = (LAS float*)(L + OFF_TOT); LAS float* GC = (LAS float*)(L + OFF_GC); LAS float* RN = (LAS float*)(L + OFF_RN);
    for (int item = first; item < NITEMS; item += stride) {
        const int bh = item / (SEQ / 64), chunk = item % (SEQ / 64), b = bh / 6, h = bh % 6;
        const int tok0 = b * SEQ + chunk * 64;
        { RW_LANES(); const int t = tid >> 3, sub = tid & 7, tok = tok0 + t;
#pragma unroll
          for (int e = 0; e < 4; ++e) { const int j = 4 * sub + e;
              TW[t * 40 + j] = f2bf(tanhf(sk::shifted(P, tok, 640 + 1152 + j, W.mu[1152 + j])));
              TA[t * 40 + j] = f2bf(sk::shifted(P, tok, 640 + 1184 + j, W.mu[1184 + j])); }
          if (layer > 0) {
#pragma unroll
              for (int e = 0; e < 2; ++e) { const int j = 2 * sub + e; TV[t * 40 + j] = f2bf(sk::shifted(P, tok, 2176 + j, W.mu_v[j])); TV[t * 40 + 16 + j] = 0; } }
          float s = 0.f;
#pragma unroll
          for (int e = 0; e < 8; ++e) { const int hc = 64 * h + 8 * sub + e; const float kc = sk::shifted(P, tok, 640 + 384 + hc, W.mu[384 + hc]) * W.k_k[hc]; s += kc * kc; }
          s += __shfl_xor(s, 1); s += __shfl_xor(s, 2); s += __shfl_xor(s, 4);
          if (sub == 0) RN[t] = 1.0f / fmaxf(sqrtf(s), 1e-12f); }
        RW_BAR();
        { RW_LANES();
#pragma unroll
        for (int e = 0; e < 2; ++e) { const int tl = 2 * w + e, ti = tl >> 2, tj = tl & 3; const f32x4 z4 = {0.f, 0.f, 0.f, 0.f};
            const size_t brow = (size_t)(64 * h + 16 * tj + fr) * 32 + 8 * fq;
            { const bf16x8 a = *(const LAS bf16x8*)(TW + (16 * ti + fr) * 40 + 8 * fq); const bf16x8 bb = *(const GAS bf16x8*)(cb.W2T + brow);
              const f32x4 d = __builtin_amdgcn_mfma_f32_16x16x32_bf16(a, bb, z4, 0, 0, 0);
#pragma unroll
              for (int r = 0; r < 4; ++r) WP[(16 * ti + 4 * fq + r) * 65 + 16 * tj + fr] = d[r]; }
            { const bf16x8 a = *(const LAS bf16x8*)(TA + (16 * ti + fr) * 40 + 8 * fq); const bf16x8 bb = *(const GAS bf16x8*)(cb.A2T + brow);
              const f32x4 d = __builtin_amdgcn_mfma_f32_16x16x32_bf16(a, bb, z4, 0, 0, 0);
#pragma unroll
              for (int r = 0; r < 4; ++r) AP[(16 * ti + 4 * fq + r) * 65 + 16 * tj + fr] = d[r]; }
            if (layer > 0) { const bf16x8 a = *(const LAS bf16x8*)(TV + (16 * ti + fr) * 40 + 8 * fq); const bf16x8 bb = *(const GAS bf16x8*)(cb.V2T + brow);
              const f32x4 d = __builtin_amdgcn_mfma_f32_16x16x32_bf16(a, bb, z4, 0, 0, 0);
#pragma unroll
              for (int r = 0; r < 4; ++r) VP[(16 * ti + 4 * fq + r) * 65 + 16 * tj + fr] = d[r]; } } }
        RW_BAR();
        { RW_LANES(); const int c = lane, hc = 64 * h + c, tq0 = 8 * w, tk0 = tok0 + tq0;
          const float mu_r = W.mu[hc], mu_k = W.mu[384 + hc], mu_v = W.mu[768 + hc], w0 = W.w0[hc], a0 = W.a0[hc], k_k = W.k_k[hc], k_a = W.k_a[hc], r_k = W.r_k[hc];
          const float v0 = layer > 0 ? W.v0[hc] : 0.f;
          const bool has_prev = (chunk * 64 + tq0) > 0;
          float pr = has_prev ? bf2f(P[(size_t)(tk0 - 1) * LDP + 640 + hc]) : 0.f, pk = has_prev ? bf2f(P[(size_t)(tk0 - 1) * LDP + 1024 + hc]) : 0.f, pv = has_prev ? bf2f(P[(size_t)(tk0 - 1) * LDP + 1408 + hc]) : 0.f;
          float rr[8], kq[8], vv[8], kkc[8], bb[8], ld[8];
#pragma unroll
          for (int j = 0; j < 8; ++j) { const int t = tq0 + j; const size_t row = (size_t)(tk0 + j) * LDP;
              const float cr = bf2f(P[row + 640 + hc]), ck = bf2f(P[row + 1024 + hc]), cv = bf2f(P[row + 1408 + hc]);
              const float r = cr + mu_r * (pr - cr), k = ck + mu_k * (pk - ck); float v = cv + mu_v * (pv - cv); pr = cr; pk = ck; pv = cv;
              const float wp = w0 + WP[t * 65 + c], ap = a0 + AP[t * 65 + c];
              const float z = -wp, sp = fmaxf(z, 0.f) + log1pf(expf(-fabsf(z))); const float wl = -sp - 0.5f;
              const float al = 1.0f / (1.0f + expf(-ap));
              if (layer > 0) { const float vp = v0 + VP[t * 65 + c]; const float vf = bf2f(VFIRST[(size_t)(tk0 + j) * 384 + hc]); v = v + (vf - v) * (1.0f / (1.0f + expf(-vp))); }
              const float kn = k * k_k * RN[t]; const float k2 = k * (1.0f + (al - 1.0f) * k_a);
              rr[j] = bf2f(f2bf(r)); kq[j] = bf2f(f2bf(k2)); vv[j] = bf2f(f2bf(v)); kkc[j] = bf2f(f2bf(kn)); bb[j] = bf2f(f2bf(kn * al)); ld[j] = bf2f(f2bf(-expf(wl)));
              cb.VOUT[(size_t)(tk0 + j) * 384 + hc] = f2bf(v);
              float dsum = rr[j] * kq[j] * r_k;
#pragma unroll
              for (int o = 1; o < 64; o <<= 1) dsum += __shfl_xor(dsum, o);
              if (lane == 0) cb.DOT[(size_t)(tk0 + j) * 6 + h] = dsum; }
          float cl[8]; cl[0] = ld[0];
#pragma unroll
          for (int j = 1; j < 8; ++j) cl[j] = cl[j - 1] + ld[j];
          TOT[w * 64 + c] = cl[7];
          RW_BAR();
          float prefix = 0.f, cumC = 0.f;
#pragma unroll
          for (int ww = 0; ww < 8; ++ww) { const float tv = TOT[ww * 64 + c]; cumC += tv; if (ww < w) prefix += tv; }
          if (w == 0) GC[c] = expf(cumC);
          unsigned ahp[4], btp[4], ktp[4], vp4[4];
#pragma unroll
          for (int j = 0; j < 8; ++j) { const int t = tq0 + j; const float cum = prefix + cl[j], cump = cum - ld[j];
              const float g = expf(cum), gp = expf(cump), ig = expf(-cum), gc = expf(cumC - cum);
              const bf16_t ah = f2bf(-kkc[j] * gp), rh = f2bf(rr[j] * g), bh = f2bf(bb[j] * ig), kh = f2bf(kq[j] * ig), bt = f2bf(bb[j] * gc), kt = f2bf(kq[j] * gc), vb = f2bf(vv[j]);
              B0[t * LD + c] = ah; B1[t * LD + c] = rh; B2[t * LD + c] = bh; B3[t * LD + c] = kh;
              if (j & 1) { ahp[j >> 1] |= (unsigned)ah << 16; btp[j >> 1] |= (unsigned)bt << 16; ktp[j >> 1] |= (unsigned)kt << 16; vp4[j >> 1] |= (unsigned)vb << 16; }
              else { ahp[j >> 1] = ah; btp[j >> 1] = bt; ktp[j >> 1] = kt; vp4[j >> 1] = vb; } }
          *(LAS v4u*)(B4 + c * LD + tq0) = (v4u){ahp[0], ahp[1], ahp[2], ahp[3]}; *(LAS v4u*)(B5 + c * LD + tq0) = (v4u){btp[0], btp[1], btp[2], btp[3]};
          *(LAS v4u*)(B6 + c * LD + tq0) = (v4u){ktp[0], ktp[1], ktp[2], ktp[3]}; *(LAS v4u*)(B7 + c * LD + tq0) = (v4u){vp4[0], vp4[1], vp4[2], vp4[3]}; }
        RW_BAR();
        { RW_LANES(); const int prod = w >> 1; const LAS bf16_t* Aop = prod < 2 ? B0 : B1; const LAS bf16_t* Bop = (prod & 1) ? B3 : B2;
#pragma unroll
          for (int e = 0; e < 8; ++e) { const int tl = (w & 1) * 8 + e, ti = tl >> 2, tj = tl & 3; f32x4 d = {0.f, 0.f, 0.f, 0.f};
              if (tj <= ti) d = mm_tile(Aop, Bop, ti, tj, fr, fq, d);
#pragma unroll
              for (int r = 0; r < 4; ++r) { const int t = 16 * ti + 4 * fq + r, i = 16 * tj + fr; const bool keep = prod < 2 ? (i < t) : (i <= t); const float val = (tj <= ti && keep) ? d[r] : 0.f;
                  if (prod == 0) F0[t * 65 + i] = val; else if (prod == 1) B8[t * LD + i] = f2bf(val); else if (prod == 2) B9[t * LD + i] = f2bf(val); else B10[t * LD + i] = f2bf(val); } } }
        RW_BAR();
        if (w == 0) { RW_LANES();
            const int blk = lane >> 4, jc = lane & 15; const LAS float* Lb = F0 + (16 * blk) * 65 + 16 * blk; float tc[16];
#pragma unroll
            for (int r = 0; r < 16; ++r) { float val = (r == jc) ? 1.f : 0.f;
#pragma unroll
                for (int i = 0; i < r; ++i) val += Lb[r * 65 + i] * tc[i];
                tc[r] = val; }
            asm volatile("s_waitcnt lgkmcnt(0)" ::: "memory");
#pragma unroll
            for (int r = 0; r < 16; ++r) F0[(16 * blk + r) * 65 + 16 * blk + jc] = tc[r];
        }
        RW_BAR();
        if (w < 2) { RW_LANES();
            const int o1 = 32 * w, o2 = 32 * w + 16; f32x4 d = {0.f, 0.f, 0.f, 0.f};
#pragma unroll
            for (int ks = 0; ks < 4; ++ks) d = __builtin_amdgcn_mfma_f32_16x16x4f32(F0[(o2 + fr) * 65 + o1 + 4 * ks + fq], F0[(o1 + 4 * ks + fq) * 65 + o1 + fr], d, 0, 0, 0);
            LAS float* tm = TMP + w * 16 * 17;
#pragma unroll
            for (int r = 0; r < 4; ++r) tm[(4 * fq + r) * 17 + fr] = d[r];
            asm volatile("s_waitcnt lgkmcnt(0)" ::: "memory");
            f32x4 d2 = {0.f, 0.f, 0.f, 0.f};
#pragma unroll
            for (int ks = 0; ks < 4; ++ks) d2 = __builtin_amdgcn_mfma_f32_16x16x4f32(F0[(o2 + fr) * 65 + o2 + 4 * ks + fq], tm[(4 * ks + fq) * 17 + fr], d2, 0, 0, 0);
            asm volatile("s_waitcnt lgkmcnt(0)" ::: "memory");
#pragma unroll
            for (int r = 0; r < 4; ++r) F0[(o2 + 4 * fq + r) * 65 + o1 + fr] = d2[r];
        }
        RW_BAR();
        if (w < 4) { RW_LANES();
            const int ti = w >> 1, tj = w & 1; f32x4 d = {0.f, 0.f, 0.f, 0.f};
#pragma unroll
            for (int ks = 0; ks < 8; ++ks) d = __builtin_amdgcn_mfma_f32_16x16x4f32(F0[(32 + 16 * ti + fr) * 65 + 4 * ks + fq], F0[(4 * ks + fq) * 65 + 16 * tj + fr], d, 0, 0, 0);
#pragma unroll
            for (int r = 0; r < 4; ++r) TMP[(16 * ti + 4 * fq + r) * 33 + 16 * tj + fr] = d[r];
        }
        RW_BAR();
        if (w < 4) { RW_LANES();
            const int ti = w >> 1, tj = w & 1; f32x4 d = {0.f, 0.f, 0.f, 0.f};
#pragma unroll
            for (int ks = 0; ks < 8; ++ks) d = __builtin_amdgcn_mfma_f32_16x16x4f32(F0[(32 + 16 * ti + fr) * 65 + 32 + 4 * ks + fq], TMP[(4 * ks + fq) * 33 + 16 * tj + fr], d, 0, 0, 0);
#pragma unroll
            for (int r = 0; r < 4; ++r) F0[(32 + 16 * ti + 4 * fq + r) * 65 + 16 * tj + fr] = d[r];
        }
        RW_BAR();
        { RW_LANES(); const int t = tid >> 3, i0 = (tid & 7) * 8;
#pragma unroll
          for (int e = 0; e < 8; ++e) B11[t * LD + i0 + e] = f2bf(F0[t * 65 + i0 + e]); }
        RW_BAR();
        { RW_LANES();
#pragma unroll
        for (int e = 0; e < 4; ++e) { const int tl = 4 * w + e, prod = tl >> 4, ti = (tl >> 2) & 3, tj = tl & 3; f32x4 d = {0.f, 0.f, 0.f, 0.f};
            d = prod == 0 ? mm_tile(B11, B4, ti, tj, fr, fq, d) : mm_tile(B8, B7, ti, tj, fr, fq, d);
            LAS bf16_t* dst = (prod == 0 ? B0 : B2) + (16 * tj + fr) * LD + 16 * ti + 4 * fq;
            *(LAS unsigned long long*)dst = (unsigned long long)pk2(d[0], d[1]) | ((unsigned long long)pk2(d[2], d[3]) << 32); } }
        RW_BAR();
        { RW_LANES();
#pragma unroll
        for (int e = 0; e < 2; ++e) { const int tl = 2 * w + e, ti = tl >> 2, tj = tl & 3; f32x4 d = {0.f, 0.f, 0.f, 0.f};
            d = mm_tile(B11, B2, ti, tj, fr, fq, d);
            LAS bf16_t* dst = B3 + (16 * tj + fr) * LD + 16 * ti + 4 * fq;
            *(LAS unsigned long long*)dst = (unsigned long long)pk2(d[0], d[1]) | ((unsigned long long)pk2(d[2], d[3]) << 32); } }
        RW_BAR();
        { RW_LANES();
#pragma unroll
        for (int e = 0; e < 8; ++e) { const int tl = 8 * w + e, prod = tl >> 4, ti = (tl >> 2) & 3, tj = tl & 3; f32x4 d = {0.f, 0.f, 0.f, 0.f};
            if (prod == 0) { d = mm_tile(B5, B3, ti, tj, fr, fq, d); d = mm_tile(B6, B7, ti, tj, fr, fq, d);
                *(GAS f32x4*)(cb.Z + (size_t)item * 4096 + (16 * tj + fr) * 64 + 16 * ti + 4 * fq) = d; }
            else if (prod == 1) { d = mm_tile(B9, B3, ti, tj, fr, fq, d); d = mm_tile(B10, B7, ti, tj, fr, fq, d);
                *(GAS f32x4*)(cb.YV + (size_t)item * 4096 + (16 * tj + fr) * 64 + 16 * ti + 4 * fq) = d; }
            else if (prod == 2) { d = mm_tile(B9, B0, ti, tj, fr, fq, d);
#pragma unroll
                for (int r = 0; r < 4; ++r) { const int t = 16 * ti + 4 * fq + r, c = 16 * tj + fr; B4[t * LD + sigpos(c)] = f2bf(d[r] + bf2f(B1[t * LD + c])); } }
            else { d = mm_tile(B5, B0, ti, tj, fr, fq, d);
#pragma unroll
                for (int r = 0; r < 4; ++r) { const int c = 16 * ti + 4 * fq + r, c2 = 16 * tj + fr; B8[c * LD + sigpos(c2)] = f2bf(d[r] + (c == c2 ? GC[c] : 0.f)); } } } }
        RW_BAR();
        { RW_LANES(); const int r = tid >> 3, ch = (tid & 7) * 8;
          *(GAS v4u*)(cb.G + (size_t)item * 4096 + r * 64 + ch) = *(const LAS v4u*)(B4 + r * LD + ch);
          *(GAS v4u*)(cb.PT + (size_t)item * 4096 + r * 64 + ch) = *(const LAS v4u*)(B8 + r * LD + ch); }
        RW_BAR();
    }
}
__device__ __forceinline__ void scan_phase(const ChunkBufs cb, int bh, int tj, int lane) {
    const int fr = lane & 15, fq = lane >> 4; const int NC = SEQ / 64;
    bf16x8 Bf0 = {0, 0, 0, 0, 0, 0, 0, 0}, Bf1 = {0, 0, 0, 0, 0, 0, 0, 0};
    for (int chunk = 0; chunk < NC; ++chunk) {
        const size_t ib = (size_t)(bh * NC + chunk) * 4096;
        bf16_t* s0 = cb.S0 + ib + (16 * tj + fr) * 64 + 8 * fq;
        *(GAS bf16x8*)s0 = Bf0; *(GAS bf16x8*)(s0 + 32) = Bf1;
        const bf16_t* pt = cb.PT + ib + fr * 64 + 8 * fq; const float* zz = cb.Z + ib + (16 * tj + fr) * 64 + 4 * fq;
        f32x4 acc[4];
#pragma unroll
        for (int ti = 0; ti < 4; ++ti) { const bf16x8 a0 = *(const GAS bf16x8*)(pt + ti * 1024), a1 = *(const GAS bf16x8*)(pt + ti * 1024 + 32); const f32x4 z = *(const GAS f32x4*)(zz + 16 * ti);
            acc[ti] = __builtin_amdgcn_mfma_f32_16x16x32_bf16(a0, Bf0, z, 0, 0, 0); acc[ti] = __builtin_amdgcn_mfma_f32_16x16x32_bf16(a1, Bf1, acc[ti], 0, 0, 0); }
        v4u n0, n1;
        n0.x = pk2(acc[0][0], acc[0][1]); n0.y = pk2(acc[0][2], acc[0][3]); n0.z = pk2(acc[1][0], acc[1][1]); n0.w = pk2(acc[1][2], acc[1][3]);
        n1.x = pk2(acc[2][0], acc[2][1]); n1.y = pk2(acc[2][2], acc[2][3]); n1.z = pk2(acc[3][0], acc[3][1]); n1.w = pk2(acc[3][2], acc[3][3]);
        Bf0 = __builtin_bit_cast(bf16x8, n0); Bf1 = __builtin_bit_cast(bf16x8, n1);
    }
}
constexpr int O_SG = 0  , O_Y = 9216  , O_GT = O_Y + 16640  ;
__device__ __forceinline__ void out_phase(LAS unsigned char* L, const bf16_t* P, const sk::RwkvW W, const ChunkBufs cb, bf16_t* MIX, int tid_in, int first, int stride) {
    const int w = __builtin_amdgcn_readfirstlane(tid_in >> 6);
    LAS bf16_t* SG = (LAS bf16_t*)(L + O_SG); LAS float* Y = (LAS float*)(L + O_Y); LAS float* GT = (LAS float*)(L + O_GT);
    for (int item = first; item < NITEMS; item += stride) {
        const int bh = item / (SEQ / 64), chunk = item % (SEQ / 64), b = bh / 6, h = bh % 6; const int tok0 = b * SEQ + chunk * 64; const size_t ib = (size_t)item * 4096;
        { RW_LANES(); const int t = tid >> 3, sub = tid & 7;
#pragma unroll
          for (int e = 0; e < 8; ++e) { const int j = 8 * sub + e; SG[t * LD + j] = f2bf(1.0f / (1.0f + expf(-sk::shifted(P, tok0 + t, 640 + 1216 + j, W.mu[1216 + j])))); } }
        RW_BAR();
        { RW_LANES();
#pragma unroll
        for (int e = 0; e < 2; ++e) { const int tl = 2 * w + e, ti = tl >> 2, tj = tl & 3;
            f32x4 d = *(const GAS f32x4*)(cb.YV + ib + (16 * tj + fr) * 64 + 16 * ti + 4 * fq); f32x4 g = {0.f, 0.f, 0.f, 0.f};
#pragma unroll
            for (int kk = 0; kk < 2; ++kk) {
                const bf16x8 a = *(const GAS bf16x8*)(cb.G + ib + (16 * ti + fr) * 64 + 32 * kk + 8 * fq), bb = *(const GAS bf16x8*)(cb.S0 + ib + (16 * tj + fr) * 64 + 32 * kk + 8 * fq);
                d = __builtin_amdgcn_mfma_f32_16x16x32_bf16(a, bb, d, 0, 0, 0);
                const bf16x8 a2 = *(const LAS bf16x8*)(SG + (16 * ti + fr) * LD + 32 * kk + 8 * fq), b2 = *(const GAS bf16x8*)(cb.G2T + (size_t)(64 * h + 16 * tj + fr) * 64 + 32 * kk + 8 * fq);
                g = __builtin_amdgcn_mfma_f32_16x16x32_bf16(a2, b2, g, 0, 0, 0); }
#pragma unroll
            for (int r = 0; r < 4; ++r) { Y[(16 * ti + 4 * fq + r) * 65 + 16 * tj + fr] = d[r]; GT[(16 * ti + 4 * fq + r) * 65 + 16 * tj + fr] = g[r]; } } }
        RW_BAR();
        { RW_LANES(); const int t = tid >> 3, sub = tid & 7, tok = tok0 + t; float yv[8], s = 0.f;
#pragma unroll
          for (int e = 0; e < 8; ++e) { yv[e] = bf2f(f2bf(Y[t * 65 + 8 * sub + e])); s += yv[e]; }
          s += __shfl_xor(s, 1); s += __shfl_xor(s, 2); s += __shfl_xor(s, 4);
          const float mean = s * (1.0f / 64.0f); float q = 0.f;
#pragma unroll
          for (int e = 0; e < 8; ++e) { const float dd = yv[e] - mean; q += dd * dd; }
          q += __shfl_xor(q, 1); q += __shfl_xor(q, 2); q += __shfl_xor(q, 4);
          const float rstd = 1.0f / sqrtf(q * (1.0f / 64.0f) + GN_EPS), dot = cb.DOT[(size_t)tok * 6 + h];
          unsigned o[4];
#pragma unroll
          for (int e = 0; e < 8; e += 2) { float r2[2];
#pragma unroll
              for (int u = 0; u < 2; ++u) { const int v = 8 * sub + e + u, hc = 64 * h + v; const float yn = (yv[e + u] - mean) * rstd * W.ln_w[hc] + W.ln_b[hc];
                  r2[u] = (yn + dot * bf2f(cb.VOUT[(size_t)tok * 384 + hc])) * GT[t * 65 + v]; }
              o[e >> 1] = pk2(r2[0], r2[1]); }
          *(GAS v4u*)(MIX + (size_t)tok * DM + 384 + 64 * h + 8 * sub) = (v4u){o[0], o[1], o[2], o[3]}; }
        RW_BAR();
    }
}
}
constexpr int NWAVES = 8;
namespace mk {
constexpr size_t WS_CTL = 0, CTL_ZERO_BYTES = 1 * MiB;
constexpr size_t CTL_SSQ = 512 * 1024;
constexpr size_t WS_SMALL = 1 * MiB, SM_BIAS = 0, SM_SSQM = 4096, SM_MKV = 512 * 1024;
constexpr size_t WS_MEMB = 2 * MiB, WS_WT = 3 * MiB, WS_XB = 28 * MiB, WS_VF = 60 * MiB, WS_PROJ = 72 * MiB, WS_MIX = 144 * MiB, WS_PREP = 176 * MiB, WS_U = 72 * MiB, WS_ACT = 160 * MiB, WS_END = 248 * MiB;
constexpr size_t WT_IN = 0, WT_OUT = 4718592, WT_UP = WT_OUT + 2 * MiB, WT_DOWN = WT_UP + 11 * MiB, WT_MKV = WT_DOWN + 5767168;
constexpr int CW_TMO = 0, CW_BAR = 4096;
constexpr int LDS_BYTES = 163840, LDSCTL_OFF = LDS_BYTES - 512, MISC_OFF = LDSCTL_OFF + 320;
constexpr size_t SM_W2T = 8192, SM_A2T = 32768, SM_V2T = 57344, SM_G2T = 81920;
constexpr size_t WS_PT = 176 * MiB, WS_G = 188 * MiB, WS_S0 = 200 * MiB, WS_Z = 212 * MiB, WS_V1 = 236 * MiB, WS_YV = 28 * MiB  , WS_DOT = 52 * MiB;
#ifndef FAST_RWKV
#define FAST_RWKV 1
#endif

struct Args { const float* in[N_IN]; float* out; unsigned char* ws; int ph_lo, ph_hi; };

__device__ __forceinline__ unsigned pk2(float lo, float hi) { return (unsigned)f2bf(lo) | ((unsigned)f2bf(hi) << 16); }
__device__ __forceinline__ float wave_sum(float v) {
#pragma unroll
    for (int o = 1; o < 64; o <<= 1) v += __shfl_xor(v, o);
    return v;
}
__device__ __forceinline__ void transpose_item(const float* W, const float* g, int K, int N, bf16_t* WT, LAS float* scr, int item, int lane) {
    const int nblk = N / 32, kb = item / nblk, nb = item % nblk, k0 = 64 * kb, n0 = 32 * nb;
#pragma unroll 8
    for (int i = 0; i < 32; ++i) { const int kk = 2 * i + (lane >> 5); float v = W[(size_t)(k0 + kk) * N + n0 + (lane & 31)]; if (g) v *= g[k0 + kk]; scr[kk * 33 + (lane & 31)] = v; }
    LDS_WAIT(); asm volatile("" ::: "memory");
    const int c = lane & 7;
#pragma unroll
    for (int j = 0; j < 4; ++j) { const int n = (lane >> 3) + 8 * j; const LAS float* s = scr + (8 * c) * 33 + n;
        v4u o; o.x = pk2(s[0 * 33], s[1 * 33]); o.y = pk2(s[2 * 33], s[3 * 33]); o.z = pk2(s[4 * 33], s[5 * 33]); o.w = pk2(s[6 * 33], s[7 * 33]);
        *(GAS v4u*)(WT + (size_t)(n0 + n) * K + k0 + 8 * c) = o; }
    LDS_WAIT(); asm volatile("" ::: "memory");
}
__device__ __forceinline__ void row_to_bf16(const float* xrow, bf16_t* orow, float* ssq_out, int lane) {
    const GAS f32x4* xr = (const GAS f32x4*)xrow + lane; f32x4 v[4]; float s = 0.f;
#pragma unroll
    for (int j = 0; j < 4; ++j) { v[j] = xr[64 * j]; s += (v[j].x * v[j].x + v[j].y * v[j].y) + (v[j].z * v[j].z + v[j].w * v[j].w); }
    s = wave_sum(s);
    GAS unsigned long long* o8 = (GAS unsigned long long*)orow + lane;
#pragma unroll
    for (int j = 0; j < 4; ++j) o8[64 * j] = (unsigned long long)pk2(v[j].x, v[j].y) | ((unsigned long long)pk2(v[j].z, v[j].w) << 32);
    if (lane == 0) *ssq_out = s;
}

__global__ void __launch_bounds__(NWAVES * 64, 2) mk_fwd(Args args) {
    extern __shared__ __attribute__((aligned(16))) unsigned char lds[];
    LAS unsigned char* L = (LAS unsigned char*)lds;
    volatile LAS unsigned* MISC = (volatile LAS unsigned*)(L + MISC_OFF);
    const int tid0 = threadIdx.x;
    const int G = gridDim.x;
    unsigned char* ws = args.ws;
    gu32* ctl = (gu32*)(ws + WS_CTL);
    for (int u = tid0; u < (LDS_BYTES - LDSCTL_OFF) / 4; u += NWAVES * 64) ((LAS unsigned*)(L + LDSCTL_OFF))[u] = 0u;
    __syncthreads();
    XcdBarrier bar = xcd_barrier_post((unsigned*)(ctl + CW_BAR), MISC + 8);
    const int lo = args.ph_lo, hi = args.ph_hi;
    int ph = 0;
#define PH_BEGIN if (lo <= ph && ph < hi) { unsigned char* wsp = args.ws; asm volatile("" : "+s"(wsp)); int tid = tid0; asm volatile("" : "+v"(tid)); const int lane = tid & 63, wave = __builtin_amdgcn_readfirstlane(tid >> 6); const long gtid = (long)blockIdx.x * (NWAVES * 64) + tid; const int gw = blockIdx.x * NWAVES + wave; LAS float* scr = (LAS float*)(L + wave * 16384); (void)lane; (void)gtid; (void)gw; (void)scr;
#define PH_END   if (ph + 1 < hi) xcd_barrier(bar); } ++ph;
    float* out = args.out;
#define SSQ_A ((float*)(wsp + WS_CTL + CTL_SSQ))
#define SSQ_B (SSQ_A + 3 * MTOK)
#define biastab ((float*)(wsp + WS_SMALL + SM_BIAS))
#define ssqm ((float*)(wsp + WS_SMALL + SM_SSQM))
#define MKV ((bf16_t*)(wsp + WS_SMALL + SM_MKV))
#define MEMB ((bf16_t*)(wsp + WS_MEMB))
#define Wt_in ((bf16_t*)(wsp + WS_WT + WT_IN))
#define Wt_out ((bf16_t*)(wsp + WS_WT + WT_OUT))
#define Wt_up ((bf16_t*)(wsp + WS_WT + WT_UP))
#define Wt_down ((bf16_t*)(wsp + WS_WT + WT_DOWN))
#define Wt_mkv ((bf16_t*)(wsp + WS_WT + WT_MKV))
#define XB ((bf16_t*)(wsp + WS_XB))
#define VF ((bf16_t*)(wsp + WS_VF))
#define PROJ ((bf16_t*)(wsp + WS_PROJ))
#define MIX ((bf16_t*)(wsp + WS_MIX))
#define U ((bf16_t*)(wsp + WS_U))
#define ACT ((bf16_t*)(wsp + WS_ACT))
#define PA ((size_t)MTOK * 384)
#define pR ((bf16_t*)(wsp + WS_PREP))
#define pK (pR + PA)
#define pV (pR + 2 * PA)
#define pKK (pR + 3 * PA)
#define pB (pR + 4 * PA)
#define pLD (pR + 5 * PA)
    const long gsize = (long)G * (NWAVES * 64);
    const int NGW = G * NWAVES;

#define MK_W() sk::RwkvW W{args.in[I_MU] + l * 1280, args.in[I_MUV], args.in[I_W0] + l * 384, args.in[I_W2] + l * 32 * 384, args.in[I_A0] + l * 384, args.in[I_A2] + l * 32 * 384, args.in[I_V0], args.in[I_V2], args.in[I_G2] + l * 64 * 384, args.in[I_KK] + l * 384, args.in[I_KA] + l * 384, args.in[I_RK] + l * 384, args.in[I_LNW] + l * 384, args.in[I_LNB] + l * 384};
#define MK_CBUF() const rw::ChunkBufs cbuf{(bf16_t*)(wsp + WS_PT), (bf16_t*)(wsp + WS_G), (float*)(wsp + WS_Z), (float*)(wsp + WS_YV), (bf16_t*)(wsp + WS_S0), (bf16_t*)(wsp + (l == 0 ? WS_VF : WS_V1)), (float*)(wsp + WS_DOT), (const bf16_t*)(wsp + WS_SMALL + SM_W2T), (const bf16_t*)(wsp + WS_SMALL + SM_A2T), (const bf16_t*)(wsp + WS_SMALL + SM_V2T), (const bf16_t*)(wsp + WS_SMALL + SM_G2T)};
    for (int l = 0; l < 2; ++l) {
        const float* xin = l == 0 ? args.in[I_X] : out;
        PH_BEGIN
            const int I_IN = 16 * 68, I_OUT = 16 * 32, I_UP = 16 * 176, I_DN = 44 * 32, I_KV = 16 * 16, NIT = I_IN + I_OUT + I_UP + I_DN + I_KV;
            for (int it = gw; it < NIT; it += NGW) {
                int r = it;
                if (r < I_IN) { transpose_item(args.in[I_WIN] + (size_t)l * 1024 * 2176, args.in[I_MIXG] + l * 1024, 1024, 2176, Wt_in, scr, r, lane); continue; } r -= I_IN;
                if (r < I_OUT) { transpose_item(args.in[I_WOUT] + (size_t)l * 1024 * 1024, nullptr, 1024, 1024, Wt_out, scr, r, lane); continue; } r -= I_OUT;
                if (r < I_UP) { transpose_item(args.in[I_WUP] + (size_t)l * 1024 * 5632, args.in[I_FFNG] + l * 1024, 1024, 5632, Wt_up, scr, r, lane); continue; } r -= I_UP;
                if (r < I_DN) { transpose_item(args.in[I_WDOWN] + (size_t)l * 2816 * 1024, nullptr, 2816, 1024, Wt_down, scr, r, lane); continue; } r -= I_DN;
                transpose_item(args.in[I_WMKV] + (size_t)l * 1024 * 512, args.in[I_MEMG] + l * 1024, 1024, 512, Wt_mkv, scr, r, lane);
            }
            for (long i = gtid; i < 128 * 1024; i += gsize) { const int n = (int)(i >> 10), k = (int)(i & 1023); float v = 0.f;
                if (l > 0 && n < 16) v = args.in[I_WINV][k * 16 + n] * args.in[I_MIXG][l * 1024 + k];
                Wt_in[(size_t)(2176 + n) * 1024 + k] = f2bf(v); }
            for (long i = gtid; i < 384 * 160; i += gsize) { const int hc = (int)(i / 160), j = (int)(i % 160); bf16_t* sm = (bf16_t*)(wsp + WS_SMALL);
                if (j < 32) sm[SM_W2T / 2 + hc * 32 + j] = f2bf(args.in[I_W2][(size_t)l * 32 * 384 + j * 384 + hc]);
                else if (j < 64) sm[SM_A2T / 2 + hc * 32 + (j - 32)] = f2bf(args.in[I_A2][(size_t)l * 32 * 384 + (j - 32) * 384 + hc]);
                else if (j < 96) sm[SM_V2T / 2 + hc * 32 + (j - 64)] = f2bf((j - 64) < 16 ? args.in[I_V2][(j - 64) * 384 + hc] : 0.f);
                else sm[SM_G2T / 2 + hc * 64 + (j - 96)] = f2bf(args.in[I_G2][(size_t)l * 64 * 384 + (j - 96) * 384 + hc]); }
            if (l == 0) {
                for (int m = gw; m < MTOK; m += NGW) row_to_bf16(args.in[I_X] + (size_t)m * DM, XB + (size_t)m * DM, SSQ_A + m, lane);
                for (int m = gw; m < 512; m += NGW) row_to_bf16(args.in[I_MEM] + (size_t)m * DM, MEMB + (size_t)m * DM, ssqm + m, lane);
                sk::d_biastab(args.in[I_RELB], biastab, gtid, gsize);
            }
        PH_END
        PH_BEGIN
            { pg8::Gemm g{XB, Wt_in, MTOK, 2304, 1024}; pg8::StaticOrder S; S.init(MTOK, 2304, G, (int)blockIdx.x);
              pg8::EpiScaleBf16 E{PROJ, LDP, SSQ_A + (size_t)l * MTOK};
              pg8::gemm_phase<pg8::EpiScaleBf16, pg8::StaticOrder, true, true>(L, g, S, E); }
            { pg8::Gemm g{MEMB, Wt_mkv, 512, 512, 1024}; pg8::StaticOrder S; S.init(512, 512, G, (int)((blockIdx.x + 192) % G));
              pg8::EpiScaleBf16 E{MKV, 512, ssqm};
              pg8::gemm_phase<pg8::EpiScaleBf16, pg8::StaticOrder, true, true>(L, g, S, E); }
        PH_END


        PH_BEGIN
            MK_W(); MK_CBUF(); (void)cbuf;
            sk::d_qknorm(PROJ, MTOK, LDP, args.in[I_AQN] + l * 64, args.in[I_AKN] + l * 64, args.in[I_MQN] + l * 64, 0, gtid, gsize);
            sk::d_qknorm(MKV, 512, 512, nullptr, nullptr, args.in[I_MKN] + l * 64, 1, gtid, gsize);
#if FAST_RWKV
            rw::chunk_phase(L, PROJ, W, l, VF, cbuf, tid, (int)blockIdx.x, G);
#else
            sk::d_rwkv_prep(PROJ, W, l, VF, pR, pK, pV, pKK, pB, pLD, gtid, gsize);
#endif
        PH_END
        PH_BEGIN
            MK_CBUF(); (void)cbuf;
            if (blockIdx.x < BATCH * 6) {
#if FAST_RWKV
                if (wave < 4) rw::scan_phase(cbuf, (int)blockIdx.x, wave, lane);
#else
                if (wave == 0) sk::d_rwkv_scan(pR, pK, pV, pKK, pB, pLD, MIX, (int)blockIdx.x, lane);
#endif
            } else {
                const long gt2 = (long)(blockIdx.x - BATCH * 6) * (NWAVES * 64) + tid, gs2 = (long)(G - BATCH * 6) * (NWAVES * 64);
                sk::d_swa(PROJ, MIX, biastab, args.in[I_SINK] + l * 6, gt2, gs2);
                sk::d_memattn(PROJ, MKV, MIX, gt2, gs2);
            }
        PH_END
        PH_BEGIN
            MK_W(); MK_CBUF(); (void)cbuf;
#if FAST_RWKV
            rw::out_phase(L, PROJ, W, cbuf, MIX, tid, (int)blockIdx.x, G);
#else
            sk::d_rwkv_fin(PROJ, W, pR, pK, pV, MIX, gtid, gsize);
#endif
        PH_END
        PH_BEGIN
            pg8::Gemm g{MIX, Wt_out, MTOK, 1024, 1024}; pg8::StaticOrder S; S.init(MTOK, 1024, G, (int)blockIdx.x);
            pg8::EpiResid E{xin, out, XB, SSQ_B + (size_t)l * MTOK, 1024};
            pg8::gemm_phase<pg8::EpiResid, pg8::StaticOrder, true, true>(L, g, S, E);
        PH_END
        for (int b = 0; b < BATCH; ++b) {
            PH_BEGIN
                pg8::Gemm g{XB + (size_t)b * SEQ * 1024, Wt_up, SEQ, 5632, 1024}; pg8::StaticOrder S; S.init(SEQ, 5632, G, (int)blockIdx.x);
                pg8::EpiScaleBf16 E{U, 5632, SSQ_B + (size_t)l * MTOK + (size_t)b * SEQ};
                pg8::gemm_phase<pg8::EpiScaleBf16, pg8::StaticOrder, true, true>(L, g, S, E);
            PH_END
            PH_BEGIN
                sk::d_conv_act(U, args.in[I_CW] + (size_t)l * 3 * 5632, args.in[I_CB] + (size_t)l * 5632, ACT + (size_t)b * SEQ * DFF, SEQ, gtid, gsize);
            PH_END
        }
        PH_BEGIN
            pg8::Gemm g{ACT, Wt_down, MTOK, 1024, 2816}; pg8::StaticOrder S; S.init(MTOK, 1024, G, (int)blockIdx.x);
            pg8::EpiResid E{out, out, XB, SSQ_A + (size_t)(l + 1) * MTOK, 1024};
            pg8::gemm_phase<pg8::EpiResid, pg8::StaticOrder, true, true>(L, g, S, E);
        PH_END
    }
#undef PH_BEGIN
#undef PH_END
}
constexpr int N_PHASES = 2 * 11;
}

#ifndef MK_PER_PHASE
#define MK_PER_PHASE 0
#endif
extern "C" void kernel_launch(void* const* d_in, const int* in_sizes, int n_in, void* d_out, int out_size, void* d_ws, size_t ws_size, hipStream_t stream) {
    static int grid = 0;
    if (grid == 0) {
        if (n_in != N_IN || out_size != MTOK * DM || ws_size < mk::WS_END) { fprintf(stderr, "kernel_launch: unexpected shapes (n_in %d out %d ws %zu)\n", n_in, out_size, ws_size); grid = -1; return; }
        int dev = 0, cus = 0, per_cu = 0;
        if (hipGetDevice(&dev) != hipSuccess || hipDeviceGetAttribute(&cus, hipDeviceAttributeMultiprocessorCount, dev) != hipSuccess) { grid = -1; return; }
        if (hipFuncSetAttribute((const void*)mk::mk_fwd, hipFuncAttributeMaxDynamicSharedMemorySize, mk::LDS_BYTES) != hipSuccess) { fprintf(stderr, "kernel_launch: hipFuncSetAttribute failed\n"); grid = -1; return; }
        if (hipOccupancyMaxActiveBlocksPerMultiprocessor(&per_cu, (const void*)mk::mk_fwd, NWAVES * 64, mk::LDS_BYTES) != hipSuccess || per_cu < 1) { fprintf(stderr, "kernel_launch: occupancy query says %d blocks per CU\n", per_cu); }
        (void)hipGetLastError();
        grid = cus;
    }
    if (grid < 0) return;
    if (hipMemsetAsync((char*)d_ws + mk::WS_CTL, 0, mk::CTL_ZERO_BYTES, stream) != hipSuccess) return;
    mk::Args a{};
    for (int i = 0; i < N_IN; ++i) a.in[i] = (const float*)d_in[i];
    a.out = (float*)d_out; a.ws = (unsigned char*)d_ws;
#if MK_PER_PHASE
    for (int p = 0; p < mk::N_PHASES; ++p) { a.ph_lo = p; a.ph_hi = p + 1; hipLaunchKernelGGL(mk::mk_fwd, dim3(grid), dim3(NWAVES * 64), mk::LDS_BYTES, stream, a); }
#else
    a.ph_lo = 0; a.ph_hi = mk::N_PHASES;
    hipLaunchKernelGGL(mk::mk_fwd, dim3(grid), dim3(NWAVES * 64), mk::LDS_BYTES, stream, a);
#endif
}
```

```cpp
#define MK_BUILD 1
#ifndef HOST_SIM
#include <hip/hip_runtime.h>
#include <cstdio>
#include <cstdint>
#endif
#ifndef SEQ_LEN
#define SEQ_LEN 8192
#endif
typedef unsigned short bf16_t;
constexpr int BATCH = 2, SEQ = SEQ_LEN, DM = 1024, MTOK = BATCH * SEQ, DFF = 2816, LDP = 2304  ;
constexpr float EPS = 1e-6f, GN_EPS = 64e-5f;
__host__ __device__ __forceinline__ float bf2f(bf16_t h) { unsigned u = (unsigned)h << 16; return __builtin_bit_cast(float, u); }
__host__ __device__ __forceinline__ bf16_t f2bf(float f) { unsigned u = __builtin_bit_cast(unsigned, f); return (bf16_t)((u + 0x7fffu + ((u >> 16) & 1u)) >> 16); }
__host__ __device__ __forceinline__ int t5_bucket(int dist) {
    if (dist < 16) return dist;
    const float v = logf((float)dist / 16.0f) / 2.0794415416798357f * 16.0f;
    int large = 16 + (int)v; return large < 31 ? large : 31;
}
constexpr size_t MiB = 1u << 20;
enum { I_X = 0, I_MEM, I_RELB, I_MIXG, I_WIN, I_WINV, I_AQN, I_AKN, I_SINK, I_MU, I_MUV, I_W0, I_W2, I_A0, I_A2, I_V0, I_V2, I_G2, I_KK, I_KA, I_RK, I_LNW, I_LNB, I_MEMG, I_WMKV, I_MQN, I_MKN, I_WOUT, I_FFNG, I_WUP, I_CW, I_CB, I_WDOWN, N_IN };
namespace sk {

__device__ __forceinline__ void d_wt(const float* W, const float* g, bf16_t* Wt, int K, int N, int Npad, long gtid, long gsize) {
    const long total = (long)Npad * K;
    for (long idx = gtid; idx < total; idx += gsize) {
        const int n = (int)(idx / K), k = (int)(idx % K);
        float v = 0.f;
        if (n < N) { v = W[(long)k * N + n]; if (g) v *= g[k]; }
        Wt[idx] = f2bf(v);
    }
}
#ifndef MK_BUILD
__global__ void k_wt(const float* W, const float* g, bf16_t* Wt, int K, int N, int Npad) { d_wt(W, g, Wt, K, N, Npad, (long)blockIdx.x * blockDim.x + threadIdx.x, (long)gridDim.x * blockDim.x); }
#endif
__device__ __forceinline__ void d_rowprep(const float* x, bf16_t* xb, float* ssq, int rows, long gtid, long gsize) {
    for (long r = gtid; r < rows; r += gsize) {
        const float* xr = x + (long)r * DM; bf16_t* o = xb + (long)r * DM; float s = 0.f;
        for (int c = 0; c < DM; ++c) { const float v = xr[c]; s += v * v; o[c] = f2bf(v); }
        ssq[r] = s;
    }
}
#ifndef MK_BUILD
__global__ void k_rowprep(const float* x, bf16_t* xb, float* ssq, int rows) { d_rowprep(x, xb, ssq, rows, (long)blockIdx.x * blockDim.x + threadIdx.x, (long)gridDim.x * blockDim.x); }
#endif
__device__ __forceinline__ void d_biastab(const float* rel_bias, float* tab, long gtid, long gsize) {
        for (long i = gtid; i < 128 * 6; i += gsize) { const int dist = i / 6, hq = i % 6; tab[i] = rel_bias[t5_bucket(dist) * 6 + hq]; }
}
#ifndef MK_BUILD
__global__ void k_biastab(const float* rel_bias, float* tab) { d_biastab(rel_bias, tab, (long)blockIdx.x * blockDim.x + threadIdx.x, (long)gridDim.x * blockDim.x); }
#endif
__device__ __forceinline__ void d_qknorm(bf16_t* P, int rows, int ld, const float* gq, const float* gk, const float* gm, int mode, long gtid, long gsize) {
    const int nj = mode == 0 ? 12 : 4;
    const long total = (long)rows * nj;
    for (long idx = gtid; idx < total; idx += gsize) {
        const int row = (int)(idx / nj), j = (int)(idx % nj);
        int col; const float* g;
        if (mode == 0) { if (j < 6) { col = 64 * j; g = gq; } else if (j < 8) { col = 384 + 64 * (j - 6); g = gk; } else { col = 1920 + 64 * (j - 8); g = gm; } }
        else { col = 64 * j; g = gm; }
        bf16_t* p = P + (long)row * ld + col; float s = 0.f;
        for (int d = 0; d < 64; ++d) { const float v = bf2f(p[d]); s += v * v; }
        const float rs = 1.0f / sqrtf(s * (1.0f / 64.0f) + EPS);
        for (int d = 0; d < 64; ++d) p[d] = f2bf(bf2f(p[d]) * rs * g[d]);
    }
}
#ifndef MK_BUILD
__global__ void k_qknorm(bf16_t* P, int rows, int ld, const float* gq, const float* gk, const float* gm, int mode) { d_qknorm(P, rows, ld, gq, gk, gm, mode, (long)blockIdx.x * blockDim.x + threadIdx.x, (long)gridDim.x * blockDim.x); }
#endif
__device__ __forceinline__ void d_swa(const bf16_t* P, bf16_t* MIX, const float* biastab, const float* sinks, long gtid, long gsize) {
    const long total = (long)MTOK * 6;
    for (long idx = gtid; idx < total; idx += gsize) {
        const int tok = (int)(idx / 6), hq = (int)(idx % 6), hkv = hq / 3, t = tok % SEQ;
        float q[64], o[64];
#pragma unroll
        for (int d = 0; d < 64; ++d) { q[d] = bf2f(P[(long)tok * LDP + 64 * hq + d]) * 0.125f; o[d] = 0.f; }
        float m = sinks[hq], l = 1.0f;
        const int j0 = t - 127 < 0 ? 0 : t - 127;
        for (int j = j0; j <= t; ++j) {
            const bf16_t* kr = P + (long)(tok - (t - j)) * LDP + 384 + 64 * hkv; const bf16_t* vr = kr + 128;
            float s = 0.f;
#pragma unroll
            for (int d = 0; d < 64; ++d) s += q[d] * bf2f(kr[d]);
            s += biastab[(t - j) * 6 + hq];
            const float mn = fmaxf(m, s), f = expf(m - mn), e = expf(s - mn);
            l = l * f + e; m = mn;
#pragma unroll
            for (int d = 0; d < 64; ++d) o[d] = o[d] * f + e * bf2f(vr[d]);
        }
        const float inv = 1.0f / l;
#pragma unroll
        for (int d = 0; d < 64; ++d) MIX[(long)tok * DM + 64 * hq + d] = f2bf(o[d] * inv);
    }
}
#ifndef MK_BUILD
__global__ __launch_bounds__(256) void k_swa(const bf16_t* P, bf16_t* MIX, const float* biastab, const float* sinks) { d_swa(P, MIX, biastab, sinks, (long)blockIdx.x * blockDim.x + threadIdx.x, (long)gridDim.x * blockDim.x); }
#endif
__device__ __forceinline__ void d_memattn(const bf16_t* P, const bf16_t* MKV, bf16_t* MIX, long gtid, long gsize) {
    const long total = (long)MTOK * 4;
    for (long idx = gtid; idx < total; idx += gsize) {
        const int tok = (int)(idx / 4), h = (int)(idx % 4), b = tok / SEQ;
        float q[64], o[64];
#pragma unroll
        for (int d = 0; d < 64; ++d) { q[d] = bf2f(P[(long)tok * LDP + 1920 + 64 * h + d]) * 0.125f; o[d] = 0.f; }
        float m = -1e30f, l = 0.f;
        for (int j = 0; j < 256; ++j) {
            const bf16_t* kr = MKV + (long)(b * 256 + j) * 512 + 64 * h; const bf16_t* vr = kr + 256;
            float s = 0.f;
#pragma unroll
            for (int d = 0; d < 64; ++d) s += q[d] * bf2f(kr[d]);
            const float mn = fmaxf(m, s), f = expf(m - mn), e = expf(s - mn);
            l = l * f + e; m = mn;
#pragma unroll
            for (int d = 0; d < 64; ++d) o[d] = o[d] * f + e * bf2f(vr[d]);
        }
        const float inv = 1.0f / l;
#pragma unroll
        for (int d = 0; d < 64; ++d) MIX[(long)tok * DM + 768 + 64 * h + d] = f2bf(o[d] * inv);
    }
}
#ifndef MK_BUILD
__global__ __launch_bounds__(256) void k_memattn(const bf16_t* P, const bf16_t* MKV, bf16_t* MIX) { d_memattn(P, MKV, MIX, (long)blockIdx.x * blockDim.x + threadIdx.x, (long)gridDim.x * blockDim.x); }
#endif
__device__ __forceinline__ float shifted(const bf16_t* P, int tok, int col, float mu) {
    const float p = bf2f(P[(long)tok * LDP + col]);
    const float prev = (tok % SEQ) == 0 ? 0.f : bf2f(P[(long)(tok - 1) * LDP + col]);
    return p + mu * (prev - p);
}
struct RwkvW { const float *mu, *mu_v, *w0, *w2, *a0, *a2, *v0, *v2, *g2, *k_k, *k_a, *r_k, *ln_w, *ln_b; };
__device__ __forceinline__ void d_rwkv_prep(const bf16_t* P, RwkvW W, int layer, bf16_t* VFIRST, bf16_t* R, bf16_t* K, bf16_t* V, bf16_t* KK, bf16_t* B, bf16_t* LOGD, long gtid, long gsize) {
    const long total = (long)MTOK * 6;
    for (long idx = gtid; idx < total; idx += gsize) {
        const int tok = (int)(idx / 6), h = (int)(idx % 6);
        float nrm = 0.f;
        for (int c = 0; c < 64; ++c) { const int hc = 64 * h + c; const float kc = shifted(P, tok, 640 + 384 + hc, W.mu[384 + hc]) * W.k_k[hc]; nrm += kc * kc; }
        const float rn = 1.0f / fmaxf(sqrtf(nrm), 1e-12f);
        for (int c = 0; c < 64; ++c) {
            const int hc = 64 * h + c; const long o = (long)tok * 384 + hc;
            const float r = shifted(P, tok, 640 + hc, W.mu[hc]);
            const float k = shifted(P, tok, 640 + 384 + hc, W.mu[384 + hc]);
            float v = shifted(P, tok, 640 + 768 + hc, W.mu[768 + hc]);
            float wp = W.w0[hc], ap = W.a0[hc];
            for (int j = 0; j < 32; ++j) {
                wp += tanhf(shifted(P, tok, 640 + 1152 + j, W.mu[1152 + j])) * W.w2[j * 384 + hc];
                ap += shifted(P, tok, 640 + 1184 + j, W.mu[1184 + j]) * W.a2[j * 384 + hc];
            }
            const float z = -wp; const float sp = fmaxf(z, 0.f) + log1pf(expf(-fabsf(z)));
            const float w = -sp - 0.5f;
            const float a = 1.0f / (1.0f + expf(-ap));
            if (layer > 0) {
                float vp = W.v0[hc];
                for (int j = 0; j < 16; ++j) vp += shifted(P, tok, 2176 + j, W.mu_v[j]) * W.v2[j * 384 + hc];
                const float vf = bf2f(VFIRST[o]);
                v = v + (vf - v) * (1.0f / (1.0f + expf(-vp)));
            } else VFIRST[o] = f2bf(v);
            const float kk = k * W.k_k[hc] * rn;
            R[o] = f2bf(r); K[o] = f2bf(k * (1.0f + (a - 1.0f) * W.k_a[hc])); V[o] = f2bf(v);
            KK[o] = f2bf(kk); B[o] = f2bf(kk * a); LOGD[o] = f2bf(-expf(w));
        }
    }
}
#ifndef MK_BUILD
__global__ void k_rwkv_prep(const bf16_t* P, RwkvW W, int layer, bf16_t* VFIRST, bf16_t* R, bf16_t* K, bf16_t* V, bf16_t* KK, bf16_t* B, bf16_t* LOGD) { d_rwkv_prep(P, W, layer, VFIRST, R, K, V, KK, B, LOGD, (long)blockIdx.x * blockDim.x + threadIdx.x, (long)gridDim.x * blockDim.x); }
#endif
__device__ __forceinline__ void d_rwkv_scan(const bf16_t* R, const bf16_t* K, const bf16_t* V, const bf16_t* KK, const bf16_t* B, const bf16_t* LOGD, bf16_t* MIX, int bh, int i) {
    const int b = bh / 6, h = bh % 6;
    float s[64];
#pragma unroll
    for (int k = 0; k < 64; ++k) s[k] = 0.f;
    for (int t = 0; t < SEQ; ++t) {
        const long o = (long)(b * SEQ + t) * 384 + 64 * h;
        float sa = 0.f;
#pragma unroll
        for (int k = 0; k < 64; ++k) sa -= s[k] * bf2f(KK[o + k]);
        const float v = bf2f(V[o + i]); float y = 0.f;
#pragma unroll
        for (int k = 0; k < 64; ++k) { s[k] = s[k] * expf(bf2f(LOGD[o + k])) + sa * bf2f(B[o + k]) + v * bf2f(K[o + k]); y += s[k] * bf2f(R[o + k]); }
        MIX[(long)(b * SEQ + t) * DM + 384 + 64 * h + i] = f2bf(y);
    }
}
#ifndef MK_BUILD
__global__ void k_rwkv_scan(const bf16_t* R, const bf16_t* K, const bf16_t* V, const bf16_t* KK, const bf16_t* B, const bf16_t* LOGD, bf16_t* MIX) { d_rwkv_scan(R, K, V, KK, B, LOGD, MIX, blockIdx.x, threadIdx.x); }
#endif
__device__ __forceinline__ void d_rwkv_fin(const bf16_t* P, RwkvW W, const bf16_t* R, const bf16_t* K, const bf16_t* V, bf16_t* MIX, long gtid, long gsize) {
    const long total = (long)MTOK * 6;
    for (long idx = gtid; idx < total; idx += gsize) {
        const int tok = (int)(idx / 6), h = (int)(idx % 6);
        bf16_t* y = MIX + (long)tok * DM + 384 + 64 * h; const long o = (long)tok * 384 + 64 * h;
        float mean = 0.f, dot = 0.f;
        for (int c = 0; c < 64; ++c) { mean += bf2f(y[c]); dot += bf2f(R[o + c]) * bf2f(K[o + c]) * W.r_k[64 * h + c]; }
        mean *= (1.0f / 64.0f); float var = 0.f;
        for (int c = 0; c < 64; ++c) { const float d = bf2f(y[c]) - mean; var += d * d; }
        const float rstd = 1.0f / sqrtf(var * (1.0f / 64.0f) + GN_EPS);
        for (int c = 0; c < 64; ++c) {
            const int hc = 64 * h + c; float g = 0.f;
            for (int j = 0; j < 64; ++j) g += (1.0f / (1.0f + expf(-shifted(P, tok, 640 + 1216 + j, W.mu[1216 + j])))) * W.g2[j * 384 + hc];
            const float yn = (bf2f(y[c]) - mean) * rstd * W.ln_w[hc] + W.ln_b[hc];
            y[c] = f2bf((yn + dot * bf2f(V[o + c])) * g);
        }
    }
}
#ifndef MK_BUILD
__global__ void k_rwkv_fin(const bf16_t* P, RwkvW W, const bf16_t* R, const bf16_t* K, const bf16_t* V, bf16_t* MIX) { d_rwkv_fin(P, W, R, K, V, MIX, (long)blockIdx.x * blockDim.x + threadIdx.x, (long)gridDim.x * blockDim.x); }
#endif
__device__ __forceinline__ void d_conv_act(const bf16_t* U, const float* cw, const float* cb, bf16_t* ACT, int rows, long gtid, long gsize) {
    const long total = (long)rows * DFF;
    for (long idx = gtid; idx < total; idx += gsize) {
        const int t = (int)(idx / DFF), c = (int)(idx % DFF);
        float gate = cb[c], val = cb[DFF + c];
#pragma unroll
        for (int i = 0; i < 3; ++i) { const int tt = t - 2 + i; if (tt >= 0) { gate += cw[i * 2 * DFF + c] * bf2f(U[(long)tt * 2 * DFF + c]); val += cw[i * 2 * DFF + DFF + c] * bf2f(U[(long)tt * 2 * DFF + DFF + c]); } }
        ACT[(long)t * DFF + c] = f2bf(gate / (1.0f + expf(-gate)) * val);
    }
}
#ifndef MK_BUILD
__global__ void k_conv_act(const bf16_t* U, const float* cw, const float* cb, bf16_t* ACT, int rows) { d_conv_act(U, cw, cb, ACT, rows, (long)blockIdx.x * blockDim.x + threadIdx.x, (long)gridDim.x * blockDim.x); }
#endif
}
namespace pg8 {
#define PG8_LAS __attribute__((address_space(3)))
typedef unsigned short bf16_t;
typedef short bf16x8 __attribute__((ext_vector_type(8)));
typedef float f32x4 __attribute__((ext_vector_type(4)));
typedef unsigned u32x4 __attribute__((ext_vector_type(4)));
constexpr int BM = 256, BK = 64, HALF = 128, HTB = HALF * BK * 2  , STAGE_BYTES = 8 * HTB, NXCD = 8, WGM = 8;

__host__ __device__ __forceinline__ int lds_byte(int r, int c) { const int st = (r >> 4) * 2 + (c >> 5), rr = r & 15, cc = c & 31, ob = rr * 64 + cc * 2; return st * 1024 + (ob ^ (((ob >> 9) & 1) << 5)); }
__host__ __device__ __forceinline__ void stage_rc(int b, int& R, int& C) { const int st = b / 1024, sb = b % 1024, swz = sb ^ (((sb >> 9) & 1) << 5); R = (st >> 1) * 16 + swz / 64; C = (st & 1) * 32 + (swz % 64) / 2; }
__host__ __device__ __forceinline__ int perm32(int rho) { const int n = rho >> 4, i = rho & 15; return 8 * (i >> 2) + 4 * n + (i & 3); }

struct Unit { int pm, pn; };
struct Gemm { const bf16_t* A; const bf16_t* Bt; int M, N, K; };

struct StaticOrder {
    int nM, nN, nwg, G, c;
    __host__ __device__ void init(int M, int N, int G_, int c_) { nM = M / BM; nN = N / BM; nwg = nM * nN; G = G_; c = c_; }
    __host__ __device__ bool next(int i, Unit& u) const {
        const long L = (long)i * G + c; if (L >= nwg) return false;
        int wgid = (int)L; { const int q = nwg / NXCD, r = nwg % NXCD, xcd = wgid % NXCD, off = wgid / NXCD; wgid = (xcd < r ? xcd * (q + 1) : r * (q + 1) + (xcd - r) * q) + off; }
        const int nig = WGM * nN, gid = wgid / nig, fm = gid * WGM, gsz = (nM - fm) < WGM ? (nM - fm) : WGM;
        u.pm = fm + ((wgid % nig) % gsz); u.pn = (wgid % nig) / gsz; return true;
    }
    __device__ __forceinline__ void a_ready(const Unit&) const {}
    __device__ __forceinline__ void done(const Unit&) const {}
};

__device__ __forceinline__ unsigned cvt_pk_bf16(float lo, float hi) { unsigned r; asm volatile("v_cvt_pk_bf16_f32 %0, %1, %2" : "=v"(r) : "v"(lo), "v"(hi)); return r; }
struct EpiScaleBf16 {
    static constexpr bool PERM = true, AFTER_DRAIN = false;
    bf16_t* O; int ldc; const float* ssq;
    __device__ __forceinline__ void operator()(const f32x4 (&acc)[2][2][4][2], const Unit& u, int wr, int wc, int fr, int fq) const {
        const int row0 = u.pm * BM + wr * 64 + fr, col0 = u.pn * BM + wc * 32 + 8 * fq;
#pragma unroll
        for (int ai = 0; ai < 2; ++ai)
#pragma unroll
            for (int m = 0; m < 4; ++m) { const int row = row0 + ai * HALF + m * 16; const float sc = 1.0f / sqrtf(ssq[row] * (1.0f / 1024.0f) + 1e-6f);
                bf16_t* rowp = O + (size_t)row * ldc + col0;
#pragma unroll
                for (int bj = 0; bj < 2; ++bj) { const f32x4 v0 = acc[ai][bj][m][0] * sc, v1 = acc[ai][bj][m][1] * sc;
                    u32x4 w; w.x = cvt_pk_bf16(v0[0], v0[1]); w.y = cvt_pk_bf16(v0[2], v0[3]); w.z = cvt_pk_bf16(v1[0], v1[1]); w.w = cvt_pk_bf16(v1[2], v1[3]);
                    *(u32x4*)(rowp + bj * HALF) = w; } }
    }
};
struct EpiResid {
    static constexpr bool PERM = false, AFTER_DRAIN = false;
    const float* base; float* out; bf16_t* xb; float* ssq; int ldc;
    __device__ __forceinline__ void operator()(const f32x4 (&acc)[2][2][4][2], const Unit& u, int wr, int wc, int fr, int fq) const {
        typedef unsigned u32x2v __attribute__((ext_vector_type(2)));
        const int col0 = u.pn * BM + wc * 32 + 4 * fq;
#pragma unroll
        for (int ai = 0; ai < 2; ++ai)
#pragma unroll
            for (int m = 0; m < 4; ++m) { const int row = u.pm * BM + ai * HALF + wr * 64 + m * 16 + fr; const size_t off = (size_t)row * ldc + col0; float sq = 0.f;
#pragma unroll
                for (int bj = 0; bj < 2; ++bj)
#pragma unroll
                    for (int n = 0; n < 2; ++n) { const f32x4 o = *(const f32x4*)(base + off + bj * HALF + n * 16) + acc[ai][bj][m][n];
                        *(f32x4*)(out + off + bj * HALF + n * 16) = o; sq += (o[0] * o[0] + o[1] * o[1]) + (o[2] * o[2] + o[3] * o[3]);
                        u32x2v w; w.x = cvt_pk_bf16(o[0], o[1]); w.y = cvt_pk_bf16(o[2], o[3]); *(u32x2v*)(xb + off + bj * HALF + n * 16) = w; }
                sq += __shfl_xor(sq, 16); sq += __shfl_xor(sq, 32);
                if (fq == 0) atomicAdd(ssq + row, sq); }
    }
};
template <class Epi, class Sched, bool ALIGN_EPI = false, bool SP2 = false>
__device__ __forceinline__ void gemm_phase(PG8_LAS unsigned char* lds, const Gemm g, const Sched& S, const Epi& E, int tid_in) {
    int tid = tid_in; asm volatile("" : "+v"(tid));
    const int wid = __builtin_amdgcn_readfirstlane(tid >> 6), lane = tid & 63, wr = wid >> 2, wc = wid & 3, fr = lane & 15, fq = lane >> 4;
    const int K = g.K, nt = K / BK;
    unsigned voffA[2], voffB[2];
#pragma unroll
    for (int i = 0; i < 2; ++i) { int R, C; stage_rc(tid * 16 + i * 8192, R, C); const int Rb = Epi::PERM ? ((R & ~31) + perm32(R & 31)) : R;
        voffA[i] = (unsigned)(R * K + C) * 2u; voffB[i] = (unsigned)(Rb * K + C) * 2u; }
    const size_t kstep = (size_t)(BK * 2);
    const size_t hstep = (size_t)HALF * K * 2;
    const size_t tstep = 2 * hstep;
    const unsigned ldsw = (unsigned)wid * 1024u;
    const int aoff = lds_byte(wr * 64 + fr, fq * 8), boff = lds_byte(wc * 32 + fr, fq * 8);
#define PG8_SA(b, h) (((b) * 2 + (h)) * HTB)
#define PG8_SB(b, h) ((4 + (b) * 2 + (h)) * HTB)
#define PG8_STAGE(bufoff, gbase, voff) do { _Pragma("unroll") for (int _i = 0; _i < 2; ++_i) \
        __builtin_amdgcn_global_load_lds((const unsigned*)((const char*)(gbase) + (voff)[_i]), (PG8_LAS unsigned*)(lds + (bufoff) + ldsw + _i * 8192), 16, 0, 0); } while (0)
#define PG8_LDA(dst, b, h) do { _Pragma("unroll") for (int m = 0; m < 4; ++m) _Pragma("unroll") for (int k = 0; k < 2; ++k) dst[m][k] = *(const PG8_LAS bf16x8*)(lds + PG8_SA(b, h) + aoff + m * 2048 + k * 1024); } while (0)
#define PG8_LDB(dst, b, h) do { _Pragma("unroll") for (int n = 0; n < 2; ++n) _Pragma("unroll") for (int k = 0; k < 2; ++k) dst[n][k] = *(const PG8_LAS bf16x8*)(lds + PG8_SB(b, h) + boff + n * 2048 + k * 1024); } while (0)
#define PG8_MMA(ai, bj, At, Bt) do { __builtin_amdgcn_s_setprio(1); _Pragma("unroll") for (int m = 0; m < 4; ++m) _Pragma("unroll") for (int n = 0; n < 2; ++n) _Pragma("unroll") for (int k = 0; k < 2; ++k) \
        acc[ai][bj][m][n] = __builtin_amdgcn_mfma_f32_16x16x32_bf16(Bt[n][k], At[m][k], acc[ai][bj][m][n], 0, 0, 0); __builtin_amdgcn_s_setprio(0); } while (0)
#define PG8_WAIT_V(n) asm volatile("s_waitcnt vmcnt(" #n ")" ::: "memory")
#define PG8_WAIT_L(n) asm volatile("s_waitcnt lgkmcnt(" #n ")" ::: "memory")
#define PG8_BAR __builtin_amdgcn_s_barrier()
#define PG8_SCHED __builtin_amdgcn_sched_barrier(0)
    Unit cur, nxt; int ui = 0;
    if (!S.next(0, cur)) return;
    f32x4 acc[2][2][4][2];
#pragma unroll
    for (int a = 0; a < 2; ++a)
#pragma unroll
        for (int b = 0; b < 2; ++b)
#pragma unroll
            for (int m = 0; m < 4; ++m)
#pragma unroll
                for (int n = 0; n < 2; ++n) acc[a][b][m][n] = (f32x4){0.f, 0.f, 0.f, 0.f};
    bf16x8 At[4][2], B0[2][2], B1[2][2];
    const char* cA = (const char*)g.A + (size_t)cur.pm * tstep; const char* cB = (const char*)g.Bt + (size_t)cur.pn * tstep;
    S.a_ready(cur);
    if constexpr (SP2) {
        PG8_STAGE(PG8_SB(0, 0), cB, voffB); PG8_STAGE(PG8_SB(0, 1), cB + hstep, voffB); PG8_STAGE(PG8_SA(0, 0), cA, voffA); PG8_STAGE(PG8_SA(0, 1), cA + hstep, voffA);
        if (wr == 1) PG8_BAR;
        PG8_WAIT_V(2); PG8_BAR;
        PG8_STAGE(PG8_SB(1, 0), cB + kstep, voffB); PG8_STAGE(PG8_SA(1, 0), cA + kstep, voffA); PG8_STAGE(PG8_SB(1, 1), cB + hstep + kstep, voffB);
        PG8_WAIT_V(6); PG8_BAR;
    } else {
        PG8_STAGE(PG8_SB(0, 0), cB, voffB); PG8_STAGE(PG8_SA(0, 0), cA, voffA); PG8_STAGE(PG8_SB(0, 1), cB + hstep, voffB); PG8_STAGE(PG8_SA(0, 1), cA + hstep, voffA);
        if (wr == 1) PG8_BAR;
        PG8_WAIT_V(4); PG8_BAR;
        PG8_STAGE(PG8_SB(1, 0), cB + kstep, voffB); PG8_STAGE(PG8_SA(1, 0), cA + kstep, voffA); PG8_STAGE(PG8_SB(1, 1), cB + hstep + kstep, voffB);
        PG8_WAIT_V(6); PG8_BAR;
    }
    for (;;) {
        const bool has_next = S.next(ui + 1, nxt);
        const char* nA = has_next ? (const char*)g.A + (size_t)nxt.pm * tstep : cA; const char* nB = has_next ? (const char*)g.Bt + (size_t)nxt.pn * tstep : cB;
        for (int t = 0; t < nt; t += 2) {
            const bool last = (t == nt - 2);
            const char* a1 = cA + (size_t)(t + 1) * kstep;
            const char* a2 = last ? nA : cA + (size_t)(t + 2) * kstep; const char* b2 = last ? nB : cB + (size_t)(t + 2) * kstep;
            const char* a3 = a2 + kstep; const char* b3 = b2 + kstep;
            if (last && has_next) S.a_ready(nxt);
            if constexpr (SP2) {
            PG8_LDB(B0, 0, 0); PG8_LDB(B1, 0, 1); PG8_SCHED; PG8_LDA(At, 0, 0); PG8_STAGE(PG8_SA(1, 1), a1 + hstep, voffA);
            PG8_WAIT_V(8); PG8_WAIT_L(0); PG8_BAR; PG8_MMA(0, 0, At, B0); PG8_MMA(0, 1, At, B1); PG8_BAR; PG8_SCHED;
            PG8_LDA(At, 0, 1); PG8_STAGE(PG8_SB(0, 0), b2, voffB); PG8_STAGE(PG8_SB(0, 1), b2 + hstep, voffB); PG8_STAGE(PG8_SA(0, 0), a2, voffA);
            PG8_WAIT_V(8); PG8_WAIT_L(0); PG8_BAR; PG8_MMA(1, 0, At, B0); PG8_MMA(1, 1, At, B1); PG8_BAR; PG8_SCHED;
            PG8_LDB(B0, 1, 0); PG8_LDB(B1, 1, 1); PG8_SCHED; PG8_LDA(At, 1, 0); PG8_STAGE(PG8_SA(0, 1), a2 + hstep, voffA);
            PG8_WAIT_V(8); PG8_WAIT_L(0); PG8_BAR; PG8_MMA(0, 0, At, B0); PG8_MMA(0, 1, At, B1); PG8_BAR; PG8_SCHED;
            PG8_LDA(At, 1, 1); PG8_STAGE(PG8_SB(1, 0), b3, voffB); PG8_STAGE(PG8_SB(1, 1), b3 + hstep, voffB); PG8_STAGE(PG8_SA(1, 0), a3, voffA);
            PG8_WAIT_V(8); PG8_WAIT_L(0); PG8_BAR; PG8_MMA(1, 0, At, B0); PG8_MMA(1, 1, At, B1); PG8_BAR; PG8_SCHED;
            } else {
            PG8_LDB(B0, 0, 0); PG8_SCHED; PG8_LDA(At, 0, 0); PG8_STAGE(PG8_SA(1, 1), a1 + hstep, voffA);
            PG8_WAIT_L(8); PG8_BAR; PG8_WAIT_L(0); PG8_MMA(0, 0, At, B0); PG8_BAR; PG8_SCHED;
            PG8_LDB(B1, 0, 1); PG8_STAGE(PG8_SB(0, 0), b2, voffB);
            PG8_BAR; PG8_WAIT_L(0); PG8_MMA(0, 1, At, B1); PG8_BAR;
            PG8_LDA(At, 0, 1); PG8_STAGE(PG8_SA(0, 0), a2, voffA);
            PG8_BAR; PG8_WAIT_L(0); PG8_MMA(1, 0, At, B0); PG8_BAR; PG8_SCHED;
            PG8_STAGE(PG8_SB(0, 1), b2 + hstep, voffB);
            PG8_WAIT_V(6); PG8_BAR; PG8_MMA(1, 1, At, B1); PG8_BAR;
            PG8_LDB(B0, 1, 0); PG8_SCHED; PG8_LDA(At, 1, 0); PG8_STAGE(PG8_SA(0, 1), a2 + hstep, voffA);
            PG8_WAIT_L(8); PG8_BAR; PG8_WAIT_L(0); PG8_MMA(0, 0, At, B0); PG8_BAR; PG8_SCHED;
            PG8_LDB(B1, 1, 1); PG8_STAGE(PG8_SB(1, 0), b3, voffB);
            PG8_BAR; PG8_WAIT_L(0); PG8_MMA(0, 1, At, B1); PG8_BAR;
            PG8_LDA(At, 1, 1); PG8_STAGE(PG8_SA(1, 0), a3, voffA);
            PG8_BAR; PG8_WAIT_L(0); PG8_MMA(1, 0, At, B0); PG8_BAR; PG8_SCHED;
            PG8_STAGE(PG8_SB(1, 1), b3 + hstep, voffB);
            PG8_WAIT_V(6); PG8_BAR; PG8_MMA(1, 1, At, B1); PG8_BAR;
            }
        }
        if constexpr (ALIGN_EPI) { if (wr == 0) PG8_BAR; }
        if constexpr (!Epi::AFTER_DRAIN) { E(acc, cur, wr, wc, fr, fq); S.done(cur); }
        if (!has_next) break;
#pragma unroll
        for (int a = 0; a < 2; ++a)
#pragma unroll
            for (int b = 0; b < 2; ++b)
#pragma unroll
                for (int m = 0; m < 4; ++m)
#pragma unroll
                    for (int n = 0; n < 2; ++n) acc[a][b][m][n] = (f32x4){0.f, 0.f, 0.f, 0.f};
        cur = nxt; cA = nA; cB = nB; ++ui;
        if constexpr (ALIGN_EPI) { if (wr == 1) PG8_BAR; }
    }
    PG8_WAIT_V(0);
    if constexpr (!ALIGN_EPI) { if (wr == 0) PG8_BAR; }
    PG8_BAR;
    if constexpr (Epi::AFTER_DRAIN) { E.fused(acc, cur, wr, wc, fr, fq, lds, wid, lane); S.done(cur); }
#undef PG8_SA
#undef PG8_SB
#undef PG8_STAGE
#undef PG8_LDA
#undef PG8_LDB
#undef PG8_MMA
#undef PG8_WAIT_V
#undef PG8_WAIT_L
#undef PG8_BAR
#undef PG8_SCHED
}
}

#ifndef PG8_SP2
#define PG8_SP2 true
#endif
#ifndef PG8_ALIGN
#define PG8_ALIGN true
#endif
#define GAS __attribute__((address_space(1)))
#define LAS __attribute__((address_space(3)))
typedef unsigned short bf16;
typedef unsigned v4u __attribute__((ext_vector_type(4)));
typedef float f32x4 __attribute__((ext_vector_type(4)));
typedef short bf16x8 __attribute__((ext_vector_type(8)));
typedef GAS unsigned gu32;
typedef GAS unsigned long long gu64;
#define RLX_AGENT __ATOMIC_RELAXED, __HIP_MEMORY_SCOPE_AGENT
#define LDS_WAIT() asm volatile("s_waitcnt lgkmcnt(0)" ::: "memory")
#define VM_WAIT() asm volatile("s_waitcnt vmcnt(0)" ::: "memory")
__device__ __forceinline__ unsigned long long rt() { return __builtin_amdgcn_s_memrealtime(); }

#define XB_TMO      128
#define XB_XCNT(j)  (256  + 64 * (j))
#define XB_XSUB(j)  (1280 + 64 * (j))
#define XB_XGEN(j)  (2304 + 64 * (j))
#define XB_TOP      3328
#define XB_TOPGEN   3392
#define XCD_BAR_WORDS 3456
#define XB_SPIN_CAP (1u << 20)

__device__ __forceinline__ unsigned xb_ld(unsigned* p)              { return __hip_atomic_load(p, __ATOMIC_RELAXED, __HIP_MEMORY_SCOPE_AGENT); }
__device__ __forceinline__ unsigned xb_add(unsigned* p, unsigned v) { return __hip_atomic_fetch_add(p, v, __ATOMIC_RELAXED, __HIP_MEMORY_SCOPE_AGENT); }
__device__ __forceinline__ unsigned xb_xcc_id() { return (unsigned)__builtin_amdgcn_s_getreg((3 << 11) | 20) & 0xFu; }
#define XB_SPIN(cond, bar) do { unsigned _sp = 0; while (cond) { __builtin_amdgcn_s_sleep(1); \
    if ((++_sp & 255u) == 0u) { if (xb_ld(&(bar)[XB_TMO])) break; if (_sp > XB_SPIN_CAP) { atomicAdd(&(bar)[XB_TMO], 1u); break; } } } } while (0)

struct XcdBarrier {
    unsigned* bar; unsigned x;
    volatile LAS unsigned* st;
};

__device__ __forceinline__ XcdBarrier xcd_barrier_post(unsigned* bar, volatile LAS unsigned* st) {
    XcdBarrier b; b.bar = bar; b.x = xb_xcc_id(); b.st = st;
    if (threadIdx.x == 0) (void)xb_add(&bar[XB_XCNT(b.x)], 1u);
    return b;
}
__device__ __forceinline__ void xcd_barrier_complete(unsigned* bar, unsigned x, unsigned& nloc, unsigned& nx) {
    const unsigned G = gridDim.x * gridDim.y * gridDim.z;
    unsigned sum, cnt, mine, sp = 0u;
    for (;;) {
        sum = 0u; cnt = 0u; mine = 0u;
#pragma unroll
        for (unsigned j = 0; j < 16; ++j) { const unsigned c = xb_ld(&bar[XB_XCNT(j)]); sum += c; cnt += (c > 0u) ? 1u : 0u; mine = (j == x) ? c : mine; }
        if (sum == G) break;
        __builtin_amdgcn_s_sleep(1);
        if ((++sp & 255u) == 0u) { if (xb_ld(&bar[XB_TMO])) break; if (sp > XB_SPIN_CAP) { atomicAdd(&bar[XB_TMO], 1u); break; } }
    }
    nloc = mine > 0u ? mine : 1u; nx = cnt > 0u ? cnt : 1u;
}

__device__ __forceinline__ void xcd_barrier(const XcdBarrier& b) {
    asm volatile("s_waitcnt vmcnt(0)" ::: "memory");
    __syncthreads();
    if (threadIdx.x == 0) {
        unsigned* bar = b.bar;
        __builtin_amdgcn_s_waitcnt(0);
        unsigned nloc = b.st[0], nx = b.st[1];
        if (nloc == 0u) { xcd_barrier_complete(bar, b.x, nloc, nx); b.st[0] = nloc; b.st[1] = nx; }
        const unsigned old = xb_add(&bar[XB_XSUB(b.x)], 1u);
        const unsigned gen = old / nloc;
        if (old + 1u == (gen + 1u) * nloc) {
            __builtin_amdgcn_fence(__ATOMIC_RELEASE, "agent");
            asm volatile("s_waitcnt vmcnt(0)" ::: "memory");
            const unsigned og = xb_add(&bar[XB_TOP], 1u);
            const unsigned tg = og / nx;
            if (og + 1u == (tg + 1u) * nx) xb_add(&bar[XB_TOPGEN], 1u);
            else XB_SPIN(xb_ld(&bar[XB_TOPGEN]) == tg, bar);
            __builtin_amdgcn_fence(__ATOMIC_ACQUIRE, "agent");
            xb_add(&bar[XB_XGEN(b.x)], 1u);
            asm volatile("s_waitcnt vmcnt(0)" ::: "memory");
        } else {
            XB_SPIN(xb_ld(&bar[XB_XGEN(b.x)]) == gen, bar);
            __builtin_amdgcn_fence(__ATOMIC_ACQUIRE, "agent");
            asm volatile("s_waitcnt vmcnt(0)" ::: "memory");
        }
    }
    __syncthreads();
}

namespace rw {
constexpr int LD = 72;
constexpr int MATB = 64 * LD * 2;
constexpr int OFF_F0 = 12 * MATB  , OFF_TMP = OFF_F0 + 64 * 65 * 4  ;
constexpr int OFF_TW = 8 * MATB  , OFF_TA = OFF_TW + 5120, OFF_TV = OFF_TA + 5120, OFF_WP = OFF_TV + 5120  , OFF_AP = OFF_WP + 16640, OFF_VP = OFF_AP + 16640;
constexpr int OFF_TOT = 139264, OFF_GC = OFF_TOT + 2048, OFF_RN = OFF_GC + 256, OFF_END = OFF_RN + 256;
constexpr int NITEMS = BATCH * 6 * (SEQ / 64);
__device__ __forceinline__ int sigpos(int c) { return (c & 32) + 8 * ((c >> 2) & 3) + 4 * ((c >> 4) & 1) + (c & 3); }
#define RW_BAR() do { asm volatile("s_waitcnt vmcnt(0) lgkmcnt(0)" ::: "memory"); __builtin_amdgcn_s_barrier(); asm volatile("" ::: "memory"); } while (0)
__device__ __forceinline__ f32x4 mm_tile(const LAS bf16_t* A, const LAS bf16_t* Bt, int ti, int tj, int fr, int fq, f32x4 acc) {
#pragma unroll
    for (int kk = 0; kk < 2; ++kk) {
        const bf16x8 a = *(const LAS bf16x8*)(A + (16 * ti + fr) * LD + 32 * kk + 8 * fq);
        const bf16x8 b = *(const LAS bf16x8*)(Bt + (16 * tj + fr) * LD + 32 * kk + 8 * fq);
        acc = __builtin_amdgcn_mfma_f32_16x16x32_bf16(a, b, acc, 0, 0, 0);
    }
    return acc;
}
__device__ __forceinline__ unsigned pk2(float lo, float hi) { return (unsigned)f2bf(lo) | ((unsigned)f2bf(hi) << 16); }
struct ChunkBufs { bf16_t* PT; bf16_t* G; float* Z; float* YV; bf16_t* S0; bf16_t* VOUT; float* DOT; const bf16_t *W2T, *A2T, *V2T, *G2T; };

#define RW_LANES() int lt_ = tid_in; asm volatile("" : "+v"(lt_)); const int tid = lt_, lane = lt_ & 63, fr = lane & 15, fq = lane >> 4; (void)tid; (void)fr; (void)fq
__device__ __forceinline__ void chunk_phase(LAS unsigned char* L, const bf16_t* P, const sk::RwkvW W, int layer, const bf16_t* VFIRST, const ChunkBufs cb, int tid_in, int first, int stride) {
    const int w = __builtin_amdgcn_readfirstlane(tid_in >> 6);
    LAS bf16_t* B0 = (LAS bf16_t*)(L + 0 * MATB); LAS bf16_t* B1 = (LAS bf16_t*)(L + 1 * MATB); LAS bf16_t* B2 = (LAS bf16_t*)(L + 2 * MATB); LAS bf16_t* B3 = (LAS bf16_t*)(L + 3 * MATB);
    LAS bf16_t* B4 = (LAS bf16_t*)(L + 4 * MATB); LAS bf16_t* B5 = (LAS bf16_t*)(L + 5 * MATB); LAS bf16_t* B6 = (LAS bf16_t*)(L + 6 * MATB); LAS bf16_t* B7 = (LAS bf16_t*)(L + 7 * MATB);
    LAS bf16_t* B8 = (LAS bf16_t*)(L + 8 * MATB); LAS bf16_t* B9 = (LAS bf16_t*)(L + 9 * MATB); LAS bf16_t* B10 = (LAS bf16_t*)(L + 10 * MATB); LAS bf16_t* B11 = (LAS bf16_t*)(L + 11 * MATB);
    LAS float* F0 = (LAS float*)(L + OFF_F0); LAS float* TMP = (LAS float*)(L + OFF_TMP);
    LAS bf16_t* TW = (LAS bf16_t*)(L + OFF_TW); LAS bf16_t* TA = (LAS bf16_t*)(L + OFF_TA); LAS bf16_t* TV = (LAS bf16_t*)(L + OFF_TV);
    LAS float* WP = (LAS float*)(L + OFF_WP); LAS float* AP = (LAS float*)(L + OFF_AP); LAS float* VP = (LAS float*)(L + OFF_VP);
    LAS float* TOT = (LAS float*)(L + OFF_TOT); LAS float* GC = (LAS float*)(L + OFF_GC); LAS float* RN = (LAS float*)(L + OFF_RN);
    for (int item = first; item < NITEMS; item += stride) {
        const int bh = item / (SEQ / 64), chunk = item % (SEQ / 64), b = bh / 6, h = bh % 6;
        const int tok0 = b * SEQ + chunk * 64;
        { RW_LANES(); const int t = tid >> 3, sub = tid & 7, tok = tok0 + t;
#pragma unroll
          for (int e = 0; e < 4; ++e) { const int j = 4 * sub + e;
              TW[t * 40 + j] = f2bf(tanhf(sk::shifted(P, tok, 640 + 1152 + j, W.mu[1152 + j])));
              TA[t * 40 + j] = f2bf(sk::shifted(P, tok, 640 + 1184 + j, W.mu[1184 + j])); }
          if (layer > 0) {
#pragma unroll
              for (int e = 0; e < 2; ++e) { const int j = 2 * sub + e; TV[t * 40 + j] = f2bf(sk::shifted(P, tok, 2176 + j, W.mu_v[j])); TV[t * 40 + 16 + j] = 0; } }
          float s = 0.f;
#pragma unroll
          for (int e = 0; e < 8; ++e) { const int hc = 64 * h + 8 * sub + e; const float kc = sk::shifted(P, tok, 640 + 384 + hc, W.mu[384 + hc]) * W.k_k[hc]; s += kc * kc; }
          s += __shfl_xor(s, 1); s += __shfl_xor(s, 2); s += __shfl_xor(s, 4);
          if (sub == 0) RN[t] = 1.0f / fmaxf(sqrtf(s), 1e-12f); }
        RW_BAR();
        { RW_LANES();
#pragma unroll
        for (int e = 0; e < 2; ++e) { const int tl = 2 * w + e, ti = tl >> 2, tj = tl & 3; const f32x4 z4 = {0.f, 0.f, 0.f, 0.f};
            const size_t brow = (size_t)(64 * h + 16 * tj + fr) * 32 + 8 * fq;
            { const bf16x8 a = *(const LAS bf16x8*)(TW + (16 * ti + fr) * 40 + 8 * fq); const bf16x8 bb = *(const GAS bf16x8*)(cb.W2T + brow);
              const f32x4 d = __builtin_amdgcn_mfma_f32_16x16x32_bf16(a, bb, z4, 0, 0, 0);
#pragma unroll
              for (int r = 0; r < 4; ++r) WP[(16 * ti + 4 * fq + r) * 65 + 16 * tj + fr] = d[r]; }
            { const bf16x8 a = *(const LAS bf16x8*)(TA + (16 * ti + fr) * 40 + 8 * fq); const bf16x8 bb = *(const GAS bf16x8*)(cb.A2T + brow);
              const f32x4 d = __builtin_amdgcn_mfma_f32_16x16x32_bf16(a, bb, z4, 0, 0, 0);
#pragma unroll
              for (int r = 0; r < 4; ++r) AP[(16 * ti + 4 * fq + r) * 65 + 16 * tj + fr] = d[r]; }
            if (layer > 0) { const bf16x8 a = *(const LAS bf16x8*)(TV + (16 * ti + fr) * 40 + 8 * fq); const bf16x8 bb = *(const GAS bf16x8*)(cb.V2T + brow);
              const f32x4 d = __builtin_amdgcn_mfma_f32_16x16x32_bf16(a, bb, z4, 0, 0, 0);
#pragma unroll
              for (int r = 0; r < 4; ++r) VP[(16 * ti + 4 * fq + r) * 65 + 16 * tj + fr] = d[r]; } } }
        RW_BAR();
        { RW_LANES(); const int c = lane, hc = 64 * h + c, tq0 = 8 * w, tk0 = tok0 + tq0;
          const float mu_r = W.mu[hc], mu_k = W.mu[384 + hc], mu_v = W.mu[768 + hc], w0 = W.w0[hc], a0 = W.a0[hc], k_k = W.k_k[hc], k_a = W.k_a[hc], r_k = W.r_k[hc];
          const float v0 = layer > 0 ? W.v0[hc] : 0.f;
          const bool has_prev = (chunk * 64 + tq0) > 0;
          float pr = has_prev ? bf2f(P[(size_t)(tk0 - 1) * LDP + 640 + hc]) : 0.f, pk = has_prev ? bf2f(P[(size_t)(tk0 - 1) * LDP + 1024 + hc]) : 0.f, pv = has_prev ? bf2f(P[(size_t)(tk0 - 1) * LDP + 1408 + hc]) : 0.f;
          float rr[8], kq[8], vv[8], kkc[8], bb[8], ld[8];
#pragma unroll
          for (int j = 0; j < 8; ++j) { const int t = tq0 + j; const size_t row = (size_t)(tk0 + j) * LDP;
              const float cr = bf2f(P[row + 640 + hc]), ck = bf2f(P[row + 1024 + hc]), cv = bf2f(P[row + 1408 + hc]);
              const float r = cr + mu_r * (pr - cr), k = ck + mu_k * (pk - ck); float v = cv + mu_v * (pv - cv); pr = cr; pk = ck; pv = cv;
              const float wp = w0 + WP[t * 65 + c], ap = a0 + AP[t * 65 + c];
              const float z = -wp, sp = fmaxf(z, 0.f) + log1pf(expf(-fabsf(z))); const float wl = -sp - 0.5f;
              const float al = 1.0f / (1.0f + expf(-ap));
              if (layer > 0) { const float vp = v0 + VP[t * 65 + c]; const float vf = bf2f(VFIRST[(size_t)(tk0 + j) * 384 + hc]); v = v + (vf - v) * (1.0f / (1.0f + expf(-vp))); }
              const float kn = k * k_k * RN[t]; const float k2 = k * (1.0f + (al - 1.0f) * k_a);
              rr[j] = bf2f(f2bf(r)); kq[j] = bf2f(f2bf(k2)); vv[j] = bf2f(f2bf(v)); kkc[j] = bf2f(f2bf(kn)); bb[j] = bf2f(f2bf(kn * al)); ld[j] = bf2f(f2bf(-expf(wl)));
              cb.VOUT[(size_t)(tk0 + j) * 384 + hc] = f2bf(v);
              float dsum = rr[j] * kq[j] * r_k;
#pragma unroll
              for (int o = 1; o < 64; o <<= 1) dsum += __shfl_xor(dsum, o);
              if (lane == 0) cb.DOT[(size_t)(tk0 + j) * 6 + h] = dsum; }
          float cl[8]; cl[0] = ld[0];
#pragma unroll
          for (int j = 1; j < 8; ++j) cl[j] = cl[j - 1] + ld[j];
          TOT[w * 64 + c] = cl[7];
          RW_BAR();
          float prefix = 0.f, cumC = 0.f;
#pragma unroll
          for (int ww = 0; ww < 8; ++ww) { const float tv = TOT[ww * 64 + c]; cumC += tv; if (ww < w) prefix += tv; }
          if (w == 0) GC[c] = expf(cumC);
          unsigned ahp[4], btp[4], ktp[4], vp4[4];
#pragma unroll
          for (int j = 0; j < 8; ++j) { const int t = tq0 + j; const float cum = prefix + cl[j], cump = cum - ld[j];
              const float g = expf(cum), gp = expf(cump), ig = expf(-cum), gc = expf(cumC - cum);
              const bf16_t ah = f2bf(-kkc[j] * gp), rh = f2bf(rr[j] * g), bh = f2bf(bb[j] * ig), kh = f2bf(kq[j] * ig), bt = f2bf(bb[j] * gc), kt = f2bf(kq[j] * gc), vb = f2bf(vv[j]);
              B0[t * LD + c] = ah; B1[t * LD + c] = rh; B2[t * LD + c] = bh; B3[t * LD + c] = kh;
              if (j & 1) { ahp[j >> 1] |= (unsigned)ah << 16; btp[j >> 1] |= (unsigned)bt << 16; ktp[j >> 1] |= (unsigned)kt << 16; vp4[j >> 1] |= (unsigned)vb << 16; }
              else { ahp[j >> 1] = ah; btp[j >> 1] = bt; ktp[j >> 1] = kt; vp4[j >> 1] = vb; } }
          *(LAS v4u*)(B4 + c * LD + tq0) = (v4u){ahp[0], ahp[1], ahp[2], ahp[3]}; *(LAS v4u*)(B5 + c * LD + tq0) = (v4u){btp[0], btp[1], btp[2], btp[3]};
          *(LAS v4u*)(B6 + c * LD + tq0) = (v4u){ktp[0], ktp[1], ktp[2], ktp[3]}; *(LAS v4u*)(B7 + c * LD + tq0) = (v4u){vp4[0], vp4[1], vp4[2], vp4[3]}; }
        RW_BAR();
        { RW_LANES(); const int prod = w >> 1; const LAS bf16_t* Aop = prod < 2 ? B0 : B1; const LAS bf16_t* Bop = (prod & 1) ? B3 : B2;
#pragma unroll
          for (int e = 0; e < 8; ++e) { const int tl = (w & 1) * 8 + e, ti = tl >> 2, tj = tl & 3; f32x4 d = {0.f, 0.f, 0.f, 0.f};
              if (tj <= ti) d = mm_tile(Aop, Bop, ti, tj, fr, fq, d);
#pragma unroll
              for (int r = 0; r < 4; ++r) { const int t = 16 * ti + 4 * fq + r, i = 16 * tj + fr; const bool keep = prod < 2 ? (i < t) : (i <= t); const float val = (tj <= ti && keep) ? d[r] : 0.f;
                  if (prod == 0) F0[t * 65 + i] = val; else if (prod == 1) B8[t * LD + i] = f2bf(val); else if (prod == 2) B9[t * LD + i] = f2bf(val); else B10[t * LD + i] = f2bf(val); } } }
        RW_BAR();
        if (w == 0) { RW_LANES();
            const int blk = lane >> 4, jc = lane & 15; const LAS float* Lb = F0 + (16 * blk) * 65 + 16 * blk; float tc[16];
#pragma unroll
            for (int r = 0; r < 16; ++r) { float val = (r == jc) ? 1.f : 0.f;
#pragma unroll
                for (int i = 0; i < r; ++i) val += Lb[r * 65 + i] * tc[i];
                tc[r] = val; }
            asm volatile("s_waitcnt lgkmcnt(0)" ::: "memory");
#pragma unroll
            for (int r = 0; r < 16; ++r) F0[(16 * blk + r) * 65 + 16 * blk + jc] = tc[r];
        }
        RW_BAR();
        if (w < 2) { RW_LANES();
            const int o1 = 32 * w, o2 = 32 * w + 16; f32x4 d = {0.f, 0.f, 0.f, 0.f};
#pragma unroll
            for (int ks = 0; ks < 4; ++ks) d = __builtin_amdgcn_mfma_f32_16x16x4f32(F0[(o2 + fr) * 65 + o1 + 4 * ks + fq], F0[(o1 + 4 * ks + fq) * 65 + o1 + fr], d, 0, 0, 0);
            LAS float* tm = TMP + w * 16 * 17;
#pragma unroll
            for (int r = 0; r < 4; ++r) tm[(4 * fq + r) * 17 + fr] = d[r];
            asm volatile("s_waitcnt lgkmcnt(0)" ::: "memory");
            f32x4 d2 = {0.f, 0.f, 0.f, 0.f};
#pragma unroll
            for (int ks = 0; ks < 4; ++ks) d2 = __builtin_amdgcn_mfma_f32_16x16x4f32(F0[(o2 + fr) * 65 + o2 + 4 * ks + fq], tm[(4 * ks + fq) * 17 + fr], d2, 0, 0, 0);
            asm volatile("s_waitcnt lgkmcnt(0)" ::: "memory");
#pragma unroll
            for (int r = 0; r < 4; ++r) F0[(o2 + 4 * fq + r) * 65 + o1 + fr] = d2[r];
        }
        RW_BAR();
        if (w < 4) { RW_LANES();
            const int ti = w >> 1, tj = w & 1; f32x4 d = {0.f, 0.f, 0.f, 0.f};
#pragma unroll
            for (int ks = 0; ks < 8; ++ks) d = __builtin_amdgcn_mfma_f32_16x16x4f32(F0[(32 + 16 * ti + fr) * 65 + 4 * ks + fq], F0[(4 * ks + fq) * 65 + 16 * tj + fr], d, 0, 0, 0);
#pragma unroll
            for (int r = 0; r < 4; ++r) TMP[(16 * ti + 4 * fq + r) * 33 + 16 * tj + fr] = d[r];
        }
        RW_BAR();
        if (w < 4) { RW_LANES();
            const int ti = w >> 1, tj = w & 1; f32x4 d = {0.f, 0.f, 0.f, 0.f};
#pragma unroll
            for (int ks = 0; ks < 8; ++ks) d = __builtin_amdgcn_mfma_f32_16x16x4f32(F0[(32 + 16 * ti + fr) * 65 + 32 + 4 * ks + fq], TMP[(4 * ks + fq) * 33 + 16 * tj + fr], d, 0, 0, 0);
#pragma unroll
            for (int r = 0; r < 4; ++r) F0[(32 + 16 * ti + 4 * fq + r) * 65 + 16 * tj + fr] = d[r];
        }
        RW_BAR();
        { RW_LANES(); const int t = tid >> 3, i0 = (tid & 7) * 8;
#pragma unroll
          for (int e = 0; e < 8; ++e) B11[t * LD + i0 + e] = f2bf(F0[t * 65 + i0 + e]); }
        RW_BAR();
        { RW_LANES();
#pragma unroll
        for (int e = 0; e < 4; ++e) { const int tl = 4 * w + e, prod = tl >> 4, ti = (tl >> 2) & 3, tj = tl & 3; f32x4 d = {0.f, 0.f, 0.f, 0.f};
            d = prod == 0 ? mm_tile(B11, B4, ti, tj, fr, fq, d) : mm_tile(B8, B7, ti, tj, fr, fq, d);
            LAS bf16_t* dst = (prod == 0 ? B0 : B2) + (16 * tj + fr) * LD + 16 * ti + 4 * fq;
            *(LAS unsigned long long*)dst = (unsigned long long)pk2(d[0], d[1]) | ((unsigned long long)pk2(d[2], d[3]) << 32); } }
        RW_BAR();
        { RW_LANES();
#pragma unroll
        for (int e = 0; e < 2; ++e) { const int tl = 2 * w + e, ti = tl >> 2, tj = tl & 3; f32x4 d = {0.f, 0.f, 0.f, 0.f};
            d = mm_tile(B11, B2, ti, tj, fr, fq, d);
            LAS bf16_t* dst = B3 + (16 * tj + fr) * LD + 16 * ti + 4 * fq;
            *(LAS unsigned long long*)dst = (unsigned long long)pk2(d[0], d[1]) | ((unsigned long long)pk2(d[2], d[3]) << 32); } }
        RW_BAR();
        { RW_LANES();
#pragma unroll
        for (int e = 0; e < 8; ++e) { const int tl = 8 * w + e, prod = tl >> 4, ti = (tl >> 2) & 3, tj = tl & 3; f32x4 d = {0.f, 0.f, 0.f, 0.f};
            if (prod == 0) { d = mm_tile(B5, B3, ti, tj, fr, fq, d); d = mm_tile(B6, B7, ti, tj, fr, fq, d);
                *(GAS f32x4*)(cb.Z + (size_t)item * 4096 + (16 * tj + fr) * 64 + 16 * ti + 4 * fq) = d; }
            else if (prod == 1) { d = mm_tile(B9, B3, ti, tj, fr, fq, d); d = mm_tile(B10, B7, ti, tj, fr, fq, d);
                *(GAS f32x4*)(cb.YV + (size_t)item * 4096 + (16 * tj + fr) * 64 + 16 * ti + 4 * fq) = d; }
            else if (prod == 2) { d = mm_tile(B9, B0, ti, tj, fr, fq, d);
#pragma unroll
                for (int r = 0; r < 4; ++r) { const int t = 16 * ti + 4 * fq + r, c = 16 * tj + fr; B4[t * LD + sigpos(c)] = f2bf(d[r] + bf2f(B1[t * LD + c])); } }
            else { d = mm_tile(B5, B0, ti, tj, fr, fq, d);
#pragma unroll
                for (int r = 0; r < 4; ++r) { const int c = 16 * ti + 4 * fq + r, c2 = 16 * tj + fr; B8[c * LD + sigpos(c2)] = f2bf(d[r] + (c == c2 ? GC[c] : 0.f)); } } } }
        RW_BAR();
        { RW_LANES(); const int r = tid >> 3, ch = (tid & 7) * 8;
          *(GAS v4u*)(cb.G + (size_t)item * 4096 + r * 64 + ch) = *(const LAS v4u*)(B4 + r * LD + ch);
          *(GAS v4u*)(cb.PT + (size_t)item * 4096 + r * 64 + ch) = *(const LAS v4u*)(B8 + r * LD + ch); }
        RW_BAR();
    }
}
__device__ __forceinline__ void scan_phase(const ChunkBufs cb, int bh, int tj, int lane) {
    const int fr = lane & 15, fq = lane >> 4; const int NC = SEQ / 64;
    bf16x8 Bf0 = {0, 0, 0, 0, 0, 0, 0, 0}, Bf1 = {0, 0, 0, 0, 0, 0, 0, 0};
    for (int chunk = 0; chunk < NC; ++chunk) {
        const size_t ib = (size_t)(bh * NC + chunk) * 4096;
        bf16_t* s0 = cb.S0 + ib + (16 * tj + fr) * 64 + 8 * fq;
        *(GAS bf16x8*)s0 = Bf0; *(GAS bf16x8*)(s0 + 32) = Bf1;
        const bf16_t* pt = cb.PT + ib + fr * 64 + 8 * fq; const float* zz = cb.Z + ib + (16 * tj + fr) * 64 + 4 * fq;
        f32x4 acc[4];
#pragma unroll
        for (int ti = 0; ti < 4; ++ti) { const bf16x8 a0 = *(const GAS bf16x8*)(pt + ti * 1024), a1 = *(const GAS bf16x8*)(pt + ti * 1024 + 32); const f32x4 z = *(const GAS f32x4*)(zz + 16 * ti);
            acc[ti] = __builtin_amdgcn_mfma_f32_16x16x32_bf16(a0, Bf0, z, 0, 0, 0); acc[ti] = __builtin_amdgcn_mfma_f32_16x16x32_bf16(a1, Bf1, acc[ti], 0, 0, 0); }
        v4u n0, n1;
        n0.x = pk2(acc[0][0], acc[0][1]); n0.y = pk2(acc[0][2], acc[0][3]); n0.z = pk2(acc[1][0], acc[1][1]); n0.w = pk2(acc[1][2], acc[1][3]);
        n1.x = pk2(acc[2][0], acc[2][1]); n1.y = pk2(acc[2][2], acc[2][3]); n1.z = pk2(acc[3][0], acc[3][1]); n1.w = pk2(acc[3][2], acc[3][3]);
        Bf0 = __builtin_bit_cast(bf16x8, n0); Bf1 = __builtin_bit_cast(bf16x8, n1);
    }
}
constexpr int O_SG = 0  , O_Y = 9216  , O_GT = O_Y + 16640  ;
__device__ __forceinline__ void out_phase(LAS unsigned char* L, const bf16_t* P, const sk::RwkvW W, const ChunkBufs cb, bf16_t* MIX, int tid_in, int first, int stride) {
    const int w = __builtin_amdgcn_readfirstlane(tid_in >> 6);
    LAS bf16_t* SG = (LAS bf16_t*)(L + O_SG); LAS float* Y = (LAS float*)(L + O_Y); LAS float* GT = (LAS float*)(L + O_GT);
    for (int item = first; item < NITEMS; item += stride) {
        const int bh = item / (SEQ / 64), chunk = item % (SEQ / 64), b = bh / 6, h = bh % 6; const int tok0 = b * SEQ + chunk * 64; const size_t ib = (size_t)item * 4096;
        { RW_LANES(); const int t = tid >> 3, sub = tid & 7;
#pragma unroll
          for (int e = 0; e < 8; ++e) { const int j = 8 * sub + e; SG[t * LD + j] = f2bf(1.0f / (1.0f + expf(-sk::shifted(P, tok0 + t, 640 + 1216 + j, W.mu[1216 + j])))); } }
        RW_BAR();
        { RW_LANES();
#pragma unroll
        for (int e = 0; e < 2; ++e) { const int tl = 2 * w + e, ti = tl >> 2, tj = tl & 3;
            f32x4 d = *(const GAS f32x4*)(cb.YV + ib + (16 * tj + fr) * 64 + 16 * ti + 4 * fq); f32x4 g = {0.f, 0.f, 0.f, 0.f};
#pragma unroll
            for (int kk = 0; kk < 2; ++kk) {
                const bf16x8 a = *(const GAS bf16x8*)(cb.G + ib + (16 * ti + fr) * 64 + 32 * kk + 8 * fq), bb = *(const GAS bf16x8*)(cb.S0 + ib + (16 * tj + fr) * 64 + 32 * kk + 8 * fq);
                d = __builtin_amdgcn_mfma_f32_16x16x32_bf16(a, bb, d, 0, 0, 0);
                const bf16x8 a2 = *(const LAS bf16x8*)(SG + (16 * ti + fr) * LD + 32 * kk + 8 * fq), b2 = *(const GAS bf16x8*)(cb.G2T + (size_t)(64 * h + 16 * tj + fr) * 64 + 32 * kk + 8 * fq);
                g = __builtin_amdgcn_mfma_f32_16x16x32_bf16(a2, b2, g, 0, 0, 0); }
#pragma unroll
            for (int r = 0; r < 4; ++r) { Y[(16 * ti + 4 * fq + r) * 65 + 16 * tj + fr] = d[r]; GT[(16 * ti + 4 * fq + r) * 65 + 16 * tj + fr] = g[r]; } } }
        RW_BAR();
        { RW_LANES(); const int t = tid >> 3, sub = tid & 7, tok = tok0 + t; float yv[8], s = 0.f;
#pragma unroll
          for (int e = 0; e < 8; ++e) { yv[e] = bf2f(f2bf(Y[t * 65 + 8 * sub + e])); s += yv[e]; }
          s += __shfl_xor(s, 1); s += __shfl_xor(s, 2); s += __shfl_xor(s, 4);
          const float mean = s * (1.0f / 64.0f); float q = 0.f;
#pragma unroll
          for (int e = 0; e < 8; ++e) { const float dd = yv[e] - mean; q += dd * dd; }
          q += __shfl_xor(q, 1); q += __shfl_xor(q, 2); q += __shfl_xor(q, 4);
          const float rstd = 1.0f / sqrtf(q * (1.0f / 64.0f) + GN_EPS), dot = cb.DOT[(size_t)tok * 6 + h];
          unsigned o[4];
#pragma unroll
          for (int e = 0; e < 8; e += 2) { float r2[2];
#pragma unroll
              for (int u = 0; u < 2; ++u) { const int v = 8 * sub + e + u, hc = 64 * h + v; const float yn = (yv[e + u] - mean) * rstd * W.ln_w[hc] + W.ln_b[hc];
                  r2[u] = (yn + dot * bf2f(cb.VOUT[(size_t)tok * 384 + hc])) * GT[t * 65 + v]; }
              o[e >> 1] = pk2(r2[0], r2[1]); }
          *(GAS v4u*)(MIX + (size_t)tok * DM + 384 + 64 * h + 8 * sub) = (v4u){o[0], o[1], o[2], o[3]}; }
        RW_BAR();
    }
}
}
namespace at {
constexpr int LDK = 72, LDV = 264;
constexpr int A_K = 0, A_V = 256 * LDK * 2  , A_BIAS = A_V + 64 * LDV * 2  , A_END = A_BIAS + 128 * 6 * 4;
__device__ __forceinline__ int vpos(int key) { return (key & ~31) + 8 * ((key >> 2) & 3) + 4 * ((key >> 4) & 1) + (key & 3); }
__device__ __forceinline__ unsigned pk2(float lo, float hi) { return (unsigned)f2bf(lo) | ((unsigned)f2bf(hi) << 16); }
#define AT_BAR() do { asm volatile("s_waitcnt vmcnt(0) lgkmcnt(0)" ::: "memory"); __builtin_amdgcn_s_barrier(); asm volatile("" ::: "memory"); } while (0)

__device__ __forceinline__ void stage_kv(LAS unsigned char* L, int tid, const bf16_t* kbase, const bf16_t* vbase, long pitch, int jvalid0, const float* gk) {
    LAS bf16_t* Kl = (LAS bf16_t*)(L + A_K); LAS bf16_t* VTl = (LAS bf16_t*)(L + A_V);
#pragma unroll
    for (int it = 0; it < 4; ++it) { const int idx = it * 512 + tid, key = idx >> 3, ch = idx & 7;
        v4u raw = {0u, 0u, 0u, 0u}; if (key >= jvalid0) raw = *(const GAS v4u*)(kbase + (long)key * pitch + 8 * ch);
        float f[8]; f[0] = bf2f((bf16_t)(raw.x & 0xffff)); f[1] = bf2f((bf16_t)(raw.x >> 16)); f[2] = bf2f((bf16_t)(raw.y & 0xffff)); f[3] = bf2f((bf16_t)(raw.y >> 16));
        f[4] = bf2f((bf16_t)(raw.z & 0xffff)); f[5] = bf2f((bf16_t)(raw.z >> 16)); f[6] = bf2f((bf16_t)(raw.w & 0xffff)); f[7] = bf2f((bf16_t)(raw.w >> 16));
        float ss = 0.f;
#pragma unroll
        for (int e = 0; e < 8; ++e) ss += f[e] * f[e];
        ss += __shfl_xor(ss, 1); ss += __shfl_xor(ss, 2); ss += __shfl_xor(ss, 4);
        const float rs = 1.0f / sqrtf(ss * (1.0f / 64.0f) + EPS);
        const f32x4 g0 = *(const GAS f32x4*)(gk + 8 * ch), g1 = *(const GAS f32x4*)(gk + 8 * ch + 4);
        v4u o; o.x = pk2(f[0] * rs * g0[0], f[1] * rs * g0[1]); o.y = pk2(f[2] * rs * g0[2], f[3] * rs * g0[3]); o.z = pk2(f[4] * rs * g1[0], f[5] * rs * g1[1]); o.w = pk2(f[6] * rs * g1[2], f[7] * rs * g1[3]);
        *(LAS v4u*)(Kl + key * LDK + 8 * ch) = o; }
#pragma unroll
    for (int it = 0; it < 4; ++it) { const int idx = it * 512 + tid, key = idx & 255, ch = idx >> 8;
        v4u raw = {0u, 0u, 0u, 0u}; if (key >= jvalid0) raw = *(const GAS v4u*)(vbase + (long)key * pitch + 8 * ch);
        LAS bf16_t* d = VTl + (8 * ch) * LDV + vpos(key);
        d[0 * LDV] = (bf16_t)(raw.x & 0xffff); d[1 * LDV] = (bf16_t)(raw.x >> 16); d[2 * LDV] = (bf16_t)(raw.y & 0xffff); d[3 * LDV] = (bf16_t)(raw.y >> 16);
        d[4 * LDV] = (bf16_t)(raw.z & 0xffff); d[5 * LDV] = (bf16_t)(raw.z >> 16); d[6 * LDV] = (bf16_t)(raw.w & 0xffff); d[7 * LDV] = (bf16_t)(raw.w >> 16); }
}
__device__ __forceinline__ void load_q(const bf16_t* qrow, const float* gq, int fq, bf16x8& q0, bf16x8& q1) {
    const v4u r0 = *(const GAS v4u*)(qrow + 8 * fq), r1 = *(const GAS v4u*)(qrow + 32 + 8 * fq);
    float f[16]; const unsigned w[8] = {r0.x, r0.y, r0.z, r0.w, r1.x, r1.y, r1.z, r1.w};
#pragma unroll
    for (int e = 0; e < 8; ++e) { f[2 * e] = bf2f((bf16_t)(w[e] & 0xffff)); f[2 * e + 1] = bf2f((bf16_t)(w[e] >> 16)); }
    float ss = 0.f;
#pragma unroll
    for (int e = 0; e < 16; ++e) ss += f[e] * f[e];
    ss += __shfl_xor(ss, 16); ss += __shfl_xor(ss, 32);
    const float rs = 0.125f / sqrtf(ss * (1.0f / 64.0f) + EPS);
    const f32x4 g0 = *(const GAS f32x4*)(gq + 8 * fq), g1 = *(const GAS f32x4*)(gq + 8 * fq + 4), g2 = *(const GAS f32x4*)(gq + 32 + 8 * fq), g3 = *(const GAS f32x4*)(gq + 36 + 8 * fq);
    v4u a, b;
    a.x = pk2(f[0] * rs * g0[0], f[1] * rs * g0[1]); a.y = pk2(f[2] * rs * g0[2], f[3] * rs * g0[3]); a.z = pk2(f[4] * rs * g1[0], f[5] * rs * g1[1]); a.w = pk2(f[6] * rs * g1[2], f[7] * rs * g1[3]);
    b.x = pk2(f[8] * rs * g2[0], f[9] * rs * g2[1]); b.y = pk2(f[10] * rs * g2[2], f[11] * rs * g2[3]); b.z = pk2(f[12] * rs * g3[0], f[13] * rs * g3[1]); b.w = pk2(f[14] * rs * g3[2], f[15] * rs * g3[3]);
    q0 = __builtin_bit_cast(bf16x8, a); q1 = __builtin_bit_cast(bf16x8, b);
}
template <int NT, bool SWA> __device__ __forceinline__ void attn_wave(const LAS unsigned char* L, bf16x8 q0, bf16x8 q1, int kt0, int qi0, int hq, float sink, bool first_block, bf16_t* outp, int fr, int fq) {
    const LAS bf16_t* Kl = (const LAS bf16_t*)(L + A_K); const LAS bf16_t* VTl = (const LAS bf16_t*)(L + A_V); const LAS float* bias = (const LAS float*)(L + A_BIAS);
    f32x4 s[NT];
#pragma unroll
    for (int t = 0; t < NT; ++t) { const LAS bf16_t* kr = Kl + (16 * (kt0 + t) + fr) * LDK + 8 * fq;
        const f32x4 z = {0.f, 0.f, 0.f, 0.f};
        s[t] = __builtin_amdgcn_mfma_f32_16x16x32_bf16(*(const LAS bf16x8*)kr, q0, z, 0, 0, 0);
        s[t] = __builtin_amdgcn_mfma_f32_16x16x32_bf16(*(const LAS bf16x8*)(kr + 32), q1, s[t], 0, 0, 0);
        if (t & 1) __builtin_amdgcn_sched_barrier(0); }
    float mx = SWA ? sink : -3.0e38f;
#pragma unroll
    for (int t = 0; t < NT; ++t)
#pragma unroll
        for (int r = 0; r < 4; ++r) {
            if (SWA) { const int kj = 16 * (kt0 + t) + 4 * fq + r, dist = qi0 + fr + 128 - kj; const bool valid = dist >= 0 && dist < 128 && !(first_block && kj < 128);
                s[t][r] = valid ? s[t][r] + bias[(valid ? dist : 0) * 6 + hq] : -3.0e38f; }
            mx = fmaxf(mx, s[t][r]); }
    mx = fmaxf(mx, __shfl_xor(mx, 16)); mx = fmaxf(mx, __shfl_xor(mx, 32));
    float l = 0.f;
#pragma unroll
    for (int t = 0; t < NT; ++t)
#pragma unroll
        for (int r = 0; r < 4; ++r) { const float p = __expf(s[t][r] - mx); s[t][r] = p; l += p; }
    l += __shfl_xor(l, 16); l += __shfl_xor(l, 32);
    if (SWA) l += __expf(sink - mx);
    f32x4 o[4];
#pragma unroll
    for (int dt = 0; dt < 4; ++dt) o[dt] = (f32x4){0.f, 0.f, 0.f, 0.f};
#pragma unroll
    for (int ks = 0; ks < NT / 2; ++ks) { v4u pw; pw.x = pk2(s[2 * ks][0], s[2 * ks][1]); pw.y = pk2(s[2 * ks][2], s[2 * ks][3]); pw.z = pk2(s[2 * ks + 1][0], s[2 * ks + 1][1]); pw.w = pk2(s[2 * ks + 1][2], s[2 * ks + 1][3]);
        const bf16x8 pb = __builtin_bit_cast(bf16x8, pw);
#pragma unroll
        for (int dt = 0; dt < 4; ++dt) o[dt] = __builtin_amdgcn_mfma_f32_16x16x32_bf16(*(const LAS bf16x8*)(VTl + (16 * dt + fr) * LDV + 32 * (kt0 / 2 + ks) + 8 * fq), pb, o[dt], 0, 0, 0);
        __builtin_amdgcn_sched_barrier(0); }
    const float inv = 1.0f / l;
#pragma unroll
    for (int dt = 0; dt < 4; ++dt) *(GAS unsigned long long*)(outp + (long)fr * DM + 16 * dt + 4 * fq) = (unsigned long long)pk2(o[dt][0] * inv, o[dt][1] * inv) | ((unsigned long long)pk2(o[dt][2] * inv, o[dt][3] * inv) << 32);
}
struct AttnArgs { const bf16_t* PROJ; const bf16_t* MKV; bf16_t* MIX; const float* biastab; const float *sinks, *gq, *gk, *gmq, *gmk; };
__device__ __forceinline__ void attn_item(LAS unsigned char* L, const AttnArgs A, int item, int tid_in) {
    const int w = __builtin_amdgcn_readfirstlane(tid_in >> 6);
    if (item < 256) {
        const int b = item >> 7, hkv = (item >> 6) & 1, blk = item & 63; const long tokb = (long)b * SEQ + blk * 128;
        { int lt_ = tid_in; asm volatile("" : "+v"(lt_)); const int tid = lt_;
          stage_kv(L, tid, A.PROJ + (tokb - 128) * LDP + 384 + 64 * hkv, A.PROJ + (tokb - 128) * LDP + 512 + 64 * hkv, LDP, blk == 0 ? 128 : 0, A.gk);
          LAS float* bl = (LAS float*)(L + A_BIAS); for (int i = tid; i < 768; i += 512) bl[i] = A.biastab[i]; }
        AT_BAR();
        { int lt_ = tid_in; asm volatile("" : "+v"(lt_)); const int lane = lt_ & 63, fr = lane & 15, fq = lane >> 4;
#pragma unroll 1
          for (int g = 0; g < 3; ++g) { const int hq = 3 * hkv + g; bf16x8 q0, q1;
              load_q(A.PROJ + (tokb + 16 * w + fr) * LDP + 64 * hq, A.gq, fq, q0, q1);
              attn_wave<10, true>(L, q0, q1, w & ~1, 16 * w, hq, A.sinks[hq], blk == 0, A.MIX + (tokb + 16 * w) * DM + 64 * hq, fr, fq); } }
        AT_BAR();
    } else {
        const int pr = item - 256, b = pr >> 7, h = (pr >> 5) & 3, blk2 = pr & 31;
        { int lt_ = tid_in; asm volatile("" : "+v"(lt_)); const int tid = lt_;
          stage_kv(L, tid, A.MKV + (long)(b * 256) * 512 + 64 * h, A.MKV + (long)(b * 256) * 512 + 256 + 64 * h, 512, 0, A.gmk); }
        AT_BAR();
        { int lt_ = tid_in; asm volatile("" : "+v"(lt_)); const int lane = lt_ & 63, fr = lane & 15, fq = lane >> 4;
#pragma unroll 1
          for (int u = 0; u < 2; ++u) { const long tokb = (long)b * SEQ + (2 * blk2 + u) * 128; bf16x8 q0, q1;
              load_q(A.PROJ + (tokb + 16 * w + fr) * LDP + 1920 + 64 * h, A.gmq, fq, q0, q1);
              attn_wave<16, false>(L, q0, q1, 0, 16 * w, 0, 0.f, false, A.MIX + (tokb + 16 * w) * DM + 768 + 64 * h, fr, fq); } }
        AT_BAR();
    }
}
}
constexpr int NWAVES = 8;
namespace mk {
constexpr size_t WS_CTL = 0, CTL_ZERO_BYTES = 1 * MiB;
constexpr size_t CTL_SSQ = 512 * 1024;
constexpr size_t WS_SMALL = 1 * MiB, SM_BIAS = 0, SM_SSQM = 4096, SM_MKV = 512 * 1024;
constexpr size_t WS_MEMB = 2 * MiB, WS_WT = 3 * MiB, WS_XB = 28 * MiB, WS_VF = 60 * MiB, WS_PROJ = 72 * MiB, WS_MIX = 144 * MiB, WS_PREP = 176 * MiB, WS_U = 72 * MiB, WS_ACT = 160 * MiB, WS_END = 248 * MiB;
constexpr size_t WT_IN = 0, WT_OUT = 4718592, WT_UP = WT_OUT + 2 * MiB, WT_DOWN = WT_UP + 11 * MiB, WT_MKV = WT_DOWN + 5767168;
constexpr int CW_TMO = 0, CW_BAR = 4096;
constexpr int LDS_BYTES = 163840, LDSCTL_OFF = LDS_BYTES - 512, MISC_OFF = LDSCTL_OFF + 320;
constexpr size_t SM_W2T = 8192, SM_A2T = 32768, SM_V2T = 57344, SM_G2T = 81920;
constexpr size_t WS_PT = 176 * MiB, WS_G = 188 * MiB, WS_S0 = 200 * MiB, WS_Z = 212 * MiB, WS_V1 = 236 * MiB, WS_YV = 28 * MiB  , WS_DOT = 52 * MiB;
#ifndef PROF_PH
#define PROF_PH -1
#endif
#ifndef PROF_N
#define PROF_N 1
#endif
#define REPEAT(k) for (int rep_ = 0; rep_ < ((PROF_PH) == (k) ? (PROF_N) : 1); ++rep_)
#ifndef FAST_RWKV
#define FAST_RWKV 1
#endif
#ifndef FAST_ATTN
#define FAST_ATTN 1
#endif

struct Args { const float* in[N_IN]; float* out; unsigned char* ws; int ph_lo, ph_hi; };

__device__ __forceinline__ unsigned pk2(float lo, float hi) { return (unsigned)f2bf(lo) | ((unsigned)f2bf(hi) << 16); }
__device__ __forceinline__ float wave_sum(float v) {
#pragma unroll
    for (int o = 1; o < 64; o <<= 1) v += __shfl_xor(v, o);
    return v;
}
__device__ __forceinline__ void transpose_item(const float* W, const float* g, int K, int N, bf16_t* WT, LAS float* scr, int item, int lane) {
    const int nblk = N / 32, kb = item / nblk, nb = item % nblk, k0 = 64 * kb, n0 = 32 * nb;
#pragma unroll 8
    for (int i = 0; i < 32; ++i) { const int kk = 2 * i + (lane >> 5); float v = W[(size_t)(k0 + kk) * N + n0 + (lane & 31)]; if (g) v *= g[k0 + kk]; scr[kk * 33 + (lane & 31)] = v; }
    LDS_WAIT(); asm volatile("" ::: "memory");
    const int c = lane & 7;
#pragma unroll
    for (int j = 0; j < 4; ++j) { const int n = (lane >> 3) + 8 * j; const LAS float* s = scr + (8 * c) * 33 + n;
        v4u o; o.x = pk2(s[0 * 33], s[1 * 33]); o.y = pk2(s[2 * 33], s[3 * 33]); o.z = pk2(s[4 * 33], s[5 * 33]); o.w = pk2(s[6 * 33], s[7 * 33]);
        *(GAS v4u*)(WT + (size_t)(n0 + n) * K + k0 + 8 * c) = o; }
    LDS_WAIT(); asm volatile("" ::: "memory");
}
__device__ __forceinline__ void row_to_bf16(const float* xrow, bf16_t* orow, float* ssq_out, int lane) {
    const GAS f32x4* xr = (const GAS f32x4*)xrow + lane; f32x4 v[4]; float s = 0.f;
#pragma unroll
    for (int j = 0; j < 4; ++j) { v[j] = xr[64 * j]; s += (v[j].x * v[j].x + v[j].y * v[j].y) + (v[j].z * v[j].z + v[j].w * v[j].w); }
    s = wave_sum(s);
    GAS unsigned long long* o8 = (GAS unsigned long long*)orow + lane;
#pragma unroll
    for (int j = 0; j < 4; ++j) o8[64 * j] = (unsigned long long)pk2(v[j].x, v[j].y) | ((unsigned long long)pk2(v[j].z, v[j].w) << 32);
    if (lane == 0) *ssq_out = s;
}

__global__ void __launch_bounds__(NWAVES * 64, 2) mk_fwd(Args args) {
    extern __shared__ __attribute__((aligned(16))) unsigned char lds[];
    LAS unsigned char* L = (LAS unsigned char*)lds;
    volatile LAS unsigned* MISC = (volatile LAS unsigned*)(L + MISC_OFF);
    const int tid0 = threadIdx.x; const int wave0 = __builtin_amdgcn_readfirstlane(tid0 >> 6);
    const int G = gridDim.x;
    unsigned char* ws = args.ws;
    gu32* ctl = (gu32*)(ws + WS_CTL);
    for (int u = tid0; u < (LDS_BYTES - LDSCTL_OFF) / 4; u += NWAVES * 64) ((LAS unsigned*)(L + LDSCTL_OFF))[u] = 0u;
    __syncthreads();
    XcdBarrier bar = xcd_barrier_post((unsigned*)(ctl + CW_BAR), MISC + 8);
    const int lo = args.ph_lo, hi = args.ph_hi;
    int ph = 0;
#define PH_BEGIN if (lo <= ph && ph < hi) { unsigned char* wsp = args.ws; asm volatile("" : "+s"(wsp)); int tid = wave0 * 64 + (int)__builtin_amdgcn_mbcnt_hi(~0u, __builtin_amdgcn_mbcnt_lo(~0u, 0u)); asm volatile("" : "+v"(tid)); const int lane = tid & 63, wave = __builtin_amdgcn_readfirstlane(tid >> 6); const long gtid = (long)blockIdx.x * (NWAVES * 64) + tid; const int gw = blockIdx.x * NWAVES + wave; LAS float* scr = (LAS float*)(L + wave * 16384); (void)lane; (void)gtid; (void)gw; (void)scr;
#define PH_END   if (ph + 1 < hi) xcd_barrier(bar); } ++ph;
    float* out = args.out;
#define SSQ_A ((float*)(wsp + WS_CTL + CTL_SSQ))
#define SSQ_B (SSQ_A + 3 * MTOK)
#define biastab ((float*)(wsp + WS_SMALL + SM_BIAS))
#define ssqm ((float*)(wsp + WS_SMALL + SM_SSQM))
#define MKV ((bf16_t*)(wsp + WS_SMALL + SM_MKV))
#define MEMB ((bf16_t*)(wsp + WS_MEMB))
#define Wt_in ((bf16_t*)(wsp + WS_WT + WT_IN))
#define Wt_out ((bf16_t*)(wsp + WS_WT + WT_OUT))
#define Wt_up ((bf16_t*)(wsp + WS_WT + WT_UP))
#define Wt_down ((bf16_t*)(wsp + WS_WT + WT_DOWN))
#define Wt_mkv ((bf16_t*)(wsp + WS_WT + WT_MKV))
#define XB ((bf16_t*)(wsp + WS_XB))
#define VF ((bf16_t*)(wsp + WS_VF))
#define PROJ ((bf16_t*)(wsp + WS_PROJ))
#define MIX ((bf16_t*)(wsp + WS_MIX))
#define U ((bf16_t*)(wsp + WS_U))
#define ACT ((bf16_t*)(wsp + WS_ACT))
#define PA ((size_t)MTOK * 384)
#define pR ((bf16_t*)(wsp + WS_PREP))
#define pK (pR + PA)
#define pV (pR + 2 * PA)
#define pKK (pR + 3 * PA)
#define pB (pR + 4 * PA)
#define pLD (pR + 5 * PA)
    const long gsize = (long)G * (NWAVES * 64);
    const int NGW = G * NWAVES;

#define MK_W() sk::RwkvW W{args.in[I_MU] + l * 1280, args.in[I_MUV], args.in[I_W0] + l * 384, args.in[I_W2] + l * 32 * 384, args.in[I_A0] + l * 384, args.in[I_A2] + l * 32 * 384, args.in[I_V0], args.in[I_V2], args.in[I_G2] + l * 64 * 384, args.in[I_KK] + l * 384, args.in[I_KA] + l * 384, args.in[I_RK] + l * 384, args.in[I_LNW] + l * 384, args.in[I_LNB] + l * 384};
#define MK_CBUF() const rw::ChunkBufs cbuf{(bf16_t*)(wsp + WS_PT), (bf16_t*)(wsp + WS_G), (float*)(wsp + WS_Z), (float*)(wsp + WS_YV), (bf16_t*)(wsp + WS_S0), (bf16_t*)(wsp + (l == 0 ? WS_VF : WS_V1)), (float*)(wsp + WS_DOT), (const bf16_t*)(wsp + WS_SMALL + SM_W2T), (const bf16_t*)(wsp + WS_SMALL + SM_A2T), (const bf16_t*)(wsp + WS_SMALL + SM_V2T), (const bf16_t*)(wsp + WS_SMALL + SM_G2T)};
    for (int l = 0; l < 2; ++l) {
        const float* xin = l == 0 ? args.in[I_X] : out;
        PH_BEGIN
            REPEAT(0) {
            const int I_IN = 16 * 68, I_OUT = 16 * 32, I_UP = 16 * 176, I_DN = 44 * 32, I_KV = 16 * 16, NIT = I_IN + I_OUT + I_UP + I_DN + I_KV;
            for (int it = gw; it < NIT; it += NGW) {
                int r = it;
                if (r < I_IN) { transpose_item(args.in[I_WIN] + (size_t)l * 1024 * 2176, args.in[I_MIXG] + l * 1024, 1024, 2176, Wt_in, scr, r, lane); continue; } r -= I_IN;
                if (r < I_OUT) { transpose_item(args.in[I_WOUT] + (size_t)l * 1024 * 1024, nullptr, 1024, 1024, Wt_out, scr, r, lane); continue; } r -= I_OUT;
                if (r < I_UP) { transpose_item(args.in[I_WUP] + (size_t)l * 1024 * 5632, args.in[I_FFNG] + l * 1024, 1024, 5632, Wt_up, scr, r, lane); continue; } r -= I_UP;
                if (r < I_DN) { transpose_item(args.in[I_WDOWN] + (size_t)l * 2816 * 1024, nullptr, 2816, 1024, Wt_down, scr, r, lane); continue; } r -= I_DN;
                transpose_item(args.in[I_WMKV] + (size_t)l * 1024 * 512, args.in[I_MEMG] + l * 1024, 1024, 512, Wt_mkv, scr, r, lane);
            }
            for (long i = gtid; i < 128 * 1024; i += gsize) { const int n = (int)(i >> 10), k = (int)(i & 1023); float v = 0.f;
                if (l > 0 && n < 16) v = args.in[I_WINV][k * 16 + n] * args.in[I_MIXG][l * 1024 + k];
                Wt_in[(size_t)(2176 + n) * 1024 + k] = f2bf(v); }
            for (long i = gtid; i < 384 * 160; i += gsize) { const int hc = (int)(i / 160), j = (int)(i % 160); bf16_t* sm = (bf16_t*)(wsp + WS_SMALL);
                if (j < 32) sm[SM_W2T / 2 + hc * 32 + j] = f2bf(args.in[I_W2][(size_t)l * 32 * 384 + j * 384 + hc]);
                else if (j < 64) sm[SM_A2T / 2 + hc * 32 + (j - 32)] = f2bf(args.in[I_A2][(size_t)l * 32 * 384 + (j - 32) * 384 + hc]);
                else if (j < 96) sm[SM_V2T / 2 + hc * 32 + (j - 64)] = f2bf((j - 64) < 16 ? args.in[I_V2][(j - 64) * 384 + hc] : 0.f);
                else sm[SM_G2T / 2 + hc * 64 + (j - 96)] = f2bf(args.in[I_G2][(size_t)l * 64 * 384 + (j - 96) * 384 + hc]); }
            if (l == 0) {
                for (int m = gw; m < MTOK; m += NGW) row_to_bf16(args.in[I_X] + (size_t)m * DM, XB + (size_t)m * DM, SSQ_A + m, lane);
                for (int m = gw; m < 512; m += NGW) row_to_bf16(args.in[I_MEM] + (size_t)m * DM, MEMB + (size_t)m * DM, ssqm + m, lane);
                sk::d_biastab(args.in[I_RELB], biastab, gtid, gsize);
            }
            }
        PH_END
        PH_BEGIN
            REPEAT(1)
            { pg8::Gemm g{XB, Wt_in, MTOK, 2304, 1024}; pg8::StaticOrder S; S.init(MTOK, 2304, G, (int)blockIdx.x);
              pg8::EpiScaleBf16 E{PROJ, LDP, SSQ_A + (size_t)l * MTOK};
              pg8::gemm_phase<pg8::EpiScaleBf16, pg8::StaticOrder, true, true>(L, g, S, E, tid); }
            { pg8::Gemm g{MEMB, Wt_mkv, 512, 512, 1024}; pg8::StaticOrder S; S.init(512, 512, G, (int)((blockIdx.x + 192) % G));
              pg8::EpiScaleBf16 E{MKV, 512, ssqm};
              pg8::gemm_phase<pg8::EpiScaleBf16, pg8::StaticOrder, true, true>(L, g, S, E, tid); }
        PH_END


        PH_BEGIN
            MK_W(); MK_CBUF(); (void)cbuf;
#if !FAST_ATTN
            sk::d_qknorm(PROJ, MTOK, LDP, args.in[I_AQN] + l * 64, args.in[I_AKN] + l * 64, args.in[I_MQN] + l * 64, 0, gtid, gsize);
            sk::d_qknorm(MKV, 512, 512, nullptr, nullptr, args.in[I_MKN] + l * 64, 1, gtid, gsize);
#endif
#if FAST_RWKV
            REPEAT(2) rw::chunk_phase(L, PROJ, W, l, VF, cbuf, tid, (int)blockIdx.x, G);
#else
            sk::d_rwkv_prep(PROJ, W, l, VF, pR, pK, pV, pKK, pB, pLD, gtid, gsize);
#endif
        PH_END
        PH_BEGIN
            MK_CBUF(); (void)cbuf;
            if (blockIdx.x < BATCH * 6) {
#if FAST_RWKV
                REPEAT(3) if (wave < 4) rw::scan_phase(cbuf, (int)blockIdx.x, wave, lane);
#else
                if (wave == 0) sk::d_rwkv_scan(pR, pK, pV, pKK, pB, pLD, MIX, (int)blockIdx.x, lane);
#endif
            } else {
#if FAST_ATTN
                const at::AttnArgs A{PROJ, MKV, MIX, biastab, args.in[I_SINK] + l * 6, args.in[I_AQN] + l * 64, args.in[I_AKN] + l * 64, args.in[I_MQN] + l * 64, args.in[I_MKN] + l * 64};
                REPEAT(7) for (int it = (int)blockIdx.x - BATCH * 6; it < 512; it += G - BATCH * 6) at::attn_item(L, A, it, tid);
#else
                const long gt2 = (long)(blockIdx.x - BATCH * 6) * (NWAVES * 64) + tid, gs2 = (long)(G - BATCH * 6) * (NWAVES * 64);
                REPEAT(7) sk::d_swa(PROJ, MIX, biastab, args.in[I_SINK] + l * 6, gt2, gs2);
                REPEAT(8) sk::d_memattn(PROJ, MKV, MIX, gt2, gs2);
#endif
            }
        PH_END
        PH_BEGIN
            MK_W(); MK_CBUF(); (void)cbuf;
#if FAST_RWKV
            REPEAT(4) rw::out_phase(L, PROJ, W, cbuf, MIX, tid, (int)blockIdx.x, G);
#else
            sk::d_rwkv_fin(PROJ, W, pR, pK, pV, MIX, gtid, gsize);
#endif
        PH_END
        PH_BEGIN
            pg8::Gemm g{MIX, Wt_out, MTOK, 1024, 1024}; pg8::StaticOrder S; S.init(MTOK, 1024, G, (int)blockIdx.x);
            pg8::EpiResid E{xin, out, XB, SSQ_B + (size_t)l * MTOK, 1024};
            pg8::gemm_phase<pg8::EpiResid, pg8::StaticOrder, true, true>(L, g, S, E, tid);
        PH_END
        for (int b = 0; b < BATCH; ++b) {
            PH_BEGIN
                REPEAT(5) {
                pg8::Gemm g{XB + (size_t)b * SEQ * 1024, Wt_up, SEQ, 5632, 1024}; pg8::StaticOrder S; S.init(SEQ, 5632, G, (int)blockIdx.x);
                pg8::EpiScaleBf16 E{U, 5632, SSQ_B + (size_t)l * MTOK + (size_t)b * SEQ};
                pg8::gemm_phase<pg8::EpiScaleBf16, pg8::StaticOrder, true, true>(L, g, S, E, tid); }
            PH_END
            PH_BEGIN
                REPEAT(6) sk::d_conv_act(U, args.in[I_CW] + (size_t)l * 3 * 5632, args.in[I_CB] + (size_t)l * 5632, ACT + (size_t)b * SEQ * DFF, SEQ, gtid, gsize);
            PH_END
        }
        PH_BEGIN
            pg8::Gemm g{ACT, Wt_down, MTOK, 1024, 2816}; pg8::StaticOrder S; S.init(MTOK, 1024, G, (int)blockIdx.x);
            pg8::EpiResid E{out, out, XB, SSQ_A + (size_t)(l + 1) * MTOK, 1024};
            pg8::gemm_phase<pg8::EpiResid, pg8::StaticOrder, true, true>(L, g, S, E, tid);
        PH_END
    }
#undef PH_BEGIN
#undef PH_END
}
constexpr int N_PHASES = 2 * 11;
}

#ifndef MK_PER_PHASE
#define MK_PER_PHASE 0
#endif
extern "C" void kernel_launch(void* const* d_in, const int* in_sizes, int n_in, void* d_out, int out_size, void* d_ws, size_t ws_size, hipStream_t stream) {
    static int grid = 0;
    if (grid == 0) {
        if (n_in != N_IN || out_size != MTOK * DM || ws_size < mk::WS_END) { fprintf(stderr, "kernel_launch: unexpected shapes (n_in %d out %d ws %zu)\n", n_in, out_size, ws_size); grid = -1; return; }
        int dev = 0, cus = 0, per_cu = 0;
        if (hipGetDevice(&dev) != hipSuccess || hipDeviceGetAttribute(&cus, hipDeviceAttributeMultiprocessorCount, dev) != hipSuccess) { grid = -1; return; }
        if (hipFuncSetAttribute((const void*)mk::mk_fwd, hipFuncAttributeMaxDynamicSharedMemorySize, mk::LDS_BYTES) != hipSuccess) { fprintf(stderr, "kernel_launch: hipFuncSetAttribute failed\n"); grid = -1; return; }
        if (hipOccupancyMaxActiveBlocksPerMultiprocessor(&per_cu, (const void*)mk::mk_fwd, NWAVES * 64, mk::LDS_BYTES) != hipSuccess || per_cu < 1) { fprintf(stderr, "kernel_launch: occupancy query says %d blocks per CU\n", per_cu); }
        (void)hipGetLastError();
        grid = cus;
    }
    if (grid < 0) return;
    if (hipMemsetAsync((char*)d_ws + mk::WS_CTL, 0, mk::CTL_ZERO_BYTES, stream) != hipSuccess) return;
    mk::Args a{};
    for (int i = 0; i < N_IN; ++i) a.in[i] = (const float*)d_in[i];
    a.out = (float*)d_out; a.ws = (unsigned char*)d_ws;
#if MK_PER_PHASE
    for (int p = 0; p < mk::N_PHASES; ++p) { a.ph_lo = p; a.ph_hi = p + 1; hipLaunchKernelGGL(mk::mk_fwd, dim3(grid), dim3(NWAVES * 64), mk::LDS_BYTES, stream, a); }
#else
    a.ph_lo = 0; a.ph_hi = mk::N_PHASES;
    hipLaunchKernelGGL(mk::mk_fwd, dim3(grid), dim3(NWAVES * 64), mk::LDS_BYTES, stream, a);
#endif
}
```

```cpp
#define MK_BUILD 1
#ifndef HOST_SIM
#include <hip/hip_runtime.h>
#include <cstdio>
#include <cstdint>
#endif
#ifndef SEQ_LEN
#define SEQ_LEN 8192
#endif
typedef unsigned short bf16_t;
constexpr int BATCH = 2, SEQ = SEQ_LEN, DM = 1024, MTOK = BATCH * SEQ, DFF = 2816, LDP = 2304  ;
constexpr float EPS = 1e-6f, GN_EPS = 64e-5f;
__host__ __device__ __forceinline__ float bf2f(bf16_t h) { unsigned u = (unsigned)h << 16; return __builtin_bit_cast(float, u); }
__host__ __device__ __forceinline__ bf16_t f2bf(float f) { unsigned u = __builtin_bit_cast(unsigned, f); return (bf16_t)((u + 0x7fffu + ((u >> 16) & 1u)) >> 16); }
__host__ __device__ __forceinline__ int t5_bucket(int dist) {
    if (dist < 16) return dist;
    const float v = logf((float)dist / 16.0f) / 2.0794415416798357f * 16.0f;
    int large = 16 + (int)v; return large < 31 ? large : 31;
}
constexpr size_t MiB = 1u << 20;
enum { I_X = 0, I_MEM, I_RELB, I_MIXG, I_WIN, I_WINV, I_AQN, I_AKN, I_SINK, I_MU, I_MUV, I_W0, I_W2, I_A0, I_A2, I_V0, I_V2, I_G2, I_KK, I_KA, I_RK, I_LNW, I_LNB, I_MEMG, I_WMKV, I_MQN, I_MKN, I_WOUT, I_FFNG, I_WUP, I_CW, I_CB, I_WDOWN, N_IN };
namespace sk {

__device__ __forceinline__ void d_wt(const float* W, const float* g, bf16_t* Wt, int K, int N, int Npad, long gtid, long gsize) {
    const long total = (long)Npad * K;
    for (long idx = gtid; idx < total; idx += gsize) {
        const int n = (int)(idx / K), k = (int)(idx % K);
        float v = 0.f;
        if (n < N) { v = W[(long)k * N + n]; if (g) v *= g[k]; }
        Wt[idx] = f2bf(v);
    }
}
#ifndef MK_BUILD
__global__ void k_wt(const float* W, const float* g, bf16_t* Wt, int K, int N, int Npad) { d_wt(W, g, Wt, K, N, Npad, (long)blockIdx.x * blockDim.x + threadIdx.x, (long)gridDim.x * blockDim.x); }
#endif
__device__ __forceinline__ void d_rowprep(const float* x, bf16_t* xb, float* ssq, int rows, long gtid, long gsize) {
    for (long r = gtid; r < rows; r += gsize) {
        const float* xr = x + (long)r * DM; bf16_t* o = xb + (long)r * DM; float s = 0.f;
        for (int c = 0; c < DM; ++c) { const float v = xr[c]; s += v * v; o[c] = f2bf(v); }
        ssq[r] = s;
    }
}
#ifndef MK_BUILD
__global__ void k_rowprep(const float* x, bf16_t* xb, float* ssq, int rows) { d_rowprep(x, xb, ssq, rows, (long)blockIdx.x * blockDim.x + threadIdx.x, (long)gridDim.x * blockDim.x); }
#endif
__device__ __forceinline__ void d_biastab(const float* rel_bias, float* tab, long gtid, long gsize) {
        for (long i = gtid; i < 128 * 6; i += gsize) { const int dist = i / 6, hq = i % 6; tab[i] = rel_bias[t5_bucket(dist) * 6 + hq]; }
}
#ifndef MK_BUILD
__global__ void k_biastab(const float* rel_bias, float* tab) { d_biastab(rel_bias, tab, (long)blockIdx.x * blockDim.x + threadIdx.x, (long)gridDim.x * blockDim.x); }
#endif
__device__ __forceinline__ void d_qknorm(bf16_t* P, int rows, int ld, const float* gq, const float* gk, const float* gm, int mode, long gtid, long gsize) {
    const int nj = mode == 0 ? 12 : 4;
    const long total = (long)rows * nj;
    for (long idx = gtid; idx < total; idx += gsize) {
        const int row = (int)(idx / nj), j = (int)(idx % nj);
        int col; const float* g;
        if (mode == 0) { if (j < 6) { col = 64 * j; g = gq; } else if (j < 8) { col = 384 + 64 * (j - 6); g = gk; } else { col = 1920 + 64 * (j - 8); g = gm; } }
        else { col = 64 * j; g = gm; }
        bf16_t* p = P + (long)row * ld + col; float s = 0.f;
        for (int d = 0; d < 64; ++d) { const float v = bf2f(p[d]); s += v * v; }
        const float rs = 1.0f / sqrtf(s * (1.0f / 64.0f) + EPS);
        for (int d = 0; d < 64; ++d) p[d] = f2bf(bf2f(p[d]) * rs * g[d]);
    }
}
#ifndef MK_BUILD
__global__ void k_qknorm(bf16_t* P, int rows, int ld, const float* gq, const float* gk, const float* gm, int mode) { d_qknorm(P, rows, ld, gq, gk, gm, mode, (long)blockIdx.x * blockDim.x + threadIdx.x, (long)gridDim.x * blockDim.x); }
#endif
__device__ __forceinline__ void d_swa(const bf16_t* P, bf16_t* MIX, const float* biastab, const float* sinks, long gtid, long gsize) {
    const long total = (long)MTOK * 6;
    for (long idx = gtid; idx < total; idx += gsize) {
        const int tok = (int)(idx / 6), hq = (int)(idx % 6), hkv = hq / 3, t = tok % SEQ;
        float q[64], o[64];
#pragma unroll
        for (int d = 0; d < 64; ++d) { q[d] = bf2f(P[(long)tok * LDP + 64 * hq + d]) * 0.125f; o[d] = 0.f; }
        float m = sinks[hq], l = 1.0f;
        const int j0 = t - 127 < 0 ? 0 : t - 127;
        for (int j = j0; j <= t; ++j) {
            const bf16_t* kr = P + (long)(tok - (t - j)) * LDP + 384 + 64 * hkv; const bf16_t* vr = kr + 128;
            float s = 0.f;
#pragma unroll
            for (int d = 0; d < 64; ++d) s += q[d] * bf2f(kr[d]);
            s += biastab[(t - j) * 6 + hq];
            const float mn = fmaxf(m, s), f = expf(m - mn), e = expf(s - mn);
            l = l * f + e; m = mn;
#pragma unroll
            for (int d = 0; d < 64; ++d) o[d] = o[d] * f + e * bf2f(vr[d]);
        }
        const float inv = 1.0f / l;
#pragma unroll
        for (int d = 0; d < 64; ++d) MIX[(long)tok * DM + 64 * hq + d] = f2bf(o[d] * inv);
    }
}
#ifndef MK_BUILD
__global__ __launch_bounds__(256) void k_swa(const bf16_t* P, bf16_t* MIX, const float* biastab, const float* sinks) { d_swa(P, MIX, biastab, sinks, (long)blockIdx.x * blockDim.x + threadIdx.x, (long)gridDim.x * blockDim.x); }
#endif
__device__ __forceinline__ void d_memattn(const bf16_t* P, const bf16_t* MKV, bf16_t* MIX, long gtid, long gsize) {
    const long total = (long)MTOK * 4;
    for (long idx = gtid; idx < total; idx += gsize) {
        const int tok = (int)(idx / 4), h = (int)(idx % 4), b = tok / SEQ;
        float q[64], o[64];
#pragma unroll
        for (int d = 0; d < 64; ++d) { q[d] = bf2f(P[(long)tok * LDP + 1920 + 64 * h + d]) * 0.125f; o[d] = 0.f; }
        float m = -1e30f, l = 0.f;
        for (int j = 0; j < 256; ++j) {
            const bf16_t* kr = MKV + (long)(b * 256 + j) * 512 + 64 * h; const bf16_t* vr = kr + 256;
            float s = 0.f;
#pragma unroll
            for (int d = 0; d < 64; ++d) s += q[d] * bf2f(kr[d]);
            const float mn = fmaxf(m, s), f = expf(m - mn), e = expf(s - mn);
            l = l * f + e; m = mn;
#pragma unroll
            for (int d = 0; d < 64; ++d) o[d] = o[d] * f + e * bf2f(vr[d]);
        }
        const float inv = 1.0f / l;
#pragma unroll
        for (int d = 0; d < 64; ++d) MIX[(long)tok * DM + 768 + 64 * h + d] = f2bf(o[d] * inv);
    }
}
#ifndef MK_BUILD
__global__ __launch_bounds__(256) void k_memattn(const bf16_t* P, const bf16_t* MKV, bf16_t* MIX) { d_memattn(P, MKV, MIX, (long)blockIdx.x * blockDim.x + threadIdx.x, (long)gridDim.x * blockDim.x); }
#endif
__device__ __forceinline__ float shifted(const bf16_t* P, int tok, int col, float mu) {
    const float p = bf2f(P[(long)tok * LDP + col]);
    const float prev = (tok % SEQ) == 0 ? 0.f : bf2f(P[(long)(tok - 1) * LDP + col]);
    return p + mu * (prev - p);
}
struct RwkvW { const float *mu, *mu_v, *w0, *w2, *a0, *a2, *v0, *v2, *g2, *k_k, *k_a, *r_k, *ln_w, *ln_b; };
__device__ __forceinline__ void d_rwkv_prep(const bf16_t* P, RwkvW W, int layer, bf16_t* VFIRST, bf16_t* R, bf16_t* K, bf16_t* V, bf16_t* KK, bf16_t* B, bf16_t* LOGD, long gtid, long gsize) {
    const long total = (long)MTOK * 6;
    for (long idx = gtid; idx < total; idx += gsize) {
        const int tok = (int)(idx / 6), h = (int)(idx % 6);
        float nrm = 0.f;
        for (int c = 0; c < 64; ++c) { const int hc = 64 * h + c; const float kc = shifted(P, tok, 640 + 384 + hc, W.mu[384 + hc]) * W.k_k[hc]; nrm += kc * kc; }
        const float rn = 1.0f / fmaxf(sqrtf(nrm), 1e-12f);
        for (int c = 0; c < 64; ++c) {
            const int hc = 64 * h + c; const long o = (long)tok * 384 + hc;
            const float r = shifted(P, tok, 640 + hc, W.mu[hc]);
            const float k = shifted(P, tok, 640 + 384 + hc, W.mu[384 + hc]);
            float v = shifted(P, tok, 640 + 768 + hc, W.mu[768 + hc]);
            float wp = W.w0[hc], ap = W.a0[hc];
            for (int j = 0; j < 32; ++j) {
                wp += tanhf(shifted(P, tok, 640 + 1152 + j, W.mu[1152 + j])) * W.w2[j * 384 + hc];
                ap += shifted(P, tok, 640 + 1184 + j, W.mu[1184 + j]) * W.a2[j * 384 + hc];
            }
            const float z = -wp; const float sp = fmaxf(z, 0.f) + log1pf(expf(-fabsf(z)));
            const float w = -sp - 0.5f;
            const float a = 1.0f / (1.0f + expf(-ap));
            if (layer > 0) {
                float vp = W.v0[hc];
                for (int j = 0; j < 16; ++j) vp += shifted(P, tok, 2176 + j, W.mu_v[j]) * W.v2[j * 384 + hc];
                const float vf = bf2f(VFIRST[o]);
                v = v + (vf - v) * (1.0f / (1.0f + expf(-vp)));
            } else VFIRST[o] = f2bf(v);
            const float kk = k * W.k_k[hc] * rn;
            R[o] = f2bf(r); K[o] = f2bf(k * (1.0f + (a - 1.0f) * W.k_a[hc])); V[o] = f2bf(v);
            KK[o] = f2bf(kk); B[o] = f2bf(kk * a); LOGD[o] = f2bf(-expf(w));
        }
    }
}
#ifndef MK_BUILD
__global__ void k_rwkv_prep(const bf16_t* P, RwkvW W, int layer, bf16_t* VFIRST, bf16_t* R, bf16_t* K, bf16_t* V, bf16_t* KK, bf16_t* B, bf16_t* LOGD) { d_rwkv_prep(P, W, layer, VFIRST, R, K, V, KK, B, LOGD, (long)blockIdx.x * blockDim.x + threadIdx.x, (long)gridDim.x * blockDim.x); }
#endif
__device__ __forceinline__ void d_rwkv_scan(const bf16_t* R, const bf16_t* K, const bf16_t* V, const bf16_t* KK, const bf16_t* B, const bf16_t* LOGD, bf16_t* MIX, int bh, int i) {
    const int b = bh / 6, h = bh % 6;
    float s[64];
#pragma unroll
    for (int k = 0; k < 64; ++k) s[k] = 0.f;
    for (int t = 0; t < SEQ; ++t) {
        const long o = (long)(b * SEQ + t) * 384 + 64 * h;
        float sa = 0.f;
#pragma unroll
        for (int k = 0; k < 64; ++k) sa -= s[k] * bf2f(KK[o + k]);
        const float v = bf2f(V[o + i]); float y = 0.f;
#pragma unroll
        for (int k = 0; k < 64; ++k) { s[k] = s[k] * expf(bf2f(LOGD[o + k])) + sa * bf2f(B[o + k]) + v * bf2f(K[o + k]); y += s[k] * bf2f(R[o + k]); }
        MIX[(long)(b * SEQ + t) * DM + 384 + 64 * h + i] = f2bf(y);
    }
}
#ifndef MK_BUILD
__global__ void k_rwkv_scan(const bf16_t* R, const bf16_t* K, const bf16_t* V, const bf16_t* KK, const bf16_t* B, const bf16_t* LOGD, bf16_t* MIX) { d_rwkv_scan(R, K, V, KK, B, LOGD, MIX, blockIdx.x, threadIdx.x); }
#endif
__device__ __forceinline__ void d_rwkv_fin(const bf16_t* P, RwkvW W, const bf16_t* R, const bf16_t* K, const bf16_t* V, bf16_t* MIX, long gtid, long gsize) {
    const long total = (long)MTOK * 6;
    for (long idx = gtid; idx < total; idx += gsize) {
        const int tok = (int)(idx / 6), h = (int)(idx % 6);
        bf16_t* y = MIX + (long)tok * DM + 384 + 64 * h; const long o = (long)tok * 384 + 64 * h;
        float mean = 0.f, dot = 0.f;
        for (int c = 0; c < 64; ++c) { mean += bf2f(y[c]); dot += bf2f(R[o + c]) * bf2f(K[o + c]) * W.r_k[64 * h + c]; }
        mean *= (1.0f / 64.0f); float var = 0.f;
        for (int c = 0; c < 64; ++c) { const float d = bf2f(y[c]) - mean; var += d * d; }
        const float rstd = 1.0f / sqrtf(var * (1.0f / 64.0f) + GN_EPS);
        for (int c = 0; c < 64; ++c) {
            const int hc = 64 * h + c; float g = 0.f;
            for (int j = 0; j < 64; ++j) g += (1.0f / (1.0f + expf(-shifted(P, tok, 640 + 1216 + j, W.mu[1216 + j])))) * W.g2[j * 384 + hc];
            const float yn = (bf2f(y[c]) - mean) * rstd * W.ln_w[hc] + W.ln_b[hc];
            y[c] = f2bf((yn + dot * bf2f(V[o + c])) * g);
        }
    }
}
#ifndef MK_BUILD
__global__ void k_rwkv_fin(const bf16_t* P, RwkvW W, const bf16_t* R, const bf16_t* K, const bf16_t* V, bf16_t* MIX) { d_rwkv_fin(P, W, R, K, V, MIX, (long)blockIdx.x * blockDim.x + threadIdx.x, (long)gridDim.x * blockDim.x); }
#endif
__device__ __forceinline__ void d_conv_act(const bf16_t* U, const float* cw, const float* cb, bf16_t* ACT, int rows, long gtid, long gsize) {
    const long total = (long)rows * DFF;
    for (long idx = gtid; idx < total; idx += gsize) {
        const int t = (int)(idx / DFF), c = (int)(idx % DFF);
        float gate = cb[c], val = cb[DFF + c];
#pragma unroll
        for (int i = 0; i < 3; ++i) { const int tt = t - 2 + i; if (tt >= 0) { gate += cw[i * 2 * DFF + c] * bf2f(U[(long)tt * 2 * DFF + c]); val += cw[i * 2 * DFF + DFF + c] * bf2f(U[(long)tt * 2 * DFF + DFF + c]); } }
        ACT[(long)t * DFF + c] = f2bf(gate / (1.0f + expf(-gate)) * val);
    }
}
#ifndef MK_BUILD
__global__ void k_conv_act(const bf16_t* U, const float* cw, const float* cb, bf16_t* ACT, int rows) { d_conv_act(U, cw, cb, ACT, rows, (long)blockIdx.x * blockDim.x + threadIdx.x, (long)gridDim.x * blockDim.x); }
#endif
}
namespace pg8 {
#define PG8_LAS __attribute__((address_space(3)))
typedef unsigned short bf16_t;
typedef short bf16x8 __attribute__((ext_vector_type(8)));
typedef float f32x4 __attribute__((ext_vector_type(4)));
typedef unsigned u32x4 __attribute__((ext_vector_type(4)));
constexpr int BM = 256, BK = 64, HALF = 128, HTB = HALF * BK * 2  , STAGE_BYTES = 8 * HTB, NXCD = 8, WGM = 8;

__host__ __device__ __forceinline__ int lds_byte(int r, int c) { const int st = (r >> 4) * 2 + (c >> 5), rr = r & 15, cc = c & 31, ob = rr * 64 + cc * 2; return st * 1024 + (ob ^ (((ob >> 9) & 1) << 5)); }
__host__ __device__ __forceinline__ void stage_rc(int b, int& R, int& C) { const int st = b / 1024, sb = b % 1024, swz = sb ^ (((sb >> 9) & 1) << 5); R = (st >> 1) * 16 + swz / 64; C = (st & 1) * 32 + (swz % 64) / 2; }
__host__ __device__ __forceinline__ int perm32(int rho) { const int n = rho >> 4, i = rho & 15; return 8 * (i >> 2) + 4 * n + (i & 3); }

struct Unit { int pm, pn; };
struct Gemm { const bf16_t* A; const bf16_t* Bt; int M, N, K; };

struct StaticOrder {
    int nM, nN, nwg, G, c;
    __host__ __device__ void init(int M, int N, int G_, int c_) { nM = M / BM; nN = N / BM; nwg = nM * nN; G = G_; c = c_; }
    __host__ __device__ bool next(int i, Unit& u) const {
        const long L = (long)i * G + c; if (L >= nwg) return false;
        int wgid = (int)L; { const int q = nwg / NXCD, r = nwg % NXCD, xcd = wgid % NXCD, off = wgid / NXCD; wgid = (xcd < r ? xcd * (q + 1) : r * (q + 1) + (xcd - r) * q) + off; }
        const int nig = WGM * nN, gid = wgid / nig, fm = gid * WGM, gsz = (nM - fm) < WGM ? (nM - fm) : WGM;
        u.pm = fm + ((wgid % nig) % gsz); u.pn = (wgid % nig) / gsz; return true;
    }
    __device__ __forceinline__ void a_ready(const Unit&) const {}
    __device__ __forceinline__ void done(const Unit&) const {}
};

__device__ __forceinline__ unsigned cvt_pk_bf16(float lo, float hi) { unsigned r; asm volatile("v_cvt_pk_bf16_f32 %0, %1, %2" : "=v"(r) : "v"(lo), "v"(hi)); return r; }
struct EpiScaleBf16 {
    static constexpr bool PERM = true, AFTER_DRAIN = false; static constexpr int AMAP = 0;
    bf16_t* O; int ldc; const float* ssq;
    __device__ __forceinline__ void operator()(const f32x4 (&acc)[2][2][4][2], const Unit& u, int wr, int wc, int fr, int fq) const {
        const int row0 = u.pm * BM + wr * 64 + fr, col0 = u.pn * BM + wc * 32 + 8 * fq;
#pragma unroll
        for (int ai = 0; ai < 2; ++ai)
#pragma unroll
            for (int m = 0; m < 4; ++m) { const int row = row0 + ai * HALF + m * 16; const float sc = 1.0f / sqrtf(ssq[row] * (1.0f / 1024.0f) + 1e-6f);
                bf16_t* rowp = O + (size_t)row * ldc + col0;
#pragma unroll
                for (int bj = 0; bj < 2; ++bj) { const f32x4 v0 = acc[ai][bj][m][0] * sc, v1 = acc[ai][bj][m][1] * sc;
                    u32x4 w; w.x = cvt_pk_bf16(v0[0], v0[1]); w.y = cvt_pk_bf16(v0[2], v0[3]); w.z = cvt_pk_bf16(v1[0], v1[1]); w.w = cvt_pk_bf16(v1[2], v1[3]);
                    *(u32x4*)(rowp + bj * HALF) = w; } }
    }
};
struct EpiResid {
    static constexpr bool PERM = false, AFTER_DRAIN = false; static constexpr int AMAP = 0;
    const float* base; float* out; bf16_t* xb; float* ssq; int ldc;
    __device__ __forceinline__ void operator()(const f32x4 (&acc)[2][2][4][2], const Unit& u, int wr, int wc, int fr, int fq) const {
        typedef unsigned u32x2v __attribute__((ext_vector_type(2)));
        const int col0 = u.pn * BM + wc * 32 + 4 * fq;
#pragma unroll
        for (int ai = 0; ai < 2; ++ai)
#pragma unroll
            for (int m = 0; m < 4; ++m) { const int row = u.pm * BM + ai * HALF + wr * 64 + m * 16 + fr; const size_t off = (size_t)row * ldc + col0; float sq = 0.f;
#pragma unroll
                for (int bj = 0; bj < 2; ++bj)
#pragma unroll
                    for (int n = 0; n < 2; ++n) { const f32x4 o = *(const f32x4*)(base + off + bj * HALF + n * 16) + acc[ai][bj][m][n];
                        *(f32x4*)(out + off + bj * HALF + n * 16) = o; sq += (o[0] * o[0] + o[1] * o[1]) + (o[2] * o[2] + o[3] * o[3]);
                        u32x2v w; w.x = cvt_pk_bf16(o[0], o[1]); w.y = cvt_pk_bf16(o[2], o[3]); *(u32x2v*)(xb + off + bj * HALF + n * 16) = w; }
                sq += __shfl_xor(sq, 16); sq += __shfl_xor(sq, 32);
                if (fq == 0) atomicAdd(ssq + row, sq); }
    }
};
struct EpiConvAct {
    static constexpr bool PERM = true, AFTER_DRAIN = false; static constexpr int AMAP = 1;
    bf16_t* ACT; const float* ssq; const float* cw; const float* cb;
    static __device__ __forceinline__ float shr1s(float x) { float r; asm volatile("s_nop 1\n\tv_mov_b32_dpp %0, %1 row_shr:1 row_mask:0xf bank_mask:0xf bound_ctrl:1" : "=v"(r) : "v"(x)); return r; }
    static __device__ __forceinline__ f32x4 shr1(f32x4 v) { f32x4 r; r[0] = shr1s(v[0]); r[1] = shr1s(v[1]); r[2] = shr1s(v[2]); r[3] = shr1s(v[3]); return r; }
    __device__ __forceinline__ void operator()(const f32x4 (&acc)[2][2][4][2], const Unit& u, int wr, int wc, int fr, int fq) const {
        const int b = u.pm / 33, pmb = u.pm % 33;
        const int pos0 = 252 * pmb + 126 * wr + 8 * fr - 2;
        const long row0 = (long)b * SEQ + pos0;
        float rs[8];
#pragma unroll
        for (int j = 0; j < 8; ++j) { const int pos = pos0 + j; const bool ok = pos >= 0 && pos < SEQ; const float q = ssq[ok ? row0 + j : 0]; rs[j] = ok ? 1.0f / sqrtf(q * (1.0f / 1024.0f) + 1e-6f) : 0.f; }
        const int ch0 = 128 * u.pn + 32 * wc + 8 * fq;
        unsigned ow[8][4];
#pragma unroll
        for (int n = 0; n < 2; ++n) { const int c = ch0 + 4 * n;
            const f32x4 w0g = *(const f32x4*)(cw + c), w1g = *(const f32x4*)(cw + 5632 + c), w2g = *(const f32x4*)(cw + 2 * 5632 + c), bg = *(const f32x4*)(cb + c);
            const f32x4 w0v = *(const f32x4*)(cw + 2816 + c), w1v = *(const f32x4*)(cw + 5632 + 2816 + c), w2v = *(const f32x4*)(cw + 2 * 5632 + 2816 + c), bv = *(const f32x4*)(cb + 2816 + c);
            f32x4 gm2 = shr1(acc[1][0][2][n] * rs[6]), gm1 = shr1(acc[1][0][3][n] * rs[7]), vm2 = shr1(acc[1][1][2][n] * rs[6]), vm1 = shr1(acc[1][1][3][n] * rs[7]);
#pragma unroll
            for (int j = 0; j < 8; ++j) { const f32x4 gj = acc[j >> 2][0][j & 3][n] * rs[j], vj = acc[j >> 2][1][j & 3][n] * rs[j];
                const f32x4 ug = bg + w0g * gm2 + w1g * gm1 + w2g * gj, uv = bv + w0v * vm2 + w1v * vm1 + w2v * vj; f32x4 a;
#pragma unroll
                for (int e = 0; e < 4; ++e) a[e] = ug[e] / (1.0f + __expf(-ug[e])) * uv[e];
                ow[j][2 * n] = cvt_pk_bf16(a[0], a[1]); ow[j][2 * n + 1] = cvt_pk_bf16(a[2], a[3]);
                gm2 = gm1; gm1 = gj; vm2 = vm1; vm1 = vj; } }
#pragma unroll
        for (int j = 0; j < 8; ++j) if (8 * fr + j >= 2 && pos0 + j < SEQ) { u32x4 w; w.x = ow[j][0]; w.y = ow[j][1]; w.z = ow[j][2]; w.w = ow[j][3]; *(u32x4*)(ACT + (size_t)(row0 + j) * 2816 + ch0) = w; }
    }
};
template <class Epi, class Sched, bool ALIGN_EPI = false, bool SP2 = false>
__device__ __forceinline__ void gemm_phase(PG8_LAS unsigned char* lds, const Gemm g, const Sched& S, const Epi& E, int tid_in) {
    int tid = tid_in; asm volatile("" : "+v"(tid));
    const int wid = __builtin_amdgcn_readfirstlane(tid >> 6), lane = tid & 63, wr = wid >> 2, wc = wid & 3, fr = lane & 15, fq = lane >> 4;
    const int K = g.K, nt = K / BK;
    unsigned voffA[2], voffB[2];
#pragma unroll
    for (int i = 0; i < 2; ++i) { int R, C; stage_rc(tid * 16 + i * 8192, R, C); const int Rb = Epi::PERM ? ((R & ~31) + perm32(R & 31)) : R;
        const int Ra = Epi::AMAP ? (126 * (R >> 6) + 8 * (R & 15) + ((R >> 4) & 3)) : R;
        voffA[i] = (unsigned)(Ra * K + C) * 2u; voffB[i] = (unsigned)(Rb * K + C) * 2u; }
    const size_t kstep = (size_t)(BK * 2);
    const size_t hstepB = (size_t)HALF * K * 2;
    const size_t hstepA = Epi::AMAP ? (size_t)4 * K * 2 : hstepB;
    const size_t tstep = 2 * hstepB;
#define PG8_ABASE(pm_) (Epi::AMAP ? (long)((long)((pm_) / 33) * SEQ + 252 * ((pm_) % 33) - 2) * (long)K * 2 : (long)(pm_) * (long)tstep)
    const unsigned ldsw = (unsigned)wid * 1024u;
    const int aoff = lds_byte(wr * 64 + fr, fq * 8), boff = lds_byte(wc * 32 + fr, fq * 8);
#define PG8_SA(b, h) (((b) * 2 + (h)) * HTB)
#define PG8_SB(b, h) ((4 + (b) * 2 + (h)) * HTB)
#define PG8_STAGE(bufoff, gbase, voff) do { _Pragma("unroll") for (int _i = 0; _i < 2; ++_i) \
        __builtin_amdgcn_global_load_lds((const unsigned*)((const char*)(gbase) + (voff)[_i]), (PG8_LAS unsigned*)(lds + (bufoff) + ldsw + _i * 8192), 16, 0, 0); } while (0)
#define PG8_LDA(dst, b, h) do { _Pragma("unroll") for (int m = 0; m < 4; ++m) _Pragma("unroll") for (int k = 0; k < 2; ++k) dst[m][k] = *(const PG8_LAS bf16x8*)(lds + PG8_SA(b, h) + aoff + m * 2048 + k * 1024); } while (0)
#define PG8_LDB(dst, b, h) do { _Pragma("unroll") for (int n = 0; n < 2; ++n) _Pragma("unroll") for (int k = 0; k < 2; ++k) dst[n][k] = *(const PG8_LAS bf16x8*)(lds + PG8_SB(b, h) + boff + n * 2048 + k * 1024); } while (0)
#define PG8_MMA(ai, bj, At, Bt) do { __builtin_amdgcn_s_setprio(1); _Pragma("unroll") for (int m = 0; m < 4; ++m) _Pragma("unroll") for (int n = 0; n < 2; ++n) _Pragma("unroll") for (int k = 0; k < 2; ++k) \
        acc[ai][bj][m][n] = __builtin_amdgcn_mfma_f32_16x16x32_bf16(Bt[n][k], At[m][k], acc[ai][bj][m][n], 0, 0, 0); __builtin_amdgcn_s_setprio(0); } while (0)
#define PG8_WAIT_V(n) asm volatile("s_waitcnt vmcnt(" #n ")" ::: "memory")
#define PG8_WAIT_L(n) asm volatile("s_waitcnt lgkmcnt(" #n ")" ::: "memory")
#define PG8_BAR __builtin_amdgcn_s_barrier()
#define PG8_SCHED __builtin_amdgcn_sched_barrier(0)
    Unit cur, nxt; int ui = 0;
    if (!S.next(0, cur)) return;
    f32x4 acc[2][2][4][2];
#pragma unroll
    for (int a = 0; a < 2; ++a)
#pragma unroll
        for (int b = 0; b < 2; ++b)
#pragma unroll
            for (int m = 0; m < 4; ++m)
#pragma unroll
                for (int n = 0; n < 2; ++n) acc[a][b][m][n] = (f32x4){0.f, 0.f, 0.f, 0.f};
    bf16x8 At[4][2], B0[2][2], B1[2][2];
    const char* cA = (const char*)g.A + PG8_ABASE(cur.pm); const char* cB = (const char*)g.Bt + (size_t)cur.pn * tstep;
    S.a_ready(cur);
    if constexpr (SP2) {
        PG8_STAGE(PG8_SB(0, 0), cB, voffB); PG8_STAGE(PG8_SB(0, 1), cB + hstepB, voffB); PG8_STAGE(PG8_SA(0, 0), cA, voffA); PG8_STAGE(PG8_SA(0, 1), cA + hstepA, voffA);
        if (wr == 1) PG8_BAR;
        PG8_WAIT_V(2); PG8_BAR;
        PG8_STAGE(PG8_SB(1, 0), cB + kstep, voffB); PG8_STAGE(PG8_SA(1, 0), cA + kstep, voffA); PG8_STAGE(PG8_SB(1, 1), cB + hstepB + kstep, voffB);
        PG8_WAIT_V(6); PG8_BAR;
    } else {
        PG8_STAGE(PG8_SB(0, 0), cB, voffB); PG8_STAGE(PG8_SA(0, 0), cA, voffA); PG8_STAGE(PG8_SB(0, 1), cB + hstepB, voffB); PG8_STAGE(PG8_SA(0, 1), cA + hstepA, voffA);
        if (wr == 1) PG8_BAR;
        PG8_WAIT_V(4); PG8_BAR;
        PG8_STAGE(PG8_SB(1, 0), cB + kstep, voffB); PG8_STAGE(PG8_SA(1, 0), cA + kstep, voffA); PG8_STAGE(PG8_SB(1, 1), cB + hstepB + kstep, voffB);
        PG8_WAIT_V(6); PG8_BAR;
    }
    for (;;) {
        const bool has_next = S.next(ui + 1, nxt);
        const char* nA = has_next ? (const char*)g.A + PG8_ABASE(nxt.pm) : cA; const char* nB = has_next ? (const char*)g.Bt + (size_t)nxt.pn * tstep : cB;
        for (int t = 0; t < nt; t += 2) {
            const bool last = (t == nt - 2);
            const char* a1 = cA + (size_t)(t + 1) * kstep;
            const char* a2 = last ? nA : cA + (size_t)(t + 2) * kstep; const char* b2 = last ? nB : cB + (size_t)(t + 2) * kstep;
            const char* a3 = a2 + kstep; const char* b3 = b2 + kstep;
            if (last && has_next) S.a_ready(nxt);
            if constexpr (SP2) {
            PG8_LDB(B0, 0, 0); PG8_LDB(B1, 0, 1); PG8_SCHED; PG8_LDA(At, 0, 0); PG8_STAGE(PG8_SA(1, 1), a1 + hstepA, voffA);
            PG8_WAIT_V(8); PG8_WAIT_L(0); PG8_BAR; PG8_MMA(0, 0, At, B0); PG8_MMA(0, 1, At, B1); PG8_BAR; PG8_SCHED;
            PG8_LDA(At, 0, 1); PG8_STAGE(PG8_SB(0, 0), b2, voffB); PG8_STAGE(PG8_SB(0, 1), b2 + hstepB, voffB); PG8_STAGE(PG8_SA(0, 0), a2, voffA);
            PG8_WAIT_V(8); PG8_WAIT_L(0); PG8_BAR; PG8_MMA(1, 0, At, B0); PG8_MMA(1, 1, At, B1); PG8_BAR; PG8_SCHED;
            PG8_LDB(B0, 1, 0); PG8_LDB(B1, 1, 1); PG8_SCHED; PG8_LDA(At, 1, 0); PG8_STAGE(PG8_SA(0, 1), a2 + hstepA, voffA);
            PG8_WAIT_V(8); PG8_WAIT_L(0); PG8_BAR; PG8_MMA(0, 0, At, B0); PG8_MMA(0, 1, At, B1); PG8_BAR; PG8_SCHED;
            PG8_LDA(At, 1, 1); PG8_STAGE(PG8_SB(1, 0), b3, voffB); PG8_STAGE(PG8_SB(1, 1), b3 + hstepB, voffB); PG8_STAGE(PG8_SA(1, 0), a3, voffA);
            PG8_WAIT_V(8); PG8_WAIT_L(0); PG8_BAR; PG8_MMA(1, 0, At, B0); PG8_MMA(1, 1, At, B1); PG8_BAR; PG8_SCHED;
            } else {
            PG8_LDB(B0, 0, 0); PG8_SCHED; PG8_LDA(At, 0, 0); PG8_STAGE(PG8_SA(1, 1), a1 + hstepA, voffA);
            PG8_WAIT_L(8); PG8_BAR; PG8_WAIT_L(0); PG8_MMA(0, 0, At, B0); PG8_BAR; PG8_SCHED;
            PG8_LDB(B1, 0, 1); PG8_STAGE(PG8_SB(0, 0), b2, voffB);
            PG8_BAR; PG8_WAIT_L(0); PG8_MMA(0, 1, At, B1); PG8_BAR;
            PG8_LDA(At, 0, 1); PG8_STAGE(PG8_SA(0, 0), a2, voffA);
            PG8_BAR; PG8_WAIT_L(0); PG8_MMA(1, 0, At, B0); PG8_BAR; PG8_SCHED;
            PG8_STAGE(PG8_SB(0, 1), b2 + hstepB, voffB);
            PG8_WAIT_V(6); PG8_BAR; PG8_MMA(1, 1, At, B1); PG8_BAR;
            PG8_LDB(B0, 1, 0); PG8_SCHED; PG8_LDA(At, 1, 0); PG8_STAGE(PG8_SA(0, 1), a2 + hstepA, voffA);
            PG8_WAIT_L(8); PG8_BAR; PG8_WAIT_L(0); PG8_MMA(0, 0, At, B0); PG8_BAR; PG8_SCHED;
            PG8_LDB(B1, 1, 1); PG8_STAGE(PG8_SB(1, 0), b3, voffB);
            PG8_BAR; PG8_WAIT_L(0); PG8_MMA(0, 1, At, B1); PG8_BAR;
            PG8_LDA(At, 1, 1); PG8_STAGE(PG8_SA(1, 0), a3, voffA);
            PG8_BAR; PG8_WAIT_L(0); PG8_MMA(1, 0, At, B0); PG8_BAR; PG8_SCHED;
            PG8_STAGE(PG8_SB(1, 1), b3 + hstepB, voffB);
            PG8_WAIT_V(6); PG8_BAR; PG8_MMA(1, 1, At, B1); PG8_BAR;
            }
        }
        if constexpr (ALIGN_EPI) { if (wr == 0) PG8_BAR; }
        if constexpr (!Epi::AFTER_DRAIN) { E(acc, cur, wr, wc, fr, fq); S.done(cur); }
        if (!has_next) break;
#pragma unroll
        for (int a = 0; a < 2; ++a)
#pragma unroll
            for (int b = 0; b < 2; ++b)
#pragma unroll
                for (int m = 0; m < 4; ++m)
#pragma unroll
                    for (int n = 0; n < 2; ++n) acc[a][b][m][n] = (f32x4){0.f, 0.f, 0.f, 0.f};
        cur = nxt; cA = nA; cB = nB; ++ui;
        if constexpr (ALIGN_EPI) { if (wr == 1) PG8_BAR; }
    }
    PG8_WAIT_V(0);
    if constexpr (!ALIGN_EPI) { if (wr == 0) PG8_BAR; }
    PG8_BAR;
    if constexpr (Epi::AFTER_DRAIN) { E.fused(acc, cur, wr, wc, fr, fq, lds, wid, lane); S.done(cur); }
#undef PG8_ABASE
#undef PG8_SA
#undef PG8_SB
#undef PG8_STAGE
#undef PG8_LDA
#undef PG8_LDB
#undef PG8_MMA
#undef PG8_WAIT_V
#undef PG8_WAIT_L
#undef PG8_BAR
#undef PG8_SCHED
}
}

#ifndef PG8_SP2
#define PG8_SP2 true
#endif
#ifndef PG8_ALIGN
#define PG8_ALIGN true
#endif
#define GAS __attribute__((address_space(1)))
#define LAS __attribute__((address_space(3)))
typedef unsigned short bf16;
typedef unsigned v4u __attribute__((ext_vector_type(4)));
typedef float f32x4 __attribute__((ext_vector_type(4)));
typedef short bf16x8 __attribute__((ext_vector_type(8)));
typedef GAS unsigned gu32;
typedef GAS unsigned long long gu64;
#define RLX_AGENT __ATOMIC_RELAXED, __HIP_MEMORY_SCOPE_AGENT
#define LDS_WAIT() asm volatile("s_waitcnt lgkmcnt(0)" ::: "memory")
#define VM_WAIT() asm volatile("s_waitcnt vmcnt(0)" ::: "memory")
__device__ __forceinline__ unsigned long long rt() { return __builtin_amdgcn_s_memrealtime(); }

#define XB_TMO      128
#define XB_XCNT(j)  (256  + 64 * (j))
#define XB_XSUB(j)  (1280 + 64 * (j))
#define XB_XGEN(j)  (2304 + 64 * (j))
#define XB_TOP      3328
#define XB_TOPGEN   3392
#define XCD_BAR_WORDS 3456
#define XB_SPIN_CAP (1u << 20)

__device__ __forceinline__ unsigned xb_ld(unsigned* p)              { return __hip_atomic_load(p, __ATOMIC_RELAXED, __HIP_MEMORY_SCOPE_AGENT); }
__device__ __forceinline__ unsigned xb_add(unsigned* p, unsigned v) { return __hip_atomic_fetch_add(p, v, __ATOMIC_RELAXED, __HIP_MEMORY_SCOPE_AGENT); }
__device__ __forceinline__ unsigned xb_xcc_id() { return (unsigned)__builtin_amdgcn_s_getreg((3 << 11) | 20) & 0xFu; }
#define XB_SPIN(cond, bar) do { unsigned _sp = 0; while (cond) { __builtin_amdgcn_s_sleep(1); \
    if ((++_sp & 255u) == 0u) { if (xb_ld(&(bar)[XB_TMO])) break; if (_sp > XB_SPIN_CAP) { atomicAdd(&(bar)[XB_TMO], 1u); break; } } } } while (0)

struct XcdBarrier {
    unsigned* bar; unsigned x;
    volatile LAS unsigned* st;
};

__device__ __forceinline__ XcdBarrier xcd_barrier_post(unsigned* bar, volatile LAS unsigned* st) {
    XcdBarrier b; b.bar = bar; b.x = xb_xcc_id(); b.st = st;
    if (threadIdx.x == 0) (void)xb_add(&bar[XB_XCNT(b.x)], 1u);
    return b;
}
__device__ __forceinline__ void xcd_barrier_complete(unsigned* bar, unsigned x, unsigned& nloc, unsigned& nx) {
    const unsigned G = gridDim.x * gridDim.y * gridDim.z;
    unsigned sum, cnt, mine, sp = 0u;
    for (;;) {
        sum = 0u; cnt = 0u; mine = 0u;
#pragma unroll
        for (unsigned j = 0; j < 16; ++j) { const unsigned c = xb_ld(&bar[XB_XCNT(j)]); sum += c; cnt += (c > 0u) ? 1u : 0u; mine = (j == x) ? c : mine; }
        if (sum == G) break;
        __builtin_amdgcn_s_sleep(1);
        if ((++sp & 255u) == 0u) { if (xb_ld(&bar[XB_TMO])) break; if (sp > XB_SPIN_CAP) { atomicAdd(&bar[XB_TMO], 1u); break; } }
    }
    nloc = mine > 0u ? mine : 1u; nx = cnt > 0u ? cnt : 1u;
}

__device__ __forceinline__ void xcd_barrier(const XcdBarrier& b) {
    asm volatile("s_waitcnt vmcnt(0)" ::: "memory");
    __syncthreads();
    if (threadIdx.x == 0) {
        unsigned* bar = b.bar;
        __builtin_amdgcn_s_waitcnt(0);
        unsigned nloc = b.st[0], nx = b.st[1];
        if (nloc == 0u) { xcd_barrier_complete(bar, b.x, nloc, nx); b.st[0] = nloc; b.st[1] = nx; }
        const unsigned old = xb_add(&bar[XB_XSUB(b.x)], 1u);
        const unsigned gen = old / nloc;
        if (old + 1u == (gen + 1u) * nloc) {
            __builtin_amdgcn_fence(__ATOMIC_RELEASE, "agent");
            asm volatile("s_waitcnt vmcnt(0)" ::: "memory");
            const unsigned og = xb_add(&bar[XB_TOP], 1u);
            const unsigned tg = og / nx;
            if (og + 1u == (tg + 1u) * nx) xb_add(&bar[XB_TOPGEN], 1u);
            else XB_SPIN(xb_ld(&bar[XB_TOPGEN]) == tg, bar);
            __builtin_amdgcn_fence(__ATOMIC_ACQUIRE, "agent");
            xb_add(&bar[XB_XGEN(b.x)], 1u);
            asm volatile("s_waitcnt vmcnt(0)" ::: "memory");
        } else {
            XB_SPIN(xb_ld(&bar[XB_XGEN(b.x)]) == gen, bar);
            __builtin_amdgcn_fence(__ATOMIC_ACQUIRE, "agent");
            asm volatile("s_waitcnt vmcnt(0)" ::: "memory");
        }
    }
    __syncthreads();
}

namespace rw {
constexpr int LD = 72;
constexpr int MATB = 64 * LD * 2;
constexpr int OFF_F0 = 12 * MATB  , OFF_TMP = OFF_F0 + 64 * 65 * 4  ;
constexpr int OFF_TW = 8 * MATB  , OFF_TA = OFF_TW + 5120, OFF_TV = OFF_TA + 5120, OFF_WP = OFF_TV + 5120  , OFF_AP = OFF_WP + 16640, OFF_VP = OFF_AP + 16640;
constexpr int OFF_TOT = 139264, OFF_GC = OFF_TOT + 2048, OFF_RN = OFF_GC + 256, OFF_END = OFF_RN + 256;
constexpr int NITEMS = BATCH * 6 * (SEQ / 64);
__device__ __forceinline__ int sigpos(int c) { return (c & 32) + 8 * ((c >> 2) & 3) + 4 * ((c >> 4) & 1) + (c & 3); }
#define RW_BAR() do { asm volatile("s_waitcnt vmcnt(0) lgkmcnt(0)" ::: "memory"); __builtin_amdgcn_s_barrier(); asm volatile("" ::: "memory"); } while (0)
__device__ __forceinline__ f32x4 mm_tile(const LAS bf16_t* A, const LAS bf16_t* Bt, int ti, int tj, int fr, int fq, f32x4 acc) {
#pragma unroll
    for (int kk = 0; kk < 2; ++kk) {
        const bf16x8 a = *(const LAS bf16x8*)(A + (16 * ti + fr) * LD + 32 * kk + 8 * fq);
        const bf16x8 b = *(const LAS bf16x8*)(Bt + (16 * tj + fr) * LD + 32 * kk + 8 * fq);
        acc = __builtin_amdgcn_mfma_f32_16x16x32_bf16(a, b, acc, 0, 0, 0);
    }
    return acc;
}
__device__ __forceinline__ unsigned pk2(float lo, float hi) { return (unsigned)f2bf(lo) | ((unsigned)f2bf(hi) << 16); }
struct ChunkBufs { bf16_t* PT; bf16_t* G; float* Z; float* YV; bf16_t* S0; bf16_t* VOUT; float* DOT; const bf16_t *W2T, *A2T, *V2T, *G2T; };

#define RW_LANES() int lt_ = tid_in; asm volatile("" : "+v"(lt_)); const int tid = lt_, lane = lt_ & 63, fr = lane & 15, fq = lane >> 4; (void)tid; (void)fr; (void)fq
__device__ __forceinline__ void chunk_phase(LAS unsigned char* L, const bf16_t* P, const sk::RwkvW W, int layer, const bf16_t* VFIRST, const ChunkBufs cb, int tid_in, int first, int stride) {
    const int w = __builtin_amdgcn_readfirstlane(tid_in >> 6);
    LAS bf16_t* B0 = (LAS bf16_t*)(L + 0 * MATB); LAS bf16_t* B1 = (LAS bf16_t*)(L + 1 * MATB); LAS bf16_t* B2 = (LAS bf16_t*)(L + 2 * MATB); LAS bf16_t* B3 = (LAS bf16_t*)(L + 3 * MATB);
    LAS bf16_t* B4 = (LAS bf16_t*)(L + 4 * MATB); LAS bf16_t* B5 = (LAS bf16_t*)(L + 5 * MATB); LAS bf16_t* B6 = (LAS bf16_t*)(L + 6 * MATB); LAS bf16_t* B7 = (LAS bf16_t*)(L + 7 * MATB);
    LAS bf16_t* B8 = (LAS bf16_t*)(L + 8 * MATB); LAS bf16_t* B9 = (LAS bf16_t*)(L + 9 * MATB); LAS bf16_t* B10 = (LAS bf16_t*)(L + 10 * MATB); LAS bf16_t* B11 = (LAS bf16_t*)(L + 11 * MATB);
    LAS float* F0 = (LAS float*)(L + OFF_F0); LAS float* TMP = (LAS float*)(L + OFF_TMP);
    LAS bf16_t* TW = (LAS bf16_t*)(L + OFF_TW); LAS bf16_t* TA = (LAS bf16_t*)(L + OFF_TA); LAS bf16_t* TV = (LAS bf16_t*)(L + OFF_TV);
    LAS float* WP = (LAS float*)(L + OFF_WP); LAS float* AP = (LAS float*)(L + OFF_AP); LAS float* VP = (LAS float*)(L + OFF_VP);
    LAS float* TOT = (LAS float*)(L + OFF_TOT); LAS float* GC = (LAS float*)(L + OFF_GC); LAS float* RN = (LAS float*)(L + OFF_RN);
    for (int item = first; item < NITEMS; item += stride) {
        const int bh = item / (SEQ / 64), chunk = item % (SEQ / 64), b = bh / 6, h = bh % 6;
        const int tok0 = b * SEQ + chunk * 64;
        { RW_LANES(); const int t = tid >> 3, sub = tid & 7, tok = tok0 + t;
#pragma unroll
          for (int e = 0; e < 4; ++e) { const int j = 4 * sub + e;
              TW[t * 40 + j] = f2bf(tanhf(sk::shifted(P, tok, 640 + 1152 + j, W.mu[1152 + j])));
              TA[t * 40 + j] = f2bf(sk::shifted(P, tok, 640 + 1184 + j, W.mu[1184 + j])); }
          if (layer > 0) {
#pragma unroll
              for (int e = 0; e < 2; ++e) { const int j = 2 * sub + e; TV[t * 40 + j] = f2bf(sk::shifted(P, tok, 2176 + j, W.mu_v[j])); TV[t * 40 + 16 + j] = 0; } }
          float s = 0.f;
#pragma unroll
          for (int e = 0; e < 8; ++e) { const int hc = 64 * h + 8 * sub + e; const float kc = sk::shifted(P, tok, 640 + 384 + hc, W.mu[384 + hc]) * W.k_k[hc]; s += kc * kc; }
          s += __shfl_xor(s, 1); s += __shfl_xor(s, 2); s += __shfl_xor(s, 4);
          if (sub == 0) RN[t] = 1.0f / fmaxf(sqrtf(s), 1e-12f); }
        RW_BAR();
        { RW_LANES();
#pragma unroll
        for (int e = 0; e < 2; ++e) { const int tl = 2 * w + e, ti = tl >> 2, tj = tl & 3; const f32x4 z4 = {0.f, 0.f, 0.f, 0.f};
            const size_t brow = (size_t)(64 * h + 16 * tj + fr) * 32 + 8 * fq;
            { const bf16x8 a = *(const LAS bf16x8*)(TW + (16 * ti + fr) * 40 + 8 * fq); const bf16x8 bb = *(const GAS bf16x8*)(cb.W2T + brow);
              const f32x4 d = __builtin_amdgcn_mfma_f32_16x16x32_bf16(a, bb, z4, 0, 0, 0);
#pragma unroll
              for (int r = 0; r < 4; ++r) WP[(16 * ti + 4 * fq + r) * 65 + 16 * tj + fr] = d[r]; }
            { const bf16x8 a = *(const LAS bf16x8*)(TA + (16 * ti + fr) * 40 + 8 * fq); const bf16x8 bb = *(const GAS bf16x8*)(cb.A2T + brow);
              const f32x4 d = __builtin_amdgcn_mfma_f32_16x16x32_bf16(a, bb, z4, 0, 0, 0);
#pragma unroll
              for (int r = 0; r < 4; ++r) AP[(16 * ti + 4 * fq + r) * 65 + 16 * tj + fr] = d[r]; }
            if (layer > 0) { const bf16x8 a = *(const LAS bf16x8*)(TV + (16 * ti + fr) * 40 + 8 * fq); const bf16x8 bb = *(const GAS bf16x8*)(cb.V2T + brow);
              const f32x4 d = __builtin_amdgcn_mfma_f32_16x16x32_bf16(a, bb, z4, 0, 0, 0);
#pragma unroll
              for (int r = 0; r < 4; ++r) VP[(16 * ti + 4 * fq + r) * 65 + 16 * tj + fr] = d[r]; } } }
        RW_BAR();
        { RW_LANES(); const int c = lane, hc = 64 * h + c, tq0 = 8 * w, tk0 = tok0 + tq0;
          const float mu_r = W.mu[hc], mu_k = W.mu[384 + hc], mu_v = W.mu[768 + hc], w0 = W.w0[hc], a0 = W.a0[hc], k_k = W.k_k[hc], k_a = W.k_a[hc], r_k = W.r_k[hc];
          const float v0 = layer > 0 ? W.v0[hc] : 0.f;
          const bool has_prev = (chunk * 64 + tq0) > 0;
          float pr = has_prev ? bf2f(P[(size_t)(tk0 - 1) * LDP + 640 + hc]) : 0.f, pk = has_prev ? bf2f(P[(size_t)(tk0 - 1) * LDP + 1024 + hc]) : 0.f, pv = has_prev ? bf2f(P[(size_t)(tk0 - 1) * LDP + 1408 + hc]) : 0.f;
          float rr[8], kq[8], vv[8], kkc[8], bb[8], ld[8];
#pragma unroll
          for (int j = 0; j < 8; ++j) { const int t = tq0 + j; const size_t row = (size_t)(tk0 + j) * LDP;
              const float cr = bf2f(P[row + 640 + hc]), ck = bf2f(P[row + 1024 + hc]), cv = bf2f(P[row + 1408 + hc]);
              const float r = cr + mu_r * (pr - cr), k = ck + mu_k * (pk - ck); float v = cv + mu_v * (pv - cv); pr = cr; pk = ck; pv = cv;
              const float wp = w0 + WP[t * 65 + c], ap = a0 + AP[t * 65 + c];
              const float z = -wp, sp = fmaxf(z, 0.f) + log1pf(expf(-fabsf(z))); const float wl = -sp - 0.5f;
              const float al = 1.0f / (1.0f + expf(-ap));
              if (layer > 0) { const float vp = v0 + VP[t * 65 + c]; const float vf = bf2f(VFIRST[(size_t)(tk0 + j) * 384 + hc]); v = v + (vf - v) * (1.0f / (1.0f + expf(-vp))); }
              const float kn = k * k_k * RN[t]; const float k2 = k * (1.0f + (al - 1.0f) * k_a);
              rr[j] = bf2f(f2bf(r)); kq[j] = bf2f(f2bf(k2)); vv[j] = bf2f(f2bf(v)); kkc[j] = bf2f(f2bf(kn)); bb[j] = bf2f(f2bf(kn * al)); ld[j] = bf2f(f2bf(-expf(wl)));
              cb.VOUT[(size_t)(tk0 + j) * 384 + hc] = f2bf(v);
              float dsum = rr[j] * kq[j] * r_k;
#pragma unroll
              for (int o = 1; o < 64; o <<= 1) dsum += __shfl_xor(dsum, o);
              if (lane == 0) cb.DOT[(size_t)(tk0 + j) * 6 + h] = dsum; }
          float cl[8]; cl[0] = ld[0];
#pragma unroll
          for (int j = 1; j < 8; ++j) cl[j] = cl[j - 1] + ld[j];
          TOT[w * 64 + c] = cl[7];
          RW_BAR();
          float prefix = 0.f, cumC = 0.f;
#pragma unroll
          for (int ww = 0; ww < 8; ++ww) { const float tv = TOT[ww * 64 + c]; cumC += tv; if (ww < w) prefix += tv; }
          if (w == 0) GC[c] = expf(cumC);
          unsigned ahp[4], btp[4], ktp[4], vp4[4];
#pragma unroll
          for (int j = 0; j < 8; ++j) { const int t = tq0 + j; const float cum = prefix + cl[j], cump = cum - ld[j];
              const float g = expf(cum), gp = expf(cump), ig = expf(-cum), gc = expf(cumC - cum);
              const bf16_t ah = f2bf(-kkc[j] * gp), rh = f2bf(rr[j] * g), bh = f2bf(bb[j] * ig), kh = f2bf(kq[j] * ig), bt = f2bf(bb[j] * gc), kt = f2bf(kq[j] * gc), vb = f2bf(vv[j]);
              B0[t * LD + c] = ah; B1[t * LD + c] = rh; B2[t * LD + c] = bh; B3[t * LD + c] = kh;
              if (j & 1) { ahp[j >> 1] |= (unsigned)ah << 16; btp[j >> 1] |= (unsigned)bt << 16; ktp[j >> 1] |= (unsigned)kt << 16; vp4[j >> 1] |= (unsigned)vb << 16; }
              else { ahp[j >> 1] = ah; btp[j >> 1] = bt; ktp[j >> 1] = kt; vp4[j >> 1] = vb; } }
          *(LAS v4u*)(B4 + c * LD + tq0) = (v4u){ahp[0], ahp[1], ahp[2], ahp[3]}; *(LAS v4u*)(B5 + c * LD + tq0) = (v4u){btp[0], btp[1], btp[2], btp[3]};
          *(LAS v4u*)(B6 + c * LD + tq0) = (v4u){ktp[0], ktp[1], ktp[2], ktp[3]}; *(LAS v4u*)(B7 + c * LD + tq0) = (v4u){vp4[0], vp4[1], vp4[2], vp4[3]}; }
        RW_BAR();
        { RW_LANES(); const int prod = w >> 1; const LAS bf16_t* Aop = prod < 2 ? B0 : B1; const LAS bf16_t* Bop = (prod & 1) ? B3 : B2;
#pragma unroll
          for (int e = 0; e < 8; ++e) { const int tl = (w & 1) * 8 + e, ti = tl >> 2, tj = tl & 3; f32x4 d = {0.f, 0.f, 0.f, 0.f};
              if (tj <= ti) d = mm_tile(Aop, Bop, ti, tj, fr, fq, d);
#pragma unroll
              for (int r = 0; r < 4; ++r) { const int t = 16 * ti + 4 * fq + r, i = 16 * tj + fr; const bool keep = prod < 2 ? (i < t) : (i <= t); const float val = (tj <= ti && keep) ? d[r] : 0.f;
                  if (prod == 0) F0[t * 65 + i] = val; else if (prod == 1) B8[t * LD + i] = f2bf(val); else if (prod == 2) B9[t * LD + i] = f2bf(val); else B10[t * LD + i] = f2bf(val); } } }
        RW_BAR();
        if (w == 0) { RW_LANES();
            const int blk = lane >> 4, jc = lane & 15; const LAS float* Lb = F0 + (16 * blk) * 65 + 16 * blk; float tc[16];
#pragma unroll
            for (int r = 0; r < 16; ++r) { float val = (r == jc) ? 1.f : 0.f;
#pragma unroll
                for (int i = 0; i < r; ++i) val += Lb[r * 65 + i] * tc[i];
                tc[r] = val; }
            asm volatile("s_waitcnt lgkmcnt(0)" ::: "memory");
#pragma unroll
            for (int r = 0; r < 16; ++r) F0[(16 * blk + r) * 65 + 16 * blk + jc] = tc[r];
        }
        RW_BAR();
        if (w < 2) { RW_LANES();
            const int o1 = 32 * w, o2 = 32 * w + 16; f32x4 d = {0.f, 0.f, 0.f, 0.f};
#pragma unroll
            for (int ks = 0; ks < 4; ++ks) d = __builtin_amdgcn_mfma_f32_16x16x4f32(F0[(o2 + fr) * 65 + o1 + 4 * ks + fq], F0[(o1 + 4 * ks + fq) * 65 + o1 + fr], d, 0, 0, 0);
            LAS float* tm = TMP + w * 16 * 17;
#pragma unroll
            for (int r = 0; r < 4; ++r) tm[(4 * fq + r) * 17 + fr] = d[r];
            asm volatile("s_waitcnt lgkmcnt(0)" ::: "memory");
            f32x4 d2 = {0.f, 0.f, 0.f, 0.f};
#pragma unroll
            for (int ks = 0; ks < 4; ++ks) d2 = __builtin_amdgcn_mfma_f32_16x16x4f32(F0[(o2 + fr) * 65 + o2 + 4 * ks + fq], tm[(4 * ks + fq) * 17 + fr], d2, 0, 0, 0);
            asm volatile("s_waitcnt lgkmcnt(0)" ::: "memory");
#pragma unroll
            for (int r = 0; r < 4; ++r) F0[(o2 + 4 * fq + r) * 65 + o1 + fr] = d2[r];
        }
        RW_BAR();
        if (w < 4) { RW_LANES();
            const int ti = w >> 1, tj = w & 1; f32x4 d = {0.f, 0.f, 0.f, 0.f};
#pragma unroll
            for (int ks = 0; ks < 8; ++ks) d = __builtin_amdgcn_mfma_f32_16x16x4f32(F0[(32 + 16 * ti + fr) * 65 + 4 * ks + fq], F0[(4 * ks + fq) * 65 + 16 * tj + fr], d, 0, 0, 0);
#pragma unroll
            for (int r = 0; r < 4; ++r) TMP[(16 * ti + 4 * fq + r) * 33 + 16 * tj + fr] = d[r];
        }
        RW_BAR();
        if (w < 4) { RW_LANES();
            const int ti = w >> 1, tj = w & 1; f32x4 d = {0.f, 0.f, 0.f, 0.f};
#pragma unroll
            for (int ks = 0; ks < 8; ++ks) d = __builtin_amdgcn_mfma_f32_16x16x4f32(F0[(32 + 16 * ti + fr) * 65 + 32 + 4 * ks + fq], TMP[(4 * ks + fq) * 33 + 16 * tj + fr], d, 0, 0, 0);
#pragma unroll
            for (int r = 0; r < 4; ++r) F0[(32 + 16 * ti + 4 * fq + r) * 65 + 16 * tj + fr] = d[r];
        }
        RW_BAR();
        { RW_LANES(); const int t = tid >> 3, i0 = (tid & 7) * 8;
#pragma unroll
          for (int e = 0; e < 8; ++e) B11[t * LD + i0 + e] = f2bf(F0[t * 65 + i0 + e]); }
        RW_BAR();
        { RW_LANES();
#pragma unroll
        for (int e = 0; e < 4; ++e) { const int tl = 4 * w + e, prod = tl >> 4, ti = (tl >> 2) & 3, tj = tl & 3; f32x4 d = {0.f, 0.f, 0.f, 0.f};
            d = prod == 0 ? mm_tile(B11, B4, ti, tj, fr, fq, d) : mm_tile(B8, B7, ti, tj, fr, fq, d);
            LAS bf16_t* dst = (prod == 0 ? B0 : B2) + (16 * tj + fr) * LD + 16 * ti + 4 * fq;
            *(LAS unsigned long long*)dst = (unsigned long long)pk2(d[0], d[1]) | ((unsigned long long)pk2(d[2], d[3]) << 32); } }
        RW_BAR();
        { RW_LANES();
#pragma unroll
        for (int e = 0; e < 2; ++e) { const int tl = 2 * w + e, ti = tl >> 2, tj = tl & 3; f32x4 d = {0.f, 0.f, 0.f, 0.f};
            d = mm_tile(B11, B2, ti, tj, fr, fq, d);
            LAS bf16_t* dst = B3 + (16 * tj + fr) * LD + 16 * ti + 4 * fq;
            *(LAS unsigned long long*)dst = (unsigned long long)pk2(d[0], d[1]) | ((unsigned long long)pk2(d[2], d[3]) << 32); } }
        RW_BAR();
        { RW_LANES();
#pragma unroll
        for (int e = 0; e < 8; ++e) { const int tl = 8 * w + e, prod = tl >> 4, ti = (tl >> 2) & 3, tj = tl & 3; f32x4 d = {0.f, 0.f, 0.f, 0.f};
            if (prod == 0) { d = mm_tile(B5, B3, ti, tj, fr, fq, d); d = mm_tile(B6, B7, ti, tj, fr, fq, d);
                *(GAS f32x4*)(cb.Z + (size_t)item * 4096 + (16 * tj + fr) * 64 + 16 * ti + 4 * fq) = d; }
            else if (prod == 1) { d = mm_tile(B9, B3, ti, tj, fr, fq, d); d = mm_tile(B10, B7, ti, tj, fr, fq, d);
                *(GAS f32x4*)(cb.YV + (size_t)item * 4096 + (16 * tj + fr) * 64 + 16 * ti + 4 * fq) = d; }
            else if (prod == 2) { d = mm_tile(B9, B0, ti, tj, fr, fq, d);
#pragma unroll
                for (int r = 0; r < 4; ++r) { const int t = 16 * ti + 4 * fq + r, c = 16 * tj + fr; B4[t * LD + sigpos(c)] = f2bf(d[r] + bf2f(B1[t * LD + c])); } }
            else { d = mm_tile(B5, B0, ti, tj, fr, fq, d);
#pragma unroll
                for (int r = 0; r < 4; ++r) { const int c = 16 * ti + 4 * fq + r, c2 = 16 * tj + fr; B8[c * LD + sigpos(c2)] = f2bf(d[r] + (c == c2 ? GC[c] : 0.f)); } } } }
        RW_BAR();
        { RW_LANES(); const int r = tid >> 3, ch = (tid & 7) * 8;
          *(GAS v4u*)(cb.G + (size_t)item * 4096 + r * 64 + ch) = *(const LAS v4u*)(B4 + r * LD + ch);
          *(GAS v4u*)(cb.PT + (size_t)item * 4096 + r * 64 + ch) = *(const LAS v4u*)(B8 + r * LD + ch); }
        RW_BAR();
    }
}
__device__ __forceinline__ void scan_phase(const ChunkBufs cb, int bh, int tj, int lane, volatile LAS unsigned* prog) {
    const int fr = lane & 15, fq = lane >> 4; const int NC = SEQ / 64;
    bf16x8 Bf0 = {0, 0, 0, 0, 0, 0, 0, 0}, Bf1 = {0, 0, 0, 0, 0, 0, 0, 0};
    const size_t ib0 = (size_t)(bh * NC) * 4096;
    const bf16_t* pt = cb.PT + ib0 + fr * 64 + 8 * fq; const float* zz = cb.Z + ib0 + (16 * tj + fr) * 64 + 4 * fq; bf16_t* s0 = cb.S0 + ib0 + (16 * tj + fr) * 64 + 8 * fq;
    bf16x8 a0[4], a1[4]; f32x4 z[4];
#pragma unroll
    for (int ti = 0; ti < 4; ++ti) { a0[ti] = *(const GAS bf16x8*)(pt + ti * 1024); a1[ti] = *(const GAS bf16x8*)(pt + ti * 1024 + 32); z[ti] = *(const GAS f32x4*)(zz + 16 * ti); }
    for (int chunk = 0; chunk < NC; ++chunk) {
        if (tj == 0 && lane == 0) prog[0] = (unsigned)chunk;
        const int nx = chunk + 1 < NC ? chunk + 1 : chunk;
        bf16x8 n0[4], n1[4]; f32x4 nz[4];
#pragma unroll
        for (int ti = 0; ti < 4; ++ti) { n0[ti] = *(const GAS bf16x8*)(pt + (size_t)nx * 4096 + ti * 1024); n1[ti] = *(const GAS bf16x8*)(pt + (size_t)nx * 4096 + ti * 1024 + 32); nz[ti] = *(const GAS f32x4*)(zz + (size_t)nx * 4096 + 16 * ti); }
        *(GAS bf16x8*)(s0 + (size_t)chunk * 4096) = Bf0; *(GAS bf16x8*)(s0 + (size_t)chunk * 4096 + 32) = Bf1;
        f32x4 acc[4];
#pragma unroll
        for (int ti = 0; ti < 4; ++ti) { acc[ti] = __builtin_amdgcn_mfma_f32_16x16x32_bf16(a0[ti], Bf0, z[ti], 0, 0, 0); acc[ti] = __builtin_amdgcn_mfma_f32_16x16x32_bf16(a1[ti], Bf1, acc[ti], 0, 0, 0); }
        v4u m0, m1;
        m0.x = pk2(acc[0][0], acc[0][1]); m0.y = pk2(acc[0][2], acc[0][3]); m0.z = pk2(acc[1][0], acc[1][1]); m0.w = pk2(acc[1][2], acc[1][3]);
        m1.x = pk2(acc[2][0], acc[2][1]); m1.y = pk2(acc[2][2], acc[2][3]); m1.z = pk2(acc[3][0], acc[3][1]); m1.w = pk2(acc[3][2], acc[3][3]);
        Bf0 = __builtin_bit_cast(bf16x8, m0); Bf1 = __builtin_bit_cast(bf16x8, m1);
#pragma unroll
        for (int ti = 0; ti < 4; ++ti) { a0[ti] = n0[ti]; a1[ti] = n1[ti]; z[ti] = nz[ti]; }
    }
}
__device__ __forceinline__ void scan_prefetch(const ChunkBufs cb, int bh, int pw, int lane, volatile LAS unsigned* prog) {
    const int NC = SEQ / 64, AHEAD = 8;
    const char* base = pw == 0 ? (const char*)(cb.PT + (size_t)(bh * NC) * 4096) : (const char*)(cb.Z + (size_t)(bh * NC) * 4096) + (pw - 1) * 8192;
    const size_t step = pw == 0 ? 8192 : 16384;
    for (int chunk = 0; chunk < NC; chunk += 8) {
        unsigned spins = 0;
        while ((int)prog[0] + AHEAD < chunk && ++spins < (1u << 16)) __builtin_amdgcn_s_sleep(8);
        const char* p = base + (size_t)chunk * step + lane * 128;
        unsigned t0, t1, t2, t3, t4, t5, t6, t7;
        asm volatile("global_load_dword %0, %8, off\n\tglobal_load_dword %1, %9, off\n\tglobal_load_dword %2, %10, off\n\tglobal_load_dword %3, %11, off\n\t"
                     "global_load_dword %4, %12, off\n\tglobal_load_dword %5, %13, off\n\tglobal_load_dword %6, %14, off\n\tglobal_load_dword %7, %15, off\n\ts_waitcnt vmcnt(0)"
                     : "=&v"(t0), "=&v"(t1), "=&v"(t2), "=&v"(t3), "=&v"(t4), "=&v"(t5), "=&v"(t6), "=&v"(t7)
                     : "v"(p), "v"(p + step), "v"(p + 2 * step), "v"(p + 3 * step), "v"(p + 4 * step), "v"(p + 5 * step), "v"(p + 6 * step), "v"(p + 7 * step) : "memory");
    }
    asm volatile("s_waitcnt vmcnt(0)" ::: "memory");
}
constexpr int O_SG = 0  , O_Y = 9216  , O_GT = O_Y + 16640  ;
__device__ __forceinline__ void out_phase(LAS unsigned char* L, const bf16_t* P, const sk::RwkvW W, const ChunkBufs cb, bf16_t* MIX, int tid_in, int first, int stride) {
    const int w = __builtin_amdgcn_readfirstlane(tid_in >> 6);
    LAS bf16_t* SG = (LAS bf16_t*)(L + O_SG); LAS float* Y = (LAS float*)(L + O_Y); LAS float* GT = (LAS float*)(L + O_GT);
    for (int item = first; item < NITEMS; item += stride) {
        const int bh = item / (SEQ / 64), chunk = item % (SEQ / 64), b = bh / 6, h = bh % 6; const int tok0 = b * SEQ + chunk * 64; const size_t ib = (size_t)item * 4096;
        { RW_LANES(); const int t = tid >> 3, sub = tid & 7;
#pragma unroll
          for (int e = 0; e < 8; ++e) { const int j = 8 * sub + e; SG[t * LD + j] = f2bf(1.0f / (1.0f + expf(-sk::shifted(P, tok0 + t, 640 + 1216 + j, W.mu[1216 + j])))); } }
        RW_BAR();
        { RW_LANES();
#pragma unroll
        for (int e = 0; e < 2; ++e) { const int tl = 2 * w + e, ti = tl >> 2, tj = tl & 3;
            f32x4 d = *(const GAS f32x4*)(cb.YV + ib + (16 * tj + fr) * 64 + 16 * ti + 4 * fq); f32x4 g = {0.f, 0.f, 0.f, 0.f};
#pragma unroll
            for (int kk = 0; kk < 2; ++kk) {
                const bf16x8 a = *(const GAS bf16x8*)(cb.G + ib + (16 * ti + fr) * 64 + 32 * kk + 8 * fq), bb = *(const GAS bf16x8*)(cb.S0 + ib + (16 * tj + fr) * 64 + 32 * kk + 8 * fq);
                d = __builtin_amdgcn_mfma_f32_16x16x32_bf16(a, bb, d, 0, 0, 0);
                const bf16x8 a2 = *(const LAS bf16x8*)(SG + (16 * ti + fr) * LD + 32 * kk + 8 * fq), b2 = *(const GAS bf16x8*)(cb.G2T + (size_t)(64 * h + 16 * tj + fr) * 64 + 32 * kk + 8 * fq);
                g = __builtin_amdgcn_mfma_f32_16x16x32_bf16(a2, b2, g, 0, 0, 0); }
#pragma unroll
            for (int r = 0; r < 4; ++r) { Y[(16 * ti + 4 * fq + r) * 65 + 16 * tj + fr] = d[r]; GT[(16 * ti + 4 * fq + r) * 65 + 16 * tj + fr] = g[r]; } } }
        RW_BAR();
        { RW_LANES(); const int t = tid >> 3, sub = tid & 7, tok = tok0 + t; float yv[8], s = 0.f;
#pragma unroll
          for (int e = 0; e < 8; ++e) { yv[e] = bf2f(f2bf(Y[t * 65 + 8 * sub + e])); s += yv[e]; }
          s += __shfl_xor(s, 1); s += __shfl_xor(s, 2); s += __shfl_xor(s, 4);
          const float mean = s * (1.0f / 64.0f); float q = 0.f;
#pragma unroll
          for (int e = 0; e < 8; ++e) { const float dd = yv[e] - mean; q += dd * dd; }
          q += __shfl_xor(q, 1); q += __shfl_xor(q, 2); q += __shfl_xor(q, 4);
          const float rstd = 1.0f / sqrtf(q * (1.0f / 64.0f) + GN_EPS), dot = cb.DOT[(size_t)tok * 6 + h];
          unsigned o[4];
#pragma unroll
          for (int e = 0; e < 8; e += 2) { float r2[2];
#pragma unroll
              for (int u = 0; u < 2; ++u) { const int v = 8 * sub + e + u, hc = 64 * h + v; const float yn = (yv[e + u] - mean) * rstd * W.ln_w[hc] + W.ln_b[hc];
                  r2[u] = (yn + dot * bf2f(cb.VOUT[(size_t)tok * 384 + hc])) * GT[t * 65 + v]; }
              o[e >> 1] = pk2(r2[0], r2[1]); }
          *(GAS v4u*)(MIX + (size_t)tok * DM + 384 + 64 * h + 8 * sub) = (v4u){o[0], o[1], o[2], o[3]}; }
        RW_BAR();
    }
}
}
namespace at {
constexpr int LDK = 72, LDV = 264;
constexpr int A_K = 0, A_V = 256 * LDK * 2  , A_BIAS = A_V + 64 * LDV * 2  , A_END = A_BIAS + 128 * 6 * 4;
__device__ __forceinline__ int vpos(int key) { return (key & ~31) + 8 * ((key >> 2) & 3) + 4 * ((key >> 4) & 1) + (key & 3); }
__device__ __forceinline__ unsigned pk2(float lo, float hi) { return (unsigned)f2bf(lo) | ((unsigned)f2bf(hi) << 16); }
#define AT_BAR() do { asm volatile("s_waitcnt vmcnt(0) lgkmcnt(0)" ::: "memory"); __builtin_amdgcn_s_barrier(); asm volatile("" ::: "memory"); } while (0)

__device__ __forceinline__ void stage_kv(LAS unsigned char* L, int tid, const bf16_t* kbase, const bf16_t* vbase, long pitch, int jvalid0, const float* gk) {
    LAS bf16_t* Kl = (LAS bf16_t*)(L + A_K); LAS bf16_t* VTl = (LAS bf16_t*)(L + A_V);
#pragma unroll
    for (int it = 0; it < 4; ++it) { const int idx = it * 512 + tid, key = idx >> 3, ch = idx & 7;
        v4u raw = {0u, 0u, 0u, 0u}; if (key >= jvalid0) raw = *(const GAS v4u*)(kbase + (long)key * pitch + 8 * ch);
        float f[8]; f[0] = bf2f((bf16_t)(raw.x & 0xffff)); f[1] = bf2f((bf16_t)(raw.x >> 16)); f[2] = bf2f((bf16_t)(raw.y & 0xffff)); f[3] = bf2f((bf16_t)(raw.y >> 16));
        f[4] = bf2f((bf16_t)(raw.z & 0xffff)); f[5] = bf2f((bf16_t)(raw.z >> 16)); f[6] = bf2f((bf16_t)(raw.w & 0xffff)); f[7] = bf2f((bf16_t)(raw.w >> 16));
        float ss = 0.f;
#pragma unroll
        for (int e = 0; e < 8; ++e) ss += f[e] * f[e];
        ss += __shfl_xor(ss, 1); ss += __shfl_xor(ss, 2); ss += __shfl_xor(ss, 4);
        const float rs = 1.0f / sqrtf(ss * (1.0f / 64.0f) + EPS);
        const f32x4 g0 = *(const GAS f32x4*)(gk + 8 * ch), g1 = *(const GAS f32x4*)(gk + 8 * ch + 4);
        v4u o; o.x = pk2(f[0] * rs * g0[0], f[1] * rs * g0[1]); o.y = pk2(f[2] * rs * g0[2], f[3] * rs * g0[3]); o.z = pk2(f[4] * rs * g1[0], f[5] * rs * g1[1]); o.w = pk2(f[6] * rs * g1[2], f[7] * rs * g1[3]);
        *(LAS v4u*)(Kl + key * LDK + 8 * ch) = o; }
#pragma unroll
    for (int it = 0; it < 4; ++it) { const int idx = it * 512 + tid, key = idx & 255, ch = idx >> 8;
        v4u raw = {0u, 0u, 0u, 0u}; if (key >= jvalid0) raw = *(const GAS v4u*)(vbase + (long)key * pitch + 8 * ch);
        LAS bf16_t* d = VTl + (8 * ch) * LDV + vpos(key);
        d[0 * LDV] = (bf16_t)(raw.x & 0xffff); d[1 * LDV] = (bf16_t)(raw.x >> 16); d[2 * LDV] = (bf16_t)(raw.y & 0xffff); d[3 * LDV] = (bf16_t)(raw.y >> 16);
        d[4 * LDV] = (bf16_t)(raw.z & 0xffff); d[5 * LDV] = (bf16_t)(raw.z >> 16); d[6 * LDV] = (bf16_t)(raw.w & 0xffff); d[7 * LDV] = (bf16_t)(raw.w >> 16); }
}
__device__ __forceinline__ void load_q(const bf16_t* qrow, const float* gq, int fq, bf16x8& q0, bf16x8& q1) {
    const v4u r0 = *(const GAS v4u*)(qrow + 8 * fq), r1 = *(const GAS v4u*)(qrow + 32 + 8 * fq);
    float f[16]; const unsigned w[8] = {r0.x, r0.y, r0.z, r0.w, r1.x, r1.y, r1.z, r1.w};
#pragma unroll
    for (int e = 0; e < 8; ++e) { f[2 * e] = bf2f((bf16_t)(w[e] & 0xffff)); f[2 * e + 1] = bf2f((bf16_t)(w[e] >> 16)); }
    float ss = 0.f;
#pragma unroll
    for (int e = 0; e < 16; ++e) ss += f[e] * f[e];
    ss += __shfl_xor(ss, 16); ss += __shfl_xor(ss, 32);
    const float rs = 0.125f / sqrtf(ss * (1.0f / 64.0f) + EPS);
    const f32x4 g0 = *(const GAS f32x4*)(gq + 8 * fq), g1 = *(const GAS f32x4*)(gq + 8 * fq + 4), g2 = *(const GAS f32x4*)(gq + 32 + 8 * fq), g3 = *(const GAS f32x4*)(gq + 36 + 8 * fq);
    v4u a, b;
    a.x = pk2(f[0] * rs * g0[0], f[1] * rs * g0[1]); a.y = pk2(f[2] * rs * g0[2], f[3] * rs * g0[3]); a.z = pk2(f[4] * rs * g1[0], f[5] * rs * g1[1]); a.w = pk2(f[6] * rs * g1[2], f[7] * rs * g1[3]);
    b.x = pk2(f[8] * rs * g2[0], f[9] * rs * g2[1]); b.y = pk2(f[10] * rs * g2[2], f[11] * rs * g2[3]); b.z = pk2(f[12] * rs * g3[0], f[13] * rs * g3[1]); b.w = pk2(f[14] * rs * g3[2], f[15] * rs * g3[3]);
    q0 = __builtin_bit_cast(bf16x8, a); q1 = __builtin_bit_cast(bf16x8, b);
}
template <int NT, bool SWA> __device__ __forceinline__ void attn_wave(const LAS unsigned char* L, bf16x8 q0, bf16x8 q1, int kt0, int qi0, int hq, float sink, bool first_block, bf16_t* outp, int fr, int fq) {
    const LAS bf16_t* Kl = (const LAS bf16_t*)(L + A_K); const LAS bf16_t* VTl = (const LAS bf16_t*)(L + A_V); const LAS float* bias = (const LAS float*)(L + A_BIAS);
    f32x4 s[NT];
#pragma unroll
    for (int t = 0; t < NT; ++t) { const LAS bf16_t* kr = Kl + (16 * (kt0 + t) + fr) * LDK + 8 * fq;
        const f32x4 z = {0.f, 0.f, 0.f, 0.f};
        s[t] = __builtin_amdgcn_mfma_f32_16x16x32_bf16(*(const LAS bf16x8*)kr, q0, z, 0, 0, 0);
        s[t] = __builtin_amdgcn_mfma_f32_16x16x32_bf16(*(const LAS bf16x8*)(kr + 32), q1, s[t], 0, 0, 0);
        if (t & 1) __builtin_amdgcn_sched_barrier(0); }
    float mx = SWA ? sink : -3.0e38f;
#pragma unroll
    for (int t = 0; t < NT; ++t)
#pragma unroll
        for (int r = 0; r < 4; ++r) {
            if (SWA) { const int kj = 16 * (kt0 + t) + 4 * fq + r, dist = qi0 + fr + 128 - kj; const bool valid = dist >= 0 && dist < 128 && !(first_block && kj < 128);
                s[t][r] = valid ? s[t][r] + bias[(valid ? dist : 0) * 6 + hq] : -3.0e38f; }
            mx = fmaxf(mx, s[t][r]); }
    mx = fmaxf(mx, __shfl_xor(mx, 16)); mx = fmaxf(mx, __shfl_xor(mx, 32));
    float l = 0.f;
#pragma unroll
    for (int t = 0; t < NT; ++t)
#pragma unroll
        for (int r = 0; r < 4; ++r) { const float p = __expf(s[t][r] - mx); s[t][r] = p; l += p; }
    l += __shfl_xor(l, 16); l += __shfl_xor(l, 32);
    if (SWA) l += __expf(sink - mx);
    f32x4 o[4];
#pragma unroll
    for (int dt = 0; dt < 4; ++dt) o[dt] = (f32x4){0.f, 0.f, 0.f, 0.f};
#pragma unroll
    for (int ks = 0; ks < NT / 2; ++ks) { v4u pw; pw.x = pk2(s[2 * ks][0], s[2 * ks][1]); pw.y = pk2(s[2 * ks][2], s[2 * ks][3]); pw.z = pk2(s[2 * ks + 1][0], s[2 * ks + 1][1]); pw.w = pk2(s[2 * ks + 1][2], s[2 * ks + 1][3]);
        const bf16x8 pb = __builtin_bit_cast(bf16x8, pw);
#pragma unroll
        for (int dt = 0; dt < 4; ++dt) o[dt] = __builtin_amdgcn_mfma_f32_16x16x32_bf16(*(const LAS bf16x8*)(VTl + (16 * dt + fr) * LDV + 32 * (kt0 / 2 + ks) + 8 * fq), pb, o[dt], 0, 0, 0);
        __builtin_amdgcn_sched_barrier(0); }
    const float inv = 1.0f / l;
#pragma unroll
    for (int dt = 0; dt < 4; ++dt) *(GAS unsigned long long*)(outp + (long)fr * DM + 16 * dt + 4 * fq) = (unsigned long long)pk2(o[dt][0] * inv, o[dt][1] * inv) | ((unsigned long long)pk2(o[dt][2] * inv, o[dt][3] * inv) << 32);
}
struct AttnArgs { const bf16_t* PROJ; const bf16_t* MKV; bf16_t* MIX; const float* biastab; const float *sinks, *gq, *gk, *gmq, *gmk; };
__device__ __forceinline__ void attn_item(LAS unsigned char* L, const AttnArgs A, int item, int tid_in) {
    const int w = __builtin_amdgcn_readfirstlane(tid_in >> 6);
    if (item < 256) {
        const int b = item >> 7, hkv = (item >> 6) & 1, blk = item & 63; const long tokb = (long)b * SEQ + blk * 128;
        { int lt_ = tid_in; asm volatile("" : "+v"(lt_)); const int tid = lt_;
          stage_kv(L, tid, A.PROJ + (tokb - 128) * LDP + 384 + 64 * hkv, A.PROJ + (tokb - 128) * LDP + 512 + 64 * hkv, LDP, blk == 0 ? 128 : 0, A.gk);
          LAS float* bl = (LAS float*)(L + A_BIAS); for (int i = tid; i < 768; i += 512) bl[i] = A.biastab[i]; }
        AT_BAR();
        { int lt_ = tid_in; asm volatile("" : "+v"(lt_)); const int lane = lt_ & 63, fr = lane & 15, fq = lane >> 4;
#pragma unroll 1
          for (int g = 0; g < 3; ++g) { const int hq = 3 * hkv + g; bf16x8 q0, q1;
              load_q(A.PROJ + (tokb + 16 * w + fr) * LDP + 64 * hq, A.gq, fq, q0, q1);
              attn_wave<10, true>(L, q0, q1, w & ~1, 16 * w, hq, A.sinks[hq], blk == 0, A.MIX + (tokb + 16 * w) * DM + 64 * hq, fr, fq); } }
        AT_BAR();
    } else {
        const int pr = item - 256, b = pr >> 7, h = (pr >> 5) & 3, blk2 = pr & 31;
        { int lt_ = tid_in; asm volatile("" : "+v"(lt_)); const int tid = lt_;
          stage_kv(L, tid, A.MKV + (long)(b * 256) * 512 + 64 * h, A.MKV + (long)(b * 256) * 512 + 256 + 64 * h, 512, 0, A.gmk); }
        AT_BAR();
        { int lt_ = tid_in; asm volatile("" : "+v"(lt_)); const int lane = lt_ & 63, fr = lane & 15, fq = lane >> 4;
#pragma unroll 1
          for (int u = 0; u < 2; ++u) { const long tokb = (long)b * SEQ + (2 * blk2 + u) * 128; bf16x8 q0, q1;
              load_q(A.PROJ + (tokb + 16 * w + fr) * LDP + 1920 + 64 * h, A.gmq, fq, q0, q1);
              attn_wave<16, false>(L, q0, q1, 0, 16 * w, 0, 0.f, false, A.MIX + (tokb + 16 * w) * DM + 768 + 64 * h, fr, fq); } }
        AT_BAR();
    }
}
}
constexpr int NWAVES = 8;
namespace mk {
constexpr size_t WS_CTL = 0, CTL_ZERO_BYTES = 1 * MiB;
constexpr size_t CTL_SSQ = 512 * 1024;
constexpr size_t WS_SMALL = 1 * MiB, SM_BIAS = 0, SM_SSQM = 4096, SM_MKV = 512 * 1024;
constexpr size_t WS_MEMB = 2 * MiB, WS_WT = 3 * MiB, WS_XB = 28 * MiB, WS_VF = 60 * MiB, WS_PROJ = 72 * MiB, WS_MIX = 144 * MiB, WS_PREP = 176 * MiB, WS_U = 72 * MiB, WS_ACT = 160 * MiB, WS_END = 248 * MiB;
constexpr size_t WT_IN = 0, WT_OUT = 4718592, WT_UP = WT_OUT + 2 * MiB, WT_DOWN = WT_UP + 11 * MiB, WT_MKV = WT_DOWN + 5767168;
constexpr int CW_TMO = 0, CW_BAR = 4096;
constexpr int LDS_BYTES = 163840, LDSCTL_OFF = LDS_BYTES - 512, MISC_OFF = LDSCTL_OFF + 320;
constexpr size_t SM_W2T = 8192, SM_A2T = 32768, SM_V2T = 57344, SM_G2T = 81920;
constexpr size_t WS_PT = 176 * MiB, WS_G = 188 * MiB, WS_S0 = 200 * MiB, WS_Z = 212 * MiB, WS_V1 = 236 * MiB, WS_YV = 28 * MiB  , WS_DOT = 52 * MiB;
#ifndef PROF_PH
#define PROF_PH -1
#endif
#ifndef PROF_N
#define PROF_N 1
#endif
#define REPEAT(k) for (int rep_ = 0; rep_ < ((PROF_PH) == (k) ? (PROF_N) : 1); ++rep_)
#ifndef FAST_RWKV
#define FAST_RWKV 1
#endif
#ifndef FAST_ATTN
#define FAST_ATTN 1
#endif

struct Args { const float* in[N_IN]; float* out; unsigned char* ws; int ph_lo, ph_hi; };

__device__ __forceinline__ unsigned pk2(float lo, float hi) { return (unsigned)f2bf(lo) | ((unsigned)f2bf(hi) << 16); }
__device__ __forceinline__ float wave_sum(float v) {
#pragma unroll
    for (int o = 1; o < 64; o <<= 1) v += __shfl_xor(v, o);
    return v;
}
template <bool UPPERM> __device__ __forceinline__ void transpose_item(const float* W, const float* g, int K, int N, bf16_t* WT, LAS float* scr, int item, int lane) {
    const int nblk = N / 32, kb = item / nblk, nb = item % nblk, k0 = 64 * kb, n0 = 32 * nb;
#pragma unroll 8
    for (int i = 0; i < 32; ++i) { const int kk = 2 * i + (lane >> 5); float v = W[(size_t)(k0 + kk) * N + n0 + (lane & 31)]; if (g) v *= g[k0 + kk]; scr[kk * 33 + (lane & 31)] = v; }
    LDS_WAIT(); asm volatile("" ::: "memory");
    const int c = lane & 7;
#pragma unroll
    for (int j = 0; j < 4; ++j) { const int n = (lane >> 3) + 8 * j; const LAS float* s = scr + (8 * c) * 33 + n;
        v4u o; o.x = pk2(s[0 * 33], s[1 * 33]); o.y = pk2(s[2 * 33], s[3 * 33]); o.z = pk2(s[4 * 33], s[5 * 33]); o.w = pk2(s[6 * 33], s[7 * 33]);
        int nr = n0 + n; if (UPPERM) nr = nr < 2816 ? 256 * (nr >> 7) + (nr & 127) : 256 * ((nr - 2816) >> 7) + 128 + ((nr - 2816) & 127);
        *(GAS v4u*)(WT + (size_t)nr * K + k0 + 8 * c) = o; }
    LDS_WAIT(); asm volatile("" ::: "memory");
}
__device__ __forceinline__ void row_to_bf16(const float* xrow, bf16_t* orow, float* ssq_out, int lane) {
    const GAS f32x4* xr = (const GAS f32x4*)xrow + lane; f32x4 v[4]; float s = 0.f;
#pragma unroll
    for (int j = 0; j < 4; ++j) { v[j] = xr[64 * j]; s += (v[j].x * v[j].x + v[j].y * v[j].y) + (v[j].z * v[j].z + v[j].w * v[j].w); }
    s = wave_sum(s);
    GAS unsigned long long* o8 = (GAS unsigned long long*)orow + lane;
#pragma unroll
    for (int j = 0; j < 4; ++j) o8[64 * j] = (unsigned long long)pk2(v[j].x, v[j].y) | ((unsigned long long)pk2(v[j].z, v[j].w) << 32);
    if (lane == 0) *ssq_out = s;
}

__global__ void __launch_bounds__(NWAVES * 64, 2) mk_fwd(Args args) {
    extern __shared__ __attribute__((aligned(16))) unsigned char lds[];
    LAS unsigned char* L = (LAS unsigned char*)lds;
    volatile LAS unsigned* MISC = (volatile LAS unsigned*)(L + MISC_OFF);
    const int tid0 = threadIdx.x; const int wave0 = __builtin_amdgcn_readfirstlane(tid0 >> 6);
    const int G = gridDim.x;
    unsigned char* ws = args.ws;
    gu32* ctl = (gu32*)(ws + WS_CTL);
    for (int u = tid0; u < (LDS_BYTES - LDSCTL_OFF) / 4; u += NWAVES * 64) ((LAS unsigned*)(L + LDSCTL_OFF))[u] = 0u;
    __syncthreads();
    XcdBarrier bar = xcd_barrier_post((unsigned*)(ctl + CW_BAR), MISC + 8);
    const int lo = args.ph_lo, hi = args.ph_hi;
    int ph = 0;
#define PH_BEGIN if (lo <= ph && ph < hi) { unsigned char* wsp = args.ws; asm volatile("" : "+s"(wsp)); int tid = wave0 * 64 + (int)__builtin_amdgcn_mbcnt_hi(~0u, __builtin_amdgcn_mbcnt_lo(~0u, 0u)); asm volatile("" : "+v"(tid)); const int lane = tid & 63, wave = __builtin_amdgcn_readfirstlane(tid >> 6); const long gtid = (long)blockIdx.x * (NWAVES * 64) + tid; const int gw = blockIdx.x * NWAVES + wave; LAS float* scr = (LAS float*)(L + wave * 16384); (void)lane; (void)gtid; (void)gw; (void)scr;
#define PH_END   if (ph + 1 < hi) xcd_barrier(bar); } ++ph;
    float* out = args.out;
#define SSQ_A ((float*)(wsp + WS_CTL + CTL_SSQ))
#define SSQ_B (SSQ_A + 3 * MTOK)
#define biastab ((float*)(wsp + WS_SMALL + SM_BIAS))
#define ssqm ((float*)(wsp + WS_SMALL + SM_SSQM))
#define MKV ((bf16_t*)(wsp + WS_SMALL + SM_MKV))
#define MEMB ((bf16_t*)(wsp + WS_MEMB))
#define Wt_in ((bf16_t*)(wsp + WS_WT + WT_IN))
#define Wt_out ((bf16_t*)(wsp + WS_WT + WT_OUT))
#define Wt_up ((bf16_t*)(wsp + WS_WT + WT_UP))
#define Wt_down ((bf16_t*)(wsp + WS_WT + WT_DOWN))
#define Wt_mkv ((bf16_t*)(wsp + WS_WT + WT_MKV))
#define XB ((bf16_t*)(wsp + WS_XB))
#define VF ((bf16_t*)(wsp + WS_VF))
#define PROJ ((bf16_t*)(wsp + WS_PROJ))
#define MIX ((bf16_t*)(wsp + WS_MIX))
#define U ((bf16_t*)(wsp + WS_U))
#define ACT ((bf16_t*)(wsp + WS_ACT))
#define PA ((size_t)MTOK * 384)
#define pR ((bf16_t*)(wsp + WS_PREP))
#define pK (pR + PA)
#define pV (pR + 2 * PA)
#define pKK (pR + 3 * PA)
#define pB (pR + 4 * PA)
#define pLD (pR + 5 * PA)
    const long gsize = (long)G * (NWAVES * 64);
    const int NGW = G * NWAVES;

#define MK_W() sk::RwkvW W{args.in[I_MU] + l * 1280, args.in[I_MUV], args.in[I_W0] + l * 384, args.in[I_W2] + l * 32 * 384, args.in[I_A0] + l * 384, args.in[I_A2] + l * 32 * 384, args.in[I_V0], args.in[I_V2], args.in[I_G2] + l * 64 * 384, args.in[I_KK] + l * 384, args.in[I_KA] + l * 384, args.in[I_RK] + l * 384, args.in[I_LNW] + l * 384, args.in[I_LNB] + l * 384};
#define MK_CBUF() const rw::ChunkBufs cbuf{(bf16_t*)(wsp + WS_PT), (bf16_t*)(wsp + WS_G), (float*)(wsp + WS_Z), (float*)(wsp + WS_YV), (bf16_t*)(wsp + WS_S0), (bf16_t*)(wsp + (l == 0 ? WS_VF : WS_V1)), (float*)(wsp + WS_DOT), (const bf16_t*)(wsp + WS_SMALL + SM_W2T), (const bf16_t*)(wsp + WS_SMALL + SM_A2T), (const bf16_t*)(wsp + WS_SMALL + SM_V2T), (const bf16_t*)(wsp + WS_SMALL + SM_G2T)};
    for (int l = 0; l < 2; ++l) {
        const float* xin = l == 0 ? args.in[I_X] : out;
        PH_BEGIN
            REPEAT(0) {
            const int I_IN = 16 * 68, I_OUT = 16 * 32, I_UP = 16 * 176, I_DN = 44 * 32, I_KV = 16 * 16, NIT = I_IN + I_OUT + I_UP + I_DN + I_KV;
            for (int it = gw; it < NIT; it += NGW) {
                int r = it;
                if (r < I_IN) { transpose_item<false>(args.in[I_WIN] + (size_t)l * 1024 * 2176, args.in[I_MIXG] + l * 1024, 1024, 2176, Wt_in, scr, r, lane); continue; } r -= I_IN;
                if (r < I_OUT) { transpose_item<false>(args.in[I_WOUT] + (size_t)l * 1024 * 1024, nullptr, 1024, 1024, Wt_out, scr, r, lane); continue; } r -= I_OUT;
                if (r < I_UP) { transpose_item<true>(args.in[I_WUP] + (size_t)l * 1024 * 5632, args.in[I_FFNG] + l * 1024, 1024, 5632, Wt_up, scr, r, lane); continue; } r -= I_UP;
                if (r < I_DN) { transpose_item<false>(args.in[I_WDOWN] + (size_t)l * 2816 * 1024, nullptr, 2816, 1024, Wt_down, scr, r, lane); continue; } r -= I_DN;
                transpose_item<false>(args.in[I_WMKV] + (size_t)l * 1024 * 512, args.in[I_MEMG] + l * 1024, 1024, 512, Wt_mkv, scr, r, lane);
            }
            for (long i = gtid; i < 128 * 1024; i += gsize) { const int n = (int)(i >> 10), k = (int)(i & 1023); float v = 0.f;
                if (l > 0 && n < 16) v = args.in[I_WINV][k * 16 + n] * args.in[I_MIXG][l * 1024 + k];
                Wt_in[(size_t)(2176 + n) * 1024 + k] = f2bf(v); }
            for (long i = gtid; i < 384 * 160; i += gsize) { const int hc = (int)(i / 160), j = (int)(i % 160); bf16_t* sm = (bf16_t*)(wsp + WS_SMALL);
                if (j < 32) sm[SM_W2T / 2 + hc * 32 + j] = f2bf(args.in[I_W2][(size_t)l * 32 * 384 + j * 384 + hc]);
                else if (j < 64) sm[SM_A2T / 2 + hc * 32 + (j - 32)] = f2bf(args.in[I_A2][(size_t)l * 32 * 384 + (j - 32) * 384 + hc]);
                else if (j < 96) sm[SM_V2T / 2 + hc * 32 + (j - 64)] = f2bf((j - 64) < 16 ? args.in[I_V2][(j - 64) * 384 + hc] : 0.f);
                else sm[SM_G2T / 2 + hc * 64 + (j - 96)] = f2bf(args.in[I_G2][(size_t)l * 64 * 384 + (j - 96) * 384 + hc]); }
            if (l == 0) {
                for (int m = gw; m < MTOK; m += NGW) row_to_bf16(args.in[I_X] + (size_t)m * DM, XB + (size_t)m * DM, SSQ_A + m, lane);
                for (int m = gw; m < 512; m += NGW) row_to_bf16(args.in[I_MEM] + (size_t)m * DM, MEMB + (size_t)m * DM, ssqm + m, lane);
                sk::d_biastab(args.in[I_RELB], biastab, gtid, gsize);
            }
            }
        PH_END
        PH_BEGIN
            REPEAT(1)
            { pg8::Gemm g{XB, Wt_in, MTOK, 2304, 1024}; pg8::StaticOrder S; S.init(MTOK, 2304, G, (int)blockIdx.x);
              pg8::EpiScaleBf16 E{PROJ, LDP, SSQ_A + (size_t)l * MTOK};
              pg8::gemm_phase<pg8::EpiScaleBf16, pg8::StaticOrder, true, true>(L, g, S, E, tid); }
            { pg8::Gemm g{MEMB, Wt_mkv, 512, 512, 1024}; pg8::StaticOrder S; S.init(512, 512, G, (int)((blockIdx.x + 192) % G));
              pg8::EpiScaleBf16 E{MKV, 512, ssqm};
              pg8::gemm_phase<pg8::EpiScaleBf16, pg8::StaticOrder, true, true>(L, g, S, E, tid); }
        PH_END


        PH_BEGIN
            MK_W(); MK_CBUF(); (void)cbuf;
#if !FAST_ATTN
            sk::d_qknorm(PROJ, MTOK, LDP, args.in[I_AQN] + l * 64, args.in[I_AKN] + l * 64, args.in[I_MQN] + l * 64, 0, gtid, gsize);
            sk::d_qknorm(MKV, 512, 512, nullptr, nullptr, args.in[I_MKN] + l * 64, 1, gtid, gsize);
#endif
#if FAST_RWKV
            REPEAT(2) rw::chunk_phase(L, PROJ, W, l, VF, cbuf, tid, (int)blockIdx.x, G);
#else
            sk::d_rwkv_prep(PROJ, W, l, VF, pR, pK, pV, pKK, pB, pLD, gtid, gsize);
#endif
        PH_END
        PH_BEGIN
            MK_CBUF(); (void)cbuf;
            if (blockIdx.x < BATCH * 6) {
#if FAST_RWKV
                REPEAT(3) { if (tid == 0) MISC[16] = 0u; __syncthreads();
                  if (wave < 4) rw::scan_phase(cbuf, (int)blockIdx.x, wave, lane, MISC + 16); else if (wave < 7) rw::scan_prefetch(cbuf, (int)blockIdx.x, wave - 4, lane, MISC + 16); }
#else
                if (wave == 0) sk::d_rwkv_scan(pR, pK, pV, pKK, pB, pLD, MIX, (int)blockIdx.x, lane);
#endif
            } else {
#if FAST_ATTN
                const at::AttnArgs A{PROJ, MKV, MIX, biastab, args.in[I_SINK] + l * 6, args.in[I_AQN] + l * 64, args.in[I_AKN] + l * 64, args.in[I_MQN] + l * 64, args.in[I_MKN] + l * 64};
                REPEAT(7) for (int it = (int)blockIdx.x - BATCH * 6; it < 512; it += G - BATCH * 6) at::attn_item(L, A, it, tid);
#else
                const long gt2 = (long)(blockIdx.x - BATCH * 6) * (NWAVES * 64) + tid, gs2 = (long)(G - BATCH * 6) * (NWAVES * 64);
                REPEAT(7) sk::d_swa(PROJ, MIX, biastab, args.in[I_SINK] + l * 6, gt2, gs2);
                REPEAT(8) sk::d_memattn(PROJ, MKV, MIX, gt2, gs2);
#endif
            }
        PH_END
        PH_BEGIN
            MK_W(); MK_CBUF(); (void)cbuf;
#if FAST_RWKV
            REPEAT(4) rw::out_phase(L, PROJ, W, cbuf, MIX, tid, (int)blockIdx.x, G);
#else
            sk::d_rwkv_fin(PROJ, W, pR, pK, pV, MIX, gtid, gsize);
#endif
        PH_END
        PH_BEGIN
            pg8::Gemm g{MIX, Wt_out, MTOK, 1024, 1024}; pg8::StaticOrder S; S.init(MTOK, 1024, G, (int)blockIdx.x);
            pg8::EpiResid E{xin, out, XB, SSQ_B + (size_t)l * MTOK, 1024};
            pg8::gemm_phase<pg8::EpiResid, pg8::StaticOrder, true, true>(L, g, S, E, tid);
        PH_END
        PH_BEGIN
            REPEAT(5) {
            pg8::Gemm g{XB, Wt_up, 66 * 256, 5632, 1024}; pg8::StaticOrder S; S.init(66 * 256, 5632, G, (int)blockIdx.x);
            pg8::EpiConvAct E{ACT, SSQ_B + (size_t)l * MTOK, args.in[I_CW] + (size_t)l * 3 * 5632, args.in[I_CB] + (size_t)l * 5632};
            pg8::gemm_phase<pg8::EpiConvAct, pg8::StaticOrder, true, true>(L, g, S, E, tid); }
        PH_END
        PH_BEGIN
            pg8::Gemm g{ACT, Wt_down, MTOK, 1024, 2816}; pg8::StaticOrder S; S.init(MTOK, 1024, G, (int)blockIdx.x);
            pg8::EpiResid E{out, out, XB, SSQ_A + (size_t)(l + 1) * MTOK, 1024};
            pg8::gemm_phase<pg8::EpiResid, pg8::StaticOrder, true, true>(L, g, S, E, tid);
        PH_END
    }
#undef PH_BEGIN
#undef PH_END
}
constexpr int N_PHASES = 2 * 8;
}

#ifndef MK_PER_PHASE
#define MK_PER_PHASE 0
#endif
extern "C" void kernel_launch(void* const* d_in, const int* in_sizes, int n_in, void* d_out, int out_size, void* d_ws, size_t ws_size, hipStream_t stream) {
    static int grid = 0;
    if (grid == 0) {
        if (n_in != N_IN || out_size != MTOK * DM || ws_size < mk::WS_END) { fprintf(stderr, "kernel_launch: unexpected shapes (n_in %d out %d ws %zu)\n", n_in, out_size, ws_size); grid = -1; return; }
        int dev = 0, cus = 0, per_cu = 0;
        if (hipGetDevice(&dev) != hipSuccess || hipDeviceGetAttribute(&cus, hipDeviceAttributeMultiprocessorCount, dev) != hipSuccess) { grid = -1; return; }
        if (hipFuncSetAttribute((const void*)mk::mk_fwd, hipFuncAttributeMaxDynamicSharedMemorySize, mk::LDS_BYTES) != hipSuccess) { fprintf(stderr, "kernel_launch: hipFuncSetAttribute failed\n"); grid = -1; return; }
        if (hipOccupancyMaxActiveBlocksPerMultiprocessor(&per_cu, (const void*)mk::mk_fwd, NWAVES * 64, mk::LDS_BYTES) != hipSuccess || per_cu < 1) { fprintf(stderr, "kernel_launch: occupancy query says %d blocks per CU\n", per_cu); }
        (void)hipGetLastError();
        grid = cus;
    }
    if (grid < 0) return;
    if (hipMemsetAsync((char*)d_ws + mk::WS_CTL, 0, mk::CTL_ZERO_BYTES, stream) != hipSuccess) return;
    mk::Args a{};
    for (int i = 0; i < N_IN; ++i) a.in[i] = (const float*)d_in[i];
    a.out = (float*)d_out; a.ws = (unsigned char*)d_ws;
#if MK_PER_PHASE
    for (int p = 0; p < mk::N_PHASES; ++p) { a.ph_lo = p; a.ph_hi = p + 1; hipLaunchKernelGGL(mk::mk_fwd, dim3(grid), dim3(NWAVES * 64), mk::LDS_BYTES, stream, a); }
#else
    a.ph_lo = 0; a.ph_hi = mk::N_PHASES;
    hipLaunchKernelGGL(mk::mk_fwd, dim3(grid), dim3(NWAVES * 64), mk::LDS_BYTES, stream, a);
#endif
}
```

```cpp
#define MK_BUILD 1
#ifndef HOST_SIM
#include <hip/hip_runtime.h>
#include <cstdio>
#include <cstdint>
#endif
#ifndef SEQ_LEN
#define SEQ_LEN 8192
#endif
typedef unsigned short bf16_t;
constexpr int BATCH = 2, SEQ = SEQ_LEN, DM = 1024, MTOK = BATCH * SEQ, DFF = 2816, LDP = 2304  ;
constexpr float EPS = 1e-6f, GN_EPS = 64e-5f;
__host__ __device__ __forceinline__ float bf2f(bf16_t h) { unsigned u = (unsigned)h << 16; return __builtin_bit_cast(float, u); }
__host__ __device__ __forceinline__ bf16_t f2bf(float f) { unsigned u = __builtin_bit_cast(unsigned, f); return (bf16_t)((u + 0x7fffu + ((u >> 16) & 1u)) >> 16); }
__host__ __device__ __forceinline__ int t5_bucket(int dist) {
    if (dist < 16) return dist;
    const float v = logf((float)dist / 16.0f) / 2.0794415416798357f * 16.0f;
    int large = 16 + (int)v; return large < 31 ? large : 31;
}
constexpr size_t MiB = 1u << 20;
enum { I_X = 0, I_MEM, I_RELB, I_MIXG, I_WIN, I_WINV, I_AQN, I_AKN, I_SINK, I_MU, I_MUV, I_W0, I_W2, I_A0, I_A2, I_V0, I_V2, I_G2, I_KK, I_KA, I_RK, I_LNW, I_LNB, I_MEMG, I_WMKV, I_MQN, I_MKN, I_WOUT, I_FFNG, I_WUP, I_CW, I_CB, I_WDOWN, N_IN };
namespace sk {

__device__ __forceinline__ void d_wt(const float* W, const float* g, bf16_t* Wt, int K, int N, int Npad, long gtid, long gsize) {
    const long total = (long)Npad * K;
    for (long idx = gtid; idx < total; idx += gsize) {
        const int n = (int)(idx / K), k = (int)(idx % K);
        float v = 0.f;
        if (n < N) { v = W[(long)k * N + n]; if (g) v *= g[k]; }
        Wt[idx] = f2bf(v);
    }
}
#ifndef MK_BUILD
__global__ void k_wt(const float* W, const float* g, bf16_t* Wt, int K, int N, int Npad) { d_wt(W, g, Wt, K, N, Npad, (long)blockIdx.x * blockDim.x + threadIdx.x, (long)gridDim.x * blockDim.x); }
#endif
__device__ __forceinline__ void d_rowprep(const float* x, bf16_t* xb, float* ssq, int rows, long gtid, long gsize) {
    for (long r = gtid; r < rows; r += gsize) {
        const float* xr = x + (long)r * DM; bf16_t* o = xb + (long)r * DM; float s = 0.f;
        for (int c = 0; c < DM; ++c) { const float v = xr[c]; s += v * v; o[c] = f2bf(v); }
        ssq[r] = s;
    }
}
#ifndef MK_BUILD
__global__ void k_rowprep(const float* x, bf16_t* xb, float* ssq, int rows) { d_rowprep(x, xb, ssq, rows, (long)blockIdx.x * blockDim.x + threadIdx.x, (long)gridDim.x * blockDim.x); }
#endif
__device__ __forceinline__ void d_biastab(const float* rel_bias, float* tab, long gtid, long gsize) {
        for (long i = gtid; i < 128 * 6; i += gsize) { const int dist = i / 6, hq = i % 6; tab[i] = rel_bias[t5_bucket(dist) * 6 + hq]; }
}
#ifndef MK_BUILD
__global__ void k_biastab(const float* rel_bias, float* tab) { d_biastab(rel_bias, tab, (long)blockIdx.x * blockDim.x + threadIdx.x, (long)gridDim.x * blockDim.x); }
#endif
__device__ __forceinline__ void d_qknorm(bf16_t* P, int rows, int ld, const float* gq, const float* gk, const float* gm, int mode, long gtid, long gsize) {
    const int nj = mode == 0 ? 12 : 4;
    const long total = (long)rows * nj;
    for (long idx = gtid; idx < total; idx += gsize) {
        const int row = (int)(idx / nj), j = (int)(idx % nj);
        int col; const float* g;
        if (mode == 0) { if (j < 6) { col = 64 * j; g = gq; } else if (j < 8) { col = 384 + 64 * (j - 6); g = gk; } else { col = 1920 + 64 * (j - 8); g = gm; } }
        else { col = 64 * j; g = gm; }
        bf16_t* p = P + (long)row * ld + col; float s = 0.f;
        for (int d = 0; d < 64; ++d) { const float v = bf2f(p[d]); s += v * v; }
        const float rs = 1.0f / sqrtf(s * (1.0f / 64.0f) + EPS);
        for (int d = 0; d < 64; ++d) p[d] = f2bf(bf2f(p[d]) * rs * g[d]);
    }
}
#ifndef MK_BUILD
__global__ void k_qknorm(bf16_t* P, int rows, int ld, const float* gq, const float* gk, const float* gm, int mode) { d_qknorm(P, rows, ld, gq, gk, gm, mode, (long)blockIdx.x * blockDim.x + threadIdx.x, (long)gridDim.x * blockDim.x); }
#endif
__device__ __forceinline__ void d_swa(const bf16_t* P, bf16_t* MIX, const float* biastab, const float* sinks, long gtid, long gsize) {
    const long total = (long)MTOK * 6;
    for (long idx = gtid; idx < total; idx += gsize) {
        const int tok = (int)(idx / 6), hq = (int)(idx % 6), hkv = hq / 3, t = tok % SEQ;
        float q[64], o[64];
#pragma unroll
        for (int d = 0; d < 64; ++d) { q[d] = bf2f(P[(long)tok * LDP + 64 * hq + d]) * 0.125f; o[d] = 0.f; }
        float m = sinks[hq], l = 1.0f;
        const int j0 = t - 127 < 0 ? 0 : t - 127;
        for (int j = j0; j <= t; ++j) {
            const bf16_t* kr = P + (long)(tok - (t - j)) * LDP + 384 + 64 * hkv; const bf16_t* vr = kr + 128;
            float s = 0.f;
#pragma unroll
            for (int d = 0; d < 64; ++d) s += q[d] * bf2f(kr[d]);
            s += biastab[(t - j) * 6 + hq];
            const float mn = fmaxf(m, s), f = expf(m - mn), e = expf(s - mn);
            l = l * f + e; m = mn;
#pragma unroll
            for (int d = 0; d < 64; ++d) o[d] = o[d] * f + e * bf2f(vr[d]);
        }
        const float inv = 1.0f / l;
#pragma unroll
        for (int d = 0; d < 64; ++d) MIX[(long)tok * DM + 64 * hq + d] = f2bf(o[d] * inv);
    }
}
#ifndef MK_BUILD
__global__ __launch_bounds__(256) void k_swa(const bf16_t* P, bf16_t* MIX, const float* biastab, const float* sinks) { d_swa(P, MIX, biastab, sinks, (long)blockIdx.x * blockDim.x + threadIdx.x, (long)gridDim.x * blockDim.x); }
#endif
__device__ __forceinline__ void d_memattn(const bf16_t* P, const bf16_t* MKV, bf16_t* MIX, long gtid, long gsize) {
    const long total = (long)MTOK * 4;
    for (long idx = gtid; idx < total; idx += gsize) {
        const int tok = (int)(idx / 4), h = (int)(idx % 4), b = tok / SEQ;
        float q[64], o[64];
#pragma unroll
        for (int d = 0; d < 64; ++d) { q[d] = bf2f(P[(long)tok * LDP + 1920 + 64 * h + d]) * 0.125f; o[d] = 0.f; }
        float m = -1e30f, l = 0.f;
        for (int j = 0; j < 256; ++j) {
            const bf16_t* kr = MKV + (long)(b * 256 + j) * 512 + 64 * h; const bf16_t* vr = kr + 256;
            float s = 0.f;
#pragma unroll
            for (int d = 0; d < 64; ++d) s += q[d] * bf2f(kr[d]);
            const float mn = fmaxf(m, s), f = expf(m - mn), e = expf(s - mn);
            l = l * f + e; m = mn;
#pragma unroll
            for (int d = 0; d < 64; ++d) o[d] = o[d] * f + e * bf2f(vr[d]);
        }
        const float inv = 1.0f / l;
#pragma unroll
        for (int d = 0; d < 64; ++d) MIX[(long)tok * DM + 768 + 64 * h + d] = f2bf(o[d] * inv);
    }
}
#ifndef MK_BUILD
__global__ __launch_bounds__(256) void k_memattn(const bf16_t* P, const bf16_t* MKV, bf16_t* MIX) { d_memattn(P, MKV, MIX, (long)blockIdx.x * blockDim.x + threadIdx.x, (long)gridDim.x * blockDim.x); }
#endif
__device__ __forceinline__ float shifted(const bf16_t* P, int tok, int col, float mu) {
    const float p = bf2f(P[(long)tok * LDP + col]);
    const float prev = (tok % SEQ) == 0 ? 0.f : bf2f(P[(long)(tok - 1) * LDP + col]);
    return p + mu * (prev - p);
}
struct RwkvW { const float *mu, *mu_v, *w0, *w2, *a0, *a2, *v0, *v2, *g2, *k_k, *k_a, *r_k, *ln_w, *ln_b; };
__device__ __forceinline__ void d_rwkv_prep(const bf16_t* P, RwkvW W, int layer, bf16_t* VFIRST, bf16_t* R, bf16_t* K, bf16_t* V, bf16_t* KK, bf16_t* B, bf16_t* LOGD, long gtid, long gsize) {
    const long total = (long)MTOK * 6;
    for (long idx = gtid; idx < total; idx += gsize) {
        const int tok = (int)(idx / 6), h = (int)(idx % 6);
        float nrm = 0.f;
        for (int c = 0; c < 64; ++c) { const int hc = 64 * h + c; const float kc = shifted(P, tok, 640 + 384 + hc, W.mu[384 + hc]) * W.k_k[hc]; nrm += kc * kc; }
        const float rn = 1.0f / fmaxf(sqrtf(nrm), 1e-12f);
        for (int c = 0; c < 64; ++c) {
            const int hc = 64 * h + c; const long o = (long)tok * 384 + hc;
            const float r = shifted(P, tok, 640 + hc, W.mu[hc]);
            const float k = shifted(P, tok, 640 + 384 + hc, W.mu[384 + hc]);
            float v = shifted(P, tok, 640 + 768 + hc, W.mu[768 + hc]);
            float wp = W.w0[hc], ap = W.a0[hc];
            for (int j = 0; j < 32; ++j) {
                wp += tanhf(shifted(P, tok, 640 + 1152 + j, W.mu[1152 + j])) * W.w2[j * 384 + hc];
                ap += shifted(P, tok, 640 + 1184 + j, W.mu[1184 + j]) * W.a2[j * 384 + hc];
            }
            const float z = -wp; const float sp = fmaxf(z, 0.f) + log1pf(expf(-fabsf(z)));
            const float w = -sp - 0.5f;
            const float a = 1.0f / (1.0f + expf(-ap));
            if (layer > 0) {
                float vp = W.v0[hc];
                for (int j = 0; j < 16; ++j) vp += shifted(P, tok, 2176 + j, W.mu_v[j]) * W.v2[j * 384 + hc];
                const float vf = bf2f(VFIRST[o]);
                v = v + (vf - v) * (1.0f / (1.0f + expf(-vp)));
            } else VFIRST[o] = f2bf(v);
            const float kk = k * W.k_k[hc] * rn;
            R[o] = f2bf(r); K[o] = f2bf(k * (1.0f + (a - 1.0f) * W.k_a[hc])); V[o] = f2bf(v);
            KK[o] = f2bf(kk); B[o] = f2bf(kk * a); LOGD[o] = f2bf(-expf(w));
        }
    }
}
#ifndef MK_BUILD
__global__ void k_rwkv_prep(const bf16_t* P, RwkvW W, int layer, bf16_t* VFIRST, bf16_t* R, bf16_t* K, bf16_t* V, bf16_t* KK, bf16_t* B, bf16_t* LOGD) { d_rwkv_prep(P, W, layer, VFIRST, R, K, V, KK, B, LOGD, (long)blockIdx.x * blockDim.x + threadIdx.x, (long)gridDim.x * blockDim.x); }
#endif
__device__ __forceinline__ void d_rwkv_scan(const bf16_t* R, const bf16_t* K, const bf16_t* V, const bf16_t* KK, const bf16_t* B, const bf16_t* LOGD, bf16_t* MIX, int bh, int i) {
    const int b = bh / 6, h = bh % 6;
    float s[64];
#pragma unroll
    for (int k = 0; k < 64; ++k) s[k] = 0.f;
    for (int t = 0; t < SEQ; ++t) {
        const long o = (long)(b * SEQ + t) * 384 + 64 * h;
        float sa = 0.f;
#pragma unroll
        for (int k = 0; k < 64; ++k) sa -= s[k] * bf2f(KK[o + k]);
        const float v = bf2f(V[o + i]); float y = 0.f;
#pragma unroll
        for (int k = 0; k < 64; ++k) { s[k] = s[k] * expf(bf2f(LOGD[o + k])) + sa * bf2f(B[o + k]) + v * bf2f(K[o + k]); y += s[k] * bf2f(R[o + k]); }
        MIX[(long)(b * SEQ + t) * DM + 384 + 64 * h + i] = f2bf(y);
    }
}
#ifndef MK_BUILD
__global__ void k_rwkv_scan(const bf16_t* R, const bf16_t* K, const bf16_t* V, const bf16_t* KK, const bf16_t* B, const bf16_t* LOGD, bf16_t* MIX) { d_rwkv_scan(R, K, V, KK, B, LOGD, MIX, blockIdx.x, threadIdx.x); }
#endif
__device__ __forceinline__ void d_rwkv_fin(const bf16_t* P, RwkvW W, const bf16_t* R, const bf16_t* K, const bf16_t* V, bf16_t* MIX, long gtid, long gsize) {
    const long total = (long)MTOK * 6;
    for (long idx = gtid; idx < total; idx += gsize) {
        const int tok = (int)(idx / 6), h = (int)(idx % 6);
        bf16_t* y = MIX + (long)tok * DM + 384 + 64 * h; const long o = (long)tok * 384 + 64 * h;
        float mean = 0.f, dot = 0.f;
        for (int c = 0; c < 64; ++c) { mean += bf2f(y[c]); dot += bf2f(R[o + c]) * bf2f(K[o + c]) * W.r_k[64 * h + c]; }
        mean *= (1.0f / 64.0f); float var = 0.f;
        for (int c = 0; c < 64; ++c) { const float d = bf2f(y[c]) - mean; var += d * d; }
        const float rstd = 1.0f / sqrtf(var * (1.0f / 64.0f) + GN_EPS);
        for (int c = 0; c < 64; ++c) {
            const int hc = 64 * h + c; float g = 0.f;
            for (int j = 0; j < 64; ++j) g += (1.0f / (1.0f + expf(-shifted(P, tok, 640 + 1216 + j, W.mu[1216 + j])))) * W.g2[j * 384 + hc];
            const float yn = (bf2f(y[c]) - mean) * rstd * W.ln_w[hc] + W.ln_b[hc];
            y[c] = f2bf((yn + dot * bf2f(V[o + c])) * g);
        }
    }
}
#ifndef MK_BUILD
__global__ void k_rwkv_fin(const bf16_t* P, RwkvW W, const bf16_t* R, const bf16_t* K, const bf16_t* V, bf16_t* MIX) { d_rwkv_fin(P, W, R, K, V, MIX, (long)blockIdx.x * blockDim.x + threadIdx.x, (long)gridDim.x * blockDim.x); }
#endif
__device__ __forceinline__ void d_conv_act(const bf16_t* U, const float* cw, const float* cb, bf16_t* ACT, int rows, long gtid, long gsize) {
    const long total = (long)rows * DFF;
    for (long idx = gtid; idx < total; idx += gsize) {
        const int t = (int)(idx / DFF), c = (int)(idx % DFF);
        float gate = cb[c], val = cb[DFF + c];
#pragma unroll
        for (int i = 0; i < 3; ++i) { const int tt = t - 2 + i; if (tt >= 0) { gate += cw[i * 2 * DFF + c] * bf2f(U[(long)tt * 2 * DFF + c]); val += cw[i * 2 * DFF + DFF + c] * bf2f(U[(long)tt * 2 * DFF + DFF + c]); } }
        ACT[(long)t * DFF + c] = f2bf(gate / (1.0f + expf(-gate)) * val);
    }
}
#ifndef MK_BUILD
__global__ void k_conv_act(const bf16_t* U, const float* cw, const float* cb, bf16_t* ACT, int rows) { d_conv_act(U, cw, cb, ACT, rows, (long)blockIdx.x * blockDim.x + threadIdx.x, (long)gridDim.x * blockDim.x); }
#endif
}
namespace pg8 {
#define PG8_LAS __attribute__((address_space(3)))
typedef unsigned short bf16_t;
typedef short bf16x8 __attribute__((ext_vector_type(8)));
typedef float f32x4 __attribute__((ext_vector_type(4)));
typedef unsigned u32x4 __attribute__((ext_vector_type(4)));
constexpr int BM = 256, BK = 64, HALF = 128, HTB = HALF * BK * 2  , STAGE_BYTES = 8 * HTB, NXCD = 8, WGM = 8;

__host__ __device__ __forceinline__ int lds_byte(int r, int c) { const int st = (r >> 4) * 2 + (c >> 5), rr = r & 15, cc = c & 31, ob = rr * 64 + cc * 2; return st * 1024 + (ob ^ (((ob >> 9) & 1) << 5)); }
__host__ __device__ __forceinline__ void stage_rc(int b, int& R, int& C) { const int st = b / 1024, sb = b % 1024, swz = sb ^ (((sb >> 9) & 1) << 5); R = (st >> 1) * 16 + swz / 64; C = (st & 1) * 32 + (swz % 64) / 2; }
__host__ __device__ __forceinline__ int perm32(int rho) { const int n = rho >> 4, i = rho & 15; return 8 * (i >> 2) + 4 * n + (i & 3); }

struct Unit { int pm, pn; };
struct Gemm { const bf16_t* A; const bf16_t* Bt; int M, N, K; };

struct StaticOrder {
    int nM, nN, nwg, G, c;
    __host__ __device__ void init(int M, int N, int G_, int c_) { nM = M / BM; nN = N / BM; nwg = nM * nN; G = G_; c = c_; }
    __host__ __device__ bool next(int i, Unit& u) const {
        const long L = (long)i * G + c; if (L >= nwg) return false;
        int wgid = (int)L; { const int q = nwg / NXCD, r = nwg % NXCD, xcd = wgid % NXCD, off = wgid / NXCD; wgid = (xcd < r ? xcd * (q + 1) : r * (q + 1) + (xcd - r) * q) + off; }
        const int nig = WGM * nN, gid = wgid / nig, fm = gid * WGM, gsz = (nM - fm) < WGM ? (nM - fm) : WGM;
        u.pm = fm + ((wgid % nig) % gsz); u.pn = (wgid % nig) / gsz; return true;
    }
    __device__ __forceinline__ void a_ready(const Unit&) const {}
    __device__ __forceinline__ void done(const Unit&) const {}
};

__device__ __forceinline__ unsigned cvt_pk_bf16(float lo, float hi) { unsigned r; asm volatile("v_cvt_pk_bf16_f32 %0, %1, %2" : "=v"(r) : "v"(lo), "v"(hi)); return r; }
struct EpiScaleBf16 {
    static constexpr bool PERM = true, AFTER_DRAIN = false; static constexpr int AMAP = 0;
    bf16_t* O; int ldc; const float* ssq;
    __device__ __forceinline__ void operator()(const f32x4 (&acc)[2][2][4][2], const Unit& u, int wr, int wc, int fr, int fq) const {
        const int row0 = u.pm * BM + wr * 64 + fr, col0 = u.pn * BM + wc * 32 + 8 * fq;
#pragma unroll
        for (int ai = 0; ai < 2; ++ai)
#pragma unroll
            for (int m = 0; m < 4; ++m) { const int row = row0 + ai * HALF + m * 16; const float sc = 1.0f / sqrtf(ssq[row] * (1.0f / 1024.0f) + 1e-6f);
                bf16_t* rowp = O + (size_t)row * ldc + col0;
#pragma unroll
                for (int bj = 0; bj < 2; ++bj) { const f32x4 v0 = acc[ai][bj][m][0] * sc, v1 = acc[ai][bj][m][1] * sc;
                    u32x4 w; w.x = cvt_pk_bf16(v0[0], v0[1]); w.y = cvt_pk_bf16(v0[2], v0[3]); w.z = cvt_pk_bf16(v1[0], v1[1]); w.w = cvt_pk_bf16(v1[2], v1[3]);
                    *(u32x4*)(rowp + bj * HALF) = w; } }
    }
};
struct EpiResid {
    static constexpr bool PERM = false, AFTER_DRAIN = false; static constexpr int AMAP = 0;
    const float* base; float* out; bf16_t* xb; float* ssq; int ldc;
    __device__ __forceinline__ void operator()(const f32x4 (&acc)[2][2][4][2], const Unit& u, int wr, int wc, int fr, int fq) const {
        typedef unsigned u32x2v __attribute__((ext_vector_type(2)));
        const int col0 = u.pn * BM + wc * 32 + 4 * fq;
#pragma unroll
        for (int ai = 0; ai < 2; ++ai)
#pragma unroll
            for (int m = 0; m < 4; ++m) { const int row = u.pm * BM + ai * HALF + wr * 64 + m * 16 + fr; const size_t off = (size_t)row * ldc + col0; float sq = 0.f;
#pragma unroll
                for (int bj = 0; bj < 2; ++bj)
#pragma unroll
                    for (int n = 0; n < 2; ++n) { const f32x4 o = *(const f32x4*)(base + off + bj * HALF + n * 16) + acc[ai][bj][m][n];
                        *(f32x4*)(out + off + bj * HALF + n * 16) = o; sq += (o[0] * o[0] + o[1] * o[1]) + (o[2] * o[2] + o[3] * o[3]);
                        u32x2v w; w.x = cvt_pk_bf16(o[0], o[1]); w.y = cvt_pk_bf16(o[2], o[3]); *(u32x2v*)(xb + off + bj * HALF + n * 16) = w; }
                sq += __shfl_xor(sq, 16); sq += __shfl_xor(sq, 32);
                if (fq == 0) atomicAdd(ssq + row, sq); }
    }
};
struct EpiConvAct {
    static constexpr bool PERM = true, AFTER_DRAIN = false; static constexpr int AMAP = 1;
    bf16_t* ACT; const float* ssq; const float* cw; const float* cb;
    static __device__ __forceinline__ float shr1s(float x) { float r; asm volatile("s_nop 1\n\tv_mov_b32_dpp %0, %1 row_shr:1 row_mask:0xf bank_mask:0xf bound_ctrl:1" : "=v"(r) : "v"(x)); return r; }
    static __device__ __forceinline__ f32x4 shr1(f32x4 v) { f32x4 r; r[0] = shr1s(v[0]); r[1] = shr1s(v[1]); r[2] = shr1s(v[2]); r[3] = shr1s(v[3]); return r; }
    __device__ __forceinline__ void operator()(const f32x4 (&acc)[2][2][4][2], const Unit& u, int wr, int wc, int fr, int fq) const {
        const int b = u.pm / 33, pmb = u.pm % 33;
        const int pos0 = 252 * pmb + 126 * wr + 8 * fr - 2;
        const long row0 = (long)b * SEQ + pos0;
        float rs[8];
#pragma unroll
        for (int j = 0; j < 8; ++j) { const int pos = pos0 + j; const bool ok = pos >= 0 && pos < SEQ; const float q = ssq[ok ? row0 + j : 0]; rs[j] = ok ? 1.0f / sqrtf(q * (1.0f / 1024.0f) + 1e-6f) : 0.f; }
        const int ch0 = 128 * u.pn + 32 * wc + 8 * fq;
        unsigned ow[8][4];
#pragma unroll
        for (int n = 0; n < 2; ++n) { const int c = ch0 + 4 * n;
            const f32x4 w0g = *(const f32x4*)(cw + c), w1g = *(const f32x4*)(cw + 5632 + c), w2g = *(const f32x4*)(cw + 2 * 5632 + c), bg = *(const f32x4*)(cb + c);
            const f32x4 w0v = *(const f32x4*)(cw + 2816 + c), w1v = *(const f32x4*)(cw + 5632 + 2816 + c), w2v = *(const f32x4*)(cw + 2 * 5632 + 2816 + c), bv = *(const f32x4*)(cb + 2816 + c);
            f32x4 gm2 = shr1(acc[1][0][2][n] * rs[6]), gm1 = shr1(acc[1][0][3][n] * rs[7]), vm2 = shr1(acc[1][1][2][n] * rs[6]), vm1 = shr1(acc[1][1][3][n] * rs[7]);
#pragma unroll
            for (int j = 0; j < 8; ++j) { const f32x4 gj = acc[j >> 2][0][j & 3][n] * rs[j], vj = acc[j >> 2][1][j & 3][n] * rs[j];
                const f32x4 ug = bg + w0g * gm2 + w1g * gm1 + w2g * gj, uv = bv + w0v * vm2 + w1v * vm1 + w2v * vj; f32x4 a;
#pragma unroll
                for (int e = 0; e < 4; ++e) a[e] = ug[e] / (1.0f + __expf(-ug[e])) * uv[e];
                ow[j][2 * n] = cvt_pk_bf16(a[0], a[1]); ow[j][2 * n + 1] = cvt_pk_bf16(a[2], a[3]);
                gm2 = gm1; gm1 = gj; vm2 = vm1; vm1 = vj; } }
#pragma unroll
        for (int j = 0; j < 8; ++j) if (8 * fr + j >= 2 && pos0 + j < SEQ) { u32x4 w; w.x = ow[j][0]; w.y = ow[j][1]; w.z = ow[j][2]; w.w = ow[j][3]; *(u32x4*)(ACT + (size_t)(row0 + j) * 2816 + ch0) = w; }
    }
};
template <class Epi, class Sched, bool ALIGN_EPI = false, bool SP2 = false>
__device__ __forceinline__ void gemm_phase(PG8_LAS unsigned char* lds, const Gemm g, const Sched& S, const Epi& E, int tid_in) {
    int tid = tid_in; asm volatile("" : "+v"(tid));
    const int wid = __builtin_amdgcn_readfirstlane(tid >> 6), lane = tid & 63, wr = wid >> 2, wc = wid & 3, fr = lane & 15, fq = lane >> 4;
    const int K = g.K, nt = K / BK;
    unsigned voffA[2], voffB[2];
#pragma unroll
    for (int i = 0; i < 2; ++i) { int R, C; stage_rc(tid * 16 + i * 8192, R, C); const int Rb = Epi::PERM ? ((R & ~31) + perm32(R & 31)) : R;
        const int Ra = Epi::AMAP ? (126 * (R >> 6) + 8 * (R & 15) + ((R >> 4) & 3)) : R;
        voffA[i] = (unsigned)(Ra * K + C) * 2u; voffB[i] = (unsigned)(Rb * K + C) * 2u; }
    const size_t kstep = (size_t)(BK * 2);
    const size_t hstepB = (size_t)HALF * K * 2;
    const size_t hstepA = Epi::AMAP ? (size_t)4 * K * 2 : hstepB;
    const size_t tstep = 2 * hstepB;
#define PG8_ABASE(pm_) (Epi::AMAP ? (long)((long)((pm_) / 33) * SEQ + 252 * ((pm_) % 33) - 2) * (long)K * 2 : (long)(pm_) * (long)tstep)
    const unsigned ldsw = (unsigned)wid * 1024u;
    const int aoff = lds_byte(wr * 64 + fr, fq * 8), boff = lds_byte(wc * 32 + fr, fq * 8);
#define PG8_SA(b, h) (((b) * 2 + (h)) * HTB)
#define PG8_SB(b, h) ((4 + (b) * 2 + (h)) * HTB)
#define PG8_STAGE(bufoff, gbase, voff) do { _Pragma("unroll") for (int _i = 0; _i < 2; ++_i) \
        __builtin_amdgcn_global_load_lds((const unsigned*)((const char*)(gbase) + (voff)[_i]), (PG8_LAS unsigned*)(lds + (bufoff) + ldsw + _i * 8192), 16, 0, 0); } while (0)
#define PG8_LDA(dst, b, h) do { _Pragma("unroll") for (int m = 0; m < 4; ++m) _Pragma("unroll") for (int k = 0; k < 2; ++k) dst[m][k] = *(const PG8_LAS bf16x8*)(lds + PG8_SA(b, h) + aoff + m * 2048 + k * 1024); } while (0)
#define PG8_LDB(dst, b, h) do { _Pragma("unroll") for (int n = 0; n < 2; ++n) _Pragma("unroll") for (int k = 0; k < 2; ++k) dst[n][k] = *(const PG8_LAS bf16x8*)(lds + PG8_SB(b, h) + boff + n * 2048 + k * 1024); } while (0)
#define PG8_MMA(ai, bj, At, Bt) do { __builtin_amdgcn_s_setprio(1); _Pragma("unroll") for (int m = 0; m < 4; ++m) _Pragma("unroll") for (int n = 0; n < 2; ++n) _Pragma("unroll") for (int k = 0; k < 2; ++k) \
        acc[ai][bj][m][n] = __builtin_amdgcn_mfma_f32_16x16x32_bf16(Bt[n][k], At[m][k], acc[ai][bj][m][n], 0, 0, 0); __builtin_amdgcn_s_setprio(0); } while (0)
#define PG8_WAIT_V(n) asm volatile("s_waitcnt vmcnt(" #n ")" ::: "memory")
#define PG8_WAIT_L(n) asm volatile("s_waitcnt lgkmcnt(" #n ")" ::: "memory")
#define PG8_BAR __builtin_amdgcn_s_barrier()
#define PG8_SCHED __builtin_amdgcn_sched_barrier(0)
    Unit cur, nxt; int ui = 0;
    if (!S.next(0, cur)) return;
    f32x4 acc[2][2][4][2];
#pragma unroll
    for (int a = 0; a < 2; ++a)
#pragma unroll
        for (int b = 0; b < 2; ++b)
#pragma unroll
            for (int m = 0; m < 4; ++m)
#pragma unroll
                for (int n = 0; n < 2; ++n) acc[a][b][m][n] = (f32x4){0.f, 0.f, 0.f, 0.f};
    bf16x8 At[4][2], B0[2][2], B1[2][2];
    const char* cA = (const char*)g.A + PG8_ABASE(cur.pm); const char* cB = (const char*)g.Bt + (size_t)cur.pn * tstep;
    S.a_ready(cur);
    if constexpr (SP2) {
        PG8_STAGE(PG8_SB(0, 0), cB, voffB); PG8_STAGE(PG8_SB(0, 1), cB + hstepB, voffB); PG8_STAGE(PG8_SA(0, 0), cA, voffA); PG8_STAGE(PG8_SA(0, 1), cA + hstepA, voffA);
        if (wr == 1) PG8_BAR;
        PG8_WAIT_V(2); PG8_BAR;
        PG8_STAGE(PG8_SB(1, 0), cB + kstep, voffB); PG8_STAGE(PG8_SA(1, 0), cA + kstep, voffA); PG8_STAGE(PG8_SB(1, 1), cB + hstepB + kstep, voffB);
        PG8_WAIT_V(6); PG8_BAR;
    } else {
        PG8_STAGE(PG8_SB(0, 0), cB, voffB); PG8_STAGE(PG8_SA(0, 0), cA, voffA); PG8_STAGE(PG8_SB(0, 1), cB + hstepB, voffB); PG8_STAGE(PG8_SA(0, 1), cA + hstepA, voffA);
        if (wr == 1) PG8_BAR;
        PG8_WAIT_V(4); PG8_BAR;
        PG8_STAGE(PG8_SB(1, 0), cB + kstep, voffB); PG8_STAGE(PG8_SA(1, 0), cA + kstep, voffA); PG8_STAGE(PG8_SB(1, 1), cB + hstepB + kstep, voffB);
        PG8_WAIT_V(6); PG8_BAR;
    }
    for (;;) {
        const bool has_next = S.next(ui + 1, nxt);
        const char* nA = has_next ? (const char*)g.A + PG8_ABASE(nxt.pm) : cA; const char* nB = has_next ? (const char*)g.Bt + (size_t)nxt.pn * tstep : cB;
        for (int t = 0; t < nt; t += 2) {
            const bool last = (t == nt - 2);
            const char* a1 = cA + (size_t)(t + 1) * kstep;
            const char* a2 = last ? nA : cA + (size_t)(t + 2) * kstep; const char* b2 = last ? nB : cB + (size_t)(t + 2) * kstep;
            const char* a3 = a2 + kstep; const char* b3 = b2 + kstep;
            if (last && has_next) S.a_ready(nxt);
            if constexpr (SP2) {
            PG8_LDB(B0, 0, 0); PG8_LDB(B1, 0, 1); PG8_SCHED; PG8_LDA(At, 0, 0); PG8_STAGE(PG8_SA(1, 1), a1 + hstepA, voffA);
            PG8_WAIT_V(8); PG8_WAIT_L(0); PG8_BAR; PG8_MMA(0, 0, At, B0); PG8_MMA(0, 1, At, B1); PG8_BAR; PG8_SCHED;
            PG8_LDA(At, 0, 1); PG8_STAGE(PG8_SB(0, 0), b2, voffB); PG8_STAGE(PG8_SB(0, 1), b2 + hstepB, voffB); PG8_STAGE(PG8_SA(0, 0), a2, voffA);
            PG8_WAIT_V(8); PG8_WAIT_L(0); PG8_BAR; PG8_MMA(1, 0, At, B0); PG8_MMA(1, 1, At, B1); PG8_BAR; PG8_SCHED;
            PG8_LDB(B0, 1, 0); PG8_LDB(B1, 1, 1); PG8_SCHED; PG8_LDA(At, 1, 0); PG8_STAGE(PG8_SA(0, 1), a2 + hstepA, voffA);
            PG8_WAIT_V(8); PG8_WAIT_L(0); PG8_BAR; PG8_MMA(0, 0, At, B0); PG8_MMA(0, 1, At, B1); PG8_BAR; PG8_SCHED;
            PG8_LDA(At, 1, 1); PG8_STAGE(PG8_SB(1, 0), b3, voffB); PG8_STAGE(PG8_SB(1, 1), b3 + hstepB, voffB); PG8_STAGE(PG8_SA(1, 0), a3, voffA);
            PG8_WAIT_V(8); PG8_WAIT_L(0); PG8_BAR; PG8_MMA(1, 0, At, B0); PG8_MMA(1, 1, At, B1); PG8_BAR; PG8_SCHED;
            } else {
            PG8_LDB(B0, 0, 0); PG8_SCHED; PG8_LDA(At, 0, 0); PG8_STAGE(PG8_SA(1, 1), a1 + hstepA, voffA);
            PG8_WAIT_L(8); PG8_BAR; PG8_WAIT_L(0); PG8_MMA(0, 0, At, B0); PG8_BAR; PG8_SCHED;
            PG8_LDB(B1, 0, 1); PG8_STAGE(PG8_SB(0, 0), b2, voffB);
            PG8_BAR; PG8_WAIT_L(0); PG8_MMA(0, 1, At, B1); PG8_BAR;
            PG8_LDA(At, 0, 1); PG8_STAGE(PG8_SA(0, 0), a2, voffA);
            PG8_BAR; PG8_WAIT_L(0); PG8_MMA(1, 0, At, B0); PG8_BAR; PG8_SCHED;
            PG8_STAGE(PG8_SB(0, 1), b2 + hstepB, voffB);
            PG8_WAIT_V(6); PG8_BAR; PG8_MMA(1, 1, At, B1); PG8_BAR;
            PG8_LDB(B0, 1, 0); PG8_SCHED; PG8_LDA(At, 1, 0); PG8_STAGE(PG8_SA(0, 1), a2 + hstepA, voffA);
            PG8_WAIT_L(8); PG8_BAR; PG8_WAIT_L(0); PG8_MMA(0, 0, At, B0); PG8_BAR; PG8_SCHED;
            PG8_LDB(B1, 1, 1); PG8_STAGE(PG8_SB(1, 0), b3, voffB);
            PG8_BAR; PG8_WAIT_L(0); PG8_MMA(0, 1, At, B1); PG8_BAR;
            PG8_LDA(At, 1, 1); PG8_STAGE(PG8_SA(1, 0), a3, voffA);
            PG8_BAR; PG8_WAIT_L(0); PG8_MMA(1, 0, At, B0); PG8_BAR; PG8_SCHED;
            PG8_STAGE(PG8_SB(1, 1), b3 + hstepB, voffB);
            PG8_WAIT_V(6); PG8_BAR; PG8_MMA(1, 1, At, B1); PG8_BAR;
            }
        }
        if constexpr (ALIGN_EPI) { if (wr == 0) PG8_BAR; }
        if constexpr (!Epi::AFTER_DRAIN) { E(acc, cur, wr, wc, fr, fq); S.done(cur); }
        if (!has_next) break;
#pragma unroll
        for (int a = 0; a < 2; ++a)
#pragma unroll
            for (int b = 0; b < 2; ++b)
#pragma unroll
                for (int m = 0; m < 4; ++m)
#pragma unroll
                    for (int n = 0; n < 2; ++n) acc[a][b][m][n] = (f32x4){0.f, 0.f, 0.f, 0.f};
        cur = nxt; cA = nA; cB = nB; ++ui;
        if constexpr (ALIGN_EPI) { if (wr == 1) PG8_BAR; }
    }
    PG8_WAIT_V(0);
    if constexpr (!ALIGN_EPI) { if (wr == 0) PG8_BAR; }
    PG8_BAR;
    if constexpr (Epi::AFTER_DRAIN) { E.fused(acc, cur, wr, wc, fr, fq, lds, wid, lane); S.done(cur); }
#undef PG8_ABASE
#undef PG8_SA
#undef PG8_SB
#undef PG8_STAGE
#undef PG8_LDA
#undef PG8_LDB
#undef PG8_MMA
#undef PG8_WAIT_V
#undef PG8_WAIT_L
#undef PG8_BAR
#undef PG8_SCHED
}
}

#ifndef PG8_SP2
#define PG8_SP2 true
#endif
#ifndef PG8_ALIGN
#define PG8_ALIGN true
#endif
#define GAS __attribute__((address_space(1)))
#define LAS __attribute__((address_space(3)))
typedef unsigned short bf16;
typedef unsigned v4u __attribute__((ext_vector_type(4)));
typedef float f32x4 __attribute__((ext_vector_type(4)));
typedef short bf16x8 __attribute__((ext_vector_type(8)));
typedef GAS unsigned gu32;
typedef GAS unsigned long long gu64;
#define RLX_AGENT __ATOMIC_RELAXED, __HIP_MEMORY_SCOPE_AGENT
#define LDS_WAIT() asm volatile("s_waitcnt lgkmcnt(0)" ::: "memory")
#define VM_WAIT() asm volatile("s_waitcnt vmcnt(0)" ::: "memory")
__device__ __forceinline__ unsigned long long rt() { return __builtin_amdgcn_s_memrealtime(); }

#define XB_TMO      128
#define XB_XCNT(j)  (256  + 64 * (j))
#define XB_XSUB(j)  (1280 + 64 * (j))
#define XB_XGEN(j)  (2304 + 64 * (j))
#define XB_TOP      3328
#define XB_TOPGEN   3392
#define XCD_BAR_WORDS 3456
#define XB_SPIN_CAP (1u << 20)

__device__ __forceinline__ unsigned xb_ld(unsigned* p)              { return __hip_atomic_load(p, __ATOMIC_RELAXED, __HIP_MEMORY_SCOPE_AGENT); }
__device__ __forceinline__ unsigned xb_add(unsigned* p, unsigned v) { return __hip_atomic_fetch_add(p, v, __ATOMIC_RELAXED, __HIP_MEMORY_SCOPE_AGENT); }
__device__ __forceinline__ unsigned xb_xcc_id() { return (unsigned)__builtin_amdgcn_s_getreg((3 << 11) | 20) & 0xFu; }
#define XB_SPIN(cond, bar) do { unsigned _sp = 0; while (cond) { __builtin_amdgcn_s_sleep(1); \
    if ((++_sp & 255u) == 0u) { if (xb_ld(&(bar)[XB_TMO])) break; if (_sp > XB_SPIN_CAP) { atomicAdd(&(bar)[XB_TMO], 1u); break; } } } } while (0)

struct XcdBarrier {
    unsigned* bar; unsigned x;
    volatile LAS unsigned* st;
};

__device__ __forceinline__ XcdBarrier xcd_barrier_post(unsigned* bar, volatile LAS unsigned* st) {
    XcdBarrier b; b.bar = bar; b.x = xb_xcc_id(); b.st = st;
    if (threadIdx.x == 0) (void)xb_add(&bar[XB_XCNT(b.x)], 1u);
    return b;
}
__device__ __forceinline__ void xcd_barrier_complete(unsigned* bar, unsigned x, unsigned& nloc, unsigned& nx) {
    const unsigned G = gridDim.x * gridDim.y * gridDim.z;
    unsigned sum, cnt, mine, sp = 0u;
    for (;;) {
        sum = 0u; cnt = 0u; mine = 0u;
#pragma unroll
        for (unsigned j = 0; j < 16; ++j) { const unsigned c = xb_ld(&bar[XB_XCNT(j)]); sum += c; cnt += (c > 0u) ? 1u : 0u; mine = (j == x) ? c : mine; }
        if (sum == G) break;
        __builtin_amdgcn_s_sleep(1);
        if ((++sp & 255u) == 0u) { if (xb_ld(&bar[XB_TMO])) break; if (sp > XB_SPIN_CAP) { atomicAdd(&bar[XB_TMO], 1u); break; } }
    }
    nloc = mine > 0u ? mine : 1u; nx = cnt > 0u ? cnt : 1u;
}

__device__ __forceinline__ void xcd_barrier(const XcdBarrier& b) {
    asm volatile("s_waitcnt vmcnt(0)" ::: "memory");
    __syncthreads();
    if (threadIdx.x == 0) {
        unsigned* bar = b.bar;
        __builtin_amdgcn_s_waitcnt(0);
        unsigned nloc = b.st[0], nx = b.st[1];
        if (nloc == 0u) { xcd_barrier_complete(bar, b.x, nloc, nx); b.st[0] = nloc; b.st[1] = nx; }
        const unsigned old = xb_add(&bar[XB_XSUB(b.x)], 1u);
        const unsigned gen = old / nloc;
        if (old + 1u == (gen + 1u) * nloc) {
            __builtin_amdgcn_fence(__ATOMIC_RELEASE, "agent");
            asm volatile("s_waitcnt vmcnt(0)" ::: "memory");
            const unsigned og = xb_add(&bar[XB_TOP], 1u);
            const unsigned tg = og / nx;
            if (og + 1u == (tg + 1u) * nx) xb_add(&bar[XB_TOPGEN], 1u);
            else XB_SPIN(xb_ld(&bar[XB_TOPGEN]) == tg, bar);
            __builtin_amdgcn_fence(__ATOMIC_ACQUIRE, "agent");
            xb_add(&bar[XB_XGEN(b.x)], 1u);
            asm volatile("s_waitcnt vmcnt(0)" ::: "memory");
        } else {
            XB_SPIN(xb_ld(&bar[XB_XGEN(b.x)]) == gen, bar);
            __builtin_amdgcn_fence(__ATOMIC_ACQUIRE, "agent");
            asm volatile("s_waitcnt vmcnt(0)" ::: "memory");
        }
    }
    __syncthreads();
}

namespace rw {
constexpr int LD = 72;
constexpr int MATB = 64 * LD * 2;
constexpr int OFF_F0 = 12 * MATB  , OFF_TMP = OFF_F0 + 64 * 65 * 4  ;
constexpr int OFF_TW = 8 * MATB  , OFF_TA = OFF_TW + 5120, OFF_TV = OFF_TA + 5120, OFF_WP = OFF_TV + 5120  , OFF_AP = OFF_WP + 16640, OFF_VP = OFF_AP + 16640;
constexpr int OFF_TOT = 139264, OFF_GC = OFF_TOT + 2048, OFF_RN = OFF_GC + 256, OFF_END = OFF_RN + 256;
constexpr int NITEMS = BATCH * 6 * (SEQ / 64);
__device__ __forceinline__ int sigpos(int c) { return (c & 32) + 8 * ((c >> 2) & 3) + 4 * ((c >> 4) & 1) + (c & 3); }
#define RW_BAR() do { asm volatile("s_waitcnt vmcnt(0) lgkmcnt(0)" ::: "memory"); __builtin_amdgcn_s_barrier(); asm volatile("" ::: "memory"); } while (0)
__device__ __forceinline__ f32x4 mm_tile(const LAS bf16_t* A, const LAS bf16_t* Bt, int ti, int tj, int fr, int fq, f32x4 acc) {
#pragma unroll
    for (int kk = 0; kk < 2; ++kk) {
        const bf16x8 a = *(const LAS bf16x8*)(A + (16 * ti + fr) * LD + 32 * kk + 8 * fq);
        const bf16x8 b = *(const LAS bf16x8*)(Bt + (16 * tj + fr) * LD + 32 * kk + 8 * fq);
        acc = __builtin_amdgcn_mfma_f32_16x16x32_bf16(a, b, acc, 0, 0, 0);
    }
    return acc;
}
__device__ __forceinline__ unsigned pk2(float lo, float hi) { return (unsigned)f2bf(lo) | ((unsigned)f2bf(hi) << 16); }
struct ChunkBufs { bf16_t* PT; bf16_t* G; float* Z; float* YV; bf16_t* S0; bf16_t* VOUT; float* DOT; const bf16_t *W2T, *A2T, *V2T, *G2T; };

#define RW_LANES() int lt_ = tid_in; asm volatile("" : "+v"(lt_)); const int tid = lt_, lane = lt_ & 63, fr = lane & 15, fq = lane >> 4; (void)tid; (void)fr; (void)fq
__device__ __forceinline__ void chunk_phase(LAS unsigned char* L, const bf16_t* P, const sk::RwkvW W, int layer, const bf16_t* VFIRST, const ChunkBufs cb, int tid_in, int first, int stride) {
    const int w = __builtin_amdgcn_readfirstlane(tid_in >> 6);
    LAS bf16_t* B0 = (LAS bf16_t*)(L + 0 * MATB); LAS bf16_t* B1 = (LAS bf16_t*)(L + 1 * MATB); LAS bf16_t* B2 = (LAS bf16_t*)(L + 2 * MATB); LAS bf16_t* B3 = (LAS bf16_t*)(L + 3 * MATB);
    LAS bf16_t* B4 = (LAS bf16_t*)(L + 4 * MATB); LAS bf16_t* B5 = (LAS bf16_t*)(L + 5 * MATB); LAS bf16_t* B6 = (LAS bf16_t*)(L + 6 * MATB); LAS bf16_t* B7 = (LAS bf16_t*)(L + 7 * MATB);
    LAS bf16_t* B8 = (LAS bf16_t*)(L + 8 * MATB); LAS bf16_t* B9 = (LAS bf16_t*)(L + 9 * MATB); LAS bf16_t* B10 = (LAS bf16_t*)(L + 10 * MATB); LAS bf16_t* B11 = (LAS bf16_t*)(L + 11 * MATB);
    LAS float* F0 = (LAS float*)(L + OFF_F0); LAS float* TMP = (LAS float*)(L + OFF_TMP);
    LAS bf16_t* TW = (LAS bf16_t*)(L + OFF_TW); LAS bf16_t* TA = (LAS bf16_t*)(L + OFF_TA); LAS bf16_t* TV = (LAS bf16_t*)(L + OFF_TV);
    LAS float* WP = (LAS float*)(L + OFF_WP); LAS float* AP = (LAS float*)(L + OFF_AP); LAS float* VP = (LAS float*)(L + OFF_VP);
    LAS float* TOT = (LAS float*)(L + OFF_TOT); LAS float* GC = (LAS float*)(L + OFF_GC); LAS float* RN = (LAS float*)(L + OFF_RN);
    for (int item = first; item < NITEMS; item += stride) {
        const int bh = item / (SEQ / 64), chunk = item % (SEQ / 64), b = bh / 6, h = bh % 6;
        const int tok0 = b * SEQ + chunk * 64;
        { RW_LANES(); const int t = tid >> 3, sub = tid & 7, tok = tok0 + t;
#pragma unroll
          for (int e = 0; e < 4; ++e) { const int j = 4 * sub + e;
              TW[t * 40 + j] = f2bf(tanhf(sk::shifted(P, tok, 640 + 1152 + j, W.mu[1152 + j])));
              TA[t * 40 + j] = f2bf(sk::shifted(P, tok, 640 + 1184 + j, W.mu[1184 + j])); }
          if (layer > 0) {
#pragma unroll
              for (int e = 0; e < 2; ++e) { const int j = 2 * sub + e; TV[t * 40 + j] = f2bf(sk::shifted(P, tok, 2176 + j, W.mu_v[j])); TV[t * 40 + 16 + j] = 0; } }
          float s = 0.f;
#pragma unroll
          for (int e = 0; e < 8; ++e) { const int hc = 64 * h + 8 * sub + e; const float kc = sk::shifted(P, tok, 640 + 384 + hc, W.mu[384 + hc]) * W.k_k[hc]; s += kc * kc; }
          s += __shfl_xor(s, 1); s += __shfl_xor(s, 2); s += __shfl_xor(s, 4);
          if (sub == 0) RN[t] = 1.0f / fmaxf(sqrtf(s), 1e-12f); }
        RW_BAR();
        { RW_LANES();
#pragma unroll
        for (int e = 0; e < 2; ++e) { const int tl = 2 * w + e, ti = tl >> 2, tj = tl & 3; const f32x4 z4 = {0.f, 0.f, 0.f, 0.f};
            const size_t brow = (size_t)(64 * h + 16 * tj + fr) * 32 + 8 * fq;
            { const bf16x8 a = *(const LAS bf16x8*)(TW + (16 * ti + fr) * 40 + 8 * fq); const bf16x8 bb = *(const GAS bf16x8*)(cb.W2T + brow);
              const f32x4 d = __builtin_amdgcn_mfma_f32_16x16x32_bf16(a, bb, z4, 0, 0, 0);
#pragma unroll
              for (int r = 0; r < 4; ++r) WP[(16 * ti + 4 * fq + r) * 65 + 16 * tj + fr] = d[r]; }
            { const bf16x8 a = *(const LAS bf16x8*)(TA + (16 * ti + fr) * 40 + 8 * fq); const bf16x8 bb = *(const GAS bf16x8*)(cb.A2T + brow);
              const f32x4 d = __builtin_amdgcn_mfma_f32_16x16x32_bf16(a, bb, z4, 0, 0, 0);
#pragma unroll
              for (int r = 0; r < 4; ++r) AP[(16 * ti + 4 * fq + r) * 65 + 16 * tj + fr] = d[r]; }
            if (layer > 0) { const bf16x8 a = *(const LAS bf16x8*)(TV + (16 * ti + fr) * 40 + 8 * fq); const bf16x8 bb = *(const GAS bf16x8*)(cb.V2T + brow);
              const f32x4 d = __builtin_amdgcn_mfma_f32_16x16x32_bf16(a, bb, z4, 0, 0, 0);
#pragma unroll
              for (int r = 0; r < 4; ++r) VP[(16 * ti + 4 * fq + r) * 65 + 16 * tj + fr] = d[r]; } } }
        RW_BAR();
        { RW_LANES(); const int c = lane, hc = 64 * h + c, tq0 = 8 * w, tk0 = tok0 + tq0;
          const float mu_r = W.mu[hc], mu_k = W.mu[384 + hc], mu_v = W.mu[768 + hc], w0 = W.w0[hc], a0 = W.a0[hc], k_k = W.k_k[hc], k_a = W.k_a[hc], r_k = W.r_k[hc];
          const float v0 = layer > 0 ? W.v0[hc] : 0.f;
          const bool has_prev = (chunk * 64 + tq0) > 0;
          float pr = has_prev ? bf2f(P[(size_t)(tk0 - 1) * LDP + 640 + hc]) : 0.f, pk = has_prev ? bf2f(P[(size_t)(tk0 - 1) * LDP + 1024 + hc]) : 0.f, pv = has_prev ? bf2f(P[(size_t)(tk0 - 1) * LDP + 1408 + hc]) : 0.f;
          float rr[8], kq[8], vv[8], kkc[8], bb[8], ld[8];
#pragma unroll
          for (int j = 0; j < 8; ++j) { const int t = tq0 + j; const size_t row = (size_t)(tk0 + j) * LDP;
              const float cr = bf2f(P[row + 640 + hc]), ck = bf2f(P[row + 1024 + hc]), cv = bf2f(P[row + 1408 + hc]);
              const float r = cr + mu_r * (pr - cr), k = ck + mu_k * (pk - ck); float v = cv + mu_v * (pv - cv); pr = cr; pk = ck; pv = cv;
              const float wp = w0 + WP[t * 65 + c], ap = a0 + AP[t * 65 + c];
              const float z = -wp, sp = fmaxf(z, 0.f) + log1pf(expf(-fabsf(z))); const float wl = -sp - 0.5f;
              const float al = 1.0f / (1.0f + expf(-ap));
              if (layer > 0) { const float vp = v0 + VP[t * 65 + c]; const float vf = bf2f(VFIRST[(size_t)(tk0 + j) * 384 + hc]); v = v + (vf - v) * (1.0f / (1.0f + expf(-vp))); }
              const float kn = k * k_k * RN[t]; const float k2 = k * (1.0f + (al - 1.0f) * k_a);
              rr[j] = bf2f(f2bf(r)); kq[j] = bf2f(f2bf(k2)); vv[j] = bf2f(f2bf(v)); kkc[j] = bf2f(f2bf(kn)); bb[j] = bf2f(f2bf(kn * al)); ld[j] = bf2f(f2bf(-expf(wl)));
              cb.VOUT[(size_t)(tk0 + j) * 384 + hc] = f2bf(v);
              float dsum = rr[j] * kq[j] * r_k;
#pragma unroll
              for (int o = 1; o < 64; o <<= 1) dsum += __shfl_xor(dsum, o);
              if (lane == 0) cb.DOT[(size_t)(tk0 + j) * 6 + h] = dsum; }
          float cl[8]; cl[0] = ld[0];
#pragma unroll
          for (int j = 1; j < 8; ++j) cl[j] = cl[j - 1] + ld[j];
          TOT[w * 64 + c] = cl[7];
          RW_BAR();
          float prefix = 0.f, cumC = 0.f;
#pragma unroll
          for (int ww = 0; ww < 8; ++ww) { const float tv = TOT[ww * 64 + c]; cumC += tv; if (ww < w) prefix += tv; }
          if (w == 0) GC[c] = expf(cumC);
          unsigned ahp[4], btp[4], ktp[4], vp4[4];
#pragma unroll
          for (int j = 0; j < 8; ++j) { const int t = tq0 + j; const float cum = prefix + cl[j], cump = cum - ld[j];
              const float g = expf(cum), gp = expf(cump), ig = expf(-cum), gc = expf(cumC - cum);
              const bf16_t ah = f2bf(-kkc[j] * gp), rh = f2bf(rr[j] * g), bh = f2bf(bb[j] * ig), kh = f2bf(kq[j] * ig), bt = f2bf(bb[j] * gc), kt = f2bf(kq[j] * gc), vb = f2bf(vv[j]);
              B0[t * LD + c] = ah; B1[t * LD + c] = rh; B2[t * LD + c] = bh; B3[t * LD + c] = kh;
              if (j & 1) { ahp[j >> 1] |= (unsigned)ah << 16; btp[j >> 1] |= (unsigned)bt << 16; ktp[j >> 1] |= (unsigned)kt << 16; vp4[j >> 1] |= (unsigned)vb << 16; }
              else { ahp[j >> 1] = ah; btp[j >> 1] = bt; ktp[j >> 1] = kt; vp4[j >> 1] = vb; } }
          *(LAS v4u*)(B4 + c * LD + tq0) = (v4u){ahp[0], ahp[1], ahp[2], ahp[3]}; *(LAS v4u*)(B5 + c * LD + tq0) = (v4u){btp[0], btp[1], btp[2], btp[3]};
          *(LAS v4u*)(B6 + c * LD + tq0) = (v4u){ktp[0], ktp[1], ktp[2], ktp[3]}; *(LAS v4u*)(B7 + c * LD + tq0) = (v4u){vp4[0], vp4[1], vp4[2], vp4[3]}; }
        RW_BAR();
        { RW_LANES(); const int prod = w >> 1; const LAS bf16_t* Aop = prod < 2 ? B0 : B1; const LAS bf16_t* Bop = (prod & 1) ? B3 : B2;
#pragma unroll
          for (int e = 0; e < 8; ++e) { const int tl = (w & 1) * 8 + e, ti = tl >> 2, tj = tl & 3; f32x4 d = {0.f, 0.f, 0.f, 0.f};
              if (tj <= ti) d = mm_tile(Aop, Bop, ti, tj, fr, fq, d);
#pragma unroll
              for (int r = 0; r < 4; ++r) { const int t = 16 * ti + 4 * fq + r, i = 16 * tj + fr; const bool keep = prod < 2 ? (i < t) : (i <= t); const float val = (tj <= ti && keep) ? d[r] : 0.f;
                  if (prod == 0) F0[t * 65 + i] = val; else if (prod == 1) B8[t * LD + i] = f2bf(val); else if (prod == 2) B9[t * LD + i] = f2bf(val); else B10[t * LD + i] = f2bf(val); } } }
        RW_BAR();
        if (w == 0) { RW_LANES();
            const int blk = lane >> 4, jc = lane & 15; const LAS float* Lb = F0 + (16 * blk) * 65 + 16 * blk; float tc[16];
#pragma unroll
            for (int r = 0; r < 16; ++r) { float val = (r == jc) ? 1.f : 0.f;
#pragma unroll
                for (int i = 0; i < r; ++i) val += Lb[r * 65 + i] * tc[i];
                tc[r] = val; }
            asm volatile("s_waitcnt lgkmcnt(0)" ::: "memory");
#pragma unroll
            for (int r = 0; r < 16; ++r) F0[(16 * blk + r) * 65 + 16 * blk + jc] = tc[r];
        }
        RW_BAR();
        if (w < 2) { RW_LANES();
            const int o1 = 32 * w, o2 = 32 * w + 16; f32x4 d = {0.f, 0.f, 0.f, 0.f};
#pragma unroll
            for (int ks = 0; ks < 4; ++ks) d = __builtin_amdgcn_mfma_f32_16x16x4f32(F0[(o2 + fr) * 65 + o1 + 4 * ks + fq], F0[(o1 + 4 * ks + fq) * 65 + o1 + fr], d, 0, 0, 0);
            LAS float* tm = TMP + w * 16 * 17;
#pragma unroll
            for (int r = 0; r < 4; ++r) tm[(4 * fq + r) * 17 + fr] = d[r];
            asm volatile("s_waitcnt lgkmcnt(0)" ::: "memory");
            f32x4 d2 = {0.f, 0.f, 0.f, 0.f};
#pragma unroll
            for (int ks = 0; ks < 4; ++ks) d2 = __builtin_amdgcn_mfma_f32_16x16x4f32(F0[(o2 + fr) * 65 + o2 + 4 * ks + fq], tm[(4 * ks + fq) * 17 + fr], d2, 0, 0, 0);
            asm volatile("s_waitcnt lgkmcnt(0)" ::: "memory");
#pragma unroll
            for (int r = 0; r < 4; ++r) F0[(o2 + 4 * fq + r) * 65 + o1 + fr] = d2[r];
        }
        RW_BAR();
        if (w < 4) { RW_LANES();
            const int ti = w >> 1, tj = w & 1; f32x4 d = {0.f, 0.f, 0.f, 0.f};
#pragma unroll
            for (int ks = 0; ks < 8; ++ks) d = __builtin_amdgcn_mfma_f32_16x16x4f32(F0[(32 + 16 * ti + fr) * 65 + 4 * ks + fq], F0[(4 * ks + fq) * 65 + 16 * tj + fr], d, 0, 0, 0);
#pragma unroll
            for (int r = 0; r < 4; ++r) TMP[(16 * ti + 4 * fq + r) * 33 + 16 * tj + fr] = d[r];
        }
        RW_BAR();
        if (w < 4) { RW_LANES();
            const int ti = w >> 1, tj = w & 1; f32x4 d = {0.f, 0.f, 0.f, 0.f};
#pragma unroll
            for (int ks = 0; ks < 8; ++ks) d = __builtin_amdgcn_mfma_f32_16x16x4f32(F0[(32 + 16 * ti + fr) * 65 + 32 + 4 * ks + fq], TMP[(4 * ks + fq) * 33 + 16 * tj + fr], d, 0, 0, 0);
#pragma unroll
            for (int r = 0; r < 4; ++r) F0[(32 + 16 * ti + 4 * fq + r) * 65 + 16 * tj + fr] = d[r];
        }
        RW_BAR();
        { RW_LANES(); const int t = tid >> 3, i0 = (tid & 7) * 8;
#pragma unroll
          for (int e = 0; e < 8; ++e) B11[t * LD + i0 + e] = f2bf(F0[t * 65 + i0 + e]); }
        RW_BAR();
        { RW_LANES();
#pragma unroll
        for (int e = 0; e < 4; ++e) { const int tl = 4 * w + e, prod = tl >> 4, ti = (tl >> 2) & 3, tj = tl & 3; f32x4 d = {0.f, 0.f, 0.f, 0.f};
            d = prod == 0 ? mm_tile(B11, B4, ti, tj, fr, fq, d) : mm_tile(B8, B7, ti, tj, fr, fq, d);
            LAS bf16_t* dst = (prod == 0 ? B0 : B2) + (16 * tj + fr) * LD + 16 * ti + 4 * fq;
            *(LAS unsigned long long*)dst = (unsigned long long)pk2(d[0], d[1]) | ((unsigned long long)pk2(d[2], d[3]) << 32); } }
        RW_BAR();
        { RW_LANES();
#pragma unroll
        for (int e = 0; e < 2; ++e) { const int tl = 2 * w + e, ti = tl >> 2, tj = tl & 3; f32x4 d = {0.f, 0.f, 0.f, 0.f};
            d = mm_tile(B11, B2, ti, tj, fr, fq, d);
            LAS bf16_t* dst = B3 + (16 * tj + fr) * LD + 16 * ti + 4 * fq;
            *(LAS unsigned long long*)dst = (unsigned long long)pk2(d[0], d[1]) | ((unsigned long long)pk2(d[2], d[3]) << 32); } }
        RW_BAR();
        { RW_LANES();
#pragma unroll
        for (int e = 0; e < 8; ++e) { const int tl = 8 * w + e, prod = tl >> 4, ti = (tl >> 2) & 3, tj = tl & 3; f32x4 d = {0.f, 0.f, 0.f, 0.f};
            if (prod == 0) { d = mm_tile(B5, B3, ti, tj, fr, fq, d); d = mm_tile(B6, B7, ti, tj, fr, fq, d);
                *(GAS f32x4*)(cb.Z + (size_t)item * 4096 + (16 * tj + fr) * 64 + 4 * ((4 * ti + fq) ^ fr)) = d; }
            else if (prod == 1) { d = mm_tile(B9, B3, ti, tj, fr, fq, d); d = mm_tile(B10, B7, ti, tj, fr, fq, d);
                *(GAS f32x4*)(cb.YV + (size_t)item * 4096 + (16 * tj + fr) * 64 + 16 * ti + 4 * fq) = d; }
            else if (prod == 2) { d = mm_tile(B9, B0, ti, tj, fr, fq, d);
#pragma unroll
                for (int r = 0; r < 4; ++r) { const int t = 16 * ti + 4 * fq + r, c = 16 * tj + fr; B4[t * LD + sigpos(c)] = f2bf(d[r] + bf2f(B1[t * LD + c])); } }
            else { d = mm_tile(B5, B0, ti, tj, fr, fq, d);
#pragma unroll
                for (int r = 0; r < 4; ++r) { const int c = 16 * ti + 4 * fq + r, c2 = 16 * tj + fr; B8[c * LD + sigpos(c2)] = f2bf(d[r] + (c == c2 ? GC[c] : 0.f)); } } } }
        RW_BAR();
        { RW_LANES(); const int r = tid >> 3, ch = (tid & 7) * 8;
          *(GAS v4u*)(cb.G + (size_t)item * 4096 + r * 64 + ch) = *(const LAS v4u*)(B4 + r * LD + ch);
          *(GAS v4u*)(cb.PT + (size_t)item * 4096 + r * 64 + 8 * ((tid & 7) ^ (r & 7))) = *(const LAS v4u*)(B8 + r * LD + ch); }
        RW_BAR();
    }
}
constexpr int SC_NS = 10, SC_SLOT = 12288, SC_LAG = 6;
__device__ __forceinline__ void scan_compute(LAS unsigned char* L, const ChunkBufs cb, int bh, int tj, int lane, volatile LAS unsigned* flags) {
    const int fr = lane & 15, fq = lane >> 4; const int NC = SEQ / 64;
    bf16x8 Bf0 = {0, 0, 0, 0, 0, 0, 0, 0}, Bf1 = {0, 0, 0, 0, 0, 0, 0, 0};
    bf16_t* s0 = cb.S0 + (size_t)(bh * NC) * 4096 + (16 * tj + fr) * 64 + 8 * fq;
    const int po0 = fr * 128 + 16 * ((fq) ^ (fr & 7)), po1 = fr * 128 + 16 * ((4 + fq) ^ (fr & 7));
    int slot = 0;
    for (int chunk = 0; chunk < NC; ++chunk) {
        unsigned spins = 0;
        while (true) { const unsigned a = flags[0], b = flags[1], c = flags[2]; const unsigned m = a < b ? (a < c ? a : c) : (b < c ? b : c); if ((int)m >= chunk + 1 || ++spins > (1u << 22)) break; __builtin_amdgcn_s_sleep(1); }
        const LAS unsigned char* sp = L + slot * SC_SLOT;
        bf16x8 a0[4], a1[4]; f32x4 z[4];
#pragma unroll
        for (int ti = 0; ti < 4; ++ti) { a0[ti] = *(const LAS bf16x8*)(sp + ti * 2048 + po0); a1[ti] = *(const LAS bf16x8*)(sp + ti * 2048 + po1); z[ti] = *(const LAS f32x4*)(sp + 8192 + fr * 256 + 16 * ((4 * ti + fq) ^ fr)); }
        asm volatile("s_waitcnt lgkmcnt(0)" ::: "memory");
        if (lane == 0) flags[3] = (unsigned)(chunk + 1);
        *(GAS bf16x8*)(s0 + (size_t)chunk * 4096) = Bf0; *(GAS bf16x8*)(s0 + (size_t)chunk * 4096 + 32) = Bf1;
        f32x4 acc[4];
#pragma unroll
        for (int ti = 0; ti < 4; ++ti) { acc[ti] = __builtin_amdgcn_mfma_f32_16x16x32_bf16(a0[ti], Bf0, z[ti], 0, 0, 0); acc[ti] = __builtin_amdgcn_mfma_f32_16x16x32_bf16(a1[ti], Bf1, acc[ti], 0, 0, 0); }
        v4u m0, m1;
        m0.x = pk2(acc[0][0], acc[0][1]); m0.y = pk2(acc[0][2], acc[0][3]); m0.z = pk2(acc[1][0], acc[1][1]); m0.w = pk2(acc[1][2], acc[1][3]);
        m1.x = pk2(acc[2][0], acc[2][1]); m1.y = pk2(acc[2][2], acc[2][3]); m1.z = pk2(acc[3][0], acc[3][1]); m1.w = pk2(acc[3][2], acc[3][3]);
        Bf0 = __builtin_bit_cast(bf16x8, m0); Bf1 = __builtin_bit_cast(bf16x8, m1);
        slot = slot + 1 == SC_NS ? 0 : slot + 1;
    }
}
__device__ __forceinline__ void scan_loader(LAS unsigned char* L, const ChunkBufs cb, int bh, int tj, int lw, int lane, volatile LAS unsigned* flags) {
    const int NC = SEQ / 64;
    const char* src[4];
#pragma unroll
    for (int k = 0; k < 4; ++k) { const int pc = 4 * lw + k;
        src[k] = pc < 8 ? (const char*)(cb.PT + (size_t)(bh * NC) * 4096) + pc * 1024 + lane * 16 : (const char*)(cb.Z + (size_t)(bh * NC) * 4096) + tj * 4096 + (pc - 8) * 1024 + lane * 16; }
    const size_t st0 = 8192, st1 = 16384;
    int slot = 0;
    for (int c = 0; c < NC; ++c) {
        unsigned spins = 0;
        while ((int)flags[3] < c - SC_NS + 1 && ++spins < (1u << 22)) __builtin_amdgcn_s_sleep(1);
        const unsigned dst = (unsigned)(slot * SC_SLOT + 4 * lw * 1024);
#pragma unroll
        for (int k = 0; k < 4; ++k) { const int pc = 4 * lw + k;
            __builtin_amdgcn_global_load_lds((const unsigned*)(src[k] + (size_t)c * (pc < 8 ? st0 : st1)), (LAS unsigned*)(L + dst + k * 1024), 16, 0, 0); }
        if (c >= SC_LAG) { asm volatile("s_waitcnt vmcnt(24)" ::: "memory"); if (lane == 0) flags[lw] = (unsigned)(c - SC_LAG + 1); }
        slot = slot + 1 == SC_NS ? 0 : slot + 1;
    }
    asm volatile("s_waitcnt vmcnt(0)" ::: "memory");
    if (lane == 0) flags[lw] = (unsigned)NC;
}
constexpr int O_SG = 0  , O_Y = 9216  , O_GT = O_Y + 16640  ;
__device__ __forceinline__ void out_phase(LAS unsigned char* L, const bf16_t* P, const sk::RwkvW W, const ChunkBufs cb, bf16_t* MIX, int tid_in, int first, int stride) {
    const int w = __builtin_amdgcn_readfirstlane(tid_in >> 6);
    LAS bf16_t* SG = (LAS bf16_t*)(L + O_SG); LAS float* Y = (LAS float*)(L + O_Y); LAS float* GT = (LAS float*)(L + O_GT);
    for (int item = first; item < NITEMS; item += stride) {
        const int bh = item / (SEQ / 64), chunk = item % (SEQ / 64), b = bh / 6, h = bh % 6; const int tok0 = b * SEQ + chunk * 64; const size_t ib = (size_t)item * 4096;
        { RW_LANES(); const int t = tid >> 3, sub = tid & 7;
#pragma unroll
          for (int e = 0; e < 8; ++e) { const int j = 8 * sub + e; SG[t * LD + j] = f2bf(1.0f / (1.0f + expf(-sk::shifted(P, tok0 + t, 640 + 1216 + j, W.mu[1216 + j])))); } }
        RW_BAR();
        { RW_LANES();
#pragma unroll
        for (int e = 0; e < 2; ++e) { const int tl = 2 * w + e, ti = tl >> 2, tj = tl & 3;
            f32x4 d = *(const GAS f32x4*)(cb.YV + ib + (16 * tj + fr) * 64 + 16 * ti + 4 * fq); f32x4 g = {0.f, 0.f, 0.f, 0.f};
#pragma unroll
            for (int kk = 0; kk < 2; ++kk) {
                const bf16x8 a = *(const GAS bf16x8*)(cb.G + ib + (16 * ti + fr) * 64 + 32 * kk + 8 * fq), bb = *(const GAS bf16x8*)(cb.S0 + ib + (16 * tj + fr) * 64 + 32 * kk + 8 * fq);
                d = __builtin_amdgcn_mfma_f32_16x16x32_bf16(a, bb, d, 0, 0, 0);
                const bf16x8 a2 = *(const LAS bf16x8*)(SG + (16 * ti + fr) * LD + 32 * kk + 8 * fq), b2 = *(const GAS bf16x8*)(cb.G2T + (size_t)(64 * h + 16 * tj + fr) * 64 + 32 * kk + 8 * fq);
                g = __builtin_amdgcn_mfma_f32_16x16x32_bf16(a2, b2, g, 0, 0, 0); }
#pragma unroll
            for (int r = 0; r < 4; ++r) { Y[(16 * ti + 4 * fq + r) * 65 + 16 * tj + fr] = d[r]; GT[(16 * ti + 4 * fq + r) * 65 + 16 * tj + fr] = g[r]; } } }
        RW_BAR();
        { RW_LANES(); const int t = tid >> 3, sub = tid & 7, tok = tok0 + t; float yv[8], s = 0.f;
#pragma unroll
          for (int e = 0; e < 8; ++e) { yv[e] = bf2f(f2bf(Y[t * 65 + 8 * sub + e])); s += yv[e]; }
          s += __shfl_xor(s, 1); s += __shfl_xor(s, 2); s += __shfl_xor(s, 4);
          const float mean = s * (1.0f / 64.0f); float q = 0.f;
#pragma unroll
          for (int e = 0; e < 8; ++e) { const float dd = yv[e] - mean; q += dd * dd; }
          q += __shfl_xor(q, 1); q += __shfl_xor(q, 2); q += __shfl_xor(q, 4);
          const float rstd = 1.0f / sqrtf(q * (1.0f / 64.0f) + GN_EPS), dot = cb.DOT[(size_t)tok * 6 + h];
          unsigned o[4];
#pragma unroll
          for (int e = 0; e < 8; e += 2) { float r2[2];
#pragma unroll
              for (int u = 0; u < 2; ++u) { const int v = 8 * sub + e + u, hc = 64 * h + v; const float yn = (yv[e + u] - mean) * rstd * W.ln_w[hc] + W.ln_b[hc];
                  r2[u] = (yn + dot * bf2f(cb.VOUT[(size_t)tok * 384 + hc])) * GT[t * 65 + v]; }
              o[e >> 1] = pk2(r2[0], r2[1]); }
          *(GAS v4u*)(MIX + (size_t)tok * DM + 384 + 64 * h + 8 * sub) = (v4u){o[0], o[1], o[2], o[3]}; }
        RW_BAR();
    }
}
}
namespace at {
constexpr int LDK = 72, LDV = 264;
constexpr int A_K = 0, A_V = 256 * LDK * 2  , A_BIAS = A_V + 64 * LDV * 2  , A_END = A_BIAS + 128 * 6 * 4;
__device__ __forceinline__ int vpos(int key) { return (key & ~31) + 8 * ((key >> 2) & 3) + 4 * ((key >> 4) & 1) + (key & 3); }
__device__ __forceinline__ unsigned pk2(float lo, float hi) { return (unsigned)f2bf(lo) | ((unsigned)f2bf(hi) << 16); }
#define AT_BAR() do { asm volatile("s_waitcnt vmcnt(0) lgkmcnt(0)" ::: "memory"); __builtin_amdgcn_s_barrier(); asm volatile("" ::: "memory"); } while (0)

__device__ __forceinline__ void stage_kv(LAS unsigned char* L, int tid, const bf16_t* kbase, const bf16_t* vbase, long pitch, int jvalid0, const float* gk) {
    LAS bf16_t* Kl = (LAS bf16_t*)(L + A_K); LAS bf16_t* VTl = (LAS bf16_t*)(L + A_V);
#pragma unroll
    for (int it = 0; it < 4; ++it) { const int idx = it * 512 + tid, key = idx >> 3, ch = idx & 7;
        v4u raw = {0u, 0u, 0u, 0u}; if (key >= jvalid0) raw = *(const GAS v4u*)(kbase + (long)key * pitch + 8 * ch);
        float f[8]; f[0] = bf2f((bf16_t)(raw.x & 0xffff)); f[1] = bf2f((bf16_t)(raw.x >> 16)); f[2] = bf2f((bf16_t)(raw.y & 0xffff)); f[3] = bf2f((bf16_t)(raw.y >> 16));
        f[4] = bf2f((bf16_t)(raw.z & 0xffff)); f[5] = bf2f((bf16_t)(raw.z >> 16)); f[6] = bf2f((bf16_t)(raw.w & 0xffff)); f[7] = bf2f((bf16_t)(raw.w >> 16));
        float ss = 0.f;
#pragma unroll
        for (int e = 0; e < 8; ++e) ss += f[e] * f[e];
        ss += __shfl_xor(ss, 1); ss += __shfl_xor(ss, 2); ss += __shfl_xor(ss, 4);
        const float rs = 1.0f / sqrtf(ss * (1.0f / 64.0f) + EPS);
        const f32x4 g0 = *(const GAS f32x4*)(gk + 8 * ch), g1 = *(const GAS f32x4*)(gk + 8 * ch + 4);
        v4u o; o.x = pk2(f[0] * rs * g0[0], f[1] * rs * g0[1]); o.y = pk2(f[2] * rs * g0[2], f[3] * rs * g0[3]); o.z = pk2(f[4] * rs * g1[0], f[5] * rs * g1[1]); o.w = pk2(f[6] * rs * g1[2], f[7] * rs * g1[3]);
        *(LAS v4u*)(Kl + key * LDK + 8 * ch) = o; }
#pragma unroll
    for (int it = 0; it < 4; ++it) { const int idx = it * 512 + tid, key = idx & 255, ch = idx >> 8;
        v4u raw = {0u, 0u, 0u, 0u}; if (key >= jvalid0) raw = *(const GAS v4u*)(vbase + (long)key * pitch + 8 * ch);
        LAS bf16_t* d = VTl + (8 * ch) * LDV + vpos(key);
        d[0 * LDV] = (bf16_t)(raw.x & 0xffff); d[1 * LDV] = (bf16_t)(raw.x >> 16); d[2 * LDV] = (bf16_t)(raw.y & 0xffff); d[3 * LDV] = (bf16_t)(raw.y >> 16);
        d[4 * LDV] = (bf16_t)(raw.z & 0xffff); d[5 * LDV] = (bf16_t)(raw.z >> 16); d[6 * LDV] = (bf16_t)(raw.w & 0xffff); d[7 * LDV] = (bf16_t)(raw.w >> 16); }
}
__device__ __forceinline__ void load_q(const bf16_t* qrow, const float* gq, int fq, bf16x8& q0, bf16x8& q1) {
    const v4u r0 = *(const GAS v4u*)(qrow + 8 * fq), r1 = *(const GAS v4u*)(qrow + 32 + 8 * fq);
    float f[16]; const unsigned w[8] = {r0.x, r0.y, r0.z, r0.w, r1.x, r1.y, r1.z, r1.w};
#pragma unroll
    for (int e = 0; e < 8; ++e) { f[2 * e] = bf2f((bf16_t)(w[e] & 0xffff)); f[2 * e + 1] = bf2f((bf16_t)(w[e] >> 16)); }
    float ss = 0.f;
#pragma unroll
    for (int e = 0; e < 16; ++e) ss += f[e] * f[e];
    ss += __shfl_xor(ss, 16); ss += __shfl_xor(ss, 32);
    const float rs = 0.125f / sqrtf(ss * (1.0f / 64.0f) + EPS);
    const f32x4 g0 = *(const GAS f32x4*)(gq + 8 * fq), g1 = *(const GAS f32x4*)(gq + 8 * fq + 4), g2 = *(const GAS f32x4*)(gq + 32 + 8 * fq), g3 = *(const GAS f32x4*)(gq + 36 + 8 * fq);
    v4u a, b;
    a.x = pk2(f[0] * rs * g0[0], f[1] * rs * g0[1]); a.y = pk2(f[2] * rs * g0[2], f[3] * rs * g0[3]); a.z = pk2(f[4] * rs * g1[0], f[5] * rs * g1[1]); a.w = pk2(f[6] * rs * g1[2], f[7] * rs * g1[3]);
    b.x = pk2(f[8] * rs * g2[0], f[9] * rs * g2[1]); b.y = pk2(f[10] * rs * g2[2], f[11] * rs * g2[3]); b.z = pk2(f[12] * rs * g3[0], f[13] * rs * g3[1]); b.w = pk2(f[14] * rs * g3[2], f[15] * rs * g3[3]);
    q0 = __builtin_bit_cast(bf16x8, a); q1 = __builtin_bit_cast(bf16x8, b);
}
template <int NT, bool SWA> __device__ __forceinline__ void attn_wave(const LAS unsigned char* L, bf16x8 q0, bf16x8 q1, int kt0, int qi0, int hq, float sink, bool first_block, bf16_t* outp, int fr, int fq) {
    const LAS bf16_t* Kl = (const LAS bf16_t*)(L + A_K); const LAS bf16_t* VTl = (const LAS bf16_t*)(L + A_V); const LAS float* bias = (const LAS float*)(L + A_BIAS);
    f32x4 s[NT];
#pragma unroll
    for (int t = 0; t < NT; ++t) { const LAS bf16_t* kr = Kl + (16 * (kt0 + t) + fr) * LDK + 8 * fq;
        const f32x4 z = {0.f, 0.f, 0.f, 0.f};
        s[t] = __builtin_amdgcn_mfma_f32_16x16x32_bf16(*(const LAS bf16x8*)kr, q0, z, 0, 0, 0);
        s[t] = __builtin_amdgcn_mfma_f32_16x16x32_bf16(*(const LAS bf16x8*)(kr + 32), q1, s[t], 0, 0, 0);
        if (t & 1) __builtin_amdgcn_sched_barrier(0); }
    float mx = SWA ? sink : -3.0e38f;
#pragma unroll
    for (int t = 0; t < NT; ++t)
#pragma unroll
        for (int r = 0; r < 4; ++r) {
            if (SWA) { const int kj = 16 * (kt0 + t) + 4 * fq + r, dist = qi0 + fr + 128 - kj; const bool valid = dist >= 0 && dist < 128 && !(first_block && kj < 128);
                s[t][r] = valid ? s[t][r] + bias[(valid ? dist : 0) * 6 + hq] : -3.0e38f; }
            mx = fmaxf(mx, s[t][r]); }
    mx = fmaxf(mx, __shfl_xor(mx, 16)); mx = fmaxf(mx, __shfl_xor(mx, 32));
    float l = 0.f;
#pragma unroll
    for (int t = 0; t < NT; ++t)
#pragma unroll
        for (int r = 0; r < 4; ++r) { const float p = __expf(s[t][r] - mx); s[t][r] = p; l += p; }
    l += __shfl_xor(l, 16); l += __shfl_xor(l, 32);
    if (SWA) l += __expf(sink - mx);
    f32x4 o[4];
#pragma unroll
    for (int dt = 0; dt < 4; ++dt) o[dt] = (f32x4){0.f, 0.f, 0.f, 0.f};
#pragma unroll
    for (int ks = 0; ks < NT / 2; ++ks) { v4u pw; pw.x = pk2(s[2 * ks][0], s[2 * ks][1]); pw.y = pk2(s[2 * ks][2], s[2 * ks][3]); pw.z = pk2(s[2 * ks + 1][0], s[2 * ks + 1][1]); pw.w = pk2(s[2 * ks + 1][2], s[2 * ks + 1][3]);
        const bf16x8 pb = __builtin_bit_cast(bf16x8, pw);
#pragma unroll
        for (int dt = 0; dt < 4; ++dt) o[dt] = __builtin_amdgcn_mfma_f32_16x16x32_bf16(*(const LAS bf16x8*)(VTl + (16 * dt + fr) * LDV + 32 * (kt0 / 2 + ks) + 8 * fq), pb, o[dt], 0, 0, 0);
        __builtin_amdgcn_sched_barrier(0); }
    const float inv = 1.0f / l;
#pragma unroll
    for (int dt = 0; dt < 4; ++dt) *(GAS unsigned long long*)(outp + (long)fr * DM + 16 * dt + 4 * fq) = (unsigned long long)pk2(o[dt][0] * inv, o[dt][1] * inv) | ((unsigned long long)pk2(o[dt][2] * inv, o[dt][3] * inv) << 32);
}
struct AttnArgs { const bf16_t* PROJ; const bf16_t* MKV; bf16_t* MIX; const float* biastab; const float *sinks, *gq, *gk, *gmq, *gmk; };
__device__ __forceinline__ void attn_item(LAS unsigned char* L, const AttnArgs A, int item, int tid_in) {
    const int w = __builtin_amdgcn_readfirstlane(tid_in >> 6);
    if (item < 256) {
        const int b = item >> 7, hkv = (item >> 6) & 1, blk = item & 63; const long tokb = (long)b * SEQ + blk * 128;
        { int lt_ = tid_in; asm volatile("" : "+v"(lt_)); const int tid = lt_;
          stage_kv(L, tid, A.PROJ + (tokb - 128) * LDP + 384 + 64 * hkv, A.PROJ + (tokb - 128) * LDP + 512 + 64 * hkv, LDP, blk == 0 ? 128 : 0, A.gk);
          LAS float* bl = (LAS float*)(L + A_BIAS); for (int i = tid; i < 768; i += 512) bl[i] = A.biastab[i]; }
        AT_BAR();
        { int lt_ = tid_in; asm volatile("" : "+v"(lt_)); const int lane = lt_ & 63, fr = lane & 15, fq = lane >> 4;
#pragma unroll 1
          for (int g = 0; g < 3; ++g) { const int hq = 3 * hkv + g; bf16x8 q0, q1;
              load_q(A.PROJ + (tokb + 16 * w + fr) * LDP + 64 * hq, A.gq, fq, q0, q1);
              attn_wave<10, true>(L, q0, q1, w & ~1, 16 * w, hq, A.sinks[hq], blk == 0, A.MIX + (tokb + 16 * w) * DM + 64 * hq, fr, fq); } }
        AT_BAR();
    } else {
        const int pr = item - 256, b = pr >> 7, h = (pr >> 5) & 3, blk2 = pr & 31;
        { int lt_ = tid_in; asm volatile("" : "+v"(lt_)); const int tid = lt_;
          stage_kv(L, tid, A.MKV + (long)(b * 256) * 512 + 64 * h, A.MKV + (long)(b * 256) * 512 + 256 + 64 * h, 512, 0, A.gmk); }
        AT_BAR();
        { int lt_ = tid_in; asm volatile("" : "+v"(lt_)); const int lane = lt_ & 63, fr = lane & 15, fq = lane >> 4;
#pragma unroll 1
          for (int u = 0; u < 2; ++u) { const long tokb = (long)b * SEQ + (2 * blk2 + u) * 128; bf16x8 q0, q1;
              load_q(A.PROJ + (tokb + 16 * w + fr) * LDP + 1920 + 64 * h, A.gmq, fq, q0, q1);
              attn_wave<16, false>(L, q0, q1, 0, 16 * w, 0, 0.f, false, A.MIX + (tokb + 16 * w) * DM + 768 + 64 * h, fr, fq); } }
        AT_BAR();
    }
}
}
constexpr int NWAVES = 8;
namespace mk {
constexpr size_t WS_CTL = 0, CTL_ZERO_BYTES = 1 * MiB;
constexpr size_t CTL_SSQ = 512 * 1024;
constexpr size_t WS_SMALL = 1 * MiB, SM_BIAS = 0, SM_SSQM = 4096, SM_MKV = 512 * 1024;
constexpr size_t WS_MEMB = 2 * MiB, WS_WT = 3 * MiB, WS_XB = 28 * MiB, WS_VF = 60 * MiB, WS_PROJ = 72 * MiB, WS_MIX = 144 * MiB, WS_PREP = 176 * MiB, WS_U = 72 * MiB, WS_ACT = 160 * MiB, WS_END = 248 * MiB;
constexpr size_t WT_IN = 0, WT_OUT = 4718592, WT_UP = WT_OUT + 2 * MiB, WT_DOWN = WT_UP + 11 * MiB, WT_MKV = WT_DOWN + 5767168;
constexpr int CW_TMO = 0, CW_BAR = 4096;
constexpr int LDS_BYTES = 163840, LDSCTL_OFF = LDS_BYTES - 512, MISC_OFF = LDSCTL_OFF + 320;
constexpr size_t SM_W2T = 8192, SM_A2T = 32768, SM_V2T = 57344, SM_G2T = 81920;
constexpr size_t WS_PT = 176 * MiB, WS_G = 188 * MiB, WS_S0 = 200 * MiB, WS_Z = 212 * MiB, WS_V1 = 236 * MiB, WS_YV = 28 * MiB  , WS_DOT = 52 * MiB;
#ifndef PROF_PH
#define PROF_PH -1
#endif
#ifndef PROF_N
#define PROF_N 1
#endif
#define REPEAT(k) for (int rep_ = 0; rep_ < ((PROF_PH) == (k) ? (PROF_N) : 1); ++rep_)
#ifndef FAST_RWKV
#define FAST_RWKV 1
#endif
#ifndef FAST_ATTN
#define FAST_ATTN 1
#endif

struct Args { const float* in[N_IN]; float* out; unsigned char* ws; int ph_lo, ph_hi; };

__device__ __forceinline__ unsigned pk2(float lo, float hi) { return (unsigned)f2bf(lo) | ((unsigned)f2bf(hi) << 16); }
__device__ __forceinline__ float wave_sum(float v) {
#pragma unroll
    for (int o = 1; o < 64; o <<= 1) v += __shfl_xor(v, o);
    return v;
}
template <bool UPPERM> __device__ __forceinline__ void transpose_item(const float* W, const float* g, int K, int N, bf16_t* WT, LAS float* scr, int item, int lane) {
    const int nblk = N / 32, kb = item / nblk, nb = item % nblk, k0 = 64 * kb, n0 = 32 * nb;
#pragma unroll 8
    for (int i = 0; i < 32; ++i) { const int kk = 2 * i + (lane >> 5); float v = W[(size_t)(k0 + kk) * N + n0 + (lane & 31)]; if (g) v *= g[k0 + kk]; scr[kk * 33 + (lane & 31)] = v; }
    LDS_WAIT(); asm volatile("" ::: "memory");
    const int c = lane & 7;
#pragma unroll
    for (int j = 0; j < 4; ++j) { const int n = (lane >> 3) + 8 * j; const LAS float* s = scr + (8 * c) * 33 + n;
        v4u o; o.x = pk2(s[0 * 33], s[1 * 33]); o.y = pk2(s[2 * 33], s[3 * 33]); o.z = pk2(s[4 * 33], s[5 * 33]); o.w = pk2(s[6 * 33], s[7 * 33]);
        int nr = n0 + n; if (UPPERM) nr = nr < 2816 ? 256 * (nr >> 7) + (nr & 127) : 256 * ((nr - 2816) >> 7) + 128 + ((nr - 2816) & 127);
        *(GAS v4u*)(WT + (size_t)nr * K + k0 + 8 * c) = o; }
    LDS_WAIT(); asm volatile("" ::: "memory");
}
__device__ __forceinline__ void row_to_bf16(const float* xrow, bf16_t* orow, float* ssq_out, int lane) {
    const GAS f32x4* xr = (const GAS f32x4*)xrow + lane; f32x4 v[4]; float s = 0.f;
#pragma unroll
    for (int j = 0; j < 4; ++j) { v[j] = xr[64 * j]; s += (v[j].x * v[j].x + v[j].y * v[j].y) + (v[j].z * v[j].z + v[j].w * v[j].w); }
    s = wave_sum(s);
    GAS unsigned long long* o8 = (GAS unsigned long long*)orow + lane;
#pragma unroll
    for (int j = 0; j < 4; ++j) o8[64 * j] = (unsigned long long)pk2(v[j].x, v[j].y) | ((unsigned long long)pk2(v[j].z, v[j].w) << 32);
    if (lane == 0) *ssq_out = s;
}

__global__ void __launch_bounds__(NWAVES * 64, 2) mk_fwd(Args args) {
    extern __shared__ __attribute__((aligned(16))) unsigned char lds[];
    LAS unsigned char* L = (LAS unsigned char*)lds;
    volatile LAS unsigned* MISC = (volatile LAS unsigned*)(L + MISC_OFF);
    const int tid0 = threadIdx.x; const int wave0 = __builtin_amdgcn_readfirstlane(tid0 >> 6);
    const int G = gridDim.x;
    unsigned char* ws = args.ws;
    gu32* ctl = (gu32*)(ws + WS_CTL);
    for (int u = tid0; u < (LDS_BYTES - LDSCTL_OFF) / 4; u += NWAVES * 64) ((LAS unsigned*)(L + LDSCTL_OFF))[u] = 0u;
    __syncthreads();
    XcdBarrier bar = xcd_barrier_post((unsigned*)(ctl + CW_BAR), MISC + 8);
    const int lo = args.ph_lo, hi = args.ph_hi;
    int ph = 0;
#define PH_BEGIN if (lo <= ph && ph < hi) { unsigned char* wsp = args.ws; asm volatile("" : "+s"(wsp)); int tid = wave0 * 64 + (int)__builtin_amdgcn_mbcnt_hi(~0u, __builtin_amdgcn_mbcnt_lo(~0u, 0u)); asm volatile("" : "+v"(tid)); const int lane = tid & 63, wave = __builtin_amdgcn_readfirstlane(tid >> 6); const long gtid = (long)blockIdx.x * (NWAVES * 64) + tid; const int gw = blockIdx.x * NWAVES + wave; LAS float* scr = (LAS float*)(L + wave * 16384); (void)lane; (void)gtid; (void)gw; (void)scr;
#define PH_END   if (ph + 1 < hi) xcd_barrier(bar); } ++ph;
    float* out = args.out;
#define SSQ_A ((float*)(wsp + WS_CTL + CTL_SSQ))
#define SSQ_B (SSQ_A + 3 * MTOK)
#define biastab ((float*)(wsp + WS_SMALL + SM_BIAS))
#define ssqm ((float*)(wsp + WS_SMALL + SM_SSQM))
#define MKV ((bf16_t*)(wsp + WS_SMALL + SM_MKV))
#define MEMB ((bf16_t*)(wsp + WS_MEMB))
#define Wt_in ((bf16_t*)(wsp + WS_WT + WT_IN))
#define Wt_out ((bf16_t*)(wsp + WS_WT + WT_OUT))
#define Wt_up ((bf16_t*)(wsp + WS_WT + WT_UP))
#define Wt_down ((bf16_t*)(wsp + WS_WT + WT_DOWN))
#define Wt_mkv ((bf16_t*)(wsp + WS_WT + WT_MKV))
#define XB ((bf16_t*)(wsp + WS_XB))
#define VF ((bf16_t*)(wsp + WS_VF))
#define PROJ ((bf16_t*)(wsp + WS_PROJ))
#define MIX ((bf16_t*)(wsp + WS_MIX))
#define U ((bf16_t*)(wsp + WS_U))
#define ACT ((bf16_t*)(wsp + WS_ACT))
#define PA ((size_t)MTOK * 384)
#define pR ((bf16_t*)(wsp + WS_PREP))
#define pK (pR + PA)
#define pV (pR + 2 * PA)
#define pKK (pR + 3 * PA)
#define pB (pR + 4 * PA)
#define pLD (pR + 5 * PA)
    const long gsize = (long)G * (NWAVES * 64);
    const int NGW = G * NWAVES;

#define MK_W() sk::RwkvW W{args.in[I_MU] + l * 1280, args.in[I_MUV], args.in[I_W0] + l * 384, args.in[I_W2] + l * 32 * 384, args.in[I_A0] + l * 384, args.in[I_A2] + l * 32 * 384, args.in[I_V0], args.in[I_V2], args.in[I_G2] + l * 64 * 384, args.in[I_KK] + l * 384, args.in[I_KA] + l * 384, args.in[I_RK] + l * 384, args.in[I_LNW] + l * 384, args.in[I_LNB] + l * 384};
#define MK_CBUF() const rw::ChunkBufs cbuf{(bf16_t*)(wsp + WS_PT), (bf16_t*)(wsp + WS_G), (float*)(wsp + WS_Z), (float*)(wsp + WS_YV), (bf16_t*)(wsp + WS_S0), (bf16_t*)(wsp + (l == 0 ? WS_VF : WS_V1)), (float*)(wsp + WS_DOT), (const bf16_t*)(wsp + WS_SMALL + SM_W2T), (const bf16_t*)(wsp + WS_SMALL + SM_A2T), (const bf16_t*)(wsp + WS_SMALL + SM_V2T), (const bf16_t*)(wsp + WS_SMALL + SM_G2T)};
    for (int l = 0; l < 2; ++l) {
        const float* xin = l == 0 ? args.in[I_X] : out;
        PH_BEGIN
            REPEAT(0) {
            const int I_IN = 16 * 68, I_OUT = 16 * 32, I_UP = 16 * 176, I_DN = 44 * 32, I_KV = 16 * 16, NIT = I_IN + I_OUT + I_UP + I_DN + I_KV;
            for (int it = gw; it < NIT; it += NGW) {
                int r = it;
                if (r < I_IN) { transpose_item<false>(args.in[I_WIN] + (size_t)l * 1024 * 2176, args.in[I_MIXG] + l * 1024, 1024, 2176, Wt_in, scr, r, lane); continue; } r -= I_IN;
                if (r < I_OUT) { transpose_item<false>(args.in[I_WOUT] + (size_t)l * 1024 * 1024, nullptr, 1024, 1024, Wt_out, scr, r, lane); continue; } r -= I_OUT;
                if (r < I_UP) { transpose_item<true>(args.in[I_WUP] + (size_t)l * 1024 * 5632, args.in[I_FFNG] + l * 1024, 1024, 5632, Wt_up, scr, r, lane); continue; } r -= I_UP;
                if (r < I_DN) { transpose_item<false>(args.in[I_WDOWN] + (size_t)l * 2816 * 1024, nullptr, 2816, 1024, Wt_down, scr, r, lane); continue; } r -= I_DN;
                transpose_item<false>(args.in[I_WMKV] + (size_t)l * 1024 * 512, args.in[I_MEMG] + l * 1024, 1024, 512, Wt_mkv, scr, r, lane);
            }
            for (long i = gtid; i < 128 * 1024; i += gsize) { const int n = (int)(i >> 10), k = (int)(i & 1023); float v = 0.f;
                if (l > 0 && n < 16) v = args.in[I_WINV][k * 16 + n] * args.in[I_MIXG][l * 1024 + k];
                Wt_in[(size_t)(2176 + n) * 1024 + k] = f2bf(v); }
            for (long i = gtid; i < 384 * 160; i += gsize) { const int hc = (int)(i / 160), j = (int)(i % 160); bf16_t* sm = (bf16_t*)(wsp + WS_SMALL);
                if (j < 32) sm[SM_W2T / 2 + hc * 32 + j] = f2bf(args.in[I_W2][(size_t)l * 32 * 384 + j * 384 + hc]);
                else if (j < 64) sm[SM_A2T / 2 + hc * 32 + (j - 32)] = f2bf(args.in[I_A2][(size_t)l * 32 * 384 + (j - 32) * 384 + hc]);
                else if (j < 96) sm[SM_V2T / 2 + hc * 32 + (j - 64)] = f2bf((j - 64) < 16 ? args.in[I_V2][(j - 64) * 384 + hc] : 0.f);
                else sm[SM_G2T / 2 + hc * 64 + (j - 96)] = f2bf(args.in[I_G2][(size_t)l * 64 * 384 + (j - 96) * 384 + hc]); }
            if (l == 0) {
                for (int m = gw; m < MTOK; m += NGW) row_to_bf16(args.in[I_X] + (size_t)m * DM, XB + (size_t)m * DM, SSQ_A + m, lane);
                for (int m = gw; m < 512; m += NGW) row_to_bf16(args.in[I_MEM] + (size_t)m * DM, MEMB + (size_t)m * DM, ssqm + m, lane);
                sk::d_biastab(args.in[I_RELB], biastab, gtid, gsize);
            }
            }
        PH_END
        PH_BEGIN
            REPEAT(1)
            { pg8::Gemm g{XB, Wt_in, MTOK, 2304, 1024}; pg8::StaticOrder S; S.init(MTOK, 2304, G, (int)blockIdx.x);
              pg8::EpiScaleBf16 E{PROJ, LDP, SSQ_A + (size_t)l * MTOK};
              pg8::gemm_phase<pg8::EpiScaleBf16, pg8::StaticOrder, true, true>(L, g, S, E, tid); }
            { pg8::Gemm g{MEMB, Wt_mkv, 512, 512, 1024}; pg8::StaticOrder S; S.init(512, 512, G, (int)((blockIdx.x + 192) % G));
              pg8::EpiScaleBf16 E{MKV, 512, ssqm};
              pg8::gemm_phase<pg8::EpiScaleBf16, pg8::StaticOrder, true, true>(L, g, S, E, tid); }
        PH_END


        PH_BEGIN
            MK_W(); MK_CBUF(); (void)cbuf;
#if !FAST_ATTN
            sk::d_qknorm(PROJ, MTOK, LDP, args.in[I_AQN] + l * 64, args.in[I_AKN] + l * 64, args.in[I_MQN] + l * 64, 0, gtid, gsize);
            sk::d_qknorm(MKV, 512, 512, nullptr, nullptr, args.in[I_MKN] + l * 64, 1, gtid, gsize);
#endif
#if FAST_RWKV
            REPEAT(2) rw::chunk_phase(L, PROJ, W, l, VF, cbuf, tid, (int)blockIdx.x, G);
#else
            sk::d_rwkv_prep(PROJ, W, l, VF, pR, pK, pV, pKK, pB, pLD, gtid, gsize);
#endif
        PH_END
        PH_BEGIN
            MK_CBUF(); (void)cbuf;
            if (blockIdx.x < 48) {
#if FAST_RWKV
                REPEAT(3) { __syncthreads(); if (tid < 8) MISC[16 + tid] = 0u; __syncthreads();
                  const int sbh = (int)blockIdx.x >> 2, stj = (int)blockIdx.x & 3;
                  if (wave == 0) rw::scan_compute(L, cbuf, sbh, stj, lane, MISC + 16); else if (wave < 4) rw::scan_loader(L, cbuf, sbh, stj, wave - 1, lane, MISC + 16); }
#endif
            } else {
#if FAST_ATTN
                const at::AttnArgs A{PROJ, MKV, MIX, biastab, args.in[I_SINK] + l * 6, args.in[I_AQN] + l * 64, args.in[I_AKN] + l * 64, args.in[I_MQN] + l * 64, args.in[I_MKN] + l * 64};
                REPEAT(7) for (int it = (int)blockIdx.x - 48; it < 512; it += G - 48) at::attn_item(L, A, it, tid);
#else
                const long gt2 = (long)(blockIdx.x - BATCH * 6) * (NWAVES * 64) + tid, gs2 = (long)(G - BATCH * 6) * (NWAVES * 64);
                REPEAT(7) sk::d_swa(PROJ, MIX, biastab, args.in[I_SINK] + l * 6, gt2, gs2);
                REPEAT(8) sk::d_memattn(PROJ, MKV, MIX, gt2, gs2);
#endif
            }
        PH_END
        PH_BEGIN
            MK_W(); MK_CBUF(); (void)cbuf;
#if FAST_RWKV
            REPEAT(4) rw::out_phase(L, PROJ, W, cbuf, MIX, tid, (int)blockIdx.x, G);
#else
            sk::d_rwkv_fin(PROJ, W, pR, pK, pV, MIX, gtid, gsize);
#endif
        PH_END
        PH_BEGIN
            pg8::Gemm g{MIX, Wt_out, MTOK, 1024, 1024}; pg8::StaticOrder S; S.init(MTOK, 1024, G, (int)blockIdx.x);
            pg8::EpiResid E{xin, out, XB, SSQ_B + (size_t)l * MTOK, 1024};
            pg8::gemm_phase<pg8::EpiResid, pg8::StaticOrder, true, true>(L, g, S, E, tid);
        PH_END
        PH_BEGIN
            REPEAT(5) {
            pg8::Gemm g{XB, Wt_up, 66 * 256, 5632, 1024}; pg8::StaticOrder S; S.init(66 * 256, 5632, G, (int)blockIdx.x);
            pg8::EpiConvAct E{ACT, SSQ_B + (size_t)l * MTOK, args.in[I_CW] + (size_t)l * 3 * 5632, args.in[I_CB] + (size_t)l * 5632};
            pg8::gemm_phase<pg8::EpiConvAct, pg8::StaticOrder, true, true>(L, g, S, E, tid); }
        PH_END
        PH_BEGIN
            pg8::Gemm g{ACT, Wt_down, MTOK, 1024, 2816}; pg8::StaticOrder S; S.init(MTOK, 1024, G, (int)blockIdx.x);
            pg8::EpiResid E{out, out, XB, SSQ_A + (size_t)(l + 1) * MTOK, 1024};
            pg8::gemm_phase<pg8::EpiResid, pg8::StaticOrder, true, true>(L, g, S, E, tid);
        PH_END
    }
#undef PH_BEGIN
#undef PH_END
}
constexpr int N_PHASES = 2 * 8;
}

#ifndef MK_PER_PHASE
#define MK_PER_PHASE 0
#endif
extern "C" void kernel_launch(void* const* d_in, const int* in_sizes, int n_in, void* d_out, int out_size, void* d_ws, size_t ws_size, hipStream_t stream) {
    static int grid = 0;
    if (grid == 0) {
        if (n_in != N_IN || out_size != MTOK * DM || ws_size < mk::WS_END) { fprintf(stderr, "kernel_launch: unexpected shapes (n_in %d out %d ws %zu)\n", n_in, out_size, ws_size); grid = -1; return; }
        int dev = 0, cus = 0, per_cu = 0;
        if (hipGetDevice(&dev) != hipSuccess || hipDeviceGetAttribute(&cus, hipDeviceAttributeMultiprocessorCount, dev) != hipSuccess) { grid = -1; return; }
        if (hipFuncSetAttribute((const void*)mk::mk_fwd, hipFuncAttributeMaxDynamicSharedMemorySize, mk::LDS_BYTES) != hipSuccess) { fprintf(stderr, "kernel_launch: hipFuncSetAttribute failed\n"); grid = -1; return; }
        if (hipOccupancyMaxActiveBlocksPerMultiprocessor(&per_cu, (const void*)mk::mk_fwd, NWAVES * 64, mk::LDS_BYTES) != hipSuccess || per_cu < 1) { fprintf(stderr, "kernel_launch: occupancy query says %d blocks per CU\n", per_cu); }
        (void)hipGetLastError();
        grid = cus;
    }
    if (grid < 0) return;
    if (hipMemsetAsync((char*)d_ws + mk::WS_CTL, 0, mk::CTL_ZERO_BYTES, stream) != hipSuccess) return;
    mk::Args a{};
    for (int i = 0; i < N_IN; ++i) a.in[i] = (const float*)d_in[i];
    a.out = (float*)d_out; a.ws = (unsigned char*)d_ws;
#if MK_PER_PHASE
    for (int p = 0; p < mk::N_PHASES; ++p) { a.ph_lo = p; a.ph_hi = p + 1; hipLaunchKernelGGL(mk::mk_fwd, dim3(grid), dim3(NWAVES * 64), mk::LDS_BYTES, stream, a); }
#else
    a.ph_lo = 0; a.ph_hi = mk::N_PHASES;
    hipLaunchKernelGGL(mk::mk_fwd, dim3(grid), dim3(NWAVES * 64), mk::LDS_BYTES, stream, a);
#endif
}
```

```cpp
#define MK_BUILD 1
#ifndef HOST_SIM
#include <hip/hip_runtime.h>
#include <cstdio>
#include <cstdint>
#endif
#ifndef SEQ_LEN
#define SEQ_LEN 8192
#endif
typedef unsigned short bf16_t;
constexpr int BATCH = 2, SEQ = SEQ_LEN, DM = 1024, MTOK = BATCH * SEQ, DFF = 2816, LDP = 2304  ;
constexpr float EPS = 1e-6f, GN_EPS = 64e-5f;
__host__ __device__ __forceinline__ float bf2f(bf16_t h) { unsigned u = (unsigned)h << 16; return __builtin_bit_cast(float, u); }
__host__ __device__ __forceinline__ bf16_t f2bf(float f) { unsigned u = __builtin_bit_cast(unsigned, f); return (bf16_t)((u + 0x7fffu + ((u >> 16) & 1u)) >> 16); }
__host__ __device__ __forceinline__ int t5_bucket(int dist) {
    if (dist < 16) return dist;
    const float v = logf((float)dist / 16.0f) / 2.0794415416798357f * 16.0f;
    int large = 16 + (int)v; return large < 31 ? large : 31;
}
constexpr size_t MiB = 1u << 20;
enum { I_X = 0, I_MEM, I_RELB, I_MIXG, I_WIN, I_WINV, I_AQN, I_AKN, I_SINK, I_MU, I_MUV, I_W0, I_W2, I_A0, I_A2, I_V0, I_V2, I_G2, I_KK, I_KA, I_RK, I_LNW, I_LNB, I_MEMG, I_WMKV, I_MQN, I_MKN, I_WOUT, I_FFNG, I_WUP, I_CW, I_CB, I_WDOWN, N_IN };
#ifndef PROF_PH
#define PROF_PH -1
#endif
#ifndef PROF_N
#define PROF_N 1
#endif
namespace sk {

__device__ __forceinline__ void d_wt(const float* W, const float* g, bf16_t* Wt, int K, int N, int Npad, long gtid, long gsize) {
    const long total = (long)Npad * K;
    for (long idx = gtid; idx < total; idx += gsize) {
        const int n = (int)(idx / K), k = (int)(idx % K);
        float v = 0.f;
        if (n < N) { v = W[(long)k * N + n]; if (g) v *= g[k]; }
        Wt[idx] = f2bf(v);
    }
}
#ifndef MK_BUILD
__global__ void k_wt(const float* W, const float* g, bf16_t* Wt, int K, int N, int Npad) { d_wt(W, g, Wt, K, N, Npad, (long)blockIdx.x * blockDim.x + threadIdx.x, (long)gridDim.x * blockDim.x); }
#endif
__device__ __forceinline__ void d_rowprep(const float* x, bf16_t* xb, float* ssq, int rows, long gtid, long gsize) {
    for (long r = gtid; r < rows; r += gsize) {
        const float* xr = x + (long)r * DM; bf16_t* o = xb + (long)r * DM; float s = 0.f;
        for (int c = 0; c < DM; ++c) { const float v = xr[c]; s += v * v; o[c] = f2bf(v); }
        ssq[r] = s;
    }
}
#ifndef MK_BUILD
__global__ void k_rowprep(const float* x, bf16_t* xb, float* ssq, int rows) { d_rowprep(x, xb, ssq, rows, (long)blockIdx.x * blockDim.x + threadIdx.x, (long)gridDim.x * blockDim.x); }
#endif
__device__ __forceinline__ void d_biastab(const float* rel_bias, float* tab, long gtid, long gsize) {
        for (long i = gtid; i < 128 * 6; i += gsize) { const int dist = i / 6, hq = i % 6; tab[i] = rel_bias[t5_bucket(dist) * 6 + hq]; }
}
#ifndef MK_BUILD
__global__ void k_biastab(const float* rel_bias, float* tab) { d_biastab(rel_bias, tab, (long)blockIdx.x * blockDim.x + threadIdx.x, (long)gridDim.x * blockDim.x); }
#endif
__device__ __forceinline__ void d_qknorm(bf16_t* P, int rows, int ld, const float* gq, const float* gk, const float* gm, int mode, long gtid, long gsize) {
    const int nj = mode == 0 ? 12 : 4;
    const long total = (long)rows * nj;
    for (long idx = gtid; idx < total; idx += gsize) {
        const int row = (int)(idx / nj), j = (int)(idx % nj);
        int col; const float* g;
        if (mode == 0) { if (j < 6) { col = 64 * j; g = gq; } else if (j < 8) { col = 384 + 64 * (j - 6); g = gk; } else { col = 1920 + 64 * (j - 8); g = gm; } }
        else { col = 64 * j; g = gm; }
        bf16_t* p = P + (long)row * ld + col; float s = 0.f;
        for (int d = 0; d < 64; ++d) { const float v = bf2f(p[d]); s += v * v; }
        const float rs = 1.0f / sqrtf(s * (1.0f / 64.0f) + EPS);
        for (int d = 0; d < 64; ++d) p[d] = f2bf(bf2f(p[d]) * rs * g[d]);
    }
}
#ifndef MK_BUILD
__global__ void k_qknorm(bf16_t* P, int rows, int ld, const float* gq, const float* gk, const float* gm, int mode) { d_qknorm(P, rows, ld, gq, gk, gm, mode, (long)blockIdx.x * blockDim.x + threadIdx.x, (long)gridDim.x * blockDim.x); }
#endif
__device__ __forceinline__ void d_swa(const bf16_t* P, bf16_t* MIX, const float* biastab, const float* sinks, long gtid, long gsize) {
    const long total = (long)MTOK * 6;
    for (long idx = gtid; idx < total; idx += gsize) {
        const int tok = (int)(idx / 6), hq = (int)(idx % 6), hkv = hq / 3, t = tok % SEQ;
        float q[64], o[64];
#pragma unroll
        for (int d = 0; d < 64; ++d) { q[d] = bf2f(P[(long)tok * LDP + 64 * hq + d]) * 0.125f; o[d] = 0.f; }
        float m = sinks[hq], l = 1.0f;
        const int j0 = t - 127 < 0 ? 0 : t - 127;
        for (int j = j0; j <= t; ++j) {
            const bf16_t* kr = P + (long)(tok - (t - j)) * LDP + 384 + 64 * hkv; const bf16_t* vr = kr + 128;
            float s = 0.f;
#pragma unroll
            for (int d = 0; d < 64; ++d) s += q[d] * bf2f(kr[d]);
            s += biastab[(t - j) * 6 + hq];
            const float mn = fmaxf(m, s), f = expf(m - mn), e = expf(s - mn);
            l = l * f + e; m = mn;
#pragma unroll
            for (int d = 0; d < 64; ++d) o[d] = o[d] * f + e * bf2f(vr[d]);
        }
        const float inv = 1.0f / l;
#pragma unroll
        for (int d = 0; d < 64; ++d) MIX[(long)tok * DM + 64 * hq + d] = f2bf(o[d] * inv);
    }
}
#ifndef MK_BUILD
__global__ __launch_bounds__(256) void k_swa(const bf16_t* P, bf16_t* MIX, const float* biastab, const float* sinks) { d_swa(P, MIX, biastab, sinks, (long)blockIdx.x * blockDim.x + threadIdx.x, (long)gridDim.x * blockDim.x); }
#endif
__device__ __forceinline__ void d_memattn(const bf16_t* P, const bf16_t* MKV, bf16_t* MIX, long gtid, long gsize) {
    const long total = (long)MTOK * 4;
    for (long idx = gtid; idx < total; idx += gsize) {
        const int tok = (int)(idx / 4), h = (int)(idx % 4), b = tok / SEQ;
        float q[64], o[64];
#pragma unroll
        for (int d = 0; d < 64; ++d) { q[d] = bf2f(P[(long)tok * LDP + 1920 + 64 * h + d]) * 0.125f; o[d] = 0.f; }
        float m = -1e30f, l = 0.f;
        for (int j = 0; j < 256; ++j) {
            const bf16_t* kr = MKV + (long)(b * 256 + j) * 512 + 64 * h; const bf16_t* vr = kr + 256;
            float s = 0.f;
#pragma unroll
            for (int d = 0; d < 64; ++d) s += q[d] * bf2f(kr[d]);
            const float mn = fmaxf(m, s), f = expf(m - mn), e = expf(s - mn);
            l = l * f + e; m = mn;
#pragma unroll
            for (int d = 0; d < 64; ++d) o[d] = o[d] * f + e * bf2f(vr[d]);
        }
        const float inv = 1.0f / l;
#pragma unroll
        for (int d = 0; d < 64; ++d) MIX[(long)tok * DM + 768 + 64 * h + d] = f2bf(o[d] * inv);
    }
}
#ifndef MK_BUILD
__global__ __launch_bounds__(256) void k_memattn(const bf16_t* P, const bf16_t* MKV, bf16_t* MIX) { d_memattn(P, MKV, MIX, (long)blockIdx.x * blockDim.x + threadIdx.x, (long)gridDim.x * blockDim.x); }
#endif
__device__ __forceinline__ float shifted(const bf16_t* P, int tok, int col, float mu) {
    const float p = bf2f(P[(long)tok * LDP + col]);
    const float prev = (tok % SEQ) == 0 ? 0.f : bf2f(P[(long)(tok - 1) * LDP + col]);
    return p + mu * (prev - p);
}
struct RwkvW { const float *mu, *mu_v, *w0, *w2, *a0, *a2, *v0, *v2, *g2, *k_k, *k_a, *r_k, *ln_w, *ln_b; };
__device__ __forceinline__ void d_rwkv_prep(const bf16_t* P, RwkvW W, int layer, bf16_t* VFIRST, bf16_t* R, bf16_t* K, bf16_t* V, bf16_t* KK, bf16_t* B, bf16_t* LOGD, long gtid, long gsize) {
    const long total = (long)MTOK * 6;
    for (long idx = gtid; idx < total; idx += gsize) {
        const int tok = (int)(idx / 6), h = (int)(idx % 6);
        float nrm = 0.f;
        for (int c = 0; c < 64; ++c) { const int hc = 64 * h + c; const float kc = shifted(P, tok, 640 + 384 + hc, W.mu[384 + hc]) * W.k_k[hc]; nrm += kc * kc; }
        const float rn = 1.0f / fmaxf(sqrtf(nrm), 1e-12f);
        for (int c = 0; c < 64; ++c) {
            const int hc = 64 * h + c; const long o = (long)tok * 384 + hc;
            const float r = shifted(P, tok, 640 + hc, W.mu[hc]);
            const float k = shifted(P, tok, 640 + 384 + hc, W.mu[384 + hc]);
            float v = shifted(P, tok, 640 + 768 + hc, W.mu[768 + hc]);
            float wp = W.w0[hc], ap = W.a0[hc];
            for (int j = 0; j < 32; ++j) {
                wp += tanhf(shifted(P, tok, 640 + 1152 + j, W.mu[1152 + j])) * W.w2[j * 384 + hc];
                ap += shifted(P, tok, 640 + 1184 + j, W.mu[1184 + j]) * W.a2[j * 384 + hc];
            }
            const float z = -wp; const float sp = fmaxf(z, 0.f) + log1pf(expf(-fabsf(z)));
            const float w = -sp - 0.5f;
            const float a = 1.0f / (1.0f + expf(-ap));
            if (layer > 0) {
                float vp = W.v0[hc];
                for (int j = 0; j < 16; ++j) vp += shifted(P, tok, 2176 + j, W.mu_v[j]) * W.v2[j * 384 + hc];
                const float vf = bf2f(VFIRST[o]);
                v = v + (vf - v) * (1.0f / (1.0f + expf(-vp)));
            } else VFIRST[o] = f2bf(v);
            const float kk = k * W.k_k[hc] * rn;
            R[o] = f2bf(r); K[o] = f2bf(k * (1.0f + (a - 1.0f) * W.k_a[hc])); V[o] = f2bf(v);
            KK[o] = f2bf(kk); B[o] = f2bf(kk * a); LOGD[o] = f2bf(-expf(w));
        }
    }
}
#ifndef MK_BUILD
__global__ void k_rwkv_prep(const bf16_t* P, RwkvW W, int layer, bf16_t* VFIRST, bf16_t* R, bf16_t* K, bf16_t* V, bf16_t* KK, bf16_t* B, bf16_t* LOGD) { d_rwkv_prep(P, W, layer, VFIRST, R, K, V, KK, B, LOGD, (long)blockIdx.x * blockDim.x + threadIdx.x, (long)gridDim.x * blockDim.x); }
#endif
__device__ __forceinline__ void d_rwkv_scan(const bf16_t* R, const bf16_t* K, const bf16_t* V, const bf16_t* KK, const bf16_t* B, const bf16_t* LOGD, bf16_t* MIX, int bh, int i) {
    const int b = bh / 6, h = bh % 6;
    float s[64];
#pragma unroll
    for (int k = 0; k < 64; ++k) s[k] = 0.f;
    for (int t = 0; t < SEQ; ++t) {
        const long o = (long)(b * SEQ + t) * 384 + 64 * h;
        float sa = 0.f;
#pragma unroll
        for (int k = 0; k < 64; ++k) sa -= s[k] * bf2f(KK[o + k]);
        const float v = bf2f(V[o + i]); float y = 0.f;
#pragma unroll
        for (int k = 0; k < 64; ++k) { s[k] = s[k] * expf(bf2f(LOGD[o + k])) + sa * bf2f(B[o + k]) + v * bf2f(K[o + k]); y += s[k] * bf2f(R[o + k]); }
        MIX[(long)(b * SEQ + t) * DM + 384 + 64 * h + i] = f2bf(y);
    }
}
#ifndef MK_BUILD
__global__ void k_rwkv_scan(const bf16_t* R, const bf16_t* K, const bf16_t* V, const bf16_t* KK, const bf16_t* B, const bf16_t* LOGD, bf16_t* MIX) { d_rwkv_scan(R, K, V, KK, B, LOGD, MIX, blockIdx.x, threadIdx.x); }
#endif
__device__ __forceinline__ void d_rwkv_fin(const bf16_t* P, RwkvW W, const bf16_t* R, const bf16_t* K, const bf16_t* V, bf16_t* MIX, long gtid, long gsize) {
    const long total = (long)MTOK * 6;
    for (long idx = gtid; idx < total; idx += gsize) {
        const int tok = (int)(idx / 6), h = (int)(idx % 6);
        bf16_t* y = MIX + (long)tok * DM + 384 + 64 * h; const long o = (long)tok * 384 + 64 * h;
        float mean = 0.f, dot = 0.f;
        for (int c = 0; c < 64; ++c) { mean += bf2f(y[c]); dot += bf2f(R[o + c]) * bf2f(K[o + c]) * W.r_k[64 * h + c]; }
        mean *= (1.0f / 64.0f); float var = 0.f;
        for (int c = 0; c < 64; ++c) { const float d = bf2f(y[c]) - mean; var += d * d; }
        const float rstd = 1.0f / sqrtf(var * (1.0f / 64.0f) + GN_EPS);
        for (int c = 0; c < 64; ++c) {
            const int hc = 64 * h + c; float g = 0.f;
            for (int j = 0; j < 64; ++j) g += (1.0f / (1.0f + expf(-shifted(P, tok, 640 + 1216 + j, W.mu[1216 + j])))) * W.g2[j * 384 + hc];
            const float yn = (bf2f(y[c]) - mean) * rstd * W.ln_w[hc] + W.ln_b[hc];
            y[c] = f2bf((yn + dot * bf2f(V[o + c])) * g);
        }
    }
}
#ifndef MK_BUILD
__global__ void k_rwkv_fin(const bf16_t* P, RwkvW W, const bf16_t* R, const bf16_t* K, const bf16_t* V, bf16_t* MIX) { d_rwkv_fin(P, W, R, K, V, MIX, (long)blockIdx.x * blockDim.x + threadIdx.x, (long)gridDim.x * blockDim.x); }
#endif
__device__ __forceinline__ void d_conv_act(const bf16_t* U, const float* cw, const float* cb, bf16_t* ACT, int rows, long gtid, long gsize) {
    const long total = (long)rows * DFF;
    for (long idx = gtid; idx < total; idx += gsize) {
        const int t = (int)(idx / DFF), c = (int)(idx % DFF);
        float gate = cb[c], val = cb[DFF + c];
#pragma unroll
        for (int i = 0; i < 3; ++i) { const int tt = t - 2 + i; if (tt >= 0) { gate += cw[i * 2 * DFF + c] * bf2f(U[(long)tt * 2 * DFF + c]); val += cw[i * 2 * DFF + DFF + c] * bf2f(U[(long)tt * 2 * DFF + DFF + c]); } }
        ACT[(long)t * DFF + c] = f2bf(gate / (1.0f + expf(-gate)) * val);
    }
}
#ifndef MK_BUILD
__global__ void k_conv_act(const bf16_t* U, const float* cw, const float* cb, bf16_t* ACT, int rows) { d_conv_act(U, cw, cb, ACT, rows, (long)blockIdx.x * blockDim.x + threadIdx.x, (long)gridDim.x * blockDim.x); }
#endif
}
namespace pg8 {
#define PG8_LAS __attribute__((address_space(3)))
typedef unsigned short bf16_t;
typedef short bf16x8 __attribute__((ext_vector_type(8)));
typedef float f32x4 __attribute__((ext_vector_type(4)));
typedef unsigned u32x4 __attribute__((ext_vector_type(4)));
constexpr int BM = 256, BK = 64, HALF = 128, HTB = HALF * BK * 2  , STAGE_BYTES = 8 * HTB, NXCD = 8, WGM = 8;

__host__ __device__ __forceinline__ int lds_byte(int r, int c) { const int st = (r >> 4) * 2 + (c >> 5), rr = r & 15, cc = c & 31, ob = rr * 64 + cc * 2; return st * 1024 + (ob ^ (((ob >> 9) & 1) << 5)); }
__host__ __device__ __forceinline__ void stage_rc(int b, int& R, int& C) { const int st = b / 1024, sb = b % 1024, swz = sb ^ (((sb >> 9) & 1) << 5); R = (st >> 1) * 16 + swz / 64; C = (st & 1) * 32 + (swz % 64) / 2; }
__host__ __device__ __forceinline__ int perm32(int rho) { const int n = rho >> 4, i = rho & 15; return 8 * (i >> 2) + 4 * n + (i & 3); }

struct Unit { int pm, pn; };
struct Gemm { const bf16_t* A; const bf16_t* Bt; int M, N, K; };

struct StaticOrder {
    int nM, nN, nwg, G, c;
    __host__ __device__ void init(int M, int N, int G_, int c_) { nM = M / BM; nN = N / BM; nwg = nM * nN; G = G_; c = c_; }
    __host__ __device__ bool next(int i, Unit& u) const {
        const long L = (long)i * G + c; if (L >= nwg) return false;
        int wgid = (int)L; { const int q = nwg / NXCD, r = nwg % NXCD, xcd = wgid % NXCD, off = wgid / NXCD; wgid = (xcd < r ? xcd * (q + 1) : r * (q + 1) + (xcd - r) * q) + off; }
        const int nig = WGM * nN, gid = wgid / nig, fm = gid * WGM, gsz = (nM - fm) < WGM ? (nM - fm) : WGM;
        u.pm = fm + ((wgid % nig) % gsz); u.pn = (wgid % nig) / gsz; return true;
    }
    __device__ __forceinline__ void a_ready(const Unit&) const {}
    __device__ __forceinline__ void done(const Unit&) const {}
};

__device__ __forceinline__ unsigned cvt_pk_bf16(float lo, float hi) { unsigned r; asm volatile("v_cvt_pk_bf16_f32 %0, %1, %2" : "=v"(r) : "v"(lo), "v"(hi)); return r; }
struct EpiScaleBf16 {
    static constexpr bool PERM = true, AFTER_DRAIN = false; static constexpr int AMAP = 0;
    bf16_t* O; int ldc; const float* ssq;
    __device__ __forceinline__ void operator()(const f32x4 (&acc)[2][2][4][2], const Unit& u, int wr, int wc, int fr, int fq) const {
        const int row0 = u.pm * BM + wr * 64 + fr, col0 = u.pn * BM + wc * 32 + 8 * fq;
#pragma unroll
        for (int ai = 0; ai < 2; ++ai)
#pragma unroll
            for (int m = 0; m < 4; ++m) { const int row = row0 + ai * HALF + m * 16; const float sc = 1.0f / sqrtf(ssq[row] * (1.0f / 1024.0f) + 1e-6f);
                bf16_t* rowp = O + (size_t)row * ldc + col0;
#pragma unroll
                for (int bj = 0; bj < 2; ++bj) { const f32x4 v0 = acc[ai][bj][m][0] * sc, v1 = acc[ai][bj][m][1] * sc;
                    u32x4 w; w.x = cvt_pk_bf16(v0[0], v0[1]); w.y = cvt_pk_bf16(v0[2], v0[3]); w.z = cvt_pk_bf16(v1[0], v1[1]); w.w = cvt_pk_bf16(v1[2], v1[3]);
                    *(u32x4*)(rowp + bj * HALF) = w; } }
    }
};
struct EpiResid {
    static constexpr bool PERM = false, AFTER_DRAIN = false; static constexpr int AMAP = 0;
    const float* base; float* out; bf16_t* xb; float* ssq; int ldc;
    __device__ __forceinline__ void operator()(const f32x4 (&acc)[2][2][4][2], const Unit& u, int wr, int wc, int fr, int fq) const {
        typedef unsigned u32x2v __attribute__((ext_vector_type(2)));
        const int col0 = u.pn * BM + wc * 32 + 4 * fq;
#pragma unroll
        for (int ai = 0; ai < 2; ++ai)
#pragma unroll
            for (int m = 0; m < 4; ++m) { const int row = u.pm * BM + ai * HALF + wr * 64 + m * 16 + fr; const size_t off = (size_t)row * ldc + col0; float sq = 0.f;
#pragma unroll
                for (int bj = 0; bj < 2; ++bj)
#pragma unroll
                    for (int n = 0; n < 2; ++n) { const f32x4 o = *(const f32x4*)(base + off + bj * HALF + n * 16) + acc[ai][bj][m][n];
                        *(f32x4*)(out + off + bj * HALF + n * 16) = o; sq += (o[0] * o[0] + o[1] * o[1]) + (o[2] * o[2] + o[3] * o[3]);
                        u32x2v w; w.x = cvt_pk_bf16(o[0], o[1]); w.y = cvt_pk_bf16(o[2], o[3]); *(u32x2v*)(xb + off + bj * HALF + n * 16) = w; }
                sq += __shfl_xor(sq, 16); sq += __shfl_xor(sq, 32);
                if (fq == 0) atomicAdd(ssq + row, sq); }
    }
};
struct EpiConvAct {
    static constexpr bool PERM = true, AFTER_DRAIN = false; static constexpr int AMAP = 1;
    bf16_t* ACT; const float* ssq; const float* cw; const float* cb;
    static __device__ __forceinline__ float shr1s(float x) { float r; asm volatile("s_nop 1\n\tv_mov_b32_dpp %0, %1 row_shr:1 row_mask:0xf bank_mask:0xf bound_ctrl:1" : "=v"(r) : "v"(x)); return r; }
    static __device__ __forceinline__ f32x4 shr1(f32x4 v) { f32x4 r; r[0] = shr1s(v[0]); r[1] = shr1s(v[1]); r[2] = shr1s(v[2]); r[3] = shr1s(v[3]); return r; }
    __device__ __forceinline__ void operator()(const f32x4 (&acc)[2][2][4][2], const Unit& u, int wr, int wc, int fr, int fq) const {
        const int b = u.pm / 33, pmb = u.pm % 33;
        const int pos0 = 252 * pmb + 126 * wr + 8 * fr - 2;
        const long row0 = (long)b * SEQ + pos0;
        float rs[8];
#pragma unroll
        for (int j = 0; j < 8; ++j) { const int pos = pos0 + j; const bool ok = pos >= 0 && pos < SEQ; const float q = ssq[ok ? row0 + j : 0]; rs[j] = ok ? 1.0f / sqrtf(q * (1.0f / 1024.0f) + 1e-6f) : 0.f; }
        const int ch0 = 128 * u.pn + 32 * wc + 8 * fq;
        unsigned ow[8][4];
#pragma unroll
        for (int n = 0; n < 2; ++n) { const int c = ch0 + 4 * n;
            const f32x4 w0g = *(const f32x4*)(cw + c), w1g = *(const f32x4*)(cw + 5632 + c), w2g = *(const f32x4*)(cw + 2 * 5632 + c), bg = *(const f32x4*)(cb + c);
            const f32x4 w0v = *(const f32x4*)(cw + 2816 + c), w1v = *(const f32x4*)(cw + 5632 + 2816 + c), w2v = *(const f32x4*)(cw + 2 * 5632 + 2816 + c), bv = *(const f32x4*)(cb + 2816 + c);
            f32x4 gm2 = shr1(acc[1][0][2][n] * rs[6]), gm1 = shr1(acc[1][0][3][n] * rs[7]), vm2 = shr1(acc[1][1][2][n] * rs[6]), vm1 = shr1(acc[1][1][3][n] * rs[7]);
#pragma unroll
            for (int j = 0; j < 8; ++j) { const f32x4 gj = acc[j >> 2][0][j & 3][n] * rs[j], vj = acc[j >> 2][1][j & 3][n] * rs[j];
                const f32x4 ug = bg + w0g * gm2 + w1g * gm1 + w2g * gj, uv = bv + w0v * vm2 + w1v * vm1 + w2v * vj; f32x4 a;
#pragma unroll
                for (int e = 0; e < 4; ++e) a[e] = ug[e] / (1.0f + __expf(-ug[e])) * uv[e];
                ow[j][2 * n] = cvt_pk_bf16(a[0], a[1]); ow[j][2 * n + 1] = cvt_pk_bf16(a[2], a[3]);
                gm2 = gm1; gm1 = gj; vm2 = vm1; vm1 = vj; } }
#pragma unroll
        for (int j = 0; j < 8; ++j) if (8 * fr + j >= 2 && pos0 + j < SEQ) { u32x4 w; w.x = ow[j][0]; w.y = ow[j][1]; w.z = ow[j][2]; w.w = ow[j][3]; *(u32x4*)(ACT + (size_t)(row0 + j) * 2816 + ch0) = w; }
    }
};
template <class Epi, class Sched, bool ALIGN_EPI = false, bool SP2 = false>
__device__ __forceinline__ void gemm_phase(PG8_LAS unsigned char* lds, const Gemm g, const Sched& S, const Epi& E, int tid_in) {
    int tid = tid_in; asm volatile("" : "+v"(tid));
    const int wid = __builtin_amdgcn_readfirstlane(tid >> 6), lane = tid & 63, wr = wid >> 2, wc = wid & 3, fr = lane & 15, fq = lane >> 4;
    const int K = g.K, nt = K / BK;
    unsigned voffA[2], voffB[2];
#pragma unroll
    for (int i = 0; i < 2; ++i) { int R, C; stage_rc(tid * 16 + i * 8192, R, C); const int Rb = Epi::PERM ? ((R & ~31) + perm32(R & 31)) : R;
        const int Ra = Epi::AMAP ? (126 * (R >> 6) + 8 * (R & 15) + ((R >> 4) & 3)) : R;
        voffA[i] = (unsigned)(Ra * K + C) * 2u; voffB[i] = (unsigned)(Rb * K + C) * 2u; }
    const size_t kstep = (size_t)(BK * 2);
    const size_t hstepB = (size_t)HALF * K * 2;
    const size_t hstepA = Epi::AMAP ? (size_t)4 * K * 2 : hstepB;
    const size_t tstep = 2 * hstepB;
#define PG8_ABASE(pm_) (Epi::AMAP ? (long)((long)((pm_) / 33) * SEQ + 252 * ((pm_) % 33) - 2) * (long)K * 2 : (long)(pm_) * (long)tstep)
    const unsigned ldsw = (unsigned)wid * 1024u;
    const int aoff = lds_byte(wr * 64 + fr, fq * 8), boff = lds_byte(wc * 32 + fr, fq * 8);
#define PG8_SA(b, h) (((b) * 2 + (h)) * HTB)
#define PG8_SB(b, h) ((4 + (b) * 2 + (h)) * HTB)
#define PG8_STAGE(bufoff, gbase, voff) do { _Pragma("unroll") for (int _i = 0; _i < 2; ++_i) \
        __builtin_amdgcn_global_load_lds((const unsigned*)((const char*)(gbase) + (voff)[_i]), (PG8_LAS unsigned*)(lds + (bufoff) + ldsw + _i * 8192), 16, 0, 0); } while (0)
#define PG8_LDA(dst, b, h) do { _Pragma("unroll") for (int m = 0; m < 4; ++m) _Pragma("unroll") for (int k = 0; k < 2; ++k) dst[m][k] = *(const PG8_LAS bf16x8*)(lds + PG8_SA(b, h) + aoff + m * 2048 + k * 1024); } while (0)
#define PG8_LDB(dst, b, h) do { _Pragma("unroll") for (int n = 0; n < 2; ++n) _Pragma("unroll") for (int k = 0; k < 2; ++k) dst[n][k] = *(const PG8_LAS bf16x8*)(lds + PG8_SB(b, h) + boff + n * 2048 + k * 1024); } while (0)
#define PG8_MMA(ai, bj, At, Bt) do { __builtin_amdgcn_s_setprio(1); _Pragma("unroll") for (int m = 0; m < 4; ++m) _Pragma("unroll") for (int n = 0; n < 2; ++n) _Pragma("unroll") for (int k = 0; k < 2; ++k) \
        acc[ai][bj][m][n] = __builtin_amdgcn_mfma_f32_16x16x32_bf16(Bt[n][k], At[m][k], acc[ai][bj][m][n], 0, 0, 0); __builtin_amdgcn_s_setprio(0); } while (0)
#define PG8_WAIT_V(n) asm volatile("s_waitcnt vmcnt(" #n ")" ::: "memory")
#define PG8_WAIT_L(n) asm volatile("s_waitcnt lgkmcnt(" #n ")" ::: "memory")
#define PG8_BAR __builtin_amdgcn_s_barrier()
#define PG8_SCHED __builtin_amdgcn_sched_barrier(0)
    Unit cur, nxt; int ui = 0;
    if (!S.next(0, cur)) return;
    f32x4 acc[2][2][4][2];
#pragma unroll
    for (int a = 0; a < 2; ++a)
#pragma unroll
        for (int b = 0; b < 2; ++b)
#pragma unroll
            for (int m = 0; m < 4; ++m)
#pragma unroll
                for (int n = 0; n < 2; ++n) acc[a][b][m][n] = (f32x4){0.f, 0.f, 0.f, 0.f};
    bf16x8 At[4][2], B0[2][2], B1[2][2];
    const char* cA = (const char*)g.A + PG8_ABASE(cur.pm); const char* cB = (const char*)g.Bt + (size_t)cur.pn * tstep;
    S.a_ready(cur);
    if constexpr (SP2) {
        PG8_STAGE(PG8_SB(0, 0), cB, voffB); PG8_STAGE(PG8_SB(0, 1), cB + hstepB, voffB); PG8_STAGE(PG8_SA(0, 0), cA, voffA); PG8_STAGE(PG8_SA(0, 1), cA + hstepA, voffA);
        if (wr == 1) PG8_BAR;
        PG8_WAIT_V(2); PG8_BAR;
        PG8_STAGE(PG8_SB(1, 0), cB + kstep, voffB); PG8_STAGE(PG8_SA(1, 0), cA + kstep, voffA); PG8_STAGE(PG8_SB(1, 1), cB + hstepB + kstep, voffB);
        PG8_WAIT_V(6); PG8_BAR;
    } else {
        PG8_STAGE(PG8_SB(0, 0), cB, voffB); PG8_STAGE(PG8_SA(0, 0), cA, voffA); PG8_STAGE(PG8_SB(0, 1), cB + hstepB, voffB); PG8_STAGE(PG8_SA(0, 1), cA + hstepA, voffA);
        if (wr == 1) PG8_BAR;
        PG8_WAIT_V(4); PG8_BAR;
        PG8_STAGE(PG8_SB(1, 0), cB + kstep, voffB); PG8_STAGE(PG8_SA(1, 0), cA + kstep, voffA); PG8_STAGE(PG8_SB(1, 1), cB + hstepB + kstep, voffB);
        PG8_WAIT_V(6); PG8_BAR;
    }
    for (;;) {
        const bool has_next = S.next(ui + 1, nxt);
        const char* nA = has_next ? (const char*)g.A + PG8_ABASE(nxt.pm) : cA; const char* nB = has_next ? (const char*)g.Bt + (size_t)nxt.pn * tstep : cB;
        for (int t = 0; t < nt; t += 2) {
            const bool last = (t == nt - 2);
            const char* a1 = cA + (size_t)(t + 1) * kstep;
            const char* a2 = last ? nA : cA + (size_t)(t + 2) * kstep; const char* b2 = last ? nB : cB + (size_t)(t + 2) * kstep;
            const char* a3 = a2 + kstep; const char* b3 = b2 + kstep;
            if (last && has_next) S.a_ready(nxt);
            if constexpr (SP2) {
            PG8_LDB(B0, 0, 0); PG8_LDB(B1, 0, 1); PG8_SCHED; PG8_LDA(At, 0, 0); PG8_STAGE(PG8_SA(1, 1), a1 + hstepA, voffA);
            PG8_WAIT_V(8); PG8_WAIT_L(0); PG8_BAR; PG8_MMA(0, 0, At, B0); PG8_MMA(0, 1, At, B1); PG8_BAR; PG8_SCHED;
            PG8_LDA(At, 0, 1); PG8_STAGE(PG8_SB(0, 0), b2, voffB); PG8_STAGE(PG8_SB(0, 1), b2 + hstepB, voffB); PG8_STAGE(PG8_SA(0, 0), a2, voffA);
            PG8_WAIT_V(8); PG8_WAIT_L(0); PG8_BAR; PG8_MMA(1, 0, At, B0); PG8_MMA(1, 1, At, B1); PG8_BAR; PG8_SCHED;
            PG8_LDB(B0, 1, 0); PG8_LDB(B1, 1, 1); PG8_SCHED; PG8_LDA(At, 1, 0); PG8_STAGE(PG8_SA(0, 1), a2 + hstepA, voffA);
            PG8_WAIT_V(8); PG8_WAIT_L(0); PG8_BAR; PG8_MMA(0, 0, At, B0); PG8_MMA(0, 1, At, B1); PG8_BAR; PG8_SCHED;
            PG8_LDA(At, 1, 1); PG8_STAGE(PG8_SB(1, 0), b3, voffB); PG8_STAGE(PG8_SB(1, 1), b3 + hstepB, voffB); PG8_STAGE(PG8_SA(1, 0), a3, voffA);
            PG8_WAIT_V(8); PG8_WAIT_L(0); PG8_BAR; PG8_MMA(1, 0, At, B0); PG8_MMA(1, 1, At, B1); PG8_BAR; PG8_SCHED;
            } else {
            PG8_LDB(B0, 0, 0); PG8_SCHED; PG8_LDA(At, 0, 0); PG8_STAGE(PG8_SA(1, 1), a1 + hstepA, voffA);
            PG8_WAIT_L(8); PG8_BAR; PG8_WAIT_L(0); PG8_MMA(0, 0, At, B0); PG8_BAR; PG8_SCHED;
            PG8_LDB(B1, 0, 1); PG8_STAGE(PG8_SB(0, 0), b2, voffB);
            PG8_BAR; PG8_WAIT_L(0); PG8_MMA(0, 1, At, B1); PG8_BAR;
            PG8_LDA(At, 0, 1); PG8_STAGE(PG8_SA(0, 0), a2, voffA);
            PG8_BAR; PG8_WAIT_L(0); PG8_MMA(1, 0, At, B0); PG8_BAR; PG8_SCHED;
            PG8_STAGE(PG8_SB(0, 1), b2 + hstepB, voffB);
            PG8_WAIT_V(6); PG8_BAR; PG8_MMA(1, 1, At, B1); PG8_BAR;
            PG8_LDB(B0, 1, 0); PG8_SCHED; PG8_LDA(At, 1, 0); PG8_STAGE(PG8_SA(0, 1), a2 + hstepA, voffA);
            PG8_WAIT_L(8); PG8_BAR; PG8_WAIT_L(0); PG8_MMA(0, 0, At, B0); PG8_BAR; PG8_SCHED;
            PG8_LDB(B1, 1, 1); PG8_STAGE(PG8_SB(1, 0), b3, voffB);
            PG8_BAR; PG8_WAIT_L(0); PG8_MMA(0, 1, At, B1); PG8_BAR;
            PG8_LDA(At, 1, 1); PG8_STAGE(PG8_SA(1, 0), a3, voffA);
            PG8_BAR; PG8_WAIT_L(0); PG8_MMA(1, 0, At, B0); PG8_BAR; PG8_SCHED;
            PG8_STAGE(PG8_SB(1, 1), b3 + hstepB, voffB);
            PG8_WAIT_V(6); PG8_BAR; PG8_MMA(1, 1, At, B1); PG8_BAR;
            }
        }
        if constexpr (ALIGN_EPI) { if (wr == 0) PG8_BAR; }
        if constexpr (!Epi::AFTER_DRAIN) { E(acc, cur, wr, wc, fr, fq); S.done(cur); }
        if (!has_next) break;
#pragma unroll
        for (int a = 0; a < 2; ++a)
#pragma unroll
            for (int b = 0; b < 2; ++b)
#pragma unroll
                for (int m = 0; m < 4; ++m)
#pragma unroll
                    for (int n = 0; n < 2; ++n) acc[a][b][m][n] = (f32x4){0.f, 0.f, 0.f, 0.f};
        cur = nxt; cA = nA; cB = nB; ++ui;
        if constexpr (ALIGN_EPI) { if (wr == 1) PG8_BAR; }
    }
    PG8_WAIT_V(0);
    if constexpr (!ALIGN_EPI) { if (wr == 0) PG8_BAR; }
    PG8_BAR;
    if constexpr (Epi::AFTER_DRAIN) { E.fused(acc, cur, wr, wc, fr, fq, lds, wid, lane); S.done(cur); }
#undef PG8_ABASE
#undef PG8_SA
#undef PG8_SB
#undef PG8_STAGE
#undef PG8_LDA
#undef PG8_LDB
#undef PG8_MMA
#undef PG8_WAIT_V
#undef PG8_WAIT_L
#undef PG8_BAR
#undef PG8_SCHED
}
}

#ifndef PG8_SP2
#define PG8_SP2 true
#endif
#ifndef PG8_ALIGN
#define PG8_ALIGN true
#endif
#define GAS __attribute__((address_space(1)))
#define LAS __attribute__((address_space(3)))
typedef unsigned short bf16;
typedef unsigned v4u __attribute__((ext_vector_type(4)));
typedef float f32x4 __attribute__((ext_vector_type(4)));
typedef short bf16x8 __attribute__((ext_vector_type(8)));
typedef GAS unsigned gu32;
typedef GAS unsigned long long gu64;
#define RLX_AGENT __ATOMIC_RELAXED, __HIP_MEMORY_SCOPE_AGENT
#define LDS_WAIT() asm volatile("s_waitcnt lgkmcnt(0)" ::: "memory")
#define VM_WAIT() asm volatile("s_waitcnt vmcnt(0)" ::: "memory")
__device__ __forceinline__ unsigned long long rt() { return __builtin_amdgcn_s_memrealtime(); }

#define XB_TMO      128
#define XB_XCNT(j)  (256  + 64 * (j))
#define XB_XSUB(j)  (1280 + 64 * (j))
#define XB_XGEN(j)  (2304 + 64 * (j))
#define XB_TOP      3328
#define XB_TOPGEN   3392
#define XCD_BAR_WORDS 3456
#define XB_SPIN_CAP (1u << 20)

__device__ __forceinline__ unsigned xb_ld(unsigned* p)              { return __hip_atomic_load(p, __ATOMIC_RELAXED, __HIP_MEMORY_SCOPE_AGENT); }
__device__ __forceinline__ unsigned xb_add(unsigned* p, unsigned v) { return __hip_atomic_fetch_add(p, v, __ATOMIC_RELAXED, __HIP_MEMORY_SCOPE_AGENT); }
__device__ __forceinline__ unsigned xb_xcc_id() { return (unsigned)__builtin_amdgcn_s_getreg((3 << 11) | 20) & 0xFu; }
#define XB_SPIN(cond, bar) do { unsigned _sp = 0; while (cond) { __builtin_amdgcn_s_sleep(1); \
    if ((++_sp & 255u) == 0u) { if (xb_ld(&(bar)[XB_TMO])) break; if (_sp > XB_SPIN_CAP) { atomicAdd(&(bar)[XB_TMO], 1u); break; } } } } while (0)

struct XcdBarrier {
    unsigned* bar; unsigned x;
    volatile LAS unsigned* st;
};

__device__ __forceinline__ XcdBarrier xcd_barrier_post(unsigned* bar, volatile LAS unsigned* st) {
    XcdBarrier b; b.bar = bar; b.x = xb_xcc_id(); b.st = st;
    if (threadIdx.x == 0) (void)xb_add(&bar[XB_XCNT(b.x)], 1u);
    return b;
}
__device__ __forceinline__ void xcd_barrier_complete(unsigned* bar, unsigned x, unsigned& nloc, unsigned& nx) {
    const unsigned G = gridDim.x * gridDim.y * gridDim.z;
    unsigned sum, cnt, mine, sp = 0u;
    for (;;) {
        sum = 0u; cnt = 0u; mine = 0u;
#pragma unroll
        for (unsigned j = 0; j < 16; ++j) { const unsigned c = xb_ld(&bar[XB_XCNT(j)]); sum += c; cnt += (c > 0u) ? 1u : 0u; mine = (j == x) ? c : mine; }
        if (sum == G) break;
        __builtin_amdgcn_s_sleep(1);
        if ((++sp & 255u) == 0u) { if (xb_ld(&bar[XB_TMO])) break; if (sp > XB_SPIN_CAP) { atomicAdd(&bar[XB_TMO], 1u); break; } }
    }
    nloc = mine > 0u ? mine : 1u; nx = cnt > 0u ? cnt : 1u;
}

__device__ __forceinline__ void xcd_barrier(const XcdBarrier& b) {
    asm volatile("s_waitcnt vmcnt(0)" ::: "memory");
    __syncthreads();
    if (threadIdx.x == 0) {
        unsigned* bar = b.bar;
        __builtin_amdgcn_s_waitcnt(0);
        unsigned nloc = b.st[0], nx = b.st[1];
        if (nloc == 0u) { xcd_barrier_complete(bar, b.x, nloc, nx); b.st[0] = nloc; b.st[1] = nx; }
        const unsigned old = xb_add(&bar[XB_XSUB(b.x)], 1u);
        const unsigned gen = old / nloc;
        if (old + 1u == (gen + 1u) * nloc) {
            __builtin_amdgcn_fence(__ATOMIC_RELEASE, "agent");
            asm volatile("s_waitcnt vmcnt(0)" ::: "memory");
            const unsigned og = xb_add(&bar[XB_TOP], 1u);
            const unsigned tg = og / nx;
            if (og + 1u == (tg + 1u) * nx) xb_add(&bar[XB_TOPGEN], 1u);
            else XB_SPIN(xb_ld(&bar[XB_TOPGEN]) == tg, bar);
            __builtin_amdgcn_fence(__ATOMIC_ACQUIRE, "agent");
            xb_add(&bar[XB_XGEN(b.x)], 1u);
            asm volatile("s_waitcnt vmcnt(0)" ::: "memory");
        } else {
            XB_SPIN(xb_ld(&bar[XB_XGEN(b.x)]) == gen, bar);
            __builtin_amdgcn_fence(__ATOMIC_ACQUIRE, "agent");
            asm volatile("s_waitcnt vmcnt(0)" ::: "memory");
        }
    }
    __syncthreads();
}

namespace rw {
constexpr int LD = 72;
constexpr int MATB = 64 * LD * 2;
constexpr int OFF_F0 = 12 * MATB  , OFF_TMP = OFF_F0 + 64 * 65 * 4  ;
constexpr int OFF_TW = 8 * MATB  , OFF_TA = OFF_TW + 5120, OFF_TV = OFF_TA + 5120, OFF_WP = OFF_TV + 5120  , OFF_AP = OFF_WP + 16640, OFF_VP = OFF_AP + 16640;
constexpr int OFF_TOT = 139264, OFF_GC = OFF_TOT + 2048, OFF_RN = OFF_GC + 256, OFF_END = OFF_RN + 256;
constexpr int NITEMS = BATCH * 6 * (SEQ / 64);
__device__ __forceinline__ int sigpos(int c) { return (c & 32) + 8 * ((c >> 2) & 3) + 4 * ((c >> 4) & 1) + (c & 3); }
#define RW_BAR() do { asm volatile("s_waitcnt lgkmcnt(0)" ::: "memory"); __builtin_amdgcn_s_barrier(); asm volatile("" ::: "memory"); } while (0)
__device__ __forceinline__ float fexp(float x) { return __expf(x); }
__device__ __forceinline__ float fsigm(float x) { return 1.0f / (1.0f + __expf(-x)); }
__device__ __forceinline__ float ftanh(float x) { const float e = __expf(-2.0f * fabsf(x)); const float t = (1.0f - e) / (1.0f + e); return x < 0.f ? -t : t; }
__device__ __forceinline__ f32x4 mm_tile(const LAS bf16_t* A, const LAS bf16_t* Bt, int ti, int tj, int fr, int fq, f32x4 acc) {
#pragma unroll
    for (int kk = 0; kk < 2; ++kk) {
        const bf16x8 a = *(const LAS bf16x8*)(A + (16 * ti + fr) * LD + 32 * kk + 8 * fq);
        const bf16x8 b = *(const LAS bf16x8*)(Bt + (16 * tj + fr) * LD + 32 * kk + 8 * fq);
        acc = __builtin_amdgcn_mfma_f32_16x16x32_bf16(a, b, acc, 0, 0, 0);
    }
    return acc;
}
__device__ __forceinline__ unsigned pk2(float lo, float hi) { return (unsigned)f2bf(lo) | ((unsigned)f2bf(hi) << 16); }
struct ChunkBufs { bf16_t* PT; bf16_t* G; float* Z; float* YV; bf16_t* S0; bf16_t* VOUT; float* DOT; const bf16_t *W2T, *A2T, *V2T, *G2T; };

#define RW_LANES() int lt_ = tid_in; asm volatile("" : "+v"(lt_)); const int tid = lt_, lane = lt_ & 63, fr = lane & 15, fq = lane >> 4; (void)tid; (void)fr; (void)fq
__device__ __forceinline__ void chunk_phase(LAS unsigned char* L, const bf16_t* P, const sk::RwkvW W, int layer, const bf16_t* VFIRST, const ChunkBufs cb, int tid_in, int first, int stride) {
    const int w = __builtin_amdgcn_readfirstlane(tid_in >> 6);
    LAS bf16_t* B0 = (LAS bf16_t*)(L + 0 * MATB); LAS bf16_t* B1 = (LAS bf16_t*)(L + 1 * MATB); LAS bf16_t* B2 = (LAS bf16_t*)(L + 2 * MATB); LAS bf16_t* B3 = (LAS bf16_t*)(L + 3 * MATB);
    LAS bf16_t* B4 = (LAS bf16_t*)(L + 4 * MATB); LAS bf16_t* B5 = (LAS bf16_t*)(L + 5 * MATB); LAS bf16_t* B6 = (LAS bf16_t*)(L + 6 * MATB); LAS bf16_t* B7 = (LAS bf16_t*)(L + 7 * MATB);
    LAS bf16_t* B8 = (LAS bf16_t*)(L + 8 * MATB); LAS bf16_t* B9 = (LAS bf16_t*)(L + 9 * MATB); LAS bf16_t* B10 = (LAS bf16_t*)(L + 10 * MATB); LAS bf16_t* B11 = (LAS bf16_t*)(L + 11 * MATB);
    LAS float* F0 = (LAS float*)(L + OFF_F0); LAS float* TMP = (LAS float*)(L + OFF_TMP);
    LAS bf16_t* TW = (LAS bf16_t*)(L + OFF_TW); LAS bf16_t* TA = (LAS bf16_t*)(L + OFF_TA); LAS bf16_t* TV = (LAS bf16_t*)(L + OFF_TV);
    LAS float* WP = (LAS float*)(L + OFF_WP); LAS float* AP = (LAS float*)(L + OFF_AP); LAS float* VP = (LAS float*)(L + OFF_VP);
    LAS float* TOT = (LAS float*)(L + OFF_TOT); LAS float* GC = (LAS float*)(L + OFF_GC); LAS float* RN = (LAS float*)(L + OFF_RN);
    for (int item = first; item < NITEMS; item += stride) {
        const int bh = item / (SEQ / 64), chunk = item % (SEQ / 64), b = bh / 6, h = bh % 6;
        const int tok0 = b * SEQ + chunk * 64;
        for (int rp_ = 0; rp_ < ((PROF_PH) == 20 ? 2 : 1); ++rp_) {
        { RW_LANES(); const int t = tid >> 3, sub = tid & 7, tok = tok0 + t;
#pragma unroll
          for (int e = 0; e < 4; ++e) { const int j = 4 * sub + e;
              TW[t * 40 + j] = f2bf(ftanh(sk::shifted(P, tok, 640 + 1152 + j, W.mu[1152 + j])));
              TA[t * 40 + j] = f2bf(sk::shifted(P, tok, 640 + 1184 + j, W.mu[1184 + j])); }
          if (layer > 0) {
#pragma unroll
              for (int e = 0; e < 2; ++e) { const int j = 2 * sub + e; TV[t * 40 + j] = f2bf(sk::shifted(P, tok, 2176 + j, W.mu_v[j])); TV[t * 40 + 16 + j] = 0; } }
          float s = 0.f;
#pragma unroll
          for (int e = 0; e < 8; ++e) { const int hc = 64 * h + 8 * sub + e; const float kc = sk::shifted(P, tok, 640 + 384 + hc, W.mu[384 + hc]) * W.k_k[hc]; s += kc * kc; }
          s += __shfl_xor(s, 1); s += __shfl_xor(s, 2); s += __shfl_xor(s, 4);
          if (sub == 0) RN[t] = 1.0f / fmaxf(sqrtf(s), 1e-12f); }
        RW_BAR();
        }
        { RW_LANES();
#pragma unroll
        for (int e = 0; e < 2; ++e) { const int tl = 2 * w + e, ti = tl >> 2, tj = tl & 3; const f32x4 z4 = {0.f, 0.f, 0.f, 0.f};
            const size_t brow = (size_t)(64 * h + 16 * tj + fr) * 32 + 8 * fq;
            { const bf16x8 a = *(const LAS bf16x8*)(TW + (16 * ti + fr) * 40 + 8 * fq); const bf16x8 bb = *(const GAS bf16x8*)(cb.W2T + brow);
              const f32x4 d = __builtin_amdgcn_mfma_f32_16x16x32_bf16(a, bb, z4, 0, 0, 0);
#pragma unroll
              for (int r = 0; r < 4; ++r) WP[(16 * ti + 4 * fq + r) * 65 + 16 * tj + fr] = d[r]; }
            { const bf16x8 a = *(const LAS bf16x8*)(TA + (16 * ti + fr) * 40 + 8 * fq); const bf16x8 bb = *(const GAS bf16x8*)(cb.A2T + brow);
              const f32x4 d = __builtin_amdgcn_mfma_f32_16x16x32_bf16(a, bb, z4, 0, 0, 0);
#pragma unroll
              for (int r = 0; r < 4; ++r) AP[(16 * ti + 4 * fq + r) * 65 + 16 * tj + fr] = d[r]; }
            if (layer > 0) { const bf16x8 a = *(const LAS bf16x8*)(TV + (16 * ti + fr) * 40 + 8 * fq); const bf16x8 bb = *(const GAS bf16x8*)(cb.V2T + brow);
              const f32x4 d = __builtin_amdgcn_mfma_f32_16x16x32_bf16(a, bb, z4, 0, 0, 0);
#pragma unroll
              for (int r = 0; r < 4; ++r) VP[(16 * ti + 4 * fq + r) * 65 + 16 * tj + fr] = d[r]; } } }
        RW_BAR();
        for (int rp_ = 0; rp_ < ((PROF_PH) == 21 ? 2 : 1); ++rp_) {
        { RW_LANES(); const int c = lane, hc = 64 * h + c, tq0 = 8 * w, tk0 = tok0 + tq0;
          const float mu_r = W.mu[hc], mu_k = W.mu[384 + hc], mu_v = W.mu[768 + hc], w0 = W.w0[hc], a0 = W.a0[hc], k_k = W.k_k[hc], k_a = W.k_a[hc], r_k = W.r_k[hc];
          const float v0 = layer > 0 ? W.v0[hc] : 0.f;
          const bool has_prev = (chunk * 64 + tq0) > 0;
          float pr = has_prev ? bf2f(P[(size_t)(tk0 - 1) * LDP + 640 + hc]) : 0.f, pk = has_prev ? bf2f(P[(size_t)(tk0 - 1) * LDP + 1024 + hc]) : 0.f, pv = has_prev ? bf2f(P[(size_t)(tk0 - 1) * LDP + 1408 + hc]) : 0.f;
          float rr[8], kq[8], vv[8], kkc[8], bb[8], ld[8];
#pragma unroll
          for (int j = 0; j < 8; ++j) { const int t = tq0 + j; const size_t row = (size_t)(tk0 + j) * LDP;
              const float cr = bf2f(P[row + 640 + hc]), ck = bf2f(P[row + 1024 + hc]), cv = bf2f(P[row + 1408 + hc]);
              const float r = cr + mu_r * (pr - cr), k = ck + mu_k * (pk - ck); float v = cv + mu_v * (pv - cv); pr = cr; pk = ck; pv = cv;
              const float wp = w0 + WP[t * 65 + c], ap = a0 + AP[t * 65 + c];
              const float z = -wp, sp = fmaxf(z, 0.f) + __logf(1.0f + __expf(-fabsf(z))); const float wl = -sp - 0.5f;
              const float al = fsigm(ap);
              if (layer > 0) { const float vp = v0 + VP[t * 65 + c]; const float vf = bf2f(VFIRST[(size_t)(tk0 + j) * 384 + hc]); v = v + (vf - v) * fsigm(vp); }
              const float kn = k * k_k * RN[t]; const float k2 = k * (1.0f + (al - 1.0f) * k_a);
              rr[j] = bf2f(f2bf(r)); kq[j] = bf2f(f2bf(k2)); vv[j] = bf2f(f2bf(v)); kkc[j] = bf2f(f2bf(kn)); bb[j] = bf2f(f2bf(kn * al)); ld[j] = bf2f(f2bf(-fexp(wl)));
              cb.VOUT[(size_t)(tk0 + j) * 384 + hc] = f2bf(v);
              float dsum = rr[j] * kq[j] * r_k;
#pragma unroll
              for (int o = 1; o < 64; o <<= 1) dsum += __shfl_xor(dsum, o);
              if (lane == 0) cb.DOT[(size_t)(tk0 + j) * 6 + h] = dsum; }
          float cl[8]; cl[0] = ld[0];
#pragma unroll
          for (int j = 1; j < 8; ++j) cl[j] = cl[j - 1] + ld[j];
          TOT[w * 64 + c] = cl[7];
          RW_BAR();
          float prefix = 0.f, cumC = 0.f;
#pragma unroll
          for (int ww = 0; ww < 8; ++ww) { const float tv = TOT[ww * 64 + c]; cumC += tv; if (ww < w) prefix += tv; }
          if (w == 0) GC[c] = fexp(cumC);
          unsigned ahp[4], btp[4], ktp[4], vp4[4];
#pragma unroll
          for (int j = 0; j < 8; ++j) { const int t = tq0 + j; const float cum = prefix + cl[j], cump = cum - ld[j];
              const float g = fexp(cum), gp = fexp(cump), ig = fexp(-cum), gc = fexp(cumC - cum);
              const bf16_t ah = f2bf(-kkc[j] * gp), rh = f2bf(rr[j] * g), bh = f2bf(bb[j] * ig), kh = f2bf(kq[j] * ig), bt = f2bf(bb[j] * gc), kt = f2bf(kq[j] * gc), vb = f2bf(vv[j]);
              B0[t * LD + c] = ah; B1[t * LD + c] = rh; B2[t * LD + c] = bh; B3[t * LD + c] = kh;
              if (j & 1) { ahp[j >> 1] |= (unsigned)ah << 16; btp[j >> 1] |= (unsigned)bt << 16; ktp[j >> 1] |= (unsigned)kt << 16; vp4[j >> 1] |= (unsigned)vb << 16; }
              else { ahp[j >> 1] = ah; btp[j >> 1] = bt; ktp[j >> 1] = kt; vp4[j >> 1] = vb; } }
          *(LAS v4u*)(B4 + c * LD + tq0) = (v4u){ahp[0], ahp[1], ahp[2], ahp[3]}; *(LAS v4u*)(B5 + c * LD + tq0) = (v4u){btp[0], btp[1], btp[2], btp[3]};
          *(LAS v4u*)(B6 + c * LD + tq0) = (v4u){ktp[0], ktp[1], ktp[2], ktp[3]}; *(LAS v4u*)(B7 + c * LD + tq0) = (v4u){vp4[0], vp4[1], vp4[2], vp4[3]}; }
        RW_BAR();
        }
        for (int rp_ = 0; rp_ < ((PROF_PH) == 22 ? 2 : 1); ++rp_) {
        { RW_LANES(); const int prod = w >> 1; const LAS bf16_t* Aop = prod < 2 ? B0 : B1; const LAS bf16_t* Bop = (prod & 1) ? B3 : B2;
#pragma unroll
          for (int e = 0; e < 8; ++e) { const int tl = (w & 1) * 8 + e, ti = tl >> 2, tj = tl & 3; f32x4 d = {0.f, 0.f, 0.f, 0.f};
              if (tj <= ti) d = mm_tile(Aop, Bop, ti, tj, fr, fq, d);
#pragma unroll
              for (int r = 0; r < 4; ++r) { const int t = 16 * ti + 4 * fq + r, i = 16 * tj + fr; const bool keep = prod < 2 ? (i < t) : (i <= t); const float val = (tj <= ti && keep) ? d[r] : 0.f;
                  if (prod == 0) F0[t * 65 + i] = val; else if (prod == 1) B8[t * LD + i] = f2bf(val); else if (prod == 2) B9[t * LD + i] = f2bf(val); else B10[t * LD + i] = f2bf(val); } } }
        RW_BAR();
        }
        if (w == 0) { RW_LANES();
            const int blk = lane >> 4, jc = lane & 15; const LAS float* Lb = F0 + (16 * blk) * 65 + 16 * blk; float tc[16];
#pragma unroll
            for (int r = 0; r < 16; ++r) { float val = (r == jc) ? 1.f : 0.f;
#pragma unroll
                for (int i = 0; i < r; ++i) val += Lb[r * 65 + i] * tc[i];
                tc[r] = val; }
            asm volatile("s_waitcnt lgkmcnt(0)" ::: "memory");
#pragma unroll
            for (int r = 0; r < 16; ++r) F0[(16 * blk + r) * 65 + 16 * blk + jc] = tc[r];
        }
        RW_BAR();
        if (w < 2) { RW_LANES();
            const int o1 = 32 * w, o2 = 32 * w + 16; f32x4 d = {0.f, 0.f, 0.f, 0.f};
#pragma unroll
            for (int ks = 0; ks < 4; ++ks) d = __builtin_amdgcn_mfma_f32_16x16x4f32(F0[(o2 + fr) * 65 + o1 + 4 * ks + fq], F0[(o1 + 4 * ks + fq) * 65 + o1 + fr], d, 0, 0, 0);
            LAS float* tm = TMP + w * 16 * 17;
#pragma unroll
            for (int r = 0; r < 4; ++r) tm[(4 * fq + r) * 17 + fr] = d[r];
            asm volatile("s_waitcnt lgkmcnt(0)" ::: "memory");
            f32x4 d2 = {0.f, 0.f, 0.f, 0.f};
#pragma unroll
            for (int ks = 0; ks < 4; ++ks) d2 = __builtin_amdgcn_mfma_f32_16x16x4f32(F0[(o2 + fr) * 65 + o2 + 4 * ks + fq], tm[(4 * ks + fq) * 17 + fr], d2, 0, 0, 0);
            asm volatile("s_waitcnt lgkmcnt(0)" ::: "memory");
#pragma unroll
            for (int r = 0; r < 4; ++r) F0[(o2 + 4 * fq + r) * 65 + o1 + fr] = d2[r];
        }
        RW_BAR();
        if (w < 4) { RW_LANES();
            const int ti = w >> 1, tj = w & 1; f32x4 d = {0.f, 0.f, 0.f, 0.f};
#pragma unroll
            for (int ks = 0; ks < 8; ++ks) d = __builtin_amdgcn_mfma_f32_16x16x4f32(F0[(32 + 16 * ti + fr) * 65 + 4 * ks + fq], F0[(4 * ks + fq) * 65 + 16 * tj + fr], d, 0, 0, 0);
#pragma unroll
            for (int r = 0; r < 4; ++r) TMP[(16 * ti + 4 * fq + r) * 33 + 16 * tj + fr] = d[r];
        }
        RW_BAR();
        if (w < 4) { RW_LANES();
            const int ti = w >> 1, tj = w & 1; f32x4 d = {0.f, 0.f, 0.f, 0.f};
#pragma unroll
            for (int ks = 0; ks < 8; ++ks) d = __builtin_amdgcn_mfma_f32_16x16x4f32(F0[(32 + 16 * ti + fr) * 65 + 32 + 4 * ks + fq], TMP[(4 * ks + fq) * 33 + 16 * tj + fr], d, 0, 0, 0);
#pragma unroll
            for (int r = 0; r < 4; ++r) F0[(32 + 16 * ti + 4 * fq + r) * 65 + 16 * tj + fr] = d[r];
        }
        RW_BAR();
        { RW_LANES(); const int t = tid >> 3, i0 = (tid & 7) * 8;
#pragma unroll
          for (int e = 0; e < 8; ++e) B11[t * LD + i0 + e] = f2bf(F0[t * 65 + i0 + e]); }
        RW_BAR();
        { RW_LANES();
#pragma unroll
        for (int e = 0; e < 4; ++e) { const int tl = 4 * w + e, prod = tl >> 4, ti = (tl >> 2) & 3, tj = tl & 3; f32x4 d = {0.f, 0.f, 0.f, 0.f};
            d = prod == 0 ? mm_tile(B11, B4, ti, tj, fr, fq, d) : mm_tile(B8, B7, ti, tj, fr, fq, d);
            LAS bf16_t* dst = (prod == 0 ? B0 : B2) + (16 * tj + fr) * LD + 16 * ti + 4 * fq;
            *(LAS unsigned long long*)dst = (unsigned long long)pk2(d[0], d[1]) | ((unsigned long long)pk2(d[2], d[3]) << 32); } }
        RW_BAR();
        { RW_LANES();
#pragma unroll
        for (int e = 0; e < 2; ++e) { const int tl = 2 * w + e, ti = tl >> 2, tj = tl & 3; f32x4 d = {0.f, 0.f, 0.f, 0.f};
            d = mm_tile(B11, B2, ti, tj, fr, fq, d);
            LAS bf16_t* dst = B3 + (16 * tj + fr) * LD + 16 * ti + 4 * fq;
            *(LAS unsigned long long*)dst = (unsigned long long)pk2(d[0], d[1]) | ((unsigned long long)pk2(d[2], d[3]) << 32); } }
        RW_BAR();
        for (int rp_ = 0; rp_ < ((PROF_PH) == 23 ? 2 : 1); ++rp_) {
        { RW_LANES();
#pragma unroll
        for (int e = 0; e < 8; ++e) { const int tl = 8 * w + e, prod = tl >> 4, ti = (tl >> 2) & 3, tj = tl & 3; f32x4 d = {0.f, 0.f, 0.f, 0.f};
            if (prod == 0) { d = mm_tile(B5, B3, ti, tj, fr, fq, d); d = mm_tile(B6, B7, ti, tj, fr, fq, d);
                *(GAS f32x4*)(cb.Z + (size_t)item * 4096 + (16 * tj + fr) * 64 + 4 * ((4 * ti + fq) ^ fr)) = d; }
            else if (prod == 1) { d = mm_tile(B9, B3, ti, tj, fr, fq, d); d = mm_tile(B10, B7, ti, tj, fr, fq, d);
                *(GAS f32x4*)(cb.YV + (size_t)item * 4096 + (16 * tj + fr) * 64 + 16 * ti + 4 * fq) = d; }
            else if (prod == 2) { d = mm_tile(B9, B0, ti, tj, fr, fq, d);
#pragma unroll
                for (int r = 0; r < 4; ++r) { const int t = 16 * ti + 4 * fq + r, c = 16 * tj + fr; B4[t * LD + sigpos(c)] = f2bf(d[r] + bf2f(B1[t * LD + c])); } }
            else { d = mm_tile(B5, B0, ti, tj, fr, fq, d);
#pragma unroll
                for (int r = 0; r < 4; ++r) { const int c = 16 * ti + 4 * fq + r, c2 = 16 * tj + fr; B8[c * LD + sigpos(c2)] = f2bf(d[r] + (c == c2 ? GC[c] : 0.f)); } } } }
        RW_BAR();
        }
        { RW_LANES(); const int r = tid >> 3, ch = (tid & 7) * 8;
          *(GAS v4u*)(cb.G + (size_t)item * 4096 + r * 64 + ch) = *(const LAS v4u*)(B4 + r * LD + ch);
          *(GAS v4u*)(cb.PT + (size_t)item * 4096 + r * 64 + 8 * ((tid & 7) ^ (r & 7))) = *(const LAS v4u*)(B8 + r * LD + ch); }
        RW_BAR();
    }
}
constexpr int SC_NS = 10, SC_SLOT = 12288, SC_LAG = 6;
__device__ __forceinline__ void scan_compute(LAS unsigned char* L, const ChunkBufs cb, int bh, int tj, int lane, volatile LAS unsigned* flags) {
    const int fr = lane & 15, fq = lane >> 4; const int NC = SEQ / 64;
    bf16x8 Bf0 = {0, 0, 0, 0, 0, 0, 0, 0}, Bf1 = {0, 0, 0, 0, 0, 0, 0, 0};
    bf16_t* s0 = cb.S0 + (size_t)(bh * NC) * 4096 + (16 * tj + fr) * 64 + 8 * fq;
    const int po0 = fr * 128 + 16 * ((fq) ^ (fr & 7)), po1 = fr * 128 + 16 * ((4 + fq) ^ (fr & 7));
    int slot = 0;
    for (int chunk = 0; chunk < NC; ++chunk) {
        unsigned spins = 0;
        while (true) { const unsigned a = flags[0], b = flags[1], c = flags[2]; const unsigned m = a < b ? (a < c ? a : c) : (b < c ? b : c); if ((int)m >= chunk + 1 || ++spins > (1u << 22)) break; __builtin_amdgcn_s_sleep(1); }
        const LAS unsigned char* sp = L + slot * SC_SLOT;
        bf16x8 a0[4], a1[4]; f32x4 z[4];
#pragma unroll
        for (int ti = 0; ti < 4; ++ti) { a0[ti] = *(const LAS bf16x8*)(sp + ti * 2048 + po0); a1[ti] = *(const LAS bf16x8*)(sp + ti * 2048 + po1); z[ti] = *(const LAS f32x4*)(sp + 8192 + fr * 256 + 16 * ((4 * ti + fq) ^ fr)); }
        asm volatile("s_waitcnt lgkmcnt(0)" ::: "memory");
        if (lane == 0) flags[3] = (unsigned)(chunk + 1);
        *(GAS bf16x8*)(s0 + (size_t)chunk * 4096) = Bf0; *(GAS bf16x8*)(s0 + (size_t)chunk * 4096 + 32) = Bf1;
        f32x4 acc[4];
#pragma unroll
        for (int ti = 0; ti < 4; ++ti) { acc[ti] = __builtin_amdgcn_mfma_f32_16x16x32_bf16(a0[ti], Bf0, z[ti], 0, 0, 0); acc[ti] = __builtin_amdgcn_mfma_f32_16x16x32_bf16(a1[ti], Bf1, acc[ti], 0, 0, 0); }
        v4u m0, m1;
        m0.x = pk2(acc[0][0], acc[0][1]); m0.y = pk2(acc[0][2], acc[0][3]); m0.z = pk2(acc[1][0], acc[1][1]); m0.w = pk2(acc[1][2], acc[1][3]);
        m1.x = pk2(acc[2][0], acc[2][1]); m1.y = pk2(acc[2][2], acc[2][3]); m1.z = pk2(acc[3][0], acc[3][1]); m1.w = pk2(acc[3][2], acc[3][3]);
        Bf0 = __builtin_bit_cast(bf16x8, m0); Bf1 = __builtin_bit_cast(bf16x8, m1);
        slot = slot + 1 == SC_NS ? 0 : slot + 1;
    }
}
__device__ __forceinline__ void scan_loader(LAS unsigned char* L, const ChunkBufs cb, int bh, int tj, int lw, int lane, volatile LAS unsigned* flags) {
    const int NC = SEQ / 64;
    const char* src[4];
#pragma unroll
    for (int k = 0; k < 4; ++k) { const int pc = 4 * lw + k;
        src[k] = pc < 8 ? (const char*)(cb.PT + (size_t)(bh * NC) * 4096) + pc * 1024 + lane * 16 : (const char*)(cb.Z + (size_t)(bh * NC) * 4096) + tj * 4096 + (pc - 8) * 1024 + lane * 16; }
    const size_t st0 = 8192, st1 = 16384;
    int slot = 0;
    for (int c = 0; c < NC; ++c) {
        unsigned spins = 0;
        while ((int)flags[3] < c - SC_NS + 1 && ++spins < (1u << 22)) __builtin_amdgcn_s_sleep(1);
        const unsigned dst = (unsigned)(slot * SC_SLOT + 4 * lw * 1024);
#pragma unroll
        for (int k = 0; k < 4; ++k) { const int pc = 4 * lw + k;
            __builtin_amdgcn_global_load_lds((const unsigned*)(src[k] + (size_t)c * (pc < 8 ? st0 : st1)), (LAS unsigned*)(L + dst + k * 1024), 16, 0, 0); }
        if (c >= SC_LAG) { asm volatile("s_waitcnt vmcnt(24)" ::: "memory"); if (lane == 0) flags[lw] = (unsigned)(c - SC_LAG + 1); }
        slot = slot + 1 == SC_NS ? 0 : slot + 1;
    }
    asm volatile("s_waitcnt vmcnt(0)" ::: "memory");
    if (lane == 0) flags[lw] = (unsigned)NC;
}
constexpr int O_SG = 0  , O_Y = 9216  , O_GT = O_Y + 16640  ;
__device__ __forceinline__ void out_phase(LAS unsigned char* L, const bf16_t* P, const sk::RwkvW W, const ChunkBufs cb, bf16_t* MIX, int tid_in, int first, int stride) {
    const int w = __builtin_amdgcn_readfirstlane(tid_in >> 6);
    LAS bf16_t* SG = (LAS bf16_t*)(L + O_SG); LAS float* Y = (LAS float*)(L + O_Y); LAS float* GT = (LAS float*)(L + O_GT);
    for (int item = first; item < NITEMS; item += stride) {
        const int bh = item / (SEQ / 64), chunk = item % (SEQ / 64), b = bh / 6, h = bh % 6; const int tok0 = b * SEQ + chunk * 64; const size_t ib = (size_t)item * 4096;
        { RW_LANES(); const int t = tid >> 3, sub = tid & 7;
#pragma unroll
          for (int e = 0; e < 8; ++e) { const int j = 8 * sub + e; SG[t * LD + j] = f2bf(fsigm(sk::shifted(P, tok0 + t, 640 + 1216 + j, W.mu[1216 + j]))); } }
        RW_BAR();
        { RW_LANES();
#pragma unroll
        for (int e = 0; e < 2; ++e) { const int tl = 2 * w + e, ti = tl >> 2, tj = tl & 3;
            f32x4 d = *(const GAS f32x4*)(cb.YV + ib + (16 * tj + fr) * 64 + 16 * ti + 4 * fq); f32x4 g = {0.f, 0.f, 0.f, 0.f};
#pragma unroll
            for (int kk = 0; kk < 2; ++kk) {
                const bf16x8 a = *(const GAS bf16x8*)(cb.G + ib + (16 * ti + fr) * 64 + 32 * kk + 8 * fq), bb = *(const GAS bf16x8*)(cb.S0 + ib + (16 * tj + fr) * 64 + 32 * kk + 8 * fq);
                d = __builtin_amdgcn_mfma_f32_16x16x32_bf16(a, bb, d, 0, 0, 0);
                const bf16x8 a2 = *(const LAS bf16x8*)(SG + (16 * ti + fr) * LD + 32 * kk + 8 * fq), b2 = *(const GAS bf16x8*)(cb.G2T + (size_t)(64 * h + 16 * tj + fr) * 64 + 32 * kk + 8 * fq);
                g = __builtin_amdgcn_mfma_f32_16x16x32_bf16(a2, b2, g, 0, 0, 0); }
#pragma unroll
            for (int r = 0; r < 4; ++r) { Y[(16 * ti + 4 * fq + r) * 65 + 16 * tj + fr] = d[r]; GT[(16 * ti + 4 * fq + r) * 65 + 16 * tj + fr] = g[r]; } } }
        RW_BAR();
        { RW_LANES(); const int t = tid >> 3, sub = tid & 7, tok = tok0 + t; float yv[8], s = 0.f;
#pragma unroll
          for (int e = 0; e < 8; ++e) { yv[e] = bf2f(f2bf(Y[t * 65 + 8 * sub + e])); s += yv[e]; }
          s += __shfl_xor(s, 1); s += __shfl_xor(s, 2); s += __shfl_xor(s, 4);
          const float mean = s * (1.0f / 64.0f); float q = 0.f;
#pragma unroll
          for (int e = 0; e < 8; ++e) { const float dd = yv[e] - mean; q += dd * dd; }
          q += __shfl_xor(q, 1); q += __shfl_xor(q, 2); q += __shfl_xor(q, 4);
          const float rstd = 1.0f / sqrtf(q * (1.0f / 64.0f) + GN_EPS), dot = cb.DOT[(size_t)tok * 6 + h];
          unsigned o[4];
#pragma unroll
          for (int e = 0; e < 8; e += 2) { float r2[2];
#pragma unroll
              for (int u = 0; u < 2; ++u) { const int v = 8 * sub + e + u, hc = 64 * h + v; const float yn = (yv[e + u] - mean) * rstd * W.ln_w[hc] + W.ln_b[hc];
                  r2[u] = (yn + dot * bf2f(cb.VOUT[(size_t)tok * 384 + hc])) * GT[t * 65 + v]; }
              o[e >> 1] = pk2(r2[0], r2[1]); }
          *(GAS v4u*)(MIX + (size_t)tok * DM + 384 + 64 * h + 8 * sub) = (v4u){o[0], o[1], o[2], o[3]}; }
        RW_BAR();
    }
}
}
namespace at {
constexpr int LDK = 72, LDV = 264;
constexpr int A_K = 0, A_V = 256 * LDK * 2  , A_BIAS = A_V + 64 * LDV * 2  , A_END = A_BIAS + 128 * 6 * 4;
__device__ __forceinline__ int vpos(int key) { return (key & ~31) + 8 * ((key >> 2) & 3) + 4 * ((key >> 4) & 1) + (key & 3); }
__device__ __forceinline__ unsigned pk2(float lo, float hi) { return (unsigned)f2bf(lo) | ((unsigned)f2bf(hi) << 16); }
#define AT_BAR() do { asm volatile("s_waitcnt vmcnt(0) lgkmcnt(0)" ::: "memory"); __builtin_amdgcn_s_barrier(); asm volatile("" ::: "memory"); } while (0)

__device__ __forceinline__ void stage_kv(LAS unsigned char* L, int tid, const bf16_t* kbase, const bf16_t* vbase, long pitch, int jvalid0, const float* gk) {
    LAS bf16_t* Kl = (LAS bf16_t*)(L + A_K); LAS bf16_t* VTl = (LAS bf16_t*)(L + A_V);
#pragma unroll
    for (int it = 0; it < 4; ++it) { const int idx = it * 512 + tid, key = idx >> 3, ch = idx & 7;
        v4u raw = {0u, 0u, 0u, 0u}; if (key >= jvalid0) raw = *(const GAS v4u*)(kbase + (long)key * pitch + 8 * ch);
        float f[8]; f[0] = bf2f((bf16_t)(raw.x & 0xffff)); f[1] = bf2f((bf16_t)(raw.x >> 16)); f[2] = bf2f((bf16_t)(raw.y & 0xffff)); f[3] = bf2f((bf16_t)(raw.y >> 16));
        f[4] = bf2f((bf16_t)(raw.z & 0xffff)); f[5] = bf2f((bf16_t)(raw.z >> 16)); f[6] = bf2f((bf16_t)(raw.w & 0xffff)); f[7] = bf2f((bf16_t)(raw.w >> 16));
        float ss = 0.f;
#pragma unroll
        for (int e = 0; e < 8; ++e) ss += f[e] * f[e];
        ss += __shfl_xor(ss, 1); ss += __shfl_xor(ss, 2); ss += __shfl_xor(ss, 4);
        const float rs = 1.0f / sqrtf(ss * (1.0f / 64.0f) + EPS);
        const f32x4 g0 = *(const GAS f32x4*)(gk + 8 * ch), g1 = *(const GAS f32x4*)(gk + 8 * ch + 4);
        v4u o; o.x = pk2(f[0] * rs * g0[0], f[1] * rs * g0[1]); o.y = pk2(f[2] * rs * g0[2], f[3] * rs * g0[3]); o.z = pk2(f[4] * rs * g1[0], f[5] * rs * g1[1]); o.w = pk2(f[6] * rs * g1[2], f[7] * rs * g1[3]);
        *(LAS v4u*)(Kl + key * LDK + 8 * ch) = o; }
#pragma unroll
    for (int it = 0; it < 4; ++it) { const int idx = it * 512 + tid, key = idx & 255, ch = idx >> 8;
        v4u raw = {0u, 0u, 0u, 0u}; if (key >= jvalid0) raw = *(const GAS v4u*)(vbase + (long)key * pitch + 8 * ch);
        LAS bf16_t* d = VTl + (8 * ch) * LDV + vpos(key);
        d[0 * LDV] = (bf16_t)(raw.x & 0xffff); d[1 * LDV] = (bf16_t)(raw.x >> 16); d[2 * LDV] = (bf16_t)(raw.y & 0xffff); d[3 * LDV] = (bf16_t)(raw.y >> 16);
        d[4 * LDV] = (bf16_t)(raw.z & 0xffff); d[5 * LDV] = (bf16_t)(raw.z >> 16); d[6 * LDV] = (bf16_t)(raw.w & 0xffff); d[7 * LDV] = (bf16_t)(raw.w >> 16); }
}
__device__ __forceinline__ void load_q(const bf16_t* qrow, const float* gq, int fq, bf16x8& q0, bf16x8& q1) {
    const v4u r0 = *(const GAS v4u*)(qrow + 8 * fq), r1 = *(const GAS v4u*)(qrow + 32 + 8 * fq);
    float f[16]; const unsigned w[8] = {r0.x, r0.y, r0.z, r0.w, r1.x, r1.y, r1.z, r1.w};
#pragma unroll
    for (int e = 0; e < 8; ++e) { f[2 * e] = bf2f((bf16_t)(w[e] & 0xffff)); f[2 * e + 1] = bf2f((bf16_t)(w[e] >> 16)); }
    float ss = 0.f;
#pragma unroll
    for (int e = 0; e < 16; ++e) ss += f[e] * f[e];
    ss += __shfl_xor(ss, 16); ss += __shfl_xor(ss, 32);
    const float rs = 0.125f / sqrtf(ss * (1.0f / 64.0f) + EPS);
    const f32x4 g0 = *(const GAS f32x4*)(gq + 8 * fq), g1 = *(const GAS f32x4*)(gq + 8 * fq + 4), g2 = *(const GAS f32x4*)(gq + 32 + 8 * fq), g3 = *(const GAS f32x4*)(gq + 36 + 8 * fq);
    v4u a, b;
    a.x = pk2(f[0] * rs * g0[0], f[1] * rs * g0[1]); a.y = pk2(f[2] * rs * g0[2], f[3] * rs * g0[3]); a.z = pk2(f[4] * rs * g1[0], f[5] * rs * g1[1]); a.w = pk2(f[6] * rs * g1[2], f[7] * rs * g1[3]);
    b.x = pk2(f[8] * rs * g2[0], f[9] * rs * g2[1]); b.y = pk2(f[10] * rs * g2[2], f[11] * rs * g2[3]); b.z = pk2(f[12] * rs * g3[0], f[13] * rs * g3[1]); b.w = pk2(f[14] * rs * g3[2], f[15] * rs * g3[3]);
    q0 = __builtin_bit_cast(bf16x8, a); q1 = __builtin_bit_cast(bf16x8, b);
}
template <int NT, bool SWA> __device__ __forceinline__ void attn_wave(const LAS unsigned char* L, bf16x8 q0, bf16x8 q1, int kt0, int qi0, int hq, float sink, bool first_block, bf16_t* outp, int fr, int fq) {
    const LAS bf16_t* Kl = (const LAS bf16_t*)(L + A_K); const LAS bf16_t* VTl = (const LAS bf16_t*)(L + A_V); const LAS float* bias = (const LAS float*)(L + A_BIAS);
    f32x4 s[NT];
#pragma unroll
    for (int t = 0; t < NT; ++t) { const LAS bf16_t* kr = Kl + (16 * (kt0 + t) + fr) * LDK + 8 * fq;
        const f32x4 z = {0.f, 0.f, 0.f, 0.f};
        s[t] = __builtin_amdgcn_mfma_f32_16x16x32_bf16(*(const LAS bf16x8*)kr, q0, z, 0, 0, 0);
        s[t] = __builtin_amdgcn_mfma_f32_16x16x32_bf16(*(const LAS bf16x8*)(kr + 32), q1, s[t], 0, 0, 0);
        if (t & 1) __builtin_amdgcn_sched_barrier(0); }
    float mx = SWA ? sink : -3.0e38f;
#pragma unroll
    for (int t = 0; t < NT; ++t)
#pragma unroll
        for (int r = 0; r < 4; ++r) {
            if (SWA) { const int kj = 16 * (kt0 + t) + 4 * fq + r, dist = qi0 + fr + 128 - kj; const bool valid = dist >= 0 && dist < 128 && !(first_block && kj < 128);
                s[t][r] = valid ? s[t][r] + bias[(valid ? dist : 0) * 6 + hq] : -3.0e38f; }
            mx = fmaxf(mx, s[t][r]); }
    mx = fmaxf(mx, __shfl_xor(mx, 16)); mx = fmaxf(mx, __shfl_xor(mx, 32));
    float l = 0.f;
#pragma unroll
    for (int t = 0; t < NT; ++t)
#pragma unroll
        for (int r = 0; r < 4; ++r) { const float p = __expf(s[t][r] - mx); s[t][r] = p; l += p; }
    l += __shfl_xor(l, 16); l += __shfl_xor(l, 32);
    if (SWA) l += __expf(sink - mx);
    f32x4 o[4];
#pragma unroll
    for (int dt = 0; dt < 4; ++dt) o[dt] = (f32x4){0.f, 0.f, 0.f, 0.f};
#pragma unroll
    for (int ks = 0; ks < NT / 2; ++ks) { v4u pw; pw.x = pk2(s[2 * ks][0], s[2 * ks][1]); pw.y = pk2(s[2 * ks][2], s[2 * ks][3]); pw.z = pk2(s[2 * ks + 1][0], s[2 * ks + 1][1]); pw.w = pk2(s[2 * ks + 1][2], s[2 * ks + 1][3]);
        const bf16x8 pb = __builtin_bit_cast(bf16x8, pw);
#pragma unroll
        for (int dt = 0; dt < 4; ++dt) o[dt] = __builtin_amdgcn_mfma_f32_16x16x32_bf16(*(const LAS bf16x8*)(VTl + (16 * dt + fr) * LDV + 32 * (kt0 / 2 + ks) + 8 * fq), pb, o[dt], 0, 0, 0);
        __builtin_amdgcn_sched_barrier(0); }
    const float inv = 1.0f / l;
#pragma unroll
    for (int dt = 0; dt < 4; ++dt) *(GAS unsigned long long*)(outp + (long)fr * DM + 16 * dt + 4 * fq) = (unsigned long long)pk2(o[dt][0] * inv, o[dt][1] * inv) | ((unsigned long long)pk2(o[dt][2] * inv, o[dt][3] * inv) << 32);
}
struct AttnArgs { const bf16_t* PROJ; const bf16_t* MKV; bf16_t* MIX; const float* biastab; const float *sinks, *gq, *gk, *gmq, *gmk; };
__device__ __forceinline__ void attn_item(LAS unsigned char* L, const AttnArgs A, int item, int tid_in) {
    const int w = __builtin_amdgcn_readfirstlane(tid_in >> 6);
    if (item < 256) {
        const int b = item >> 7, hkv = (item >> 6) & 1, blk = item & 63; const long tokb = (long)b * SEQ + blk * 128;
        { int lt_ = tid_in; asm volatile("" : "+v"(lt_)); const int tid = lt_;
          stage_kv(L, tid, A.PROJ + (tokb - 128) * LDP + 384 + 64 * hkv, A.PROJ + (tokb - 128) * LDP + 512 + 64 * hkv, LDP, blk == 0 ? 128 : 0, A.gk);
          LAS float* bl = (LAS float*)(L + A_BIAS); for (int i = tid; i < 768; i += 512) bl[i] = A.biastab[i]; }
        AT_BAR();
        { int lt_ = tid_in; asm volatile("" : "+v"(lt_)); const int lane = lt_ & 63, fr = lane & 15, fq = lane >> 4;
#pragma unroll 1
          for (int g = 0; g < 3; ++g) { const int hq = 3 * hkv + g; bf16x8 q0, q1;
              load_q(A.PROJ + (tokb + 16 * w + fr) * LDP + 64 * hq, A.gq, fq, q0, q1);
              attn_wave<10, true>(L, q0, q1, w & ~1, 16 * w, hq, A.sinks[hq], blk == 0, A.MIX + (tokb + 16 * w) * DM + 64 * hq, fr, fq); } }
        AT_BAR();
    } else {
        const int pr = item - 256, b = pr >> 7, h = (pr >> 5) & 3, blk2 = pr & 31;
        { int lt_ = tid_in; asm volatile("" : "+v"(lt_)); const int tid = lt_;
          stage_kv(L, tid, A.MKV + (long)(b * 256) * 512 + 64 * h, A.MKV + (long)(b * 256) * 512 + 256 + 64 * h, 512, 0, A.gmk); }
        AT_BAR();
        { int lt_ = tid_in; asm volatile("" : "+v"(lt_)); const int lane = lt_ & 63, fr = lane & 15, fq = lane >> 4;
#pragma unroll 1
          for (int u = 0; u < 2; ++u) { const long tokb = (long)b * SEQ + (2 * blk2 + u) * 128; bf16x8 q0, q1;
              load_q(A.PROJ + (tokb + 16 * w + fr) * LDP + 1920 + 64 * h, A.gmq, fq, q0, q1);
              attn_wave<16, false>(L, q0, q1, 0, 16 * w, 0, 0.f, false, A.MIX + (tokb + 16 * w) * DM + 768 + 64 * h, fr, fq); } }
        AT_BAR();
    }
}
}
constexpr int NWAVES = 8;
namespace mk {
constexpr size_t WS_CTL = 0, CTL_ZERO_BYTES = 1 * MiB;
constexpr size_t CTL_SSQ = 512 * 1024;
constexpr size_t WS_SMALL = 1 * MiB, SM_BIAS = 0, SM_SSQM = 4096, SM_MKV = 512 * 1024;
constexpr size_t WS_MEMB = 2 * MiB, WS_WT = 3 * MiB, WS_XB = 28 * MiB, WS_VF = 60 * MiB, WS_PROJ = 72 * MiB, WS_MIX = 144 * MiB, WS_PREP = 176 * MiB, WS_U = 72 * MiB, WS_ACT = 160 * MiB, WS_WIN1 = 248 * MiB  , WS_END = 254 * MiB;
constexpr size_t WT_IN = 0, WT_OUT = 4718592, WT_UP = WT_OUT + 2 * MiB, WT_DOWN = WT_UP + 11 * MiB, WT_MKV = WT_DOWN + 5767168;
constexpr int CW_TMO = 0, CW_BAR = 4096;
constexpr int LDS_BYTES = 163840, LDSCTL_OFF = LDS_BYTES - 512, MISC_OFF = LDSCTL_OFF + 320;
constexpr size_t SM_W2T = 8192, SM_A2T = 32768, SM_V2T = 57344, SM_G2T = 81920, SM_LORA_L = 122880;
constexpr size_t WS_PT = 176 * MiB, WS_G = 188 * MiB, WS_S0 = 200 * MiB, WS_Z = 212 * MiB, WS_V1 = 236 * MiB, WS_YV = 28 * MiB  , WS_DOT = 52 * MiB;
#ifndef PROF_PH
#define PROF_PH -1
#endif
#ifndef PROF_N
#define PROF_N 1
#endif
#define REPEAT(k) for (int rep_ = 0; rep_ < ((PROF_PH) == (k) ? (PROF_N) : 1); ++rep_)
#ifndef FAST_RWKV
#define FAST_RWKV 1
#endif
#ifndef FAST_ATTN
#define FAST_ATTN 1
#endif

struct Args { const float* in[N_IN]; float* out; unsigned char* ws; int ph_lo, ph_hi; };

__device__ __forceinline__ unsigned pk2(float lo, float hi) { return (unsigned)f2bf(lo) | ((unsigned)f2bf(hi) << 16); }
__device__ __forceinline__ float wave_sum(float v) {
#pragma unroll
    for (int o = 1; o < 64; o <<= 1) v += __shfl_xor(v, o);
    return v;
}
template <bool UPPERM> __device__ __forceinline__ void transpose_item(const float* W, const float* g, int K, int N, bf16_t* WT, LAS float* scr, int item, int lane) {
    const int nblk = N / 32, kb = item / nblk, nb = item % nblk, k0 = 64 * kb, n0 = 32 * nb;
    float tv[32];
#pragma unroll
    for (int i = 0; i < 32; ++i) tv[i] = W[(size_t)(k0 + 2 * i + (lane >> 5)) * N + n0 + (lane & 31)];
#pragma unroll
    for (int i = 0; i < 32; ++i) { const int kk = 2 * i + (lane >> 5); float v = tv[i]; if (g) v *= g[k0 + kk]; scr[kk * 33 + (lane & 31)] = v; }
    LDS_WAIT(); asm volatile("" ::: "memory");
    const int c = lane & 7;
#pragma unroll
    for (int j = 0; j < 4; ++j) { const int n = (lane >> 3) + 8 * j; const LAS float* s = scr + (8 * c) * 33 + n;
        v4u o; o.x = pk2(s[0 * 33], s[1 * 33]); o.y = pk2(s[2 * 33], s[3 * 33]); o.z = pk2(s[4 * 33], s[5 * 33]); o.w = pk2(s[6 * 33], s[7 * 33]);
        int nr = n0 + n; if (UPPERM) nr = nr < 2816 ? 256 * (nr >> 7) + (nr & 127) : 256 * ((nr - 2816) >> 7) + 128 + ((nr - 2816) & 127);
        *(GAS v4u*)(WT + (size_t)nr * K + k0 + 8 * c) = o; }
    LDS_WAIT(); asm volatile("" ::: "memory");
}
__device__ __forceinline__ void row_to_bf16(const float* xrow, bf16_t* orow, float* ssq_out, int lane) {
    const GAS f32x4* xr = (const GAS f32x4*)xrow + lane; f32x4 v[4]; float s = 0.f;
#pragma unroll
    for (int j = 0; j < 4; ++j) { v[j] = xr[64 * j]; s += (v[j].x * v[j].x + v[j].y * v[j].y) + (v[j].z * v[j].z + v[j].w * v[j].w); }
    s = wave_sum(s);
    GAS unsigned long long* o8 = (GAS unsigned long long*)orow + lane;
#pragma unroll
    for (int j = 0; j < 4; ++j) o8[64 * j] = (unsigned long long)pk2(v[j].x, v[j].y) | ((unsigned long long)pk2(v[j].z, v[j].w) << 32);
    if (lane == 0) *ssq_out = s;
}

__global__ void __launch_bounds__(NWAVES * 64, 2) mk_fwd(Args args) {
    extern __shared__ __attribute__((aligned(16))) unsigned char lds[];
    LAS unsigned char* L = (LAS unsigned char*)lds;
    volatile LAS unsigned* MISC = (volatile LAS unsigned*)(L + MISC_OFF);
    const int tid0 = threadIdx.x; const int wave0 = __builtin_amdgcn_readfirstlane(tid0 >> 6);
    const int G = gridDim.x;
    unsigned char* ws = args.ws;
    gu32* ctl = (gu32*)(ws + WS_CTL);
    for (int u = tid0; u < (LDS_BYTES - LDSCTL_OFF) / 4; u += NWAVES * 64) ((LAS unsigned*)(L + LDSCTL_OFF))[u] = 0u;
    __syncthreads();
    XcdBarrier bar = xcd_barrier_post((unsigned*)(ctl + CW_BAR), MISC + 8);
    const int lo = args.ph_lo, hi = args.ph_hi;
    int ph = 0;
#define PH_BEGIN if (lo <= ph && ph < hi) { unsigned char* wsp = args.ws; asm volatile("" : "+s"(wsp)); int tid = wave0 * 64 + (int)__builtin_amdgcn_mbcnt_hi(~0u, __builtin_amdgcn_mbcnt_lo(~0u, 0u)); asm volatile("" : "+v"(tid)); const int lane = tid & 63, wave = __builtin_amdgcn_readfirstlane(tid >> 6); const long gtid = (long)blockIdx.x * (NWAVES * 64) + tid; const int gw = blockIdx.x * NWAVES + wave; LAS float* scr = (LAS float*)(L + wave * 16384); (void)lane; (void)gtid; (void)gw; (void)scr;
#define PH_END   if (ph + 1 < hi) xcd_barrier(bar); } ++ph;
    float* out = args.out;
#define SSQ_A ((float*)(wsp + WS_CTL + CTL_SSQ))
#define SSQ_B (SSQ_A + 3 * MTOK)
#define biastab ((float*)(wsp + WS_SMALL + SM_BIAS))
#define ssqm ((float*)(wsp + WS_SMALL + SM_SSQM))
#define MKV ((bf16_t*)(wsp + WS_SMALL + SM_MKV))
#define MEMB ((bf16_t*)(wsp + WS_MEMB))
#define Wt_in ((bf16_t*)(wsp + (l == 0 ? WS_WT + WT_IN : WS_WIN1)))
#define Wt_out ((bf16_t*)(wsp + WS_WT + WT_OUT))
#define Wt_up ((bf16_t*)(wsp + WS_WT + WT_UP))
#define Wt_down ((bf16_t*)(wsp + WS_WT + WT_DOWN))
#define Wt_mkv ((bf16_t*)(wsp + (l == 0 ? WS_WT + WT_MKV : WS_WIN1 + 4718592)))
#define XB ((bf16_t*)(wsp + WS_XB))
#define VF ((bf16_t*)(wsp + WS_VF))
#define PROJ ((bf16_t*)(wsp + WS_PROJ))
#define MIX ((bf16_t*)(wsp + WS_MIX))
#define U ((bf16_t*)(wsp + WS_U))
#define ACT ((bf16_t*)(wsp + WS_ACT))
#define PA ((size_t)MTOK * 384)
#define pR ((bf16_t*)(wsp + WS_PREP))
#define pK (pR + PA)
#define pV (pR + 2 * PA)
#define pKK (pR + 3 * PA)
#define pB (pR + 4 * PA)
#define pLD (pR + 5 * PA)
    const long gsize = (long)G * (NWAVES * 64);
    const int NGW = G * NWAVES;

#define MK_W() sk::RwkvW W{args.in[I_MU] + l * 1280, args.in[I_MUV], args.in[I_W0] + l * 384, args.in[I_W2] + l * 32 * 384, args.in[I_A0] + l * 384, args.in[I_A2] + l * 32 * 384, args.in[I_V0], args.in[I_V2], args.in[I_G2] + l * 64 * 384, args.in[I_KK] + l * 384, args.in[I_KA] + l * 384, args.in[I_RK] + l * 384, args.in[I_LNW] + l * 384, args.in[I_LNB] + l * 384};
#define MK_CBUF() const rw::ChunkBufs cbuf{(bf16_t*)(wsp + WS_PT), (bf16_t*)(wsp + WS_G), (float*)(wsp + WS_Z), (float*)(wsp + WS_YV), (bf16_t*)(wsp + WS_S0), (bf16_t*)(wsp + (l == 0 ? WS_VF : WS_V1)), (float*)(wsp + WS_DOT), (const bf16_t*)(wsp + WS_SMALL + SM_W2T + l * SM_LORA_L), (const bf16_t*)(wsp + WS_SMALL + SM_A2T + l * SM_LORA_L), (const bf16_t*)(wsp + WS_SMALL + SM_V2T + l * SM_LORA_L), (const bf16_t*)(wsp + WS_SMALL + SM_G2T + l * SM_LORA_L)};
    for (int l = 0; l < 2; ++l) {
        const float* xin = l == 0 ? args.in[I_X] : out;
        if (l == 0) {
        PH_BEGIN
            REPEAT(0) {
            const int I_IN = 16 * 68, I_KV = 16 * 16, NIT = 2 * (I_IN + I_KV);
            for (int it = gw; it < NIT; it += NGW) {
                int r = it; const int ll = r >= I_IN + I_KV ? 1 : 0; r -= ll * (I_IN + I_KV);
                bf16_t* win = (bf16_t*)(wsp + (ll == 0 ? WS_WT + WT_IN : WS_WIN1)); bf16_t* wkv = (bf16_t*)(wsp + (ll == 0 ? WS_WT + WT_MKV : WS_WIN1 + 4718592));
                if (r < I_IN) transpose_item<false>(args.in[I_WIN] + (size_t)ll * 1024 * 2176, args.in[I_MIXG] + ll * 1024, 1024, 2176, win, scr, r, lane);
                else transpose_item<false>(args.in[I_WMKV] + (size_t)ll * 1024 * 512, args.in[I_MEMG] + ll * 1024, 1024, 512, wkv, scr, r - I_IN, lane);
            }
            for (long i = gtid; i < 2 * 128 * 1024; i += gsize) { const int ll = (int)(i >> 17), n = (int)(i >> 10) & 127, k = (int)(i & 1023); float v = 0.f;
                if (ll > 0 && n < 16) v = args.in[I_WINV][k * 16 + n] * args.in[I_MIXG][1024 + k];
                ((bf16_t*)(wsp + (ll == 0 ? WS_WT + WT_IN : WS_WIN1)))[(size_t)(2176 + n) * 1024 + k] = f2bf(v); }
            for (long i = gtid; i < 2 * 384 * 160; i += gsize) { const int ll = (int)(i / (384 * 160)), r2 = (int)(i % (384 * 160)), hc = r2 / 160, j = r2 % 160; bf16_t* sm = (bf16_t*)(wsp + WS_SMALL + ll * SM_LORA_L);
                if (j < 32) sm[SM_W2T / 2 + hc * 32 + j] = f2bf(args.in[I_W2][(size_t)ll * 32 * 384 + j * 384 + hc]);
                else if (j < 64) sm[SM_A2T / 2 + hc * 32 + (j - 32)] = f2bf(args.in[I_A2][(size_t)ll * 32 * 384 + (j - 32) * 384 + hc]);
                else if (j < 96) sm[SM_V2T / 2 + hc * 32 + (j - 64)] = f2bf((j - 64) < 16 ? args.in[I_V2][(j - 64) * 384 + hc] : 0.f);
                else sm[SM_G2T / 2 + hc * 64 + (j - 96)] = f2bf(args.in[I_G2][(size_t)ll * 64 * 384 + (j - 96) * 384 + hc]); }
            for (int m = gw; m < MTOK; m += NGW) row_to_bf16(args.in[I_X] + (size_t)m * DM, XB + (size_t)m * DM, SSQ_A + m, lane);
            for (int m = gw; m < 512; m += NGW) row_to_bf16(args.in[I_MEM] + (size_t)m * DM, MEMB + (size_t)m * DM, ssqm + m, lane);
            sk::d_biastab(args.in[I_RELB], biastab, gtid, gsize);
            }
        PH_END
        }
        PH_BEGIN
            REPEAT(1)
            { pg8::Gemm g{XB, Wt_in, MTOK, 2304, 1024}; pg8::StaticOrder S; S.init(MTOK, 2304, G, (int)blockIdx.x);
              pg8::EpiScaleBf16 E{PROJ, LDP, SSQ_A + (size_t)l * MTOK};
              pg8::gemm_phase<pg8::EpiScaleBf16, pg8::StaticOrder, true, true>(L, g, S, E, tid); }
            { pg8::Gemm g{MEMB, Wt_mkv, 512, 512, 1024}; pg8::StaticOrder S; S.init(512, 512, G, (int)((blockIdx.x + 192) % G));
              pg8::EpiScaleBf16 E{MKV, 512, ssqm};
              pg8::gemm_phase<pg8::EpiScaleBf16, pg8::StaticOrder, true, true>(L, g, S, E, tid); }
            if (blockIdx.x >= 64) {
                const int I_OUT = 16 * 32, I_UP = 16 * 176, I_DN = 44 * 32, NIT = I_OUT + I_UP + I_DN;
                for (int it = ((int)blockIdx.x - 64) * NWAVES + wave; it < NIT; it += (G - 64) * NWAVES) {
                    int r = it;
                    if (r < I_OUT) { transpose_item<false>(args.in[I_WOUT] + (size_t)l * 1024 * 1024, nullptr, 1024, 1024, Wt_out, scr, r, lane); continue; } r -= I_OUT;
                    if (r < I_UP) { transpose_item<true>(args.in[I_WUP] + (size_t)l * 1024 * 5632, args.in[I_FFNG] + l * 1024, 1024, 5632, Wt_up, scr, r, lane); continue; } r -= I_UP;
                    transpose_item<false>(args.in[I_WDOWN] + (size_t)l * 2816 * 1024, nullptr, 2816, 1024, Wt_down, scr, r, lane);
                }
            }
        PH_END


        PH_BEGIN
            MK_W(); MK_CBUF(); (void)cbuf;
#if !FAST_ATTN
            sk::d_qknorm(PROJ, MTOK, LDP, args.in[I_AQN] + l * 64, args.in[I_AKN] + l * 64, args.in[I_MQN] + l * 64, 0, gtid, gsize);
            sk::d_qknorm(MKV, 512, 512, nullptr, nullptr, args.in[I_MKN] + l * 64, 1, gtid, gsize);
#endif
#if FAST_RWKV
            REPEAT(2) rw::chunk_phase(L, PROJ, W, l, VF, cbuf, tid, (int)blockIdx.x, G);
#else
            sk::d_rwkv_prep(PROJ, W, l, VF, pR, pK, pV, pKK, pB, pLD, gtid, gsize);
#endif
        PH_END
        PH_BEGIN
            MK_CBUF(); (void)cbuf;
            if (blockIdx.x < 48) {
#if FAST_RWKV
                REPEAT(3) { __syncthreads(); if (tid < 8) MISC[16 + tid] = 0u; __syncthreads();
                  const int sbh = (int)blockIdx.x >> 2, stj = (int)blockIdx.x & 3;
                  if (wave == 0) rw::scan_compute(L, cbuf, sbh, stj, lane, MISC + 16); else if (wave < 4) rw::scan_loader(L, cbuf, sbh, stj, wave - 1, lane, MISC + 16); }
#endif
            } else {
#if FAST_ATTN
                const at::AttnArgs A{PROJ, MKV, MIX, biastab, args.in[I_SINK] + l * 6, args.in[I_AQN] + l * 64, args.in[I_AKN] + l * 64, args.in[I_MQN] + l * 64, args.in[I_MKN] + l * 64};
                REPEAT(7) for (int it = (int)blockIdx.x - 48; it < 512; it += G - 48) at::attn_item(L, A, it, tid);
#else
                const long gt2 = (long)(blockIdx.x - BATCH * 6) * (NWAVES * 64) + tid, gs2 = (long)(G - BATCH * 6) * (NWAVES * 64);
                REPEAT(7) sk::d_swa(PROJ, MIX, biastab, args.in[I_SINK] + l * 6, gt2, gs2);
                REPEAT(8) sk::d_memattn(PROJ, MKV, MIX, gt2, gs2);
#endif
            }
        PH_END
        PH_BEGIN
            MK_W(); MK_CBUF(); (void)cbuf;
#if FAST_RWKV
            REPEAT(4) rw::out_phase(L, PROJ, W, cbuf, MIX, tid, (int)blockIdx.x, G);
#else
            sk::d_rwkv_fin(PROJ, W, pR, pK, pV, MIX, gtid, gsize);
#endif
        PH_END
        PH_BEGIN
            pg8::Gemm g{MIX, Wt_out, MTOK, 1024, 1024}; pg8::StaticOrder S; S.init(MTOK, 1024, G, (int)blockIdx.x);
            pg8::EpiResid E{xin, out, XB, SSQ_B + (size_t)l * MTOK, 1024};
            pg8::gemm_phase<pg8::EpiResid, pg8::StaticOrder, true, true>(L, g, S, E, tid);
        PH_END
        PH_BEGIN
            REPEAT(5) {
            pg8::Gemm g{XB, Wt_up, 66 * 256, 5632, 1024}; pg8::StaticOrder S; S.init(66 * 256, 5632, G, (int)blockIdx.x);
            pg8::EpiConvAct E{ACT, SSQ_B + (size_t)l * MTOK, args.in[I_CW] + (size_t)l * 3 * 5632, args.in[I_CB] + (size_t)l * 5632};
            pg8::gemm_phase<pg8::EpiConvAct, pg8::StaticOrder, true, true>(L, g, S, E, tid); }
        PH_END
        PH_BEGIN
            pg8::Gemm g{ACT, Wt_down, MTOK, 1024, 2816}; pg8::StaticOrder S; S.init(MTOK, 1024, G, (int)blockIdx.x);
            pg8::EpiResid E{out, out, XB, SSQ_A + (size_t)(l + 1) * MTOK, 1024};
            pg8::gemm_phase<pg8::EpiResid, pg8::StaticOrder, true, true>(L, g, S, E, tid);
        PH_END
    }
#undef PH_BEGIN
#undef PH_END
}
constexpr int N_PHASES = 1 + 2 * 7;
}

#ifndef MK_PER_PHASE
#define MK_PER_PHASE 0
#endif
extern "C" void kernel_launch(void* const* d_in, const int* in_sizes, int n_in, void* d_out, int out_size, void* d_ws, size_t ws_size, hipStream_t stream) {
    static int grid = 0;
    if (grid == 0) {
        if (n_in != N_IN || out_size != MTOK * DM || ws_size < mk::WS_END) { fprintf(stderr, "kernel_launch: unexpected shapes (n_in %d out %d ws %zu)\n", n_in, out_size, ws_size); grid = -1; return; }
        int dev = 0, cus = 0, per_cu = 0;
        if (hipGetDevice(&dev) != hipSuccess || hipDeviceGetAttribute(&cus, hipDeviceAttributeMultiprocessorCount, dev) != hipSuccess) { grid = -1; return; }
        if (hipFuncSetAttribute((const void*)mk::mk_fwd, hipFuncAttributeMaxDynamicSharedMemorySize, mk::LDS_BYTES) != hipSuccess) { fprintf(stderr, "kernel_launch: hipFuncSetAttribute failed\n"); grid = -1; return; }
        if (hipOccupancyMaxActiveBlocksPerMultiprocessor(&per_cu, (const void*)mk::mk_fwd, NWAVES * 64, mk::LDS_BYTES) != hipSuccess || per_cu < 1) { fprintf(stderr, "kernel_launch: occupancy query says %d blocks per CU\n", per_cu); }
        (void)hipGetLastError();
        grid = cus;
    }
    if (grid < 0) return;
    if (hipMemsetAsync((char*)d_ws + mk::WS_CTL, 0, mk::CTL_ZERO_BYTES, stream) != hipSuccess) return;
    mk::Args a{};
    for (int i = 0; i < N_IN; ++i) a.in[i] = (const float*)d_in[i];
    a.out = (float*)d_out; a.ws = (unsigned char*)d_ws;
#if MK_PER_PHASE
    for (int p = 0; p < mk::N_PHASES; ++p) { a.ph_lo = p; a.ph_hi = p + 1; hipLaunchKernelGGL(mk::mk_fwd, dim3(grid), dim3(NWAVES * 64), mk::LDS_BYTES, stream, a); }
#else
    a.ph_lo = 0; a.ph_hi = mk::N_PHASES;
    hipLaunchKernelGGL(mk::mk_fwd, dim3(grid), dim3(NWAVES * 64), mk::LDS_BYTES, stream, a);
#endif
}
```

```cpp
#define MK_BUILD 1
#ifndef HOST_SIM
#include <hip/hip_runtime.h>
#include <cstdio>
#include <cstdint>
#endif
#ifndef SEQ_LEN
#define SEQ_LEN 8192
#endif
typedef unsigned short bf16_t;
constexpr int BATCH = 2, SEQ = SEQ_LEN, DM = 1024, MTOK = BATCH * SEQ, DFF = 2816, LDP = 2304  ;
constexpr float EPS = 1e-6f, GN_EPS = 64e-5f;
__host__ __device__ __forceinline__ float bf2f(bf16_t h) { unsigned u = (unsigned)h << 16; return __builtin_bit_cast(float, u); }
__host__ __device__ __forceinline__ bf16_t f2bf(float f) { unsigned u = __builtin_bit_cast(unsigned, f); return (bf16_t)((u + 0x7fffu + ((u >> 16) & 1u)) >> 16); }
__host__ __device__ __forceinline__ int t5_bucket(int dist) {
    if (dist < 16) return dist;
    const float v = logf((float)dist / 16.0f) / 2.0794415416798357f * 16.0f;
    int large = 16 + (int)v; return large < 31 ? large : 31;
}
constexpr size_t MiB = 1u << 20;
enum { I_X = 0, I_MEM, I_RELB, I_MIXG, I_WIN, I_WINV, I_AQN, I_AKN, I_SINK, I_MU, I_MUV, I_W0, I_W2, I_A0, I_A2, I_V0, I_V2, I_G2, I_KK, I_KA, I_RK, I_LNW, I_LNB, I_MEMG, I_WMKV, I_MQN, I_MKN, I_WOUT, I_FFNG, I_WUP, I_CW, I_CB, I_WDOWN, N_IN };
#ifndef PROF_PH
#define PROF_PH -1
#endif
#ifndef PROF_N
#define PROF_N 1
#endif
namespace sk {

__device__ __forceinline__ void d_wt(const float* W, const float* g, bf16_t* Wt, int K, int N, int Npad, long gtid, long gsize) {
    const long total = (long)Npad * K;
    for (long idx = gtid; idx < total; idx += gsize) {
        const int n = (int)(idx / K), k = (int)(idx % K);
        float v = 0.f;
        if (n < N) { v = W[(long)k * N + n]; if (g) v *= g[k]; }
        Wt[idx] = f2bf(v);
    }
}
#ifndef MK_BUILD
__global__ void k_wt(const float* W, const float* g, bf16_t* Wt, int K, int N, int Npad) { d_wt(W, g, Wt, K, N, Npad, (long)blockIdx.x * blockDim.x + threadIdx.x, (long)gridDim.x * blockDim.x); }
#endif
__device__ __forceinline__ void d_rowprep(const float* x, bf16_t* xb, float* ssq, int rows, long gtid, long gsize) {
    for (long r = gtid; r < rows; r += gsize) {
        const float* xr = x + (long)r * DM; bf16_t* o = xb + (long)r * DM; float s = 0.f;
        for (int c = 0; c < DM; ++c) { const float v = xr[c]; s += v * v; o[c] = f2bf(v); }
        ssq[r] = s;
    }
}
#ifndef MK_BUILD
__global__ void k_rowprep(const float* x, bf16_t* xb, float* ssq, int rows) { d_rowprep(x, xb, ssq, rows, (long)blockIdx.x * blockDim.x + threadIdx.x, (long)gridDim.x * blockDim.x); }
#endif
__device__ __forceinline__ void d_biastab(const float* rel_bias, float* tab, long gtid, long gsize) {
        for (long i = gtid; i < 128 * 6; i += gsize) { const int dist = i / 6, hq = i % 6; tab[i] = rel_bias[t5_bucket(dist) * 6 + hq]; }
}
#ifndef MK_BUILD
__global__ void k_biastab(const float* rel_bias, float* tab) { d_biastab(rel_bias, tab, (long)blockIdx.x * blockDim.x + threadIdx.x, (long)gridDim.x * blockDim.x); }
#endif
__device__ __forceinline__ void d_qknorm(bf16_t* P, int rows, int ld, const float* gq, const float* gk, const float* gm, int mode, long gtid, long gsize) {
    const int nj = mode == 0 ? 12 : 4;
    const long total = (long)rows * nj;
    for (long idx = gtid; idx < total; idx += gsize) {
        const int row = (int)(idx / nj), j = (int)(idx % nj);
        int col; const float* g;
        if (mode == 0) { if (j < 6) { col = 64 * j; g = gq; } else if (j < 8) { col = 384 + 64 * (j - 6); g = gk; } else { col = 1920 + 64 * (j - 8); g = gm; } }
        else { col = 64 * j; g = gm; }
        bf16_t* p = P + (long)row * ld + col; float s = 0.f;
        for (int d = 0; d < 64; ++d) { const float v = bf2f(p[d]); s += v * v; }
        const float rs = 1.0f / sqrtf(s * (1.0f / 64.0f) + EPS);
        for (int d = 0; d < 64; ++d) p[d] = f2bf(bf2f(p[d]) * rs * g[d]);
    }
}
#ifndef MK_BUILD
__global__ void k_qknorm(bf16_t* P, int rows, int ld, const float* gq, const float* gk, const float* gm, int mode) { d_qknorm(P, rows, ld, gq, gk, gm, mode, (long)blockIdx.x * blockDim.x + threadIdx.x, (long)gridDim.x * blockDim.x); }
#endif
__device__ __forceinline__ void d_swa(const bf16_t* P, bf16_t* MIX, const float* biastab, const float* sinks, long gtid, long gsize) {
    const long total = (long)MTOK * 6;
    for (long idx = gtid; idx < total; idx += gsize) {
        const int tok = (int)(idx / 6), hq = (int)(idx % 6), hkv = hq / 3, t = tok % SEQ;
        float q[64], o[64];
#pragma unroll
        for (int d = 0; d < 64; ++d) { q[d] = bf2f(P[(long)tok * LDP + 64 * hq + d]) * 0.125f; o[d] = 0.f; }
        float m = sinks[hq], l = 1.0f;
        const int j0 = t - 127 < 0 ? 0 : t - 127;
        for (int j = j0; j <= t; ++j) {
            const bf16_t* kr = P + (long)(tok - (t - j)) * LDP + 384 + 64 * hkv; const bf16_t* vr = kr + 128;
            float s = 0.f;
#pragma unroll
            for (int d = 0; d < 64; ++d) s += q[d] * bf2f(kr[d]);
            s += biastab[(t - j) * 6 + hq];
            const float mn = fmaxf(m, s), f = expf(m - mn), e = expf(s - mn);
            l = l * f + e; m = mn;
#pragma unroll
            for (int d = 0; d < 64; ++d) o[d] = o[d] * f + e * bf2f(vr[d]);
        }
        const float inv = 1.0f / l;
#pragma unroll
        for (int d = 0; d < 64; ++d) MIX[(long)tok * DM + 64 * hq + d] = f2bf(o[d] * inv);
    }
}
#ifndef MK_BUILD
__global__ __launch_bounds__(256) void k_swa(const bf16_t* P, bf16_t* MIX, const float* biastab, const float* sinks) { d_swa(P, MIX, biastab, sinks, (long)blockIdx.x * blockDim.x + threadIdx.x, (long)gridDim.x * blockDim.x); }
#endif
__device__ __forceinline__ void d_memattn(const bf16_t* P, const bf16_t* MKV, bf16_t* MIX, long gtid, long gsize) {
    const long total = (long)MTOK * 4;
    for (long idx = gtid; idx < total; idx += gsize) {
        const int tok = (int)(idx / 4), h = (int)(idx % 4), b = tok / SEQ;
        float q[64], o[64];
#pragma unroll
        for (int d = 0; d < 64; ++d) { q[d] = bf2f(P[(long)tok * LDP + 1920 + 64 * h + d]) * 0.125f; o[d] = 0.f; }
        float m = -1e30f, l = 0.f;
        for (int j = 0; j < 256; ++j) {
            const bf16_t* kr = MKV + (long)(b * 256 + j) * 512 + 64 * h; const bf16_t* vr = kr + 256;
            float s = 0.f;
#pragma unroll
            for (int d = 0; d < 64; ++d) s += q[d] * bf2f(kr[d]);
            const float mn = fmaxf(m, s), f = expf(m - mn), e = expf(s - mn);
            l = l * f + e; m = mn;
#pragma unroll
            for (int d = 0; d < 64; ++d) o[d] = o[d] * f + e * bf2f(vr[d]);
        }
        const float inv = 1.0f / l;
#pragma unroll
        for (int d = 0; d < 64; ++d) MIX[(long)tok * DM + 768 + 64 * h + d] = f2bf(o[d] * inv);
    }
}
#ifndef MK_BUILD
__global__ __launch_bounds__(256) void k_memattn(const bf16_t* P, const bf16_t* MKV, bf16_t* MIX) { d_memattn(P, MKV, MIX, (long)blockIdx.x * blockDim.x + threadIdx.x, (long)gridDim.x * blockDim.x); }
#endif
__device__ __forceinline__ float shifted(const bf16_t* P, int tok, int col, float mu) {
    const float p = bf2f(P[(long)tok * LDP + col]);
    const float prev = (tok % SEQ) == 0 ? 0.f : bf2f(P[(long)(tok - 1) * LDP + col]);
    return p + mu * (prev - p);
}
struct RwkvW { const float *mu, *mu_v, *w0, *w2, *a0, *a2, *v0, *v2, *g2, *k_k, *k_a, *r_k, *ln_w, *ln_b; };
__device__ __forceinline__ void d_rwkv_prep(const bf16_t* P, RwkvW W, int layer, bf16_t* VFIRST, bf16_t* R, bf16_t* K, bf16_t* V, bf16_t* KK, bf16_t* B, bf16_t* LOGD, long gtid, long gsize) {
    const long total = (long)MTOK * 6;
    for (long idx = gtid; idx < total; idx += gsize) {
        const int tok = (int)(idx / 6), h = (int)(idx % 6);
        float nrm = 0.f;
        for (int c = 0; c < 64; ++c) { const int hc = 64 * h + c; const float kc = shifted(P, tok, 640 + 384 + hc, W.mu[384 + hc]) * W.k_k[hc]; nrm += kc * kc; }
        const float rn = 1.0f / fmaxf(sqrtf(nrm), 1e-12f);
        for (int c = 0; c < 64; ++c) {
            const int hc = 64 * h + c; const long o = (long)tok * 384 + hc;
            const float r = shifted(P, tok, 640 + hc, W.mu[hc]);
            const float k = shifted(P, tok, 640 + 384 + hc, W.mu[384 + hc]);
            float v = shifted(P, tok, 640 + 768 + hc, W.mu[768 + hc]);
            float wp = W.w0[hc], ap = W.a0[hc];
            for (int j = 0; j < 32; ++j) {
                wp += tanhf(shifted(P, tok, 640 + 1152 + j, W.mu[1152 + j])) * W.w2[j * 384 + hc];
                ap += shifted(P, tok, 640 + 1184 + j, W.mu[1184 + j]) * W.a2[j * 384 + hc];
            }
            const float z = -wp; const float sp = fmaxf(z, 0.f) + log1pf(expf(-fabsf(z)));
            const float w = -sp - 0.5f;
            const float a = 1.0f / (1.0f + expf(-ap));
            if (layer > 0) {
                float vp = W.v0[hc];
                for (int j = 0; j < 16; ++j) vp += shifted(P, tok, 2176 + j, W.mu_v[j]) * W.v2[j * 384 + hc];
                const float vf = bf2f(VFIRST[o]);
                v = v + (vf - v) * (1.0f / (1.0f + expf(-vp)));
            } else VFIRST[o] = f2bf(v);
            const float kk = k * W.k_k[hc] * rn;
            R[o] = f2bf(r); K[o] = f2bf(k * (1.0f + (a - 1.0f) * W.k_a[hc])); V[o] = f2bf(v);
            KK[o] = f2bf(kk); B[o] = f2bf(kk * a); LOGD[o] = f2bf(-expf(w));
        }
    }
}
#ifndef MK_BUILD
__global__ void k_rwkv_prep(const bf16_t* P, RwkvW W, int layer, bf16_t* VFIRST, bf16_t* R, bf16_t* K, bf16_t* V, bf16_t* KK, bf16_t* B, bf16_t* LOGD) { d_rwkv_prep(P, W, layer, VFIRST, R, K, V, KK, B, LOGD, (long)blockIdx.x * blockDim.x + threadIdx.x, (long)gridDim.x * blockDim.x); }
#endif
__device__ __forceinline__ void d_rwkv_scan(const bf16_t* R, const bf16_t* K, const bf16_t* V, const bf16_t* KK, const bf16_t* B, const bf16_t* LOGD, bf16_t* MIX, int bh, int i) {
    const int b = bh / 6, h = bh % 6;
    float s[64];
#pragma unroll
    for (int k = 0; k < 64; ++k) s[k] = 0.f;
    for (int t = 0; t < SEQ; ++t) {
        const long o = (long)(b * SEQ + t) * 384 + 64 * h;
        float sa = 0.f;
#pragma unroll
        for (int k = 0; k < 64; ++k) sa -= s[k] * bf2f(KK[o + k]);
        const float v = bf2f(V[o + i]); float y = 0.f;
#pragma unroll
        for (int k = 0; k < 64; ++k) { s[k] = s[k] * expf(bf2f(LOGD[o + k])) + sa * bf2f(B[o + k]) + v * bf2f(K[o + k]); y += s[k] * bf2f(R[o + k]); }
        MIX[(long)(b * SEQ + t) * DM + 384 + 64 * h + i] = f2bf(y);
    }
}
#ifndef MK_BUILD
__global__ void k_rwkv_scan(const bf16_t* R, const bf16_t* K, const bf16_t* V, const bf16_t* KK, const bf16_t* B, const bf16_t* LOGD, bf16_t* MIX) { d_rwkv_scan(R, K, V, KK, B, LOGD, MIX, blockIdx.x, threadIdx.x); }
#endif
__device__ __forceinline__ void d_rwkv_fin(const bf16_t* P, RwkvW W, const bf16_t* R, const bf16_t* K, const bf16_t* V, bf16_t* MIX, long gtid, long gsize) {
    const long total = (long)MTOK * 6;
    for (long idx = gtid; idx < total; idx += gsize) {
        const int tok = (int)(idx / 6), h = (int)(idx % 6);
        bf16_t* y = MIX + (long)tok * DM + 384 + 64 * h; const long o = (long)tok * 384 + 64 * h;
        float mean = 0.f, dot = 0.f;
        for (int c = 0; c < 64; ++c) { mean += bf2f(y[c]); dot += bf2f(R[o + c]) * bf2f(K[o + c]) * W.r_k[64 * h + c]; }
        mean *= (1.0f / 64.0f); float var = 0.f;
        for (int c = 0; c < 64; ++c) { const float d = bf2f(y[c]) - mean; var += d * d; }
        const float rstd = 1.0f / sqrtf(var * (1.0f / 64.0f) + GN_EPS);
        for (int c = 0; c < 64; ++c) {
            const int hc = 64 * h + c; float g = 0.f;
            for (int j = 0; j < 64; ++j) g += (1.0f / (1.0f + expf(-shifted(P, tok, 640 + 1216 + j, W.mu[1216 + j])))) * W.g2[j * 384 + hc];
            const float yn = (bf2f(y[c]) - mean) * rstd * W.ln_w[hc] + W.ln_b[hc];
            y[c] = f2bf((yn + dot * bf2f(V[o + c])) * g);
        }
    }
}
#ifndef MK_BUILD
__global__ void k_rwkv_fin(const bf16_t* P, RwkvW W, const bf16_t* R, const bf16_t* K, const bf16_t* V, bf16_t* MIX) { d_rwkv_fin(P, W, R, K, V, MIX, (long)blockIdx.x * blockDim.x + threadIdx.x, (long)gridDim.x * blockDim.x); }
#endif
__device__ __forceinline__ void d_conv_act(const bf16_t* U, const float* cw, const float* cb, bf16_t* ACT, int rows, long gtid, long gsize) {
    const long total = (long)rows * DFF;
    for (long idx = gtid; idx < total; idx += gsize) {
        const int t = (int)(idx / DFF), c = (int)(idx % DFF);
        float gate = cb[c], val = cb[DFF + c];
#pragma unroll
        for (int i = 0; i < 3; ++i) { const int tt = t - 2 + i; if (tt >= 0) { gate += cw[i * 2 * DFF + c] * bf2f(U[(long)tt * 2 * DFF + c]); val += cw[i * 2 * DFF + DFF + c] * bf2f(U[(long)tt * 2 * DFF + DFF + c]); } }
        ACT[(long)t * DFF + c] = f2bf(gate / (1.0f + expf(-gate)) * val);
    }
}
#ifndef MK_BUILD
__global__ void k_conv_act(const bf16_t* U, const float* cw, const float* cb, bf16_t* ACT, int rows) { d_conv_act(U, cw, cb, ACT, rows, (long)blockIdx.x * blockDim.x + threadIdx.x, (long)gridDim.x * blockDim.x); }
#endif
}
namespace pg8 {
#define PG8_LAS __attribute__((address_space(3)))
typedef unsigned short bf16_t;
typedef short bf16x8 __attribute__((ext_vector_type(8)));
typedef float f32x4 __attribute__((ext_vector_type(4)));
typedef unsigned u32x4 __attribute__((ext_vector_type(4)));
constexpr int BM = 256, BK = 64, HALF = 128, HTB = HALF * BK * 2  , STAGE_BYTES = 8 * HTB, NXCD = 8, WGM = 8;

__host__ __device__ __forceinline__ int lds_byte(int r, int c) { const int st = (r >> 4) * 2 + (c >> 5), rr = r & 15, cc = c & 31, ob = rr * 64 + cc * 2; return st * 1024 + (ob ^ (((ob >> 9) & 1) << 5)); }
__host__ __device__ __forceinline__ void stage_rc(int b, int& R, int& C) { const int st = b / 1024, sb = b % 1024, swz = sb ^ (((sb >> 9) & 1) << 5); R = (st >> 1) * 16 + swz / 64; C = (st & 1) * 32 + (swz % 64) / 2; }
__host__ __device__ __forceinline__ int perm32(int rho) { const int n = rho >> 4, i = rho & 15; return 8 * (i >> 2) + 4 * n + (i & 3); }

struct Unit { int pm, pn; };
struct Gemm { const bf16_t* A; const bf16_t* Bt; int M, N, K; };

struct StaticOrder {
    int nM, nN, nwg, G, c;
    __host__ __device__ void init(int M, int N, int G_, int c_) { nM = M / BM; nN = N / BM; nwg = nM * nN; G = G_; c = c_; }
    __host__ __device__ bool next(int i, Unit& u) const {
        const long L = (long)i * G + c; if (L >= nwg) return false;
        int wgid = (int)L; { const int q = nwg / NXCD, r = nwg % NXCD, xcd = wgid % NXCD, off = wgid / NXCD; wgid = (xcd < r ? xcd * (q + 1) : r * (q + 1) + (xcd - r) * q) + off; }
        const int nig = WGM * nN, gid = wgid / nig, fm = gid * WGM, gsz = (nM - fm) < WGM ? (nM - fm) : WGM;
        u.pm = fm + ((wgid % nig) % gsz); u.pn = (wgid % nig) / gsz; return true;
    }
    __device__ __forceinline__ void a_ready(const Unit&) const {}
    __device__ __forceinline__ void done(const Unit&) const {}
};

__device__ __forceinline__ unsigned cvt_pk_bf16(float lo, float hi) { unsigned r; asm volatile("v_cvt_pk_bf16_f32 %0, %1, %2" : "=v"(r) : "v"(lo), "v"(hi)); return r; }
struct EpiScaleBf16 {
    static constexpr bool PERM = true, AFTER_DRAIN = false; static constexpr int AMAP = 0;
    bf16_t* O; int ldc; const float* ssq;
    __device__ __forceinline__ void operator()(const f32x4 (&acc)[2][2][4][2], const Unit& u, int wr, int wc, int fr, int fq) const {
        const int row0 = u.pm * BM + wr * 64 + fr, col0 = u.pn * BM + wc * 32 + 8 * fq;
#pragma unroll
        for (int ai = 0; ai < 2; ++ai)
#pragma unroll
            for (int m = 0; m < 4; ++m) { const int row = row0 + ai * HALF + m * 16; const float sc = 1.0f / sqrtf(ssq[row] * (1.0f / 1024.0f) + 1e-6f);
                bf16_t* rowp = O + (size_t)row * ldc + col0;
#pragma unroll
                for (int bj = 0; bj < 2; ++bj) { const f32x4 v0 = acc[ai][bj][m][0] * sc, v1 = acc[ai][bj][m][1] * sc;
                    u32x4 w; w.x = cvt_pk_bf16(v0[0], v0[1]); w.y = cvt_pk_bf16(v0[2], v0[3]); w.z = cvt_pk_bf16(v1[0], v1[1]); w.w = cvt_pk_bf16(v1[2], v1[3]);
                    *(u32x4*)(rowp + bj * HALF) = w; } }
    }
};
struct EpiResid {
    static constexpr bool PERM = false, AFTER_DRAIN = false; static constexpr int AMAP = 0;
    const float* base; float* out; bf16_t* xb; float* ssq; int ldc;
    __device__ __forceinline__ void operator()(const f32x4 (&acc)[2][2][4][2], const Unit& u, int wr, int wc, int fr, int fq) const {
        typedef unsigned u32x2v __attribute__((ext_vector_type(2)));
        const int col0 = u.pn * BM + wc * 32 + 4 * fq;
#pragma unroll
        for (int ai = 0; ai < 2; ++ai)
#pragma unroll
            for (int m = 0; m < 4; ++m) { const int row = u.pm * BM + ai * HALF + wr * 64 + m * 16 + fr; const size_t off = (size_t)row * ldc + col0; float sq = 0.f;
#pragma unroll
                for (int bj = 0; bj < 2; ++bj)
#pragma unroll
                    for (int n = 0; n < 2; ++n) { const f32x4 o = *(const f32x4*)(base + off + bj * HALF + n * 16) + acc[ai][bj][m][n];
                        *(f32x4*)(out + off + bj * HALF + n * 16) = o; sq += (o[0] * o[0] + o[1] * o[1]) + (o[2] * o[2] + o[3] * o[3]);
                        u32x2v w; w.x = cvt_pk_bf16(o[0], o[1]); w.y = cvt_pk_bf16(o[2], o[3]); *(u32x2v*)(xb + off + bj * HALF + n * 16) = w; }
                sq += __shfl_xor(sq, 16); sq += __shfl_xor(sq, 32);
                if (fq == 0) atomicAdd(ssq + row, sq); }
    }
};
struct EpiConvAct {
    static constexpr bool PERM = true, AFTER_DRAIN = false; static constexpr int AMAP = 1;
    bf16_t* ACT; const float* ssq; const float* cw; const float* cb;
    static __device__ __forceinline__ float shr1s(float x) { float r; asm volatile("s_nop 1\n\tv_mov_b32_dpp %0, %1 row_shr:1 row_mask:0xf bank_mask:0xf bound_ctrl:1" : "=v"(r) : "v"(x)); return r; }
    static __device__ __forceinline__ f32x4 shr1(f32x4 v) { f32x4 r; r[0] = shr1s(v[0]); r[1] = shr1s(v[1]); r[2] = shr1s(v[2]); r[3] = shr1s(v[3]); return r; }
    __device__ __forceinline__ void operator()(const f32x4 (&acc)[2][2][4][2], const Unit& u, int wr, int wc, int fr, int fq) const {
        const int b = u.pm / 33, pmb = u.pm % 33;
        const int pos0 = 252 * pmb + 126 * wr + 8 * fr - 2;
        const long row0 = (long)b * SEQ + pos0;
        float rs[8];
#pragma unroll
        for (int j = 0; j < 8; ++j) { const int pos = pos0 + j; const bool ok = pos >= 0 && pos < SEQ; const float q = ssq[ok ? row0 + j : 0]; rs[j] = ok ? 1.0f / sqrtf(q * (1.0f / 1024.0f) + 1e-6f) : 0.f; }
        const int ch0 = 128 * u.pn + 32 * wc + 8 * fq;
        unsigned ow[8][4];
#pragma unroll
        for (int n = 0; n < 2; ++n) { const int c = ch0 + 4 * n;
            const f32x4 w0g = *(const f32x4*)(cw + c), w1g = *(const f32x4*)(cw + 5632 + c), w2g = *(const f32x4*)(cw + 2 * 5632 + c), bg = *(const f32x4*)(cb + c);
            const f32x4 w0v = *(const f32x4*)(cw + 2816 + c), w1v = *(const f32x4*)(cw + 5632 + 2816 + c), w2v = *(const f32x4*)(cw + 2 * 5632 + 2816 + c), bv = *(const f32x4*)(cb + 2816 + c);
            f32x4 gm2 = shr1(acc[1][0][2][n] * rs[6]), gm1 = shr1(acc[1][0][3][n] * rs[7]), vm2 = shr1(acc[1][1][2][n] * rs[6]), vm1 = shr1(acc[1][1][3][n] * rs[7]);
#pragma unroll
            for (int j = 0; j < 8; ++j) { const f32x4 gj = acc[j >> 2][0][j & 3][n] * rs[j], vj = acc[j >> 2][1][j & 3][n] * rs[j];
                const f32x4 ug = bg + w0g * gm2 + w1g * gm1 + w2g * gj, uv = bv + w0v * vm2 + w1v * vm1 + w2v * vj; f32x4 a;
#pragma unroll
                for (int e = 0; e < 4; ++e) a[e] = ug[e] / (1.0f + __expf(-ug[e])) * uv[e];
                ow[j][2 * n] = cvt_pk_bf16(a[0], a[1]); ow[j][2 * n + 1] = cvt_pk_bf16(a[2], a[3]);
                gm2 = gm1; gm1 = gj; vm2 = vm1; vm1 = vj; } }
#pragma unroll
        for (int j = 0; j < 8; ++j) if (8 * fr + j >= 2 && pos0 + j < SEQ) { u32x4 w; w.x = ow[j][0]; w.y = ow[j][1]; w.z = ow[j][2]; w.w = ow[j][3]; *(u32x4*)(ACT + (size_t)(row0 + j) * 2816 + ch0) = w; }
    }
};
template <class Epi, class Sched, bool ALIGN_EPI = false, bool SP2 = false>
__device__ __forceinline__ void gemm_phase(PG8_LAS unsigned char* lds, const Gemm g, const Sched& S, const Epi& E, int tid_in) {
    int tid = tid_in; asm volatile("" : "+v"(tid));
    const int wid = __builtin_amdgcn_readfirstlane(tid >> 6), lane = tid & 63, wr = wid >> 2, wc = wid & 3, fr = lane & 15, fq = lane >> 4;
    const int K = g.K, nt = K / BK;
    unsigned voffA[2], voffB[2];
#pragma unroll
    for (int i = 0; i < 2; ++i) { int R, C; stage_rc(tid * 16 + i * 8192, R, C); const int Rb = Epi::PERM ? ((R & ~31) + perm32(R & 31)) : R;
        const int Ra = Epi::AMAP ? (126 * (R >> 6) + 8 * (R & 15) + ((R >> 4) & 3)) : R;
        voffA[i] = (unsigned)(Ra * K + C) * 2u; voffB[i] = (unsigned)(Rb * K + C) * 2u; }
    const size_t kstep = (size_t)(BK * 2);
    const size_t hstepB = (size_t)HALF * K * 2;
    const size_t hstepA = Epi::AMAP ? (size_t)4 * K * 2 : hstepB;
    const size_t tstep = 2 * hstepB;
#define PG8_ABASE(pm_) (Epi::AMAP ? (long)((long)((pm_) / 33) * SEQ + 252 * ((pm_) % 33) - 2) * (long)K * 2 : (long)(pm_) * (long)tstep)
    const unsigned ldsw = (unsigned)wid * 1024u;
    const int aoff = lds_byte(wr * 64 + fr, fq * 8), boff = lds_byte(wc * 32 + fr, fq * 8);
#define PG8_SA(b, h) (((b) * 2 + (h)) * HTB)
#define PG8_SB(b, h) ((4 + (b) * 2 + (h)) * HTB)
#define PG8_STAGE(bufoff, gbase, voff) do { _Pragma("unroll") for (int _i = 0; _i < 2; ++_i) \
        __builtin_amdgcn_global_load_lds((const unsigned*)((const char*)(gbase) + (voff)[_i]), (PG8_LAS unsigned*)(lds + (bufoff) + ldsw + _i * 8192), 16, 0, 0); } while (0)
#define PG8_LDA(dst, b, h) do { _Pragma("unroll") for (int m = 0; m < 4; ++m) _Pragma("unroll") for (int k = 0; k < 2; ++k) dst[m][k] = *(const PG8_LAS bf16x8*)(lds + PG8_SA(b, h) + aoff + m * 2048 + k * 1024); } while (0)
#define PG8_LDB(dst, b, h) do { _Pragma("unroll") for (int n = 0; n < 2; ++n) _Pragma("unroll") for (int k = 0; k < 2; ++k) dst[n][k] = *(const PG8_LAS bf16x8*)(lds + PG8_SB(b, h) + boff + n * 2048 + k * 1024); } while (0)
#define PG8_MMA(ai, bj, At, Bt) do { __builtin_amdgcn_s_setprio(1); _Pragma("unroll") for (int m = 0; m < 4; ++m) _Pragma("unroll") for (int n = 0; n < 2; ++n) _Pragma("unroll") for (int k = 0; k < 2; ++k) \
        acc[ai][bj][m][n] = __builtin_amdgcn_mfma_f32_16x16x32_bf16(Bt[n][k], At[m][k], acc[ai][bj][m][n], 0, 0, 0); __builtin_amdgcn_s_setprio(0); } while (0)
#define PG8_WAIT_V(n) asm volatile("s_waitcnt vmcnt(" #n ")" ::: "memory")
#define PG8_WAIT_L(n) asm volatile("s_waitcnt lgkmcnt(" #n ")" ::: "memory")
#define PG8_BAR __builtin_amdgcn_s_barrier()
#define PG8_SCHED __builtin_amdgcn_sched_barrier(0)
    Unit cur, nxt; int ui = 0;
    if (!S.next(0, cur)) return;
    f32x4 acc[2][2][4][2];
#pragma unroll
    for (int a = 0; a < 2; ++a)
#pragma unroll
        for (int b = 0; b < 2; ++b)
#pragma unroll
            for (int m = 0; m < 4; ++m)
#pragma unroll
                for (int n = 0; n < 2; ++n) acc[a][b][m][n] = (f32x4){0.f, 0.f, 0.f, 0.f};
    bf16x8 At[4][2], B0[2][2], B1[2][2];
    const char* cA = (const char*)g.A + PG8_ABASE(cur.pm); const char* cB = (const char*)g.Bt + (size_t)cur.pn * tstep;
    S.a_ready(cur);
    if constexpr (SP2) {
        PG8_STAGE(PG8_SB(0, 0), cB, voffB); PG8_STAGE(PG8_SB(0, 1), cB + hstepB, voffB); PG8_STAGE(PG8_SA(0, 0), cA, voffA); PG8_STAGE(PG8_SA(0, 1), cA + hstepA, voffA);
        if (wr == 1) PG8_BAR;
        PG8_WAIT_V(2); PG8_BAR;
        PG8_STAGE(PG8_SB(1, 0), cB + kstep, voffB); PG8_STAGE(PG8_SA(1, 0), cA + kstep, voffA); PG8_STAGE(PG8_SB(1, 1), cB + hstepB + kstep, voffB);
        PG8_WAIT_V(6); PG8_BAR;
    } else {
        PG8_STAGE(PG8_SB(0, 0), cB, voffB); PG8_STAGE(PG8_SA(0, 0), cA, voffA); PG8_STAGE(PG8_SB(0, 1), cB + hstepB, voffB); PG8_STAGE(PG8_SA(0, 1), cA + hstepA, voffA);
        if (wr == 1) PG8_BAR;
        PG8_WAIT_V(4); PG8_BAR;
        PG8_STAGE(PG8_SB(1, 0), cB + kstep, voffB); PG8_STAGE(PG8_SA(1, 0), cA + kstep, voffA); PG8_STAGE(PG8_SB(1, 1), cB + hstepB + kstep, voffB);
        PG8_WAIT_V(6); PG8_BAR;
    }
    for (;;) {
        const bool has_next = S.next(ui + 1, nxt);
        const char* nA = has_next ? (const char*)g.A + PG8_ABASE(nxt.pm) : cA; const char* nB = has_next ? (const char*)g.Bt + (size_t)nxt.pn * tstep : cB;
        for (int t = 0; t < nt; t += 2) {
            const bool last = (t == nt - 2);
            const char* a1 = cA + (size_t)(t + 1) * kstep;
            const char* a2 = last ? nA : cA + (size_t)(t + 2) * kstep; const char* b2 = last ? nB : cB + (size_t)(t + 2) * kstep;
            const char* a3 = a2 + kstep; const char* b3 = b2 + kstep;
            if (last && has_next) S.a_ready(nxt);
            if constexpr (SP2) {
            PG8_LDB(B0, 0, 0); PG8_LDB(B1, 0, 1); PG8_SCHED; PG8_LDA(At, 0, 0); PG8_STAGE(PG8_SA(1, 1), a1 + hstepA, voffA);
            PG8_WAIT_V(8); PG8_WAIT_L(0); PG8_BAR; PG8_MMA(0, 0, At, B0); PG8_MMA(0, 1, At, B1); PG8_BAR; PG8_SCHED;
            PG8_LDA(At, 0, 1); PG8_STAGE(PG8_SB(0, 0), b2, voffB); PG8_STAGE(PG8_SB(0, 1), b2 + hstepB, voffB); PG8_STAGE(PG8_SA(0, 0), a2, voffA);
            PG8_WAIT_V(8); PG8_WAIT_L(0); PG8_BAR; PG8_MMA(1, 0, At, B0); PG8_MMA(1, 1, At, B1); PG8_BAR; PG8_SCHED;
            PG8_LDB(B0, 1, 0); PG8_LDB(B1, 1, 1); PG8_SCHED; PG8_LDA(At, 1, 0); PG8_STAGE(PG8_SA(0, 1), a2 + hstepA, voffA);
            PG8_WAIT_V(8); PG8_WAIT_L(0); PG8_BAR; PG8_MMA(0, 0, At, B0); PG8_MMA(0, 1, At, B1); PG8_BAR; PG8_SCHED;
            PG8_LDA(At, 1, 1); PG8_STAGE(PG8_SB(1, 0), b3, voffB); PG8_STAGE(PG8_SB(1, 1), b3 + hstepB, voffB); PG8_STAGE(PG8_SA(1, 0), a3, voffA);
            PG8_WAIT_V(8); PG8_WAIT_L(0); PG8_BAR; PG8_MMA(1, 0, At, B0); PG8_MMA(1, 1, At, B1); PG8_BAR; PG8_SCHED;
            } else {
            PG8_LDB(B0, 0, 0); PG8_SCHED; PG8_LDA(At, 0, 0); PG8_STAGE(PG8_SA(1, 1), a1 + hstepA, voffA);
            PG8_WAIT_L(8); PG8_BAR; PG8_WAIT_L(0); PG8_MMA(0, 0, At, B0); PG8_BAR; PG8_SCHED;
            PG8_LDB(B1, 0, 1); PG8_STAGE(PG8_SB(0, 0), b2, voffB);
            PG8_BAR; PG8_WAIT_L(0); PG8_MMA(0, 1, At, B1); PG8_BAR;
            PG8_LDA(At, 0, 1); PG8_STAGE(PG8_SA(0, 0), a2, voffA);
            PG8_BAR; PG8_WAIT_L(0); PG8_MMA(1, 0, At, B0); PG8_BAR; PG8_SCHED;
            PG8_STAGE(PG8_SB(0, 1), b2 + hstepB, voffB);
            PG8_WAIT_V(6); PG8_BAR; PG8_MMA(1, 1, At, B1); PG8_BAR;
            PG8_LDB(B0, 1, 0); PG8_SCHED; PG8_LDA(At, 1, 0); PG8_STAGE(PG8_SA(0, 1), a2 + hstepA, voffA);
            PG8_WAIT_L(8); PG8_BAR; PG8_WAIT_L(0); PG8_MMA(0, 0, At, B0); PG8_BAR; PG8_SCHED;
            PG8_LDB(B1, 1, 1); PG8_STAGE(PG8_SB(1, 0), b3, voffB);
            PG8_BAR; PG8_WAIT_L(0); PG8_MMA(0, 1, At, B1); PG8_BAR;
            PG8_LDA(At, 1, 1); PG8_STAGE(PG8_SA(1, 0), a3, voffA);
            PG8_BAR; PG8_WAIT_L(0); PG8_MMA(1, 0, At, B0); PG8_BAR; PG8_SCHED;
            PG8_STAGE(PG8_SB(1, 1), b3 + hstepB, voffB);
            PG8_WAIT_V(6); PG8_BAR; PG8_MMA(1, 1, At, B1); PG8_BAR;
            }
        }
        if constexpr (ALIGN_EPI) { if (wr == 0) PG8_BAR; }
        if constexpr (!Epi::AFTER_DRAIN) { E(acc, cur, wr, wc, fr, fq); S.done(cur); }
        if (!has_next) break;
#pragma unroll
        for (int a = 0; a < 2; ++a)
#pragma unroll
            for (int b = 0; b < 2; ++b)
#pragma unroll
                for (int m = 0; m < 4; ++m)
#pragma unroll
                    for (int n = 0; n < 2; ++n) acc[a][b][m][n] = (f32x4){0.f, 0.f, 0.f, 0.f};
        cur = nxt; cA = nA; cB = nB; ++ui;
        if constexpr (ALIGN_EPI) { if (wr == 1) PG8_BAR; }
    }
    PG8_WAIT_V(0);
    if constexpr (!ALIGN_EPI) { if (wr == 0) PG8_BAR; }
    PG8_BAR;
    if constexpr (Epi::AFTER_DRAIN) { E.fused(acc, cur, wr, wc, fr, fq, lds, wid, lane); S.done(cur); }
#undef PG8_ABASE
#undef PG8_SA
#undef PG8_SB
#undef PG8_STAGE
#undef PG8_LDA
#undef PG8_LDB
#undef PG8_MMA
#undef PG8_WAIT_V
#undef PG8_WAIT_L
#undef PG8_BAR
#undef PG8_SCHED
}
}

#ifndef PG8_SP2
#define PG8_SP2 true
#endif
#ifndef PG8_ALIGN
#define PG8_ALIGN true
#endif
#define GAS __attribute__((address_space(1)))
#define LAS __attribute__((address_space(3)))
typedef unsigned short bf16;
typedef unsigned v4u __attribute__((ext_vector_type(4)));
typedef float f32x4 __attribute__((ext_vector_type(4)));
typedef short bf16x8 __attribute__((ext_vector_type(8)));
typedef GAS unsigned gu32;
typedef GAS unsigned long long gu64;
#define RLX_AGENT __ATOMIC_RELAXED, __HIP_MEMORY_SCOPE_AGENT
#define LDS_WAIT() asm volatile("s_waitcnt lgkmcnt(0)" ::: "memory")
#define VM_WAIT() asm volatile("s_waitcnt vmcnt(0)" ::: "memory")
__device__ __forceinline__ unsigned long long rt() { return __builtin_amdgcn_s_memrealtime(); }

#define XB_TMO      128
#define XB_XCNT(j)  (256  + 64 * (j))
#define XB_XSUB(j)  (1280 + 64 * (j))
#define XB_XGEN(j)  (2304 + 64 * (j))
#define XB_TOP      3328
#define XB_TOPGEN   3392
#define XCD_BAR_WORDS 3456
#define XB_SPIN_CAP (1u << 20)

__device__ __forceinline__ unsigned xb_ld(unsigned* p)              { return __hip_atomic_load(p, __ATOMIC_RELAXED, __HIP_MEMORY_SCOPE_AGENT); }
__device__ __forceinline__ unsigned xb_add(unsigned* p, unsigned v) { return __hip_atomic_fetch_add(p, v, __ATOMIC_RELAXED, __HIP_MEMORY_SCOPE_AGENT); }
__device__ __forceinline__ unsigned xb_xcc_id() { return (unsigned)__builtin_amdgcn_s_getreg((3 << 11) | 20) & 0xFu; }
#define XB_SPIN(cond, bar) do { unsigned _sp = 0; while (cond) { __builtin_amdgcn_s_sleep(1); \
    if ((++_sp & 255u) == 0u) { if (xb_ld(&(bar)[XB_TMO])) break; if (_sp > XB_SPIN_CAP) { atomicAdd(&(bar)[XB_TMO], 1u); break; } } } } while (0)

struct XcdBarrier {
    unsigned* bar; unsigned x;
    volatile LAS unsigned* st;
};

__device__ __forceinline__ XcdBarrier xcd_barrier_post(unsigned* bar, volatile LAS unsigned* st) {
    XcdBarrier b; b.bar = bar; b.x = xb_xcc_id(); b.st = st;
    if (threadIdx.x == 0) (void)xb_add(&bar[XB_XCNT(b.x)], 1u);
    return b;
}
__device__ __forceinline__ void xcd_barrier_complete(unsigned* bar, unsigned x, unsigned& nloc, unsigned& nx) {
    const unsigned G = gridDim.x * gridDim.y * gridDim.z;
    unsigned sum, cnt, mine, sp = 0u;
    for (;;) {
        sum = 0u; cnt = 0u; mine = 0u;
#pragma unroll
        for (unsigned j = 0; j < 16; ++j) { const unsigned c = xb_ld(&bar[XB_XCNT(j)]); sum += c; cnt += (c > 0u) ? 1u : 0u; mine = (j == x) ? c : mine; }
        if (sum == G) break;
        __builtin_amdgcn_s_sleep(1);
        if ((++sp & 255u) == 0u) { if (xb_ld(&bar[XB_TMO])) break; if (sp > XB_SPIN_CAP) { atomicAdd(&bar[XB_TMO], 1u); break; } }
    }
    nloc = mine > 0u ? mine : 1u; nx = cnt > 0u ? cnt : 1u;
}

__device__ __forceinline__ void xcd_barrier(const XcdBarrier& b) {
    asm volatile("s_waitcnt vmcnt(0)" ::: "memory");
    __syncthreads();
    if (threadIdx.x == 0) {
        unsigned* bar = b.bar;
        __builtin_amdgcn_s_waitcnt(0);
        unsigned nloc = b.st[0], nx = b.st[1];
        if (nloc == 0u) { xcd_barrier_complete(bar, b.x, nloc, nx); b.st[0] = nloc; b.st[1] = nx; }
        const unsigned old = xb_add(&bar[XB_XSUB(b.x)], 1u);
        const unsigned gen = old / nloc;
        if (old + 1u == (gen + 1u) * nloc) {
            __builtin_amdgcn_fence(__ATOMIC_RELEASE, "agent");
            asm volatile("s_waitcnt vmcnt(0)" ::: "memory");
            const unsigned og = xb_add(&bar[XB_TOP], 1u);
            const unsigned tg = og / nx;
            if (og + 1u == (tg + 1u) * nx) xb_add(&bar[XB_TOPGEN], 1u);
            else XB_SPIN(xb_ld(&bar[XB_TOPGEN]) == tg, bar);
            __builtin_amdgcn_fence(__ATOMIC_ACQUIRE, "agent");
            xb_add(&bar[XB_XGEN(b.x)], 1u);
            asm volatile("s_waitcnt vmcnt(0)" ::: "memory");
        } else {
            XB_SPIN(xb_ld(&bar[XB_XGEN(b.x)]) == gen, bar);
            __builtin_amdgcn_fence(__ATOMIC_ACQUIRE, "agent");
            asm volatile("s_waitcnt vmcnt(0)" ::: "memory");
        }
    }
    __syncthreads();
}

namespace rw {
constexpr int LD = 72;
constexpr int MATB = 64 * LD * 2;
constexpr int OFF_F0 = 12 * MATB  , OFF_TMP = OFF_F0 + 64 * 65 * 4  ;
constexpr int OFF_TW = 8 * MATB  , OFF_TA = OFF_TW + 5120, OFF_TV = OFF_TA + 5120, OFF_WP = OFF_TV + 5120  , OFF_AP = OFF_WP + 16640, OFF_VP = OFF_AP + 16640;
constexpr int OFF_TOT = 139264, OFF_GC = OFF_TOT + 2048, OFF_RN = OFF_GC + 256, OFF_END = OFF_RN + 256;
constexpr int NITEMS = BATCH * 6 * (SEQ / 64);
__device__ __forceinline__ int sigpos(int c) { return (c & 32) + 8 * ((c >> 2) & 3) + 4 * ((c >> 4) & 1) + (c & 3); }
#define RW_BAR() do { asm volatile("s_waitcnt lgkmcnt(0)" ::: "memory"); __builtin_amdgcn_s_barrier(); asm volatile("" ::: "memory"); } while (0)
__device__ __forceinline__ float fexp(float x) { return __expf(x); }
__device__ __forceinline__ float fsigm(float x) { return 1.0f / (1.0f + __expf(-x)); }
__device__ __forceinline__ float ftanh(float x) { const float e = __expf(-2.0f * fabsf(x)); const float t = (1.0f - e) / (1.0f + e); return x < 0.f ? -t : t; }
__device__ __forceinline__ f32x4 mm_tile(const LAS bf16_t* A, const LAS bf16_t* Bt, int ti, int tj, int fr, int fq, f32x4 acc) {
#pragma unroll
    for (int kk = 0; kk < 2; ++kk) {
        const bf16x8 a = *(const LAS bf16x8*)(A + (16 * ti + fr) * LD + 32 * kk + 8 * fq);
        const bf16x8 b = *(const LAS bf16x8*)(Bt + (16 * tj + fr) * LD + 32 * kk + 8 * fq);
        acc = __builtin_amdgcn_mfma_f32_16x16x32_bf16(a, b, acc, 0, 0, 0);
    }
    return acc;
}
__device__ __forceinline__ unsigned pk2(float lo, float hi) { typedef float f2_t __attribute__((ext_vector_type(2))); typedef __bf16 b2_t __attribute__((ext_vector_type(2))); f2_t v = {lo, hi}; return __builtin_bit_cast(unsigned, __builtin_convertvector(v, b2_t)); }
struct ChunkBufs { bf16_t* PT; bf16_t* G; float* Z; float* YV; bf16_t* S0; bf16_t* VOUT; float* DOT; const bf16_t *W2T, *A2T, *V2T, *G2T; };

#define RW_LANES() int lt_ = tid_in; asm volatile("" : "+v"(lt_)); const int tid = lt_, lane = lt_ & 63, fr = lane & 15, fq = lane >> 4; (void)tid; (void)fr; (void)fq
__device__ __forceinline__ void chunk_phase(LAS unsigned char* L, const bf16_t* P, const sk::RwkvW W, int layer, const bf16_t* VFIRST, const ChunkBufs cb, int tid_in, int first, int stride) {
    const int w = __builtin_amdgcn_readfirstlane(tid_in >> 6);
    LAS bf16_t* B0 = (LAS bf16_t*)(L + 0 * MATB); LAS bf16_t* B1 = (LAS bf16_t*)(L + 1 * MATB); LAS bf16_t* B2 = (LAS bf16_t*)(L + 2 * MATB); LAS bf16_t* B3 = (LAS bf16_t*)(L + 3 * MATB);
    LAS bf16_t* B4 = (LAS bf16_t*)(L + 4 * MATB); LAS bf16_t* B5 = (LAS bf16_t*)(L + 5 * MATB); LAS bf16_t* B6 = (LAS bf16_t*)(L + 6 * MATB); LAS bf16_t* B7 = (LAS bf16_t*)(L + 7 * MATB);
    LAS bf16_t* B8 = (LAS bf16_t*)(L + 8 * MATB); LAS bf16_t* B9 = (LAS bf16_t*)(L + 9 * MATB); LAS bf16_t* B10 = (LAS bf16_t*)(L + 10 * MATB); LAS bf16_t* B11 = (LAS bf16_t*)(L + 11 * MATB);
    LAS float* F0 = (LAS float*)(L + OFF_F0); LAS float* TMP = (LAS float*)(L + OFF_TMP);
    LAS bf16_t* TW = (LAS bf16_t*)(L + OFF_TW); LAS bf16_t* TA = (LAS bf16_t*)(L + OFF_TA); LAS bf16_t* TV = (LAS bf16_t*)(L + OFF_TV);
    LAS float* WP = (LAS float*)(L + OFF_WP); LAS float* AP = (LAS float*)(L + OFF_AP); LAS float* VP = (LAS float*)(L + OFF_VP);
    LAS float* TOT = (LAS float*)(L + OFF_TOT); LAS float* GC = (LAS float*)(L + OFF_GC); LAS float* RN = (LAS float*)(L + OFF_RN);
    for (int item = first; item < NITEMS; item += stride) {
        const int bh = item / (SEQ / 64), chunk = item % (SEQ / 64), b = bh / 6, h = bh % 6;
        const int tok0 = b * SEQ + chunk * 64;
        unsigned short e_r[9], e_k[9], e_v[9], e_vf[8]; float e_mu_r, e_mu_k, e_mu_v, e_w0, e_a0, e_kk, e_ka, e_rk, e_v0;
        { RW_LANES(); const int hc = 64 * h + lane, tk0 = tok0 + 8 * w; const bool has_prev = (chunk * 64 + 8 * w) > 0;
#pragma unroll
          for (int j = 0; j < 9; ++j) { const size_t row = (size_t)(tk0 + j - 1) * LDP; const bool ok = j > 0 || has_prev;
              e_r[j] = ok ? P[row + 640 + hc] : (unsigned short)0; e_k[j] = ok ? P[row + 1024 + hc] : (unsigned short)0; e_v[j] = ok ? P[row + 1408 + hc] : (unsigned short)0; }
#pragma unroll
          for (int j = 0; j < 8; ++j) e_vf[j] = layer > 0 ? VFIRST[(size_t)(tk0 + j) * 384 + hc] : (unsigned short)0;
          e_mu_r = W.mu[hc]; e_mu_k = W.mu[384 + hc]; e_mu_v = W.mu[768 + hc]; e_w0 = W.w0[hc]; e_a0 = W.a0[hc]; e_kk = W.k_k[hc]; e_ka = W.k_a[hc]; e_rk = W.r_k[hc]; e_v0 = layer > 0 ? W.v0[hc] : 0.f; }
        for (int rp_ = 0; rp_ < ((PROF_PH) == 20 ? 2 : 1); ++rp_) {
        { RW_LANES(); const int t = tid >> 3, sub = tid & 7, tok = tok0 + t; const bool hp = (chunk * 64 + t) > 0;
          const bf16_t* rc = P + (size_t)tok * LDP; const bf16_t* rp = rc - LDP; const v4u z4 = {0u, 0u, 0u, 0u};
          const v4u lc = *(const GAS v4u*)(rc + 1792 + 8 * sub), lp = hp ? *(const GAS v4u*)(rp + 1792 + 8 * sub) : z4;
          const v4u kc4 = *(const GAS v4u*)(rc + 1024 + 64 * h + 8 * sub), kp4 = hp ? *(const GAS v4u*)(rp + 1024 + 64 * h + 8 * sub) : z4;
          v4u vc4 = z4, vp4 = z4; if (layer > 0 && sub < 2) { vc4 = *(const GAS v4u*)(rc + 2176 + 8 * sub); if (hp) vp4 = *(const GAS v4u*)(rp + 2176 + 8 * sub); }
          const unsigned lcw[4] = {lc.x, lc.y, lc.z, lc.w}, lpw[4] = {lp.x, lp.y, lp.z, lp.w}, kcw[4] = {kc4.x, kc4.y, kc4.z, kc4.w}, kpw[4] = {kp4.x, kp4.y, kp4.z, kp4.w}, vcw[4] = {vc4.x, vc4.y, vc4.z, vc4.w}, vpw[4] = {vp4.x, vp4.y, vp4.z, vp4.w};
          unsigned lo[4], vo[4]; float s = 0.f;
#pragma unroll
          for (int e2 = 0; e2 < 4; ++e2) { float xl[2], xv[2];
#pragma unroll
              for (int u = 0; u < 2; ++u) { const int e = 2 * e2 + u; const int sh = 16 * u;
                  const float c1 = bf2f((bf16_t)((lcw[e2] >> sh) & 0xffff)), p1 = bf2f((bf16_t)((lpw[e2] >> sh) & 0xffff)); const float x = c1 + W.mu[1152 + 8 * sub + e] * (p1 - c1);
                  xl[u] = sub < 4 ? ftanh(x) : x;
                  const float c2 = bf2f((bf16_t)((kcw[e2] >> sh) & 0xffff)), p2 = bf2f((bf16_t)((kpw[e2] >> sh) & 0xffff)); const int hc = 64 * h + 8 * sub + e;
                  const float kx = (c2 + W.mu[384 + hc] * (p2 - c2)) * W.k_k[hc]; s += kx * kx;
                  const float c3 = bf2f((bf16_t)((vcw[e2] >> sh) & 0xffff)), p3 = bf2f((bf16_t)((vpw[e2] >> sh) & 0xffff)); xv[u] = (layer > 0 && sub < 2) ? c3 + W.mu_v[8 * sub + e] * (p3 - c3) : 0.f; }
              lo[e2] = pk2(xl[0], xl[1]); vo[e2] = pk2(xv[0], xv[1]); }
          *(LAS v4u*)((sub < 4 ? TW : TA) + t * 40 + 8 * (sub & 3)) = (v4u){lo[0], lo[1], lo[2], lo[3]};
          if (layer > 0 && sub < 4) *(LAS v4u*)(TV + t * 40 + 8 * sub) = (v4u){vo[0], vo[1], vo[2], vo[3]};
          s += __shfl_xor(s, 1); s += __shfl_xor(s, 2); s += __shfl_xor(s, 4);
          if (sub == 0) RN[t] = 1.0f / fmaxf(sqrtf(s), 1e-12f); }
        RW_BAR();
        }
        { RW_LANES();
#pragma unroll
        for (int e = 0; e < 2; ++e) { const int tl = 2 * w + e, ti = tl >> 2, tj = tl & 3; const f32x4 z4 = {0.f, 0.f, 0.f, 0.f};
            const size_t brow = (size_t)(64 * h + 16 * tj + fr) * 32 + 8 * fq;
            { const bf16x8 a = *(const LAS bf16x8*)(TW + (16 * ti + fr) * 40 + 8 * fq); const bf16x8 bb = *(const GAS bf16x8*)(cb.W2T + brow);
              const f32x4 d = __builtin_amdgcn_mfma_f32_16x16x32_bf16(a, bb, z4, 0, 0, 0);
#pragma unroll
              for (int r = 0; r < 4; ++r) WP[(16 * ti + 4 * fq + r) * 65 + 16 * tj + fr] = d[r]; }
            { const bf16x8 a = *(const LAS bf16x8*)(TA + (16 * ti + fr) * 40 + 8 * fq); const bf16x8 bb = *(const GAS bf16x8*)(cb.A2T + brow);
              const f32x4 d = __builtin_amdgcn_mfma_f32_16x16x32_bf16(a, bb, z4, 0, 0, 0);
#pragma unroll
              for (int r = 0; r < 4; ++r) AP[(16 * ti + 4 * fq + r) * 65 + 16 * tj + fr] = d[r]; }
            if (layer > 0) { const bf16x8 a = *(const LAS bf16x8*)(TV + (16 * ti + fr) * 40 + 8 * fq); const bf16x8 bb = *(const GAS bf16x8*)(cb.V2T + brow);
              const f32x4 d = __builtin_amdgcn_mfma_f32_16x16x32_bf16(a, bb, z4, 0, 0, 0);
#pragma unroll
              for (int r = 0; r < 4; ++r) VP[(16 * ti + 4 * fq + r) * 65 + 16 * tj + fr] = d[r]; } } }
        RW_BAR();
        for (int rp_ = 0; rp_ < ((PROF_PH) == 21 ? 2 : 1); ++rp_) {
        { RW_LANES(); const int c = lane, hc = 64 * h + c, tq0 = 8 * w, tk0 = tok0 + tq0;
          const float mu_r = e_mu_r, mu_k = e_mu_k, mu_v = e_mu_v, w0 = e_w0, a0 = e_a0, k_k = e_kk, k_a = e_ka, r_k = e_rk, v0 = e_v0;
          float pr = bf2f(e_r[0]), pk = bf2f(e_k[0]), pv = bf2f(e_v[0]);
          float rr[8], kq[8], vv[8], kkc[8], bb[8], ld[8], pd[8];
#pragma unroll
          for (int j = 0; j < 8; ++j) { const int t = tq0 + j;
              const float cr = bf2f(e_r[j + 1]), ck = bf2f(e_k[j + 1]), cv = bf2f(e_v[j + 1]);
              const float r = cr + mu_r * (pr - cr), k = ck + mu_k * (pk - ck); float v = cv + mu_v * (pv - cv); pr = cr; pk = ck; pv = cv;
              const float wp = w0 + WP[t * 65 + c], ap = a0 + AP[t * 65 + c];
              const float z = -wp, sp = fmaxf(z, 0.f) + __logf(1.0f + __expf(-fabsf(z))); const float wl = -sp - 0.5f;
              const float al = fsigm(ap);
              if (layer > 0) { const float vp = v0 + VP[t * 65 + c]; const float vf = bf2f(e_vf[j]); v = v + (vf - v) * fsigm(vp); }
              const float kn = k * k_k * RN[t]; const float k2 = k * (1.0f + (al - 1.0f) * k_a);
              rr[j] = r; kq[j] = k2; vv[j] = v; kkc[j] = kn; bb[j] = kn * al; ld[j] = -fexp(wl); pd[j] = r * k2 * r_k; }
          {
#pragma unroll
            for (int j = 0; j < 8; j += 2) { const unsigned pv2 = pk2(vv[j], vv[j + 1]); cb.VOUT[(size_t)(tk0 + j) * 384 + hc] = (bf16_t)(pv2 & 0xffff); cb.VOUT[(size_t)(tk0 + j + 1) * 384 + hc] = (bf16_t)(pv2 >> 16); } }
          {
            const bool b5 = lane & 32, b4 = lane & 16, b3 = lane & 8; float s4[4], s2[2], s1;
#pragma unroll
            for (int i = 0; i < 4; ++i) { const float keep = b5 ? pd[i + 4] : pd[i], send = b5 ? pd[i] : pd[i + 4]; s4[i] = keep + __shfl_xor(send, 32); }
#pragma unroll
            for (int i = 0; i < 2; ++i) { const float keep = b4 ? s4[i + 2] : s4[i], send = b4 ? s4[i] : s4[i + 2]; s2[i] = keep + __shfl_xor(send, 16); }
            { const float keep = b3 ? s2[1] : s2[0], send = b3 ? s2[0] : s2[1]; s1 = keep + __shfl_xor(send, 8); }
            s1 += __shfl_xor(s1, 4); s1 += __shfl_xor(s1, 2); s1 += __shfl_xor(s1, 1);
            if ((lane & 7) == 0) cb.DOT[(size_t)(tk0 + (lane >> 3)) * 6 + h] = s1; }
          float cl[8]; cl[0] = ld[0];
#pragma unroll
          for (int j = 1; j < 8; ++j) cl[j] = cl[j - 1] + ld[j];
          TOT[w * 64 + c] = cl[7];
          RW_BAR();
          float prefix = 0.f, cumC = 0.f;
#pragma unroll
          for (int ww = 0; ww < 8; ++ww) { const float tv = TOT[ww * 64 + c]; cumC += tv; if (ww < w) prefix += tv; }
          const float gcc = fexp(cumC); if (w == 0) GC[c] = gcc;
          unsigned ahp[4], btp[4], ktp[4], vp4[4]; float gprev = fexp(prefix), ah_e = 0.f, bt_e = 0.f, kt_e = 0.f;
#pragma unroll
          for (int j = 0; j < 8; ++j) { const int t = tq0 + j; const float g = fexp(prefix + cl[j]), ig = __builtin_amdgcn_rcpf(g), gc = gcc * ig;
              const float ah = -kkc[j] * gprev, rh = rr[j] * g, bh = bb[j] * ig, kh = kq[j] * ig, bt = bb[j] * gc, kt = kq[j] * gc; gprev = g;
              const unsigned w01 = pk2(ah, rh), w23 = pk2(bh, kh);
              B0[t * LD + c] = (bf16_t)(w01 & 0xffff); B1[t * LD + c] = (bf16_t)(w01 >> 16); B2[t * LD + c] = (bf16_t)(w23 & 0xffff); B3[t * LD + c] = (bf16_t)(w23 >> 16);
              if (j & 1) { ahp[j >> 1] = pk2(ah_e, ah); btp[j >> 1] = pk2(bt_e, bt); ktp[j >> 1] = pk2(kt_e, kt); vp4[j >> 1] = pk2(vv[j - 1], vv[j]); }
              else { ah_e = ah; bt_e = bt; kt_e = kt; } }
          *(LAS v4u*)(B4 + c * LD + tq0) = (v4u){ahp[0], ahp[1], ahp[2], ahp[3]}; *(LAS v4u*)(B5 + c * LD + tq0) = (v4u){btp[0], btp[1], btp[2], btp[3]};
          *(LAS v4u*)(B6 + c * LD + tq0) = (v4u){ktp[0], ktp[1], ktp[2], ktp[3]}; *(LAS v4u*)(B7 + c * LD + tq0) = (v4u){vp4[0], vp4[1], vp4[2], vp4[3]}; }
        RW_BAR();
        }
        for (int rp_ = 0; rp_ < ((PROF_PH) == 22 ? 2 : 1); ++rp_) {
        { RW_LANES(); const int prod = w >> 1; const LAS bf16_t* Aop = prod < 2 ? B0 : B1; const LAS bf16_t* Bop = (prod & 1) ? B3 : B2;
#pragma unroll
          for (int e = 0; e < 8; ++e) { const int tl = (w & 1) * 8 + e, ti = tl >> 2, tj = tl & 3; f32x4 d = {0.f, 0.f, 0.f, 0.f};
              if (tj <= ti) d = mm_tile(Aop, Bop, ti, tj, fr, fq, d);
#pragma unroll
              for (int r = 0; r < 4; ++r) { const int t = 16 * ti + 4 * fq + r, i = 16 * tj + fr; const bool keep = prod < 2 ? (i < t) : (i <= t); const float val = (tj <= ti && keep) ? d[r] : 0.f;
                  if (prod == 0) F0[t * 65 + i] = val; else if (prod == 1) B8[t * LD + i] = f2bf(val); else if (prod == 2) B9[t * LD + i] = f2bf(val); else B10[t * LD + i] = f2bf(val); } } }
        RW_BAR();
        }
        if (w == 0) { RW_LANES();
            const int blk = lane >> 4, jc = lane & 15; const LAS float* Lb = F0 + (16 * blk) * 65 + 16 * blk; float tc[16];
#pragma unroll
            for (int r = 0; r < 16; ++r) { float val = (r == jc) ? 1.f : 0.f;
#pragma unroll
                for (int i = 0; i < r; ++i) val += Lb[r * 65 + i] * tc[i];
                tc[r] = val; }
            asm volatile("s_waitcnt lgkmcnt(0)" ::: "memory");
#pragma unroll
            for (int r = 0; r < 16; ++r) F0[(16 * blk + r) * 65 + 16 * blk + jc] = tc[r];
        }
        RW_BAR();
        if (w < 2) { RW_LANES();
            const int o1 = 32 * w, o2 = 32 * w + 16; f32x4 d = {0.f, 0.f, 0.f, 0.f};
#pragma unroll
            for (int ks = 0; ks < 4; ++ks) d = __builtin_amdgcn_mfma_f32_16x16x4f32(F0[(o2 + fr) * 65 + o1 + 4 * ks + fq], F0[(o1 + 4 * ks + fq) * 65 + o1 + fr], d, 0, 0, 0);
            LAS float* tm = TMP + w * 16 * 17;
#pragma unroll
            for (int r = 0; r < 4; ++r) tm[(4 * fq + r) * 17 + fr] = d[r];
            asm volatile("s_waitcnt lgkmcnt(0)" ::: "memory");
            f32x4 d2 = {0.f, 0.f, 0.f, 0.f};
#pragma unroll
            for (int ks = 0; ks < 4; ++ks) d2 = __builtin_amdgcn_mfma_f32_16x16x4f32(F0[(o2 + fr) * 65 + o2 + 4 * ks + fq], tm[(4 * ks + fq) * 17 + fr], d2, 0, 0, 0);
            asm volatile("s_waitcnt lgkmcnt(0)" ::: "memory");
#pragma unroll
            for (int r = 0; r < 4; ++r) F0[(o2 + 4 * fq + r) * 65 + o1 + fr] = d2[r];
        }
        RW_BAR();
        if (w < 4) { RW_LANES();
            const int ti = w >> 1, tj = w & 1; f32x4 d = {0.f, 0.f, 0.f, 0.f};
#pragma unroll
            for (int ks = 0; ks < 8; ++ks) d = __builtin_amdgcn_mfma_f32_16x16x4f32(F0[(32 + 16 * ti + fr) * 65 + 4 * ks + fq], F0[(4 * ks + fq) * 65 + 16 * tj + fr], d, 0, 0, 0);
#pragma unroll
            for (int r = 0; r < 4; ++r) TMP[(16 * ti + 4 * fq + r) * 33 + 16 * tj + fr] = d[r];
        }
        RW_BAR();
        if (w < 4) { RW_LANES();
            const int ti = w >> 1, tj = w & 1; f32x4 d = {0.f, 0.f, 0.f, 0.f};
#pragma unroll
            for (int ks = 0; ks < 8; ++ks) d = __builtin_amdgcn_mfma_f32_16x16x4f32(F0[(32 + 16 * ti + fr) * 65 + 32 + 4 * ks + fq], TMP[(4 * ks + fq) * 33 + 16 * tj + fr], d, 0, 0, 0);
#pragma unroll
            for (int r = 0; r < 4; ++r) F0[(32 + 16 * ti + 4 * fq + r) * 65 + 16 * tj + fr] = d[r];
        }
        RW_BAR();
        { RW_LANES(); const int t = tid >> 3, i0 = (tid & 7) * 8;
#pragma unroll
          for (int e = 0; e < 8; ++e) B11[t * LD + i0 + e] = f2bf(F0[t * 65 + i0 + e]); }
        RW_BAR();
        { RW_LANES();
#pragma unroll
        for (int e = 0; e < 4; ++e) { const int tl = 4 * w + e, prod = tl >> 4, ti = (tl >> 2) & 3, tj = tl & 3; f32x4 d = {0.f, 0.f, 0.f, 0.f};
            d = prod == 0 ? mm_tile(B11, B4, ti, tj, fr, fq, d) : mm_tile(B8, B7, ti, tj, fr, fq, d);
            LAS bf16_t* dst = (prod == 0 ? B0 : B2) + (16 * tj + fr) * LD + 16 * ti + 4 * fq;
            *(LAS unsigned long long*)dst = (unsigned long long)pk2(d[0], d[1]) | ((unsigned long long)pk2(d[2], d[3]) << 32); } }
        RW_BAR();
        { RW_LANES();
#pragma unroll
        for (int e = 0; e < 2; ++e) { const int tl = 2 * w + e, ti = tl >> 2, tj = tl & 3; f32x4 d = {0.f, 0.f, 0.f, 0.f};
            d = mm_tile(B11, B2, ti, tj, fr, fq, d);
            LAS bf16_t* dst = B3 + (16 * tj + fr) * LD + 16 * ti + 4 * fq;
            *(LAS unsigned long long*)dst = (unsigned long long)pk2(d[0], d[1]) | ((unsigned long long)pk2(d[2], d[3]) << 32); } }
        RW_BAR();
        for (int rp_ = 0; rp_ < ((PROF_PH) == 23 ? 2 : 1); ++rp_) {
        { RW_LANES();
#pragma unroll
        for (int e = 0; e < 8; ++e) { const int tl = 8 * w + e, prod = tl >> 4, ti = (tl >> 2) & 3, tj = tl & 3; f32x4 d = {0.f, 0.f, 0.f, 0.f};
            if (prod == 0) { d = mm_tile(B5, B3, ti, tj, fr, fq, d); d = mm_tile(B6, B7, ti, tj, fr, fq, d);
                *(GAS f32x4*)(cb.Z + (size_t)item * 4096 + (16 * tj + fr) * 64 + 4 * ((4 * ti + fq) ^ fr)) = d; }
            else if (prod == 1) { d = mm_tile(B9, B3, ti, tj, fr, fq, d); d = mm_tile(B10, B7, ti, tj, fr, fq, d);
                *(GAS f32x4*)(cb.YV + (size_t)item * 4096 + (16 * tj + fr) * 64 + 16 * ti + 4 * fq) = d; }
            else if (prod == 2) { d = mm_tile(B9, B0, ti, tj, fr, fq, d);
#pragma unroll
                for (int r = 0; r < 4; ++r) { const int t = 16 * ti + 4 * fq + r, c = 16 * tj + fr; B4[t * LD + sigpos(c)] = f2bf(d[r] + bf2f(B1[t * LD + c])); } }
            else { d = mm_tile(B5, B0, ti, tj, fr, fq, d);
#pragma unroll
                for (int r = 0; r < 4; ++r) { const int c = 16 * ti + 4 * fq + r, c2 = 16 * tj + fr; B8[c * LD + sigpos(c2)] = f2bf(d[r] + (c == c2 ? GC[c] : 0.f)); } } } }
        RW_BAR();
        }
        { RW_LANES(); const int r = tid >> 3, ch = (tid & 7) * 8;
          *(GAS v4u*)(cb.G + (size_t)item * 4096 + r * 64 + ch) = *(const LAS v4u*)(B4 + r * LD + ch);
          *(GAS v4u*)(cb.PT + (size_t)item * 4096 + r * 64 + 8 * ((tid & 7) ^ (r & 7))) = *(const LAS v4u*)(B8 + r * LD + ch); }
        RW_BAR();
    }
}
constexpr int SC_NS = 10, SC_SLOT = 12288, SC_LAG = 6;
__device__ __forceinline__ void scan_compute(LAS unsigned char* L, const ChunkBufs cb, int bh, int tj, int lane, volatile LAS unsigned* flags) {
    const int fr = lane & 15, fq = lane >> 4; const int NC = SEQ / 64;
    bf16x8 Bf0 = {0, 0, 0, 0, 0, 0, 0, 0}, Bf1 = {0, 0, 0, 0, 0, 0, 0, 0};
    bf16_t* s0 = cb.S0 + (size_t)(bh * NC) * 4096 + (16 * tj + fr) * 64 + 8 * fq;
    const int po0 = fr * 128 + 16 * ((fq) ^ (fr & 7)), po1 = fr * 128 + 16 * ((4 + fq) ^ (fr & 7));
    int slot = 0;
    for (int chunk = 0; chunk < NC; ++chunk) {
        unsigned spins = 0;
        while (true) { const unsigned a = flags[0], b = flags[1], c = flags[2]; const unsigned m = a < b ? (a < c ? a : c) : (b < c ? b : c); if ((int)m >= chunk + 1 || ++spins > (1u << 22)) break; __builtin_amdgcn_s_sleep(1); }
        const LAS unsigned char* sp = L + slot * SC_SLOT;
        bf16x8 a0[4], a1[4]; f32x4 z[4];
#pragma unroll
        for (int ti = 0; ti < 4; ++ti) { a0[ti] = *(const LAS bf16x8*)(sp + ti * 2048 + po0); a1[ti] = *(const LAS bf16x8*)(sp + ti * 2048 + po1); z[ti] = *(const LAS f32x4*)(sp + 8192 + fr * 256 + 16 * ((4 * ti + fq) ^ fr)); }
        asm volatile("s_waitcnt lgkmcnt(0)" ::: "memory");
        if (lane == 0) flags[3] = (unsigned)(chunk + 1);
        *(GAS bf16x8*)(s0 + (size_t)chunk * 4096) = Bf0; *(GAS bf16x8*)(s0 + (size_t)chunk * 4096 + 32) = Bf1;
        f32x4 acc[4];
#pragma unroll
        for (int ti = 0; ti < 4; ++ti) { acc[ti] = __builtin_amdgcn_mfma_f32_16x16x32_bf16(a0[ti], Bf0, z[ti], 0, 0, 0); acc[ti] = __builtin_amdgcn_mfma_f32_16x16x32_bf16(a1[ti], Bf1, acc[ti], 0, 0, 0); }
        v4u m0, m1;
        m0.x = pk2(acc[0][0], acc[0][1]); m0.y = pk2(acc[0][2], acc[0][3]); m0.z = pk2(acc[1][0], acc[1][1]); m0.w = pk2(acc[1][2], acc[1][3]);
        m1.x = pk2(acc[2][0], acc[2][1]); m1.y = pk2(acc[2][2], acc[2][3]); m1.z = pk2(acc[3][0], acc[3][1]); m1.w = pk2(acc[3][2], acc[3][3]);
        Bf0 = __builtin_bit_cast(bf16x8, m0); Bf1 = __builtin_bit_cast(bf16x8, m1);
        slot = slot + 1 == SC_NS ? 0 : slot + 1;
    }
}
__device__ __forceinline__ void scan_loader(LAS unsigned char* L, const ChunkBufs cb, int bh, int tj, int lw, int lane, volatile LAS unsigned* flags) {
    const int NC = SEQ / 64;
    const char* src[4];
#pragma unroll
    for (int k = 0; k < 4; ++k) { const int pc = 4 * lw + k;
        src[k] = pc < 8 ? (const char*)(cb.PT + (size_t)(bh * NC) * 4096) + pc * 1024 + lane * 16 : (const char*)(cb.Z + (size_t)(bh * NC) * 4096) + tj * 4096 + (pc - 8) * 1024 + lane * 16; }
    const size_t st0 = 8192, st1 = 16384;
    int slot = 0;
    for (int c = 0; c < NC; ++c) {
        unsigned spins = 0;
        while ((int)flags[3] < c - SC_NS + 1 && ++spins < (1u << 22)) __builtin_amdgcn_s_sleep(1);
        const unsigned dst = (unsigned)(slot * SC_SLOT + 4 * lw * 1024);
#pragma unroll
        for (int k = 0; k < 4; ++k) { const int pc = 4 * lw + k;
            __builtin_amdgcn_global_load_lds((const unsigned*)(src[k] + (size_t)c * (pc < 8 ? st0 : st1)), (LAS unsigned*)(L + dst + k * 1024), 16, 0, 0); }
        if (c >= SC_LAG) { asm volatile("s_waitcnt vmcnt(24)" ::: "memory"); if (lane == 0) flags[lw] = (unsigned)(c - SC_LAG + 1); }
        slot = slot + 1 == SC_NS ? 0 : slot + 1;
    }
    asm volatile("s_waitcnt vmcnt(0)" ::: "memory");
    if (lane == 0) flags[lw] = (unsigned)NC;
}
constexpr int O_SG = 0  , O_Y = 9216  , O_GT = O_Y + 16640  ;
__device__ __forceinline__ void out_phase(LAS unsigned char* L, const bf16_t* P, const sk::RwkvW W, const ChunkBufs cb, bf16_t* MIX, int tid_in, int first, int stride) {
    const int w = __builtin_amdgcn_readfirstlane(tid_in >> 6);
    LAS bf16_t* SG = (LAS bf16_t*)(L + O_SG); LAS float* Y = (LAS float*)(L + O_Y); LAS float* GT = (LAS float*)(L + O_GT);
    for (int item = first; item < NITEMS; item += stride) {
        const int bh = item / (SEQ / 64), chunk = item % (SEQ / 64), b = bh / 6, h = bh % 6; const int tok0 = b * SEQ + chunk * 64; const size_t ib = (size_t)item * 4096;
        { RW_LANES(); const int t = tid >> 3, sub = tid & 7, tok = tok0 + t; const bool hp = (chunk * 64 + t) > 0;
          const bf16_t* rc = P + (size_t)tok * LDP + 1856 + 8 * sub; const v4u z4 = {0u, 0u, 0u, 0u};
          const v4u gc4 = *(const GAS v4u*)rc, gp4 = hp ? *(const GAS v4u*)(rc - LDP) : z4;
          const f32x4 m0 = *(const GAS f32x4*)(W.mu + 1216 + 8 * sub), m1 = *(const GAS f32x4*)(W.mu + 1220 + 8 * sub);
          const unsigned cw_[4] = {gc4.x, gc4.y, gc4.z, gc4.w}, pw_[4] = {gp4.x, gp4.y, gp4.z, gp4.w}; unsigned o[4];
#pragma unroll
          for (int e2 = 0; e2 < 4; ++e2) { float x[2];
#pragma unroll
              for (int u = 0; u < 2; ++u) { const int e = 2 * e2 + u; const float c1 = bf2f((bf16_t)((cw_[e2] >> (16 * u)) & 0xffff)), p1 = bf2f((bf16_t)((pw_[e2] >> (16 * u)) & 0xffff));
                  x[u] = fsigm(c1 + (e < 4 ? m0[e & 3] : m1[e & 3]) * (p1 - c1)); }
              o[e2] = pk2(x[0], x[1]); }
          *(LAS v4u*)(SG + t * LD + 8 * sub) = (v4u){o[0], o[1], o[2], o[3]}; }
        RW_BAR();
        { RW_LANES();
#pragma unroll
        for (int e = 0; e < 2; ++e) { const int tl = 2 * w + e, ti = tl >> 2, tj = tl & 3;
            f32x4 d = *(const GAS f32x4*)(cb.YV + ib + (16 * tj + fr) * 64 + 16 * ti + 4 * fq); f32x4 g = {0.f, 0.f, 0.f, 0.f};
#pragma unroll
            for (int kk = 0; kk < 2; ++kk) {
                const bf16x8 a = *(const GAS bf16x8*)(cb.G + ib + (16 * ti + fr) * 64 + 32 * kk + 8 * fq), bb = *(const GAS bf16x8*)(cb.S0 + ib + (16 * tj + fr) * 64 + 32 * kk + 8 * fq);
                d = __builtin_amdgcn_mfma_f32_16x16x32_bf16(a, bb, d, 0, 0, 0);
                const bf16x8 a2 = *(const LAS bf16x8*)(SG + (16 * ti + fr) * LD + 32 * kk + 8 * fq), b2 = *(const GAS bf16x8*)(cb.G2T + (size_t)(64 * h + 16 * tj + fr) * 64 + 32 * kk + 8 * fq);
                g = __builtin_amdgcn_mfma_f32_16x16x32_bf16(a2, b2, g, 0, 0, 0); }
#pragma unroll
            for (int r = 0; r < 4; ++r) { Y[(16 * ti + 4 * fq + r) * 65 + 16 * tj + fr] = d[r]; GT[(16 * ti + 4 * fq + r) * 65 + 16 * tj + fr] = g[r]; } } }
        RW_BAR();
        { RW_LANES(); const int t = tid >> 3, sub = tid & 7, tok = tok0 + t; float yv[8], s = 0.f;
#pragma unroll
          for (int e = 0; e < 8; ++e) { yv[e] = bf2f(f2bf(Y[t * 65 + 8 * sub + e])); s += yv[e]; }
          s += __shfl_xor(s, 1); s += __shfl_xor(s, 2); s += __shfl_xor(s, 4);
          const float mean = s * (1.0f / 64.0f); float q = 0.f;
#pragma unroll
          for (int e = 0; e < 8; ++e) { const float dd = yv[e] - mean; q += dd * dd; }
          q += __shfl_xor(q, 1); q += __shfl_xor(q, 2); q += __shfl_xor(q, 4);
          const float rstd = 1.0f / sqrtf(q * (1.0f / 64.0f) + GN_EPS), dot = cb.DOT[(size_t)tok * 6 + h];
          unsigned o[4];
#pragma unroll
          for (int e = 0; e < 8; e += 2) { float r2[2];
#pragma unroll
              for (int u = 0; u < 2; ++u) { const int v = 8 * sub + e + u, hc = 64 * h + v; const float yn = (yv[e + u] - mean) * rstd * W.ln_w[hc] + W.ln_b[hc];
                  r2[u] = (yn + dot * bf2f(cb.VOUT[(size_t)tok * 384 + hc])) * GT[t * 65 + v]; }
              o[e >> 1] = pk2(r2[0], r2[1]); }
          *(GAS v4u*)(MIX + (size_t)tok * DM + 384 + 64 * h + 8 * sub) = (v4u){o[0], o[1], o[2], o[3]}; }
        RW_BAR();
    }
}
}
namespace at {
constexpr int LDK = 72, LDV = 264;
constexpr int A_K = 0, A_V = 256 * LDK * 2  , A_BIAS = A_V + 64 * LDV * 2  , A_END = A_BIAS + 128 * 6 * 4;
__device__ __forceinline__ int vpos(int key) { return (key & ~31) + 8 * ((key >> 2) & 3) + 4 * ((key >> 4) & 1) + (key & 3); }
__device__ __forceinline__ unsigned pk2(float lo, float hi) { typedef float f2_t __attribute__((ext_vector_type(2))); typedef __bf16 b2_t __attribute__((ext_vector_type(2))); f2_t v = {lo, hi}; return __builtin_bit_cast(unsigned, __builtin_convertvector(v, b2_t)); }
#define AT_BAR() do { asm volatile("s_waitcnt vmcnt(0) lgkmcnt(0)" ::: "memory"); __builtin_amdgcn_s_barrier(); asm volatile("" ::: "memory"); } while (0)

__device__ __forceinline__ void stage_kv(LAS unsigned char* L, int tid, const bf16_t* kbase, const bf16_t* vbase, long pitch, int jvalid0, const float* gk) {
    LAS bf16_t* Kl = (LAS bf16_t*)(L + A_K); LAS bf16_t* VTl = (LAS bf16_t*)(L + A_V);
#pragma unroll
    for (int it = 0; it < 4; ++it) { const int idx = it * 512 + tid, key = idx >> 3, ch = idx & 7;
        v4u raw = {0u, 0u, 0u, 0u}; if (key >= jvalid0) raw = *(const GAS v4u*)(kbase + (long)key * pitch + 8 * ch);
        float f[8]; f[0] = bf2f((bf16_t)(raw.x & 0xffff)); f[1] = bf2f((bf16_t)(raw.x >> 16)); f[2] = bf2f((bf16_t)(raw.y & 0xffff)); f[3] = bf2f((bf16_t)(raw.y >> 16));
        f[4] = bf2f((bf16_t)(raw.z & 0xffff)); f[5] = bf2f((bf16_t)(raw.z >> 16)); f[6] = bf2f((bf16_t)(raw.w & 0xffff)); f[7] = bf2f((bf16_t)(raw.w >> 16));
        float ss = 0.f;
#pragma unroll
        for (int e = 0; e < 8; ++e) ss += f[e] * f[e];
        ss += __shfl_xor(ss, 1); ss += __shfl_xor(ss, 2); ss += __shfl_xor(ss, 4);
        const float rs = 1.0f / sqrtf(ss * (1.0f / 64.0f) + EPS);
        const f32x4 g0 = *(const GAS f32x4*)(gk + 8 * ch), g1 = *(const GAS f32x4*)(gk + 8 * ch + 4);
        v4u o; o.x = pk2(f[0] * rs * g0[0], f[1] * rs * g0[1]); o.y = pk2(f[2] * rs * g0[2], f[3] * rs * g0[3]); o.z = pk2(f[4] * rs * g1[0], f[5] * rs * g1[1]); o.w = pk2(f[6] * rs * g1[2], f[7] * rs * g1[3]);
        *(LAS v4u*)(Kl + key * LDK + 8 * ch) = o; }
#pragma unroll
    for (int it = 0; it < 4; ++it) { const int idx = it * 512 + tid, key = idx & 255, ch = idx >> 8;
        v4u raw = {0u, 0u, 0u, 0u}; if (key >= jvalid0) raw = *(const GAS v4u*)(vbase + (long)key * pitch + 8 * ch);
        LAS bf16_t* d = VTl + (8 * ch) * LDV + vpos(key);
        d[0 * LDV] = (bf16_t)(raw.x & 0xffff); d[1 * LDV] = (bf16_t)(raw.x >> 16); d[2 * LDV] = (bf16_t)(raw.y & 0xffff); d[3 * LDV] = (bf16_t)(raw.y >> 16);
        d[4 * LDV] = (bf16_t)(raw.z & 0xffff); d[5 * LDV] = (bf16_t)(raw.z >> 16); d[6 * LDV] = (bf16_t)(raw.w & 0xffff); d[7 * LDV] = (bf16_t)(raw.w >> 16); }
}
__device__ __forceinline__ void load_q(const bf16_t* qrow, const float* gq, int fq, bf16x8& q0, bf16x8& q1) {
    const v4u r0 = *(const GAS v4u*)(qrow + 8 * fq), r1 = *(const GAS v4u*)(qrow + 32 + 8 * fq);
    float f[16]; const unsigned w[8] = {r0.x, r0.y, r0.z, r0.w, r1.x, r1.y, r1.z, r1.w};
#pragma unroll
    for (int e = 0; e < 8; ++e) { f[2 * e] = bf2f((bf16_t)(w[e] & 0xffff)); f[2 * e + 1] = bf2f((bf16_t)(w[e] >> 16)); }
    float ss = 0.f;
#pragma unroll
    for (int e = 0; e < 16; ++e) ss += f[e] * f[e];
    ss += __shfl_xor(ss, 16); ss += __shfl_xor(ss, 32);
    const float rs = 0.125f / sqrtf(ss * (1.0f / 64.0f) + EPS);
    const f32x4 g0 = *(const GAS f32x4*)(gq + 8 * fq), g1 = *(const GAS f32x4*)(gq + 8 * fq + 4), g2 = *(const GAS f32x4*)(gq + 32 + 8 * fq), g3 = *(const GAS f32x4*)(gq + 36 + 8 * fq);
    v4u a, b;
    a.x = pk2(f[0] * rs * g0[0], f[1] * rs * g0[1]); a.y = pk2(f[2] * rs * g0[2], f[3] * rs * g0[3]); a.z = pk2(f[4] * rs * g1[0], f[5] * rs * g1[1]); a.w = pk2(f[6] * rs * g1[2], f[7] * rs * g1[3]);
    b.x = pk2(f[8] * rs * g2[0], f[9] * rs * g2[1]); b.y = pk2(f[10] * rs * g2[2], f[11] * rs * g2[3]); b.z = pk2(f[12] * rs * g3[0], f[13] * rs * g3[1]); b.w = pk2(f[14] * rs * g3[2], f[15] * rs * g3[3]);
    q0 = __builtin_bit_cast(bf16x8, a); q1 = __builtin_bit_cast(bf16x8, b);
}
template <int NT, bool SWA> __device__ __forceinline__ void attn_wave(const LAS unsigned char* L, bf16x8 q0, bf16x8 q1, int kt0, int qi0, int hq, float sink, bool first_block, bf16_t* outp, int fr, int fq) {
    const LAS bf16_t* Kl = (const LAS bf16_t*)(L + A_K); const LAS bf16_t* VTl = (const LAS bf16_t*)(L + A_V); const LAS float* bias = (const LAS float*)(L + A_BIAS);
    f32x4 s[NT];
#pragma unroll
    for (int t = 0; t < NT; ++t) { const LAS bf16_t* kr = Kl + (16 * (kt0 + t) + fr) * LDK + 8 * fq;
        const f32x4 z = {0.f, 0.f, 0.f, 0.f};
        s[t] = __builtin_amdgcn_mfma_f32_16x16x32_bf16(*(const LAS bf16x8*)kr, q0, z, 0, 0, 0);
        s[t] = __builtin_amdgcn_mfma_f32_16x16x32_bf16(*(const LAS bf16x8*)(kr + 32), q1, s[t], 0, 0, 0);
        if (t & 1) __builtin_amdgcn_sched_barrier(0); }
    float mx = SWA ? sink : -3.0e38f;
#pragma unroll
    for (int t = 0; t < NT; ++t)
#pragma unroll
        for (int r = 0; r < 4; ++r) {
            if (SWA) { const int kj = 16 * (kt0 + t) + 4 * fq + r, dist = qi0 + fr + 128 - kj; const bool valid = dist >= 0 && dist < 128 && !(first_block && kj < 128);
                s[t][r] = valid ? s[t][r] + bias[(valid ? dist : 0) * 6 + hq] : -3.0e38f; }
            mx = fmaxf(mx, s[t][r]); }
    mx = fmaxf(mx, __shfl_xor(mx, 16)); mx = fmaxf(mx, __shfl_xor(mx, 32));
    float l = 0.f;
#pragma unroll
    for (int t = 0; t < NT; ++t)
#pragma unroll
        for (int r = 0; r < 4; ++r) { const float p = __expf(s[t][r] - mx); s[t][r] = p; l += p; }
    l += __shfl_xor(l, 16); l += __shfl_xor(l, 32);
    if (SWA) l += __expf(sink - mx);
    f32x4 o[4];
#pragma unroll
    for (int dt = 0; dt < 4; ++dt) o[dt] = (f32x4){0.f, 0.f, 0.f, 0.f};
#pragma unroll
    for (int ks = 0; ks < NT / 2; ++ks) { v4u pw; pw.x = pk2(s[2 * ks][0], s[2 * ks][1]); pw.y = pk2(s[2 * ks][2], s[2 * ks][3]); pw.z = pk2(s[2 * ks + 1][0], s[2 * ks + 1][1]); pw.w = pk2(s[2 * ks + 1][2], s[2 * ks + 1][3]);
        const bf16x8 pb = __builtin_bit_cast(bf16x8, pw);
#pragma unroll
        for (int dt = 0; dt < 4; ++dt) o[dt] = __builtin_amdgcn_mfma_f32_16x16x32_bf16(*(const LAS bf16x8*)(VTl + (16 * dt + fr) * LDV + 32 * (kt0 / 2 + ks) + 8 * fq), pb, o[dt], 0, 0, 0);
        __builtin_amdgcn_sched_barrier(0); }
    const float inv = 1.0f / l;
#pragma unroll
    for (int dt = 0; dt < 4; ++dt) *(GAS unsigned long long*)(outp + (long)fr * DM + 16 * dt + 4 * fq) = (unsigned long long)pk2(o[dt][0] * inv, o[dt][1] * inv) | ((unsigned long long)pk2(o[dt][2] * inv, o[dt][3] * inv) << 32);
}
struct AttnArgs { const bf16_t* PROJ; const bf16_t* MKV; bf16_t* MIX; const float* biastab; const float *sinks, *gq, *gk, *gmq, *gmk; };
__device__ __forceinline__ void attn_item(LAS unsigned char* L, const AttnArgs A, int item, int tid_in) {
    const int w = __builtin_amdgcn_readfirstlane(tid_in >> 6);
    if (item < 256) {
        const int b = item >> 7, hkv = (item >> 6) & 1, blk = item & 63; const long tokb = (long)b * SEQ + blk * 128;
        { int lt_ = tid_in; asm volatile("" : "+v"(lt_)); const int tid = lt_;
          stage_kv(L, tid, A.PROJ + (tokb - 128) * LDP + 384 + 64 * hkv, A.PROJ + (tokb - 128) * LDP + 512 + 64 * hkv, LDP, blk == 0 ? 128 : 0, A.gk);
          LAS float* bl = (LAS float*)(L + A_BIAS); for (int i = tid; i < 768; i += 512) bl[i] = A.biastab[i]; }
        AT_BAR();
        { int lt_ = tid_in; asm volatile("" : "+v"(lt_)); const int lane = lt_ & 63, fr = lane & 15, fq = lane >> 4;
#pragma unroll 1
          for (int g = 0; g < 3; ++g) { const int hq = 3 * hkv + g; bf16x8 q0, q1;
              load_q(A.PROJ + (tokb + 16 * w + fr) * LDP + 64 * hq, A.gq, fq, q0, q1);
              attn_wave<10, true>(L, q0, q1, w & ~1, 16 * w, hq, A.sinks[hq], blk == 0, A.MIX + (tokb + 16 * w) * DM + 64 * hq, fr, fq); } }
        AT_BAR();
    } else {
        const int pr = item - 256, b = pr >> 7, h = (pr >> 5) & 3, blk2 = pr & 31;
        { int lt_ = tid_in; asm volatile("" : "+v"(lt_)); const int tid = lt_;
          stage_kv(L, tid, A.MKV + (long)(b * 256) * 512 + 64 * h, A.MKV + (long)(b * 256) * 512 + 256 + 64 * h, 512, 0, A.gmk); }
        AT_BAR();
        { int lt_ = tid_in; asm volatile("" : "+v"(lt_)); const int lane = lt_ & 63, fr = lane & 15, fq = lane >> 4;
#pragma unroll 1
          for (int u = 0; u < 2; ++u) { const long tokb = (long)b * SEQ + (2 * blk2 + u) * 128; bf16x8 q0, q1;
              load_q(A.PROJ + (tokb + 16 * w + fr) * LDP + 1920 + 64 * h, A.gmq, fq, q0, q1);
              attn_wave<16, false>(L, q0, q1, 0, 16 * w, 0, 0.f, false, A.MIX + (tokb + 16 * w) * DM + 768 + 64 * h, fr, fq); } }
        AT_BAR();
    }
}
}
constexpr int NWAVES = 8;
namespace mk {
constexpr size_t WS_CTL = 0, CTL_ZERO_BYTES = 1 * MiB;
constexpr size_t CTL_SSQ = 512 * 1024;
constexpr size_t WS_SMALL = 1 * MiB, SM_BIAS = 0, SM_SSQM = 4096, SM_MKV = 512 * 1024;
constexpr size_t WS_MEMB = 2 * MiB, WS_WT = 3 * MiB, WS_XB = 28 * MiB, WS_VF = 60 * MiB, WS_PROJ = 72 * MiB, WS_MIX = 144 * MiB, WS_PREP = 176 * MiB, WS_U = 72 * MiB, WS_ACT = 160 * MiB, WS_WIN1 = 248 * MiB  , WS_END = 254 * MiB;
constexpr size_t WT_IN = 0, WT_OUT = 4718592, WT_UP = WT_OUT + 2 * MiB, WT_DOWN = WT_UP + 11 * MiB, WT_MKV = WT_DOWN + 5767168;
constexpr int CW_TMO = 0, CW_BAR = 4096;
constexpr int LDS_BYTES = 163840, LDSCTL_OFF = LDS_BYTES - 512, MISC_OFF = LDSCTL_OFF + 320;
constexpr size_t SM_W2T = 8192, SM_A2T = 32768, SM_V2T = 57344, SM_G2T = 81920, SM_LORA_L = 122880;
constexpr size_t WS_PT = 176 * MiB, WS_G = 188 * MiB, WS_S0 = 200 * MiB, WS_Z = 212 * MiB, WS_V1 = 236 * MiB, WS_YV = 28 * MiB  , WS_DOT = 52 * MiB;
#ifndef PROF_PH
#define PROF_PH -1
#endif
#ifndef PROF_N
#define PROF_N 1
#endif
#ifndef PROF_TA
#define PROF_TA -1
#endif
#ifndef PROF_TB
#define PROF_TB -1
#endif
#define REPEAT(k) for (int rep_ = 0; rep_ < ((PROF_PH) == (k) ? (PROF_N) : 1); ++rep_)
#ifndef FAST_RWKV
#define FAST_RWKV 1
#endif
#ifndef FAST_ATTN
#define FAST_ATTN 1
#endif

struct Args { const float* in[N_IN]; float* out; unsigned char* ws; int ph_lo, ph_hi; };

__device__ __forceinline__ unsigned pk2(float lo, float hi) { typedef float f2_t __attribute__((ext_vector_type(2))); typedef __bf16 b2_t __attribute__((ext_vector_type(2))); f2_t v = {lo, hi}; return __builtin_bit_cast(unsigned, __builtin_convertvector(v, b2_t)); }
__device__ __forceinline__ float wave_sum(float v) {
#pragma unroll
    for (int o = 1; o < 64; o <<= 1) v += __shfl_xor(v, o);
    return v;
}
template <bool UPPERM> __device__ __forceinline__ void transpose_item(const float* W, const float* g, int K, int N, bf16_t* WT, LAS float* scr, int item, int lane) {
    const int nblk = N / 32, kb = item / nblk, nb = item % nblk, k0 = 64 * kb, n0 = 32 * nb;
    float tv[32];
#pragma unroll
    for (int i = 0; i < 32; ++i) tv[i] = W[(size_t)(k0 + 2 * i + (lane >> 5)) * N + n0 + (lane & 31)];
#pragma unroll
    for (int i = 0; i < 32; ++i) { const int kk = 2 * i + (lane >> 5); float v = tv[i]; if (g) v *= g[k0 + kk]; scr[kk * 33 + (lane & 31)] = v; }
    LDS_WAIT(); asm volatile("" ::: "memory");
    const int c = lane & 7;
#pragma unroll
    for (int j = 0; j < 4; ++j) { const int n = (lane >> 3) + 8 * j; const LAS float* s = scr + (8 * c) * 33 + n;
        v4u o; o.x = pk2(s[0 * 33], s[1 * 33]); o.y = pk2(s[2 * 33], s[3 * 33]); o.z = pk2(s[4 * 33], s[5 * 33]); o.w = pk2(s[6 * 33], s[7 * 33]);
        int nr = n0 + n; if (UPPERM) nr = nr < 2816 ? 256 * (nr >> 7) + (nr & 127) : 256 * ((nr - 2816) >> 7) + 128 + ((nr - 2816) & 127);
        *(GAS v4u*)(WT + (size_t)nr * K + k0 + 8 * c) = o; }
    LDS_WAIT(); asm volatile("" ::: "memory");
}
__device__ __forceinline__ void row_to_bf16(const float* xrow, bf16_t* orow, float* ssq_out, int lane) {
    const GAS f32x4* xr = (const GAS f32x4*)xrow + lane; f32x4 v[4]; float s = 0.f;
#pragma unroll
    for (int j = 0; j < 4; ++j) { v[j] = xr[64 * j]; s += (v[j].x * v[j].x + v[j].y * v[j].y) + (v[j].z * v[j].z + v[j].w * v[j].w); }
    s = wave_sum(s);
    GAS unsigned long long* o8 = (GAS unsigned long long*)orow + lane;
#pragma unroll
    for (int j = 0; j < 4; ++j) o8[64 * j] = (unsigned long long)pk2(v[j].x, v[j].y) | ((unsigned long long)pk2(v[j].z, v[j].w) << 32);
    if (lane == 0) *ssq_out = s;
}

__global__ void __launch_bounds__(NWAVES * 64, 2) mk_fwd(Args args) {
    extern __shared__ __attribute__((aligned(16))) unsigned char lds[];
    LAS unsigned char* L = (LAS unsigned char*)lds;
    volatile LAS unsigned* MISC = (volatile LAS unsigned*)(L + MISC_OFF);
    const int tid0 = threadIdx.x; const int wave0 = __builtin_amdgcn_readfirstlane(tid0 >> 6);
    const int G = gridDim.x;
    unsigned char* ws = args.ws;
    gu32* ctl = (gu32*)(ws + WS_CTL);
    for (int u = tid0; u < (LDS_BYTES - LDSCTL_OFF) / 4; u += NWAVES * 64) ((LAS unsigned*)(L + LDSCTL_OFF))[u] = 0u;
    __syncthreads();
    XcdBarrier bar = xcd_barrier_post((unsigned*)(ctl + CW_BAR), MISC + 8);
    const int lo = args.ph_lo, hi = args.ph_hi;
    int ph = 0;
#define PH_BEGIN if (lo <= ph && ph < hi) { if ((PROF_TA) >= 0 && blockIdx.x == 0 && tid0 == 0) MISC[24 + ph] = (unsigned)__builtin_amdgcn_s_memrealtime(); unsigned char* wsp = args.ws; asm volatile("" : "+s"(wsp)); int tid = wave0 * 64 + (int)__builtin_amdgcn_mbcnt_hi(~0u, __builtin_amdgcn_mbcnt_lo(~0u, 0u)); asm volatile("" : "+v"(tid)); const int lane = tid & 63, wave = __builtin_amdgcn_readfirstlane(tid >> 6); const long gtid = (long)blockIdx.x * (NWAVES * 64) + tid; const int gw = blockIdx.x * NWAVES + wave; LAS float* scr = (LAS float*)(L + wave * 16384); (void)lane; (void)gtid; (void)gw; (void)scr;
#define PH_END   if (ph + 1 < hi) { xcd_barrier(bar); if ((PROF_PH) == 30 && ph == 3) for (int xb_ = 0; xb_ < 10; ++xb_) xcd_barrier(bar); } } ++ph;
    float* out = args.out;
#define SSQ_A ((float*)(wsp + WS_CTL + CTL_SSQ))
#define SSQ_B (SSQ_A + 3 * MTOK)
#define biastab ((float*)(wsp + WS_SMALL + SM_BIAS))
#define ssqm ((float*)(wsp + WS_SMALL + SM_SSQM))
#define MKV ((bf16_t*)(wsp + WS_SMALL + SM_MKV))
#define MEMB ((bf16_t*)(wsp + WS_MEMB))
#define Wt_in ((bf16_t*)(wsp + (l == 0 ? WS_WT + WT_IN : WS_WIN1)))
#define Wt_out ((bf16_t*)(wsp + WS_WT + WT_OUT))
#define Wt_up ((bf16_t*)(wsp + WS_WT + WT_UP))
#define Wt_down ((bf16_t*)(wsp + WS_WT + WT_DOWN))
#define Wt_mkv ((bf16_t*)(wsp + (l == 0 ? WS_WT + WT_MKV : WS_WIN1 + 4718592)))
#define XB ((bf16_t*)(wsp + WS_XB))
#define VF ((bf16_t*)(wsp + WS_VF))
#define PROJ ((bf16_t*)(wsp + WS_PROJ))
#define MIX ((bf16_t*)(wsp + WS_MIX))
#define U ((bf16_t*)(wsp + WS_U))
#define ACT ((bf16_t*)(wsp + WS_ACT))
#define PA ((size_t)MTOK * 384)
#define pR ((bf16_t*)(wsp + WS_PREP))
#define pK (pR + PA)
#define pV (pR + 2 * PA)
#define pKK (pR + 3 * PA)
#define pB (pR + 4 * PA)
#define pLD (pR + 5 * PA)
    const long gsize = (long)G * (NWAVES * 64);
    const int NGW = G * NWAVES;

#define MK_W() sk::RwkvW W{args.in[I_MU] + l * 1280, args.in[I_MUV], args.in[I_W0] + l * 384, args.in[I_W2] + l * 32 * 384, args.in[I_A0] + l * 384, args.in[I_A2] + l * 32 * 384, args.in[I_V0], args.in[I_V2], args.in[I_G2] + l * 64 * 384, args.in[I_KK] + l * 384, args.in[I_KA] + l * 384, args.in[I_RK] + l * 384, args.in[I_LNW] + l * 384, args.in[I_LNB] + l * 384};
#define MK_CBUF() const rw::ChunkBufs cbuf{(bf16_t*)(wsp + WS_PT), (bf16_t*)(wsp + WS_G), (float*)(wsp + WS_Z), (float*)(wsp + WS_YV), (bf16_t*)(wsp + WS_S0), (bf16_t*)(wsp + (l == 0 ? WS_VF : WS_V1)), (float*)(wsp + WS_DOT), (const bf16_t*)(wsp + WS_SMALL + SM_W2T + l * SM_LORA_L), (const bf16_t*)(wsp + WS_SMALL + SM_A2T + l * SM_LORA_L), (const bf16_t*)(wsp + WS_SMALL + SM_V2T + l * SM_LORA_L), (const bf16_t*)(wsp + WS_SMALL + SM_G2T + l * SM_LORA_L)};
    for (int l = 0; l < 2; ++l) {
        const float* xin = l == 0 ? args.in[I_X] : out;
        if (l == 0) {
        PH_BEGIN
            REPEAT(0) {
            const int I_IN = 16 * 68, I_KV = 16 * 16, NIT = 2 * (I_IN + I_KV);
            for (int it = gw; it < NIT; it += NGW) {
                int r = it; const int ll = r >= I_IN + I_KV ? 1 : 0; r -= ll * (I_IN + I_KV);
                bf16_t* win = (bf16_t*)(wsp + (ll == 0 ? WS_WT + WT_IN : WS_WIN1)); bf16_t* wkv = (bf16_t*)(wsp + (ll == 0 ? WS_WT + WT_MKV : WS_WIN1 + 4718592));
                if (r < I_IN) transpose_item<false>(args.in[I_WIN] + (size_t)ll * 1024 * 2176, args.in[I_MIXG] + ll * 1024, 1024, 2176, win, scr, r, lane);
                else transpose_item<false>(args.in[I_WMKV] + (size_t)ll * 1024 * 512, args.in[I_MEMG] + ll * 1024, 1024, 512, wkv, scr, r - I_IN, lane);
            }
            for (long i = gtid; i < 2 * 128 * 1024; i += gsize) { const int ll = (int)(i >> 17), n = (int)(i >> 10) & 127, k = (int)(i & 1023); float v = 0.f;
                if (ll > 0 && n < 16) v = args.in[I_WINV][k * 16 + n] * args.in[I_MIXG][1024 + k];
                ((bf16_t*)(wsp + (ll == 0 ? WS_WT + WT_IN : WS_WIN1)))[(size_t)(2176 + n) * 1024 + k] = f2bf(v); }
            for (long i = gtid; i < 2 * 384 * 160; i += gsize) { const int ll = (int)(i / (384 * 160)), r2 = (int)(i % (384 * 160)), hc = r2 / 160, j = r2 % 160; bf16_t* sm = (bf16_t*)(wsp + WS_SMALL + ll * SM_LORA_L);
                if (j < 32) sm[SM_W2T / 2 + hc * 32 + j] = f2bf(args.in[I_W2][(size_t)ll * 32 * 384 + j * 384 + hc]);
                else if (j < 64) sm[SM_A2T / 2 + hc * 32 + (j - 32)] = f2bf(args.in[I_A2][(size_t)ll * 32 * 384 + (j - 32) * 384 + hc]);
                else if (j < 96) sm[SM_V2T / 2 + hc * 32 + (j - 64)] = f2bf((j - 64) < 16 ? args.in[I_V2][(j - 64) * 384 + hc] : 0.f);
                else sm[SM_G2T / 2 + hc * 64 + (j - 96)] = f2bf(args.in[I_G2][(size_t)ll * 64 * 384 + (j - 96) * 384 + hc]); }
            for (int m = gw; m < MTOK; m += NGW) row_to_bf16(args.in[I_X] + (size_t)m * DM, XB + (size_t)m * DM, SSQ_A + m, lane);
            for (int m = gw; m < 512; m += NGW) row_to_bf16(args.in[I_MEM] + (size_t)m * DM, MEMB + (size_t)m * DM, ssqm + m, lane);
            sk::d_biastab(args.in[I_RELB], biastab, gtid, gsize);
            }
        PH_END
        }
        PH_BEGIN
            REPEAT(1)
            { pg8::Gemm g{XB, Wt_in, MTOK, 2304, 1024}; pg8::StaticOrder S; S.init(MTOK, 2304, G, (int)blockIdx.x);
              pg8::EpiScaleBf16 E{PROJ, LDP, SSQ_A + (size_t)l * MTOK};
              pg8::gemm_phase<pg8::EpiScaleBf16, pg8::StaticOrder, true, true>(L, g, S, E, tid); }
            { pg8::Gemm g{MEMB, Wt_mkv, 512, 512, 1024}; pg8::StaticOrder S; S.init(512, 512, G, (int)((blockIdx.x + 192) % G));
              pg8::EpiScaleBf16 E{MKV, 512, ssqm};
              pg8::gemm_phase<pg8::EpiScaleBf16, pg8::StaticOrder, true, true>(L, g, S, E, tid); }
            REPEAT(9) if (blockIdx.x >= 64) {
                const int I_OUT = 16 * 32, I_UP = 16 * 176, NIT = I_OUT + I_UP;
                for (int it = ((int)blockIdx.x - 64) * NWAVES + wave; it < NIT; it += (G - 64) * NWAVES) {
                    int r = it;
                    if (r < I_OUT) { transpose_item<false>(args.in[I_WOUT] + (size_t)l * 1024 * 1024, nullptr, 1024, 1024, Wt_out, scr, r, lane); continue; } r -= I_OUT;
                    transpose_item<true>(args.in[I_WUP] + (size_t)l * 1024 * 5632, args.in[I_FFNG] + l * 1024, 1024, 5632, Wt_up, scr, r, lane);
                }
            }
        PH_END


        PH_BEGIN
            MK_W(); MK_CBUF(); (void)cbuf;
#if !FAST_ATTN
            sk::d_qknorm(PROJ, MTOK, LDP, args.in[I_AQN] + l * 64, args.in[I_AKN] + l * 64, args.in[I_MQN] + l * 64, 0, gtid, gsize);
            sk::d_qknorm(MKV, 512, 512, nullptr, nullptr, args.in[I_MKN] + l * 64, 1, gtid, gsize);
#endif
#if FAST_RWKV
            REPEAT(2) rw::chunk_phase(L, PROJ, W, l, VF, cbuf, tid, (int)blockIdx.x, G);
#else
            sk::d_rwkv_prep(PROJ, W, l, VF, pR, pK, pV, pKK, pB, pLD, gtid, gsize);
#endif
        PH_END
        PH_BEGIN
            MK_CBUF(); (void)cbuf;
            if (blockIdx.x < 48) {
#if FAST_RWKV
                REPEAT(3) { __syncthreads(); if (tid < 8) MISC[16 + tid] = 0u; __syncthreads();
                  const int sbh = (int)blockIdx.x >> 2, stj = (int)blockIdx.x & 3;
                  if (wave == 0) rw::scan_compute(L, cbuf, sbh, stj, lane, MISC + 16); else if (wave < 4) rw::scan_loader(L, cbuf, sbh, stj, wave - 1, lane, MISC + 16);
                  else { LAS float* scr2 = (LAS float*)(L + 122880 + (wave - 4) * 9216);
                      for (int it = (int)blockIdx.x * 4 + (wave - 4); it < 44 * 32; it += 48 * 4) transpose_item<false>(args.in[I_WDOWN] + (size_t)l * 2816 * 1024, nullptr, 2816, 1024, Wt_down, scr2, it, lane); } }
#endif
            } else {
#if FAST_ATTN
                const at::AttnArgs A{PROJ, MKV, MIX, biastab, args.in[I_SINK] + l * 6, args.in[I_AQN] + l * 64, args.in[I_AKN] + l * 64, args.in[I_MQN] + l * 64, args.in[I_MKN] + l * 64};
                REPEAT(7) for (int it = (int)blockIdx.x - 48; it < 512; it += G - 48) at::attn_item(L, A, it, tid);
#else
                const long gt2 = (long)(blockIdx.x - BATCH * 6) * (NWAVES * 64) + tid, gs2 = (long)(G - BATCH * 6) * (NWAVES * 64);
                REPEAT(7) sk::d_swa(PROJ, MIX, biastab, args.in[I_SINK] + l * 6, gt2, gs2);
                REPEAT(8) sk::d_memattn(PROJ, MKV, MIX, gt2, gs2);
#endif
            }
        PH_END
        PH_BEGIN
            MK_W(); MK_CBUF(); (void)cbuf;
#if FAST_RWKV
            REPEAT(4) rw::out_phase(L, PROJ, W, cbuf, MIX, tid, (int)blockIdx.x, G);
#else
            sk::d_rwkv_fin(PROJ, W, pR, pK, pV, MIX, gtid, gsize);
#endif
        PH_END
        PH_BEGIN
            if ((PROF_PH) == 31) { pg8::Gemm g2{MIX, Wt_out, MTOK, 1024, 1024}; pg8::StaticOrder S2; S2.init(MTOK, 1024, G, (int)blockIdx.x); pg8::EpiScaleBf16 E2{PROJ, 1024, SSQ_A}; pg8::gemm_phase<pg8::EpiScaleBf16, pg8::StaticOrder, true, true>(L, g2, S2, E2, tid); }
            pg8::Gemm g{MIX, Wt_out, MTOK, 1024, 1024}; pg8::StaticOrder S; S.init(MTOK, 1024, G, (int)blockIdx.x);
            pg8::EpiResid E{xin, out, XB, SSQ_B + (size_t)l * MTOK, 1024};
            pg8::gemm_phase<pg8::EpiResid, pg8::StaticOrder, true, true>(L, g, S, E, tid);
        PH_END
        PH_BEGIN
            REPEAT(5) {
            pg8::Gemm g{XB, Wt_up, 66 * 256, 5632, 1024}; pg8::StaticOrder S; S.init(66 * 256, 5632, G, (int)blockIdx.x);
            pg8::EpiConvAct E{ACT, SSQ_B + (size_t)l * MTOK, args.in[I_CW] + (size_t)l * 3 * 5632, args.in[I_CB] + (size_t)l * 5632};
            pg8::gemm_phase<pg8::EpiConvAct, pg8::StaticOrder, true, true>(L, g, S, E, tid); }
        PH_END
        PH_BEGIN
            if ((PROF_PH) == 32) { pg8::Gemm g2{ACT, Wt_down, MTOK, 1024, 2816}; pg8::StaticOrder S2; S2.init(MTOK, 1024, G, (int)blockIdx.x); pg8::EpiScaleBf16 E2{PROJ, 1024, SSQ_A}; pg8::gemm_phase<pg8::EpiScaleBf16, pg8::StaticOrder, true, true>(L, g2, S2, E2, tid); }
            pg8::Gemm g{ACT, Wt_down, MTOK, 1024, 2816}; pg8::StaticOrder S; S.init(MTOK, 1024, G, (int)blockIdx.x);
            pg8::EpiResid E{out, out, XB, SSQ_A + (size_t)(l + 1) * MTOK, 1024};
            pg8::gemm_phase<pg8::EpiResid, pg8::StaticOrder, true, true>(L, g, S, E, tid);
        PH_END
    }
    if ((PROF_TA) >= 0 && blockIdx.x == 0 && tid0 == 0) {
        MISC[24 + ph] = (unsigned)__builtin_amdgcn_s_memrealtime();
        const unsigned ta = MISC[24 + (PROF_TA) + 1] - MISC[24 + (PROF_TA)], tb = (PROF_TB) >= 0 ? MISC[24 + (PROF_TB) + 1] - MISC[24 + (PROF_TB)] : 0u;
        const unsigned long long extra = (unsigned long long)ta + 1000ull * (unsigned long long)(((tb + 50u) / 100u) * 100u);
        const unsigned long long t0 = __builtin_amdgcn_s_memrealtime(); while (__builtin_amdgcn_s_memrealtime() - t0 < extra) __builtin_amdgcn_s_sleep(32);
    }
#undef PH_BEGIN
#undef PH_END
}
constexpr int N_PHASES = 1 + 2 * 7;
}

#ifndef MK_PER_PHASE
#define MK_PER_PHASE 0
#endif
extern "C" void kernel_launch(void* const* d_in, const int* in_sizes, int n_in, void* d_out, int out_size, void* d_ws, size_t ws_size, hipStream_t stream) {
    static int grid = 0;
    if (grid == 0) {
        if (n_in != N_IN || out_size != MTOK * DM || ws_size < mk::WS_END) { fprintf(stderr, "kernel_launch: unexpected shapes (n_in %d out %d ws %zu)\n", n_in, out_size, ws_size); grid = -1; return; }
        int dev = 0, cus = 0, per_cu = 0;
        if (hipGetDevice(&dev) != hipSuccess || hipDeviceGetAttribute(&cus, hipDeviceAttributeMultiprocessorCount, dev) != hipSuccess) { grid = -1; return; }
        if (hipFuncSetAttribute((const void*)mk::mk_fwd, hipFuncAttributeMaxDynamicSharedMemorySize, mk::LDS_BYTES) != hipSuccess) { fprintf(stderr, "kernel_launch: hipFuncSetAttribute failed\n"); grid = -1; return; }
        if (hipOccupancyMaxActiveBlocksPerMultiprocessor(&per_cu, (const void*)mk::mk_fwd, NWAVES * 64, mk::LDS_BYTES) != hipSuccess || per_cu < 1) { fprintf(stderr, "kernel_launch: occupancy query says %d blocks per CU\n", per_cu); }
        (void)hipGetLastError();
        grid = cus;
    }
    if (grid < 0) return;
    if (hipMemsetAsync((char*)d_ws + mk::WS_CTL, 0, mk::CTL_ZERO_BYTES, stream) != hipSuccess) return;
    mk::Args a{};
    for (int i = 0; i < N_IN; ++i) a.in[i] = (const float*)d_in[i];
    a.out = (float*)d_out; a.ws = (unsigned char*)d_ws;
#if MK_PER_PHASE
    for (int p = 0; p < mk::N_PHASES; ++p) { a.ph_lo = p; a.ph_hi = p + 1; hipLaunchKernelGGL(mk::mk_fwd, dim3(grid), dim3(NWAVES * 64), mk::LDS_BYTES, stream, a); }
#else
    a.ph_lo = 0; a.ph_hi = mk::N_PHASES;
    hipLaunchKernelGGL(mk::mk_fwd, dim3(grid), dim3(NWAVES * 64), mk::LDS_BYTES, stream, a);
#endif
}
```

```cpp
#define MK_BUILD 1
#ifndef HOST_SIM
#include <hip/hip_runtime.h>
#include <cstdio>
#include <cstdint>
#endif
#ifndef SEQ_LEN
#define SEQ_LEN 8192
#endif
typedef unsigned short bf16_t;
constexpr int BATCH = 2, SEQ = SEQ_LEN, DM = 1024, MTOK = BATCH * SEQ, DFF = 2816, LDP = 2304  ;
constexpr float EPS = 1e-6f, GN_EPS = 64e-5f;
__host__ __device__ __forceinline__ float bf2f(bf16_t h) { unsigned u = (unsigned)h << 16; return __builtin_bit_cast(float, u); }
__host__ __device__ __forceinline__ bf16_t f2bf(float f) { unsigned u = __builtin_bit_cast(unsigned, f); return (bf16_t)((u + 0x7fffu + ((u >> 16) & 1u)) >> 16); }
__host__ __device__ __forceinline__ int t5_bucket(int dist) {
    if (dist < 16) return dist;
    const float v = logf((float)dist / 16.0f) / 2.0794415416798357f * 16.0f;
    int large = 16 + (int)v; return large < 31 ? large : 31;
}
constexpr size_t MiB = 1u << 20;
enum { I_X = 0, I_MEM, I_RELB, I_MIXG, I_WIN, I_WINV, I_AQN, I_AKN, I_SINK, I_MU, I_MUV, I_W0, I_W2, I_A0, I_A2, I_V0, I_V2, I_G2, I_KK, I_KA, I_RK, I_LNW, I_LNB, I_MEMG, I_WMKV, I_MQN, I_MKN, I_WOUT, I_FFNG, I_WUP, I_CW, I_CB, I_WDOWN, N_IN };
#ifndef PROF_PH
#define PROF_PH -1
#endif
#ifndef PROF_N
#define PROF_N 1
#endif
namespace sk {

__device__ __forceinline__ void d_wt(const float* W, const float* g, bf16_t* Wt, int K, int N, int Npad, long gtid, long gsize) {
    const long total = (long)Npad * K;
    for (long idx = gtid; idx < total; idx += gsize) {
        const int n = (int)(idx / K), k = (int)(idx % K);
        float v = 0.f;
        if (n < N) { v = W[(long)k * N + n]; if (g) v *= g[k]; }
        Wt[idx] = f2bf(v);
    }
}
#ifndef MK_BUILD
__global__ void k_wt(const float* W, const float* g, bf16_t* Wt, int K, int N, int Npad) { d_wt(W, g, Wt, K, N, Npad, (long)blockIdx.x * blockDim.x + threadIdx.x, (long)gridDim.x * blockDim.x); }
#endif
__device__ __forceinline__ void d_rowprep(const float* x, bf16_t* xb, float* ssq, int rows, long gtid, long gsize) {
    for (long r = gtid; r < rows; r += gsize) {
        const float* xr = x + (long)r * DM; bf16_t* o = xb + (long)r * DM; float s = 0.f;
        for (int c = 0; c < DM; ++c) { const float v = xr[c]; s += v * v; o[c] = f2bf(v); }
        ssq[r] = s;
    }
}
#ifndef MK_BUILD
__global__ void k_rowprep(const float* x, bf16_t* xb, float* ssq, int rows) { d_rowprep(x, xb, ssq, rows, (long)blockIdx.x * blockDim.x + threadIdx.x, (long)gridDim.x * blockDim.x); }
#endif
__device__ __forceinline__ void d_biastab(const float* rel_bias, float* tab, long gtid, long gsize) {
        for (long i = gtid; i < 128 * 6; i += gsize) { const int dist = i / 6, hq = i % 6; tab[i] = rel_bias[t5_bucket(dist) * 6 + hq]; }
}
#ifndef MK_BUILD
__global__ void k_biastab(const float* rel_bias, float* tab) { d_biastab(rel_bias, tab, (long)blockIdx.x * blockDim.x + threadIdx.x, (long)gridDim.x * blockDim.x); }
#endif
__device__ __forceinline__ void d_qknorm(bf16_t* P, int rows, int ld, const float* gq, const float* gk, const float* gm, int mode, long gtid, long gsize) {
    const int nj = mode == 0 ? 12 : 4;
    const long total = (long)rows * nj;
    for (long idx = gtid; idx < total; idx += gsize) {
        const int row = (int)(idx / nj), j = (int)(idx % nj);
        int col; const float* g;
        if (mode == 0) { if (j < 6) { col = 64 * j; g = gq; } else if (j < 8) { col = 384 + 64 * (j - 6); g = gk; } else { col = 1920 + 64 * (j - 8); g = gm; } }
        else { col = 64 * j; g = gm; }
        bf16_t* p = P + (long)row * ld + col; float s = 0.f;
        for (int d = 0; d < 64; ++d) { const float v = bf2f(p[d]); s += v * v; }
        const float rs = 1.0f / sqrtf(s * (1.0f / 64.0f) + EPS);
        for (int d = 0; d < 64; ++d) p[d] = f2bf(bf2f(p[d]) * rs * g[d]);
    }
}
#ifndef MK_BUILD
__global__ void k_qknorm(bf16_t* P, int rows, int ld, const float* gq, const float* gk, const float* gm, int mode) { d_qknorm(P, rows, ld, gq, gk, gm, mode, (long)blockIdx.x * blockDim.x + threadIdx.x, (long)gridDim.x * blockDim.x); }
#endif
__device__ __forceinline__ void d_swa(const bf16_t* P, bf16_t* MIX, const float* biastab, const float* sinks, long gtid, long gsize) {
    const long total = (long)MTOK * 6;
    for (long idx = gtid; idx < total; idx += gsize) {
        const int tok = (int)(idx / 6), hq = (int)(idx % 6), hkv = hq / 3, t = tok % SEQ;
        float q[64], o[64];
#pragma unroll
        for (int d = 0; d < 64; ++d) { q[d] = bf2f(P[(long)tok * LDP + 64 * hq + d]) * 0.125f; o[d] = 0.f; }
        float m = sinks[hq], l = 1.0f;
        const int j0 = t - 127 < 0 ? 0 : t - 127;
        for (int j = j0; j <= t; ++j) {
            const bf16_t* kr = P + (long)(tok - (t - j)) * LDP + 384 + 64 * hkv; const bf16_t* vr = kr + 128;
            float s = 0.f;
#pragma unroll
            for (int d = 0; d < 64; ++d) s += q[d] * bf2f(kr[d]);
            s += biastab[(t - j) * 6 + hq];
            const float mn = fmaxf(m, s), f = expf(m - mn), e = expf(s - mn);
            l = l * f + e; m = mn;
#pragma unroll
            for (int d = 0; d < 64; ++d) o[d] = o[d] * f + e * bf2f(vr[d]);
        }
        const float inv = 1.0f / l;
#pragma unroll
        for (int d = 0; d < 64; ++d) MIX[(long)tok * DM + 64 * hq + d] = f2bf(o[d] * inv);
    }
}
#ifndef MK_BUILD
__global__ __launch_bounds__(256) void k_swa(const bf16_t* P, bf16_t* MIX, const float* biastab, const float* sinks) { d_swa(P, MIX, biastab, sinks, (long)blockIdx.x * blockDim.x + threadIdx.x, (long)gridDim.x * blockDim.x); }
#endif
__device__ __forceinline__ void d_memattn(const bf16_t* P, const bf16_t* MKV, bf16_t* MIX, long gtid, long gsize) {
    const long total = (long)MTOK * 4;
    for (long idx = gtid; idx < total; idx += gsize) {
        const int tok = (int)(idx / 4), h = (int)(idx % 4), b = tok / SEQ;
        float q[64], o[64];
#pragma unroll
        for (int d = 0; d < 64; ++d) { q[d] = bf2f(P[(long)tok * LDP + 1920 + 64 * h + d]) * 0.125f; o[d] = 0.f; }
        float m = -1e30f, l = 0.f;
        for (int j = 0; j < 256; ++j) {
            const bf16_t* kr = MKV + (long)(b * 256 + j) * 512 + 64 * h; const bf16_t* vr = kr + 256;
            float s = 0.f;
#pragma unroll
            for (int d = 0; d < 64; ++d) s += q[d] * bf2f(kr[d]);
            const float mn = fmaxf(m, s), f = expf(m - mn), e = expf(s - mn);
            l = l * f + e; m = mn;
#pragma unroll
            for (int d = 0; d < 64; ++d) o[d] = o[d] * f + e * bf2f(vr[d]);
        }
        const float inv = 1.0f / l;
#pragma unroll
        for (int d = 0; d < 64; ++d) MIX[(long)tok * DM + 768 + 64 * h + d] = f2bf(o[d] * inv);
    }
}
#ifndef MK_BUILD
__global__ __launch_bounds__(256) void k_memattn(const bf16_t* P, const bf16_t* MKV, bf16_t* MIX) { d_memattn(P, MKV, MIX, (long)blockIdx.x * blockDim.x + threadIdx.x, (long)gridDim.x * blockDim.x); }
#endif
__device__ __forceinline__ float shifted(const bf16_t* P, int tok, int col, float mu) {
    const float p = bf2f(P[(long)tok * LDP + col]);
    const float prev = (tok % SEQ) == 0 ? 0.f : bf2f(P[(long)(tok - 1) * LDP + col]);
    return p + mu * (prev - p);
}
struct RwkvW { const float *mu, *mu_v, *w0, *w2, *a0, *a2, *v0, *v2, *g2, *k_k, *k_a, *r_k, *ln_w, *ln_b; };
__device__ __forceinline__ void d_rwkv_prep(const bf16_t* P, RwkvW W, int layer, bf16_t* VFIRST, bf16_t* R, bf16_t* K, bf16_t* V, bf16_t* KK, bf16_t* B, bf16_t* LOGD, long gtid, long gsize) {
    const long total = (long)MTOK * 6;
    for (long idx = gtid; idx < total; idx += gsize) {
        const int tok = (int)(idx / 6), h = (int)(idx % 6);
        float nrm = 0.f;
        for (int c = 0; c < 64; ++c) { const int hc = 64 * h + c; const float kc = shifted(P, tok, 640 + 384 + hc, W.mu[384 + hc]) * W.k_k[hc]; nrm += kc * kc; }
        const float rn = 1.0f / fmaxf(sqrtf(nrm), 1e-12f);
        for (int c = 0; c < 64; ++c) {
            const int hc = 64 * h + c; const long o = (long)tok * 384 + hc;
            const float r = shifted(P, tok, 640 + hc, W.mu[hc]);
            const float k = shifted(P, tok, 640 + 384 + hc, W.mu[384 + hc]);
            float v = shifted(P, tok, 640 + 768 + hc, W.mu[768 + hc]);
            float wp = W.w0[hc], ap = W.a0[hc];
            for (int j = 0; j < 32; ++j) {
                wp += tanhf(shifted(P, tok, 640 + 1152 + j, W.mu[1152 + j])) * W.w2[j * 384 + hc];
                ap += shifted(P, tok, 640 + 1184 + j, W.mu[1184 + j]) * W.a2[j * 384 + hc];
            }
            const float z = -wp; const float sp = fmaxf(z, 0.f) + log1pf(expf(-fabsf(z)));
            const float w = -sp - 0.5f;
            const float a = 1.0f / (1.0f + expf(-ap));
            if (layer > 0) {
                float vp = W.v0[hc];
                for (int j = 0; j < 16; ++j) vp += shifted(P, tok, 2176 + j, W.mu_v[j]) * W.v2[j * 384 + hc];
                const float vf = bf2f(VFIRST[o]);
                v = v + (vf - v) * (1.0f / (1.0f + expf(-vp)));
            } else VFIRST[o] = f2bf(v);
            const float kk = k * W.k_k[hc] * rn;
            R[o] = f2bf(r); K[o] = f2bf(k * (1.0f + (a - 1.0f) * W.k_a[hc])); V[o] = f2bf(v);
            KK[o] = f2bf(kk); B[o] = f2bf(kk * a); LOGD[o] = f2bf(-expf(w));
        }
    }
}
#ifndef MK_BUILD
__global__ void k_rwkv_prep(const bf16_t* P, RwkvW W, int layer, bf16_t* VFIRST, bf16_t* R, bf16_t* K, bf16_t* V, bf16_t* KK, bf16_t* B, bf16_t* LOGD) { d_rwkv_prep(P, W, layer, VFIRST, R, K, V, KK, B, LOGD, (long)blockIdx.x * blockDim.x + threadIdx.x, (long)gridDim.x * blockDim.x); }
#endif
__device__ __forceinline__ void d_rwkv_scan(const bf16_t* R, const bf16_t* K, const bf16_t* V, const bf16_t* KK, const bf16_t* B, const bf16_t* LOGD, bf16_t* MIX, int bh, int i) {
    const int b = bh / 6, h = bh % 6;
    float s[64];
#pragma unroll
    for (int k = 0; k < 64; ++k) s[k] = 0.f;
    for (int t = 0; t < SEQ; ++t) {
        const long o = (long)(b * SEQ + t) * 384 + 64 * h;
        float sa = 0.f;
#pragma unroll
        for (int k = 0; k < 64; ++k) sa -= s[k] * bf2f(KK[o + k]);
        const float v = bf2f(V[o + i]); float y = 0.f;
#pragma unroll
        for (int k = 0; k < 64; ++k) { s[k] = s[k] * expf(bf2f(LOGD[o + k])) + sa * bf2f(B[o + k]) + v * bf2f(K[o + k]); y += s[k] * bf2f(R[o + k]); }
        MIX[(long)(b * SEQ + t) * DM + 384 + 64 * h + i] = f2bf(y);
    }
}
#ifndef MK_BUILD
__global__ void k_rwkv_scan(const bf16_t* R, const bf16_t* K, const bf16_t* V, const bf16_t* KK, const bf16_t* B, const bf16_t* LOGD, bf16_t* MIX) { d_rwkv_scan(R, K, V, KK, B, LOGD, MIX, blockIdx.x, threadIdx.x); }
#endif
__device__ __forceinline__ void d_rwkv_fin(const bf16_t* P, RwkvW W, const bf16_t* R, const bf16_t* K, const bf16_t* V, bf16_t* MIX, long gtid, long gsize) {
    const long total = (long)MTOK * 6;
    for (long idx = gtid; idx < total; idx += gsize) {
        const int tok = (int)(idx / 6), h = (int)(idx % 6);
        bf16_t* y = MIX + (long)tok * DM + 384 + 64 * h; const long o = (long)tok * 384 + 64 * h;
        float mean = 0.f, dot = 0.f;
        for (int c = 0; c < 64; ++c) { mean += bf2f(y[c]); dot += bf2f(R[o + c]) * bf2f(K[o + c]) * W.r_k[64 * h + c]; }
        mean *= (1.0f / 64.0f); float var = 0.f;
        for (int c = 0; c < 64; ++c) { const float d = bf2f(y[c]) - mean; var += d * d; }
        const float rstd = 1.0f / sqrtf(var * (1.0f / 64.0f) + GN_EPS);
        for (int c = 0; c < 64; ++c) {
            const int hc = 64 * h + c; float g = 0.f;
            for (int j = 0; j < 64; ++j) g += (1.0f / (1.0f + expf(-shifted(P, tok, 640 + 1216 + j, W.mu[1216 + j])))) * W.g2[j * 384 + hc];
            const float yn = (bf2f(y[c]) - mean) * rstd * W.ln_w[hc] + W.ln_b[hc];
            y[c] = f2bf((yn + dot * bf2f(V[o + c])) * g);
        }
    }
}
#ifndef MK_BUILD
__global__ void k_rwkv_fin(const bf16_t* P, RwkvW W, const bf16_t* R, const bf16_t* K, const bf16_t* V, bf16_t* MIX) { d_rwkv_fin(P, W, R, K, V, MIX, (long)blockIdx.x * blockDim.x + threadIdx.x, (long)gridDim.x * blockDim.x); }
#endif
__device__ __forceinline__ void d_conv_act(const bf16_t* U, const float* cw, const float* cb, bf16_t* ACT, int rows, long gtid, long gsize) {
    const long total = (long)rows * DFF;
    for (long idx = gtid; idx < total; idx += gsize) {
        const int t = (int)(idx / DFF), c = (int)(idx % DFF);
        float gate = cb[c], val = cb[DFF + c];
#pragma unroll
        for (int i = 0; i < 3; ++i) { const int tt = t - 2 + i; if (tt >= 0) { gate += cw[i * 2 * DFF + c] * bf2f(U[(long)tt * 2 * DFF + c]); val += cw[i * 2 * DFF + DFF + c] * bf2f(U[(long)tt * 2 * DFF + DFF + c]); } }
        ACT[(long)t * DFF + c] = f2bf(gate / (1.0f + expf(-gate)) * val);
    }
}
#ifndef MK_BUILD
__global__ void k_conv_act(const bf16_t* U, const float* cw, const float* cb, bf16_t* ACT, int rows) { d_conv_act(U, cw, cb, ACT, rows, (long)blockIdx.x * blockDim.x + threadIdx.x, (long)gridDim.x * blockDim.x); }
#endif
}
namespace pg8 {
#define PG8_LAS __attribute__((address_space(3)))
typedef unsigned short bf16_t;
typedef short bf16x8 __attribute__((ext_vector_type(8)));
typedef float f32x4 __attribute__((ext_vector_type(4)));
typedef unsigned u32x4 __attribute__((ext_vector_type(4)));
constexpr int BM = 256, BK = 64, HALF = 128, HTB = HALF * BK * 2  , STAGE_BYTES = 8 * HTB, NXCD = 8, WGM = 8;

__host__ __device__ __forceinline__ int lds_byte(int r, int c) { const int st = (r >> 4) * 2 + (c >> 5), rr = r & 15, cc = c & 31, ob = rr * 64 + cc * 2; return st * 1024 + (ob ^ (((ob >> 9) & 1) << 5)); }
__host__ __device__ __forceinline__ void stage_rc(int b, int& R, int& C) { const int st = b / 1024, sb = b % 1024, swz = sb ^ (((sb >> 9) & 1) << 5); R = (st >> 1) * 16 + swz / 64; C = (st & 1) * 32 + (swz % 64) / 2; }
__host__ __device__ __forceinline__ int perm32(int rho) { const int n = rho >> 4, i = rho & 15; return 8 * (i >> 2) + 4 * n + (i & 3); }

struct Unit { int pm, pn; };
struct Gemm { const bf16_t* A; const bf16_t* Bt; int M, N, K; };

struct StaticOrder {
    int nM, nN, nwg, G, c;
    __host__ __device__ void init(int M, int N, int G_, int c_) { nM = M / BM; nN = N / BM; nwg = nM * nN; G = G_; c = c_; }
    __host__ __device__ bool next(int i, Unit& u) const {
        const long L = (long)i * G + c; if (L >= nwg) return false;
        int wgid = (int)L; { const int q = nwg / NXCD, r = nwg % NXCD, xcd = wgid % NXCD, off = wgid / NXCD; wgid = (xcd < r ? xcd * (q + 1) : r * (q + 1) + (xcd - r) * q) + off; }
        const int nig = WGM * nN, gid = wgid / nig, fm = gid * WGM, gsz = (nM - fm) < WGM ? (nM - fm) : WGM;
        u.pm = fm + ((wgid % nig) % gsz); u.pn = (wgid % nig) / gsz; return true;
    }
    __device__ __forceinline__ void a_ready(const Unit&) const {}
    __device__ __forceinline__ void done(const Unit&) const {}
};

__device__ __forceinline__ unsigned cvt_pk_bf16(float lo, float hi) { unsigned r; asm volatile("v_cvt_pk_bf16_f32 %0, %1, %2" : "=v"(r) : "v"(lo), "v"(hi)); return r; }
struct EpiScaleBf16 {
    static constexpr bool PERM = true, AFTER_DRAIN = false; static constexpr int AMAP = 0;
    bf16_t* O; int ldc; const float* ssq;
    __device__ __forceinline__ void operator()(const f32x4 (&acc)[2][2][4][2], const Unit& u, int wr, int wc, int fr, int fq) const {
        const int row0 = u.pm * BM + wr * 64 + fr, col0 = u.pn * BM + wc * 32 + 8 * fq;
#pragma unroll
        for (int ai = 0; ai < 2; ++ai)
#pragma unroll
            for (int m = 0; m < 4; ++m) { const int row = row0 + ai * HALF + m * 16; const float sc = 1.0f / sqrtf(ssq[row] * (1.0f / 1024.0f) + 1e-6f);
                bf16_t* rowp = O + (size_t)row * ldc + col0;
#pragma unroll
                for (int bj = 0; bj < 2; ++bj) { const f32x4 v0 = acc[ai][bj][m][0] * sc, v1 = acc[ai][bj][m][1] * sc;
                    u32x4 w; w.x = cvt_pk_bf16(v0[0], v0[1]); w.y = cvt_pk_bf16(v0[2], v0[3]); w.z = cvt_pk_bf16(v1[0], v1[1]); w.w = cvt_pk_bf16(v1[2], v1[3]);
                    *(u32x4*)(rowp + bj * HALF) = w; } }
    }
};
struct EpiResid {
    static constexpr bool PERM = false, AFTER_DRAIN = false; static constexpr int AMAP = 0;
    const float* base; float* out; bf16_t* xb; float* ssq; int ldc;
    __device__ __forceinline__ void operator()(const f32x4 (&acc)[2][2][4][2], const Unit& u, int wr, int wc, int fr, int fq) const {
        typedef unsigned u32x2v __attribute__((ext_vector_type(2)));
        const int col0 = u.pn * BM + wc * 32 + 4 * fq;
#pragma unroll
        for (int ai = 0; ai < 2; ++ai)
#pragma unroll
            for (int m = 0; m < 4; ++m) { const int row = u.pm * BM + ai * HALF + wr * 64 + m * 16 + fr; const size_t off = (size_t)row * ldc + col0; float sq = 0.f;
#pragma unroll
                for (int bj = 0; bj < 2; ++bj)
#pragma unroll
                    for (int n = 0; n < 2; ++n) { const f32x4 o = *(const f32x4*)(base + off + bj * HALF + n * 16) + acc[ai][bj][m][n];
                        *(f32x4*)(out + off + bj * HALF + n * 16) = o; sq += (o[0] * o[0] + o[1] * o[1]) + (o[2] * o[2] + o[3] * o[3]);
                        u32x2v w; w.x = cvt_pk_bf16(o[0], o[1]); w.y = cvt_pk_bf16(o[2], o[3]); *(u32x2v*)(xb + off + bj * HALF + n * 16) = w; }
                sq += __shfl_xor(sq, 16); sq += __shfl_xor(sq, 32);
                if (fq == 0) atomicAdd(ssq + row, sq); }
    }
};
struct EpiConvAct {
    static constexpr bool PERM = true, AFTER_DRAIN = false; static constexpr int AMAP = 1;
    bf16_t* ACT; const float* ssq; const float* cw; const float* cb;
    static __device__ __forceinline__ float shr1s(float x) { float r; asm volatile("s_nop 1\n\tv_mov_b32_dpp %0, %1 row_shr:1 row_mask:0xf bank_mask:0xf bound_ctrl:1" : "=v"(r) : "v"(x)); return r; }
    static __device__ __forceinline__ f32x4 shr1(f32x4 v) { f32x4 r; r[0] = shr1s(v[0]); r[1] = shr1s(v[1]); r[2] = shr1s(v[2]); r[3] = shr1s(v[3]); return r; }
    __device__ __forceinline__ void operator()(const f32x4 (&acc)[2][2][4][2], const Unit& u, int wr, int wc, int fr, int fq) const {
        const int b = u.pm / 33, pmb = u.pm % 33;
        const int pos0 = 252 * pmb + 126 * wr + 8 * fr - 2;
        const long row0 = (long)b * SEQ + pos0;
        float rs[8];
#pragma unroll
        for (int j = 0; j < 8; ++j) { const int pos = pos0 + j; const bool ok = pos >= 0 && pos < SEQ; const float q = ssq[ok ? row0 + j : 0]; rs[j] = ok ? 1.0f / sqrtf(q * (1.0f / 1024.0f) + 1e-6f) : 0.f; }
        const int ch0 = 128 * u.pn + 32 * wc + 8 * fq;
        unsigned ow[8][4];
#pragma unroll
        for (int n = 0; n < 2; ++n) { const int c = ch0 + 4 * n;
            const f32x4 w0g = *(const f32x4*)(cw + c), w1g = *(const f32x4*)(cw + 5632 + c), w2g = *(const f32x4*)(cw + 2 * 5632 + c), bg = *(const f32x4*)(cb + c);
            const f32x4 w0v = *(const f32x4*)(cw + 2816 + c), w1v = *(const f32x4*)(cw + 5632 + 2816 + c), w2v = *(const f32x4*)(cw + 2 * 5632 + 2816 + c), bv = *(const f32x4*)(cb + 2816 + c);
            f32x4 gm2 = shr1(acc[1][0][2][n] * rs[6]), gm1 = shr1(acc[1][0][3][n] * rs[7]), vm2 = shr1(acc[1][1][2][n] * rs[6]), vm1 = shr1(acc[1][1][3][n] * rs[7]);
#pragma unroll
            for (int j = 0; j < 8; ++j) { const f32x4 gj = acc[j >> 2][0][j & 3][n] * rs[j], vj = acc[j >> 2][1][j & 3][n] * rs[j];
                const f32x4 ug = bg + w0g * gm2 + w1g * gm1 + w2g * gj, uv = bv + w0v * vm2 + w1v * vm1 + w2v * vj; f32x4 a;
#pragma unroll
                for (int e = 0; e < 4; ++e) a[e] = ug[e] / (1.0f + __expf(-ug[e])) * uv[e];
                ow[j][2 * n] = cvt_pk_bf16(a[0], a[1]); ow[j][2 * n + 1] = cvt_pk_bf16(a[2], a[3]);
                gm2 = gm1; gm1 = gj; vm2 = vm1; vm1 = vj; } }
#pragma unroll
        for (int j = 0; j < 8; ++j) if (8 * fr + j >= 2 && pos0 + j < SEQ) { u32x4 w; w.x = ow[j][0]; w.y = ow[j][1]; w.z = ow[j][2]; w.w = ow[j][3]; *(u32x4*)(ACT + (size_t)(row0 + j) * 2816 + ch0) = w; }
    }
};
template <class Epi, class Sched, bool ALIGN_EPI = false, bool SP2 = false>
__device__ __forceinline__ void gemm_phase(PG8_LAS unsigned char* lds, const Gemm g, const Sched& S, const Epi& E, int tid_in) {
    int tid = tid_in; asm volatile("" : "+v"(tid));
    const int wid = __builtin_amdgcn_readfirstlane(tid >> 6), lane = tid & 63, wr = wid >> 2, wc = wid & 3, fr = lane & 15, fq = lane >> 4;
    const int K = g.K, nt = K / BK;
    unsigned voffA[2], voffB[2];
#pragma unroll
    for (int i = 0; i < 2; ++i) { int R, C; stage_rc(tid * 16 + i * 8192, R, C); const int Rb = Epi::PERM ? ((R & ~31) + perm32(R & 31)) : R;
        const int Ra = Epi::AMAP ? (126 * (R >> 6) + 8 * (R & 15) + ((R >> 4) & 3)) : R;
        voffA[i] = (unsigned)(Ra * K + C) * 2u; voffB[i] = (unsigned)(Rb * K + C) * 2u; }
    const size_t kstep = (size_t)(BK * 2);
    const size_t hstepB = (size_t)HALF * K * 2;
    const size_t hstepA = Epi::AMAP ? (size_t)4 * K * 2 : hstepB;
    const size_t tstep = 2 * hstepB;
#define PG8_ABASE(pm_) (Epi::AMAP ? (long)((long)((pm_) / 33) * SEQ + 252 * ((pm_) % 33) - 2) * (long)K * 2 : (long)(pm_) * (long)tstep)
    const unsigned ldsw = (unsigned)wid * 1024u;
    const int aoff = lds_byte(wr * 64 + fr, fq * 8), boff = lds_byte(wc * 32 + fr, fq * 8);
#define PG8_SA(b, h) (((b) * 2 + (h)) * HTB)
#define PG8_SB(b, h) ((4 + (b) * 2 + (h)) * HTB)
#define PG8_STAGE(bufoff, gbase, voff) do { _Pragma("unroll") for (int _i = 0; _i < 2; ++_i) \
        __builtin_amdgcn_global_load_lds((const unsigned*)((const char*)(gbase) + (voff)[_i]), (PG8_LAS unsigned*)(lds + (bufoff) + ldsw + _i * 8192), 16, 0, 0); } while (0)
#define PG8_LDA(dst, b, h) do { _Pragma("unroll") for (int m = 0; m < 4; ++m) _Pragma("unroll") for (int k = 0; k < 2; ++k) dst[m][k] = *(const PG8_LAS bf16x8*)(lds + PG8_SA(b, h) + aoff + m * 2048 + k * 1024); } while (0)
#define PG8_LDB(dst, b, h) do { _Pragma("unroll") for (int n = 0; n < 2; ++n) _Pragma("unroll") for (int k = 0; k < 2; ++k) dst[n][k] = *(const PG8_LAS bf16x8*)(lds + PG8_SB(b, h) + boff + n * 2048 + k * 1024); } while (0)
#define PG8_MMA(ai, bj, At, Bt) do { __builtin_amdgcn_s_setprio(1); _Pragma("unroll") for (int m = 0; m < 4; ++m) _Pragma("unroll") for (int n = 0; n < 2; ++n) _Pragma("unroll") for (int k = 0; k < 2; ++k) \
        acc[ai][bj][m][n] = __builtin_amdgcn_mfma_f32_16x16x32_bf16(Bt[n][k], At[m][k], acc[ai][bj][m][n], 0, 0, 0); __builtin_amdgcn_s_setprio(0); } while (0)
#define PG8_WAIT_V(n) asm volatile("s_waitcnt vmcnt(" #n ")" ::: "memory")
#define PG8_WAIT_L(n) asm volatile("s_waitcnt lgkmcnt(" #n ")" ::: "memory")
#define PG8_BAR __builtin_amdgcn_s_barrier()
#define PG8_SCHED __builtin_amdgcn_sched_barrier(0)
    Unit cur, nxt; int ui = 0;
    if (!S.next(0, cur)) return;
    f32x4 acc[2][2][4][2];
#pragma unroll
    for (int a = 0; a < 2; ++a)
#pragma unroll
        for (int b = 0; b < 2; ++b)
#pragma unroll
            for (int m = 0; m < 4; ++m)
#pragma unroll
                for (int n = 0; n < 2; ++n) acc[a][b][m][n] = (f32x4){0.f, 0.f, 0.f, 0.f};
    bf16x8 At[4][2], B0[2][2], B1[2][2];
    const char* cA = (const char*)g.A + PG8_ABASE(cur.pm); const char* cB = (const char*)g.Bt + (size_t)cur.pn * tstep;
    S.a_ready(cur);
    if constexpr (SP2) {
        PG8_STAGE(PG8_SB(0, 0), cB, voffB); PG8_STAGE(PG8_SB(0, 1), cB + hstepB, voffB); PG8_STAGE(PG8_SA(0, 0), cA, voffA); PG8_STAGE(PG8_SA(0, 1), cA + hstepA, voffA);
        if (wr == 1) PG8_BAR;
        PG8_WAIT_V(2); PG8_BAR;
        PG8_STAGE(PG8_SB(1, 0), cB + kstep, voffB); PG8_STAGE(PG8_SA(1, 0), cA + kstep, voffA); PG8_STAGE(PG8_SB(1, 1), cB + hstepB + kstep, voffB);
        PG8_WAIT_V(6); PG8_BAR;
    } else {
        PG8_STAGE(PG8_SB(0, 0), cB, voffB); PG8_STAGE(PG8_SA(0, 0), cA, voffA); PG8_STAGE(PG8_SB(0, 1), cB + hstepB, voffB); PG8_STAGE(PG8_SA(0, 1), cA + hstepA, voffA);
        if (wr == 1) PG8_BAR;
        PG8_WAIT_V(4); PG8_BAR;
        PG8_STAGE(PG8_SB(1, 0), cB + kstep, voffB); PG8_STAGE(PG8_SA(1, 0), cA + kstep, voffA); PG8_STAGE(PG8_SB(1, 1), cB + hstepB + kstep, voffB);
        PG8_WAIT_V(6); PG8_BAR;
    }
    for (;;) {
        const bool has_next = S.next(ui + 1, nxt);
        const char* nA = has_next ? (const char*)g.A + PG8_ABASE(nxt.pm) : cA; const char* nB = has_next ? (const char*)g.Bt + (size_t)nxt.pn * tstep : cB;
        for (int t = 0; t < nt; t += 2) {
            const bool last = (t == nt - 2);
            const char* a1 = cA + (size_t)(t + 1) * kstep;
            const char* a2 = last ? nA : cA + (size_t)(t + 2) * kstep; const char* b2 = last ? nB : cB + (size_t)(t + 2) * kstep;
            const char* a3 = a2 + kstep; const char* b3 = b2 + kstep;
            if (last && has_next) S.a_ready(nxt);
            if constexpr (SP2) {
            PG8_LDB(B0, 0, 0); PG8_LDB(B1, 0, 1); PG8_SCHED; PG8_LDA(At, 0, 0); PG8_STAGE(PG8_SA(1, 1), a1 + hstepA, voffA);
            PG8_WAIT_V(8); PG8_WAIT_L(0); PG8_BAR; PG8_MMA(0, 0, At, B0); PG8_MMA(0, 1, At, B1); PG8_BAR; PG8_SCHED;
            PG8_LDA(At, 0, 1); PG8_STAGE(PG8_SB(0, 0), b2, voffB); PG8_STAGE(PG8_SB(0, 1), b2 + hstepB, voffB); PG8_STAGE(PG8_SA(0, 0), a2, voffA);
            PG8_WAIT_V(8); PG8_WAIT_L(0); PG8_BAR; PG8_MMA(1, 0, At, B0); PG8_MMA(1, 1, At, B1); PG8_BAR; PG8_SCHED;
            PG8_LDB(B0, 1, 0); PG8_LDB(B1, 1, 1); PG8_SCHED; PG8_LDA(At, 1, 0); PG8_STAGE(PG8_SA(0, 1), a2 + hstepA, voffA);
            PG8_WAIT_V(8); PG8_WAIT_L(0); PG8_BAR; PG8_MMA(0, 0, At, B0); PG8_MMA(0, 1, At, B1); PG8_BAR; PG8_SCHED;
            PG8_LDA(At, 1, 1); PG8_STAGE(PG8_SB(1, 0), b3, voffB); PG8_STAGE(PG8_SB(1, 1), b3 + hstepB, voffB); PG8_STAGE(PG8_SA(1, 0), a3, voffA);
            PG8_WAIT_V(8); PG8_WAIT_L(0); PG8_BAR; PG8_MMA(1, 0, At, B0); PG8_MMA(1, 1, At, B1); PG8_BAR; PG8_SCHED;
            } else {
            PG8_LDB(B0, 0, 0); PG8_SCHED; PG8_LDA(At, 0, 0); PG8_STAGE(PG8_SA(1, 1), a1 + hstepA, voffA);
            PG8_WAIT_L(8); PG8_BAR; PG8_WAIT_L(0); PG8_MMA(0, 0, At, B0); PG8_BAR; PG8_SCHED;
            PG8_LDB(B1, 0, 1); PG8_STAGE(PG8_SB(0, 0), b2, voffB);
            PG8_BAR; PG8_WAIT_L(0); PG8_MMA(0, 1, At, B1); PG8_BAR;
            PG8_LDA(At, 0, 1); PG8_STAGE(PG8_SA(0, 0), a2, voffA);
            PG8_BAR; PG8_WAIT_L(0); PG8_MMA(1, 0, At, B0); PG8_BAR; PG8_SCHED;
            PG8_STAGE(PG8_SB(0, 1), b2 + hstepB, voffB);
            PG8_WAIT_V(6); PG8_BAR; PG8_MMA(1, 1, At, B1); PG8_BAR;
            PG8_LDB(B0, 1, 0); PG8_SCHED; PG8_LDA(At, 1, 0); PG8_STAGE(PG8_SA(0, 1), a2 + hstepA, voffA);
            PG8_WAIT_L(8); PG8_BAR; PG8_WAIT_L(0); PG8_MMA(0, 0, At, B0); PG8_BAR; PG8_SCHED;
            PG8_LDB(B1, 1, 1); PG8_STAGE(PG8_SB(1, 0), b3, voffB);
            PG8_BAR; PG8_WAIT_L(0); PG8_MMA(0, 1, At, B1); PG8_BAR;
            PG8_LDA(At, 1, 1); PG8_STAGE(PG8_SA(1, 0), a3, voffA);
            PG8_BAR; PG8_WAIT_L(0); PG8_MMA(1, 0, At, B0); PG8_BAR; PG8_SCHED;
            PG8_STAGE(PG8_SB(1, 1), b3 + hstepB, voffB);
            PG8_WAIT_V(6); PG8_BAR; PG8_MMA(1, 1, At, B1); PG8_BAR;
            }
        }
        if constexpr (ALIGN_EPI) { if (wr == 0) PG8_BAR; }
        if constexpr (!Epi::AFTER_DRAIN) { E(acc, cur, wr, wc, fr, fq); S.done(cur); }
        if (!has_next) break;
#pragma unroll
        for (int a = 0; a < 2; ++a)
#pragma unroll
            for (int b = 0; b < 2; ++b)
#pragma unroll
                for (int m = 0; m < 4; ++m)
#pragma unroll
                    for (int n = 0; n < 2; ++n) acc[a][b][m][n] = (f32x4){0.f, 0.f, 0.f, 0.f};
        cur = nxt; cA = nA; cB = nB; ++ui;
        if constexpr (ALIGN_EPI) { if (wr == 1) PG8_BAR; }
    }
    PG8_WAIT_V(0);
    if constexpr (!ALIGN_EPI) { if (wr == 0) PG8_BAR; }
    PG8_BAR;
    if constexpr (Epi::AFTER_DRAIN) { E.fused(acc, cur, wr, wc, fr, fq, lds, wid, lane); S.done(cur); }
#undef PG8_ABASE
#undef PG8_SA
#undef PG8_SB
#undef PG8_STAGE
#undef PG8_LDA
#undef PG8_LDB
#undef PG8_MMA
#undef PG8_WAIT_V
#undef PG8_WAIT_L
#undef PG8_BAR
#undef PG8_SCHED
}
}

#ifndef PG8_SP2
#define PG8_SP2 true
#endif
#ifndef PG8_ALIGN
#define PG8_ALIGN true
#endif
#define GAS __attribute__((address_space(1)))
#define LAS __attribute__((address_space(3)))
typedef unsigned short bf16;
typedef unsigned v4u __attribute__((ext_vector_type(4)));
typedef float f32x4 __attribute__((ext_vector_type(4)));
typedef short bf16x8 __attribute__((ext_vector_type(8)));
typedef GAS unsigned gu32;
typedef GAS unsigned long long gu64;
#define RLX_AGENT __ATOMIC_RELAXED, __HIP_MEMORY_SCOPE_AGENT
#define LDS_WAIT() asm volatile("s_waitcnt lgkmcnt(0)" ::: "memory")
#define VM_WAIT() asm volatile("s_waitcnt vmcnt(0)" ::: "memory")
__device__ __forceinline__ unsigned long long rt() { return __builtin_amdgcn_s_memrealtime(); }

#define XB_TMO      128
#define XB_XCNT(j)  (256  + 64 * (j))
#define XB_XSUB(j)  (1280 + 64 * (j))
#define XB_XGEN(j)  (2304 + 64 * (j))
#define XB_TOP      3328
#define XB_TOPGEN   3392
#define XCD_BAR_WORDS 3456
#define XB_SPIN_CAP (1u << 20)

__device__ __forceinline__ unsigned xb_ld(unsigned* p)              { return __hip_atomic_load(p, __ATOMIC_RELAXED, __HIP_MEMORY_SCOPE_AGENT); }
__device__ __forceinline__ unsigned xb_add(unsigned* p, unsigned v) { return __hip_atomic_fetch_add(p, v, __ATOMIC_RELAXED, __HIP_MEMORY_SCOPE_AGENT); }
__device__ __forceinline__ unsigned xb_xcc_id() { return (unsigned)__builtin_amdgcn_s_getreg((3 << 11) | 20) & 0xFu; }
#define XB_SPIN(cond, bar) do { unsigned _sp = 0; while (cond) { __builtin_amdgcn_s_sleep(1); \
    if ((++_sp & 255u) == 0u) { if (xb_ld(&(bar)[XB_TMO])) break; if (_sp > XB_SPIN_CAP) { atomicAdd(&(bar)[XB_TMO], 1u); break; } } } } while (0)

struct XcdBarrier {
    unsigned* bar; unsigned x;
    volatile LAS unsigned* st;
};

__device__ __forceinline__ XcdBarrier xcd_barrier_post(unsigned* bar, volatile LAS unsigned* st) {
    XcdBarrier b; b.bar = bar; b.x = xb_xcc_id(); b.st = st;
    if (threadIdx.x == 0) (void)xb_add(&bar[XB_XCNT(b.x)], 1u);
    return b;
}
__device__ __forceinline__ void xcd_barrier_complete(unsigned* bar, unsigned x, unsigned& nloc, unsigned& nx) {
    const unsigned G = gridDim.x * gridDim.y * gridDim.z;
    unsigned sum, cnt, mine, sp = 0u;
    for (;;) {
        sum = 0u; cnt = 0u; mine = 0u;
#pragma unroll
        for (unsigned j = 0; j < 16; ++j) { const unsigned c = xb_ld(&bar[XB_XCNT(j)]); sum += c; cnt += (c > 0u) ? 1u : 0u; mine = (j == x) ? c : mine; }
        if (sum == G) break;
        __builtin_amdgcn_s_sleep(1);
        if ((++sp & 255u) == 0u) { if (xb_ld(&bar[XB_TMO])) break; if (sp > XB_SPIN_CAP) { atomicAdd(&bar[XB_TMO], 1u); break; } }
    }
    nloc = mine > 0u ? mine : 1u; nx = cnt > 0u ? cnt : 1u;
}

__device__ __forceinline__ void xcd_barrier(const XcdBarrier& b) {
    asm volatile("s_waitcnt vmcnt(0)" ::: "memory");
    __syncthreads();
    if (threadIdx.x == 0) {
        unsigned* bar = b.bar;
        __builtin_amdgcn_s_waitcnt(0);
        unsigned nloc = b.st[0], nx = b.st[1];
        if (nloc == 0u) { xcd_barrier_complete(bar, b.x, nloc, nx); b.st[0] = nloc; b.st[1] = nx; }
        const unsigned old = xb_add(&bar[XB_XSUB(b.x)], 1u);
        const unsigned gen = old / nloc;
        if (old + 1u == (gen + 1u) * nloc) {
            __builtin_amdgcn_fence(__ATOMIC_RELEASE, "agent");
            asm volatile("s_waitcnt vmcnt(0)" ::: "memory");
            const unsigned og = xb_add(&bar[XB_TOP], 1u);
            const unsigned tg = og / nx;
            if (og + 1u == (tg + 1u) * nx) xb_add(&bar[XB_TOPGEN], 1u);
            else XB_SPIN(xb_ld(&bar[XB_TOPGEN]) == tg, bar);
            __builtin_amdgcn_fence(__ATOMIC_ACQUIRE, "agent");
            xb_add(&bar[XB_XGEN(b.x)], 1u);
            asm volatile("s_waitcnt vmcnt(0)" ::: "memory");
        } else {
            XB_SPIN(xb_ld(&bar[XB_XGEN(b.x)]) == gen, bar);
            __builtin_amdgcn_fence(__ATOMIC_ACQUIRE, "agent");
            asm volatile("s_waitcnt vmcnt(0)" ::: "memory");
        }
    }
    __syncthreads();
}

namespace rw {
constexpr int LD = 72;
constexpr int MATB = 64 * LD * 2;
constexpr int OFF_F0 = 12 * MATB  , OFF_TMP = OFF_F0 + 64 * 65 * 4  ;
constexpr int OFF_TW = 8 * MATB  , OFF_TA = OFF_TW + 5120, OFF_TV = OFF_TA + 5120, OFF_WP = OFF_TV + 5120  , OFF_AP = OFF_WP + 16640, OFF_VP = OFF_AP + 16640;
constexpr int OFF_TOT = 139264, OFF_GC = OFF_TOT + 2048, OFF_RN = OFF_GC + 256, OFF_END = OFF_RN + 256;
constexpr int NITEMS = BATCH * 6 * (SEQ / 64);
__device__ __forceinline__ int sigpos(int c) { return (c & 32) + 8 * ((c >> 2) & 3) + 4 * ((c >> 4) & 1) + (c & 3); }
#define RW_BAR() do { asm volatile("s_waitcnt lgkmcnt(0)" ::: "memory"); __builtin_amdgcn_s_barrier(); asm volatile("" ::: "memory"); } while (0)
__device__ __forceinline__ float fexp(float x) { return __expf(x); }
__device__ __forceinline__ float fsigm(float x) { return 1.0f / (1.0f + __expf(-x)); }
__device__ __forceinline__ float ftanh(float x) { const float e = __expf(-2.0f * fabsf(x)); const float t = (1.0f - e) / (1.0f + e); return x < 0.f ? -t : t; }
__device__ __forceinline__ f32x4 mm_tile(const LAS bf16_t* A, const LAS bf16_t* Bt, int ti, int tj, int fr, int fq, f32x4 acc) {
#pragma unroll
    for (int kk = 0; kk < 2; ++kk) {
        const bf16x8 a = *(const LAS bf16x8*)(A + (16 * ti + fr) * LD + 32 * kk + 8 * fq);
        const bf16x8 b = *(const LAS bf16x8*)(Bt + (16 * tj + fr) * LD + 32 * kk + 8 * fq);
        acc = __builtin_amdgcn_mfma_f32_16x16x32_bf16(a, b, acc, 0, 0, 0);
    }
    return acc;
}
__device__ __forceinline__ unsigned pk2(float lo, float hi) { typedef float f2_t __attribute__((ext_vector_type(2))); typedef __bf16 b2_t __attribute__((ext_vector_type(2))); f2_t v = {lo, hi}; return __builtin_bit_cast(unsigned, __builtin_convertvector(v, b2_t)); }
struct ChunkBufs { bf16_t* PT; bf16_t* G; float* Z; float* YV; bf16_t* S0; bf16_t* VOUT; float* DOT; const bf16_t *W2T, *A2T, *V2T, *G2T; };

#define RW_LANES() int lt_ = tid_in; asm volatile("" : "+v"(lt_)); const int tid = lt_, lane = lt_ & 63, fr = lane & 15, fq = lane >> 4; (void)tid; (void)fr; (void)fq
__device__ __forceinline__ void chunk_phase(LAS unsigned char* L, const bf16_t* P, const sk::RwkvW W, int layer, const bf16_t* VFIRST, const ChunkBufs cb, int tid_in, int first, int stride) {
    const int w = __builtin_amdgcn_readfirstlane(tid_in >> 6);
    LAS bf16_t* B0 = (LAS bf16_t*)(L + 0 * MATB); LAS bf16_t* B1 = (LAS bf16_t*)(L + 1 * MATB); LAS bf16_t* B2 = (LAS bf16_t*)(L + 2 * MATB); LAS bf16_t* B3 = (LAS bf16_t*)(L + 3 * MATB);
    LAS bf16_t* B4 = (LAS bf16_t*)(L + 4 * MATB); LAS bf16_t* B5 = (LAS bf16_t*)(L + 5 * MATB); LAS bf16_t* B6 = (LAS bf16_t*)(L + 6 * MATB); LAS bf16_t* B7 = (LAS bf16_t*)(L + 7 * MATB);
    LAS bf16_t* B8 = (LAS bf16_t*)(L + 8 * MATB); LAS bf16_t* B9 = (LAS bf16_t*)(L + 9 * MATB); LAS bf16_t* B10 = (LAS bf16_t*)(L + 10 * MATB); LAS bf16_t* B11 = (LAS bf16_t*)(L + 11 * MATB);
    LAS float* F0 = (LAS float*)(L + OFF_F0); LAS float* TMP = (LAS float*)(L + OFF_TMP);
    LAS bf16_t* TW = (LAS bf16_t*)(L + OFF_TW); LAS bf16_t* TA = (LAS bf16_t*)(L + OFF_TA); LAS bf16_t* TV = (LAS bf16_t*)(L + OFF_TV);
    LAS float* WP = (LAS float*)(L + OFF_WP); LAS float* AP = (LAS float*)(L + OFF_AP); LAS float* VP = (LAS float*)(L + OFF_VP);
    LAS float* TOT = (LAS float*)(L + OFF_TOT); LAS float* GC = (LAS float*)(L + OFF_GC); LAS float* RN = (LAS float*)(L + OFF_RN);
    for (int item = first; item < NITEMS; item += stride) {
        const int bh = item / (SEQ / 64), chunk = item % (SEQ / 64), b = bh / 6, h = bh % 6;
        const int tok0 = b * SEQ + chunk * 64;
        unsigned short e_r[9], e_k[9], e_v[9], e_vf[8]; float e_mu_r, e_mu_k, e_mu_v, e_w0, e_a0, e_kk, e_ka, e_rk, e_v0;
        { RW_LANES(); const int hc = 64 * h + lane, tk0 = tok0 + 8 * w; const bool has_prev = (chunk * 64 + 8 * w) > 0;
#pragma unroll
          for (int j = 0; j < 9; ++j) { const size_t row = (size_t)(tk0 + j - 1) * LDP; const bool ok = j > 0 || has_prev;
              e_r[j] = ok ? P[row + 640 + hc] : (unsigned short)0; e_k[j] = ok ? P[row + 1024 + hc] : (unsigned short)0; e_v[j] = ok ? P[row + 1408 + hc] : (unsigned short)0; }
#pragma unroll
          for (int j = 0; j < 8; ++j) e_vf[j] = layer > 0 ? VFIRST[(size_t)(tk0 + j) * 384 + hc] : (unsigned short)0;
          e_mu_r = W.mu[hc]; e_mu_k = W.mu[384 + hc]; e_mu_v = W.mu[768 + hc]; e_w0 = W.w0[hc]; e_a0 = W.a0[hc]; e_kk = W.k_k[hc]; e_ka = W.k_a[hc]; e_rk = W.r_k[hc]; e_v0 = layer > 0 ? W.v0[hc] : 0.f; }
        for (int rp_ = 0; rp_ < ((PROF_PH) == 20 ? 2 : 1); ++rp_) {
        { RW_LANES(); const int t = tid >> 3, sub = tid & 7, tok = tok0 + t; const bool hp = (chunk * 64 + t) > 0;
          const bf16_t* rc = P + (size_t)tok * LDP; const bf16_t* rp = rc - LDP; const v4u z4 = {0u, 0u, 0u, 0u};
          const v4u lc = *(const GAS v4u*)(rc + 1792 + 8 * sub), lp = hp ? *(const GAS v4u*)(rp + 1792 + 8 * sub) : z4;
          const v4u kc4 = *(const GAS v4u*)(rc + 1024 + 64 * h + 8 * sub), kp4 = hp ? *(const GAS v4u*)(rp + 1024 + 64 * h + 8 * sub) : z4;
          v4u vc4 = z4, vp4 = z4; if (layer > 0 && sub < 2) { vc4 = *(const GAS v4u*)(rc + 2176 + 8 * sub); if (hp) vp4 = *(const GAS v4u*)(rp + 2176 + 8 * sub); }
          const unsigned lcw[4] = {lc.x, lc.y, lc.z, lc.w}, lpw[4] = {lp.x, lp.y, lp.z, lp.w}, kcw[4] = {kc4.x, kc4.y, kc4.z, kc4.w}, kpw[4] = {kp4.x, kp4.y, kp4.z, kp4.w}, vcw[4] = {vc4.x, vc4.y, vc4.z, vc4.w}, vpw[4] = {vp4.x, vp4.y, vp4.z, vp4.w};
          unsigned lo[4], vo[4]; float s = 0.f;
          const f32x4 mA0 = *(const GAS f32x4*)(W.mu + 1152 + 8 * sub), mA1 = *(const GAS f32x4*)(W.mu + 1156 + 8 * sub);
          const f32x4 mK0 = *(const GAS f32x4*)(W.mu + 384 + 64 * h + 8 * sub), mK1 = *(const GAS f32x4*)(W.mu + 388 + 64 * h + 8 * sub);
          const f32x4 kk0 = *(const GAS f32x4*)(W.k_k + 64 * h + 8 * sub), kk1 = *(const GAS f32x4*)(W.k_k + 64 * h + 8 * sub + 4);
          f32x4 mV0 = {0.f, 0.f, 0.f, 0.f}, mV1 = mV0; if (layer > 0 && sub < 2) { mV0 = *(const GAS f32x4*)(W.mu_v + 8 * sub); mV1 = *(const GAS f32x4*)(W.mu_v + 8 * sub + 4); }
#pragma unroll
          for (int e2 = 0; e2 < 4; ++e2) { float xl[2], xv[2];
#pragma unroll
              for (int u = 0; u < 2; ++u) { const int e = 2 * e2 + u; const int sh = 16 * u;
                  const float c1 = bf2f((bf16_t)((lcw[e2] >> sh) & 0xffff)), p1 = bf2f((bf16_t)((lpw[e2] >> sh) & 0xffff)); const float x = c1 + (e < 4 ? mA0[e & 3] : mA1[e & 3]) * (p1 - c1);
                  xl[u] = sub < 4 ? ftanh(x) : x;
                  const float c2 = bf2f((bf16_t)((kcw[e2] >> sh) & 0xffff)), p2 = bf2f((bf16_t)((kpw[e2] >> sh) & 0xffff));
                  const float kx = (c2 + (e < 4 ? mK0[e & 3] : mK1[e & 3]) * (p2 - c2)) * (e < 4 ? kk0[e & 3] : kk1[e & 3]); s += kx * kx;
                  const float c3 = bf2f((bf16_t)((vcw[e2] >> sh) & 0xffff)), p3 = bf2f((bf16_t)((vpw[e2] >> sh) & 0xffff)); xv[u] = c3 + (e < 4 ? mV0[e & 3] : mV1[e & 3]) * (p3 - c3); }
              lo[e2] = pk2(xl[0], xl[1]); vo[e2] = pk2(xv[0], xv[1]); }
          *(LAS v4u*)((sub < 4 ? TW : TA) + t * 40 + 8 * (sub & 3)) = (v4u){lo[0], lo[1], lo[2], lo[3]};
          if (layer > 0 && sub < 4) *(LAS v4u*)(TV + t * 40 + 8 * sub) = (v4u){vo[0], vo[1], vo[2], vo[3]};
          s += __shfl_xor(s, 1); s += __shfl_xor(s, 2); s += __shfl_xor(s, 4);
          if (sub == 0) RN[t] = 1.0f / fmaxf(sqrtf(s), 1e-12f); }
        RW_BAR();
        }
        { RW_LANES();
#pragma unroll
        for (int e = 0; e < 2; ++e) { const int tl = 2 * w + e, ti = tl >> 2, tj = tl & 3; const f32x4 z4 = {0.f, 0.f, 0.f, 0.f};
            const size_t brow = (size_t)(64 * h + 16 * tj + fr) * 32 + 8 * fq;
            { const bf16x8 a = *(const LAS bf16x8*)(TW + (16 * ti + fr) * 40 + 8 * fq); const bf16x8 bb = *(const GAS bf16x8*)(cb.W2T + brow);
              const f32x4 d = __builtin_amdgcn_mfma_f32_16x16x32_bf16(a, bb, z4, 0, 0, 0);
#pragma unroll
              for (int r = 0; r < 4; ++r) WP[(16 * ti + 4 * fq + r) * 65 + 16 * tj + fr] = d[r]; }
            { const bf16x8 a = *(const LAS bf16x8*)(TA + (16 * ti + fr) * 40 + 8 * fq); const bf16x8 bb = *(const GAS bf16x8*)(cb.A2T + brow);
              const f32x4 d = __builtin_amdgcn_mfma_f32_16x16x32_bf16(a, bb, z4, 0, 0, 0);
#pragma unroll
              for (int r = 0; r < 4; ++r) AP[(16 * ti + 4 * fq + r) * 65 + 16 * tj + fr] = d[r]; }
            if (layer > 0) { const bf16x8 a = *(const LAS bf16x8*)(TV + (16 * ti + fr) * 40 + 8 * fq); const bf16x8 bb = *(const GAS bf16x8*)(cb.V2T + brow);
              const f32x4 d = __builtin_amdgcn_mfma_f32_16x16x32_bf16(a, bb, z4, 0, 0, 0);
#pragma unroll
              for (int r = 0; r < 4; ++r) VP[(16 * ti + 4 * fq + r) * 65 + 16 * tj + fr] = d[r]; } } }
        RW_BAR();
        for (int rp_ = 0; rp_ < ((PROF_PH) == 21 ? 2 : 1); ++rp_) {
        { RW_LANES(); const int c = lane, hc = 64 * h + c, tq0 = 8 * w, tk0 = tok0 + tq0;
          const float mu_r = e_mu_r, mu_k = e_mu_k, mu_v = e_mu_v, w0 = e_w0, a0 = e_a0, k_k = e_kk, k_a = e_ka, r_k = e_rk, v0 = e_v0;
          float pr = bf2f(e_r[0]), pk = bf2f(e_k[0]), pv = bf2f(e_v[0]);
          float rr[8], kq[8], vv[8], kkc[8], bb[8], ld[8], pd[8];
#pragma unroll
          for (int j = 0; j < 8; ++j) { const int t = tq0 + j;
              const float cr = bf2f(e_r[j + 1]), ck = bf2f(e_k[j + 1]), cv = bf2f(e_v[j + 1]);
              const float r = cr + mu_r * (pr - cr), k = ck + mu_k * (pk - ck); float v = cv + mu_v * (pv - cv); pr = cr; pk = ck; pv = cv;
              const float wp = w0 + WP[t * 65 + c], ap = a0 + AP[t * 65 + c];
              const float z = -wp, sp = fmaxf(z, 0.f) + __logf(1.0f + __expf(-fabsf(z))); const float wl = -sp - 0.5f;
              const float al = fsigm(ap);
              if (layer > 0) { const float vp = v0 + VP[t * 65 + c]; const float vf = bf2f(e_vf[j]); v = v + (vf - v) * fsigm(vp); }
              const float kn = k * k_k * RN[t]; const float k2 = k * (1.0f + (al - 1.0f) * k_a);
              rr[j] = r; kq[j] = k2; vv[j] = v; kkc[j] = kn; bb[j] = kn * al; ld[j] = -fexp(wl); pd[j] = r * k2 * r_k; }
          {
#pragma unroll
            for (int j = 0; j < 8; j += 2) { const unsigned pv2 = pk2(vv[j], vv[j + 1]); cb.VOUT[(size_t)(tk0 + j) * 384 + hc] = (bf16_t)(pv2 & 0xffff); cb.VOUT[(size_t)(tk0 + j + 1) * 384 + hc] = (bf16_t)(pv2 >> 16); } }
          {
            const bool b5 = lane & 32, b4 = lane & 16, b3 = lane & 8; float s4[4], s2[2], s1;
#pragma unroll
            for (int i = 0; i < 4; ++i) { const float keep = b5 ? pd[i + 4] : pd[i], send = b5 ? pd[i] : pd[i + 4]; s4[i] = keep + __shfl_xor(send, 32); }
#pragma unroll
            for (int i = 0; i < 2; ++i) { const float keep = b4 ? s4[i + 2] : s4[i], send = b4 ? s4[i] : s4[i + 2]; s2[i] = keep + __shfl_xor(send, 16); }
            { const float keep = b3 ? s2[1] : s2[0], send = b3 ? s2[0] : s2[1]; s1 = keep + __shfl_xor(send, 8); }
            s1 += __shfl_xor(s1, 4); s1 += __shfl_xor(s1, 2); s1 += __shfl_xor(s1, 1);
            if ((lane & 7) == 0) cb.DOT[(size_t)(tk0 + (lane >> 3)) * 6 + h] = s1; }
          float cl[8]; cl[0] = ld[0];
#pragma unroll
          for (int j = 1; j < 8; ++j) cl[j] = cl[j - 1] + ld[j];
          TOT[w * 64 + c] = cl[7];
          RW_BAR();
          float prefix = 0.f, cumC = 0.f;
#pragma unroll
          for (int ww = 0; ww < 8; ++ww) { const float tv = TOT[ww * 64 + c]; cumC += tv; if (ww < w) prefix += tv; }
          const float gcc = fexp(cumC); if (w == 0) GC[c] = gcc;
          unsigned ahp[4], btp[4], ktp[4], vp4[4]; float gprev = fexp(prefix), ah_e = 0.f, bt_e = 0.f, kt_e = 0.f;
#pragma unroll
          for (int j = 0; j < 8; ++j) { const int t = tq0 + j; const float g = fexp(prefix + cl[j]), ig = __builtin_amdgcn_rcpf(g), gc = gcc * ig;
              const float ah = -kkc[j] * gprev, rh = rr[j] * g, bh = bb[j] * ig, kh = kq[j] * ig, bt = bb[j] * gc, kt = kq[j] * gc; gprev = g;
              const unsigned w01 = pk2(ah, rh), w23 = pk2(bh, kh);
              B0[t * LD + c] = (bf16_t)(w01 & 0xffff); B1[t * LD + c] = (bf16_t)(w01 >> 16); B2[t * LD + c] = (bf16_t)(w23 & 0xffff); B3[t * LD + c] = (bf16_t)(w23 >> 16);
              if (j & 1) { ahp[j >> 1] = pk2(ah_e, ah); btp[j >> 1] = pk2(bt_e, bt); ktp[j >> 1] = pk2(kt_e, kt); vp4[j >> 1] = pk2(vv[j - 1], vv[j]); }
              else { ah_e = ah; bt_e = bt; kt_e = kt; } }
          *(LAS v4u*)(B4 + c * LD + tq0) = (v4u){ahp[0], ahp[1], ahp[2], ahp[3]}; *(LAS v4u*)(B5 + c * LD + tq0) = (v4u){btp[0], btp[1], btp[2], btp[3]};
          *(LAS v4u*)(B6 + c * LD + tq0) = (v4u){ktp[0], ktp[1], ktp[2], ktp[3]}; *(LAS v4u*)(B7 + c * LD + tq0) = (v4u){vp4[0], vp4[1], vp4[2], vp4[3]}; }
        RW_BAR();
        }
        for (int rp_ = 0; rp_ < ((PROF_PH) == 22 ? 2 : 1); ++rp_) {
        { RW_LANES(); const int prod = w >> 1; const LAS bf16_t* Aop = prod < 2 ? B0 : B1; const LAS bf16_t* Bop = (prod & 1) ? B3 : B2;
#pragma unroll
          for (int e = 0; e < 8; ++e) { const int tl = (w & 1) * 8 + e, ti = tl >> 2, tj = tl & 3; f32x4 d = {0.f, 0.f, 0.f, 0.f};
              if (tj <= ti) d = mm_tile(Aop, Bop, ti, tj, fr, fq, d);
#pragma unroll
              for (int r = 0; r < 4; ++r) { const int t = 16 * ti + 4 * fq + r, i = 16 * tj + fr; const bool keep = prod < 2 ? (i < t) : (i <= t); const float val = (tj <= ti && keep) ? d[r] : 0.f;
                  if (prod == 0) F0[t * 65 + i] = val; else if (prod == 1) B8[t * LD + i] = f2bf(val); else if (prod == 2) B9[t * LD + i] = f2bf(val); else B10[t * LD + i] = f2bf(val); } } }
        RW_BAR();
        }
        if (w == 0) { RW_LANES();
            const int blk = lane >> 4, jc = lane & 15; const LAS float* Lb = F0 + (16 * blk) * 65 + 16 * blk; float tc[16];
#pragma unroll
            for (int r = 0; r < 16; ++r) { float val = (r == jc) ? 1.f : 0.f;
#pragma unroll
                for (int i = 0; i < r; ++i) val += Lb[r * 65 + i] * tc[i];
                tc[r] = val; }
            asm volatile("s_waitcnt lgkmcnt(0)" ::: "memory");
#pragma unroll
            for (int r = 0; r < 16; ++r) F0[(16 * blk + r) * 65 + 16 * blk + jc] = tc[r];
        }
        RW_BAR();
        if (w < 2) { RW_LANES();
            const int o1 = 32 * w, o2 = 32 * w + 16; f32x4 d = {0.f, 0.f, 0.f, 0.f};
#pragma unroll
            for (int ks = 0; ks < 4; ++ks) d = __builtin_amdgcn_mfma_f32_16x16x4f32(F0[(o2 + fr) * 65 + o1 + 4 * ks + fq], F0[(o1 + 4 * ks + fq) * 65 + o1 + fr], d, 0, 0, 0);
            LAS float* tm = TMP + w * 16 * 17;
#pragma unroll
            for (int r = 0; r < 4; ++r) tm[(4 * fq + r) * 17 + fr] = d[r];
            asm volatile("s_waitcnt lgkmcnt(0)" ::: "memory");
            f32x4 d2 = {0.f, 0.f, 0.f, 0.f};
#pragma unroll
            for (int ks = 0; ks < 4; ++ks) d2 = __builtin_amdgcn_mfma_f32_16x16x4f32(F0[(o2 + fr) * 65 + o2 + 4 * ks + fq], tm[(4 * ks + fq) * 17 + fr], d2, 0, 0, 0);
            asm volatile("s_waitcnt lgkmcnt(0)" ::: "memory");
#pragma unroll
            for (int r = 0; r < 4; ++r) F0[(o2 + 4 * fq + r) * 65 + o1 + fr] = d2[r];
        }
        RW_BAR();
        if (w < 4) { RW_LANES();
            const int ti = w >> 1, tj = w & 1; f32x4 d = {0.f, 0.f, 0.f, 0.f};
#pragma unroll
            for (int ks = 0; ks < 8; ++ks) d = __builtin_amdgcn_mfma_f32_16x16x4f32(F0[(32 + 16 * ti + fr) * 65 + 4 * ks + fq], F0[(4 * ks + fq) * 65 + 16 * tj + fr], d, 0, 0, 0);
#pragma unroll
            for (int r = 0; r < 4; ++r) TMP[(16 * ti + 4 * fq + r) * 33 + 16 * tj + fr] = d[r];
        }
        RW_BAR();
        if (w < 4) { RW_LANES();
            const int ti = w >> 1, tj = w & 1; f32x4 d = {0.f, 0.f, 0.f, 0.f};
#pragma unroll
            for (int ks = 0; ks < 8; ++ks) d = __builtin_amdgcn_mfma_f32_16x16x4f32(F0[(32 + 16 * ti + fr) * 65 + 32 + 4 * ks + fq], TMP[(4 * ks + fq) * 33 + 16 * tj + fr], d, 0, 0, 0);
#pragma unroll
            for (int r = 0; r < 4; ++r) F0[(32 + 16 * ti + 4 * fq + r) * 65 + 16 * tj + fr] = d[r];
        }
        RW_BAR();
        { RW_LANES(); const int t = tid >> 3, i0 = (tid & 7) * 8;
#pragma unroll
          for (int e = 0; e < 8; ++e) B11[t * LD + i0 + e] = f2bf(F0[t * 65 + i0 + e]); }
        RW_BAR();
        { RW_LANES();
#pragma unroll
        for (int e = 0; e < 4; ++e) { const int tl = 4 * w + e, prod = tl >> 4, ti = (tl >> 2) & 3, tj = tl & 3; f32x4 d = {0.f, 0.f, 0.f, 0.f};
            d = prod == 0 ? mm_tile(B11, B4, ti, tj, fr, fq, d) : mm_tile(B8, B7, ti, tj, fr, fq, d);
            LAS bf16_t* dst = (prod == 0 ? B0 : B2) + (16 * tj + fr) * LD + 16 * ti + 4 * fq;
            *(LAS unsigned long long*)dst = (unsigned long long)pk2(d[0], d[1]) | ((unsigned long long)pk2(d[2], d[3]) << 32); } }
        RW_BAR();
        { RW_LANES();
#pragma unroll
        for (int e = 0; e < 2; ++e) { const int tl = 2 * w + e, ti = tl >> 2, tj = tl & 3; f32x4 d = {0.f, 0.f, 0.f, 0.f};
            d = mm_tile(B11, B2, ti, tj, fr, fq, d);
            LAS bf16_t* dst = B3 + (16 * tj + fr) * LD + 16 * ti + 4 * fq;
            *(LAS unsigned long long*)dst = (unsigned long long)pk2(d[0], d[1]) | ((unsigned long long)pk2(d[2], d[3]) << 32); } }
        RW_BAR();
        for (int rp_ = 0; rp_ < ((PROF_PH) == 23 ? 2 : 1); ++rp_) {
        { RW_LANES();
#pragma unroll
        for (int e = 0; e < 8; ++e) { const int tl = 8 * w + e, prod = tl >> 4, ti = (tl >> 2) & 3, tj = tl & 3; f32x4 d = {0.f, 0.f, 0.f, 0.f};
            if (prod == 0) { d = mm_tile(B5, B3, ti, tj, fr, fq, d); d = mm_tile(B6, B7, ti, tj, fr, fq, d);
                *(GAS f32x4*)(cb.Z + (size_t)item * 4096 + (16 * tj + fr) * 64 + 4 * ((4 * ti + fq) ^ fr)) = d; }
            else if (prod == 1) { d = mm_tile(B9, B3, ti, tj, fr, fq, d); d = mm_tile(B10, B7, ti, tj, fr, fq, d);
                *(GAS f32x4*)(cb.YV + (size_t)item * 4096 + (16 * tj + fr) * 64 + 16 * ti + 4 * fq) = d; }
            else if (prod == 2) { d = mm_tile(B9, B0, ti, tj, fr, fq, d);
#pragma unroll
                for (int r = 0; r < 4; ++r) { const int t = 16 * ti + 4 * fq + r, c = 16 * tj + fr; B4[t * LD + sigpos(c)] = f2bf(d[r] + bf2f(B1[t * LD + c])); } }
            else { d = mm_tile(B5, B0, ti, tj, fr, fq, d);
#pragma unroll
                for (int r = 0; r < 4; ++r) { const int c = 16 * ti + 4 * fq + r, c2 = 16 * tj + fr; B8[c * LD + sigpos(c2)] = f2bf(d[r] + (c == c2 ? GC[c] : 0.f)); } } } }
        RW_BAR();
        }
        { RW_LANES(); const int r = tid >> 3, ch = (tid & 7) * 8;
          *(GAS v4u*)(cb.G + (size_t)item * 4096 + r * 64 + ch) = *(const LAS v4u*)(B4 + r * LD + ch);
          *(GAS v4u*)(cb.PT + (size_t)item * 4096 + r * 64 + 8 * ((tid & 7) ^ (r & 7))) = *(const LAS v4u*)(B8 + r * LD + ch); }
        RW_BAR();
    }
}
constexpr int SC_NS = 10, SC_SLOT = 12288, SC_LAG = 6;
__device__ __forceinline__ void scan_compute(LAS unsigned char* L, const ChunkBufs cb, int bh, int tj, int lane, volatile LAS unsigned* flags) {
    const int fr = lane & 15, fq = lane >> 4; const int NC = SEQ / 64;
    bf16x8 Bf0 = {0, 0, 0, 0, 0, 0, 0, 0}, Bf1 = {0, 0, 0, 0, 0, 0, 0, 0};
    bf16_t* s0 = cb.S0 + (size_t)(bh * NC) * 4096 + (16 * tj + fr) * 64 + 8 * fq;
    const int po0 = fr * 128 + 16 * ((fq) ^ (fr & 7)), po1 = fr * 128 + 16 * ((4 + fq) ^ (fr & 7));
    int slot = 0;
    for (int chunk = 0; chunk < NC; ++chunk) {
        unsigned spins = 0;
        while (true) { const unsigned a = flags[0], b = flags[1], c = flags[2]; const unsigned m = a < b ? (a < c ? a : c) : (b < c ? b : c); if ((int)m >= chunk + 1 || ++spins > (1u << 22)) break; __builtin_amdgcn_s_sleep(1); }
        const LAS unsigned char* sp = L + slot * SC_SLOT;
        bf16x8 a0[4], a1[4]; f32x4 z[4];
#pragma unroll
        for (int ti = 0; ti < 4; ++ti) { a0[ti] = *(const LAS bf16x8*)(sp + ti * 2048 + po0); a1[ti] = *(const LAS bf16x8*)(sp + ti * 2048 + po1); z[ti] = *(const LAS f32x4*)(sp + 8192 + fr * 256 + 16 * ((4 * ti + fq) ^ fr)); }
        asm volatile("s_waitcnt lgkmcnt(0)" ::: "memory");
        if (lane == 0) flags[3] = (unsigned)(chunk + 1);
        *(GAS bf16x8*)(s0 + (size_t)chunk * 4096) = Bf0; *(GAS bf16x8*)(s0 + (size_t)chunk * 4096 + 32) = Bf1;
        f32x4 acc[4];
#pragma unroll
        for (int ti = 0; ti < 4; ++ti) { acc[ti] = __builtin_amdgcn_mfma_f32_16x16x32_bf16(a0[ti], Bf0, z[ti], 0, 0, 0); acc[ti] = __builtin_amdgcn_mfma_f32_16x16x32_bf16(a1[ti], Bf1, acc[ti], 0, 0, 0); }
        v4u m0, m1;
        m0.x = pk2(acc[0][0], acc[0][1]); m0.y = pk2(acc[0][2], acc[0][3]); m0.z = pk2(acc[1][0], acc[1][1]); m0.w = pk2(acc[1][2], acc[1][3]);
        m1.x = pk2(acc[2][0], acc[2][1]); m1.y = pk2(acc[2][2], acc[2][3]); m1.z = pk2(acc[3][0], acc[3][1]); m1.w = pk2(acc[3][2], acc[3][3]);
        Bf0 = __builtin_bit_cast(bf16x8, m0); Bf1 = __builtin_bit_cast(bf16x8, m1);
        slot = slot + 1 == SC_NS ? 0 : slot + 1;
    }
}
__device__ __forceinline__ void scan_loader(LAS unsigned char* L, const ChunkBufs cb, int bh, int tj, int lw, int lane, volatile LAS unsigned* flags) {
    const int NC = SEQ / 64;
    const char* src[4];
#pragma unroll
    for (int k = 0; k < 4; ++k) { const int pc = 4 * lw + k;
        src[k] = pc < 8 ? (const char*)(cb.PT + (size_t)(bh * NC) * 4096) + pc * 1024 + lane * 16 : (const char*)(cb.Z + (size_t)(bh * NC) * 4096) + tj * 4096 + (pc - 8) * 1024 + lane * 16; }
    const size_t st0 = 8192, st1 = 16384;
    int slot = 0;
    for (int c = 0; c < NC; ++c) {
        unsigned spins = 0;
        while ((int)flags[3] < c - SC_NS + 1 && ++spins < (1u << 22)) __builtin_amdgcn_s_sleep(1);
        const unsigned dst = (unsigned)(slot * SC_SLOT + 4 * lw * 1024);
#pragma unroll
        for (int k = 0; k < 4; ++k) { const int pc = 4 * lw + k;
            __builtin_amdgcn_global_load_lds((const unsigned*)(src[k] + (size_t)c * (pc < 8 ? st0 : st1)), (LAS unsigned*)(L + dst + k * 1024), 16, 0, 0); }
        if (c >= SC_LAG) { asm volatile("s_waitcnt vmcnt(24)" ::: "memory"); if (lane == 0) flags[lw] = (unsigned)(c - SC_LAG + 1); }
        slot = slot + 1 == SC_NS ? 0 : slot + 1;
    }
    asm volatile("s_waitcnt vmcnt(0)" ::: "memory");
    if (lane == 0) flags[lw] = (unsigned)NC;
}
constexpr int O_SG = 0  , O_Y = 9216  , O_GT = O_Y + 16640  ;
__device__ __forceinline__ void out_phase(LAS unsigned char* L, const bf16_t* P, const sk::RwkvW W, const ChunkBufs cb, bf16_t* MIX, int tid_in, int first, int stride) {
    const int w = __builtin_amdgcn_readfirstlane(tid_in >> 6);
    LAS bf16_t* SG = (LAS bf16_t*)(L + O_SG); LAS float* Y = (LAS float*)(L + O_Y); LAS float* GT = (LAS float*)(L + O_GT);
    for (int item = first; item < NITEMS; item += stride) {
        const int bh = item / (SEQ / 64), chunk = item % (SEQ / 64), b = bh / 6, h = bh % 6; const int tok0 = b * SEQ + chunk * 64; const size_t ib = (size_t)item * 4096;
        { RW_LANES(); const int t = tid >> 3, sub = tid & 7, tok = tok0 + t; const bool hp = (chunk * 64 + t) > 0;
          const bf16_t* rc = P + (size_t)tok * LDP + 1856 + 8 * sub; const v4u z4 = {0u, 0u, 0u, 0u};
          const v4u gc4 = *(const GAS v4u*)rc, gp4 = hp ? *(const GAS v4u*)(rc - LDP) : z4;
          const f32x4 m0 = *(const GAS f32x4*)(W.mu + 1216 + 8 * sub), m1 = *(const GAS f32x4*)(W.mu + 1220 + 8 * sub);
          const unsigned cw_[4] = {gc4.x, gc4.y, gc4.z, gc4.w}, pw_[4] = {gp4.x, gp4.y, gp4.z, gp4.w}; unsigned o[4];
#pragma unroll
          for (int e2 = 0; e2 < 4; ++e2) { float x[2];
#pragma unroll
              for (int u = 0; u < 2; ++u) { const int e = 2 * e2 + u; const float c1 = bf2f((bf16_t)((cw_[e2] >> (16 * u)) & 0xffff)), p1 = bf2f((bf16_t)((pw_[e2] >> (16 * u)) & 0xffff));
                  x[u] = fsigm(c1 + (e < 4 ? m0[e & 3] : m1[e & 3]) * (p1 - c1)); }
              o[e2] = pk2(x[0], x[1]); }
          *(LAS v4u*)(SG + t * LD + 8 * sub) = (v4u){o[0], o[1], o[2], o[3]}; }
        RW_BAR();
        { RW_LANES();
#pragma unroll
        for (int e = 0; e < 2; ++e) { const int tl = 2 * w + e, ti = tl >> 2, tj = tl & 3;
            f32x4 d = *(const GAS f32x4*)(cb.YV + ib + (16 * tj + fr) * 64 + 16 * ti + 4 * fq); f32x4 g = {0.f, 0.f, 0.f, 0.f};
#pragma unroll
            for (int kk = 0; kk < 2; ++kk) {
                const bf16x8 a = *(const GAS bf16x8*)(cb.G + ib + (16 * ti + fr) * 64 + 32 * kk + 8 * fq), bb = *(const GAS bf16x8*)(cb.S0 + ib + (16 * tj + fr) * 64 + 32 * kk + 8 * fq);
                d = __builtin_amdgcn_mfma_f32_16x16x32_bf16(a, bb, d, 0, 0, 0);
                const bf16x8 a2 = *(const LAS bf16x8*)(SG + (16 * ti + fr) * LD + 32 * kk + 8 * fq), b2 = *(const GAS bf16x8*)(cb.G2T + (size_t)(64 * h + 16 * tj + fr) * 64 + 32 * kk + 8 * fq);
                g = __builtin_amdgcn_mfma_f32_16x16x32_bf16(a2, b2, g, 0, 0, 0); }
#pragma unroll
            for (int r = 0; r < 4; ++r) { Y[(16 * ti + 4 * fq + r) * 65 + 16 * tj + fr] = d[r]; GT[(16 * ti + 4 * fq + r) * 65 + 16 * tj + fr] = g[r]; } } }
        RW_BAR();
        { RW_LANES(); const int t = tid >> 3, sub = tid & 7, tok = tok0 + t; float yv[8], s = 0.f;
#pragma unroll
          for (int e = 0; e < 8; ++e) { yv[e] = bf2f(f2bf(Y[t * 65 + 8 * sub + e])); s += yv[e]; }
          s += __shfl_xor(s, 1); s += __shfl_xor(s, 2); s += __shfl_xor(s, 4);
          const float mean = s * (1.0f / 64.0f); float q = 0.f;
#pragma unroll
          for (int e = 0; e < 8; ++e) { const float dd = yv[e] - mean; q += dd * dd; }
          q += __shfl_xor(q, 1); q += __shfl_xor(q, 2); q += __shfl_xor(q, 4);
          const float rstd = 1.0f / sqrtf(q * (1.0f / 64.0f) + GN_EPS), dot = cb.DOT[(size_t)tok * 6 + h];
          unsigned o[4];
#pragma unroll
          for (int e = 0; e < 8; e += 2) { float r2[2];
#pragma unroll
              for (int u = 0; u < 2; ++u) { const int v = 8 * sub + e + u, hc = 64 * h + v; const float yn = (yv[e + u] - mean) * rstd * W.ln_w[hc] + W.ln_b[hc];
                  r2[u] = (yn + dot * bf2f(cb.VOUT[(size_t)tok * 384 + hc])) * GT[t * 65 + v]; }
              o[e >> 1] = pk2(r2[0], r2[1]); }
          *(GAS v4u*)(MIX + (size_t)tok * DM + 384 + 64 * h + 8 * sub) = (v4u){o[0], o[1], o[2], o[3]}; }
        RW_BAR();
    }
}
}
namespace at {
constexpr int LDK = 72, LDV = 264;
constexpr int A_K = 0, A_V = 256 * LDK * 2  , A_BIAS = A_V + 64 * LDV * 2  , A_END = A_BIAS + 128 * 6 * 4;
__device__ __forceinline__ int vpos(int key) { return (key & ~31) + 8 * ((key >> 2) & 3) + 4 * ((key >> 4) & 1) + (key & 3); }
__device__ __forceinline__ unsigned pk2(float lo, float hi) { typedef float f2_t __attribute__((ext_vector_type(2))); typedef __bf16 b2_t __attribute__((ext_vector_type(2))); f2_t v = {lo, hi}; return __builtin_bit_cast(unsigned, __builtin_convertvector(v, b2_t)); }
#define AT_BAR() do { asm volatile("s_waitcnt vmcnt(0) lgkmcnt(0)" ::: "memory"); __builtin_amdgcn_s_barrier(); asm volatile("" ::: "memory"); } while (0)

__device__ __forceinline__ void stage_kv(LAS unsigned char* L, int tid, const bf16_t* kbase, const bf16_t* vbase, long pitch, int jvalid0, const float* gk) {
    LAS bf16_t* Kl = (LAS bf16_t*)(L + A_K); LAS bf16_t* VTl = (LAS bf16_t*)(L + A_V);
#pragma unroll
    for (int it = 0; it < 4; ++it) { const int idx = it * 512 + tid, key = idx >> 3, ch = idx & 7;
        v4u raw = {0u, 0u, 0u, 0u}; if (key >= jvalid0) raw = *(const GAS v4u*)(kbase + (long)key * pitch + 8 * ch);
        float f[8]; f[0] = bf2f((bf16_t)(raw.x & 0xffff)); f[1] = bf2f((bf16_t)(raw.x >> 16)); f[2] = bf2f((bf16_t)(raw.y & 0xffff)); f[3] = bf2f((bf16_t)(raw.y >> 16));
        f[4] = bf2f((bf16_t)(raw.z & 0xffff)); f[5] = bf2f((bf16_t)(raw.z >> 16)); f[6] = bf2f((bf16_t)(raw.w & 0xffff)); f[7] = bf2f((bf16_t)(raw.w >> 16));
        float ss = 0.f;
#pragma unroll
        for (int e = 0; e < 8; ++e) ss += f[e] * f[e];
        ss += __shfl_xor(ss, 1); ss += __shfl_xor(ss, 2); ss += __shfl_xor(ss, 4);
        const float rs = 1.0f / sqrtf(ss * (1.0f / 64.0f) + EPS);
        const f32x4 g0 = *(const GAS f32x4*)(gk + 8 * ch), g1 = *(const GAS f32x4*)(gk + 8 * ch + 4);
        v4u o; o.x = pk2(f[0] * rs * g0[0], f[1] * rs * g0[1]); o.y = pk2(f[2] * rs * g0[2], f[3] * rs * g0[3]); o.z = pk2(f[4] * rs * g1[0], f[5] * rs * g1[1]); o.w = pk2(f[6] * rs * g1[2], f[7] * rs * g1[3]);
        *(LAS v4u*)(Kl + key * LDK + 8 * ch) = o; }
#pragma unroll
    for (int it = 0; it < 4; ++it) { const int idx = it * 512 + tid, key = idx & 255, ch = idx >> 8;
        v4u raw = {0u, 0u, 0u, 0u}; if (key >= jvalid0) raw = *(const GAS v4u*)(vbase + (long)key * pitch + 8 * ch);
        LAS bf16_t* d = VTl + (8 * ch) * LDV + vpos(key);
        d[0 * LDV] = (bf16_t)(raw.x & 0xffff); d[1 * LDV] = (bf16_t)(raw.x >> 16); d[2 * LDV] = (bf16_t)(raw.y & 0xffff); d[3 * LDV] = (bf16_t)(raw.y >> 16);
        d[4 * LDV] = (bf16_t)(raw.z & 0xffff); d[5 * LDV] = (bf16_t)(raw.z >> 16); d[6 * LDV] = (bf16_t)(raw.w & 0xffff); d[7 * LDV] = (bf16_t)(raw.w >> 16); }
}
__device__ __forceinline__ void load_q(const bf16_t* qrow, const float* gq, int fq, bf16x8& q0, bf16x8& q1) {
    const v4u r0 = *(const GAS v4u*)(qrow + 8 * fq), r1 = *(const GAS v4u*)(qrow + 32 + 8 * fq);
    float f[16]; const unsigned w[8] = {r0.x, r0.y, r0.z, r0.w, r1.x, r1.y, r1.z, r1.w};
#pragma unroll
    for (int e = 0; e < 8; ++e) { f[2 * e] = bf2f((bf16_t)(w[e] & 0xffff)); f[2 * e + 1] = bf2f((bf16_t)(w[e] >> 16)); }
    float ss = 0.f;
#pragma unroll
    for (int e = 0; e < 16; ++e) ss += f[e] * f[e];
    ss += __shfl_xor(ss, 16); ss += __shfl_xor(ss, 32);
    const float rs = 0.125f / sqrtf(ss * (1.0f / 64.0f) + EPS);
    const f32x4 g0 = *(const GAS f32x4*)(gq + 8 * fq), g1 = *(const GAS f32x4*)(gq + 8 * fq + 4), g2 = *(const GAS f32x4*)(gq + 32 + 8 * fq), g3 = *(const GAS f32x4*)(gq + 36 + 8 * fq);
    v4u a, b;
    a.x = pk2(f[0] * rs * g0[0], f[1] * rs * g0[1]); a.y = pk2(f[2] * rs * g0[2], f[3] * rs * g0[3]); a.z = pk2(f[4] * rs * g1[0], f[5] * rs * g1[1]); a.w = pk2(f[6] * rs * g1[2], f[7] * rs * g1[3]);
    b.x = pk2(f[8] * rs * g2[0], f[9] * rs * g2[1]); b.y = pk2(f[10] * rs * g2[2], f[11] * rs * g2[3]); b.z = pk2(f[12] * rs * g3[0], f[13] * rs * g3[1]); b.w = pk2(f[14] * rs * g3[2], f[15] * rs * g3[3]);
    q0 = __builtin_bit_cast(bf16x8, a); q1 = __builtin_bit_cast(bf16x8, b);
}
template <int NT, bool SWA> __device__ __forceinline__ void attn_wave(const LAS unsigned char* L, bf16x8 q0, bf16x8 q1, int kt0, int qi0, int hq, float sink, bool first_block, bf16_t* outp, int fr, int fq) {
    const LAS bf16_t* Kl = (const LAS bf16_t*)(L + A_K); const LAS bf16_t* VTl = (const LAS bf16_t*)(L + A_V); const LAS float* bias = (const LAS float*)(L + A_BIAS);
    f32x4 s[NT];
#pragma unroll
    for (int t = 0; t < NT; ++t) { const LAS bf16_t* kr = Kl + (16 * (kt0 + t) + fr) * LDK + 8 * fq;
        const f32x4 z = {0.f, 0.f, 0.f, 0.f};
        s[t] = __builtin_amdgcn_mfma_f32_16x16x32_bf16(*(const LAS bf16x8*)kr, q0, z, 0, 0, 0);
        s[t] = __builtin_amdgcn_mfma_f32_16x16x32_bf16(*(const LAS bf16x8*)(kr + 32), q1, s[t], 0, 0, 0);
        if (t & 1) __builtin_amdgcn_sched_barrier(0); }
    float mx = SWA ? sink : -3.0e38f;
#pragma unroll
    for (int t = 0; t < NT; ++t)
#pragma unroll
        for (int r = 0; r < 4; ++r) {
            if (SWA) { const int kj = 16 * (kt0 + t) + 4 * fq + r, dist = qi0 + fr + 128 - kj; const bool valid = dist >= 0 && dist < 128 && !(first_block && kj < 128);
                s[t][r] = valid ? s[t][r] + bias[(valid ? dist : 0) * 6 + hq] : -3.0e38f; }
            mx = fmaxf(mx, s[t][r]); }
    mx = fmaxf(mx, __shfl_xor(mx, 16)); mx = fmaxf(mx, __shfl_xor(mx, 32));
    float l = 0.f;
#pragma unroll
    for (int t = 0; t < NT; ++t)
#pragma unroll
        for (int r = 0; r < 4; ++r) { const float p = __expf(s[t][r] - mx); s[t][r] = p; l += p; }
    l += __shfl_xor(l, 16); l += __shfl_xor(l, 32);
    if (SWA) l += __expf(sink - mx);
    f32x4 o[4];
#pragma unroll
    for (int dt = 0; dt < 4; ++dt) o[dt] = (f32x4){0.f, 0.f, 0.f, 0.f};
#pragma unroll
    for (int ks = 0; ks < NT / 2; ++ks) { v4u pw; pw.x = pk2(s[2 * ks][0], s[2 * ks][1]); pw.y = pk2(s[2 * ks][2], s[2 * ks][3]); pw.z = pk2(s[2 * ks + 1][0], s[2 * ks + 1][1]); pw.w = pk2(s[2 * ks + 1][2], s[2 * ks + 1][3]);
        const bf16x8 pb = __builtin_bit_cast(bf16x8, pw);
#pragma unroll
        for (int dt = 0; dt < 4; ++dt) o[dt] = __builtin_amdgcn_mfma_f32_16x16x32_bf16(*(const LAS bf16x8*)(VTl + (16 * dt + fr) * LDV + 32 * (kt0 / 2 + ks) + 8 * fq), pb, o[dt], 0, 0, 0);
        __builtin_amdgcn_sched_barrier(0); }
    const float inv = 1.0f / l;
#pragma unroll
    for (int dt = 0; dt < 4; ++dt) *(GAS unsigned long long*)(outp + (long)fr * DM + 16 * dt + 4 * fq) = (unsigned long long)pk2(o[dt][0] * inv, o[dt][1] * inv) | ((unsigned long long)pk2(o[dt][2] * inv, o[dt][3] * inv) << 32);
}
struct AttnArgs { const bf16_t* PROJ; const bf16_t* MKV; bf16_t* MIX; const float* biastab; const float *sinks, *gq, *gk, *gmq, *gmk; };
__device__ __forceinline__ void attn_item(LAS unsigned char* L, const AttnArgs A, int item, int tid_in) {
    const int w = __builtin_amdgcn_readfirstlane(tid_in >> 6);
    if (item < 256) {
        const int b = item >> 7, hkv = (item >> 6) & 1, blk = item & 63; const long tokb = (long)b * SEQ + blk * 128;
        { int lt_ = tid_in; asm volatile("" : "+v"(lt_)); const int tid = lt_;
          stage_kv(L, tid, A.PROJ + (tokb - 128) * LDP + 384 + 64 * hkv, A.PROJ + (tokb - 128) * LDP + 512 + 64 * hkv, LDP, blk == 0 ? 128 : 0, A.gk);
          LAS float* bl = (LAS float*)(L + A_BIAS); for (int i = tid; i < 768; i += 512) bl[i] = A.biastab[i]; }
        AT_BAR();
        { int lt_ = tid_in; asm volatile("" : "+v"(lt_)); const int lane = lt_ & 63, fr = lane & 15, fq = lane >> 4;
#pragma unroll 1
          for (int g = 0; g < 3; ++g) { const int hq = 3 * hkv + g; bf16x8 q0, q1;
              load_q(A.PROJ + (tokb + 16 * w + fr) * LDP + 64 * hq, A.gq, fq, q0, q1);
              attn_wave<10, true>(L, q0, q1, w & ~1, 16 * w, hq, A.sinks[hq], blk == 0, A.MIX + (tokb + 16 * w) * DM + 64 * hq, fr, fq); } }
        AT_BAR();
    } else {
        const int pr = item - 256, b = pr >> 7, h = (pr >> 5) & 3, blk2 = pr & 31;
        { int lt_ = tid_in; asm volatile("" : "+v"(lt_)); const int tid = lt_;
          stage_kv(L, tid, A.MKV + (long)(b * 256) * 512 + 64 * h, A.MKV + (long)(b * 256) * 512 + 256 + 64 * h, 512, 0, A.gmk); }
        AT_BAR();
        { int lt_ = tid_in; asm volatile("" : "+v"(lt_)); const int lane = lt_ & 63, fr = lane & 15, fq = lane >> 4;
#pragma unroll 1
          for (int u = 0; u < 2; ++u) { const long tokb = (long)b * SEQ + (2 * blk2 + u) * 128; bf16x8 q0, q1;
              load_q(A.PROJ + (tokb + 16 * w + fr) * LDP + 1920 + 64 * h, A.gmq, fq, q0, q1);
              attn_wave<16, false>(L, q0, q1, 0, 16 * w, 0, 0.f, false, A.MIX + (tokb + 16 * w) * DM + 768 + 64 * h, fr, fq); } }
        AT_BAR();
    }
}
}
constexpr int NWAVES = 8;
namespace mk {
constexpr size_t WS_CTL = 0, CTL_ZERO_BYTES = 1 * MiB;
constexpr size_t CTL_SSQ = 512 * 1024;
constexpr size_t WS_SMALL = 1 * MiB, SM_BIAS = 0, SM_SSQM = 4096, SM_MKV = 512 * 1024;
constexpr size_t WS_MEMB = 2 * MiB, WS_WT = 3 * MiB, WS_XB = 28 * MiB, WS_VF = 60 * MiB, WS_PROJ = 72 * MiB, WS_MIX = 144 * MiB, WS_PREP = 176 * MiB, WS_U = 72 * MiB, WS_ACT = 160 * MiB, WS_WIN1 = 248 * MiB  , WS_END = 254 * MiB;
constexpr size_t WT_IN = 0, WT_OUT = 4718592, WT_UP = WT_OUT + 2 * MiB, WT_DOWN = WT_UP + 11 * MiB, WT_MKV = WT_DOWN + 5767168;
constexpr int CW_TMO = 0, CW_BAR = 4096, CW_ATTQ = 8192;
constexpr int LDS_BYTES = 163840, LDSCTL_OFF = LDS_BYTES - 512, MISC_OFF = LDSCTL_OFF + 320;
constexpr size_t SM_W2T = 8192, SM_A2T = 32768, SM_V2T = 57344, SM_G2T = 81920, SM_LORA_L = 122880;
constexpr size_t WS_PT = 176 * MiB, WS_G = 188 * MiB, WS_S0 = 200 * MiB, WS_Z = 212 * MiB, WS_V1 = 236 * MiB, WS_YV = 28 * MiB  , WS_DOT = 52 * MiB;
#ifndef PROF_PH
#define PROF_PH -1
#endif
#ifndef PROF_N
#define PROF_N 1
#endif
#ifndef PROF_TA
#define PROF_TA -1
#endif
#ifndef PROF_TB
#define PROF_TB -1
#endif
#define REPEAT(k) for (int rep_ = 0; rep_ < ((PROF_PH) == (k) ? (PROF_N) : 1); ++rep_)
#ifndef FAST_RWKV
#define FAST_RWKV 1
#endif
#ifndef FAST_ATTN
#define FAST_ATTN 1
#endif

struct Args { const float* in[N_IN]; float* out; unsigned char* ws; int ph_lo, ph_hi; };

__device__ __forceinline__ unsigned pk2(float lo, float hi) { typedef float f2_t __attribute__((ext_vector_type(2))); typedef __bf16 b2_t __attribute__((ext_vector_type(2))); f2_t v = {lo, hi}; return __builtin_bit_cast(unsigned, __builtin_convertvector(v, b2_t)); }
__device__ __forceinline__ float wave_sum(float v) {
#pragma unroll
    for (int o = 1; o < 64; o <<= 1) v += __shfl_xor(v, o);
    return v;
}
template <bool UPPERM> __device__ __forceinline__ void transpose_item(const float* W, const float* g, int K, int N, bf16_t* WT, LAS float* scr, int item, int lane) {
    const int nblk = N / 32, kb = item / nblk, nb = item % nblk, k0 = 64 * kb, n0 = 32 * nb;
    float tv[32];
#pragma unroll
    for (int i = 0; i < 32; ++i) tv[i] = W[(size_t)(k0 + 2 * i + (lane >> 5)) * N + n0 + (lane & 31)];
#pragma unroll
    for (int i = 0; i < 32; ++i) { const int kk = 2 * i + (lane >> 5); float v = tv[i]; if (g) v *= g[k0 + kk]; scr[kk * 33 + (lane & 31)] = v; }
    LDS_WAIT(); asm volatile("" ::: "memory");
    const int c = lane & 7;
#pragma unroll
    for (int j = 0; j < 4; ++j) { const int n = (lane >> 3) + 8 * j; const LAS float* s = scr + (8 * c) * 33 + n;
        v4u o; o.x = pk2(s[0 * 33], s[1 * 33]); o.y = pk2(s[2 * 33], s[3 * 33]); o.z = pk2(s[4 * 33], s[5 * 33]); o.w = pk2(s[6 * 33], s[7 * 33]);
        int nr = n0 + n; if (UPPERM) nr = nr < 2816 ? 256 * (nr >> 7) + (nr & 127) : 256 * ((nr - 2816) >> 7) + 128 + ((nr - 2816) & 127);
        *(GAS v4u*)(WT + (size_t)nr * K + k0 + 8 * c) = o; }
    LDS_WAIT(); asm volatile("" ::: "memory");
}
__device__ __forceinline__ void row_to_bf16(const float* xrow, bf16_t* orow, float* ssq_out, int lane) {
    const GAS f32x4* xr = (const GAS f32x4*)xrow + lane; f32x4 v[4]; float s = 0.f;
#pragma unroll
    for (int j = 0; j < 4; ++j) { v[j] = xr[64 * j]; s += (v[j].x * v[j].x + v[j].y * v[j].y) + (v[j].z * v[j].z + v[j].w * v[j].w); }
    s = wave_sum(s);
    GAS unsigned long long* o8 = (GAS unsigned long long*)orow + lane;
#pragma unroll
    for (int j = 0; j < 4; ++j) o8[64 * j] = (unsigned long long)pk2(v[j].x, v[j].y) | ((unsigned long long)pk2(v[j].z, v[j].w) << 32);
    if (lane == 0) *ssq_out = s;
}

__global__ void __launch_bounds__(NWAVES * 64, 2) mk_fwd(Args args) {
    extern __shared__ __attribute__((aligned(16))) unsigned char lds[];
    LAS unsigned char* L = (LAS unsigned char*)lds;
    volatile LAS unsigned* MISC = (volatile LAS unsigned*)(L + MISC_OFF);
    const int tid0 = threadIdx.x; const int wave0 = __builtin_amdgcn_readfirstlane(tid0 >> 6);
    const int G = gridDim.x;
    unsigned char* ws = args.ws;
    gu32* ctl = (gu32*)(ws + WS_CTL);
    for (int u = tid0; u < (LDS_BYTES - LDSCTL_OFF) / 4; u += NWAVES * 64) ((LAS unsigned*)(L + LDSCTL_OFF))[u] = 0u;
    __syncthreads();
    XcdBarrier bar = xcd_barrier_post((unsigned*)(ctl + CW_BAR), MISC + 8);
    const int lo = args.ph_lo, hi = args.ph_hi;
    int ph = 0;
#define PH_BEGIN if (lo <= ph && ph < hi) { if ((PROF_TA) >= 0 && blockIdx.x == 0 && tid0 == 0) MISC[24 + ph] = (unsigned)__builtin_amdgcn_s_memrealtime(); unsigned char* wsp = args.ws; asm volatile("" : "+s"(wsp)); int tid = wave0 * 64 + (int)__builtin_amdgcn_mbcnt_hi(~0u, __builtin_amdgcn_mbcnt_lo(~0u, 0u)); asm volatile("" : "+v"(tid)); const int lane = tid & 63, wave = __builtin_amdgcn_readfirstlane(tid >> 6); const long gtid = (long)blockIdx.x * (NWAVES * 64) + tid; const int gw = blockIdx.x * NWAVES + wave; LAS float* scr = (LAS float*)(L + wave * 16384); (void)lane; (void)gtid; (void)gw; (void)scr;
#define PH_END   if (ph + 1 < hi) { xcd_barrier(bar); if ((PROF_PH) == 30 && ph == 3) for (int xb_ = 0; xb_ < 10; ++xb_) xcd_barrier(bar); } } ++ph;
    float* out = args.out;
#define SSQ_A ((float*)(wsp + WS_CTL + CTL_SSQ))
#define SSQ_B (SSQ_A + 3 * MTOK)
#define biastab ((float*)(wsp + WS_SMALL + SM_BIAS))
#define ssqm ((float*)(wsp + WS_SMALL + SM_SSQM))
#define MKV ((bf16_t*)(wsp + WS_SMALL + SM_MKV))
#define MEMB ((bf16_t*)(wsp + WS_MEMB))
#define Wt_in ((bf16_t*)(wsp + (l == 0 ? WS_WT + WT_IN : WS_WIN1)))
#define Wt_out ((bf16_t*)(wsp + WS_WT + WT_OUT))
#define Wt_up ((bf16_t*)(wsp + WS_WT + WT_UP))
#define Wt_down ((bf16_t*)(wsp + WS_WT + WT_DOWN))
#define Wt_mkv ((bf16_t*)(wsp + (l == 0 ? WS_WT + WT_MKV : WS_WIN1 + 4718592)))
#define XB ((bf16_t*)(wsp + WS_XB))
#define VF ((bf16_t*)(wsp + WS_VF))
#define PROJ ((bf16_t*)(wsp + WS_PROJ))
#define MIX ((bf16_t*)(wsp + WS_MIX))
#define U ((bf16_t*)(wsp + WS_U))
#define ACT ((bf16_t*)(wsp + WS_ACT))
#define PA ((size_t)MTOK * 384)
#define pR ((bf16_t*)(wsp + WS_PREP))
#define pK (pR + PA)
#define pV (pR + 2 * PA)
#define pKK (pR + 3 * PA)
#define pB (pR + 4 * PA)
#define pLD (pR + 5 * PA)
    const long gsize = (long)G * (NWAVES * 64);
    const int NGW = G * NWAVES;

#define MK_W() sk::RwkvW W{args.in[I_MU] + l * 1280, args.in[I_MUV], args.in[I_W0] + l * 384, args.in[I_W2] + l * 32 * 384, args.in[I_A0] + l * 384, args.in[I_A2] + l * 32 * 384, args.in[I_V0], args.in[I_V2], args.in[I_G2] + l * 64 * 384, args.in[I_KK] + l * 384, args.in[I_KA] + l * 384, args.in[I_RK] + l * 384, args.in[I_LNW] + l * 384, args.in[I_LNB] + l * 384};
#define MK_CBUF() const rw::ChunkBufs cbuf{(bf16_t*)(wsp + WS_PT), (bf16_t*)(wsp + WS_G), (float*)(wsp + WS_Z), (float*)(wsp + WS_YV), (bf16_t*)(wsp + WS_S0), (bf16_t*)(wsp + (l == 0 ? WS_VF : WS_V1)), (float*)(wsp + WS_DOT), (const bf16_t*)(wsp + WS_SMALL + SM_W2T + l * SM_LORA_L), (const bf16_t*)(wsp + WS_SMALL + SM_A2T + l * SM_LORA_L), (const bf16_t*)(wsp + WS_SMALL + SM_V2T + l * SM_LORA_L), (const bf16_t*)(wsp + WS_SMALL + SM_G2T + l * SM_LORA_L)};
    for (int l = 0; l < 2; ++l) {
        const float* xin = l == 0 ? args.in[I_X] : out;
        if (l == 0) {
        PH_BEGIN
            REPEAT(0) {
            const int I_IN = 16 * 68, I_KV = 16 * 16, NIT = 2 * (I_IN + I_KV);
            for (int it = gw; it < NIT; it += NGW) {
                int r = it; const int ll = r >= I_IN + I_KV ? 1 : 0; r -= ll * (I_IN + I_KV);
                bf16_t* win = (bf16_t*)(wsp + (ll == 0 ? WS_WT + WT_IN : WS_WIN1)); bf16_t* wkv = (bf16_t*)(wsp + (ll == 0 ? WS_WT + WT_MKV : WS_WIN1 + 4718592));
                if (r < I_IN) transpose_item<false>(args.in[I_WIN] + (size_t)ll * 1024 * 2176, args.in[I_MIXG] + ll * 1024, 1024, 2176, win, scr, r, lane);
                else transpose_item<false>(args.in[I_WMKV] + (size_t)ll * 1024 * 512, args.in[I_MEMG] + ll * 1024, 1024, 512, wkv, scr, r - I_IN, lane);
            }
            for (long i = gtid; i < 2 * 128 * 1024; i += gsize) { const int ll = (int)(i >> 17), n = (int)(i >> 10) & 127, k = (int)(i & 1023); float v = 0.f;
                if (ll > 0 && n < 16) v = args.in[I_WINV][k * 16 + n] * args.in[I_MIXG][1024 + k];
                ((bf16_t*)(wsp + (ll == 0 ? WS_WT + WT_IN : WS_WIN1)))[(size_t)(2176 + n) * 1024 + k] = f2bf(v); }
            for (long i = gtid; i < 2 * 384 * 160; i += gsize) { const int ll = (int)(i / (384 * 160)), r2 = (int)(i % (384 * 160)), hc = r2 / 160, j = r2 % 160; bf16_t* sm = (bf16_t*)(wsp + WS_SMALL + ll * SM_LORA_L);
                if (j < 32) sm[SM_W2T / 2 + hc * 32 + j] = f2bf(args.in[I_W2][(size_t)ll * 32 * 384 + j * 384 + hc]);
                else if (j < 64) sm[SM_A2T / 2 + hc * 32 + (j - 32)] = f2bf(args.in[I_A2][(size_t)ll * 32 * 384 + (j - 32) * 384 + hc]);
                else if (j < 96) sm[SM_V2T / 2 + hc * 32 + (j - 64)] = f2bf((j - 64) < 16 ? args.in[I_V2][(j - 64) * 384 + hc] : 0.f);
                else sm[SM_G2T / 2 + hc * 64 + (j - 96)] = f2bf(args.in[I_G2][(size_t)ll * 64 * 384 + (j - 96) * 384 + hc]); }
            for (int m = gw; m < MTOK; m += NGW) row_to_bf16(args.in[I_X] + (size_t)m * DM, XB + (size_t)m * DM, SSQ_A + m, lane);
            for (int m = gw; m < 512; m += NGW) row_to_bf16(args.in[I_MEM] + (size_t)m * DM, MEMB + (size_t)m * DM, ssqm + m, lane);
            sk::d_biastab(args.in[I_RELB], biastab, gtid, gsize);
            }
        PH_END
        }
        PH_BEGIN
            REPEAT(1)
            { pg8::Gemm g{XB, Wt_in, MTOK, 2304, 1024}; pg8::StaticOrder S; S.init(MTOK, 2304, G, (int)blockIdx.x);
              pg8::EpiScaleBf16 E{PROJ, LDP, SSQ_A + (size_t)l * MTOK};
              pg8::gemm_phase<pg8::EpiScaleBf16, pg8::StaticOrder, true, true>(L, g, S, E, tid); }
            { pg8::Gemm g{MEMB, Wt_mkv, 512, 512, 1024}; pg8::StaticOrder S; S.init(512, 512, G, (int)((blockIdx.x + 192) % G));
              pg8::EpiScaleBf16 E{MKV, 512, ssqm};
              pg8::gemm_phase<pg8::EpiScaleBf16, pg8::StaticOrder, true, true>(L, g, S, E, tid); }
            REPEAT(9) if (blockIdx.x >= 64) {
                const int I_OUT = 16 * 32, I_UP = 16 * 176, I_DN = 44 * 32, NIT = I_OUT + I_UP + I_DN;
                for (int it = ((int)blockIdx.x - 64) * NWAVES + wave; it < NIT; it += (G - 64) * NWAVES) {
                    int r = it;
                    if (r < I_OUT) { transpose_item<false>(args.in[I_WOUT] + (size_t)l * 1024 * 1024, nullptr, 1024, 1024, Wt_out, scr, r, lane); continue; } r -= I_OUT;
                    if (r < I_UP) { transpose_item<true>(args.in[I_WUP] + (size_t)l * 1024 * 5632, args.in[I_FFNG] + l * 1024, 1024, 5632, Wt_up, scr, r, lane); continue; } r -= I_UP;
                    transpose_item<false>(args.in[I_WDOWN] + (size_t)l * 2816 * 1024, nullptr, 2816, 1024, Wt_down, scr, r, lane);
                }
            }
        PH_END


        PH_BEGIN
            MK_W(); MK_CBUF(); (void)cbuf;
#if !FAST_ATTN
            sk::d_qknorm(PROJ, MTOK, LDP, args.in[I_AQN] + l * 64, args.in[I_AKN] + l * 64, args.in[I_MQN] + l * 64, 0, gtid, gsize);
            sk::d_qknorm(MKV, 512, 512, nullptr, nullptr, args.in[I_MKN] + l * 64, 1, gtid, gsize);
#endif
#if FAST_RWKV
            REPEAT(2) rw::chunk_phase(L, PROJ, W, l, VF, cbuf, tid, (int)blockIdx.x, G);
#else
            sk::d_rwkv_prep(PROJ, W, l, VF, pR, pK, pV, pKK, pB, pLD, gtid, gsize);
#endif
        PH_END
        PH_BEGIN
            MK_CBUF(); (void)cbuf;
            if (blockIdx.x < 48) {
#if FAST_RWKV
                REPEAT(3) { __syncthreads(); if (tid < 8) MISC[16 + tid] = 0u; __syncthreads();
                  const int sbh = (int)blockIdx.x >> 2, stj = (int)blockIdx.x & 3;
                  if (wave == 0) rw::scan_compute(L, cbuf, sbh, stj, lane, MISC + 16); else if (wave < 4) rw::scan_loader(L, cbuf, sbh, stj, wave - 1, lane, MISC + 16);
 }
#endif
            } else {
#if FAST_ATTN
                const at::AttnArgs A{PROJ, MKV, MIX, biastab, args.in[I_SINK] + l * 6, args.in[I_AQN] + l * 64, args.in[I_AKN] + l * 64, args.in[I_MQN] + l * 64, args.in[I_MKN] + l * 64};
                REPEAT(7) for (;;) {
                    if (tid == 0) MISC[20] = atomicAdd((unsigned*)(ctl + CW_ATTQ + 64 * l), 1u);
                    __syncthreads(); const int it = (int)MISC[20]; __syncthreads();
                    if (it >= 512) break;
                    at::attn_item(L, A, it < 256 ? 256 + it : it - 256, tid); }
#else
                const long gt2 = (long)(blockIdx.x - BATCH * 6) * (NWAVES * 64) + tid, gs2 = (long)(G - BATCH * 6) * (NWAVES * 64);
                REPEAT(7) sk::d_swa(PROJ, MIX, biastab, args.in[I_SINK] + l * 6, gt2, gs2);
                REPEAT(8) sk::d_memattn(PROJ, MKV, MIX, gt2, gs2);
#endif
            }
        PH_END
        PH_BEGIN
            MK_W(); MK_CBUF(); (void)cbuf;
#if FAST_RWKV
            REPEAT(4) rw::out_phase(L, PROJ, W, cbuf, MIX, tid, (int)blockIdx.x, G);
#else
            sk::d_rwkv_fin(PROJ, W, pR, pK, pV, MIX, gtid, gsize);
#endif
        PH_END
        PH_BEGIN
            if ((PROF_PH) == 31) { pg8::Gemm g2{MIX, Wt_out, MTOK, 1024, 1024}; pg8::StaticOrder S2; S2.init(MTOK, 1024, G, (int)blockIdx.x); pg8::EpiScaleBf16 E2{PROJ, 1024, SSQ_A}; pg8::gemm_phase<pg8::EpiScaleBf16, pg8::StaticOrder, true, true>(L, g2, S2, E2, tid); }
            pg8::Gemm g{MIX, Wt_out, MTOK, 1024, 1024}; pg8::StaticOrder S; S.init(MTOK, 1024, G, (int)blockIdx.x);
            pg8::EpiResid E{xin, out, XB, SSQ_B + (size_t)l * MTOK, 1024};
            pg8::gemm_phase<pg8::EpiResid, pg8::StaticOrder, true, true>(L, g, S, E, tid);
        PH_END
        PH_BEGIN
            REPEAT(5) {
            pg8::Gemm g{XB, Wt_up, 66 * 256, 5632, 1024}; pg8::StaticOrder S; S.init(66 * 256, 5632, G, (int)blockIdx.x);
            pg8::EpiConvAct E{ACT, SSQ_B + (size_t)l * MTOK, args.in[I_CW] + (size_t)l * 3 * 5632, args.in[I_CB] + (size_t)l * 5632};
            pg8::gemm_phase<pg8::EpiConvAct, pg8::StaticOrder, true, true>(L, g, S, E, tid); }
        PH_END
        PH_BEGIN
            if ((PROF_PH) == 32) { pg8::Gemm g2{ACT, Wt_down, MTOK, 1024, 2816}; pg8::StaticOrder S2; S2.init(MTOK, 1024, G, (int)blockIdx.x); pg8::EpiScaleBf16 E2{PROJ, 1024, SSQ_A}; pg8::gemm_phase<pg8::EpiScaleBf16, pg8::StaticOrder, true, true>(L, g2, S2, E2, tid); }
            pg8::Gemm g{ACT, Wt_down, MTOK, 1024, 2816}; pg8::StaticOrder S; S.init(MTOK, 1024, G, (int)blockIdx.x);
            pg8::EpiResid E{out, out, XB, SSQ_A + (size_t)(l + 1) * MTOK, 1024};
            pg8::gemm_phase<pg8::EpiResid, pg8::StaticOrder, true, true>(L, g, S, E, tid);
        PH_END
    }
    if ((PROF_TA) >= 0 && blockIdx.x == 0 && tid0 == 0) {
        MISC[24 + ph] = (unsigned)__builtin_amdgcn_s_memrealtime();
        const unsigned ta = MISC[24 + (PROF_TA) + 1] - MISC[24 + (PROF_TA)], tb = (PROF_TB) >= 0 ? MISC[24 + (PROF_TB) + 1] - MISC[24 + (PROF_TB)] : 0u;
        const unsigned long long extra = (unsigned long long)ta + 1000ull * (unsigned long long)(((tb + 50u) / 100u) * 100u);
        const unsigned long long t0 = __builtin_amdgcn_s_memrealtime(); while (__builtin_amdgcn_s_memrealtime() - t0 < extra) __builtin_amdgcn_s_sleep(32);
    }
#undef PH_BEGIN
#undef PH_END
}
constexpr int N_PHASES = 1 + 2 * 7;
}

#ifndef MK_PER_PHASE
#define MK_PER_PHASE 0
#endif
extern "C" void kernel_launch(void* const* d_in, const int* in_sizes, int n_in, void* d_out, int out_size, void* d_ws, size_t ws_size, hipStream_t stream) {
    static int grid = 0;
    if (grid == 0) {
        if (n_in != N_IN || out_size != MTOK * DM || ws_size < mk::WS_END) { fprintf(stderr, "kernel_launch: unexpected shapes (n_in %d out %d ws %zu)\n", n_in, out_size, ws_size); grid = -1; return; }
        int dev = 0, cus = 0, per_cu = 0;
        if (hipGetDevice(&dev) != hipSuccess || hipDeviceGetAttribute(&cus, hipDeviceAttributeMultiprocessorCount, dev) != hipSuccess) { grid = -1; return; }
        if (hipFuncSetAttribute((const void*)mk::mk_fwd, hipFuncAttributeMaxDynamicSharedMemorySize, mk::LDS_BYTES) != hipSuccess) { fprintf(stderr, "kernel_launch: hipFuncSetAttribute failed\n"); grid = -1; return; }
        if (hipOccupancyMaxActiveBlocksPerMultiprocessor(&per_cu, (const void*)mk::mk_fwd, NWAVES * 64, mk::LDS_BYTES) != hipSuccess || per_cu < 1) { fprintf(stderr, "kernel_launch: occupancy query says %d blocks per CU\n", per_cu); }
        (void)hipGetLastError();
        grid = cus;
    }
    if (grid < 0) return;
    if (hipMemsetAsync((char*)d_ws + mk::WS_CTL, 0, mk::CTL_ZERO_BYTES, stream) != hipSuccess) return;
    mk::Args a{};
    for (int i = 0; i < N_IN; ++i) a.in[i] = (const float*)d_in[i];
    a.out = (float*)d_out; a.ws = (unsigned char*)d_ws;
#if MK_PER_PHASE
    for (int p = 0; p < mk::N_PHASES; ++p) { a.ph_lo = p; a.ph_hi = p + 1; hipLaunchKernelGGL(mk::mk_fwd, dim3(grid), dim3(NWAVES * 64), mk::LDS_BYTES, stream, a); }
#else
    a.ph_lo = 0; a.ph_hi = mk::N_PHASES;
    hipLaunchKernelGGL(mk::mk_fwd, dim3(grid), dim3(NWAVES * 64), mk::LDS_BYTES, stream, a);
#endif
}
```

```cpp
#define MK_BUILD 1
#ifndef HOST_SIM
#include <hip/hip_runtime.h>
#include <cstdio>
#include <cstdint>
#endif
#ifndef SEQ_LEN
#define SEQ_LEN 8192
#endif
typedef unsigned short bf16_t;
constexpr int BATCH = 2, SEQ = SEQ_LEN, DM = 1024, MTOK = BATCH * SEQ, DFF = 2816, LDP = 2304  ;
constexpr float EPS = 1e-6f, GN_EPS = 64e-5f;
__host__ __device__ __forceinline__ float bf2f(bf16_t h) { unsigned u = (unsigned)h << 16; return __builtin_bit_cast(float, u); }
__host__ __device__ __forceinline__ bf16_t f2bf(float f) { unsigned u = __builtin_bit_cast(unsigned, f); return (bf16_t)((u + 0x7fffu + ((u >> 16) & 1u)) >> 16); }
__host__ __device__ __forceinline__ int t5_bucket(int dist) {
    if (dist < 16) return dist;
    const float v = logf((float)dist / 16.0f) / 2.0794415416798357f * 16.0f;
    int large = 16 + (int)v; return large < 31 ? large : 31;
}
constexpr size_t MiB = 1u << 20;
enum { I_X = 0, I_MEM, I_RELB, I_MIXG, I_WIN, I_WINV, I_AQN, I_AKN, I_SINK, I_MU, I_MUV, I_W0, I_W2, I_A0, I_A2, I_V0, I_V2, I_G2, I_KK, I_KA, I_RK, I_LNW, I_LNB, I_MEMG, I_WMKV, I_MQN, I_MKN, I_WOUT, I_FFNG, I_WUP, I_CW, I_CB, I_WDOWN, N_IN };
#ifndef PROF_PH
#define PROF_PH -1
#endif
#ifndef PROF_N
#define PROF_N 1
#endif
namespace sk {

__device__ __forceinline__ void d_wt(const float* W, const float* g, bf16_t* Wt, int K, int N, int Npad, long gtid, long gsize) {
    const long total = (long)Npad * K;
    for (long idx = gtid; idx < total; idx += gsize) {
        const int n = (int)(idx / K), k = (int)(idx % K);
        float v = 0.f;
        if (n < N) { v = W[(long)k * N + n]; if (g) v *= g[k]; }
        Wt[idx] = f2bf(v);
    }
}
#ifndef MK_BUILD
__global__ void k_wt(const float* W, const float* g, bf16_t* Wt, int K, int N, int Npad) { d_wt(W, g, Wt, K, N, Npad, (long)blockIdx.x * blockDim.x + threadIdx.x, (long)gridDim.x * blockDim.x); }
#endif
__device__ __forceinline__ void d_rowprep(const float* x, bf16_t* xb, float* ssq, int rows, long gtid, long gsize) {
    for (long r = gtid; r < rows; r += gsize) {
        const float* xr = x + (long)r * DM; bf16_t* o = xb + (long)r * DM; float s = 0.f;
        for (int c = 0; c < DM; ++c) { const float v = xr[c]; s += v * v; o[c] = f2bf(v); }
        ssq[r] = s;
    }
}
#ifndef MK_BUILD
__global__ void k_rowprep(const float* x, bf16_t* xb, float* ssq, int rows) { d_rowprep(x, xb, ssq, rows, (long)blockIdx.x * blockDim.x + threadIdx.x, (long)gridDim.x * blockDim.x); }
#endif
__device__ __forceinline__ void d_biastab(const float* rel_bias, float* tab, long gtid, long gsize) {
        for (long i = gtid; i < 128 * 6; i += gsize) { const int dist = i / 6, hq = i % 6; tab[i] = rel_bias[t5_bucket(dist) * 6 + hq]; }
}
#ifndef MK_BUILD
__global__ void k_biastab(const float* rel_bias, float* tab) { d_biastab(rel_bias, tab, (long)blockIdx.x * blockDim.x + threadIdx.x, (long)gridDim.x * blockDim.x); }
#endif
__device__ __forceinline__ void d_qknorm(bf16_t* P, int rows, int ld, const float* gq, const float* gk, const float* gm, int mode, long gtid, long gsize) {
    const int nj = mode == 0 ? 12 : 4;
    const long total = (long)rows * nj;
    for (long idx = gtid; idx < total; idx += gsize) {
        const int row = (int)(idx / nj), j = (int)(idx % nj);
        int col; const float* g;
        if (mode == 0) { if (j < 6) { col = 64 * j; g = gq; } else if (j < 8) { col = 384 + 64 * (j - 6); g = gk; } else { col = 1920 + 64 * (j - 8); g = gm; } }
        else { col = 64 * j; g = gm; }
        bf16_t* p = P + (long)row * ld + col; float s = 0.f;
        for (int d = 0; d < 64; ++d) { const float v = bf2f(p[d]); s += v * v; }
        const float rs = 1.0f / sqrtf(s * (1.0f / 64.0f) + EPS);
        for (int d = 0; d < 64; ++d) p[d] = f2bf(bf2f(p[d]) * rs * g[d]);
    }
}
#ifndef MK_BUILD
__global__ void k_qknorm(bf16_t* P, int rows, int ld, const float* gq, const float* gk, const float* gm, int mode) { d_qknorm(P, rows, ld, gq, gk, gm, mode, (long)blockIdx.x * blockDim.x + threadIdx.x, (long)gridDim.x * blockDim.x); }
#endif
__device__ __forceinline__ void d_swa(const bf16_t* P, bf16_t* MIX, const float* biastab, const float* sinks, long gtid, long gsize) {
    const long total = (long)MTOK * 6;
    for (long idx = gtid; idx < total; idx += gsize) {
        const int tok = (int)(idx / 6), hq = (int)(idx % 6), hkv = hq / 3, t = tok % SEQ;
        float q[64], o[64];
#pragma unroll
        for (int d = 0; d < 64; ++d) { q[d] = bf2f(P[(long)tok * LDP + 64 * hq + d]) * 0.125f; o[d] = 0.f; }
        float m = sinks[hq], l = 1.0f;
        const int j0 = t - 127 < 0 ? 0 : t - 127;
        for (int j = j0; j <= t; ++j) {
            const bf16_t* kr = P + (long)(tok - (t - j)) * LDP + 384 + 64 * hkv; const bf16_t* vr = kr + 128;
            float s = 0.f;
#pragma unroll
            for (int d = 0; d < 64; ++d) s += q[d] * bf2f(kr[d]);
            s += biastab[(t - j) * 6 + hq];
            const float mn = fmaxf(m, s), f = expf(m - mn), e = expf(s - mn);
            l = l * f + e; m = mn;
#pragma unroll
            for (int d = 0; d < 64; ++d) o[d] = o[d] * f + e * bf2f(vr[d]);
        }
        const float inv = 1.0f / l;
#pragma unroll
        for (int d = 0; d < 64; ++d) MIX[(long)tok * DM + 64 * hq + d] = f2bf(o[d] * inv);
    }
}
#ifndef MK_BUILD
__global__ __launch_bounds__(256) void k_swa(const bf16_t* P, bf16_t* MIX, const float* biastab, const float* sinks) { d_swa(P, MIX, biastab, sinks, (long)blockIdx.x * blockDim.x + threadIdx.x, (long)gridDim.x * blockDim.x); }
#endif
__device__ __forceinline__ void d_memattn(const bf16_t* P, const bf16_t* MKV, bf16_t* MIX, long gtid, long gsize) {
    const long total = (long)MTOK * 4;
    for (long idx = gtid; idx < total; idx += gsize) {
        const int tok = (int)(idx / 4), h = (int)(idx % 4), b = tok / SEQ;
        float q[64], o[64];
#pragma unroll
        for (int d = 0; d < 64; ++d) { q[d] = bf2f(P[(long)tok * LDP + 1920 + 64 * h + d]) * 0.125f; o[d] = 0.f; }
        float m = -1e30f, l = 0.f;
        for (int j = 0; j < 256; ++j) {
            const bf16_t* kr = MKV + (long)(b * 256 + j) * 512 + 64 * h; const bf16_t* vr = kr + 256;
            float s = 0.f;
#pragma unroll
            for (int d = 0; d < 64; ++d) s += q[d] * bf2f(kr[d]);
            const float mn = fmaxf(m, s), f = expf(m - mn), e = expf(s - mn);
            l = l * f + e; m = mn;
#pragma unroll
            for (int d = 0; d < 64; ++d) o[d] = o[d] * f + e * bf2f(vr[d]);
        }
        const float inv = 1.0f / l;
#pragma unroll
        for (int d = 0; d < 64; ++d) MIX[(long)tok * DM + 768 + 64 * h + d] = f2bf(o[d] * inv);
    }
}
#ifndef MK_BUILD
__global__ __launch_bounds__(256) void k_memattn(const bf16_t* P, const bf16_t* MKV, bf16_t* MIX) { d_memattn(P, MKV, MIX, (long)blockIdx.x * blockDim.x + threadIdx.x, (long)gridDim.x * blockDim.x); }
#endif
__device__ __forceinline__ float shifted(const bf16_t* P, int tok, int col, float mu) {
    const float p = bf2f(P[(long)tok * LDP + col]);
    const float prev = (tok % SEQ) == 0 ? 0.f : bf2f(P[(long)(tok - 1) * LDP + col]);
    return p + mu * (prev - p);
}
struct RwkvW { const float *mu, *mu_v, *w0, *w2, *a0, *a2, *v0, *v2, *g2, *k_k, *k_a, *r_k, *ln_w, *ln_b; };
__device__ __forceinline__ void d_rwkv_prep(const bf16_t* P, RwkvW W, int layer, bf16_t* VFIRST, bf16_t* R, bf16_t* K, bf16_t* V, bf16_t* KK, bf16_t* B, bf16_t* LOGD, long gtid, long gsize) {
    const long total = (long)MTOK * 6;
    for (long idx = gtid; idx < total; idx += gsize) {
        const int tok = (int)(idx / 6), h = (int)(idx % 6);
        float nrm = 0.f;
        for (int c = 0; c < 64; ++c) { const int hc = 64 * h + c; const float kc = shifted(P, tok, 640 + 384 + hc, W.mu[384 + hc]) * W.k_k[hc]; nrm += kc * kc; }
        const float rn = 1.0f / fmaxf(sqrtf(nrm), 1e-12f);
        for (int c = 0; c < 64; ++c) {
            const int hc = 64 * h + c; const long o = (long)tok * 384 + hc;
            const float r = shifted(P, tok, 640 + hc, W.mu[hc]);
            const float k = shifted(P, tok, 640 + 384 + hc, W.mu[384 + hc]);
            float v = shifted(P, tok, 640 + 768 + hc, W.mu[768 + hc]);
            float wp = W.w0[hc], ap = W.a0[hc];
            for (int j = 0; j < 32; ++j) {
                wp += tanhf(shifted(P, tok, 640 + 1152 + j, W.mu[1152 + j])) * W.w2[j * 384 + hc];
                ap += shifted(P, tok, 640 + 1184 + j, W.mu[1184 + j]) * W.a2[j * 384 + hc];
            }
            const float z = -wp; const float sp = fmaxf(z, 0.f) + log1pf(expf(-fabsf(z)));
            const float w = -sp - 0.5f;
            const float a = 1.0f / (1.0f + expf(-ap));
            if (layer > 0) {
                float vp = W.v0[hc];
                for (int j = 0; j < 16; ++j) vp += shifted(P, tok, 2176 + j, W.mu_v[j]) * W.v2[j * 384 + hc];
                const float vf = bf2f(VFIRST[o]);
                v = v + (vf - v) * (1.0f / (1.0f + expf(-vp)));
            } else VFIRST[o] = f2bf(v);
            const float kk = k * W.k_k[hc] * rn;
            R[o] = f2bf(r); K[o] = f2bf(k * (1.0f + (a - 1.0f) * W.k_a[hc])); V[o] = f2bf(v);
            KK[o] = f2bf(kk); B[o] = f2bf(kk * a); LOGD[o] = f2bf(-expf(w));
        }
    }
}
#ifndef MK_BUILD
__global__ void k_rwkv_prep(const bf16_t* P, RwkvW W, int layer, bf16_t* VFIRST, bf16_t* R, bf16_t* K, bf16_t* V, bf16_t* KK, bf16_t* B, bf16_t* LOGD) { d_rwkv_prep(P, W, layer, VFIRST, R, K, V, KK, B, LOGD, (long)blockIdx.x * blockDim.x + threadIdx.x, (long)gridDim.x * blockDim.x); }
#endif
__device__ __forceinline__ void d_rwkv_scan(const bf16_t* R, const bf16_t* K, const bf16_t* V, const bf16_t* KK, const bf16_t* B, const bf16_t* LOGD, bf16_t* MIX, int bh, int i) {
    const int b = bh / 6, h = bh % 6;
    float s[64];
#pragma unroll
    for (int k = 0; k < 64; ++k) s[k] = 0.f;
    for (int t = 0; t < SEQ; ++t) {
        const long o = (long)(b * SEQ + t) * 384 + 64 * h;
        float sa = 0.f;
#pragma unroll
        for (int k = 0; k < 64; ++k) sa -= s[k] * bf2f(KK[o + k]);
        const float v = bf2f(V[o + i]); float y = 0.f;
#pragma unroll
        for (int k = 0; k < 64; ++k) { s[k] = s[k] * expf(bf2f(LOGD[o + k])) + sa * bf2f(B[o + k]) + v * bf2f(K[o + k]); y += s[k] * bf2f(R[o + k]); }
        MIX[(long)(b * SEQ + t) * DM + 384 + 64 * h + i] = f2bf(y);
    }
}
#ifndef MK_BUILD
__global__ void k_rwkv_scan(const bf16_t* R, const bf16_t* K, const bf16_t* V, const bf16_t* KK, const bf16_t* B, const bf16_t* LOGD, bf16_t* MIX) { d_rwkv_scan(R, K, V, KK, B, LOGD, MIX, blockIdx.x, threadIdx.x); }
#endif
__device__ __forceinline__ void d_rwkv_fin(const bf16_t* P, RwkvW W, const bf16_t* R, const bf16_t* K, const bf16_t* V, bf16_t* MIX, long gtid, long gsize) {
    const long total = (long)MTOK * 6;
    for (long idx = gtid; idx < total; idx += gsize) {
        const int tok = (int)(idx / 6), h = (int)(idx % 6);
        bf16_t* y = MIX + (long)tok * DM + 384 + 64 * h; const long o = (long)tok * 384 + 64 * h;
        float mean = 0.f, dot = 0.f;
        for (int c = 0; c < 64; ++c) { mean += bf2f(y[c]); dot += bf2f(R[o + c]) * bf2f(K[o + c]) * W.r_k[64 * h + c]; }
        mean *= (1.0f / 64.0f); float var = 0.f;
        for (int c = 0; c < 64; ++c) { const float d = bf2f(y[c]) - mean; var += d * d; }
        const float rstd = 1.0f / sqrtf(var * (1.0f / 64.0f) + GN_EPS);
        for (int c = 0; c < 64; ++c) {
            const int hc = 64 * h + c; float g = 0.f;
            for (int j = 0; j < 64; ++j) g += (1.0f / (1.0f + expf(-shifted(P, tok, 640 + 1216 + j, W.mu[1216 + j])))) * W.g2[j * 384 + hc];
            const float yn = (bf2f(y[c]) - mean) * rstd * W.ln_w[hc] + W.ln_b[hc];
            y[c] = f2bf((yn + dot * bf2f(V[o + c])) * g);
        }
    }
}
#ifndef MK_BUILD
__global__ void k_rwkv_fin(const bf16_t* P, RwkvW W, const bf16_t* R, const bf16_t* K, const bf16_t* V, bf16_t* MIX) { d_rwkv_fin(P, W, R, K, V, MIX, (long)blockIdx.x * blockDim.x + threadIdx.x, (long)gridDim.x * blockDim.x); }
#endif
__device__ __forceinline__ void d_conv_act(const bf16_t* U, const float* cw, const float* cb, bf16_t* ACT, int rows, long gtid, long gsize) {
    const long total = (long)rows * DFF;
    for (long idx = gtid; idx < total; idx += gsize) {
        const int t = (int)(idx / DFF), c = (int)(idx % DFF);
        float gate = cb[c], val = cb[DFF + c];
#pragma unroll
        for (int i = 0; i < 3; ++i) { const int tt = t - 2 + i; if (tt >= 0) { gate += cw[i * 2 * DFF + c] * bf2f(U[(long)tt * 2 * DFF + c]); val += cw[i * 2 * DFF + DFF + c] * bf2f(U[(long)tt * 2 * DFF + DFF + c]); } }
        ACT[(long)t * DFF + c] = f2bf(gate / (1.0f + expf(-gate)) * val);
    }
}
#ifndef MK_BUILD
__global__ void k_conv_act(const bf16_t* U, const float* cw, const float* cb, bf16_t* ACT, int rows) { d_conv_act(U, cw, cb, ACT, rows, (long)blockIdx.x * blockDim.x + threadIdx.x, (long)gridDim.x * blockDim.x); }
#endif
}
namespace pg8 {
#define PG8_LAS __attribute__((address_space(3)))
typedef unsigned short bf16_t;
typedef short bf16x8 __attribute__((ext_vector_type(8)));
typedef float f32x4 __attribute__((ext_vector_type(4)));
typedef unsigned u32x4 __attribute__((ext_vector_type(4)));
constexpr int BM = 256, BK = 64, HALF = 128, HTB = HALF * BK * 2  , STAGE_BYTES = 8 * HTB, NXCD = 8, WGM = 8;

__host__ __device__ __forceinline__ int lds_byte(int r, int c) { const int st = (r >> 4) * 2 + (c >> 5), rr = r & 15, cc = c & 31, ob = rr * 64 + cc * 2; return st * 1024 + (ob ^ (((ob >> 9) & 1) << 5)); }
__host__ __device__ __forceinline__ void stage_rc(int b, int& R, int& C) { const int st = b / 1024, sb = b % 1024, swz = sb ^ (((sb >> 9) & 1) << 5); R = (st >> 1) * 16 + swz / 64; C = (st & 1) * 32 + (swz % 64) / 2; }
__host__ __device__ __forceinline__ int perm32(int rho) { const int n = rho >> 4, i = rho & 15; return 8 * (i >> 2) + 4 * n + (i & 3); }

struct Unit { int pm, pn; };
struct Gemm { const bf16_t* A; const bf16_t* Bt; int M, N, K; };

struct StaticOrder {
    int nM, nN, nwg, G, c;
    __host__ __device__ void init(int M, int N, int G_, int c_) { nM = M / BM; nN = N / BM; nwg = nM * nN; G = G_; c = c_; }
    __host__ __device__ bool next(int i, Unit& u) const {
        const long L = (long)i * G + c; if (L >= nwg) return false;
        int wgid = (int)L; { const int q = nwg / NXCD, r = nwg % NXCD, xcd = wgid % NXCD, off = wgid / NXCD; wgid = (xcd < r ? xcd * (q + 1) : r * (q + 1) + (xcd - r) * q) + off; }
        const int nig = WGM * nN, gid = wgid / nig, fm = gid * WGM, gsz = (nM - fm) < WGM ? (nM - fm) : WGM;
        u.pm = fm + ((wgid % nig) % gsz); u.pn = (wgid % nig) / gsz; return true;
    }
    __device__ __forceinline__ void a_ready(const Unit&) const {}
    __device__ __forceinline__ void done(const Unit&) const {}
};

__device__ __forceinline__ unsigned cvt_pk_bf16(float lo, float hi) { unsigned r; asm volatile("v_cvt_pk_bf16_f32 %0, %1, %2" : "=v"(r) : "v"(lo), "v"(hi)); return r; }
struct EpiScaleBf16 {
    static constexpr bool PERM = true, AFTER_DRAIN = false; static constexpr int AMAP = 0;
    bf16_t* O; int ldc; const float* ssq;
    __device__ __forceinline__ void operator()(const f32x4 (&acc)[2][2][4][2], const Unit& u, int wr, int wc, int fr, int fq) const {
        const int row0 = u.pm * BM + wr * 64 + fr, col0 = u.pn * BM + wc * 32 + 8 * fq;
#pragma unroll
        for (int ai = 0; ai < 2; ++ai)
#pragma unroll
            for (int m = 0; m < 4; ++m) { const int row = row0 + ai * HALF + m * 16; const float sc = 1.0f / sqrtf(ssq[row] * (1.0f / 1024.0f) + 1e-6f);
                bf16_t* rowp = O + (size_t)row * ldc + col0;
#pragma unroll
                for (int bj = 0; bj < 2; ++bj) { const f32x4 v0 = acc[ai][bj][m][0] * sc, v1 = acc[ai][bj][m][1] * sc;
                    u32x4 w; w.x = cvt_pk_bf16(v0[0], v0[1]); w.y = cvt_pk_bf16(v0[2], v0[3]); w.z = cvt_pk_bf16(v1[0], v1[1]); w.w = cvt_pk_bf16(v1[2], v1[3]);
                    *(u32x4*)(rowp + bj * HALF) = w; } }
    }
};
struct EpiResid {
    static constexpr bool PERM = false, AFTER_DRAIN = false; static constexpr int AMAP = 0;
    const float* base; float* out; bf16_t* xb; float* ssq; int ldc;
    __device__ __forceinline__ void operator()(const f32x4 (&acc)[2][2][4][2], const Unit& u, int wr, int wc, int fr, int fq) const {
        typedef unsigned u32x2v __attribute__((ext_vector_type(2)));
        const int col0 = u.pn * BM + wc * 32 + 4 * fq;
#pragma unroll
        for (int ai = 0; ai < 2; ++ai)
#pragma unroll
            for (int m = 0; m < 4; ++m) { const int row = u.pm * BM + ai * HALF + wr * 64 + m * 16 + fr; const size_t off = (size_t)row * ldc + col0; float sq = 0.f;
#pragma unroll
                for (int bj = 0; bj < 2; ++bj)
#pragma unroll
                    for (int n = 0; n < 2; ++n) { const f32x4 o = *(const f32x4*)(base + off + bj * HALF + n * 16) + acc[ai][bj][m][n];
                        *(f32x4*)(out + off + bj * HALF + n * 16) = o; sq += (o[0] * o[0] + o[1] * o[1]) + (o[2] * o[2] + o[3] * o[3]);
                        u32x2v w; w.x = cvt_pk_bf16(o[0], o[1]); w.y = cvt_pk_bf16(o[2], o[3]); *(u32x2v*)(xb + off + bj * HALF + n * 16) = w; }
                sq += __shfl_xor(sq, 16); sq += __shfl_xor(sq, 32);
                if (fq == 0) atomicAdd(ssq + row, sq); }
    }
};
struct EpiConvAct {
    static constexpr bool PERM = true, AFTER_DRAIN = false; static constexpr int AMAP = 1;
    bf16_t* ACT; const float* ssq; const float* cw; const float* cb;
    static __device__ __forceinline__ float shr1s(float x) { float r; asm volatile("s_nop 1\n\tv_mov_b32_dpp %0, %1 row_shr:1 row_mask:0xf bank_mask:0xf bound_ctrl:1" : "=v"(r) : "v"(x)); return r; }
    static __device__ __forceinline__ f32x4 shr1(f32x4 v) { f32x4 r; r[0] = shr1s(v[0]); r[1] = shr1s(v[1]); r[2] = shr1s(v[2]); r[3] = shr1s(v[3]); return r; }
    __device__ __forceinline__ void operator()(const f32x4 (&acc)[2][2][4][2], const Unit& u, int wr, int wc, int fr, int fq) const {
        const int b = u.pm / 33, pmb = u.pm % 33;
        const int pos0 = 252 * pmb + 126 * wr + 8 * fr - 2;
        const long row0 = (long)b * SEQ + pos0;
        float rs[8];
#pragma unroll
        for (int j = 0; j < 8; ++j) { const int pos = pos0 + j; const bool ok = pos >= 0 && pos < SEQ; const float q = ssq[ok ? row0 + j : 0]; rs[j] = ok ? 1.0f / sqrtf(q * (1.0f / 1024.0f) + 1e-6f) : 0.f; }
        const int ch0 = 128 * u.pn + 32 * wc + 8 * fq;
        unsigned ow[8][4];
#pragma unroll
        for (int n = 0; n < 2; ++n) { const int c = ch0 + 4 * n;
            const f32x4 w0g = *(const f32x4*)(cw + c), w1g = *(const f32x4*)(cw + 5632 + c), w2g = *(const f32x4*)(cw + 2 * 5632 + c), bg = *(const f32x4*)(cb + c);
            const f32x4 w0v = *(const f32x4*)(cw + 2816 + c), w1v = *(const f32x4*)(cw + 5632 + 2816 + c), w2v = *(const f32x4*)(cw + 2 * 5632 + 2816 + c), bv = *(const f32x4*)(cb + 2816 + c);
            f32x4 gm2 = shr1(acc[1][0][2][n] * rs[6]), gm1 = shr1(acc[1][0][3][n] * rs[7]), vm2 = shr1(acc[1][1][2][n] * rs[6]), vm1 = shr1(acc[1][1][3][n] * rs[7]);
#pragma unroll
            for (int j = 0; j < 8; ++j) { const f32x4 gj = acc[j >> 2][0][j & 3][n] * rs[j], vj = acc[j >> 2][1][j & 3][n] * rs[j];
                const f32x4 ug = bg + w0g * gm2 + w1g * gm1 + w2g * gj, uv = bv + w0v * vm2 + w1v * vm1 + w2v * vj; f32x4 a;
#pragma unroll
                for (int e = 0; e < 4; ++e) a[e] = ug[e] / (1.0f + __expf(-ug[e])) * uv[e];
                ow[j][2 * n] = cvt_pk_bf16(a[0], a[1]); ow[j][2 * n + 1] = cvt_pk_bf16(a[2], a[3]);
                gm2 = gm1; gm1 = gj; vm2 = vm1; vm1 = vj; } }
#pragma unroll
        for (int j = 0; j < 8; ++j) if (8 * fr + j >= 2 && pos0 + j < SEQ) { u32x4 w; w.x = ow[j][0]; w.y = ow[j][1]; w.z = ow[j][2]; w.w = ow[j][3]; *(u32x4*)(ACT + (size_t)(row0 + j) * 2816 + ch0) = w; }
    }
};
template <class Epi, class Sched, bool ALIGN_EPI = false, bool SP2 = false>
__device__ __forceinline__ void gemm_phase(PG8_LAS unsigned char* lds, const Gemm g, const Sched& S, const Epi& E, int tid_in) {
    int tid = tid_in; asm volatile("" : "+v"(tid));
    const int wid = __builtin_amdgcn_readfirstlane(tid >> 6), lane = tid & 63, wr = wid >> 2, wc = wid & 3, fr = lane & 15, fq = lane >> 4;
    const int K = g.K, nt = K / BK;
    unsigned voffA[2], voffB[2];
#pragma unroll
    for (int i = 0; i < 2; ++i) { int R, C; stage_rc(tid * 16 + i * 8192, R, C); const int Rb = Epi::PERM ? ((R & ~31) + perm32(R & 31)) : R;
        const int Ra = Epi::AMAP ? (126 * (R >> 6) + 8 * (R & 15) + ((R >> 4) & 3)) : R;
        voffA[i] = (unsigned)(Ra * K + C) * 2u; voffB[i] = (unsigned)(Rb * K + C) * 2u; }
    const size_t kstep = (size_t)(BK * 2);
    const size_t hstepB = (size_t)HALF * K * 2;
    const size_t hstepA = Epi::AMAP ? (size_t)4 * K * 2 : hstepB;
    const size_t tstep = 2 * hstepB;
#define PG8_ABASE(pm_) (Epi::AMAP ? (long)((long)((pm_) / 33) * SEQ + 252 * ((pm_) % 33) - 2) * (long)K * 2 : (long)(pm_) * (long)tstep)
    const unsigned ldsw = (unsigned)wid * 1024u;
    const int aoff = lds_byte(wr * 64 + fr, fq * 8), boff = lds_byte(wc * 32 + fr, fq * 8);
#define PG8_SA(b, h) (((b) * 2 + (h)) * HTB)
#define PG8_SB(b, h) ((4 + (b) * 2 + (h)) * HTB)
#define PG8_STAGE(bufoff, gbase, voff) do { _Pragma("unroll") for (int _i = 0; _i < 2; ++_i) \
        __builtin_amdgcn_global_load_lds((const unsigned*)((const char*)(gbase) + (voff)[_i]), (PG8_LAS unsigned*)(lds + (bufoff) + ldsw + _i * 8192), 16, 0, 0); } while (0)
#define PG8_LDA(dst, b, h) do { _Pragma("unroll") for (int m = 0; m < 4; ++m) _Pragma("unroll") for (int k = 0; k < 2; ++k) dst[m][k] = *(const PG8_LAS bf16x8*)(lds + PG8_SA(b, h) + aoff + m * 2048 + k * 1024); } while (0)
#define PG8_LDB(dst, b, h) do { _Pragma("unroll") for (int n = 0; n < 2; ++n) _Pragma("unroll") for (int k = 0; k < 2; ++k) dst[n][k] = *(const PG8_LAS bf16x8*)(lds + PG8_SB(b, h) + boff + n * 2048 + k * 1024); } while (0)
#define PG8_MMA(ai, bj, At, Bt) do { __builtin_amdgcn_s_setprio(1); _Pragma("unroll") for (int m = 0; m < 4; ++m) _Pragma("unroll") for (int n = 0; n < 2; ++n) _Pragma("unroll") for (int k = 0; k < 2; ++k) \
        acc[ai][bj][m][n] = __builtin_amdgcn_mfma_f32_16x16x32_bf16(Bt[n][k], At[m][k], acc[ai][bj][m][n], 0, 0, 0); __builtin_amdgcn_s_setprio(0); } while (0)
#define PG8_WAIT_V(n) asm volatile("s_waitcnt vmcnt(" #n ")" ::: "memory")
#define PG8_WAIT_L(n) asm volatile("s_waitcnt lgkmcnt(" #n ")" ::: "memory")
#define PG8_BAR __builtin_amdgcn_s_barrier()
#define PG8_SCHED __builtin_amdgcn_sched_barrier(0)
    Unit cur, nxt; int ui = 0;
    if (!S.next(0, cur)) return;
    f32x4 acc[2][2][4][2];
#pragma unroll
    for (int a = 0; a < 2; ++a)
#pragma unroll
        for (int b = 0; b < 2; ++b)
#pragma unroll
            for (int m = 0; m < 4; ++m)
#pragma unroll
                for (int n = 0; n < 2; ++n) acc[a][b][m][n] = (f32x4){0.f, 0.f, 0.f, 0.f};
    bf16x8 At[4][2], B0[2][2], B1[2][2];
    const char* cA = (const char*)g.A + PG8_ABASE(cur.pm); const char* cB = (const char*)g.Bt + (size_t)cur.pn * tstep;
    S.a_ready(cur);
    if constexpr (SP2) {
        PG8_STAGE(PG8_SB(0, 0), cB, voffB); PG8_STAGE(PG8_SB(0, 1), cB + hstepB, voffB); PG8_STAGE(PG8_SA(0, 0), cA, voffA); PG8_STAGE(PG8_SA(0, 1), cA + hstepA, voffA);
        if (wr == 1) PG8_BAR;
        PG8_WAIT_V(2); PG8_BAR;
        PG8_STAGE(PG8_SB(1, 0), cB + kstep, voffB); PG8_STAGE(PG8_SA(1, 0), cA + kstep, voffA); PG8_STAGE(PG8_SB(1, 1), cB + hstepB + kstep, voffB);
        PG8_WAIT_V(6); PG8_BAR;
    } else {
        PG8_STAGE(PG8_SB(0, 0), cB, voffB); PG8_STAGE(PG8_SA(0, 0), cA, voffA); PG8_STAGE(PG8_SB(0, 1), cB + hstepB, voffB); PG8_STAGE(PG8_SA(0, 1), cA + hstepA, voffA);
        if (wr == 1) PG8_BAR;
        PG8_WAIT_V(4); PG8_BAR;
        PG8_STAGE(PG8_SB(1, 0), cB + kstep, voffB); PG8_STAGE(PG8_SA(1, 0), cA + kstep, voffA); PG8_STAGE(PG8_SB(1, 1), cB + hstepB + kstep, voffB);
        PG8_WAIT_V(6); PG8_BAR;
    }
    for (;;) {
        const bool has_next = S.next(ui + 1, nxt);
        const char* nA = has_next ? (const char*)g.A + PG8_ABASE(nxt.pm) : cA; const char* nB = has_next ? (const char*)g.Bt + (size_t)nxt.pn * tstep : cB;
        for (int t = 0; t < nt; t += 2) {
            const bool last = (t == nt - 2);
            const char* a1 = cA + (size_t)(t + 1) * kstep;
            const char* a2 = last ? nA : cA + (size_t)(t + 2) * kstep; const char* b2 = last ? nB : cB + (size_t)(t + 2) * kstep;
            const char* a3 = a2 + kstep; const char* b3 = b2 + kstep;
            if (last && has_next) S.a_ready(nxt);
            if constexpr (SP2) {
            PG8_LDB(B0, 0, 0); PG8_LDB(B1, 0, 1); PG8_SCHED; PG8_LDA(At, 0, 0); PG8_STAGE(PG8_SA(1, 1), a1 + hstepA, voffA);
            PG8_WAIT_V(8); PG8_WAIT_L(0); PG8_BAR; PG8_MMA(0, 0, At, B0); PG8_MMA(0, 1, At, B1); PG8_BAR; PG8_SCHED;
            PG8_LDA(At, 0, 1); PG8_STAGE(PG8_SB(0, 0), b2, voffB); PG8_STAGE(PG8_SB(0, 1), b2 + hstepB, voffB); PG8_STAGE(PG8_SA(0, 0), a2, voffA);
            PG8_WAIT_V(8); PG8_WAIT_L(0); PG8_BAR; PG8_MMA(1, 0, At, B0); PG8_MMA(1, 1, At, B1); PG8_BAR; PG8_SCHED;
            PG8_LDB(B0, 1, 0); PG8_LDB(B1, 1, 1); PG8_SCHED; PG8_LDA(At, 1, 0); PG8_STAGE(PG8_SA(0, 1), a2 + hstepA, voffA);
            PG8_WAIT_V(8); PG8_WAIT_L(0); PG8_BAR; PG8_MMA(0, 0, At, B0); PG8_MMA(0, 1, At, B1); PG8_BAR; PG8_SCHED;
            PG8_LDA(At, 1, 1); PG8_STAGE(PG8_SB(1, 0), b3, voffB); PG8_STAGE(PG8_SB(1, 1), b3 + hstepB, voffB); PG8_STAGE(PG8_SA(1, 0), a3, voffA);
            PG8_WAIT_V(8); PG8_WAIT_L(0); PG8_BAR; PG8_MMA(1, 0, At, B0); PG8_MMA(1, 1, At, B1); PG8_BAR; PG8_SCHED;
            } else {
            PG8_LDB(B0, 0, 0); PG8_SCHED; PG8_LDA(At, 0, 0); PG8_STAGE(PG8_SA(1, 1), a1 + hstepA, voffA);
            PG8_WAIT_L(8); PG8_BAR; PG8_WAIT_L(0); PG8_MMA(0, 0, At, B0); PG8_BAR; PG8_SCHED;
            PG8_LDB(B1, 0, 1); PG8_STAGE(PG8_SB(0, 0), b2, voffB);
            PG8_BAR; PG8_WAIT_L(0); PG8_MMA(0, 1, At, B1); PG8_BAR;
            PG8_LDA(At, 0, 1); PG8_STAGE(PG8_SA(0, 0), a2, voffA);
            PG8_BAR; PG8_WAIT_L(0); PG8_MMA(1, 0, At, B0); PG8_BAR; PG8_SCHED;
            PG8_STAGE(PG8_SB(0, 1), b2 + hstepB, voffB);
            PG8_WAIT_V(6); PG8_BAR; PG8_MMA(1, 1, At, B1); PG8_BAR;
            PG8_LDB(B0, 1, 0); PG8_SCHED; PG8_LDA(At, 1, 0); PG8_STAGE(PG8_SA(0, 1), a2 + hstepA, voffA);
            PG8_WAIT_L(8); PG8_BAR; PG8_WAIT_L(0); PG8_MMA(0, 0, At, B0); PG8_BAR; PG8_SCHED;
            PG8_LDB(B1, 1, 1); PG8_STAGE(PG8_SB(1, 0), b3, voffB);
            PG8_BAR; PG8_WAIT_L(0); PG8_MMA(0, 1, At, B1); PG8_BAR;
            PG8_LDA(At, 1, 1); PG8_STAGE(PG8_SA(1, 0), a3, voffA);
            PG8_BAR; PG8_WAIT_L(0); PG8_MMA(1, 0, At, B0); PG8_BAR; PG8_SCHED;
            PG8_STAGE(PG8_SB(1, 1), b3 + hstepB, voffB);
            PG8_WAIT_V(6); PG8_BAR; PG8_MMA(1, 1, At, B1); PG8_BAR;
            }
        }
        if constexpr (ALIGN_EPI) { if (wr == 0) PG8_BAR; }
        if constexpr (!Epi::AFTER_DRAIN) { E(acc, cur, wr, wc, fr, fq); S.done(cur); }
        if (!has_next) break;
#pragma unroll
        for (int a = 0; a < 2; ++a)
#pragma unroll
            for (int b = 0; b < 2; ++b)
#pragma unroll
                for (int m = 0; m < 4; ++m)
#pragma unroll
                    for (int n = 0; n < 2; ++n) acc[a][b][m][n] = (f32x4){0.f, 0.f, 0.f, 0.f};
        cur = nxt; cA = nA; cB = nB; ++ui;
        if constexpr (ALIGN_EPI) { if (wr == 1) PG8_BAR; }
    }
    PG8_WAIT_V(0);
    if constexpr (!ALIGN_EPI) { if (wr == 0) PG8_BAR; }
    PG8_BAR;
    if constexpr (Epi::AFTER_DRAIN) { E.fused(acc, cur, wr, wc, fr, fq, lds, wid, lane); S.done(cur); }
#undef PG8_ABASE
#undef PG8_SA
#undef PG8_SB
#undef PG8_STAGE
#undef PG8_LDA
#undef PG8_LDB
#undef PG8_MMA
#undef PG8_WAIT_V
#undef PG8_WAIT_L
#undef PG8_BAR
#undef PG8_SCHED
}
}

#ifndef PG8_SP2
#define PG8_SP2 true
#endif
#ifndef PG8_ALIGN
#define PG8_ALIGN true
#endif
#define GAS __attribute__((address_space(1)))
#define LAS __attribute__((address_space(3)))
typedef unsigned short bf16;
typedef unsigned v4u __attribute__((ext_vector_type(4)));
typedef float f32x4 __attribute__((ext_vector_type(4)));
typedef short bf16x8 __attribute__((ext_vector_type(8)));
typedef GAS unsigned gu32;
typedef GAS unsigned long long gu64;
#define RLX_AGENT __ATOMIC_RELAXED, __HIP_MEMORY_SCOPE_AGENT
#define LDS_WAIT() asm volatile("s_waitcnt lgkmcnt(0)" ::: "memory")
#define VM_WAIT() asm volatile("s_waitcnt vmcnt(0)" ::: "memory")
__device__ __forceinline__ unsigned long long rt() { return __builtin_amdgcn_s_memrealtime(); }

#define XB_TMO      128
#define XB_XCNT(j)  (256  + 64 * (j))
#define XB_XSUB(j)  (1280 + 64 * (j))
#define XB_XGEN(j)  (2304 + 64 * (j))
#define XB_TOP      3328
#define XB_TOPGEN   3392
#define XCD_BAR_WORDS 3456
#define XB_SPIN_CAP (1u << 20)

__device__ __forceinline__ unsigned xb_ld(unsigned* p)              { return __hip_atomic_load(p, __ATOMIC_RELAXED, __HIP_MEMORY_SCOPE_AGENT); }
__device__ __forceinline__ unsigned xb_add(unsigned* p, unsigned v) { return __hip_atomic_fetch_add(p, v, __ATOMIC_RELAXED, __HIP_MEMORY_SCOPE_AGENT); }
__device__ __forceinline__ unsigned xb_xcc_id() { return (unsigned)__builtin_amdgcn_s_getreg((3 << 11) | 20) & 0xFu; }
#define XB_SPIN(cond, bar) do { unsigned _sp = 0; while (cond) { __builtin_amdgcn_s_sleep(1); \
    if ((++_sp & 255u) == 0u) { if (xb_ld(&(bar)[XB_TMO])) break; if (_sp > XB_SPIN_CAP) { atomicAdd(&(bar)[XB_TMO], 1u); break; } } } } while (0)

struct XcdBarrier {
    unsigned* bar; unsigned x;
    volatile LAS unsigned* st;
};

__device__ __forceinline__ XcdBarrier xcd_barrier_post(unsigned* bar, volatile LAS unsigned* st) {
    XcdBarrier b; b.bar = bar; b.x = xb_xcc_id(); b.st = st;
    if (threadIdx.x == 0) (void)xb_add(&bar[XB_XCNT(b.x)], 1u);
    return b;
}
__device__ __forceinline__ void xcd_barrier_complete(unsigned* bar, unsigned x, unsigned& nloc, unsigned& nx) {
    const unsigned G = gridDim.x * gridDim.y * gridDim.z;
    unsigned sum, cnt, mine, sp = 0u;
    for (;;) {
        sum = 0u; cnt = 0u; mine = 0u;
#pragma unroll
        for (unsigned j = 0; j < 16; ++j) { const unsigned c = xb_ld(&bar[XB_XCNT(j)]); sum += c; cnt += (c > 0u) ? 1u : 0u; mine = (j == x) ? c : mine; }
        if (sum == G) break;
        __builtin_amdgcn_s_sleep(1);
        if ((++sp & 255u) == 0u) { if (xb_ld(&bar[XB_TMO])) break; if (sp > XB_SPIN_CAP) { atomicAdd(&bar[XB_TMO], 1u); break; } }
    }
    nloc = mine > 0u ? mine : 1u; nx = cnt > 0u ? cnt : 1u;
}

__device__ __forceinline__ void xcd_barrier(const XcdBarrier& b) {
    asm volatile("s_waitcnt vmcnt(0)" ::: "memory");
    __syncthreads();
    if (threadIdx.x == 0) {
        unsigned* bar = b.bar;
        __builtin_amdgcn_s_waitcnt(0);
        unsigned nloc = b.st[0], nx = b.st[1];
        if (nloc == 0u) { xcd_barrier_complete(bar, b.x, nloc, nx); b.st[0] = nloc; b.st[1] = nx; }
        const unsigned old = xb_add(&bar[XB_XSUB(b.x)], 1u);
        const unsigned gen = old / nloc;
        if (old + 1u == (gen + 1u) * nloc) {
            __builtin_amdgcn_fence(__ATOMIC_RELEASE, "agent");
            asm volatile("s_waitcnt vmcnt(0)" ::: "memory");
            const unsigned og = xb_add(&bar[XB_TOP], 1u);
            const unsigned tg = og / nx;
            if (og + 1u == (tg + 1u) * nx) xb_add(&bar[XB_TOPGEN], 1u);
            else XB_SPIN(xb_ld(&bar[XB_TOPGEN]) == tg, bar);
            __builtin_amdgcn_fence(__ATOMIC_ACQUIRE, "agent");
            xb_add(&bar[XB_XGEN(b.x)], 1u);
            asm volatile("s_waitcnt vmcnt(0)" ::: "memory");
        } else {
            XB_SPIN(xb_ld(&bar[XB_XGEN(b.x)]) == gen, bar);
            __builtin_amdgcn_fence(__ATOMIC_ACQUIRE, "agent");
            asm volatile("s_waitcnt vmcnt(0)" ::: "memory");
        }
    }
    __syncthreads();
}

namespace rw {
constexpr int LD = 72;
constexpr int MATB = 64 * LD * 2;
constexpr int OFF_F0 = 12 * MATB  , OFF_TMP = OFF_F0 + 64 * 65 * 4  ;
constexpr int OFF_TW = 8 * MATB  , OFF_TA = OFF_TW + 5120, OFF_TV = OFF_TA + 5120, OFF_WP = OFF_TV + 5120  , OFF_AP = OFF_WP + 16640, OFF_VP = OFF_AP + 16640;
constexpr int OFF_TOT = 139264, OFF_GC = OFF_TOT + 2048, OFF_RN = OFF_GC + 256, OFF_END = OFF_RN + 256;
constexpr int NITEMS = BATCH * 6 * (SEQ / 64);
__device__ __forceinline__ int sigpos(int c) { return (c & 32) + 8 * ((c >> 2) & 3) + 4 * ((c >> 4) & 1) + (c & 3); }
#define RW_BAR() do { asm volatile("s_waitcnt lgkmcnt(0)" ::: "memory"); __builtin_amdgcn_s_barrier(); asm volatile("" ::: "memory"); } while (0)
__device__ __forceinline__ float fexp(float x) { return __expf(x); }
__device__ __forceinline__ float fsigm(float x) { return 1.0f / (1.0f + __expf(-x)); }
__device__ __forceinline__ float ftanh(float x) { const float e = __expf(-2.0f * fabsf(x)); const float t = (1.0f - e) / (1.0f + e); return x < 0.f ? -t : t; }
__device__ __forceinline__ f32x4 mm_tile(const LAS bf16_t* A, const LAS bf16_t* Bt, int ti, int tj, int fr, int fq, f32x4 acc) {
#pragma unroll
    for (int kk = 0; kk < 2; ++kk) {
        const bf16x8 a = *(const LAS bf16x8*)(A + (16 * ti + fr) * LD + 32 * kk + 8 * fq);
        const bf16x8 b = *(const LAS bf16x8*)(Bt + (16 * tj + fr) * LD + 32 * kk + 8 * fq);
        acc = __builtin_amdgcn_mfma_f32_16x16x32_bf16(a, b, acc, 0, 0, 0);
    }
    return acc;
}
__device__ __forceinline__ unsigned pk2(float lo, float hi) { typedef float f2_t __attribute__((ext_vector_type(2))); typedef __bf16 b2_t __attribute__((ext_vector_type(2))); f2_t v = {lo, hi}; return __builtin_bit_cast(unsigned, __builtin_convertvector(v, b2_t)); }
struct ChunkBufs { bf16_t* PT; bf16_t* G; float* Z; bf16_t* YV; bf16_t* S0; bf16_t* VOUT; float* DOT; const bf16_t *W2T, *A2T, *V2T, *G2T; };

#define RW_LANES() int lt_ = tid_in; asm volatile("" : "+v"(lt_)); const int tid = lt_, lane = lt_ & 63, fr = lane & 15, fq = lane >> 4; (void)tid; (void)fr; (void)fq
__device__ __forceinline__ int chunk_phase(LAS unsigned char* L, const bf16_t* P, const sk::RwkvW W, int layer, const bf16_t* VFIRST, const ChunkBufs cb, int tid_in, unsigned* qctr, volatile LAS unsigned* qw) {
    const int w = __builtin_amdgcn_readfirstlane(tid_in >> 6);
    LAS bf16_t* B0 = (LAS bf16_t*)(L + 0 * MATB); LAS bf16_t* B1 = (LAS bf16_t*)(L + 1 * MATB); LAS bf16_t* B2 = (LAS bf16_t*)(L + 2 * MATB); LAS bf16_t* B3 = (LAS bf16_t*)(L + 3 * MATB);
    LAS bf16_t* B4 = (LAS bf16_t*)(L + 4 * MATB); LAS bf16_t* B5 = (LAS bf16_t*)(L + 5 * MATB); LAS bf16_t* B6 = (LAS bf16_t*)(L + 6 * MATB); LAS bf16_t* B7 = (LAS bf16_t*)(L + 7 * MATB);
    LAS bf16_t* B8 = (LAS bf16_t*)(L + 8 * MATB); LAS bf16_t* B9 = (LAS bf16_t*)(L + 9 * MATB); LAS bf16_t* B10 = (LAS bf16_t*)(L + 10 * MATB); LAS bf16_t* B11 = (LAS bf16_t*)(L + 11 * MATB);
    LAS float* F0 = (LAS float*)(L + OFF_F0); LAS float* TMP = (LAS float*)(L + OFF_TMP);
    LAS bf16_t* TW = (LAS bf16_t*)(L + OFF_TW); LAS bf16_t* TA = (LAS bf16_t*)(L + OFF_TA); LAS bf16_t* TV = (LAS bf16_t*)(L + OFF_TV);
    LAS float* WP = (LAS float*)(L + OFF_WP); LAS float* AP = (LAS float*)(L + OFF_AP); LAS float* VP = (LAS float*)(L + OFF_VP);
    LAS float* TOT = (LAS float*)(L + OFF_TOT); LAS float* GC = (LAS float*)(L + OFF_GC); LAS float* RN = (LAS float*)(L + OFF_RN);
    for (;;) {
        if (tid_in == 0) qw[0] = atomicAdd(qctr, 1u);
        RW_BAR(); const int item = (int)qw[0]; RW_BAR();
        if (item >= NITEMS) return item;
        const int bh = item / (SEQ / 64), chunk = item % (SEQ / 64), b = bh / 6, h = bh % 6;
        const int tok0 = b * SEQ + chunk * 64;
        unsigned short e_r[9], e_k[9], e_v[9], e_vf[8]; float e_mu_r, e_mu_k, e_mu_v, e_w0, e_a0, e_kk, e_ka, e_rk, e_v0;
        { RW_LANES(); const int hc = 64 * h + lane, tk0 = tok0 + 8 * w; const bool has_prev = (chunk * 64 + 8 * w) > 0;
#pragma unroll
          for (int j = 0; j < 9; ++j) { const size_t row = (size_t)(tk0 + j - 1) * LDP; const bool ok = j > 0 || has_prev;
              e_r[j] = ok ? P[row + 640 + hc] : (unsigned short)0; e_k[j] = ok ? P[row + 1024 + hc] : (unsigned short)0; e_v[j] = ok ? P[row + 1408 + hc] : (unsigned short)0; }
#pragma unroll
          for (int j = 0; j < 8; ++j) e_vf[j] = layer > 0 ? VFIRST[(size_t)(tk0 + j) * 384 + hc] : (unsigned short)0;
          e_mu_r = W.mu[hc]; e_mu_k = W.mu[384 + hc]; e_mu_v = W.mu[768 + hc]; e_w0 = W.w0[hc]; e_a0 = W.a0[hc]; e_kk = W.k_k[hc]; e_ka = W.k_a[hc]; e_rk = W.r_k[hc]; e_v0 = layer > 0 ? W.v0[hc] : 0.f; }
        for (int rp_ = 0; rp_ < ((PROF_PH) == 20 ? 2 : 1); ++rp_) {
        { RW_LANES(); const int t = tid >> 3, sub = tid & 7, tok = tok0 + t; const bool hp = (chunk * 64 + t) > 0;
          const bf16_t* rc = P + (size_t)tok * LDP; const bf16_t* rp = rc - LDP; const v4u z4 = {0u, 0u, 0u, 0u};
          const v4u lc = *(const GAS v4u*)(rc + 1792 + 8 * sub), lp = hp ? *(const GAS v4u*)(rp + 1792 + 8 * sub) : z4;
          const v4u kc4 = *(const GAS v4u*)(rc + 1024 + 64 * h + 8 * sub), kp4 = hp ? *(const GAS v4u*)(rp + 1024 + 64 * h + 8 * sub) : z4;
          v4u vc4 = z4, vp4 = z4; if (layer > 0 && sub < 2) { vc4 = *(const GAS v4u*)(rc + 1920 + 8 * sub); if (hp) vp4 = *(const GAS v4u*)(rp + 1920 + 8 * sub); }
          const unsigned lcw[4] = {lc.x, lc.y, lc.z, lc.w}, lpw[4] = {lp.x, lp.y, lp.z, lp.w}, kcw[4] = {kc4.x, kc4.y, kc4.z, kc4.w}, kpw[4] = {kp4.x, kp4.y, kp4.z, kp4.w}, vcw[4] = {vc4.x, vc4.y, vc4.z, vc4.w}, vpw[4] = {vp4.x, vp4.y, vp4.z, vp4.w};
          unsigned lo[4], vo[4]; float s = 0.f;
          const f32x4 mA0 = *(const GAS f32x4*)(W.mu + 1152 + 8 * sub), mA1 = *(const GAS f32x4*)(W.mu + 1156 + 8 * sub);
          const f32x4 mK0 = *(const GAS f32x4*)(W.mu + 384 + 64 * h + 8 * sub), mK1 = *(const GAS f32x4*)(W.mu + 388 + 64 * h + 8 * sub);
          const f32x4 kk0 = *(const GAS f32x4*)(W.k_k + 64 * h + 8 * sub), kk1 = *(const GAS f32x4*)(W.k_k + 64 * h + 8 * sub + 4);
          f32x4 mV0 = {0.f, 0.f, 0.f, 0.f}, mV1 = mV0; if (layer > 0 && sub < 2) { mV0 = *(const GAS f32x4*)(W.mu_v + 8 * sub); mV1 = *(const GAS f32x4*)(W.mu_v + 8 * sub + 4); }
#pragma unroll
          for (int e2 = 0; e2 < 4; ++e2) { float xl[2], xv[2];
#pragma unroll
              for (int u = 0; u < 2; ++u) { const int e = 2 * e2 + u; const int sh = 16 * u;
                  const float c1 = bf2f((bf16_t)((lcw[e2] >> sh) & 0xffff)), p1 = bf2f((bf16_t)((lpw[e2] >> sh) & 0xffff)); const float x = c1 + (e < 4 ? mA0[e & 3] : mA1[e & 3]) * (p1 - c1);
                  xl[u] = sub < 4 ? ftanh(x) : x;
                  const float c2 = bf2f((bf16_t)((kcw[e2] >> sh) & 0xffff)), p2 = bf2f((bf16_t)((kpw[e2] >> sh) & 0xffff));
                  const float kx = (c2 + (e < 4 ? mK0[e & 3] : mK1[e & 3]) * (p2 - c2)) * (e < 4 ? kk0[e & 3] : kk1[e & 3]); s += kx * kx;
                  const float c3 = bf2f((bf16_t)((vcw[e2] >> sh) & 0xffff)), p3 = bf2f((bf16_t)((vpw[e2] >> sh) & 0xffff)); xv[u] = c3 + (e < 4 ? mV0[e & 3] : mV1[e & 3]) * (p3 - c3); }
              lo[e2] = pk2(xl[0], xl[1]); vo[e2] = pk2(xv[0], xv[1]); }
          *(LAS v4u*)((sub < 4 ? TW : TA) + t * 40 + 8 * (sub & 3)) = (v4u){lo[0], lo[1], lo[2], lo[3]};
          if (layer > 0 && sub < 4) *(LAS v4u*)(TV + t * 40 + 8 * sub) = (v4u){vo[0], vo[1], vo[2], vo[3]};
          s += __shfl_xor(s, 1); s += __shfl_xor(s, 2); s += __shfl_xor(s, 4);
          if (sub == 0) RN[t] = 1.0f / fmaxf(sqrtf(s), 1e-12f); }
        RW_BAR();
        }
        { RW_LANES();
#pragma unroll
        for (int e = 0; e < 2; ++e) { const int tl = 2 * w + e, ti = tl >> 2, tj = tl & 3; const f32x4 z4 = {0.f, 0.f, 0.f, 0.f};
            const size_t brow = (size_t)(64 * h + 16 * tj + fr) * 32 + 8 * fq;
            { const bf16x8 a = *(const LAS bf16x8*)(TW + (16 * ti + fr) * 40 + 8 * fq); const bf16x8 bb = *(const GAS bf16x8*)(cb.W2T + brow);
              const f32x4 d = __builtin_amdgcn_mfma_f32_16x16x32_bf16(a, bb, z4, 0, 0, 0);
#pragma unroll
              for (int r = 0; r < 4; ++r) WP[(16 * ti + 4 * fq + r) * 65 + 16 * tj + fr] = d[r]; }
            { const bf16x8 a = *(const LAS bf16x8*)(TA + (16 * ti + fr) * 40 + 8 * fq); const bf16x8 bb = *(const GAS bf16x8*)(cb.A2T + brow);
              const f32x4 d = __builtin_amdgcn_mfma_f32_16x16x32_bf16(a, bb, z4, 0, 0, 0);
#pragma unroll
              for (int r = 0; r < 4; ++r) AP[(16 * ti + 4 * fq + r) * 65 + 16 * tj + fr] = d[r]; }
            if (layer > 0) { const bf16x8 a = *(const LAS bf16x8*)(TV + (16 * ti + fr) * 40 + 8 * fq); const bf16x8 bb = *(const GAS bf16x8*)(cb.V2T + brow);
              const f32x4 d = __builtin_amdgcn_mfma_f32_16x16x32_bf16(a, bb, z4, 0, 0, 0);
#pragma unroll
              for (int r = 0; r < 4; ++r) VP[(16 * ti + 4 * fq + r) * 65 + 16 * tj + fr] = d[r]; } } }
        RW_BAR();
        for (int rp_ = 0; rp_ < ((PROF_PH) == 21 ? 2 : 1); ++rp_) {
        { RW_LANES(); const int c = lane, hc = 64 * h + c, tq0 = 8 * w, tk0 = tok0 + tq0;
          const float mu_r = e_mu_r, mu_k = e_mu_k, mu_v = e_mu_v, w0 = e_w0, a0 = e_a0, k_k = e_kk, k_a = e_ka, r_k = e_rk, v0 = e_v0;
          float pr = bf2f(e_r[0]), pk = bf2f(e_k[0]), pv = bf2f(e_v[0]);
          float rr[8], kq[8], vv[8], kkc[8], bb[8], ld[8], pd[8];
#pragma unroll
          for (int j = 0; j < 8; ++j) { const int t = tq0 + j;
              const float cr = bf2f(e_r[j + 1]), ck = bf2f(e_k[j + 1]), cv = bf2f(e_v[j + 1]);
              const float r = cr + mu_r * (pr - cr), k = ck + mu_k * (pk - ck); float v = cv + mu_v * (pv - cv); pr = cr; pk = ck; pv = cv;
              const float wp = w0 + WP[t * 65 + c], ap = a0 + AP[t * 65 + c];
              const float z = -wp, sp = fmaxf(z, 0.f) + __logf(1.0f + __expf(-fabsf(z))); const float wl = -sp - 0.5f;
              const float al = fsigm(ap);
              if (layer > 0) { const float vp = v0 + VP[t * 65 + c]; const float vf = bf2f(e_vf[j]); v = v + (vf - v) * fsigm(vp); }
              const float kn = k * k_k * RN[t]; const float k2 = k * (1.0f + (al - 1.0f) * k_a);
              rr[j] = r; kq[j] = k2; vv[j] = v; kkc[j] = kn; bb[j] = kn * al; ld[j] = -fexp(wl); pd[j] = r * k2 * r_k; }
          {
#pragma unroll
            for (int j = 0; j < 8; j += 2) { const unsigned pv2 = pk2(vv[j], vv[j + 1]); cb.VOUT[(size_t)(tk0 + j) * 384 + hc] = (bf16_t)(pv2 & 0xffff); cb.VOUT[(size_t)(tk0 + j + 1) * 384 + hc] = (bf16_t)(pv2 >> 16); } }
          {
            const bool b5 = lane & 32, b4 = lane & 16, b3 = lane & 8; float s4[4], s2[2], s1;
#pragma unroll
            for (int i = 0; i < 4; ++i) { const float keep = b5 ? pd[i + 4] : pd[i], send = b5 ? pd[i] : pd[i + 4]; s4[i] = keep + __shfl_xor(send, 32); }
#pragma unroll
            for (int i = 0; i < 2; ++i) { const float keep = b4 ? s4[i + 2] : s4[i], send = b4 ? s4[i] : s4[i + 2]; s2[i] = keep + __shfl_xor(send, 16); }
            { const float keep = b3 ? s2[1] : s2[0], send = b3 ? s2[0] : s2[1]; s1 = keep + __shfl_xor(send, 8); }
            s1 += __shfl_xor(s1, 4); s1 += __shfl_xor(s1, 2); s1 += __shfl_xor(s1, 1);
            if ((lane & 7) == 0) cb.DOT[(size_t)(tk0 + (lane >> 3)) * 6 + h] = s1; }
          float cl[8]; cl[0] = ld[0];
#pragma unroll
          for (int j = 1; j < 8; ++j) cl[j] = cl[j - 1] + ld[j];
          TOT[w * 64 + c] = cl[7];
          RW_BAR();
          float prefix = 0.f, cumC = 0.f;
#pragma unroll
          for (int ww = 0; ww < 8; ++ww) { const float tv = TOT[ww * 64 + c]; cumC += tv; if (ww < w) prefix += tv; }
          const float gcc = fexp(cumC); if (w == 0) GC[c] = gcc;
          unsigned ahp[4], btp[4], ktp[4], vp4[4]; float gprev = fexp(prefix), ah_e = 0.f, bt_e = 0.f, kt_e = 0.f;
#pragma unroll
          for (int j = 0; j < 8; ++j) { const int t = tq0 + j; const float g = fexp(prefix + cl[j]), ig = __builtin_amdgcn_rcpf(g), gc = gcc * ig;
              const float ah = -kkc[j] * gprev, rh = rr[j] * g, bh = bb[j] * ig, kh = kq[j] * ig, bt = bb[j] * gc, kt = kq[j] * gc; gprev = g;
              const unsigned w01 = pk2(ah, rh), w23 = pk2(bh, kh);
              B0[t * LD + c] = (bf16_t)(w01 & 0xffff); B1[t * LD + c] = (bf16_t)(w01 >> 16); B2[t * LD + c] = (bf16_t)(w23 & 0xffff); B3[t * LD + c] = (bf16_t)(w23 >> 16);
              if (j & 1) { ahp[j >> 1] = pk2(ah_e, ah); btp[j >> 1] = pk2(bt_e, bt); ktp[j >> 1] = pk2(kt_e, kt); vp4[j >> 1] = pk2(vv[j - 1], vv[j]); }
              else { ah_e = ah; bt_e = bt; kt_e = kt; } }
          *(LAS v4u*)(B4 + c * LD + tq0) = (v4u){ahp[0], ahp[1], ahp[2], ahp[3]}; *(LAS v4u*)(B5 + c * LD + tq0) = (v4u){btp[0], btp[1], btp[2], btp[3]};
          *(LAS v4u*)(B6 + c * LD + tq0) = (v4u){ktp[0], ktp[1], ktp[2], ktp[3]}; *(LAS v4u*)(B7 + c * LD + tq0) = (v4u){vp4[0], vp4[1], vp4[2], vp4[3]}; }
        RW_BAR();
        }
        for (int rp_ = 0; rp_ < ((PROF_PH) == 22 ? 2 : 1); ++rp_) {
        { RW_LANES(); const int prod = w >> 1; const LAS bf16_t* Aop = prod < 2 ? B0 : B1; const LAS bf16_t* Bop = (prod & 1) ? B3 : B2;
#pragma unroll
          for (int e = 0; e < 8; ++e) { const int tl = (w & 1) * 8 + e, ti = tl >> 2, tj = tl & 3; f32x4 d = {0.f, 0.f, 0.f, 0.f};
              if (tj <= ti) d = mm_tile(Aop, Bop, ti, tj, fr, fq, d);
#pragma unroll
              for (int r = 0; r < 4; ++r) { const int t = 16 * ti + 4 * fq + r, i = 16 * tj + fr; const bool keep = prod < 2 ? (i < t) : (i <= t); const float val = (tj <= ti && keep) ? d[r] : 0.f;
                  if (prod == 0) F0[t * 65 + i] = val; else if (prod == 1) B8[t * LD + i] = f2bf(val); else if (prod == 2) B9[t * LD + i] = f2bf(val); else B10[t * LD + i] = f2bf(val); } } }
        RW_BAR();
        }
        if (w == 0) { RW_LANES();
            const int blk = lane >> 4, jc = lane & 15; const LAS float* Lb = F0 + (16 * blk) * 65 + 16 * blk; float tc[16];
#pragma unroll
            for (int r = 0; r < 16; ++r) { float val = (r == jc) ? 1.f : 0.f;
#pragma unroll
                for (int i = 0; i < r; ++i) val += Lb[r * 65 + i] * tc[i];
                tc[r] = val; }
            asm volatile("s_waitcnt lgkmcnt(0)" ::: "memory");
#pragma unroll
            for (int r = 0; r < 16; ++r) F0[(16 * blk + r) * 65 + 16 * blk + jc] = tc[r];
        }
        RW_BAR();
        if (w < 2) { RW_LANES();
            const int o1 = 32 * w, o2 = 32 * w + 16; f32x4 d = {0.f, 0.f, 0.f, 0.f};
#pragma unroll
            for (int ks = 0; ks < 4; ++ks) d = __builtin_amdgcn_mfma_f32_16x16x4f32(F0[(o2 + fr) * 65 + o1 + 4 * ks + fq], F0[(o1 + 4 * ks + fq) * 65 + o1 + fr], d, 0, 0, 0);
            LAS float* tm = TMP + w * 16 * 17;
#pragma unroll
            for (int r = 0; r < 4; ++r) tm[(4 * fq + r) * 17 + fr] = d[r];
            asm volatile("s_waitcnt lgkmcnt(0)" ::: "memory");
            f32x4 d2 = {0.f, 0.f, 0.f, 0.f};
#pragma unroll
            for (int ks = 0; ks < 4; ++ks) d2 = __builtin_amdgcn_mfma_f32_16x16x4f32(F0[(o2 + fr) * 65 + o2 + 4 * ks + fq], tm[(4 * ks + fq) * 17 + fr], d2, 0, 0, 0);
            asm volatile("s_waitcnt lgkmcnt(0)" ::: "memory");
#pragma unroll
            for (int r = 0; r < 4; ++r) F0[(o2 + 4 * fq + r) * 65 + o1 + fr] = d2[r];
        }
        RW_BAR();
        if (w < 4) { RW_LANES();
            const int ti = w >> 1, tj = w & 1; f32x4 d = {0.f, 0.f, 0.f, 0.f};
#pragma unroll
            for (int ks = 0; ks < 8; ++ks) d = __builtin_amdgcn_mfma_f32_16x16x4f32(F0[(32 + 16 * ti + fr) * 65 + 4 * ks + fq], F0[(4 * ks + fq) * 65 + 16 * tj + fr], d, 0, 0, 0);
#pragma unroll
            for (int r = 0; r < 4; ++r) TMP[(16 * ti + 4 * fq + r) * 33 + 16 * tj + fr] = d[r];
        }
        RW_BAR();
        if (w < 4) { RW_LANES();
            const int ti = w >> 1, tj = w & 1; f32x4 d = {0.f, 0.f, 0.f, 0.f};
#pragma unroll
            for (int ks = 0; ks < 8; ++ks) d = __builtin_amdgcn_mfma_f32_16x16x4f32(F0[(32 + 16 * ti + fr) * 65 + 32 + 4 * ks + fq], TMP[(4 * ks + fq) * 33 + 16 * tj + fr], d, 0, 0, 0);
#pragma unroll
            for (int r = 0; r < 4; ++r) F0[(32 + 16 * ti + 4 * fq + r) * 65 + 16 * tj + fr] = d[r];
        }
        RW_BAR();
        { RW_LANES(); const int t = tid >> 3, i0 = (tid & 7) * 8;
#pragma unroll
          for (int e = 0; e < 8; ++e) B11[t * LD + i0 + e] = f2bf(F0[t * 65 + i0 + e]); }
        RW_BAR();
        { RW_LANES();
#pragma unroll
        for (int e = 0; e < 4; ++e) { const int tl = 4 * w + e, prod = tl >> 4, ti = (tl >> 2) & 3, tj = tl & 3; f32x4 d = {0.f, 0.f, 0.f, 0.f};
            d = prod == 0 ? mm_tile(B11, B4, ti, tj, fr, fq, d) : mm_tile(B8, B7, ti, tj, fr, fq, d);
            LAS bf16_t* dst = (prod == 0 ? B0 : B2) + (16 * tj + fr) * LD + 16 * ti + 4 * fq;
            *(LAS unsigned long long*)dst = (unsigned long long)pk2(d[0], d[1]) | ((unsigned long long)pk2(d[2], d[3]) << 32); } }
        RW_BAR();
        { RW_LANES();
#pragma unroll
        for (int e = 0; e < 2; ++e) { const int tl = 2 * w + e, ti = tl >> 2, tj = tl & 3; f32x4 d = {0.f, 0.f, 0.f, 0.f};
            d = mm_tile(B11, B2, ti, tj, fr, fq, d);
            LAS bf16_t* dst = B3 + (16 * tj + fr) * LD + 16 * ti + 4 * fq;
            *(LAS unsigned long long*)dst = (unsigned long long)pk2(d[0], d[1]) | ((unsigned long long)pk2(d[2], d[3]) << 32); } }
        RW_BAR();
        for (int rp_ = 0; rp_ < ((PROF_PH) == 23 ? 2 : 1); ++rp_) {
        { RW_LANES();
#pragma unroll
        for (int e = 0; e < 8; ++e) { const int tl = 8 * w + e, prod = tl >> 4, ti = (tl >> 2) & 3, tj = tl & 3; f32x4 d = {0.f, 0.f, 0.f, 0.f};
            if (prod == 0) { d = mm_tile(B5, B3, ti, tj, fr, fq, d); d = mm_tile(B6, B7, ti, tj, fr, fq, d);
                *(GAS f32x4*)(cb.Z + (size_t)item * 4096 + (16 * tj + fr) * 64 + 4 * ((4 * ti + fq) ^ fr)) = d; }
            else if (prod == 1) { d = mm_tile(B9, B3, ti, tj, fr, fq, d); d = mm_tile(B10, B7, ti, tj, fr, fq, d);
                *(GAS unsigned long long*)(cb.YV + (size_t)item * 4096 + (16 * tj + fr) * 64 + 16 * ti + 4 * fq) = (unsigned long long)pk2(d[0], d[1]) | ((unsigned long long)pk2(d[2], d[3]) << 32); }
            else if (prod == 2) { d = mm_tile(B9, B0, ti, tj, fr, fq, d);
#pragma unroll
                for (int r = 0; r < 4; ++r) { const int t = 16 * ti + 4 * fq + r, c = 16 * tj + fr; B4[t * LD + sigpos(c)] = f2bf(d[r] + bf2f(B1[t * LD + c])); } }
            else { d = mm_tile(B5, B0, ti, tj, fr, fq, d);
#pragma unroll
                for (int r = 0; r < 4; ++r) { const int c = 16 * ti + 4 * fq + r, c2 = 16 * tj + fr; B8[c * LD + sigpos(c2)] = f2bf(d[r] + (c == c2 ? GC[c] : 0.f)); } } } }
        RW_BAR();
        }
        { RW_LANES(); const int r = tid >> 3, ch = (tid & 7) * 8;
          *(GAS v4u*)(cb.G + (size_t)item * 4096 + r * 64 + ch) = *(const LAS v4u*)(B4 + r * LD + ch);
          *(GAS v4u*)(cb.PT + (size_t)item * 4096 + r * 64 + 8 * ((tid & 7) ^ (r & 7))) = *(const LAS v4u*)(B8 + r * LD + ch); }
        RW_BAR();
    }
}
constexpr int SC_NS = 10, SC_SLOT = 12288, SC_LAG = 6;
__device__ __forceinline__ void scan_compute(LAS unsigned char* L, const ChunkBufs cb, int bh, int tj, int lane, volatile LAS unsigned* flags) {
    const int fr = lane & 15, fq = lane >> 4; const int NC = SEQ / 64;
    bf16x8 Bf0 = {0, 0, 0, 0, 0, 0, 0, 0}, Bf1 = {0, 0, 0, 0, 0, 0, 0, 0};
    bf16_t* s0 = cb.S0 + (size_t)(bh * NC) * 4096 + (16 * tj + fr) * 64 + 8 * fq;
    const int po0 = fr * 128 + 16 * ((fq) ^ (fr & 7)), po1 = fr * 128 + 16 * ((4 + fq) ^ (fr & 7));
    int slot = 0;
    for (int chunk = 0; chunk < NC; ++chunk) {
        unsigned spins = 0;
        while (true) { const unsigned a = flags[0], b = flags[1], c = flags[2]; const unsigned m = a < b ? (a < c ? a : c) : (b < c ? b : c); if ((int)m >= chunk + 1 || ++spins > (1u << 22)) break; __builtin_amdgcn_s_sleep(1); }
        const LAS unsigned char* sp = L + slot * SC_SLOT;
        bf16x8 a0[4], a1[4]; f32x4 z[4];
#pragma unroll
        for (int ti = 0; ti < 4; ++ti) { a0[ti] = *(const LAS bf16x8*)(sp + ti * 2048 + po0); a1[ti] = *(const LAS bf16x8*)(sp + ti * 2048 + po1); z[ti] = *(const LAS f32x4*)(sp + 8192 + fr * 256 + 16 * ((4 * ti + fq) ^ fr)); }
        asm volatile("s_waitcnt lgkmcnt(0)" ::: "memory");
        if (lane == 0) flags[3] = (unsigned)(chunk + 1);
        *(GAS bf16x8*)(s0 + (size_t)chunk * 4096) = Bf0; *(GAS bf16x8*)(s0 + (size_t)chunk * 4096 + 32) = Bf1;
        f32x4 acc[4];
#pragma unroll
        for (int ti = 0; ti < 4; ++ti) { acc[ti] = __builtin_amdgcn_mfma_f32_16x16x32_bf16(a0[ti], Bf0, z[ti], 0, 0, 0); acc[ti] = __builtin_amdgcn_mfma_f32_16x16x32_bf16(a1[ti], Bf1, acc[ti], 0, 0, 0); }
        v4u m0, m1;
        m0.x = pk2(acc[0][0], acc[0][1]); m0.y = pk2(acc[0][2], acc[0][3]); m0.z = pk2(acc[1][0], acc[1][1]); m0.w = pk2(acc[1][2], acc[1][3]);
        m1.x = pk2(acc[2][0], acc[2][1]); m1.y = pk2(acc[2][2], acc[2][3]); m1.z = pk2(acc[3][0], acc[3][1]); m1.w = pk2(acc[3][2], acc[3][3]);
        Bf0 = __builtin_bit_cast(bf16x8, m0); Bf1 = __builtin_bit_cast(bf16x8, m1);
        slot = slot + 1 == SC_NS ? 0 : slot + 1;
    }
}
__device__ __forceinline__ void scan_loader(LAS unsigned char* L, const ChunkBufs cb, int bh, int tj, int lw, int lane, volatile LAS unsigned* flags) {
    const int NC = SEQ / 64;
    const char* src[4];
#pragma unroll
    for (int k = 0; k < 4; ++k) { const int pc = 4 * lw + k;
        src[k] = pc < 8 ? (const char*)(cb.PT + (size_t)(bh * NC) * 4096) + pc * 1024 + lane * 16 : (const char*)(cb.Z + (size_t)(bh * NC) * 4096) + tj * 4096 + (pc - 8) * 1024 + lane * 16; }
    const size_t st0 = 8192, st1 = 16384;
    int slot = 0;
    for (int c = 0; c < NC; ++c) {
        unsigned spins = 0;
        while ((int)flags[3] < c - SC_NS + 1 && ++spins < (1u << 22)) __builtin_amdgcn_s_sleep(1);
        const unsigned dst = (unsigned)(slot * SC_SLOT + 4 * lw * 1024);
#pragma unroll
        for (int k = 0; k < 4; ++k) { const int pc = 4 * lw + k;
            __builtin_amdgcn_global_load_lds((const unsigned*)(src[k] + (size_t)c * (pc < 8 ? st0 : st1)), (LAS unsigned*)(L + dst + k * 1024), 16, 0, 0); }
        if (c >= SC_LAG) { asm volatile("s_waitcnt vmcnt(24)" ::: "memory"); if (lane == 0) flags[lw] = (unsigned)(c - SC_LAG + 1); }
        slot = slot + 1 == SC_NS ? 0 : slot + 1;
    }
    asm volatile("s_waitcnt vmcnt(0)" ::: "memory");
    if (lane == 0) flags[lw] = (unsigned)NC;
}
constexpr int O_SG = 0  , O_Y = 9216  , O_GT = O_Y + 16640  ;
__device__ __forceinline__ void out_phase(LAS unsigned char* L, const bf16_t* P, const sk::RwkvW W, const ChunkBufs cb, bf16_t* MIX, int tid_in, int first, int stride) {
    const int w = __builtin_amdgcn_readfirstlane(tid_in >> 6);
    LAS bf16_t* SG = (LAS bf16_t*)(L + O_SG); LAS float* Y = (LAS float*)(L + O_Y); LAS float* GT = (LAS float*)(L + O_GT);
    for (int item = first; item < NITEMS; item += stride) {
        const int bh = item / (SEQ / 64), chunk = item % (SEQ / 64), b = bh / 6, h = bh % 6; const int tok0 = b * SEQ + chunk * 64; const size_t ib = (size_t)item * 4096;
        { RW_LANES(); const int t = tid >> 3, sub = tid & 7, tok = tok0 + t; const bool hp = (chunk * 64 + t) > 0;
          const bf16_t* rc = P + (size_t)tok * LDP + 1856 + 8 * sub; const v4u z4 = {0u, 0u, 0u, 0u};
          const v4u gc4 = *(const GAS v4u*)rc, gp4 = hp ? *(const GAS v4u*)(rc - LDP) : z4;
          const f32x4 m0 = *(const GAS f32x4*)(W.mu + 1216 + 8 * sub), m1 = *(const GAS f32x4*)(W.mu + 1220 + 8 * sub);
          const unsigned cw_[4] = {gc4.x, gc4.y, gc4.z, gc4.w}, pw_[4] = {gp4.x, gp4.y, gp4.z, gp4.w}; unsigned o[4];
#pragma unroll
          for (int e2 = 0; e2 < 4; ++e2) { float x[2];
#pragma unroll
              for (int u = 0; u < 2; ++u) { const int e = 2 * e2 + u; const float c1 = bf2f((bf16_t)((cw_[e2] >> (16 * u)) & 0xffff)), p1 = bf2f((bf16_t)((pw_[e2] >> (16 * u)) & 0xffff));
                  x[u] = fsigm(c1 + (e < 4 ? m0[e & 3] : m1[e & 3]) * (p1 - c1)); }
              o[e2] = pk2(x[0], x[1]); }
          *(LAS v4u*)(SG + t * LD + 8 * sub) = (v4u){o[0], o[1], o[2], o[3]}; }
        RW_BAR();
        { RW_LANES();
#pragma unroll
        for (int e = 0; e < 2; ++e) { const int tl = 2 * w + e, ti = tl >> 2, tj = tl & 3;
            const unsigned long long yw = *(const GAS unsigned long long*)(cb.YV + ib + (16 * tj + fr) * 64 + 16 * ti + 4 * fq);
            f32x4 d = {bf2f((bf16_t)(yw & 0xffff)), bf2f((bf16_t)((yw >> 16) & 0xffff)), bf2f((bf16_t)((yw >> 32) & 0xffff)), bf2f((bf16_t)(yw >> 48))}; f32x4 g = {0.f, 0.f, 0.f, 0.f};
#pragma unroll
            for (int kk = 0; kk < 2; ++kk) {
                const bf16x8 a = *(const GAS bf16x8*)(cb.G + ib + (16 * ti + fr) * 64 + 32 * kk + 8 * fq), bb = *(const GAS bf16x8*)(cb.S0 + ib + (16 * tj + fr) * 64 + 32 * kk + 8 * fq);
                d = __builtin_amdgcn_mfma_f32_16x16x32_bf16(a, bb, d, 0, 0, 0);
                const bf16x8 a2 = *(const LAS bf16x8*)(SG + (16 * ti + fr) * LD + 32 * kk + 8 * fq), b2 = *(const GAS bf16x8*)(cb.G2T + (size_t)(64 * h + 16 * tj + fr) * 64 + 32 * kk + 8 * fq);
                g = __builtin_amdgcn_mfma_f32_16x16x32_bf16(a2, b2, g, 0, 0, 0); }
#pragma unroll
            for (int r = 0; r < 4; ++r) { Y[(16 * ti + 4 * fq + r) * 65 + 16 * tj + fr] = d[r]; GT[(16 * ti + 4 * fq + r) * 65 + 16 * tj + fr] = g[r]; } } }
        RW_BAR();
        { RW_LANES(); const int t = tid >> 3, sub = tid & 7, tok = tok0 + t; float yv[8], s = 0.f;
#pragma unroll
          for (int e = 0; e < 8; ++e) { yv[e] = bf2f(f2bf(Y[t * 65 + 8 * sub + e])); s += yv[e]; }
          s += __shfl_xor(s, 1); s += __shfl_xor(s, 2); s += __shfl_xor(s, 4);
          const float mean = s * (1.0f / 64.0f); float q = 0.f;
#pragma unroll
          for (int e = 0; e < 8; ++e) { const float dd = yv[e] - mean; q += dd * dd; }
          q += __shfl_xor(q, 1); q += __shfl_xor(q, 2); q += __shfl_xor(q, 4);
          const float rstd = 1.0f / sqrtf(q * (1.0f / 64.0f) + GN_EPS), dot = cb.DOT[(size_t)tok * 6 + h];
          unsigned o[4];
#pragma unroll
          for (int e = 0; e < 8; e += 2) { float r2[2];
#pragma unroll
              for (int u = 0; u < 2; ++u) { const int v = 8 * sub + e + u, hc = 64 * h + v; const float yn = (yv[e + u] - mean) * rstd * W.ln_w[hc] + W.ln_b[hc];
                  r2[u] = (yn + dot * bf2f(cb.VOUT[(size_t)tok * 384 + hc])) * GT[t * 65 + v]; }
              o[e >> 1] = pk2(r2[0], r2[1]); }
          *(GAS v4u*)(MIX + (size_t)tok * DM + 384 + 64 * h + 8 * sub) = (v4u){o[0], o[1], o[2], o[3]}; }
        RW_BAR();
    }
}
}
namespace at {
constexpr int LDK = 72, LDV = 264;
constexpr int A_K = 0, A_V = 256 * LDK * 2  , A_BIAS = A_V + 64 * LDV * 2  , A_END = A_BIAS + 128 * 6 * 4;
__device__ __forceinline__ int vpos(int key) { return (key & ~31) + 8 * ((key >> 2) & 3) + 4 * ((key >> 4) & 1) + (key & 3); }
__device__ __forceinline__ unsigned pk2(float lo, float hi) { typedef float f2_t __attribute__((ext_vector_type(2))); typedef __bf16 b2_t __attribute__((ext_vector_type(2))); f2_t v = {lo, hi}; return __builtin_bit_cast(unsigned, __builtin_convertvector(v, b2_t)); }
#define AT_BAR() do { asm volatile("s_waitcnt vmcnt(0) lgkmcnt(0)" ::: "memory"); __builtin_amdgcn_s_barrier(); asm volatile("" ::: "memory"); } while (0)

__device__ __forceinline__ void stage_kv(LAS unsigned char* L, int tid, const bf16_t* kbase, const bf16_t* vbase, long pitch, int jvalid0, const float* gk) {
    LAS bf16_t* Kl = (LAS bf16_t*)(L + A_K); LAS bf16_t* VTl = (LAS bf16_t*)(L + A_V);
#pragma unroll
    for (int it = 0; it < 4; ++it) { const int idx = it * 512 + tid, key = idx >> 3, ch = idx & 7;
        v4u raw = {0u, 0u, 0u, 0u}; if (key >= jvalid0) raw = *(const GAS v4u*)(kbase + (long)key * pitch + 8 * ch);
        float f[8]; f[0] = bf2f((bf16_t)(raw.x & 0xffff)); f[1] = bf2f((bf16_t)(raw.x >> 16)); f[2] = bf2f((bf16_t)(raw.y & 0xffff)); f[3] = bf2f((bf16_t)(raw.y >> 16));
        f[4] = bf2f((bf16_t)(raw.z & 0xffff)); f[5] = bf2f((bf16_t)(raw.z >> 16)); f[6] = bf2f((bf16_t)(raw.w & 0xffff)); f[7] = bf2f((bf16_t)(raw.w >> 16));
        float ss = 0.f;
#pragma unroll
        for (int e = 0; e < 8; ++e) ss += f[e] * f[e];
        ss += __shfl_xor(ss, 1); ss += __shfl_xor(ss, 2); ss += __shfl_xor(ss, 4);
        const float rs = 1.0f / sqrtf(ss * (1.0f / 64.0f) + EPS);
        const f32x4 g0 = *(const GAS f32x4*)(gk + 8 * ch), g1 = *(const GAS f32x4*)(gk + 8 * ch + 4);
        v4u o; o.x = pk2(f[0] * rs * g0[0], f[1] * rs * g0[1]); o.y = pk2(f[2] * rs * g0[2], f[3] * rs * g0[3]); o.z = pk2(f[4] * rs * g1[0], f[5] * rs * g1[1]); o.w = pk2(f[6] * rs * g1[2], f[7] * rs * g1[3]);
        *(LAS v4u*)(Kl + key * LDK + 8 * ch) = o; }
#pragma unroll
    for (int it = 0; it < 4; ++it) { const int idx = it * 512 + tid, key = idx & 255, ch = idx >> 8;
        v4u raw = {0u, 0u, 0u, 0u}; if (key >= jvalid0) raw = *(const GAS v4u*)(vbase + (long)key * pitch + 8 * ch);
        LAS bf16_t* d = VTl + (8 * ch) * LDV + vpos(key);
        d[0 * LDV] = (bf16_t)(raw.x & 0xffff); d[1 * LDV] = (bf16_t)(raw.x >> 16); d[2 * LDV] = (bf16_t)(raw.y & 0xffff); d[3 * LDV] = (bf16_t)(raw.y >> 16);
        d[4 * LDV] = (bf16_t)(raw.z & 0xffff); d[5 * LDV] = (bf16_t)(raw.z >> 16); d[6 * LDV] = (bf16_t)(raw.w & 0xffff); d[7 * LDV] = (bf16_t)(raw.w >> 16); }
}
__device__ __forceinline__ void load_q(const bf16_t* qrow, const float* gq, int fq, bf16x8& q0, bf16x8& q1) {
    const v4u r0 = *(const GAS v4u*)(qrow + 8 * fq), r1 = *(const GAS v4u*)(qrow + 32 + 8 * fq);
    float f[16]; const unsigned w[8] = {r0.x, r0.y, r0.z, r0.w, r1.x, r1.y, r1.z, r1.w};
#pragma unroll
    for (int e = 0; e < 8; ++e) { f[2 * e] = bf2f((bf16_t)(w[e] & 0xffff)); f[2 * e + 1] = bf2f((bf16_t)(w[e] >> 16)); }
    float ss = 0.f;
#pragma unroll
    for (int e = 0; e < 16; ++e) ss += f[e] * f[e];
    ss += __shfl_xor(ss, 16); ss += __shfl_xor(ss, 32);
    const float rs = 0.125f / sqrtf(ss * (1.0f / 64.0f) + EPS);
    const f32x4 g0 = *(const GAS f32x4*)(gq + 8 * fq), g1 = *(const GAS f32x4*)(gq + 8 * fq + 4), g2 = *(const GAS f32x4*)(gq + 32 + 8 * fq), g3 = *(const GAS f32x4*)(gq + 36 + 8 * fq);
    v4u a, b;
    a.x = pk2(f[0] * rs * g0[0], f[1] * rs * g0[1]); a.y = pk2(f[2] * rs * g0[2], f[3] * rs * g0[3]); a.z = pk2(f[4] * rs * g1[0], f[5] * rs * g1[1]); a.w = pk2(f[6] * rs * g1[2], f[7] * rs * g1[3]);
    b.x = pk2(f[8] * rs * g2[0], f[9] * rs * g2[1]); b.y = pk2(f[10] * rs * g2[2], f[11] * rs * g2[3]); b.z = pk2(f[12] * rs * g3[0], f[13] * rs * g3[1]); b.w = pk2(f[14] * rs * g3[2], f[15] * rs * g3[3]);
    q0 = __builtin_bit_cast(bf16x8, a); q1 = __builtin_bit_cast(bf16x8, b);
}
template <int NT, bool SWA> __device__ __forceinline__ void attn_wave(const LAS unsigned char* L, bf16x8 q0, bf16x8 q1, int kt0, int qi0, int hq, float sink, bool first_block, bf16_t* outp, int fr, int fq) {
    const LAS bf16_t* Kl = (const LAS bf16_t*)(L + A_K); const LAS bf16_t* VTl = (const LAS bf16_t*)(L + A_V); const LAS float* bias = (const LAS float*)(L + A_BIAS);
    f32x4 s[NT];
#pragma unroll
    for (int t = 0; t < NT; ++t) { const LAS bf16_t* kr = Kl + (16 * (kt0 + t) + fr) * LDK + 8 * fq;
        const f32x4 z = {0.f, 0.f, 0.f, 0.f};
        s[t] = __builtin_amdgcn_mfma_f32_16x16x32_bf16(*(const LAS bf16x8*)kr, q0, z, 0, 0, 0);
        s[t] = __builtin_amdgcn_mfma_f32_16x16x32_bf16(*(const LAS bf16x8*)(kr + 32), q1, s[t], 0, 0, 0);
        if (t & 1) __builtin_amdgcn_sched_barrier(0); }
    float mx = SWA ? sink : -3.0e38f;
#pragma unroll
    for (int t = 0; t < NT; ++t)
#pragma unroll
        for (int r = 0; r < 4; ++r) {
            if (SWA) { const int kj = 16 * (kt0 + t) + 4 * fq + r, dist = qi0 + fr + 128 - kj; const bool valid = dist >= 0 && dist < 128 && !(first_block && kj < 128);
                s[t][r] = valid ? s[t][r] + bias[(valid ? dist : 0) * 6 + hq] : -3.0e38f; }
            mx = fmaxf(mx, s[t][r]); }
    mx = fmaxf(mx, __shfl_xor(mx, 16)); mx = fmaxf(mx, __shfl_xor(mx, 32));
    float l = 0.f;
#pragma unroll
    for (int t = 0; t < NT; ++t)
#pragma unroll
        for (int r = 0; r < 4; ++r) { const float p = __expf(s[t][r] - mx); s[t][r] = p; l += p; }
    l += __shfl_xor(l, 16); l += __shfl_xor(l, 32);
    if (SWA) l += __expf(sink - mx);
    f32x4 o[4];
#pragma unroll
    for (int dt = 0; dt < 4; ++dt) o[dt] = (f32x4){0.f, 0.f, 0.f, 0.f};
#pragma unroll
    for (int ks = 0; ks < NT / 2; ++ks) { v4u pw; pw.x = pk2(s[2 * ks][0], s[2 * ks][1]); pw.y = pk2(s[2 * ks][2], s[2 * ks][3]); pw.z = pk2(s[2 * ks + 1][0], s[2 * ks + 1][1]); pw.w = pk2(s[2 * ks + 1][2], s[2 * ks + 1][3]);
        const bf16x8 pb = __builtin_bit_cast(bf16x8, pw);
#pragma unroll
        for (int dt = 0; dt < 4; ++dt) o[dt] = __builtin_amdgcn_mfma_f32_16x16x32_bf16(*(const LAS bf16x8*)(VTl + (16 * dt + fr) * LDV + 32 * (kt0 / 2 + ks) + 8 * fq), pb, o[dt], 0, 0, 0);
        __builtin_amdgcn_sched_barrier(0); }
    const float inv = 1.0f / l;
#pragma unroll
    for (int dt = 0; dt < 4; ++dt) *(GAS unsigned long long*)(outp + (long)fr * DM + 16 * dt + 4 * fq) = (unsigned long long)pk2(o[dt][0] * inv, o[dt][1] * inv) | ((unsigned long long)pk2(o[dt][2] * inv, o[dt][3] * inv) << 32);
}
struct AttnArgs { const bf16_t* PROJ; const bf16_t* MKV; bf16_t* MIX; const float* biastab; const float *sinks, *gq, *gk, *gmq, *gmk; };
__device__ __forceinline__ void attn_item(LAS unsigned char* L, const AttnArgs A, int item, int tid_in) {
    const int w = __builtin_amdgcn_readfirstlane(tid_in >> 6);
    if (item < 256) {
        const int b = item >> 7, hkv = (item >> 6) & 1, blk = item & 63; const long tokb = (long)b * SEQ + blk * 128;
        { int lt_ = tid_in; asm volatile("" : "+v"(lt_)); const int tid = lt_;
          stage_kv(L, tid, A.PROJ + (tokb - 128) * LDP + 384 + 64 * hkv, A.PROJ + (tokb - 128) * LDP + 512 + 64 * hkv, LDP, blk == 0 ? 128 : 0, A.gk);
          LAS float* bl = (LAS float*)(L + A_BIAS); for (int i = tid; i < 768; i += 512) bl[i] = A.biastab[i]; }
        AT_BAR();
        { int lt_ = tid_in; asm volatile("" : "+v"(lt_)); const int lane = lt_ & 63, fr = lane & 15, fq = lane >> 4;
#pragma unroll 1
          for (int g = 0; g < 3; ++g) { const int hq = 3 * hkv + g; bf16x8 q0, q1;
              load_q(A.PROJ + (tokb + 16 * w + fr) * LDP + 64 * hq, A.gq, fq, q0, q1);
              attn_wave<10, true>(L, q0, q1, w & ~1, 16 * w, hq, A.sinks[hq], blk == 0, A.MIX + (tokb + 16 * w) * DM + 64 * hq, fr, fq); } }
        AT_BAR();
    } else {
        const int pr = item - 256, b = pr >> 7, h = (pr >> 5) & 3, blk2 = pr & 31;
        { int lt_ = tid_in; asm volatile("" : "+v"(lt_)); const int tid = lt_;
          stage_kv(L, tid, A.MKV + (long)(b * 256) * 512 + 64 * h, A.MKV + (long)(b * 256) * 512 + 256 + 64 * h, 512, 0, A.gmk); }
        AT_BAR();
        { int lt_ = tid_in; asm volatile("" : "+v"(lt_)); const int lane = lt_ & 63, fr = lane & 15, fq = lane >> 4;
#pragma unroll 1
          for (int u = 0; u < 2; ++u) { const long tokb = (long)b * SEQ + (2 * blk2 + u) * 128; bf16x8 q0, q1;
              load_q(A.PROJ + (tokb + 16 * w + fr) * LDP + 1984 + 64 * h, A.gmq, fq, q0, q1);
              attn_wave<16, false>(L, q0, q1, 0, 16 * w, 0, 0.f, false, A.MIX + (tokb + 16 * w) * DM + 768 + 64 * h, fr, fq); } }
        AT_BAR();
    }
}
}
constexpr int NWAVES = 8;
namespace mk {
constexpr size_t WS_CTL = 0, CTL_ZERO_BYTES = 1 * MiB;
constexpr size_t CTL_SSQ = 512 * 1024;
constexpr size_t WS_SMALL = 1 * MiB, SM_BIAS = 0, SM_SSQM = 4096, SM_MKV = 512 * 1024;
constexpr size_t WS_MEMB = 2 * MiB, WS_WT = 3 * MiB, WS_XB = 28 * MiB, WS_VF = 60 * MiB, WS_PROJ = 72 * MiB, WS_MIX = 144 * MiB, WS_PREP = 176 * MiB, WS_U = 72 * MiB, WS_ACT = 160 * MiB, WS_WIN1 = 248 * MiB  , WS_END = 255 * MiB;
constexpr size_t WT_IN = 0, WT_OUT = 4718592, WT_UP = WT_OUT + 2 * MiB, WT_DOWN = WT_UP + 11 * MiB, WT_MKV = WT_DOWN + 5767168;
constexpr int CW_TMO = 0, CW_BAR = 4096, CW_ATTQ = 8192, CW_CHQ = 8448;
constexpr int LDS_BYTES = 163840, LDSCTL_OFF = LDS_BYTES - 512, MISC_OFF = LDSCTL_OFF + 320;
constexpr size_t SM_W2T = 8192, SM_A2T = 32768, SM_V2T = 57344, SM_G2T = 81920, SM_LORA_L = 122880;
constexpr size_t WS_PT = 176 * MiB, WS_G = 188 * MiB, WS_S0 = 200 * MiB, WS_Z = 212 * MiB, WS_YV = 236 * MiB  , WS_DOT = 254 * MiB;
#ifndef PROF_PH
#define PROF_PH -1
#endif
#ifndef PROF_N
#define PROF_N 1
#endif
#ifndef PROF_TA
#define PROF_TA -1
#endif
#ifndef PROF_TB
#define PROF_TB -1
#endif
#define REPEAT(k) for (int rep_ = 0; rep_ < ((PROF_PH) == (k) ? (PROF_N) : 1); ++rep_)
#ifndef FAST_RWKV
#define FAST_RWKV 1
#endif
#ifndef FAST_ATTN
#define FAST_ATTN 1
#endif

struct Args { const float* in[N_IN]; float* out; unsigned char* ws; int ph_lo, ph_hi; };

__device__ __forceinline__ unsigned pk2(float lo, float hi) { typedef float f2_t __attribute__((ext_vector_type(2))); typedef __bf16 b2_t __attribute__((ext_vector_type(2))); f2_t v = {lo, hi}; return __builtin_bit_cast(unsigned, __builtin_convertvector(v, b2_t)); }
__device__ __forceinline__ float wave_sum(float v) {
#pragma unroll
    for (int o = 1; o < 64; o <<= 1) v += __shfl_xor(v, o);
    return v;
}
template <int MODE> __device__ __forceinline__ void transpose_item(const float* W, const float* g, int K, int N, bf16_t* WT, LAS float* scr, int item, int lane) {
    const int nblk = N / 32, kb = item / nblk, nb = item % nblk, k0 = 64 * kb, n0 = 32 * nb;
    float tv[32];
#pragma unroll
    for (int i = 0; i < 32; ++i) tv[i] = W[(size_t)(k0 + 2 * i + (lane >> 5)) * N + n0 + (lane & 31)];
#pragma unroll
    for (int i = 0; i < 32; ++i) { const int kk = 2 * i + (lane >> 5); float v = tv[i]; if (g) v *= g[k0 + kk]; scr[kk * 33 + (lane & 31)] = v; }
    LDS_WAIT(); asm volatile("" ::: "memory");
    const int c = lane & 7;
#pragma unroll
    for (int j = 0; j < 4; ++j) { const int n = (lane >> 3) + 8 * j; const LAS float* s = scr + (8 * c) * 33 + n;
        v4u o; o.x = pk2(s[0 * 33], s[1 * 33]); o.y = pk2(s[2 * 33], s[3 * 33]); o.z = pk2(s[4 * 33], s[5 * 33]); o.w = pk2(s[6 * 33], s[7 * 33]);
        int nr = n0 + n; if (MODE == 2) nr = nr < 1920 ? nr : nr + 64;
        if (MODE == 1) nr = nr < 2816 ? 256 * (nr >> 7) + (nr & 127) : 256 * ((nr - 2816) >> 7) + 128 + ((nr - 2816) & 127);
        *(GAS v4u*)(WT + (size_t)nr * K + k0 + 8 * c) = o; }
    LDS_WAIT(); asm volatile("" ::: "memory");
}
__device__ __forceinline__ void row_to_bf16(const float* xrow, bf16_t* orow, float* ssq_out, int lane) {
    const GAS f32x4* xr = (const GAS f32x4*)xrow + lane; f32x4 v[4]; float s = 0.f;
#pragma unroll
    for (int j = 0; j < 4; ++j) { v[j] = xr[64 * j]; s += (v[j].x * v[j].x + v[j].y * v[j].y) + (v[j].z * v[j].z + v[j].w * v[j].w); }
    s = wave_sum(s);
    GAS unsigned long long* o8 = (GAS unsigned long long*)orow + lane;
#pragma unroll
    for (int j = 0; j < 4; ++j) o8[64 * j] = (unsigned long long)pk2(v[j].x, v[j].y) | ((unsigned long long)pk2(v[j].z, v[j].w) << 32);
    if (lane == 0) *ssq_out = s;
}

__global__ void __launch_bounds__(NWAVES * 64, 2) mk_fwd(Args args) {
    extern __shared__ __attribute__((aligned(16))) unsigned char lds[];
    LAS unsigned char* L = (LAS unsigned char*)lds;
    volatile LAS unsigned* MISC = (volatile LAS unsigned*)(L + MISC_OFF);
    const int tid0 = threadIdx.x; const int wave0 = __builtin_amdgcn_readfirstlane(tid0 >> 6);
    const int G = gridDim.x;
    unsigned char* ws = args.ws;
    gu32* ctl = (gu32*)(ws + WS_CTL);
    for (int u = tid0; u < (LDS_BYTES - LDSCTL_OFF) / 4; u += NWAVES * 64) ((LAS unsigned*)(L + LDSCTL_OFF))[u] = 0u;
    __syncthreads();
    XcdBarrier bar = xcd_barrier_post((unsigned*)(ctl + CW_BAR), MISC + 8);
    const int lo = args.ph_lo, hi = args.ph_hi;
    int ph = 0;
#define PH_BEGIN if (lo <= ph && ph < hi) { if ((PROF_TA) >= 0 && blockIdx.x == 0 && tid0 == 0) MISC[24 + ph] = (unsigned)__builtin_amdgcn_s_memrealtime(); unsigned char* wsp = args.ws; asm volatile("" : "+s"(wsp)); int tid = wave0 * 64 + (int)__builtin_amdgcn_mbcnt_hi(~0u, __builtin_amdgcn_mbcnt_lo(~0u, 0u)); asm volatile("" : "+v"(tid)); const int lane = tid & 63, wave = __builtin_amdgcn_readfirstlane(tid >> 6); const long gtid = (long)blockIdx.x * (NWAVES * 64) + tid; const int gw = blockIdx.x * NWAVES + wave; LAS float* scr = (LAS float*)(L + wave * 16384); (void)lane; (void)gtid; (void)gw; (void)scr;
#define PH_END   if (ph + 1 < hi) { xcd_barrier(bar); if ((PROF_PH) == 30 && ph == 3) for (int xb_ = 0; xb_ < 10; ++xb_) xcd_barrier(bar); } } ++ph;
    float* out = args.out;
#define SSQ_A ((float*)(wsp + WS_CTL + CTL_SSQ))
#define SSQ_B (SSQ_A + 3 * MTOK)
#define biastab ((float*)(wsp + WS_SMALL + SM_BIAS))
#define ssqm ((float*)(wsp + WS_SMALL + SM_SSQM))
#define MKV ((bf16_t*)(wsp + WS_SMALL + SM_MKV))
#define MEMB ((bf16_t*)(wsp + WS_MEMB))
#define Wt_in ((bf16_t*)(wsp + (l == 0 ? WS_WT + WT_IN : WS_WIN1)))
#define Wt_out ((bf16_t*)(wsp + WS_WT + WT_OUT))
#define Wt_up ((bf16_t*)(wsp + WS_WT + WT_UP))
#define Wt_down ((bf16_t*)(wsp + WS_WT + WT_DOWN))
#define Wt_mkv ((bf16_t*)(wsp + (l == 0 ? WS_WT + WT_MKV : WS_WIN1 + 4718592)))
#define XB ((bf16_t*)(wsp + WS_XB))
#define VF ((bf16_t*)(wsp + WS_VF))
#define PROJ ((bf16_t*)(wsp + WS_PROJ))
#define MIX ((bf16_t*)(wsp + WS_MIX))
#define U ((bf16_t*)(wsp + WS_U))
#define ACT ((bf16_t*)(wsp + WS_ACT))
#define PA ((size_t)MTOK * 384)
#define pR ((bf16_t*)(wsp + WS_PREP))
#define pK (pR + PA)
#define pV (pR + 2 * PA)
#define pKK (pR + 3 * PA)
#define pB (pR + 4 * PA)
#define pLD (pR + 5 * PA)
    const long gsize = (long)G * (NWAVES * 64);
    const int NGW = G * NWAVES;

#define MK_W() sk::RwkvW W{args.in[I_MU] + l * 1280, args.in[I_MUV], args.in[I_W0] + l * 384, args.in[I_W2] + l * 32 * 384, args.in[I_A0] + l * 384, args.in[I_A2] + l * 32 * 384, args.in[I_V0], args.in[I_V2], args.in[I_G2] + l * 64 * 384, args.in[I_KK] + l * 384, args.in[I_KA] + l * 384, args.in[I_RK] + l * 384, args.in[I_LNW] + l * 384, args.in[I_LNB] + l * 384};
#define MK_CBUF() const rw::ChunkBufs cbuf{(bf16_t*)(wsp + WS_PT), (bf16_t*)(wsp + WS_G), (float*)(wsp + WS_Z), (bf16_t*)(wsp + WS_YV), (bf16_t*)(wsp + WS_S0), (bf16_t*)(wsp + WS_VF), (float*)(wsp + WS_DOT), (const bf16_t*)(wsp + WS_SMALL + SM_W2T + l * SM_LORA_L), (const bf16_t*)(wsp + WS_SMALL + SM_A2T + l * SM_LORA_L), (const bf16_t*)(wsp + WS_SMALL + SM_V2T + l * SM_LORA_L), (const bf16_t*)(wsp + WS_SMALL + SM_G2T + l * SM_LORA_L)};
    for (int l = 0; l < 2; ++l) {
        const float* xin = l == 0 ? args.in[I_X] : out;
        if (l == 0) {
        PH_BEGIN
            REPEAT(0) {
            const int I_IN = 16 * 68, I_KV = 16 * 16, NIT = 2 * (I_IN + I_KV);
            for (int it = gw; it < NIT; it += NGW) {
                int r = it; const int ll = r >= I_IN + I_KV ? 1 : 0; r -= ll * (I_IN + I_KV);
                bf16_t* win = (bf16_t*)(wsp + (ll == 0 ? WS_WT + WT_IN : WS_WIN1)); bf16_t* wkv = (bf16_t*)(wsp + (ll == 0 ? WS_WT + WT_MKV : WS_WIN1 + 4718592));
                if (r < I_IN) transpose_item<2>(args.in[I_WIN] + (size_t)ll * 1024 * 2176, args.in[I_MIXG] + ll * 1024, 1024, 2176, win, scr, r, lane);
                else transpose_item<0>(args.in[I_WMKV] + (size_t)ll * 1024 * 512, args.in[I_MEMG] + ll * 1024, 1024, 512, wkv, scr, r - I_IN, lane);
            }
            for (long i = gtid; i < 2 * 128 * 1024; i += gsize) { const int ll = (int)(i >> 17), n = (int)(i >> 10) & 127, k = (int)(i & 1023); float v = 0.f;
                if (ll > 0 && n < 16) v = args.in[I_WINV][k * 16 + n] * args.in[I_MIXG][1024 + k];
                ((bf16_t*)(wsp + (ll == 0 ? WS_WT + WT_IN : WS_WIN1)))[(size_t)(n < 64 ? 1920 + n : 2176 + n) * 1024 + k] = f2bf(v); }
            for (long i = gtid; i < 2 * 384 * 160; i += gsize) { const int ll = (int)(i / (384 * 160)), r2 = (int)(i % (384 * 160)), hc = r2 / 160, j = r2 % 160; bf16_t* sm = (bf16_t*)(wsp + WS_SMALL + ll * SM_LORA_L);
                if (j < 32) sm[SM_W2T / 2 + hc * 32 + j] = f2bf(args.in[I_W2][(size_t)ll * 32 * 384 + j * 384 + hc]);
                else if (j < 64) sm[SM_A2T / 2 + hc * 32 + (j - 32)] = f2bf(args.in[I_A2][(size_t)ll * 32 * 384 + (j - 32) * 384 + hc]);
                else if (j < 96) sm[SM_V2T / 2 + hc * 32 + (j - 64)] = f2bf((j - 64) < 16 ? args.in[I_V2][(j - 64) * 384 + hc] : 0.f);
                else sm[SM_G2T / 2 + hc * 64 + (j - 96)] = f2bf(args.in[I_G2][(size_t)ll * 64 * 384 + (j - 96) * 384 + hc]); }
            for (int m = gw; m < MTOK; m += NGW) row_to_bf16(args.in[I_X] + (size_t)m * DM, XB + (size_t)m * DM, SSQ_A + m, lane);
            for (int m = gw; m < 512; m += NGW) row_to_bf16(args.in[I_MEM] + (size_t)m * DM, MEMB + (size_t)m * DM, ssqm + m, lane);
            sk::d_biastab(args.in[I_RELB], biastab, gtid, gsize);
            }
        PH_END
        }
        PH_BEGIN
            REPEAT(1)
            { pg8::Gemm g{XB, Wt_in, MTOK, 2048, 1024}; pg8::StaticOrder S; S.init(MTOK, 2048, G, (int)blockIdx.x);
              pg8::EpiScaleBf16 E{PROJ, LDP, SSQ_A + (size_t)l * MTOK};
              pg8::gemm_phase<pg8::EpiScaleBf16, pg8::StaticOrder, true, true>(L, g, S, E, tid); }
        PH_END
        PH_BEGIN
            MK_W(); MK_CBUF(); (void)cbuf;
#if !FAST_ATTN
            sk::d_qknorm(PROJ, MTOK, LDP, args.in[I_AQN] + l * 64, args.in[I_AKN] + l * 64, args.in[I_MQN] + l * 64, 0, gtid, gsize);
            sk::d_qknorm(MKV, 512, 512, nullptr, nullptr, args.in[I_MKN] + l * 64, 1, gtid, gsize);
#endif
#if FAST_RWKV
            {
              const bool t8 = blockIdx.x < 64;
              const pg8::Gemm g = t8 ? pg8::Gemm{XB, Wt_in + (size_t)2048 * 1024, MTOK, 256, 1024} : pg8::Gemm{MEMB, Wt_mkv, 512, 512, 1024};
              pg8::StaticOrder S; if (t8) S.init(MTOK, 256, G, (int)blockIdx.x); else S.init(512, 512, G, (int)((blockIdx.x + 192) % G));
              const pg8::EpiScaleBf16 E = t8 ? pg8::EpiScaleBf16{PROJ + 2048, LDP, SSQ_A + (size_t)l * MTOK} : pg8::EpiScaleBf16{MKV, 512, ssqm};
              pg8::gemm_phase<pg8::EpiScaleBf16, pg8::StaticOrder, true, true>(L, g, S, E, tid); }
            { unsigned* qc = (unsigned*)(ctl + CW_CHQ + 64 * l);
              int q = rw::chunk_phase(L, PROJ, W, l, VF, cbuf, tid, qc, MISC + 21);
              const int I_OUT = 16 * 32, I_UP = 16 * 176, I_DN = 44 * 32, NIT = I_OUT + I_UP + I_DN;
              for (;;) { const int it = (q - rw::NITEMS) * NWAVES + wave;
                  if ((q - rw::NITEMS) * NWAVES >= NIT) break;
                  if (it < NIT) { int r = it;
                      if (r < I_OUT) transpose_item<0>(args.in[I_WOUT] + (size_t)l * 1024 * 1024, nullptr, 1024, 1024, Wt_out, scr, r, lane);
                      else if (r < I_OUT + I_UP) transpose_item<1>(args.in[I_WUP] + (size_t)l * 1024 * 5632, args.in[I_FFNG] + l * 1024, 1024, 5632, Wt_up, scr, r - I_OUT, lane);
                      else transpose_item<0>(args.in[I_WDOWN] + (size_t)l * 2816 * 1024, nullptr, 2816, 1024, Wt_down, scr, r - I_OUT - I_UP, lane); }
                  __syncthreads(); if (tid == 0) MISC[21] = atomicAdd(qc, 1u); __syncthreads(); q = (int)MISC[21]; __syncthreads(); } }
#else
            sk::d_rwkv_prep(PROJ, W, l, VF, pR, pK, pV, pKK, pB, pLD, gtid, gsize);
#endif
        PH_END
        PH_BEGIN
            MK_CBUF(); (void)cbuf;
            if (blockIdx.x < 48) {
#if FAST_RWKV
                REPEAT(3) { __syncthreads(); if (tid < 8) MISC[16 + tid] = 0u; __syncthreads();
                  const int sbh = (int)blockIdx.x >> 2, stj = (int)blockIdx.x & 3;
                  if (wave == 0) rw::scan_compute(L, cbuf, sbh, stj, lane, MISC + 16); else if (wave < 4) rw::scan_loader(L, cbuf, sbh, stj, wave - 1, lane, MISC + 16);
 }
#endif
            } else {
#if FAST_ATTN
                const at::AttnArgs A{PROJ, MKV, MIX, biastab, args.in[I_SINK] + l * 6, args.in[I_AQN] + l * 64, args.in[I_AKN] + l * 64, args.in[I_MQN] + l * 64, args.in[I_MKN] + l * 64};
                REPEAT(7) for (;;) {
                    if (tid == 0) MISC[20] = atomicAdd((unsigned*)(ctl + CW_ATTQ + 64 * l), 1u);
                    __syncthreads(); const int it = (int)MISC[20]; __syncthreads();
                    if (it >= 512) break;
                    at::attn_item(L, A, it < 256 ? 256 + it : it - 256, tid); }
#else
                const long gt2 = (long)(blockIdx.x - BATCH * 6) * (NWAVES * 64) + tid, gs2 = (long)(G - BATCH * 6) * (NWAVES * 64);
                REPEAT(7) sk::d_swa(PROJ, MIX, biastab, args.in[I_SINK] + l * 6, gt2, gs2);
                REPEAT(8) sk::d_memattn(PROJ, MKV, MIX, gt2, gs2);
#endif
            }
        PH_END
        PH_BEGIN
            MK_W(); MK_CBUF(); (void)cbuf;
#if FAST_RWKV
            REPEAT(4) rw::out_phase(L, PROJ, W, cbuf, MIX, tid, (int)blockIdx.x, G);
#else
            sk::d_rwkv_fin(PROJ, W, pR, pK, pV, MIX, gtid, gsize);
#endif
        PH_END
        PH_BEGIN
            if ((PROF_PH) == 31) { pg8::Gemm g2{MIX, Wt_out, MTOK, 1024, 1024}; pg8::StaticOrder S2; S2.init(MTOK, 1024, G, (int)blockIdx.x); pg8::EpiScaleBf16 E2{PROJ, 1024, SSQ_A}; pg8::gemm_phase<pg8::EpiScaleBf16, pg8::StaticOrder, true, true>(L, g2, S2, E2, tid); }
            pg8::Gemm g{MIX, Wt_out, MTOK, 1024, 1024}; pg8::StaticOrder S; S.init(MTOK, 1024, G, (int)blockIdx.x);
            pg8::EpiResid E{xin, out, XB, SSQ_B + (size_t)l * MTOK, 1024};
            pg8::gemm_phase<pg8::EpiResid, pg8::StaticOrder, true, true>(L, g, S, E, tid);
        PH_END
        PH_BEGIN
            REPEAT(5) {
            pg8::Gemm g{XB, Wt_up, 66 * 256, 5632, 1024}; pg8::StaticOrder S; S.init(66 * 256, 5632, G, (int)blockIdx.x);
            pg8::EpiConvAct E{ACT, SSQ_B + (size_t)l * MTOK, args.in[I_CW] + (size_t)l * 3 * 5632, args.in[I_CB] + (size_t)l * 5632};
            pg8::gemm_phase<pg8::EpiConvAct, pg8::StaticOrder, true, true>(L, g, S, E, tid); }
        PH_END
        PH_BEGIN
            if ((PROF_PH) == 32) { pg8::Gemm g2{ACT, Wt_down, MTOK, 1024, 2816}; pg8::StaticOrder S2; S2.init(MTOK, 1024, G, (int)blockIdx.x); pg8::EpiScaleBf16 E2{PROJ, 1024, SSQ_A}; pg8::gemm_phase<pg8::EpiScaleBf16, pg8::StaticOrder, true, true>(L, g2, S2, E2, tid); }
            pg8::Gemm g{ACT, Wt_down, MTOK, 1024, 2816}; pg8::StaticOrder S; S.init(MTOK, 1024, G, (int)blockIdx.x);
            pg8::EpiResid E{out, out, XB, SSQ_A + (size_t)(l + 1) * MTOK, 1024};
            pg8::gemm_phase<pg8::EpiResid, pg8::StaticOrder, true, true>(L, g, S, E, tid);
        PH_END
    }
    if ((PROF_TA) >= 0 && blockIdx.x == 0 && tid0 == 0) {
        MISC[24 + ph] = (unsigned)__builtin_amdgcn_s_memrealtime();
        const unsigned ta = MISC[24 + (PROF_TA) + 1] - MISC[24 + (PROF_TA)], tb = (PROF_TB) >= 0 ? MISC[24 + (PROF_TB) + 1] - MISC[24 + (PROF_TB)] : 0u;
        const unsigned long long extra = (unsigned long long)ta + 1000ull * (unsigned long long)(((tb + 50u) / 100u) * 100u);
        const unsigned long long t0 = __builtin_amdgcn_s_memrealtime(); while (__builtin_amdgcn_s_memrealtime() - t0 < extra) __builtin_amdgcn_s_sleep(32);
    }
#undef PH_BEGIN
#undef PH_END
}
constexpr int N_PHASES = 1 + 2 * 7;
}

#ifndef MK_PER_PHASE
#define MK_PER_PHASE 0
#endif
extern "C" void kernel_launch(void* const* d_in, const int* in_sizes, int n_in, void* d_out, int out_size, void* d_ws, size_t ws_size, hipStream_t stream) {
    static int grid = 0;
    if (grid == 0) {
        if (n_in != N_IN || out_size != MTOK * DM || ws_size < mk::WS_END) { fprintf(stderr, "kernel_launch: unexpected shapes (n_in %d out %d ws %zu)\n", n_in, out_size, ws_size); grid = -1; return; }
        int dev = 0, cus = 0, per_cu = 0;
        if (hipGetDevice(&dev) != hipSuccess || hipDeviceGetAttribute(&cus, hipDeviceAttributeMultiprocessorCount, dev) != hipSuccess) { grid = -1; return; }
        if (hipFuncSetAttribute((const void*)mk::mk_fwd, hipFuncAttributeMaxDynamicSharedMemorySize, mk::LDS_BYTES) != hipSuccess) { fprintf(stderr, "kernel_launch: hipFuncSetAttribute failed\n"); grid = -1; return; }
        if (hipOccupancyMaxActiveBlocksPerMultiprocessor(&per_cu, (const void*)mk::mk_fwd, NWAVES * 64, mk::LDS_BYTES) != hipSuccess || per_cu < 1) { fprintf(stderr, "kernel_launch: occupancy query says %d blocks per CU\n", per_cu); }
        (void)hipGetLastError();
        grid = cus;
    }
    if (grid < 0) return;
    if (hipMemsetAsync((char*)d_ws + mk::WS_CTL, 0, mk::CTL_ZERO_BYTES, stream) != hipSuccess) return;
    mk::Args a{};
    for (int i = 0; i < N_IN; ++i) a.in[i] = (const float*)d_in[i];
    a.out = (float*)d_out; a.ws = (unsigned char*)d_ws;
#if MK_PER_PHASE
    for (int p = 0; p < mk::N_PHASES; ++p) { a.ph_lo = p; a.ph_hi = p + 1; hipLaunchKernelGGL(mk::mk_fwd, dim3(grid), dim3(NWAVES * 64), mk::LDS_BYTES, stream, a); }
#else
    a.ph_lo = 0; a.ph_hi = mk::N_PHASES;
    hipLaunchKernelGGL(mk::mk_fwd, dim3(grid), dim3(NWAVES * 64), mk::LDS_BYTES, stream, a);
#endif
}
```

```cpp
#define MK_BUILD 1
#ifndef HOST_SIM
#include <hip/hip_runtime.h>
#include <cstdio>
#include <cstdint>
#endif
#ifndef SEQ_LEN
#define SEQ_LEN 8192
#endif
typedef unsigned short bf16_t;
constexpr int BATCH = 2, SEQ = SEQ_LEN, DM = 1024, MTOK = BATCH * SEQ, DFF = 2816, LDP = 2304  ;
constexpr float EPS = 1e-6f, GN_EPS = 64e-5f;
__host__ __device__ __forceinline__ float bf2f(bf16_t h) { unsigned u = (unsigned)h << 16; return __builtin_bit_cast(float, u); }
__host__ __device__ __forceinline__ bf16_t f2bf(float f) { unsigned u = __builtin_bit_cast(unsigned, f); return (bf16_t)((u + 0x7fffu + ((u >> 16) & 1u)) >> 16); }
__host__ __device__ __forceinline__ int t5_bucket(int dist) {
    if (dist < 16) return dist;
    const float v = logf((float)dist / 16.0f) / 2.0794415416798357f * 16.0f;
    int large = 16 + (int)v; return large < 31 ? large : 31;
}
constexpr size_t MiB = 1u << 20;
enum { I_X = 0, I_MEM, I_RELB, I_MIXG, I_WIN, I_WINV, I_AQN, I_AKN, I_SINK, I_MU, I_MUV, I_W0, I_W2, I_A0, I_A2, I_V0, I_V2, I_G2, I_KK, I_KA, I_RK, I_LNW, I_LNB, I_MEMG, I_WMKV, I_MQN, I_MKN, I_WOUT, I_FFNG, I_WUP, I_CW, I_CB, I_WDOWN, N_IN };
#ifndef PROF_PH
#define PROF_PH -1
#endif
#ifndef PROF_N
#define PROF_N 1
#endif
namespace sk {

__device__ __forceinline__ void d_wt(const float* W, const float* g, bf16_t* Wt, int K, int N, int Npad, long gtid, long gsize) {
    const long total = (long)Npad * K;
    for (long idx = gtid; idx < total; idx += gsize) {
        const int n = (int)(idx / K), k = (int)(idx % K);
        float v = 0.f;
        if (n < N) { v = W[(long)k * N + n]; if (g) v *= g[k]; }
        Wt[idx] = f2bf(v);
    }
}
#ifndef MK_BUILD
__global__ void k_wt(const float* W, const float* g, bf16_t* Wt, int K, int N, int Npad) { d_wt(W, g, Wt, K, N, Npad, (long)blockIdx.x * blockDim.x + threadIdx.x, (long)gridDim.x * blockDim.x); }
#endif
__device__ __forceinline__ void d_rowprep(const float* x, bf16_t* xb, float* ssq, int rows, long gtid, long gsize) {
    for (long r = gtid; r < rows; r += gsize) {
        const float* xr = x + (long)r * DM; bf16_t* o = xb + (long)r * DM; float s = 0.f;
        for (int c = 0; c < DM; ++c) { const float v = xr[c]; s += v * v; o[c] = f2bf(v); }
        ssq[r] = s;
    }
}
#ifndef MK_BUILD
__global__ void k_rowprep(const float* x, bf16_t* xb, float* ssq, int rows) { d_rowprep(x, xb, ssq, rows, (long)blockIdx.x * blockDim.x + threadIdx.x, (long)gridDim.x * blockDim.x); }
#endif
__device__ __forceinline__ void d_biastab(const float* rel_bias, float* tab, long gtid, long gsize) {
        for (long i = gtid; i < 128 * 6; i += gsize) { const int dist = i / 6, hq = i % 6; tab[i] = rel_bias[t5_bucket(dist) * 6 + hq]; }
}
#ifndef MK_BUILD
__global__ void k_biastab(const float* rel_bias, float* tab) { d_biastab(rel_bias, tab, (long)blockIdx.x * blockDim.x + threadIdx.x, (long)gridDim.x * blockDim.x); }
#endif
__device__ __forceinline__ void d_qknorm(bf16_t* P, int rows, int ld, const float* gq, const float* gk, const float* gm, int mode, long gtid, long gsize) {
    const int nj = mode == 0 ? 12 : 4;
    const long total = (long)rows * nj;
    for (long idx = gtid; idx < total; idx += gsize) {
        const int row = (int)(idx / nj), j = (int)(idx % nj);
        int col; const float* g;
        if (mode == 0) { if (j < 6) { col = 64 * j; g = gq; } else if (j < 8) { col = 384 + 64 * (j - 6); g = gk; } else { col = 1920 + 64 * (j - 8); g = gm; } }
        else { col = 64 * j; g = gm; }
        bf16_t* p = P + (long)row * ld + col; float s = 0.f;
        for (int d = 0; d < 64; ++d) { const float v = bf2f(p[d]); s += v * v; }
        const float rs = 1.0f / sqrtf(s * (1.0f / 64.0f) + EPS);
        for (int d = 0; d < 64; ++d) p[d] = f2bf(bf2f(p[d]) * rs * g[d]);
    }
}
#ifndef MK_BUILD
__global__ void k_qknorm(bf16_t* P, int rows, int ld, const float* gq, const float* gk, const float* gm, int mode) { d_qknorm(P, rows, ld, gq, gk, gm, mode, (long)blockIdx.x * blockDim.x + threadIdx.x, (long)gridDim.x * blockDim.x); }
#endif
__device__ __forceinline__ void d_swa(const bf16_t* P, bf16_t* MIX, const float* biastab, const float* sinks, long gtid, long gsize) {
    const long total = (long)MTOK * 6;
    for (long idx = gtid; idx < total; idx += gsize) {
        const int tok = (int)(idx / 6), hq = (int)(idx % 6), hkv = hq / 3, t = tok % SEQ;
        float q[64], o[64];
#pragma unroll
        for (int d = 0; d < 64; ++d) { q[d] = bf2f(P[(long)tok * LDP + 64 * hq + d]) * 0.125f; o[d] = 0.f; }
        float m = sinks[hq], l = 1.0f;
        const int j0 = t - 127 < 0 ? 0 : t - 127;
        for (int j = j0; j <= t; ++j) {
            const bf16_t* kr = P + (long)(tok - (t - j)) * LDP + 384 + 64 * hkv; const bf16_t* vr = kr + 128;
            float s = 0.f;
#pragma unroll
            for (int d = 0; d < 64; ++d) s += q[d] * bf2f(kr[d]);
            s += biastab[(t - j) * 6 + hq];
            const float mn = fmaxf(m, s), f = expf(m - mn), e = expf(s - mn);
            l = l * f + e; m = mn;
#pragma unroll
            for (int d = 0; d < 64; ++d) o[d] = o[d] * f + e * bf2f(vr[d]);
        }
        const float inv = 1.0f / l;
#pragma unroll
        for (int d = 0; d < 64; ++d) MIX[(long)tok * DM + 64 * hq + d] = f2bf(o[d] * inv);
    }
}
#ifndef MK_BUILD
__global__ __launch_bounds__(256) void k_swa(const bf16_t* P, bf16_t* MIX, const float* biastab, const float* sinks) { d_swa(P, MIX, biastab, sinks, (long)blockIdx.x * blockDim.x + threadIdx.x, (long)gridDim.x * blockDim.x); }
#endif
__device__ __forceinline__ void d_memattn(const bf16_t* P, const bf16_t* MKV, bf16_t* MIX, long gtid, long gsize) {
    const long total = (long)MTOK * 4;
    for (long idx = gtid; idx < total; idx += gsize) {
        const int tok = (int)(idx / 4), h = (int)(idx % 4), b = tok / SEQ;
        float q[64], o[64];
#pragma unroll
        for (int d = 0; d < 64; ++d) { q[d] = bf2f(P[(long)tok * LDP + 1920 + 64 * h + d]) * 0.125f; o[d] = 0.f; }
        float m = -1e30f, l = 0.f;
        for (int j = 0; j < 256; ++j) {
            const bf16_t* kr = MKV + (long)(b * 256 + j) * 512 + 64 * h; const bf16_t* vr = kr + 256;
            float s = 0.f;
#pragma unroll
            for (int d = 0; d < 64; ++d) s += q[d] * bf2f(kr[d]);
            const float mn = fmaxf(m, s), f = expf(m - mn), e = expf(s - mn);
            l = l * f + e; m = mn;
#pragma unroll
            for (int d = 0; d < 64; ++d) o[d] = o[d] * f + e * bf2f(vr[d]);
        }
        const float inv = 1.0f / l;
#pragma unroll
        for (int d = 0; d < 64; ++d) MIX[(long)tok * DM + 768 + 64 * h + d] = f2bf(o[d] * inv);
    }
}
#ifndef MK_BUILD
__global__ __launch_bounds__(256) void k_memattn(const bf16_t* P, const bf16_t* MKV, bf16_t* MIX) { d_memattn(P, MKV, MIX, (long)blockIdx.x * blockDim.x + threadIdx.x, (long)gridDim.x * blockDim.x); }
#endif
__device__ __forceinline__ float shifted(const bf16_t* P, int tok, int col, float mu) {
    const float p = bf2f(P[(long)tok * LDP + col]);
    const float prev = (tok % SEQ) == 0 ? 0.f : bf2f(P[(long)(tok - 1) * LDP + col]);
    return p + mu * (prev - p);
}
struct RwkvW { const float *mu, *mu_v, *w0, *w2, *a0, *a2, *v0, *v2, *g2, *k_k, *k_a, *r_k, *ln_w, *ln_b; };
__device__ __forceinline__ void d_rwkv_prep(const bf16_t* P, RwkvW W, int layer, bf16_t* VFIRST, bf16_t* R, bf16_t* K, bf16_t* V, bf16_t* KK, bf16_t* B, bf16_t* LOGD, long gtid, long gsize) {
    const long total = (long)MTOK * 6;
    for (long idx = gtid; idx < total; idx += gsize) {
        const int tok = (int)(idx / 6), h = (int)(idx % 6);
        float nrm = 0.f;
        for (int c = 0; c < 64; ++c) { const int hc = 64 * h + c; const float kc = shifted(P, tok, 640 + 384 + hc, W.mu[384 + hc]) * W.k_k[hc]; nrm += kc * kc; }
        const float rn = 1.0f / fmaxf(sqrtf(nrm), 1e-12f);
        for (int c = 0; c < 64; ++c) {
            const int hc = 64 * h + c; const long o = (long)tok * 384 + hc;
            const float r = shifted(P, tok, 640 + hc, W.mu[hc]);
            const float k = shifted(P, tok, 640 + 384 + hc, W.mu[384 + hc]);
            float v = shifted(P, tok, 640 + 768 + hc, W.mu[768 + hc]);
            float wp = W.w0[hc], ap = W.a0[hc];
            for (int j = 0; j < 32; ++j) {
                wp += tanhf(shifted(P, tok, 640 + 1152 + j, W.mu[1152 + j])) * W.w2[j * 384 + hc];
                ap += shifted(P, tok, 640 + 1184 + j, W.mu[1184 + j]) * W.a2[j * 384 + hc];
            }
            const float z = -wp; const float sp = fmaxf(z, 0.f) + log1pf(expf(-fabsf(z)));
            const float w = -sp - 0.5f;
            const float a = 1.0f / (1.0f + expf(-ap));
            if (layer > 0) {
                float vp = W.v0[hc];
                for (int j = 0; j < 16; ++j) vp += shifted(P, tok, 2176 + j, W.mu_v[j]) * W.v2[j * 384 + hc];
                const float vf = bf2f(VFIRST[o]);
                v = v + (vf - v) * (1.0f / (1.0f + expf(-vp)));
            } else VFIRST[o] = f2bf(v);
            const float kk = k * W.k_k[hc] * rn;
            R[o] = f2bf(r); K[o] = f2bf(k * (1.0f + (a - 1.0f) * W.k_a[hc])); V[o] = f2bf(v);
            KK[o] = f2bf(kk); B[o] = f2bf(kk * a); LOGD[o] = f2bf(-expf(w));
        }
    }
}
#ifndef MK_BUILD
__global__ void k_rwkv_prep(const bf16_t* P, RwkvW W, int layer, bf16_t* VFIRST, bf16_t* R, bf16_t* K, bf16_t* V, bf16_t* KK, bf16_t* B, bf16_t* LOGD) { d_rwkv_prep(P, W, layer, VFIRST, R, K, V, KK, B, LOGD, (long)blockIdx.x * blockDim.x + threadIdx.x, (long)gridDim.x * blockDim.x); }
#endif
__device__ __forceinline__ void d_rwkv_scan(const bf16_t* R, const bf16_t* K, const bf16_t* V, const bf16_t* KK, const bf16_t* B, const bf16_t* LOGD, bf16_t* MIX, int bh, int i) {
    const int b = bh / 6, h = bh % 6;
    float s[64];
#pragma unroll
    for (int k = 0; k < 64; ++k) s[k] = 0.f;
    for (int t = 0; t < SEQ; ++t) {
        const long o = (long)(b * SEQ + t) * 384 + 64 * h;
        float sa = 0.f;
#pragma unroll
        for (int k = 0; k < 64; ++k) sa -= s[k] * bf2f(KK[o + k]);
        const float v = bf2f(V[o + i]); float y = 0.f;
#pragma unroll
        for (int k = 0; k < 64; ++k) { s[k] = s[k] * expf(bf2f(LOGD[o + k])) + sa * bf2f(B[o + k]) + v * bf2f(K[o + k]); y += s[k] * bf2f(R[o + k]); }
        MIX[(long)(b * SEQ + t) * DM + 384 + 64 * h + i] = f2bf(y);
    }
}
#ifndef MK_BUILD
__global__ void k_rwkv_scan(const bf16_t* R, const bf16_t* K, const bf16_t* V, const bf16_t* KK, const bf16_t* B, const bf16_t* LOGD, bf16_t* MIX) { d_rwkv_scan(R, K, V, KK, B, LOGD, MIX, blockIdx.x, threadIdx.x); }
#endif
__device__ __forceinline__ void d_rwkv_fin(const bf16_t* P, RwkvW W, const bf16_t* R, const bf16_t* K, const bf16_t* V, bf16_t* MIX, long gtid, long gsize) {
    const long total = (long)MTOK * 6;
    for (long idx = gtid; idx < total; idx += gsize) {
        const int tok = (int)(idx / 6), h = (int)(idx % 6);
        bf16_t* y = MIX + (long)tok * DM + 384 + 64 * h; const long o = (long)tok * 384 + 64 * h;
        float mean = 0.f, dot = 0.f;
        for (int c = 0; c < 64; ++c) { mean += bf2f(y[c]); dot += bf2f(R[o + c]) * bf2f(K[o + c]) * W.r_k[64 * h + c]; }
        mean *= (1.0f / 64.0f); float var = 0.f;
        for (int c = 0; c < 64; ++c) { const float d = bf2f(y[c]) - mean; var += d * d; }
        const float rstd = 1.0f / sqrtf(var * (1.0f / 64.0f) + GN_EPS);
        for (int c = 0; c < 64; ++c) {
            const int hc = 64 * h + c; float g = 0.f;
            for (int j = 0; j < 64; ++j) g += (1.0f / (1.0f + expf(-shifted(P, tok, 640 + 1216 + j, W.mu[1216 + j])))) * W.g2[j * 384 + hc];
            const float yn = (bf2f(y[c]) - mean) * rstd * W.ln_w[hc] + W.ln_b[hc];
            y[c] = f2bf((yn + dot * bf2f(V[o + c])) * g);
        }
    }
}
#ifndef MK_BUILD
__global__ void k_rwkv_fin(const bf16_t* P, RwkvW W, const bf16_t* R, const bf16_t* K, const bf16_t* V, bf16_t* MIX) { d_rwkv_fin(P, W, R, K, V, MIX, (long)blockIdx.x * blockDim.x + threadIdx.x, (long)gridDim.x * blockDim.x); }
#endif
__device__ __forceinline__ void d_conv_act(const bf16_t* U, const float* cw, const float* cb, bf16_t* ACT, int rows, long gtid, long gsize) {
    const long total = (long)rows * DFF;
    for (long idx = gtid; idx < total; idx += gsize) {
        const int t = (int)(idx / DFF), c = (int)(idx % DFF);
        float gate = cb[c], val = cb[DFF + c];
#pragma unroll
        for (int i = 0; i < 3; ++i) { const int tt = t - 2 + i; if (tt >= 0) { gate += cw[i * 2 * DFF + c] * bf2f(U[(long)tt * 2 * DFF + c]); val += cw[i * 2 * DFF + DFF + c] * bf2f(U[(long)tt * 2 * DFF + DFF + c]); } }
        ACT[(long)t * DFF + c] = f2bf(gate / (1.0f + expf(-gate)) * val);
    }
}
#ifndef MK_BUILD
__global__ void k_conv_act(const bf16_t* U, const float* cw, const float* cb, bf16_t* ACT, int rows) { d_conv_act(U, cw, cb, ACT, rows, (long)blockIdx.x * blockDim.x + threadIdx.x, (long)gridDim.x * blockDim.x); }
#endif
}
namespace pg8 {
#define PG8_LAS __attribute__((address_space(3)))
typedef unsigned short bf16_t;
typedef short bf16x8 __attribute__((ext_vector_type(8)));
typedef float f32x4 __attribute__((ext_vector_type(4)));
typedef unsigned u32x4 __attribute__((ext_vector_type(4)));
constexpr int BM = 256, BK = 64, HALF = 128, HTB = HALF * BK * 2  , STAGE_BYTES = 8 * HTB, NXCD = 8, WGM = 8;

__host__ __device__ __forceinline__ int lds_byte(int r, int c) { const int st = (r >> 4) * 2 + (c >> 5), rr = r & 15, cc = c & 31, ob = rr * 64 + cc * 2; return st * 1024 + (ob ^ (((ob >> 9) & 1) << 5)); }
__host__ __device__ __forceinline__ void stage_rc(int b, int& R, int& C) { const int st = b / 1024, sb = b % 1024, swz = sb ^ (((sb >> 9) & 1) << 5); R = (st >> 1) * 16 + swz / 64; C = (st & 1) * 32 + (swz % 64) / 2; }
__host__ __device__ __forceinline__ int perm32(int rho) { const int n = rho >> 4, i = rho & 15; return 8 * (i >> 2) + 4 * n + (i & 3); }

struct Unit { int pm, pn; };
struct Gemm { const bf16_t* A; const bf16_t* Bt; int M, N, K; };

struct StaticOrder {
    int nM, nN, nwg, G, c;
    __host__ __device__ void init(int M, int N, int G_, int c_) { nM = M / BM; nN = N / BM; nwg = nM * nN; G = G_; c = c_; }
    __host__ __device__ bool next(int i, Unit& u) const {
        const long L = (long)i * G + c; if (L >= nwg) return false;
        int wgid = (int)L; { const int q = nwg / NXCD, r = nwg % NXCD, xcd = wgid % NXCD, off = wgid / NXCD; wgid = (xcd < r ? xcd * (q + 1) : r * (q + 1) + (xcd - r) * q) + off; }
        const int nig = WGM * nN, gid = wgid / nig, fm = gid * WGM, gsz = (nM - fm) < WGM ? (nM - fm) : WGM;
        u.pm = fm + ((wgid % nig) % gsz); u.pn = (wgid % nig) / gsz; return true;
    }
    __device__ __forceinline__ void a_ready(const Unit&) const {}
    __device__ __forceinline__ void done(const Unit&) const {}
};

__device__ __forceinline__ unsigned cvt_pk_bf16(float lo, float hi) { unsigned r; asm volatile("v_cvt_pk_bf16_f32 %0, %1, %2" : "=v"(r) : "v"(lo), "v"(hi)); return r; }
struct EpiScaleBf16 {
    static constexpr bool PERM = true, AFTER_DRAIN = false; static constexpr int AMAP = 0;
    bf16_t* O; int ldc; const float* ssq;
    __device__ __forceinline__ void operator()(const f32x4 (&acc)[2][2][4][2], const Unit& u, int wr, int wc, int fr, int fq) const {
        const int row0 = u.pm * BM + wr * 64 + fr, col0 = u.pn * BM + wc * 32 + 8 * fq;
#pragma unroll
        for (int ai = 0; ai < 2; ++ai)
#pragma unroll
            for (int m = 0; m < 4; ++m) { const int row = row0 + ai * HALF + m * 16; const float sc = 1.0f / sqrtf(ssq[row] * (1.0f / 1024.0f) + 1e-6f);
                bf16_t* rowp = O + (size_t)row * ldc + col0;
#pragma unroll
                for (int bj = 0; bj < 2; ++bj) { const f32x4 v0 = acc[ai][bj][m][0] * sc, v1 = acc[ai][bj][m][1] * sc;
                    u32x4 w; w.x = cvt_pk_bf16(v0[0], v0[1]); w.y = cvt_pk_bf16(v0[2], v0[3]); w.z = cvt_pk_bf16(v1[0], v1[1]); w.w = cvt_pk_bf16(v1[2], v1[3]);
                    *(u32x4*)(rowp + bj * HALF) = w; } }
    }
};
struct EpiResid {
    static constexpr bool PERM = false, AFTER_DRAIN = false; static constexpr int AMAP = 0;
    const float* base; float* out; bf16_t* xb; float* ssq; int ldc;
    __device__ __forceinline__ void operator()(const f32x4 (&acc)[2][2][4][2], const Unit& u, int wr, int wc, int fr, int fq) const {
        typedef unsigned u32x2v __attribute__((ext_vector_type(2)));
        const int col0 = u.pn * BM + wc * 32 + 4 * fq;
#pragma unroll
        for (int ai = 0; ai < 2; ++ai)
#pragma unroll
            for (int m = 0; m < 4; ++m) { const int row = u.pm * BM + ai * HALF + wr * 64 + m * 16 + fr; const size_t off = (size_t)row * ldc + col0; float sq = 0.f;
#pragma unroll
                for (int bj = 0; bj < 2; ++bj)
#pragma unroll
                    for (int n = 0; n < 2; ++n) { const f32x4 o = *(const f32x4*)(base + off + bj * HALF + n * 16) + acc[ai][bj][m][n];
                        *(f32x4*)(out + off + bj * HALF + n * 16) = o; sq += (o[0] * o[0] + o[1] * o[1]) + (o[2] * o[2] + o[3] * o[3]);
                        u32x2v w; w.x = cvt_pk_bf16(o[0], o[1]); w.y = cvt_pk_bf16(o[2], o[3]); *(u32x2v*)(xb + off + bj * HALF + n * 16) = w; }
                sq += __shfl_xor(sq, 16); sq += __shfl_xor(sq, 32);
                if (fq == 0) atomicAdd(ssq + row, sq); }
    }
};
struct EpiConvAct {
    static constexpr bool PERM = true, AFTER_DRAIN = false; static constexpr int AMAP = 1;
    bf16_t* ACT; const float* ssq; const float* cw; const float* cb;
    static __device__ __forceinline__ float shr1s(float x) { float r; asm volatile("s_nop 1\n\tv_mov_b32_dpp %0, %1 row_shr:1 row_mask:0xf bank_mask:0xf bound_ctrl:1" : "=v"(r) : "v"(x)); return r; }
    static __device__ __forceinline__ f32x4 shr1(f32x4 v) { f32x4 r; r[0] = shr1s(v[0]); r[1] = shr1s(v[1]); r[2] = shr1s(v[2]); r[3] = shr1s(v[3]); return r; }
    __device__ __forceinline__ void operator()(const f32x4 (&acc)[2][2][4][2], const Unit& u, int wr, int wc, int fr, int fq) const {
        const int b = u.pm / 33, pmb = u.pm % 33;
        const int pos0 = 252 * pmb + 126 * wr + 8 * fr - 2;
        const long row0 = (long)b * SEQ + pos0;
        float rs[8];
#pragma unroll
        for (int j = 0; j < 8; ++j) { const int pos = pos0 + j; const bool ok = pos >= 0 && pos < SEQ; const float q = ssq[ok ? row0 + j : 0]; rs[j] = ok ? 1.0f / sqrtf(q * (1.0f / 1024.0f) + 1e-6f) : 0.f; }
        const int ch0 = 128 * u.pn + 32 * wc + 8 * fq;
        unsigned ow[8][4];
#pragma unroll
        for (int n = 0; n < 2; ++n) { const int c = ch0 + 4 * n;
            const f32x4 w0g = *(const f32x4*)(cw + c), w1g = *(const f32x4*)(cw + 5632 + c), w2g = *(const f32x4*)(cw + 2 * 5632 + c), bg = *(const f32x4*)(cb + c);
            const f32x4 w0v = *(const f32x4*)(cw + 2816 + c), w1v = *(const f32x4*)(cw + 5632 + 2816 + c), w2v = *(const f32x4*)(cw + 2 * 5632 + 2816 + c), bv = *(const f32x4*)(cb + 2816 + c);
            f32x4 gm2 = shr1(acc[1][0][2][n] * rs[6]), gm1 = shr1(acc[1][0][3][n] * rs[7]), vm2 = shr1(acc[1][1][2][n] * rs[6]), vm1 = shr1(acc[1][1][3][n] * rs[7]);
#pragma unroll
            for (int j = 0; j < 8; ++j) { const f32x4 gj = acc[j >> 2][0][j & 3][n] * rs[j], vj = acc[j >> 2][1][j & 3][n] * rs[j];
                const f32x4 ug = bg + w0g * gm2 + w1g * gm1 + w2g * gj, uv = bv + w0v * vm2 + w1v * vm1 + w2v * vj; f32x4 a;
#pragma unroll
                for (int e = 0; e < 4; ++e) a[e] = ug[e] / (1.0f + __expf(-ug[e])) * uv[e];
                ow[j][2 * n] = cvt_pk_bf16(a[0], a[1]); ow[j][2 * n + 1] = cvt_pk_bf16(a[2], a[3]);
                gm2 = gm1; gm1 = gj; vm2 = vm1; vm1 = vj; } }
#pragma unroll
        for (int j = 0; j < 8; ++j) if (8 * fr + j >= 2 && pos0 + j < SEQ) { u32x4 w; w.x = ow[j][0]; w.y = ow[j][1]; w.z = ow[j][2]; w.w = ow[j][3]; *(u32x4*)(ACT + (size_t)(row0 + j) * 2816 + ch0) = w; }
    }
};
template <class Epi, class Sched, bool ALIGN_EPI = false, bool SP2 = false>
__device__ __forceinline__ void gemm_phase(PG8_LAS unsigned char* lds, const Gemm g, const Sched& S, const Epi& E, int tid_in) {
    int tid = tid_in; asm volatile("" : "+v"(tid));
    const int wid = __builtin_amdgcn_readfirstlane(tid >> 6), lane = tid & 63, wr = wid >> 2, wc = wid & 3, fr = lane & 15, fq = lane >> 4;
    const int K = g.K, nt = K / BK;
    unsigned voffA[2], voffB[2];
#pragma unroll
    for (int i = 0; i < 2; ++i) { int R, C; stage_rc(tid * 16 + i * 8192, R, C); const int Rb = Epi::PERM ? ((R & ~31) + perm32(R & 31)) : R;
        const int Ra = Epi::AMAP ? (126 * (R >> 6) + 8 * (R & 15) + ((R >> 4) & 3)) : R;
        voffA[i] = (unsigned)(Ra * K + C) * 2u; voffB[i] = (unsigned)(Rb * K + C) * 2u; }
    const size_t kstep = (size_t)(BK * 2);
    const size_t hstepB = (size_t)HALF * K * 2;
    const size_t hstepA = Epi::AMAP ? (size_t)4 * K * 2 : hstepB;
    const size_t tstep = 2 * hstepB;
#define PG8_ABASE(pm_) (Epi::AMAP ? (long)((long)((pm_) / 33) * SEQ + 252 * ((pm_) % 33) - 2) * (long)K * 2 : (long)(pm_) * (long)tstep)
    const unsigned ldsw = (unsigned)wid * 1024u;
    const int aoff = lds_byte(wr * 64 + fr, fq * 8), boff = lds_byte(wc * 32 + fr, fq * 8);
#define PG8_SA(b, h) (((b) * 2 + (h)) * HTB)
#define PG8_SB(b, h) ((4 + (b) * 2 + (h)) * HTB)
#define PG8_STAGE(bufoff, gbase, voff) do { _Pragma("unroll") for (int _i = 0; _i < 2; ++_i) \
        __builtin_amdgcn_global_load_lds((const unsigned*)((const char*)(gbase) + (voff)[_i]), (PG8_LAS unsigned*)(lds + (bufoff) + ldsw + _i * 8192), 16, 0, 0); } while (0)
#define PG8_LDA(dst, b, h) do { _Pragma("unroll") for (int m = 0; m < 4; ++m) _Pragma("unroll") for (int k = 0; k < 2; ++k) dst[m][k] = *(const PG8_LAS bf16x8*)(lds + PG8_SA(b, h) + aoff + m * 2048 + k * 1024); } while (0)
#define PG8_LDB(dst, b, h) do { _Pragma("unroll") for (int n = 0; n < 2; ++n) _Pragma("unroll") for (int k = 0; k < 2; ++k) dst[n][k] = *(const PG8_LAS bf16x8*)(lds + PG8_SB(b, h) + boff + n * 2048 + k * 1024); } while (0)
#define PG8_MMA(ai, bj, At, Bt) do { __builtin_amdgcn_s_setprio(1); _Pragma("unroll") for (int m = 0; m < 4; ++m) _Pragma("unroll") for (int n = 0; n < 2; ++n) _Pragma("unroll") for (int k = 0; k < 2; ++k) \
        acc[ai][bj][m][n] = __builtin_amdgcn_mfma_f32_16x16x32_bf16(Bt[n][k], At[m][k], acc[ai][bj][m][n], 0, 0, 0); __builtin_amdgcn_s_setprio(0); } while (0)
#define PG8_WAIT_V(n) asm volatile("s_waitcnt vmcnt(" #n ")" ::: "memory")
#define PG8_WAIT_L(n) asm volatile("s_waitcnt lgkmcnt(" #n ")" ::: "memory")
#define PG8_BAR __builtin_amdgcn_s_barrier()
#define PG8_SCHED __builtin_amdgcn_sched_barrier(0)
    Unit cur, nxt; int ui = 0;
    if (!S.next(0, cur)) return;
    f32x4 acc[2][2][4][2];
#pragma unroll
    for (int a = 0; a < 2; ++a)
#pragma unroll
        for (int b = 0; b < 2; ++b)
#pragma unroll
            for (int m = 0; m < 4; ++m)
#pragma unroll
                for (int n = 0; n < 2; ++n) acc[a][b][m][n] = (f32x4){0.f, 0.f, 0.f, 0.f};
    bf16x8 At[4][2], B0[2][2], B1[2][2];
    const char* cA = (const char*)g.A + PG8_ABASE(cur.pm); const char* cB = (const char*)g.Bt + (size_t)cur.pn * tstep;
    S.a_ready(cur);
    if constexpr (SP2) {
        PG8_STAGE(PG8_SB(0, 0), cB, voffB); PG8_STAGE(PG8_SB(0, 1), cB + hstepB, voffB); PG8_STAGE(PG8_SA(0, 0), cA, voffA); PG8_STAGE(PG8_SA(0, 1), cA + hstepA, voffA);
        if (wr == 1) PG8_BAR;
        PG8_WAIT_V(2); PG8_BAR;
        PG8_STAGE(PG8_SB(1, 0), cB + kstep, voffB); PG8_STAGE(PG8_SA(1, 0), cA + kstep, voffA); PG8_STAGE(PG8_SB(1, 1), cB + hstepB + kstep, voffB);
        PG8_WAIT_V(6); PG8_BAR;
    } else {
        PG8_STAGE(PG8_SB(0, 0), cB, voffB); PG8_STAGE(PG8_SA(0, 0), cA, voffA); PG8_STAGE(PG8_SB(0, 1), cB + hstepB, voffB); PG8_STAGE(PG8_SA(0, 1), cA + hstepA, voffA);
        if (wr == 1) PG8_BAR;
        PG8_WAIT_V(4); PG8_BAR;
        PG8_STAGE(PG8_SB(1, 0), cB + kstep, voffB); PG8_STAGE(PG8_SA(1, 0), cA + kstep, voffA); PG8_STAGE(PG8_SB(1, 1), cB + hstepB + kstep, voffB);
        PG8_WAIT_V(6); PG8_BAR;
    }
    for (;;) {
        const bool has_next = S.next(ui + 1, nxt);
        const char* nA = has_next ? (const char*)g.A + PG8_ABASE(nxt.pm) : cA; const char* nB = has_next ? (const char*)g.Bt + (size_t)nxt.pn * tstep : cB;
        for (int t = 0; t < nt; t += 2) {
            const bool last = (t == nt - 2);
            const char* a1 = cA + (size_t)(t + 1) * kstep;
            const char* a2 = last ? nA : cA + (size_t)(t + 2) * kstep; const char* b2 = last ? nB : cB + (size_t)(t + 2) * kstep;
            const char* a3 = a2 + kstep; const char* b3 = b2 + kstep;
            if (last && has_next) S.a_ready(nxt);
            if constexpr (SP2) {
            PG8_LDB(B0, 0, 0); PG8_LDB(B1, 0, 1); PG8_SCHED; PG8_LDA(At, 0, 0); PG8_STAGE(PG8_SA(1, 1), a1 + hstepA, voffA);
            PG8_WAIT_V(8); PG8_WAIT_L(0); PG8_BAR; PG8_MMA(0, 0, At, B0); PG8_MMA(0, 1, At, B1); PG8_BAR; PG8_SCHED;
            PG8_LDA(At, 0, 1); PG8_STAGE(PG8_SB(0, 0), b2, voffB); PG8_STAGE(PG8_SB(0, 1), b2 + hstepB, voffB); PG8_STAGE(PG8_SA(0, 0), a2, voffA);
            PG8_WAIT_V(8); PG8_WAIT_L(0); PG8_BAR; PG8_MMA(1, 0, At, B0); PG8_MMA(1, 1, At, B1); PG8_BAR; PG8_SCHED;
            PG8_LDB(B0, 1, 0); PG8_LDB(B1, 1, 1); PG8_SCHED; PG8_LDA(At, 1, 0); PG8_STAGE(PG8_SA(0, 1), a2 + hstepA, voffA);
            PG8_WAIT_V(8); PG8_WAIT_L(0); PG8_BAR; PG8_MMA(0, 0, At, B0); PG8_MMA(0, 1, At, B1); PG8_BAR; PG8_SCHED;
            PG8_LDA(At, 1, 1); PG8_STAGE(PG8_SB(1, 0), b3, voffB); PG8_STAGE(PG8_SB(1, 1), b3 + hstepB, voffB); PG8_STAGE(PG8_SA(1, 0), a3, voffA);
            PG8_WAIT_V(8); PG8_WAIT_L(0); PG8_BAR; PG8_MMA(1, 0, At, B0); PG8_MMA(1, 1, At, B1); PG8_BAR; PG8_SCHED;
            } else {
            PG8_LDB(B0, 0, 0); PG8_SCHED; PG8_LDA(At, 0, 0); PG8_STAGE(PG8_SA(1, 1), a1 + hstepA, voffA);
            PG8_WAIT_L(8); PG8_BAR; PG8_WAIT_L(0); PG8_MMA(0, 0, At, B0); PG8_BAR; PG8_SCHED;
            PG8_LDB(B1, 0, 1); PG8_STAGE(PG8_SB(0, 0), b2, voffB);
            PG8_BAR; PG8_WAIT_L(0); PG8_MMA(0, 1, At, B1); PG8_BAR;
            PG8_LDA(At, 0, 1); PG8_STAGE(PG8_SA(0, 0), a2, voffA);
            PG8_BAR; PG8_WAIT_L(0); PG8_MMA(1, 0, At, B0); PG8_BAR; PG8_SCHED;
            PG8_STAGE(PG8_SB(0, 1), b2 + hstepB, voffB);
            PG8_WAIT_V(6); PG8_BAR; PG8_MMA(1, 1, At, B1); PG8_BAR;
            PG8_LDB(B0, 1, 0); PG8_SCHED; PG8_LDA(At, 1, 0); PG8_STAGE(PG8_SA(0, 1), a2 + hstepA, voffA);
            PG8_WAIT_L(8); PG8_BAR; PG8_WAIT_L(0); PG8_MMA(0, 0, At, B0); PG8_BAR; PG8_SCHED;
            PG8_LDB(B1, 1, 1); PG8_STAGE(PG8_SB(1, 0), b3, voffB);
            PG8_BAR; PG8_WAIT_L(0); PG8_MMA(0, 1, At, B1); PG8_BAR;
            PG8_LDA(At, 1, 1); PG8_STAGE(PG8_SA(1, 0), a3, voffA);
            PG8_BAR; PG8_WAIT_L(0); PG8_MMA(1, 0, At, B0); PG8_BAR; PG8_SCHED;
            PG8_STAGE(PG8_SB(1, 1), b3 + hstepB, voffB);
            PG8_WAIT_V(6); PG8_BAR; PG8_MMA(1, 1, At, B1); PG8_BAR;
            }
        }
        if constexpr (ALIGN_EPI) { if (wr == 0) PG8_BAR; }
        if constexpr (!Epi::AFTER_DRAIN) { E(acc, cur, wr, wc, fr, fq); S.done(cur); }
        if (!has_next) break;
#pragma unroll
        for (int a = 0; a < 2; ++a)
#pragma unroll
            for (int b = 0; b < 2; ++b)
#pragma unroll
                for (int m = 0; m < 4; ++m)
#pragma unroll
                    for (int n = 0; n < 2; ++n) acc[a][b][m][n] = (f32x4){0.f, 0.f, 0.f, 0.f};
        cur = nxt; cA = nA; cB = nB; ++ui;
        if constexpr (ALIGN_EPI) { if (wr == 1) PG8_BAR; }
    }
    PG8_WAIT_V(0);
    if constexpr (!ALIGN_EPI) { if (wr == 0) PG8_BAR; }
    PG8_BAR;
    if constexpr (Epi::AFTER_DRAIN) { E.fused(acc, cur, wr, wc, fr, fq, lds, wid, lane); S.done(cur); }
#undef PG8_ABASE
#undef PG8_SA
#undef PG8_SB
#undef PG8_STAGE
#undef PG8_LDA
#undef PG8_LDB
#undef PG8_MMA
#undef PG8_WAIT_V
#undef PG8_WAIT_L
#undef PG8_BAR
#undef PG8_SCHED
}
}

#ifndef PG8_SP2
#define PG8_SP2 true
#endif
#ifndef PG8_ALIGN
#define PG8_ALIGN true
#endif
#define GAS __attribute__((address_space(1)))
#define LAS __attribute__((address_space(3)))
typedef unsigned short bf16;
typedef unsigned v4u __attribute__((ext_vector_type(4)));
typedef float f32x4 __attribute__((ext_vector_type(4)));
typedef short bf16x8 __attribute__((ext_vector_type(8)));
typedef GAS unsigned gu32;
typedef GAS unsigned long long gu64;
#define RLX_AGENT __ATOMIC_RELAXED, __HIP_MEMORY_SCOPE_AGENT
#define LDS_WAIT() asm volatile("s_waitcnt lgkmcnt(0)" ::: "memory")
#define VM_WAIT() asm volatile("s_waitcnt vmcnt(0)" ::: "memory")
__device__ __forceinline__ unsigned long long rt() { return __builtin_amdgcn_s_memrealtime(); }

#define XB_TMO      128
#define XB_XCNT(j)  (256  + 64 * (j))
#define XB_XSUB(j)  (1280 + 64 * (j))
#define XB_XGEN(j)  (2304 + 64 * (j))
#define XB_TOP      3328
#define XB_TOPGEN   3392
#define XCD_BAR_WORDS 3456
#define XB_SPIN_CAP (1u << 20)

__device__ __forceinline__ unsigned xb_ld(unsigned* p)              { return __hip_atomic_load(p, __ATOMIC_RELAXED, __HIP_MEMORY_SCOPE_AGENT); }
__device__ __forceinline__ unsigned xb_add(unsigned* p, unsigned v) { return __hip_atomic_fetch_add(p, v, __ATOMIC_RELAXED, __HIP_MEMORY_SCOPE_AGENT); }
__device__ __forceinline__ unsigned xb_xcc_id() { return (unsigned)__builtin_amdgcn_s_getreg((3 << 11) | 20) & 0xFu; }
#define XB_SPIN(cond, bar) do { unsigned _sp = 0; while (cond) { __builtin_amdgcn_s_sleep(1); \
    if ((++_sp & 255u) == 0u) { if (xb_ld(&(bar)[XB_TMO])) break; if (_sp > XB_SPIN_CAP) { atomicAdd(&(bar)[XB_TMO], 1u); break; } } } } while (0)

struct XcdBarrier {
    unsigned* bar; unsigned x;
    volatile LAS unsigned* st;
};

__device__ __forceinline__ XcdBarrier xcd_barrier_post(unsigned* bar, volatile LAS unsigned* st) {
    XcdBarrier b; b.bar = bar; b.x = xb_xcc_id(); b.st = st;
    if (threadIdx.x == 0) (void)xb_add(&bar[XB_XCNT(b.x)], 1u);
    return b;
}
__device__ __forceinline__ void xcd_barrier_complete(unsigned* bar, unsigned x, unsigned& nloc, unsigned& nx) {
    const unsigned G = gridDim.x * gridDim.y * gridDim.z;
    unsigned sum, cnt, mine, sp = 0u;
    for (;;) {
        sum = 0u; cnt = 0u; mine = 0u;
#pragma unroll
        for (unsigned j = 0; j < 16; ++j) { const unsigned c = xb_ld(&bar[XB_XCNT(j)]); sum += c; cnt += (c > 0u) ? 1u : 0u; mine = (j == x) ? c : mine; }
        if (sum == G) break;
        __builtin_amdgcn_s_sleep(1);
        if ((++sp & 255u) == 0u) { if (xb_ld(&bar[XB_TMO])) break; if (sp > XB_SPIN_CAP) { atomicAdd(&bar[XB_TMO], 1u); break; } }
    }
    nloc = mine > 0u ? mine : 1u; nx = cnt > 0u ? cnt : 1u;
}

__device__ __forceinline__ void xcd_barrier(const XcdBarrier& b) {
    asm volatile("s_waitcnt vmcnt(0)" ::: "memory");
    __syncthreads();
    if (threadIdx.x == 0) {
        unsigned* bar = b.bar;
        __builtin_amdgcn_s_waitcnt(0);
        unsigned nloc = b.st[0], nx = b.st[1];
        if (nloc == 0u) { xcd_barrier_complete(bar, b.x, nloc, nx); b.st[0] = nloc; b.st[1] = nx; }
        const unsigned old = xb_add(&bar[XB_XSUB(b.x)], 1u);
        const unsigned gen = old / nloc;
        if (old + 1u == (gen + 1u) * nloc) {
            __builtin_amdgcn_fence(__ATOMIC_RELEASE, "agent");
            asm volatile("s_waitcnt vmcnt(0)" ::: "memory");
            const unsigned og = xb_add(&bar[XB_TOP], 1u);
            const unsigned tg = og / nx;
            if (og + 1u == (tg + 1u) * nx) xb_add(&bar[XB_TOPGEN], 1u);
            else XB_SPIN(xb_ld(&bar[XB_TOPGEN]) == tg, bar);
            __builtin_amdgcn_fence(__ATOMIC_ACQUIRE, "agent");
            xb_add(&bar[XB_XGEN(b.x)], 1u);
            asm volatile("s_waitcnt vmcnt(0)" ::: "memory");
        } else {
            XB_SPIN(xb_ld(&bar[XB_XGEN(b.x)]) == gen, bar);
            __builtin_amdgcn_fence(__ATOMIC_ACQUIRE, "agent");
            asm volatile("s_waitcnt vmcnt(0)" ::: "memory");
        }
    }
    __syncthreads();
}

namespace mk {
constexpr size_t WS_CTL = 0, CTL_ZERO_BYTES = 1 * MiB;
constexpr size_t CTL_SSQ = 512 * 1024;
constexpr size_t WS_SMALL = 1 * MiB, SM_BIAS = 0, SM_SSQM = 4096, SM_MKV = 512 * 1024;
constexpr size_t WS_MEMB = 2 * MiB, WS_WT = 3 * MiB, WS_XB = 28 * MiB, WS_VF = 60 * MiB, WS_PROJ = 72 * MiB, WS_MIX = 144 * MiB, WS_PREP = 176 * MiB, WS_U = 72 * MiB, WS_ACT = 160 * MiB, WS_WIN1 = 248 * MiB  , WS_END = 255 * MiB;
constexpr size_t WT_IN = 0, WT_OUT = 4718592, WT_UP = WT_OUT + 2 * MiB, WT_DOWN = WT_UP + 11 * MiB, WT_MKV = WT_DOWN + 5767168;
constexpr int CW_TMO = 0, CW_BAR = 4096, CW_ATTQ = 8192, CW_CHQ = 8448;
constexpr int LDS_BYTES = 163840, LDSCTL_OFF = LDS_BYTES - 512, MISC_OFF = LDSCTL_OFF + 320;
constexpr size_t SM_W2T = 8192, SM_A2T = 32768, SM_V2T = 57344, SM_G2T = 81920, SM_LORA_L = 122880;
constexpr size_t WS_PT = 176 * MiB, WS_G = 188 * MiB, WS_S0 = 200 * MiB, WS_Z = 212 * MiB, WS_YV = 236 * MiB  , WS_DOT = 254 * MiB;
constexpr size_t SM_RWP = 262144, RWP_BYTES = 17472;
constexpr int RP_MU = 0, RP_MUV = 1280, RP_W0 = 1296, RP_A0 = 1680, RP_V0 = 2064, RP_KK = 2448, RP_KA = 2832, RP_RK = 3216, RP_LNW = 3600, RP_LNB = 3984, RP_SIZE = 4368;
}
namespace rw {
constexpr int LD = 72;
constexpr int MATB = 64 * LD * 2;
constexpr int OFF_F0 = 12 * MATB  , OFF_TMP = OFF_F0 + 64 * 65 * 4  ;
constexpr int OFF_TW = 8 * MATB  , OFF_TA = OFF_TW + 5120, OFF_TV = OFF_TA + 5120, OFF_WP = OFF_TV + 5120  , OFF_AP = OFF_WP + 16640, OFF_VP = OFF_AP + 16640;
constexpr int OFF_TOT = 139264, OFF_GC = OFF_TOT + 2048, OFF_RN = OFF_GC + 256, OFF_END = OFF_RN + 256;
constexpr int NITEMS = BATCH * 6 * (SEQ / 64);
__device__ __forceinline__ int sigpos(int c) { return (c & 32) + 8 * ((c >> 2) & 3) + 4 * ((c >> 4) & 1) + (c & 3); }
#define RW_BAR() do { asm volatile("s_waitcnt lgkmcnt(0)" ::: "memory"); __builtin_amdgcn_s_barrier(); asm volatile("" ::: "memory"); } while (0)
__device__ __forceinline__ float fexp(float x) { return __expf(x); }
__device__ __forceinline__ float fsigm(float x) { return 1.0f / (1.0f + __expf(-x)); }
__device__ __forceinline__ float ftanh(float x) { const float e = __expf(-2.0f * fabsf(x)); const float t = (1.0f - e) / (1.0f + e); return x < 0.f ? -t : t; }
__device__ __forceinline__ f32x4 mm_tile(const LAS bf16_t* A, const LAS bf16_t* Bt, int ti, int tj, int fr, int fq, f32x4 acc) {
#pragma unroll
    for (int kk = 0; kk < 2; ++kk) {
        const bf16x8 a = *(const LAS bf16x8*)(A + (16 * ti + fr) * LD + 32 * kk + 8 * fq);
        const bf16x8 b = *(const LAS bf16x8*)(Bt + (16 * tj + fr) * LD + 32 * kk + 8 * fq);
        acc = __builtin_amdgcn_mfma_f32_16x16x32_bf16(a, b, acc, 0, 0, 0);
    }
    return acc;
}
__device__ __forceinline__ unsigned pk2(float lo, float hi) { typedef float f2_t __attribute__((ext_vector_type(2))); typedef __bf16 b2_t __attribute__((ext_vector_type(2))); f2_t v = {lo, hi}; return __builtin_bit_cast(unsigned, __builtin_convertvector(v, b2_t)); }
#define RW_PT   ((GAS bf16_t*)(wsb + mk::WS_PT))
#define RW_G    ((GAS bf16_t*)(wsb + mk::WS_G))
#define RW_Z    ((GAS float*)(wsb + mk::WS_Z))
#define RW_YV   ((GAS bf16_t*)(wsb + mk::WS_YV))
#define RW_S0   ((GAS bf16_t*)(wsb + mk::WS_S0))
#define RW_VF   ((GAS bf16_t*)(wsb + mk::WS_VF))
#define RW_DOT  ((GAS float*)(wsb + mk::WS_DOT))
#define RW_PROJ ((const GAS bf16_t*)(wsb + mk::WS_PROJ))
#define RW_MIX  ((GAS bf16_t*)(wsb + mk::WS_MIX))
#define RW_LORA(off) ((const GAS bf16_t*)(wsb + mk::WS_SMALL + (off) + layer * mk::SM_LORA_L))
#define RWP(off) ((const GAS float*)(wsb + mk::WS_SMALL + mk::SM_RWP + layer * mk::RWP_BYTES) + (off))
struct ChunkBufs { bf16_t* PT; bf16_t* G; float* Z; bf16_t* YV; bf16_t* S0; bf16_t* VOUT; float* DOT; const bf16_t *W2T, *A2T, *V2T, *G2T; };

#define RW_LANES() int lt_ = tid_in; asm volatile("" : "+v"(lt_)); const int tid = lt_, lane = lt_ & 63, fr = lane & 15, fq = lane >> 4; (void)tid; (void)fr; (void)fq
__device__ __forceinline__ int chunk_phase(LAS unsigned char* L, unsigned char* wsb, int layer, int tid_in, unsigned* qctr, volatile LAS unsigned* qw) {
    const GAS bf16_t* P = RW_PROJ;
    const int w = __builtin_amdgcn_readfirstlane(tid_in >> 6);
    LAS bf16_t* B0 = (LAS bf16_t*)(L + 0 * MATB); LAS bf16_t* B1 = (LAS bf16_t*)(L + 1 * MATB); LAS bf16_t* B2 = (LAS bf16_t*)(L + 2 * MATB); LAS bf16_t* B3 = (LAS bf16_t*)(L + 3 * MATB);
    LAS bf16_t* B4 = (LAS bf16_t*)(L + 4 * MATB); LAS bf16_t* B5 = (LAS bf16_t*)(L + 5 * MATB); LAS bf16_t* B6 = (LAS bf16_t*)(L + 6 * MATB); LAS bf16_t* B7 = (LAS bf16_t*)(L + 7 * MATB);
    LAS bf16_t* B8 = (LAS bf16_t*)(L + 8 * MATB); LAS bf16_t* B9 = (LAS bf16_t*)(L + 9 * MATB); LAS bf16_t* B10 = (LAS bf16_t*)(L + 10 * MATB); LAS bf16_t* B11 = (LAS bf16_t*)(L + 11 * MATB);
    LAS float* F0 = (LAS float*)(L + OFF_F0); LAS float* TMP = (LAS float*)(L + OFF_TMP);
    LAS bf16_t* TW = (LAS bf16_t*)(L + OFF_TW); LAS bf16_t* TA = (LAS bf16_t*)(L + OFF_TA); LAS bf16_t* TV = (LAS bf16_t*)(L + OFF_TV);
    LAS float* WP = (LAS float*)(L + OFF_WP); LAS float* AP = (LAS float*)(L + OFF_AP); LAS float* VP = (LAS float*)(L + OFF_VP);
    LAS float* TOT = (LAS float*)(L + OFF_TOT); LAS float* GC = (LAS float*)(L + OFF_GC); LAS float* RN = (LAS float*)(L + OFF_RN);
    for (;;) {
        if (tid_in == 0) qw[0] = atomicAdd(qctr, 1u);
        RW_BAR(); const int item = (int)qw[0]; RW_BAR();
        if (item >= NITEMS) return item;
        const int bh = item / (SEQ / 64), chunk = item % (SEQ / 64), b = bh / 6, h = bh % 6;
        const int tok0 = b * SEQ + chunk * 64;
        unsigned short e_r[9], e_k[9], e_v[9], e_vf[8]; float e_mu_r, e_mu_k, e_mu_v, e_w0, e_a0, e_kk, e_ka, e_rk, e_v0;
        { RW_LANES(); const int hc = 64 * h + lane, tk0 = tok0 + 8 * w; const bool has_prev = (chunk * 64 + 8 * w) > 0;
#pragma unroll
          for (int j = 0; j < 9; ++j) { const size_t row = (size_t)(tk0 + j - 1) * LDP; const bool ok = j > 0 || has_prev;
              e_r[j] = ok ? P[row + 640 + hc] : (unsigned short)0; e_k[j] = ok ? P[row + 1024 + hc] : (unsigned short)0; e_v[j] = ok ? P[row + 1408 + hc] : (unsigned short)0; }
#pragma unroll
          for (int j = 0; j < 8; ++j) e_vf[j] = layer > 0 ? RW_VF[(size_t)(tk0 + j) * 384 + hc] : (unsigned short)0;
          e_mu_r = RWP(mk::RP_MU)[hc]; e_mu_k = RWP(mk::RP_MU)[384 + hc]; e_mu_v = RWP(mk::RP_MU)[768 + hc]; e_w0 = RWP(mk::RP_W0)[hc]; e_a0 = RWP(mk::RP_A0)[hc]; e_kk = RWP(mk::RP_KK)[hc]; e_ka = RWP(mk::RP_KA)[hc]; e_rk = RWP(mk::RP_RK)[hc]; e_v0 = layer > 0 ? RWP(mk::RP_V0)[hc] : 0.f; }
        for (int rp_ = 0; rp_ < ((PROF_PH) == 20 ? 2 : 1); ++rp_) {
        { RW_LANES(); const int t = tid >> 3, sub = tid & 7, tok = tok0 + t; const bool hp = (chunk * 64 + t) > 0;
          const GAS bf16_t* rc = P + (size_t)tok * LDP; const GAS bf16_t* rp = rc - LDP; const v4u z4 = {0u, 0u, 0u, 0u};
          const v4u lc = *(const GAS v4u*)(rc + 1792 + 8 * sub), lp = hp ? *(const GAS v4u*)(rp + 1792 + 8 * sub) : z4;
          const v4u kc4 = *(const GAS v4u*)(rc + 1024 + 64 * h + 8 * sub), kp4 = hp ? *(const GAS v4u*)(rp + 1024 + 64 * h + 8 * sub) : z4;
          v4u vc4 = z4, vp4 = z4; if (layer > 0 && sub < 2) { vc4 = *(const GAS v4u*)(rc + 1920 + 8 * sub); if (hp) vp4 = *(const GAS v4u*)(rp + 1920 + 8 * sub); }
          const unsigned lcw[4] = {lc.x, lc.y, lc.z, lc.w}, lpw[4] = {lp.x, lp.y, lp.z, lp.w}, kcw[4] = {kc4.x, kc4.y, kc4.z, kc4.w}, kpw[4] = {kp4.x, kp4.y, kp4.z, kp4.w}, vcw[4] = {vc4.x, vc4.y, vc4.z, vc4.w}, vpw[4] = {vp4.x, vp4.y, vp4.z, vp4.w};
          unsigned lo[4], vo[4]; float s = 0.f;
          const f32x4 mA0 = *(const GAS f32x4*)(RWP(mk::RP_MU) + 1152 + 8 * sub), mA1 = *(const GAS f32x4*)(RWP(mk::RP_MU) + 1156 + 8 * sub);
          const f32x4 mK0 = *(const GAS f32x4*)(RWP(mk::RP_MU) + 384 + 64 * h + 8 * sub), mK1 = *(const GAS f32x4*)(RWP(mk::RP_MU) + 388 + 64 * h + 8 * sub);
          const f32x4 kk0 = *(const GAS f32x4*)(RWP(mk::RP_KK) + 64 * h + 8 * sub), kk1 = *(const GAS f32x4*)(RWP(mk::RP_KK) + 64 * h + 8 * sub + 4);
          f32x4 mV0 = {0.f, 0.f, 0.f, 0.f}, mV1 = mV0; if (layer > 0 && sub < 2) { mV0 = *(const GAS f32x4*)(RWP(mk::RP_MUV) + 8 * sub); mV1 = *(const GAS f32x4*)(RWP(mk::RP_MUV) + 8 * sub + 4); }
#pragma unroll
          for (int e2 = 0; e2 < 4; ++e2) { float xl[2], xv[2];
#pragma unroll
              for (int u = 0; u < 2; ++u) { const int e = 2 * e2 + u; const int sh = 16 * u;
                  const float c1 = bf2f((bf16_t)((lcw[e2] >> sh) & 0xffff)), p1 = bf2f((bf16_t)((lpw[e2] >> sh) & 0xffff)); const float x = c1 + (e < 4 ? mA0[e & 3] : mA1[e & 3]) * (p1 - c1);
                  xl[u] = sub < 4 ? ftanh(x) : x;
                  const float c2 = bf2f((bf16_t)((kcw[e2] >> sh) & 0xffff)), p2 = bf2f((bf16_t)((kpw[e2] >> sh) & 0xffff));
                  const float kx = (c2 + (e < 4 ? mK0[e & 3] : mK1[e & 3]) * (p2 - c2)) * (e < 4 ? kk0[e & 3] : kk1[e & 3]); s += kx * kx;
                  const float c3 = bf2f((bf16_t)((vcw[e2] >> sh) & 0xffff)), p3 = bf2f((bf16_t)((vpw[e2] >> sh) & 0xffff)); xv[u] = c3 + (e < 4 ? mV0[e & 3] : mV1[e & 3]) * (p3 - c3); }
              lo[e2] = pk2(xl[0], xl[1]); vo[e2] = pk2(xv[0], xv[1]); }
          *(LAS v4u*)((sub < 4 ? TW : TA) + t * 40 + 8 * (sub & 3)) = (v4u){lo[0], lo[1], lo[2], lo[3]};
          if (layer > 0 && sub < 4) *(LAS v4u*)(TV + t * 40 + 8 * sub) = (v4u){vo[0], vo[1], vo[2], vo[3]};
          s += __shfl_xor(s, 1); s += __shfl_xor(s, 2); s += __shfl_xor(s, 4);
          if (sub == 0) RN[t] = 1.0f / fmaxf(sqrtf(s), 1e-12f); }
        RW_BAR();
        }
        { RW_LANES();
#pragma unroll
        for (int e = 0; e < 2; ++e) { const int tl = 2 * w + e, ti = tl >> 2, tj = tl & 3; const f32x4 z4 = {0.f, 0.f, 0.f, 0.f};
            const size_t brow = (size_t)(64 * h + 16 * tj + fr) * 32 + 8 * fq;
            { const bf16x8 a = *(const LAS bf16x8*)(TW + (16 * ti + fr) * 40 + 8 * fq); const bf16x8 bb = *(const GAS bf16x8*)(RW_LORA(mk::SM_W2T) + brow);
              const f32x4 d = __builtin_amdgcn_mfma_f32_16x16x32_bf16(a, bb, z4, 0, 0, 0);
#pragma unroll
              for (int r = 0; r < 4; ++r) WP[(16 * ti + 4 * fq + r) * 65 + 16 * tj + fr] = d[r]; }
            { const bf16x8 a = *(const LAS bf16x8*)(TA + (16 * ti + fr) * 40 + 8 * fq); const bf16x8 bb = *(const GAS bf16x8*)(RW_LORA(mk::SM_A2T) + brow);
              const f32x4 d = __builtin_amdgcn_mfma_f32_16x16x32_bf16(a, bb, z4, 0, 0, 0);
#pragma unroll
              for (int r = 0; r < 4; ++r) AP[(16 * ti + 4 * fq + r) * 65 + 16 * tj + fr] = d[r]; }
            if (layer > 0) { const bf16x8 a = *(const LAS bf16x8*)(TV + (16 * ti + fr) * 40 + 8 * fq); const bf16x8 bb = *(const GAS bf16x8*)(RW_LORA(mk::SM_V2T) + brow);
              const f32x4 d = __builtin_amdgcn_mfma_f32_16x16x32_bf16(a, bb, z4, 0, 0, 0);
#pragma unroll
              for (int r = 0; r < 4; ++r) VP[(16 * ti + 4 * fq + r) * 65 + 16 * tj + fr] = d[r]; } } }
        RW_BAR();
        for (int rp_ = 0; rp_ < ((PROF_PH) == 21 ? 2 : 1); ++rp_) {
        { RW_LANES(); const int c = lane, hc = 64 * h + c, tq0 = 8 * w, tk0 = tok0 + tq0;
          const float mu_r = e_mu_r, mu_k = e_mu_k, mu_v = e_mu_v, w0 = e_w0, a0 = e_a0, k_k = e_kk, k_a = e_ka, r_k = e_rk, v0 = e_v0;
          float pr = bf2f(e_r[0]), pk = bf2f(e_k[0]), pv = bf2f(e_v[0]);
          float rr[8], kq[8], vv[8], kkc[8], bb[8], ld[8], pd[8];
#pragma unroll
          for (int j = 0; j < 8; ++j) { const int t = tq0 + j;
              const float cr = bf2f(e_r[j + 1]), ck = bf2f(e_k[j + 1]), cv = bf2f(e_v[j + 1]);
              const float r = cr + mu_r * (pr - cr), k = ck + mu_k * (pk - ck); float v = cv + mu_v * (pv - cv); pr = cr; pk = ck; pv = cv;
              const float wp = w0 + WP[t * 65 + c], ap = a0 + AP[t * 65 + c];
              const float z = -wp, sp = fmaxf(z, 0.f) + __logf(1.0f + __expf(-fabsf(z))); const float wl = -sp - 0.5f;
              const float al = fsigm(ap);
              if (layer > 0) { const float vp = v0 + VP[t * 65 + c]; const float vf = bf2f(e_vf[j]); v = v + (vf - v) * fsigm(vp); }
              const float kn = k * k_k * RN[t]; const float k2 = k * (1.0f + (al - 1.0f) * k_a);
              rr[j] = r; kq[j] = k2; vv[j] = v; kkc[j] = kn; bb[j] = kn * al; ld[j] = -fexp(wl); pd[j] = r * k2 * r_k; }
          {
#pragma unroll
            for (int j = 0; j < 8; j += 2) { const unsigned pv2 = pk2(vv[j], vv[j + 1]); RW_VF[(size_t)(tk0 + j) * 384 + hc] = (bf16_t)(pv2 & 0xffff); RW_VF[(size_t)(tk0 + j + 1) * 384 + hc] = (bf16_t)(pv2 >> 16); } }
          {
            const bool b5 = lane & 32, b4 = lane & 16, b3 = lane & 8; float s4[4], s2[2], s1;
#pragma unroll
            for (int i = 0; i < 4; ++i) { const float keep = b5 ? pd[i + 4] : pd[i], send = b5 ? pd[i] : pd[i + 4]; s4[i] = keep + __shfl_xor(send, 32); }
#pragma unroll
            for (int i = 0; i < 2; ++i) { const float keep = b4 ? s4[i + 2] : s4[i], send = b4 ? s4[i] : s4[i + 2]; s2[i] = keep + __shfl_xor(send, 16); }
            { const float keep = b3 ? s2[1] : s2[0], send = b3 ? s2[0] : s2[1]; s1 = keep + __shfl_xor(send, 8); }
            s1 += __shfl_xor(s1, 4); s1 += __shfl_xor(s1, 2); s1 += __shfl_xor(s1, 1);
            if ((lane & 7) == 0) RW_DOT[(size_t)(tk0 + (lane >> 3)) * 6 + h] = s1; }
          float cl[8]; cl[0] = ld[0];
#pragma unroll
          for (int j = 1; j < 8; ++j) cl[j] = cl[j - 1] + ld[j];
          TOT[w * 64 + c] = cl[7];
          RW_BAR();
          float prefix = 0.f, cumC = 0.f;
#pragma unroll
          for (int ww = 0; ww < 8; ++ww) { const float tv = TOT[ww * 64 + c]; cumC += tv; if (ww < w) prefix += tv; }
          const float gcc = fexp(cumC); if (w == 0) GC[c] = gcc;
          unsigned ahp[4], btp[4], ktp[4], vp4[4]; float gprev = fexp(prefix), ah_e = 0.f, bt_e = 0.f, kt_e = 0.f;
#pragma unroll
          for (int j = 0; j < 8; ++j) { const int t = tq0 + j; const float g = fexp(prefix + cl[j]), ig = __builtin_amdgcn_rcpf(g), gc = gcc * ig;
              const float ah = -kkc[j] * gprev, rh = rr[j] * g, bh = bb[j] * ig, kh = kq[j] * ig, bt = bb[j] * gc, kt = kq[j] * gc; gprev = g;
              const unsigned w01 = pk2(ah, rh), w23 = pk2(bh, kh);
              B0[t * LD + c] = (bf16_t)(w01 & 0xffff); B1[t * LD + c] = (bf16_t)(w01 >> 16); B2[t * LD + c] = (bf16_t)(w23 & 0xffff); B3[t * LD + c] = (bf16_t)(w23 >> 16);
              if (j & 1) { ahp[j >> 1] = pk2(ah_e, ah); btp[j >> 1] = pk2(bt_e, bt); ktp[j >> 1] = pk2(kt_e, kt); vp4[j >> 1] = pk2(vv[j - 1], vv[j]); }
              else { ah_e = ah; bt_e = bt; kt_e = kt; } }
          *(LAS v4u*)(B4 + c * LD + tq0) = (v4u){ahp[0], ahp[1], ahp[2], ahp[3]}; *(LAS v4u*)(B5 + c * LD + tq0) = (v4u){btp[0], btp[1], btp[2], btp[3]};
          *(LAS v4u*)(B6 + c * LD + tq0) = (v4u){ktp[0], ktp[1], ktp[2], ktp[3]}; *(LAS v4u*)(B7 + c * LD + tq0) = (v4u){vp4[0], vp4[1], vp4[2], vp4[3]}; }
        RW_BAR();
        }
        for (int rp_ = 0; rp_ < ((PROF_PH) == 22 ? 2 : 1); ++rp_) {
        { RW_LANES(); const int prod = w >> 1; const LAS bf16_t* Aop = prod < 2 ? B0 : B1; const LAS bf16_t* Bop = (prod & 1) ? B3 : B2;
#pragma unroll
          for (int e = 0; e < 8; ++e) { const int tl = (w & 1) * 8 + e, ti = tl >> 2, tj = tl & 3; f32x4 d = {0.f, 0.f, 0.f, 0.f};
              if (tj <= ti) d = mm_tile(Aop, Bop, ti, tj, fr, fq, d);
#pragma unroll
              for (int r = 0; r < 4; ++r) { const int t = 16 * ti + 4 * fq + r, i = 16 * tj + fr; const bool keep = prod < 2 ? (i < t) : (i <= t); const float val = (tj <= ti && keep) ? d[r] : 0.f;
                  if (prod == 0) F0[t * 65 + i] = val; else if (prod == 1) B8[t * LD + i] = f2bf(val); else if (prod == 2) B9[t * LD + i] = f2bf(val); else B10[t * LD + i] = f2bf(val); } } }
        RW_BAR();
        }
        if (w == 0) { RW_LANES();
            const int blk = lane >> 4, jc = lane & 15; const LAS float* Lb = F0 + (16 * blk) * 65 + 16 * blk; float tc[16];
#pragma unroll
            for (int r = 0; r < 16; ++r) { float val = (r == jc) ? 1.f : 0.f;
#pragma unroll
                for (int i = 0; i < r; ++i) val += Lb[r * 65 + i] * tc[i];
                tc[r] = val; }
            asm volatile("s_waitcnt lgkmcnt(0)" ::: "memory");
#pragma unroll
            for (int r = 0; r < 16; ++r) F0[(16 * blk + r) * 65 + 16 * blk + jc] = tc[r];
        }
        RW_BAR();
        if (w < 2) { RW_LANES();
            const int o1 = 32 * w, o2 = 32 * w + 16; f32x4 d = {0.f, 0.f, 0.f, 0.f};
#pragma unroll
            for (int ks = 0; ks < 4; ++ks) d = __builtin_amdgcn_mfma_f32_16x16x4f32(F0[(o2 + fr) * 65 + o1 + 4 * ks + fq], F0[(o1 + 4 * ks + fq) * 65 + o1 + fr], d, 0, 0, 0);
            LAS float* tm = TMP + w * 16 * 17;
#pragma unroll
            for (int r = 0; r < 4; ++r) tm[(4 * fq + r) * 17 + fr] = d[r];
            asm volatile("s_waitcnt lgkmcnt(0)" ::: "memory");
            f32x4 d2 = {0.f, 0.f, 0.f, 0.f};
#pragma unroll
            for (int ks = 0; ks < 4; ++ks) d2 = __builtin_amdgcn_mfma_f32_16x16x4f32(F0[(o2 + fr) * 65 + o2 + 4 * ks + fq], tm[(4 * ks + fq) * 17 + fr], d2, 0, 0, 0);
            asm volatile("s_waitcnt lgkmcnt(0)" ::: "memory");
#pragma unroll
            for (int r = 0; r < 4; ++r) F0[(o2 + 4 * fq + r) * 65 + o1 + fr] = d2[r];
        }
        RW_BAR();
        if (w < 4) { RW_LANES();
            const int ti = w >> 1, tj = w & 1; f32x4 d = {0.f, 0.f, 0.f, 0.f};
#pragma unroll
            for (int ks = 0; ks < 8; ++ks) d = __builtin_amdgcn_mfma_f32_16x16x4f32(F0[(32 + 16 * ti + fr) * 65 + 4 * ks + fq], F0[(4 * ks + fq) * 65 + 16 * tj + fr], d, 0, 0, 0);
#pragma unroll
            for (int r = 0; r < 4; ++r) TMP[(16 * ti + 4 * fq + r) * 33 + 16 * tj + fr] = d[r];
        }
        RW_BAR();
        if (w < 4) { RW_LANES();
            const int ti = w >> 1, tj = w & 1; f32x4 d = {0.f, 0.f, 0.f, 0.f};
#pragma unroll
            for (int ks = 0; ks < 8; ++ks) d = __builtin_amdgcn_mfma_f32_16x16x4f32(F0[(32 + 16 * ti + fr) * 65 + 32 + 4 * ks + fq], TMP[(4 * ks + fq) * 33 + 16 * tj + fr], d, 0, 0, 0);
#pragma unroll
            for (int r = 0; r < 4; ++r) F0[(32 + 16 * ti + 4 * fq + r) * 65 + 16 * tj + fr] = d[r];
        }
        RW_BAR();
        { RW_LANES(); const int t = tid >> 3, i0 = (tid & 7) * 8;
#pragma unroll
          for (int e = 0; e < 8; ++e) B11[t * LD + i0 + e] = f2bf(F0[t * 65 + i0 + e]); }
        RW_BAR();
        { RW_LANES();
#pragma unroll
        for (int e = 0; e < 4; ++e) { const int tl = 4 * w + e, prod = tl >> 4, ti = (tl >> 2) & 3, tj = tl & 3; f32x4 d = {0.f, 0.f, 0.f, 0.f};
            d = prod == 0 ? mm_tile(B11, B4, ti, tj, fr, fq, d) : mm_tile(B8, B7, ti, tj, fr, fq, d);
            LAS bf16_t* dst = (prod == 0 ? B0 : B2) + (16 * tj + fr) * LD + 16 * ti + 4 * fq;
            *(LAS unsigned long long*)dst = (unsigned long long)pk2(d[0], d[1]) | ((unsigned long long)pk2(d[2], d[3]) << 32); } }
        RW_BAR();
        { RW_LANES();
#pragma unroll
        for (int e = 0; e < 2; ++e) { const int tl = 2 * w + e, ti = tl >> 2, tj = tl & 3; f32x4 d = {0.f, 0.f, 0.f, 0.f};
            d = mm_tile(B11, B2, ti, tj, fr, fq, d);
            LAS bf16_t* dst = B3 + (16 * tj + fr) * LD + 16 * ti + 4 * fq;
            *(LAS unsigned long long*)dst = (unsigned long long)pk2(d[0], d[1]) | ((unsigned long long)pk2(d[2], d[3]) << 32); } }
        RW_BAR();
        for (int rp_ = 0; rp_ < ((PROF_PH) == 23 ? 2 : 1); ++rp_) {
        { RW_LANES();
#pragma unroll
        for (int e = 0; e < 8; ++e) { const int tl = 8 * w + e, prod = tl >> 4, ti = (tl >> 2) & 3, tj = tl & 3; f32x4 d = {0.f, 0.f, 0.f, 0.f};
            if (prod == 0) { d = mm_tile(B5, B3, ti, tj, fr, fq, d); d = mm_tile(B6, B7, ti, tj, fr, fq, d);
                *(GAS f32x4*)(RW_Z + (size_t)item * 4096 + (16 * tj + fr) * 64 + 4 * ((4 * ti + fq) ^ fr)) = d; }
            else if (prod == 1) { d = mm_tile(B9, B3, ti, tj, fr, fq, d); d = mm_tile(B10, B7, ti, tj, fr, fq, d);
                *(GAS unsigned long long*)(RW_YV + (size_t)item * 4096 + (16 * tj + fr) * 64 + 16 * ti + 4 * fq) = (unsigned long long)pk2(d[0], d[1]) | ((unsigned long long)pk2(d[2], d[3]) << 32); }
            else if (prod == 2) { d = mm_tile(B9, B0, ti, tj, fr, fq, d);
#pragma unroll
                for (int r = 0; r < 4; ++r) { const int t = 16 * ti + 4 * fq + r, c = 16 * tj + fr; B4[t * LD + sigpos(c)] = f2bf(d[r] + bf2f(B1[t * LD + c])); } }
            else { d = mm_tile(B5, B0, ti, tj, fr, fq, d);
#pragma unroll
                for (int r = 0; r < 4; ++r) { const int c = 16 * ti + 4 * fq + r, c2 = 16 * tj + fr; B8[c * LD + sigpos(c2)] = f2bf(d[r] + (c == c2 ? GC[c] : 0.f)); } } } }
        RW_BAR();
        }
        { RW_LANES(); const int r = tid >> 3, ch = (tid & 7) * 8;
          *(GAS v4u*)(RW_G + (size_t)item * 4096 + r * 64 + ch) = *(const LAS v4u*)(B4 + r * LD + ch);
          *(GAS v4u*)(RW_PT + (size_t)item * 4096 + r * 64 + 8 * ((tid & 7) ^ (r & 7))) = *(const LAS v4u*)(B8 + r * LD + ch); }
        RW_BAR();
    }
}
constexpr int SC_NS = 10, SC_SLOT = 12288, SC_LAG = 6;
__device__ __forceinline__ void scan_compute(LAS unsigned char* L, const ChunkBufs cb, int bh, int tj, int lane, volatile LAS unsigned* flags) {
    const int fr = lane & 15, fq = lane >> 4; const int NC = SEQ / 64;
    bf16x8 Bf0 = {0, 0, 0, 0, 0, 0, 0, 0}, Bf1 = {0, 0, 0, 0, 0, 0, 0, 0};
    bf16_t* s0 = cb.S0 + (size_t)(bh * NC) * 4096 + (16 * tj + fr) * 64 + 8 * fq;
    const int po0 = fr * 128 + 16 * ((fq) ^ (fr & 7)), po1 = fr * 128 + 16 * ((4 + fq) ^ (fr & 7));
    int slot = 0;
    for (int chunk = 0; chunk < NC; ++chunk) {
        unsigned spins = 0;
        while (true) { const unsigned a = flags[0], b = flags[1], c = flags[2]; const unsigned m = a < b ? (a < c ? a : c) : (b < c ? b : c); if ((int)m >= chunk + 1 || ++spins > (1u << 22)) break; __builtin_amdgcn_s_sleep(1); }
        const LAS unsigned char* sp = L + slot * SC_SLOT;
        bf16x8 a0[4], a1[4]; f32x4 z[4];
#pragma unroll
        for (int ti = 0; ti < 4; ++ti) { a0[ti] = *(const LAS bf16x8*)(sp + ti * 2048 + po0); a1[ti] = *(const LAS bf16x8*)(sp + ti * 2048 + po1); z[ti] = *(const LAS f32x4*)(sp + 8192 + fr * 256 + 16 * ((4 * ti + fq) ^ fr)); }
        asm volatile("s_waitcnt lgkmcnt(0)" ::: "memory");
        if (lane == 0) flags[3] = (unsigned)(chunk + 1);
        *(GAS bf16x8*)(s0 + (size_t)chunk * 4096) = Bf0; *(GAS bf16x8*)(s0 + (size_t)chunk * 4096 + 32) = Bf1;
        f32x4 acc[4];
#pragma unroll
        for (int ti = 0; ti < 4; ++ti) { acc[ti] = __builtin_amdgcn_mfma_f32_16x16x32_bf16(a0[ti], Bf0, z[ti], 0, 0, 0); acc[ti] = __builtin_amdgcn_mfma_f32_16x16x32_bf16(a1[ti], Bf1, acc[ti], 0, 0, 0); }
        v4u m0, m1;
        m0.x = pk2(acc[0][0], acc[0][1]); m0.y = pk2(acc[0][2], acc[0][3]); m0.z = pk2(acc[1][0], acc[1][1]); m0.w = pk2(acc[1][2], acc[1][3]);
        m1.x = pk2(acc[2][0], acc[2][1]); m1.y = pk2(acc[2][2], acc[2][3]); m1.z = pk2(acc[3][0], acc[3][1]); m1.w = pk2(acc[3][2], acc[3][3]);
        Bf0 = __builtin_bit_cast(bf16x8, m0); Bf1 = __builtin_bit_cast(bf16x8, m1);
        slot = slot + 1 == SC_NS ? 0 : slot + 1;
    }
}
__device__ __forceinline__ void scan_loader(LAS unsigned char* L, const ChunkBufs cb, int bh, int tj, int lw, int lane, volatile LAS unsigned* flags) {
    const int NC = SEQ / 64;
    const char* src[4];
#pragma unroll
    for (int k = 0; k < 4; ++k) { const int pc = 4 * lw + k;
        src[k] = pc < 8 ? (const char*)(cb.PT + (size_t)(bh * NC) * 4096) + pc * 1024 + lane * 16 : (const char*)(cb.Z + (size_t)(bh * NC) * 4096) + tj * 4096 + (pc - 8) * 1024 + lane * 16; }
    const size_t st0 = 8192, st1 = 16384;
    int slot = 0;
    for (int c = 0; c < NC; ++c) {
        unsigned spins = 0;
        while ((int)flags[3] < c - SC_NS + 1 && ++spins < (1u << 22)) __builtin_amdgcn_s_sleep(1);
        const unsigned dst = (unsigned)(slot * SC_SLOT + 4 * lw * 1024);
#pragma unroll
        for (int k = 0; k < 4; ++k) { const int pc = 4 * lw + k;
            __builtin_amdgcn_global_load_lds((const unsigned*)(src[k] + (size_t)c * (pc < 8 ? st0 : st1)), (LAS unsigned*)(L + dst + k * 1024), 16, 0, 0); }
        if (c >= SC_LAG) { asm volatile("s_waitcnt vmcnt(24)" ::: "memory"); if (lane == 0) flags[lw] = (unsigned)(c - SC_LAG + 1); }
        slot = slot + 1 == SC_NS ? 0 : slot + 1;
    }
    asm volatile("s_waitcnt vmcnt(0)" ::: "memory");
    if (lane == 0) flags[lw] = (unsigned)NC;
}
constexpr int O_SG = 0  , O_Y = 9216  , O_GT = O_Y + 16640  ;
struct OutRegs { v4u gc4, gp4, vo4; unsigned long long yw[2]; bf16x8 a[2][2], bb[2][2], b2[2][2]; float dot; f32x4 lw0, lw1, lb0, lb1; };
__device__ __forceinline__ void out_load(OutRegs& R, unsigned char* wsb, int layer, int item, int tid, int w) {
    const GAS bf16_t* P = RW_PROJ;
    const int lane = tid & 63, fr = lane & 15, fq = lane >> 4;
    const int bh = item / (SEQ / 64), chunk = item % (SEQ / 64), b = bh / 6, h = bh % 6; const int tok0 = b * SEQ + chunk * 64; const size_t ib = (size_t)item * 4096;
    const int t = tid >> 3, sub = tid & 7, tok = tok0 + t; const bool hp = (chunk * 64 + t) > 0;
    const GAS bf16_t* rc = P + (size_t)tok * LDP + 1856 + 8 * sub; const v4u z4 = {0u, 0u, 0u, 0u};
    R.gc4 = *(const GAS v4u*)rc; R.gp4 = hp ? *(const GAS v4u*)(rc - LDP) : z4;
#pragma unroll
    for (int e = 0; e < 2; ++e) { const int tl = 2 * w + e, ti = tl >> 2, tj = tl & 3;
        R.yw[e] = *(const GAS unsigned long long*)(RW_YV + ib + (16 * tj + fr) * 64 + 16 * ti + 4 * fq);
#pragma unroll
        for (int kk = 0; kk < 2; ++kk) { R.a[e][kk] = *(const GAS bf16x8*)(RW_G + ib + (16 * ti + fr) * 64 + 32 * kk + 8 * fq); R.bb[e][kk] = *(const GAS bf16x8*)(RW_S0 + ib + (16 * tj + fr) * 64 + 32 * kk + 8 * fq);
            R.b2[e][kk] = *(const GAS bf16x8*)(RW_LORA(mk::SM_G2T) + (size_t)(64 * h + 16 * tj + fr) * 64 + 32 * kk + 8 * fq); } }
    R.dot = RW_DOT[(size_t)tok * 6 + h]; R.vo4 = *(const GAS v4u*)(RW_VF + (size_t)tok * 384 + 64 * h + 8 * sub);
    R.lw0 = *(const GAS f32x4*)(RWP(mk::RP_LNW) + 64 * h + 8 * sub); R.lw1 = *(const GAS f32x4*)(RWP(mk::RP_LNW) + 64 * h + 8 * sub + 4); R.lb0 = *(const GAS f32x4*)(RWP(mk::RP_LNB) + 64 * h + 8 * sub); R.lb1 = *(const GAS f32x4*)(RWP(mk::RP_LNB) + 64 * h + 8 * sub + 4);
}
__device__ __forceinline__ void out_phase(LAS unsigned char* L, unsigned char* wsb, int layer, int tid_in, int first, int stride) {
    GAS bf16_t* MIX = RW_MIX;
    const int w = __builtin_amdgcn_readfirstlane(tid_in >> 6);
    LAS bf16_t* SG = (LAS bf16_t*)(L + O_SG); LAS float* Y = (LAS float*)(L + O_Y); LAS float* GT = (LAS float*)(L + O_GT);
    OutRegs R; if (first < NITEMS) { RW_LANES(); out_load(R, wsb, layer, first, tid, w); }
    for (int item = first; item < NITEMS; item += stride) {
        const int bh = item / (SEQ / 64), chunk = item % (SEQ / 64), b = bh / 6, h = bh % 6; const int tok0 = b * SEQ + chunk * 64;
        OutRegs N = R; if (item + stride < NITEMS) { RW_LANES(); out_load(N, wsb, layer, item + stride, tid, w); }
        { RW_LANES(); const int t = tid >> 3, sub = tid & 7;
          const f32x4 m0 = *(const GAS f32x4*)(RWP(mk::RP_MU) + 1216 + 8 * sub), m1 = *(const GAS f32x4*)(RWP(mk::RP_MU) + 1220 + 8 * sub);
          const unsigned cw_[4] = {R.gc4.x, R.gc4.y, R.gc4.z, R.gc4.w}, pw_[4] = {R.gp4.x, R.gp4.y, R.gp4.z, R.gp4.w}; unsigned o[4];
#pragma unroll
          for (int e2 = 0; e2 < 4; ++e2) { float x[2];
#pragma unroll
              for (int u = 0; u < 2; ++u) { const int e = 2 * e2 + u; const float c1 = bf2f((bf16_t)((cw_[e2] >> (16 * u)) & 0xffff)), p1 = bf2f((bf16_t)((pw_[e2] >> (16 * u)) & 0xffff));
                  x[u] = fsigm(c1 + (e < 4 ? m0[e & 3] : m1[e & 3]) * (p1 - c1)); }
              o[e2] = pk2(x[0], x[1]); }
          *(LAS v4u*)(SG + t * LD + 8 * sub) = (v4u){o[0], o[1], o[2], o[3]}; }
        RW_BAR();
        { RW_LANES();
#pragma unroll
        for (int e = 0; e < 2; ++e) { const int tl = 2 * w + e, ti = tl >> 2, tj = tl & 3; const unsigned long long yw = R.yw[e];
            f32x4 d = {bf2f((bf16_t)(yw & 0xffff)), bf2f((bf16_t)((yw >> 16) & 0xffff)), bf2f((bf16_t)((yw >> 32) & 0xffff)), bf2f((bf16_t)(yw >> 48))}; f32x4 g = {0.f, 0.f, 0.f, 0.f};
#pragma unroll
            for (int kk = 0; kk < 2; ++kk) {
                d = __builtin_amdgcn_mfma_f32_16x16x32_bf16(R.a[e][kk], R.bb[e][kk], d, 0, 0, 0);
                const bf16x8 a2 = *(const LAS bf16x8*)(SG + (16 * ti + fr) * LD + 32 * kk + 8 * fq);
                g = __builtin_amdgcn_mfma_f32_16x16x32_bf16(a2, R.b2[e][kk], g, 0, 0, 0); }
#pragma unroll
            for (int r = 0; r < 4; ++r) { Y[(16 * ti + 4 * fq + r) * 65 + 16 * tj + fr] = d[r]; GT[(16 * ti + 4 * fq + r) * 65 + 16 * tj + fr] = g[r]; } } }
        RW_BAR();
        { RW_LANES(); const int t = tid >> 3, sub = tid & 7, tok = tok0 + t; float yv[8], s = 0.f;
#pragma unroll
          for (int e = 0; e < 8; ++e) { yv[e] = Y[t * 65 + 8 * sub + e]; s += yv[e]; }
          s += __shfl_xor(s, 1); s += __shfl_xor(s, 2); s += __shfl_xor(s, 4);
          const float mean = s * (1.0f / 64.0f); float q = 0.f;
#pragma unroll
          for (int e = 0; e < 8; ++e) { const float dd = yv[e] - mean; q += dd * dd; }
          q += __shfl_xor(q, 1); q += __shfl_xor(q, 2); q += __shfl_xor(q, 4);
          const float rstd = __builtin_amdgcn_rsqf(q * (1.0f / 64.0f) + GN_EPS), dot = R.dot;
          const unsigned vw[4] = {R.vo4.x, R.vo4.y, R.vo4.z, R.vo4.w}; unsigned o[4];
#pragma unroll
          for (int e = 0; e < 8; e += 2) { float r2[2];
#pragma unroll
              for (int u = 0; u < 2; ++u) { const int ee = e + u; const float lw = ee < 4 ? R.lw0[ee & 3] : R.lw1[ee & 3], lb = ee < 4 ? R.lb0[ee & 3] : R.lb1[ee & 3];
                  const float yn = (yv[ee] - mean) * rstd * lw + lb; const float vv = bf2f((bf16_t)((vw[ee >> 1] >> (16 * (ee & 1))) & 0xffff));
                  r2[u] = (yn + dot * vv) * GT[t * 65 + 8 * sub + ee]; }
              o[e >> 1] = pk2(r2[0], r2[1]); }
          *(GAS v4u*)(MIX + (size_t)tok * DM + 384 + 64 * h + 8 * sub) = (v4u){o[0], o[1], o[2], o[3]}; }
        RW_BAR();
        R = N;
    }
}
}
namespace at {
constexpr int LDK = 72, LDV = 264;
constexpr int A_K = 0, A_V = 256 * LDK * 2  , A_BIAS = A_V + 64 * LDV * 2  , LDB = 256, BOFF = 48, A_END = A_BIAS + 6 * LDB * 4;
__device__ __forceinline__ int vpos(int key) { return (key & ~31) + 8 * ((key >> 2) & 3) + 4 * ((key >> 4) & 1) + (key & 3); }
__device__ __forceinline__ unsigned pk2(float lo, float hi) { typedef float f2_t __attribute__((ext_vector_type(2))); typedef __bf16 b2_t __attribute__((ext_vector_type(2))); f2_t v = {lo, hi}; return __builtin_bit_cast(unsigned, __builtin_convertvector(v, b2_t)); }
#define AT_BAR() do { asm volatile("s_waitcnt vmcnt(0) lgkmcnt(0)" ::: "memory"); __builtin_amdgcn_s_barrier(); asm volatile("" ::: "memory"); } while (0)

__device__ __forceinline__ void stage_kv(LAS unsigned char* L, int tid, const bf16_t* kbase, const bf16_t* vbase, long pitch, int jvalid0, const float* gk) {
    LAS bf16_t* Kl = (LAS bf16_t*)(L + A_K); LAS bf16_t* VTl = (LAS bf16_t*)(L + A_V);
#pragma unroll
    for (int it = 0; it < 4; ++it) { const int idx = it * 512 + tid, key = idx >> 3, ch = idx & 7;
        v4u raw = {0u, 0u, 0u, 0u}; if (key >= jvalid0) raw = *(const GAS v4u*)(kbase + (long)key * pitch + 8 * ch);
        float f[8]; f[0] = bf2f((bf16_t)(raw.x & 0xffff)); f[1] = bf2f((bf16_t)(raw.x >> 16)); f[2] = bf2f((bf16_t)(raw.y & 0xffff)); f[3] = bf2f((bf16_t)(raw.y >> 16));
        f[4] = bf2f((bf16_t)(raw.z & 0xffff)); f[5] = bf2f((bf16_t)(raw.z >> 16)); f[6] = bf2f((bf16_t)(raw.w & 0xffff)); f[7] = bf2f((bf16_t)(raw.w >> 16));
        float ss = 0.f;
#pragma unroll
        for (int e = 0; e < 8; ++e) ss += f[e] * f[e];
        ss += __shfl_xor(ss, 1); ss += __shfl_xor(ss, 2); ss += __shfl_xor(ss, 4);
        const float rs = 1.0f / sqrtf(ss * (1.0f / 64.0f) + EPS);
        const f32x4 g0 = *(const GAS f32x4*)(gk + 8 * ch), g1 = *(const GAS f32x4*)(gk + 8 * ch + 4);
        v4u o; o.x = pk2(f[0] * rs * g0[0], f[1] * rs * g0[1]); o.y = pk2(f[2] * rs * g0[2], f[3] * rs * g0[3]); o.z = pk2(f[4] * rs * g1[0], f[5] * rs * g1[1]); o.w = pk2(f[6] * rs * g1[2], f[7] * rs * g1[3]);
        *(LAS v4u*)(Kl + key * LDK + 8 * ch) = o; }
#pragma unroll
    for (int it = 0; it < 4; ++it) { const int idx = it * 512 + tid, key = idx & 255, ch = idx >> 8;
        v4u raw = {0u, 0u, 0u, 0u}; if (key >= jvalid0) raw = *(const GAS v4u*)(vbase + (long)key * pitch + 8 * ch);
        LAS bf16_t* d = VTl + (8 * ch) * LDV + vpos(key);
        d[0 * LDV] = (bf16_t)(raw.x & 0xffff); d[1 * LDV] = (bf16_t)(raw.x >> 16); d[2 * LDV] = (bf16_t)(raw.y & 0xffff); d[3 * LDV] = (bf16_t)(raw.y >> 16);
        d[4 * LDV] = (bf16_t)(raw.z & 0xffff); d[5 * LDV] = (bf16_t)(raw.z >> 16); d[6 * LDV] = (bf16_t)(raw.w & 0xffff); d[7 * LDV] = (bf16_t)(raw.w >> 16); }
}
__device__ __forceinline__ void load_q(const bf16_t* qrow, const float* gq, int fq, bf16x8& q0, bf16x8& q1) {
    const v4u r0 = *(const GAS v4u*)(qrow + 8 * fq), r1 = *(const GAS v4u*)(qrow + 32 + 8 * fq);
    float f[16]; const unsigned w[8] = {r0.x, r0.y, r0.z, r0.w, r1.x, r1.y, r1.z, r1.w};
#pragma unroll
    for (int e = 0; e < 8; ++e) { f[2 * e] = bf2f((bf16_t)(w[e] & 0xffff)); f[2 * e + 1] = bf2f((bf16_t)(w[e] >> 16)); }
    float ss = 0.f;
#pragma unroll
    for (int e = 0; e < 16; ++e) ss += f[e] * f[e];
    ss += __shfl_xor(ss, 16); ss += __shfl_xor(ss, 32);
    const float rs = 0.125f / sqrtf(ss * (1.0f / 64.0f) + EPS);
    const f32x4 g0 = *(const GAS f32x4*)(gq + 8 * fq), g1 = *(const GAS f32x4*)(gq + 8 * fq + 4), g2 = *(const GAS f32x4*)(gq + 32 + 8 * fq), g3 = *(const GAS f32x4*)(gq + 36 + 8 * fq);
    v4u a, b;
    a.x = pk2(f[0] * rs * g0[0], f[1] * rs * g0[1]); a.y = pk2(f[2] * rs * g0[2], f[3] * rs * g0[3]); a.z = pk2(f[4] * rs * g1[0], f[5] * rs * g1[1]); a.w = pk2(f[6] * rs * g1[2], f[7] * rs * g1[3]);
    b.x = pk2(f[8] * rs * g2[0], f[9] * rs * g2[1]); b.y = pk2(f[10] * rs * g2[2], f[11] * rs * g2[3]); b.z = pk2(f[12] * rs * g3[0], f[13] * rs * g3[1]); b.w = pk2(f[14] * rs * g3[2], f[15] * rs * g3[3]);
    q0 = __builtin_bit_cast(bf16x8, a); q1 = __builtin_bit_cast(bf16x8, b);
}
template <int NT, bool SWA> __device__ __forceinline__ void attn_wave(const LAS unsigned char* L, bf16x8 q0, bf16x8 q1, int kt0, int qi0, int hq, float sink, bool first_block, bf16_t* outp, int fr, int fq) {
    const LAS bf16_t* Kl = (const LAS bf16_t*)(L + A_K); const LAS bf16_t* VTl = (const LAS bf16_t*)(L + A_V); const LAS float* bias = (const LAS float*)(L + A_BIAS);
    f32x4 s[NT];
#pragma unroll
    for (int t = 0; t < NT; ++t) { const LAS bf16_t* kr = Kl + (16 * (kt0 + t) + fr) * LDK + 8 * fq;
        const f32x4 z = {0.f, 0.f, 0.f, 0.f};
        s[t] = __builtin_amdgcn_mfma_f32_16x16x32_bf16(*(const LAS bf16x8*)kr, q0, z, 0, 0, 0);
        s[t] = __builtin_amdgcn_mfma_f32_16x16x32_bf16(*(const LAS bf16x8*)(kr + 32), q1, s[t], 0, 0, 0);
        if (t & 1) __builtin_amdgcn_sched_barrier(0); }
    float mx = SWA ? sink : -3.0e38f;
    if (SWA) {
        const int odd = (qi0 >> 4) & 1; const int D0 = qi0 + fr + 128 - 16 * kt0 - 4 * fq;
        const LAS float* bp = bias + hq * LDB + BOFF + D0 - 147;
#pragma unroll
        for (int t = 0; t < NT; ++t) { const int c = t - odd;
            if (c >= 1 && c <= 7 && !first_block) {
#pragma unroll
                for (int r = 0; r < 4; ++r) { s[t][r] += bp[147 - 16 * t - r]; mx = fmaxf(mx, s[t][r]); }
            } else {
#pragma unroll
                for (int r = 0; r < 4; ++r) { const int dist = D0 - 16 * t - r; const bool valid = (unsigned)dist < 128u && !(first_block && 16 * (kt0 + t) + 4 * fq + r < 128);
                    s[t][r] = valid ? s[t][r] + bp[147 - 16 * t - r] : -3.0e38f; mx = fmaxf(mx, s[t][r]); } } }
    } else {
#pragma unroll
        for (int t = 0; t < NT; ++t)
#pragma unroll
            for (int r = 0; r < 4; ++r) mx = fmaxf(mx, s[t][r]);
    }
    mx = fmaxf(mx, __shfl_xor(mx, 16)); mx = fmaxf(mx, __shfl_xor(mx, 32));
    float l = 0.f;
#pragma unroll
    for (int t = 0; t < NT; ++t)
#pragma unroll
        for (int r = 0; r < 4; ++r) { const float p = __expf(s[t][r] - mx); s[t][r] = p; l += p; }
    l += __shfl_xor(l, 16); l += __shfl_xor(l, 32);
    if (SWA) l += __expf(sink - mx);
    f32x4 o[4];
#pragma unroll
    for (int dt = 0; dt < 4; ++dt) o[dt] = (f32x4){0.f, 0.f, 0.f, 0.f};
#pragma unroll
    for (int ks = 0; ks < NT / 2; ++ks) { v4u pw; pw.x = pk2(s[2 * ks][0], s[2 * ks][1]); pw.y = pk2(s[2 * ks][2], s[2 * ks][3]); pw.z = pk2(s[2 * ks + 1][0], s[2 * ks + 1][1]); pw.w = pk2(s[2 * ks + 1][2], s[2 * ks + 1][3]);
        const bf16x8 pb = __builtin_bit_cast(bf16x8, pw);
#pragma unroll
        for (int dt = 0; dt < 4; ++dt) o[dt] = __builtin_amdgcn_mfma_f32_16x16x32_bf16(*(const LAS bf16x8*)(VTl + (16 * dt + fr) * LDV + 32 * (kt0 / 2 + ks) + 8 * fq), pb, o[dt], 0, 0, 0);
        __builtin_amdgcn_sched_barrier(0); }
    const float inv = 1.0f / l;
#pragma unroll
    for (int dt = 0; dt < 4; ++dt) *(GAS unsigned long long*)(outp + (long)fr * DM + 16 * dt + 4 * fq) = (unsigned long long)pk2(o[dt][0] * inv, o[dt][1] * inv) | ((unsigned long long)pk2(o[dt][2] * inv, o[dt][3] * inv) << 32);
}
struct AttnArgs { const bf16_t* PROJ; const bf16_t* MKV; bf16_t* MIX; const float* biastab; const float *sinks, *gq, *gk, *gmq, *gmk; };
__device__ __forceinline__ void attn_item(LAS unsigned char* L, const AttnArgs A, int item, int tid_in) {
    const int w = __builtin_amdgcn_readfirstlane(tid_in >> 6);
    if (item < 256) {
        const int b = item >> 7, hkv = (item >> 6) & 1, blk = item & 63; const long tokb = (long)b * SEQ + blk * 128;
        { int lt_ = tid_in; asm volatile("" : "+v"(lt_)); const int tid = lt_;
          stage_kv(L, tid, A.PROJ + (tokb - 128) * LDP + 384 + 64 * hkv, A.PROJ + (tokb - 128) * LDP + 512 + 64 * hkv, LDP, blk == 0 ? 128 : 0, A.gk);
          LAS float* bl = (LAS float*)(L + A_BIAS); for (int i = tid; i < 6 * LDB; i += 512) { const int hh = i / LDB, d = i % LDB - BOFF; bl[i] = (d >= 0 && d < 128) ? A.biastab[d * 6 + hh] : 0.f; } }
        AT_BAR();
        { int lt_ = tid_in; asm volatile("" : "+v"(lt_)); const int lane = lt_ & 63, fr = lane & 15, fq = lane >> 4;
#pragma unroll 1
          for (int g = 0; g < 3; ++g) { const int hq = 3 * hkv + g; bf16x8 q0, q1;
              load_q(A.PROJ + (tokb + 16 * w + fr) * LDP + 64 * hq, A.gq, fq, q0, q1);
              attn_wave<10, true>(L, q0, q1, w & ~1, 16 * w, hq, A.sinks[hq], blk == 0, A.MIX + (tokb + 16 * w) * DM + 64 * hq, fr, fq); } }
        AT_BAR();
    } else {
        const int pr = item - 256, b = pr >> 7, h = (pr >> 5) & 3, blk2 = pr & 31;
        { int lt_ = tid_in; asm volatile("" : "+v"(lt_)); const int tid = lt_;
          stage_kv(L, tid, A.MKV + (long)(b * 256) * 512 + 64 * h, A.MKV + (long)(b * 256) * 512 + 256 + 64 * h, 512, 0, A.gmk); }
        AT_BAR();
        { int lt_ = tid_in; asm volatile("" : "+v"(lt_)); const int lane = lt_ & 63, fr = lane & 15, fq = lane >> 4;
#pragma unroll 1
          for (int u = 0; u < 2; ++u) { const long tokb = (long)b * SEQ + (2 * blk2 + u) * 128; bf16x8 q0, q1;
              load_q(A.PROJ + (tokb + 16 * w + fr) * LDP + 1984 + 64 * h, A.gmq, fq, q0, q1);
              attn_wave<16, false>(L, q0, q1, 0, 16 * w, 0, 0.f, false, A.MIX + (tokb + 16 * w) * DM + 768 + 64 * h, fr, fq); } }
        AT_BAR();
    }
}
}
constexpr int NWAVES = 8;
namespace mk {
#ifndef PROF_PH
#define PROF_PH -1
#endif
#ifndef PROF_N
#define PROF_N 1
#endif
#ifndef PROF_TA
#define PROF_TA -1
#endif
#ifndef PROF_TB
#define PROF_TB -1
#endif
#define REPEAT(k) for (int rep_ = 0; rep_ < ((PROF_PH) == (k) ? (PROF_N) : 1); ++rep_)
#ifndef FAST_RWKV
#define FAST_RWKV 1
#endif
#ifndef FAST_ATTN
#define FAST_ATTN 1
#endif

struct Args { const float* in[N_IN]; float* out; unsigned char* ws; int ph_lo, ph_hi; };

__device__ __forceinline__ unsigned pk2(float lo, float hi) { typedef float f2_t __attribute__((ext_vector_type(2))); typedef __bf16 b2_t __attribute__((ext_vector_type(2))); f2_t v = {lo, hi}; return __builtin_bit_cast(unsigned, __builtin_convertvector(v, b2_t)); }
__device__ __forceinline__ float wave_sum(float v) {
#pragma unroll
    for (int o = 1; o < 64; o <<= 1) v += __shfl_xor(v, o);
    return v;
}
template <int MODE> __device__ __forceinline__ void transpose_item(const float* W, const float* g, int K, int N, bf16_t* WT, LAS float* scr, int item, int lane) {
    const int nblk = N / 32, kb = item / nblk, nb = item % nblk, k0 = 64 * kb, n0 = 32 * nb;
    float tv[32];
#pragma unroll
    for (int i = 0; i < 32; ++i) tv[i] = W[(size_t)(k0 + 2 * i + (lane >> 5)) * N + n0 + (lane & 31)];
#pragma unroll
    for (int i = 0; i < 32; ++i) { const int kk = 2 * i + (lane >> 5); float v = tv[i]; if (g) v *= g[k0 + kk]; scr[kk * 33 + (lane & 31)] = v; }
    LDS_WAIT(); asm volatile("" ::: "memory");
    const int c = lane & 7;
#pragma unroll
    for (int j = 0; j < 4; ++j) { const int n = (lane >> 3) + 8 * j; const LAS float* s = scr + (8 * c) * 33 + n;
        v4u o; o.x = pk2(s[0 * 33], s[1 * 33]); o.y = pk2(s[2 * 33], s[3 * 33]); o.z = pk2(s[4 * 33], s[5 * 33]); o.w = pk2(s[6 * 33], s[7 * 33]);
        int nr = n0 + n; if (MODE == 2) nr = nr < 1920 ? nr : nr + 64;
        if (MODE == 1) nr = nr < 2816 ? 256 * (nr >> 7) + (nr & 127) : 256 * ((nr - 2816) >> 7) + 128 + ((nr - 2816) & 127);
        *(GAS v4u*)(WT + (size_t)nr * K + k0 + 8 * c) = o; }
    LDS_WAIT(); asm volatile("" ::: "memory");
}
template <int R> __device__ __forceinline__ void rows_to_bf16(const float* x, bf16_t* o, float* ssq, long row0, long rstride, int lane) {
    f32x4 v[R][4]; float s[R];
#pragma unroll
    for (int r = 0; r < R; ++r) { const GAS f32x4* xr = (const GAS f32x4*)(x + (row0 + r * rstride) * DM) + lane;
#pragma unroll
        for (int j = 0; j < 4; ++j) v[r][j] = xr[64 * j]; }
#pragma unroll
    for (int r = 0; r < R; ++r) { s[r] = 0.f;
#pragma unroll
        for (int j = 0; j < 4; ++j) s[r] += (v[r][j].x * v[r][j].x + v[r][j].y * v[r][j].y) + (v[r][j].z * v[r][j].z + v[r][j].w * v[r][j].w); }
#pragma unroll
    for (int o2 = 1; o2 < 64; o2 <<= 1) {
#pragma unroll
        for (int r = 0; r < R; ++r) s[r] += __shfl_xor(s[r], o2); }
#pragma unroll
    for (int r = 0; r < R; ++r) { GAS unsigned long long* o8 = (GAS unsigned long long*)(o + (row0 + r * rstride) * DM) + lane;
#pragma unroll
        for (int j = 0; j < 4; ++j) o8[64 * j] = (unsigned long long)pk2(v[r][j].x, v[r][j].y) | ((unsigned long long)pk2(v[r][j].z, v[r][j].w) << 32);
        if (lane == 0) ssq[row0 + r * rstride] = s[r]; }
}
__device__ __forceinline__ void row_to_bf16(const float* xrow, bf16_t* orow, float* ssq_out, int lane) {
    const GAS f32x4* xr = (const GAS f32x4*)xrow + lane; f32x4 v[4]; float s = 0.f;
#pragma unroll
    for (int j = 0; j < 4; ++j) { v[j] = xr[64 * j]; s += (v[j].x * v[j].x + v[j].y * v[j].y) + (v[j].z * v[j].z + v[j].w * v[j].w); }
    s = wave_sum(s);
    GAS unsigned long long* o8 = (GAS unsigned long long*)orow + lane;
#pragma unroll
    for (int j = 0; j < 4; ++j) o8[64 * j] = (unsigned long long)pk2(v[j].x, v[j].y) | ((unsigned long long)pk2(v[j].z, v[j].w) << 32);
    if (lane == 0) *ssq_out = s;
}

__global__ void __launch_bounds__(NWAVES * 64, 2) mk_fwd(Args args) {
    extern __shared__ __attribute__((aligned(16))) unsigned char lds[];
    LAS unsigned char* L = (LAS unsigned char*)lds;
    volatile LAS unsigned* MISC = (volatile LAS unsigned*)(L + MISC_OFF);
    const int tid0 = threadIdx.x; const int wave0 = __builtin_amdgcn_readfirstlane(tid0 >> 6);
    const int G = gridDim.x;
    unsigned char* ws = args.ws;
    gu32* ctl = (gu32*)(ws + WS_CTL);
    for (int u = tid0; u < (LDS_BYTES - LDSCTL_OFF) / 4; u += NWAVES * 64) ((LAS unsigned*)(L + LDSCTL_OFF))[u] = 0u;
    __syncthreads();
    XcdBarrier bar = xcd_barrier_post((unsigned*)(ctl + CW_BAR), MISC + 8);
    const int lo = args.ph_lo, hi = args.ph_hi;
    int ph = 0;
#define PH_BEGIN if (lo <= ph && ph < hi) { if ((PROF_TA) >= 0 && blockIdx.x == 0 && tid0 == 0) MISC[24 + ph] = (unsigned)__builtin_amdgcn_s_memrealtime(); unsigned char* wsp = args.ws; asm volatile("" : "+s"(wsp)); int tid = wave0 * 64 + (int)__builtin_amdgcn_mbcnt_hi(~0u, __builtin_amdgcn_mbcnt_lo(~0u, 0u)); asm volatile("" : "+v"(tid)); const int lane = tid & 63, wave = __builtin_amdgcn_readfirstlane(tid >> 6); const long gtid = (long)blockIdx.x * (NWAVES * 64) + tid; const int gw = blockIdx.x * NWAVES + wave; LAS float* scr = (LAS float*)(L + wave * 16384); (void)lane; (void)gtid; (void)gw; (void)scr;
#define PH_END   if (ph + 1 < hi) { xcd_barrier(bar); if ((PROF_PH) == 30 && ph == 3) for (int xb_ = 0; xb_ < 10; ++xb_) xcd_barrier(bar); } } ++ph;
    float* out = args.out;
#define SSQ_A ((float*)(wsp + WS_CTL + CTL_SSQ))
#define SSQ_B (SSQ_A + 3 * MTOK)
#define biastab ((float*)(wsp + WS_SMALL + SM_BIAS))
#define ssqm ((float*)(wsp + WS_SMALL + SM_SSQM))
#define MKV ((bf16_t*)(wsp + WS_SMALL + SM_MKV))
#define MEMB ((bf16_t*)(wsp + WS_MEMB))
#define Wt_in ((bf16_t*)(wsp + (l == 0 ? WS_WT + WT_IN : WS_WIN1)))
#define Wt_out ((bf16_t*)(wsp + WS_WT + WT_OUT))
#define Wt_up ((bf16_t*)(wsp + WS_WT + WT_UP))
#define Wt_down ((bf16_t*)(wsp + WS_WT + WT_DOWN))
#define Wt_mkv ((bf16_t*)(wsp + (l == 0 ? WS_WT + WT_MKV : WS_WIN1 + 4718592)))
#define XB ((bf16_t*)(wsp + WS_XB))
#define VF ((bf16_t*)(wsp + WS_VF))
#define PROJ ((bf16_t*)(wsp + WS_PROJ))
#define MIX ((bf16_t*)(wsp + WS_MIX))
#define U ((bf16_t*)(wsp + WS_U))
#define ACT ((bf16_t*)(wsp + WS_ACT))
#define PA ((size_t)MTOK * 384)
#define pR ((bf16_t*)(wsp + WS_PREP))
#define pK (pR + PA)
#define pV (pR + 2 * PA)
#define pKK (pR + 3 * PA)
#define pB (pR + 4 * PA)
#define pLD (pR + 5 * PA)
    const long gsize = (long)G * (NWAVES * 64);
    const int NGW = G * NWAVES;

#define MK_W() sk::RwkvW W{args.in[I_MU] + l * 1280, args.in[I_MUV], args.in[I_W0] + l * 384, args.in[I_W2] + l * 32 * 384, args.in[I_A0] + l * 384, args.in[I_A2] + l * 32 * 384, args.in[I_V0], args.in[I_V2], args.in[I_G2] + l * 64 * 384, args.in[I_KK] + l * 384, args.in[I_KA] + l * 384, args.in[I_RK] + l * 384, args.in[I_LNW] + l * 384, args.in[I_LNB] + l * 384};
#define MK_CBUF() const rw::ChunkBufs cbuf{(bf16_t*)(wsp + WS_PT), (bf16_t*)(wsp + WS_G), (float*)(wsp + WS_Z), (bf16_t*)(wsp + WS_YV), (bf16_t*)(wsp + WS_S0), (bf16_t*)(wsp + WS_VF), (float*)(wsp + WS_DOT), (const bf16_t*)(wsp + WS_SMALL + SM_W2T + l * SM_LORA_L), (const bf16_t*)(wsp + WS_SMALL + SM_A2T + l * SM_LORA_L), (const bf16_t*)(wsp + WS_SMALL + SM_V2T + l * SM_LORA_L), (const bf16_t*)(wsp + WS_SMALL + SM_G2T + l * SM_LORA_L)};
    for (int l = 0; l < 2; ++l) {
        const float* xin = l == 0 ? args.in[I_X] : out;
        if (l == 0) {
        PH_BEGIN
            REPEAT(0) {
            const int I_IN = 16 * 68, I_KV = 16 * 16, NIT = 2 * (I_IN + I_KV);
            for (int it = gw; it < NIT; it += NGW) {
                int r = it; const int ll = r >= I_IN + I_KV ? 1 : 0; r -= ll * (I_IN + I_KV);
                bf16_t* win = (bf16_t*)(wsp + (ll == 0 ? WS_WT + WT_IN : WS_WIN1)); bf16_t* wkv = (bf16_t*)(wsp + (ll == 0 ? WS_WT + WT_MKV : WS_WIN1 + 4718592));
                if (r < I_IN) transpose_item<2>(args.in[I_WIN] + (size_t)ll * 1024 * 2176, args.in[I_MIXG] + ll * 1024, 1024, 2176, win, scr, r, lane);
                else transpose_item<0>(args.in[I_WMKV] + (size_t)ll * 1024 * 512, args.in[I_MEMG] + ll * 1024, 1024, 512, wkv, scr, r - I_IN, lane);
            }
            for (long i = gtid; i < 2 * 128 * 1024; i += gsize) { const int ll = (int)(i >> 17), n = (int)(i >> 10) & 127, k = (int)(i & 1023); float v = 0.f;
                if (ll > 0 && n < 16) v = args.in[I_WINV][k * 16 + n] * args.in[I_MIXG][1024 + k];
                ((bf16_t*)(wsp + (ll == 0 ? WS_WT + WT_IN : WS_WIN1)))[(size_t)(n < 64 ? 1920 + n : 2176 + n) * 1024 + k] = f2bf(v); }
            for (long i = gtid; i < 2 * RP_SIZE; i += gsize) { const int ll = (int)(i / RP_SIZE), r = (int)(i % RP_SIZE); float v;
                if (r < RP_MUV) v = args.in[I_MU][ll * 1280 + r]; else if (r < RP_W0) v = args.in[I_MUV][r - RP_MUV]; else if (r < RP_A0) v = args.in[I_W0][ll * 384 + r - RP_W0];
                else if (r < RP_V0) v = args.in[I_A0][ll * 384 + r - RP_A0]; else if (r < RP_KK) v = args.in[I_V0][r - RP_V0]; else if (r < RP_KA) v = args.in[I_KK][ll * 384 + r - RP_KK];
                else if (r < RP_RK) v = args.in[I_KA][ll * 384 + r - RP_KA]; else if (r < RP_LNW) v = args.in[I_RK][ll * 384 + r - RP_RK]; else if (r < RP_LNB) v = args.in[I_LNW][ll * 384 + r - RP_LNW];
                else v = args.in[I_LNB][ll * 384 + r - RP_LNB];
                ((float*)(wsp + WS_SMALL + SM_RWP + ll * RWP_BYTES))[r] = v; }
            for (long i = gtid; i < 2 * 384 * 160; i += gsize) { const int ll = (int)(i / (384 * 160)), r2 = (int)(i % (384 * 160)), hc = r2 / 160, j = r2 % 160; bf16_t* sm = (bf16_t*)(wsp + WS_SMALL + ll * SM_LORA_L);
                if (j < 32) sm[SM_W2T / 2 + hc * 32 + j] = f2bf(args.in[I_W2][(size_t)ll * 32 * 384 + j * 384 + hc]);
                else if (j < 64) sm[SM_A2T / 2 + hc * 32 + (j - 32)] = f2bf(args.in[I_A2][(size_t)ll * 32 * 384 + (j - 32) * 384 + hc]);
                else if (j < 96) sm[SM_V2T / 2 + hc * 32 + (j - 64)] = f2bf((j - 64) < 16 ? args.in[I_V2][(j - 64) * 384 + hc] : 0.f);
                else sm[SM_G2T / 2 + hc * 64 + (j - 96)] = f2bf(args.in[I_G2][(size_t)ll * 64 * 384 + (j - 96) * 384 + hc]); }
            if (MTOK % (4 * NGW) == 0) { for (long m = gw; m < MTOK; m += 4L * NGW) rows_to_bf16<4>(args.in[I_X], XB, SSQ_A, m, NGW, lane); }
            else { for (int m = gw; m < MTOK; m += NGW) row_to_bf16(args.in[I_X] + (size_t)m * DM, XB + (size_t)m * DM, SSQ_A + m, lane); }
            for (int m = gw; m < 512; m += NGW) row_to_bf16(args.in[I_MEM] + (size_t)m * DM, MEMB + (size_t)m * DM, ssqm + m, lane);
            sk::d_biastab(args.in[I_RELB], biastab, gtid, gsize);
            }
        PH_END
        }
        PH_BEGIN
            REPEAT(1)
            { pg8::Gemm g{XB, Wt_in, MTOK, 2048, 1024}; pg8::StaticOrder S; S.init(MTOK, 2048, G, (int)blockIdx.x);
              pg8::EpiScaleBf16 E{PROJ, LDP, SSQ_A + (size_t)l * MTOK};
              pg8::gemm_phase<pg8::EpiScaleBf16, pg8::StaticOrder, true, true>(L, g, S, E, tid); }
        PH_END
        PH_BEGIN
            MK_W(); MK_CBUF(); (void)cbuf;
#if !FAST_ATTN
            sk::d_qknorm(PROJ, MTOK, LDP, args.in[I_AQN] + l * 64, args.in[I_AKN] + l * 64, args.in[I_MQN] + l * 64, 0, gtid, gsize);
            sk::d_qknorm(MKV, 512, 512, nullptr, nullptr, args.in[I_MKN] + l * 64, 1, gtid, gsize);
#endif
#if FAST_RWKV
            {
              const bool t8 = blockIdx.x < 64;
              const pg8::Gemm g = t8 ? pg8::Gemm{XB, Wt_in + (size_t)2048 * 1024, MTOK, 256, 1024} : pg8::Gemm{MEMB, Wt_mkv, 512, 512, 1024};
              pg8::StaticOrder S; if (t8) S.init(MTOK, 256, G, (int)blockIdx.x); else S.init(512, 512, G, (int)((blockIdx.x + 192) % G));
              const pg8::EpiScaleBf16 E = t8 ? pg8::EpiScaleBf16{PROJ + 2048, LDP, SSQ_A + (size_t)l * MTOK} : pg8::EpiScaleBf16{MKV, 512, ssqm};
              pg8::gemm_phase<pg8::EpiScaleBf16, pg8::StaticOrder, true, true>(L, g, S, E, tid); }
            { unsigned* qc = (unsigned*)(ctl + CW_CHQ + 64 * l);
              int q = rw::chunk_phase(L, wsp, l, tid, qc, MISC + 21);
              const int I_OUT = 16 * 32, I_UP = 16 * 176, I_DN = 44 * 32, NIT = I_OUT + I_UP + I_DN;
              for (;;) { const int it = (q - rw::NITEMS) * NWAVES + wave;
                  if ((q - rw::NITEMS) * NWAVES >= NIT) break;
                  if (it < NIT) { int r = it;
                      if (r < I_OUT) transpose_item<0>(args.in[I_WOUT] + (size_t)l * 1024 * 1024, nullptr, 1024, 1024, Wt_out, scr, r, lane);
                      else if (r < I_OUT + I_UP) transpose_item<1>(args.in[I_WUP] + (size_t)l * 1024 * 5632, args.in[I_FFNG] + l * 1024, 1024, 5632, Wt_up, scr, r - I_OUT, lane);
                      else transpose_item<0>(args.in[I_WDOWN] + (size_t)l * 2816 * 1024, nullptr, 2816, 1024, Wt_down, scr, r - I_OUT - I_UP, lane); }
                  __syncthreads(); if (tid == 0) MISC[21] = atomicAdd(qc, 1u); __syncthreads(); q = (int)MISC[21]; __syncthreads(); } }
#else
            sk::d_rwkv_prep(PROJ, W, l, VF, pR, pK, pV, pKK, pB, pLD, gtid, gsize);
#endif
        PH_END
        PH_BEGIN
            MK_CBUF(); (void)cbuf;
            if (blockIdx.x < 48) {
#if FAST_RWKV
                REPEAT(3) { __syncthreads(); if (tid < 8) MISC[16 + tid] = 0u; __syncthreads();
                  const int sbh = (int)blockIdx.x >> 2, stj = (int)blockIdx.x & 3;
                  if (wave == 0) rw::scan_compute(L, cbuf, sbh, stj, lane, MISC + 16); else if (wave < 4) rw::scan_loader(L, cbuf, sbh, stj, wave - 1, lane, MISC + 16);
 }
#endif
            } else {
#if FAST_ATTN
                const at::AttnArgs A{PROJ, MKV, MIX, biastab, args.in[I_SINK] + l * 6, args.in[I_AQN] + l * 64, args.in[I_AKN] + l * 64, args.in[I_MQN] + l * 64, args.in[I_MKN] + l * 64};
                REPEAT(7) for (;;) {
                    if (tid == 0) MISC[20] = atomicAdd((unsigned*)(ctl + CW_ATTQ + 64 * l), 1u);
                    __syncthreads(); const int it = (int)MISC[20]; __syncthreads();
                    if (it >= 512) break;
                    at::attn_item(L, A, it < 256 ? 256 + it : it - 256, tid); }
#else
                const long gt2 = (long)(blockIdx.x - BATCH * 6) * (NWAVES * 64) + tid, gs2 = (long)(G - BATCH * 6) * (NWAVES * 64);
                REPEAT(7) sk::d_swa(PROJ, MIX, biastab, args.in[I_SINK] + l * 6, gt2, gs2);
                REPEAT(8) sk::d_memattn(PROJ, MKV, MIX, gt2, gs2);
#endif
            }
        PH_END
        PH_BEGIN
            MK_W(); MK_CBUF(); (void)cbuf;
#if FAST_RWKV
            REPEAT(4) rw::out_phase(L, wsp, l, tid, (int)blockIdx.x, G);
#else
            sk::d_rwkv_fin(PROJ, W, pR, pK, pV, MIX, gtid, gsize);
#endif
        PH_END
        PH_BEGIN
            if ((PROF_PH) == 31) { pg8::Gemm g2{MIX, Wt_out, MTOK, 1024, 1024}; pg8::StaticOrder S2; S2.init(MTOK, 1024, G, (int)blockIdx.x); pg8::EpiScaleBf16 E2{PROJ, 1024, SSQ_A}; pg8::gemm_phase<pg8::EpiScaleBf16, pg8::StaticOrder, true, true>(L, g2, S2, E2, tid); }
            pg8::Gemm g{MIX, Wt_out, MTOK, 1024, 1024}; pg8::StaticOrder S; S.init(MTOK, 1024, G, (int)blockIdx.x);
            pg8::EpiResid E{xin, out, XB, SSQ_B + (size_t)l * MTOK, 1024};
            pg8::gemm_phase<pg8::EpiResid, pg8::StaticOrder, true, true>(L, g, S, E, tid);
        PH_END
        PH_BEGIN
            REPEAT(5) {
            pg8::Gemm g{XB, Wt_up, 66 * 256, 5632, 1024}; pg8::StaticOrder S; S.init(66 * 256, 5632, G, (int)blockIdx.x);
            pg8::EpiConvAct E{ACT, SSQ_B + (size_t)l * MTOK, args.in[I_CW] + (size_t)l * 3 * 5632, args.in[I_CB] + (size_t)l * 5632};
            pg8::gemm_phase<pg8::EpiConvAct, pg8::StaticOrder, true, true>(L, g, S, E, tid); }
        PH_END
        PH_BEGIN
            if ((PROF_PH) == 32) { pg8::Gemm g2{ACT, Wt_down, MTOK, 1024, 2816}; pg8::StaticOrder S2; S2.init(MTOK, 1024, G, (int)blockIdx.x); pg8::EpiScaleBf16 E2{PROJ, 1024, SSQ_A}; pg8::gemm_phase<pg8::EpiScaleBf16, pg8::StaticOrder, true, true>(L, g2, S2, E2, tid); }
            pg8::Gemm g{ACT, Wt_down, MTOK, 1024, 2816}; pg8::StaticOrder S; S.init(MTOK, 1024, G, (int)blockIdx.x);
            pg8::EpiResid E{out, out, XB, SSQ_A + (size_t)(l + 1) * MTOK, 1024};
            pg8::gemm_phase<pg8::EpiResid, pg8::StaticOrder, true, true>(L, g, S, E, tid);
        PH_END
    }
    if ((PROF_TA) >= 0 && blockIdx.x == 0 && tid0 == 0) {
        MISC[24 + ph] = (unsigned)__builtin_amdgcn_s_memrealtime();
        const unsigned ta = MISC[24 + (PROF_TA) + 1] - MISC[24 + (PROF_TA)], tb = (PROF_TB) >= 0 ? MISC[24 + (PROF_TB) + 1] - MISC[24 + (PROF_TB)] : 0u;
        const unsigned long long extra = (unsigned long long)ta + 1000ull * (unsigned long long)(((tb + 50u) / 100u) * 100u);
        const unsigned long long t0 = __builtin_amdgcn_s_memrealtime(); while (__builtin_amdgcn_s_memrealtime() - t0 < extra) __builtin_amdgcn_s_sleep(32);
    }
#undef PH_BEGIN
#undef PH_END
}
constexpr int N_PHASES = 1 + 2 * 7;
}

#ifndef MK_PER_PHASE
#define MK_PER_PHASE 0
#endif
extern "C" void kernel_launch(void* const* d_in, const int* in_sizes, int n_in, void* d_out, int out_size, void* d_ws, size_t ws_size, hipStream_t stream) {
    static int grid = 0;
    if (grid == 0) {
        if (n_in != N_IN || out_size != MTOK * DM || ws_size < mk::WS_END) { fprintf(stderr, "kernel_launch: unexpected shapes (n_in %d out %d ws %zu)\n", n_in, out_size, ws_size); grid = -1; return; }
        int dev = 0, cus = 0, per_cu = 0;
        if (hipGetDevice(&dev) != hipSuccess || hipDeviceGetAttribute(&cus, hipDeviceAttributeMultiprocessorCount, dev) != hipSuccess) { grid = -1; return; }
        if (hipFuncSetAttribute((const void*)mk::mk_fwd, hipFuncAttributeMaxDynamicSharedMemorySize, mk::LDS_BYTES) != hipSuccess) { fprintf(stderr, "kernel_launch: hipFuncSetAttribute failed\n"); grid = -1; return; }
        if (hipOccupancyMaxActiveBlocksPerMultiprocessor(&per_cu, (const void*)mk::mk_fwd, NWAVES * 64, mk::LDS_BYTES) != hipSuccess || per_cu < 1) { fprintf(stderr, "kernel_launch: occupancy query says %d blocks per CU\n", per_cu); }
        (void)hipGetLastError();
        grid = cus;
    }
    if (grid < 0) return;
    if (hipMemsetAsync((char*)d_ws + mk::WS_CTL, 0, mk::CTL_ZERO_BYTES, stream) != hipSuccess) return;
    mk::Args a{};
    for (int i = 0; i < N_IN; ++i) a.in[i] = (const float*)d_in[i];
    a.out = (float*)d_out; a.ws = (unsigned char*)d_ws;
#if MK_PER_PHASE
    for (int p = 0; p < mk::N_PHASES; ++p) { a.ph_lo = p; a.ph_hi = p + 1; hipLaunchKernelGGL(mk::mk_fwd, dim3(grid), dim3(NWAVES * 64), mk::LDS_BYTES, stream, a); }
#else
    a.ph_lo = 0; a.ph_hi = mk::N_PHASES;
    hipLaunchKernelGGL(mk::mk_fwd, dim3(grid), dim3(NWAVES * 64), mk::LDS_BYTES, stream, a);
#endif
}
```

```cpp
#define MK_BUILD 1
#ifndef HOST_SIM
#include <hip/hip_runtime.h>
#include <cstdio>
#include <cstdint>
#endif
#ifndef SEQ_LEN
#define SEQ_LEN 8192
#endif
typedef unsigned short bf16_t;
constexpr int BATCH = 2, SEQ = SEQ_LEN, DM = 1024, MTOK = BATCH * SEQ, DFF = 2816, LDP = 2304  ;
constexpr float EPS = 1e-6f, GN_EPS = 64e-5f;
__host__ __device__ __forceinline__ float bf2f(bf16_t h) { unsigned u = (unsigned)h << 16; return __builtin_bit_cast(float, u); }
__host__ __device__ __forceinline__ bf16_t f2bf(float f) { unsigned u = __builtin_bit_cast(unsigned, f); return (bf16_t)((u + 0x7fffu + ((u >> 16) & 1u)) >> 16); }
__host__ __device__ __forceinline__ int t5_bucket(int dist) {
    if (dist < 16) return dist;
    const float v = logf((float)dist / 16.0f) / 2.0794415416798357f * 16.0f;
    int large = 16 + (int)v; return large < 31 ? large : 31;
}
constexpr size_t MiB = 1u << 20;
enum { I_X = 0, I_MEM, I_RELB, I_MIXG, I_WIN, I_WINV, I_AQN, I_AKN, I_SINK, I_MU, I_MUV, I_W0, I_W2, I_A0, I_A2, I_V0, I_V2, I_G2, I_KK, I_KA, I_RK, I_LNW, I_LNB, I_MEMG, I_WMKV, I_MQN, I_MKN, I_WOUT, I_FFNG, I_WUP, I_CW, I_CB, I_WDOWN, N_IN };
#ifndef PROF_PH
#define PROF_PH -1
#endif
#ifndef PROF_N
#define PROF_N 1
#endif
namespace sk {

__device__ __forceinline__ void d_wt(const float* W, const float* g, bf16_t* Wt, int K, int N, int Npad, long gtid, long gsize) {
    const long total = (long)Npad * K;
    for (long idx = gtid; idx < total; idx += gsize) {
        const int n = (int)(idx / K), k = (int)(idx % K);
        float v = 0.f;
        if (n < N) { v = W[(long)k * N + n]; if (g) v *= g[k]; }
        Wt[idx] = f2bf(v);
    }
}
#ifndef MK_BUILD
__global__ void k_wt(const float* W, const float* g, bf16_t* Wt, int K, int N, int Npad) { d_wt(W, g, Wt, K, N, Npad, (long)blockIdx.x * blockDim.x + threadIdx.x, (long)gridDim.x * blockDim.x); }
#endif
__device__ __forceinline__ void d_rowprep(const float* x, bf16_t* xb, float* ssq, int rows, long gtid, long gsize) {
    for (long r = gtid; r < rows; r += gsize) {
        const float* xr = x + (long)r * DM; bf16_t* o = xb + (long)r * DM; float s = 0.f;
        for (int c = 0; c < DM; ++c) { const float v = xr[c]; s += v * v; o[c] = f2bf(v); }
        ssq[r] = s;
    }
}
#ifndef MK_BUILD
__global__ void k_rowprep(const float* x, bf16_t* xb, float* ssq, int rows) { d_rowprep(x, xb, ssq, rows, (long)blockIdx.x * blockDim.x + threadIdx.x, (long)gridDim.x * blockDim.x); }
#endif
__device__ __forceinline__ void d_biastab(const float* rel_bias, float* tab, long gtid, long gsize) {
        for (long i = gtid; i < 128 * 6; i += gsize) { const int dist = i / 6, hq = i % 6; tab[i] = rel_bias[t5_bucket(dist) * 6 + hq]; }
}
#ifndef MK_BUILD
__global__ void k_biastab(const float* rel_bias, float* tab) { d_biastab(rel_bias, tab, (long)blockIdx.x * blockDim.x + threadIdx.x, (long)gridDim.x * blockDim.x); }
#endif
__device__ __forceinline__ void d_qknorm(bf16_t* P, int rows, int ld, const float* gq, const float* gk, const float* gm, int mode, long gtid, long gsize) {
    const int nj = mode == 0 ? 12 : 4;
    const long total = (long)rows * nj;
    for (long idx = gtid; idx < total; idx += gsize) {
        const int row = (int)(idx / nj), j = (int)(idx % nj);
        int col; const float* g;
        if (mode == 0) { if (j < 6) { col = 64 * j; g = gq; } else if (j < 8) { col = 384 + 64 * (j - 6); g = gk; } else { col = 1920 + 64 * (j - 8); g = gm; } }
        else { col = 64 * j; g = gm; }
        bf16_t* p = P + (long)row * ld + col; float s = 0.f;
        for (int d = 0; d < 64; ++d) { const float v = bf2f(p[d]); s += v * v; }
        const float rs = 1.0f / sqrtf(s * (1.0f / 64.0f) + EPS);
        for (int d = 0; d < 64; ++d) p[d] = f2bf(bf2f(p[d]) * rs * g[d]);
    }
}
#ifndef MK_BUILD
__global__ void k_qknorm(bf16_t* P, int rows, int ld, const float* gq, const float* gk, const float* gm, int mode) { d_qknorm(P, rows, ld, gq, gk, gm, mode, (long)blockIdx.x * blockDim.x + threadIdx.x, (long)gridDim.x * blockDim.x); }
#endif
__device__ __forceinline__ void d_swa(const bf16_t* P, bf16_t* MIX, const float* biastab, const float* sinks, long gtid, long gsize) {
    const long total = (long)MTOK * 6;
    for (long idx = gtid; idx < total; idx += gsize) {
        const int tok = (int)(idx / 6), hq = (int)(idx % 6), hkv = hq / 3, t = tok % SEQ;
        float q[64], o[64];
#pragma unroll
        for (int d = 0; d < 64; ++d) { q[d] = bf2f(P[(long)tok * LDP + 64 * hq + d]) * 0.125f; o[d] = 0.f; }
        float m = sinks[hq], l = 1.0f;
        const int j0 = t - 127 < 0 ? 0 : t - 127;
        for (int j = j0; j <= t; ++j) {
            const bf16_t* kr = P + (long)(tok - (t - j)) * LDP + 384 + 64 * hkv; const bf16_t* vr = kr + 128;
            float s = 0.f;
#pragma unroll
            for (int d = 0; d < 64; ++d) s += q[d] * bf2f(kr[d]);
            s += biastab[(t - j) * 6 + hq];
            const float mn = fmaxf(m, s), f = expf(m - mn), e = expf(s - mn);
            l = l * f + e; m = mn;
#pragma unroll
            for (int d = 0; d < 64; ++d) o[d] = o[d] * f + e * bf2f(vr[d]);
        }
        const float inv = 1.0f / l;
#pragma unroll
        for (int d = 0; d < 64; ++d) MIX[(long)tok * DM + 64 * hq + d] = f2bf(o[d] * inv);
    }
}
#ifndef MK_BUILD
__global__ __launch_bounds__(256) void k_swa(const bf16_t* P, bf16_t* MIX, const float* biastab, const float* sinks) { d_swa(P, MIX, biastab, sinks, (long)blockIdx.x * blockDim.x + threadIdx.x, (long)gridDim.x * blockDim.x); }
#endif
__device__ __forceinline__ void d_memattn(const bf16_t* P, const bf16_t* MKV, bf16_t* MIX, long gtid, long gsize) {
    const long total = (long)MTOK * 4;
    for (long idx = gtid; idx < total; idx += gsize) {
        const int tok = (int)(idx / 4), h = (int)(idx % 4), b = tok / SEQ;
        float q[64], o[64];
#pragma unroll
        for (int d = 0; d < 64; ++d) { q[d] = bf2f(P[(long)tok * LDP + 1920 + 64 * h + d]) * 0.125f; o[d] = 0.f; }
        float m = -1e30f, l = 0.f;
        for (int j = 0; j < 256; ++j) {
            const bf16_t* kr = MKV + (long)(b * 256 + j) * 512 + 64 * h; const bf16_t* vr = kr + 256;
            float s = 0.f;
#pragma unroll
            for (int d = 0; d < 64; ++d) s += q[d] * bf2f(kr[d]);
            const float mn = fmaxf(m, s), f = expf(m - mn), e = expf(s - mn);
            l = l * f + e; m = mn;
#pragma unroll
            for (int d = 0; d < 64; ++d) o[d] = o[d] * f + e * bf2f(vr[d]);
        }
        const float inv = 1.0f / l;
#pragma unroll
        for (int d = 0; d < 64; ++d) MIX[(long)tok * DM + 768 + 64 * h + d] = f2bf(o[d] * inv);
    }
}
#ifndef MK_BUILD
__global__ __launch_bounds__(256) void k_memattn(const bf16_t* P, const bf16_t* MKV, bf16_t* MIX) { d_memattn(P, MKV, MIX, (long)blockIdx.x * blockDim.x + threadIdx.x, (long)gridDim.x * blockDim.x); }
#endif
__device__ __forceinline__ float shifted(const bf16_t* P, int tok, int col, float mu) {
    const float p = bf2f(P[(long)tok * LDP + col]);
    const float prev = (tok % SEQ) == 0 ? 0.f : bf2f(P[(long)(tok - 1) * LDP + col]);
    return p + mu * (prev - p);
}
struct RwkvW { const float *mu, *mu_v, *w0, *w2, *a0, *a2, *v0, *v2, *g2, *k_k, *k_a, *r_k, *ln_w, *ln_b; };
__device__ __forceinline__ void d_rwkv_prep(const bf16_t* P, RwkvW W, int layer, bf16_t* VFIRST, bf16_t* R, bf16_t* K, bf16_t* V, bf16_t* KK, bf16_t* B, bf16_t* LOGD, long gtid, long gsize) {
    const long total = (long)MTOK * 6;
    for (long idx = gtid; idx < total; idx += gsize) {
        const int tok = (int)(idx / 6), h = (int)(idx % 6);
        float nrm = 0.f;
        for (int c = 0; c < 64; ++c) { const int hc = 64 * h + c; const float kc = shifted(P, tok, 640 + 384 + hc, W.mu[384 + hc]) * W.k_k[hc]; nrm += kc * kc; }
        const float rn = 1.0f / fmaxf(sqrtf(nrm), 1e-12f);
        for (int c = 0; c < 64; ++c) {
            const int hc = 64 * h + c; const long o = (long)tok * 384 + hc;
            const float r = shifted(P, tok, 640 + hc, W.mu[hc]);
            const float k = shifted(P, tok, 640 + 384 + hc, W.mu[384 + hc]);
            float v = shifted(P, tok, 640 + 768 + hc, W.mu[768 + hc]);
            float wp = W.w0[hc], ap = W.a0[hc];
            for (int j = 0; j < 32; ++j) {
                wp += tanhf(shifted(P, tok, 640 + 1152 + j, W.mu[1152 + j])) * W.w2[j * 384 + hc];
                ap += shifted(P, tok, 640 + 1184 + j, W.mu[1184 + j]) * W.a2[j * 384 + hc];
            }
            const float z = -wp; const float sp = fmaxf(z, 0.f) + log1pf(expf(-fabsf(z)));
            const float w = -sp - 0.5f;
            const float a = 1.0f / (1.0f + expf(-ap));
            if (layer > 0) {
                float vp = W.v0[hc];
                for (int j = 0; j < 16; ++j) vp += shifted(P, tok, 2176 + j, W.mu_v[j]) * W.v2[j * 384 + hc];
                const float vf = bf2f(VFIRST[o]);
                v = v + (vf - v) * (1.0f / (1.0f + expf(-vp)));
            } else VFIRST[o] = f2bf(v);
            const float kk = k * W.k_k[hc] * rn;
            R[o] = f2bf(r); K[o] = f2bf(k * (1.0f + (a - 1.0f) * W.k_a[hc])); V[o] = f2bf(v);
            KK[o] = f2bf(kk); B[o] = f2bf(kk * a); LOGD[o] = f2bf(-expf(w));
        }
    }
}
#ifndef MK_BUILD
__global__ void k_rwkv_prep(const bf16_t* P, RwkvW W, int layer, bf16_t* VFIRST, bf16_t* R, bf16_t* K, bf16_t* V, bf16_t* KK, bf16_t* B, bf16_t* LOGD) { d_rwkv_prep(P, W, layer, VFIRST, R, K, V, KK, B, LOGD, (long)blockIdx.x * blockDim.x + threadIdx.x, (long)gridDim.x * blockDim.x); }
#endif
__device__ __forceinline__ void d_rwkv_scan(const bf16_t* R, const bf16_t* K, const bf16_t* V, const bf16_t* KK, const bf16_t* B, const bf16_t* LOGD, bf16_t* MIX, int bh, int i) {
    const int b = bh / 6, h = bh % 6;
    float s[64];
#pragma unroll
    for (int k = 0; k < 64; ++k) s[k] = 0.f;
    for (int t = 0; t < SEQ; ++t) {
        const long o = (long)(b * SEQ + t) * 384 + 64 * h;
        float sa = 0.f;
#pragma unroll
        for (int k = 0; k < 64; ++k) sa -= s[k] * bf2f(KK[o + k]);
        const float v = bf2f(V[o + i]); float y = 0.f;
#pragma unroll
        for (int k = 0; k < 64; ++k) { s[k] = s[k] * expf(bf2f(LOGD[o + k])) + sa * bf2f(B[o + k]) + v * bf2f(K[o + k]); y += s[k] * bf2f(R[o + k]); }
        MIX[(long)(b * SEQ + t) * DM + 384 + 64 * h + i] = f2bf(y);
    }
}
#ifndef MK_BUILD
__global__ void k_rwkv_scan(const bf16_t* R, const bf16_t* K, const bf16_t* V, const bf16_t* KK, const bf16_t* B, const bf16_t* LOGD, bf16_t* MIX) { d_rwkv_scan(R, K, V, KK, B, LOGD, MIX, blockIdx.x, threadIdx.x); }
#endif
__device__ __forceinline__ void d_rwkv_fin(const bf16_t* P, RwkvW W, const bf16_t* R, const bf16_t* K, const bf16_t* V, bf16_t* MIX, long gtid, long gsize) {
    const long total = (long)MTOK * 6;
    for (long idx = gtid; idx < total; idx += gsize) {
        const int tok = (int)(idx / 6), h = (int)(idx % 6);
        bf16_t* y = MIX + (long)tok * DM + 384 + 64 * h; const long o = (long)tok * 384 + 64 * h;
        float mean = 0.f, dot = 0.f;
        for (int c = 0; c < 64; ++c) { mean += bf2f(y[c]); dot += bf2f(R[o + c]) * bf2f(K[o + c]) * W.r_k[64 * h + c]; }
        mean *= (1.0f / 64.0f); float var = 0.f;
        for (int c = 0; c < 64; ++c) { const float d = bf2f(y[c]) - mean; var += d * d; }
        const float rstd = 1.0f / sqrtf(var * (1.0f / 64.0f) + GN_EPS);
        for (int c = 0; c < 64; ++c) {
            const int hc = 64 * h + c; float g = 0.f;
            for (int j = 0; j < 64; ++j) g += (1.0f / (1.0f + expf(-shifted(P, tok, 640 + 1216 + j, W.mu[1216 + j])))) * W.g2[j * 384 + hc];
            const float yn = (bf2f(y[c]) - mean) * rstd * W.ln_w[hc] + W.ln_b[hc];
            y[c] = f2bf((yn + dot * bf2f(V[o + c])) * g);
        }
    }
}
#ifndef MK_BUILD
__global__ void k_rwkv_fin(const bf16_t* P, RwkvW W, const bf16_t* R, const bf16_t* K, const bf16_t* V, bf16_t* MIX) { d_rwkv_fin(P, W, R, K, V, MIX, (long)blockIdx.x * blockDim.x + threadIdx.x, (long)gridDim.x * blockDim.x); }
#endif
__device__ __forceinline__ void d_conv_act(const bf16_t* U, const float* cw, const float* cb, bf16_t* ACT, int rows, long gtid, long gsize) {
    const long total = (long)rows * DFF;
    for (long idx = gtid; idx < total; idx += gsize) {
        const int t = (int)(idx / DFF), c = (int)(idx % DFF);
        float gate = cb[c], val = cb[DFF + c];
#pragma unroll
        for (int i = 0; i < 3; ++i) { const int tt = t - 2 + i; if (tt >= 0) { gate += cw[i * 2 * DFF + c] * bf2f(U[(long)tt * 2 * DFF + c]); val += cw[i * 2 * DFF + DFF + c] * bf2f(U[(long)tt * 2 * DFF + DFF + c]); } }
        ACT[(long)t * DFF + c] = f2bf(gate / (1.0f + expf(-gate)) * val);
    }
}
#ifndef MK_BUILD
__global__ void k_conv_act(const bf16_t* U, const float* cw, const float* cb, bf16_t* ACT, int rows) { d_conv_act(U, cw, cb, ACT, rows, (long)blockIdx.x * blockDim.x + threadIdx.x, (long)gridDim.x * blockDim.x); }
#endif
}
namespace pg8 {
#define PG8_LAS __attribute__((address_space(3)))
typedef unsigned short bf16_t;
typedef short bf16x8 __attribute__((ext_vector_type(8)));
typedef float f32x4 __attribute__((ext_vector_type(4)));
typedef unsigned u32x4 __attribute__((ext_vector_type(4)));
constexpr int BM = 256, BK = 64, HALF = 128, HTB = HALF * BK * 2  , STAGE_BYTES = 8 * HTB, NXCD = 8, WGM = 8;

__host__ __device__ __forceinline__ int lds_byte(int r, int c) { const int st = (r >> 4) * 2 + (c >> 5), rr = r & 15, cc = c & 31, ob = rr * 64 + cc * 2; return st * 1024 + (ob ^ (((ob >> 9) & 1) << 5)); }
__host__ __device__ __forceinline__ void stage_rc(int b, int& R, int& C) { const int st = b / 1024, sb = b % 1024, swz = sb ^ (((sb >> 9) & 1) << 5); R = (st >> 1) * 16 + swz / 64; C = (st & 1) * 32 + (swz % 64) / 2; }
__host__ __device__ __forceinline__ int perm32(int rho) { const int n = rho >> 4, i = rho & 15; return 8 * (i >> 2) + 4 * n + (i & 3); }

struct Unit { int pm, pn; };
struct Gemm { const bf16_t* A; const bf16_t* Bt; int M, N, K; };

struct StaticOrder {
    int nM, nN, nwg, G, c;
    __host__ __device__ void init(int M, int N, int G_, int c_) { nM = M / BM; nN = N / BM; nwg = nM * nN; G = G_; c = c_; }
    __host__ __device__ bool next(int i, Unit& u) const {
        const long L = (long)i * G + c; if (L >= nwg) return false;
        int wgid = (int)L; { const int q = nwg / NXCD, r = nwg % NXCD, xcd = wgid % NXCD, off = wgid / NXCD; wgid = (xcd < r ? xcd * (q + 1) : r * (q + 1) + (xcd - r) * q) + off; }
        const int nig = WGM * nN, gid = wgid / nig, fm = gid * WGM, gsz = (nM - fm) < WGM ? (nM - fm) : WGM;
        u.pm = fm + ((wgid % nig) % gsz); u.pn = (wgid % nig) / gsz; return true;
    }
    __device__ __forceinline__ void a_ready(const Unit&) const {}
    __device__ __forceinline__ void done(const Unit&) const {}
};

__device__ __forceinline__ unsigned cvt_pk_bf16(float lo, float hi) { unsigned r; asm volatile("v_cvt_pk_bf16_f32 %0, %1, %2" : "=v"(r) : "v"(lo), "v"(hi)); return r; }
struct EpiScaleBf16 {
    static constexpr bool PERM = true, AFTER_DRAIN = false; static constexpr int AMAP = 0;
    bf16_t* O; int ldc; const float* ssq;
    __device__ __forceinline__ void operator()(const f32x4 (&acc)[2][2][4][2], const Unit& u, int wr, int wc, int fr, int fq) const {
        const int row0 = u.pm * BM + wr * 64 + fr, col0 = u.pn * BM + wc * 32 + 8 * fq;
#pragma unroll
        for (int ai = 0; ai < 2; ++ai)
#pragma unroll
            for (int m = 0; m < 4; ++m) { const int row = row0 + ai * HALF + m * 16; const float sc = __builtin_amdgcn_rsqf(ssq[row] * (1.0f / 1024.0f) + 1e-6f);
                bf16_t* rowp = O + (size_t)row * ldc + col0;
#pragma unroll
                for (int bj = 0; bj < 2; ++bj) { const f32x4 v0 = acc[ai][bj][m][0] * sc, v1 = acc[ai][bj][m][1] * sc;
                    u32x4 w; w.x = cvt_pk_bf16(v0[0], v0[1]); w.y = cvt_pk_bf16(v0[2], v0[3]); w.z = cvt_pk_bf16(v1[0], v1[1]); w.w = cvt_pk_bf16(v1[2], v1[3]);
                    *(u32x4*)(rowp + bj * HALF) = w; } }
    }
};
struct EpiResid {
    static constexpr bool PERM = false, AFTER_DRAIN = false; static constexpr int AMAP = 0;
    const float* base; float* out; bf16_t* xb; float* ssq; int ldc;
    __device__ __forceinline__ void operator()(const f32x4 (&acc)[2][2][4][2], const Unit& u, int wr, int wc, int fr, int fq) const {
        typedef unsigned u32x2v __attribute__((ext_vector_type(2)));
        const int col0 = u.pn * BM + wc * 32 + 4 * fq;
#pragma unroll
        for (int ai = 0; ai < 2; ++ai)
#pragma unroll
            for (int m = 0; m < 4; ++m) { const int row = u.pm * BM + ai * HALF + wr * 64 + m * 16 + fr; const size_t off = (size_t)row * ldc + col0; float sq = 0.f;
#pragma unroll
                for (int bj = 0; bj < 2; ++bj)
#pragma unroll
                    for (int n = 0; n < 2; ++n) { const f32x4 o = *(const f32x4*)(base + off + bj * HALF + n * 16) + acc[ai][bj][m][n];
                        *(f32x4*)(out + off + bj * HALF + n * 16) = o; sq += (o[0] * o[0] + o[1] * o[1]) + (o[2] * o[2] + o[3] * o[3]);
                        u32x2v w; w.x = cvt_pk_bf16(o[0], o[1]); w.y = cvt_pk_bf16(o[2], o[3]); *(u32x2v*)(xb + off + bj * HALF + n * 16) = w; }
                sq += __shfl_xor(sq, 16); sq += __shfl_xor(sq, 32);
                if (fq == 0) atomicAdd(ssq + row, sq); }
    }
};
struct EpiConvAct {
    static constexpr bool PERM = true, AFTER_DRAIN = false; static constexpr int AMAP = 1;
    bf16_t* ACT; const float* ssq; const float* cw; const float* cb;
    static __device__ __forceinline__ float shr1s(float x) { float r; asm volatile("s_nop 1\n\tv_mov_b32_dpp %0, %1 row_shr:1 row_mask:0xf bank_mask:0xf bound_ctrl:1" : "=v"(r) : "v"(x)); return r; }
    static __device__ __forceinline__ f32x4 shr1(f32x4 v) { f32x4 r; r[0] = shr1s(v[0]); r[1] = shr1s(v[1]); r[2] = shr1s(v[2]); r[3] = shr1s(v[3]); return r; }
    __device__ __forceinline__ void operator()(const f32x4 (&acc)[2][2][4][2], const Unit& u, int wr, int wc, int fr, int fq) const {
        const int b = u.pm / 33, pmb = u.pm % 33;
        const int pos0 = 252 * pmb + 126 * wr + 8 * fr - 2;
        const long row0 = (long)b * SEQ + pos0;
        float rs[8];
#pragma unroll
        for (int j = 0; j < 8; ++j) { const int pos = pos0 + j; const bool ok = pos >= 0 && pos < SEQ; const float q = ssq[ok ? row0 + j : 0]; rs[j] = ok ? __builtin_amdgcn_rsqf(q * (1.0f / 1024.0f) + 1e-6f) : 0.f; }
        const int ch0 = 128 * u.pn + 32 * wc + 8 * fq;
        unsigned ow[8][4];
#pragma unroll
        for (int n = 0; n < 2; ++n) { const int c = ch0 + 4 * n;
            const f32x4 w0g = *(const f32x4*)(cw + c), w1g = *(const f32x4*)(cw + 5632 + c), w2g = *(const f32x4*)(cw + 2 * 5632 + c), bg = *(const f32x4*)(cb + c);
            const f32x4 w0v = *(const f32x4*)(cw + 2816 + c), w1v = *(const f32x4*)(cw + 5632 + 2816 + c), w2v = *(const f32x4*)(cw + 2 * 5632 + 2816 + c), bv = *(const f32x4*)(cb + 2816 + c);
            f32x4 gm2 = shr1(acc[1][0][2][n] * rs[6]), gm1 = shr1(acc[1][0][3][n] * rs[7]), vm2 = shr1(acc[1][1][2][n] * rs[6]), vm1 = shr1(acc[1][1][3][n] * rs[7]);
#pragma unroll
            for (int j = 0; j < 8; ++j) { const f32x4 gj = acc[j >> 2][0][j & 3][n] * rs[j], vj = acc[j >> 2][1][j & 3][n] * rs[j];
                const f32x4 ug = bg + w0g * gm2 + w1g * gm1 + w2g * gj, uv = bv + w0v * vm2 + w1v * vm1 + w2v * vj; f32x4 a;
#pragma unroll
                for (int e = 0; e < 4; ++e) a[e] = ug[e] * __builtin_amdgcn_rcpf(1.0f + __expf(-ug[e])) * uv[e];
                ow[j][2 * n] = cvt_pk_bf16(a[0], a[1]); ow[j][2 * n + 1] = cvt_pk_bf16(a[2], a[3]);
                gm2 = gm1; gm1 = gj; vm2 = vm1; vm1 = vj; } }
#pragma unroll
        for (int j = 0; j < 8; ++j) if (8 * fr + j >= 2 && pos0 + j < SEQ) { u32x4 w; w.x = ow[j][0]; w.y = ow[j][1]; w.z = ow[j][2]; w.w = ow[j][3]; *(u32x4*)(ACT + (size_t)(row0 + j) * 2816 + ch0) = w; }
    }
};
template <class Epi, class Sched, bool ALIGN_EPI = false, bool SP2 = false>
__device__ __forceinline__ void gemm_phase(PG8_LAS unsigned char* lds, const Gemm g, const Sched& S, const Epi& E, int tid_in) {
    int tid = tid_in; asm volatile("" : "+v"(tid));
    const int wid = __builtin_amdgcn_readfirstlane(tid >> 6), lane = tid & 63, wr = wid >> 2, wc = wid & 3, fr = lane & 15, fq = lane >> 4;
    const int K = g.K, nt = K / BK;
    unsigned voffA[2], voffB[2];
#pragma unroll
    for (int i = 0; i < 2; ++i) { int R, C; stage_rc(tid * 16 + i * 8192, R, C); const int Rb = Epi::PERM ? ((R & ~31) + perm32(R & 31)) : R;
        const int Ra = Epi::AMAP ? (126 * (R >> 6) + 8 * (R & 15) + ((R >> 4) & 3)) : R;
        voffA[i] = (unsigned)(Ra * K + C) * 2u; voffB[i] = (unsigned)(Rb * K + C) * 2u; }
    const size_t kstep = (size_t)(BK * 2);
    const size_t hstepB = (size_t)HALF * K * 2;
    const size_t hstepA = Epi::AMAP ? (size_t)4 * K * 2 : hstepB;
    const size_t tstep = 2 * hstepB;
#define PG8_ABASE(pm_) (Epi::AMAP ? (long)((long)((pm_) / 33) * SEQ + 252 * ((pm_) % 33) - 2) * (long)K * 2 : (long)(pm_) * (long)tstep)
    const unsigned ldsw = (unsigned)wid * 1024u;
    const int aoff = lds_byte(wr * 64 + fr, fq * 8), boff = lds_byte(wc * 32 + fr, fq * 8);
#define PG8_SA(b, h) (((b) * 2 + (h)) * HTB)
#define PG8_SB(b, h) ((4 + (b) * 2 + (h)) * HTB)
#define PG8_STAGE(bufoff, gbase, voff) do { _Pragma("unroll") for (int _i = 0; _i < 2; ++_i) \
        __builtin_amdgcn_global_load_lds((const unsigned*)((const char*)(gbase) + (voff)[_i]), (PG8_LAS unsigned*)(lds + (bufoff) + ldsw + _i * 8192), 16, 0, 0); } while (0)
#define PG8_LDA(dst, b, h) do { _Pragma("unroll") for (int m = 0; m < 4; ++m) _Pragma("unroll") for (int k = 0; k < 2; ++k) dst[m][k] = *(const PG8_LAS bf16x8*)(lds + PG8_SA(b, h) + aoff + m * 2048 + k * 1024); } while (0)
#define PG8_LDB(dst, b, h) do { _Pragma("unroll") for (int n = 0; n < 2; ++n) _Pragma("unroll") for (int k = 0; k < 2; ++k) dst[n][k] = *(const PG8_LAS bf16x8*)(lds + PG8_SB(b, h) + boff + n * 2048 + k * 1024); } while (0)
#define PG8_MMA(ai, bj, At, Bt) do { __builtin_amdgcn_s_setprio(1); _Pragma("unroll") for (int m = 0; m < 4; ++m) _Pragma("unroll") for (int n = 0; n < 2; ++n) _Pragma("unroll") for (int k = 0; k < 2; ++k) \
        acc[ai][bj][m][n] = __builtin_amdgcn_mfma_f32_16x16x32_bf16(Bt[n][k], At[m][k], acc[ai][bj][m][n], 0, 0, 0); __builtin_amdgcn_s_setprio(0); } while (0)
#define PG8_WAIT_V(n) asm volatile("s_waitcnt vmcnt(" #n ")" ::: "memory")
#define PG8_WAIT_L(n) asm volatile("s_waitcnt lgkmcnt(" #n ")" ::: "memory")
#define PG8_BAR __builtin_amdgcn_s_barrier()
#define PG8_SCHED __builtin_amdgcn_sched_barrier(0)
    Unit cur, nxt; int ui = 0;
    if (!S.next(0, cur)) return;
    f32x4 acc[2][2][4][2];
#pragma unroll
    for (int a = 0; a < 2; ++a)
#pragma unroll
        for (int b = 0; b < 2; ++b)
#pragma unroll
            for (int m = 0; m < 4; ++m)
#pragma unroll
                for (int n = 0; n < 2; ++n) acc[a][b][m][n] = (f32x4){0.f, 0.f, 0.f, 0.f};
    bf16x8 At[4][2], B0[2][2], B1[2][2];
    const char* cA = (const char*)g.A + PG8_ABASE(cur.pm); const char* cB = (const char*)g.Bt + (size_t)cur.pn * tstep;
    S.a_ready(cur);
    if constexpr (SP2) {
        PG8_STAGE(PG8_SB(0, 0), cB, voffB); PG8_STAGE(PG8_SB(0, 1), cB + hstepB, voffB); PG8_STAGE(PG8_SA(0, 0), cA, voffA); PG8_STAGE(PG8_SA(0, 1), cA + hstepA, voffA);
        if (wr == 1) PG8_BAR;
        PG8_WAIT_V(2); PG8_BAR;
        PG8_STAGE(PG8_SB(1, 0), cB + kstep, voffB); PG8_STAGE(PG8_SA(1, 0), cA + kstep, voffA); PG8_STAGE(PG8_SB(1, 1), cB + hstepB + kstep, voffB);
        PG8_WAIT_V(6); PG8_BAR;
    } else {
        PG8_STAGE(PG8_SB(0, 0), cB, voffB); PG8_STAGE(PG8_SA(0, 0), cA, voffA); PG8_STAGE(PG8_SB(0, 1), cB + hstepB, voffB); PG8_STAGE(PG8_SA(0, 1), cA + hstepA, voffA);
        if (wr == 1) PG8_BAR;
        PG8_WAIT_V(4); PG8_BAR;
        PG8_STAGE(PG8_SB(1, 0), cB + kstep, voffB); PG8_STAGE(PG8_SA(1, 0), cA + kstep, voffA); PG8_STAGE(PG8_SB(1, 1), cB + hstepB + kstep, voffB);
        PG8_WAIT_V(6); PG8_BAR;
    }
    for (;;) {
        const bool has_next = S.next(ui + 1, nxt);
        const char* nA = has_next ? (const char*)g.A + PG8_ABASE(nxt.pm) : cA; const char* nB = has_next ? (const char*)g.Bt + (size_t)nxt.pn * tstep : cB;
        for (int t = 0; t < nt; t += 2) {
            const bool last = (t == nt - 2);
            const char* a1 = cA + (size_t)(t + 1) * kstep;
            const char* a2 = last ? nA : cA + (size_t)(t + 2) * kstep; const char* b2 = last ? nB : cB + (size_t)(t + 2) * kstep;
            const char* a3 = a2 + kstep; const char* b3 = b2 + kstep;
            if (last && has_next) S.a_ready(nxt);
            if constexpr (SP2) {
            PG8_LDB(B0, 0, 0); PG8_LDB(B1, 0, 1); PG8_SCHED; PG8_LDA(At, 0, 0); PG8_STAGE(PG8_SA(1, 1), a1 + hstepA, voffA);
            PG8_WAIT_V(8); PG8_WAIT_L(0); PG8_BAR; PG8_MMA(0, 0, At, B0); PG8_MMA(0, 1, At, B1); PG8_BAR; PG8_SCHED;
            PG8_LDA(At, 0, 1); PG8_STAGE(PG8_SB(0, 0), b2, voffB); PG8_STAGE(PG8_SB(0, 1), b2 + hstepB, voffB); PG8_STAGE(PG8_SA(0, 0), a2, voffA);
            PG8_WAIT_V(8); PG8_WAIT_L(0); PG8_BAR; PG8_MMA(1, 0, At, B0); PG8_MMA(1, 1, At, B1); PG8_BAR; PG8_SCHED;
            PG8_LDB(B0, 1, 0); PG8_LDB(B1, 1, 1); PG8_SCHED; PG8_LDA(At, 1, 0); PG8_STAGE(PG8_SA(0, 1), a2 + hstepA, voffA);
            PG8_WAIT_V(8); PG8_WAIT_L(0); PG8_BAR; PG8_MMA(0, 0, At, B0); PG8_MMA(0, 1, At, B1); PG8_BAR; PG8_SCHED;
            PG8_LDA(At, 1, 1); PG8_STAGE(PG8_SB(1, 0), b3, voffB); PG8_STAGE(PG8_SB(1, 1), b3 + hstepB, voffB); PG8_STAGE(PG8_SA(1, 0), a3, voffA);
            PG8_WAIT_V(8); PG8_WAIT_L(0); PG8_BAR; PG8_MMA(1, 0, At, B0); PG8_MMA(1, 1, At, B1); PG8_BAR; PG8_SCHED;
            } else {
            PG8_LDB(B0, 0, 0); PG8_SCHED; PG8_LDA(At, 0, 0); PG8_STAGE(PG8_SA(1, 1), a1 + hstepA, voffA);
            PG8_WAIT_L(8); PG8_BAR; PG8_WAIT_L(0); PG8_MMA(0, 0, At, B0); PG8_BAR; PG8_SCHED;
            PG8_LDB(B1, 0, 1); PG8_STAGE(PG8_SB(0, 0), b2, voffB);
            PG8_BAR; PG8_WAIT_L(0); PG8_MMA(0, 1, At, B1); PG8_BAR;
            PG8_LDA(At, 0, 1); PG8_STAGE(PG8_SA(0, 0), a2, voffA);
            PG8_BAR; PG8_WAIT_L(0); PG8_MMA(1, 0, At, B0); PG8_BAR; PG8_SCHED;
            PG8_STAGE(PG8_SB(0, 1), b2 + hstepB, voffB);
            PG8_WAIT_V(6); PG8_BAR; PG8_MMA(1, 1, At, B1); PG8_BAR;
            PG8_LDB(B0, 1, 0); PG8_SCHED; PG8_LDA(At, 1, 0); PG8_STAGE(PG8_SA(0, 1), a2 + hstepA, voffA);
            PG8_WAIT_L(8); PG8_BAR; PG8_WAIT_L(0); PG8_MMA(0, 0, At, B0); PG8_BAR; PG8_SCHED;
            PG8_LDB(B1, 1, 1); PG8_STAGE(PG8_SB(1, 0), b3, voffB);
            PG8_BAR; PG8_WAIT_L(0); PG8_MMA(0, 1, At, B1); PG8_BAR;
            PG8_LDA(At, 1, 1); PG8_STAGE(PG8_SA(1, 0), a3, voffA);
            PG8_BAR; PG8_WAIT_L(0); PG8_MMA(1, 0, At, B0); PG8_BAR; PG8_SCHED;
            PG8_STAGE(PG8_SB(1, 1), b3 + hstepB, voffB);
            PG8_WAIT_V(6); PG8_BAR; PG8_MMA(1, 1, At, B1); PG8_BAR;
            }
        }
        if constexpr (ALIGN_EPI) { if (wr == 0) PG8_BAR; }
        if constexpr (!Epi::AFTER_DRAIN) { E(acc, cur, wr, wc, fr, fq); S.done(cur); }
        if (!has_next) break;
#pragma unroll
        for (int a = 0; a < 2; ++a)
#pragma unroll
            for (int b = 0; b < 2; ++b)
#pragma unroll
                for (int m = 0; m < 4; ++m)
#pragma unroll
                    for (int n = 0; n < 2; ++n) acc[a][b][m][n] = (f32x4){0.f, 0.f, 0.f, 0.f};
        cur = nxt; cA = nA; cB = nB; ++ui;
        if constexpr (ALIGN_EPI) { if (wr == 1) PG8_BAR; }
    }
    PG8_WAIT_V(0);
    if constexpr (!ALIGN_EPI) { if (wr == 0) PG8_BAR; }
    PG8_BAR;
    if constexpr (Epi::AFTER_DRAIN) { E.fused(acc, cur, wr, wc, fr, fq, lds, wid, lane); S.done(cur); }
#undef PG8_ABASE
#undef PG8_SA
#undef PG8_SB
#undef PG8_STAGE
#undef PG8_LDA
#undef PG8_LDB
#undef PG8_MMA
#undef PG8_WAIT_V
#undef PG8_WAIT_L
#undef PG8_BAR
#undef PG8_SCHED
}
}

#ifndef PG8_SP2
#define PG8_SP2 true
#endif
#ifndef PG8_ALIGN
#define PG8_ALIGN true
#endif
#define GAS __attribute__((address_space(1)))
#define LAS __attribute__((address_space(3)))
typedef unsigned short bf16;
typedef unsigned v4u __attribute__((ext_vector_type(4)));
typedef float f32x4 __attribute__((ext_vector_type(4)));
typedef short bf16x8 __attribute__((ext_vector_type(8)));
typedef GAS unsigned gu32;
typedef GAS unsigned long long gu64;
#define RLX_AGENT __ATOMIC_RELAXED, __HIP_MEMORY_SCOPE_AGENT
#define LDS_WAIT() asm volatile("s_waitcnt lgkmcnt(0)" ::: "memory")
#define VM_WAIT() asm volatile("s_waitcnt vmcnt(0)" ::: "memory")
__device__ __forceinline__ unsigned long long rt() { return __builtin_amdgcn_s_memrealtime(); }

#define XB_TMO      128
#define XB_XCNT(j)  (256  + 64 * (j))
#define XB_XSUB(j)  (1280 + 64 * (j))
#define XB_XGEN(j)  (2304 + 64 * (j))
#define XB_TOP      3328
#define XB_TOPGEN   3392
#define XCD_BAR_WORDS 3456
#define XB_SPIN_CAP (1u << 20)

__device__ __forceinline__ unsigned xb_ld(unsigned* p)              { return __hip_atomic_load(p, __ATOMIC_RELAXED, __HIP_MEMORY_SCOPE_AGENT); }
__device__ __forceinline__ unsigned xb_add(unsigned* p, unsigned v) { return __hip_atomic_fetch_add(p, v, __ATOMIC_RELAXED, __HIP_MEMORY_SCOPE_AGENT); }
__device__ __forceinline__ unsigned xb_xcc_id() { return (unsigned)__builtin_amdgcn_s_getreg((3 << 11) | 20) & 0xFu; }
#define XB_SPIN(cond, bar) do { unsigned _sp = 0; while (cond) { __builtin_amdgcn_s_sleep(1); \
    if ((++_sp & 255u) == 0u) { if (xb_ld(&(bar)[XB_TMO])) break; if (_sp > XB_SPIN_CAP) { atomicAdd(&(bar)[XB_TMO], 1u); break; } } } } while (0)

struct XcdBarrier {
    unsigned* bar; unsigned x;
    volatile LAS unsigned* st;
};

__device__ __forceinline__ XcdBarrier xcd_barrier_post(unsigned* bar, volatile LAS unsigned* st) {
    XcdBarrier b; b.bar = bar; b.x = xb_xcc_id(); b.st = st;
    if (threadIdx.x == 0) (void)xb_add(&bar[XB_XCNT(b.x)], 1u);
    return b;
}
__device__ __forceinline__ void xcd_barrier_complete(unsigned* bar, unsigned x, unsigned& nloc, unsigned& nx) {
    const unsigned G = gridDim.x * gridDim.y * gridDim.z;
    unsigned sum, cnt, mine, sp = 0u;
    for (;;) {
        sum = 0u; cnt = 0u; mine = 0u;
#pragma unroll
        for (unsigned j = 0; j < 16; ++j) { const unsigned c = xb_ld(&bar[XB_XCNT(j)]); sum += c; cnt += (c > 0u) ? 1u : 0u; mine = (j == x) ? c : mine; }
        if (sum == G) break;
        __builtin_amdgcn_s_sleep(1);
        if ((++sp & 255u) == 0u) { if (xb_ld(&bar[XB_TMO])) break; if (sp > XB_SPIN_CAP) { atomicAdd(&bar[XB_TMO], 1u); break; } }
    }
    nloc = mine > 0u ? mine : 1u; nx = cnt > 0u ? cnt : 1u;
}

__device__ __forceinline__ void xcd_barrier(const XcdBarrier& b) {
    asm volatile("s_waitcnt vmcnt(0)" ::: "memory");
    __syncthreads();
    if (threadIdx.x == 0) {
        unsigned* bar = b.bar;
        __builtin_amdgcn_s_waitcnt(0);
        unsigned nloc = b.st[0], nx = b.st[1];
        if (nloc == 0u) { xcd_barrier_complete(bar, b.x, nloc, nx); b.st[0] = nloc; b.st[1] = nx; }
        const unsigned old = xb_add(&bar[XB_XSUB(b.x)], 1u);
        const unsigned gen = old / nloc;
        if (old + 1u == (gen + 1u) * nloc) {
            __builtin_amdgcn_fence(__ATOMIC_RELEASE, "agent");
            asm volatile("s_waitcnt vmcnt(0)" ::: "memory");
            const unsigned og = xb_add(&bar[XB_TOP], 1u);
            const unsigned tg = og / nx;
            if (og + 1u == (tg + 1u) * nx) xb_add(&bar[XB_TOPGEN], 1u);
            else XB_SPIN(xb_ld(&bar[XB_TOPGEN]) == tg, bar);
            __builtin_amdgcn_fence(__ATOMIC_ACQUIRE, "agent");
            xb_add(&bar[XB_XGEN(b.x)], 1u);
            asm volatile("s_waitcnt vmcnt(0)" ::: "memory");
        } else {
            XB_SPIN(xb_ld(&bar[XB_XGEN(b.x)]) == gen, bar);
            __builtin_amdgcn_fence(__ATOMIC_ACQUIRE, "agent");
            asm volatile("s_waitcnt vmcnt(0)" ::: "memory");
        }
    }
    __syncthreads();
}

namespace mk {
constexpr size_t WS_CTL = 0, CTL_ZERO_BYTES = 1 * MiB;
constexpr size_t CTL_SSQ = 512 * 1024;
constexpr size_t WS_SMALL = 1 * MiB, SM_BIAS = 0, SM_SSQM = 4096, SM_MKV = 512 * 1024;
constexpr size_t WS_MEMB = 2 * MiB, WS_WT = 3 * MiB, WS_XB = 28 * MiB, WS_VF = 60 * MiB, WS_PROJ = 72 * MiB, WS_MIX = 144 * MiB, WS_PREP = 176 * MiB, WS_U = 72 * MiB, WS_ACT = 160 * MiB, WS_WIN1 = 248 * MiB  , WS_END = 255 * MiB;
constexpr size_t WT_IN = 0, WT_OUT = 4718592, WT_UP = WT_OUT + 2 * MiB, WT_DOWN = WT_UP + 11 * MiB, WT_MKV = WT_DOWN + 5767168;
constexpr int CW_TMO = 0, CW_BAR = 4096, CW_ATTQ = 8192, CW_CHQ = 8448;
constexpr int LDS_BYTES = 163840, LDSCTL_OFF = LDS_BYTES - 512, MISC_OFF = LDSCTL_OFF + 320;
constexpr size_t SM_W2T = 8192, SM_A2T = 32768, SM_V2T = 57344, SM_G2T = 81920, SM_LORA_L = 122880;
constexpr size_t WS_PT = 176 * MiB, WS_G = 188 * MiB, WS_S0 = 200 * MiB, WS_Z = 212 * MiB, WS_YV = 236 * MiB  , WS_DOT = 254 * MiB;
constexpr size_t SM_RWP = 262144, RWP_BYTES = 17472;
constexpr int RP_MU = 0, RP_MUV = 1280, RP_W0 = 1296, RP_A0 = 1680, RP_V0 = 2064, RP_KK = 2448, RP_KA = 2832, RP_RK = 3216, RP_LNW = 3600, RP_LNB = 3984, RP_SIZE = 4368;
}
namespace rw {
constexpr int LD = 72;
constexpr int MATB = 64 * LD * 2;
constexpr int OFF_F0 = 12 * MATB  , OFF_TMP = OFF_F0 + 64 * 65 * 4  ;
constexpr int OFF_TW = 8 * MATB  , OFF_TA = OFF_TW + 5120, OFF_TV = OFF_TA + 5120, OFF_WP = OFF_TV + 5120  , OFF_AP = OFF_WP + 16640, OFF_VP = OFF_AP + 16640;
constexpr int OFF_TOT = 139264, OFF_GC = OFF_TOT + 2048, OFF_RN = OFF_GC + 256, OFF_END = OFF_RN + 256;
constexpr int NITEMS = BATCH * 6 * (SEQ / 64);
__device__ __forceinline__ int sigpos(int c) { return (c & 32) + 8 * ((c >> 2) & 3) + 4 * ((c >> 4) & 1) + (c & 3); }
#define RW_BAR() do { asm volatile("s_waitcnt lgkmcnt(0)" ::: "memory"); __builtin_amdgcn_s_barrier(); asm volatile("" ::: "memory"); } while (0)
__device__ __forceinline__ float fexp(float x) { return __expf(x); }
__device__ __forceinline__ float fsigm(float x) { return __builtin_amdgcn_rcpf(1.0f + __expf(-x)); }
__device__ __forceinline__ float ftanh(float x) { const float e = __expf(-2.0f * fabsf(x)); const float t = (1.0f - e) * __builtin_amdgcn_rcpf(1.0f + e); return x < 0.f ? -t : t; }
__device__ __forceinline__ f32x4 mm_tile(const LAS bf16_t* A, const LAS bf16_t* Bt, int ti, int tj, int fr, int fq, f32x4 acc) {
#pragma unroll
    for (int kk = 0; kk < 2; ++kk) {
        const bf16x8 a = *(const LAS bf16x8*)(A + (16 * ti + fr) * LD + 32 * kk + 8 * fq);
        const bf16x8 b = *(const LAS bf16x8*)(Bt + (16 * tj + fr) * LD + 32 * kk + 8 * fq);
        acc = __builtin_amdgcn_mfma_f32_16x16x32_bf16(a, b, acc, 0, 0, 0);
    }
    return acc;
}
__device__ __forceinline__ unsigned pk2(float lo, float hi) { typedef float f2_t __attribute__((ext_vector_type(2))); typedef __bf16 b2_t __attribute__((ext_vector_type(2))); f2_t v = {lo, hi}; return __builtin_bit_cast(unsigned, __builtin_convertvector(v, b2_t)); }
#define RW_PT   ((GAS bf16_t*)(wsb + mk::WS_PT))
#define RW_G    ((GAS bf16_t*)(wsb + mk::WS_G))
#define RW_Z    ((GAS float*)(wsb + mk::WS_Z))
#define RW_YV   ((GAS bf16_t*)(wsb + mk::WS_YV))
#define RW_S0   ((GAS bf16_t*)(wsb + mk::WS_S0))
#define RW_VF   ((GAS bf16_t*)(wsb + mk::WS_VF))
#define RW_DOT  ((GAS float*)(wsb + mk::WS_DOT))
#define RW_PROJ ((const GAS bf16_t*)(wsb + mk::WS_PROJ))
#define RW_MIX  ((GAS bf16_t*)(wsb + mk::WS_MIX))
#define RW_LORA(off) ((const GAS bf16_t*)(wsb + mk::WS_SMALL + (off) + layer * mk::SM_LORA_L))
#define RWP(off) ((const GAS float*)(wsb + mk::WS_SMALL + mk::SM_RWP + layer * mk::RWP_BYTES) + (off))
struct ChunkBufs { bf16_t* PT; bf16_t* G; float* Z; bf16_t* YV; bf16_t* S0; bf16_t* VOUT; float* DOT; const bf16_t *W2T, *A2T, *V2T, *G2T; };

#define RW_LANES() int lt_ = tid_in; asm volatile("" : "+v"(lt_)); const int tid = lt_, lane = lt_ & 63, fr = lane & 15, fq = lane >> 4; (void)tid; (void)fr; (void)fq
__device__ __forceinline__ int chunk_phase(LAS unsigned char* L, unsigned char* wsb, int layer, int tid_in, unsigned* qctr, volatile LAS unsigned* qw) {
    const GAS bf16_t* P = RW_PROJ;
    const int w = __builtin_amdgcn_readfirstlane(tid_in >> 6);
    LAS bf16_t* B0 = (LAS bf16_t*)(L + 0 * MATB); LAS bf16_t* B1 = (LAS bf16_t*)(L + 1 * MATB); LAS bf16_t* B2 = (LAS bf16_t*)(L + 2 * MATB); LAS bf16_t* B3 = (LAS bf16_t*)(L + 3 * MATB);
    LAS bf16_t* B4 = (LAS bf16_t*)(L + 4 * MATB); LAS bf16_t* B5 = (LAS bf16_t*)(L + 5 * MATB); LAS bf16_t* B6 = (LAS bf16_t*)(L + 6 * MATB); LAS bf16_t* B7 = (LAS bf16_t*)(L + 7 * MATB);
    LAS bf16_t* B8 = (LAS bf16_t*)(L + 8 * MATB); LAS bf16_t* B9 = (LAS bf16_t*)(L + 9 * MATB); LAS bf16_t* B10 = (LAS bf16_t*)(L + 10 * MATB); LAS bf16_t* B11 = (LAS bf16_t*)(L + 11 * MATB);
    LAS float* F0 = (LAS float*)(L + OFF_F0); LAS float* TMP = (LAS float*)(L + OFF_TMP);
    LAS bf16_t* TW = (LAS bf16_t*)(L + OFF_TW); LAS bf16_t* TA = (LAS bf16_t*)(L + OFF_TA); LAS bf16_t* TV = (LAS bf16_t*)(L + OFF_TV);
    LAS float* WP = (LAS float*)(L + OFF_WP); LAS float* AP = (LAS float*)(L + OFF_AP); LAS float* VP = (LAS float*)(L + OFF_VP);
    LAS float* TOT = (LAS float*)(L + OFF_TOT); LAS float* GC = (LAS float*)(L + OFF_GC); LAS float* RN = (LAS float*)(L + OFF_RN);
    for (;;) {
        if (tid_in == 0) qw[0] = atomicAdd(qctr, 1u);
        RW_BAR(); const int item = (int)qw[0]; RW_BAR();
        if (item >= NITEMS) return item;
        const int bh = item / (SEQ / 64), chunk = item % (SEQ / 64), b = bh / 6, h = bh % 6;
        const int tok0 = b * SEQ + chunk * 64;
        unsigned short e_r[9], e_k[9], e_v[9], e_vf[8]; float e_mu_r, e_mu_k, e_mu_v, e_w0, e_a0, e_kk, e_ka, e_rk, e_v0;
        { RW_LANES(); const int hc = 64 * h + lane, tk0 = tok0 + 8 * w; const bool has_prev = (chunk * 64 + 8 * w) > 0;
#pragma unroll
          for (int j = 0; j < 9; ++j) { const size_t row = (size_t)(tk0 + j - 1) * LDP; const bool ok = j > 0 || has_prev;
              e_r[j] = ok ? P[row + 640 + hc] : (unsigned short)0; e_k[j] = ok ? P[row + 1024 + hc] : (unsigned short)0; e_v[j] = ok ? P[row + 1408 + hc] : (unsigned short)0; }
#pragma unroll
          for (int j = 0; j < 8; ++j) e_vf[j] = layer > 0 ? RW_VF[(size_t)(tk0 + j) * 384 + hc] : (unsigned short)0;
          e_mu_r = RWP(mk::RP_MU)[hc]; e_mu_k = RWP(mk::RP_MU)[384 + hc]; e_mu_v = RWP(mk::RP_MU)[768 + hc]; e_w0 = RWP(mk::RP_W0)[hc]; e_a0 = RWP(mk::RP_A0)[hc]; e_kk = RWP(mk::RP_KK)[hc]; e_ka = RWP(mk::RP_KA)[hc]; e_rk = RWP(mk::RP_RK)[hc]; e_v0 = layer > 0 ? RWP(mk::RP_V0)[hc] : 0.f; }
        for (int rp_ = 0; rp_ < ((PROF_PH) == 20 ? 2 : 1); ++rp_) {
        { RW_LANES(); const int t = tid >> 3, sub = tid & 7, tok = tok0 + t; const bool hp = (chunk * 64 + t) > 0;
          const GAS bf16_t* rc = P + (size_t)tok * LDP; const GAS bf16_t* rp = rc - LDP; const v4u z4 = {0u, 0u, 0u, 0u};
          const v4u lc = *(const GAS v4u*)(rc + 1792 + 8 * sub), lp = hp ? *(const GAS v4u*)(rp + 1792 + 8 * sub) : z4;
          const v4u kc4 = *(const GAS v4u*)(rc + 1024 + 64 * h + 8 * sub), kp4 = hp ? *(const GAS v4u*)(rp + 1024 + 64 * h + 8 * sub) : z4;
          v4u vc4 = z4, vp4 = z4; if (layer > 0 && sub < 2) { vc4 = *(const GAS v4u*)(rc + 1920 + 8 * sub); if (hp) vp4 = *(const GAS v4u*)(rp + 1920 + 8 * sub); }
          const unsigned lcw[4] = {lc.x, lc.y, lc.z, lc.w}, lpw[4] = {lp.x, lp.y, lp.z, lp.w}, kcw[4] = {kc4.x, kc4.y, kc4.z, kc4.w}, kpw[4] = {kp4.x, kp4.y, kp4.z, kp4.w}, vcw[4] = {vc4.x, vc4.y, vc4.z, vc4.w}, vpw[4] = {vp4.x, vp4.y, vp4.z, vp4.w};
          unsigned lo[4], vo[4]; float s = 0.f;
          const f32x4 mA0 = *(const GAS f32x4*)(RWP(mk::RP_MU) + 1152 + 8 * sub), mA1 = *(const GAS f32x4*)(RWP(mk::RP_MU) + 1156 + 8 * sub);
          const f32x4 mK0 = *(const GAS f32x4*)(RWP(mk::RP_MU) + 384 + 64 * h + 8 * sub), mK1 = *(const GAS f32x4*)(RWP(mk::RP_MU) + 388 + 64 * h + 8 * sub);
          const f32x4 kk0 = *(const GAS f32x4*)(RWP(mk::RP_KK) + 64 * h + 8 * sub), kk1 = *(const GAS f32x4*)(RWP(mk::RP_KK) + 64 * h + 8 * sub + 4);
          f32x4 mV0 = {0.f, 0.f, 0.f, 0.f}, mV1 = mV0; if (layer > 0 && sub < 2) { mV0 = *(const GAS f32x4*)(RWP(mk::RP_MUV) + 8 * sub); mV1 = *(const GAS f32x4*)(RWP(mk::RP_MUV) + 8 * sub + 4); }
#pragma unroll
          for (int e2 = 0; e2 < 4; ++e2) { float xl[2], xv[2];
#pragma unroll
              for (int u = 0; u < 2; ++u) { const int e = 2 * e2 + u; const int sh = 16 * u;
                  const float c1 = bf2f((bf16_t)((lcw[e2] >> sh) & 0xffff)), p1 = bf2f((bf16_t)((lpw[e2] >> sh) & 0xffff)); const float x = c1 + (e < 4 ? mA0[e & 3] : mA1[e & 3]) * (p1 - c1);
                  xl[u] = sub < 4 ? ftanh(x) : x;
                  const float c2 = bf2f((bf16_t)((kcw[e2] >> sh) & 0xffff)), p2 = bf2f((bf16_t)((kpw[e2] >> sh) & 0xffff));
                  const float kx = (c2 + (e < 4 ? mK0[e & 3] : mK1[e & 3]) * (p2 - c2)) * (e < 4 ? kk0[e & 3] : kk1[e & 3]); s += kx * kx;
                  const float c3 = bf2f((bf16_t)((vcw[e2] >> sh) & 0xffff)), p3 = bf2f((bf16_t)((vpw[e2] >> sh) & 0xffff)); xv[u] = c3 + (e < 4 ? mV0[e & 3] : mV1[e & 3]) * (p3 - c3); }
              lo[e2] = pk2(xl[0], xl[1]); vo[e2] = pk2(xv[0], xv[1]); }
          *(LAS v4u*)((sub < 4 ? TW : TA) + t * 40 + 8 * (sub & 3)) = (v4u){lo[0], lo[1], lo[2], lo[3]};
          if (layer > 0 && sub < 4) *(LAS v4u*)(TV + t * 40 + 8 * sub) = (v4u){vo[0], vo[1], vo[2], vo[3]};
          s += __shfl_xor(s, 1); s += __shfl_xor(s, 2); s += __shfl_xor(s, 4);
          if (sub == 0) RN[t] = __builtin_amdgcn_rsqf(fmaxf(s, 1e-24f)); }
        RW_BAR();
        }
        { RW_LANES();
#pragma unroll
        for (int e = 0; e < 2; ++e) { const int tl = 2 * w + e, ti = tl >> 2, tj = tl & 3; const f32x4 z4 = {0.f, 0.f, 0.f, 0.f};
            const size_t brow = (size_t)(64 * h + 16 * tj + fr) * 32 + 8 * fq;
            { const bf16x8 a = *(const LAS bf16x8*)(TW + (16 * ti + fr) * 40 + 8 * fq); const bf16x8 bb = *(const GAS bf16x8*)(RW_LORA(mk::SM_W2T) + brow);
              const f32x4 d = __builtin_amdgcn_mfma_f32_16x16x32_bf16(a, bb, z4, 0, 0, 0);
#pragma unroll
              for (int r = 0; r < 4; ++r) WP[(16 * ti + 4 * fq + r) * 65 + 16 * tj + fr] = d[r]; }
            { const bf16x8 a = *(const LAS bf16x8*)(TA + (16 * ti + fr) * 40 + 8 * fq); const bf16x8 bb = *(const GAS bf16x8*)(RW_LORA(mk::SM_A2T) + brow);
              const f32x4 d = __builtin_amdgcn_mfma_f32_16x16x32_bf16(a, bb, z4, 0, 0, 0);
#pragma unroll
              for (int r = 0; r < 4; ++r) AP[(16 * ti + 4 * fq + r) * 65 + 16 * tj + fr] = d[r]; }
            if (layer > 0) { const bf16x8 a = *(const LAS bf16x8*)(TV + (16 * ti + fr) * 40 + 8 * fq); const bf16x8 bb = *(const GAS bf16x8*)(RW_LORA(mk::SM_V2T) + brow);
              const f32x4 d = __builtin_amdgcn_mfma_f32_16x16x32_bf16(a, bb, z4, 0, 0, 0);
#pragma unroll
              for (int r = 0; r < 4; ++r) VP[(16 * ti + 4 * fq + r) * 65 + 16 * tj + fr] = d[r]; } } }
        RW_BAR();
        for (int rp_ = 0; rp_ < ((PROF_PH) == 21 ? 2 : 1); ++rp_) {
        { RW_LANES(); const int c = lane, hc = 64 * h + c, tq0 = 8 * w, tk0 = tok0 + tq0;
          const float mu_r = e_mu_r, mu_k = e_mu_k, mu_v = e_mu_v, w0 = e_w0, a0 = e_a0, k_k = e_kk, k_a = e_ka, r_k = e_rk, v0 = e_v0;
          float pr = bf2f(e_r[0]), pk = bf2f(e_k[0]), pv = bf2f(e_v[0]);
          float rr[8], kq[8], vv[8], kkc[8], bb[8], ld[8], pd[8];
#pragma unroll
          for (int j = 0; j < 8; ++j) { const int t = tq0 + j;
              const float cr = bf2f(e_r[j + 1]), ck = bf2f(e_k[j + 1]), cv = bf2f(e_v[j + 1]);
              const float r = cr + mu_r * (pr - cr), k = ck + mu_k * (pk - ck); float v = cv + mu_v * (pv - cv); pr = cr; pk = ck; pv = cv;
              const float wp = w0 + WP[t * 65 + c], ap = a0 + AP[t * 65 + c];
              const float z = -wp, sp = fmaxf(z, 0.f) + __logf(1.0f + __expf(-fabsf(z))); const float wl = -sp - 0.5f;
              const float al = fsigm(ap);
              if (layer > 0) { const float vp = v0 + VP[t * 65 + c]; const float vf = bf2f(e_vf[j]); v = v + (vf - v) * fsigm(vp); }
              const float kn = k * k_k * RN[t]; const float k2 = k * (1.0f + (al - 1.0f) * k_a);
              rr[j] = r; kq[j] = k2; vv[j] = v; kkc[j] = kn; bb[j] = kn * al; ld[j] = -fexp(wl); pd[j] = r * k2 * r_k; }
          {
#pragma unroll
            for (int j = 0; j < 8; j += 2) { const unsigned pv2 = pk2(vv[j], vv[j + 1]); RW_VF[(size_t)(tk0 + j) * 384 + hc] = (bf16_t)(pv2 & 0xffff); RW_VF[(size_t)(tk0 + j + 1) * 384 + hc] = (bf16_t)(pv2 >> 16); } }
          {
            const bool b5 = lane & 32, b4 = lane & 16, b3 = lane & 8; float s4[4], s2[2], s1;
#pragma unroll
            for (int i = 0; i < 4; ++i) { const float keep = b5 ? pd[i + 4] : pd[i], send = b5 ? pd[i] : pd[i + 4]; s4[i] = keep + __shfl_xor(send, 32); }
#pragma unroll
            for (int i = 0; i < 2; ++i) { const float keep = b4 ? s4[i + 2] : s4[i], send = b4 ? s4[i] : s4[i + 2]; s2[i] = keep + __shfl_xor(send, 16); }
            { const float keep = b3 ? s2[1] : s2[0], send = b3 ? s2[0] : s2[1]; s1 = keep + __shfl_xor(send, 8); }
            s1 += __shfl_xor(s1, 4); s1 += __shfl_xor(s1, 2); s1 += __shfl_xor(s1, 1);
            if ((lane & 7) == 0) RW_DOT[(size_t)(tk0 + (lane >> 3)) * 6 + h] = s1; }
          float cl[8]; cl[0] = ld[0];
#pragma unroll
          for (int j = 1; j < 8; ++j) cl[j] = cl[j - 1] + ld[j];
          TOT[w * 64 + c] = cl[7];
          RW_BAR();
          float prefix = 0.f, cumC = 0.f;
#pragma unroll
          for (int ww = 0; ww < 8; ++ww) { const float tv = TOT[ww * 64 + c]; cumC += tv; if (ww < w) prefix += tv; }
          const float gcc = fexp(cumC); if (w == 0) GC[c] = gcc;
          unsigned ahp[4], btp[4], ktp[4], vp4[4]; float gprev = fexp(prefix), ah_e = 0.f, bt_e = 0.f, kt_e = 0.f;
#pragma unroll
          for (int j = 0; j < 8; ++j) { const int t = tq0 + j; const float g = fexp(prefix + cl[j]), ig = __builtin_amdgcn_rcpf(g), gc = gcc * ig;
              const float ah = -kkc[j] * gprev, rh = rr[j] * g, bh = bb[j] * ig, kh = kq[j] * ig, bt = bb[j] * gc, kt = kq[j] * gc; gprev = g;
              const unsigned w01 = pk2(ah, rh), w23 = pk2(bh, kh);
              B0[t * LD + c] = (bf16_t)(w01 & 0xffff); B1[t * LD + c] = (bf16_t)(w01 >> 16); B2[t * LD + c] = (bf16_t)(w23 & 0xffff); B3[t * LD + c] = (bf16_t)(w23 >> 16);
              if (j & 1) { ahp[j >> 1] = pk2(ah_e, ah); btp[j >> 1] = pk2(bt_e, bt); ktp[j >> 1] = pk2(kt_e, kt); vp4[j >> 1] = pk2(vv[j - 1], vv[j]); }
              else { ah_e = ah; bt_e = bt; kt_e = kt; } }
          *(LAS v4u*)(B4 + c * LD + tq0) = (v4u){ahp[0], ahp[1], ahp[2], ahp[3]}; *(LAS v4u*)(B5 + c * LD + tq0) = (v4u){btp[0], btp[1], btp[2], btp[3]};
          *(LAS v4u*)(B6 + c * LD + tq0) = (v4u){ktp[0], ktp[1], ktp[2], ktp[3]}; *(LAS v4u*)(B7 + c * LD + tq0) = (v4u){vp4[0], vp4[1], vp4[2], vp4[3]}; }
        RW_BAR();
        }
        for (int rp_ = 0; rp_ < ((PROF_PH) == 22 ? 2 : 1); ++rp_) {
        { RW_LANES(); const int prod = w >> 1; const LAS bf16_t* Aop = prod < 2 ? B0 : B1; const LAS bf16_t* Bop = (prod & 1) ? B3 : B2;
#pragma unroll
          for (int e = 0; e < 8; ++e) { const int tl = (w & 1) * 8 + e, ti = tl >> 2, tj = tl & 3; f32x4 d = {0.f, 0.f, 0.f, 0.f};
              if (tj <= ti) d = mm_tile(Aop, Bop, ti, tj, fr, fq, d);
#pragma unroll
              for (int r = 0; r < 4; ++r) { const int t = 16 * ti + 4 * fq + r, i = 16 * tj + fr; const bool keep = prod < 2 ? (i < t) : (i <= t); const float val = (tj <= ti && keep) ? d[r] : 0.f;
                  if (prod == 0) F0[t * 65 + i] = val; else if (prod == 1) B8[t * LD + i] = f2bf(val); else if (prod == 2) B9[t * LD + i] = f2bf(val); else B10[t * LD + i] = f2bf(val); } } }
        RW_BAR();
        }
        if (w == 0) { RW_LANES();
            const int blk = lane >> 4, jc = lane & 15; const LAS float* Lb = F0 + (16 * blk) * 65 + 16 * blk; float tc[16];
#pragma unroll
            for (int r = 0; r < 16; ++r) { float val = (r == jc) ? 1.f : 0.f;
#pragma unroll
                for (int i = 0; i < r; ++i) val += Lb[r * 65 + i] * tc[i];
                tc[r] = val; }
            asm volatile("s_waitcnt lgkmcnt(0)" ::: "memory");
#pragma unroll
            for (int r = 0; r < 16; ++r) F0[(16 * blk + r) * 65 + 16 * blk + jc] = tc[r];
        }
        RW_BAR();
        if (w < 2) { RW_LANES();
            const int o1 = 32 * w, o2 = 32 * w + 16; f32x4 d = {0.f, 0.f, 0.f, 0.f};
#pragma unroll
            for (int ks = 0; ks < 4; ++ks) d = __builtin_amdgcn_mfma_f32_16x16x4f32(F0[(o2 + fr) * 65 + o1 + 4 * ks + fq], F0[(o1 + 4 * ks + fq) * 65 + o1 + fr], d, 0, 0, 0);
            LAS float* tm = TMP + w * 16 * 17;
#pragma unroll
            for (int r = 0; r < 4; ++r) tm[(4 * fq + r) * 17 + fr] = d[r];
            asm volatile("s_waitcnt lgkmcnt(0)" ::: "memory");
            f32x4 d2 = {0.f, 0.f, 0.f, 0.f};
#pragma unroll
            for (int ks = 0; ks < 4; ++ks) d2 = __builtin_amdgcn_mfma_f32_16x16x4f32(F0[(o2 + fr) * 65 + o2 + 4 * ks + fq], tm[(4 * ks + fq) * 17 + fr], d2, 0, 0, 0);
            asm volatile("s_waitcnt lgkmcnt(0)" ::: "memory");
#pragma unroll
            for (int r = 0; r < 4; ++r) F0[(o2 + 4 * fq + r) * 65 + o1 + fr] = d2[r];
        }
        RW_BAR();
        if (w < 4) { RW_LANES();
            const int ti = w >> 1, tj = w & 1; f32x4 d = {0.f, 0.f, 0.f, 0.f};
#pragma unroll
            for (int ks = 0; ks < 8; ++ks) d = __builtin_amdgcn_mfma_f32_16x16x4f32(F0[(32 + 16 * ti + fr) * 65 + 4 * ks + fq], F0[(4 * ks + fq) * 65 + 16 * tj + fr], d, 0, 0, 0);
#pragma unroll
            for (int r = 0; r < 4; ++r) TMP[(16 * ti + 4 * fq + r) * 33 + 16 * tj + fr] = d[r];
        }
        RW_BAR();
        if (w < 4) { RW_LANES();
            const int ti = w >> 1, tj = w & 1; f32x4 d = {0.f, 0.f, 0.f, 0.f};
#pragma unroll
            for (int ks = 0; ks < 8; ++ks) d = __builtin_amdgcn_mfma_f32_16x16x4f32(F0[(32 + 16 * ti + fr) * 65 + 32 + 4 * ks + fq], TMP[(4 * ks + fq) * 33 + 16 * tj + fr], d, 0, 0, 0);
#pragma unroll
            for (int r = 0; r < 4; ++r) F0[(32 + 16 * ti + 4 * fq + r) * 65 + 16 * tj + fr] = d[r];
        }
        RW_BAR();
        { RW_LANES(); const int t = tid >> 3, i0 = (tid & 7) * 8;
#pragma unroll
          for (int e = 0; e < 8; ++e) B11[t * LD + i0 + e] = f2bf(F0[t * 65 + i0 + e]); }
        RW_BAR();
        { RW_LANES();
#pragma unroll
        for (int e = 0; e < 4; ++e) { const int tl = 4 * w + e, prod = tl >> 4, ti = (tl >> 2) & 3, tj = tl & 3; f32x4 d = {0.f, 0.f, 0.f, 0.f};
            d = prod == 0 ? mm_tile(B11, B4, ti, tj, fr, fq, d) : mm_tile(B8, B7, ti, tj, fr, fq, d);
            LAS bf16_t* dst = (prod == 0 ? B0 : B2) + (16 * tj + fr) * LD + 16 * ti + 4 * fq;
            *(LAS unsigned long long*)dst = (unsigned long long)pk2(d[0], d[1]) | ((unsigned long long)pk2(d[2], d[3]) << 32); } }
        RW_BAR();
        { RW_LANES();
#pragma unroll
        for (int e = 0; e < 2; ++e) { const int tl = 2 * w + e, ti = tl >> 2, tj = tl & 3; f32x4 d = {0.f, 0.f, 0.f, 0.f};
            d = mm_tile(B11, B2, ti, tj, fr, fq, d);
            LAS bf16_t* dst = B3 + (16 * tj + fr) * LD + 16 * ti + 4 * fq;
            *(LAS unsigned long long*)dst = (unsigned long long)pk2(d[0], d[1]) | ((unsigned long long)pk2(d[2], d[3]) << 32); } }
        RW_BAR();
        for (int rp_ = 0; rp_ < ((PROF_PH) == 23 ? 2 : 1); ++rp_) {
        { RW_LANES();
#pragma unroll
        for (int e = 0; e < 8; ++e) { const int tl = 8 * w + e, prod = tl >> 4, ti = (tl >> 2) & 3, tj = tl & 3; f32x4 d = {0.f, 0.f, 0.f, 0.f};
            if (prod == 0) { d = mm_tile(B5, B3, ti, tj, fr, fq, d); d = mm_tile(B6, B7, ti, tj, fr, fq, d);
                *(GAS f32x4*)(RW_Z + (size_t)item * 4096 + (16 * tj + fr) * 64 + 4 * ((4 * ti + fq) ^ fr)) = d; }
            else if (prod == 1) { d = mm_tile(B9, B3, ti, tj, fr, fq, d); d = mm_tile(B10, B7, ti, tj, fr, fq, d);
                *(GAS unsigned long long*)(RW_YV + (size_t)item * 4096 + (16 * tj + fr) * 64 + 16 * ti + 4 * fq) = (unsigned long long)pk2(d[0], d[1]) | ((unsigned long long)pk2(d[2], d[3]) << 32); }
            else if (prod == 2) { d = mm_tile(B9, B0, ti, tj, fr, fq, d);
#pragma unroll
                for (int r = 0; r < 4; ++r) { const int t = 16 * ti + 4 * fq + r, c = 16 * tj + fr; B4[t * LD + sigpos(c)] = f2bf(d[r] + bf2f(B1[t * LD + c])); } }
            else { d = mm_tile(B5, B0, ti, tj, fr, fq, d);
#pragma unroll
                for (int r = 0; r < 4; ++r) { const int c = 16 * ti + 4 * fq + r, c2 = 16 * tj + fr; B8[c * LD + sigpos(c2)] = f2bf(d[r] + (c == c2 ? GC[c] : 0.f)); } } } }
        RW_BAR();
        }
        { RW_LANES(); const int r = tid >> 3, ch = (tid & 7) * 8;
          *(GAS v4u*)(RW_G + (size_t)item * 4096 + r * 64 + ch) = *(const LAS v4u*)(B4 + r * LD + ch);
          *(GAS v4u*)(RW_PT + (size_t)item * 4096 + r * 64 + 8 * ((tid & 7) ^ (r & 7))) = *(const LAS v4u*)(B8 + r * LD + ch); }
        RW_BAR();
    }
}
constexpr int SC_NS = 10, SC_SLOT = 12288, SC_LAG = 6;
__device__ __forceinline__ void scan_compute(LAS unsigned char* L, const ChunkBufs cb, int bh, int tj, int lane, volatile LAS unsigned* flags) {
    const int fr = lane & 15, fq = lane >> 4; const int NC = SEQ / 64;
    bf16x8 Bf0 = {0, 0, 0, 0, 0, 0, 0, 0}, Bf1 = {0, 0, 0, 0, 0, 0, 0, 0};
    bf16_t* s0 = cb.S0 + (size_t)(bh * NC) * 4096 + (16 * tj + fr) * 64 + 8 * fq;
    const int po0 = fr * 128 + 16 * ((fq) ^ (fr & 7)), po1 = fr * 128 + 16 * ((4 + fq) ^ (fr & 7));
    int slot = 0;
    for (int chunk = 0; chunk < NC; ++chunk) {
        unsigned spins = 0;
        while (true) { const unsigned a = flags[0], b = flags[1], c = flags[2]; const unsigned m = a < b ? (a < c ? a : c) : (b < c ? b : c); if ((int)m >= chunk + 1 || ++spins > (1u << 22)) break; __builtin_amdgcn_s_sleep(1); }
        const LAS unsigned char* sp = L + slot * SC_SLOT;
        bf16x8 a0[4], a1[4]; f32x4 z[4];
#pragma unroll
        for (int ti = 0; ti < 4; ++ti) { a0[ti] = *(const LAS bf16x8*)(sp + ti * 2048 + po0); a1[ti] = *(const LAS bf16x8*)(sp + ti * 2048 + po1); z[ti] = *(const LAS f32x4*)(sp + 8192 + fr * 256 + 16 * ((4 * ti + fq) ^ fr)); }
        asm volatile("s_waitcnt lgkmcnt(0)" ::: "memory");
        if (lane == 0) flags[3] = (unsigned)(chunk + 1);
        *(GAS bf16x8*)(s0 + (size_t)chunk * 4096) = Bf0; *(GAS bf16x8*)(s0 + (size_t)chunk * 4096 + 32) = Bf1;
        f32x4 acc[4];
#pragma unroll
        for (int ti = 0; ti < 4; ++ti) { acc[ti] = __builtin_amdgcn_mfma_f32_16x16x32_bf16(a0[ti], Bf0, z[ti], 0, 0, 0); acc[ti] = __builtin_amdgcn_mfma_f32_16x16x32_bf16(a1[ti], Bf1, acc[ti], 0, 0, 0); }
        v4u m0, m1;
        m0.x = pk2(acc[0][0], acc[0][1]); m0.y = pk2(acc[0][2], acc[0][3]); m0.z = pk2(acc[1][0], acc[1][1]); m0.w = pk2(acc[1][2], acc[1][3]);
        m1.x = pk2(acc[2][0], acc[2][1]); m1.y = pk2(acc[2][2], acc[2][3]); m1.z = pk2(acc[3][0], acc[3][1]); m1.w = pk2(acc[3][2], acc[3][3]);
        Bf0 = __builtin_bit_cast(bf16x8, m0); Bf1 = __builtin_bit_cast(bf16x8, m1);
        slot = slot + 1 == SC_NS ? 0 : slot + 1;
    }
}
__device__ __forceinline__ void scan_loader(LAS unsigned char* L, const ChunkBufs cb, int bh, int tj, int lw, int lane, volatile LAS unsigned* flags) {
    const int NC = SEQ / 64;
    const char* src[4];
#pragma unroll
    for (int k = 0; k < 4; ++k) { const int pc = 4 * lw + k;
        src[k] = pc < 8 ? (const char*)(cb.PT + (size_t)(bh * NC) * 4096) + pc * 1024 + lane * 16 : (const char*)(cb.Z + (size_t)(bh * NC) * 4096) + tj * 4096 + (pc - 8) * 1024 + lane * 16; }
    const size_t st0 = 8192, st1 = 16384;
    int slot = 0;
    for (int c = 0; c < NC; ++c) {
        unsigned spins = 0;
        while ((int)flags[3] < c - SC_NS + 1 && ++spins < (1u << 22)) __builtin_amdgcn_s_sleep(1);
        const unsigned dst = (unsigned)(slot * SC_SLOT + 4 * lw * 1024);
#pragma unroll
        for (int k = 0; k < 4; ++k) { const int pc = 4 * lw + k;
            __builtin_amdgcn_global_load_lds((const unsigned*)(src[k] + (size_t)c * (pc < 8 ? st0 : st1)), (LAS unsigned*)(L + dst + k * 1024), 16, 0, 0); }
        if (c >= SC_LAG) { asm volatile("s_waitcnt vmcnt(24)" ::: "memory"); if (lane == 0) flags[lw] = (unsigned)(c - SC_LAG + 1); }
        slot = slot + 1 == SC_NS ? 0 : slot + 1;
    }
    asm volatile("s_waitcnt vmcnt(0)" ::: "memory");
    if (lane == 0) flags[lw] = (unsigned)NC;
}
constexpr int O_SG = 0  , O_Y = 9216  , O_GT = O_Y + 16640  ;
struct OutRegs { v4u gc4, gp4, vo4; unsigned long long yw[2]; bf16x8 a[2][2], bb[2][2], b2[2][2]; float dot; f32x4 lw0, lw1, lb0, lb1; };
__device__ __forceinline__ void out_load(OutRegs& R, unsigned char* wsb, int layer, int item, int tid, int w) {
    const GAS bf16_t* P = RW_PROJ;
    const int lane = tid & 63, fr = lane & 15, fq = lane >> 4;
    const int bh = item / (SEQ / 64), chunk = item % (SEQ / 64), b = bh / 6, h = bh % 6; const int tok0 = b * SEQ + chunk * 64; const size_t ib = (size_t)item * 4096;
    const int t = tid >> 3, sub = tid & 7, tok = tok0 + t; const bool hp = (chunk * 64 + t) > 0;
    const GAS bf16_t* rc = P + (size_t)tok * LDP + 1856 + 8 * sub; const v4u z4 = {0u, 0u, 0u, 0u};
    R.gc4 = *(const GAS v4u*)rc; R.gp4 = hp ? *(const GAS v4u*)(rc - LDP) : z4;
#pragma unroll
    for (int e = 0; e < 2; ++e) { const int tl = 2 * w + e, ti = tl >> 2, tj = tl & 3;
        R.yw[e] = *(const GAS unsigned long long*)(RW_YV + ib + (16 * tj + fr) * 64 + 16 * ti + 4 * fq);
#pragma unroll
        for (int kk = 0; kk < 2; ++kk) { R.a[e][kk] = *(const GAS bf16x8*)(RW_G + ib + (16 * ti + fr) * 64 + 32 * kk + 8 * fq); R.bb[e][kk] = *(const GAS bf16x8*)(RW_S0 + ib + (16 * tj + fr) * 64 + 32 * kk + 8 * fq);
            R.b2[e][kk] = *(const GAS bf16x8*)(RW_LORA(mk::SM_G2T) + (size_t)(64 * h + 16 * tj + fr) * 64 + 32 * kk + 8 * fq); } }
    R.dot = RW_DOT[(size_t)tok * 6 + h]; R.vo4 = *(const GAS v4u*)(RW_VF + (size_t)tok * 384 + 64 * h + 8 * sub);
    R.lw0 = *(const GAS f32x4*)(RWP(mk::RP_LNW) + 64 * h + 8 * sub); R.lw1 = *(const GAS f32x4*)(RWP(mk::RP_LNW) + 64 * h + 8 * sub + 4); R.lb0 = *(const GAS f32x4*)(RWP(mk::RP_LNB) + 64 * h + 8 * sub); R.lb1 = *(const GAS f32x4*)(RWP(mk::RP_LNB) + 64 * h + 8 * sub + 4);
}
__device__ __forceinline__ void out_phase(LAS unsigned char* L, unsigned char* wsb, int layer, int tid_in, int first, int stride) {
    GAS bf16_t* MIX = RW_MIX;
    const int w = __builtin_amdgcn_readfirstlane(tid_in >> 6);
    LAS bf16_t* SG = (LAS bf16_t*)(L + O_SG); LAS float* Y = (LAS float*)(L + O_Y); LAS float* GT = (LAS float*)(L + O_GT);
    OutRegs R; if (first < NITEMS) { RW_LANES(); out_load(R, wsb, layer, first, tid, w); }
    for (int item = first; item < NITEMS; item += stride) {
        const int bh = item / (SEQ / 64), chunk = item % (SEQ / 64), b = bh / 6, h = bh % 6; const int tok0 = b * SEQ + chunk * 64;
        OutRegs N = R; if (item + stride < NITEMS) { RW_LANES(); out_load(N, wsb, layer, item + stride, tid, w); }
        { RW_LANES(); const int t = tid >> 3, sub = tid & 7;
          const f32x4 m0 = *(const GAS f32x4*)(RWP(mk::RP_MU) + 1216 + 8 * sub), m1 = *(const GAS f32x4*)(RWP(mk::RP_MU) + 1220 + 8 * sub);
          const unsigned cw_[4] = {R.gc4.x, R.gc4.y, R.gc4.z, R.gc4.w}, pw_[4] = {R.gp4.x, R.gp4.y, R.gp4.z, R.gp4.w}; unsigned o[4];
#pragma unroll
          for (int e2 = 0; e2 < 4; ++e2) { float x[2];
#pragma unroll
              for (int u = 0; u < 2; ++u) { const int e = 2 * e2 + u; const float c1 = bf2f((bf16_t)((cw_[e2] >> (16 * u)) & 0xffff)), p1 = bf2f((bf16_t)((pw_[e2] >> (16 * u)) & 0xffff));
                  x[u] = fsigm(c1 + (e < 4 ? m0[e & 3] : m1[e & 3]) * (p1 - c1)); }
              o[e2] = pk2(x[0], x[1]); }
          *(LAS v4u*)(SG + t * LD + 8 * sub) = (v4u){o[0], o[1], o[2], o[3]}; }
        RW_BAR();
        { RW_LANES();
#pragma unroll
        for (int e = 0; e < 2; ++e) { const int tl = 2 * w + e, ti = tl >> 2, tj = tl & 3; const unsigned long long yw = R.yw[e];
            f32x4 d = {bf2f((bf16_t)(yw & 0xffff)), bf2f((bf16_t)((yw >> 16) & 0xffff)), bf2f((bf16_t)((yw >> 32) & 0xffff)), bf2f((bf16_t)(yw >> 48))}; f32x4 g = {0.f, 0.f, 0.f, 0.f};
#pragma unroll
            for (int kk = 0; kk < 2; ++kk) {
                d = __builtin_amdgcn_mfma_f32_16x16x32_bf16(R.a[e][kk], R.bb[e][kk], d, 0, 0, 0);
                const bf16x8 a2 = *(const LAS bf16x8*)(SG + (16 * ti + fr) * LD + 32 * kk + 8 * fq);
                g = __builtin_amdgcn_mfma_f32_16x16x32_bf16(a2, R.b2[e][kk], g, 0, 0, 0); }
#pragma unroll
            for (int r = 0; r < 4; ++r) { Y[(16 * ti + 4 * fq + r) * 65 + 16 * tj + fr] = d[r]; GT[(16 * ti + 4 * fq + r) * 65 + 16 * tj + fr] = g[r]; } } }
        RW_BAR();
        { RW_LANES(); const int t = tid >> 3, sub = tid & 7, tok = tok0 + t; float yv[8], s = 0.f;
#pragma unroll
          for (int e = 0; e < 8; ++e) { yv[e] = Y[t * 65 + 8 * sub + e]; s += yv[e]; }
          s += __shfl_xor(s, 1); s += __shfl_xor(s, 2); s += __shfl_xor(s, 4);
          const float mean = s * (1.0f / 64.0f); float q = 0.f;
#pragma unroll
          for (int e = 0; e < 8; ++e) { const float dd = yv[e] - mean; q += dd * dd; }
          q += __shfl_xor(q, 1); q += __shfl_xor(q, 2); q += __shfl_xor(q, 4);
          const float rstd = __builtin_amdgcn_rsqf(q * (1.0f / 64.0f) + GN_EPS), dot = R.dot;
          const unsigned vw[4] = {R.vo4.x, R.vo4.y, R.vo4.z, R.vo4.w}; unsigned o[4];
#pragma unroll
          for (int e = 0; e < 8; e += 2) { float r2[2];
#pragma unroll
              for (int u = 0; u < 2; ++u) { const int ee = e + u; const float lw = ee < 4 ? R.lw0[ee & 3] : R.lw1[ee & 3], lb = ee < 4 ? R.lb0[ee & 3] : R.lb1[ee & 3];
                  const float yn = (yv[ee] - mean) * rstd * lw + lb; const float vv = bf2f((bf16_t)((vw[ee >> 1] >> (16 * (ee & 1))) & 0xffff));
                  r2[u] = (yn + dot * vv) * GT[t * 65 + 8 * sub + ee]; }
              o[e >> 1] = pk2(r2[0], r2[1]); }
          *(GAS v4u*)(MIX + (size_t)tok * DM + 384 + 64 * h + 8 * sub) = (v4u){o[0], o[1], o[2], o[3]}; }
        RW_BAR();
        R = N;
    }
}
}
namespace at {
constexpr int LDK = 72, LDV = 264;
constexpr int A_K = 0, A_V = 256 * LDK * 2  , A_BIAS = A_V + 64 * LDV * 2  , LDB = 256, BOFF = 48, A_END = A_BIAS + 6 * LDB * 4;
__device__ __forceinline__ int vpos(int key) { return (key & ~31) + 8 * ((key >> 2) & 3) + 4 * ((key >> 4) & 1) + (key & 3); }
__device__ __forceinline__ unsigned pk2(float lo, float hi) { typedef float f2_t __attribute__((ext_vector_type(2))); typedef __bf16 b2_t __attribute__((ext_vector_type(2))); f2_t v = {lo, hi}; return __builtin_bit_cast(unsigned, __builtin_convertvector(v, b2_t)); }
#define AT_BAR() do { asm volatile("s_waitcnt vmcnt(0) lgkmcnt(0)" ::: "memory"); __builtin_amdgcn_s_barrier(); asm volatile("" ::: "memory"); } while (0)

struct StageRegs { v4u k[4], v[4]; };
__device__ __forceinline__ void stage_issue(StageRegs& R, int tid, const bf16_t* kbase, const bf16_t* vbase, long pitch, int jvalid0) {
    const v4u z4 = {0u, 0u, 0u, 0u};
#pragma unroll
    for (int it = 0; it < 4; ++it) { const int idx = it * 512 + tid, key = idx >> 3, ch = idx & 7; R.k[it] = key >= jvalid0 ? *(const GAS v4u*)(kbase + (long)key * pitch + 8 * ch) : z4; }
#pragma unroll
    for (int it = 0; it < 4; ++it) { const int idx = it * 512 + tid, key = idx & 255, ch = idx >> 8; R.v[it] = key >= jvalid0 ? *(const GAS v4u*)(vbase + (long)key * pitch + 8 * ch) : z4; }
}
__device__ __forceinline__ void stage_commit(LAS unsigned char* L, const StageRegs& R, int tid, const float* gk) {
    LAS bf16_t* Kl = (LAS bf16_t*)(L + A_K); LAS bf16_t* VTl = (LAS bf16_t*)(L + A_V);
#pragma unroll
    for (int it = 0; it < 4; ++it) { const int idx = it * 512 + tid, key = idx >> 3, ch = idx & 7; const v4u raw = R.k[it];
        float f[8]; f[0] = __builtin_bit_cast(float, raw.x << 16); f[1] = __builtin_bit_cast(float, raw.x & 0xffff0000u); f[2] = __builtin_bit_cast(float, raw.y << 16); f[3] = __builtin_bit_cast(float, raw.y & 0xffff0000u);
        f[4] = __builtin_bit_cast(float, raw.z << 16); f[5] = __builtin_bit_cast(float, raw.z & 0xffff0000u); f[6] = __builtin_bit_cast(float, raw.w << 16); f[7] = __builtin_bit_cast(float, raw.w & 0xffff0000u);
        float ss = 0.f;
#pragma unroll
        for (int e = 0; e < 8; ++e) ss += f[e] * f[e];
        ss += __shfl_xor(ss, 1); ss += __shfl_xor(ss, 2); ss += __shfl_xor(ss, 4);
        const float rs = __builtin_amdgcn_rsqf(ss * (1.0f / 64.0f) + EPS);
        const f32x4 g0 = *(const GAS f32x4*)(gk + 8 * ch), g1 = *(const GAS f32x4*)(gk + 8 * ch + 4);
        v4u o; o.x = pk2(f[0] * rs * g0[0], f[1] * rs * g0[1]); o.y = pk2(f[2] * rs * g0[2], f[3] * rs * g0[3]); o.z = pk2(f[4] * rs * g1[0], f[5] * rs * g1[1]); o.w = pk2(f[6] * rs * g1[2], f[7] * rs * g1[3]);
        *(LAS v4u*)(Kl + key * LDK + 8 * ch) = o; }
#pragma unroll
    for (int it = 0; it < 4; ++it) { const int idx = it * 512 + tid, key = idx & 255, ch = idx >> 8; const v4u raw = R.v[it];
        LAS bf16_t* d = VTl + (8 * ch) * LDV + vpos(key);
        d[0 * LDV] = (bf16_t)(raw.x & 0xffff); d[1 * LDV] = (bf16_t)(raw.x >> 16); d[2 * LDV] = (bf16_t)(raw.y & 0xffff); d[3 * LDV] = (bf16_t)(raw.y >> 16);
        d[4 * LDV] = (bf16_t)(raw.z & 0xffff); d[5 * LDV] = (bf16_t)(raw.z >> 16); d[6 * LDV] = (bf16_t)(raw.w & 0xffff); d[7 * LDV] = (bf16_t)(raw.w >> 16); }
}
struct QRaw { v4u r0, r1; };
__device__ __forceinline__ QRaw q_raw(const bf16_t* qrow, int fq) { QRaw q; q.r0 = *(const GAS v4u*)(qrow + 8 * fq); q.r1 = *(const GAS v4u*)(qrow + 32 + 8 * fq); return q; }
__device__ __forceinline__ void q_finish(const QRaw qr, const float* gq, int fq, bf16x8& q0, bf16x8& q1) {
    float f[16]; const unsigned w[8] = {qr.r0.x, qr.r0.y, qr.r0.z, qr.r0.w, qr.r1.x, qr.r1.y, qr.r1.z, qr.r1.w};
#pragma unroll
    for (int e = 0; e < 8; ++e) { f[2 * e] = __builtin_bit_cast(float, w[e] << 16); f[2 * e + 1] = __builtin_bit_cast(float, w[e] & 0xffff0000u); }
    float ss = 0.f;
#pragma unroll
    for (int e = 0; e < 16; ++e) ss += f[e] * f[e];
    ss += __shfl_xor(ss, 16); ss += __shfl_xor(ss, 32);
    const float rs = 0.125f * __builtin_amdgcn_rsqf(ss * (1.0f / 64.0f) + EPS);
    const f32x4 g0 = *(const GAS f32x4*)(gq + 8 * fq), g1 = *(const GAS f32x4*)(gq + 8 * fq + 4), g2 = *(const GAS f32x4*)(gq + 32 + 8 * fq), g3 = *(const GAS f32x4*)(gq + 36 + 8 * fq);
    v4u a, b;
    a.x = pk2(f[0] * rs * g0[0], f[1] * rs * g0[1]); a.y = pk2(f[2] * rs * g0[2], f[3] * rs * g0[3]); a.z = pk2(f[4] * rs * g1[0], f[5] * rs * g1[1]); a.w = pk2(f[6] * rs * g1[2], f[7] * rs * g1[3]);
    b.x = pk2(f[8] * rs * g2[0], f[9] * rs * g2[1]); b.y = pk2(f[10] * rs * g2[2], f[11] * rs * g2[3]); b.z = pk2(f[12] * rs * g3[0], f[13] * rs * g3[1]); b.w = pk2(f[14] * rs * g3[2], f[15] * rs * g3[3]);
    q0 = __builtin_bit_cast(bf16x8, a); q1 = __builtin_bit_cast(bf16x8, b);
}
template <int NT, bool SWA> __device__ __forceinline__ void attn_wave(const LAS unsigned char* L, bf16x8 q0, bf16x8 q1, int kt0, int qi0, int hq, float sink, bool first_block, bf16_t* outp, int fr, int fq) {
    const LAS bf16_t* Kl = (const LAS bf16_t*)(L + A_K); const LAS bf16_t* VTl = (const LAS bf16_t*)(L + A_V); const LAS float* bias = (const LAS float*)(L + A_BIAS);
    f32x4 s[NT];
#pragma unroll
    for (int t = 0; t < NT; ++t) { const LAS bf16_t* kr = Kl + (16 * (kt0 + t) + fr) * LDK + 8 * fq;
        const f32x4 z = {0.f, 0.f, 0.f, 0.f};
        s[t] = __builtin_amdgcn_mfma_f32_16x16x32_bf16(*(const LAS bf16x8*)kr, q0, z, 0, 0, 0);
        s[t] = __builtin_amdgcn_mfma_f32_16x16x32_bf16(*(const LAS bf16x8*)(kr + 32), q1, s[t], 0, 0, 0);
        if (t & 1) __builtin_amdgcn_sched_barrier(0); }
    float mx = SWA ? sink : -3.0e38f;
    if (SWA) {
        const int odd = (qi0 >> 4) & 1; const int D0 = qi0 + fr + 128 - 16 * kt0 - 4 * fq;
        const LAS float* bp = bias + hq * LDB + BOFF + D0 - 147;
#pragma unroll
        for (int t = 0; t < NT; ++t) { const int c = t - odd;
            if (c >= 1 && c <= 7 && !first_block) {
#pragma unroll
                for (int r = 0; r < 4; ++r) { s[t][r] += bp[147 - 16 * t - r]; mx = fmaxf(mx, s[t][r]); }
            } else {
#pragma unroll
                for (int r = 0; r < 4; ++r) { const int dist = D0 - 16 * t - r; const bool valid = (unsigned)dist < 128u && !(first_block && 16 * (kt0 + t) + 4 * fq + r < 128);
                    s[t][r] = valid ? s[t][r] + bp[147 - 16 * t - r] : -3.0e38f; mx = fmaxf(mx, s[t][r]); } } }
    } else {
#pragma unroll
        for (int t = 0; t < NT; ++t)
#pragma unroll
            for (int r = 0; r < 4; ++r) mx = fmaxf(mx, s[t][r]);
    }
    mx = fmaxf(mx, __shfl_xor(mx, 16)); mx = fmaxf(mx, __shfl_xor(mx, 32));
    float l = 0.f;
#pragma unroll
    for (int t = 0; t < NT; ++t)
#pragma unroll
        for (int r = 0; r < 4; ++r) { const float p = __expf(s[t][r] - mx); s[t][r] = p; l += p; }
    l += __shfl_xor(l, 16); l += __shfl_xor(l, 32);
    if (SWA) l += __expf(sink - mx);
    f32x4 o[4];
#pragma unroll
    for (int dt = 0; dt < 4; ++dt) o[dt] = (f32x4){0.f, 0.f, 0.f, 0.f};
#pragma unroll
    for (int ks = 0; ks < NT / 2; ++ks) { v4u pw; pw.x = pk2(s[2 * ks][0], s[2 * ks][1]); pw.y = pk2(s[2 * ks][2], s[2 * ks][3]); pw.z = pk2(s[2 * ks + 1][0], s[2 * ks + 1][1]); pw.w = pk2(s[2 * ks + 1][2], s[2 * ks + 1][3]);
        const bf16x8 pb = __builtin_bit_cast(bf16x8, pw);
#pragma unroll
        for (int dt = 0; dt < 4; ++dt) o[dt] = __builtin_amdgcn_mfma_f32_16x16x32_bf16(*(const LAS bf16x8*)(VTl + (16 * dt + fr) * LDV + 32 * (kt0 / 2 + ks) + 8 * fq), pb, o[dt], 0, 0, 0);
        __builtin_amdgcn_sched_barrier(0); }
    const float inv = __builtin_amdgcn_rcpf(l);
#pragma unroll
    for (int dt = 0; dt < 4; ++dt) *(GAS unsigned long long*)(outp + (long)fr * DM + 16 * dt + 4 * fq) = (unsigned long long)pk2(o[dt][0] * inv, o[dt][1] * inv) | ((unsigned long long)pk2(o[dt][2] * inv, o[dt][3] * inv) << 32);
}
struct AttnArgs { const bf16_t* PROJ; const bf16_t* MKV; bf16_t* MIX; const float* biastab; const float *sinks, *gq, *gk, *gmq, *gmk; };
__device__ __forceinline__ void item_stage_issue(StageRegs& R, const AttnArgs A, int q, int tid) {
    if (q >= 256) { const int item = q - 256, b = item >> 7, hkv = (item >> 6) & 1, blk = item & 63; const long tokb = (long)b * SEQ + blk * 128;
        stage_issue(R, tid, A.PROJ + (tokb - 128) * LDP + 384 + 64 * hkv, A.PROJ + (tokb - 128) * LDP + 512 + 64 * hkv, LDP, blk == 0 ? 128 : 0); }
    else { const int b = q >> 7, h = (q >> 5) & 3; stage_issue(R, tid, A.MKV + (long)(b * 256) * 512 + 64 * h, A.MKV + (long)(b * 256) * 512 + 256 + 64 * h, 512, 0); }
}
__device__ __forceinline__ void attn_phase(LAS unsigned char* L, const AttnArgs A, unsigned* qctr, volatile LAS unsigned* qw, int tid_in) {
    const int w = __builtin_amdgcn_readfirstlane(tid_in >> 6);
    { int lt_ = tid_in; asm volatile("" : "+v"(lt_)); const int tid = lt_;
      LAS float* bl = (LAS float*)(L + A_BIAS); for (int i = tid; i < 6 * LDB; i += 512) { const int hh = i / LDB, d = i % LDB - BOFF; bl[i] = (d >= 0 && d < 128) ? A.biastab[d * 6 + hh] : 0.f; } }
    if (tid_in == 0) qw[0] = atomicAdd(qctr, 1u);
    AT_BAR(); int q = (int)qw[0]; AT_BAR();
    StageRegs SR; if (q < 512) { int lt_ = tid_in; asm volatile("" : "+v"(lt_)); item_stage_issue(SR, A, q, lt_); }
    while (q < 512) {
        int lt_ = tid_in; asm volatile("" : "+v"(lt_)); const int tid = lt_, lane = lt_ & 63, fr = lane & 15, fq = lane >> 4;
        const bool swa = q >= 256;
        stage_commit(L, SR, tid, swa ? A.gk : A.gmk);
        QRaw qa, qb, qc; int b, hh, blk;
        if (swa) { const int item = q - 256; b = item >> 7; hh = (item >> 6) & 1; blk = item & 63; const bf16_t* qp = A.PROJ + ((long)b * SEQ + blk * 128 + 16 * w + fr) * LDP + 192 * hh;
            qa = q_raw(qp, fq); qb = q_raw(qp + 64, fq); qc = q_raw(qp + 128, fq); }
        else { b = q >> 7; hh = (q >> 5) & 3; blk = q & 31; const bf16_t* qp = A.PROJ + ((long)b * SEQ + (2 * blk) * 128 + 16 * w + fr) * LDP + 1984 + 64 * hh;
            qa = q_raw(qp, fq); qb = q_raw(qp + (long)128 * LDP, fq); qc = qb; }
        if (tid_in == 0) qw[0] = atomicAdd(qctr, 1u);
        AT_BAR(); const int qn = (int)qw[0];
        if (qn < 512) item_stage_issue(SR, A, qn, tid);
        if (swa) { const long tokb = (long)b * SEQ + blk * 128;
#pragma unroll 1
            for (int g = 0; g < 3; ++g) { const int hq = 3 * hh + g; bf16x8 q0, q1; const QRaw cq = g == 0 ? qa : (g == 1 ? qb : qc); q_finish(cq, A.gq, fq, q0, q1);
                attn_wave<10, true>(L, q0, q1, w & ~1, 16 * w, hq, A.sinks[hq], blk == 0, A.MIX + (tokb + 16 * w) * DM + 64 * hq, fr, fq); } }
        else {
#pragma unroll 1
            for (int u = 0; u < 2; ++u) { const long tokb = (long)b * SEQ + (2 * blk + u) * 128; bf16x8 q0, q1; const QRaw cq = u == 0 ? qa : qb; q_finish(cq, A.gmq, fq, q0, q1);
                attn_wave<16, false>(L, q0, q1, 0, 16 * w, 0, 0.f, false, A.MIX + (tokb + 16 * w) * DM + 768 + 64 * hh, fr, fq); } }
        AT_BAR();
        q = qn;
    }
}
}
constexpr int NWAVES = 8;
namespace mk {
#ifndef PROF_PH
#define PROF_PH -1
#endif
#ifndef PROF_N
#define PROF_N 1
#endif
#ifndef PROF_TA
#define PROF_TA -1
#endif
#ifndef PROF_TB
#define PROF_TB -1
#endif
#define REPEAT(k) for (int rep_ = 0; rep_ < ((PROF_PH) == (k) ? (PROF_N) : 1); ++rep_)
#ifndef FAST_RWKV
#define FAST_RWKV 1
#endif
#ifndef FAST_ATTN
#define FAST_ATTN 1
#endif

struct Args { const float* in[N_IN]; float* out; unsigned char* ws; int ph_lo, ph_hi; };

__device__ __forceinline__ unsigned pk2(float lo, float hi) { typedef float f2_t __attribute__((ext_vector_type(2))); typedef __bf16 b2_t __attribute__((ext_vector_type(2))); f2_t v = {lo, hi}; return __builtin_bit_cast(unsigned, __builtin_convertvector(v, b2_t)); }
__device__ __forceinline__ float wave_sum(float v) {
#pragma unroll
    for (int o = 1; o < 64; o <<= 1) v += __shfl_xor(v, o);
    return v;
}
template <int MODE> __device__ __forceinline__ void transpose_item(const float* W, const float* g, int K, int N, bf16_t* WT, LAS float* scr, int item, int lane) {
    const int nblk = N / 32, kb = item / nblk, nb = item % nblk, k0 = 64 * kb, n0 = 32 * nb;
    float tv[32];
#pragma unroll
    for (int i = 0; i < 32; ++i) tv[i] = W[(size_t)(k0 + 2 * i + (lane >> 5)) * N + n0 + (lane & 31)];
#pragma unroll
    for (int i = 0; i < 32; ++i) { const int kk = 2 * i + (lane >> 5); float v = tv[i]; if (g) v *= g[k0 + kk]; scr[kk * 33 + (lane & 31)] = v; }
    LDS_WAIT(); asm volatile("" ::: "memory");
    const int c = lane & 7;
#pragma unroll
    for (int j = 0; j < 4; ++j) { const int n = (lane >> 3) + 8 * j; const LAS float* s = scr + (8 * c) * 33 + n;
        v4u o; o.x = pk2(s[0 * 33], s[1 * 33]); o.y = pk2(s[2 * 33], s[3 * 33]); o.z = pk2(s[4 * 33], s[5 * 33]); o.w = pk2(s[6 * 33], s[7 * 33]);
        int nr = n0 + n; if (MODE == 2) nr = nr < 1920 ? nr : nr + 64;
        if (MODE == 1) nr = nr < 2816 ? 256 * (nr >> 7) + (nr & 127) : 256 * ((nr - 2816) >> 7) + 128 + ((nr - 2816) & 127);
        *(GAS v4u*)(WT + (size_t)nr * K + k0 + 8 * c) = o; }
    LDS_WAIT(); asm volatile("" ::: "memory");
}
template <int R> __device__ __forceinline__ void rows_to_bf16(const float* x, bf16_t* o, float* ssq, long row0, long rstride, int lane) {
    f32x4 v[R][4]; float s[R];
#pragma unroll
    for (int r = 0; r < R; ++r) { const GAS f32x4* xr = (const GAS f32x4*)(x + (row0 + r * rstride) * DM) + lane;
#pragma unroll
        for (int j = 0; j < 4; ++j) v[r][j] = xr[64 * j]; }
#pragma unroll
    for (int r = 0; r < R; ++r) { s[r] = 0.f;
#pragma unroll
        for (int j = 0; j < 4; ++j) s[r] += (v[r][j].x * v[r][j].x + v[r][j].y * v[r][j].y) + (v[r][j].z * v[r][j].z + v[r][j].w * v[r][j].w); }
#pragma unroll
    for (int o2 = 1; o2 < 64; o2 <<= 1) {
#pragma unroll
        for (int r = 0; r < R; ++r) s[r] += __shfl_xor(s[r], o2); }
#pragma unroll
    for (int r = 0; r < R; ++r) { GAS unsigned long long* o8 = (GAS unsigned long long*)(o + (row0 + r * rstride) * DM) + lane;
#pragma unroll
        for (int j = 0; j < 4; ++j) o8[64 * j] = (unsigned long long)pk2(v[r][j].x, v[r][j].y) | ((unsigned long long)pk2(v[r][j].z, v[r][j].w) << 32);
        if (lane == 0) ssq[row0 + r * rstride] = s[r]; }
}
__device__ __forceinline__ void row_to_bf16(const float* xrow, bf16_t* orow, float* ssq_out, int lane) {
    const GAS f32x4* xr = (const GAS f32x4*)xrow + lane; f32x4 v[4]; float s = 0.f;
#pragma unroll
    for (int j = 0; j < 4; ++j) { v[j] = xr[64 * j]; s += (v[j].x * v[j].x + v[j].y * v[j].y) + (v[j].z * v[j].z + v[j].w * v[j].w); }
    s = wave_sum(s);
    GAS unsigned long long* o8 = (GAS unsigned long long*)orow + lane;
#pragma unroll
    for (int j = 0; j < 4; ++j) o8[64 * j] = (unsigned long long)pk2(v[j].x, v[j].y) | ((unsigned long long)pk2(v[j].z, v[j].w) << 32);
    if (lane == 0) *ssq_out = s;
}

__global__ void __launch_bounds__(NWAVES * 64, 2) mk_fwd(Args args) {
    extern __shared__ __attribute__((aligned(16))) unsigned char lds[];
    LAS unsigned char* L = (LAS unsigned char*)lds;
    volatile LAS unsigned* MISC = (volatile LAS unsigned*)(L + MISC_OFF);
    const int tid0 = threadIdx.x; const int wave0 = __builtin_amdgcn_readfirstlane(tid0 >> 6);
    const int G = gridDim.x;
    unsigned char* ws = args.ws;
    gu32* ctl = (gu32*)(ws + WS_CTL);
    for (int u = tid0; u < (LDS_BYTES - LDSCTL_OFF) / 4; u += NWAVES * 64) ((LAS unsigned*)(L + LDSCTL_OFF))[u] = 0u;
    __syncthreads();
    XcdBarrier bar = xcd_barrier_post((unsigned*)(ctl + CW_BAR), MISC + 8);
    const int lo = args.ph_lo, hi = args.ph_hi;
    int ph = 0;
#define PH_BEGIN if (lo <= ph && ph < hi) { if ((PROF_TA) >= 0 && blockIdx.x == 0 && tid0 == 0) MISC[24 + ph] = (unsigned)__builtin_amdgcn_s_memrealtime(); unsigned char* wsp = args.ws; asm volatile("" : "+s"(wsp)); int tid = wave0 * 64 + (int)__builtin_amdgcn_mbcnt_hi(~0u, __builtin_amdgcn_mbcnt_lo(~0u, 0u)); asm volatile("" : "+v"(tid)); const int lane = tid & 63, wave = __builtin_amdgcn_readfirstlane(tid >> 6); const long gtid = (long)blockIdx.x * (NWAVES * 64) + tid; const int gw = blockIdx.x * NWAVES + wave; LAS float* scr = (LAS float*)(L + wave * 16384); (void)lane; (void)gtid; (void)gw; (void)scr;
#define PH_END   if (ph + 1 < hi) { xcd_barrier(bar); if ((PROF_PH) == 30 && ph == 3) for (int xb_ = 0; xb_ < 10; ++xb_) xcd_barrier(bar); } } ++ph;
    float* out = args.out;
#define SSQ_A ((float*)(wsp + WS_CTL + CTL_SSQ))
#define SSQ_B (SSQ_A + 3 * MTOK)
#define biastab ((float*)(wsp + WS_SMALL + SM_BIAS))
#define ssqm ((float*)(wsp + WS_SMALL + SM_SSQM))
#define MKV ((bf16_t*)(wsp + WS_SMALL + SM_MKV))
#define MEMB ((bf16_t*)(wsp + WS_MEMB))
#define Wt_in ((bf16_t*)(wsp + (l == 0 ? WS_WT + WT_IN : WS_WIN1)))
#define Wt_out ((bf16_t*)(wsp + WS_WT + WT_OUT))
#define Wt_up ((bf16_t*)(wsp + WS_WT + WT_UP))
#define Wt_down ((bf16_t*)(wsp + WS_WT + WT_DOWN))
#define Wt_mkv ((bf16_t*)(wsp + (l == 0 ? WS_WT + WT_MKV : WS_WIN1 + 4718592)))
#define XB ((bf16_t*)(wsp + WS_XB))
#define VF ((bf16_t*)(wsp + WS_VF))
#define PROJ ((bf16_t*)(wsp + WS_PROJ))
#define MIX ((bf16_t*)(wsp + WS_MIX))
#define U ((bf16_t*)(wsp + WS_U))
#define ACT ((bf16_t*)(wsp + WS_ACT))
#define PA ((size_t)MTOK * 384)
#define pR ((bf16_t*)(wsp + WS_PREP))
#define pK (pR + PA)
#define pV (pR + 2 * PA)
#define pKK (pR + 3 * PA)
#define pB (pR + 4 * PA)
#define pLD (pR + 5 * PA)
    const long gsize = (long)G * (NWAVES * 64);
    const int NGW = G * NWAVES;

#define MK_W() sk::RwkvW W{args.in[I_MU] + l * 1280, args.in[I_MUV], args.in[I_W0] + l * 384, args.in[I_W2] + l * 32 * 384, args.in[I_A0] + l * 384, args.in[I_A2] + l * 32 * 384, args.in[I_V0], args.in[I_V2], args.in[I_G2] + l * 64 * 384, args.in[I_KK] + l * 384, args.in[I_KA] + l * 384, args.in[I_RK] + l * 384, args.in[I_LNW] + l * 384, args.in[I_LNB] + l * 384};
#define MK_CBUF() const rw::ChunkBufs cbuf{(bf16_t*)(wsp + WS_PT), (bf16_t*)(wsp + WS_G), (float*)(wsp + WS_Z), (bf16_t*)(wsp + WS_YV), (bf16_t*)(wsp + WS_S0), (bf16_t*)(wsp + WS_VF), (float*)(wsp + WS_DOT), (const bf16_t*)(wsp + WS_SMALL + SM_W2T + l * SM_LORA_L), (const bf16_t*)(wsp + WS_SMALL + SM_A2T + l * SM_LORA_L), (const bf16_t*)(wsp + WS_SMALL + SM_V2T + l * SM_LORA_L), (const bf16_t*)(wsp + WS_SMALL + SM_G2T + l * SM_LORA_L)};
    for (int l = 0; l < 2; ++l) {
        const float* xin = l == 0 ? args.in[I_X] : out;
        if (l == 0) {
        PH_BEGIN
            REPEAT(0) {
            const int I_IN = 16 * 68, I_KV = 16 * 16, NIT = 2 * (I_IN + I_KV);
            for (int it = gw; it < NIT; it += NGW) {
                int r = it; const int ll = r >= I_IN + I_KV ? 1 : 0; r -= ll * (I_IN + I_KV);
                bf16_t* win = (bf16_t*)(wsp + (ll == 0 ? WS_WT + WT_IN : WS_WIN1)); bf16_t* wkv = (bf16_t*)(wsp + (ll == 0 ? WS_WT + WT_MKV : WS_WIN1 + 4718592));
                if (r < I_IN) transpose_item<2>(args.in[I_WIN] + (size_t)ll * 1024 * 2176, args.in[I_MIXG] + ll * 1024, 1024, 2176, win, scr, r, lane);
                else transpose_item<0>(args.in[I_WMKV] + (size_t)ll * 1024 * 512, args.in[I_MEMG] + ll * 1024, 1024, 512, wkv, scr, r - I_IN, lane);
            }
            for (long i = gtid; i < 2 * 128 * 1024; i += gsize) { const int ll = (int)(i >> 17), n = (int)(i >> 10) & 127, k = (int)(i & 1023); float v = 0.f;
                if (ll > 0 && n < 16) v = args.in[I_WINV][k * 16 + n] * args.in[I_MIXG][1024 + k];
                ((bf16_t*)(wsp + (ll == 0 ? WS_WT + WT_IN : WS_WIN1)))[(size_t)(n < 64 ? 1920 + n : 2176 + n) * 1024 + k] = f2bf(v); }
            for (long i = gtid; i < 2 * RP_SIZE; i += gsize) { const int ll = (int)(i / RP_SIZE), r = (int)(i % RP_SIZE); float v;
                if (r < RP_MUV) v = args.in[I_MU][ll * 1280 + r]; else if (r < RP_W0) v = args.in[I_MUV][r - RP_MUV]; else if (r < RP_A0) v = args.in[I_W0][ll * 384 + r - RP_W0];
                else if (r < RP_V0) v = args.in[I_A0][ll * 384 + r - RP_A0]; else if (r < RP_KK) v = args.in[I_V0][r - RP_V0]; else if (r < RP_KA) v = args.in[I_KK][ll * 384 + r - RP_KK];
                else if (r < RP_RK) v = args.in[I_KA][ll * 384 + r - RP_KA]; else if (r < RP_LNW) v = args.in[I_RK][ll * 384 + r - RP_RK]; else if (r < RP_LNB) v = args.in[I_LNW][ll * 384 + r - RP_LNW];
                else v = args.in[I_LNB][ll * 384 + r - RP_LNB];
                ((float*)(wsp + WS_SMALL + SM_RWP + ll * RWP_BYTES))[r] = v; }
            for (long i = gtid; i < 2 * 384 * 160; i += gsize) { const int ll = (int)(i / (384 * 160)), r2 = (int)(i % (384 * 160)), hc = r2 / 160, j = r2 % 160; bf16_t* sm = (bf16_t*)(wsp + WS_SMALL + ll * SM_LORA_L);
                if (j < 32) sm[SM_W2T / 2 + hc * 32 + j] = f2bf(args.in[I_W2][(size_t)ll * 32 * 384 + j * 384 + hc]);
                else if (j < 64) sm[SM_A2T / 2 + hc * 32 + (j - 32)] = f2bf(args.in[I_A2][(size_t)ll * 32 * 384 + (j - 32) * 384 + hc]);
                else if (j < 96) sm[SM_V2T / 2 + hc * 32 + (j - 64)] = f2bf((j - 64) < 16 ? args.in[I_V2][(j - 64) * 384 + hc] : 0.f);
                else sm[SM_G2T / 2 + hc * 64 + (j - 96)] = f2bf(args.in[I_G2][(size_t)ll * 64 * 384 + (j - 96) * 384 + hc]); }
            if (MTOK % (4 * NGW) == 0) { for (long m = gw; m < MTOK; m += 4L * NGW) rows_to_bf16<4>(args.in[I_X], XB, SSQ_A, m, NGW, lane); }
            else { for (int m = gw; m < MTOK; m += NGW) row_to_bf16(args.in[I_X] + (size_t)m * DM, XB + (size_t)m * DM, SSQ_A + m, lane); }
            for (int m = gw; m < 512; m += NGW) row_to_bf16(args.in[I_MEM] + (size_t)m * DM, MEMB + (size_t)m * DM, ssqm + m, lane);
            sk::d_biastab(args.in[I_RELB], biastab, gtid, gsize);
            }
        PH_END
        }
        PH_BEGIN
            REPEAT(1)
            { pg8::Gemm g{XB, Wt_in, MTOK, 2048, 1024}; pg8::StaticOrder S; S.init(MTOK, 2048, G, (int)blockIdx.x);
              pg8::EpiScaleBf16 E{PROJ, LDP, SSQ_A + (size_t)l * MTOK};
              pg8::gemm_phase<pg8::EpiScaleBf16, pg8::StaticOrder, true, true>(L, g, S, E, tid); }
        PH_END
        PH_BEGIN
            MK_W(); MK_CBUF(); (void)cbuf;
#if !FAST_ATTN
            sk::d_qknorm(PROJ, MTOK, LDP, args.in[I_AQN] + l * 64, args.in[I_AKN] + l * 64, args.in[I_MQN] + l * 64, 0, gtid, gsize);
            sk::d_qknorm(MKV, 512, 512, nullptr, nullptr, args.in[I_MKN] + l * 64, 1, gtid, gsize);
#endif
#if FAST_RWKV
            {
              const bool t8 = blockIdx.x < 64;
              const pg8::Gemm g = t8 ? pg8::Gemm{XB, Wt_in + (size_t)2048 * 1024, MTOK, 256, 1024} : pg8::Gemm{MEMB, Wt_mkv, 512, 512, 1024};
              pg8::StaticOrder S; if (t8) S.init(MTOK, 256, G, (int)blockIdx.x); else S.init(512, 512, G, (int)((blockIdx.x + 192) % G));
              const pg8::EpiScaleBf16 E = t8 ? pg8::EpiScaleBf16{PROJ + 2048, LDP, SSQ_A + (size_t)l * MTOK} : pg8::EpiScaleBf16{MKV, 512, ssqm};
              pg8::gemm_phase<pg8::EpiScaleBf16, pg8::StaticOrder, true, true>(L, g, S, E, tid); }
            { unsigned* qc = (unsigned*)(ctl + CW_CHQ + 64 * l);
              int q = rw::chunk_phase(L, wsp, l, tid, qc, MISC + 21);
              const int I_OUT = 16 * 32, I_UP = 16 * 176, I_DN = 44 * 32, NIT = I_OUT + I_UP + I_DN;
              for (;;) { const int it = (q - rw::NITEMS) * NWAVES + wave;
                  if ((q - rw::NITEMS) * NWAVES >= NIT) break;
                  if (it < NIT) { int r = it;
                      if (r < I_OUT) transpose_item<0>(args.in[I_WOUT] + (size_t)l * 1024 * 1024, nullptr, 1024, 1024, Wt_out, scr, r, lane);
                      else if (r < I_OUT + I_UP) transpose_item<1>(args.in[I_WUP] + (size_t)l * 1024 * 5632, args.in[I_FFNG] + l * 1024, 1024, 5632, Wt_up, scr, r - I_OUT, lane);
                      else transpose_item<0>(args.in[I_WDOWN] + (size_t)l * 2816 * 1024, nullptr, 2816, 1024, Wt_down, scr, r - I_OUT - I_UP, lane); }
                  __syncthreads(); if (tid == 0) MISC[21] = atomicAdd(qc, 1u); __syncthreads(); q = (int)MISC[21]; __syncthreads(); } }
#else
            sk::d_rwkv_prep(PROJ, W, l, VF, pR, pK, pV, pKK, pB, pLD, gtid, gsize);
#endif
        PH_END
        PH_BEGIN
            MK_CBUF(); (void)cbuf;
            if (blockIdx.x < 48) {
#if FAST_RWKV
                REPEAT(3) { __syncthreads(); if (tid < 8) MISC[16 + tid] = 0u; __syncthreads();
                  const int sbh = (int)blockIdx.x >> 2, stj = (int)blockIdx.x & 3;
                  if (wave == 0) rw::scan_compute(L, cbuf, sbh, stj, lane, MISC + 16); else if (wave < 4) rw::scan_loader(L, cbuf, sbh, stj, wave - 1, lane, MISC + 16);
 }
#endif
            } else {
#if FAST_ATTN
                const at::AttnArgs A{PROJ, MKV, MIX, biastab, args.in[I_SINK] + l * 6, args.in[I_AQN] + l * 64, args.in[I_AKN] + l * 64, args.in[I_MQN] + l * 64, args.in[I_MKN] + l * 64};
                at::attn_phase(L, A, (unsigned*)(ctl + CW_ATTQ + 64 * l), MISC + 20, tid);
#else
                const long gt2 = (long)(blockIdx.x - BATCH * 6) * (NWAVES * 64) + tid, gs2 = (long)(G - BATCH * 6) * (NWAVES * 64);
                REPEAT(7) sk::d_swa(PROJ, MIX, biastab, args.in[I_SINK] + l * 6, gt2, gs2);
                REPEAT(8) sk::d_memattn(PROJ, MKV, MIX, gt2, gs2);
#endif
            }
        PH_END
        PH_BEGIN
            MK_W(); MK_CBUF(); (void)cbuf;
#if FAST_RWKV
            REPEAT(4) rw::out_phase(L, wsp, l, tid, (int)blockIdx.x, G);
#else
            sk::d_rwkv_fin(PROJ, W, pR, pK, pV, MIX, gtid, gsize);
#endif
        PH_END
        PH_BEGIN
            if ((PROF_PH) == 31) { pg8::Gemm g2{MIX, Wt_out, MTOK, 1024, 1024}; pg8::StaticOrder S2; S2.init(MTOK, 1024, G, (int)blockIdx.x); pg8::EpiScaleBf16 E2{PROJ, 1024, SSQ_A}; pg8::gemm_phase<pg8::EpiScaleBf16, pg8::StaticOrder, true, true>(L, g2, S2, E2, tid); }
            pg8::Gemm g{MIX, Wt_out, MTOK, 1024, 1024}; pg8::StaticOrder S; S.init(MTOK, 1024, G, (int)blockIdx.x);
            pg8::EpiResid E{xin, out, XB, SSQ_B + (size_t)l * MTOK, 1024};
            pg8::gemm_phase<pg8::EpiResid, pg8::StaticOrder, true, true>(L, g, S, E, tid);
        PH_END
        PH_BEGIN
            REPEAT(5) {
            pg8::Gemm g{XB, Wt_up, 66 * 256, 5632, 1024}; pg8::StaticOrder S; S.init(66 * 256, 5632, G, (int)blockIdx.x);
            pg8::EpiConvAct E{ACT, SSQ_B + (size_t)l * MTOK, args.in[I_CW] + (size_t)l * 3 * 5632, args.in[I_CB] + (size_t)l * 5632};
            pg8::gemm_phase<pg8::EpiConvAct, pg8::StaticOrder, true, true>(L, g, S, E, tid); }
        PH_END
        PH_BEGIN
            if ((PROF_PH) == 32) { pg8::Gemm g2{ACT, Wt_down, MTOK, 1024, 2816}; pg8::StaticOrder S2; S2.init(MTOK, 1024, G, (int)blockIdx.x); pg8::EpiScaleBf16 E2{PROJ, 1024, SSQ_A}; pg8::gemm_phase<pg8::EpiScaleBf16, pg8::StaticOrder, true, true>(L, g2, S2, E2, tid); }
            pg8::Gemm g{ACT, Wt_down, MTOK, 1024, 2816}; pg8::StaticOrder S; S.init(MTOK, 1024, G, (int)blockIdx.x);
            pg8::EpiResid E{out, out, XB, SSQ_A + (size_t)(l + 1) * MTOK, 1024};
            pg8::gemm_phase<pg8::EpiResid, pg8::StaticOrder, true, true>(L, g, S, E, tid);
        PH_END
    }
    if ((PROF_TA) >= 0 && blockIdx.x == 0 && tid0 == 0) {
        MISC[24 + ph] = (unsigned)__builtin_amdgcn_s_memrealtime();
        const unsigned ta = MISC[24 + (PROF_TA) + 1] - MISC[24 + (PROF_TA)], tb = (PROF_TB) >= 0 ? MISC[24 + (PROF_TB) + 1] - MISC[24 + (PROF_TB)] : 0u;
        const unsigned long long extra = (unsigned long long)ta + 1000ull * (unsigned long long)(((tb + 50u) / 100u) * 100u);
        const unsigned long long t0 = __builtin_amdgcn_s_memrealtime(); while (__builtin_amdgcn_s_memrealtime() - t0 < extra) __builtin_amdgcn_s_sleep(32);
    }
#undef PH_BEGIN
#undef PH_END
}
constexpr int N_PHASES = 1 + 2 * 7;
}

#ifndef MK_PER_PHASE
#define MK_PER_PHASE 0
#endif
extern "C" void kernel_launch(void* const* d_in, const int* in_sizes, int n_in, void* d_out, int out_size, void* d_ws, size_t ws_size, hipStream_t stream) {
    static int grid = 0;
    if (grid == 0) {
        if (n_in != N_IN || out_size != MTOK * DM || ws_size < mk::WS_END) { fprintf(stderr, "kernel_launch: unexpected shapes (n_in %d out %d ws %zu)\n", n_in, out_size, ws_size); grid = -1; return; }
        int dev = 0, cus = 0, per_cu = 0;
        if (hipGetDevice(&dev) != hipSuccess || hipDeviceGetAttribute(&cus, hipDeviceAttributeMultiprocessorCount, dev) != hipSuccess) { grid = -1; return; }
        if (hipFuncSetAttribute((const void*)mk::mk_fwd, hipFuncAttributeMaxDynamicSharedMemorySize, mk::LDS_BYTES) != hipSuccess) { fprintf(stderr, "kernel_launch: hipFuncSetAttribute failed\n"); grid = -1; return; }
        if (hipOccupancyMaxActiveBlocksPerMultiprocessor(&per_cu, (const void*)mk::mk_fwd, NWAVES * 64, mk::LDS_BYTES) != hipSuccess || per_cu < 1) { fprintf(stderr, "kernel_launch: occupancy query says %d blocks per CU\n", per_cu); }
        (void)hipGetLastError();
        grid = cus;
    }
    if (grid < 0) return;
    if (hipMemsetAsync((char*)d_ws + mk::WS_CTL, 0, mk::CTL_ZERO_BYTES, stream) != hipSuccess) return;
    mk::Args a{};
    for (int i = 0; i < N_IN; ++i) a.in[i] = (const float*)d_in[i];
    a.out = (float*)d_out; a.ws = (unsigned char*)d_ws;
#if MK_PER_PHASE
    for (int p = 0; p < mk::N_PHASES; ++p) { a.ph_lo = p; a.ph_hi = p + 1; hipLaunchKernelGGL(mk::mk_fwd, dim3(grid), dim3(NWAVES * 64), mk::LDS_BYTES, stream, a); }
#else
    a.ph_lo = 0; a.ph_hi = mk::N_PHASES;
    hipLaunchKernelGGL(mk::mk_fwd, dim3(grid), dim3(NWAVES * 64), mk::LDS_BYTES, stream, a);
#endif
}
```

```cpp
#define MK_BUILD 1
#ifndef HOST_SIM
#include <hip/hip_runtime.h>
#include <cstdio>
#include <cstdint>
#endif
#ifndef SEQ_LEN
#define SEQ_LEN 8192
#endif
typedef unsigned short bf16_t;
constexpr int BATCH = 2, SEQ = SEQ_LEN, DM = 1024, MTOK = BATCH * SEQ, DFF = 2816, LDP = 2304  ;
constexpr float EPS = 1e-6f, GN_EPS = 64e-5f;
__host__ __device__ __forceinline__ float bf2f(bf16_t h) { unsigned u = (unsigned)h << 16; return __builtin_bit_cast(float, u); }
__host__ __device__ __forceinline__ bf16_t f2bf(float f) { unsigned u = __builtin_bit_cast(unsigned, f); return (bf16_t)((u + 0x7fffu + ((u >> 16) & 1u)) >> 16); }
__host__ __device__ __forceinline__ int t5_bucket(int dist) {
    if (dist < 16) return dist;
    const float v = logf((float)dist / 16.0f) / 2.0794415416798357f * 16.0f;
    int large = 16 + (int)v; return large < 31 ? large : 31;
}
constexpr size_t MiB = 1u << 20;
enum { I_X = 0, I_MEM, I_RELB, I_MIXG, I_WIN, I_WINV, I_AQN, I_AKN, I_SINK, I_MU, I_MUV, I_W0, I_W2, I_A0, I_A2, I_V0, I_V2, I_G2, I_KK, I_KA, I_RK, I_LNW, I_LNB, I_MEMG, I_WMKV, I_MQN, I_MKN, I_WOUT, I_FFNG, I_WUP, I_CW, I_CB, I_WDOWN, N_IN };
#ifndef PROF_PH
#define PROF_PH -1
#endif
#ifndef PROF_N
#define PROF_N 1
#endif
namespace sk {

__device__ __forceinline__ void d_wt(const float* W, const float* g, bf16_t* Wt, int K, int N, int Npad, long gtid, long gsize) {
    const long total = (long)Npad * K;
    for (long idx = gtid; idx < total; idx += gsize) {
        const int n = (int)(idx / K), k = (int)(idx % K);
        float v = 0.f;
        if (n < N) { v = W[(long)k * N + n]; if (g) v *= g[k]; }
        Wt[idx] = f2bf(v);
    }
}
#ifndef MK_BUILD
__global__ void k_wt(const float* W, const float* g, bf16_t* Wt, int K, int N, int Npad) { d_wt(W, g, Wt, K, N, Npad, (long)blockIdx.x * blockDim.x + threadIdx.x, (long)gridDim.x * blockDim.x); }
#endif
__device__ __forceinline__ void d_rowprep(const float* x, bf16_t* xb, float* ssq, int rows, long gtid, long gsize) {
    for (long r = gtid; r < rows; r += gsize) {
        const float* xr = x + (long)r * DM; bf16_t* o = xb + (long)r * DM; float s = 0.f;
        for (int c = 0; c < DM; ++c) { const float v = xr[c]; s += v * v; o[c] = f2bf(v); }
        ssq[r] = s;
    }
}
#ifndef MK_BUILD
__global__ void k_rowprep(const float* x, bf16_t* xb, float* ssq, int rows) { d_rowprep(x, xb, ssq, rows, (long)blockIdx.x * blockDim.x + threadIdx.x, (long)gridDim.x * blockDim.x); }
#endif
__device__ __forceinline__ void d_biastab(const float* rel_bias, float* tab, long gtid, long gsize) {
        for (long i = gtid; i < 128 * 6; i += gsize) { const int dist = i / 6, hq = i % 6; tab[i] = rel_bias[t5_bucket(dist) * 6 + hq]; }
}
#ifndef MK_BUILD
__global__ void k_biastab(const float* rel_bias, float* tab) { d_biastab(rel_bias, tab, (long)blockIdx.x * blockDim.x + threadIdx.x, (long)gridDim.x * blockDim.x); }
#endif
__device__ __forceinline__ void d_qknorm(bf16_t* P, int rows, int ld, const float* gq, const float* gk, const float* gm, int mode, long gtid, long gsize) {
    const int nj = mode == 0 ? 12 : 4;
    const long total = (long)rows * nj;
    for (long idx = gtid; idx < total; idx += gsize) {
        const int row = (int)(idx / nj), j = (int)(idx % nj);
        int col; const float* g;
        if (mode == 0) { if (j < 6) { col = 64 * j; g = gq; } else if (j < 8) { col = 384 + 64 * (j - 6); g = gk; } else { col = 1920 + 64 * (j - 8); g = gm; } }
        else { col = 64 * j; g = gm; }
        bf16_t* p = P + (long)row * ld + col; float s = 0.f;
        for (int d = 0; d < 64; ++d) { const float v = bf2f(p[d]); s += v * v; }
        const float rs = 1.0f / sqrtf(s * (1.0f / 64.0f) + EPS);
        for (int d = 0; d < 64; ++d) p[d] = f2bf(bf2f(p[d]) * rs * g[d]);
    }
}
#ifndef MK_BUILD
__global__ void k_qknorm(bf16_t* P, int rows, int ld, const float* gq, const float* gk, const float* gm, int mode) { d_qknorm(P, rows, ld, gq, gk, gm, mode, (long)blockIdx.x * blockDim.x + threadIdx.x, (long)gridDim.x * blockDim.x); }
#endif
__device__ __forceinline__ void d_swa(const bf16_t* P, bf16_t* MIX, const float* biastab, const float* sinks, long gtid, long gsize) {
    const long total = (long)MTOK * 6;
    for (long idx = gtid; idx < total; idx += gsize) {
        const int tok = (int)(idx / 6), hq = (int)(idx % 6), hkv = hq / 3, t = tok % SEQ;
        float q[64], o[64];
#pragma unroll
        for (int d = 0; d < 64; ++d) { q[d] = bf2f(P[(long)tok * LDP + 64 * hq + d]) * 0.125f; o[d] = 0.f; }
        float m = sinks[hq], l = 1.0f;
        const int j0 = t - 127 < 0 ? 0 : t - 127;
        for (int j = j0; j <= t; ++j) {
            const bf16_t* kr = P + (long)(tok - (t - j)) * LDP + 384 + 64 * hkv; const bf16_t* vr = kr + 128;
            float s = 0.f;
#pragma unroll
            for (int d = 0; d < 64; ++d) s += q[d] * bf2f(kr[d]);
            s += biastab[(t - j) * 6 + hq];
            const float mn = fmaxf(m, s), f = expf(m - mn), e = expf(s - mn);
            l = l * f + e; m = mn;
#pragma unroll
            for (int d = 0; d < 64; ++d) o[d] = o[d] * f + e * bf2f(vr[d]);
        }
        const float inv = 1.0f / l;
#pragma unroll
        for (int d = 0; d < 64; ++d) MIX[(long)tok * DM + 64 * hq + d] = f2bf(o[d] * inv);
    }
}
#ifndef MK_BUILD
__global__ __launch_bounds__(256) void k_swa(const bf16_t* P, bf16_t* MIX, const float* biastab, const float* sinks) { d_swa(P, MIX, biastab, sinks, (long)blockIdx.x * blockDim.x + threadIdx.x, (long)gridDim.x * blockDim.x); }
#endif
__device__ __forceinline__ void d_memattn(const bf16_t* P, const bf16_t* MKV, bf16_t* MIX, long gtid, long gsize) {
    const long total = (long)MTOK * 4;
    for (long idx = gtid; idx < total; idx += gsize) {
        const int tok = (int)(idx / 4), h = (int)(idx % 4), b = tok / SEQ;
        float q[64], o[64];
#pragma unroll
        for (int d = 0; d < 64; ++d) { q[d] = bf2f(P[(long)tok * LDP + 1920 + 64 * h + d]) * 0.125f; o[d] = 0.f; }
        float m = -1e30f, l = 0.f;
        for (int j = 0; j < 256; ++j) {
            const bf16_t* kr = MKV + (long)(b * 256 + j) * 512 + 64 * h; const bf16_t* vr = kr + 256;
            float s = 0.f;
#pragma unroll
            for (int d = 0; d < 64; ++d) s += q[d] * bf2f(kr[d]);
            const float mn = fmaxf(m, s), f = expf(m - mn), e = expf(s - mn);
            l = l * f + e; m = mn;
#pragma unroll
            for (int d = 0; d < 64; ++d) o[d] = o[d] * f + e * bf2f(vr[d]);
        }
        const float inv = 1.0f / l;
#pragma unroll
        for (int d = 0; d < 64; ++d) MIX[(long)tok * DM + 768 + 64 * h + d] = f2bf(o[d] * inv);
    }
}
#ifndef MK_BUILD
__global__ __launch_bounds__(256) void k_memattn(const bf16_t* P, const bf16_t* MKV, bf16_t* MIX) { d_memattn(P, MKV, MIX, (long)blockIdx.x * blockDim.x + threadIdx.x, (long)gridDim.x * blockDim.x); }
#endif
__device__ __forceinline__ float shifted(const bf16_t* P, int tok, int col, float mu) {
    const float p = bf2f(P[(long)tok * LDP + col]);
    const float prev = (tok % SEQ) == 0 ? 0.f : bf2f(P[(long)(tok - 1) * LDP + col]);
    return p + mu * (prev - p);
}
struct RwkvW { const float *mu, *mu_v, *w0, *w2, *a0, *a2, *v0, *v2, *g2, *k_k, *k_a, *r_k, *ln_w, *ln_b; };
__device__ __forceinline__ void d_rwkv_prep(const bf16_t* P, RwkvW W, int layer, bf16_t* VFIRST, bf16_t* R, bf16_t* K, bf16_t* V, bf16_t* KK, bf16_t* B, bf16_t* LOGD, long gtid, long gsize) {
    const long total = (long)MTOK * 6;
    for (long idx = gtid; idx < total; idx += gsize) {
        const int tok = (int)(idx / 6), h = (int)(idx % 6);
        float nrm = 0.f;
        for (int c = 0; c < 64; ++c) { const int hc = 64 * h + c; const float kc = shifted(P, tok, 640 + 384 + hc, W.mu[384 + hc]) * W.k_k[hc]; nrm += kc * kc; }
        const float rn = 1.0f / fmaxf(sqrtf(nrm), 1e-12f);
        for (int c = 0; c < 64; ++c) {
            const int hc = 64 * h + c; const long o = (long)tok * 384 + hc;
            const float r = shifted(P, tok, 640 + hc, W.mu[hc]);
            const float k = shifted(P, tok, 640 + 384 + hc, W.mu[384 + hc]);
            float v = shifted(P, tok, 640 + 768 + hc, W.mu[768 + hc]);
            float wp = W.w0[hc], ap = W.a0[hc];
            for (int j = 0; j < 32; ++j) {
                wp += tanhf(shifted(P, tok, 640 + 1152 + j, W.mu[1152 + j])) * W.w2[j * 384 + hc];
                ap += shifted(P, tok, 640 + 1184 + j, W.mu[1184 + j]) * W.a2[j * 384 + hc];
            }
            const float z = -wp; const float sp = fmaxf(z, 0.f) + log1pf(expf(-fabsf(z)));
            const float w = -sp - 0.5f;
            const float a = 1.0f / (1.0f + expf(-ap));
            if (layer > 0) {
                float vp = W.v0[hc];
                for (int j = 0; j < 16; ++j) vp += shifted(P, tok, 2176 + j, W.mu_v[j]) * W.v2[j * 384 + hc];
                const float vf = bf2f(VFIRST[o]);
                v = v + (vf - v) * (1.0f / (1.0f + expf(-vp)));
            } else VFIRST[o] = f2bf(v);
            const float kk = k * W.k_k[hc] * rn;
            R[o] = f2bf(r); K[o] = f2bf(k * (1.0f + (a - 1.0f) * W.k_a[hc])); V[o] = f2bf(v);
            KK[o] = f2bf(kk); B[o] = f2bf(kk * a); LOGD[o] = f2bf(-expf(w));
        }
    }
}
#ifndef MK_BUILD
__global__ void k_rwkv_prep(const bf16_t* P, RwkvW W, int layer, bf16_t* VFIRST, bf16_t* R, bf16_t* K, bf16_t* V, bf16_t* KK, bf16_t* B, bf16_t* LOGD) { d_rwkv_prep(P, W, layer, VFIRST, R, K, V, KK, B, LOGD, (long)blockIdx.x * blockDim.x + threadIdx.x, (long)gridDim.x * blockDim.x); }
#endif
__device__ __forceinline__ void d_rwkv_scan(const bf16_t* R, const bf16_t* K, const bf16_t* V, const bf16_t* KK, const bf16_t* B, const bf16_t* LOGD, bf16_t* MIX, int bh, int i) {
    const int b = bh / 6, h = bh % 6;
    float s[64];
#pragma unroll
    for (int k = 0; k < 64; ++k) s[k] = 0.f;
    for (int t = 0; t < SEQ; ++t) {
        const long o = (long)(b * SEQ + t) * 384 + 64 * h;
        float sa = 0.f;
#pragma unroll
        for (int k = 0; k < 64; ++k) sa -= s[k] * bf2f(KK[o + k]);
        const float v = bf2f(V[o + i]); float y = 0.f;
#pragma unroll
        for (int k = 0; k < 64; ++k) { s[k] = s[k] * expf(bf2f(LOGD[o + k])) + sa * bf2f(B[o + k]) + v * bf2f(K[o + k]); y += s[k] * bf2f(R[o + k]); }
        MIX[(long)(b * SEQ + t) * DM + 384 + 64 * h + i] = f2bf(y);
    }
}
#ifndef MK_BUILD
__global__ void k_rwkv_scan(const bf16_t* R, const bf16_t* K, const bf16_t* V, const bf16_t* KK, const bf16_t* B, const bf16_t* LOGD, bf16_t* MIX) { d_rwkv_scan(R, K, V, KK, B, LOGD, MIX, blockIdx.x, threadIdx.x); }
#endif
__device__ __forceinline__ void d_rwkv_fin(const bf16_t* P, RwkvW W, const bf16_t* R, const bf16_t* K, const bf16_t* V, bf16_t* MIX, long gtid, long gsize) {
    const long total = (long)MTOK * 6;
    for (long idx = gtid; idx < total; idx += gsize) {
        const int tok = (int)(idx / 6), h = (int)(idx % 6);
        bf16_t* y = MIX + (long)tok * DM + 384 + 64 * h; const long o = (long)tok * 384 + 64 * h;
        float mean = 0.f, dot = 0.f;
        for (int c = 0; c < 64; ++c) { mean += bf2f(y[c]); dot += bf2f(R[o + c]) * bf2f(K[o + c]) * W.r_k[64 * h + c]; }
        mean *= (1.0f / 64.0f); float var = 0.f;
        for (int c = 0; c < 64; ++c) { const float d = bf2f(y[c]) - mean; var += d * d; }
        const float rstd = 1.0f / sqrtf(var * (1.0f / 64.0f) + GN_EPS);
        for (int c = 0; c < 64; ++c) {
            const int hc = 64 * h + c; float g = 0.f;
            for (int j = 0; j < 64; ++j) g += (1.0f / (1.0f + expf(-shifted(P, tok, 640 + 1216 + j, W.mu[1216 + j])))) * W.g2[j * 384 + hc];
            const float yn = (bf2f(y[c]) - mean) * rstd * W.ln_w[hc] + W.ln_b[hc];
            y[c] = f2bf((yn + dot * bf2f(V[o + c])) * g);
        }
    }
}
#ifndef MK_BUILD
__global__ void k_rwkv_fin(const bf16_t* P, RwkvW W, const bf16_t* R, const bf16_t* K, const bf16_t* V, bf16_t* MIX) { d_rwkv_fin(P, W, R, K, V, MIX, (long)blockIdx.x * blockDim.x + threadIdx.x, (long)gridDim.x * blockDim.x); }
#endif
__device__ __forceinline__ void d_conv_act(const bf16_t* U, const float* cw, const float* cb, bf16_t* ACT, int rows, long gtid, long gsize) {
    const long total = (long)rows * DFF;
    for (long idx = gtid; idx < total; idx += gsize) {
        const int t = (int)(idx / DFF), c = (int)(idx % DFF);
        float gate = cb[c], val = cb[DFF + c];
#pragma unroll
        for (int i = 0; i < 3; ++i) { const int tt = t - 2 + i; if (tt >= 0) { gate += cw[i * 2 * DFF + c] * bf2f(U[(long)tt * 2 * DFF + c]); val += cw[i * 2 * DFF + DFF + c] * bf2f(U[(long)tt * 2 * DFF + DFF + c]); } }
        ACT[(long)t * DFF + c] = f2bf(gate / (1.0f + expf(-gate)) * val);
    }
}
#ifndef MK_BUILD
__global__ void k_conv_act(const bf16_t* U, const float* cw, const float* cb, bf16_t* ACT, int rows) { d_conv_act(U, cw, cb, ACT, rows, (long)blockIdx.x * blockDim.x + threadIdx.x, (long)gridDim.x * blockDim.x); }
#endif
}
namespace pg8 {
#define PG8_LAS __attribute__((address_space(3)))
typedef unsigned short bf16_t;
typedef short bf16x8 __attribute__((ext_vector_type(8)));
typedef float f32x4 __attribute__((ext_vector_type(4)));
typedef unsigned u32x4 __attribute__((ext_vector_type(4)));
constexpr int BM = 256, BK = 64, HALF = 128, HTB = HALF * BK * 2  , STAGE_BYTES = 8 * HTB, NXCD = 8, WGM = 8;

__host__ __device__ __forceinline__ int lds_byte(int r, int c) { const int st = (r >> 4) * 2 + (c >> 5), rr = r & 15, cc = c & 31, ob = rr * 64 + cc * 2; return st * 1024 + (ob ^ (((ob >> 9) & 1) << 5)); }
__host__ __device__ __forceinline__ void stage_rc(int b, int& R, int& C) { const int st = b / 1024, sb = b % 1024, swz = sb ^ (((sb >> 9) & 1) << 5); R = (st >> 1) * 16 + swz / 64; C = (st & 1) * 32 + (swz % 64) / 2; }
__host__ __device__ __forceinline__ int perm32(int rho) { const int n = rho >> 4, i = rho & 15; return 8 * (i >> 2) + 4 * n + (i & 3); }

struct Unit { int pm, pn; };
struct Gemm { const bf16_t* A; const bf16_t* Bt; int M, N, K; };

struct StaticOrder {
    int nM, nN, nwg, G, c;
    __host__ __device__ void init(int M, int N, int G_, int c_) { nM = M / BM; nN = N / BM; nwg = nM * nN; G = G_; c = c_; }
    __host__ __device__ bool next(int i, Unit& u) const {
        const long L = (long)i * G + c; if (L >= nwg) return false;
        int wgid = (int)L; { const int q = nwg / NXCD, r = nwg % NXCD, xcd = wgid % NXCD, off = wgid / NXCD; wgid = (xcd < r ? xcd * (q + 1) : r * (q + 1) + (xcd - r) * q) + off; }
        const int nig = WGM * nN, gid = wgid / nig, fm = gid * WGM, gsz = (nM - fm) < WGM ? (nM - fm) : WGM;
        u.pm = fm + ((wgid % nig) % gsz); u.pn = (wgid % nig) / gsz; return true;
    }
    __device__ __forceinline__ void a_ready(const Unit&) const {}
    __device__ __forceinline__ void done(const Unit&) const {}
};

__device__ __forceinline__ unsigned cvt_pk_bf16(float lo, float hi) { unsigned r; asm volatile("v_cvt_pk_bf16_f32 %0, %1, %2" : "=v"(r) : "v"(lo), "v"(hi)); return r; }
struct EpiScaleBf16 {
    static constexpr bool PERM = true, AFTER_DRAIN = false; static constexpr int AMAP = 0;
    bf16_t* O; int ldc; const float* ssq;
    __device__ __forceinline__ void operator()(const f32x4 (&acc)[2][2][4][2], const Unit& u, int wr, int wc, int fr, int fq) const {
        const int row0 = u.pm * BM + wr * 64 + fr, col0 = u.pn * BM + wc * 32 + 8 * fq;
#pragma unroll
        for (int ai = 0; ai < 2; ++ai)
#pragma unroll
            for (int m = 0; m < 4; ++m) { const int row = row0 + ai * HALF + m * 16; const float sc = __builtin_amdgcn_rsqf(ssq[row] * (1.0f / 1024.0f) + 1e-6f);
                bf16_t* rowp = O + (size_t)row * ldc + col0;
#pragma unroll
                for (int bj = 0; bj < 2; ++bj) { const f32x4 v0 = acc[ai][bj][m][0] * sc, v1 = acc[ai][bj][m][1] * sc;
                    u32x4 w; w.x = cvt_pk_bf16(v0[0], v0[1]); w.y = cvt_pk_bf16(v0[2], v0[3]); w.z = cvt_pk_bf16(v1[0], v1[1]); w.w = cvt_pk_bf16(v1[2], v1[3]);
                    *(u32x4*)(rowp + bj * HALF) = w; } }
    }
};
template <bool FINAL> struct EpiResid {
    static constexpr bool PERM = false, AFTER_DRAIN = false; static constexpr int AMAP = 0;
    float* out; bf16_t* xb; float* ssq; int ldc;
    __device__ __forceinline__ void operator()(const f32x4 (&acc)[2][2][4][2], const Unit& u, int wr, int wc, int fr, int fq) const {
        typedef unsigned u32x2v __attribute__((ext_vector_type(2)));
        const int col0 = u.pn * BM + wc * 32 + 4 * fq;
#pragma unroll
        for (int ai = 0; ai < 2; ++ai) {
            u32x2v bs[4][2][2];
#pragma unroll
            for (int m = 0; m < 4; ++m) { const size_t off = (size_t)(u.pm * BM + ai * HALF + wr * 64 + m * 16 + fr) * ldc + col0;
#pragma unroll
                for (int bj = 0; bj < 2; ++bj)
#pragma unroll
                    for (int n = 0; n < 2; ++n) bs[m][bj][n] = *(const u32x2v*)(xb + off + bj * HALF + n * 16); }
#pragma unroll
            for (int m = 0; m < 4; ++m) { const int row = u.pm * BM + ai * HALF + wr * 64 + m * 16 + fr; const size_t off = (size_t)row * ldc + col0; float sq = 0.f;
#pragma unroll
                for (int bj = 0; bj < 2; ++bj)
#pragma unroll
                    for (int n = 0; n < 2; ++n) { const u32x2v b2 = bs[m][bj][n];
                        f32x4 o = {__builtin_bit_cast(float, b2.x << 16), __builtin_bit_cast(float, b2.x & 0xffff0000u), __builtin_bit_cast(float, b2.y << 16), __builtin_bit_cast(float, b2.y & 0xffff0000u)};
                        o = o + acc[ai][bj][m][n];
                        if (FINAL) *(f32x4*)(out + off + bj * HALF + n * 16) = o;
                        else { u32x2v w; w.x = cvt_pk_bf16(o[0], o[1]); w.y = cvt_pk_bf16(o[2], o[3]); *(u32x2v*)(xb + off + bj * HALF + n * 16) = w;
                            const float r0 = __builtin_bit_cast(float, w.x << 16), r1 = __builtin_bit_cast(float, w.x & 0xffff0000u), r2 = __builtin_bit_cast(float, w.y << 16), r3 = __builtin_bit_cast(float, w.y & 0xffff0000u);
                            sq += (r0 * r0 + r1 * r1) + (r2 * r2 + r3 * r3); } }
                if (!FINAL) { sq += __shfl_xor(sq, 16); sq += __shfl_xor(sq, 32); if (fq == 0) atomicAdd(ssq + row, sq); } } }
    }
};
struct EpiConvAct {
    static constexpr bool PERM = true, AFTER_DRAIN = false; static constexpr int AMAP = 1;
    bf16_t* ACT; const float* ssq; const float* cw; const float* cb;
    static __device__ __forceinline__ float shr1s(float x) { float r; asm volatile("s_nop 1\n\tv_mov_b32_dpp %0, %1 row_shr:1 row_mask:0xf bank_mask:0xf bound_ctrl:1" : "=v"(r) : "v"(x)); return r; }
    static __device__ __forceinline__ f32x4 shr1(f32x4 v) { f32x4 r; r[0] = shr1s(v[0]); r[1] = shr1s(v[1]); r[2] = shr1s(v[2]); r[3] = shr1s(v[3]); return r; }
    __device__ __forceinline__ void operator()(const f32x4 (&acc)[2][2][4][2], const Unit& u, int wr, int wc, int fr, int fq) const {
        const int b = u.pm / 33, pmb = u.pm % 33;
        const int pos0 = 252 * pmb + 126 * wr + 8 * fr - 2;
        const long row0 = (long)b * SEQ + pos0;
        float rs[8];
#pragma unroll
        for (int j = 0; j < 8; ++j) { const int pos = pos0 + j; const bool ok = pos >= 0 && pos < SEQ; const float q = ssq[ok ? row0 + j : 0]; rs[j] = ok ? __builtin_amdgcn_rsqf(q * (1.0f / 1024.0f) + 1e-6f) : 0.f; }
        const int ch0 = 128 * u.pn + 32 * wc + 8 * fq;
        unsigned ow[8][4];
#pragma unroll
        for (int n = 0; n < 2; ++n) { const int c = ch0 + 4 * n;
            const f32x4 w0g = *(const f32x4*)(cw + c), w1g = *(const f32x4*)(cw + 5632 + c), w2g = *(const f32x4*)(cw + 2 * 5632 + c), bg = *(const f32x4*)(cb + c);
            const f32x4 w0v = *(const f32x4*)(cw + 2816 + c), w1v = *(const f32x4*)(cw + 5632 + 2816 + c), w2v = *(const f32x4*)(cw + 2 * 5632 + 2816 + c), bv = *(const f32x4*)(cb + 2816 + c);
            f32x4 gm2 = shr1(acc[1][0][2][n] * rs[6]), gm1 = shr1(acc[1][0][3][n] * rs[7]), vm2 = shr1(acc[1][1][2][n] * rs[6]), vm1 = shr1(acc[1][1][3][n] * rs[7]);
#pragma unroll
            for (int j = 0; j < 8; ++j) { const f32x4 gj = acc[j >> 2][0][j & 3][n] * rs[j], vj = acc[j >> 2][1][j & 3][n] * rs[j];
                const f32x4 ug = bg + w0g * gm2 + w1g * gm1 + w2g * gj, uv = bv + w0v * vm2 + w1v * vm1 + w2v * vj; f32x4 a;
#pragma unroll
                for (int e = 0; e < 4; ++e) a[e] = ug[e] * __builtin_amdgcn_rcpf(1.0f + __expf(-ug[e])) * uv[e];
                ow[j][2 * n] = cvt_pk_bf16(a[0], a[1]); ow[j][2 * n + 1] = cvt_pk_bf16(a[2], a[3]);
                gm2 = gm1; gm1 = gj; vm2 = vm1; vm1 = vj; } }
#pragma unroll
        for (int j = 0; j < 8; ++j) if (8 * fr + j >= 2 && pos0 + j < SEQ) { u32x4 w; w.x = ow[j][0]; w.y = ow[j][1]; w.z = ow[j][2]; w.w = ow[j][3]; *(u32x4*)(ACT + (size_t)(row0 + j) * 2816 + ch0) = w; }
    }
};
template <class Epi, class Sched, bool ALIGN_EPI = false, bool SP2 = false>
__device__ __forceinline__ void gemm_phase(PG8_LAS unsigned char* lds, const Gemm g, const Sched& S, const Epi& E, int tid_in) {
    int tid = tid_in; asm volatile("" : "+v"(tid));
    const int wid = __builtin_amdgcn_readfirstlane(tid >> 6), lane = tid & 63, wr = wid >> 2, wc = wid & 3, fr = lane & 15, fq = lane >> 4;
    const int K = g.K, nt = K / BK;
    unsigned voffA[2], voffB[2];
#pragma unroll
    for (int i = 0; i < 2; ++i) { int R, C; stage_rc(tid * 16 + i * 8192, R, C); const int Rb = Epi::PERM ? ((R & ~31) + perm32(R & 31)) : R;
        const int Ra = Epi::AMAP ? (126 * (R >> 6) + 8 * (R & 15) + ((R >> 4) & 3)) : R;
        voffA[i] = (unsigned)(Ra * K + C) * 2u; voffB[i] = (unsigned)(Rb * K + C) * 2u; }
    const size_t kstep = (size_t)(BK * 2);
    const size_t hstepB = (size_t)HALF * K * 2;
    const size_t hstepA = Epi::AMAP ? (size_t)4 * K * 2 : hstepB;
    const size_t tstep = 2 * hstepB;
#define PG8_ABASE(pm_) (Epi::AMAP ? (long)((long)((pm_) / 33) * SEQ + 252 * ((pm_) % 33) - 2) * (long)K * 2 : (long)(pm_) * (long)tstep)
    const unsigned ldsw = (unsigned)wid * 1024u;
    const int aoff = lds_byte(wr * 64 + fr, fq * 8), boff = lds_byte(wc * 32 + fr, fq * 8);
#define PG8_SA(b, h) (((b) * 2 + (h)) * HTB)
#define PG8_SB(b, h) ((4 + (b) * 2 + (h)) * HTB)
#define PG8_STAGE(bufoff, gbase, voff) do { _Pragma("unroll") for (int _i = 0; _i < 2; ++_i) \
        __builtin_amdgcn_global_load_lds((const unsigned*)((const char*)(gbase) + (voff)[_i]), (PG8_LAS unsigned*)(lds + (bufoff) + ldsw + _i * 8192), 16, 0, 0); } while (0)
#define PG8_LDA(dst, b, h) do { _Pragma("unroll") for (int m = 0; m < 4; ++m) _Pragma("unroll") for (int k = 0; k < 2; ++k) dst[m][k] = *(const PG8_LAS bf16x8*)(lds + PG8_SA(b, h) + aoff + m * 2048 + k * 1024); } while (0)
#define PG8_LDB(dst, b, h) do { _Pragma("unroll") for (int n = 0; n < 2; ++n) _Pragma("unroll") for (int k = 0; k < 2; ++k) dst[n][k] = *(const PG8_LAS bf16x8*)(lds + PG8_SB(b, h) + boff + n * 2048 + k * 1024); } while (0)
#define PG8_MMA(ai, bj, At, Bt) do { __builtin_amdgcn_s_setprio(1); _Pragma("unroll") for (int m = 0; m < 4; ++m) _Pragma("unroll") for (int n = 0; n < 2; ++n) _Pragma("unroll") for (int k = 0; k < 2; ++k) \
        acc[ai][bj][m][n] = __builtin_amdgcn_mfma_f32_16x16x32_bf16(Bt[n][k], At[m][k], acc[ai][bj][m][n], 0, 0, 0); __builtin_amdgcn_s_setprio(0); } while (0)
#define PG8_WAIT_V(n) asm volatile("s_waitcnt vmcnt(" #n ")" ::: "memory")
#define PG8_WAIT_L(n) asm volatile("s_waitcnt lgkmcnt(" #n ")" ::: "memory")
#define PG8_BAR __builtin_amdgcn_s_barrier()
#define PG8_SCHED __builtin_amdgcn_sched_barrier(0)
    Unit cur, nxt; int ui = 0;
    if (!S.next(0, cur)) return;
    f32x4 acc[2][2][4][2];
#pragma unroll
    for (int a = 0; a < 2; ++a)
#pragma unroll
        for (int b = 0; b < 2; ++b)
#pragma unroll
            for (int m = 0; m < 4; ++m)
#pragma unroll
                for (int n = 0; n < 2; ++n) acc[a][b][m][n] = (f32x4){0.f, 0.f, 0.f, 0.f};
    bf16x8 At[4][2], B0[2][2], B1[2][2];
    const char* cA = (const char*)g.A + PG8_ABASE(cur.pm); const char* cB = (const char*)g.Bt + (size_t)cur.pn * tstep;
    S.a_ready(cur);
    if constexpr (SP2) {
        PG8_STAGE(PG8_SB(0, 0), cB, voffB); PG8_STAGE(PG8_SB(0, 1), cB + hstepB, voffB); PG8_STAGE(PG8_SA(0, 0), cA, voffA); PG8_STAGE(PG8_SA(0, 1), cA + hstepA, voffA);
        if (wr == 1) PG8_BAR;
        PG8_WAIT_V(2); PG8_BAR;
        PG8_STAGE(PG8_SB(1, 0), cB + kstep, voffB); PG8_STAGE(PG8_SA(1, 0), cA + kstep, voffA); PG8_STAGE(PG8_SB(1, 1), cB + hstepB + kstep, voffB);
        PG8_WAIT_V(6); PG8_BAR;
    } else {
        PG8_STAGE(PG8_SB(0, 0), cB, voffB); PG8_STAGE(PG8_SA(0, 0), cA, voffA); PG8_STAGE(PG8_SB(0, 1), cB + hstepB, voffB); PG8_STAGE(PG8_SA(0, 1), cA + hstepA, voffA);
        if (wr == 1) PG8_BAR;
        PG8_WAIT_V(4); PG8_BAR;
        PG8_STAGE(PG8_SB(1, 0), cB + kstep, voffB); PG8_STAGE(PG8_SA(1, 0), cA + kstep, voffA); PG8_STAGE(PG8_SB(1, 1), cB + hstepB + kstep, voffB);
        PG8_WAIT_V(6); PG8_BAR;
    }
    for (;;) {
        const bool has_next = S.next(ui + 1, nxt);
        const char* nA = has_next ? (const char*)g.A + PG8_ABASE(nxt.pm) : cA; const char* nB = has_next ? (const char*)g.Bt + (size_t)nxt.pn * tstep : cB;
        for (int t = 0; t < nt; t += 2) {
            const bool last = (t == nt - 2);
            const char* a1 = cA + (size_t)(t + 1) * kstep;
            const char* a2 = last ? nA : cA + (size_t)(t + 2) * kstep; const char* b2 = last ? nB : cB + (size_t)(t + 2) * kstep;
            const char* a3 = a2 + kstep; const char* b3 = b2 + kstep;
            if (last && has_next) S.a_ready(nxt);
            if constexpr (SP2) {
            PG8_LDB(B0, 0, 0); PG8_LDB(B1, 0, 1); PG8_SCHED; PG8_LDA(At, 0, 0); PG8_STAGE(PG8_SA(1, 1), a1 + hstepA, voffA);
            PG8_WAIT_V(8); PG8_WAIT_L(0); PG8_BAR; PG8_MMA(0, 0, At, B0); PG8_MMA(0, 1, At, B1); PG8_BAR; PG8_SCHED;
            PG8_LDA(At, 0, 1); PG8_STAGE(PG8_SB(0, 0), b2, voffB); PG8_STAGE(PG8_SB(0, 1), b2 + hstepB, voffB); PG8_STAGE(PG8_SA(0, 0), a2, voffA);
            PG8_WAIT_V(8); PG8_WAIT_L(0); PG8_BAR; PG8_MMA(1, 0, At, B0); PG8_MMA(1, 1, At, B1); PG8_BAR; PG8_SCHED;
            PG8_LDB(B0, 1, 0); PG8_LDB(B1, 1, 1); PG8_SCHED; PG8_LDA(At, 1, 0); PG8_STAGE(PG8_SA(0, 1), a2 + hstepA, voffA);
            PG8_WAIT_V(8); PG8_WAIT_L(0); PG8_BAR; PG8_MMA(0, 0, At, B0); PG8_MMA(0, 1, At, B1); PG8_BAR; PG8_SCHED;
            PG8_LDA(At, 1, 1); PG8_STAGE(PG8_SB(1, 0), b3, voffB); PG8_STAGE(PG8_SB(1, 1), b3 + hstepB, voffB); PG8_STAGE(PG8_SA(1, 0), a3, voffA);
            PG8_WAIT_V(8); PG8_WAIT_L(0); PG8_BAR; PG8_MMA(1, 0, At, B0); PG8_MMA(1, 1, At, B1); PG8_BAR; PG8_SCHED;
            } else {
            PG8_LDB(B0, 0, 0); PG8_SCHED; PG8_LDA(At, 0, 0); PG8_STAGE(PG8_SA(1, 1), a1 + hstepA, voffA);
            PG8_WAIT_L(8); PG8_BAR; PG8_WAIT_L(0); PG8_MMA(0, 0, At, B0); PG8_BAR; PG8_SCHED;
            PG8_LDB(B1, 0, 1); PG8_STAGE(PG8_SB(0, 0), b2, voffB);
            PG8_BAR; PG8_WAIT_L(0); PG8_MMA(0, 1, At, B1); PG8_BAR;
            PG8_LDA(At, 0, 1); PG8_STAGE(PG8_SA(0, 0), a2, voffA);
            PG8_BAR; PG8_WAIT_L(0); PG8_MMA(1, 0, At, B0); PG8_BAR; PG8_SCHED;
            PG8_STAGE(PG8_SB(0, 1), b2 + hstepB, voffB);
            PG8_WAIT_V(6); PG8_BAR; PG8_MMA(1, 1, At, B1); PG8_BAR;
            PG8_LDB(B0, 1, 0); PG8_SCHED; PG8_LDA(At, 1, 0); PG8_STAGE(PG8_SA(0, 1), a2 + hstepA, voffA);
            PG8_WAIT_L(8); PG8_BAR; PG8_WAIT_L(0); PG8_MMA(0, 0, At, B0); PG8_BAR; PG8_SCHED;
            PG8_LDB(B1, 1, 1); PG8_STAGE(PG8_SB(1, 0), b3, voffB);
            PG8_BAR; PG8_WAIT_L(0); PG8_MMA(0, 1, At, B1); PG8_BAR;
            PG8_LDA(At, 1, 1); PG8_STAGE(PG8_SA(1, 0), a3, voffA);
            PG8_BAR; PG8_WAIT_L(0); PG8_MMA(1, 0, At, B0); PG8_BAR; PG8_SCHED;
            PG8_STAGE(PG8_SB(1, 1), b3 + hstepB, voffB);
            PG8_WAIT_V(6); PG8_BAR; PG8_MMA(1, 1, At, B1); PG8_BAR;
            }
        }
        if constexpr (ALIGN_EPI) { if (wr == 0) PG8_BAR; }
        if constexpr (!Epi::AFTER_DRAIN) { E(acc, cur, wr, wc, fr, fq); S.done(cur); }
        if (!has_next) break;
#pragma unroll
        for (int a = 0; a < 2; ++a)
#pragma unroll
            for (int b = 0; b < 2; ++b)
#pragma unroll
                for (int m = 0; m < 4; ++m)
#pragma unroll
                    for (int n = 0; n < 2; ++n) acc[a][b][m][n] = (f32x4){0.f, 0.f, 0.f, 0.f};
        cur = nxt; cA = nA; cB = nB; ++ui;
        if constexpr (ALIGN_EPI) { if (wr == 1) PG8_BAR; }
    }
    PG8_WAIT_V(0);
    if constexpr (!ALIGN_EPI) { if (wr == 0) PG8_BAR; }
    PG8_BAR;
    if constexpr (Epi::AFTER_DRAIN) { E.fused(acc, cur, wr, wc, fr, fq, lds, wid, lane); S.done(cur); }
#undef PG8_ABASE
#undef PG8_SA
#undef PG8_SB
#undef PG8_STAGE
#undef PG8_LDA
#undef PG8_LDB
#undef PG8_MMA
#undef PG8_WAIT_V
#undef PG8_WAIT_L
#undef PG8_BAR
#undef PG8_SCHED
}
}

#ifndef PG8_SP2
#define PG8_SP2 true
#endif
#ifndef PG8_ALIGN
#define PG8_ALIGN true
#endif
#define GAS __attribute__((address_space(1)))
#define LAS __attribute__((address_space(3)))
typedef unsigned short bf16;
typedef unsigned v4u __attribute__((ext_vector_type(4)));
typedef float f32x4 __attribute__((ext_vector_type(4)));
typedef short bf16x8 __attribute__((ext_vector_type(8)));
typedef GAS unsigned gu32;
typedef GAS unsigned long long gu64;
#define RLX_AGENT __ATOMIC_RELAXED, __HIP_MEMORY_SCOPE_AGENT
#define LDS_WAIT() asm volatile("s_waitcnt lgkmcnt(0)" ::: "memory")
#define VM_WAIT() asm volatile("s_waitcnt vmcnt(0)" ::: "memory")
__device__ __forceinline__ unsigned long long rt() { return __builtin_amdgcn_s_memrealtime(); }

#define XB_TMO      128
#define XB_XCNT(j)  (256  + 64 * (j))
#define XB_XSUB(j)  (1280 + 64 * (j))
#define XB_XGEN(j)  (2304 + 64 * (j))
#define XB_TOP      3328
#define XB_TOPGEN   3392
#define XCD_BAR_WORDS 3456
#define XB_SPIN_CAP (1u << 20)

__device__ __forceinline__ unsigned xb_ld(unsigned* p)              { return __hip_atomic_load(p, __ATOMIC_RELAXED, __HIP_MEMORY_SCOPE_AGENT); }
__device__ __forceinline__ unsigned xb_add(unsigned* p, unsigned v) { return __hip_atomic_fetch_add(p, v, __ATOMIC_RELAXED, __HIP_MEMORY_SCOPE_AGENT); }
__device__ __forceinline__ unsigned xb_xcc_id() { return (unsigned)__builtin_amdgcn_s_getreg((3 << 11) | 20) & 0xFu; }
#define XB_SPIN(cond, bar) do { unsigned _sp = 0; while (cond) { __builtin_amdgcn_s_sleep(1); \
    if ((++_sp & 255u) == 0u) { if (xb_ld(&(bar)[XB_TMO])) break; if (_sp > XB_SPIN_CAP) { atomicAdd(&(bar)[XB_TMO], 1u); break; } } } } while (0)

struct XcdBarrier {
    unsigned* bar; unsigned x;
    volatile LAS unsigned* st;
};

__device__ __forceinline__ XcdBarrier xcd_barrier_post(unsigned* bar, volatile LAS unsigned* st) {
    XcdBarrier b; b.bar = bar; b.x = xb_xcc_id(); b.st = st;
    if (threadIdx.x == 0) (void)xb_add(&bar[XB_XCNT(b.x)], 1u);
    return b;
}
__device__ __forceinline__ void xcd_barrier_complete(unsigned* bar, unsigned x, unsigned& nloc, unsigned& nx) {
    const unsigned G = gridDim.x * gridDim.y * gridDim.z;
    unsigned sum, cnt, mine, sp = 0u;
    for (;;) {
        sum = 0u; cnt = 0u; mine = 0u;
#pragma unroll
        for (unsigned j = 0; j < 16; ++j) { const unsigned c = xb_ld(&bar[XB_XCNT(j)]); sum += c; cnt += (c > 0u) ? 1u : 0u; mine = (j == x) ? c : mine; }
        if (sum == G) break;
        __builtin_amdgcn_s_sleep(1);
        if ((++sp & 255u) == 0u) { if (xb_ld(&bar[XB_TMO])) break; if (sp > XB_SPIN_CAP) { atomicAdd(&bar[XB_TMO], 1u); break; } }
    }
    nloc = mine > 0u ? mine : 1u; nx = cnt > 0u ? cnt : 1u;
}

__device__ __forceinline__ void xcd_barrier(const XcdBarrier& b) {
    asm volatile("s_waitcnt vmcnt(0)" ::: "memory");
    __syncthreads();
    if (threadIdx.x == 0) {
        unsigned* bar = b.bar;
        __builtin_amdgcn_s_waitcnt(0);
        unsigned nloc = b.st[0], nx = b.st[1];
        if (nloc == 0u) { xcd_barrier_complete(bar, b.x, nloc, nx); b.st[0] = nloc; b.st[1] = nx; }
        const unsigned old = xb_add(&bar[XB_XSUB(b.x)], 1u);
        const unsigned gen = old / nloc;
        if (old + 1u == (gen + 1u) * nloc) {
            __builtin_amdgcn_fence(__ATOMIC_RELEASE, "agent");
            asm volatile("s_waitcnt vmcnt(0)" ::: "memory");
            const unsigned og = xb_add(&bar[XB_TOP], 1u);
            const unsigned tg = og / nx;
            if (og + 1u == (tg + 1u) * nx) xb_add(&bar[XB_TOPGEN], 1u);
            else XB_SPIN(xb_ld(&bar[XB_TOPGEN]) == tg, bar);
            __builtin_amdgcn_fence(__ATOMIC_ACQUIRE, "agent");
            xb_add(&bar[XB_XGEN(b.x)], 1u);
            asm volatile("s_waitcnt vmcnt(0)" ::: "memory");
        } else {
            XB_SPIN(xb_ld(&bar[XB_XGEN(b.x)]) == gen, bar);
            __builtin_amdgcn_fence(__ATOMIC_ACQUIRE, "agent");
            asm volatile("s_waitcnt vmcnt(0)" ::: "memory");
        }
    }
    __syncthreads();
}

namespace mk {
constexpr size_t WS_CTL = 0, CTL_ZERO_BYTES = 1 * MiB;
constexpr size_t CTL_SSQ = 512 * 1024;
constexpr size_t WS_SMALL = 1 * MiB, SM_BIAS = 0, SM_SSQM = 4096, SM_MKV = 512 * 1024;
constexpr size_t WS_MEMB = 2 * MiB, WS_WT = 3 * MiB, WS_XB = 28 * MiB, WS_VF = 60 * MiB, WS_PROJ = 72 * MiB, WS_MIX = 144 * MiB, WS_PREP = 176 * MiB, WS_U = 72 * MiB, WS_ACT = 160 * MiB, WS_WIN1 = 248 * MiB  , WS_END = 255 * MiB;
constexpr size_t WT_IN = 0, WT_OUT = 4718592, WT_UP = WT_OUT + 2 * MiB, WT_DOWN = WT_UP + 11 * MiB, WT_MKV = WT_DOWN + 5767168;
constexpr int CW_TMO = 0, CW_BAR = 4096, CW_ATTQ = 8192, CW_CHQ = 8448;
constexpr int LDS_BYTES = 163840, LDSCTL_OFF = LDS_BYTES - 512, MISC_OFF = LDSCTL_OFF + 320;
constexpr size_t SM_W2T = 8192, SM_A2T = 32768, SM_V2T = 57344, SM_G2T = 81920, SM_LORA_L = 122880;
constexpr size_t WS_PT = 176 * MiB, WS_G = 188 * MiB, WS_S0 = 200 * MiB, WS_Z = 212 * MiB, WS_YV = 236 * MiB  , WS_DOT = 254 * MiB;
constexpr size_t SM_RWP = 262144, RWP_BYTES = 17472;
constexpr int RP_MU = 0, RP_MUV = 1280, RP_W0 = 1296, RP_A0 = 1680, RP_V0 = 2064, RP_KK = 2448, RP_KA = 2832, RP_RK = 3216, RP_LNW = 3600, RP_LNB = 3984, RP_SIZE = 4368;
}
namespace rw {
constexpr int LD = 72;
constexpr int MATB = 64 * LD * 2;
constexpr int OFF_F0 = 12 * MATB  , OFF_TMP = OFF_F0 + 64 * 65 * 4  ;
constexpr int OFF_TW = 8 * MATB  , OFF_TA = OFF_TW + 5120, OFF_TV = OFF_TA + 5120, OFF_WP = OFF_TV + 5120  , OFF_AP = OFF_WP + 16640, OFF_VP = OFF_AP + 16640;
constexpr int OFF_TOT = 139264, OFF_GC = OFF_TOT + 2048, OFF_RN = OFF_GC + 256, OFF_END = OFF_RN + 256;
constexpr int NITEMS = BATCH * 6 * (SEQ / 64);
__device__ __forceinline__ int sigpos(int c) { return (c & 32) + 8 * ((c >> 2) & 3) + 4 * ((c >> 4) & 1) + (c & 3); }
#define RW_BAR() do { asm volatile("s_waitcnt lgkmcnt(0)" ::: "memory"); __builtin_amdgcn_s_barrier(); asm volatile("" ::: "memory"); } while (0)
__device__ __forceinline__ float fexp(float x) { return __expf(x); }
__device__ __forceinline__ float fsigm(float x) { return __builtin_amdgcn_rcpf(1.0f + __expf(-x)); }
__device__ __forceinline__ float ftanh(float x) { const float e = __expf(-2.0f * fabsf(x)); const float t = (1.0f - e) * __builtin_amdgcn_rcpf(1.0f + e); return x < 0.f ? -t : t; }
__device__ __forceinline__ f32x4 mm_tile(const LAS bf16_t* A, const LAS bf16_t* Bt, int ti, int tj, int fr, int fq, f32x4 acc) {
#pragma unroll
    for (int kk = 0; kk < 2; ++kk) {
        const bf16x8 a = *(const LAS bf16x8*)(A + (16 * ti + fr) * LD + 32 * kk + 8 * fq);
        const bf16x8 b = *(const LAS bf16x8*)(Bt + (16 * tj + fr) * LD + 32 * kk + 8 * fq);
        acc = __builtin_amdgcn_mfma_f32_16x16x32_bf16(a, b, acc, 0, 0, 0);
    }
    return acc;
}
__device__ __forceinline__ unsigned pk2(float lo, float hi) { typedef float f2_t __attribute__((ext_vector_type(2))); typedef __bf16 b2_t __attribute__((ext_vector_type(2))); f2_t v = {lo, hi}; return __builtin_bit_cast(unsigned, __builtin_convertvector(v, b2_t)); }
#define RW_PT   ((GAS bf16_t*)(wsb + mk::WS_PT))
#define RW_G    ((GAS bf16_t*)(wsb + mk::WS_G))
#define RW_Z    ((GAS float*)(wsb + mk::WS_Z))
#define RW_YV   ((GAS bf16_t*)(wsb + mk::WS_YV))
#define RW_S0   ((GAS bf16_t*)(wsb + mk::WS_S0))
#define RW_VF   ((GAS bf16_t*)(wsb + mk::WS_VF))
#define RW_DOT  ((GAS float*)(wsb + mk::WS_DOT))
#define RW_PROJ ((const GAS bf16_t*)(wsb + mk::WS_PROJ))
#define RW_MIX  ((GAS bf16_t*)(wsb + mk::WS_MIX))
#define RW_LORA(off) ((const GAS bf16_t*)(wsb + mk::WS_SMALL + (off) + layer * mk::SM_LORA_L))
#define RWP(off) ((const GAS float*)(wsb + mk::WS_SMALL + mk::SM_RWP + layer * mk::RWP_BYTES) + (off))
struct ChunkBufs { bf16_t* PT; bf16_t* G; float* Z; bf16_t* YV; bf16_t* S0; bf16_t* VOUT; float* DOT; const bf16_t *W2T, *A2T, *V2T, *G2T; };

#define RW_LANES() int lt_ = tid_in; asm volatile("" : "+v"(lt_)); const int tid = lt_, lane = lt_ & 63, fr = lane & 15, fq = lane >> 4; (void)tid; (void)fr; (void)fq
__device__ __forceinline__ int chunk_phase(LAS unsigned char* L, unsigned char* wsb, int layer, int tid_in, unsigned* qctr, volatile LAS unsigned* qw) {
    const GAS bf16_t* P = RW_PROJ;
    const int w = __builtin_amdgcn_readfirstlane(tid_in >> 6);
    LAS bf16_t* B0 = (LAS bf16_t*)(L + 0 * MATB); LAS bf16_t* B1 = (LAS bf16_t*)(L + 1 * MATB); LAS bf16_t* B2 = (LAS bf16_t*)(L + 2 * MATB); LAS bf16_t* B3 = (LAS bf16_t*)(L + 3 * MATB);
    LAS bf16_t* B4 = (LAS bf16_t*)(L + 4 * MATB); LAS bf16_t* B5 = (LAS bf16_t*)(L + 5 * MATB); LAS bf16_t* B6 = (LAS bf16_t*)(L + 6 * MATB); LAS bf16_t* B7 = (LAS bf16_t*)(L + 7 * MATB);
    LAS bf16_t* B8 = (LAS bf16_t*)(L + 8 * MATB); LAS bf16_t* B9 = (LAS bf16_t*)(L + 9 * MATB); LAS bf16_t* B10 = (LAS bf16_t*)(L + 10 * MATB); LAS bf16_t* B11 = (LAS bf16_t*)(L + 11 * MATB);
    LAS float* F0 = (LAS float*)(L + OFF_F0); LAS float* TMP = (LAS float*)(L + OFF_TMP);
    LAS bf16_t* TW = (LAS bf16_t*)(L + OFF_TW); LAS bf16_t* TA = (LAS bf16_t*)(L + OFF_TA); LAS bf16_t* TV = (LAS bf16_t*)(L + OFF_TV);
    LAS float* WP = (LAS float*)(L + OFF_WP); LAS float* AP = (LAS float*)(L + OFF_AP); LAS float* VP = (LAS float*)(L + OFF_VP);
    LAS float* TOT = (LAS float*)(L + OFF_TOT); LAS float* GC = (LAS float*)(L + OFF_GC); LAS float* RN = (LAS float*)(L + OFF_RN);
    for (;;) {
        if (tid_in == 0) qw[0] = atomicAdd(qctr, 1u);
        RW_BAR(); const int item = (int)qw[0]; RW_BAR();
        if (item >= NITEMS) return item;
        const int bh = item / (SEQ / 64), chunk = item % (SEQ / 64), b = bh / 6, h = bh % 6;
        const int tok0 = b * SEQ + chunk * 64;
        unsigned short e_r[9], e_k[9], e_v[9], e_vf[8]; float e_mu_r, e_mu_k, e_mu_v, e_w0, e_a0, e_kk, e_ka, e_rk, e_v0;
        { RW_LANES(); const int hc = 64 * h + lane, tk0 = tok0 + 8 * w; const bool has_prev = (chunk * 64 + 8 * w) > 0;
#pragma unroll
          for (int j = 0; j < 9; ++j) { const size_t row = (size_t)(tk0 + j - 1) * LDP; const bool ok = j > 0 || has_prev;
              e_r[j] = ok ? P[row + 640 + hc] : (unsigned short)0; e_k[j] = ok ? P[row + 1024 + hc] : (unsigned short)0; e_v[j] = ok ? P[row + 1408 + hc] : (unsigned short)0; }
#pragma unroll
          for (int j = 0; j < 8; ++j) e_vf[j] = layer > 0 ? RW_VF[(size_t)(tk0 + j) * 384 + hc] : (unsigned short)0;
          e_mu_r = RWP(mk::RP_MU)[hc]; e_mu_k = RWP(mk::RP_MU)[384 + hc]; e_mu_v = RWP(mk::RP_MU)[768 + hc]; e_w0 = RWP(mk::RP_W0)[hc]; e_a0 = RWP(mk::RP_A0)[hc]; e_kk = RWP(mk::RP_KK)[hc]; e_ka = RWP(mk::RP_KA)[hc]; e_rk = RWP(mk::RP_RK)[hc]; e_v0 = layer > 0 ? RWP(mk::RP_V0)[hc] : 0.f; }
        for (int rp_ = 0; rp_ < ((PROF_PH) == 20 ? 2 : 1); ++rp_) {
        { RW_LANES(); const int t = tid >> 3, sub = tid & 7, tok = tok0 + t; const bool hp = (chunk * 64 + t) > 0;
          const GAS bf16_t* rc = P + (size_t)tok * LDP; const GAS bf16_t* rp = rc - LDP; const v4u z4 = {0u, 0u, 0u, 0u};
          const v4u lc = *(const GAS v4u*)(rc + 1792 + 8 * sub), lp = hp ? *(const GAS v4u*)(rp + 1792 + 8 * sub) : z4;
          const v4u kc4 = *(const GAS v4u*)(rc + 1024 + 64 * h + 8 * sub), kp4 = hp ? *(const GAS v4u*)(rp + 1024 + 64 * h + 8 * sub) : z4;
          v4u vc4 = z4, vp4 = z4; if (layer > 0 && sub < 2) { vc4 = *(const GAS v4u*)(rc + 1920 + 8 * sub); if (hp) vp4 = *(const GAS v4u*)(rp + 1920 + 8 * sub); }
          const unsigned lcw[4] = {lc.x, lc.y, lc.z, lc.w}, lpw[4] = {lp.x, lp.y, lp.z, lp.w}, kcw[4] = {kc4.x, kc4.y, kc4.z, kc4.w}, kpw[4] = {kp4.x, kp4.y, kp4.z, kp4.w}, vcw[4] = {vc4.x, vc4.y, vc4.z, vc4.w}, vpw[4] = {vp4.x, vp4.y, vp4.z, vp4.w};
          unsigned lo[4], vo[4]; float s = 0.f;
          const f32x4 mA0 = *(const GAS f32x4*)(RWP(mk::RP_MU) + 1152 + 8 * sub), mA1 = *(const GAS f32x4*)(RWP(mk::RP_MU) + 1156 + 8 * sub);
          const f32x4 mK0 = *(const GAS f32x4*)(RWP(mk::RP_MU) + 384 + 64 * h + 8 * sub), mK1 = *(const GAS f32x4*)(RWP(mk::RP_MU) + 388 + 64 * h + 8 * sub);
          const f32x4 kk0 = *(const GAS f32x4*)(RWP(mk::RP_KK) + 64 * h + 8 * sub), kk1 = *(const GAS f32x4*)(RWP(mk::RP_KK) + 64 * h + 8 * sub + 4);
          f32x4 mV0 = {0.f, 0.f, 0.f, 0.f}, mV1 = mV0; if (layer > 0 && sub < 2) { mV0 = *(const GAS f32x4*)(RWP(mk::RP_MUV) + 8 * sub); mV1 = *(const GAS f32x4*)(RWP(mk::RP_MUV) + 8 * sub + 4); }
#pragma unroll
          for (int e2 = 0; e2 < 4; ++e2) { float xl[2], xv[2];
#pragma unroll
              for (int u = 0; u < 2; ++u) { const int e = 2 * e2 + u; const int sh = 16 * u;
                  const float c1 = bf2f((bf16_t)((lcw[e2] >> sh) & 0xffff)), p1 = bf2f((bf16_t)((lpw[e2] >> sh) & 0xffff)); const float x = c1 + (e < 4 ? mA0[e & 3] : mA1[e & 3]) * (p1 - c1);
                  xl[u] = sub < 4 ? ftanh(x) : x;
                  const float c2 = bf2f((bf16_t)((kcw[e2] >> sh) & 0xffff)), p2 = bf2f((bf16_t)((kpw[e2] >> sh) & 0xffff));
                  const float kx = (c2 + (e < 4 ? mK0[e & 3] : mK1[e & 3]) * (p2 - c2)) * (e < 4 ? kk0[e & 3] : kk1[e & 3]); s += kx * kx;
                  const float c3 = bf2f((bf16_t)((vcw[e2] >> sh) & 0xffff)), p3 = bf2f((bf16_t)((vpw[e2] >> sh) & 0xffff)); xv[u] = c3 + (e < 4 ? mV0[e & 3] : mV1[e & 3]) * (p3 - c3); }
              lo[e2] = pk2(xl[0], xl[1]); vo[e2] = pk2(xv[0], xv[1]); }
          *(LAS v4u*)((sub < 4 ? TW : TA) + t * 40 + 8 * (sub & 3)) = (v4u){lo[0], lo[1], lo[2], lo[3]};
          if (layer > 0 && sub < 4) *(LAS v4u*)(TV + t * 40 + 8 * sub) = (v4u){vo[0], vo[1], vo[2], vo[3]};
          s += __shfl_xor(s, 1); s += __shfl_xor(s, 2); s += __shfl_xor(s, 4);
          if (sub == 0) RN[t] = __builtin_amdgcn_rsqf(fmaxf(s, 1e-24f)); }
        RW_BAR();
        }
        { RW_LANES();
#pragma unroll
        for (int e = 0; e < 2; ++e) { const int tl = 2 * w + e, ti = tl >> 2, tj = tl & 3; const f32x4 z4 = {0.f, 0.f, 0.f, 0.f};
            const size_t brow = (size_t)(64 * h + 16 * tj + fr) * 32 + 8 * fq;
            { const bf16x8 a = *(const LAS bf16x8*)(TW + (16 * ti + fr) * 40 + 8 * fq); const bf16x8 bb = *(const GAS bf16x8*)(RW_LORA(mk::SM_W2T) + brow);
              const f32x4 d = __builtin_amdgcn_mfma_f32_16x16x32_bf16(a, bb, z4, 0, 0, 0);
#pragma unroll
              for (int r = 0; r < 4; ++r) WP[(16 * ti + 4 * fq + r) * 65 + 16 * tj + fr] = d[r]; }
            { const bf16x8 a = *(const LAS bf16x8*)(TA + (16 * ti + fr) * 40 + 8 * fq); const bf16x8 bb = *(const GAS bf16x8*)(RW_LORA(mk::SM_A2T) + brow);
              const f32x4 d = __builtin_amdgcn_mfma_f32_16x16x32_bf16(a, bb, z4, 0, 0, 0);
#pragma unroll
              for (int r = 0; r < 4; ++r) AP[(16 * ti + 4 * fq + r) * 65 + 16 * tj + fr] = d[r]; }
            if (layer > 0) { const bf16x8 a = *(const LAS bf16x8*)(TV + (16 * ti + fr) * 40 + 8 * fq); const bf16x8 bb = *(const GAS bf16x8*)(RW_LORA(mk::SM_V2T) + brow);
              const f32x4 d = __builtin_amdgcn_mfma_f32_16x16x32_bf16(a, bb, z4, 0, 0, 0);
#pragma unroll
              for (int r = 0; r < 4; ++r) VP[(16 * ti + 4 * fq + r) * 65 + 16 * tj + fr] = d[r]; } } }
        RW_BAR();
        for (int rp_ = 0; rp_ < ((PROF_PH) == 21 ? 2 : 1); ++rp_) {
        { RW_LANES(); const int c = lane, hc = 64 * h + c, tq0 = 8 * w, tk0 = tok0 + tq0;
          const float mu_r = e_mu_r, mu_k = e_mu_k, mu_v = e_mu_v, w0 = e_w0, a0 = e_a0, k_k = e_kk, k_a = e_ka, r_k = e_rk, v0 = e_v0;
          float pr = bf2f(e_r[0]), pk = bf2f(e_k[0]), pv = bf2f(e_v[0]);
          float rr[8], kq[8], vv[8], kkc[8], bb[8], ld[8], pd[8];
#pragma unroll
          for (int j = 0; j < 8; ++j) { const int t = tq0 + j;
              const float cr = bf2f(e_r[j + 1]), ck = bf2f(e_k[j + 1]), cv = bf2f(e_v[j + 1]);
              const float r = cr + mu_r * (pr - cr), k = ck + mu_k * (pk - ck); float v = cv + mu_v * (pv - cv); pr = cr; pk = ck; pv = cv;
              const float wp = w0 + WP[t * 65 + c], ap = a0 + AP[t * 65 + c];
              const float z = -wp, sp = fmaxf(z, 0.f) + __logf(1.0f + __expf(-fabsf(z))); const float wl = -sp - 0.5f;
              const float al = fsigm(ap);
              if (layer > 0) { const float vp = v0 + VP[t * 65 + c]; const float vf = bf2f(e_vf[j]); v = v + (vf - v) * fsigm(vp); }
              const float kn = k * k_k * RN[t]; const float k2 = k * (1.0f + (al - 1.0f) * k_a);
              rr[j] = r; kq[j] = k2; vv[j] = v; kkc[j] = kn; bb[j] = kn * al; ld[j] = -fexp(wl); pd[j] = r * k2 * r_k; }
          {
#pragma unroll
            for (int j = 0; j < 8; j += 2) { const unsigned pv2 = pk2(vv[j], vv[j + 1]); RW_VF[(size_t)(tk0 + j) * 384 + hc] = (bf16_t)(pv2 & 0xffff); RW_VF[(size_t)(tk0 + j + 1) * 384 + hc] = (bf16_t)(pv2 >> 16); } }
          {
            const bool b5 = lane & 32, b4 = lane & 16, b3 = lane & 8; float s4[4], s2[2], s1;
#pragma unroll
            for (int i = 0; i < 4; ++i) { const float keep = b5 ? pd[i + 4] : pd[i], send = b5 ? pd[i] : pd[i + 4]; s4[i] = keep + __shfl_xor(send, 32); }
#pragma unroll
            for (int i = 0; i < 2; ++i) { const float keep = b4 ? s4[i + 2] : s4[i], send = b4 ? s4[i] : s4[i + 2]; s2[i] = keep + __shfl_xor(send, 16); }
            { const float keep = b3 ? s2[1] : s2[0], send = b3 ? s2[0] : s2[1]; s1 = keep + __shfl_xor(send, 8); }
            s1 += __shfl_xor(s1, 4); s1 += __shfl_xor(s1, 2); s1 += __shfl_xor(s1, 1);
            if ((lane & 7) == 0) RW_DOT[(size_t)(tk0 + (lane >> 3)) * 6 + h] = s1; }
          float cl[8]; cl[0] = ld[0];
#pragma unroll
          for (int j = 1; j < 8; ++j) cl[j] = cl[j - 1] + ld[j];
          TOT[w * 64 + c] = cl[7];
          RW_BAR();
          float prefix = 0.f, cumC = 0.f;
#pragma unroll
          for (int ww = 0; ww < 8; ++ww) { const float tv = TOT[ww * 64 + c]; cumC += tv; if (ww < w) prefix += tv; }
          const float gcc = fexp(cumC); if (w == 0) GC[c] = gcc;
          unsigned ahp[4], btp[4], ktp[4], vp4[4]; float gprev = fexp(prefix), ah_e = 0.f, bt_e = 0.f, kt_e = 0.f;
#pragma unroll
          for (int j = 0; j < 8; ++j) { const int t = tq0 + j; const float g = fexp(prefix + cl[j]), ig = __builtin_amdgcn_rcpf(g), gc = gcc * ig;
              const float ah = -kkc[j] * gprev, rh = rr[j] * g, bh = bb[j] * ig, kh = kq[j] * ig, bt = bb[j] * gc, kt = kq[j] * gc; gprev = g;
              const unsigned w01 = pk2(ah, rh), w23 = pk2(bh, kh);
              B0[t * LD + c] = (bf16_t)(w01 & 0xffff); B1[t * LD + c] = (bf16_t)(w01 >> 16); B2[t * LD + c] = (bf16_t)(w23 & 0xffff); B3[t * LD + c] = (bf16_t)(w23 >> 16);
              if (j & 1) { ahp[j >> 1] = pk2(ah_e, ah); btp[j >> 1] = pk2(bt_e, bt); ktp[j >> 1] = pk2(kt_e, kt); vp4[j >> 1] = pk2(vv[j - 1], vv[j]); }
              else { ah_e = ah; bt_e = bt; kt_e = kt; } }
          *(LAS v4u*)(B4 + c * LD + tq0) = (v4u){ahp[0], ahp[1], ahp[2], ahp[3]}; *(LAS v4u*)(B5 + c * LD + tq0) = (v4u){btp[0], btp[1], btp[2], btp[3]};
          *(LAS v4u*)(B6 + c * LD + tq0) = (v4u){ktp[0], ktp[1], ktp[2], ktp[3]}; *(LAS v4u*)(B7 + c * LD + tq0) = (v4u){vp4[0], vp4[1], vp4[2], vp4[3]}; }
        RW_BAR();
        }
        for (int rp_ = 0; rp_ < ((PROF_PH) == 22 ? 2 : 1); ++rp_) {
        { RW_LANES(); const int prod = w >> 1; const LAS bf16_t* Aop = prod < 2 ? B0 : B1; const LAS bf16_t* Bop = (prod & 1) ? B3 : B2;
#pragma unroll
          for (int e = 0; e < 8; ++e) { const int tl = (w & 1) * 8 + e, ti = tl >> 2, tj = tl & 3; f32x4 d = {0.f, 0.f, 0.f, 0.f};
              if (tj <= ti) d = mm_tile(Aop, Bop, ti, tj, fr, fq, d);
#pragma unroll
              for (int r = 0; r < 4; ++r) { const int t = 16 * ti + 4 * fq + r, i = 16 * tj + fr; const bool keep = prod < 2 ? (i < t) : (i <= t); const float val = (tj <= ti && keep) ? d[r] : 0.f;
                  if (prod == 0) F0[t * 65 + i] = val; else if (prod == 1) B8[t * LD + i] = f2bf(val); else if (prod == 2) B9[t * LD + i] = f2bf(val); else B10[t * LD + i] = f2bf(val); } } }
        RW_BAR();
        }
        if (w == 0) { RW_LANES();
            const int blk = lane >> 4, jc = lane & 15; const LAS float* Lb = F0 + (16 * blk) * 65 + 16 * blk; float tc[16];
#pragma unroll
            for (int r = 0; r < 16; ++r) { float val = (r == jc) ? 1.f : 0.f;
#pragma unroll
                for (int i = 0; i < r; ++i) val += Lb[r * 65 + i] * tc[i];
                tc[r] = val; }
            asm volatile("s_waitcnt lgkmcnt(0)" ::: "memory");
#pragma unroll
            for (int r = 0; r < 16; ++r) F0[(16 * blk + r) * 65 + 16 * blk + jc] = tc[r];
        }
        RW_BAR();
        if (w < 2) { RW_LANES();
            const int o1 = 32 * w, o2 = 32 * w + 16; f32x4 d = {0.f, 0.f, 0.f, 0.f};
#pragma unroll
            for (int ks = 0; ks < 4; ++ks) d = __builtin_amdgcn_mfma_f32_16x16x4f32(F0[(o2 + fr) * 65 + o1 + 4 * ks + fq], F0[(o1 + 4 * ks + fq) * 65 + o1 + fr], d, 0, 0, 0);
            LAS float* tm = TMP + w * 16 * 17;
#pragma unroll
            for (int r = 0; r < 4; ++r) tm[(4 * fq + r) * 17 + fr] = d[r];
            asm volatile("s_waitcnt lgkmcnt(0)" ::: "memory");
            f32x4 d2 = {0.f, 0.f, 0.f, 0.f};
#pragma unroll
            for (int ks = 0; ks < 4; ++ks) d2 = __builtin_amdgcn_mfma_f32_16x16x4f32(F0[(o2 + fr) * 65 + o2 + 4 * ks + fq], tm[(4 * ks + fq) * 17 + fr], d2, 0, 0, 0);
            asm volatile("s_waitcnt lgkmcnt(0)" ::: "memory");
#pragma unroll
            for (int r = 0; r < 4; ++r) F0[(o2 + 4 * fq + r) * 65 + o1 + fr] = d2[r];
        }
        RW_BAR();
        if (w < 4) { RW_LANES();
            const int ti = w >> 1, tj = w & 1; f32x4 d = {0.f, 0.f, 0.f, 0.f};
#pragma unroll
            for (int ks = 0; ks < 8; ++ks) d = __builtin_amdgcn_mfma_f32_16x16x4f32(F0[(32 + 16 * ti + fr) * 65 + 4 * ks + fq], F0[(4 * ks + fq) * 65 + 16 * tj + fr], d, 0, 0, 0);
#pragma unroll
            for (int r = 0; r < 4; ++r) TMP[(16 * ti + 4 * fq + r) * 33 + 16 * tj + fr] = d[r];
        }
        RW_BAR();
        if (w < 4) { RW_LANES();
            const int ti = w >> 1, tj = w & 1; f32x4 d = {0.f, 0.f, 0.f, 0.f};
#pragma unroll
            for (int ks = 0; ks < 8; ++ks) d = __builtin_amdgcn_mfma_f32_16x16x4f32(F0[(32 + 16 * ti + fr) * 65 + 32 + 4 * ks + fq], TMP[(4 * ks + fq) * 33 + 16 * tj + fr], d, 0, 0, 0);
#pragma unroll
            for (int r = 0; r < 4; ++r) F0[(32 + 16 * ti + 4 * fq + r) * 65 + 16 * tj + fr] = d[r];
        }
        RW_BAR();
        { RW_LANES(); const int t = tid >> 3, i0 = (tid & 7) * 8;
#pragma unroll
          for (int e = 0; e < 8; ++e) B11[t * LD + i0 + e] = f2bf(F0[t * 65 + i0 + e]); }
        RW_BAR();
        { RW_LANES();
#pragma unroll
        for (int e = 0; e < 4; ++e) { const int tl = 4 * w + e, prod = tl >> 4, ti = (tl >> 2) & 3, tj = tl & 3; f32x4 d = {0.f, 0.f, 0.f, 0.f};
            d = prod == 0 ? mm_tile(B11, B4, ti, tj, fr, fq, d) : mm_tile(B8, B7, ti, tj, fr, fq, d);
            LAS bf16_t* dst = (prod == 0 ? B0 : B2) + (16 * tj + fr) * LD + 16 * ti + 4 * fq;
            *(LAS unsigned long long*)dst = (unsigned long long)pk2(d[0], d[1]) | ((unsigned long long)pk2(d[2], d[3]) << 32); } }
        RW_BAR();
        { RW_LANES();
#pragma unroll
        for (int e = 0; e < 2; ++e) { const int tl = 2 * w + e, ti = tl >> 2, tj = tl & 3; f32x4 d = {0.f, 0.f, 0.f, 0.f};
            d = mm_tile(B11, B2, ti, tj, fr, fq, d);
            LAS bf16_t* dst = B3 + (16 * tj + fr) * LD + 16 * ti + 4 * fq;
            *(LAS unsigned long long*)dst = (unsigned long long)pk2(d[0], d[1]) | ((unsigned long long)pk2(d[2], d[3]) << 32); } }
        RW_BAR();
        for (int rp_ = 0; rp_ < ((PROF_PH) == 23 ? 2 : 1); ++rp_) {
        { RW_LANES();
#pragma unroll
        for (int e = 0; e < 8; ++e) { const int tl = 8 * w + e, prod = tl >> 4, ti = (tl >> 2) & 3, tj = tl & 3; f32x4 d = {0.f, 0.f, 0.f, 0.f};
            if (prod == 0) { d = mm_tile(B5, B3, ti, tj, fr, fq, d); d = mm_tile(B6, B7, ti, tj, fr, fq, d);
                *(GAS f32x4*)(RW_Z + (size_t)item * 4096 + (16 * tj + fr) * 64 + 4 * ((4 * ti + fq) ^ fr)) = d; }
            else if (prod == 1) { d = mm_tile(B9, B3, ti, tj, fr, fq, d); d = mm_tile(B10, B7, ti, tj, fr, fq, d);
                *(GAS unsigned long long*)(RW_YV + (size_t)item * 4096 + (16 * tj + fr) * 64 + 16 * ti + 4 * fq) = (unsigned long long)pk2(d[0], d[1]) | ((unsigned long long)pk2(d[2], d[3]) << 32); }
            else if (prod == 2) { d = mm_tile(B9, B0, ti, tj, fr, fq, d);
#pragma unroll
                for (int r = 0; r < 4; ++r) { const int t = 16 * ti + 4 * fq + r, c = 16 * tj + fr; B4[t * LD + sigpos(c)] = f2bf(d[r] + bf2f(B1[t * LD + c])); } }
            else { d = mm_tile(B5, B0, ti, tj, fr, fq, d);
#pragma unroll
                for (int r = 0; r < 4; ++r) { const int c = 16 * ti + 4 * fq + r, c2 = 16 * tj + fr; B8[c * LD + sigpos(c2)] = f2bf(d[r] + (c == c2 ? GC[c] : 0.f)); } } } }
        RW_BAR();
        }
        { RW_LANES(); const int r = tid >> 3, ch = (tid & 7) * 8;
          *(GAS v4u*)(RW_G + (size_t)item * 4096 + r * 64 + ch) = *(const LAS v4u*)(B4 + r * LD + ch);
          *(GAS v4u*)(RW_PT + (size_t)item * 4096 + r * 64 + 8 * ((tid & 7) ^ (r & 7))) = *(const LAS v4u*)(B8 + r * LD + ch); }
        RW_BAR();
    }
}
constexpr int SC_NS = 10, SC_SLOT = 12288, SC_LAG = 6;
__device__ __forceinline__ void scan_compute(LAS unsigned char* L, const ChunkBufs cb, int bh, int tj, int lane, volatile LAS unsigned* flags) {
    const int fr = lane & 15, fq = lane >> 4; const int NC = SEQ / 64;
    bf16x8 Bf0 = {0, 0, 0, 0, 0, 0, 0, 0}, Bf1 = {0, 0, 0, 0, 0, 0, 0, 0};
    bf16_t* s0 = cb.S0 + (size_t)(bh * NC) * 4096 + (16 * tj + fr) * 64 + 8 * fq;
    const int po0 = fr * 128 + 16 * ((fq) ^ (fr & 7)), po1 = fr * 128 + 16 * ((4 + fq) ^ (fr & 7));
    int slot = 0;
    for (int chunk = 0; chunk < NC; ++chunk) {
        unsigned spins = 0;
        while (true) { const unsigned a = flags[0], b = flags[1], c = flags[2]; const unsigned m = a < b ? (a < c ? a : c) : (b < c ? b : c); if ((int)m >= chunk + 1 || ++spins > (1u << 22)) break; __builtin_amdgcn_s_sleep(1); }
        const LAS unsigned char* sp = L + slot * SC_SLOT;
        bf16x8 a0[4], a1[4]; f32x4 z[4];
#pragma unroll
        for (int ti = 0; ti < 4; ++ti) { a0[ti] = *(const LAS bf16x8*)(sp + ti * 2048 + po0); a1[ti] = *(const LAS bf16x8*)(sp + ti * 2048 + po1); z[ti] = *(const LAS f32x4*)(sp + 8192 + fr * 256 + 16 * ((4 * ti + fq) ^ fr)); }
        asm volatile("s_waitcnt lgkmcnt(0)" ::: "memory");
        if (lane == 0) flags[3] = (unsigned)(chunk + 1);
        *(GAS bf16x8*)(s0 + (size_t)chunk * 4096) = Bf0; *(GAS bf16x8*)(s0 + (size_t)chunk * 4096 + 32) = Bf1;
        f32x4 acc[4];
#pragma unroll
        for (int ti = 0; ti < 4; ++ti) { acc[ti] = __builtin_amdgcn_mfma_f32_16x16x32_bf16(a0[ti], Bf0, z[ti], 0, 0, 0); acc[ti] = __builtin_amdgcn_mfma_f32_16x16x32_bf16(a1[ti], Bf1, acc[ti], 0, 0, 0); }
        v4u m0, m1;
        m0.x = pk2(acc[0][0], acc[0][1]); m0.y = pk2(acc[0][2], acc[0][3]); m0.z = pk2(acc[1][0], acc[1][1]); m0.w = pk2(acc[1][2], acc[1][3]);
        m1.x = pk2(acc[2][0], acc[2][1]); m1.y = pk2(acc[2][2], acc[2][3]); m1.z = pk2(acc[3][0], acc[3][1]); m1.w = pk2(acc[3][2], acc[3][3]);
        Bf0 = __builtin_bit_cast(bf16x8, m0); Bf1 = __builtin_bit_cast(bf16x8, m1);
        slot = slot + 1 == SC_NS ? 0 : slot + 1;
    }
}
__device__ __forceinline__ void scan_loader(LAS unsigned char* L, const ChunkBufs cb, int bh, int tj, int lw, int lane, volatile LAS unsigned* flags) {
    const int NC = SEQ / 64;
    const char* src[4];
#pragma unroll
    for (int k = 0; k < 4; ++k) { const int pc = 4 * lw + k;
        src[k] = pc < 8 ? (const char*)(cb.PT + (size_t)(bh * NC) * 4096) + pc * 1024 + lane * 16 : (const char*)(cb.Z + (size_t)(bh * NC) * 4096) + tj * 4096 + (pc - 8) * 1024 + lane * 16; }
    const size_t st0 = 8192, st1 = 16384;
    int slot = 0;
    for (int c = 0; c < NC; ++c) {
        unsigned spins = 0;
        while ((int)flags[3] < c - SC_NS + 1 && ++spins < (1u << 22)) __builtin_amdgcn_s_sleep(1);
        const unsigned dst = (unsigned)(slot * SC_SLOT + 4 * lw * 1024);
#pragma unroll
        for (int k = 0; k < 4; ++k) { const int pc = 4 * lw + k;
            __builtin_amdgcn_global_load_lds((const unsigned*)(src[k] + (size_t)c * (pc < 8 ? st0 : st1)), (LAS unsigned*)(L + dst + k * 1024), 16, 0, 0); }
        if (c >= SC_LAG) { asm volatile("s_waitcnt vmcnt(24)" ::: "memory"); if (lane == 0) flags[lw] = (unsigned)(c - SC_LAG + 1); }
        slot = slot + 1 == SC_NS ? 0 : slot + 1;
    }
    asm volatile("s_waitcnt vmcnt(0)" ::: "memory");
    if (lane == 0) flags[lw] = (unsigned)NC;
}
constexpr int O_SG = 0  , O_Y = 9216  , O_GT = O_Y + 16640  ;
struct OutRegs { v4u gc4, gp4, vo4; unsigned long long yw[2]; bf16x8 a[2][2], bb[2][2], b2[2][2]; float dot; f32x4 lw0, lw1, lb0, lb1; };
__device__ __forceinline__ void out_load(OutRegs& R, unsigned char* wsb, int layer, int item, int tid, int w) {
    const GAS bf16_t* P = RW_PROJ;
    const int lane = tid & 63, fr = lane & 15, fq = lane >> 4;
    const int bh = item / (SEQ / 64), chunk = item % (SEQ / 64), b = bh / 6, h = bh % 6; const int tok0 = b * SEQ + chunk * 64; const size_t ib = (size_t)item * 4096;
    const int t = tid >> 3, sub = tid & 7, tok = tok0 + t; const bool hp = (chunk * 64 + t) > 0;
    const GAS bf16_t* rc = P + (size_t)tok * LDP + 1856 + 8 * sub; const v4u z4 = {0u, 0u, 0u, 0u};
    R.gc4 = *(const GAS v4u*)rc; R.gp4 = hp ? *(const GAS v4u*)(rc - LDP) : z4;
#pragma unroll
    for (int e = 0; e < 2; ++e) { const int tl = 2 * w + e, ti = tl >> 2, tj = tl & 3;
        R.yw[e] = *(const GAS unsigned long long*)(RW_YV + ib + (16 * tj + fr) * 64 + 16 * ti + 4 * fq);
#pragma unroll
        for (int kk = 0; kk < 2; ++kk) { R.a[e][kk] = *(const GAS bf16x8*)(RW_G + ib + (16 * ti + fr) * 64 + 32 * kk + 8 * fq); R.bb[e][kk] = *(const GAS bf16x8*)(RW_S0 + ib + (16 * tj + fr) * 64 + 32 * kk + 8 * fq);
            R.b2[e][kk] = *(const GAS bf16x8*)(RW_LORA(mk::SM_G2T) + (size_t)(64 * h + 16 * tj + fr) * 64 + 32 * kk + 8 * fq); } }
    R.dot = RW_DOT[(size_t)tok * 6 + h]; R.vo4 = *(const GAS v4u*)(RW_VF + (size_t)tok * 384 + 64 * h + 8 * sub);
    R.lw0 = *(const GAS f32x4*)(RWP(mk::RP_LNW) + 64 * h + 8 * sub); R.lw1 = *(const GAS f32x4*)(RWP(mk::RP_LNW) + 64 * h + 8 * sub + 4); R.lb0 = *(const GAS f32x4*)(RWP(mk::RP_LNB) + 64 * h + 8 * sub); R.lb1 = *(const GAS f32x4*)(RWP(mk::RP_LNB) + 64 * h + 8 * sub + 4);
}
__device__ __forceinline__ void out_phase(LAS unsigned char* L, unsigned char* wsb, int layer, int tid_in, int first, int stride) {
    GAS bf16_t* MIX = RW_MIX;
    const int w = __builtin_amdgcn_readfirstlane(tid_in >> 6);
    LAS bf16_t* SG = (LAS bf16_t*)(L + O_SG); LAS float* Y = (LAS float*)(L + O_Y); LAS float* GT = (LAS float*)(L + O_GT);
    OutRegs R; if (first < NITEMS) { RW_LANES(); out_load(R, wsb, layer, first, tid, w); }
    for (int item = first; item < NITEMS; item += stride) {
        const int bh = item / (SEQ / 64), chunk = item % (SEQ / 64), b = bh / 6, h = bh % 6; const int tok0 = b * SEQ + chunk * 64;
        OutRegs N = R; if (item + stride < NITEMS) { RW_LANES(); out_load(N, wsb, layer, item + stride, tid, w); }
        { RW_LANES(); const int t = tid >> 3, sub = tid & 7;
          const f32x4 m0 = *(const GAS f32x4*)(RWP(mk::RP_MU) + 1216 + 8 * sub), m1 = *(const GAS f32x4*)(RWP(mk::RP_MU) + 1220 + 8 * sub);
          const unsigned cw_[4] = {R.gc4.x, R.gc4.y, R.gc4.z, R.gc4.w}, pw_[4] = {R.gp4.x, R.gp4.y, R.gp4.z, R.gp4.w}; unsigned o[4];
#pragma unroll
          for (int e2 = 0; e2 < 4; ++e2) { float x[2];
#pragma unroll
              for (int u = 0; u < 2; ++u) { const int e = 2 * e2 + u; const float c1 = bf2f((bf16_t)((cw_[e2] >> (16 * u)) & 0xffff)), p1 = bf2f((bf16_t)((pw_[e2] >> (16 * u)) & 0xffff));
                  x[u] = fsigm(c1 + (e < 4 ? m0[e & 3] : m1[e & 3]) * (p1 - c1)); }
              o[e2] = pk2(x[0], x[1]); }
          *(LAS v4u*)(SG + t * LD + 8 * sub) = (v4u){o[0], o[1], o[2], o[3]}; }
        RW_BAR();
        { RW_LANES();
#pragma unroll
        for (int e = 0; e < 2; ++e) { const int tl = 2 * w + e, ti = tl >> 2, tj = tl & 3; const unsigned long long yw = R.yw[e];
            f32x4 d = {bf2f((bf16_t)(yw & 0xffff)), bf2f((bf16_t)((yw >> 16) & 0xffff)), bf2f((bf16_t)((yw >> 32) & 0xffff)), bf2f((bf16_t)(yw >> 48))}; f32x4 g = {0.f, 0.f, 0.f, 0.f};
#pragma unroll
            for (int kk = 0; kk < 2; ++kk) {
                d = __builtin_amdgcn_mfma_f32_16x16x32_bf16(R.a[e][kk], R.bb[e][kk], d, 0, 0, 0);
                const bf16x8 a2 = *(const LAS bf16x8*)(SG + (16 * ti + fr) * LD + 32 * kk + 8 * fq);
                g = __builtin_amdgcn_mfma_f32_16x16x32_bf16(a2, R.b2[e][kk], g, 0, 0, 0); }
#pragma unroll
            for (int r = 0; r < 4; ++r) { Y[(16 * ti + 4 * fq + r) * 65 + 16 * tj + fr] = d[r]; GT[(16 * ti + 4 * fq + r) * 65 + 16 * tj + fr] = g[r]; } } }
        RW_BAR();
        { RW_LANES(); const int t = tid >> 3, sub = tid & 7, tok = tok0 + t; float yv[8], s = 0.f;
#pragma unroll
          for (int e = 0; e < 8; ++e) { yv[e] = Y[t * 65 + 8 * sub + e]; s += yv[e]; }
          s += __shfl_xor(s, 1); s += __shfl_xor(s, 2); s += __shfl_xor(s, 4);
          const float mean = s * (1.0f / 64.0f); float q = 0.f;
#pragma unroll
          for (int e = 0; e < 8; ++e) { const float dd = yv[e] - mean; q += dd * dd; }
          q += __shfl_xor(q, 1); q += __shfl_xor(q, 2); q += __shfl_xor(q, 4);
          const float rstd = __builtin_amdgcn_rsqf(q * (1.0f / 64.0f) + GN_EPS), dot = R.dot;
          const unsigned vw[4] = {R.vo4.x, R.vo4.y, R.vo4.z, R.vo4.w}; unsigned o[4];
#pragma unroll
          for (int e = 0; e < 8; e += 2) { float r2[2];
#pragma unroll
              for (int u = 0; u < 2; ++u) { const int ee = e + u; const float lw = ee < 4 ? R.lw0[ee & 3] : R.lw1[ee & 3], lb = ee < 4 ? R.lb0[ee & 3] : R.lb1[ee & 3];
                  const float yn = (yv[ee] - mean) * rstd * lw + lb; const float vv = bf2f((bf16_t)((vw[ee >> 1] >> (16 * (ee & 1))) & 0xffff));
                  r2[u] = (yn + dot * vv) * GT[t * 65 + 8 * sub + ee]; }
              o[e >> 1] = pk2(r2[0], r2[1]); }
          *(GAS v4u*)(MIX + (size_t)tok * DM + 384 + 64 * h + 8 * sub) = (v4u){o[0], o[1], o[2], o[3]}; }
        RW_BAR();
        R = N;
    }
}
}
namespace at {
constexpr int LDK = 72, LDV = 264;
constexpr int A_K = 0, A_V = 256 * LDK * 2  , A_BIAS = A_V + 64 * LDV * 2  , LDB = 256, BOFF = 48, A_END = A_BIAS + 6 * LDB * 4;
__device__ __forceinline__ int vpos(int key) { return (key & ~31) + 8 * ((key >> 2) & 3) + 4 * ((key >> 4) & 1) + (key & 3); }
__device__ __forceinline__ unsigned pk2(float lo, float hi) { typedef float f2_t __attribute__((ext_vector_type(2))); typedef __bf16 b2_t __attribute__((ext_vector_type(2))); f2_t v = {lo, hi}; return __builtin_bit_cast(unsigned, __builtin_convertvector(v, b2_t)); }
#define AT_BAR() do { asm volatile("s_waitcnt vmcnt(0) lgkmcnt(0)" ::: "memory"); __builtin_amdgcn_s_barrier(); asm volatile("" ::: "memory"); } while (0)

struct StageRegs { v4u k[4], v[4]; };
__device__ __forceinline__ void stage_issue(StageRegs& R, int tid, const bf16_t* kbase, const bf16_t* vbase, long pitch, int jvalid0) {
    const v4u z4 = {0u, 0u, 0u, 0u};
#pragma unroll
    for (int it = 0; it < 4; ++it) { const int idx = it * 512 + tid, key = idx >> 3, ch = idx & 7; R.k[it] = key >= jvalid0 ? *(const GAS v4u*)(kbase + (long)key * pitch + 8 * ch) : z4; }
#pragma unroll
    for (int it = 0; it < 4; ++it) { const int idx = it * 512 + tid, key = idx & 255, ch = idx >> 8; R.v[it] = key >= jvalid0 ? *(const GAS v4u*)(vbase + (long)key * pitch + 8 * ch) : z4; }
}
__device__ __forceinline__ void stage_commit(LAS unsigned char* L, const StageRegs& R, int tid, const float* gk) {
    LAS bf16_t* Kl = (LAS bf16_t*)(L + A_K); LAS bf16_t* VTl = (LAS bf16_t*)(L + A_V);
#pragma unroll
    for (int it = 0; it < 4; ++it) { const int idx = it * 512 + tid, key = idx >> 3, ch = idx & 7; const v4u raw = R.k[it];
        float f[8]; f[0] = __builtin_bit_cast(float, raw.x << 16); f[1] = __builtin_bit_cast(float, raw.x & 0xffff0000u); f[2] = __builtin_bit_cast(float, raw.y << 16); f[3] = __builtin_bit_cast(float, raw.y & 0xffff0000u);
        f[4] = __builtin_bit_cast(float, raw.z << 16); f[5] = __builtin_bit_cast(float, raw.z & 0xffff0000u); f[6] = __builtin_bit_cast(float, raw.w << 16); f[7] = __builtin_bit_cast(float, raw.w & 0xffff0000u);
        float ss = 0.f;
#pragma unroll
        for (int e = 0; e < 8; ++e) ss += f[e] * f[e];
        ss += __shfl_xor(ss, 1); ss += __shfl_xor(ss, 2); ss += __shfl_xor(ss, 4);
        const float rs = __builtin_amdgcn_rsqf(ss * (1.0f / 64.0f) + EPS);
        const f32x4 g0 = *(const GAS f32x4*)(gk + 8 * ch), g1 = *(const GAS f32x4*)(gk + 8 * ch + 4);
        v4u o; o.x = pk2(f[0] * rs * g0[0], f[1] * rs * g0[1]); o.y = pk2(f[2] * rs * g0[2], f[3] * rs * g0[3]); o.z = pk2(f[4] * rs * g1[0], f[5] * rs * g1[1]); o.w = pk2(f[6] * rs * g1[2], f[7] * rs * g1[3]);
        *(LAS v4u*)(Kl + key * LDK + 8 * ch) = o; }
#pragma unroll
    for (int it = 0; it < 4; ++it) { const int idx = it * 512 + tid, key = idx & 255, ch = idx >> 8; const v4u raw = R.v[it];
        LAS bf16_t* d = VTl + (8 * ch) * LDV + vpos(key);
        d[0 * LDV] = (bf16_t)(raw.x & 0xffff); d[1 * LDV] = (bf16_t)(raw.x >> 16); d[2 * LDV] = (bf16_t)(raw.y & 0xffff); d[3 * LDV] = (bf16_t)(raw.y >> 16);
        d[4 * LDV] = (bf16_t)(raw.z & 0xffff); d[5 * LDV] = (bf16_t)(raw.z >> 16); d[6 * LDV] = (bf16_t)(raw.w & 0xffff); d[7 * LDV] = (bf16_t)(raw.w >> 16); }
}
struct QRaw { v4u r0, r1; };
__device__ __forceinline__ QRaw q_raw(const bf16_t* qrow, int fq) { QRaw q; q.r0 = *(const GAS v4u*)(qrow + 8 * fq); q.r1 = *(const GAS v4u*)(qrow + 32 + 8 * fq); return q; }
__device__ __forceinline__ void q_finish(const QRaw qr, const float* gq, int fq, bf16x8& q0, bf16x8& q1) {
    float f[16]; const unsigned w[8] = {qr.r0.x, qr.r0.y, qr.r0.z, qr.r0.w, qr.r1.x, qr.r1.y, qr.r1.z, qr.r1.w};
#pragma unroll
    for (int e = 0; e < 8; ++e) { f[2 * e] = __builtin_bit_cast(float, w[e] << 16); f[2 * e + 1] = __builtin_bit_cast(float, w[e] & 0xffff0000u); }
    float ss = 0.f;
#pragma unroll
    for (int e = 0; e < 16; ++e) ss += f[e] * f[e];
    ss += __shfl_xor(ss, 16); ss += __shfl_xor(ss, 32);
    const float rs = 0.125f * __builtin_amdgcn_rsqf(ss * (1.0f / 64.0f) + EPS);
    const f32x4 g0 = *(const GAS f32x4*)(gq + 8 * fq), g1 = *(const GAS f32x4*)(gq + 8 * fq + 4), g2 = *(const GAS f32x4*)(gq + 32 + 8 * fq), g3 = *(const GAS f32x4*)(gq + 36 + 8 * fq);
    v4u a, b;
    a.x = pk2(f[0] * rs * g0[0], f[1] * rs * g0[1]); a.y = pk2(f[2] * rs * g0[2], f[3] * rs * g0[3]); a.z = pk2(f[4] * rs * g1[0], f[5] * rs * g1[1]); a.w = pk2(f[6] * rs * g1[2], f[7] * rs * g1[3]);
    b.x = pk2(f[8] * rs * g2[0], f[9] * rs * g2[1]); b.y = pk2(f[10] * rs * g2[2], f[11] * rs * g2[3]); b.z = pk2(f[12] * rs * g3[0], f[13] * rs * g3[1]); b.w = pk2(f[14] * rs * g3[2], f[15] * rs * g3[3]);
    q0 = __builtin_bit_cast(bf16x8, a); q1 = __builtin_bit_cast(bf16x8, b);
}
template <int NT, bool SWA> __device__ __forceinline__ void attn_wave(const LAS unsigned char* L, bf16x8 q0, bf16x8 q1, int kt0, int qi0, int hq, float sink, bool first_block, bf16_t* outp, int fr, int fq) {
    const LAS bf16_t* Kl = (const LAS bf16_t*)(L + A_K); const LAS bf16_t* VTl = (const LAS bf16_t*)(L + A_V); const LAS float* bias = (const LAS float*)(L + A_BIAS);
    f32x4 s[NT];
#pragma unroll
    for (int t = 0; t < NT; ++t) { const LAS bf16_t* kr = Kl + (16 * (kt0 + t) + fr) * LDK + 8 * fq;
        const f32x4 z = {0.f, 0.f, 0.f, 0.f};
        s[t] = __builtin_amdgcn_mfma_f32_16x16x32_bf16(*(const LAS bf16x8*)kr, q0, z, 0, 0, 0);
        s[t] = __builtin_amdgcn_mfma_f32_16x16x32_bf16(*(const LAS bf16x8*)(kr + 32), q1, s[t], 0, 0, 0);
        if (t & 1) __builtin_amdgcn_sched_barrier(0); }
    float mx = SWA ? sink : -3.0e38f;
    if (SWA) {
        const int odd = (qi0 >> 4) & 1; const int D0 = qi0 + fr + 128 - 16 * kt0 - 4 * fq;
        const LAS float* bp = bias + hq * LDB + BOFF + D0 - 147;
#pragma unroll
        for (int t = 0; t < NT; ++t) { const int c = t - odd;
            if (c >= 1 && c <= 7 && !first_block) {
#pragma unroll
                for (int r = 0; r < 4; ++r) { s[t][r] += bp[147 - 16 * t - r]; mx = fmaxf(mx, s[t][r]); }
            } else {
#pragma unroll
                for (int r = 0; r < 4; ++r) { const int dist = D0 - 16 * t - r; const bool valid = (unsigned)dist < 128u && !(first_block && 16 * (kt0 + t) + 4 * fq + r < 128);
                    s[t][r] = valid ? s[t][r] + bp[147 - 16 * t - r] : -3.0e38f; mx = fmaxf(mx, s[t][r]); } } }
    } else {
#pragma unroll
        for (int t = 0; t < NT; ++t)
#pragma unroll
            for (int r = 0; r < 4; ++r) mx = fmaxf(mx, s[t][r]);
    }
    mx = fmaxf(mx, __shfl_xor(mx, 16)); mx = fmaxf(mx, __shfl_xor(mx, 32));
    float l = 0.f;
#pragma unroll
    for (int t = 0; t < NT; ++t)
#pragma unroll
        for (int r = 0; r < 4; ++r) { const float p = __expf(s[t][r] - mx); s[t][r] = p; l += p; }
    l += __shfl_xor(l, 16); l += __shfl_xor(l, 32);
    if (SWA) l += __expf(sink - mx);
    f32x4 o[4];
#pragma unroll
    for (int dt = 0; dt < 4; ++dt) o[dt] = (f32x4){0.f, 0.f, 0.f, 0.f};
#pragma unroll
    for (int ks = 0; ks < NT / 2; ++ks) { v4u pw; pw.x = pk2(s[2 * ks][0], s[2 * ks][1]); pw.y = pk2(s[2 * ks][2], s[2 * ks][3]); pw.z = pk2(s[2 * ks + 1][0], s[2 * ks + 1][1]); pw.w = pk2(s[2 * ks + 1][2], s[2 * ks + 1][3]);
        const bf16x8 pb = __builtin_bit_cast(bf16x8, pw);
#pragma unroll
        for (int dt = 0; dt < 4; ++dt) o[dt] = __builtin_amdgcn_mfma_f32_16x16x32_bf16(*(const LAS bf16x8*)(VTl + (16 * dt + fr) * LDV + 32 * (kt0 / 2 + ks) + 8 * fq), pb, o[dt], 0, 0, 0);
        __builtin_amdgcn_sched_barrier(0); }
    const float inv = __builtin_amdgcn_rcpf(l);
#pragma unroll
    for (int dt = 0; dt < 4; ++dt) *(GAS unsigned long long*)(outp + (long)fr * DM + 16 * dt + 4 * fq) = (unsigned long long)pk2(o[dt][0] * inv, o[dt][1] * inv) | ((unsigned long long)pk2(o[dt][2] * inv, o[dt][3] * inv) << 32);
}
struct AttnArgs { const bf16_t* PROJ; const bf16_t* MKV; bf16_t* MIX; const float* biastab; const float *sinks, *gq, *gk, *gmq, *gmk; };
__device__ __forceinline__ void item_stage_issue(StageRegs& R, const AttnArgs A, int q, int tid) {
    if (q >= 256) { const int item = q - 256, b = item >> 7, hkv = (item >> 6) & 1, blk = item & 63; const long tokb = (long)b * SEQ + blk * 128;
        stage_issue(R, tid, A.PROJ + (tokb - 128) * LDP + 384 + 64 * hkv, A.PROJ + (tokb - 128) * LDP + 512 + 64 * hkv, LDP, blk == 0 ? 128 : 0); }
    else { const int b = q >> 7, h = (q >> 5) & 3; stage_issue(R, tid, A.MKV + (long)(b * 256) * 512 + 64 * h, A.MKV + (long)(b * 256) * 512 + 256 + 64 * h, 512, 0); }
}
__device__ __forceinline__ void attn_phase(LAS unsigned char* L, const AttnArgs A, unsigned* qctr, volatile LAS unsigned* qw, int tid_in) {
    const int w = __builtin_amdgcn_readfirstlane(tid_in >> 6);
    { int lt_ = tid_in; asm volatile("" : "+v"(lt_)); const int tid = lt_;
      LAS float* bl = (LAS float*)(L + A_BIAS); for (int i = tid; i < 6 * LDB; i += 512) { const int hh = i / LDB, d = i % LDB - BOFF; bl[i] = (d >= 0 && d < 128) ? A.biastab[d * 6 + hh] : 0.f; } }
    if (tid_in == 0) qw[0] = atomicAdd(qctr, 1u);
    AT_BAR(); int q = (int)qw[0]; AT_BAR();
    StageRegs SR; if (q < 512) { int lt_ = tid_in; asm volatile("" : "+v"(lt_)); item_stage_issue(SR, A, q, lt_); }
    while (q < 512) {
        int lt_ = tid_in; asm volatile("" : "+v"(lt_)); const int tid = lt_, lane = lt_ & 63, fr = lane & 15, fq = lane >> 4;
        const bool swa = q >= 256;
        stage_commit(L, SR, tid, swa ? A.gk : A.gmk);
        QRaw qa, qb, qc; int b, hh, blk;
        if (swa) { const int item = q - 256; b = item >> 7; hh = (item >> 6) & 1; blk = item & 63; const bf16_t* qp = A.PROJ + ((long)b * SEQ + blk * 128 + 16 * w + fr) * LDP + 192 * hh;
            qa = q_raw(qp, fq); qb = q_raw(qp + 64, fq); qc = q_raw(qp + 128, fq); }
        else { b = q >> 7; hh = (q >> 5) & 3; blk = q & 31; const bf16_t* qp = A.PROJ + ((long)b * SEQ + (2 * blk) * 128 + 16 * w + fr) * LDP + 1984 + 64 * hh;
            qa = q_raw(qp, fq); qb = q_raw(qp + (long)128 * LDP, fq); qc = qb; }
        if (tid_in == 0) qw[0] = atomicAdd(qctr, 1u);
        AT_BAR(); const int qn = (int)qw[0];
        if (qn < 512) item_stage_issue(SR, A, qn, tid);
        if (swa) { const long tokb = (long)b * SEQ + blk * 128;
#pragma unroll 1
            for (int g = 0; g < 3; ++g) { const int hq = 3 * hh + g; bf16x8 q0, q1; const QRaw cq = g == 0 ? qa : (g == 1 ? qb : qc); q_finish(cq, A.gq, fq, q0, q1);
                attn_wave<10, true>(L, q0, q1, w & ~1, 16 * w, hq, A.sinks[hq], blk == 0, A.MIX + (tokb + 16 * w) * DM + 64 * hq, fr, fq); } }
        else {
#pragma unroll 1
            for (int u = 0; u < 2; ++u) { const long tokb = (long)b * SEQ + (2 * blk + u) * 128; bf16x8 q0, q1; const QRaw cq = u == 0 ? qa : qb; q_finish(cq, A.gmq, fq, q0, q1);
                attn_wave<16, false>(L, q0, q1, 0, 16 * w, 0, 0.f, false, A.MIX + (tokb + 16 * w) * DM + 768 + 64 * hh, fr, fq); } }
        AT_BAR();
        q = qn;
    }
}
}
constexpr int NWAVES = 8;
namespace mk {
#ifndef PROF_PH
#define PROF_PH -1
#endif
#ifndef PROF_N
#define PROF_N 1
#endif
#ifndef PROF_TA
#define PROF_TA -1
#endif
#ifndef PROF_TB
#define PROF_TB -1
#endif
#define REPEAT(k) for (int rep_ = 0; rep_ < ((PROF_PH) == (k) ? (PROF_N) : 1); ++rep_)
#ifndef FAST_RWKV
#define FAST_RWKV 1
#endif
#ifndef FAST_ATTN
#define FAST_ATTN 1
#endif

struct Args { const float* in[N_IN]; float* out; unsigned char* ws; int ph_lo, ph_hi; };

__device__ __forceinline__ unsigned pk2(float lo, float hi) { typedef float f2_t __attribute__((ext_vector_type(2))); typedef __bf16 b2_t __attribute__((ext_vector_type(2))); f2_t v = {lo, hi}; return __builtin_bit_cast(unsigned, __builtin_convertvector(v, b2_t)); }
__device__ __forceinline__ float wave_sum(float v) {
#pragma unroll
    for (int o = 1; o < 64; o <<= 1) v += __shfl_xor(v, o);
    return v;
}
template <int MODE> __device__ __forceinline__ void transpose_item(const float* W, const float* g, int K, int N, bf16_t* WT, LAS float* scr, int item, int lane) {
    const int nblk = N / 32, kb = item / nblk, nb = item % nblk, k0 = 64 * kb, n0 = 32 * nb;
    float tv[32];
#pragma unroll
    for (int i = 0; i < 32; ++i) tv[i] = W[(size_t)(k0 + 2 * i + (lane >> 5)) * N + n0 + (lane & 31)];
#pragma unroll
    for (int i = 0; i < 32; ++i) { const int kk = 2 * i + (lane >> 5); float v = tv[i]; if (g) v *= g[k0 + kk]; scr[kk * 33 + (lane & 31)] = v; }
    LDS_WAIT(); asm volatile("" ::: "memory");
    const int c = lane & 7;
#pragma unroll
    for (int j = 0; j < 4; ++j) { const int n = (lane >> 3) + 8 * j; const LAS float* s = scr + (8 * c) * 33 + n;
        v4u o; o.x = pk2(s[0 * 33], s[1 * 33]); o.y = pk2(s[2 * 33], s[3 * 33]); o.z = pk2(s[4 * 33], s[5 * 33]); o.w = pk2(s[6 * 33], s[7 * 33]);
        int nr = n0 + n; if (MODE == 2) nr = nr < 1920 ? nr : nr + 64;
        if (MODE == 1) nr = nr < 2816 ? 256 * (nr >> 7) + (nr & 127) : 256 * ((nr - 2816) >> 7) + 128 + ((nr - 2816) & 127);
        *(GAS v4u*)(WT + (size_t)nr * K + k0 + 8 * c) = o; }
    LDS_WAIT(); asm volatile("" ::: "memory");
}
template <int R> __device__ __forceinline__ void rows_to_bf16(const float* x, bf16_t* o, float* ssq, long row0, long rstride, int lane) {
    f32x4 v[R][4]; float s[R];
#pragma unroll
    for (int r = 0; r < R; ++r) { const GAS f32x4* xr = (const GAS f32x4*)(x + (row0 + r * rstride) * DM) + lane;
#pragma unroll
        for (int j = 0; j < 4; ++j) v[r][j] = xr[64 * j]; }
#pragma unroll
    for (int r = 0; r < R; ++r) { s[r] = 0.f;
#pragma unroll
        for (int j = 0; j < 4; ++j) s[r] += (v[r][j].x * v[r][j].x + v[r][j].y * v[r][j].y) + (v[r][j].z * v[r][j].z + v[r][j].w * v[r][j].w); }
#pragma unroll
    for (int o2 = 1; o2 < 64; o2 <<= 1) {
#pragma unroll
        for (int r = 0; r < R; ++r) s[r] += __shfl_xor(s[r], o2); }
#pragma unroll
    for (int r = 0; r < R; ++r) { GAS unsigned long long* o8 = (GAS unsigned long long*)(o + (row0 + r * rstride) * DM) + lane;
#pragma unroll
        for (int j = 0; j < 4; ++j) o8[64 * j] = (unsigned long long)pk2(v[r][j].x, v[r][j].y) | ((unsigned long long)pk2(v[r][j].z, v[r][j].w) << 32);
        if (lane == 0) ssq[row0 + r * rstride] = s[r]; }
}
__device__ __forceinline__ void row_to_bf16(const float* xrow, bf16_t* orow, float* ssq_out, int lane) {
    const GAS f32x4* xr = (const GAS f32x4*)xrow + lane; f32x4 v[4]; float s = 0.f;
#pragma unroll
    for (int j = 0; j < 4; ++j) { v[j] = xr[64 * j]; s += (v[j].x * v[j].x + v[j].y * v[j].y) + (v[j].z * v[j].z + v[j].w * v[j].w); }
    s = wave_sum(s);
    GAS unsigned long long* o8 = (GAS unsigned long long*)orow + lane;
#pragma unroll
    for (int j = 0; j < 4; ++j) o8[64 * j] = (unsigned long long)pk2(v[j].x, v[j].y) | ((unsigned long long)pk2(v[j].z, v[j].w) << 32);
    if (lane == 0) *ssq_out = s;
}

__global__ void __launch_bounds__(NWAVES * 64, 2) mk_fwd(Args args) {
    extern __shared__ __attribute__((aligned(16))) unsigned char lds[];
    LAS unsigned char* L = (LAS unsigned char*)lds;
    volatile LAS unsigned* MISC = (volatile LAS unsigned*)(L + MISC_OFF);
    const int tid0 = threadIdx.x; const int wave0 = __builtin_amdgcn_readfirstlane(tid0 >> 6);
    const int G = gridDim.x;
    unsigned char* ws = args.ws;
    gu32* ctl = (gu32*)(ws + WS_CTL);
    for (int u = tid0; u < (LDS_BYTES - LDSCTL_OFF) / 4; u += NWAVES * 64) ((LAS unsigned*)(L + LDSCTL_OFF))[u] = 0u;
    __syncthreads();
    XcdBarrier bar = xcd_barrier_post((unsigned*)(ctl + CW_BAR), MISC + 8);
    const int lo = args.ph_lo, hi = args.ph_hi;
    int ph = 0;
#define PH_BEGIN if (lo <= ph && ph < hi) { if ((PROF_TA) >= 0 && blockIdx.x == 0 && tid0 == 0) MISC[24 + ph] = (unsigned)__builtin_amdgcn_s_memrealtime(); unsigned char* wsp = args.ws; asm volatile("" : "+s"(wsp)); int tid = wave0 * 64 + (int)__builtin_amdgcn_mbcnt_hi(~0u, __builtin_amdgcn_mbcnt_lo(~0u, 0u)); asm volatile("" : "+v"(tid)); const int lane = tid & 63, wave = __builtin_amdgcn_readfirstlane(tid >> 6); const long gtid = (long)blockIdx.x * (NWAVES * 64) + tid; const int gw = blockIdx.x * NWAVES + wave; LAS float* scr = (LAS float*)(L + wave * 16384); (void)lane; (void)gtid; (void)gw; (void)scr;
#define PH_END   if (ph + 1 < hi) { xcd_barrier(bar); if ((PROF_PH) == 30 && ph == 3) for (int xb_ = 0; xb_ < 10; ++xb_) xcd_barrier(bar); } } ++ph;
    float* out = args.out;
#define SSQ_A ((float*)(wsp + WS_CTL + CTL_SSQ))
#define SSQ_B (SSQ_A + 3 * MTOK)
#define biastab ((float*)(wsp + WS_SMALL + SM_BIAS))
#define ssqm ((float*)(wsp + WS_SMALL + SM_SSQM))
#define MKV ((bf16_t*)(wsp + WS_SMALL + SM_MKV))
#define MEMB ((bf16_t*)(wsp + WS_MEMB))
#define Wt_in ((bf16_t*)(wsp + (l == 0 ? WS_WT + WT_IN : WS_WIN1)))
#define Wt_out ((bf16_t*)(wsp + WS_WT + WT_OUT))
#define Wt_up ((bf16_t*)(wsp + WS_WT + WT_UP))
#define Wt_down ((bf16_t*)(wsp + WS_WT + WT_DOWN))
#define Wt_mkv ((bf16_t*)(wsp + (l == 0 ? WS_WT + WT_MKV : WS_WIN1 + 4718592)))
#define XB ((bf16_t*)(wsp + WS_XB))
#define VF ((bf16_t*)(wsp + WS_VF))
#define PROJ ((bf16_t*)(wsp + WS_PROJ))
#define MIX ((bf16_t*)(wsp + WS_MIX))
#define U ((bf16_t*)(wsp + WS_U))
#define ACT ((bf16_t*)(wsp + WS_ACT))
#define PA ((size_t)MTOK * 384)
#define pR ((bf16_t*)(wsp + WS_PREP))
#define pK (pR + PA)
#define pV (pR + 2 * PA)
#define pKK (pR + 3 * PA)
#define pB (pR + 4 * PA)
#define pLD (pR + 5 * PA)
    const long gsize = (long)G * (NWAVES * 64);
    const int NGW = G * NWAVES;

#define MK_W() sk::RwkvW W{args.in[I_MU] + l * 1280, args.in[I_MUV], args.in[I_W0] + l * 384, args.in[I_W2] + l * 32 * 384, args.in[I_A0] + l * 384, args.in[I_A2] + l * 32 * 384, args.in[I_V0], args.in[I_V2], args.in[I_G2] + l * 64 * 384, args.in[I_KK] + l * 384, args.in[I_KA] + l * 384, args.in[I_RK] + l * 384, args.in[I_LNW] + l * 384, args.in[I_LNB] + l * 384};
#define MK_CBUF() const rw::ChunkBufs cbuf{(bf16_t*)(wsp + WS_PT), (bf16_t*)(wsp + WS_G), (float*)(wsp + WS_Z), (bf16_t*)(wsp + WS_YV), (bf16_t*)(wsp + WS_S0), (bf16_t*)(wsp + WS_VF), (float*)(wsp + WS_DOT), (const bf16_t*)(wsp + WS_SMALL + SM_W2T + l * SM_LORA_L), (const bf16_t*)(wsp + WS_SMALL + SM_A2T + l * SM_LORA_L), (const bf16_t*)(wsp + WS_SMALL + SM_V2T + l * SM_LORA_L), (const bf16_t*)(wsp + WS_SMALL + SM_G2T + l * SM_LORA_L)};
    for (int l = 0; l < 2; ++l) {
        const float* xin = l == 0 ? args.in[I_X] : out;
        if (l == 0) {
        PH_BEGIN
            REPEAT(0) {
            const int I_IN = 16 * 68, I_KV = 16 * 16, NIT = 2 * (I_IN + I_KV);
            for (int it = gw; it < NIT; it += NGW) {
                int r = it; const int ll = r >= I_IN + I_KV ? 1 : 0; r -= ll * (I_IN + I_KV);
                bf16_t* win = (bf16_t*)(wsp + (ll == 0 ? WS_WT + WT_IN : WS_WIN1)); bf16_t* wkv = (bf16_t*)(wsp + (ll == 0 ? WS_WT + WT_MKV : WS_WIN1 + 4718592));
                if (r < I_IN) transpose_item<2>(args.in[I_WIN] + (size_t)ll * 1024 * 2176, args.in[I_MIXG] + ll * 1024, 1024, 2176, win, scr, r, lane);
                else transpose_item<0>(args.in[I_WMKV] + (size_t)ll * 1024 * 512, args.in[I_MEMG] + ll * 1024, 1024, 512, wkv, scr, r - I_IN, lane);
            }
            for (long i = gtid; i < 2 * 128 * 1024; i += gsize) { const int ll = (int)(i >> 17), n = (int)(i >> 10) & 127, k = (int)(i & 1023); float v = 0.f;
                if (ll > 0 && n < 16) v = args.in[I_WINV][k * 16 + n] * args.in[I_MIXG][1024 + k];
                ((bf16_t*)(wsp + (ll == 0 ? WS_WT + WT_IN : WS_WIN1)))[(size_t)(n < 64 ? 1920 + n : 2176 + n) * 1024 + k] = f2bf(v); }
            for (long i = gtid; i < 2 * RP_SIZE; i += gsize) { const int ll = (int)(i / RP_SIZE), r = (int)(i % RP_SIZE); float v;
                if (r < RP_MUV) v = args.in[I_MU][ll * 1280 + r]; else if (r < RP_W0) v = args.in[I_MUV][r - RP_MUV]; else if (r < RP_A0) v = args.in[I_W0][ll * 384 + r - RP_W0];
                else if (r < RP_V0) v = args.in[I_A0][ll * 384 + r - RP_A0]; else if (r < RP_KK) v = args.in[I_V0][r - RP_V0]; else if (r < RP_KA) v = args.in[I_KK][ll * 384 + r - RP_KK];
                else if (r < RP_RK) v = args.in[I_KA][ll * 384 + r - RP_KA]; else if (r < RP_LNW) v = args.in[I_RK][ll * 384 + r - RP_RK]; else if (r < RP_LNB) v = args.in[I_LNW][ll * 384 + r - RP_LNW];
                else v = args.in[I_LNB][ll * 384 + r - RP_LNB];
                ((float*)(wsp + WS_SMALL + SM_RWP + ll * RWP_BYTES))[r] = v; }
            for (long i = gtid; i < 2 * 384 * 160; i += gsize) { const int ll = (int)(i / (384 * 160)), r2 = (int)(i % (384 * 160)), hc = r2 / 160, j = r2 % 160; bf16_t* sm = (bf16_t*)(wsp + WS_SMALL + ll * SM_LORA_L);
                if (j < 32) sm[SM_W2T / 2 + hc * 32 + j] = f2bf(args.in[I_W2][(size_t)ll * 32 * 384 + j * 384 + hc]);
                else if (j < 64) sm[SM_A2T / 2 + hc * 32 + (j - 32)] = f2bf(args.in[I_A2][(size_t)ll * 32 * 384 + (j - 32) * 384 + hc]);
                else if (j < 96) sm[SM_V2T / 2 + hc * 32 + (j - 64)] = f2bf((j - 64) < 16 ? args.in[I_V2][(j - 64) * 384 + hc] : 0.f);
                else sm[SM_G2T / 2 + hc * 64 + (j - 96)] = f2bf(args.in[I_G2][(size_t)ll * 64 * 384 + (j - 96) * 384 + hc]); }
            if (MTOK % (4 * NGW) == 0) { for (long m = gw; m < MTOK; m += 4L * NGW) rows_to_bf16<4>(args.in[I_X], XB, SSQ_A, m, NGW, lane); }
            else { for (int m = gw; m < MTOK; m += NGW) row_to_bf16(args.in[I_X] + (size_t)m * DM, XB + (size_t)m * DM, SSQ_A + m, lane); }
            for (int m = gw; m < 512; m += NGW) row_to_bf16(args.in[I_MEM] + (size_t)m * DM, MEMB + (size_t)m * DM, ssqm + m, lane);
            sk::d_biastab(args.in[I_RELB], biastab, gtid, gsize);
            }
        PH_END
        }
        PH_BEGIN
            REPEAT(1)
            { pg8::Gemm g{XB, Wt_in, MTOK, 2048, 1024}; pg8::StaticOrder S; S.init(MTOK, 2048, G, (int)blockIdx.x);
              pg8::EpiScaleBf16 E{PROJ, LDP, SSQ_A + (size_t)l * MTOK};
              pg8::gemm_phase<pg8::EpiScaleBf16, pg8::StaticOrder, true, true>(L, g, S, E, tid); }
        PH_END
        PH_BEGIN
            MK_W(); MK_CBUF(); (void)cbuf;
#if !FAST_ATTN
            sk::d_qknorm(PROJ, MTOK, LDP, args.in[I_AQN] + l * 64, args.in[I_AKN] + l * 64, args.in[I_MQN] + l * 64, 0, gtid, gsize);
            sk::d_qknorm(MKV, 512, 512, nullptr, nullptr, args.in[I_MKN] + l * 64, 1, gtid, gsize);
#endif
#if FAST_RWKV
            {
              const bool t8 = blockIdx.x < 64;
              const pg8::Gemm g = t8 ? pg8::Gemm{XB, Wt_in + (size_t)2048 * 1024, MTOK, 256, 1024} : pg8::Gemm{MEMB, Wt_mkv, 512, 512, 1024};
              pg8::StaticOrder S; if (t8) S.init(MTOK, 256, G, (int)blockIdx.x); else S.init(512, 512, G, (int)((blockIdx.x + 192) % G));
              const pg8::EpiScaleBf16 E = t8 ? pg8::EpiScaleBf16{PROJ + 2048, LDP, SSQ_A + (size_t)l * MTOK} : pg8::EpiScaleBf16{MKV, 512, ssqm};
              pg8::gemm_phase<pg8::EpiScaleBf16, pg8::StaticOrder, true, true>(L, g, S, E, tid); }
            { unsigned* qc = (unsigned*)(ctl + CW_CHQ + 64 * l);
              int q = rw::chunk_phase(L, wsp, l, tid, qc, MISC + 21);
              const int I_OUT = 16 * 32, I_UP = 16 * 176, I_DN = 44 * 32, NIT = I_OUT + I_UP + I_DN;
              for (;;) { const int it = (q - rw::NITEMS) * NWAVES + wave;
                  if ((q - rw::NITEMS) * NWAVES >= NIT) break;
                  if (it < NIT) { int r = it;
                      if (r < I_OUT) transpose_item<0>(args.in[I_WOUT] + (size_t)l * 1024 * 1024, nullptr, 1024, 1024, Wt_out, scr, r, lane);
                      else if (r < I_OUT + I_UP) transpose_item<1>(args.in[I_WUP] + (size_t)l * 1024 * 5632, args.in[I_FFNG] + l * 1024, 1024, 5632, Wt_up, scr, r - I_OUT, lane);
                      else transpose_item<0>(args.in[I_WDOWN] + (size_t)l * 2816 * 1024, nullptr, 2816, 1024, Wt_down, scr, r - I_OUT - I_UP, lane); }
                  __syncthreads(); if (tid == 0) MISC[21] = atomicAdd(qc, 1u); __syncthreads(); q = (int)MISC[21]; __syncthreads(); } }
#else
            sk::d_rwkv_prep(PROJ, W, l, VF, pR, pK, pV, pKK, pB, pLD, gtid, gsize);
#endif
        PH_END
        PH_BEGIN
            MK_CBUF(); (void)cbuf;
            if (blockIdx.x < 48) {
#if FAST_RWKV
                REPEAT(3) { __syncthreads(); if (tid < 8) MISC[16 + tid] = 0u; __syncthreads();
                  const int sbh = (int)blockIdx.x >> 2, stj = (int)blockIdx.x & 3;
                  if (wave == 0) rw::scan_compute(L, cbuf, sbh, stj, lane, MISC + 16); else if (wave < 4) rw::scan_loader(L, cbuf, sbh, stj, wave - 1, lane, MISC + 16);
 }
#endif
            } else {
#if FAST_ATTN
                const at::AttnArgs A{PROJ, MKV, MIX, biastab, args.in[I_SINK] + l * 6, args.in[I_AQN] + l * 64, args.in[I_AKN] + l * 64, args.in[I_MQN] + l * 64, args.in[I_MKN] + l * 64};
                at::attn_phase(L, A, (unsigned*)(ctl + CW_ATTQ + 64 * l), MISC + 20, tid);
#else
                const long gt2 = (long)(blockIdx.x - BATCH * 6) * (NWAVES * 64) + tid, gs2 = (long)(G - BATCH * 6) * (NWAVES * 64);
                REPEAT(7) sk::d_swa(PROJ, MIX, biastab, args.in[I_SINK] + l * 6, gt2, gs2);
                REPEAT(8) sk::d_memattn(PROJ, MKV, MIX, gt2, gs2);
#endif
            }
        PH_END
        PH_BEGIN
            MK_W(); MK_CBUF(); (void)cbuf;
#if FAST_RWKV
            REPEAT(4) rw::out_phase(L, wsp, l, tid, (int)blockIdx.x, G);
#else
            sk::d_rwkv_fin(PROJ, W, pR, pK, pV, MIX, gtid, gsize);
#endif
        PH_END
        PH_BEGIN
            if ((PROF_PH) == 31) { pg8::Gemm g2{MIX, Wt_out, MTOK, 1024, 1024}; pg8::StaticOrder S2; S2.init(MTOK, 1024, G, (int)blockIdx.x); pg8::EpiScaleBf16 E2{PROJ, 1024, SSQ_A}; pg8::gemm_phase<pg8::EpiScaleBf16, pg8::StaticOrder, true, true>(L, g2, S2, E2, tid); }
            pg8::Gemm g{MIX, Wt_out, MTOK, 1024, 1024}; pg8::StaticOrder S; S.init(MTOK, 1024, G, (int)blockIdx.x);
            pg8::EpiResid<false> E{out, XB, SSQ_B + (size_t)l * MTOK, 1024};
            pg8::gemm_phase<pg8::EpiResid<false>, pg8::StaticOrder, true, true>(L, g, S, E, tid);
        PH_END
        PH_BEGIN
            REPEAT(5) {
            pg8::Gemm g{XB, Wt_up, 66 * 256, 5632, 1024}; pg8::StaticOrder S; S.init(66 * 256, 5632, G, (int)blockIdx.x);
            pg8::EpiConvAct E{ACT, SSQ_B + (size_t)l * MTOK, args.in[I_CW] + (size_t)l * 3 * 5632, args.in[I_CB] + (size_t)l * 5632};
            pg8::gemm_phase<pg8::EpiConvAct, pg8::StaticOrder, true, true>(L, g, S, E, tid); }
        PH_END
        PH_BEGIN
            if ((PROF_PH) == 32) { pg8::Gemm g2{ACT, Wt_down, MTOK, 1024, 2816}; pg8::StaticOrder S2; S2.init(MTOK, 1024, G, (int)blockIdx.x); pg8::EpiScaleBf16 E2{PROJ, 1024, SSQ_A}; pg8::gemm_phase<pg8::EpiScaleBf16, pg8::StaticOrder, true, true>(L, g2, S2, E2, tid); }
            pg8::Gemm g{ACT, Wt_down, MTOK, 1024, 2816}; pg8::StaticOrder S; S.init(MTOK, 1024, G, (int)blockIdx.x);
            if (l == 0) { pg8::EpiResid<false> E{out, XB, SSQ_A + (size_t)(l + 1) * MTOK, 1024}; pg8::gemm_phase<pg8::EpiResid<false>, pg8::StaticOrder, true, true>(L, g, S, E, tid); }
            else { pg8::EpiResid<true> E{out, XB, nullptr, 1024}; pg8::gemm_phase<pg8::EpiResid<true>, pg8::StaticOrder, true, true>(L, g, S, E, tid); }
        PH_END
    }
    if ((PROF_TA) >= 0 && blockIdx.x == 0 && tid0 == 0) {
        MISC[24 + ph] = (unsigned)__builtin_amdgcn_s_memrealtime();
        const unsigned ta = MISC[24 + (PROF_TA) + 1] - MISC[24 + (PROF_TA)], tb = (PROF_TB) >= 0 ? MISC[24 + (PROF_TB) + 1] - MISC[24 + (PROF_TB)] : 0u;
        const unsigned long long extra = (unsigned long long)ta + 1000ull * (unsigned long long)(((tb + 50u) / 100u) * 100u);
        const unsigned long long t0 = __builtin_amdgcn_s_memrealtime(); while (__builtin_amdgcn_s_memrealtime() - t0 < extra) __builtin_amdgcn_s_sleep(32);
    }
#undef PH_BEGIN
#undef PH_END
}
constexpr int N_PHASES = 1 + 2 * 7;
}

#ifndef MK_PER_PHASE
#define MK_PER_PHASE 0
#endif
extern "C" void kernel_launch(void* const* d_in, const int* in_sizes, int n_in, void* d_out, int out_size, void* d_ws, size_t ws_size, hipStream_t stream) {
    static int grid = 0;
    if (grid == 0) {
        if (n_in != N_IN || out_size != MTOK * DM || ws_size < mk::WS_END) { fprintf(stderr, "kernel_launch: unexpected shapes (n_in %d out %d ws %zu)\n", n_in, out_size, ws_size); grid = -1; return; }
        int dev = 0, cus = 0, per_cu = 0;
        if (hipGetDevice(&dev) != hipSuccess || hipDeviceGetAttribute(&cus, hipDeviceAttributeMultiprocessorCount, dev) != hipSuccess) { grid = -1; return; }
        if (hipFuncSetAttribute((const void*)mk::mk_fwd, hipFuncAttributeMaxDynamicSharedMemorySize, mk::LDS_BYTES) != hipSuccess) { fprintf(stderr, "kernel_launch: hipFuncSetAttribute failed\n"); grid = -1; return; }
        if (hipOccupancyMaxActiveBlocksPerMultiprocessor(&per_cu, (const void*)mk::mk_fwd, NWAVES * 64, mk::LDS_BYTES) != hipSuccess || per_cu < 1) { fprintf(stderr, "kernel_launch: occupancy query says %d blocks per CU\n", per_cu); }
        (void)hipGetLastError();
        grid = cus;
    }
    if (grid < 0) return;
    if (hipMemsetAsync((char*)d_ws + mk::WS_CTL, 0, mk::CTL_ZERO_BYTES, stream) != hipSuccess) return;
    mk::Args a{};
    for (int i = 0; i < N_IN; ++i) a.in[i] = (const float*)d_in[i];
    a.out = (float*)d_out; a.ws = (unsigned char*)d_ws;
#if MK_PER_PHASE
    for (int p = 0; p < mk::N_PHASES; ++p) { a.ph_lo = p; a.ph_hi = p + 1; hipLaunchKernelGGL(mk::mk_fwd, dim3(grid), dim3(NWAVES * 64), mk::LDS_BYTES, stream, a); }
#else
    a.ph_lo = 0; a.ph_hi = mk::N_PHASES;
    hipLaunchKernelGGL(mk::mk_fwd, dim3(grid), dim3(NWAVES * 64), mk::LDS_BYTES, stream, a);
#endif
}
```

```cpp
#define MK_BUILD 1
#ifndef HOST_SIM
#include <hip/hip_runtime.h>
#include <cstdio>
#include <cstdint>
#endif
#ifndef SEQ_LEN
#define SEQ_LEN 8192
#endif
typedef unsigned short bf16_t;
constexpr int BATCH = 2, SEQ = SEQ_LEN, DM = 1024, MTOK = BATCH * SEQ, DFF = 2816, LDP = 2304  ;
constexpr float EPS = 1e-6f, GN_EPS = 64e-5f;
__host__ __device__ __forceinline__ float bf2f(bf16_t h) { unsigned u = (unsigned)h << 16; return __builtin_bit_cast(float, u); }
__host__ __device__ __forceinline__ bf16_t f2bf(float f) { unsigned u = __builtin_bit_cast(unsigned, f); return (bf16_t)((u + 0x7fffu + ((u >> 16) & 1u)) >> 16); }
__host__ __device__ __forceinline__ int t5_bucket(int dist) {
    if (dist < 16) return dist;
    const float v = logf((float)dist / 16.0f) / 2.0794415416798357f * 16.0f;
    int large = 16 + (int)v; return large < 31 ? large : 31;
}
constexpr size_t MiB = 1u << 20;
enum { I_X = 0, I_MEM, I_RELB, I_MIXG, I_WIN, I_WINV, I_AQN, I_AKN, I_SINK, I_MU, I_MUV, I_W0, I_W2, I_A0, I_A2, I_V0, I_V2, I_G2, I_KK, I_KA, I_RK, I_LNW, I_LNB, I_MEMG, I_WMKV, I_MQN, I_MKN, I_WOUT, I_FFNG, I_WUP, I_CW, I_CB, I_WDOWN, N_IN };
#ifndef PROF_PH
#define PROF_PH -1
#endif
#ifndef PROF_N
#define PROF_N 1
#endif
namespace sk {

__device__ __forceinline__ void d_wt(const float* W, const float* g, bf16_t* Wt, int K, int N, int Npad, long gtid, long gsize) {
    const long total = (long)Npad * K;
    for (long idx = gtid; idx < total; idx += gsize) {
        const int n = (int)(idx / K), k = (int)(idx % K);
        float v = 0.f;
        if (n < N) { v = W[(long)k * N + n]; if (g) v *= g[k]; }
        Wt[idx] = f2bf(v);
    }
}
#ifndef MK_BUILD
__global__ void k_wt(const float* W, const float* g, bf16_t* Wt, int K, int N, int Npad) { d_wt(W, g, Wt, K, N, Npad, (long)blockIdx.x * blockDim.x + threadIdx.x, (long)gridDim.x * blockDim.x); }
#endif
__device__ __forceinline__ void d_rowprep(const float* x, bf16_t* xb, float* ssq, int rows, long gtid, long gsize) {
    for (long r = gtid; r < rows; r += gsize) {
        const float* xr = x + (long)r * DM; bf16_t* o = xb + (long)r * DM; float s = 0.f;
        for (int c = 0; c < DM; ++c) { const float v = xr[c]; s += v * v; o[c] = f2bf(v); }
        ssq[r] = s;
    }
}
#ifndef MK_BUILD
__global__ void k_rowprep(const float* x, bf16_t* xb, float* ssq, int rows) { d_rowprep(x, xb, ssq, rows, (long)blockIdx.x * blockDim.x + threadIdx.x, (long)gridDim.x * blockDim.x); }
#endif
__device__ __forceinline__ void d_biastab(const float* rel_bias, float* tab, long gtid, long gsize) {
        for (long i = gtid; i < 128 * 6; i += gsize) { const int dist = i / 6, hq = i % 6; tab[i] = rel_bias[t5_bucket(dist) * 6 + hq]; }
}
#ifndef MK_BUILD
__global__ void k_biastab(const float* rel_bias, float* tab) { d_biastab(rel_bias, tab, (long)blockIdx.x * blockDim.x + threadIdx.x, (long)gridDim.x * blockDim.x); }
#endif
__device__ __forceinline__ void d_qknorm(bf16_t* P, int rows, int ld, const float* gq, const float* gk, const float* gm, int mode, long gtid, long gsize) {
    const int nj = mode == 0 ? 12 : 4;
    const long total = (long)rows * nj;
    for (long idx = gtid; idx < total; idx += gsize) {
        const int row = (int)(idx / nj), j = (int)(idx % nj);
        int col; const float* g;
        if (mode == 0) { if (j < 6) { col = 64 * j; g = gq; } else if (j < 8) { col = 384 + 64 * (j - 6); g = gk; } else { col = 1920 + 64 * (j - 8); g = gm; } }
        else { col = 64 * j; g = gm; }
        bf16_t* p = P + (long)row * ld + col; float s = 0.f;
        for (int d = 0; d < 64; ++d) { const float v = bf2f(p[d]); s += v * v; }
        const float rs = 1.0f / sqrtf(s * (1.0f / 64.0f) + EPS);
        for (int d = 0; d < 64; ++d) p[d] = f2bf(bf2f(p[d]) * rs * g[d]);
    }
}
#ifndef MK_BUILD
__global__ void k_qknorm(bf16_t* P, int rows, int ld, const float* gq, const float* gk, const float* gm, int mode) { d_qknorm(P, rows, ld, gq, gk, gm, mode, (long)blockIdx.x * blockDim.x + threadIdx.x, (long)gridDim.x * blockDim.x); }
#endif
__device__ __forceinline__ void d_swa(const bf16_t* P, bf16_t* MIX, const float* biastab, const float* sinks, long gtid, long gsize) {
    const long total = (long)MTOK * 6;
    for (long idx = gtid; idx < total; idx += gsize) {
        const int tok = (int)(idx / 6), hq = (int)(idx % 6), hkv = hq / 3, t = tok % SEQ;
        float q[64], o[64];
#pragma unroll
        for (int d = 0; d < 64; ++d) { q[d] = bf2f(P[(long)tok * LDP + 64 * hq + d]) * 0.125f; o[d] = 0.f; }
        float m = sinks[hq], l = 1.0f;
        const int j0 = t - 127 < 0 ? 0 : t - 127;
        for (int j = j0; j <= t; ++j) {
            const bf16_t* kr = P + (long)(tok - (t - j)) * LDP + 384 + 64 * hkv; const bf16_t* vr = kr + 128;
            float s = 0.f;
#pragma unroll
            for (int d = 0; d < 64; ++d) s += q[d] * bf2f(kr[d]);
            s += biastab[(t - j) * 6 + hq];
            const float mn = fmaxf(m, s), f = expf(m - mn), e = expf(s - mn);
            l = l * f + e; m = mn;
#pragma unroll
            for (int d = 0; d < 64; ++d) o[d] = o[d] * f + e * bf2f(vr[d]);
        }
        const float inv = 1.0f / l;
#pragma unroll
        for (int d = 0; d < 64; ++d) MIX[(long)tok * DM + 64 * hq + d] = f2bf(o[d] * inv);
    }
}
#ifndef MK_BUILD
__global__ __launch_bounds__(256) void k_swa(const bf16_t* P, bf16_t* MIX, const float* biastab, const float* sinks) { d_swa(P, MIX, biastab, sinks, (long)blockIdx.x * blockDim.x + threadIdx.x, (long)gridDim.x * blockDim.x); }
#endif
__device__ __forceinline__ void d_memattn(const bf16_t* P, const bf16_t* MKV, bf16_t* MIX, long gtid, long gsize) {
    const long total = (long)MTOK * 4;
    for (long idx = gtid; idx < total; idx += gsize) {
        const int tok = (int)(idx / 4), h = (int)(idx % 4), b = tok / SEQ;
        float q[64], o[64];
#pragma unroll
        for (int d = 0; d < 64; ++d) { q[d] = bf2f(P[(long)tok * LDP + 1920 + 64 * h + d]) * 0.125f; o[d] = 0.f; }
        float m = -1e30f, l = 0.f;
        for (int j = 0; j < 256; ++j) {
            const bf16_t* kr = MKV + (long)(b * 256 + j) * 512 + 64 * h; const bf16_t* vr = kr + 256;
            float s = 0.f;
#pragma unroll
            for (int d = 0; d < 64; ++d) s += q[d] * bf2f(kr[d]);
            const float mn = fmaxf(m, s), f = expf(m - mn), e = expf(s - mn);
            l = l * f + e; m = mn;
#pragma unroll
            for (int d = 0; d < 64; ++d) o[d] = o[d] * f + e * bf2f(vr[d]);
        }
        const float inv = 1.0f / l;
#pragma unroll
        for (int d = 0; d < 64; ++d) MIX[(long)tok * DM + 768 + 64 * h + d] = f2bf(o[d] * inv);
    }
}
#ifndef MK_BUILD
__global__ __launch_bounds__(256) void k_memattn(const bf16_t* P, const bf16_t* MKV, bf16_t* MIX) { d_memattn(P, MKV, MIX, (long)blockIdx.x * blockDim.x + threadIdx.x, (long)gridDim.x * blockDim.x); }
#endif
__device__ __forceinline__ float shifted(const bf16_t* P, int tok, int col, float mu) {
    const float p = bf2f(P[(long)tok * LDP + col]);
    const float prev = (tok % SEQ) == 0 ? 0.f : bf2f(P[(long)(tok - 1) * LDP + col]);
    return p + mu * (prev - p);
}
struct RwkvW { const float *mu, *mu_v, *w0, *w2, *a0, *a2, *v0, *v2, *g2, *k_k, *k_a, *r_k, *ln_w, *ln_b; };
__device__ __forceinline__ void d_rwkv_prep(const bf16_t* P, RwkvW W, int layer, bf16_t* VFIRST, bf16_t* R, bf16_t* K, bf16_t* V, bf16_t* KK, bf16_t* B, bf16_t* LOGD, long gtid, long gsize) {
    const long total = (long)MTOK * 6;
    for (long idx = gtid; idx < total; idx += gsize) {
        const int tok = (int)(idx / 6), h = (int)(idx % 6);
        float nrm = 0.f;
        for (int c = 0; c < 64; ++c) { const int hc = 64 * h + c; const float kc = shifted(P, tok, 640 + 384 + hc, W.mu[384 + hc]) * W.k_k[hc]; nrm += kc * kc; }
        const float rn = 1.0f / fmaxf(sqrtf(nrm), 1e-12f);
        for (int c = 0; c < 64; ++c) {
            const int hc = 64 * h + c; const long o = (long)tok * 384 + hc;
            const float r = shifted(P, tok, 640 + hc, W.mu[hc]);
            const float k = shifted(P, tok, 640 + 384 + hc, W.mu[384 + hc]);
            float v = shifted(P, tok, 640 + 768 + hc, W.mu[768 + hc]);
            float wp = W.w0[hc], ap = W.a0[hc];
            for (int j = 0; j < 32; ++j) {
                wp += tanhf(shifted(P, tok, 640 + 1152 + j, W.mu[1152 + j])) * W.w2[j * 384 + hc];
                ap += shifted(P, tok, 640 + 1184 + j, W.mu[1184 + j]) * W.a2[j * 384 + hc];
            }
            const float z = -wp; const float sp = fmaxf(z, 0.f) + log1pf(expf(-fabsf(z)));
            const float w = -sp - 0.5f;
            const float a = 1.0f / (1.0f + expf(-ap));
            if (layer > 0) {
                float vp = W.v0[hc];
                for (int j = 0; j < 16; ++j) vp += shifted(P, tok, 2176 + j, W.mu_v[j]) * W.v2[j * 384 + hc];
                const float vf = bf2f(VFIRST[o]);
                v = v + (vf - v) * (1.0f / (1.0f + expf(-vp)));
            } else VFIRST[o] = f2bf(v);
            const float kk = k * W.k_k[hc] * rn;
            R[o] = f2bf(r); K[o] = f2bf(k * (1.0f + (a - 1.0f) * W.k_a[hc])); V[o] = f2bf(v);
            KK[o] = f2bf(kk); B[o] = f2bf(kk * a); LOGD[o] = f2bf(-expf(w));
        }
    }
}
#ifndef MK_BUILD
__global__ void k_rwkv_prep(const bf16_t* P, RwkvW W, int layer, bf16_t* VFIRST, bf16_t* R, bf16_t* K, bf16_t* V, bf16_t* KK, bf16_t* B, bf16_t* LOGD) { d_rwkv_prep(P, W, layer, VFIRST, R, K, V, KK, B, LOGD, (long)blockIdx.x * blockDim.x + threadIdx.x, (long)gridDim.x * blockDim.x); }
#endif
__device__ __forceinline__ void d_rwkv_scan(const bf16_t* R, const bf16_t* K, const bf16_t* V, const bf16_t* KK, const bf16_t* B, const bf16_t* LOGD, bf16_t* MIX, int bh, int i) {
    const int b = bh / 6, h = bh % 6;
    float s[64];
#pragma unroll
    for (int k = 0; k < 64; ++k) s[k] = 0.f;
    for (int t = 0; t < SEQ; ++t) {
        const long o = (long)(b * SEQ + t) * 384 + 64 * h;
        float sa = 0.f;
#pragma unroll
        for (int k = 0; k < 64; ++k) sa -= s[k] * bf2f(KK[o + k]);
        const float v = bf2f(V[o + i]); float y = 0.f;
#pragma unroll
        for (int k = 0; k < 64; ++k) { s[k] = s[k] * expf(bf2f(LOGD[o + k])) + sa * bf2f(B[o + k]) + v * bf2f(K[o + k]); y += s[k] * bf2f(R[o + k]); }
        MIX[(long)(b * SEQ + t) * DM + 384 + 64 * h + i] = f2bf(y);
    }
}
#ifndef MK_BUILD
__global__ void k_rwkv_scan(const bf16_t* R, const bf16_t* K, const bf16_t* V, const bf16_t* KK, const bf16_t* B, const bf16_t* LOGD, bf16_t* MIX) { d_rwkv_scan(R, K, V, KK, B, LOGD, MIX, blockIdx.x, threadIdx.x); }
#endif
__device__ __forceinline__ void d_rwkv_fin(const bf16_t* P, RwkvW W, const bf16_t* R, const bf16_t* K, const bf16_t* V, bf16_t* MIX, long gtid, long gsize) {
    const long total = (long)MTOK * 6;
    for (long idx = gtid; idx < total; idx += gsize) {
        const int tok = (int)(idx / 6), h = (int)(idx % 6);
        bf16_t* y = MIX + (long)tok * DM + 384 + 64 * h; const long o = (long)tok * 384 + 64 * h;
        float mean = 0.f, dot = 0.f;
        for (int c = 0; c < 64; ++c) { mean += bf2f(y[c]); dot += bf2f(R[o + c]) * bf2f(K[o + c]) * W.r_k[64 * h + c]; }
        mean *= (1.0f / 64.0f); float var = 0.f;
        for (int c = 0; c < 64; ++c) { const float d = bf2f(y[c]) - mean; var += d * d; }
        const float rstd = 1.0f / sqrtf(var * (1.0f / 64.0f) + GN_EPS);
        for (int c = 0; c < 64; ++c) {
            const int hc = 64 * h + c; float g = 0.f;
            for (int j = 0; j < 64; ++j) g += (1.0f / (1.0f + expf(-shifted(P, tok, 640 + 1216 + j, W.mu[1216 + j])))) * W.g2[j * 384 + hc];
            const float yn = (bf2f(y[c]) - mean) * rstd * W.ln_w[hc] + W.ln_b[hc];
            y[c] = f2bf((yn + dot * bf2f(V[o + c])) * g);
        }
    }
}
#ifndef MK_BUILD
__global__ void k_rwkv_fin(const bf16_t* P, RwkvW W, const bf16_t* R, const bf16_t* K, const bf16_t* V, bf16_t* MIX) { d_rwkv_fin(P, W, R, K, V, MIX, (long)blockIdx.x * blockDim.x + threadIdx.x, (long)gridDim.x * blockDim.x); }
#endif
__device__ __forceinline__ void d_conv_act(const bf16_t* U, const float* cw, const float* cb, bf16_t* ACT, int rows, long gtid, long gsize) {
    const long total = (long)rows * DFF;
    for (long idx = gtid; idx < total; idx += gsize) {
        const int t = (int)(idx / DFF), c = (int)(idx % DFF);
        float gate = cb[c], val = cb[DFF + c];
#pragma unroll
        for (int i = 0; i < 3; ++i) { const int tt = t - 2 + i; if (tt >= 0) { gate += cw[i * 2 * DFF + c] * bf2f(U[(long)tt * 2 * DFF + c]); val += cw[i * 2 * DFF + DFF + c] * bf2f(U[(long)tt * 2 * DFF + DFF + c]); } }
        ACT[(long)t * DFF + c] = f2bf(gate / (1.0f + expf(-gate)) * val);
    }
}
#ifndef MK_BUILD
__global__ void k_conv_act(const bf16_t* U, const float* cw, const float* cb, bf16_t* ACT, int rows) { d_conv_act(U, cw, cb, ACT, rows, (long)blockIdx.x * blockDim.x + threadIdx.x, (long)gridDim.x * blockDim.x); }
#endif
}
namespace pg8 {
#define PG8_LAS __attribute__((address_space(3)))
typedef unsigned short bf16_t;
typedef short bf16x8 __attribute__((ext_vector_type(8)));
typedef float f32x4 __attribute__((ext_vector_type(4)));
typedef unsigned u32x4 __attribute__((ext_vector_type(4)));
constexpr int BM = 256, BK = 64, HALF = 128, HTB = HALF * BK * 2  , STAGE_BYTES = 8 * HTB, NXCD = 8, WGM = 8;

__host__ __device__ __forceinline__ int lds_byte(int r, int c) { const int st = (r >> 4) * 2 + (c >> 5), rr = r & 15, cc = c & 31, ob = rr * 64 + cc * 2; return st * 1024 + (ob ^ (((ob >> 9) & 1) << 5)); }
__host__ __device__ __forceinline__ void stage_rc(int b, int& R, int& C) { const int st = b / 1024, sb = b % 1024, swz = sb ^ (((sb >> 9) & 1) << 5); R = (st >> 1) * 16 + swz / 64; C = (st & 1) * 32 + (swz % 64) / 2; }
__host__ __device__ __forceinline__ int perm32(int rho) { const int n = rho >> 4, i = rho & 15; return 8 * (i >> 2) + 4 * n + (i & 3); }

struct Unit { int pm, pn; };
struct Gemm { const bf16_t* A; const bf16_t* Bt; int M, N, K; };

struct StaticOrder {
    int nM, nN, nwg, G, c;
    __host__ __device__ void init(int M, int N, int G_, int c_) { nM = M / BM; nN = N / BM; nwg = nM * nN; G = G_; c = c_; }
    __host__ __device__ bool next(int i, Unit& u) const {
        const long L = (long)i * G + c; if (L >= nwg) return false;
        int wgid = (int)L; { const int q = nwg / NXCD, r = nwg % NXCD, xcd = wgid % NXCD, off = wgid / NXCD; wgid = (xcd < r ? xcd * (q + 1) : r * (q + 1) + (xcd - r) * q) + off; }
        const int nig = WGM * nN, gid = wgid / nig, fm = gid * WGM, gsz = (nM - fm) < WGM ? (nM - fm) : WGM;
        u.pm = fm + ((wgid % nig) % gsz); u.pn = (wgid % nig) / gsz; return true;
    }
    __device__ __forceinline__ void a_ready(const Unit&) const {}
    __device__ __forceinline__ void done(const Unit&) const {}
};

__device__ __forceinline__ unsigned cvt_pk_bf16(float lo, float hi) { unsigned r; asm volatile("v_cvt_pk_bf16_f32 %0, %1, %2" : "=v"(r) : "v"(lo), "v"(hi)); return r; }
struct EpiScaleBf16 {
    static constexpr bool PERM = true, AFTER_DRAIN = false; static constexpr int AMAP = 0;
    bf16_t* O; int ldc; const float* ssq;
    __device__ __forceinline__ void operator()(const f32x4 (&acc)[2][2][4][2], const Unit& u, int wr, int wc, int fr, int fq) const {
        const int row0 = u.pm * BM + wr * 64 + fr, col0 = u.pn * BM + wc * 32 + 8 * fq;
#pragma unroll
        for (int ai = 0; ai < 2; ++ai)
#pragma unroll
            for (int m = 0; m < 4; ++m) { const int row = row0 + ai * HALF + m * 16; const float sc = __builtin_amdgcn_rsqf(ssq[row] * (1.0f / 1024.0f) + 1e-6f);
                bf16_t* rowp = O + (size_t)row * ldc + col0;
#pragma unroll
                for (int bj = 0; bj < 2; ++bj) { const f32x4 v0 = acc[ai][bj][m][0] * sc, v1 = acc[ai][bj][m][1] * sc;
                    u32x4 w; w.x = cvt_pk_bf16(v0[0], v0[1]); w.y = cvt_pk_bf16(v0[2], v0[3]); w.z = cvt_pk_bf16(v1[0], v1[1]); w.w = cvt_pk_bf16(v1[2], v1[3]);
                    *(u32x4*)(rowp + bj * HALF) = w; } }
    }
};
template <bool FINAL> struct EpiResid {
    static constexpr bool PERM = false, AFTER_DRAIN = false; static constexpr int AMAP = 0;
    float* out; bf16_t* xb; float* ssq; int ldc;
    __device__ __forceinline__ void operator()(const f32x4 (&acc)[2][2][4][2], const Unit& u, int wr, int wc, int fr, int fq) const {
        typedef unsigned u32x2v __attribute__((ext_vector_type(2)));
        const int col0 = u.pn * BM + wc * 32 + 4 * fq;
#pragma unroll
        for (int ai = 0; ai < 2; ++ai) {
            u32x2v bs[4][2][2];
#pragma unroll
            for (int m = 0; m < 4; ++m) { const size_t off = (size_t)(u.pm * BM + ai * HALF + wr * 64 + m * 16 + fr) * ldc + col0;
#pragma unroll
                for (int bj = 0; bj < 2; ++bj)
#pragma unroll
                    for (int n = 0; n < 2; ++n) bs[m][bj][n] = *(const u32x2v*)(xb + off + bj * HALF + n * 16); }
#pragma unroll
            for (int m = 0; m < 4; ++m) { const int row = u.pm * BM + ai * HALF + wr * 64 + m * 16 + fr; const size_t off = (size_t)row * ldc + col0; float sq = 0.f;
#pragma unroll
                for (int bj = 0; bj < 2; ++bj)
#pragma unroll
                    for (int n = 0; n < 2; ++n) { const u32x2v b2 = bs[m][bj][n];
                        f32x4 o = {__builtin_bit_cast(float, b2.x << 16), __builtin_bit_cast(float, b2.x & 0xffff0000u), __builtin_bit_cast(float, b2.y << 16), __builtin_bit_cast(float, b2.y & 0xffff0000u)};
                        o = o + acc[ai][bj][m][n];
                        if (FINAL) *(f32x4*)(out + off + bj * HALF + n * 16) = o;
                        else { u32x2v w; w.x = cvt_pk_bf16(o[0], o[1]); w.y = cvt_pk_bf16(o[2], o[3]); *(u32x2v*)(xb + off + bj * HALF + n * 16) = w;
                            const float r0 = __builtin_bit_cast(float, w.x << 16), r1 = __builtin_bit_cast(float, w.x & 0xffff0000u), r2 = __builtin_bit_cast(float, w.y << 16), r3 = __builtin_bit_cast(float, w.y & 0xffff0000u);
                            sq += (r0 * r0 + r1 * r1) + (r2 * r2 + r3 * r3); } }
                if (!FINAL) { sq += __shfl_xor(sq, 16); sq += __shfl_xor(sq, 32); if (fq == 0) atomicAdd(ssq + row, sq); } } }
    }
};
struct EpiConvAct {
    static constexpr bool PERM = true, AFTER_DRAIN = false; static constexpr int AMAP = 1;
    bf16_t* ACT; const float* ssq; const float* cw; const float* cb;
    static __device__ __forceinline__ float shr1s(float x) { float r; asm volatile("s_nop 1\n\tv_mov_b32_dpp %0, %1 row_shr:1 row_mask:0xf bank_mask:0xf bound_ctrl:1" : "=v"(r) : "v"(x)); return r; }
    static __device__ __forceinline__ f32x4 shr1(f32x4 v) { f32x4 r; r[0] = shr1s(v[0]); r[1] = shr1s(v[1]); r[2] = shr1s(v[2]); r[3] = shr1s(v[3]); return r; }
    __device__ __forceinline__ void operator()(const f32x4 (&acc)[2][2][4][2], const Unit& u, int wr, int wc, int fr, int fq) const {
        const int b = u.pm / 33, pmb = u.pm % 33;
        const int pos0 = 252 * pmb + 126 * wr + 8 * fr - 2;
        const long row0 = (long)b * SEQ + pos0;
        float rs[8];
#pragma unroll
        for (int j = 0; j < 8; ++j) { const int pos = pos0 + j; const bool ok = pos >= 0 && pos < SEQ; const float q = ssq[ok ? row0 + j : 0]; rs[j] = ok ? __builtin_amdgcn_rsqf(q * (1.0f / 1024.0f) + 1e-6f) : 0.f; }
        const int ch0 = 128 * u.pn + 32 * wc + 8 * fq;
        unsigned ow[8][4];
#pragma unroll
        for (int n = 0; n < 2; ++n) { const int c = ch0 + 4 * n;
            const f32x4 w0g = *(const f32x4*)(cw + c), w1g = *(const f32x4*)(cw + 5632 + c), w2g = *(const f32x4*)(cw + 2 * 5632 + c), bg = *(const f32x4*)(cb + c);
            const f32x4 w0v = *(const f32x4*)(cw + 2816 + c), w1v = *(const f32x4*)(cw + 5632 + 2816 + c), w2v = *(const f32x4*)(cw + 2 * 5632 + 2816 + c), bv = *(const f32x4*)(cb + 2816 + c);
            f32x4 gm2 = shr1(acc[1][0][2][n] * rs[6]), gm1 = shr1(acc[1][0][3][n] * rs[7]), vm2 = shr1(acc[1][1][2][n] * rs[6]), vm1 = shr1(acc[1][1][3][n] * rs[7]);
#pragma unroll
            for (int j = 0; j < 8; ++j) { const f32x4 gj = acc[j >> 2][0][j & 3][n] * rs[j], vj = acc[j >> 2][1][j & 3][n] * rs[j];
                const f32x4 ug = bg + w0g * gm2 + w1g * gm1 + w2g * gj, uv = bv + w0v * vm2 + w1v * vm1 + w2v * vj; f32x4 a;
#pragma unroll
                for (int e = 0; e < 4; ++e) a[e] = ug[e] * __builtin_amdgcn_rcpf(1.0f + __expf(-ug[e])) * uv[e];
                ow[j][2 * n] = cvt_pk_bf16(a[0], a[1]); ow[j][2 * n + 1] = cvt_pk_bf16(a[2], a[3]);
                gm2 = gm1; gm1 = gj; vm2 = vm1; vm1 = vj; } }
#pragma unroll
        for (int j = 0; j < 8; ++j) if (8 * fr + j >= 2 && pos0 + j < SEQ) { u32x4 w; w.x = ow[j][0]; w.y = ow[j][1]; w.z = ow[j][2]; w.w = ow[j][3]; *(u32x4*)(ACT + (size_t)(row0 + j) * 2816 + ch0) = w; }
    }
};
template <class Epi, class Sched, bool ALIGN_EPI = false, bool SP2 = false>
__device__ __forceinline__ void gemm_phase(PG8_LAS unsigned char* lds, const Gemm g, const Sched& S, const Epi& E, int tid_in) {
    int tid = tid_in; asm volatile("" : "+v"(tid));
    const int wid = __builtin_amdgcn_readfirstlane(tid >> 6), lane = tid & 63, wr = wid >> 2, wc = wid & 3, fr = lane & 15, fq = lane >> 4;
    const int K = g.K, nt = K / BK;
    unsigned voffA[2], voffB[2];
#pragma unroll
    for (int i = 0; i < 2; ++i) { int R, C; stage_rc(tid * 16 + i * 8192, R, C); const int Rb = Epi::PERM ? ((R & ~31) + perm32(R & 31)) : R;
        const int Ra = Epi::AMAP ? (126 * (R >> 6) + 8 * (R & 15) + ((R >> 4) & 3)) : R;
        voffA[i] = (unsigned)(Ra * K + C) * 2u; voffB[i] = (unsigned)(Rb * K + C) * 2u; }
    const size_t kstep = (size_t)(BK * 2);
    const size_t hstepB = (size_t)HALF * K * 2;
    const size_t hstepA = Epi::AMAP ? (size_t)4 * K * 2 : hstepB;
    const size_t tstep = 2 * hstepB;
#define PG8_ABASE(pm_) (Epi::AMAP ? (long)((long)((pm_) / 33) * SEQ + 252 * ((pm_) % 33) - 2) * (long)K * 2 : (long)(pm_) * (long)tstep)
    const unsigned ldsw = (unsigned)wid * 1024u;
    const int aoff = lds_byte(wr * 64 + fr, fq * 8), boff = lds_byte(wc * 32 + fr, fq * 8);
#define PG8_SA(b, h) (((b) * 2 + (h)) * HTB)
#define PG8_SB(b, h) ((4 + (b) * 2 + (h)) * HTB)
#define PG8_STAGE(bufoff, gbase, voff) do { _Pragma("unroll") for (int _i = 0; _i < 2; ++_i) \
        __builtin_amdgcn_global_load_lds((const unsigned*)((const char*)(gbase) + (voff)[_i]), (PG8_LAS unsigned*)(lds + (bufoff) + ldsw + _i * 8192), 16, 0, 0); } while (0)
#define PG8_LDA(dst, b, h) do { _Pragma("unroll") for (int m = 0; m < 4; ++m) _Pragma("unroll") for (int k = 0; k < 2; ++k) dst[m][k] = *(const PG8_LAS bf16x8*)(lds + PG8_SA(b, h) + aoff + m * 2048 + k * 1024); } while (0)
#define PG8_LDB(dst, b, h) do { _Pragma("unroll") for (int n = 0; n < 2; ++n) _Pragma("unroll") for (int k = 0; k < 2; ++k) dst[n][k] = *(const PG8_LAS bf16x8*)(lds + PG8_SB(b, h) + boff + n * 2048 + k * 1024); } while (0)
#define PG8_MMA(ai, bj, At, Bt) do { __builtin_amdgcn_s_setprio(1); _Pragma("unroll") for (int m = 0; m < 4; ++m) _Pragma("unroll") for (int n = 0; n < 2; ++n) _Pragma("unroll") for (int k = 0; k < 2; ++k) \
        acc[ai][bj][m][n] = __builtin_amdgcn_mfma_f32_16x16x32_bf16(Bt[n][k], At[m][k], acc[ai][bj][m][n], 0, 0, 0); __builtin_amdgcn_s_setprio(0); } while (0)
#define PG8_WAIT_V(n) asm volatile("s_waitcnt vmcnt(" #n ")" ::: "memory")
#define PG8_WAIT_L(n) asm volatile("s_waitcnt lgkmcnt(" #n ")" ::: "memory")
#define PG8_BAR __builtin_amdgcn_s_barrier()
#define PG8_SCHED __builtin_amdgcn_sched_barrier(0)
    Unit cur, nxt; int ui = 0;
    if (!S.next(0, cur)) return;
    f32x4 acc[2][2][4][2];
#pragma unroll
    for (int a = 0; a < 2; ++a)
#pragma unroll
        for (int b = 0; b < 2; ++b)
#pragma unroll
            for (int m = 0; m < 4; ++m)
#pragma unroll
                for (int n = 0; n < 2; ++n) acc[a][b][m][n] = (f32x4){0.f, 0.f, 0.f, 0.f};
    bf16x8 At[4][2], B0[2][2], B1[2][2];
    const char* cA = (const char*)g.A + PG8_ABASE(cur.pm); const char* cB = (const char*)g.Bt + (size_t)cur.pn * tstep;
    S.a_ready(cur);
    if constexpr (SP2) {
        PG8_STAGE(PG8_SB(0, 0), cB, voffB); PG8_STAGE(PG8_SB(0, 1), cB + hstepB, voffB); PG8_STAGE(PG8_SA(0, 0), cA, voffA); PG8_STAGE(PG8_SA(0, 1), cA + hstepA, voffA);
        if (wr == 1) PG8_BAR;
        PG8_WAIT_V(2); PG8_BAR;
        PG8_STAGE(PG8_SB(1, 0), cB + kstep, voffB); PG8_STAGE(PG8_SA(1, 0), cA + kstep, voffA); PG8_STAGE(PG8_SB(1, 1), cB + hstepB + kstep, voffB);
        PG8_WAIT_V(6); PG8_BAR;
    } else {
        PG8_STAGE(PG8_SB(0, 0), cB, voffB); PG8_STAGE(PG8_SA(0, 0), cA, voffA); PG8_STAGE(PG8_SB(0, 1), cB + hstepB, voffB); PG8_STAGE(PG8_SA(0, 1), cA + hstepA, voffA);
        if (wr == 1) PG8_BAR;
        PG8_WAIT_V(4); PG8_BAR;
        PG8_STAGE(PG8_SB(1, 0), cB + kstep, voffB); PG8_STAGE(PG8_SA(1, 0), cA + kstep, voffA); PG8_STAGE(PG8_SB(1, 1), cB + hstepB + kstep, voffB);
        PG8_WAIT_V(6); PG8_BAR;
    }
    for (;;) {
        const bool has_next = S.next(ui + 1, nxt);
        const char* nA = has_next ? (const char*)g.A + PG8_ABASE(nxt.pm) : cA; const char* nB = has_next ? (const char*)g.Bt + (size_t)nxt.pn * tstep : cB;
        for (int t = 0; t < nt; t += 2) {
            const bool last = (t == nt - 2);
            const char* a1 = cA + (size_t)(t + 1) * kstep;
            const char* a2 = last ? nA : cA + (size_t)(t + 2) * kstep; const char* b2 = last ? nB : cB + (size_t)(t + 2) * kstep;
            const char* a3 = a2 + kstep; const char* b3 = b2 + kstep;
            if (last && has_next) S.a_ready(nxt);
            if constexpr (SP2) {
            PG8_LDB(B0, 0, 0); PG8_LDB(B1, 0, 1); PG8_SCHED; PG8_LDA(At, 0, 0); PG8_STAGE(PG8_SA(1, 1), a1 + hstepA, voffA);
            PG8_WAIT_V(8); PG8_WAIT_L(0); PG8_BAR; PG8_MMA(0, 0, At, B0); PG8_MMA(0, 1, At, B1); PG8_BAR; PG8_SCHED;
            PG8_LDA(At, 0, 1); PG8_STAGE(PG8_SB(0, 0), b2, voffB); PG8_STAGE(PG8_SB(0, 1), b2 + hstepB, voffB); PG8_STAGE(PG8_SA(0, 0), a2, voffA);
            PG8_WAIT_V(8); PG8_WAIT_L(0); PG8_BAR; PG8_MMA(1, 0, At, B0); PG8_MMA(1, 1, At, B1); PG8_BAR; PG8_SCHED;
            PG8_LDB(B0, 1, 0); PG8_LDB(B1, 1, 1); PG8_SCHED; PG8_LDA(At, 1, 0); PG8_STAGE(PG8_SA(0, 1), a2 + hstepA, voffA);
            PG8_WAIT_V(8); PG8_WAIT_L(0); PG8_BAR; PG8_MMA(0, 0, At, B0); PG8_MMA(0, 1, At, B1); PG8_BAR; PG8_SCHED;
            PG8_LDA(At, 1, 1); PG8_STAGE(PG8_SB(1, 0), b3, voffB); PG8_STAGE(PG8_SB(1, 1), b3 + hstepB, voffB); PG8_STAGE(PG8_SA(1, 0), a3, voffA);
            PG8_WAIT_V(8); PG8_WAIT_L(0); PG8_BAR; PG8_MMA(1, 0, At, B0); PG8_MMA(1, 1, At, B1); PG8_BAR; PG8_SCHED;
            } else {
            PG8_LDB(B0, 0, 0); PG8_SCHED; PG8_LDA(At, 0, 0); PG8_STAGE(PG8_SA(1, 1), a1 + hstepA, voffA);
            PG8_WAIT_L(8); PG8_BAR; PG8_WAIT_L(0); PG8_MMA(0, 0, At, B0); PG8_BAR; PG8_SCHED;
            PG8_LDB(B1, 0, 1); PG8_STAGE(PG8_SB(0, 0), b2, voffB);
            PG8_BAR; PG8_WAIT_L(0); PG8_MMA(0, 1, At, B1); PG8_BAR;
            PG8_LDA(At, 0, 1); PG8_STAGE(PG8_SA(0, 0), a2, voffA);
            PG8_BAR; PG8_WAIT_L(0); PG8_MMA(1, 0, At, B0); PG8_BAR; PG8_SCHED;
            PG8_STAGE(PG8_SB(0, 1), b2 + hstepB, voffB);
            PG8_WAIT_V(6); PG8_BAR; PG8_MMA(1, 1, At, B1); PG8_BAR;
            PG8_LDB(B0, 1, 0); PG8_SCHED; PG8_LDA(At, 1, 0); PG8_STAGE(PG8_SA(0, 1), a2 + hstepA, voffA);
            PG8_WAIT_L(8); PG8_BAR; PG8_WAIT_L(0); PG8_MMA(0, 0, At, B0); PG8_BAR; PG8_SCHED;
            PG8_LDB(B1, 1, 1); PG8_STAGE(PG8_SB(1, 0), b3, voffB);
            PG8_BAR; PG8_WAIT_L(0); PG8_MMA(0, 1, At, B1); PG8_BAR;
            PG8_LDA(At, 1, 1); PG8_STAGE(PG8_SA(1, 0), a3, voffA);
            PG8_BAR; PG8_WAIT_L(0); PG8_MMA(1, 0, At, B0); PG8_BAR; PG8_SCHED;
            PG8_STAGE(PG8_SB(1, 1), b3 + hstepB, voffB);
            PG8_WAIT_V(6); PG8_BAR; PG8_MMA(1, 1, At, B1); PG8_BAR;
            }
        }
        if constexpr (ALIGN_EPI) { if (wr == 0) PG8_BAR; }
        if constexpr (!Epi::AFTER_DRAIN) { E(acc, cur, wr, wc, fr, fq); S.done(cur); }
        if (!has_next) break;
#pragma unroll
        for (int a = 0; a < 2; ++a)
#pragma unroll
            for (int b = 0; b < 2; ++b)
#pragma unroll
                for (int m = 0; m < 4; ++m)
#pragma unroll
                    for (int n = 0; n < 2; ++n) acc[a][b][m][n] = (f32x4){0.f, 0.f, 0.f, 0.f};
        cur = nxt; cA = nA; cB = nB; ++ui;
        if constexpr (ALIGN_EPI) { if (wr == 1) PG8_BAR; }
    }
    PG8_WAIT_V(0);
    if constexpr (!ALIGN_EPI) { if (wr == 0) PG8_BAR; }
    PG8_BAR;
    if constexpr (Epi::AFTER_DRAIN) { E.fused(acc, cur, wr, wc, fr, fq, lds, wid, lane); S.done(cur); }
#undef PG8_ABASE
#undef PG8_SA
#undef PG8_SB
#undef PG8_STAGE
#undef PG8_LDA
#undef PG8_LDB
#undef PG8_MMA
#undef PG8_WAIT_V
#undef PG8_WAIT_L
#undef PG8_BAR
#undef PG8_SCHED
}
}

#ifndef PG8_SP2
#define PG8_SP2 true
#endif
#ifndef PG8_ALIGN
#define PG8_ALIGN true
#endif
#define GAS __attribute__((address_space(1)))
#define LAS __attribute__((address_space(3)))
typedef unsigned short bf16;
typedef unsigned v4u __attribute__((ext_vector_type(4)));
typedef float f32x4 __attribute__((ext_vector_type(4)));
typedef short bf16x8 __attribute__((ext_vector_type(8)));
typedef GAS unsigned gu32;
typedef GAS unsigned long long gu64;
#define RLX_AGENT __ATOMIC_RELAXED, __HIP_MEMORY_SCOPE_AGENT
#define LDS_WAIT() asm volatile("s_waitcnt lgkmcnt(0)" ::: "memory")
#define VM_WAIT() asm volatile("s_waitcnt vmcnt(0)" ::: "memory")
__device__ __forceinline__ unsigned long long rt() { return __builtin_amdgcn_s_memrealtime(); }

#define XB_TMO      128
#define XB_XCNT(j)  (256  + 64 * (j))
#define XB_XSUB(j)  (1280 + 64 * (j))
#define XB_XGEN(j)  (2304 + 64 * (j))
#define XB_TOP      3328
#define XB_TOPGEN   3392
#define XCD_BAR_WORDS 3456
#define XB_SPIN_CAP (1u << 20)

__device__ __forceinline__ unsigned xb_ld(unsigned* p)              { return __hip_atomic_load(p, __ATOMIC_RELAXED, __HIP_MEMORY_SCOPE_AGENT); }
__device__ __forceinline__ unsigned xb_add(unsigned* p, unsigned v) { return __hip_atomic_fetch_add(p, v, __ATOMIC_RELAXED, __HIP_MEMORY_SCOPE_AGENT); }
__device__ __forceinline__ unsigned xb_xcc_id() { return (unsigned)__builtin_amdgcn_s_getreg((3 << 11) | 20) & 0xFu; }
#define XB_SPIN(cond, bar) do { unsigned _sp = 0; while (cond) { __builtin_amdgcn_s_sleep(1); \
    if ((++_sp & 255u) == 0u) { if (xb_ld(&(bar)[XB_TMO])) break; if (_sp > XB_SPIN_CAP) { atomicAdd(&(bar)[XB_TMO], 1u); break; } } } } while (0)

struct XcdBarrier {
    unsigned* bar; unsigned x;
    volatile LAS unsigned* st;
};

__device__ __forceinline__ XcdBarrier xcd_barrier_post(unsigned* bar, volatile LAS unsigned* st) {
    XcdBarrier b; b.bar = bar; b.x = xb_xcc_id(); b.st = st;
    if (threadIdx.x == 0) (void)xb_add(&bar[XB_XCNT(b.x)], 1u);
    return b;
}
__device__ __forceinline__ void xcd_barrier_complete(unsigned* bar, unsigned x, unsigned& nloc, unsigned& nx) {
    const unsigned G = gridDim.x * gridDim.y * gridDim.z;
    unsigned sum, cnt, mine, sp = 0u;
    for (;;) {
        sum = 0u; cnt = 0u; mine = 0u;
#pragma unroll
        for (unsigned j = 0; j < 16; ++j) { const unsigned c = xb_ld(&bar[XB_XCNT(j)]); sum += c; cnt += (c > 0u) ? 1u : 0u; mine = (j == x) ? c : mine; }
        if (sum == G) break;
        __builtin_amdgcn_s_sleep(1);
        if ((++sp & 255u) == 0u) { if (xb_ld(&bar[XB_TMO])) break; if (sp > XB_SPIN_CAP) { atomicAdd(&bar[XB_TMO], 1u); break; } }
    }
    nloc = mine > 0u ? mine : 1u; nx = cnt > 0u ? cnt : 1u;
}

__device__ __forceinline__ void xcd_barrier(const XcdBarrier& b) {
    asm volatile("s_waitcnt vmcnt(0)" ::: "memory");
    __syncthreads();
    if (threadIdx.x == 0) {
        unsigned* bar = b.bar;
        __builtin_amdgcn_s_waitcnt(0);
        unsigned nloc = b.st[0], nx = b.st[1];
        if (nloc == 0u) { xcd_barrier_complete(bar, b.x, nloc, nx); b.st[0] = nloc; b.st[1] = nx; }
        const unsigned old = xb_add(&bar[XB_XSUB(b.x)], 1u);
        const unsigned gen = old / nloc;
        if (old + 1u == (gen + 1u) * nloc) {
            __builtin_amdgcn_fence(__ATOMIC_RELEASE, "agent");
            asm volatile("s_waitcnt vmcnt(0)" ::: "memory");
            const unsigned og = xb_add(&bar[XB_TOP], 1u);
            const unsigned tg = og / nx;
            if (og + 1u == (tg + 1u) * nx) xb_add(&bar[XB_TOPGEN], 1u);
            else XB_SPIN(xb_ld(&bar[XB_TOPGEN]) == tg, bar);
            __builtin_amdgcn_fence(__ATOMIC_ACQUIRE, "agent");
            xb_add(&bar[XB_XGEN(b.x)], 1u);
            asm volatile("s_waitcnt vmcnt(0)" ::: "memory");
        } else {
            XB_SPIN(xb_ld(&bar[XB_XGEN(b.x)]) == gen, bar);
            __builtin_amdgcn_fence(__ATOMIC_ACQUIRE, "agent");
            asm volatile("s_waitcnt vmcnt(0)" ::: "memory");
        }
    }
    __syncthreads();
}

namespace mk {
constexpr size_t WS_CTL = 0, CTL_ZERO_BYTES = 1 * MiB;
constexpr size_t CTL_SSQ = 512 * 1024;
constexpr size_t WS_SMALL = 1 * MiB, SM_BIAS = 0, SM_SSQM = 4096, SM_MKV = 512 * 1024;
constexpr size_t WS_MEMB = 2 * MiB, WS_WT = 3 * MiB, WS_XB = 28 * MiB, WS_VF = 60 * MiB, WS_PROJ = 72 * MiB, WS_MIX = 144 * MiB, WS_PREP = 176 * MiB, WS_U = 72 * MiB, WS_ACT = 160 * MiB, WS_WIN1 = 248 * MiB  , WS_END = 255 * MiB;
constexpr size_t WT_IN = 0, WT_OUT = 4718592, WT_UP = WT_OUT + 2 * MiB, WT_DOWN = WT_UP + 11 * MiB, WT_MKV = WT_DOWN + 5767168;
constexpr int CW_TMO = 0, CW_BAR = 4096, CW_ATTQ = 8192, CW_CHQ = 8448;
constexpr int LDS_BYTES = 163840, LDSCTL_OFF = LDS_BYTES - 512, MISC_OFF = LDSCTL_OFF + 320;
constexpr size_t SM_W2T = 8192, SM_A2T = 32768, SM_V2T = 57344, SM_G2T = 81920, SM_LORA_L = 122880;
constexpr size_t WS_PT = 176 * MiB, WS_G = 188 * MiB, WS_S0 = 200 * MiB, WS_Z = 212 * MiB, WS_YV = 236 * MiB  , WS_DOT = 254 * MiB;
constexpr size_t SM_RWP = 262144, RWP_BYTES = 17472;
constexpr int RP_MU = 0, RP_MUV = 1280, RP_W0 = 1296, RP_A0 = 1680, RP_V0 = 2064, RP_KK = 2448, RP_KA = 2832, RP_RK = 3216, RP_LNW = 3600, RP_LNB = 3984, RP_SIZE = 4368;
}
namespace rw {
constexpr int LD = 72;
constexpr int MATB = 64 * LD * 2;
constexpr int OFF_F0 = 12 * MATB  , OFF_TMP = OFF_F0 + 64 * 65 * 4  ;
constexpr int OFF_TW = 8 * MATB  , OFF_TA = OFF_TW + 5120, OFF_TV = OFF_TA + 5120, OFF_WP = OFF_TV + 5120  , OFF_AP = OFF_WP + 16640, OFF_VP = OFF_AP + 16640;
constexpr int OFF_TOT = 139264, OFF_GC = OFF_TOT + 2048, OFF_RN = OFF_GC + 256, OFF_END = OFF_RN + 256;
constexpr int NITEMS = BATCH * 6 * (SEQ / 64);
__device__ __forceinline__ int sigpos(int c) { return (c & 32) + 8 * ((c >> 2) & 3) + 4 * ((c >> 4) & 1) + (c & 3); }
#define RW_BAR() do { asm volatile("s_waitcnt lgkmcnt(0)" ::: "memory"); __builtin_amdgcn_s_barrier(); asm volatile("" ::: "memory"); } while (0)
__device__ __forceinline__ float fexp(float x) { return __expf(x); }
__device__ __forceinline__ float fsigm(float x) { return __builtin_amdgcn_rcpf(1.0f + __expf(-x)); }
__device__ __forceinline__ float ftanh(float x) { const float e = __expf(-2.0f * fabsf(x)); const float t = (1.0f - e) * __builtin_amdgcn_rcpf(1.0f + e); return x < 0.f ? -t : t; }
__device__ __forceinline__ f32x4 mm_tile(const LAS bf16_t* A, const LAS bf16_t* Bt, int ti, int tj, int fr, int fq, f32x4 acc) {
#pragma unroll
    for (int kk = 0; kk < 2; ++kk) {
        const bf16x8 a = *(const LAS bf16x8*)(A + (16 * ti + fr) * LD + 32 * kk + 8 * fq);
        const bf16x8 b = *(const LAS bf16x8*)(Bt + (16 * tj + fr) * LD + 32 * kk + 8 * fq);
        acc = __builtin_amdgcn_mfma_f32_16x16x32_bf16(a, b, acc, 0, 0, 0);
    }
    return acc;
}
__device__ __forceinline__ unsigned pk2(float lo, float hi) { typedef float f2_t __attribute__((ext_vector_type(2))); typedef __bf16 b2_t __attribute__((ext_vector_type(2))); f2_t v = {lo, hi}; return __builtin_bit_cast(unsigned, __builtin_convertvector(v, b2_t)); }
#define RW_PT   ((GAS bf16_t*)(wsb + mk::WS_PT))
#define RW_G    ((GAS bf16_t*)(wsb + mk::WS_G))
#define RW_Z    ((GAS float*)(wsb + mk::WS_Z))
#define RW_YV   ((GAS bf16_t*)(wsb + mk::WS_YV))
#define RW_S0   ((GAS bf16_t*)(wsb + mk::WS_S0))
#define RW_VF   ((GAS bf16_t*)(wsb + mk::WS_VF))
#define RW_DOT  ((GAS float*)(wsb + mk::WS_DOT))
#define RW_PROJ ((const GAS bf16_t*)(wsb + mk::WS_PROJ))
#define RW_MIX  ((GAS bf16_t*)(wsb + mk::WS_MIX))
#define RW_LORA(off) ((const GAS bf16_t*)(wsb + mk::WS_SMALL + (off) + layer * mk::SM_LORA_L))
#define RWP(off) ((const GAS float*)(wsb + mk::WS_SMALL + mk::SM_RWP + layer * mk::RWP_BYTES) + (off))
struct ChunkBufs { bf16_t* PT; bf16_t* G; float* Z; bf16_t* YV; bf16_t* S0; bf16_t* VOUT; float* DOT; const bf16_t *W2T, *A2T, *V2T, *G2T; };

#define RW_LANES() int lt_ = tid_in; asm volatile("" : "+v"(lt_)); const int tid = lt_, lane = lt_ & 63, fr = lane & 15, fq = lane >> 4; (void)tid; (void)fr; (void)fq
struct ChunkLoads { unsigned short e_r[9], e_k[9], e_v[9], e_vf[8]; v4u lc, lp, kc4, kp4, vc4, vp4; };
__device__ __forceinline__ void chunk_loads(ChunkLoads& C, unsigned char* wsb, int layer, int item, int tid, int w) {
    const GAS bf16_t* P = RW_PROJ; const int lane = tid & 63;
    const int bh = item / (SEQ / 64), chunk = item % (SEQ / 64), b = bh / 6, h = bh % 6; const int tok0 = b * SEQ + chunk * 64;
    { const int hc = 64 * h + lane, tk0 = tok0 + 8 * w; const bool has_prev = (chunk * 64 + 8 * w) > 0;
#pragma unroll
      for (int j = 0; j < 9; ++j) { const size_t row = (size_t)(tk0 + j - 1) * LDP; const bool ok = j > 0 || has_prev;
          C.e_r[j] = ok ? P[row + 640 + hc] : (unsigned short)0; C.e_k[j] = ok ? P[row + 1024 + hc] : (unsigned short)0; C.e_v[j] = ok ? P[row + 1408 + hc] : (unsigned short)0; }
#pragma unroll
      for (int j = 0; j < 8; ++j) C.e_vf[j] = layer > 0 ? RW_VF[(size_t)(tk0 + j) * 384 + hc] : (unsigned short)0; }
    { const int t = tid >> 3, sub = tid & 7, tok = tok0 + t; const bool hp = (chunk * 64 + t) > 0;
      const GAS bf16_t* rc = P + (size_t)tok * LDP; const GAS bf16_t* rp = rc - LDP; const v4u z4 = {0u, 0u, 0u, 0u};
      C.lc = *(const GAS v4u*)(rc + 1792 + 8 * sub); C.lp = hp ? *(const GAS v4u*)(rp + 1792 + 8 * sub) : z4;
      C.kc4 = *(const GAS v4u*)(rc + 1024 + 64 * h + 8 * sub); C.kp4 = hp ? *(const GAS v4u*)(rp + 1024 + 64 * h + 8 * sub) : z4;
      C.vc4 = z4; C.vp4 = z4; if (layer > 0 && sub < 2) { C.vc4 = *(const GAS v4u*)(rc + 1920 + 8 * sub); if (hp) C.vp4 = *(const GAS v4u*)(rp + 1920 + 8 * sub); } }
}
__device__ __forceinline__ int chunk_phase(LAS unsigned char* L, unsigned char* wsb, int layer, int tid_in, unsigned* qctr, volatile LAS unsigned* qw) {
    const GAS bf16_t* P = RW_PROJ;
    const int w = __builtin_amdgcn_readfirstlane(tid_in >> 6);
    LAS bf16_t* B0 = (LAS bf16_t*)(L + 0 * MATB); LAS bf16_t* B1 = (LAS bf16_t*)(L + 1 * MATB); LAS bf16_t* B2 = (LAS bf16_t*)(L + 2 * MATB); LAS bf16_t* B3 = (LAS bf16_t*)(L + 3 * MATB);
    LAS bf16_t* B4 = (LAS bf16_t*)(L + 4 * MATB); LAS bf16_t* B5 = (LAS bf16_t*)(L + 5 * MATB); LAS bf16_t* B6 = (LAS bf16_t*)(L + 6 * MATB); LAS bf16_t* B7 = (LAS bf16_t*)(L + 7 * MATB);
    LAS bf16_t* B8 = (LAS bf16_t*)(L + 8 * MATB); LAS bf16_t* B9 = (LAS bf16_t*)(L + 9 * MATB); LAS bf16_t* B10 = (LAS bf16_t*)(L + 10 * MATB); LAS bf16_t* B11 = (LAS bf16_t*)(L + 11 * MATB);
    LAS float* F0 = (LAS float*)(L + OFF_F0); LAS float* TMP = (LAS float*)(L + OFF_TMP);
    LAS bf16_t* TW = (LAS bf16_t*)(L + OFF_TW); LAS bf16_t* TA = (LAS bf16_t*)(L + OFF_TA); LAS bf16_t* TV = (LAS bf16_t*)(L + OFF_TV);
    LAS float* WP = (LAS float*)(L + OFF_WP); LAS float* AP = (LAS float*)(L + OFF_AP); LAS float* VP = (LAS float*)(L + OFF_VP);
    LAS float* TOT = (LAS float*)(L + OFF_TOT); LAS float* GC = (LAS float*)(L + OFF_GC); LAS float* RN = (LAS float*)(L + OFF_RN);
    if (tid_in == 0) qw[0] = atomicAdd(qctr, 1u);
    RW_BAR(); int item = (int)qw[0]; RW_BAR();
    ChunkLoads CL; if (item < NITEMS) { RW_LANES(); chunk_loads(CL, wsb, layer, item, tid, w); }
    for (;;) {
        if (item >= NITEMS) return item;
        if (tid_in == 0) qw[0] = atomicAdd(qctr, 1u);
        const int bh = item / (SEQ / 64), chunk = item % (SEQ / 64), b = bh / 6, h = bh % 6;
        const int tok0 = b * SEQ + chunk * 64;
        float e_mu_r, e_mu_k, e_mu_v, e_w0, e_a0, e_kk, e_ka, e_rk, e_v0;
        { RW_LANES(); const int hc = 64 * h + lane;
          e_mu_r = RWP(mk::RP_MU)[hc]; e_mu_k = RWP(mk::RP_MU)[384 + hc]; e_mu_v = RWP(mk::RP_MU)[768 + hc]; e_w0 = RWP(mk::RP_W0)[hc]; e_a0 = RWP(mk::RP_A0)[hc]; e_kk = RWP(mk::RP_KK)[hc]; e_ka = RWP(mk::RP_KA)[hc]; e_rk = RWP(mk::RP_RK)[hc]; e_v0 = layer > 0 ? RWP(mk::RP_V0)[hc] : 0.f; }
        for (int rp_ = 0; rp_ < ((PROF_PH) == 20 ? 2 : 1); ++rp_) {
        { RW_LANES(); const int t = tid >> 3, sub = tid & 7;
          const v4u lc = CL.lc, lp = CL.lp, kc4 = CL.kc4, kp4 = CL.kp4, vc4 = CL.vc4, vp4 = CL.vp4;
          const unsigned lcw[4] = {lc.x, lc.y, lc.z, lc.w}, lpw[4] = {lp.x, lp.y, lp.z, lp.w}, kcw[4] = {kc4.x, kc4.y, kc4.z, kc4.w}, kpw[4] = {kp4.x, kp4.y, kp4.z, kp4.w}, vcw[4] = {vc4.x, vc4.y, vc4.z, vc4.w}, vpw[4] = {vp4.x, vp4.y, vp4.z, vp4.w};
          unsigned lo[4], vo[4]; float s = 0.f;
          const f32x4 mA0 = *(const GAS f32x4*)(RWP(mk::RP_MU) + 1152 + 8 * sub), mA1 = *(const GAS f32x4*)(RWP(mk::RP_MU) + 1156 + 8 * sub);
          const f32x4 mK0 = *(const GAS f32x4*)(RWP(mk::RP_MU) + 384 + 64 * h + 8 * sub), mK1 = *(const GAS f32x4*)(RWP(mk::RP_MU) + 388 + 64 * h + 8 * sub);
          const f32x4 kk0 = *(const GAS f32x4*)(RWP(mk::RP_KK) + 64 * h + 8 * sub), kk1 = *(const GAS f32x4*)(RWP(mk::RP_KK) + 64 * h + 8 * sub + 4);
          f32x4 mV0 = {0.f, 0.f, 0.f, 0.f}, mV1 = mV0; if (layer > 0 && sub < 2) { mV0 = *(const GAS f32x4*)(RWP(mk::RP_MUV) + 8 * sub); mV1 = *(const GAS f32x4*)(RWP(mk::RP_MUV) + 8 * sub + 4); }
#pragma unroll
          for (int e2 = 0; e2 < 4; ++e2) { float xl[2], xv[2];
#pragma unroll
              for (int u = 0; u < 2; ++u) { const int e = 2 * e2 + u; const int sh = 16 * u;
                  const float c1 = bf2f((bf16_t)((lcw[e2] >> sh) & 0xffff)), p1 = bf2f((bf16_t)((lpw[e2] >> sh) & 0xffff)); const float x = c1 + (e < 4 ? mA0[e & 3] : mA1[e & 3]) * (p1 - c1);
                  xl[u] = sub < 4 ? ftanh(x) : x;
                  const float c2 = bf2f((bf16_t)((kcw[e2] >> sh) & 0xffff)), p2 = bf2f((bf16_t)((kpw[e2] >> sh) & 0xffff));
                  const float kx = (c2 + (e < 4 ? mK0[e & 3] : mK1[e & 3]) * (p2 - c2)) * (e < 4 ? kk0[e & 3] : kk1[e & 3]); s += kx * kx;
                  const float c3 = bf2f((bf16_t)((vcw[e2] >> sh) & 0xffff)), p3 = bf2f((bf16_t)((vpw[e2] >> sh) & 0xffff)); xv[u] = c3 + (e < 4 ? mV0[e & 3] : mV1[e & 3]) * (p3 - c3); }
              lo[e2] = pk2(xl[0], xl[1]); vo[e2] = pk2(xv[0], xv[1]); }
          *(LAS v4u*)((sub < 4 ? TW : TA) + t * 40 + 8 * (sub & 3)) = (v4u){lo[0], lo[1], lo[2], lo[3]};
          if (layer > 0 && sub < 4) *(LAS v4u*)(TV + t * 40 + 8 * sub) = (v4u){vo[0], vo[1], vo[2], vo[3]};
          s += __shfl_xor(s, 1); s += __shfl_xor(s, 2); s += __shfl_xor(s, 4);
          if (sub == 0) RN[t] = __builtin_amdgcn_rsqf(fmaxf(s, 1e-24f)); }
        RW_BAR();
        }
        const int nxt = (int)qw[0];
        { RW_LANES();
#pragma unroll
        for (int e = 0; e < 2; ++e) { const int tl = 2 * w + e, ti = tl >> 2, tj = tl & 3; const f32x4 z4 = {0.f, 0.f, 0.f, 0.f};
            const size_t brow = (size_t)(64 * h + 16 * tj + fr) * 32 + 8 * fq;
            { const bf16x8 a = *(const LAS bf16x8*)(TW + (16 * ti + fr) * 40 + 8 * fq); const bf16x8 bb = *(const GAS bf16x8*)(RW_LORA(mk::SM_W2T) + brow);
              const f32x4 d = __builtin_amdgcn_mfma_f32_16x16x32_bf16(a, bb, z4, 0, 0, 0);
#pragma unroll
              for (int r = 0; r < 4; ++r) WP[(16 * ti + 4 * fq + r) * 65 + 16 * tj + fr] = d[r]; }
            { const bf16x8 a = *(const LAS bf16x8*)(TA + (16 * ti + fr) * 40 + 8 * fq); const bf16x8 bb = *(const GAS bf16x8*)(RW_LORA(mk::SM_A2T) + brow);
              const f32x4 d = __builtin_amdgcn_mfma_f32_16x16x32_bf16(a, bb, z4, 0, 0, 0);
#pragma unroll
              for (int r = 0; r < 4; ++r) AP[(16 * ti + 4 * fq + r) * 65 + 16 * tj + fr] = d[r]; }
            if (layer > 0) { const bf16x8 a = *(const LAS bf16x8*)(TV + (16 * ti + fr) * 40 + 8 * fq); const bf16x8 bb = *(const GAS bf16x8*)(RW_LORA(mk::SM_V2T) + brow);
              const f32x4 d = __builtin_amdgcn_mfma_f32_16x16x32_bf16(a, bb, z4, 0, 0, 0);
#pragma unroll
              for (int r = 0; r < 4; ++r) VP[(16 * ti + 4 * fq + r) * 65 + 16 * tj + fr] = d[r]; } } }
        RW_BAR();
        for (int rp_ = 0; rp_ < ((PROF_PH) == 21 ? 2 : 1); ++rp_) {
        { RW_LANES(); const int c = lane, hc = 64 * h + c, tq0 = 8 * w, tk0 = tok0 + tq0;
          const float mu_r = e_mu_r, mu_k = e_mu_k, mu_v = e_mu_v, w0 = e_w0, a0 = e_a0, k_k = e_kk, k_a = e_ka, r_k = e_rk, v0 = e_v0;
          float pr = bf2f(CL.e_r[0]), pk = bf2f(CL.e_k[0]), pv = bf2f(CL.e_v[0]);
          float rr[8], kq[8], vv[8], kkc[8], bb[8], ld[8], pd[8];
#pragma unroll
          for (int j = 0; j < 8; ++j) { const int t = tq0 + j;
              const float cr = bf2f(CL.e_r[j + 1]), ck = bf2f(CL.e_k[j + 1]), cv = bf2f(CL.e_v[j + 1]);
              const float r = cr + mu_r * (pr - cr), k = ck + mu_k * (pk - ck); float v = cv + mu_v * (pv - cv); pr = cr; pk = ck; pv = cv;
              const float wp = w0 + WP[t * 65 + c], ap = a0 + AP[t * 65 + c];
              const float z = -wp, sp = fmaxf(z, 0.f) + __logf(1.0f + __expf(-fabsf(z))); const float wl = -sp - 0.5f;
              const float al = fsigm(ap);
              if (layer > 0) { const float vp = v0 + VP[t * 65 + c]; const float vf = bf2f(CL.e_vf[j]); v = v + (vf - v) * fsigm(vp); }
              const float kn = k * k_k * RN[t]; const float k2 = k * (1.0f + (al - 1.0f) * k_a);
              rr[j] = r; kq[j] = k2; vv[j] = v; kkc[j] = kn; bb[j] = kn * al; ld[j] = -fexp(wl); pd[j] = r * k2 * r_k; }
          {
#pragma unroll
            for (int j = 0; j < 8; j += 2) { const unsigned pv2 = pk2(vv[j], vv[j + 1]); RW_VF[(size_t)(tk0 + j) * 384 + hc] = (bf16_t)(pv2 & 0xffff); RW_VF[(size_t)(tk0 + j + 1) * 384 + hc] = (bf16_t)(pv2 >> 16); } }
          {
            const bool b5 = lane & 32, b4 = lane & 16, b3 = lane & 8; float s4[4], s2[2], s1;
#pragma unroll
            for (int i = 0; i < 4; ++i) { const float keep = b5 ? pd[i + 4] : pd[i], send = b5 ? pd[i] : pd[i + 4]; s4[i] = keep + __shfl_xor(send, 32); }
#pragma unroll
            for (int i = 0; i < 2; ++i) { const float keep = b4 ? s4[i + 2] : s4[i], send = b4 ? s4[i] : s4[i + 2]; s2[i] = keep + __shfl_xor(send, 16); }
            { const float keep = b3 ? s2[1] : s2[0], send = b3 ? s2[0] : s2[1]; s1 = keep + __shfl_xor(send, 8); }
            s1 += __shfl_xor(s1, 4); s1 += __shfl_xor(s1, 2); s1 += __shfl_xor(s1, 1);
            if ((lane & 7) == 0) RW_DOT[(size_t)(tk0 + (lane >> 3)) * 6 + h] = s1; }
          float cl[8]; cl[0] = ld[0];
#pragma unroll
          for (int j = 1; j < 8; ++j) cl[j] = cl[j - 1] + ld[j];
          TOT[w * 64 + c] = cl[7];
          RW_BAR();
          float prefix = 0.f, cumC = 0.f;
#pragma unroll
          for (int ww = 0; ww < 8; ++ww) { const float tv = TOT[ww * 64 + c]; cumC += tv; if (ww < w) prefix += tv; }
          const float gcc = fexp(cumC); if (w == 0) GC[c] = gcc;
          unsigned ahp[4], btp[4], ktp[4], vp4[4]; float gprev = fexp(prefix), ah_e = 0.f, bt_e = 0.f, kt_e = 0.f;
#pragma unroll
          for (int j = 0; j < 8; ++j) { const int t = tq0 + j; const float g = fexp(prefix + cl[j]), ig = __builtin_amdgcn_rcpf(g), gc = gcc * ig;
              const float ah = -kkc[j] * gprev, rh = rr[j] * g, bh = bb[j] * ig, kh = kq[j] * ig, bt = bb[j] * gc, kt = kq[j] * gc; gprev = g;
              const unsigned w01 = pk2(ah, rh), w23 = pk2(bh, kh);
              B0[t * LD + c] = (bf16_t)(w01 & 0xffff); B1[t * LD + c] = (bf16_t)(w01 >> 16); B2[t * LD + c] = (bf16_t)(w23 & 0xffff); B3[t * LD + c] = (bf16_t)(w23 >> 16);
              if (j & 1) { ahp[j >> 1] = pk2(ah_e, ah); btp[j >> 1] = pk2(bt_e, bt); ktp[j >> 1] = pk2(kt_e, kt); vp4[j >> 1] = pk2(vv[j - 1], vv[j]); }
              else { ah_e = ah; bt_e = bt; kt_e = kt; } }
          *(LAS v4u*)(B4 + c * LD + tq0) = (v4u){ahp[0], ahp[1], ahp[2], ahp[3]}; *(LAS v4u*)(B5 + c * LD + tq0) = (v4u){btp[0], btp[1], btp[2], btp[3]};
          *(LAS v4u*)(B6 + c * LD + tq0) = (v4u){ktp[0], ktp[1], ktp[2], ktp[3]}; *(LAS v4u*)(B7 + c * LD + tq0) = (v4u){vp4[0], vp4[1], vp4[2], vp4[3]}; }
        RW_BAR();
        }
        if (nxt < NITEMS) { RW_LANES(); chunk_loads(CL, wsb, layer, nxt, tid, w); }
        for (int rp_ = 0; rp_ < ((PROF_PH) == 22 ? 2 : 1); ++rp_) {
        { RW_LANES(); const int prod = w >> 1; const LAS bf16_t* Aop = prod < 2 ? B0 : B1; const LAS bf16_t* Bop = (prod & 1) ? B3 : B2;
#pragma unroll
          for (int e = 0; e < 8; ++e) { const int tl = (w & 1) * 8 + e, ti = tl >> 2, tj = tl & 3; f32x4 d = {0.f, 0.f, 0.f, 0.f};
              if (tj <= ti) d = mm_tile(Aop, Bop, ti, tj, fr, fq, d);
#pragma unroll
              for (int r = 0; r < 4; ++r) { const int t = 16 * ti + 4 * fq + r, i = 16 * tj + fr; const bool keep = prod < 2 ? (i < t) : (i <= t); const float val = (tj <= ti && keep) ? d[r] : 0.f;
                  if (prod == 0) F0[t * 65 + i] = val; else if (prod == 1) B8[t * LD + i] = f2bf(val); else if (prod == 2) B9[t * LD + i] = f2bf(val); else B10[t * LD + i] = f2bf(val); } } }
        RW_BAR();
        }
        if (w == 0) { RW_LANES();
            const int blk = lane >> 4, jc = lane & 15; const LAS float* Lb = F0 + (16 * blk) * 65 + 16 * blk; float tc[16];
#pragma unroll
            for (int r = 0; r < 16; ++r) { float val = (r == jc) ? 1.f : 0.f;
#pragma unroll
                for (int i = 0; i < r; ++i) val += Lb[r * 65 + i] * tc[i];
                tc[r] = val; }
            asm volatile("s_waitcnt lgkmcnt(0)" ::: "memory");
#pragma unroll
            for (int r = 0; r < 16; ++r) F0[(16 * blk + r) * 65 + 16 * blk + jc] = tc[r];
        } else { RW_LANES();
#pragma unroll 1
            for (int tl = w - 1; tl < 16; tl += 7) { const int ti = tl >> 2, tj = tl & 3; f32x4 d = {0.f, 0.f, 0.f, 0.f};
                d = mm_tile(B8, B7, ti, tj, fr, fq, d);
                LAS bf16_t* dst = B2 + (16 * tj + fr) * LD + 16 * ti + 4 * fq;
                *(LAS unsigned long long*)dst = (unsigned long long)pk2(d[0], d[1]) | ((unsigned long long)pk2(d[2], d[3]) << 32); } }
        RW_BAR();
        if (w < 2) { RW_LANES();
            const int o1 = 32 * w, o2 = 32 * w + 16; f32x4 d = {0.f, 0.f, 0.f, 0.f};
#pragma unroll
            for (int ks = 0; ks < 4; ++ks) d = __builtin_amdgcn_mfma_f32_16x16x4f32(F0[(o2 + fr) * 65 + o1 + 4 * ks + fq], F0[(o1 + 4 * ks + fq) * 65 + o1 + fr], d, 0, 0, 0);
            LAS float* tm = TMP + w * 16 * 17;
#pragma unroll
            for (int r = 0; r < 4; ++r) tm[(4 * fq + r) * 17 + fr] = d[r];
            asm volatile("s_waitcnt lgkmcnt(0)" ::: "memory");
            f32x4 d2 = {0.f, 0.f, 0.f, 0.f};
#pragma unroll
            for (int ks = 0; ks < 4; ++ks) d2 = __builtin_amdgcn_mfma_f32_16x16x4f32(F0[(o2 + fr) * 65 + o2 + 4 * ks + fq], tm[(4 * ks + fq) * 17 + fr], d2, 0, 0, 0);
            asm volatile("s_waitcnt lgkmcnt(0)" ::: "memory");
#pragma unroll
            for (int r = 0; r < 4; ++r) F0[(o2 + 4 * fq + r) * 65 + o1 + fr] = d2[r];
        }
        RW_BAR();
        if (w < 4) { RW_LANES();
            const int ti = w >> 1, tj = w & 1; f32x4 d = {0.f, 0.f, 0.f, 0.f};
#pragma unroll
            for (int ks = 0; ks < 8; ++ks) d = __builtin_amdgcn_mfma_f32_16x16x4f32(F0[(32 + 16 * ti + fr) * 65 + 4 * ks + fq], F0[(4 * ks + fq) * 65 + 16 * tj + fr], d, 0, 0, 0);
#pragma unroll
            for (int r = 0; r < 4; ++r) TMP[(16 * ti + 4 * fq + r) * 33 + 16 * tj + fr] = d[r];
        }
        RW_BAR();
        if (w < 4) { RW_LANES();
            const int ti = w >> 1, tj = w & 1; f32x4 d = {0.f, 0.f, 0.f, 0.f};
#pragma unroll
            for (int ks = 0; ks < 8; ++ks) d = __builtin_amdgcn_mfma_f32_16x16x4f32(F0[(32 + 16 * ti + fr) * 65 + 32 + 4 * ks + fq], TMP[(4 * ks + fq) * 33 + 16 * tj + fr], d, 0, 0, 0);
#pragma unroll
            for (int r = 0; r < 4; ++r) F0[(32 + 16 * ti + 4 * fq + r) * 65 + 16 * tj + fr] = d[r];
        }
        RW_BAR();
        { RW_LANES(); const int t = tid >> 3, i0 = (tid & 7) * 8;
#pragma unroll
          for (int e = 0; e < 8; ++e) B11[t * LD + i0 + e] = f2bf(F0[t * 65 + i0 + e]); }
        RW_BAR();
        { RW_LANES();
#pragma unroll
        for (int e = 0; e < 4; ++e) { const int tl = 4 * w + e, prod = tl >> 4, ti = (tl >> 2) & 3, tj = tl & 3; f32x4 d = {0.f, 0.f, 0.f, 0.f};
            d = prod == 0 ? mm_tile(B11, B4, ti, tj, fr, fq, d) : mm_tile(B11, B2, ti, tj, fr, fq, d);
            LAS bf16_t* dst = (prod == 0 ? B0 : B3) + (16 * tj + fr) * LD + 16 * ti + 4 * fq;
            *(LAS unsigned long long*)dst = (unsigned long long)pk2(d[0], d[1]) | ((unsigned long long)pk2(d[2], d[3]) << 32); } }
        RW_BAR();
        for (int rp_ = 0; rp_ < ((PROF_PH) == 23 ? 2 : 1); ++rp_) {
        { RW_LANES();
#pragma unroll
        for (int e = 0; e < 8; ++e) { const int tl = 8 * w + e, prod = tl >> 4, ti = (tl >> 2) & 3, tj = tl & 3; f32x4 d = {0.f, 0.f, 0.f, 0.f};
            if (prod == 0) { d = mm_tile(B5, B3, ti, tj, fr, fq, d); d = mm_tile(B6, B7, ti, tj, fr, fq, d);
                *(GAS f32x4*)(RW_Z + (size_t)item * 4096 + (16 * tj + fr) * 64 + 4 * ((4 * ti + fq) ^ fr)) = d; }
            else if (prod == 1) { d = mm_tile(B9, B3, ti, tj, fr, fq, d); d = mm_tile(B10, B7, ti, tj, fr, fq, d);
                *(GAS unsigned long long*)(RW_YV + (size_t)item * 4096 + (16 * tj + fr) * 64 + 16 * ti + 4 * fq) = (unsigned long long)pk2(d[0], d[1]) | ((unsigned long long)pk2(d[2], d[3]) << 32); }
            else if (prod == 2) { d = mm_tile(B9, B0, ti, tj, fr, fq, d);
#pragma unroll
                for (int r = 0; r < 4; ++r) { const int t = 16 * ti + 4 * fq + r, c = 16 * tj + fr; B4[t * LD + sigpos(c)] = f2bf(d[r] + bf2f(B1[t * LD + c])); } }
            else { d = mm_tile(B5, B0, ti, tj, fr, fq, d);
#pragma unroll
                for (int r = 0; r < 4; ++r) { const int c = 16 * ti + 4 * fq + r, c2 = 16 * tj + fr; B8[c * LD + sigpos(c2)] = f2bf(d[r] + (c == c2 ? GC[c] : 0.f)); } } } }
        RW_BAR();
        }
        { RW_LANES(); const int r = tid >> 3, ch = (tid & 7) * 8;
          *(GAS v4u*)(RW_G + (size_t)item * 4096 + r * 64 + ch) = *(const LAS v4u*)(B4 + r * LD + ch);
          *(GAS v4u*)(RW_PT + (size_t)item * 4096 + r * 64 + 8 * ((tid & 7) ^ (r & 7))) = *(const LAS v4u*)(B8 + r * LD + ch); }
        RW_BAR();
        item = nxt;
    }
}
constexpr int SC_NS = 10, SC_SLOT = 12288, SC_LAG = 6;
__device__ __forceinline__ void scan_compute(LAS unsigned char* L, const ChunkBufs cb, int bh, int tj, int lane, volatile LAS unsigned* flags) {
    const int fr = lane & 15, fq = lane >> 4; const int NC = SEQ / 64;
    bf16x8 Bf0 = {0, 0, 0, 0, 0, 0, 0, 0}, Bf1 = {0, 0, 0, 0, 0, 0, 0, 0};
    bf16_t* s0 = cb.S0 + (size_t)(bh * NC) * 4096 + (16 * tj + fr) * 64 + 8 * fq;
    const int po0 = fr * 128 + 16 * ((fq) ^ (fr & 7)), po1 = fr * 128 + 16 * ((4 + fq) ^ (fr & 7));
    int slot = 0;
    for (int chunk = 0; chunk < NC; ++chunk) {
        unsigned spins = 0;
        while (true) { const unsigned a = flags[0], b = flags[1], c = flags[2]; const unsigned m = a < b ? (a < c ? a : c) : (b < c ? b : c); if ((int)m >= chunk + 1 || ++spins > (1u << 22)) break; __builtin_amdgcn_s_sleep(1); }
        const LAS unsigned char* sp = L + slot * SC_SLOT;
        bf16x8 a0[4], a1[4]; f32x4 z[4];
#pragma unroll
        for (int ti = 0; ti < 4; ++ti) { a0[ti] = *(const LAS bf16x8*)(sp + ti * 2048 + po0); a1[ti] = *(const LAS bf16x8*)(sp + ti * 2048 + po1); z[ti] = *(const LAS f32x4*)(sp + 8192 + fr * 256 + 16 * ((4 * ti + fq) ^ fr)); }
        asm volatile("s_waitcnt lgkmcnt(0)" ::: "memory");
        if (lane == 0) flags[3] = (unsigned)(chunk + 1);
        *(GAS bf16x8*)(s0 + (size_t)chunk * 4096) = Bf0; *(GAS bf16x8*)(s0 + (size_t)chunk * 4096 + 32) = Bf1;
        f32x4 acc[4];
#pragma unroll
        for (int ti = 0; ti < 4; ++ti) { acc[ti] = __builtin_amdgcn_mfma_f32_16x16x32_bf16(a0[ti], Bf0, z[ti], 0, 0, 0); acc[ti] = __builtin_amdgcn_mfma_f32_16x16x32_bf16(a1[ti], Bf1, acc[ti], 0, 0, 0); }
        v4u m0, m1;
        m0.x = pk2(acc[0][0], acc[0][1]); m0.y = pk2(acc[0][2], acc[0][3]); m0.z = pk2(acc[1][0], acc[1][1]); m0.w = pk2(acc[1][2], acc[1][3]);
        m1.x = pk2(acc[2][0], acc[2][1]); m1.y = pk2(acc[2][2], acc[2][3]); m1.z = pk2(acc[3][0], acc[3][1]); m1.w = pk2(acc[3][2], acc[3][3]);
        Bf0 = __builtin_bit_cast(bf16x8, m0); Bf1 = __builtin_bit_cast(bf16x8, m1);
        slot = slot + 1 == SC_NS ? 0 : slot + 1;
    }
}
__device__ __forceinline__ void scan_loader(LAS unsigned char* L, const ChunkBufs cb, int bh, int tj, int lw, int lane, volatile LAS unsigned* flags) {
    const int NC = SEQ / 64;
    const char* src[4];
#pragma unroll
    for (int k = 0; k < 4; ++k) { const int pc = 4 * lw + k;
        src[k] = pc < 8 ? (const char*)(cb.PT + (size_t)(bh * NC) * 4096) + pc * 1024 + lane * 16 : (const char*)(cb.Z + (size_t)(bh * NC) * 4096) + tj * 4096 + (pc - 8) * 1024 + lane * 16; }
    const size_t st0 = 8192, st1 = 16384;
    int slot = 0;
    for (int c = 0; c < NC; ++c) {
        unsigned spins = 0;
        while ((int)flags[3] < c - SC_NS + 1 && ++spins < (1u << 22)) __builtin_amdgcn_s_sleep(1);
        const unsigned dst = (unsigned)(slot * SC_SLOT + 4 * lw * 1024);
#pragma unroll
        for (int k = 0; k < 4; ++k) { const int pc = 4 * lw + k;
            __builtin_amdgcn_global_load_lds((const unsigned*)(src[k] + (size_t)c * (pc < 8 ? st0 : st1)), (LAS unsigned*)(L + dst + k * 1024), 16, 0, 0); }
        if (c >= SC_LAG) { asm volatile("s_waitcnt vmcnt(24)" ::: "memory"); if (lane == 0) flags[lw] = (unsigned)(c - SC_LAG + 1); }
        slot = slot + 1 == SC_NS ? 0 : slot + 1;
    }
    asm volatile("s_waitcnt vmcnt(0)" ::: "memory");
    if (lane == 0) flags[lw] = (unsigned)NC;
}
constexpr int O_SG = 0  , O_Y = 9216  , O_GT = O_Y + 16640  ;
struct OutRegs { v4u gc4, gp4, vo4; unsigned long long yw[2]; bf16x8 a[2][2], bb[2][2], b2[2][2]; float dot; f32x4 lw0, lw1, lb0, lb1; };
__device__ __forceinline__ void out_load(OutRegs& R, unsigned char* wsb, int layer, int item, int tid, int w) {
    const GAS bf16_t* P = RW_PROJ;
    const int lane = tid & 63, fr = lane & 15, fq = lane >> 4;
    const int bh = item / (SEQ / 64), chunk = item % (SEQ / 64), b = bh / 6, h = bh % 6; const int tok0 = b * SEQ + chunk * 64; const size_t ib = (size_t)item * 4096;
    const int t = tid >> 3, sub = tid & 7, tok = tok0 + t; const bool hp = (chunk * 64 + t) > 0;
    const GAS bf16_t* rc = P + (size_t)tok * LDP + 1856 + 8 * sub; const v4u z4 = {0u, 0u, 0u, 0u};
    R.gc4 = *(const GAS v4u*)rc; R.gp4 = hp ? *(const GAS v4u*)(rc - LDP) : z4;
#pragma unroll
    for (int e = 0; e < 2; ++e) { const int tl = 2 * w + e, ti = tl >> 2, tj = tl & 3;
        R.yw[e] = *(const GAS unsigned long long*)(RW_YV + ib + (16 * tj + fr) * 64 + 16 * ti + 4 * fq);
#pragma unroll
        for (int kk = 0; kk < 2; ++kk) { R.a[e][kk] = *(const GAS bf16x8*)(RW_G + ib + (16 * ti + fr) * 64 + 32 * kk + 8 * fq); R.bb[e][kk] = *(const GAS bf16x8*)(RW_S0 + ib + (16 * tj + fr) * 64 + 32 * kk + 8 * fq);
            R.b2[e][kk] = *(const GAS bf16x8*)(RW_LORA(mk::SM_G2T) + (size_t)(64 * h + 16 * tj + fr) * 64 + 32 * kk + 8 * fq); } }
    R.dot = RW_DOT[(size_t)tok * 6 + h]; R.vo4 = *(const GAS v4u*)(RW_VF + (size_t)tok * 384 + 64 * h + 8 * sub);
    R.lw0 = *(const GAS f32x4*)(RWP(mk::RP_LNW) + 64 * h + 8 * sub); R.lw1 = *(const GAS f32x4*)(RWP(mk::RP_LNW) + 64 * h + 8 * sub + 4); R.lb0 = *(const GAS f32x4*)(RWP(mk::RP_LNB) + 64 * h + 8 * sub); R.lb1 = *(const GAS f32x4*)(RWP(mk::RP_LNB) + 64 * h + 8 * sub + 4);
}
__device__ __forceinline__ void out_phase(LAS unsigned char* L, unsigned char* wsb, int layer, int tid_in, int first, int stride) {
    GAS bf16_t* MIX = RW_MIX;
    const int w = __builtin_amdgcn_readfirstlane(tid_in >> 6);
    LAS bf16_t* SG = (LAS bf16_t*)(L + O_SG); LAS float* Y = (LAS float*)(L + O_Y); LAS float* GT = (LAS float*)(L + O_GT);
    OutRegs R; if (first < NITEMS) { RW_LANES(); out_load(R, wsb, layer, first, tid, w); }
    for (int item = first; item < NITEMS; item += stride) {
        const int bh = item / (SEQ / 64), chunk = item % (SEQ / 64), b = bh / 6, h = bh % 6; const int tok0 = b * SEQ + chunk * 64;
        OutRegs N = R; if (item + stride < NITEMS) { RW_LANES(); out_load(N, wsb, layer, item + stride, tid, w); }
        { RW_LANES(); const int t = tid >> 3, sub = tid & 7;
          const f32x4 m0 = *(const GAS f32x4*)(RWP(mk::RP_MU) + 1216 + 8 * sub), m1 = *(const GAS f32x4*)(RWP(mk::RP_MU) + 1220 + 8 * sub);
          const unsigned cw_[4] = {R.gc4.x, R.gc4.y, R.gc4.z, R.gc4.w}, pw_[4] = {R.gp4.x, R.gp4.y, R.gp4.z, R.gp4.w}; unsigned o[4];
#pragma unroll
          for (int e2 = 0; e2 < 4; ++e2) { float x[2];
#pragma unroll
              for (int u = 0; u < 2; ++u) { const int e = 2 * e2 + u; const float c1 = bf2f((bf16_t)((cw_[e2] >> (16 * u)) & 0xffff)), p1 = bf2f((bf16_t)((pw_[e2] >> (16 * u)) & 0xffff));
                  x[u] = fsigm(c1 + (e < 4 ? m0[e & 3] : m1[e & 3]) * (p1 - c1)); }
              o[e2] = pk2(x[0], x[1]); }
          *(LAS v4u*)(SG + t * LD + 8 * sub) = (v4u){o[0], o[1], o[2], o[3]}; }
        RW_BAR();
        { RW_LANES();
#pragma unroll
        for (int e = 0; e < 2; ++e) { const int tl = 2 * w + e, ti = tl >> 2, tj = tl & 3; const unsigned long long yw = R.yw[e];
            f32x4 d = {bf2f((bf16_t)(yw & 0xffff)), bf2f((bf16_t)((yw >> 16) & 0xffff)), bf2f((bf16_t)((yw >> 32) & 0xffff)), bf2f((bf16_t)(yw >> 48))}; f32x4 g = {0.f, 0.f, 0.f, 0.f};
#pragma unroll
            for (int kk = 0; kk < 2; ++kk) {
                d = __builtin_amdgcn_mfma_f32_16x16x32_bf16(R.a[e][kk], R.bb[e][kk], d, 0, 0, 0);
                const bf16x8 a2 = *(const LAS bf16x8*)(SG + (16 * ti + fr) * LD + 32 * kk + 8 * fq);
                g = __builtin_amdgcn_mfma_f32_16x16x32_bf16(a2, R.b2[e][kk], g, 0, 0, 0); }
#pragma unroll
            for (int r = 0; r < 4; ++r) { Y[(16 * ti + 4 * fq + r) * 65 + 16 * tj + fr] = d[r]; GT[(16 * ti + 4 * fq + r) * 65 + 16 * tj + fr] = g[r]; } } }
        RW_BAR();
        { RW_LANES(); const int t = tid >> 3, sub = tid & 7, tok = tok0 + t; float yv[8], s = 0.f;
#pragma unroll
          for (int e = 0; e < 8; ++e) { yv[e] = Y[t * 65 + 8 * sub + e]; s += yv[e]; }
          s += __shfl_xor(s, 1); s += __shfl_xor(s, 2); s += __shfl_xor(s, 4);
          const float mean = s * (1.0f / 64.0f); float q = 0.f;
#pragma unroll
          for (int e = 0; e < 8; ++e) { const float dd = yv[e] - mean; q += dd * dd; }
          q += __shfl_xor(q, 1); q += __shfl_xor(q, 2); q += __shfl_xor(q, 4);
          const float rstd = __builtin_amdgcn_rsqf(q * (1.0f / 64.0f) + GN_EPS), dot = R.dot;
          const unsigned vw[4] = {R.vo4.x, R.vo4.y, R.vo4.z, R.vo4.w}; unsigned o[4];
#pragma unroll
          for (int e = 0; e < 8; e += 2) { float r2[2];
#pragma unroll
              for (int u = 0; u < 2; ++u) { const int ee = e + u; const float lw = ee < 4 ? R.lw0[ee & 3] : R.lw1[ee & 3], lb = ee < 4 ? R.lb0[ee & 3] : R.lb1[ee & 3];
                  const float yn = (yv[ee] - mean) * rstd * lw + lb; const float vv = bf2f((bf16_t)((vw[ee >> 1] >> (16 * (ee & 1))) & 0xffff));
                  r2[u] = (yn + dot * vv) * GT[t * 65 + 8 * sub + ee]; }
              o[e >> 1] = pk2(r2[0], r2[1]); }
          *(GAS v4u*)(MIX + (size_t)tok * DM + 384 + 64 * h + 8 * sub) = (v4u){o[0], o[1], o[2], o[3]}; }
        RW_BAR();
        R = N;
    }
}
}
namespace at {
constexpr int LDK = 72, LDV = 264;
constexpr int A_K = 0, A_V = 256 * LDK * 2  , A_BIAS = A_V + 64 * LDV * 2  , LDB = 256, BOFF = 48, A_END = A_BIAS + 6 * LDB * 4;
__device__ __forceinline__ int vpos(int key) { return (key & ~31) + 8 * ((key >> 2) & 3) + 4 * ((key >> 4) & 1) + (key & 3); }
__device__ __forceinline__ unsigned pk2(float lo, float hi) { typedef float f2_t __attribute__((ext_vector_type(2))); typedef __bf16 b2_t __attribute__((ext_vector_type(2))); f2_t v = {lo, hi}; return __builtin_bit_cast(unsigned, __builtin_convertvector(v, b2_t)); }
#define AT_BAR() do { asm volatile("s_waitcnt vmcnt(0) lgkmcnt(0)" ::: "memory"); __builtin_amdgcn_s_barrier(); asm volatile("" ::: "memory"); } while (0)

struct StageRegs { v4u k[4], v[4]; };
__device__ __forceinline__ void stage_issue(StageRegs& R, int tid, const bf16_t* kbase, const bf16_t* vbase, long pitch, int jvalid0) {
    const v4u z4 = {0u, 0u, 0u, 0u};
#pragma unroll
    for (int it = 0; it < 4; ++it) { const int idx = it * 512 + tid, key = idx >> 3, ch = idx & 7; R.k[it] = key >= jvalid0 ? *(const GAS v4u*)(kbase + (long)key * pitch + 8 * ch) : z4; }
#pragma unroll
    for (int it = 0; it < 4; ++it) { const int idx = it * 512 + tid, key = idx & 255, ch = idx >> 8; R.v[it] = key >= jvalid0 ? *(const GAS v4u*)(vbase + (long)key * pitch + 8 * ch) : z4; }
}
__device__ __forceinline__ void stage_commit(LAS unsigned char* L, const StageRegs& R, int tid, const float* gk) {
    LAS bf16_t* Kl = (LAS bf16_t*)(L + A_K); LAS bf16_t* VTl = (LAS bf16_t*)(L + A_V);
#pragma unroll
    for (int it = 0; it < 4; ++it) { const int idx = it * 512 + tid, key = idx >> 3, ch = idx & 7; const v4u raw = R.k[it];
        float f[8]; f[0] = __builtin_bit_cast(float, raw.x << 16); f[1] = __builtin_bit_cast(float, raw.x & 0xffff0000u); f[2] = __builtin_bit_cast(float, raw.y << 16); f[3] = __builtin_bit_cast(float, raw.y & 0xffff0000u);
        f[4] = __builtin_bit_cast(float, raw.z << 16); f[5] = __builtin_bit_cast(float, raw.z & 0xffff0000u); f[6] = __builtin_bit_cast(float, raw.w << 16); f[7] = __builtin_bit_cast(float, raw.w & 0xffff0000u);
        float ss = 0.f;
#pragma unroll
        for (int e = 0; e < 8; ++e) ss += f[e] * f[e];
        ss += __shfl_xor(ss, 1); ss += __shfl_xor(ss, 2); ss += __shfl_xor(ss, 4);
        const float rs = __builtin_amdgcn_rsqf(ss * (1.0f / 64.0f) + EPS);
        const f32x4 g0 = *(const GAS f32x4*)(gk + 8 * ch), g1 = *(const GAS f32x4*)(gk + 8 * ch + 4);
        v4u o; o.x = pk2(f[0] * rs * g0[0], f[1] * rs * g0[1]); o.y = pk2(f[2] * rs * g0[2], f[3] * rs * g0[3]); o.z = pk2(f[4] * rs * g1[0], f[5] * rs * g1[1]); o.w = pk2(f[6] * rs * g1[2], f[7] * rs * g1[3]);
        *(LAS v4u*)(Kl + key * LDK + 8 * ch) = o; }
#pragma unroll
    for (int it = 0; it < 4; ++it) { const int idx = it * 512 + tid, key = idx & 255, ch = idx >> 8; const v4u raw = R.v[it];
        LAS bf16_t* d = VTl + (8 * ch) * LDV + vpos(key);
        d[0 * LDV] = (bf16_t)(raw.x & 0xffff); d[1 * LDV] = (bf16_t)(raw.x >> 16); d[2 * LDV] = (bf16_t)(raw.y & 0xffff); d[3 * LDV] = (bf16_t)(raw.y >> 16);
        d[4 * LDV] = (bf16_t)(raw.z & 0xffff); d[5 * LDV] = (bf16_t)(raw.z >> 16); d[6 * LDV] = (bf16_t)(raw.w & 0xffff); d[7 * LDV] = (bf16_t)(raw.w >> 16); }
}
struct QRaw { v4u r0, r1; };
__device__ __forceinline__ QRaw q_raw(const bf16_t* qrow, int fq) { QRaw q; q.r0 = *(const GAS v4u*)(qrow + 8 * fq); q.r1 = *(const GAS v4u*)(qrow + 32 + 8 * fq); return q; }
__device__ __forceinline__ void q_finish(const QRaw qr, const float* gq, int fq, bf16x8& q0, bf16x8& q1) {
    float f[16]; const unsigned w[8] = {qr.r0.x, qr.r0.y, qr.r0.z, qr.r0.w, qr.r1.x, qr.r1.y, qr.r1.z, qr.r1.w};
#pragma unroll
    for (int e = 0; e < 8; ++e) { f[2 * e] = __builtin_bit_cast(float, w[e] << 16); f[2 * e + 1] = __builtin_bit_cast(float, w[e] & 0xffff0000u); }
    float ss = 0.f;
#pragma unroll
    for (int e = 0; e < 16; ++e) ss += f[e] * f[e];
    ss += __shfl_xor(ss, 16); ss += __shfl_xor(ss, 32);
    const float rs = 0.125f * __builtin_amdgcn_rsqf(ss * (1.0f / 64.0f) + EPS);
    const f32x4 g0 = *(const GAS f32x4*)(gq + 8 * fq), g1 = *(const GAS f32x4*)(gq + 8 * fq + 4), g2 = *(const GAS f32x4*)(gq + 32 + 8 * fq), g3 = *(const GAS f32x4*)(gq + 36 + 8 * fq);
    v4u a, b;
    a.x = pk2(f[0] * rs * g0[0], f[1] * rs * g0[1]); a.y = pk2(f[2] * rs * g0[2], f[3] * rs * g0[3]); a.z = pk2(f[4] * rs * g1[0], f[5] * rs * g1[1]); a.w = pk2(f[6] * rs * g1[2], f[7] * rs * g1[3]);
    b.x = pk2(f[8] * rs * g2[0], f[9] * rs * g2[1]); b.y = pk2(f[10] * rs * g2[2], f[11] * rs * g2[3]); b.z = pk2(f[12] * rs * g3[0], f[13] * rs * g3[1]); b.w = pk2(f[14] * rs * g3[2], f[15] * rs * g3[3]);
    q0 = __builtin_bit_cast(bf16x8, a); q1 = __builtin_bit_cast(bf16x8, b);
}
template <int NT, bool SWA> __device__ __forceinline__ void attn_wave(const LAS unsigned char* L, bf16x8 q0, bf16x8 q1, int kt0, int qi0, int hq, float sink, bool first_block, bf16_t* outp, int fr, int fq) {
    const LAS bf16_t* Kl = (const LAS bf16_t*)(L + A_K); const LAS bf16_t* VTl = (const LAS bf16_t*)(L + A_V); const LAS float* bias = (const LAS float*)(L + A_BIAS);
    f32x4 s[NT];
#pragma unroll
    for (int t = 0; t < NT; ++t) { const LAS bf16_t* kr = Kl + (16 * (kt0 + t) + fr) * LDK + 8 * fq;
        const f32x4 z = {0.f, 0.f, 0.f, 0.f};
        s[t] = __builtin_amdgcn_mfma_f32_16x16x32_bf16(*(const LAS bf16x8*)kr, q0, z, 0, 0, 0);
        s[t] = __builtin_amdgcn_mfma_f32_16x16x32_bf16(*(const LAS bf16x8*)(kr + 32), q1, s[t], 0, 0, 0);
        if (t & 1) __builtin_amdgcn_sched_barrier(0); }
    float mx = SWA ? sink : -3.0e38f;
    if (SWA) {
        const int odd = (qi0 >> 4) & 1; const int D0 = qi0 + fr + 128 - 16 * kt0 - 4 * fq;
        const LAS float* bp = bias + hq * LDB + BOFF + D0 - 147;
#pragma unroll
        for (int t = 0; t < NT; ++t) { const int c = t - odd;
            if (c >= 1 && c <= 7 && !first_block) {
#pragma unroll
                for (int r = 0; r < 4; ++r) { s[t][r] += bp[147 - 16 * t - r]; mx = fmaxf(mx, s[t][r]); }
            } else {
#pragma unroll
                for (int r = 0; r < 4; ++r) { const int dist = D0 - 16 * t - r; const bool valid = (unsigned)dist < 128u && !(first_block && 16 * (kt0 + t) + 4 * fq + r < 128);
                    s[t][r] = valid ? s[t][r] + bp[147 - 16 * t - r] : -3.0e38f; mx = fmaxf(mx, s[t][r]); } } }
    } else {
#pragma unroll
        for (int t = 0; t < NT; ++t)
#pragma unroll
            for (int r = 0; r < 4; ++r) mx = fmaxf(mx, s[t][r]);
    }
    mx = fmaxf(mx, __shfl_xor(mx, 16)); mx = fmaxf(mx, __shfl_xor(mx, 32));
    float l = 0.f;
#pragma unroll
    for (int t = 0; t < NT; ++t)
#pragma unroll
        for (int r = 0; r < 4; ++r) { const float p = __expf(s[t][r] - mx); s[t][r] = p; l += p; }
    l += __shfl_xor(l, 16); l += __shfl_xor(l, 32);
    if (SWA) l += __expf(sink - mx);
    f32x4 o[4];
#pragma unroll
    for (int dt = 0; dt < 4; ++dt) o[dt] = (f32x4){0.f, 0.f, 0.f, 0.f};
#pragma unroll
    for (int ks = 0; ks < NT / 2; ++ks) { v4u pw; pw.x = pk2(s[2 * ks][0], s[2 * ks][1]); pw.y = pk2(s[2 * ks][2], s[2 * ks][3]); pw.z = pk2(s[2 * ks + 1][0], s[2 * ks + 1][1]); pw.w = pk2(s[2 * ks + 1][2], s[2 * ks + 1][3]);
        const bf16x8 pb = __builtin_bit_cast(bf16x8, pw);
#pragma unroll
        for (int dt = 0; dt < 4; ++dt) o[dt] = __builtin_amdgcn_mfma_f32_16x16x32_bf16(*(const LAS bf16x8*)(VTl + (16 * dt + fr) * LDV + 32 * (kt0 / 2 + ks) + 8 * fq), pb, o[dt], 0, 0, 0);
        __builtin_amdgcn_sched_barrier(0); }
    const float inv = __builtin_amdgcn_rcpf(l);
#pragma unroll
    for (int dt = 0; dt < 4; ++dt) *(GAS unsigned long long*)(outp + (long)fr * DM + 16 * dt + 4 * fq) = (unsigned long long)pk2(o[dt][0] * inv, o[dt][1] * inv) | ((unsigned long long)pk2(o[dt][2] * inv, o[dt][3] * inv) << 32);
}
struct AttnArgs { const bf16_t* PROJ; const bf16_t* MKV; bf16_t* MIX; const float* biastab; const float *sinks, *gq, *gk, *gmq, *gmk; };
__device__ __forceinline__ void item_stage_issue(StageRegs& R, const AttnArgs A, int q, int tid) {
    if (q >= 256) { const int item = q - 256, b = item >> 7, hkv = (item >> 6) & 1, blk = item & 63; const long tokb = (long)b * SEQ + blk * 128;
        stage_issue(R, tid, A.PROJ + (tokb - 128) * LDP + 384 + 64 * hkv, A.PROJ + (tokb - 128) * LDP + 512 + 64 * hkv, LDP, blk == 0 ? 128 : 0); }
    else { const int b = q >> 7, h = (q >> 5) & 3; stage_issue(R, tid, A.MKV + (long)(b * 256) * 512 + 64 * h, A.MKV + (long)(b * 256) * 512 + 256 + 64 * h, 512, 0); }
}
__device__ __forceinline__ void attn_phase(LAS unsigned char* L, const AttnArgs A, unsigned* qctr, volatile LAS unsigned* qw, int tid_in) {
    const int w = __builtin_amdgcn_readfirstlane(tid_in >> 6);
    { int lt_ = tid_in; asm volatile("" : "+v"(lt_)); const int tid = lt_;
      LAS float* bl = (LAS float*)(L + A_BIAS); for (int i = tid; i < 6 * LDB; i += 512) { const int hh = i / LDB, d = i % LDB - BOFF; bl[i] = (d >= 0 && d < 128) ? A.biastab[d * 6 + hh] : 0.f; } }
    if (tid_in == 0) qw[0] = atomicAdd(qctr, 1u);
    AT_BAR(); int q = (int)qw[0]; AT_BAR();
    StageRegs SR; if (q < 512) { int lt_ = tid_in; asm volatile("" : "+v"(lt_)); item_stage_issue(SR, A, q, lt_); }
    while (q < 512) {
        int lt_ = tid_in; asm volatile("" : "+v"(lt_)); const int tid = lt_, lane = lt_ & 63, fr = lane & 15, fq = lane >> 4;
        const bool swa = q >= 256;
        stage_commit(L, SR, tid, swa ? A.gk : A.gmk);
        QRaw qa, qb, qc; int b, hh, blk;
        if (swa) { const int item = q - 256; b = item >> 7; hh = (item >> 6) & 1; blk = item & 63; const bf16_t* qp = A.PROJ + ((long)b * SEQ + blk * 128 + 16 * w + fr) * LDP + 192 * hh;
            qa = q_raw(qp, fq); qb = q_raw(qp + 64, fq); qc = q_raw(qp + 128, fq); }
        else { b = q >> 7; hh = (q >> 5) & 3; blk = q & 31; const bf16_t* qp = A.PROJ + ((long)b * SEQ + (2 * blk) * 128 + 16 * w + fr) * LDP + 1984 + 64 * hh;
            qa = q_raw(qp, fq); qb = q_raw(qp + (long)128 * LDP, fq); qc = qb; }
        if (tid_in == 0) qw[0] = atomicAdd(qctr, 1u);
        AT_BAR(); const int qn = (int)qw[0];
        if (qn < 512) item_stage_issue(SR, A, qn, tid);
        if (swa) { const long tokb = (long)b * SEQ + blk * 128;
#pragma unroll 1
            for (int g = 0; g < 3; ++g) { const int hq = 3 * hh + g; bf16x8 q0, q1; const QRaw cq = g == 0 ? qa : (g == 1 ? qb : qc); q_finish(cq, A.gq, fq, q0, q1);
                attn_wave<10, true>(L, q0, q1, w & ~1, 16 * w, hq, A.sinks[hq], blk == 0, A.MIX + (tokb + 16 * w) * DM + 64 * hq, fr, fq); } }
        else {
#pragma unroll 1
            for (int u = 0; u < 2; ++u) { const long tokb = (long)b * SEQ + (2 * blk + u) * 128; bf16x8 q0, q1; const QRaw cq = u == 0 ? qa : qb; q_finish(cq, A.gmq, fq, q0, q1);
                attn_wave<16, false>(L, q0, q1, 0, 16 * w, 0, 0.f, false, A.MIX + (tokb + 16 * w) * DM + 768 + 64 * hh, fr, fq); } }
        AT_BAR();
        q = qn;
    }
}
}
constexpr int NWAVES = 8;
namespace mk {
#ifndef PROF_PH
#define PROF_PH -1
#endif
#ifndef PROF_N
#define PROF_N 1
#endif
#ifndef PROF_TA
#define PROF_TA -1
#endif
#ifndef PROF_TB
#define PROF_TB -1
#endif
#define REPEAT(k) for (int rep_ = 0; rep_ < ((PROF_PH) == (k) ? (PROF_N) : 1); ++rep_)
#ifndef FAST_RWKV
#define FAST_RWKV 1
#endif
#ifndef FAST_ATTN
#define FAST_ATTN 1
#endif

struct Args { const float* in[N_IN]; float* out; unsigned char* ws; int ph_lo, ph_hi; };

__device__ __forceinline__ unsigned pk2(float lo, float hi) { typedef float f2_t __attribute__((ext_vector_type(2))); typedef __bf16 b2_t __attribute__((ext_vector_type(2))); f2_t v = {lo, hi}; return __builtin_bit_cast(unsigned, __builtin_convertvector(v, b2_t)); }
__device__ __forceinline__ float wave_sum(float v) {
#pragma unroll
    for (int o = 1; o < 64; o <<= 1) v += __shfl_xor(v, o);
    return v;
}
template <int MODE> __device__ __forceinline__ void transpose_item(const float* W, const float* g, int K, int N, bf16_t* WT, LAS float* scr, int item, int lane) {
    const int nblk = N / 32, kb = item / nblk, nb = item % nblk, k0 = 64 * kb, n0 = 32 * nb;
    float tv[32];
#pragma unroll
    for (int i = 0; i < 32; ++i) tv[i] = W[(size_t)(k0 + 2 * i + (lane >> 5)) * N + n0 + (lane & 31)];
#pragma unroll
    for (int i = 0; i < 32; ++i) { const int kk = 2 * i + (lane >> 5); float v = tv[i]; if (g) v *= g[k0 + kk]; scr[kk * 33 + (lane & 31)] = v; }
    LDS_WAIT(); asm volatile("" ::: "memory");
    const int c = lane & 7;
#pragma unroll
    for (int j = 0; j < 4; ++j) { const int n = (lane >> 3) + 8 * j; const LAS float* s = scr + (8 * c) * 33 + n;
        v4u o; o.x = pk2(s[0 * 33], s[1 * 33]); o.y = pk2(s[2 * 33], s[3 * 33]); o.z = pk2(s[4 * 33], s[5 * 33]); o.w = pk2(s[6 * 33], s[7 * 33]);
        int nr = n0 + n; if (MODE == 2) nr = nr < 1920 ? nr : nr + 64;
        if (MODE == 1) nr = nr < 2816 ? 256 * (nr >> 7) + (nr & 127) : 256 * ((nr - 2816) >> 7) + 128 + ((nr - 2816) & 127);
        *(GAS v4u*)(WT + (size_t)nr * K + k0 + 8 * c) = o; }
    LDS_WAIT(); asm volatile("" ::: "memory");
}
template <int R> __device__ __forceinline__ void rows_to_bf16(const float* x, bf16_t* o, float* ssq, long row0, long rstride, int lane) {
    f32x4 v[R][4]; float s[R];
#pragma unroll
    for (int r = 0; r < R; ++r) { const GAS f32x4* xr = (const GAS f32x4*)(x + (row0 + r * rstride) * DM) + lane;
#pragma unroll
        for (int j = 0; j < 4; ++j) v[r][j] = xr[64 * j]; }
#pragma unroll
    for (int r = 0; r < R; ++r) { s[r] = 0.f;
#pragma unroll
        for (int j = 0; j < 4; ++j) s[r] += (v[r][j].x * v[r][j].x + v[r][j].y * v[r][j].y) + (v[r][j].z * v[r][j].z + v[r][j].w * v[r][j].w); }
#pragma unroll
    for (int o2 = 1; o2 < 64; o2 <<= 1) {
#pragma unroll
        for (int r = 0; r < R; ++r) s[r] += __shfl_xor(s[r], o2); }
#pragma unroll
    for (int r = 0; r < R; ++r) { GAS unsigned long long* o8 = (GAS unsigned long long*)(o + (row0 + r * rstride) * DM) + lane;
#pragma unroll
        for (int j = 0; j < 4; ++j) o8[64 * j] = (unsigned long long)pk2(v[r][j].x, v[r][j].y) | ((unsigned long long)pk2(v[r][j].z, v[r][j].w) << 32);
        if (lane == 0) ssq[row0 + r * rstride] = s[r]; }
}
__device__ __forceinline__ void row_to_bf16(const float* xrow, bf16_t* orow, float* ssq_out, int lane) {
    const GAS f32x4* xr = (const GAS f32x4*)xrow + lane; f32x4 v[4]; float s = 0.f;
#pragma unroll
    for (int j = 0; j < 4; ++j) { v[j] = xr[64 * j]; s += (v[j].x * v[j].x + v[j].y * v[j].y) + (v[j].z * v[j].z + v[j].w * v[j].w); }
    s = wave_sum(s);
    GAS unsigned long long* o8 = (GAS unsigned long long*)orow + lane;
#pragma unroll
    for (int j = 0; j < 4; ++j) o8[64 * j] = (unsigned long long)pk2(v[j].x, v[j].y) | ((unsigned long long)pk2(v[j].z, v[j].w) << 32);
    if (lane == 0) *ssq_out = s;
}

__global__ void __launch_bounds__(NWAVES * 64, 2) mk_fwd(Args args) {
    extern __shared__ __attribute__((aligned(16))) unsigned char lds[];
    LAS unsigned char* L = (LAS unsigned char*)lds;
    volatile LAS unsigned* MISC = (volatile LAS unsigned*)(L + MISC_OFF);
    const int tid0 = threadIdx.x; const int wave0 = __builtin_amdgcn_readfirstlane(tid0 >> 6);
    const int G = gridDim.x;
    unsigned char* ws = args.ws;
    gu32* ctl = (gu32*)(ws + WS_CTL);
    for (int u = tid0; u < (LDS_BYTES - LDSCTL_OFF) / 4; u += NWAVES * 64) ((LAS unsigned*)(L + LDSCTL_OFF))[u] = 0u;
    __syncthreads();
    XcdBarrier bar = xcd_barrier_post((unsigned*)(ctl + CW_BAR), MISC + 8);
    const int lo = args.ph_lo, hi = args.ph_hi;
    int ph = 0;
#define PH_BEGIN if (lo <= ph && ph < hi) { if ((PROF_TA) >= 0 && blockIdx.x == 0 && tid0 == 0) MISC[24 + ph] = (unsigned)__builtin_amdgcn_s_memrealtime(); unsigned char* wsp = args.ws; asm volatile("" : "+s"(wsp)); int tid = wave0 * 64 + (int)__builtin_amdgcn_mbcnt_hi(~0u, __builtin_amdgcn_mbcnt_lo(~0u, 0u)); asm volatile("" : "+v"(tid)); const int lane = tid & 63, wave = __builtin_amdgcn_readfirstlane(tid >> 6); const long gtid = (long)blockIdx.x * (NWAVES * 64) + tid; const int gw = blockIdx.x * NWAVES + wave; LAS float* scr = (LAS float*)(L + wave * 16384); (void)lane; (void)gtid; (void)gw; (void)scr;
#define PH_END   if (ph + 1 < hi) { xcd_barrier(bar); if ((PROF_PH) == 30 && ph == 3) for (int xb_ = 0; xb_ < 10; ++xb_) xcd_barrier(bar); } } ++ph;
    float* out = args.out;
#define SSQ_A ((float*)(wsp + WS_CTL + CTL_SSQ))
#define SSQ_B (SSQ_A + 3 * MTOK)
#define biastab ((float*)(wsp + WS_SMALL + SM_BIAS))
#define ssqm ((float*)(wsp + WS_SMALL + SM_SSQM))
#define MKV ((bf16_t*)(wsp + WS_SMALL + SM_MKV))
#define MEMB ((bf16_t*)(wsp + WS_MEMB))
#define Wt_in ((bf16_t*)(wsp + (l == 0 ? WS_WT + WT_IN : WS_WIN1)))
#define Wt_out ((bf16_t*)(wsp + WS_WT + WT_OUT))
#define Wt_up ((bf16_t*)(wsp + WS_WT + WT_UP))
#define Wt_down ((bf16_t*)(wsp + WS_WT + WT_DOWN))
#define Wt_mkv ((bf16_t*)(wsp + (l == 0 ? WS_WT + WT_MKV : WS_WIN1 + 4718592)))
#define XB ((bf16_t*)(wsp + WS_XB))
#define VF ((bf16_t*)(wsp + WS_VF))
#define PROJ ((bf16_t*)(wsp + WS_PROJ))
#define MIX ((bf16_t*)(wsp + WS_MIX))
#define U ((bf16_t*)(wsp + WS_U))
#define ACT ((bf16_t*)(wsp + WS_ACT))
#define PA ((size_t)MTOK * 384)
#define pR ((bf16_t*)(wsp + WS_PREP))
#define pK (pR + PA)
#define pV (pR + 2 * PA)
#define pKK (pR + 3 * PA)
#define pB (pR + 4 * PA)
#define pLD (pR + 5 * PA)
    const long gsize = (long)G * (NWAVES * 64);
    const int NGW = G * NWAVES;

#define MK_W() sk::RwkvW W{args.in[I_MU] + l * 1280, args.in[I_MUV], args.in[I_W0] + l * 384, args.in[I_W2] + l * 32 * 384, args.in[I_A0] + l * 384, args.in[I_A2] + l * 32 * 384, args.in[I_V0], args.in[I_V2], args.in[I_G2] + l * 64 * 384, args.in[I_KK] + l * 384, args.in[I_KA] + l * 384, args.in[I_RK] + l * 384, args.in[I_LNW] + l * 384, args.in[I_LNB] + l * 384};
#define MK_CBUF() const rw::ChunkBufs cbuf{(bf16_t*)(wsp + WS_PT), (bf16_t*)(wsp + WS_G), (float*)(wsp + WS_Z), (bf16_t*)(wsp + WS_YV), (bf16_t*)(wsp + WS_S0), (bf16_t*)(wsp + WS_VF), (float*)(wsp + WS_DOT), (const bf16_t*)(wsp + WS_SMALL + SM_W2T + l * SM_LORA_L), (const bf16_t*)(wsp + WS_SMALL + SM_A2T + l * SM_LORA_L), (const bf16_t*)(wsp + WS_SMALL + SM_V2T + l * SM_LORA_L), (const bf16_t*)(wsp + WS_SMALL + SM_G2T + l * SM_LORA_L)};
    for (int l = 0; l < 2; ++l) {
        const float* xin = l == 0 ? args.in[I_X] : out;
        if (l == 0) {
        PH_BEGIN
            REPEAT(0) {
            const int I_IN = 16 * 68, I_KV = 16 * 16, NIT = 2 * (I_IN + I_KV);
            for (int it = gw; it < NIT; it += NGW) {
                int r = it; const int ll = r >= I_IN + I_KV ? 1 : 0; r -= ll * (I_IN + I_KV);
                bf16_t* win = (bf16_t*)(wsp + (ll == 0 ? WS_WT + WT_IN : WS_WIN1)); bf16_t* wkv = (bf16_t*)(wsp + (ll == 0 ? WS_WT + WT_MKV : WS_WIN1 + 4718592));
                if (r < I_IN) transpose_item<2>(args.in[I_WIN] + (size_t)ll * 1024 * 2176, args.in[I_MIXG] + ll * 1024, 1024, 2176, win, scr, r, lane);
                else transpose_item<0>(args.in[I_WMKV] + (size_t)ll * 1024 * 512, args.in[I_MEMG] + ll * 1024, 1024, 512, wkv, scr, r - I_IN, lane);
            }
            for (long i = gtid; i < 2 * 128 * 1024; i += gsize) { const int ll = (int)(i >> 17), n = (int)(i >> 10) & 127, k = (int)(i & 1023); float v = 0.f;
                if (ll > 0 && n < 16) v = args.in[I_WINV][k * 16 + n] * args.in[I_MIXG][1024 + k];
                ((bf16_t*)(wsp + (ll == 0 ? WS_WT + WT_IN : WS_WIN1)))[(size_t)(n < 64 ? 1920 + n : 2176 + n) * 1024 + k] = f2bf(v); }
            for (long i = gtid; i < 2 * RP_SIZE; i += gsize) { const int ll = (int)(i / RP_SIZE), r = (int)(i % RP_SIZE); float v;
                if (r < RP_MUV) v = args.in[I_MU][ll * 1280 + r]; else if (r < RP_W0) v = args.in[I_MUV][r - RP_MUV]; else if (r < RP_A0) v = args.in[I_W0][ll * 384 + r - RP_W0];
                else if (r < RP_V0) v = args.in[I_A0][ll * 384 + r - RP_A0]; else if (r < RP_KK) v = args.in[I_V0][r - RP_V0]; else if (r < RP_KA) v = args.in[I_KK][ll * 384 + r - RP_KK];
                else if (r < RP_RK) v = args.in[I_KA][ll * 384 + r - RP_KA]; else if (r < RP_LNW) v = args.in[I_RK][ll * 384 + r - RP_RK]; else if (r < RP_LNB) v = args.in[I_LNW][ll * 384 + r - RP_LNW];
                else v = args.in[I_LNB][ll * 384 + r - RP_LNB];
                ((float*)(wsp + WS_SMALL + SM_RWP + ll * RWP_BYTES))[r] = v; }
            for (long i = gtid; i < 2 * 384 * 160; i += gsize) { const int ll = (int)(i / (384 * 160)), r2 = (int)(i % (384 * 160)), hc = r2 / 160, j = r2 % 160; bf16_t* sm = (bf16_t*)(wsp + WS_SMALL + ll * SM_LORA_L);
                if (j < 32) sm[SM_W2T / 2 + hc * 32 + j] = f2bf(args.in[I_W2][(size_t)ll * 32 * 384 + j * 384 + hc]);
                else if (j < 64) sm[SM_A2T / 2 + hc * 32 + (j - 32)] = f2bf(args.in[I_A2][(size_t)ll * 32 * 384 + (j - 32) * 384 + hc]);
                else if (j < 96) sm[SM_V2T / 2 + hc * 32 + (j - 64)] = f2bf((j - 64) < 16 ? args.in[I_V2][(j - 64) * 384 + hc] : 0.f);
                else sm[SM_G2T / 2 + hc * 64 + (j - 96)] = f2bf(args.in[I_G2][(size_t)ll * 64 * 384 + (j - 96) * 384 + hc]); }
            if (MTOK % (4 * NGW) == 0) { for (long m = gw; m < MTOK; m += 4L * NGW) rows_to_bf16<4>(args.in[I_X], XB, SSQ_A, m, NGW, lane); }
            else { for (int m = gw; m < MTOK; m += NGW) row_to_bf16(args.in[I_X] + (size_t)m * DM, XB + (size_t)m * DM, SSQ_A + m, lane); }
            for (int m = gw; m < 512; m += NGW) row_to_bf16(args.in[I_MEM] + (size_t)m * DM, MEMB + (size_t)m * DM, ssqm + m, lane);
            sk::d_biastab(args.in[I_RELB], biastab, gtid, gsize);
            }
        PH_END
        }
        PH_BEGIN
            REPEAT(1)
            { pg8::Gemm g{XB, Wt_in, MTOK, 2048, 1024}; pg8::StaticOrder S; S.init(MTOK, 2048, G, (int)blockIdx.x);
              pg8::EpiScaleBf16 E{PROJ, LDP, SSQ_A + (size_t)l * MTOK};
              pg8::gemm_phase<pg8::EpiScaleBf16, pg8::StaticOrder, true, true>(L, g, S, E, tid); }
        PH_END
        PH_BEGIN
            MK_W(); MK_CBUF(); (void)cbuf;
#if !FAST_ATTN
            sk::d_qknorm(PROJ, MTOK, LDP, args.in[I_AQN] + l * 64, args.in[I_AKN] + l * 64, args.in[I_MQN] + l * 64, 0, gtid, gsize);
            sk::d_qknorm(MKV, 512, 512, nullptr, nullptr, args.in[I_MKN] + l * 64, 1, gtid, gsize);
#endif
#if FAST_RWKV
            {
              const bool t8 = blockIdx.x < 64;
              const pg8::Gemm g = t8 ? pg8::Gemm{XB, Wt_in + (size_t)2048 * 1024, MTOK, 256, 1024} : pg8::Gemm{MEMB, Wt_mkv, 512, 512, 1024};
              pg8::StaticOrder S; if (t8) S.init(MTOK, 256, G, (int)blockIdx.x); else S.init(512, 512, G, (int)((blockIdx.x + 192) % G));
              const pg8::EpiScaleBf16 E = t8 ? pg8::EpiScaleBf16{PROJ + 2048, LDP, SSQ_A + (size_t)l * MTOK} : pg8::EpiScaleBf16{MKV, 512, ssqm};
              pg8::gemm_phase<pg8::EpiScaleBf16, pg8::StaticOrder, true, true>(L, g, S, E, tid); }
            { unsigned* qc = (unsigned*)(ctl + CW_CHQ + 64 * l);
              int q = rw::chunk_phase(L, wsp, l, tid, qc, MISC + 21);
              const int I_OUT = 16 * 32, I_UP = 16 * 176, I_DN = 44 * 32, NIT = I_OUT + I_UP + I_DN;
              for (;;) { const int it = (q - rw::NITEMS) * NWAVES + wave;
                  if ((q - rw::NITEMS) * NWAVES >= NIT) break;
                  if (it < NIT) { int r = it;
                      if (r < I_OUT) transpose_item<0>(args.in[I_WOUT] + (size_t)l * 1024 * 1024, nullptr, 1024, 1024, Wt_out, scr, r, lane);
                      else if (r < I_OUT + I_UP) transpose_item<1>(args.in[I_WUP] + (size_t)l * 1024 * 5632, args.in[I_FFNG] + l * 1024, 1024, 5632, Wt_up, scr, r - I_OUT, lane);
                      else transpose_item<0>(args.in[I_WDOWN] + (size_t)l * 2816 * 1024, nullptr, 2816, 1024, Wt_down, scr, r - I_OUT - I_UP, lane); }
                  __syncthreads(); if (tid == 0) MISC[21] = atomicAdd(qc, 1u); __syncthreads(); q = (int)MISC[21]; __syncthreads(); } }
#else
            sk::d_rwkv_prep(PROJ, W, l, VF, pR, pK, pV, pKK, pB, pLD, gtid, gsize);
#endif
        PH_END
        PH_BEGIN
            MK_CBUF(); (void)cbuf;
            if (blockIdx.x < 48) {
#if FAST_RWKV
                REPEAT(3) { __syncthreads(); if (tid < 8) MISC[16 + tid] = 0u; __syncthreads();
                  const int sbh = (int)blockIdx.x >> 2, stj = (int)blockIdx.x & 3;
                  if (wave == 0) rw::scan_compute(L, cbuf, sbh, stj, lane, MISC + 16); else if (wave < 4) rw::scan_loader(L, cbuf, sbh, stj, wave - 1, lane, MISC + 16);
 }
#endif
            } else {
#if FAST_ATTN
                const at::AttnArgs A{PROJ, MKV, MIX, biastab, args.in[I_SINK] + l * 6, args.in[I_AQN] + l * 64, args.in[I_AKN] + l * 64, args.in[I_MQN] + l * 64, args.in[I_MKN] + l * 64};
                at::attn_phase(L, A, (unsigned*)(ctl + CW_ATTQ + 64 * l), MISC + 20, tid);
#else
                const long gt2 = (long)(blockIdx.x - BATCH * 6) * (NWAVES * 64) + tid, gs2 = (long)(G - BATCH * 6) * (NWAVES * 64);
                REPEAT(7) sk::d_swa(PROJ, MIX, biastab, args.in[I_SINK] + l * 6, gt2, gs2);
                REPEAT(8) sk::d_memattn(PROJ, MKV, MIX, gt2, gs2);
#endif
            }
        PH_END
        PH_BEGIN
            MK_W(); MK_CBUF(); (void)cbuf;
#if FAST_RWKV
            REPEAT(4) rw::out_phase(L, wsp, l, tid, (int)blockIdx.x, G);
#else
            sk::d_rwkv_fin(PROJ, W, pR, pK, pV, MIX, gtid, gsize);
#endif
        PH_END
        PH_BEGIN
            if ((PROF_PH) == 31) { pg8::Gemm g2{MIX, Wt_out, MTOK, 1024, 1024}; pg8::StaticOrder S2; S2.init(MTOK, 1024, G, (int)blockIdx.x); pg8::EpiScaleBf16 E2{PROJ, 1024, SSQ_A}; pg8::gemm_phase<pg8::EpiScaleBf16, pg8::StaticOrder, true, true>(L, g2, S2, E2, tid); }
            pg8::Gemm g{MIX, Wt_out, MTOK, 1024, 1024}; pg8::StaticOrder S; S.init(MTOK, 1024, G, (int)blockIdx.x);
            pg8::EpiResid<false> E{out, XB, SSQ_B + (size_t)l * MTOK, 1024};
            pg8::gemm_phase<pg8::EpiResid<false>, pg8::StaticOrder, true, true>(L, g, S, E, tid);
        PH_END
        PH_BEGIN
            REPEAT(5) {
            pg8::Gemm g{XB, Wt_up, 66 * 256, 5632, 1024}; pg8::StaticOrder S; S.init(66 * 256, 5632, G, (int)blockIdx.x);
            pg8::EpiConvAct E{ACT, SSQ_B + (size_t)l * MTOK, args.in[I_CW] + (size_t)l * 3 * 5632, args.in[I_CB] + (size_t)l * 5632};
            pg8::gemm_phase<pg8::EpiConvAct, pg8::StaticOrder, true, true>(L, g, S, E, tid); }
        PH_END
        PH_BEGIN
            if ((PROF_PH) == 32) { pg8::Gemm g2{ACT, Wt_down, MTOK, 1024, 2816}; pg8::StaticOrder S2; S2.init(MTOK, 1024, G, (int)blockIdx.x); pg8::EpiScaleBf16 E2{PROJ, 1024, SSQ_A}; pg8::gemm_phase<pg8::EpiScaleBf16, pg8::StaticOrder, true, true>(L, g2, S2, E2, tid); }
            pg8::Gemm g{ACT, Wt_down, MTOK, 1024, 2816}; pg8::StaticOrder S; S.init(MTOK, 1024, G, (int)blockIdx.x);
            if (l == 0) { pg8::EpiResid<false> E{out, XB, SSQ_A + (size_t)(l + 1) * MTOK, 1024}; pg8::gemm_phase<pg8::EpiResid<false>, pg8::StaticOrder, true, true>(L, g, S, E, tid); }
            else { pg8::EpiResid<true> E{out, XB, nullptr, 1024}; pg8::gemm_phase<pg8::EpiResid<true>, pg8::StaticOrder, true, true>(L, g, S, E, tid); }
        PH_END
    }
    if ((PROF_TA) >= 0 && blockIdx.x == 0 && tid0 == 0) {
        MISC[24 + ph] = (unsigned)__builtin_amdgcn_s_memrealtime();
        const unsigned ta = MISC[24 + (PROF_TA) + 1] - MISC[24 + (PROF_TA)], tb = (PROF_TB) >= 0 ? MISC[24 + (PROF_TB) + 1] - MISC[24 + (PROF_TB)] : 0u;
        const unsigned long long extra = (unsigned long long)ta + 1000ull * (unsigned long long)(((tb + 50u) / 100u) * 100u);
        const unsigned long long t0 = __builtin_amdgcn_s_memrealtime(); while (__builtin_amdgcn_s_memrealtime() - t0 < extra) __builtin_amdgcn_s_sleep(32);
    }
#undef PH_BEGIN
#undef PH_END
}
constexpr int N_PHASES = 1 + 2 * 7;
}

#ifndef MK_PER_PHASE
#define MK_PER_PHASE 0
#endif
extern "C" void kernel_launch(void* const* d_in, const int* in_sizes, int n_in, void* d_out, int out_size, void* d_ws, size_t ws_size, hipStream_t stream) {
    static int grid = 0;
    if (grid == 0) {
        if (n_in != N_IN || out_size != MTOK * DM || ws_size < mk::WS_END) { fprintf(stderr, "kernel_launch: unexpected shapes (n_in %d out %d ws %zu)\n", n_in, out_size, ws_size); grid = -1; return; }
        int dev = 0, cus = 0, per_cu = 0;
        if (hipGetDevice(&dev) != hipSuccess || hipDeviceGetAttribute(&cus, hipDeviceAttributeMultiprocessorCount, dev) != hipSuccess) { grid = -1; return; }
        if (hipFuncSetAttribute((const void*)mk::mk_fwd, hipFuncAttributeMaxDynamicSharedMemorySize, mk::LDS_BYTES) != hipSuccess) { fprintf(stderr, "kernel_launch: hipFuncSetAttribute failed\n"); grid = -1; return; }
        if (hipOccupancyMaxActiveBlocksPerMultiprocessor(&per_cu, (const void*)mk::mk_fwd, NWAVES * 64, mk::LDS_BYTES) != hipSuccess || per_cu < 1) { fprintf(stderr, "kernel_launch: occupancy query says %d blocks per CU\n", per_cu); }
        (void)hipGetLastError();
        grid = cus;
    }
    if (grid < 0) return;
    if (hipMemsetAsync((char*)d_ws + mk::WS_CTL, 0, mk::CTL_ZERO_BYTES, stream) != hipSuccess) return;
    mk::Args a{};
    for (int i = 0; i < N_IN; ++i) a.in[i] = (const float*)d_in[i];
    a.out = (float*)d_out; a.ws = (unsigned char*)d_ws;
#if MK_PER_PHASE
    for (int p = 0; p < mk::N_PHASES; ++p) { a.ph_lo = p; a.ph_hi = p + 1; hipLaunchKernelGGL(mk::mk_fwd, dim3(grid), dim3(NWAVES * 64), mk::LDS_BYTES, stream, a); }
#else
    a.ph_lo = 0; a.ph_hi = mk::N_PHASES;
    hipLaunchKernelGGL(mk::mk_fwd, dim3(grid), dim3(NWAVES * 64), mk::LDS_BYTES, stream, a);
#endif
}
```

```cpp
#define MK_BUILD 1
#ifndef HOST_SIM
#include <hip/hip_runtime.h>
#include <cstdio>
#include <cstdint>
#endif
#ifndef SEQ_LEN
#define SEQ_LEN 8192
#endif
typedef unsigned short bf16_t;
constexpr int BATCH = 2, SEQ = SEQ_LEN, DM = 1024, MTOK = BATCH * SEQ, DFF = 2816, LDP = 2304  ;
constexpr float EPS = 1e-6f, GN_EPS = 64e-5f;
__host__ __device__ __forceinline__ float bf2f(bf16_t h) { unsigned u = (unsigned)h << 16; return __builtin_bit_cast(float, u); }
__host__ __device__ __forceinline__ bf16_t f2bf(float f) { unsigned u = __builtin_bit_cast(unsigned, f); return (bf16_t)((u + 0x7fffu + ((u >> 16) & 1u)) >> 16); }
__host__ __device__ __forceinline__ int t5_bucket(int dist) {
    if (dist < 16) return dist;
    const float v = logf((float)dist / 16.0f) / 2.0794415416798357f * 16.0f;
    int large = 16 + (int)v; return large < 31 ? large : 31;
}
constexpr size_t MiB = 1u << 20;
enum { I_X = 0, I_MEM, I_RELB, I_MIXG, I_WIN, I_WINV, I_AQN, I_AKN, I_SINK, I_MU, I_MUV, I_W0, I_W2, I_A0, I_A2, I_V0, I_V2, I_G2, I_KK, I_KA, I_RK, I_LNW, I_LNB, I_MEMG, I_WMKV, I_MQN, I_MKN, I_WOUT, I_FFNG, I_WUP, I_CW, I_CB, I_WDOWN, N_IN };
#ifndef PROF_PH
#define PROF_PH -1
#endif
#ifndef PROF_N
#define PROF_N 1
#endif
namespace sk {

__device__ __forceinline__ void d_wt(const float* W, const float* g, bf16_t* Wt, int K, int N, int Npad, long gtid, long gsize) {
    const long total = (long)Npad * K;
    for (long idx = gtid; idx < total; idx += gsize) {
        const int n = (int)(idx / K), k = (int)(idx % K);
        float v = 0.f;
        if (n < N) { v = W[(long)k * N + n]; if (g) v *= g[k]; }
        Wt[idx] = f2bf(v);
    }
}
#ifndef MK_BUILD
__global__ void k_wt(const float* W, const float* g, bf16_t* Wt, int K, int N, int Npad) { d_wt(W, g, Wt, K, N, Npad, (long)blockIdx.x * blockDim.x + threadIdx.x, (long)gridDim.x * blockDim.x); }
#endif
__device__ __forceinline__ void d_rowprep(const float* x, bf16_t* xb, float* ssq, int rows, long gtid, long gsize) {
    for (long r = gtid; r < rows; r += gsize) {
        const float* xr = x + (long)r * DM; bf16_t* o = xb + (long)r * DM; float s = 0.f;
        for (int c = 0; c < DM; ++c) { const float v = xr[c]; s += v * v; o[c] = f2bf(v); }
        ssq[r] = s;
    }
}
#ifndef MK_BUILD
__global__ void k_rowprep(const float* x, bf16_t* xb, float* ssq, int rows) { d_rowprep(x, xb, ssq, rows, (long)blockIdx.x * blockDim.x + threadIdx.x, (long)gridDim.x * blockDim.x); }
#endif
__device__ __forceinline__ void d_biastab(const float* rel_bias, float* tab, long gtid, long gsize) {
        for (long i = gtid; i < 128 * 6; i += gsize) { const int dist = i / 6, hq = i % 6; tab[i] = rel_bias[t5_bucket(dist) * 6 + hq]; }
}
#ifndef MK_BUILD
__global__ void k_biastab(const float* rel_bias, float* tab) { d_biastab(rel_bias, tab, (long)blockIdx.x * blockDim.x + threadIdx.x, (long)gridDim.x * blockDim.x); }
#endif
__device__ __forceinline__ void d_qknorm(bf16_t* P, int rows, int ld, const float* gq, const float* gk, const float* gm, int mode, long gtid, long gsize) {
    const int nj = mode == 0 ? 12 : 4;
    const long total = (long)rows * nj;
    for (long idx = gtid; idx < total; idx += gsize) {
        const int row = (int)(idx / nj), j = (int)(idx % nj);
        int col; const float* g;
        if (mode == 0) { if (j < 6) { col = 64 * j; g = gq; } else if (j < 8) { col = 384 + 64 * (j - 6); g = gk; } else { col = 1920 + 64 * (j - 8); g = gm; } }
        else { col = 64 * j; g = gm; }
        bf16_t* p = P + (long)row * ld + col; float s = 0.f;
        for (int d = 0; d < 64; ++d) { const float v = bf2f(p[d]); s += v * v; }
        const float rs = 1.0f / sqrtf(s * (1.0f / 64.0f) + EPS);
        for (int d = 0; d < 64; ++d) p[d] = f2bf(bf2f(p[d]) * rs * g[d]);
    }
}
#ifndef MK_BUILD
__global__ void k_qknorm(bf16_t* P, int rows, int ld, const float* gq, const float* gk, const float* gm, int mode) { d_qknorm(P, rows, ld, gq, gk, gm, mode, (long)blockIdx.x * blockDim.x + threadIdx.x, (long)gridDim.x * blockDim.x); }
#endif
__device__ __forceinline__ void d_swa(const bf16_t* P, bf16_t* MIX, const float* biastab, const float* sinks, long gtid, long gsize) {
    const long total = (long)MTOK * 6;
    for (long idx = gtid; idx < total; idx += gsize) {
        const int tok = (int)(idx / 6), hq = (int)(idx % 6), hkv = hq / 3, t = tok % SEQ;
        float q[64], o[64];
#pragma unroll
        for (int d = 0; d < 64; ++d) { q[d] = bf2f(P[(long)tok * LDP + 64 * hq + d]) * 0.125f; o[d] = 0.f; }
        float m = sinks[hq], l = 1.0f;
        const int j0 = t - 127 < 0 ? 0 : t - 127;
        for (int j = j0; j <= t; ++j) {
            const bf16_t* kr = P + (long)(tok - (t - j)) * LDP + 384 + 64 * hkv; const bf16_t* vr = kr + 128;
            float s = 0.f;
#pragma unroll
            for (int d = 0; d < 64; ++d) s += q[d] * bf2f(kr[d]);
            s += biastab[(t - j) * 6 + hq];
            const float mn = fmaxf(m, s), f = expf(m - mn), e = expf(s - mn);
            l = l * f + e; m = mn;
#pragma unroll
            for (int d = 0; d < 64; ++d) o[d] = o[d] * f + e * bf2f(vr[d]);
        }
        const float inv = 1.0f / l;
#pragma unroll
        for (int d = 0; d < 64; ++d) MIX[(long)tok * DM + 64 * hq + d] = f2bf(o[d] * inv);
    }
}
#ifndef MK_BUILD
__global__ __launch_bounds__(256) void k_swa(const bf16_t* P, bf16_t* MIX, const float* biastab, const float* sinks) { d_swa(P, MIX, biastab, sinks, (long)blockIdx.x * blockDim.x + threadIdx.x, (long)gridDim.x * blockDim.x); }
#endif
__device__ __forceinline__ void d_memattn(const bf16_t* P, const bf16_t* MKV, bf16_t* MIX, long gtid, long gsize) {
    const long total = (long)MTOK * 4;
    for (long idx = gtid; idx < total; idx += gsize) {
        const int tok = (int)(idx / 4), h = (int)(idx % 4), b = tok / SEQ;
        float q[64], o[64];
#pragma unroll
        for (int d = 0; d < 64; ++d) { q[d] = bf2f(P[(long)tok * LDP + 1920 + 64 * h + d]) * 0.125f; o[d] = 0.f; }
        float m = -1e30f, l = 0.f;
        for (int j = 0; j < 256; ++j) {
            const bf16_t* kr = MKV + (long)(b * 256 + j) * 512 + 64 * h; const bf16_t* vr = kr + 256;
            float s = 0.f;
#pragma unroll
            for (int d = 0; d < 64; ++d) s += q[d] * bf2f(kr[d]);
            const float mn = fmaxf(m, s), f = expf(m - mn), e = expf(s - mn);
            l = l * f + e; m = mn;
#pragma unroll
            for (int d = 0; d < 64; ++d) o[d] = o[d] * f + e * bf2f(vr[d]);
        }
        const float inv = 1.0f / l;
#pragma unroll
        for (int d = 0; d < 64; ++d) MIX[(long)tok * DM + 768 + 64 * h + d] = f2bf(o[d] * inv);
    }
}
#ifndef MK_BUILD
__global__ __launch_bounds__(256) void k_memattn(const bf16_t* P, const bf16_t* MKV, bf16_t* MIX) { d_memattn(P, MKV, MIX, (long)blockIdx.x * blockDim.x + threadIdx.x, (long)gridDim.x * blockDim.x); }
#endif
__device__ __forceinline__ float shifted(const bf16_t* P, int tok, int col, float mu) {
    const float p = bf2f(P[(long)tok * LDP + col]);
    const float prev = (tok % SEQ) == 0 ? 0.f : bf2f(P[(long)(tok - 1) * LDP + col]);
    return p + mu * (prev - p);
}
struct RwkvW { const float *mu, *mu_v, *w0, *w2, *a0, *a2, *v0, *v2, *g2, *k_k, *k_a, *r_k, *ln_w, *ln_b; };
__device__ __forceinline__ void d_rwkv_prep(const bf16_t* P, RwkvW W, int layer, bf16_t* VFIRST, bf16_t* R, bf16_t* K, bf16_t* V, bf16_t* KK, bf16_t* B, bf16_t* LOGD, long gtid, long gsize) {
    const long total = (long)MTOK * 6;
    for (long idx = gtid; idx < total; idx += gsize) {
        const int tok = (int)(idx / 6), h = (int)(idx % 6);
        float nrm = 0.f;
        for (int c = 0; c < 64; ++c) { const int hc = 64 * h + c; const float kc = shifted(P, tok, 640 + 384 + hc, W.mu[384 + hc]) * W.k_k[hc]; nrm += kc * kc; }
        const float rn = 1.0f / fmaxf(sqrtf(nrm), 1e-12f);
        for (int c = 0; c < 64; ++c) {
            const int hc = 64 * h + c; const long o = (long)tok * 384 + hc;
            const float r = shifted(P, tok, 640 + hc, W.mu[hc]);
            const float k = shifted(P, tok, 640 + 384 + hc, W.mu[384 + hc]);
            float v = shifted(P, tok, 640 + 768 + hc, W.mu[768 + hc]);
            float wp = W.w0[hc], ap = W.a0[hc];
            for (int j = 0; j < 32; ++j) {
                wp += tanhf(shifted(P, tok, 640 + 1152 + j, W.mu[1152 + j])) * W.w2[j * 384 + hc];
                ap += shifted(P, tok, 640 + 1184 + j, W.mu[1184 + j]) * W.a2[j * 384 + hc];
            }
            const float z = -wp; const float sp = fmaxf(z, 0.f) + log1pf(expf(-fabsf(z)));
            const float w = -sp - 0.5f;
            const float a = 1.0f / (1.0f + expf(-ap));
            if (layer > 0) {
                float vp = W.v0[hc];
                for (int j = 0; j < 16; ++j) vp += shifted(P, tok, 2176 + j, W.mu_v[j]) * W.v2[j * 384 + hc];
                const float vf = bf2f(VFIRST[o]);
                v = v + (vf - v) * (1.0f / (1.0f + expf(-vp)));
            } else VFIRST[o] = f2bf(v);
            const float kk = k * W.k_k[hc] * rn;
            R[o] = f2bf(r); K[o] = f2bf(k * (1.0f + (a - 1.0f) * W.k_a[hc])); V[o] = f2bf(v);
            KK[o] = f2bf(kk); B[o] = f2bf(kk * a); LOGD[o] = f2bf(-expf(w));
        }
    }
}
#ifndef MK_BUILD
__global__ void k_rwkv_prep(const bf16_t* P, RwkvW W, int layer, bf16_t* VFIRST, bf16_t* R, bf16_t* K, bf16_t* V, bf16_t* KK, bf16_t* B, bf16_t* LOGD) { d_rwkv_prep(P, W, layer, VFIRST, R, K, V, KK, B, LOGD, (long)blockIdx.x * blockDim.x + threadIdx.x, (long)gridDim.x * blockDim.x); }
#endif
__device__ __forceinline__ void d_rwkv_scan(const bf16_t* R, const bf16_t* K, const bf16_t* V, const bf16_t* KK, const bf16_t* B, const bf16_t* LOGD, bf16_t* MIX, int bh, int i) {
    const int b = bh / 6, h = bh % 6;
    float s[64];
#pragma unroll
    for (int k = 0; k < 64; ++k) s[k] = 0.f;
    for (int t = 0; t < SEQ; ++t) {
        const long o = (long)(b * SEQ + t) * 384 + 64 * h;
        float sa = 0.f;
#pragma unroll
        for (int k = 0; k < 64; ++k) sa -= s[k] * bf2f(KK[o + k]);
        const float v = bf2f(V[o + i]); float y = 0.f;
#pragma unroll
        for (int k = 0; k < 64; ++k) { s[k] = s[k] * expf(bf2f(LOGD[o + k])) + sa * bf2f(B[o + k]) + v * bf2f(K[o + k]); y += s[k] * bf2f(R[o + k]); }
        MIX[(long)(b * SEQ + t) * DM + 384 + 64 * h + i] = f2bf(y);
    }
}
#ifndef MK_BUILD
__global__ void k_rwkv_scan(const bf16_t* R, const bf16_t* K, const bf16_t* V, const bf16_t* KK, const bf16_t* B, const bf16_t* LOGD, bf16_t* MIX) { d_rwkv_scan(R, K, V, KK, B, LOGD, MIX, blockIdx.x, threadIdx.x); }
#endif
__device__ __forceinline__ void d_rwkv_fin(const bf16_t* P, RwkvW W, const bf16_t* R, const bf16_t* K, const bf16_t* V, bf16_t* MIX, long gtid, long gsize) {
    const long total = (long)MTOK * 6;
    for (long idx = gtid; idx < total; idx += gsize) {
        const int tok = (int)(idx / 6), h = (int)(idx % 6);
        bf16_t* y = MIX + (long)tok * DM + 384 + 64 * h; const long o = (long)tok * 384 + 64 * h;
        float mean = 0.f, dot = 0.f;
        for (int c = 0; c < 64; ++c) { mean += bf2f(y[c]); dot += bf2f(R[o + c]) * bf2f(K[o + c]) * W.r_k[64 * h + c]; }
        mean *= (1.0f / 64.0f); float var = 0.f;
        for (int c = 0; c < 64; ++c) { const float d = bf2f(y[c]) - mean; var += d * d; }
        const float rstd = 1.0f / sqrtf(var * (1.0f / 64.0f) + GN_EPS);
        for (int c = 0; c < 64; ++c) {
            const int hc = 64 * h + c; float g = 0.f;
            for (int j = 0; j < 64; ++j) g += (1.0f / (1.0f + expf(-shifted(P, tok, 640 + 1216 + j, W.mu[1216 + j])))) * W.g2[j * 384 + hc];
            const float yn = (bf2f(y[c]) - mean) * rstd * W.ln_w[hc] + W.ln_b[hc];
            y[c] = f2bf((yn + dot * bf2f(V[o + c])) * g);
        }
    }
}
#ifndef MK_BUILD
__global__ void k_rwkv_fin(const bf16_t* P, RwkvW W, const bf16_t* R, const bf16_t* K, const bf16_t* V, bf16_t* MIX) { d_rwkv_fin(P, W, R, K, V, MIX, (long)blockIdx.x * blockDim.x + threadIdx.x, (long)gridDim.x * blockDim.x); }
#endif
__device__ __forceinline__ void d_conv_act(const bf16_t* U, const float* cw, const float* cb, bf16_t* ACT, int rows, long gtid, long gsize) {
    const long total = (long)rows * DFF;
    for (long idx = gtid; idx < total; idx += gsize) {
        const int t = (int)(idx / DFF), c = (int)(idx % DFF);
        float gate = cb[c], val = cb[DFF + c];
#pragma unroll
        for (int i = 0; i < 3; ++i) { const int tt = t - 2 + i; if (tt >= 0) { gate += cw[i * 2 * DFF + c] * bf2f(U[(long)tt * 2 * DFF + c]); val += cw[i * 2 * DFF + DFF + c] * bf2f(U[(long)tt * 2 * DFF + DFF + c]); } }
        ACT[(long)t * DFF + c] = f2bf(gate / (1.0f + expf(-gate)) * val);
    }
}
#ifndef MK_BUILD
__global__ void k_conv_act(const bf16_t* U, const float* cw, const float* cb, bf16_t* ACT, int rows) { d_conv_act(U, cw, cb, ACT, rows, (long)blockIdx.x * blockDim.x + threadIdx.x, (long)gridDim.x * blockDim.x); }
#endif
}
namespace pg8 {
#define PG8_LAS __attribute__((address_space(3)))
typedef unsigned short bf16_t;
typedef short bf16x8 __attribute__((ext_vector_type(8)));
typedef float f32x4 __attribute__((ext_vector_type(4)));
typedef unsigned u32x4 __attribute__((ext_vector_type(4)));
constexpr int BM = 256, BK = 64, HALF = 128, HTB = HALF * BK * 2  , STAGE_BYTES = 8 * HTB, NXCD = 8, WGM = 8;

__host__ __device__ __forceinline__ int lds_byte(int r, int c) { const int st = (r >> 4) * 2 + (c >> 5), rr = r & 15, cc = c & 31, ob = rr * 64 + cc * 2; return st * 1024 + (ob ^ (((ob >> 9) & 1) << 5)); }
__host__ __device__ __forceinline__ void stage_rc(int b, int& R, int& C) { const int st = b / 1024, sb = b % 1024, swz = sb ^ (((sb >> 9) & 1) << 5); R = (st >> 1) * 16 + swz / 64; C = (st & 1) * 32 + (swz % 64) / 2; }
__host__ __device__ __forceinline__ int perm32(int rho) { const int n = rho >> 4, i = rho & 15; return 8 * (i >> 2) + 4 * n + (i & 3); }

struct Unit { int pm, pn; };
struct Gemm { const bf16_t* A; const bf16_t* Bt; int M, N, K; };

struct StaticOrder {
    int nM, nN, nwg, G, c;
    __host__ __device__ void init(int M, int N, int G_, int c_) { nM = M / BM; nN = N / BM; nwg = nM * nN; G = G_; c = c_; }
    __host__ __device__ bool next(int i, Unit& u) const {
        const long L = (long)i * G + c; if (L >= nwg) return false;
        int wgid = (int)L; { const int q = nwg / NXCD, r = nwg % NXCD, xcd = wgid % NXCD, off = wgid / NXCD; wgid = (xcd < r ? xcd * (q + 1) : r * (q + 1) + (xcd - r) * q) + off; }
        const int nig = WGM * nN, gid = wgid / nig, fm = gid * WGM, gsz = (nM - fm) < WGM ? (nM - fm) : WGM;
        u.pm = fm + ((wgid % nig) % gsz); u.pn = (wgid % nig) / gsz; return true;
    }
    __device__ __forceinline__ void a_ready(const Unit&) const {}
    __device__ __forceinline__ void done(const Unit&) const {}
};

__device__ __forceinline__ unsigned cvt_pk_bf16(float lo, float hi) { unsigned r; asm volatile("v_cvt_pk_bf16_f32 %0, %1, %2" : "=v"(r) : "v"(lo), "v"(hi)); return r; }
struct EpiScaleBf16 {
    static constexpr bool PERM = true, AFTER_DRAIN = false; static constexpr int AMAP = 0;
    bf16_t* O; int ldc; const float* ssq;
    __device__ __forceinline__ void operator()(const f32x4 (&acc)[2][2][4][2], const Unit& u, int wr, int wc, int fr, int fq) const {
        const int row0 = u.pm * BM + wr * 64 + fr, col0 = u.pn * BM + wc * 32 + 8 * fq;
#pragma unroll
        for (int ai = 0; ai < 2; ++ai)
#pragma unroll
            for (int m = 0; m < 4; ++m) { const int row = row0 + ai * HALF + m * 16; const float sc = __builtin_amdgcn_rsqf(ssq[row] * (1.0f / 1024.0f) + 1e-6f);
                bf16_t* rowp = O + (size_t)row * ldc + col0;
#pragma unroll
                for (int bj = 0; bj < 2; ++bj) { const f32x4 v0 = acc[ai][bj][m][0] * sc, v1 = acc[ai][bj][m][1] * sc;
                    u32x4 w; w.x = cvt_pk_bf16(v0[0], v0[1]); w.y = cvt_pk_bf16(v0[2], v0[3]); w.z = cvt_pk_bf16(v1[0], v1[1]); w.w = cvt_pk_bf16(v1[2], v1[3]);
                    *(u32x4*)(rowp + bj * HALF) = w; } }
    }
};
template <bool FINAL> struct EpiResid {
    static constexpr bool PERM = false, AFTER_DRAIN = false; static constexpr int AMAP = 0;
    float* out; bf16_t* xb; float* ssq; int ldc;
    __device__ __forceinline__ void operator()(const f32x4 (&acc)[2][2][4][2], const Unit& u, int wr, int wc, int fr, int fq) const {
        typedef unsigned u32x2v __attribute__((ext_vector_type(2)));
        const int col0 = u.pn * BM + wc * 32 + 4 * fq;
#pragma unroll
        for (int ai = 0; ai < 2; ++ai) {
            u32x2v bs[4][2][2];
#pragma unroll
            for (int m = 0; m < 4; ++m) { const size_t off = (size_t)(u.pm * BM + ai * HALF + wr * 64 + m * 16 + fr) * ldc + col0;
#pragma unroll
                for (int bj = 0; bj < 2; ++bj)
#pragma unroll
                    for (int n = 0; n < 2; ++n) bs[m][bj][n] = *(const u32x2v*)(xb + off + bj * HALF + n * 16); }
#pragma unroll
            for (int m = 0; m < 4; ++m) { const int row = u.pm * BM + ai * HALF + wr * 64 + m * 16 + fr; const size_t off = (size_t)row * ldc + col0; float sq = 0.f;
#pragma unroll
                for (int bj = 0; bj < 2; ++bj)
#pragma unroll
                    for (int n = 0; n < 2; ++n) { const u32x2v b2 = bs[m][bj][n];
                        f32x4 o = {__builtin_bit_cast(float, b2.x << 16), __builtin_bit_cast(float, b2.x & 0xffff0000u), __builtin_bit_cast(float, b2.y << 16), __builtin_bit_cast(float, b2.y & 0xffff0000u)};
                        o = o + acc[ai][bj][m][n];
                        if (FINAL) *(f32x4*)(out + off + bj * HALF + n * 16) = o;
                        else { u32x2v w; w.x = cvt_pk_bf16(o[0], o[1]); w.y = cvt_pk_bf16(o[2], o[3]); *(u32x2v*)(xb + off + bj * HALF + n * 16) = w;
                            const float r0 = __builtin_bit_cast(float, w.x << 16), r1 = __builtin_bit_cast(float, w.x & 0xffff0000u), r2 = __builtin_bit_cast(float, w.y << 16), r3 = __builtin_bit_cast(float, w.y & 0xffff0000u);
                            sq += (r0 * r0 + r1 * r1) + (r2 * r2 + r3 * r3); } }
                if (!FINAL) { sq += __shfl_xor(sq, 16); sq += __shfl_xor(sq, 32); if (fq == 0) atomicAdd(ssq + row, sq); } } }
    }
};
struct EpiConvAct {
    static constexpr bool PERM = true, AFTER_DRAIN = false; static constexpr int AMAP = 1;
    bf16_t* ACT; const float* ssq; const float* cw; const float* cb;
    static __device__ __forceinline__ float shr1s(float x) { float r; asm volatile("s_nop 1\n\tv_mov_b32_dpp %0, %1 row_shr:1 row_mask:0xf bank_mask:0xf bound_ctrl:1" : "=v"(r) : "v"(x)); return r; }
    static __device__ __forceinline__ f32x4 shr1(f32x4 v) { f32x4 r; r[0] = shr1s(v[0]); r[1] = shr1s(v[1]); r[2] = shr1s(v[2]); r[3] = shr1s(v[3]); return r; }
    __device__ __forceinline__ void operator()(const f32x4 (&acc)[2][2][4][2], const Unit& u, int wr, int wc, int fr, int fq) const {
        const int b = u.pm / 33, pmb = u.pm % 33;
        const int pos0 = 252 * pmb + 126 * wr + 8 * fr - 2;
        const long row0 = (long)b * SEQ + pos0;
        float rs[8];
#pragma unroll
        for (int j = 0; j < 8; ++j) { const int pos = pos0 + j; const bool ok = pos >= 0 && pos < SEQ; const float q = ssq[ok ? row0 + j : 0]; rs[j] = ok ? __builtin_amdgcn_rsqf(q * (1.0f / 1024.0f) + 1e-6f) : 0.f; }
        const int ch0 = 128 * u.pn + 32 * wc + 8 * fq;
        unsigned ow[8][4];
#pragma unroll
        for (int n = 0; n < 2; ++n) { const int c = ch0 + 4 * n;
            const f32x4 w0g = *(const f32x4*)(cw + c), w1g = *(const f32x4*)(cw + 5632 + c), w2g = *(const f32x4*)(cw + 2 * 5632 + c), bg = *(const f32x4*)(cb + c);
            const f32x4 w0v = *(const f32x4*)(cw + 2816 + c), w1v = *(const f32x4*)(cw + 5632 + 2816 + c), w2v = *(const f32x4*)(cw + 2 * 5632 + 2816 + c), bv = *(const f32x4*)(cb + 2816 + c);
            f32x4 gm2 = shr1(acc[1][0][2][n] * rs[6]), gm1 = shr1(acc[1][0][3][n] * rs[7]), vm2 = shr1(acc[1][1][2][n] * rs[6]), vm1 = shr1(acc[1][1][3][n] * rs[7]);
#pragma unroll
            for (int j = 0; j < 8; ++j) { const f32x4 gj = acc[j >> 2][0][j & 3][n] * rs[j], vj = acc[j >> 2][1][j & 3][n] * rs[j];
                const f32x4 ug = bg + w0g * gm2 + w1g * gm1 + w2g * gj, uv = bv + w0v * vm2 + w1v * vm1 + w2v * vj; f32x4 a;
#pragma unroll
                for (int e = 0; e < 4; ++e) a[e] = ug[e] * __builtin_amdgcn_rcpf(1.0f + __expf(-ug[e])) * uv[e];
                ow[j][2 * n] = cvt_pk_bf16(a[0], a[1]); ow[j][2 * n + 1] = cvt_pk_bf16(a[2], a[3]);
                gm2 = gm1; gm1 = gj; vm2 = vm1; vm1 = vj; } }
#pragma unroll
        for (int j = 0; j < 8; ++j) if (8 * fr + j >= 2 && pos0 + j < SEQ) { u32x4 w; w.x = ow[j][0]; w.y = ow[j][1]; w.z = ow[j][2]; w.w = ow[j][3]; *(u32x4*)(ACT + (size_t)(row0 + j) * 2816 + ch0) = w; }
    }
};
template <class Epi, class Sched, bool ALIGN_EPI = false, bool SP2 = false>
__device__ __forceinline__ void gemm_phase(PG8_LAS unsigned char* lds, const Gemm g, const Sched& S, const Epi& E, int tid_in) {
    int tid = tid_in; asm volatile("" : "+v"(tid));
    const int wid = __builtin_amdgcn_readfirstlane(tid >> 6), lane = tid & 63, wr = wid >> 2, wc = wid & 3, fr = lane & 15, fq = lane >> 4;
    const int K = g.K, nt = K / BK;
    unsigned voffA[2], voffB[2];
#pragma unroll
    for (int i = 0; i < 2; ++i) { int R, C; stage_rc(tid * 16 + i * 8192, R, C); const int Rb = Epi::PERM ? ((R & ~31) + perm32(R & 31)) : R;
        const int Ra = Epi::AMAP ? (126 * (R >> 6) + 8 * (R & 15) + ((R >> 4) & 3)) : R;
        voffA[i] = (unsigned)(Ra * K + C) * 2u; voffB[i] = (unsigned)(Rb * K + C) * 2u; }
    const size_t kstep = (size_t)(BK * 2);
    const size_t hstepB = (size_t)HALF * K * 2;
    const size_t hstepA = Epi::AMAP ? (size_t)4 * K * 2 : hstepB;
    const size_t tstep = 2 * hstepB;
#define PG8_ABASE(pm_) (Epi::AMAP ? (long)((long)((pm_) / 33) * SEQ + 252 * ((pm_) % 33) - 2) * (long)K * 2 : (long)(pm_) * (long)tstep)
    const unsigned ldsw = (unsigned)wid * 1024u;
    const int aoff = lds_byte(wr * 64 + fr, fq * 8), boff = lds_byte(wc * 32 + fr, fq * 8);
#define PG8_SA(b, h) (((b) * 2 + (h)) * HTB)
#define PG8_SB(b, h) ((4 + (b) * 2 + (h)) * HTB)
#define PG8_STAGE(bufoff, gbase, voff) do { _Pragma("unroll") for (int _i = 0; _i < 2; ++_i) \
        __builtin_amdgcn_global_load_lds((const unsigned*)((const char*)(gbase) + (voff)[_i]), (PG8_LAS unsigned*)(lds + (bufoff) + ldsw + _i * 8192), 16, 0, 0); } while (0)
#define PG8_LDA(dst, b, h) do { _Pragma("unroll") for (int m = 0; m < 4; ++m) _Pragma("unroll") for (int k = 0; k < 2; ++k) dst[m][k] = *(const PG8_LAS bf16x8*)(lds + PG8_SA(b, h) + aoff + m * 2048 + k * 1024); } while (0)
#define PG8_LDB(dst, b, h) do { _Pragma("unroll") for (int n = 0; n < 2; ++n) _Pragma("unroll") for (int k = 0; k < 2; ++k) dst[n][k] = *(const PG8_LAS bf16x8*)(lds + PG8_SB(b, h) + boff + n * 2048 + k * 1024); } while (0)
#define PG8_MMA(ai, bj, At, Bt) do { __builtin_amdgcn_s_setprio(1); _Pragma("unroll") for (int m = 0; m < 4; ++m) _Pragma("unroll") for (int n = 0; n < 2; ++n) _Pragma("unroll") for (int k = 0; k < 2; ++k) \
        acc[ai][bj][m][n] = __builtin_amdgcn_mfma_f32_16x16x32_bf16(Bt[n][k], At[m][k], acc[ai][bj][m][n], 0, 0, 0); __builtin_amdgcn_s_setprio(0); } while (0)
#define PG8_WAIT_V(n) asm volatile("s_waitcnt vmcnt(" #n ")" ::: "memory")
#define PG8_WAIT_L(n) asm volatile("s_waitcnt lgkmcnt(" #n ")" ::: "memory")
#define PG8_BAR __builtin_amdgcn_s_barrier()
#define PG8_SCHED __builtin_amdgcn_sched_barrier(0)
    Unit cur, nxt; int ui = 0;
    if (!S.next(0, cur)) return;
    f32x4 acc[2][2][4][2];
#pragma unroll
    for (int a = 0; a < 2; ++a)
#pragma unroll
        for (int b = 0; b < 2; ++b)
#pragma unroll
            for (int m = 0; m < 4; ++m)
#pragma unroll
                for (int n = 0; n < 2; ++n) acc[a][b][m][n] = (f32x4){0.f, 0.f, 0.f, 0.f};
    bf16x8 At[4][2], B0[2][2], B1[2][2];
    const char* cA = (const char*)g.A + PG8_ABASE(cur.pm); const char* cB = (const char*)g.Bt + (size_t)cur.pn * tstep;
    S.a_ready(cur);
    if constexpr (SP2) {
        PG8_STAGE(PG8_SB(0, 0), cB, voffB); PG8_STAGE(PG8_SB(0, 1), cB + hstepB, voffB); PG8_STAGE(PG8_SA(0, 0), cA, voffA); PG8_STAGE(PG8_SA(0, 1), cA + hstepA, voffA);
        if (wr == 1) PG8_BAR;
        PG8_WAIT_V(2); PG8_BAR;
        PG8_STAGE(PG8_SB(1, 0), cB + kstep, voffB); PG8_STAGE(PG8_SA(1, 0), cA + kstep, voffA); PG8_STAGE(PG8_SB(1, 1), cB + hstepB + kstep, voffB);
        PG8_WAIT_V(6); PG8_BAR;
    } else {
        PG8_STAGE(PG8_SB(0, 0), cB, voffB); PG8_STAGE(PG8_SA(0, 0), cA, voffA); PG8_STAGE(PG8_SB(0, 1), cB + hstepB, voffB); PG8_STAGE(PG8_SA(0, 1), cA + hstepA, voffA);
        if (wr == 1) PG8_BAR;
        PG8_WAIT_V(4); PG8_BAR;
        PG8_STAGE(PG8_SB(1, 0), cB + kstep, voffB); PG8_STAGE(PG8_SA(1, 0), cA + kstep, voffA); PG8_STAGE(PG8_SB(1, 1), cB + hstepB + kstep, voffB);
        PG8_WAIT_V(6); PG8_BAR;
    }
    for (;;) {
        const bool has_next = S.next(ui + 1, nxt);
        const char* nA = has_next ? (const char*)g.A + PG8_ABASE(nxt.pm) : cA; const char* nB = has_next ? (const char*)g.Bt + (size_t)nxt.pn * tstep : cB;
        for (int t = 0; t < nt; t += 2) {
            const bool last = (t == nt - 2);
            const char* a1 = cA + (size_t)(t + 1) * kstep;
            const char* a2 = last ? nA : cA + (size_t)(t + 2) * kstep; const char* b2 = last ? nB : cB + (size_t)(t + 2) * kstep;
            const char* a3 = a2 + kstep; const char* b3 = b2 + kstep;
            if (last && has_next) S.a_ready(nxt);
            if constexpr (SP2) {
            PG8_LDB(B0, 0, 0); PG8_LDB(B1, 0, 1); PG8_SCHED; PG8_LDA(At, 0, 0); PG8_STAGE(PG8_SA(1, 1), a1 + hstepA, voffA);
            PG8_WAIT_V(8); PG8_WAIT_L(0); PG8_BAR; PG8_MMA(0, 0, At, B0); PG8_MMA(0, 1, At, B1); PG8_BAR; PG8_SCHED;
            PG8_LDA(At, 0, 1); PG8_STAGE(PG8_SB(0, 0), b2, voffB); PG8_STAGE(PG8_SB(0, 1), b2 + hstepB, voffB); PG8_STAGE(PG8_SA(0, 0), a2, voffA);
            PG8_WAIT_V(8); PG8_WAIT_L(0); PG8_BAR; PG8_MMA(1, 0, At, B0); PG8_MMA(1, 1, At, B1); PG8_BAR; PG8_SCHED;
            PG8_LDB(B0, 1, 0); PG8_LDB(B1, 1, 1); PG8_SCHED; PG8_LDA(At, 1, 0); PG8_STAGE(PG8_SA(0, 1), a2 + hstepA, voffA);
            PG8_WAIT_V(8); PG8_WAIT_L(0); PG8_BAR; PG8_MMA(0, 0, At, B0); PG8_MMA(0, 1, At, B1); PG8_BAR; PG8_SCHED;
            PG8_LDA(At, 1, 1); PG8_STAGE(PG8_SB(1, 0), b3, voffB); PG8_STAGE(PG8_SB(1, 1), b3 + hstepB, voffB); PG8_STAGE(PG8_SA(1, 0), a3, voffA);
            PG8_WAIT_V(8); PG8_WAIT_L(0); PG8_BAR; PG8_MMA(1, 0, At, B0); PG8_MMA(1, 1, At, B1); PG8_BAR; PG8_SCHED;
            } else {
            PG8_LDB(B0, 0, 0); PG8_SCHED; PG8_LDA(At, 0, 0); PG8_STAGE(PG8_SA(1, 1), a1 + hstepA, voffA);
            PG8_WAIT_L(8); PG8_BAR; PG8_WAIT_L(0); PG8_MMA(0, 0, At, B0); PG8_BAR; PG8_SCHED;
            PG8_LDB(B1, 0, 1); PG8_STAGE(PG8_SB(0, 0), b2, voffB);
            PG8_BAR; PG8_WAIT_L(0); PG8_MMA(0, 1, At, B1); PG8_BAR;
            PG8_LDA(At, 0, 1); PG8_STAGE(PG8_SA(0, 0), a2, voffA);
            PG8_BAR; PG8_WAIT_L(0); PG8_MMA(1, 0, At, B0); PG8_BAR; PG8_SCHED;
            PG8_STAGE(PG8_SB(0, 1), b2 + hstepB, voffB);
            PG8_WAIT_V(6); PG8_BAR; PG8_MMA(1, 1, At, B1); PG8_BAR;
            PG8_LDB(B0, 1, 0); PG8_SCHED; PG8_LDA(At, 1, 0); PG8_STAGE(PG8_SA(0, 1), a2 + hstepA, voffA);
            PG8_WAIT_L(8); PG8_BAR; PG8_WAIT_L(0); PG8_MMA(0, 0, At, B0); PG8_BAR; PG8_SCHED;
            PG8_LDB(B1, 1, 1); PG8_STAGE(PG8_SB(1, 0), b3, voffB);
            PG8_BAR; PG8_WAIT_L(0); PG8_MMA(0, 1, At, B1); PG8_BAR;
            PG8_LDA(At, 1, 1); PG8_STAGE(PG8_SA(1, 0), a3, voffA);
            PG8_BAR; PG8_WAIT_L(0); PG8_MMA(1, 0, At, B0); PG8_BAR; PG8_SCHED;
            PG8_STAGE(PG8_SB(1, 1), b3 + hstepB, voffB);
            PG8_WAIT_V(6); PG8_BAR; PG8_MMA(1, 1, At, B1); PG8_BAR;
            }
        }
        if constexpr (ALIGN_EPI) { if (wr == 0) PG8_BAR; }
        if constexpr (!Epi::AFTER_DRAIN) { E(acc, cur, wr, wc, fr, fq); S.done(cur); }
        if (!has_next) break;
#pragma unroll
        for (int a = 0; a < 2; ++a)
#pragma unroll
            for (int b = 0; b < 2; ++b)
#pragma unroll
                for (int m = 0; m < 4; ++m)
#pragma unroll
                    for (int n = 0; n < 2; ++n) acc[a][b][m][n] = (f32x4){0.f, 0.f, 0.f, 0.f};
        cur = nxt; cA = nA; cB = nB; ++ui;
        if constexpr (ALIGN_EPI) { if (wr == 1) PG8_BAR; }
    }
    PG8_WAIT_V(0);
    if constexpr (!ALIGN_EPI) { if (wr == 0) PG8_BAR; }
    PG8_BAR;
    if constexpr (Epi::AFTER_DRAIN) { E.fused(acc, cur, wr, wc, fr, fq, lds, wid, lane); S.done(cur); }
#undef PG8_ABASE
#undef PG8_SA
#undef PG8_SB
#undef PG8_STAGE
#undef PG8_LDA
#undef PG8_LDB
#undef PG8_MMA
#undef PG8_WAIT_V
#undef PG8_WAIT_L
#undef PG8_BAR
#undef PG8_SCHED
}
}

#ifndef PG8_SP2
#define PG8_SP2 true
#endif
#ifndef PG8_ALIGN
#define PG8_ALIGN true
#endif
#define GAS __attribute__((address_space(1)))
#define LAS __attribute__((address_space(3)))
typedef unsigned short bf16;
typedef unsigned v4u __attribute__((ext_vector_type(4)));
typedef float f32x4 __attribute__((ext_vector_type(4)));
typedef short bf16x8 __attribute__((ext_vector_type(8)));
typedef GAS unsigned gu32;
typedef GAS unsigned long long gu64;
#define RLX_AGENT __ATOMIC_RELAXED, __HIP_MEMORY_SCOPE_AGENT
#define LDS_WAIT() asm volatile("s_waitcnt lgkmcnt(0)" ::: "memory")
#define VM_WAIT() asm volatile("s_waitcnt vmcnt(0)" ::: "memory")
__device__ __forceinline__ unsigned long long rt() { return __builtin_amdgcn_s_memrealtime(); }

#define XB_TMO      128
#define XB_XCNT(j)  (256  + 64 * (j))
#define XB_XSUB(j)  (1280 + 64 * (j))
#define XB_XGEN(j)  (2304 + 64 * (j))
#define XB_TOP      3328
#define XB_TOPGEN   3392
#define XCD_BAR_WORDS 3456
#define XB_SPIN_CAP (1u << 20)

__device__ __forceinline__ unsigned xb_ld(unsigned* p)              { return __hip_atomic_load(p, __ATOMIC_RELAXED, __HIP_MEMORY_SCOPE_AGENT); }
__device__ __forceinline__ unsigned xb_add(unsigned* p, unsigned v) { return __hip_atomic_fetch_add(p, v, __ATOMIC_RELAXED, __HIP_MEMORY_SCOPE_AGENT); }
__device__ __forceinline__ unsigned xb_xcc_id() { return (unsigned)__builtin_amdgcn_s_getreg((3 << 11) | 20) & 0xFu; }
#define XB_SPIN(cond, bar) do { unsigned _sp = 0; while (cond) { __builtin_amdgcn_s_sleep(1); \
    if ((++_sp & 255u) == 0u) { if (xb_ld(&(bar)[XB_TMO])) break; if (_sp > XB_SPIN_CAP) { atomicAdd(&(bar)[XB_TMO], 1u); break; } } } } while (0)

struct XcdBarrier {
    unsigned* bar; unsigned x;
    volatile LAS unsigned* st;
};

__device__ __forceinline__ XcdBarrier xcd_barrier_post(unsigned* bar, volatile LAS unsigned* st) {
    XcdBarrier b; b.bar = bar; b.x = xb_xcc_id(); b.st = st;
    if (threadIdx.x == 0) (void)xb_add(&bar[XB_XCNT(b.x)], 1u);
    return b;
}
__device__ __forceinline__ void xcd_barrier_complete(unsigned* bar, unsigned x, unsigned& nloc, unsigned& nx) {
    const unsigned G = gridDim.x * gridDim.y * gridDim.z;
    unsigned sum, cnt, mine, sp = 0u;
    for (;;) {
        sum = 0u; cnt = 0u; mine = 0u;
#pragma unroll
        for (unsigned j = 0; j < 16; ++j) { const unsigned c = xb_ld(&bar[XB_XCNT(j)]); sum += c; cnt += (c > 0u) ? 1u : 0u; mine = (j == x) ? c : mine; }
        if (sum == G) break;
        __builtin_amdgcn_s_sleep(1);
        if ((++sp & 255u) == 0u) { if (xb_ld(&bar[XB_TMO])) break; if (sp > XB_SPIN_CAP) { atomicAdd(&bar[XB_TMO], 1u); break; } }
    }
    nloc = mine > 0u ? mine : 1u; nx = cnt > 0u ? cnt : 1u;
}

__device__ __forceinline__ void xcd_barrier(const XcdBarrier& b) {
    asm volatile("s_waitcnt vmcnt(0)" ::: "memory");
    __syncthreads();
    if (threadIdx.x == 0) {
        unsigned* bar = b.bar;
        __builtin_amdgcn_s_waitcnt(0);
        unsigned nloc = b.st[0], nx = b.st[1];
        if (nloc == 0u) { xcd_barrier_complete(bar, b.x, nloc, nx); b.st[0] = nloc; b.st[1] = nx; }
        const unsigned old = xb_add(&bar[XB_XSUB(b.x)], 1u);
        const unsigned gen = old / nloc;
        if (old + 1u == (gen + 1u) * nloc) {
            __builtin_amdgcn_fence(__ATOMIC_RELEASE, "agent");
            asm volatile("s_waitcnt vmcnt(0)" ::: "memory");
            const unsigned og = xb_add(&bar[XB_TOP], 1u);
            const unsigned tg = og / nx;
            if (og + 1u == (tg + 1u) * nx) xb_add(&bar[XB_TOPGEN], 1u);
            else XB_SPIN(xb_ld(&bar[XB_TOPGEN]) == tg, bar);
            __builtin_amdgcn_fence(__ATOMIC_ACQUIRE, "agent");
            xb_add(&bar[XB_XGEN(b.x)], 1u);
            asm volatile("s_waitcnt vmcnt(0)" ::: "memory");
        } else {
            XB_SPIN(xb_ld(&bar[XB_XGEN(b.x)]) == gen, bar);
            __builtin_amdgcn_fence(__ATOMIC_ACQUIRE, "agent");
            asm volatile("s_waitcnt vmcnt(0)" ::: "memory");
        }
    }
    __syncthreads();
}

namespace mk {
constexpr size_t WS_CTL = 0, CTL_ZERO_BYTES = 1 * MiB;
constexpr size_t CTL_SSQ = 512 * 1024;
constexpr size_t WS_SMALL = 1 * MiB, SM_BIAS = 0, SM_SSQM = 4096, SM_MKV = 512 * 1024;
constexpr size_t WS_MEMB = 2 * MiB, WS_WT = 3 * MiB, WS_XB = 28 * MiB, WS_VF = 60 * MiB, WS_PROJ = 72 * MiB, WS_MIX = 144 * MiB, WS_PREP = 176 * MiB, WS_U = 72 * MiB, WS_ACT = 160 * MiB, WS_WIN1 = 248 * MiB  , WS_END = 255 * MiB;
constexpr size_t WT_IN = 0, WT_OUT = 4718592, WT_UP = WT_OUT + 2 * MiB, WT_DOWN = WT_UP + 11 * MiB, WT_MKV = WT_DOWN + 5767168;
constexpr int CW_TMO = 0, CW_BAR = 4096, CW_ATTQ = 8192, CW_CHQ = 8448;
constexpr int LDS_BYTES = 163840, LDSCTL_OFF = LDS_BYTES - 512, MISC_OFF = LDSCTL_OFF + 320;
constexpr size_t SM_W2T = 8192, SM_A2T = 32768, SM_V2T = 57344, SM_G2T = 81920, SM_LORA_L = 122880;
constexpr size_t WS_PT = 176 * MiB, WS_G = 188 * MiB, WS_S0 = 200 * MiB, WS_Z = 212 * MiB, WS_YV = 236 * MiB  , WS_DOT = 254 * MiB;
constexpr size_t SM_RWP = 262144, RWP_BYTES = 17472;
constexpr int RP_MU = 0, RP_MUV = 1280, RP_W0 = 1296, RP_A0 = 1680, RP_V0 = 2064, RP_KK = 2448, RP_KA = 2832, RP_RK = 3216, RP_LNW = 3600, RP_LNB = 3984, RP_SIZE = 4368;
}
namespace rw {
constexpr int LD = 72;
constexpr int MATB = 64 * LD * 2;
constexpr int OFF_F0 = 12 * MATB  , OFF_TMP = OFF_F0 + 64 * 65 * 4  ;
constexpr int OFF_TW = 8 * MATB  , OFF_TA = OFF_TW + 5120, OFF_TV = OFF_TA + 5120, OFF_WP = OFF_TV + 5120  , OFF_AP = OFF_WP + 16640, OFF_VP = OFF_AP + 16640;
constexpr int OFF_TOT = 139264, OFF_GC = OFF_TOT + 2048, OFF_RN = OFF_GC + 256, OFF_END = OFF_RN + 256;
constexpr int NITEMS = BATCH * 6 * (SEQ / 64);
__device__ __forceinline__ int sigpos(int c) { return (c & 32) + 8 * ((c >> 2) & 3) + 4 * ((c >> 4) & 1) + (c & 3); }
#define RW_BAR() do { asm volatile("s_waitcnt lgkmcnt(0)" ::: "memory"); __builtin_amdgcn_s_barrier(); asm volatile("" ::: "memory"); } while (0)
__device__ __forceinline__ float fexp(float x) { return __expf(x); }
__device__ __forceinline__ float fsigm(float x) { return __builtin_amdgcn_rcpf(1.0f + __expf(-x)); }
__device__ __forceinline__ float ftanh(float x) { const float e = __expf(-2.0f * fabsf(x)); const float t = (1.0f - e) * __builtin_amdgcn_rcpf(1.0f + e); return x < 0.f ? -t : t; }
__device__ __forceinline__ f32x4 mm_tile(const LAS bf16_t* A, const LAS bf16_t* Bt, int ti, int tj, int fr, int fq, f32x4 acc) {
#pragma unroll
    for (int kk = 0; kk < 2; ++kk) {
        const bf16x8 a = *(const LAS bf16x8*)(A + (16 * ti + fr) * LD + 32 * kk + 8 * fq);
        const bf16x8 b = *(const LAS bf16x8*)(Bt + (16 * tj + fr) * LD + 32 * kk + 8 * fq);
        acc = __builtin_amdgcn_mfma_f32_16x16x32_bf16(a, b, acc, 0, 0, 0);
    }
    return acc;
}
__device__ __forceinline__ unsigned pk2(float lo, float hi) { typedef float f2_t __attribute__((ext_vector_type(2))); typedef __bf16 b2_t __attribute__((ext_vector_type(2))); f2_t v = {lo, hi}; return __builtin_bit_cast(unsigned, __builtin_convertvector(v, b2_t)); }
#define RW_PT   ((GAS bf16_t*)(wsb + mk::WS_PT))
#define RW_G    ((GAS bf16_t*)(wsb + mk::WS_G))
#define RW_Z    ((GAS float*)(wsb + mk::WS_Z))
#define RW_YV   ((GAS bf16_t*)(wsb + mk::WS_YV))
#define RW_S0   ((GAS bf16_t*)(wsb + mk::WS_S0))
#define RW_VF   ((GAS bf16_t*)(wsb + mk::WS_VF))
#define RW_DOT  ((GAS float*)(wsb + mk::WS_DOT))
#define RW_PROJ ((const GAS bf16_t*)(wsb + mk::WS_PROJ))
#define RW_MIX  ((GAS bf16_t*)(wsb + mk::WS_MIX))
#define RW_LORA(off) ((const GAS bf16_t*)(wsb + mk::WS_SMALL + (off) + layer * mk::SM_LORA_L))
#define RWP(off) ((const GAS float*)(wsb + mk::WS_SMALL + mk::SM_RWP + layer * mk::RWP_BYTES) + (off))
struct ChunkBufs { bf16_t* PT; bf16_t* G; float* Z; bf16_t* YV; bf16_t* S0; bf16_t* VOUT; float* DOT; const bf16_t *W2T, *A2T, *V2T, *G2T; };

#define RW_LANES() int lt_ = tid_in; asm volatile("" : "+v"(lt_)); const int tid = lt_, lane = lt_ & 63, fr = lane & 15, fq = lane >> 4; (void)tid; (void)fr; (void)fq
struct ChunkLoads { unsigned short e_r[9], e_k[9], e_v[9], e_vf[8]; v4u lc, lp, kc4, kp4, vc4, vp4; };
__device__ __forceinline__ void chunk_loads(ChunkLoads& C, unsigned char* wsb, int layer, int item, int tid, int w) {
    const GAS bf16_t* P = RW_PROJ; const int lane = tid & 63;
    const int bh = item / (SEQ / 64), chunk = item % (SEQ / 64), b = bh / 6, h = bh % 6; const int tok0 = b * SEQ + chunk * 64;
    { const int hc = 64 * h + lane, tk0 = tok0 + 8 * w; const bool has_prev = (chunk * 64 + 8 * w) > 0;
#pragma unroll
      for (int j = 0; j < 9; ++j) { const size_t row = (size_t)(tk0 + j - 1) * LDP; const bool ok = j > 0 || has_prev;
          C.e_r[j] = ok ? P[row + 640 + hc] : (unsigned short)0; C.e_k[j] = ok ? P[row + 1024 + hc] : (unsigned short)0; C.e_v[j] = ok ? P[row + 1408 + hc] : (unsigned short)0; }
#pragma unroll
      for (int j = 0; j < 8; ++j) C.e_vf[j] = layer > 0 ? RW_VF[(size_t)(tk0 + j) * 384 + hc] : (unsigned short)0; }
    { const int t = tid >> 3, sub = tid & 7, tok = tok0 + t; const bool hp = (chunk * 64 + t) > 0;
      const GAS bf16_t* rc = P + (size_t)tok * LDP; const GAS bf16_t* rp = rc - LDP; const v4u z4 = {0u, 0u, 0u, 0u};
      C.lc = *(const GAS v4u*)(rc + 1792 + 8 * sub); C.lp = hp ? *(const GAS v4u*)(rp + 1792 + 8 * sub) : z4;
      C.kc4 = *(const GAS v4u*)(rc + 1024 + 64 * h + 8 * sub); C.kp4 = hp ? *(const GAS v4u*)(rp + 1024 + 64 * h + 8 * sub) : z4;
      C.vc4 = z4; C.vp4 = z4; if (layer > 0 && sub < 2) { C.vc4 = *(const GAS v4u*)(rc + 1920 + 8 * sub); if (hp) C.vp4 = *(const GAS v4u*)(rp + 1920 + 8 * sub); } }
}
__device__ __forceinline__ int chunk_phase(LAS unsigned char* L, unsigned char* wsb, int layer, int tid_in, unsigned* qctr, volatile LAS unsigned* qw) {
    const GAS bf16_t* P = RW_PROJ;
    const int w = __builtin_amdgcn_readfirstlane(tid_in >> 6);
    LAS bf16_t* B0 = (LAS bf16_t*)(L + 0 * MATB); LAS bf16_t* B1 = (LAS bf16_t*)(L + 1 * MATB); LAS bf16_t* B2 = (LAS bf16_t*)(L + 2 * MATB); LAS bf16_t* B3 = (LAS bf16_t*)(L + 3 * MATB);
    LAS bf16_t* B4 = (LAS bf16_t*)(L + 4 * MATB); LAS bf16_t* B5 = (LAS bf16_t*)(L + 5 * MATB); LAS bf16_t* B6 = (LAS bf16_t*)(L + 6 * MATB); LAS bf16_t* B7 = (LAS bf16_t*)(L + 7 * MATB);
    LAS bf16_t* B8 = (LAS bf16_t*)(L + 8 * MATB); LAS bf16_t* B9 = (LAS bf16_t*)(L + 9 * MATB); LAS bf16_t* B10 = (LAS bf16_t*)(L + 10 * MATB); LAS bf16_t* B11 = (LAS bf16_t*)(L + 11 * MATB);
    LAS float* F0 = (LAS float*)(L + OFF_F0); LAS float* TMP = (LAS float*)(L + OFF_TMP);
    LAS bf16_t* TW = (LAS bf16_t*)(L + OFF_TW); LAS bf16_t* TA = (LAS bf16_t*)(L + OFF_TA); LAS bf16_t* TV = (LAS bf16_t*)(L + OFF_TV);
    LAS float* WP = (LAS float*)(L + OFF_WP); LAS float* AP = (LAS float*)(L + OFF_AP); LAS float* VP = (LAS float*)(L + OFF_VP);
    LAS float* TOT = (LAS float*)(L + OFF_TOT); LAS float* GC = (LAS float*)(L + OFF_GC); LAS float* RN = (LAS float*)(L + OFF_RN);
    if (tid_in == 0) qw[0] = atomicAdd(qctr, 1u);
    RW_BAR(); int item = (int)qw[0]; RW_BAR();
    ChunkLoads CL; if (item < NITEMS) { RW_LANES(); chunk_loads(CL, wsb, layer, item, tid, w); }
    for (;;) {
        if (item >= NITEMS) return item;
        if (tid_in == 0) qw[0] = atomicAdd(qctr, 1u);
        const int bh = item / (SEQ / 64), chunk = item % (SEQ / 64), b = bh / 6, h = bh % 6;
        const int tok0 = b * SEQ + chunk * 64;
        float e_mu_r, e_mu_k, e_mu_v, e_w0, e_a0, e_kk, e_ka, e_rk, e_v0;
        { RW_LANES(); const int hc = 64 * h + lane;
          e_mu_r = RWP(mk::RP_MU)[hc]; e_mu_k = RWP(mk::RP_MU)[384 + hc]; e_mu_v = RWP(mk::RP_MU)[768 + hc]; e_w0 = RWP(mk::RP_W0)[hc]; e_a0 = RWP(mk::RP_A0)[hc]; e_kk = RWP(mk::RP_KK)[hc]; e_ka = RWP(mk::RP_KA)[hc]; e_rk = RWP(mk::RP_RK)[hc]; e_v0 = layer > 0 ? RWP(mk::RP_V0)[hc] : 0.f; }
        for (int rp_ = 0; rp_ < ((PROF_PH) == 20 ? 2 : 1); ++rp_) {
        { RW_LANES(); const int t = tid >> 3, sub = tid & 7;
          const v4u lc = CL.lc, lp = CL.lp, kc4 = CL.kc4, kp4 = CL.kp4, vc4 = CL.vc4, vp4 = CL.vp4;
          const unsigned lcw[4] = {lc.x, lc.y, lc.z, lc.w}, lpw[4] = {lp.x, lp.y, lp.z, lp.w}, kcw[4] = {kc4.x, kc4.y, kc4.z, kc4.w}, kpw[4] = {kp4.x, kp4.y, kp4.z, kp4.w}, vcw[4] = {vc4.x, vc4.y, vc4.z, vc4.w}, vpw[4] = {vp4.x, vp4.y, vp4.z, vp4.w};
          unsigned lo[4], vo[4]; float s = 0.f;
          const f32x4 mA0 = *(const GAS f32x4*)(RWP(mk::RP_MU) + 1152 + 8 * sub), mA1 = *(const GAS f32x4*)(RWP(mk::RP_MU) + 1156 + 8 * sub);
          const f32x4 mK0 = *(const GAS f32x4*)(RWP(mk::RP_MU) + 384 + 64 * h + 8 * sub), mK1 = *(const GAS f32x4*)(RWP(mk::RP_MU) + 388 + 64 * h + 8 * sub);
          const f32x4 kk0 = *(const GAS f32x4*)(RWP(mk::RP_KK) + 64 * h + 8 * sub), kk1 = *(const GAS f32x4*)(RWP(mk::RP_KK) + 64 * h + 8 * sub + 4);
          f32x4 mV0 = {0.f, 0.f, 0.f, 0.f}, mV1 = mV0; if (layer > 0 && sub < 2) { mV0 = *(const GAS f32x4*)(RWP(mk::RP_MUV) + 8 * sub); mV1 = *(const GAS f32x4*)(RWP(mk::RP_MUV) + 8 * sub + 4); }
#pragma unroll
          for (int e2 = 0; e2 < 4; ++e2) { float xl[2], xv[2];
#pragma unroll
              for (int u = 0; u < 2; ++u) { const int e = 2 * e2 + u; const int sh = 16 * u;
                  const float c1 = bf2f((bf16_t)((lcw[e2] >> sh) & 0xffff)), p1 = bf2f((bf16_t)((lpw[e2] >> sh) & 0xffff)); const float x = c1 + (e < 4 ? mA0[e & 3] : mA1[e & 3]) * (p1 - c1);
                  xl[u] = sub < 4 ? ftanh(x) : x;
                  const float c2 = bf2f((bf16_t)((kcw[e2] >> sh) & 0xffff)), p2 = bf2f((bf16_t)((kpw[e2] >> sh) & 0xffff));
                  const float kx = (c2 + (e < 4 ? mK0[e & 3] : mK1[e & 3]) * (p2 - c2)) * (e < 4 ? kk0[e & 3] : kk1[e & 3]); s += kx * kx;
                  const float c3 = bf2f((bf16_t)((vcw[e2] >> sh) & 0xffff)), p3 = bf2f((bf16_t)((vpw[e2] >> sh) & 0xffff)); xv[u] = c3 + (e < 4 ? mV0[e & 3] : mV1[e & 3]) * (p3 - c3); }
              lo[e2] = pk2(xl[0], xl[1]); vo[e2] = pk2(xv[0], xv[1]); }
          *(LAS v4u*)((sub < 4 ? TW : TA) + t * 40 + 8 * (sub & 3)) = (v4u){lo[0], lo[1], lo[2], lo[3]};
          if (layer > 0 && sub < 4) *(LAS v4u*)(TV + t * 40 + 8 * sub) = (v4u){vo[0], vo[1], vo[2], vo[3]};
          s += __shfl_xor(s, 1); s += __shfl_xor(s, 2); s += __shfl_xor(s, 4);
          if (sub == 0) RN[t] = __builtin_amdgcn_rsqf(fmaxf(s, 1e-24f)); }
        RW_BAR();
        }
        const int nxt = (int)qw[0];
        { RW_LANES();
#pragma unroll
        for (int e = 0; e < 2; ++e) { const int tl = 2 * w + e, ti = tl >> 2, tj = tl & 3; const f32x4 z4 = {0.f, 0.f, 0.f, 0.f};
            const size_t brow = (size_t)(64 * h + 16 * tj + fr) * 32 + 8 * fq;
            { const bf16x8 a = *(const LAS bf16x8*)(TW + (16 * ti + fr) * 40 + 8 * fq); const bf16x8 bb = *(const GAS bf16x8*)(RW_LORA(mk::SM_W2T) + brow);
              const f32x4 d = __builtin_amdgcn_mfma_f32_16x16x32_bf16(a, bb, z4, 0, 0, 0);
#pragma unroll
              for (int r = 0; r < 4; ++r) WP[(16 * ti + 4 * fq + r) * 65 + 16 * tj + fr] = d[r]; }
            { const bf16x8 a = *(const LAS bf16x8*)(TA + (16 * ti + fr) * 40 + 8 * fq); const bf16x8 bb = *(const GAS bf16x8*)(RW_LORA(mk::SM_A2T) + brow);
              const f32x4 d = __builtin_amdgcn_mfma_f32_16x16x32_bf16(a, bb, z4, 0, 0, 0);
#pragma unroll
              for (int r = 0; r < 4; ++r) AP[(16 * ti + 4 * fq + r) * 65 + 16 * tj + fr] = d[r]; }
            if (layer > 0) { const bf16x8 a = *(const LAS bf16x8*)(TV + (16 * ti + fr) * 40 + 8 * fq); const bf16x8 bb = *(const GAS bf16x8*)(RW_LORA(mk::SM_V2T) + brow);
              const f32x4 d = __builtin_amdgcn_mfma_f32_16x16x32_bf16(a, bb, z4, 0, 0, 0);
#pragma unroll
              for (int r = 0; r < 4; ++r) VP[(16 * ti + 4 * fq + r) * 65 + 16 * tj + fr] = d[r]; } } }
        RW_BAR();
        for (int rp_ = 0; rp_ < ((PROF_PH) == 21 ? 2 : 1); ++rp_) {
        { RW_LANES(); const int c = lane, hc = 64 * h + c, tq0 = 8 * w, tk0 = tok0 + tq0;
          const float mu_r = e_mu_r, mu_k = e_mu_k, mu_v = e_mu_v, w0 = e_w0, a0 = e_a0, k_k = e_kk, k_a = e_ka, r_k = e_rk, v0 = e_v0;
          float pr = bf2f(CL.e_r[0]), pk = bf2f(CL.e_k[0]), pv = bf2f(CL.e_v[0]);
          float rr[8], kq[8], vv[8], kkc[8], bb[8], ld[8], pd[8];
#pragma unroll
          for (int j = 0; j < 8; ++j) { const int t = tq0 + j;
              const float cr = bf2f(CL.e_r[j + 1]), ck = bf2f(CL.e_k[j + 1]), cv = bf2f(CL.e_v[j + 1]);
              const float r = cr + mu_r * (pr - cr), k = ck + mu_k * (pk - ck); float v = cv + mu_v * (pv - cv); pr = cr; pk = ck; pv = cv;
              const float wp = w0 + WP[t * 65 + c], ap = a0 + AP[t * 65 + c];
              const float z = -wp, sp = fmaxf(z, 0.f) + __logf(1.0f + __expf(-fabsf(z))); const float wl = -sp - 0.5f;
              const float al = fsigm(ap);
              if (layer > 0) { const float vp = v0 + VP[t * 65 + c]; const float vf = bf2f(CL.e_vf[j]); v = v + (vf - v) * fsigm(vp); }
              const float kn = k * k_k * RN[t]; const float k2 = k * (1.0f + (al - 1.0f) * k_a);
              rr[j] = r; kq[j] = k2; vv[j] = v; kkc[j] = kn; bb[j] = kn * al; ld[j] = -fexp(wl); pd[j] = r * k2 * r_k; }
          {
#pragma unroll
            for (int j = 0; j < 8; j += 2) { const unsigned pv2 = pk2(vv[j], vv[j + 1]); RW_VF[(size_t)(tk0 + j) * 384 + hc] = (bf16_t)(pv2 & 0xffff); RW_VF[(size_t)(tk0 + j + 1) * 384 + hc] = (bf16_t)(pv2 >> 16); } }
          {
            const bool b5 = lane & 32, b4 = lane & 16, b3 = lane & 8; float s4[4], s2[2], s1;
#pragma unroll
            for (int i = 0; i < 4; ++i) { const float keep = b5 ? pd[i + 4] : pd[i], send = b5 ? pd[i] : pd[i + 4]; s4[i] = keep + __shfl_xor(send, 32); }
#pragma unroll
            for (int i = 0; i < 2; ++i) { const float keep = b4 ? s4[i + 2] : s4[i], send = b4 ? s4[i] : s4[i + 2]; s2[i] = keep + __shfl_xor(send, 16); }
            { const float keep = b3 ? s2[1] : s2[0], send = b3 ? s2[0] : s2[1]; s1 = keep + __shfl_xor(send, 8); }
            s1 += __shfl_xor(s1, 4); s1 += __shfl_xor(s1, 2); s1 += __shfl_xor(s1, 1);
            if ((lane & 7) == 0) RW_DOT[(size_t)(tk0 + (lane >> 3)) * 6 + h] = s1; }
          float cl[8]; cl[0] = ld[0];
#pragma unroll
          for (int j = 1; j < 8; ++j) cl[j] = cl[j - 1] + ld[j];
          TOT[w * 64 + c] = cl[7];
          RW_BAR();
          float prefix = 0.f, cumC = 0.f;
#pragma unroll
          for (int ww = 0; ww < 8; ++ww) { const float tv = TOT[ww * 64 + c]; cumC += tv; if (ww < w) prefix += tv; }
          const float gcc = fexp(cumC); if (w == 0) GC[c] = gcc;
          unsigned ahp[4], btp[4], ktp[4], vp4[4]; float gprev = fexp(prefix), ah_e = 0.f, bt_e = 0.f, kt_e = 0.f;
#pragma unroll
          for (int j = 0; j < 8; ++j) { const int t = tq0 + j; const float g = fexp(prefix + cl[j]), ig = __builtin_amdgcn_rcpf(g), gc = gcc * ig;
              const float ah = -kkc[j] * gprev, rh = rr[j] * g, bh = bb[j] * ig, kh = kq[j] * ig, bt = bb[j] * gc, kt = kq[j] * gc; gprev = g;
              const unsigned w01 = pk2(ah, rh), w23 = pk2(bh, kh);
              B0[t * LD + c] = (bf16_t)(w01 & 0xffff); B1[t * LD + c] = (bf16_t)(w01 >> 16); B2[t * LD + c] = (bf16_t)(w23 & 0xffff); B3[t * LD + c] = (bf16_t)(w23 >> 16);
              if (j & 1) { ahp[j >> 1] = pk2(ah_e, ah); btp[j >> 1] = pk2(bt_e, bt); ktp[j >> 1] = pk2(kt_e, kt); vp4[j >> 1] = pk2(vv[j - 1], vv[j]); }
              else { ah_e = ah; bt_e = bt; kt_e = kt; } }
          *(LAS v4u*)(B4 + c * LD + tq0) = (v4u){ahp[0], ahp[1], ahp[2], ahp[3]}; *(LAS v4u*)(B5 + c * LD + tq0) = (v4u){btp[0], btp[1], btp[2], btp[3]};
          *(LAS v4u*)(B6 + c * LD + tq0) = (v4u){ktp[0], ktp[1], ktp[2], ktp[3]}; *(LAS v4u*)(B7 + c * LD + tq0) = (v4u){vp4[0], vp4[1], vp4[2], vp4[3]}; }
        RW_BAR();
        }
        if (nxt < NITEMS) { RW_LANES(); chunk_loads(CL, wsb, layer, nxt, tid, w); }
        for (int rp_ = 0; rp_ < ((PROF_PH) == 22 ? 2 : 1); ++rp_) {
        { RW_LANES(); const int prod = w >> 1; const LAS bf16_t* Aop = prod < 2 ? B0 : B1; const LAS bf16_t* Bop = (prod & 1) ? B3 : B2;
#pragma unroll
          for (int e = 0; e < 8; ++e) { const int tl = (w & 1) * 8 + e, ti = tl >> 2, tj = tl & 3; f32x4 d = {0.f, 0.f, 0.f, 0.f};
              if (tj <= ti) d = mm_tile(Aop, Bop, ti, tj, fr, fq, d);
#pragma unroll
              for (int r = 0; r < 4; ++r) { const int t = 16 * ti + 4 * fq + r, i = 16 * tj + fr; const bool keep = prod < 2 ? (i < t) : (i <= t); const float val = (tj <= ti && keep) ? d[r] : 0.f;
                  if (prod == 0) F0[t * 65 + i] = val; else if (prod == 1) B8[t * LD + i] = f2bf(val); else if (prod == 2) B9[t * LD + i] = f2bf(val); else B10[t * LD + i] = f2bf(val); } } }
        RW_BAR();
        }
        if (w == 0) { RW_LANES();
            const int blk = lane >> 4, jc = lane & 15; const LAS float* Lb = F0 + (16 * blk) * 65 + 16 * blk; float tc[16];
#pragma unroll
            for (int r = 0; r < 16; ++r) { float val = (r == jc) ? 1.f : 0.f;
#pragma unroll
                for (int i = 0; i < r; ++i) val += Lb[r * 65 + i] * tc[i];
                tc[r] = val; }
            asm volatile("s_waitcnt lgkmcnt(0)" ::: "memory");
#pragma unroll
            for (int r = 0; r < 16; ++r) F0[(16 * blk + r) * 65 + 16 * blk + jc] = tc[r];
        } else { RW_LANES();
#pragma unroll 1
            for (int tl = w - 1; tl < 16; tl += 7) { const int ti = tl >> 2, tj = tl & 3; f32x4 d = {0.f, 0.f, 0.f, 0.f};
                d = mm_tile(B8, B7, ti, tj, fr, fq, d);
                LAS bf16_t* dst = B2 + (16 * tj + fr) * LD + 16 * ti + 4 * fq;
                *(LAS unsigned long long*)dst = (unsigned long long)pk2(d[0], d[1]) | ((unsigned long long)pk2(d[2], d[3]) << 32); } }
        RW_BAR();
        if (w < 2) { RW_LANES();
            const int o1 = 32 * w, o2 = 32 * w + 16; f32x4 d = {0.f, 0.f, 0.f, 0.f};
#pragma unroll
            for (int ks = 0; ks < 4; ++ks) d = __builtin_amdgcn_mfma_f32_16x16x4f32(F0[(o2 + fr) * 65 + o1 + 4 * ks + fq], F0[(o1 + 4 * ks + fq) * 65 + o1 + fr], d, 0, 0, 0);
            LAS float* tm = TMP + w * 16 * 17;
#pragma unroll
            for (int r = 0; r < 4; ++r) tm[(4 * fq + r) * 17 + fr] = d[r];
            asm volatile("s_waitcnt lgkmcnt(0)" ::: "memory");
            f32x4 d2 = {0.f, 0.f, 0.f, 0.f};
#pragma unroll
            for (int ks = 0; ks < 4; ++ks) d2 = __builtin_amdgcn_mfma_f32_16x16x4f32(F0[(o2 + fr) * 65 + o2 + 4 * ks + fq], tm[(4 * ks + fq) * 17 + fr], d2, 0, 0, 0);
            asm volatile("s_waitcnt lgkmcnt(0)" ::: "memory");
#pragma unroll
            for (int r = 0; r < 4; ++r) F0[(o2 + 4 * fq + r) * 65 + o1 + fr] = d2[r];
        }
        RW_BAR();
        if (w < 4) { RW_LANES();
            const int ti = w >> 1, tj = w & 1; f32x4 d = {0.f, 0.f, 0.f, 0.f};
#pragma unroll
            for (int ks = 0; ks < 8; ++ks) d = __builtin_amdgcn_mfma_f32_16x16x4f32(F0[(32 + 16 * ti + fr) * 65 + 4 * ks + fq], F0[(4 * ks + fq) * 65 + 16 * tj + fr], d, 0, 0, 0);
#pragma unroll
            for (int r = 0; r < 4; ++r) TMP[(16 * ti + 4 * fq + r) * 33 + 16 * tj + fr] = d[r];
        }
        RW_BAR();
        if (w < 4) { RW_LANES();
            const int ti = w >> 1, tj = w & 1; f32x4 d = {0.f, 0.f, 0.f, 0.f};
#pragma unroll
            for (int ks = 0; ks < 8; ++ks) d = __builtin_amdgcn_mfma_f32_16x16x4f32(F0[(32 + 16 * ti + fr) * 65 + 32 + 4 * ks + fq], TMP[(4 * ks + fq) * 33 + 16 * tj + fr], d, 0, 0, 0);
#pragma unroll
            for (int r = 0; r < 4; ++r) F0[(32 + 16 * ti + 4 * fq + r) * 65 + 16 * tj + fr] = d[r];
        }
        RW_BAR();
        { RW_LANES(); const int t = tid >> 3, i0 = (tid & 7) * 8;
#pragma unroll
          for (int e = 0; e < 8; ++e) B11[t * LD + i0 + e] = f2bf(F0[t * 65 + i0 + e]); }
        RW_BAR();
        { RW_LANES();
#pragma unroll
        for (int e = 0; e < 4; ++e) { const int tl = 4 * w + e, prod = tl >> 4, ti = (tl >> 2) & 3, tj = tl & 3; f32x4 d = {0.f, 0.f, 0.f, 0.f};
            d = prod == 0 ? mm_tile(B11, B4, ti, tj, fr, fq, d) : mm_tile(B11, B2, ti, tj, fr, fq, d);
            LAS bf16_t* dst = (prod == 0 ? B0 : B3) + (16 * tj + fr) * LD + 16 * ti + 4 * fq;
            *(LAS unsigned long long*)dst = (unsigned long long)pk2(d[0], d[1]) | ((unsigned long long)pk2(d[2], d[3]) << 32); } }
        RW_BAR();
        for (int rp_ = 0; rp_ < ((PROF_PH) == 23 ? 2 : 1); ++rp_) {
        { RW_LANES();
#pragma unroll
        for (int e = 0; e < 8; ++e) { const int tl = 8 * w + e, prod = tl >> 4, ti = (tl >> 2) & 3, tj = tl & 3; f32x4 d = {0.f, 0.f, 0.f, 0.f};
            if (prod == 0) { d = mm_tile(B5, B3, ti, tj, fr, fq, d); d = mm_tile(B6, B7, ti, tj, fr, fq, d);
                *(GAS f32x4*)(RW_Z + (size_t)item * 4096 + (16 * tj + fr) * 64 + 4 * ((4 * ti + fq) ^ fr)) = d; }
            else if (prod == 1) { d = mm_tile(B9, B3, ti, tj, fr, fq, d); d = mm_tile(B10, B7, ti, tj, fr, fq, d);
                *(GAS unsigned long long*)(RW_YV + (size_t)item * 4096 + (16 * tj + fr) * 64 + 16 * ti + 4 * fq) = (unsigned long long)pk2(d[0], d[1]) | ((unsigned long long)pk2(d[2], d[3]) << 32); }
            else if (prod == 2) { d = mm_tile(B9, B0, ti, tj, fr, fq, d);
#pragma unroll
                for (int r = 0; r < 4; ++r) { const int t = 16 * ti + 4 * fq + r, c = 16 * tj + fr; B4[t * LD + sigpos(c)] = f2bf(d[r] + bf2f(B1[t * LD + c])); } }
            else { d = mm_tile(B5, B0, ti, tj, fr, fq, d);
#pragma unroll
                for (int r = 0; r < 4; ++r) { const int c = 16 * ti + 4 * fq + r, c2 = 16 * tj + fr; B8[c * LD + sigpos(c2)] = f2bf(d[r] + (c == c2 ? GC[c] : 0.f)); } } } }
        RW_BAR();
        }
        { RW_LANES(); const int r = tid >> 3, ch = (tid & 7) * 8;
          *(GAS v4u*)(RW_G + (size_t)item * 4096 + r * 64 + ch) = *(const LAS v4u*)(B4 + r * LD + ch);
          *(GAS v4u*)(RW_PT + (size_t)item * 4096 + r * 64 + 8 * ((tid & 7) ^ (r & 7))) = *(const LAS v4u*)(B8 + r * LD + ch); }
        RW_BAR();
        item = nxt;
    }
}
constexpr int SC_NS = 10, SC_SLOT = 12288, SC_LAG = 6;
__device__ __forceinline__ void scan_compute(LAS unsigned char* L, const ChunkBufs cb, int bh, int tj, int lane, volatile LAS unsigned* flags) {
    const int fr = lane & 15, fq = lane >> 4; const int NC = SEQ / 64;
    bf16x8 Bf0 = {0, 0, 0, 0, 0, 0, 0, 0}, Bf1 = {0, 0, 0, 0, 0, 0, 0, 0};
    bf16_t* s0 = cb.S0 + (size_t)(bh * NC) * 4096 + (16 * tj + fr) * 64 + 8 * fq;
    const int po0 = fr * 128 + 16 * ((fq) ^ (fr & 7)), po1 = fr * 128 + 16 * ((4 + fq) ^ (fr & 7)), pz = 8192 + fr * 256;
#define SC_WAIT(n) do { unsigned spins_ = 0; while (true) { const unsigned a_ = flags[0], b_ = flags[1], c_ = flags[2]; const unsigned m_ = a_ < b_ ? (a_ < c_ ? a_ : c_) : (b_ < c_ ? b_ : c_); if ((int)m_ >= (n) || ++spins_ > (1u << 22)) break; __builtin_amdgcn_s_sleep(1); } } while (0)
#define SC_READ(A0, A1, Z, slot_) do { const LAS unsigned char* sp_ = L + (slot_) * SC_SLOT; _Pragma("unroll") for (int ti = 0; ti < 4; ++ti) { A0[ti] = *(const LAS bf16x8*)(sp_ + ti * 2048 + po0); A1[ti] = *(const LAS bf16x8*)(sp_ + ti * 2048 + po1); Z[ti] = *(const LAS f32x4*)(sp_ + pz + 16 * ((4 * ti + fq) ^ fr)); } } while (0)
#define SC_STEP(A0, A1, Z, chunk_) do { \
        *(GAS bf16x8*)(s0 + (size_t)(chunk_) * 4096) = Bf0; *(GAS bf16x8*)(s0 + (size_t)(chunk_) * 4096 + 32) = Bf1; \
        f32x4 acc_[4]; _Pragma("unroll") for (int ti = 0; ti < 4; ++ti) { acc_[ti] = __builtin_amdgcn_mfma_f32_16x16x32_bf16(A0[ti], Bf0, Z[ti], 0, 0, 0); acc_[ti] = __builtin_amdgcn_mfma_f32_16x16x32_bf16(A1[ti], Bf1, acc_[ti], 0, 0, 0); } \
        v4u m0_, m1_; m0_.x = pk2(acc_[0][0], acc_[0][1]); m0_.y = pk2(acc_[0][2], acc_[0][3]); m0_.z = pk2(acc_[1][0], acc_[1][1]); m0_.w = pk2(acc_[1][2], acc_[1][3]); \
        m1_.x = pk2(acc_[2][0], acc_[2][1]); m1_.y = pk2(acc_[2][2], acc_[2][3]); m1_.z = pk2(acc_[3][0], acc_[3][1]); m1_.w = pk2(acc_[3][2], acc_[3][3]); \
        Bf0 = __builtin_bit_cast(bf16x8, m0_); Bf1 = __builtin_bit_cast(bf16x8, m1_); } while (0)
    bf16x8 xa0[4], xa1[4], ya0[4], ya1[4]; f32x4 xz[4], yz[4];
    SC_WAIT(1); SC_READ(xa0, xa1, xz, 0);
    asm volatile("s_waitcnt lgkmcnt(0)" ::: "memory"); if (lane == 0) flags[3] = 1u;
    int slot = 1;
    for (int chunk = 0; chunk < NC; chunk += 2) {
        SC_WAIT(chunk + 2); SC_READ(ya0, ya1, yz, slot); slot = slot + 1 == SC_NS ? 0 : slot + 1;
        SC_STEP(xa0, xa1, xz, chunk);
        asm volatile("s_waitcnt lgkmcnt(0)" ::: "memory"); if (lane == 0) flags[3] = (unsigned)(chunk + 2);
        if (chunk + 2 < NC) { SC_WAIT(chunk + 3); SC_READ(xa0, xa1, xz, slot); slot = slot + 1 == SC_NS ? 0 : slot + 1; }
        SC_STEP(ya0, ya1, yz, chunk + 1);
        asm volatile("s_waitcnt lgkmcnt(0)" ::: "memory"); if (lane == 0 && chunk + 2 < NC) flags[3] = (unsigned)(chunk + 3);
    }
#undef SC_WAIT
#undef SC_READ
#undef SC_STEP
}
__device__ __forceinline__ void scan_loader(LAS unsigned char* L, const ChunkBufs cb, int bh, int tj, int lw, int lane, volatile LAS unsigned* flags) {
    const int NC = SEQ / 64;
    const char* src[4];
#pragma unroll
    for (int k = 0; k < 4; ++k) { const int pc = 4 * lw + k;
        src[k] = pc < 8 ? (const char*)(cb.PT + (size_t)(bh * NC) * 4096) + pc * 1024 + lane * 16 : (const char*)(cb.Z + (size_t)(bh * NC) * 4096) + tj * 4096 + (pc - 8) * 1024 + lane * 16; }
    const size_t st0 = 8192, st1 = 16384;
    int slot = 0;
    for (int c = 0; c < NC; ++c) {
        unsigned spins = 0;
        while ((int)flags[3] < c - SC_NS + 1 && ++spins < (1u << 22)) __builtin_amdgcn_s_sleep(1);
        const unsigned dst = (unsigned)(slot * SC_SLOT + 4 * lw * 1024);
#pragma unroll
        for (int k = 0; k < 4; ++k) { const int pc = 4 * lw + k;
            __builtin_amdgcn_global_load_lds((const unsigned*)(src[k] + (size_t)c * (pc < 8 ? st0 : st1)), (LAS unsigned*)(L + dst + k * 1024), 16, 0, 0); }
        if (c >= SC_LAG) { asm volatile("s_waitcnt vmcnt(24)" ::: "memory"); if (lane == 0) flags[lw] = (unsigned)(c - SC_LAG + 1); }
        slot = slot + 1 == SC_NS ? 0 : slot + 1;
    }
    asm volatile("s_waitcnt vmcnt(0)" ::: "memory");
    if (lane == 0) flags[lw] = (unsigned)NC;
}
constexpr int O_SG = 0  , O_Y = 9216  , O_GT = O_Y + 16640  ;
struct OutRegs { v4u gc4, gp4, vo4; unsigned long long yw[2]; bf16x8 a[2][2], bb[2][2], b2[2][2]; float dot; f32x4 lw0, lw1, lb0, lb1; };
__device__ __forceinline__ void out_load(OutRegs& R, unsigned char* wsb, int layer, int item, int tid, int w) {
    const GAS bf16_t* P = RW_PROJ;
    const int lane = tid & 63, fr = lane & 15, fq = lane >> 4;
    const int bh = item / (SEQ / 64), chunk = item % (SEQ / 64), b = bh / 6, h = bh % 6; const int tok0 = b * SEQ + chunk * 64; const size_t ib = (size_t)item * 4096;
    const int t = tid >> 3, sub = tid & 7, tok = tok0 + t; const bool hp = (chunk * 64 + t) > 0;
    const GAS bf16_t* rc = P + (size_t)tok * LDP + 1856 + 8 * sub; const v4u z4 = {0u, 0u, 0u, 0u};
    R.gc4 = *(const GAS v4u*)rc; R.gp4 = hp ? *(const GAS v4u*)(rc - LDP) : z4;
#pragma unroll
    for (int e = 0; e < 2; ++e) { const int tl = 2 * w + e, ti = tl >> 2, tj = tl & 3;
        R.yw[e] = *(const GAS unsigned long long*)(RW_YV + ib + (16 * tj + fr) * 64 + 16 * ti + 4 * fq);
#pragma unroll
        for (int kk = 0; kk < 2; ++kk) { R.a[e][kk] = *(const GAS bf16x8*)(RW_G + ib + (16 * ti + fr) * 64 + 32 * kk + 8 * fq); R.bb[e][kk] = *(const GAS bf16x8*)(RW_S0 + ib + (16 * tj + fr) * 64 + 32 * kk + 8 * fq);
            R.b2[e][kk] = *(const GAS bf16x8*)(RW_LORA(mk::SM_G2T) + (size_t)(64 * h + 16 * tj + fr) * 64 + 32 * kk + 8 * fq); } }
    R.dot = RW_DOT[(size_t)tok * 6 + h]; R.vo4 = *(const GAS v4u*)(RW_VF + (size_t)tok * 384 + 64 * h + 8 * sub);
    R.lw0 = *(const GAS f32x4*)(RWP(mk::RP_LNW) + 64 * h + 8 * sub); R.lw1 = *(const GAS f32x4*)(RWP(mk::RP_LNW) + 64 * h + 8 * sub + 4); R.lb0 = *(const GAS f32x4*)(RWP(mk::RP_LNB) + 64 * h + 8 * sub); R.lb1 = *(const GAS f32x4*)(RWP(mk::RP_LNB) + 64 * h + 8 * sub + 4);
}
__device__ __forceinline__ void out_phase(LAS unsigned char* L, unsigned char* wsb, int layer, int tid_in, int first, int stride) {
    GAS bf16_t* MIX = RW_MIX;
    const int w = __builtin_amdgcn_readfirstlane(tid_in >> 6);
    LAS bf16_t* SG = (LAS bf16_t*)(L + O_SG); LAS float* Y = (LAS float*)(L + O_Y); LAS float* GT = (LAS float*)(L + O_GT);
    OutRegs R; if (first < NITEMS) { RW_LANES(); out_load(R, wsb, layer, first, tid, w); }
    for (int item = first; item < NITEMS; item += stride) {
        const int bh = item / (SEQ / 64), chunk = item % (SEQ / 64), b = bh / 6, h = bh % 6; const int tok0 = b * SEQ + chunk * 64;
        OutRegs N = R; if (item + stride < NITEMS) { RW_LANES(); out_load(N, wsb, layer, item + stride, tid, w); }
        { RW_LANES(); const int t = tid >> 3, sub = tid & 7;
          const f32x4 m0 = *(const GAS f32x4*)(RWP(mk::RP_MU) + 1216 + 8 * sub), m1 = *(const GAS f32x4*)(RWP(mk::RP_MU) + 1220 + 8 * sub);
          const unsigned cw_[4] = {R.gc4.x, R.gc4.y, R.gc4.z, R.gc4.w}, pw_[4] = {R.gp4.x, R.gp4.y, R.gp4.z, R.gp4.w}; unsigned o[4];
#pragma unroll
          for (int e2 = 0; e2 < 4; ++e2) { float x[2];
#pragma unroll
              for (int u = 0; u < 2; ++u) { const int e = 2 * e2 + u; const float c1 = bf2f((bf16_t)((cw_[e2] >> (16 * u)) & 0xffff)), p1 = bf2f((bf16_t)((pw_[e2] >> (16 * u)) & 0xffff));
                  x[u] = fsigm(c1 + (e < 4 ? m0[e & 3] : m1[e & 3]) * (p1 - c1)); }
              o[e2] = pk2(x[0], x[1]); }
          *(LAS v4u*)(SG + t * LD + 8 * sub) = (v4u){o[0], o[1], o[2], o[3]}; }
        RW_BAR();
        { RW_LANES();
#pragma unroll
        for (int e = 0; e < 2; ++e) { const int tl = 2 * w + e, ti = tl >> 2, tj = tl & 3; const unsigned long long yw = R.yw[e];
            f32x4 d = {bf2f((bf16_t)(yw & 0xffff)), bf2f((bf16_t)((yw >> 16) & 0xffff)), bf2f((bf16_t)((yw >> 32) & 0xffff)), bf2f((bf16_t)(yw >> 48))}; f32x4 g = {0.f, 0.f, 0.f, 0.f};
#pragma unroll
            for (int kk = 0; kk < 2; ++kk) {
                d = __builtin_amdgcn_mfma_f32_16x16x32_bf16(R.a[e][kk], R.bb[e][kk], d, 0, 0, 0);
                const bf16x8 a2 = *(const LAS bf16x8*)(SG + (16 * ti + fr) * LD + 32 * kk + 8 * fq);
                g = __builtin_amdgcn_mfma_f32_16x16x32_bf16(a2, R.b2[e][kk], g, 0, 0, 0); }
#pragma unroll
            for (int r = 0; r < 4; ++r) { Y[(16 * ti + 4 * fq + r) * 65 + 16 * tj + fr] = d[r]; GT[(16 * ti + 4 * fq + r) * 65 + 16 * tj + fr] = g[r]; } } }
        RW_BAR();
        { RW_LANES(); const int t = tid >> 3, sub = tid & 7, tok = tok0 + t; float yv[8], s = 0.f;
#pragma unroll
          for (int e = 0; e < 8; ++e) { yv[e] = Y[t * 65 + 8 * sub + e]; s += yv[e]; }
          s += __shfl_xor(s, 1); s += __shfl_xor(s, 2); s += __shfl_xor(s, 4);
          const float mean = s * (1.0f / 64.0f); float q = 0.f;
#pragma unroll
          for (int e = 0; e < 8; ++e) { const float dd = yv[e] - mean; q += dd * dd; }
          q += __shfl_xor(q, 1); q += __shfl_xor(q, 2); q += __shfl_xor(q, 4);
          const float rstd = __builtin_amdgcn_rsqf(q * (1.0f / 64.0f) + GN_EPS), dot = R.dot;
          const unsigned vw[4] = {R.vo4.x, R.vo4.y, R.vo4.z, R.vo4.w}; unsigned o[4];
#pragma unroll
          for (int e = 0; e < 8; e += 2) { float r2[2];
#pragma unroll
              for (int u = 0; u < 2; ++u) { const int ee = e + u; const float lw = ee < 4 ? R.lw0[ee & 3] : R.lw1[ee & 3], lb = ee < 4 ? R.lb0[ee & 3] : R.lb1[ee & 3];
                  const float yn = (yv[ee] - mean) * rstd * lw + lb; const float vv = bf2f((bf16_t)((vw[ee >> 1] >> (16 * (ee & 1))) & 0xffff));
                  r2[u] = (yn + dot * vv) * GT[t * 65 + 8 * sub + ee]; }
              o[e >> 1] = pk2(r2[0], r2[1]); }
          *(GAS v4u*)(MIX + (size_t)tok * DM + 384 + 64 * h + 8 * sub) = (v4u){o[0], o[1], o[2], o[3]}; }
        RW_BAR();
        R = N;
    }
}
}
namespace at {
constexpr int LDK = 72, LDV = 264;
constexpr int A_K = 0, A_V = 256 * LDK * 2  , A_BIAS = A_V + 64 * LDV * 2  , LDB = 256, BOFF = 48, A_END = A_BIAS + 6 * LDB * 4;
__device__ __forceinline__ int vpos(int key) { return (key & ~31) + 8 * ((key >> 2) & 3) + 4 * ((key >> 4) & 1) + (key & 3); }
__device__ __forceinline__ unsigned pk2(float lo, float hi) { typedef float f2_t __attribute__((ext_vector_type(2))); typedef __bf16 b2_t __attribute__((ext_vector_type(2))); f2_t v = {lo, hi}; return __builtin_bit_cast(unsigned, __builtin_convertvector(v, b2_t)); }
#define AT_BAR() do { asm volatile("s_waitcnt vmcnt(0) lgkmcnt(0)" ::: "memory"); __builtin_amdgcn_s_barrier(); asm volatile("" ::: "memory"); } while (0)

struct StageRegs { v4u k[4], v[4]; };
__device__ __forceinline__ void stage_issue(StageRegs& R, int tid, const bf16_t* kbase, const bf16_t* vbase, long pitch, int jvalid0) {
    const v4u z4 = {0u, 0u, 0u, 0u};
#pragma unroll
    for (int it = 0; it < 4; ++it) { const int idx = it * 512 + tid, key = idx >> 3, ch = idx & 7; R.k[it] = key >= jvalid0 ? *(const GAS v4u*)(kbase + (long)key * pitch + 8 * ch) : z4; }
#pragma unroll
    for (int it = 0; it < 4; ++it) { const int idx = it * 512 + tid, key = idx & 255, ch = idx >> 8; R.v[it] = key >= jvalid0 ? *(const GAS v4u*)(vbase + (long)key * pitch + 8 * ch) : z4; }
}
__device__ __forceinline__ void stage_commit(LAS unsigned char* L, const StageRegs& R, int tid, const float* gk) {
    LAS bf16_t* Kl = (LAS bf16_t*)(L + A_K); LAS bf16_t* VTl = (LAS bf16_t*)(L + A_V);
#pragma unroll
    for (int it = 0; it < 4; ++it) { const int idx = it * 512 + tid, key = idx >> 3, ch = idx & 7; const v4u raw = R.k[it];
        float f[8]; f[0] = __builtin_bit_cast(float, raw.x << 16); f[1] = __builtin_bit_cast(float, raw.x & 0xffff0000u); f[2] = __builtin_bit_cast(float, raw.y << 16); f[3] = __builtin_bit_cast(float, raw.y & 0xffff0000u);
        f[4] = __builtin_bit_cast(float, raw.z << 16); f[5] = __builtin_bit_cast(float, raw.z & 0xffff0000u); f[6] = __builtin_bit_cast(float, raw.w << 16); f[7] = __builtin_bit_cast(float, raw.w & 0xffff0000u);
        float ss = 0.f;
#pragma unroll
        for (int e = 0; e < 8; ++e) ss += f[e] * f[e];
        ss += __shfl_xor(ss, 1); ss += __shfl_xor(ss, 2); ss += __shfl_xor(ss, 4);
        const float rs = __builtin_amdgcn_rsqf(ss * (1.0f / 64.0f) + EPS);
        const f32x4 g0 = *(const GAS f32x4*)(gk + 8 * ch), g1 = *(const GAS f32x4*)(gk + 8 * ch + 4);
        v4u o; o.x = pk2(f[0] * rs * g0[0], f[1] * rs * g0[1]); o.y = pk2(f[2] * rs * g0[2], f[3] * rs * g0[3]); o.z = pk2(f[4] * rs * g1[0], f[5] * rs * g1[1]); o.w = pk2(f[6] * rs * g1[2], f[7] * rs * g1[3]);
        *(LAS v4u*)(Kl + key * LDK + 8 * ch) = o; }
#pragma unroll
    for (int it = 0; it < 4; ++it) { const int idx = it * 512 + tid, key = idx & 255, ch = idx >> 8; const v4u raw = R.v[it];
        LAS bf16_t* d = VTl + (8 * ch) * LDV + vpos(key);
        d[0 * LDV] = (bf16_t)(raw.x & 0xffff); d[1 * LDV] = (bf16_t)(raw.x >> 16); d[2 * LDV] = (bf16_t)(raw.y & 0xffff); d[3 * LDV] = (bf16_t)(raw.y >> 16);
        d[4 * LDV] = (bf16_t)(raw.z & 0xffff); d[5 * LDV] = (bf16_t)(raw.z >> 16); d[6 * LDV] = (bf16_t)(raw.w & 0xffff); d[7 * LDV] = (bf16_t)(raw.w >> 16); }
}
struct QRaw { v4u r0, r1; };
__device__ __forceinline__ QRaw q_raw(const bf16_t* qrow, int fq) { QRaw q; q.r0 = *(const GAS v4u*)(qrow + 8 * fq); q.r1 = *(const GAS v4u*)(qrow + 32 + 8 * fq); return q; }
__device__ __forceinline__ void q_finish(const QRaw qr, const float* gq, int fq, bf16x8& q0, bf16x8& q1) {
    float f[16]; const unsigned w[8] = {qr.r0.x, qr.r0.y, qr.r0.z, qr.r0.w, qr.r1.x, qr.r1.y, qr.r1.z, qr.r1.w};
#pragma unroll
    for (int e = 0; e < 8; ++e) { f[2 * e] = __builtin_bit_cast(float, w[e] << 16); f[2 * e + 1] = __builtin_bit_cast(float, w[e] & 0xffff0000u); }
    float ss = 0.f;
#pragma unroll
    for (int e = 0; e < 16; ++e) ss += f[e] * f[e];
    ss += __shfl_xor(ss, 16); ss += __shfl_xor(ss, 32);
    const float rs = 0.125f * __builtin_amdgcn_rsqf(ss * (1.0f / 64.0f) + EPS);
    const f32x4 g0 = *(const GAS f32x4*)(gq + 8 * fq), g1 = *(const GAS f32x4*)(gq + 8 * fq + 4), g2 = *(const GAS f32x4*)(gq + 32 + 8 * fq), g3 = *(const GAS f32x4*)(gq + 36 + 8 * fq);
    v4u a, b;
    a.x = pk2(f[0] * rs * g0[0], f[1] * rs * g0[1]); a.y = pk2(f[2] * rs * g0[2], f[3] * rs * g0[3]); a.z = pk2(f[4] * rs * g1[0], f[5] * rs * g1[1]); a.w = pk2(f[6] * rs * g1[2], f[7] * rs * g1[3]);
    b.x = pk2(f[8] * rs * g2[0], f[9] * rs * g2[1]); b.y = pk2(f[10] * rs * g2[2], f[11] * rs * g2[3]); b.z = pk2(f[12] * rs * g3[0], f[13] * rs * g3[1]); b.w = pk2(f[14] * rs * g3[2], f[15] * rs * g3[3]);
    q0 = __builtin_bit_cast(bf16x8, a); q1 = __builtin_bit_cast(bf16x8, b);
}
template <int NT, bool SWA> __device__ __forceinline__ void attn_wave(const LAS unsigned char* L, bf16x8 q0, bf16x8 q1, int kt0, int qi0, int hq, float sink, bool first_block, bf16_t* outp, int fr, int fq) {
    const LAS bf16_t* Kl = (const LAS bf16_t*)(L + A_K); const LAS bf16_t* VTl = (const LAS bf16_t*)(L + A_V); const LAS float* bias = (const LAS float*)(L + A_BIAS);
    f32x4 s[NT];
#pragma unroll
    for (int t = 0; t < NT; ++t) { const LAS bf16_t* kr = Kl + (16 * (kt0 + t) + fr) * LDK + 8 * fq;
        const f32x4 z = {0.f, 0.f, 0.f, 0.f};
        s[t] = __builtin_amdgcn_mfma_f32_16x16x32_bf16(*(const LAS bf16x8*)kr, q0, z, 0, 0, 0);
        s[t] = __builtin_amdgcn_mfma_f32_16x16x32_bf16(*(const LAS bf16x8*)(kr + 32), q1, s[t], 0, 0, 0);
        if (t & 1) __builtin_amdgcn_sched_barrier(0); }
    float mx = SWA ? sink : -3.0e38f;
    if (SWA) {
        const int odd = (qi0 >> 4) & 1; const int D0 = qi0 + fr + 128 - 16 * kt0 - 4 * fq;
        const LAS float* bp = bias + hq * LDB + BOFF + D0 - 147;
#pragma unroll
        for (int t = 0; t < NT; ++t) { const int c = t - odd;
            if (c >= 1 && c <= 7 && !first_block) {
#pragma unroll
                for (int r = 0; r < 4; ++r) { s[t][r] += bp[147 - 16 * t - r]; mx = fmaxf(mx, s[t][r]); }
            } else {
#pragma unroll
                for (int r = 0; r < 4; ++r) { const int dist = D0 - 16 * t - r; const bool valid = (unsigned)dist < 128u && !(first_block && 16 * (kt0 + t) + 4 * fq + r < 128);
                    s[t][r] = valid ? s[t][r] + bp[147 - 16 * t - r] : -3.0e38f; mx = fmaxf(mx, s[t][r]); } } }
    } else {
#pragma unroll
        for (int t = 0; t < NT; ++t)
#pragma unroll
            for (int r = 0; r < 4; ++r) mx = fmaxf(mx, s[t][r]);
    }
    mx = fmaxf(mx, __shfl_xor(mx, 16)); mx = fmaxf(mx, __shfl_xor(mx, 32));
    float l = 0.f;
#pragma unroll
    for (int t = 0; t < NT; ++t)
#pragma unroll
        for (int r = 0; r < 4; ++r) { const float p = __expf(s[t][r] - mx); s[t][r] = p; l += p; }
    l += __shfl_xor(l, 16); l += __shfl_xor(l, 32);
    if (SWA) l += __expf(sink - mx);
    f32x4 o[4];
#pragma unroll
    for (int dt = 0; dt < 4; ++dt) o[dt] = (f32x4){0.f, 0.f, 0.f, 0.f};
#pragma unroll
    for (int ks = 0; ks < NT / 2; ++ks) { v4u pw; pw.x = pk2(s[2 * ks][0], s[2 * ks][1]); pw.y = pk2(s[2 * ks][2], s[2 * ks][3]); pw.z = pk2(s[2 * ks + 1][0], s[2 * ks + 1][1]); pw.w = pk2(s[2 * ks + 1][2], s[2 * ks + 1][3]);
        const bf16x8 pb = __builtin_bit_cast(bf16x8, pw);
#pragma unroll
        for (int dt = 0; dt < 4; ++dt) o[dt] = __builtin_amdgcn_mfma_f32_16x16x32_bf16(*(const LAS bf16x8*)(VTl + (16 * dt + fr) * LDV + 32 * (kt0 / 2 + ks) + 8 * fq), pb, o[dt], 0, 0, 0);
        __builtin_amdgcn_sched_barrier(0); }
    const float inv = __builtin_amdgcn_rcpf(l);
#pragma unroll
    for (int dt = 0; dt < 4; ++dt) *(GAS unsigned long long*)(outp + (long)fr * DM + 16 * dt + 4 * fq) = (unsigned long long)pk2(o[dt][0] * inv, o[dt][1] * inv) | ((unsigned long long)pk2(o[dt][2] * inv, o[dt][3] * inv) << 32);
}
__device__ __forceinline__ void swa_wave3(const LAS unsigned char* L, const bf16x8 (&q0)[3], const bf16x8 (&q1)[3], int kt0, int qi0, int hq0, const float (&sink)[3], bool first_block, bf16_t* outp, int fr, int fq) {
    constexpr int NT = 10;
    const LAS bf16_t* Kl = (const LAS bf16_t*)(L + A_K); const LAS bf16_t* VTl = (const LAS bf16_t*)(L + A_V); const LAS float* bias = (const LAS float*)(L + A_BIAS);
    f32x4 s[3][NT];
#pragma unroll
    for (int t = 0; t < NT; ++t) { const LAS bf16_t* kr = Kl + (16 * (kt0 + t) + fr) * LDK + 8 * fq; const bf16x8 k0 = *(const LAS bf16x8*)kr, k1 = *(const LAS bf16x8*)(kr + 32);
        const f32x4 z = {0.f, 0.f, 0.f, 0.f};
#pragma unroll
        for (int g = 0; g < 3; ++g) { s[g][t] = __builtin_amdgcn_mfma_f32_16x16x32_bf16(k0, q0[g], z, 0, 0, 0); s[g][t] = __builtin_amdgcn_mfma_f32_16x16x32_bf16(k1, q1[g], s[g][t], 0, 0, 0); }
        if (t & 1) __builtin_amdgcn_sched_barrier(0); }
    const int odd = (qi0 >> 4) & 1; const int D0 = qi0 + fr + 128 - 16 * kt0 - 4 * fq;
    float inv[3];
#pragma unroll
    for (int g = 0; g < 3; ++g) { const LAS float* bp = bias + (hq0 + g) * LDB + BOFF + D0 - 147; float mx = sink[g];
#pragma unroll
        for (int t = 0; t < NT; ++t) { const int c = t - odd;
            if (c >= 1 && c <= 7 && !first_block) {
#pragma unroll
                for (int r = 0; r < 4; ++r) { s[g][t][r] += bp[147 - 16 * t - r]; mx = fmaxf(mx, s[g][t][r]); }
            } else {
#pragma unroll
                for (int r = 0; r < 4; ++r) { const int dist = D0 - 16 * t - r; const bool valid = (unsigned)dist < 128u && !(first_block && 16 * (kt0 + t) + 4 * fq + r < 128);
                    s[g][t][r] = valid ? s[g][t][r] + bp[147 - 16 * t - r] : -3.0e38f; mx = fmaxf(mx, s[g][t][r]); } } }
        mx = fmaxf(mx, __shfl_xor(mx, 16)); mx = fmaxf(mx, __shfl_xor(mx, 32));
        float l = 0.f;
#pragma unroll
        for (int t = 0; t < NT; ++t)
#pragma unroll
            for (int r = 0; r < 4; ++r) { const float p = __expf(s[g][t][r] - mx); s[g][t][r] = p; l += p; }
        l += __shfl_xor(l, 16); l += __shfl_xor(l, 32); l += __expf(sink[g] - mx);
        inv[g] = __builtin_amdgcn_rcpf(l); }
    f32x4 o[3][4];
#pragma unroll
    for (int g = 0; g < 3; ++g)
#pragma unroll
        for (int dt = 0; dt < 4; ++dt) o[g][dt] = (f32x4){0.f, 0.f, 0.f, 0.f};
#pragma unroll
    for (int ks = 0; ks < NT / 2; ++ks) { bf16x8 pb[3];
#pragma unroll
        for (int g = 0; g < 3; ++g) { v4u pw; pw.x = pk2(s[g][2 * ks][0], s[g][2 * ks][1]); pw.y = pk2(s[g][2 * ks][2], s[g][2 * ks][3]); pw.z = pk2(s[g][2 * ks + 1][0], s[g][2 * ks + 1][1]); pw.w = pk2(s[g][2 * ks + 1][2], s[g][2 * ks + 1][3]); pb[g] = __builtin_bit_cast(bf16x8, pw); }
#pragma unroll
        for (int dt = 0; dt < 4; ++dt) { const bf16x8 vf = *(const LAS bf16x8*)(VTl + (16 * dt + fr) * LDV + 32 * (kt0 / 2 + ks) + 8 * fq);
#pragma unroll
            for (int g = 0; g < 3; ++g) o[g][dt] = __builtin_amdgcn_mfma_f32_16x16x32_bf16(vf, pb[g], o[g][dt], 0, 0, 0); }
        __builtin_amdgcn_sched_barrier(0); }
#pragma unroll
    for (int g = 0; g < 3; ++g)
#pragma unroll
        for (int dt = 0; dt < 4; ++dt) *(GAS unsigned long long*)(outp + (long)fr * DM + 64 * g + 16 * dt + 4 * fq) = (unsigned long long)pk2(o[g][dt][0] * inv[g], o[g][dt][1] * inv[g]) | ((unsigned long long)pk2(o[g][dt][2] * inv[g], o[g][dt][3] * inv[g]) << 32);
}
struct AttnArgs { const bf16_t* PROJ; const bf16_t* MKV; bf16_t* MIX; const float* biastab; const float *sinks, *gq, *gk, *gmq, *gmk; };
__device__ __forceinline__ void item_stage_issue(StageRegs& R, const AttnArgs A, int q, int tid) {
    if (q >= 256) { const int item = q - 256, b = item >> 7, hkv = (item >> 6) & 1, blk = item & 63; const long tokb = (long)b * SEQ + blk * 128;
        stage_issue(R, tid, A.PROJ + (tokb - 128) * LDP + 384 + 64 * hkv, A.PROJ + (tokb - 128) * LDP + 512 + 64 * hkv, LDP, blk == 0 ? 128 : 0); }
    else { const int b = q >> 7, h = (q >> 5) & 3; stage_issue(R, tid, A.MKV + (long)(b * 256) * 512 + 64 * h, A.MKV + (long)(b * 256) * 512 + 256 + 64 * h, 512, 0); }
}
__device__ __forceinline__ void attn_phase(LAS unsigned char* L, const AttnArgs A, unsigned* qctr, volatile LAS unsigned* qw, int tid_in) {
    const int w = __builtin_amdgcn_readfirstlane(tid_in >> 6);
    { int lt_ = tid_in; asm volatile("" : "+v"(lt_)); const int tid = lt_;
      LAS float* bl = (LAS float*)(L + A_BIAS); for (int i = tid; i < 6 * LDB; i += 512) { const int hh = i / LDB, d = i % LDB - BOFF; bl[i] = (d >= 0 && d < 128) ? A.biastab[d * 6 + hh] : 0.f; } }
    if (tid_in == 0) qw[0] = atomicAdd(qctr, 1u);
    AT_BAR(); int q = (int)qw[0]; AT_BAR();
    StageRegs SR; if (q < 512) { int lt_ = tid_in; asm volatile("" : "+v"(lt_)); item_stage_issue(SR, A, q, lt_); }
    while (q < 512) {
        int lt_ = tid_in; asm volatile("" : "+v"(lt_)); const int tid = lt_, lane = lt_ & 63, fr = lane & 15, fq = lane >> 4;
        const bool swa = q >= 256;
        stage_commit(L, SR, tid, swa ? A.gk : A.gmk);
        QRaw qa, qb, qc; int b, hh, blk;
        if (swa) { const int item = q - 256; b = item >> 7; hh = (item >> 6) & 1; blk = item & 63; const bf16_t* qp = A.PROJ + ((long)b * SEQ + blk * 128 + 16 * w + fr) * LDP + 192 * hh;
            qa = q_raw(qp, fq); qb = q_raw(qp + 64, fq); qc = q_raw(qp + 128, fq); }
        else { b = q >> 7; hh = (q >> 5) & 3; blk = q & 31; const bf16_t* qp = A.PROJ + ((long)b * SEQ + (2 * blk) * 128 + 16 * w + fr) * LDP + 1984 + 64 * hh;
            qa = q_raw(qp, fq); qb = q_raw(qp + (long)128 * LDP, fq); qc = qb; }
        if (tid_in == 0) qw[0] = atomicAdd(qctr, 1u);
        AT_BAR(); const int qn = (int)qw[0];
        if (qn < 512) item_stage_issue(SR, A, qn, tid);
        if (swa) { const long tokb = (long)b * SEQ + blk * 128; bf16x8 q0[3], q1[3];
            q_finish(qa, A.gq, fq, q0[0], q1[0]); q_finish(qb, A.gq, fq, q0[1], q1[1]); q_finish(qc, A.gq, fq, q0[2], q1[2]);
            const float sk3[3] = {A.sinks[3 * hh], A.sinks[3 * hh + 1], A.sinks[3 * hh + 2]};
            swa_wave3(L, q0, q1, w & ~1, 16 * w, 3 * hh, sk3, blk == 0, A.MIX + (tokb + 16 * w) * DM + 192 * hh, fr, fq); }
        else {
#pragma unroll 1
            for (int u = 0; u < 2; ++u) { const long tokb = (long)b * SEQ + (2 * blk + u) * 128; bf16x8 q0, q1; const QRaw cq = u == 0 ? qa : qb; q_finish(cq, A.gmq, fq, q0, q1);
                attn_wave<16, false>(L, q0, q1, 0, 16 * w, 0, 0.f, false, A.MIX + (tokb + 16 * w) * DM + 768 + 64 * hh, fr, fq); } }
        AT_BAR();
        q = qn;
    }
}
}
constexpr int NWAVES = 8;
namespace mk {
#ifndef PROF_PH
#define PROF_PH -1
#endif
#ifndef PROF_N
#define PROF_N 1
#endif
#ifndef PROF_TA
#define PROF_TA -1
#endif
#ifndef PROF_TB
#define PROF_TB -1
#endif
#define REPEAT(k) for (int rep_ = 0; rep_ < ((PROF_PH) == (k) ? (PROF_N) : 1); ++rep_)
#ifndef FAST_RWKV
#define FAST_RWKV 1
#endif
#ifndef FAST_ATTN
#define FAST_ATTN 1
#endif

struct Args { const float* in[N_IN]; float* out; unsigned char* ws; int ph_lo, ph_hi; };

__device__ __forceinline__ unsigned pk2(float lo, float hi) { typedef float f2_t __attribute__((ext_vector_type(2))); typedef __bf16 b2_t __attribute__((ext_vector_type(2))); f2_t v = {lo, hi}; return __builtin_bit_cast(unsigned, __builtin_convertvector(v, b2_t)); }
__device__ __forceinline__ float wave_sum(float v) {
#pragma unroll
    for (int o = 1; o < 64; o <<= 1) v += __shfl_xor(v, o);
    return v;
}
template <int MODE> __device__ __forceinline__ void transpose_item(const float* W, const float* g, int K, int N, bf16_t* WT, LAS float* scr, int item, int lane) {
    const int nblk = N / 32, kb = item / nblk, nb = item % nblk, k0 = 64 * kb, n0 = 32 * nb;
    float tv[32];
#pragma unroll
    for (int i = 0; i < 32; ++i) tv[i] = W[(size_t)(k0 + 2 * i + (lane >> 5)) * N + n0 + (lane & 31)];
#pragma unroll
    for (int i = 0; i < 32; ++i) { const int kk = 2 * i + (lane >> 5); float v = tv[i]; if (g) v *= g[k0 + kk]; scr[kk * 33 + (lane & 31)] = v; }
    LDS_WAIT(); asm volatile("" ::: "memory");
    const int c = lane & 7;
#pragma unroll
    for (int j = 0; j < 4; ++j) { const int n = (lane >> 3) + 8 * j; const LAS float* s = scr + (8 * c) * 33 + n;
        v4u o; o.x = pk2(s[0 * 33], s[1 * 33]); o.y = pk2(s[2 * 33], s[3 * 33]); o.z = pk2(s[4 * 33], s[5 * 33]); o.w = pk2(s[6 * 33], s[7 * 33]);
        int nr = n0 + n; if (MODE == 2) nr = nr < 1920 ? nr : nr + 64;
        if (MODE == 1) nr = nr < 2816 ? 256 * (nr >> 7) + (nr & 127) : 256 * ((nr - 2816) >> 7) + 128 + ((nr - 2816) & 127);
        *(GAS v4u*)(WT + (size_t)nr * K + k0 + 8 * c) = o; }
    LDS_WAIT(); asm volatile("" ::: "memory");
}
template <int R> __device__ __forceinline__ void rows_to_bf16(const float* x, bf16_t* o, float* ssq, long row0, long rstride, int lane) {
    f32x4 v[R][4]; float s[R];
#pragma unroll
    for (int r = 0; r < R; ++r) { const GAS f32x4* xr = (const GAS f32x4*)(x + (row0 + r * rstride) * DM) + lane;
#pragma unroll
        for (int j = 0; j < 4; ++j) v[r][j] = xr[64 * j]; }
#pragma unroll
    for (int r = 0; r < R; ++r) { s[r] = 0.f;
#pragma unroll
        for (int j = 0; j < 4; ++j) s[r] += (v[r][j].x * v[r][j].x + v[r][j].y * v[r][j].y) + (v[r][j].z * v[r][j].z + v[r][j].w * v[r][j].w); }
#pragma unroll
    for (int o2 = 1; o2 < 64; o2 <<= 1) {
#pragma unroll
        for (int r = 0; r < R; ++r) s[r] += __shfl_xor(s[r], o2); }
#pragma unroll
    for (int r = 0; r < R; ++r) { GAS unsigned long long* o8 = (GAS unsigned long long*)(o + (row0 + r * rstride) * DM) + lane;
#pragma unroll
        for (int j = 0; j < 4; ++j) o8[64 * j] = (unsigned long long)pk2(v[r][j].x, v[r][j].y) | ((unsigned long long)pk2(v[r][j].z, v[r][j].w) << 32);
        if (lane == 0) ssq[row0 + r * rstride] = s[r]; }
}
__device__ __forceinline__ void row_to_bf16(const float* xrow, bf16_t* orow, float* ssq_out, int lane) {
    const GAS f32x4* xr = (const GAS f32x4*)xrow + lane; f32x4 v[4]; float s = 0.f;
#pragma unroll
    for (int j = 0; j < 4; ++j) { v[j] = xr[64 * j]; s += (v[j].x * v[j].x + v[j].y * v[j].y) + (v[j].z * v[j].z + v[j].w * v[j].w); }
    s = wave_sum(s);
    GAS unsigned long long* o8 = (GAS unsigned long long*)orow + lane;
#pragma unroll
    for (int j = 0; j < 4; ++j) o8[64 * j] = (unsigned long long)pk2(v[j].x, v[j].y) | ((unsigned long long)pk2(v[j].z, v[j].w) << 32);
    if (lane == 0) *ssq_out = s;
}

__global__ void __launch_bounds__(NWAVES * 64, 2) mk_fwd(Args args) {
    extern __shared__ __attribute__((aligned(16))) unsigned char lds[];
    LAS unsigned char* L = (LAS unsigned char*)lds;
    volatile LAS unsigned* MISC = (volatile LAS unsigned*)(L + MISC_OFF);
    const int tid0 = threadIdx.x; const int wave0 = __builtin_amdgcn_readfirstlane(tid0 >> 6);
    const int G = gridDim.x;
    unsigned char* ws = args.ws;
    gu32* ctl = (gu32*)(ws + WS_CTL);
    for (int u = tid0; u < (LDS_BYTES - LDSCTL_OFF) / 4; u += NWAVES * 64) ((LAS unsigned*)(L + LDSCTL_OFF))[u] = 0u;
    __syncthreads();
    XcdBarrier bar = xcd_barrier_post((unsigned*)(ctl + CW_BAR), MISC + 8);
    const int lo = args.ph_lo, hi = args.ph_hi;
    int ph = 0;
#define PH_BEGIN if (lo <= ph && ph < hi) { if ((PROF_TA) >= 0 && blockIdx.x == 0 && tid0 == 0) MISC[24 + ph] = (unsigned)__builtin_amdgcn_s_memrealtime(); unsigned char* wsp = args.ws; asm volatile("" : "+s"(wsp)); int tid = wave0 * 64 + (int)__builtin_amdgcn_mbcnt_hi(~0u, __builtin_amdgcn_mbcnt_lo(~0u, 0u)); asm volatile("" : "+v"(tid)); const int lane = tid & 63, wave = __builtin_amdgcn_readfirstlane(tid >> 6); const long gtid = (long)blockIdx.x * (NWAVES * 64) + tid; const int gw = blockIdx.x * NWAVES + wave; LAS float* scr = (LAS float*)(L + wave * 16384); (void)lane; (void)gtid; (void)gw; (void)scr;
#define PH_END   if (ph + 1 < hi) { xcd_barrier(bar); if ((PROF_PH) == 30 && ph == 3) for (int xb_ = 0; xb_ < 10; ++xb_) xcd_barrier(bar); } } ++ph;
    float* out = args.out;
#define SSQ_A ((float*)(wsp + WS_CTL + CTL_SSQ))
#define SSQ_B (SSQ_A + 3 * MTOK)
#define biastab ((float*)(wsp + WS_SMALL + SM_BIAS))
#define ssqm ((float*)(wsp + WS_SMALL + SM_SSQM))
#define MKV ((bf16_t*)(wsp + WS_SMALL + SM_MKV))
#define MEMB ((bf16_t*)(wsp + WS_MEMB))
#define Wt_in ((bf16_t*)(wsp + (l == 0 ? WS_WT + WT_IN : WS_WIN1)))
#define Wt_out ((bf16_t*)(wsp + WS_WT + WT_OUT))
#define Wt_up ((bf16_t*)(wsp + WS_WT + WT_UP))
#define Wt_down ((bf16_t*)(wsp + WS_WT + WT_DOWN))
#define Wt_mkv ((bf16_t*)(wsp + (l == 0 ? WS_WT + WT_MKV : WS_WIN1 + 4718592)))
#define XB ((bf16_t*)(wsp + WS_XB))
#define VF ((bf16_t*)(wsp + WS_VF))
#define PROJ ((bf16_t*)(wsp + WS_PROJ))
#define MIX ((bf16_t*)(wsp + WS_MIX))
#define U ((bf16_t*)(wsp + WS_U))
#define ACT ((bf16_t*)(wsp + WS_ACT))
#define PA ((size_t)MTOK * 384)
#define pR ((bf16_t*)(wsp + WS_PREP))
#define pK (pR + PA)
#define pV (pR + 2 * PA)
#define pKK (pR + 3 * PA)
#define pB (pR + 4 * PA)
#define pLD (pR + 5 * PA)
    const long gsize = (long)G * (NWAVES * 64);
    const int NGW = G * NWAVES;

#define MK_W() sk::RwkvW W{args.in[I_MU] + l * 1280, args.in[I_MUV], args.in[I_W0] + l * 384, args.in[I_W2] + l * 32 * 384, args.in[I_A0] + l * 384, args.in[I_A2] + l * 32 * 384, args.in[I_V0], args.in[I_V2], args.in[I_G2] + l * 64 * 384, args.in[I_KK] + l * 384, args.in[I_KA] + l * 384, args.in[I_RK] + l * 384, args.in[I_LNW] + l * 384, args.in[I_LNB] + l * 384};
#define MK_CBUF() const rw::ChunkBufs cbuf{(bf16_t*)(wsp + WS_PT), (bf16_t*)(wsp + WS_G), (float*)(wsp + WS_Z), (bf16_t*)(wsp + WS_YV), (bf16_t*)(wsp + WS_S0), (bf16_t*)(wsp + WS_VF), (float*)(wsp + WS_DOT), (const bf16_t*)(wsp + WS_SMALL + SM_W2T + l * SM_LORA_L), (const bf16_t*)(wsp + WS_SMALL + SM_A2T + l * SM_LORA_L), (const bf16_t*)(wsp + WS_SMALL + SM_V2T + l * SM_LORA_L), (const bf16_t*)(wsp + WS_SMALL + SM_G2T + l * SM_LORA_L)};
    for (int l = 0; l < 2; ++l) {
        const float* xin = l == 0 ? args.in[I_X] : out;
        if (l == 0) {
        PH_BEGIN
            REPEAT(0) {
            const int I_IN = 16 * 68, I_KV = 16 * 16, NIT = 2 * (I_IN + I_KV);
            for (int it = gw; it < NIT; it += NGW) {
                int r = it; const int ll = r >= I_IN + I_KV ? 1 : 0; r -= ll * (I_IN + I_KV);
                bf16_t* win = (bf16_t*)(wsp + (ll == 0 ? WS_WT + WT_IN : WS_WIN1)); bf16_t* wkv = (bf16_t*)(wsp + (ll == 0 ? WS_WT + WT_MKV : WS_WIN1 + 4718592));
                if (r < I_IN) transpose_item<2>(args.in[I_WIN] + (size_t)ll * 1024 * 2176, args.in[I_MIXG] + ll * 1024, 1024, 2176, win, scr, r, lane);
                else transpose_item<0>(args.in[I_WMKV] + (size_t)ll * 1024 * 512, args.in[I_MEMG] + ll * 1024, 1024, 512, wkv, scr, r - I_IN, lane);
            }
            for (long i = gtid; i < 2 * 128 * 1024; i += gsize) { const int ll = (int)(i >> 17), n = (int)(i >> 10) & 127, k = (int)(i & 1023); float v = 0.f;
                if (ll > 0 && n < 16) v = args.in[I_WINV][k * 16 + n] * args.in[I_MIXG][1024 + k];
                ((bf16_t*)(wsp + (ll == 0 ? WS_WT + WT_IN : WS_WIN1)))[(size_t)(n < 64 ? 1920 + n : 2176 + n) * 1024 + k] = f2bf(v); }
            for (long i = gtid; i < 2 * RP_SIZE; i += gsize) { const int ll = (int)(i / RP_SIZE), r = (int)(i % RP_SIZE); float v;
                if (r < RP_MUV) v = args.in[I_MU][ll * 1280 + r]; else if (r < RP_W0) v = args.in[I_MUV][r - RP_MUV]; else if (r < RP_A0) v = args.in[I_W0][ll * 384 + r - RP_W0];
                else if (r < RP_V0) v = args.in[I_A0][ll * 384 + r - RP_A0]; else if (r < RP_KK) v = args.in[I_V0][r - RP_V0]; else if (r < RP_KA) v = args.in[I_KK][ll * 384 + r - RP_KK];
                else if (r < RP_RK) v = args.in[I_KA][ll * 384 + r - RP_KA]; else if (r < RP_LNW) v = args.in[I_RK][ll * 384 + r - RP_RK]; else if (r < RP_LNB) v = args.in[I_LNW][ll * 384 + r - RP_LNW];
                else v = args.in[I_LNB][ll * 384 + r - RP_LNB];
                ((float*)(wsp + WS_SMALL + SM_RWP + ll * RWP_BYTES))[r] = v; }
            for (long i = gtid; i < 2 * 384 * 160; i += gsize) { const int ll = (int)(i / (384 * 160)), r2 = (int)(i % (384 * 160)), hc = r2 / 160, j = r2 % 160; bf16_t* sm = (bf16_t*)(wsp + WS_SMALL + ll * SM_LORA_L);
                if (j < 32) sm[SM_W2T / 2 + hc * 32 + j] = f2bf(args.in[I_W2][(size_t)ll * 32 * 384 + j * 384 + hc]);
                else if (j < 64) sm[SM_A2T / 2 + hc * 32 + (j - 32)] = f2bf(args.in[I_A2][(size_t)ll * 32 * 384 + (j - 32) * 384 + hc]);
                else if (j < 96) sm[SM_V2T / 2 + hc * 32 + (j - 64)] = f2bf((j - 64) < 16 ? args.in[I_V2][(j - 64) * 384 + hc] : 0.f);
                else sm[SM_G2T / 2 + hc * 64 + (j - 96)] = f2bf(args.in[I_G2][(size_t)ll * 64 * 384 + (j - 96) * 384 + hc]); }
            if (MTOK % (4 * NGW) == 0) { for (long m = gw; m < MTOK; m += 4L * NGW) rows_to_bf16<4>(args.in[I_X], XB, SSQ_A, m, NGW, lane); }
            else { for (int m = gw; m < MTOK; m += NGW) row_to_bf16(args.in[I_X] + (size_t)m * DM, XB + (size_t)m * DM, SSQ_A + m, lane); }
            for (int m = gw; m < 512; m += NGW) row_to_bf16(args.in[I_MEM] + (size_t)m * DM, MEMB + (size_t)m * DM, ssqm + m, lane);
            sk::d_biastab(args.in[I_RELB], biastab, gtid, gsize);
            }
        PH_END
        }
        PH_BEGIN
            REPEAT(1)
            { pg8::Gemm g{XB, Wt_in, MTOK, 2048, 1024}; pg8::StaticOrder S; S.init(MTOK, 2048, G, (int)blockIdx.x);
              pg8::EpiScaleBf16 E{PROJ, LDP, SSQ_A + (size_t)l * MTOK};
              pg8::gemm_phase<pg8::EpiScaleBf16, pg8::StaticOrder, true, true>(L, g, S, E, tid); }
        PH_END
        PH_BEGIN
            MK_W(); MK_CBUF(); (void)cbuf;
#if !FAST_ATTN
            sk::d_qknorm(PROJ, MTOK, LDP, args.in[I_AQN] + l * 64, args.in[I_AKN] + l * 64, args.in[I_MQN] + l * 64, 0, gtid, gsize);
            sk::d_qknorm(MKV, 512, 512, nullptr, nullptr, args.in[I_MKN] + l * 64, 1, gtid, gsize);
#endif
#if FAST_RWKV
            {
              const bool t8 = blockIdx.x < 64;
              const pg8::Gemm g = t8 ? pg8::Gemm{XB, Wt_in + (size_t)2048 * 1024, MTOK, 256, 1024} : pg8::Gemm{MEMB, Wt_mkv, 512, 512, 1024};
              pg8::StaticOrder S; if (t8) S.init(MTOK, 256, G, (int)blockIdx.x); else S.init(512, 512, G, (int)((blockIdx.x + 192) % G));
              const pg8::EpiScaleBf16 E = t8 ? pg8::EpiScaleBf16{PROJ + 2048, LDP, SSQ_A + (size_t)l * MTOK} : pg8::EpiScaleBf16{MKV, 512, ssqm};
              pg8::gemm_phase<pg8::EpiScaleBf16, pg8::StaticOrder, true, true>(L, g, S, E, tid); }
            { unsigned* qc = (unsigned*)(ctl + CW_CHQ + 64 * l);
              int q = rw::chunk_phase(L, wsp, l, tid, qc, MISC + 21);
              const int I_OUT = 16 * 32, I_UP = 16 * 176, I_DN = 44 * 32, NIT = I_OUT + I_UP + I_DN;
              for (;;) { const int it = (q - rw::NITEMS) * NWAVES + wave;
                  if ((q - rw::NITEMS) * NWAVES >= NIT) break;
                  if (it < NIT) { int r = it;
                      if (r < I_OUT) transpose_item<0>(args.in[I_WOUT] + (size_t)l * 1024 * 1024, nullptr, 1024, 1024, Wt_out, scr, r, lane);
                      else if (r < I_OUT + I_UP) transpose_item<1>(args.in[I_WUP] + (size_t)l * 1024 * 5632, args.in[I_FFNG] + l * 1024, 1024, 5632, Wt_up, scr, r - I_OUT, lane);
                      else transpose_item<0>(args.in[I_WDOWN] + (size_t)l * 2816 * 1024, nullptr, 2816, 1024, Wt_down, scr, r - I_OUT - I_UP, lane); }
                  __syncthreads(); if (tid == 0) MISC[21] = atomicAdd(qc, 1u); __syncthreads(); q = (int)MISC[21]; __syncthreads(); } }
#else
            sk::d_rwkv_prep(PROJ, W, l, VF, pR, pK, pV, pKK, pB, pLD, gtid, gsize);
#endif
        PH_END
        PH_BEGIN
            MK_CBUF(); (void)cbuf;
            if (blockIdx.x < 48) {
#if FAST_RWKV
                REPEAT(3) { __syncthreads(); if (tid < 8) MISC[16 + tid] = 0u; __syncthreads();
                  const int sbh = (int)blockIdx.x >> 2, stj = (int)blockIdx.x & 3;
                  if (wave == 0) rw::scan_compute(L, cbuf, sbh, stj, lane, MISC + 16); else if (wave < 4) rw::scan_loader(L, cbuf, sbh, stj, wave - 1, lane, MISC + 16);
 }
#endif
            } else {
#if FAST_ATTN
                const at::AttnArgs A{PROJ, MKV, MIX, biastab, args.in[I_SINK] + l * 6, args.in[I_AQN] + l * 64, args.in[I_AKN] + l * 64, args.in[I_MQN] + l * 64, args.in[I_MKN] + l * 64};
                at::attn_phase(L, A, (unsigned*)(ctl + CW_ATTQ + 64 * l), MISC + 20, tid);
#else
                const long gt2 = (long)(blockIdx.x - BATCH * 6) * (NWAVES * 64) + tid, gs2 = (long)(G - BATCH * 6) * (NWAVES * 64);
                REPEAT(7) sk::d_swa(PROJ, MIX, biastab, args.in[I_SINK] + l * 6, gt2, gs2);
                REPEAT(8) sk::d_memattn(PROJ, MKV, MIX, gt2, gs2);
#endif
            }
        PH_END
        PH_BEGIN
            MK_W(); MK_CBUF(); (void)cbuf;
#if FAST_RWKV
            REPEAT(4) rw::out_phase(L, wsp, l, tid, (int)blockIdx.x, G);
#else
            sk::d_rwkv_fin(PROJ, W, pR, pK, pV, MIX, gtid, gsize);
#endif
        PH_END
        PH_BEGIN
            if ((PROF_PH) == 31) { pg8::Gemm g2{MIX, Wt_out, MTOK, 1024, 1024}; pg8::StaticOrder S2; S2.init(MTOK, 1024, G, (int)blockIdx.x); pg8::EpiScaleBf16 E2{PROJ, 1024, SSQ_A}; pg8::gemm_phase<pg8::EpiScaleBf16, pg8::StaticOrder, true, true>(L, g2, S2, E2, tid); }
            pg8::Gemm g{MIX, Wt_out, MTOK, 1024, 1024}; pg8::StaticOrder S; S.init(MTOK, 1024, G, (int)blockIdx.x);
            pg8::EpiResid<false> E{out, XB, SSQ_B + (size_t)l * MTOK, 1024};
            pg8::gemm_phase<pg8::EpiResid<false>, pg8::StaticOrder, true, true>(L, g, S, E, tid);
        PH_END
        PH_BEGIN
            REPEAT(5) {
            pg8::Gemm g{XB, Wt_up, 66 * 256, 5632, 1024}; pg8::StaticOrder S; S.init(66 * 256, 5632, G, (int)blockIdx.x);
            pg8::EpiConvAct E{ACT, SSQ_B + (size_t)l * MTOK, args.in[I_CW] + (size_t)l * 3 * 5632, args.in[I_CB] + (size_t)l * 5632};
            pg8::gemm_phase<pg8::EpiConvAct, pg8::StaticOrder, true, true>(L, g, S, E, tid); }
        PH_END
        PH_BEGIN
            if ((PROF_PH) == 32) { pg8::Gemm g2{ACT, Wt_down, MTOK, 1024, 2816}; pg8::StaticOrder S2; S2.init(MTOK, 1024, G, (int)blockIdx.x); pg8::EpiScaleBf16 E2{PROJ, 1024, SSQ_A}; pg8::gemm_phase<pg8::EpiScaleBf16, pg8::StaticOrder, true, true>(L, g2, S2, E2, tid); }
            pg8::Gemm g{ACT, Wt_down, MTOK, 1024, 2816}; pg8::StaticOrder S; S.init(MTOK, 1024, G, (int)blockIdx.x);
            if (l == 0) { pg8::EpiResid<false> E{out, XB, SSQ_A + (size_t)(l + 1) * MTOK, 1024}; pg8::gemm_phase<pg8::EpiResid<false>, pg8::StaticOrder, true, true>(L, g, S, E, tid); }
            else { pg8::EpiResid<true> E{out, XB, nullptr, 1024}; pg8::gemm_phase<pg8::EpiResid<true>, pg8::StaticOrder, true, true>(L, g, S, E, tid); }
        PH_END
    }
    if ((PROF_TA) >= 0 && blockIdx.x == 0 && tid0 == 0) {
        MISC[24 + ph] = (unsigned)__builtin_amdgcn_s_memrealtime();
        const unsigned ta = MISC[24 + (PROF_TA) + 1] - MISC[24 + (PROF_TA)], tb = (PROF_TB) >= 0 ? MISC[24 + (PROF_TB) + 1] - MISC[24 + (PROF_TB)] : 0u;
        const unsigned long long extra = (unsigned long long)ta + 1000ull * (unsigned long long)(((tb + 50u) / 100u) * 100u);
        const unsigned long long t0 = __builtin_amdgcn_s_memrealtime(); while (__builtin_amdgcn_s_memrealtime() - t0 < extra) __builtin_amdgcn_s_sleep(32);
    }
#undef PH_BEGIN
#undef PH_END
}
constexpr int N_PHASES = 1 + 2 * 7;
}

#ifndef MK_PER_PHASE
#define MK_PER_PHASE 0
#endif
extern "C" void kernel_launch(void* const* d_in, const int* in_sizes, int n_in, void* d_out, int out_size, void* d_ws, size_t ws_size, hipStream_t stream) {
    static int grid = 0;
    if (grid == 0) {
        if (n_in != N_IN || out_size != MTOK * DM || ws_size < mk::WS_END) { fprintf(stderr, "kernel_launch: unexpected shapes (n_in %d out %d ws %zu)\n", n_in, out_size, ws_size); grid = -1; return; }
        int dev = 0, cus = 0, per_cu = 0;
        if (hipGetDevice(&dev) != hipSuccess || hipDeviceGetAttribute(&cus, hipDeviceAttributeMultiprocessorCount, dev) != hipSuccess) { grid = -1; return; }
        if (hipFuncSetAttribute((const void*)mk::mk_fwd, hipFuncAttributeMaxDynamicSharedMemorySize, mk::LDS_BYTES) != hipSuccess) { fprintf(stderr, "kernel_launch: hipFuncSetAttribute failed\n"); grid = -1; return; }
        if (hipOccupancyMaxActiveBlocksPerMultiprocessor(&per_cu, (const void*)mk::mk_fwd, NWAVES * 64, mk::LDS_BYTES) != hipSuccess || per_cu < 1) { fprintf(stderr, "kernel_launch: occupancy query says %d blocks per CU\n", per_cu); }
        (void)hipGetLastError();
        grid = cus;
    }
    if (grid < 0) return;
    if (hipMemsetAsync((char*)d_ws + mk::WS_CTL, 0, mk::CTL_ZERO_BYTES, stream) != hipSuccess) return;
    mk::Args a{};
    for (int i = 0; i < N_IN; ++i) a.in[i] = (const float*)d_in[i];
    a.out = (float*)d_out; a.ws = (unsigned char*)d_ws;
#if MK_PER_PHASE
    for (int p = 0; p < mk::N_PHASES; ++p) { a.ph_lo = p; a.ph_hi = p + 1; hipLaunchKernelGGL(mk::mk_fwd, dim3(grid), dim3(NWAVES * 64), mk::LDS_BYTES, stream, a); }
#else
    a.ph_lo = 0; a.ph_hi = mk::N_PHASES;
    hipLaunchKernelGGL(mk::mk_fwd, dim3(grid), dim3(NWAVES * 64), mk::LDS_BYTES, stream, a);
#endif
}
```

```cpp
#define MK_BUILD 1
#ifndef HOST_SIM
#include <hip/hip_runtime.h>
#include <cstdio>
#include <cstdint>
#endif
#ifndef SEQ_LEN
#define SEQ_LEN 8192
#endif
typedef unsigned short bf16_t;
constexpr int BATCH = 2, SEQ = SEQ_LEN, DM = 1024, MTOK = BATCH * SEQ, DFF = 2816, LDP = 2304  ;
constexpr float EPS = 1e-6f, GN_EPS = 64e-5f;
__host__ __device__ __forceinline__ float bf2f(bf16_t h) { unsigned u = (unsigned)h << 16; return __builtin_bit_cast(float, u); }
__host__ __device__ __forceinline__ bf16_t f2bf(float f) { unsigned u = __builtin_bit_cast(unsigned, f); return (bf16_t)((u + 0x7fffu + ((u >> 16) & 1u)) >> 16); }
__host__ __device__ __forceinline__ int t5_bucket(int dist) {
    if (dist < 16) return dist;
    const float v = logf((float)dist / 16.0f) / 2.0794415416798357f * 16.0f;
    int large = 16 + (int)v; return large < 31 ? large : 31;
}
constexpr size_t MiB = 1u << 20;
enum { I_X = 0, I_MEM, I_RELB, I_MIXG, I_WIN, I_WINV, I_AQN, I_AKN, I_SINK, I_MU, I_MUV, I_W0, I_W2, I_A0, I_A2, I_V0, I_V2, I_G2, I_KK, I_KA, I_RK, I_LNW, I_LNB, I_MEMG, I_WMKV, I_MQN, I_MKN, I_WOUT, I_FFNG, I_WUP, I_CW, I_CB, I_WDOWN, N_IN };
#ifndef PROF_PH
#define PROF_PH -1
#endif
#ifndef PROF_N
#define PROF_N 1
#endif
namespace sk {

__device__ __forceinline__ void d_wt(const float* W, const float* g, bf16_t* Wt, int K, int N, int Npad, long gtid, long gsize) {
    const long total = (long)Npad * K;
    for (long idx = gtid; idx < total; idx += gsize) {
        const int n = (int)(idx / K), k = (int)(idx % K);
        float v = 0.f;
        if (n < N) { v = W[(long)k * N + n]; if (g) v *= g[k]; }
        Wt[idx] = f2bf(v);
    }
}
#ifndef MK_BUILD
__global__ void k_wt(const float* W, const float* g, bf16_t* Wt, int K, int N, int Npad) { d_wt(W, g, Wt, K, N, Npad, (long)blockIdx.x * blockDim.x + threadIdx.x, (long)gridDim.x * blockDim.x); }
#endif
__device__ __forceinline__ void d_rowprep(const float* x, bf16_t* xb, float* ssq, int rows, long gtid, long gsize) {
    for (long r = gtid; r < rows; r += gsize) {
        const float* xr = x + (long)r * DM; bf16_t* o = xb + (long)r * DM; float s = 0.f;
        for (int c = 0; c < DM; ++c) { const float v = xr[c]; s += v * v; o[c] = f2bf(v); }
        ssq[r] = s;
    }
}
#ifndef MK_BUILD
__global__ void k_rowprep(const float* x, bf16_t* xb, float* ssq, int rows) { d_rowprep(x, xb, ssq, rows, (long)blockIdx.x * blockDim.x + threadIdx.x, (long)gridDim.x * blockDim.x); }
#endif
__device__ __forceinline__ void d_biastab(const float* rel_bias, float* tab, long gtid, long gsize) {
        for (long i = gtid; i < 128 * 6; i += gsize) { const int dist = i / 6, hq = i % 6; tab[i] = rel_bias[t5_bucket(dist) * 6 + hq]; }
}
#ifndef MK_BUILD
__global__ void k_biastab(const float* rel_bias, float* tab) { d_biastab(rel_bias, tab, (long)blockIdx.x * blockDim.x + threadIdx.x, (long)gridDim.x * blockDim.x); }
#endif
__device__ __forceinline__ void d_qknorm(bf16_t* P, int rows, int ld, const float* gq, const float* gk, const float* gm, int mode, long gtid, long gsize) {
    const int nj = mode == 0 ? 12 : 4;
    const long total = (long)rows * nj;
    for (long idx = gtid; idx < total; idx += gsize) {
        const int row = (int)(idx / nj), j = (int)(idx % nj);
        int col; const float* g;
        if (mode == 0) { if (j < 6) { col = 64 * j; g = gq; } else if (j < 8) { col = 384 + 64 * (j - 6); g = gk; } else { col = 1920 + 64 * (j - 8); g = gm; } }
        else { col = 64 * j; g = gm; }
        bf16_t* p = P + (long)row * ld + col; float s = 0.f;
        for (int d = 0; d < 64; ++d) { const float v = bf2f(p[d]); s += v * v; }
        const float rs = 1.0f / sqrtf(s * (1.0f / 64.0f) + EPS);
        for (int d = 0; d < 64; ++d) p[d] = f2bf(bf2f(p[d]) * rs * g[d]);
    }
}
#ifndef MK_BUILD
__global__ void k_qknorm(bf16_t* P, int rows, int ld, const float* gq, const float* gk, const float* gm, int mode) { d_qknorm(P, rows, ld, gq, gk, gm, mode, (long)blockIdx.x * blockDim.x + threadIdx.x, (long)gridDim.x * blockDim.x); }
#endif
__device__ __forceinline__ void d_swa(const bf16_t* P, bf16_t* MIX, const float* biastab, const float* sinks, long gtid, long gsize) {
    const long total = (long)MTOK * 6;
    for (long idx = gtid; idx < total; idx += gsize) {
        const int tok = (int)(idx / 6), hq = (int)(idx % 6), hkv = hq / 3, t = tok % SEQ;
        float q[64], o[64];
#pragma unroll
        for (int d = 0; d < 64; ++d) { q[d] = bf2f(P[(long)tok * LDP + 64 * hq + d]) * 0.125f; o[d] = 0.f; }
        float m = sinks[hq], l = 1.0f;
        const int j0 = t - 127 < 0 ? 0 : t - 127;
        for (int j = j0; j <= t; ++j) {
            const bf16_t* kr = P + (long)(tok - (t - j)) * LDP + 384 + 64 * hkv; const bf16_t* vr = kr + 128;
            float s = 0.f;
#pragma unroll
            for (int d = 0; d < 64; ++d) s += q[d] * bf2f(kr[d]);
            s += biastab[(t - j) * 6 + hq];
            const float mn = fmaxf(m, s), f = expf(m - mn), e = expf(s - mn);
            l = l * f + e; m = mn;
#pragma unroll
            for (int d = 0; d < 64; ++d) o[d] = o[d] * f + e * bf2f(vr[d]);
        }
        const float inv = 1.0f / l;
#pragma unroll
        for (int d = 0; d < 64; ++d) MIX[(long)tok * DM + 64 * hq + d] = f2bf(o[d] * inv);
    }
}
#ifndef MK_BUILD
__global__ __launch_bounds__(256) void k_swa(const bf16_t* P, bf16_t* MIX, const float* biastab, const float* sinks) { d_swa(P, MIX, biastab, sinks, (long)blockIdx.x * blockDim.x + threadIdx.x, (long)gridDim.x * blockDim.x); }
#endif
__device__ __forceinline__ void d_memattn(const bf16_t* P, const bf16_t* MKV, bf16_t* MIX, long gtid, long gsize) {
    const long total = (long)MTOK * 4;
    for (long idx = gtid; idx < total; idx += gsize) {
        const int tok = (int)(idx / 4), h = (int)(idx % 4), b = tok / SEQ;
        float q[64], o[64];
#pragma unroll
        for (int d = 0; d < 64; ++d) { q[d] = bf2f(P[(long)tok * LDP + 1920 + 64 * h + d]) * 0.125f; o[d] = 0.f; }
        float m = -1e30f, l = 0.f;
        for (int j = 0; j < 256; ++j) {
            const bf16_t* kr = MKV + (long)(b * 256 + j) * 512 + 64 * h; const bf16_t* vr = kr + 256;
            float s = 0.f;
#pragma unroll
            for (int d = 0; d < 64; ++d) s += q[d] * bf2f(kr[d]);
            const float mn = fmaxf(m, s), f = expf(m - mn), e = expf(s - mn);
            l = l * f + e; m = mn;
#pragma unroll
            for (int d = 0; d < 64; ++d) o[d] = o[d] * f + e * bf2f(vr[d]);
        }
        const float inv = 1.0f / l;
#pragma unroll
        for (int d = 0; d < 64; ++d) MIX[(long)tok * DM + 768 + 64 * h + d] = f2bf(o[d] * inv);
    }
}
#ifndef MK_BUILD
__global__ __launch_bounds__(256) void k_memattn(const bf16_t* P, const bf16_t* MKV, bf16_t* MIX) { d_memattn(P, MKV, MIX, (long)blockIdx.x * blockDim.x + threadIdx.x, (long)gridDim.x * blockDim.x); }
#endif
__device__ __forceinline__ float shifted(const bf16_t* P, int tok, int col, float mu) {
    const float p = bf2f(P[(long)tok * LDP + col]);
    const float prev = (tok % SEQ) == 0 ? 0.f : bf2f(P[(long)(tok - 1) * LDP + col]);
    return p + mu * (prev - p);
}
struct RwkvW { const float *mu, *mu_v, *w0, *w2, *a0, *a2, *v0, *v2, *g2, *k_k, *k_a, *r_k, *ln_w, *ln_b; };
__device__ __forceinline__ void d_rwkv_prep(const bf16_t* P, RwkvW W, int layer, bf16_t* VFIRST, bf16_t* R, bf16_t* K, bf16_t* V, bf16_t* KK, bf16_t* B, bf16_t* LOGD, long gtid, long gsize) {
    const long total = (long)MTOK * 6;
    for (long idx = gtid; idx < total; idx += gsize) {
        const int tok = (int)(idx / 6), h = (int)(idx % 6);
        float nrm = 0.f;
        for (int c = 0; c < 64; ++c) { const int hc = 64 * h + c; const float kc = shifted(P, tok, 640 + 384 + hc, W.mu[384 + hc]) * W.k_k[hc]; nrm += kc * kc; }
        const float rn = 1.0f / fmaxf(sqrtf(nrm), 1e-12f);
        for (int c = 0; c < 64; ++c) {
            const int hc = 64 * h + c; const long o = (long)tok * 384 + hc;
            const float r = shifted(P, tok, 640 + hc, W.mu[hc]);
            const float k = shifted(P, tok, 640 + 384 + hc, W.mu[384 + hc]);
            float v = shifted(P, tok, 640 + 768 + hc, W.mu[768 + hc]);
            float wp = W.w0[hc], ap = W.a0[hc];
            for (int j = 0; j < 32; ++j) {
                wp += tanhf(shifted(P, tok, 640 + 1152 + j, W.mu[1152 + j])) * W.w2[j * 384 + hc];
                ap += shifted(P, tok, 640 + 1184 + j, W.mu[1184 + j]) * W.a2[j * 384 + hc];
            }
            const float z = -wp; const float sp = fmaxf(z, 0.f) + log1pf(expf(-fabsf(z)));
            const float w = -sp - 0.5f;
            const float a = 1.0f / (1.0f + expf(-ap));
            if (layer > 0) {
                float vp = W.v0[hc];
                for (int j = 0; j < 16; ++j) vp += shifted(P, tok, 2176 + j, W.mu_v[j]) * W.v2[j * 384 + hc];
                const float vf = bf2f(VFIRST[o]);
                v = v + (vf - v) * (1.0f / (1.0f + expf(-vp)));
            } else VFIRST[o] = f2bf(v);
            const float kk = k * W.k_k[hc] * rn;
            R[o] = f2bf(r); K[o] = f2bf(k * (1.0f + (a - 1.0f) * W.k_a[hc])); V[o] = f2bf(v);
            KK[o] = f2bf(kk); B[o] = f2bf(kk * a); LOGD[o] = f2bf(-expf(w));
        }
    }
}
#ifndef MK_BUILD
__global__ void k_rwkv_prep(const bf16_t* P, RwkvW W, int layer, bf16_t* VFIRST, bf16_t* R, bf16_t* K, bf16_t* V, bf16_t* KK, bf16_t* B, bf16_t* LOGD) { d_rwkv_prep(P, W, layer, VFIRST, R, K, V, KK, B, LOGD, (long)blockIdx.x * blockDim.x + threadIdx.x, (long)gridDim.x * blockDim.x); }
#endif
__device__ __forceinline__ void d_rwkv_scan(const bf16_t* R, const bf16_t* K, const bf16_t* V, const bf16_t* KK, const bf16_t* B, const bf16_t* LOGD, bf16_t* MIX, int bh, int i) {
    const int b = bh / 6, h = bh % 6;
    float s[64];
#pragma unroll
    for (int k = 0; k < 64; ++k) s[k] = 0.f;
    for (int t = 0; t < SEQ; ++t) {
        const long o = (long)(b * SEQ + t) * 384 + 64 * h;
        float sa = 0.f;
#pragma unroll
        for (int k = 0; k < 64; ++k) sa -= s[k] * bf2f(KK[o + k]);
        const float v = bf2f(V[o + i]); float y = 0.f;
#pragma unroll
        for (int k = 0; k < 64; ++k) { s[k] = s[k] * expf(bf2f(LOGD[o + k])) + sa * bf2f(B[o + k]) + v * bf2f(K[o + k]); y += s[k] * bf2f(R[o + k]); }
        MIX[(long)(b * SEQ + t) * DM + 384 + 64 * h + i] = f2bf(y);
    }
}
#ifndef MK_BUILD
__global__ void k_rwkv_scan(const bf16_t* R, const bf16_t* K, const bf16_t* V, const bf16_t* KK, const bf16_t* B, const bf16_t* LOGD, bf16_t* MIX) { d_rwkv_scan(R, K, V, KK, B, LOGD, MIX, blockIdx.x, threadIdx.x); }
#endif
__device__ __forceinline__ void d_rwkv_fin(const bf16_t* P, RwkvW W, const bf16_t* R, const bf16_t* K, const bf16_t* V, bf16_t* MIX, long gtid, long gsize) {
    const long total = (long)MTOK * 6;
    for (long idx = gtid; idx < total; idx += gsize) {
        const int tok = (int)(idx / 6), h = (int)(idx % 6);
        bf16_t* y = MIX + (long)tok * DM + 384 + 64 * h; const long o = (long)tok * 384 + 64 * h;
        float mean = 0.f, dot = 0.f;
        for (int c = 0; c < 64; ++c) { mean += bf2f(y[c]); dot += bf2f(R[o + c]) * bf2f(K[o + c]) * W.r_k[64 * h + c]; }
        mean *= (1.0f / 64.0f); float var = 0.f;
        for (int c = 0; c < 64; ++c) { const float d = bf2f(y[c]) - mean; var += d * d; }
        const float rstd = 1.0f / sqrtf(var * (1.0f / 64.0f) + GN_EPS);
        for (int c = 0; c < 64; ++c) {
            const int hc = 64 * h + c; float g = 0.f;
            for (int j = 0; j < 64; ++j) g += (1.0f / (1.0f + expf(-shifted(P, tok, 640 + 1216 + j, W.mu[1216 + j])))) * W.g2[j * 384 + hc];
            const float yn = (bf2f(y[c]) - mean) * rstd * W.ln_w[hc] + W.ln_b[hc];
            y[c] = f2bf((yn + dot * bf2f(V[o + c])) * g);
        }
    }
}
#ifndef MK_BUILD
__global__ void k_rwkv_fin(const bf16_t* P, RwkvW W, const bf16_t* R, const bf16_t* K, const bf16_t* V, bf16_t* MIX) { d_rwkv_fin(P, W, R, K, V, MIX, (long)blockIdx.x * blockDim.x + threadIdx.x, (long)gridDim.x * blockDim.x); }
#endif
__device__ __forceinline__ void d_conv_act(const bf16_t* U, const float* cw, const float* cb, bf16_t* ACT, int rows, long gtid, long gsize) {
    const long total = (long)rows * DFF;
    for (long idx = gtid; idx < total; idx += gsize) {
        const int t = (int)(idx / DFF), c = (int)(idx % DFF);
        float gate = cb[c], val = cb[DFF + c];
#pragma unroll
        for (int i = 0; i < 3; ++i) { const int tt = t - 2 + i; if (tt >= 0) { gate += cw[i * 2 * DFF + c] * bf2f(U[(long)tt * 2 * DFF + c]); val += cw[i * 2 * DFF + DFF + c] * bf2f(U[(long)tt * 2 * DFF + DFF + c]); } }
        ACT[(long)t * DFF + c] = f2bf(gate / (1.0f + expf(-gate)) * val);
    }
}
#ifndef MK_BUILD
__global__ void k_conv_act(const bf16_t* U, const float* cw, const float* cb, bf16_t* ACT, int rows) { d_conv_act(U, cw, cb, ACT, rows, (long)blockIdx.x * blockDim.x + threadIdx.x, (long)gridDim.x * blockDim.x); }
#endif
}
namespace pg8 {
#define PG8_LAS __attribute__((address_space(3)))
typedef unsigned short bf16_t;
typedef short bf16x8 __attribute__((ext_vector_type(8)));
typedef float f32x4 __attribute__((ext_vector_type(4)));
typedef unsigned u32x4 __attribute__((ext_vector_type(4)));
constexpr int BM = 256, BK = 64, HALF = 128, HTB = HALF * BK * 2  , STAGE_BYTES = 8 * HTB, NXCD = 8, WGM = 8;

__host__ __device__ __forceinline__ int lds_byte(int r, int c) { const int st = (r >> 4) * 2 + (c >> 5), rr = r & 15, cc = c & 31, ob = rr * 64 + cc * 2; return st * 1024 + (ob ^ (((ob >> 9) & 1) << 5)); }
__host__ __device__ __forceinline__ void stage_rc(int b, int& R, int& C) { const int st = b / 1024, sb = b % 1024, swz = sb ^ (((sb >> 9) & 1) << 5); R = (st >> 1) * 16 + swz / 64; C = (st & 1) * 32 + (swz % 64) / 2; }
__host__ __device__ __forceinline__ int perm32(int rho) { const int n = rho >> 4, i = rho & 15; return 8 * (i >> 2) + 4 * n + (i & 3); }

struct Unit { int pm, pn; };
struct Gemm { const bf16_t* A; const bf16_t* Bt; int M, N, K; };

struct StaticOrder {
    int nM, nN, nwg, G, c;
    __host__ __device__ void init(int M, int N, int G_, int c_) { nM = M / BM; nN = N / BM; nwg = nM * nN; G = G_; c = c_; }
    __host__ __device__ bool next(int i, Unit& u) const {
        const long L = (long)i * G + c; if (L >= nwg) return false;
        int wgid = (int)L; { const int q = nwg / NXCD, r = nwg % NXCD, xcd = wgid % NXCD, off = wgid / NXCD; wgid = (xcd < r ? xcd * (q + 1) : r * (q + 1) + (xcd - r) * q) + off; }
        const int nig = WGM * nN, gid = wgid / nig, fm = gid * WGM, gsz = (nM - fm) < WGM ? (nM - fm) : WGM;
        u.pm = fm + ((wgid % nig) % gsz); u.pn = (wgid % nig) / gsz; return true;
    }
    __device__ __forceinline__ void a_ready(const Unit&) const {}
    __device__ __forceinline__ void done(const Unit&) const {}
};

__device__ __forceinline__ unsigned cvt_pk_bf16(float lo, float hi) { unsigned r; asm volatile("v_cvt_pk_bf16_f32 %0, %1, %2" : "=v"(r) : "v"(lo), "v"(hi)); return r; }
struct EpiScaleBf16 {
    static constexpr bool PERM = true, AFTER_DRAIN = false; static constexpr int AMAP = 0;
    bf16_t* O; int ldc; const float* ssq;
    __device__ __forceinline__ void operator()(const f32x4 (&acc)[2][2][4][2], const Unit& u, int wr, int wc, int fr, int fq) const {
        const int row0 = u.pm * BM + wr * 64 + fr, col0 = u.pn * BM + wc * 32 + 8 * fq;
#pragma unroll
        for (int ai = 0; ai < 2; ++ai)
#pragma unroll
            for (int m = 0; m < 4; ++m) { const int row = row0 + ai * HALF + m * 16; const float sc = __builtin_amdgcn_rsqf(ssq[row] * (1.0f / 1024.0f) + 1e-6f);
                bf16_t* rowp = O + (size_t)row * ldc + col0;
#pragma unroll
                for (int bj = 0; bj < 2; ++bj) { const f32x4 v0 = acc[ai][bj][m][0] * sc, v1 = acc[ai][bj][m][1] * sc;
                    u32x4 w; w.x = cvt_pk_bf16(v0[0], v0[1]); w.y = cvt_pk_bf16(v0[2], v0[3]); w.z = cvt_pk_bf16(v1[0], v1[1]); w.w = cvt_pk_bf16(v1[2], v1[3]);
                    *(u32x4*)(rowp + bj * HALF) = w; } }
    }
};
template <bool FINAL> struct EpiResid {
    static constexpr bool PERM = false, AFTER_DRAIN = false; static constexpr int AMAP = 0;
    float* out; bf16_t* xb; float* ssq; int ldc;
    __device__ __forceinline__ void operator()(const f32x4 (&acc)[2][2][4][2], const Unit& u, int wr, int wc, int fr, int fq) const {
        typedef unsigned u32x2v __attribute__((ext_vector_type(2)));
        const int col0 = u.pn * BM + wc * 32 + 4 * fq;
#pragma unroll
        for (int ai = 0; ai < 2; ++ai) {
            u32x2v bs[4][2][2];
#pragma unroll
            for (int m = 0; m < 4; ++m) { const size_t off = (size_t)(u.pm * BM + ai * HALF + wr * 64 + m * 16 + fr) * ldc + col0;
#pragma unroll
                for (int bj = 0; bj < 2; ++bj)
#pragma unroll
                    for (int n = 0; n < 2; ++n) bs[m][bj][n] = *(const u32x2v*)(xb + off + bj * HALF + n * 16); }
#pragma unroll
            for (int m = 0; m < 4; ++m) { const int row = u.pm * BM + ai * HALF + wr * 64 + m * 16 + fr; const size_t off = (size_t)row * ldc + col0; float sq = 0.f;
#pragma unroll
                for (int bj = 0; bj < 2; ++bj)
#pragma unroll
                    for (int n = 0; n < 2; ++n) { const u32x2v b2 = bs[m][bj][n];
                        f32x4 o = {__builtin_bit_cast(float, b2.x << 16), __builtin_bit_cast(float, b2.x & 0xffff0000u), __builtin_bit_cast(float, b2.y << 16), __builtin_bit_cast(float, b2.y & 0xffff0000u)};
                        o = o + acc[ai][bj][m][n];
                        if (FINAL) *(f32x4*)(out + off + bj * HALF + n * 16) = o;
                        else { u32x2v w; w.x = cvt_pk_bf16(o[0], o[1]); w.y = cvt_pk_bf16(o[2], o[3]); *(u32x2v*)(xb + off + bj * HALF + n * 16) = w;
                            const float r0 = __builtin_bit_cast(float, w.x << 16), r1 = __builtin_bit_cast(float, w.x & 0xffff0000u), r2 = __builtin_bit_cast(float, w.y << 16), r3 = __builtin_bit_cast(float, w.y & 0xffff0000u);
                            sq += (r0 * r0 + r1 * r1) + (r2 * r2 + r3 * r3); } }
                if (!FINAL) { sq += __shfl_xor(sq, 16); sq += __shfl_xor(sq, 32); if (fq == 0) atomicAdd(ssq + row, sq); } } }
    }
};
struct EpiConvAct {
    static constexpr bool PERM = true, AFTER_DRAIN = false; static constexpr int AMAP = 1;
    bf16_t* ACT; const float* ssq; const float* cw; const float* cb;
    static __device__ __forceinline__ float shr1s(float x) { float r; asm volatile("s_nop 1\n\tv_mov_b32_dpp %0, %1 row_shr:1 row_mask:0xf bank_mask:0xf bound_ctrl:1" : "=v"(r) : "v"(x)); return r; }
    static __device__ __forceinline__ f32x4 shr1(f32x4 v) { f32x4 r; r[0] = shr1s(v[0]); r[1] = shr1s(v[1]); r[2] = shr1s(v[2]); r[3] = shr1s(v[3]); return r; }
    __device__ __forceinline__ void operator()(const f32x4 (&acc)[2][2][4][2], const Unit& u, int wr, int wc, int fr, int fq) const {
        const int b = u.pm / 33, pmb = u.pm % 33;
        const int pos0 = 252 * pmb + 126 * wr + 8 * fr - 2;
        const long row0 = (long)b * SEQ + pos0;
        float rs[8];
#pragma unroll
        for (int j = 0; j < 8; ++j) { const int pos = pos0 + j; const bool ok = pos >= 0 && pos < SEQ; const float q = ssq[ok ? row0 + j : 0]; rs[j] = ok ? __builtin_amdgcn_rsqf(q * (1.0f / 1024.0f) + 1e-6f) : 0.f; }
        const int ch0 = 128 * u.pn + 32 * wc + 8 * fq;
        unsigned ow[8][4];
#pragma unroll
        for (int n = 0; n < 2; ++n) { const int c = ch0 + 4 * n;
            const f32x4 w0g = *(const f32x4*)(cw + c), w1g = *(const f32x4*)(cw + 5632 + c), w2g = *(const f32x4*)(cw + 2 * 5632 + c), bg = *(const f32x4*)(cb + c);
            const f32x4 w0v = *(const f32x4*)(cw + 2816 + c), w1v = *(const f32x4*)(cw + 5632 + 2816 + c), w2v = *(const f32x4*)(cw + 2 * 5632 + 2816 + c), bv = *(const f32x4*)(cb + 2816 + c);
            f32x4 gm2 = shr1(acc[1][0][2][n] * rs[6]), gm1 = shr1(acc[1][0][3][n] * rs[7]), vm2 = shr1(acc[1][1][2][n] * rs[6]), vm1 = shr1(acc[1][1][3][n] * rs[7]);
#pragma unroll
            for (int j = 0; j < 8; ++j) { const f32x4 gj = acc[j >> 2][0][j & 3][n] * rs[j], vj = acc[j >> 2][1][j & 3][n] * rs[j];
                const f32x4 ug = bg + w0g * gm2 + w1g * gm1 + w2g * gj, uv = bv + w0v * vm2 + w1v * vm1 + w2v * vj; f32x4 a;
#pragma unroll
                for (int e = 0; e < 4; ++e) a[e] = ug[e] * __builtin_amdgcn_rcpf(1.0f + __expf(-ug[e])) * uv[e];
                ow[j][2 * n] = cvt_pk_bf16(a[0], a[1]); ow[j][2 * n + 1] = cvt_pk_bf16(a[2], a[3]);
                gm2 = gm1; gm1 = gj; vm2 = vm1; vm1 = vj; } }
#pragma unroll
        for (int j = 0; j < 8; ++j) if (8 * fr + j >= 2 && pos0 + j < SEQ) { u32x4 w; w.x = ow[j][0]; w.y = ow[j][1]; w.z = ow[j][2]; w.w = ow[j][3]; *(u32x4*)(ACT + (size_t)(row0 + j) * 2816 + ch0) = w; }
    }
};
template <class Epi, class Sched, bool ALIGN_EPI = false, bool SP2 = false>
__device__ __forceinline__ void gemm_phase(PG8_LAS unsigned char* lds, const Gemm g, const Sched& S, const Epi& E, int tid_in) {
    int tid = tid_in; asm volatile("" : "+v"(tid));
    const int wid = __builtin_amdgcn_readfirstlane(tid >> 6), lane = tid & 63, wr = wid >> 2, wc = wid & 3, fr = lane & 15, fq = lane >> 4;
    const int K = g.K, nt = K / BK;
    unsigned voffA[2], voffB[2];
#pragma unroll
    for (int i = 0; i < 2; ++i) { int R, C; stage_rc(tid * 16 + i * 8192, R, C); const int Rb = Epi::PERM ? ((R & ~31) + perm32(R & 31)) : R;
        const int Ra = Epi::AMAP ? (126 * (R >> 6) + 8 * (R & 15) + ((R >> 4) & 3)) : R;
        voffA[i] = (unsigned)(Ra * K + C) * 2u; voffB[i] = (unsigned)(Rb * K + C) * 2u; }
    const size_t kstep = (size_t)(BK * 2);
    const size_t hstepB = (size_t)HALF * K * 2;
    const size_t hstepA = Epi::AMAP ? (size_t)4 * K * 2 : hstepB;
    const size_t tstep = 2 * hstepB;
#define PG8_ABASE(pm_) (Epi::AMAP ? (long)((long)((pm_) / 33) * SEQ + 252 * ((pm_) % 33) - 2) * (long)K * 2 : (long)(pm_) * (long)tstep)
    const unsigned ldsw = (unsigned)wid * 1024u;
    const int aoff = lds_byte(wr * 64 + fr, fq * 8), boff = lds_byte(wc * 32 + fr, fq * 8);
#define PG8_SA(b, h) (((b) * 2 + (h)) * HTB)
#define PG8_SB(b, h) ((4 + (b) * 2 + (h)) * HTB)
#define PG8_STAGE(bufoff, gbase, voff) do { _Pragma("unroll") for (int _i = 0; _i < 2; ++_i) \
        __builtin_amdgcn_global_load_lds((const unsigned*)((const char*)(gbase) + (voff)[_i]), (PG8_LAS unsigned*)(lds + (bufoff) + ldsw + _i * 8192), 16, 0, 0); } while (0)
#define PG8_LDA(dst, b, h) do { _Pragma("unroll") for (int m = 0; m < 4; ++m) _Pragma("unroll") for (int k = 0; k < 2; ++k) dst[m][k] = *(const PG8_LAS bf16x8*)(lds + PG8_SA(b, h) + aoff + m * 2048 + k * 1024); } while (0)
#define PG8_LDB(dst, b, h) do { _Pragma("unroll") for (int n = 0; n < 2; ++n) _Pragma("unroll") for (int k = 0; k < 2; ++k) dst[n][k] = *(const PG8_LAS bf16x8*)(lds + PG8_SB(b, h) + boff + n * 2048 + k * 1024); } while (0)
#define PG8_MMA(ai, bj, At, Bt) do { __builtin_amdgcn_s_setprio(1); _Pragma("unroll") for (int m = 0; m < 4; ++m) _Pragma("unroll") for (int n = 0; n < 2; ++n) _Pragma("unroll") for (int k = 0; k < 2; ++k) \
        acc[ai][bj][m][n] = __builtin_amdgcn_mfma_f32_16x16x32_bf16(Bt[n][k], At[m][k], acc[ai][bj][m][n], 0, 0, 0); __builtin_amdgcn_s_setprio(0); } while (0)
#define PG8_WAIT_V(n) asm volatile("s_waitcnt vmcnt(" #n ")" ::: "memory")
#define PG8_WAIT_L(n) asm volatile("s_waitcnt lgkmcnt(" #n ")" ::: "memory")
#define PG8_BAR __builtin_amdgcn_s_barrier()
#define PG8_SCHED __builtin_amdgcn_sched_barrier(0)
    Unit cur, nxt; int ui = 0;
    if (!S.next(0, cur)) return;
    f32x4 acc[2][2][4][2];
#pragma unroll
    for (int a = 0; a < 2; ++a)
#pragma unroll
        for (int b = 0; b < 2; ++b)
#pragma unroll
            for (int m = 0; m < 4; ++m)
#pragma unroll
                for (int n = 0; n < 2; ++n) acc[a][b][m][n] = (f32x4){0.f, 0.f, 0.f, 0.f};
    bf16x8 At[4][2], B0[2][2], B1[2][2];
    const char* cA = (const char*)g.A + PG8_ABASE(cur.pm); const char* cB = (const char*)g.Bt + (size_t)cur.pn * tstep;
    S.a_ready(cur);
    if constexpr (SP2) {
        PG8_STAGE(PG8_SB(0, 0), cB, voffB); PG8_STAGE(PG8_SB(0, 1), cB + hstepB, voffB); PG8_STAGE(PG8_SA(0, 0), cA, voffA); PG8_STAGE(PG8_SA(0, 1), cA + hstepA, voffA);
        if (wr == 1) PG8_BAR;
        PG8_WAIT_V(2); PG8_BAR;
        PG8_STAGE(PG8_SB(1, 0), cB + kstep, voffB); PG8_STAGE(PG8_SA(1, 0), cA + kstep, voffA); PG8_STAGE(PG8_SB(1, 1), cB + hstepB + kstep, voffB);
        PG8_WAIT_V(6); PG8_BAR;
    } else {
        PG8_STAGE(PG8_SB(0, 0), cB, voffB); PG8_STAGE(PG8_SA(0, 0), cA, voffA); PG8_STAGE(PG8_SB(0, 1), cB + hstepB, voffB); PG8_STAGE(PG8_SA(0, 1), cA + hstepA, voffA);
        if (wr == 1) PG8_BAR;
        PG8_WAIT_V(4); PG8_BAR;
        PG8_STAGE(PG8_SB(1, 0), cB + kstep, voffB); PG8_STAGE(PG8_SA(1, 0), cA + kstep, voffA); PG8_STAGE(PG8_SB(1, 1), cB + hstepB + kstep, voffB);
        PG8_WAIT_V(6); PG8_BAR;
    }
    for (;;) {
        const bool has_next = S.next(ui + 1, nxt);
        const char* nA = has_next ? (const char*)g.A + PG8_ABASE(nxt.pm) : cA; const char* nB = has_next ? (const char*)g.Bt + (size_t)nxt.pn * tstep : cB;
        for (int t = 0; t < nt; t += 2) {
            const bool last = (t == nt - 2);
            const char* a1 = cA + (size_t)(t + 1) * kstep;
            const char* a2 = last ? nA : cA + (size_t)(t + 2) * kstep; const char* b2 = last ? nB : cB + (size_t)(t + 2) * kstep;
            const char* a3 = a2 + kstep; const char* b3 = b2 + kstep;
            if (last && has_next) S.a_ready(nxt);
            if constexpr (SP2) {
            PG8_LDB(B0, 0, 0); PG8_LDB(B1, 0, 1); PG8_SCHED; PG8_LDA(At, 0, 0); PG8_STAGE(PG8_SA(1, 1), a1 + hstepA, voffA);
            PG8_WAIT_V(8); PG8_WAIT_L(0); PG8_BAR; PG8_MMA(0, 0, At, B0); PG8_MMA(0, 1, At, B1); PG8_BAR; PG8_SCHED;
            PG8_LDA(At, 0, 1); PG8_STAGE(PG8_SB(0, 0), b2, voffB); PG8_STAGE(PG8_SB(0, 1), b2 + hstepB, voffB); PG8_STAGE(PG8_SA(0, 0), a2, voffA);
            PG8_WAIT_V(8); PG8_WAIT_L(0); PG8_BAR; PG8_MMA(1, 0, At, B0); PG8_MMA(1, 1, At, B1); PG8_BAR; PG8_SCHED;
            PG8_LDB(B0, 1, 0); PG8_LDB(B1, 1, 1); PG8_SCHED; PG8_LDA(At, 1, 0); PG8_STAGE(PG8_SA(0, 1), a2 + hstepA, voffA);
            PG8_WAIT_V(8); PG8_WAIT_L(0); PG8_BAR; PG8_MMA(0, 0, At, B0); PG8_MMA(0, 1, At, B1); PG8_BAR; PG8_SCHED;
            PG8_LDA(At, 1, 1); PG8_STAGE(PG8_SB(1, 0), b3, voffB); PG8_STAGE(PG8_SB(1, 1), b3 + hstepB, voffB); PG8_STAGE(PG8_SA(1, 0), a3, voffA);
            PG8_WAIT_V(8); PG8_WAIT_L(0); PG8_BAR; PG8_MMA(1, 0, At, B0); PG8_MMA(1, 1, At, B1); PG8_BAR; PG8_SCHED;
            } else {
            PG8_LDB(B0, 0, 0); PG8_SCHED; PG8_LDA(At, 0, 0); PG8_STAGE(PG8_SA(1, 1), a1 + hstepA, voffA);
            PG8_WAIT_L(8); PG8_BAR; PG8_WAIT_L(0); PG8_MMA(0, 0, At, B0); PG8_BAR; PG8_SCHED;
            PG8_LDB(B1, 0, 1); PG8_STAGE(PG8_SB(0, 0), b2, voffB);
            PG8_BAR; PG8_WAIT_L(0); PG8_MMA(0, 1, At, B1); PG8_BAR;
            PG8_LDA(At, 0, 1); PG8_STAGE(PG8_SA(0, 0), a2, voffA);
            PG8_BAR; PG8_WAIT_L(0); PG8_MMA(1, 0, At, B0); PG8_BAR; PG8_SCHED;
            PG8_STAGE(PG8_SB(0, 1), b2 + hstepB, voffB);
            PG8_WAIT_V(6); PG8_BAR; PG8_MMA(1, 1, At, B1); PG8_BAR;
            PG8_LDB(B0, 1, 0); PG8_SCHED; PG8_LDA(At, 1, 0); PG8_STAGE(PG8_SA(0, 1), a2 + hstepA, voffA);
            PG8_WAIT_L(8); PG8_BAR; PG8_WAIT_L(0); PG8_MMA(0, 0, At, B0); PG8_BAR; PG8_SCHED;
            PG8_LDB(B1, 1, 1); PG8_STAGE(PG8_SB(1, 0), b3, voffB);
            PG8_BAR; PG8_WAIT_L(0); PG8_MMA(0, 1, At, B1); PG8_BAR;
            PG8_LDA(At, 1, 1); PG8_STAGE(PG8_SA(1, 0), a3, voffA);
            PG8_BAR; PG8_WAIT_L(0); PG8_MMA(1, 0, At, B0); PG8_BAR; PG8_SCHED;
            PG8_STAGE(PG8_SB(1, 1), b3 + hstepB, voffB);
            PG8_WAIT_V(6); PG8_BAR; PG8_MMA(1, 1, At, B1); PG8_BAR;
            }
        }
        if constexpr (ALIGN_EPI) { if (wr == 0) PG8_BAR; }
        if constexpr (!Epi::AFTER_DRAIN) { E(acc, cur, wr, wc, fr, fq); S.done(cur); }
        if (!has_next) break;
#pragma unroll
        for (int a = 0; a < 2; ++a)
#pragma unroll
            for (int b = 0; b < 2; ++b)
#pragma unroll
                for (int m = 0; m < 4; ++m)
#pragma unroll
                    for (int n = 0; n < 2; ++n) acc[a][b][m][n] = (f32x4){0.f, 0.f, 0.f, 0.f};
        cur = nxt; cA = nA; cB = nB; ++ui;
        if constexpr (ALIGN_EPI) { if (wr == 1) PG8_BAR; }
    }
    PG8_WAIT_V(0);
    if constexpr (!ALIGN_EPI) { if (wr == 0) PG8_BAR; }
    PG8_BAR;
    if constexpr (Epi::AFTER_DRAIN) { E.fused(acc, cur, wr, wc, fr, fq, lds, wid, lane); S.done(cur); }
#undef PG8_ABASE
#undef PG8_SA
#undef PG8_SB
#undef PG8_STAGE
#undef PG8_LDA
#undef PG8_LDB
#undef PG8_MMA
#undef PG8_WAIT_V
#undef PG8_WAIT_L
#undef PG8_BAR
#undef PG8_SCHED
}
}

#ifndef PG8_SP2
#define PG8_SP2 true
#endif
#ifndef PG8_ALIGN
#define PG8_ALIGN true
#endif
#define GAS __attribute__((address_space(1)))
#define LAS __attribute__((address_space(3)))
typedef unsigned short bf16;
typedef unsigned v4u __attribute__((ext_vector_type(4)));
typedef float f32x4 __attribute__((ext_vector_type(4)));
typedef short bf16x8 __attribute__((ext_vector_type(8)));
typedef GAS unsigned gu32;
typedef GAS unsigned long long gu64;
#define RLX_AGENT __ATOMIC_RELAXED, __HIP_MEMORY_SCOPE_AGENT
#define LDS_WAIT() asm volatile("s_waitcnt lgkmcnt(0)" ::: "memory")
#define VM_WAIT() asm volatile("s_waitcnt vmcnt(0)" ::: "memory")
__device__ __forceinline__ unsigned long long rt() { return __builtin_amdgcn_s_memrealtime(); }

#define XB_TMO      128
#define XB_XCNT(j)  (256  + 64 * (j))
#define XB_XSUB(j)  (1280 + 64 * (j))
#define XB_XGEN(j)  (2304 + 64 * (j))
#define XB_TOP      3328
#define XB_TOPGEN   3392
#define XCD_BAR_WORDS 3456
#define XB_SPIN_CAP (1u << 20)

__device__ __forceinline__ unsigned xb_ld(unsigned* p)              { return __hip_atomic_load(p, __ATOMIC_RELAXED, __HIP_MEMORY_SCOPE_AGENT); }
__device__ __forceinline__ unsigned xb_add(unsigned* p, unsigned v) { return __hip_atomic_fetch_add(p, v, __ATOMIC_RELAXED, __HIP_MEMORY_SCOPE_AGENT); }
__device__ __forceinline__ unsigned xb_xcc_id() { return (unsigned)__builtin_amdgcn_s_getreg((3 << 11) | 20) & 0xFu; }
#define XB_SPIN(cond, bar) do { unsigned _sp = 0; while (cond) { __builtin_amdgcn_s_sleep(1); \
    if ((++_sp & 255u) == 0u) { if (xb_ld(&(bar)[XB_TMO])) break; if (_sp > XB_SPIN_CAP) { atomicAdd(&(bar)[XB_TMO], 1u); break; } } } } while (0)

struct XcdBarrier {
    unsigned* bar; unsigned x;
    volatile LAS unsigned* st;
};

__device__ __forceinline__ XcdBarrier xcd_barrier_post(unsigned* bar, volatile LAS unsigned* st) {
    XcdBarrier b; b.bar = bar; b.x = xb_xcc_id(); b.st = st;
    if (threadIdx.x == 0) (void)xb_add(&bar[XB_XCNT(b.x)], 1u);
    return b;
}
__device__ __forceinline__ void xcd_barrier_complete(unsigned* bar, unsigned x, unsigned& nloc, unsigned& nx) {
    const unsigned G = gridDim.x * gridDim.y * gridDim.z;
    unsigned sum, cnt, mine, sp = 0u;
    for (;;) {
        sum = 0u; cnt = 0u; mine = 0u;
#pragma unroll
        for (unsigned j = 0; j < 16; ++j) { const unsigned c = xb_ld(&bar[XB_XCNT(j)]); sum += c; cnt += (c > 0u) ? 1u : 0u; mine = (j == x) ? c : mine; }
        if (sum == G) break;
        __builtin_amdgcn_s_sleep(1);
        if ((++sp & 255u) == 0u) { if (xb_ld(&bar[XB_TMO])) break; if (sp > XB_SPIN_CAP) { atomicAdd(&bar[XB_TMO], 1u); break; } }
    }
    nloc = mine > 0u ? mine : 1u; nx = cnt > 0u ? cnt : 1u;
}

__device__ __forceinline__ void xcd_barrier(const XcdBarrier& b) {
    asm volatile("s_waitcnt vmcnt(0)" ::: "memory");
    __syncthreads();
    if (threadIdx.x == 0) {
        unsigned* bar = b.bar;
        __builtin_amdgcn_s_waitcnt(0);
        unsigned nloc = b.st[0], nx = b.st[1];
        if (nloc == 0u) { xcd_barrier_complete(bar, b.x, nloc, nx); b.st[0] = nloc; b.st[1] = nx; }
        const unsigned old = xb_add(&bar[XB_XSUB(b.x)], 1u);
        const unsigned gen = old / nloc;
        if (old + 1u == (gen + 1u) * nloc) {
            __builtin_amdgcn_fence(__ATOMIC_RELEASE, "agent");
            asm volatile("s_waitcnt vmcnt(0)" ::: "memory");
            const unsigned og = xb_add(&bar[XB_TOP], 1u);
            const unsigned tg = og / nx;
            if (og + 1u == (tg + 1u) * nx) xb_add(&bar[XB_TOPGEN], 1u);
            else XB_SPIN(xb_ld(&bar[XB_TOPGEN]) == tg, bar);
            __builtin_amdgcn_fence(__ATOMIC_ACQUIRE, "agent");
            xb_add(&bar[XB_XGEN(b.x)], 1u);
            asm volatile("s_waitcnt vmcnt(0)" ::: "memory");
        } else {
            XB_SPIN(xb_ld(&bar[XB_XGEN(b.x)]) == gen, bar);
            __builtin_amdgcn_fence(__ATOMIC_ACQUIRE, "agent");
            asm volatile("s_waitcnt vmcnt(0)" ::: "memory");
        }
    }
    __syncthreads();
}

namespace mk {
constexpr size_t WS_CTL = 0, CTL_ZERO_BYTES = 1 * MiB;
constexpr size_t CTL_SSQ = 512 * 1024;
constexpr size_t WS_SMALL = 1 * MiB, SM_BIAS = 0, SM_SSQM = 4096, SM_MKV = 512 * 1024;
constexpr size_t WS_MEMB = 2 * MiB, WS_WT = 3 * MiB, WS_XB = 28 * MiB, WS_VF = 60 * MiB, WS_PROJ = 72 * MiB, WS_MIX = 144 * MiB, WS_PREP = 176 * MiB, WS_U = 72 * MiB, WS_ACT = 160 * MiB, WS_WIN1 = 248 * MiB  , WS_END = 255 * MiB;
constexpr size_t WT_IN = 0, WT_OUT = 4718592, WT_UP = WT_OUT + 2 * MiB, WT_DOWN = WT_UP + 11 * MiB, WT_MKV = WT_DOWN + 5767168;
constexpr int CW_TMO = 0, CW_BAR = 4096, CW_ATTQ = 8192, CW_CHQ = 8448;
constexpr int LDS_BYTES = 163840, LDSCTL_OFF = LDS_BYTES - 512, MISC_OFF = LDSCTL_OFF + 320;
constexpr size_t SM_W2T = 8192, SM_A2T = 32768, SM_V2T = 57344, SM_G2T = 81920, SM_LORA_L = 122880;
constexpr size_t WS_PT = 176 * MiB, WS_G = 188 * MiB, WS_S0 = 200 * MiB, WS_Z = 212 * MiB, WS_YV = 236 * MiB  , WS_DOT = 254 * MiB;
constexpr size_t SM_RWP = 262144, RWP_BYTES = 17472;
constexpr int RP_MU = 0, RP_MUV = 1280, RP_W0 = 1296, RP_A0 = 1680, RP_V0 = 2064, RP_KK = 2448, RP_KA = 2832, RP_RK = 3216, RP_LNW = 3600, RP_LNB = 3984, RP_SIZE = 4368;
}
namespace rw {
constexpr int LD = 72;
constexpr int MATB = 64 * LD * 2;
constexpr int OFF_F0 = 12 * MATB  , OFF_TMP = OFF_F0 + 64 * 65 * 4  ;
constexpr int OFF_TW = 8 * MATB  , OFF_TA = OFF_TW + 5120, OFF_TV = OFF_TA + 5120, OFF_WP = OFF_TV + 5120  , OFF_AP = OFF_WP + 16640, OFF_VP = OFF_AP + 16640;
constexpr int OFF_TOT = 139264, OFF_GC = OFF_TOT + 2048, OFF_RN = OFF_GC + 256, OFF_END = OFF_RN + 256;
constexpr int NITEMS = BATCH * 6 * (SEQ / 64);
__device__ __forceinline__ int sigpos(int c) { return (c & 32) + 8 * ((c >> 2) & 3) + 4 * ((c >> 4) & 1) + (c & 3); }
#define RW_BAR() do { asm volatile("s_waitcnt lgkmcnt(0)" ::: "memory"); __builtin_amdgcn_s_barrier(); asm volatile("" ::: "memory"); } while (0)
__device__ __forceinline__ float fexp(float x) { return __expf(x); }
__device__ __forceinline__ float fsigm(float x) { return __builtin_amdgcn_rcpf(1.0f + __expf(-x)); }
__device__ __forceinline__ float ftanh(float x) { const float e = __expf(-2.0f * fabsf(x)); const float t = (1.0f - e) * __builtin_amdgcn_rcpf(1.0f + e); return x < 0.f ? -t : t; }
__device__ __forceinline__ f32x4 mm_tile(const LAS bf16_t* A, const LAS bf16_t* Bt, int ti, int tj, int fr, int fq, f32x4 acc) {
#pragma unroll
    for (int kk = 0; kk < 2; ++kk) {
        const bf16x8 a = *(const LAS bf16x8*)(A + (16 * ti + fr) * LD + 32 * kk + 8 * fq);
        const bf16x8 b = *(const LAS bf16x8*)(Bt + (16 * tj + fr) * LD + 32 * kk + 8 * fq);
        acc = __builtin_amdgcn_mfma_f32_16x16x32_bf16(a, b, acc, 0, 0, 0);
    }
    return acc;
}
__device__ __forceinline__ unsigned pk2(float lo, float hi) { typedef float f2_t __attribute__((ext_vector_type(2))); typedef __bf16 b2_t __attribute__((ext_vector_type(2))); f2_t v = {lo, hi}; return __builtin_bit_cast(unsigned, __builtin_convertvector(v, b2_t)); }
#define RW_PT   ((GAS bf16_t*)(wsb + mk::WS_PT))
#define RW_G    ((GAS bf16_t*)(wsb + mk::WS_G))
#define RW_Z    ((GAS float*)(wsb + mk::WS_Z))
#define RW_YV   ((GAS bf16_t*)(wsb + mk::WS_YV))
#define RW_S0   ((GAS bf16_t*)(wsb + mk::WS_S0))
#define RW_VF   ((GAS bf16_t*)(wsb + mk::WS_VF))
#define RW_DOT  ((GAS float*)(wsb + mk::WS_DOT))
#define RW_PROJ ((const GAS bf16_t*)(wsb + mk::WS_PROJ))
#define RW_MIX  ((GAS bf16_t*)(wsb + mk::WS_MIX))
#define RW_LORA(off) ((const GAS bf16_t*)(wsb + mk::WS_SMALL + (off) + layer * mk::SM_LORA_L))
#define RWP(off) ((const GAS float*)(wsb + mk::WS_SMALL + mk::SM_RWP + layer * mk::RWP_BYTES) + (off))
struct ChunkBufs { bf16_t* PT; bf16_t* G; float* Z; bf16_t* YV; bf16_t* S0; bf16_t* VOUT; float* DOT; const bf16_t *W2T, *A2T, *V2T, *G2T; };

#define RW_LANES() int lt_ = tid_in; asm volatile("" : "+v"(lt_)); const int tid = lt_, lane = lt_ & 63, fr = lane & 15, fq = lane >> 4; (void)tid; (void)fr; (void)fq
struct ChunkLoads { unsigned short e_r[9], e_k[9], e_v[9], e_vf[8]; v4u lc, lp, kc4, kp4, vc4, vp4; };
__device__ __forceinline__ void chunk_loads(ChunkLoads& C, unsigned char* wsb, int layer, int item, int tid, int w) {
    const GAS bf16_t* P = RW_PROJ; const int lane = tid & 63;
    const int bh = item / (SEQ / 64), chunk = item % (SEQ / 64), b = bh / 6, h = bh % 6; const int tok0 = b * SEQ + chunk * 64;
    { const int hc = 64 * h + lane, tk0 = tok0 + 8 * w; const bool has_prev = (chunk * 64 + 8 * w) > 0;
#pragma unroll
      for (int j = 0; j < 9; ++j) { const size_t row = (size_t)(tk0 + j - 1) * LDP; const bool ok = j > 0 || has_prev;
          C.e_r[j] = ok ? P[row + 640 + hc] : (unsigned short)0; C.e_k[j] = ok ? P[row + 1024 + hc] : (unsigned short)0; C.e_v[j] = ok ? P[row + 1408 + hc] : (unsigned short)0; }
#pragma unroll
      for (int j = 0; j < 8; ++j) C.e_vf[j] = layer > 0 ? RW_VF[(size_t)(tk0 + j) * 384 + hc] : (unsigned short)0; }
    { const int t = tid >> 3, sub = tid & 7, tok = tok0 + t; const bool hp = (chunk * 64 + t) > 0;
      const GAS bf16_t* rc = P + (size_t)tok * LDP; const GAS bf16_t* rp = rc - LDP; const v4u z4 = {0u, 0u, 0u, 0u};
      C.lc = *(const GAS v4u*)(rc + 1792 + 8 * sub); C.lp = hp ? *(const GAS v4u*)(rp + 1792 + 8 * sub) : z4;
      C.kc4 = *(const GAS v4u*)(rc + 1024 + 64 * h + 8 * sub); C.kp4 = hp ? *(const GAS v4u*)(rp + 1024 + 64 * h + 8 * sub) : z4;
      C.vc4 = z4; C.vp4 = z4; if (layer > 0 && sub < 2) { C.vc4 = *(const GAS v4u*)(rc + 1920 + 8 * sub); if (hp) C.vp4 = *(const GAS v4u*)(rp + 1920 + 8 * sub); } }
}
__device__ __forceinline__ int chunk_phase(LAS unsigned char* L, unsigned char* wsb, int layer, int tid_in, unsigned* qctr, volatile LAS unsigned* qw) {
    const GAS bf16_t* P = RW_PROJ;
    const int w = __builtin_amdgcn_readfirstlane(tid_in >> 6);
    LAS bf16_t* B0 = (LAS bf16_t*)(L + 0 * MATB); LAS bf16_t* B1 = (LAS bf16_t*)(L + 1 * MATB); LAS bf16_t* B2 = (LAS bf16_t*)(L + 2 * MATB); LAS bf16_t* B3 = (LAS bf16_t*)(L + 3 * MATB);
    LAS bf16_t* B4 = (LAS bf16_t*)(L + 4 * MATB); LAS bf16_t* B5 = (LAS bf16_t*)(L + 5 * MATB); LAS bf16_t* B6 = (LAS bf16_t*)(L + 6 * MATB); LAS bf16_t* B7 = (LAS bf16_t*)(L + 7 * MATB);
    LAS bf16_t* B8 = (LAS bf16_t*)(L + 8 * MATB); LAS bf16_t* B9 = (LAS bf16_t*)(L + 9 * MATB); LAS bf16_t* B10 = (LAS bf16_t*)(L + 10 * MATB); LAS bf16_t* B11 = (LAS bf16_t*)(L + 11 * MATB);
    LAS float* F0 = (LAS float*)(L + OFF_F0); LAS float* TMP = (LAS float*)(L + OFF_TMP);
    LAS bf16_t* TW = (LAS bf16_t*)(L + OFF_TW); LAS bf16_t* TA = (LAS bf16_t*)(L + OFF_TA); LAS bf16_t* TV = (LAS bf16_t*)(L + OFF_TV);
    LAS float* WP = (LAS float*)(L + OFF_WP); LAS float* AP = (LAS float*)(L + OFF_AP); LAS float* VP = (LAS float*)(L + OFF_VP);
    LAS float* TOT = (LAS float*)(L + OFF_TOT); LAS float* GC = (LAS float*)(L + OFF_GC); LAS float* RN = (LAS float*)(L + OFF_RN);
    if (tid_in == 0) qw[0] = atomicAdd(qctr, 1u);
    RW_BAR(); int item = (int)qw[0]; RW_BAR();
    ChunkLoads CL; if (item < NITEMS) { RW_LANES(); chunk_loads(CL, wsb, layer, item, tid, w); }
    for (;;) {
        if (item >= NITEMS) return item;
        if (tid_in == 0) qw[0] = atomicAdd(qctr, 1u);
        const int bh = item / (SEQ / 64), chunk = item % (SEQ / 64), b = bh / 6, h = bh % 6;
        const int tok0 = b * SEQ + chunk * 64;
        float e_mu_r, e_mu_k, e_mu_v, e_w0, e_a0, e_kk, e_ka, e_rk, e_v0;
        { RW_LANES(); const int hc = 64 * h + lane;
          e_mu_r = RWP(mk::RP_MU)[hc]; e_mu_k = RWP(mk::RP_MU)[384 + hc]; e_mu_v = RWP(mk::RP_MU)[768 + hc]; e_w0 = RWP(mk::RP_W0)[hc]; e_a0 = RWP(mk::RP_A0)[hc]; e_kk = RWP(mk::RP_KK)[hc]; e_ka = RWP(mk::RP_KA)[hc]; e_rk = RWP(mk::RP_RK)[hc]; e_v0 = layer > 0 ? RWP(mk::RP_V0)[hc] : 0.f; }
        for (int rp_ = 0; rp_ < ((PROF_PH) == 20 ? 2 : 1); ++rp_) {
        { RW_LANES(); const int t = tid >> 3, sub = tid & 7;
          const v4u lc = CL.lc, lp = CL.lp, kc4 = CL.kc4, kp4 = CL.kp4, vc4 = CL.vc4, vp4 = CL.vp4;
          const unsigned lcw[4] = {lc.x, lc.y, lc.z, lc.w}, lpw[4] = {lp.x, lp.y, lp.z, lp.w}, kcw[4] = {kc4.x, kc4.y, kc4.z, kc4.w}, kpw[4] = {kp4.x, kp4.y, kp4.z, kp4.w}, vcw[4] = {vc4.x, vc4.y, vc4.z, vc4.w}, vpw[4] = {vp4.x, vp4.y, vp4.z, vp4.w};
          unsigned lo[4], vo[4]; float s = 0.f;
          const f32x4 mA0 = *(const GAS f32x4*)(RWP(mk::RP_MU) + 1152 + 8 * sub), mA1 = *(const GAS f32x4*)(RWP(mk::RP_MU) + 1156 + 8 * sub);
          const f32x4 mK0 = *(const GAS f32x4*)(RWP(mk::RP_MU) + 384 + 64 * h + 8 * sub), mK1 = *(const GAS f32x4*)(RWP(mk::RP_MU) + 388 + 64 * h + 8 * sub);
          const f32x4 kk0 = *(const GAS f32x4*)(RWP(mk::RP_KK) + 64 * h + 8 * sub), kk1 = *(const GAS f32x4*)(RWP(mk::RP_KK) + 64 * h + 8 * sub + 4);
          f32x4 mV0 = {0.f, 0.f, 0.f, 0.f}, mV1 = mV0; if (layer > 0 && sub < 2) { mV0 = *(const GAS f32x4*)(RWP(mk::RP_MUV) + 8 * sub); mV1 = *(const GAS f32x4*)(RWP(mk::RP_MUV) + 8 * sub + 4); }
#pragma unroll
          for (int e2 = 0; e2 < 4; ++e2) { float xl[2], xv[2];
#pragma unroll
              for (int u = 0; u < 2; ++u) { const int e = 2 * e2 + u; const int sh = 16 * u;
                  const float c1 = bf2f((bf16_t)((lcw[e2] >> sh) & 0xffff)), p1 = bf2f((bf16_t)((lpw[e2] >> sh) & 0xffff)); const float x = c1 + (e < 4 ? mA0[e & 3] : mA1[e & 3]) * (p1 - c1);
                  xl[u] = sub < 4 ? ftanh(x) : x;
                  const float c2 = bf2f((bf16_t)((kcw[e2] >> sh) & 0xffff)), p2 = bf2f((bf16_t)((kpw[e2] >> sh) & 0xffff));
                  const float kx = (c2 + (e < 4 ? mK0[e & 3] : mK1[e & 3]) * (p2 - c2)) * (e < 4 ? kk0[e & 3] : kk1[e & 3]); s += kx * kx;
                  const float c3 = bf2f((bf16_t)((vcw[e2] >> sh) & 0xffff)), p3 = bf2f((bf16_t)((vpw[e2] >> sh) & 0xffff)); xv[u] = c3 + (e < 4 ? mV0[e & 3] : mV1[e & 3]) * (p3 - c3); }
              lo[e2] = pk2(xl[0], xl[1]); vo[e2] = pk2(xv[0], xv[1]); }
          *(LAS v4u*)((sub < 4 ? TW : TA) + t * 40 + 8 * (sub & 3)) = (v4u){lo[0], lo[1], lo[2], lo[3]};
          if (layer > 0 && sub < 4) *(LAS v4u*)(TV + t * 40 + 8 * sub) = (v4u){vo[0], vo[1], vo[2], vo[3]};
          s += __shfl_xor(s, 1); s += __shfl_xor(s, 2); s += __shfl_xor(s, 4);
          if (sub == 0) RN[t] = __builtin_amdgcn_rsqf(fmaxf(s, 1e-24f)); }
        RW_BAR();
        }
        const int nxt = (int)qw[0];
        { RW_LANES();
#pragma unroll
        for (int e = 0; e < 2; ++e) { const int tl = 2 * w + e, ti = tl >> 2, tj = tl & 3; const f32x4 z4 = {0.f, 0.f, 0.f, 0.f};
            const size_t brow = (size_t)(64 * h + 16 * tj + fr) * 32 + 8 * fq;
            { const bf16x8 a = *(const LAS bf16x8*)(TW + (16 * ti + fr) * 40 + 8 * fq); const bf16x8 bb = *(const GAS bf16x8*)(RW_LORA(mk::SM_W2T) + brow);
              const f32x4 d = __builtin_amdgcn_mfma_f32_16x16x32_bf16(a, bb, z4, 0, 0, 0);
#pragma unroll
              for (int r = 0; r < 4; ++r) WP[(16 * ti + 4 * fq + r) * 65 + 16 * tj + fr] = d[r]; }
            { const bf16x8 a = *(const LAS bf16x8*)(TA + (16 * ti + fr) * 40 + 8 * fq); const bf16x8 bb = *(const GAS bf16x8*)(RW_LORA(mk::SM_A2T) + brow);
              const f32x4 d = __builtin_amdgcn_mfma_f32_16x16x32_bf16(a, bb, z4, 0, 0, 0);
#pragma unroll
              for (int r = 0; r < 4; ++r) AP[(16 * ti + 4 * fq + r) * 65 + 16 * tj + fr] = d[r]; }
            if (layer > 0) { const bf16x8 a = *(const LAS bf16x8*)(TV + (16 * ti + fr) * 40 + 8 * fq); const bf16x8 bb = *(const GAS bf16x8*)(RW_LORA(mk::SM_V2T) + brow);
              const f32x4 d = __builtin_amdgcn_mfma_f32_16x16x32_bf16(a, bb, z4, 0, 0, 0);
#pragma unroll
              for (int r = 0; r < 4; ++r) VP[(16 * ti + 4 * fq + r) * 65 + 16 * tj + fr] = d[r]; } } }
        RW_BAR();
        for (int rp_ = 0; rp_ < ((PROF_PH) == 21 ? 2 : 1); ++rp_) {
        { RW_LANES(); const int c = lane, hc = 64 * h + c, tq0 = 8 * w, tk0 = tok0 + tq0;
          const float mu_r = e_mu_r, mu_k = e_mu_k, mu_v = e_mu_v, w0 = e_w0, a0 = e_a0, k_k = e_kk, k_a = e_ka, r_k = e_rk, v0 = e_v0;
          float pr = bf2f(CL.e_r[0]), pk = bf2f(CL.e_k[0]), pv = bf2f(CL.e_v[0]);
          float rr[8], kq[8], vv[8], kkc[8], bb[8], ld[8], pd[8];
#pragma unroll
          for (int j = 0; j < 8; ++j) { const int t = tq0 + j;
              const float cr = bf2f(CL.e_r[j + 1]), ck = bf2f(CL.e_k[j + 1]), cv = bf2f(CL.e_v[j + 1]);
              const float r = cr + mu_r * (pr - cr), k = ck + mu_k * (pk - ck); float v = cv + mu_v * (pv - cv); pr = cr; pk = ck; pv = cv;
              const float wp = w0 + WP[t * 65 + c], ap = a0 + AP[t * 65 + c];
              const float z = -wp, sp = fmaxf(z, 0.f) + __logf(1.0f + __expf(-fabsf(z))); const float wl = -sp - 0.5f;
              const float al = fsigm(ap);
              if (layer > 0) { const float vp = v0 + VP[t * 65 + c]; const float vf = bf2f(CL.e_vf[j]); v = v + (vf - v) * fsigm(vp); }
              const float kn = k * k_k * RN[t]; const float k2 = k * (1.0f + (al - 1.0f) * k_a);
              rr[j] = r; kq[j] = k2; vv[j] = v; kkc[j] = kn; bb[j] = kn * al; ld[j] = -fexp(wl); pd[j] = r * k2 * r_k; }
          {
#pragma unroll
            for (int j = 0; j < 8; j += 2) { const unsigned pv2 = pk2(vv[j], vv[j + 1]); RW_VF[(size_t)(tk0 + j) * 384 + hc] = (bf16_t)(pv2 & 0xffff); RW_VF[(size_t)(tk0 + j + 1) * 384 + hc] = (bf16_t)(pv2 >> 16); } }
          {
            const bool b5 = lane & 32, b4 = lane & 16, b3 = lane & 8; float s4[4], s2[2], s1;
#pragma unroll
            for (int i = 0; i < 4; ++i) { const float keep = b5 ? pd[i + 4] : pd[i], send = b5 ? pd[i] : pd[i + 4]; s4[i] = keep + __shfl_xor(send, 32); }
#pragma unroll
            for (int i = 0; i < 2; ++i) { const float keep = b4 ? s4[i + 2] : s4[i], send = b4 ? s4[i] : s4[i + 2]; s2[i] = keep + __shfl_xor(send, 16); }
            { const float keep = b3 ? s2[1] : s2[0], send = b3 ? s2[0] : s2[1]; s1 = keep + __shfl_xor(send, 8); }
            s1 += __shfl_xor(s1, 4); s1 += __shfl_xor(s1, 2); s1 += __shfl_xor(s1, 1);
            if ((lane & 7) == 0) RW_DOT[(size_t)(tk0 + (lane >> 3)) * 6 + h] = s1; }
          float cl[8]; cl[0] = ld[0];
#pragma unroll
          for (int j = 1; j < 8; ++j) cl[j] = cl[j - 1] + ld[j];
          TOT[w * 64 + c] = cl[7];
          RW_BAR();
          float prefix = 0.f, cumC = 0.f;
#pragma unroll
          for (int ww = 0; ww < 8; ++ww) { const float tv = TOT[ww * 64 + c]; cumC += tv; if (ww < w) prefix += tv; }
          const float gcc = fexp(cumC); if (w == 0) GC[c] = gcc;
          unsigned ahp[4], btp[4], ktp[4], vp4[4]; float gprev = fexp(prefix), ah_e = 0.f, bt_e = 0.f, kt_e = 0.f;
#pragma unroll
          for (int j = 0; j < 8; ++j) { const int t = tq0 + j; const float g = fexp(prefix + cl[j]), ig = __builtin_amdgcn_rcpf(g), gc = gcc * ig;
              const float ah = -kkc[j] * gprev, rh = rr[j] * g, bh = bb[j] * ig, kh = kq[j] * ig, bt = bb[j] * gc, kt = kq[j] * gc; gprev = g;
              const unsigned w01 = pk2(ah, rh), w23 = pk2(bh, kh);
              B0[t * LD + c] = (bf16_t)(w01 & 0xffff); B1[t * LD + c] = (bf16_t)(w01 >> 16); B2[t * LD + c] = (bf16_t)(w23 & 0xffff); B3[t * LD + c] = (bf16_t)(w23 >> 16);
              if (j & 1) { ahp[j >> 1] = pk2(ah_e, ah); btp[j >> 1] = pk2(bt_e, bt); ktp[j >> 1] = pk2(kt_e, kt); vp4[j >> 1] = pk2(vv[j - 1], vv[j]); }
              else { ah_e = ah; bt_e = bt; kt_e = kt; } }
          *(LAS v4u*)(B4 + c * LD + tq0) = (v4u){ahp[0], ahp[1], ahp[2], ahp[3]}; *(LAS v4u*)(B5 + c * LD + tq0) = (v4u){btp[0], btp[1], btp[2], btp[3]};
          *(LAS v4u*)(B6 + c * LD + tq0) = (v4u){ktp[0], ktp[1], ktp[2], ktp[3]}; *(LAS v4u*)(B7 + c * LD + tq0) = (v4u){vp4[0], vp4[1], vp4[2], vp4[3]}; }
        RW_BAR();
        }
        if (nxt < NITEMS) { RW_LANES(); chunk_loads(CL, wsb, layer, nxt, tid, w); }
        for (int rp_ = 0; rp_ < ((PROF_PH) == 22 ? 2 : 1); ++rp_) {
        { RW_LANES(); const int prod = w >> 1; const LAS bf16_t* Aop = prod < 2 ? B0 : B1; const LAS bf16_t* Bop = (prod & 1) ? B3 : B2;
#pragma unroll
          for (int e = 0; e < 8; ++e) { const int tl = (w & 1) * 8 + e, ti = tl >> 2, tj = tl & 3; f32x4 d = {0.f, 0.f, 0.f, 0.f};
              if (tj <= ti) d = mm_tile(Aop, Bop, ti, tj, fr, fq, d);
#pragma unroll
              for (int r = 0; r < 4; ++r) { const int t = 16 * ti + 4 * fq + r, i = 16 * tj + fr; const bool keep = prod < 2 ? (i < t) : (i <= t); const float val = (tj <= ti && keep) ? d[r] : 0.f;
                  if (prod == 0) F0[t * 65 + i] = val; else if (prod == 1) B8[t * LD + i] = f2bf(val); else if (prod == 2) B9[t * LD + i] = f2bf(val); else B10[t * LD + i] = f2bf(val); } } }
        RW_BAR();
        }
        if (w == 0) { RW_LANES();
            const int blk = lane >> 4, jc = lane & 15; const LAS float* Lb = F0 + (16 * blk) * 65 + 16 * blk; float tc[16];
#pragma unroll
            for (int r = 0; r < 16; ++r) { float val = (r == jc) ? 1.f : 0.f;
#pragma unroll
                for (int i = 0; i < r; ++i) val += Lb[r * 65 + i] * tc[i];
                tc[r] = val; }
            asm volatile("s_waitcnt lgkmcnt(0)" ::: "memory");
#pragma unroll
            for (int r = 0; r < 16; ++r) F0[(16 * blk + r) * 65 + 16 * blk + jc] = tc[r];
        } else { RW_LANES();
#pragma unroll 1
            for (int tl = w - 1; tl < 16; tl += 7) { const int ti = tl >> 2, tj = tl & 3; f32x4 d = {0.f, 0.f, 0.f, 0.f};
                d = mm_tile(B8, B7, ti, tj, fr, fq, d);
                LAS bf16_t* dst = B2 + (16 * tj + fr) * LD + 16 * ti + 4 * fq;
                *(LAS unsigned long long*)dst = (unsigned long long)pk2(d[0], d[1]) | ((unsigned long long)pk2(d[2], d[3]) << 32); } }
        RW_BAR();
        if (w < 2) { RW_LANES();
            const int o1 = 32 * w, o2 = 32 * w + 16; f32x4 d = {0.f, 0.f, 0.f, 0.f};
#pragma unroll
            for (int ks = 0; ks < 4; ++ks) d = __builtin_amdgcn_mfma_f32_16x16x4f32(F0[(o2 + fr) * 65 + o1 + 4 * ks + fq], F0[(o1 + 4 * ks + fq) * 65 + o1 + fr], d, 0, 0, 0);
            LAS float* tm = TMP + w * 16 * 17;
#pragma unroll
            for (int r = 0; r < 4; ++r) tm[(4 * fq + r) * 17 + fr] = d[r];
            asm volatile("s_waitcnt lgkmcnt(0)" ::: "memory");
            f32x4 d2 = {0.f, 0.f, 0.f, 0.f};
#pragma unroll
            for (int ks = 0; ks < 4; ++ks) d2 = __builtin_amdgcn_mfma_f32_16x16x4f32(F0[(o2 + fr) * 65 + o2 + 4 * ks + fq], tm[(4 * ks + fq) * 17 + fr], d2, 0, 0, 0);
            asm volatile("s_waitcnt lgkmcnt(0)" ::: "memory");
#pragma unroll
            for (int r = 0; r < 4; ++r) F0[(o2 + 4 * fq + r) * 65 + o1 + fr] = d2[r];
        }
        RW_BAR();
        if (w < 4) { RW_LANES();
            const int ti = w >> 1, tj = w & 1; f32x4 d = {0.f, 0.f, 0.f, 0.f};
#pragma unroll
            for (int ks = 0; ks < 8; ++ks) d = __builtin_amdgcn_mfma_f32_16x16x4f32(F0[(32 + 16 * ti + fr) * 65 + 4 * ks + fq], F0[(4 * ks + fq) * 65 + 16 * tj + fr], d, 0, 0, 0);
#pragma unroll
            for (int r = 0; r < 4; ++r) TMP[(16 * ti + 4 * fq + r) * 33 + 16 * tj + fr] = d[r];
        }
        RW_BAR();
        if (w < 4) { RW_LANES();
            const int ti = w >> 1, tj = w & 1; f32x4 d = {0.f, 0.f, 0.f, 0.f};
#pragma unroll
            for (int ks = 0; ks < 8; ++ks) d = __builtin_amdgcn_mfma_f32_16x16x4f32(F0[(32 + 16 * ti + fr) * 65 + 32 + 4 * ks + fq], TMP[(4 * ks + fq) * 33 + 16 * tj + fr], d, 0, 0, 0);
#pragma unroll
            for (int r = 0; r < 4; ++r) F0[(32 + 16 * ti + 4 * fq + r) * 65 + 16 * tj + fr] = d[r];
        }
        RW_BAR();
        { RW_LANES(); const int t = tid >> 3, i0 = (tid & 7) * 8;
#pragma unroll
          for (int e = 0; e < 8; ++e) B11[t * LD + i0 + e] = f2bf(F0[t * 65 + i0 + e]); }
        RW_BAR();
        { RW_LANES();
#pragma unroll
        for (int e = 0; e < 4; ++e) { const int tl = 4 * w + e, prod = tl >> 4, ti = (tl >> 2) & 3, tj = tl & 3; f32x4 d = {0.f, 0.f, 0.f, 0.f};
            d = prod == 0 ? mm_tile(B11, B4, ti, tj, fr, fq, d) : mm_tile(B11, B2, ti, tj, fr, fq, d);
            LAS bf16_t* dst = (prod == 0 ? B0 : B3) + (16 * tj + fr) * LD + 16 * ti + 4 * fq;
            *(LAS unsigned long long*)dst = (unsigned long long)pk2(d[0], d[1]) | ((unsigned long long)pk2(d[2], d[3]) << 32); } }
        RW_BAR();
        for (int rp_ = 0; rp_ < ((PROF_PH) == 23 ? 2 : 1); ++rp_) {
        { RW_LANES();
#pragma unroll
        for (int e = 0; e < 8; ++e) { const int tl = 8 * w + e, prod = tl >> 4, ti = (tl >> 2) & 3, tj = tl & 3; f32x4 d = {0.f, 0.f, 0.f, 0.f};
            if (prod == 0) { d = mm_tile(B5, B3, ti, tj, fr, fq, d); d = mm_tile(B6, B7, ti, tj, fr, fq, d);
                *(GAS f32x4*)(RW_Z + (size_t)item * 4096 + (16 * tj + fr) * 64 + 4 * ((4 * ti + fq) ^ fr)) = d; }
            else if (prod == 1) { d = mm_tile(B9, B3, ti, tj, fr, fq, d); d = mm_tile(B10, B7, ti, tj, fr, fq, d);
                *(GAS unsigned long long*)(RW_YV + (size_t)item * 4096 + (16 * tj + fr) * 64 + 16 * ti + 4 * fq) = (unsigned long long)pk2(d[0], d[1]) | ((unsigned long long)pk2(d[2], d[3]) << 32); }
            else if (prod == 2) { d = mm_tile(B9, B0, ti, tj, fr, fq, d);
#pragma unroll
                for (int r = 0; r < 4; ++r) { const int t = 16 * ti + 4 * fq + r, c = 16 * tj + fr; B4[t * LD + sigpos(c)] = f2bf(d[r] + bf2f(B1[t * LD + c])); } }
            else { d = mm_tile(B5, B0, ti, tj, fr, fq, d);
#pragma unroll
                for (int r = 0; r < 4; ++r) { const int c = 16 * ti + 4 * fq + r, c2 = 16 * tj + fr; B8[c * LD + sigpos(c2)] = f2bf(d[r] + (c == c2 ? GC[c] : 0.f)); } } } }
        RW_BAR();
        }
        { RW_LANES(); const int r = tid >> 3, ch = (tid & 7) * 8;
          *(GAS v4u*)(RW_G + (size_t)item * 4096 + r * 64 + ch) = *(const LAS v4u*)(B4 + r * LD + ch);
          *(GAS v4u*)(RW_PT + (size_t)item * 4096 + r * 64 + 8 * ((tid & 7) ^ (r & 7))) = *(const LAS v4u*)(B8 + r * LD + ch); }
        RW_BAR();
        item = nxt;
    }
}
constexpr int SC_NS = 10, SC_SLOT = 12288, SC_LAG = 6;
__device__ __forceinline__ void scan_compute(LAS unsigned char* L, const ChunkBufs cb, int bh, int tj, int lane, volatile LAS unsigned* flags) {
    const int fr = lane & 15, fq = lane >> 4; const int NC = SEQ / 64;
    bf16x8 Bf0 = {0, 0, 0, 0, 0, 0, 0, 0}, Bf1 = {0, 0, 0, 0, 0, 0, 0, 0};
    bf16_t* s0 = cb.S0 + (size_t)(bh * NC) * 4096 + (16 * tj + fr) * 64 + 8 * fq;
    const int po0 = fr * 128 + 16 * ((fq) ^ (fr & 7)), po1 = fr * 128 + 16 * ((4 + fq) ^ (fr & 7)), pz = 8192 + fr * 256;
#define SC_WAIT(n) do { unsigned spins_ = 0; while (true) { const unsigned a_ = flags[0], b_ = flags[1], c_ = flags[2]; const unsigned m_ = a_ < b_ ? (a_ < c_ ? a_ : c_) : (b_ < c_ ? b_ : c_); if ((int)m_ >= (n) || ++spins_ > (1u << 22)) break; __builtin_amdgcn_s_sleep(1); } } while (0)
#define SC_READ(A0, A1, Z, slot_) do { const LAS unsigned char* sp_ = L + (slot_) * SC_SLOT; _Pragma("unroll") for (int ti = 0; ti < 4; ++ti) { A0[ti] = *(const LAS bf16x8*)(sp_ + ti * 2048 + po0); A1[ti] = *(const LAS bf16x8*)(sp_ + ti * 2048 + po1); Z[ti] = *(const LAS f32x4*)(sp_ + pz + 16 * ((4 * ti + fq) ^ fr)); } } while (0)
#define SC_STEP(A0, A1, Z, chunk_) do { \
        *(GAS bf16x8*)(s0 + (size_t)(chunk_) * 4096) = Bf0; *(GAS bf16x8*)(s0 + (size_t)(chunk_) * 4096 + 32) = Bf1; \
        f32x4 acc_[4]; _Pragma("unroll") for (int ti = 0; ti < 4; ++ti) { acc_[ti] = __builtin_amdgcn_mfma_f32_16x16x32_bf16(A0[ti], Bf0, Z[ti], 0, 0, 0); acc_[ti] = __builtin_amdgcn_mfma_f32_16x16x32_bf16(A1[ti], Bf1, acc_[ti], 0, 0, 0); } \
        v4u m0_, m1_; m0_.x = pk2(acc_[0][0], acc_[0][1]); m0_.y = pk2(acc_[0][2], acc_[0][3]); m0_.z = pk2(acc_[1][0], acc_[1][1]); m0_.w = pk2(acc_[1][2], acc_[1][3]); \
        m1_.x = pk2(acc_[2][0], acc_[2][1]); m1_.y = pk2(acc_[2][2], acc_[2][3]); m1_.z = pk2(acc_[3][0], acc_[3][1]); m1_.w = pk2(acc_[3][2], acc_[3][3]); \
        Bf0 = __builtin_bit_cast(bf16x8, m0_); Bf1 = __builtin_bit_cast(bf16x8, m1_); } while (0)
    bf16x8 xa0[4], xa1[4], ya0[4], ya1[4]; f32x4 xz[4], yz[4];
    SC_WAIT(1); SC_READ(xa0, xa1, xz, 0);
    asm volatile("s_waitcnt lgkmcnt(0)" ::: "memory"); if (lane == 0) flags[3] = 1u;
    int slot = 1;
    for (int chunk = 0; chunk < NC; chunk += 2) {
        SC_WAIT(chunk + 2); SC_READ(ya0, ya1, yz, slot); slot = slot + 1 == SC_NS ? 0 : slot + 1;
        SC_STEP(xa0, xa1, xz, chunk);
        asm volatile("s_waitcnt lgkmcnt(0)" ::: "memory"); if (lane == 0) flags[3] = (unsigned)(chunk + 2);
        if (chunk + 2 < NC) { SC_WAIT(chunk + 3); SC_READ(xa0, xa1, xz, slot); slot = slot + 1 == SC_NS ? 0 : slot + 1; }
        SC_STEP(ya0, ya1, yz, chunk + 1);
        asm volatile("s_waitcnt lgkmcnt(0)" ::: "memory"); if (lane == 0 && chunk + 2 < NC) flags[3] = (unsigned)(chunk + 3);
    }
#undef SC_WAIT
#undef SC_READ
#undef SC_STEP
}
__device__ __forceinline__ void scan_loader(LAS unsigned char* L, const ChunkBufs cb, int bh, int tj, int lw, int lane, volatile LAS unsigned* flags) {
    const int NC = SEQ / 64;
    const char* src[4];
#pragma unroll
    for (int k = 0; k < 4; ++k) { const int pc = 4 * lw + k;
        src[k] = pc < 8 ? (const char*)(cb.PT + (size_t)(bh * NC) * 4096) + pc * 1024 + lane * 16 : (const char*)(cb.Z + (size_t)(bh * NC) * 4096) + tj * 4096 + (pc - 8) * 1024 + lane * 16; }
    const size_t st0 = 8192, st1 = 16384;
    int slot = 0;
    for (int c = 0; c < NC; ++c) {
        unsigned spins = 0;
        while ((int)flags[3] < c - SC_NS + 1 && ++spins < (1u << 22)) __builtin_amdgcn_s_sleep(1);
        const unsigned dst = (unsigned)(slot * SC_SLOT + 4 * lw * 1024);
#pragma unroll
        for (int k = 0; k < 4; ++k) { const int pc = 4 * lw + k;
            __builtin_amdgcn_global_load_lds((const unsigned*)(src[k] + (size_t)c * (pc < 8 ? st0 : st1)), (LAS unsigned*)(L + dst + k * 1024), 16, 0, 0); }
        if (c >= SC_LAG) { asm volatile("s_waitcnt vmcnt(24)" ::: "memory"); if (lane == 0) flags[lw] = (unsigned)(c - SC_LAG + 1); }
        slot = slot + 1 == SC_NS ? 0 : slot + 1;
    }
    asm volatile("s_waitcnt vmcnt(0)" ::: "memory");
    if (lane == 0) flags[lw] = (unsigned)NC;
}
constexpr int O_SG = 0  , O_Y = 9216  , O_GT = O_Y + 16640  ;
struct OutRegs { v4u gc4, gp4, vo4; unsigned long long yw[2]; bf16x8 a[2][2], bb[2][2], b2[2][2]; float dot; f32x4 lw0, lw1, lb0, lb1; };
__device__ __forceinline__ void out_load(OutRegs& R, unsigned char* wsb, int layer, int item, int tid, int w) {
    const GAS bf16_t* P = RW_PROJ;
    const int lane = tid & 63, fr = lane & 15, fq = lane >> 4;
    const int bh = item / (SEQ / 64), chunk = item % (SEQ / 64), b = bh / 6, h = bh % 6; const int tok0 = b * SEQ + chunk * 64; const size_t ib = (size_t)item * 4096;
    const int t = tid >> 3, sub = tid & 7, tok = tok0 + t; const bool hp = (chunk * 64 + t) > 0;
    const GAS bf16_t* rc = P + (size_t)tok * LDP + 1856 + 8 * sub; const v4u z4 = {0u, 0u, 0u, 0u};
    R.gc4 = *(const GAS v4u*)rc; R.gp4 = hp ? *(const GAS v4u*)(rc - LDP) : z4;
#pragma unroll
    for (int e = 0; e < 2; ++e) { const int tl = 2 * w + e, ti = tl >> 2, tj = tl & 3;
        R.yw[e] = *(const GAS unsigned long long*)(RW_YV + ib + (16 * tj + fr) * 64 + 16 * ti + 4 * fq);
#pragma unroll
        for (int kk = 0; kk < 2; ++kk) { R.a[e][kk] = *(const GAS bf16x8*)(RW_G + ib + (16 * ti + fr) * 64 + 32 * kk + 8 * fq); R.bb[e][kk] = *(const GAS bf16x8*)(RW_S0 + ib + (16 * tj + fr) * 64 + 32 * kk + 8 * fq);
            R.b2[e][kk] = *(const GAS bf16x8*)(RW_LORA(mk::SM_G2T) + (size_t)(64 * h + 16 * tj + fr) * 64 + 32 * kk + 8 * fq); } }
    R.dot = RW_DOT[(size_t)tok * 6 + h]; R.vo4 = *(const GAS v4u*)(RW_VF + (size_t)tok * 384 + 64 * h + 8 * sub);
    R.lw0 = *(const GAS f32x4*)(RWP(mk::RP_LNW) + 64 * h + 8 * sub); R.lw1 = *(const GAS f32x4*)(RWP(mk::RP_LNW) + 64 * h + 8 * sub + 4); R.lb0 = *(const GAS f32x4*)(RWP(mk::RP_LNB) + 64 * h + 8 * sub); R.lb1 = *(const GAS f32x4*)(RWP(mk::RP_LNB) + 64 * h + 8 * sub + 4);
}
__device__ __forceinline__ void out_phase(LAS unsigned char* L, unsigned char* wsb, int layer, int tid_in, int first, int stride) {
    GAS bf16_t* MIX = RW_MIX;
    const int w = __builtin_amdgcn_readfirstlane(tid_in >> 6);
    LAS bf16_t* SG = (LAS bf16_t*)(L + O_SG); LAS float* Y = (LAS float*)(L + O_Y); LAS float* GT = (LAS float*)(L + O_GT);
    OutRegs R; if (first < NITEMS) { RW_LANES(); out_load(R, wsb, layer, first, tid, w); }
    for (int item = first; item < NITEMS; item += stride) {
        const int bh = item / (SEQ / 64), chunk = item % (SEQ / 64), b = bh / 6, h = bh % 6; const int tok0 = b * SEQ + chunk * 64;
        OutRegs N = R; if (item + stride < NITEMS) { RW_LANES(); out_load(N, wsb, layer, item + stride, tid, w); }
        { RW_LANES(); const int t = tid >> 3, sub = tid & 7;
          const f32x4 m0 = *(const GAS f32x4*)(RWP(mk::RP_MU) + 1216 + 8 * sub), m1 = *(const GAS f32x4*)(RWP(mk::RP_MU) + 1220 + 8 * sub);
          const unsigned cw_[4] = {R.gc4.x, R.gc4.y, R.gc4.z, R.gc4.w}, pw_[4] = {R.gp4.x, R.gp4.y, R.gp4.z, R.gp4.w}; unsigned o[4];
#pragma unroll
          for (int e2 = 0; e2 < 4; ++e2) { float x[2];
#pragma unroll
              for (int u = 0; u < 2; ++u) { const int e = 2 * e2 + u; const float c1 = bf2f((bf16_t)((cw_[e2] >> (16 * u)) & 0xffff)), p1 = bf2f((bf16_t)((pw_[e2] >> (16 * u)) & 0xffff));
                  x[u] = fsigm(c1 + (e < 4 ? m0[e & 3] : m1[e & 3]) * (p1 - c1)); }
              o[e2] = pk2(x[0], x[1]); }
          *(LAS v4u*)(SG + t * LD + 8 * sub) = (v4u){o[0], o[1], o[2], o[3]}; }
        RW_BAR();
        { RW_LANES();
#pragma unroll
        for (int e = 0; e < 2; ++e) { const int tl = 2 * w + e, ti = tl >> 2, tj = tl & 3; const unsigned long long yw = R.yw[e];
            f32x4 d = {bf2f((bf16_t)(yw & 0xffff)), bf2f((bf16_t)((yw >> 16) & 0xffff)), bf2f((bf16_t)((yw >> 32) & 0xffff)), bf2f((bf16_t)(yw >> 48))}; f32x4 g = {0.f, 0.f, 0.f, 0.f};
#pragma unroll
            for (int kk = 0; kk < 2; ++kk) {
                d = __builtin_amdgcn_mfma_f32_16x16x32_bf16(R.a[e][kk], R.bb[e][kk], d, 0, 0, 0);
                const bf16x8 a2 = *(const LAS bf16x8*)(SG + (16 * ti + fr) * LD + 32 * kk + 8 * fq);
                g = __builtin_amdgcn_mfma_f32_16x16x32_bf16(a2, R.b2[e][kk], g, 0, 0, 0); }
#pragma unroll
            for (int r = 0; r < 4; ++r) { Y[(16 * ti + 4 * fq + r) * 65 + 16 * tj + fr] = d[r]; GT[(16 * ti + 4 * fq + r) * 65 + 16 * tj + fr] = g[r]; } } }
        RW_BAR();
        { RW_LANES(); const int t = tid >> 3, sub = tid & 7, tok = tok0 + t; float yv[8], s = 0.f;
#pragma unroll
          for (int e = 0; e < 8; ++e) { yv[e] = Y[t * 65 + 8 * sub + e]; s += yv[e]; }
          s += __shfl_xor(s, 1); s += __shfl_xor(s, 2); s += __shfl_xor(s, 4);
          const float mean = s * (1.0f / 64.0f); float q = 0.f;
#pragma unroll
          for (int e = 0; e < 8; ++e) { const float dd = yv[e] - mean; q += dd * dd; }
          q += __shfl_xor(q, 1); q += __shfl_xor(q, 2); q += __shfl_xor(q, 4);
          const float rstd = __builtin_amdgcn_rsqf(q * (1.0f / 64.0f) + GN_EPS), dot = R.dot;
          const unsigned vw[4] = {R.vo4.x, R.vo4.y, R.vo4.z, R.vo4.w}; unsigned o[4];
#pragma unroll
          for (int e = 0; e < 8; e += 2) { float r2[2];
#pragma unroll
              for (int u = 0; u < 2; ++u) { const int ee = e + u; const float lw = ee < 4 ? R.lw0[ee & 3] : R.lw1[ee & 3], lb = ee < 4 ? R.lb0[ee & 3] : R.lb1[ee & 3];
                  const float yn = (yv[ee] - mean) * rstd * lw + lb; const float vv = bf2f((bf16_t)((vw[ee >> 1] >> (16 * (ee & 1))) & 0xffff));
                  r2[u] = (yn + dot * vv) * GT[t * 65 + 8 * sub + ee]; }
              o[e >> 1] = pk2(r2[0], r2[1]); }
          *(GAS v4u*)(MIX + (size_t)tok * DM + 384 + 64 * h + 8 * sub) = (v4u){o[0], o[1], o[2], o[3]}; }
        RW_BAR();
        R = N;
    }
}
}
namespace at {
constexpr int LDK = 72, LDV = 264;
constexpr int A_K = 0, A_V = 256 * LDK * 2  , A_BIAS = A_V + 64 * LDV * 2  , LDB = 256, BOFF = 48, A_END = A_BIAS + 6 * LDB * 4;
__device__ __forceinline__ int vpos(int key) { return (key & ~31) + 8 * ((key >> 2) & 3) + 4 * ((key >> 4) & 1) + (key & 3); }
__device__ __forceinline__ unsigned pk2(float lo, float hi) { typedef float f2_t __attribute__((ext_vector_type(2))); typedef __bf16 b2_t __attribute__((ext_vector_type(2))); f2_t v = {lo, hi}; return __builtin_bit_cast(unsigned, __builtin_convertvector(v, b2_t)); }
#define AT_BAR() do { asm volatile("s_waitcnt vmcnt(0) lgkmcnt(0)" ::: "memory"); __builtin_amdgcn_s_barrier(); asm volatile("" ::: "memory"); } while (0)

struct StageRegs { v4u k[4], v[4]; };
__device__ __forceinline__ void stage_issue(StageRegs& R, int tid, const bf16_t* kbase, const bf16_t* vbase, long pitch, int jvalid0) {
    const v4u z4 = {0u, 0u, 0u, 0u};
#pragma unroll
    for (int it = 0; it < 4; ++it) { const int idx = it * 512 + tid, key = idx >> 3, ch = idx & 7; R.k[it] = key >= jvalid0 ? *(const GAS v4u*)(kbase + (long)key * pitch + 8 * ch) : z4; }
#pragma unroll
    for (int it = 0; it < 4; ++it) { const int idx = it * 512 + tid, key = idx & 255, ch = idx >> 8; R.v[it] = key >= jvalid0 ? *(const GAS v4u*)(vbase + (long)key * pitch + 8 * ch) : z4; }
}
__device__ __forceinline__ void stage_commit(LAS unsigned char* L, const StageRegs& R, int tid, const float* gk) {
    LAS bf16_t* Kl = (LAS bf16_t*)(L + A_K); LAS bf16_t* VTl = (LAS bf16_t*)(L + A_V);
#pragma unroll
    for (int it = 0; it < 4; ++it) { const int idx = it * 512 + tid, key = idx >> 3, ch = idx & 7; const v4u raw = R.k[it];
        float f[8]; f[0] = __builtin_bit_cast(float, raw.x << 16); f[1] = __builtin_bit_cast(float, raw.x & 0xffff0000u); f[2] = __builtin_bit_cast(float, raw.y << 16); f[3] = __builtin_bit_cast(float, raw.y & 0xffff0000u);
        f[4] = __builtin_bit_cast(float, raw.z << 16); f[5] = __builtin_bit_cast(float, raw.z & 0xffff0000u); f[6] = __builtin_bit_cast(float, raw.w << 16); f[7] = __builtin_bit_cast(float, raw.w & 0xffff0000u);
        float ss = 0.f;
#pragma unroll
        for (int e = 0; e < 8; ++e) ss += f[e] * f[e];
        ss += __shfl_xor(ss, 1); ss += __shfl_xor(ss, 2); ss += __shfl_xor(ss, 4);
        const float rs = __builtin_amdgcn_rsqf(ss * (1.0f / 64.0f) + EPS);
        const f32x4 g0 = *(const GAS f32x4*)(gk + 8 * ch), g1 = *(const GAS f32x4*)(gk + 8 * ch + 4);
        v4u o; o.x = pk2(f[0] * rs * g0[0], f[1] * rs * g0[1]); o.y = pk2(f[2] * rs * g0[2], f[3] * rs * g0[3]); o.z = pk2(f[4] * rs * g1[0], f[5] * rs * g1[1]); o.w = pk2(f[6] * rs * g1[2], f[7] * rs * g1[3]);
        *(LAS v4u*)(Kl + key * LDK + 8 * ch) = o; }
#pragma unroll
    for (int it = 0; it < 4; ++it) { const int idx = it * 512 + tid, key = idx & 255, ch = idx >> 8; const v4u raw = R.v[it];
        LAS bf16_t* d = VTl + (8 * ch) * LDV + vpos(key);
        d[0 * LDV] = (bf16_t)(raw.x & 0xffff); d[1 * LDV] = (bf16_t)(raw.x >> 16); d[2 * LDV] = (bf16_t)(raw.y & 0xffff); d[3 * LDV] = (bf16_t)(raw.y >> 16);
        d[4 * LDV] = (bf16_t)(raw.z & 0xffff); d[5 * LDV] = (bf16_t)(raw.z >> 16); d[6 * LDV] = (bf16_t)(raw.w & 0xffff); d[7 * LDV] = (bf16_t)(raw.w >> 16); }
}
struct QRaw { v4u r0, r1; };
__device__ __forceinline__ QRaw q_raw(const bf16_t* qrow, int fq) { QRaw q; q.r0 = *(const GAS v4u*)(qrow + 8 * fq); q.r1 = *(const GAS v4u*)(qrow + 32 + 8 * fq); return q; }
__device__ __forceinline__ void q_finish(const QRaw qr, const float* gq, int fq, bf16x8& q0, bf16x8& q1) {
    float f[16]; const unsigned w[8] = {qr.r0.x, qr.r0.y, qr.r0.z, qr.r0.w, qr.r1.x, qr.r1.y, qr.r1.z, qr.r1.w};
#pragma unroll
    for (int e = 0; e < 8; ++e) { f[2 * e] = __builtin_bit_cast(float, w[e] << 16); f[2 * e + 1] = __builtin_bit_cast(float, w[e] & 0xffff0000u); }
    float ss = 0.f;
#pragma unroll
    for (int e = 0; e < 16; ++e) ss += f[e] * f[e];
    ss += __shfl_xor(ss, 16); ss += __shfl_xor(ss, 32);
    const float rs = 0.125f * __builtin_amdgcn_rsqf(ss * (1.0f / 64.0f) + EPS);
    const f32x4 g0 = *(const GAS f32x4*)(gq + 8 * fq), g1 = *(const GAS f32x4*)(gq + 8 * fq + 4), g2 = *(const GAS f32x4*)(gq + 32 + 8 * fq), g3 = *(const GAS f32x4*)(gq + 36 + 8 * fq);
    v4u a, b;
    a.x = pk2(f[0] * rs * g0[0], f[1] * rs * g0[1]); a.y = pk2(f[2] * rs * g0[2], f[3] * rs * g0[3]); a.z = pk2(f[4] * rs * g1[0], f[5] * rs * g1[1]); a.w = pk2(f[6] * rs * g1[2], f[7] * rs * g1[3]);
    b.x = pk2(f[8] * rs * g2[0], f[9] * rs * g2[1]); b.y = pk2(f[10] * rs * g2[2], f[11] * rs * g2[3]); b.z = pk2(f[12] * rs * g3[0], f[13] * rs * g3[1]); b.w = pk2(f[14] * rs * g3[2], f[15] * rs * g3[3]);
    q0 = __builtin_bit_cast(bf16x8, a); q1 = __builtin_bit_cast(bf16x8, b);
}
template <int NT, bool SWA> __device__ __forceinline__ void attn_wave(const LAS unsigned char* L, bf16x8 q0, bf16x8 q1, int kt0, int qi0, int hq, float sink, bool first_block, bf16_t* outp, int fr, int fq) {
    const LAS bf16_t* Kl = (const LAS bf16_t*)(L + A_K); const LAS bf16_t* VTl = (const LAS bf16_t*)(L + A_V); const LAS float* bias = (const LAS float*)(L + A_BIAS);
    f32x4 s[NT];
#pragma unroll
    for (int t = 0; t < NT; ++t) { const LAS bf16_t* kr = Kl + (16 * (kt0 + t) + fr) * LDK + 8 * fq;
        const f32x4 z = {0.f, 0.f, 0.f, 0.f};
        s[t] = __builtin_amdgcn_mfma_f32_16x16x32_bf16(*(const LAS bf16x8*)kr, q0, z, 0, 0, 0);
        s[t] = __builtin_amdgcn_mfma_f32_16x16x32_bf16(*(const LAS bf16x8*)(kr + 32), q1, s[t], 0, 0, 0);
        if (t & 1) __builtin_amdgcn_sched_barrier(0); }
    float mx = SWA ? sink : -3.0e38f;
    if (SWA) {
        const int odd = (qi0 >> 4) & 1; const int D0 = qi0 + fr + 128 - 16 * kt0 - 4 * fq;
        const LAS float* bp = bias + hq * LDB + BOFF + D0 - 147;
#pragma unroll
        for (int t = 0; t < NT; ++t) { const int c = t - odd;
            if (c >= 1 && c <= 7 && !first_block) {
#pragma unroll
                for (int r = 0; r < 4; ++r) { s[t][r] += bp[147 - 16 * t - r]; mx = fmaxf(mx, s[t][r]); }
            } else {
#pragma unroll
                for (int r = 0; r < 4; ++r) { const int dist = D0 - 16 * t - r; const bool valid = (unsigned)dist < 128u && !(first_block && 16 * (kt0 + t) + 4 * fq + r < 128);
                    s[t][r] = valid ? s[t][r] + bp[147 - 16 * t - r] : -3.0e38f; mx = fmaxf(mx, s[t][r]); } } }
    } else {
#pragma unroll
        for (int t = 0; t < NT; ++t)
#pragma unroll
            for (int r = 0; r < 4; ++r) mx = fmaxf(mx, s[t][r]);
    }
    mx = fmaxf(mx, __shfl_xor(mx, 16)); mx = fmaxf(mx, __shfl_xor(mx, 32));
    float l = 0.f;
#pragma unroll
    for (int t = 0; t < NT; ++t)
#pragma unroll
        for (int r = 0; r < 4; ++r) { const float p = __expf(s[t][r] - mx); s[t][r] = p; l += p; }
    l += __shfl_xor(l, 16); l += __shfl_xor(l, 32);
    if (SWA) l += __expf(sink - mx);
    f32x4 o[4];
#pragma unroll
    for (int dt = 0; dt < 4; ++dt) o[dt] = (f32x4){0.f, 0.f, 0.f, 0.f};
#pragma unroll
    for (int ks = 0; ks < NT / 2; ++ks) { v4u pw; pw.x = pk2(s[2 * ks][0], s[2 * ks][1]); pw.y = pk2(s[2 * ks][2], s[2 * ks][3]); pw.z = pk2(s[2 * ks + 1][0], s[2 * ks + 1][1]); pw.w = pk2(s[2 * ks + 1][2], s[2 * ks + 1][3]);
        const bf16x8 pb = __builtin_bit_cast(bf16x8, pw);
#pragma unroll
        for (int dt = 0; dt < 4; ++dt) o[dt] = __builtin_amdgcn_mfma_f32_16x16x32_bf16(*(const LAS bf16x8*)(VTl + (16 * dt + fr) * LDV + 32 * (kt0 / 2 + ks) + 8 * fq), pb, o[dt], 0, 0, 0);
        __builtin_amdgcn_sched_barrier(0); }
    const float inv = __builtin_amdgcn_rcpf(l);
#pragma unroll
    for (int dt = 0; dt < 4; ++dt) *(GAS unsigned long long*)(outp + (long)fr * DM + 16 * dt + 4 * fq) = (unsigned long long)pk2(o[dt][0] * inv, o[dt][1] * inv) | ((unsigned long long)pk2(o[dt][2] * inv, o[dt][3] * inv) << 32);
}
__device__ __forceinline__ void swa_wave3(const LAS unsigned char* L, const bf16x8 (&q0)[3], const bf16x8 (&q1)[3], int kt0, int qi0, int hq0, const float (&sink)[3], bool first_block, bf16_t* outp, int fr, int fq) {
    constexpr int NT = 10;
    const LAS bf16_t* Kl = (const LAS bf16_t*)(L + A_K); const LAS bf16_t* VTl = (const LAS bf16_t*)(L + A_V); const LAS float* bias = (const LAS float*)(L + A_BIAS);
    f32x4 s[3][NT];
#pragma unroll
    for (int t = 0; t < NT; ++t) { const LAS bf16_t* kr = Kl + (16 * (kt0 + t) + fr) * LDK + 8 * fq; const bf16x8 k0 = *(const LAS bf16x8*)kr, k1 = *(const LAS bf16x8*)(kr + 32);
        const f32x4 z = {0.f, 0.f, 0.f, 0.f};
#pragma unroll
        for (int g = 0; g < 3; ++g) { s[g][t] = __builtin_amdgcn_mfma_f32_16x16x32_bf16(k0, q0[g], z, 0, 0, 0); s[g][t] = __builtin_amdgcn_mfma_f32_16x16x32_bf16(k1, q1[g], s[g][t], 0, 0, 0); }
        if (t & 1) __builtin_amdgcn_sched_barrier(0); }
    const int odd = (qi0 >> 4) & 1; const int D0 = qi0 + fr + 128 - 16 * kt0 - 4 * fq;
    float inv[3];
#pragma unroll
    for (int g = 0; g < 3; ++g) { const LAS float* bp = bias + (hq0 + g) * LDB + BOFF + D0 - 147; float mx = sink[g];
#pragma unroll
        for (int t = 0; t < NT; ++t) { const int c = t - odd;
            if (c >= 1 && c <= 7 && !first_block) {
#pragma unroll
                for (int r = 0; r < 4; ++r) { s[g][t][r] += bp[147 - 16 * t - r]; mx = fmaxf(mx, s[g][t][r]); }
            } else {
#pragma unroll
                for (int r = 0; r < 4; ++r) { const int dist = D0 - 16 * t - r; const bool valid = (unsigned)dist < 128u && !(first_block && 16 * (kt0 + t) + 4 * fq + r < 128);
                    s[g][t][r] = valid ? s[g][t][r] + bp[147 - 16 * t - r] : -3.0e38f; mx = fmaxf(mx, s[g][t][r]); } } }
        mx = fmaxf(mx, __shfl_xor(mx, 16)); mx = fmaxf(mx, __shfl_xor(mx, 32));
        float l = 0.f;
#pragma unroll
        for (int t = 0; t < NT; ++t)
#pragma unroll
            for (int r = 0; r < 4; ++r) { const float p = __expf(s[g][t][r] - mx); s[g][t][r] = p; l += p; }
        l += __shfl_xor(l, 16); l += __shfl_xor(l, 32); l += __expf(sink[g] - mx);
        inv[g] = __builtin_amdgcn_rcpf(l); }
    f32x4 o[3][4];
#pragma unroll
    for (int g = 0; g < 3; ++g)
#pragma unroll
        for (int dt = 0; dt < 4; ++dt) o[g][dt] = (f32x4){0.f, 0.f, 0.f, 0.f};
#pragma unroll
    for (int ks = 0; ks < NT / 2; ++ks) { bf16x8 pb[3];
#pragma unroll
        for (int g = 0; g < 3; ++g) { v4u pw; pw.x = pk2(s[g][2 * ks][0], s[g][2 * ks][1]); pw.y = pk2(s[g][2 * ks][2], s[g][2 * ks][3]); pw.z = pk2(s[g][2 * ks + 1][0], s[g][2 * ks + 1][1]); pw.w = pk2(s[g][2 * ks + 1][2], s[g][2 * ks + 1][3]); pb[g] = __builtin_bit_cast(bf16x8, pw); }
#pragma unroll
        for (int dt = 0; dt < 4; ++dt) { const bf16x8 vf = *(const LAS bf16x8*)(VTl + (16 * dt + fr) * LDV + 32 * (kt0 / 2 + ks) + 8 * fq);
#pragma unroll
            for (int g = 0; g < 3; ++g) o[g][dt] = __builtin_amdgcn_mfma_f32_16x16x32_bf16(vf, pb[g], o[g][dt], 0, 0, 0); }
        __builtin_amdgcn_sched_barrier(0); }
#pragma unroll
    for (int g = 0; g < 3; ++g)
#pragma unroll
        for (int dt = 0; dt < 4; ++dt) *(GAS unsigned long long*)(outp + (long)fr * DM + 64 * g + 16 * dt + 4 * fq) = (unsigned long long)pk2(o[g][dt][0] * inv[g], o[g][dt][1] * inv[g]) | ((unsigned long long)pk2(o[g][dt][2] * inv[g], o[g][dt][3] * inv[g]) << 32);
}
struct AttnArgs { const bf16_t* PROJ; const bf16_t* MKV; bf16_t* MIX; const float* biastab; const float *sinks, *gq, *gk, *gmq, *gmk; };
__device__ __forceinline__ void item_stage_issue(StageRegs& R, const AttnArgs A, int q, int tid) {
    if (q >= 256) { const int item = q - 256, b = item >> 7, hkv = (item >> 6) & 1, blk = item & 63; const long tokb = (long)b * SEQ + blk * 128;
        stage_issue(R, tid, A.PROJ + (tokb - 128) * LDP + 384 + 64 * hkv, A.PROJ + (tokb - 128) * LDP + 512 + 64 * hkv, LDP, blk == 0 ? 128 : 0); }
    else { const int b = q >> 7, h = (q >> 5) & 3; stage_issue(R, tid, A.MKV + (long)(b * 256) * 512 + 64 * h, A.MKV + (long)(b * 256) * 512 + 256 + 64 * h, 512, 0); }
}
__device__ __forceinline__ void attn_phase(LAS unsigned char* L, const AttnArgs A, unsigned* qctr, volatile LAS unsigned* qw, int tid_in) {
    const int w = __builtin_amdgcn_readfirstlane(tid_in >> 6);
    { int lt_ = tid_in; asm volatile("" : "+v"(lt_)); const int tid = lt_;
      LAS float* bl = (LAS float*)(L + A_BIAS); for (int i = tid; i < 6 * LDB; i += 512) { const int hh = i / LDB, d = i % LDB - BOFF; bl[i] = (d >= 0 && d < 128) ? A.biastab[d * 6 + hh] : 0.f; } }
    if (tid_in == 0) qw[0] = atomicAdd(qctr, 1u);
    AT_BAR(); int q = (int)qw[0]; AT_BAR();
    StageRegs SR; if (q < 512) { int lt_ = tid_in; asm volatile("" : "+v"(lt_)); item_stage_issue(SR, A, q, lt_); }
    while (q < 512) {
        int lt_ = tid_in; asm volatile("" : "+v"(lt_)); const int tid = lt_, lane = lt_ & 63, fr = lane & 15, fq = lane >> 4;
        const bool swa = q >= 256;
        stage_commit(L, SR, tid, swa ? A.gk : A.gmk);
        QRaw qa, qb, qc; int b, hh, blk;
        if (swa) { const int item = q - 256; b = item >> 7; hh = (item >> 6) & 1; blk = item & 63; const bf16_t* qp = A.PROJ + ((long)b * SEQ + blk * 128 + 16 * w + fr) * LDP + 192 * hh;
            qa = q_raw(qp, fq); qb = q_raw(qp + 64, fq); qc = q_raw(qp + 128, fq); }
        else { b = q >> 7; hh = (q >> 5) & 3; blk = q & 31; const bf16_t* qp = A.PROJ + ((long)b * SEQ + (2 * blk) * 128 + 16 * w + fr) * LDP + 1984 + 64 * hh;
            qa = q_raw(qp, fq); qb = q_raw(qp + (long)128 * LDP, fq); qc = qb; }
        if (tid_in == 0) qw[0] = atomicAdd(qctr, 1u);
        AT_BAR(); const int qn = (int)qw[0];
        if (qn < 512) item_stage_issue(SR, A, qn, tid);
        if (swa) { const long tokb = (long)b * SEQ + blk * 128; bf16x8 q0[3], q1[3];
            q_finish(qa, A.gq, fq, q0[0], q1[0]); q_finish(qb, A.gq, fq, q0[1], q1[1]); q_finish(qc, A.gq, fq, q0[2], q1[2]);
            const float sk3[3] = {A.sinks[3 * hh], A.sinks[3 * hh + 1], A.sinks[3 * hh + 2]};
            swa_wave3(L, q0, q1, w & ~1, 16 * w, 3 * hh, sk3, blk == 0, A.MIX + (tokb + 16 * w) * DM + 192 * hh, fr, fq); }
        else {
#pragma unroll 1
            for (int u = 0; u < 2; ++u) { const long tokb = (long)b * SEQ + (2 * blk + u) * 128; bf16x8 q0, q1; const QRaw cq = u == 0 ? qa : qb; q_finish(cq, A.gmq, fq, q0, q1);
                attn_wave<16, false>(L, q0, q1, 0, 16 * w, 0, 0.f, false, A.MIX + (tokb + 16 * w) * DM + 768 + 64 * hh, fr, fq); } }
        AT_BAR();
        q = qn;
    }
}
}
constexpr int NWAVES = 8;
namespace mk {
#ifndef PROF_PH
#define PROF_PH -1
#endif
#ifndef PROF_N
#define PROF_N 1
#endif
#ifndef PROF_TA
#define PROF_TA -1
#endif
#ifndef PROF_TB
#define PROF_TB -1
#endif
#define REPEAT(k) for (int rep_ = 0; rep_ < ((PROF_PH) == (k) ? (PROF_N) : 1); ++rep_)
#ifndef FAST_RWKV
#define FAST_RWKV 1
#endif
#ifndef FAST_ATTN
#define FAST_ATTN 1
#endif

struct Args { const float* in[N_IN]; float* out; unsigned char* ws; int ph_lo, ph_hi; };

__device__ __forceinline__ unsigned pk2(float lo, float hi) { typedef float f2_t __attribute__((ext_vector_type(2))); typedef __bf16 b2_t __attribute__((ext_vector_type(2))); f2_t v = {lo, hi}; return __builtin_bit_cast(unsigned, __builtin_convertvector(v, b2_t)); }
__device__ __forceinline__ float wave_sum(float v) {
#pragma unroll
    for (int o = 1; o < 64; o <<= 1) v += __shfl_xor(v, o);
    return v;
}
template <int MODE> __device__ __forceinline__ void transpose_item(const float* W, const float* g, int K, int N, bf16_t* WT, LAS float* scr, int item, int lane) {
    const int nblk = N / 32, kb = item / nblk, nb = item % nblk, k0 = 64 * kb, n0 = 32 * nb;
    float tv[32];
#pragma unroll
    for (int i = 0; i < 32; ++i) tv[i] = W[(size_t)(k0 + 2 * i + (lane >> 5)) * N + n0 + (lane & 31)];
#pragma unroll
    for (int i = 0; i < 32; ++i) { const int kk = 2 * i + (lane >> 5); float v = tv[i]; if (g) v *= g[k0 + kk]; scr[kk * 33 + (lane & 31)] = v; }
    LDS_WAIT(); asm volatile("" ::: "memory");
    const int c = lane & 7;
#pragma unroll
    for (int j = 0; j < 4; ++j) { const int n = (lane >> 3) + 8 * j; const LAS float* s = scr + (8 * c) * 33 + n;
        v4u o; o.x = pk2(s[0 * 33], s[1 * 33]); o.y = pk2(s[2 * 33], s[3 * 33]); o.z = pk2(s[4 * 33], s[5 * 33]); o.w = pk2(s[6 * 33], s[7 * 33]);
        int nr = n0 + n; if (MODE == 2) nr = nr < 1920 ? nr : nr + 64;
        if (MODE == 1) nr = nr < 2816 ? 256 * (nr >> 7) + (nr & 127) : 256 * ((nr - 2816) >> 7) + 128 + ((nr - 2816) & 127);
        *(GAS v4u*)(WT + (size_t)nr * K + k0 + 8 * c) = o; }
    LDS_WAIT(); asm volatile("" ::: "memory");
}
template <int R> __device__ __forceinline__ void rows_to_bf16(const float* x, bf16_t* o, float* ssq, long row0, long rstride, int lane) {
    f32x4 v[R][4]; float s[R];
#pragma unroll
    for (int r = 0; r < R; ++r) { const GAS f32x4* xr = (const GAS f32x4*)(x + (row0 + r * rstride) * DM) + lane;
#pragma unroll
        for (int j = 0; j < 4; ++j) v[r][j] = xr[64 * j]; }
#pragma unroll
    for (int r = 0; r < R; ++r) { s[r] = 0.f;
#pragma unroll
        for (int j = 0; j < 4; ++j) s[r] += (v[r][j].x * v[r][j].x + v[r][j].y * v[r][j].y) + (v[r][j].z * v[r][j].z + v[r][j].w * v[r][j].w); }
#pragma unroll
    for (int o2 = 1; o2 < 64; o2 <<= 1) {
#pragma unroll
        for (int r = 0; r < R; ++r) s[r] += __shfl_xor(s[r], o2); }
#pragma unroll
    for (int r = 0; r < R; ++r) { GAS unsigned long long* o8 = (GAS unsigned long long*)(o + (row0 + r * rstride) * DM) + lane;
#pragma unroll
        for (int j = 0; j < 4; ++j) o8[64 * j] = (unsigned long long)pk2(v[r][j].x, v[r][j].y) | ((unsigned long long)pk2(v[r][j].z, v[r][j].w) << 32);
        if (lane == 0) ssq[row0 + r * rstride] = s[r]; }
}
__device__ __forceinline__ void row_to_bf16(const float* xrow, bf16_t* orow, float* ssq_out, int lane) {
    const GAS f32x4* xr = (const GAS f32x4*)xrow + lane; f32x4 v[4]; float s = 0.f;
#pragma unroll
    for (int j = 0; j < 4; ++j) { v[j] = xr[64 * j]; s += (v[j].x * v[j].x + v[j].y * v[j].y) + (v[j].z * v[j].z + v[j].w * v[j].w); }
    s = wave_sum(s);
    GAS unsigned long long* o8 = (GAS unsigned long long*)orow + lane;
#pragma unroll
    for (int j = 0; j < 4; ++j) o8[64 * j] = (unsigned long long)pk2(v[j].x, v[j].y) | ((unsigned long long)pk2(v[j].z, v[j].w) << 32);
    if (lane == 0) *ssq_out = s;
}

__global__ void __launch_bounds__(NWAVES * 64, 2) mk_fwd(Args args) {
    extern __shared__ __attribute__((aligned(16))) unsigned char lds[];
    LAS unsigned char* L = (LAS unsigned char*)lds;
    volatile LAS unsigned* MISC = (volatile LAS unsigned*)(L + MISC_OFF);
    const int tid0 = threadIdx.x; const int wave0 = __builtin_amdgcn_readfirstlane(tid0 >> 6);
    const int G = gridDim.x;
    unsigned char* ws = args.ws;
    gu32* ctl = (gu32*)(ws + WS_CTL);
    for (int u = tid0; u < (LDS_BYTES - LDSCTL_OFF) / 4; u += NWAVES * 64) ((LAS unsigned*)(L + LDSCTL_OFF))[u] = 0u;
    __syncthreads();
    XcdBarrier bar = xcd_barrier_post((unsigned*)(ctl + CW_BAR), MISC + 8);
    const int lo = args.ph_lo, hi = args.ph_hi;
    int ph = 0;
#define PH_BEGIN if (lo <= ph && ph < hi) { if ((PROF_TA) >= 0 && blockIdx.x == 0 && tid0 == 0) MISC[24 + ph] = (unsigned)__builtin_amdgcn_s_memrealtime(); unsigned char* wsp = args.ws; asm volatile("" : "+s"(wsp)); int tid = wave0 * 64 + (int)__builtin_amdgcn_mbcnt_hi(~0u, __builtin_amdgcn_mbcnt_lo(~0u, 0u)); asm volatile("" : "+v"(tid)); const int lane = tid & 63, wave = __builtin_amdgcn_readfirstlane(tid >> 6); const long gtid = (long)blockIdx.x * (NWAVES * 64) + tid; const int gw = blockIdx.x * NWAVES + wave; LAS float* scr = (LAS float*)(L + wave * 16384); (void)lane; (void)gtid; (void)gw; (void)scr;
#define PH_END   if (ph + 1 < hi) { xcd_barrier(bar); if ((PROF_PH) == 30 && ph == 3) for (int xb_ = 0; xb_ < 10; ++xb_) xcd_barrier(bar); } } ++ph;
    float* out = args.out;
#define SSQ_A ((float*)(wsp + WS_CTL + CTL_SSQ))
#define SSQ_B (SSQ_A + 3 * MTOK)
#define biastab ((float*)(wsp + WS_SMALL + SM_BIAS))
#define ssqm ((float*)(wsp + WS_SMALL + SM_SSQM))
#define MKV ((bf16_t*)(wsp + WS_SMALL + SM_MKV))
#define MEMB ((bf16_t*)(wsp + WS_MEMB))
#define Wt_in ((bf16_t*)(wsp + (l == 0 ? WS_WT + WT_IN : WS_WIN1)))
#define Wt_out ((bf16_t*)(wsp + WS_WT + WT_OUT))
#define Wt_up ((bf16_t*)(wsp + WS_WT + WT_UP))
#define Wt_down ((bf16_t*)(wsp + WS_WT + WT_DOWN))
#define Wt_mkv ((bf16_t*)(wsp + (l == 0 ? WS_WT + WT_MKV : WS_WIN1 + 4718592)))
#define XB ((bf16_t*)(wsp + WS_XB))
#define VF ((bf16_t*)(wsp + WS_VF))
#define PROJ ((bf16_t*)(wsp + WS_PROJ))
#define MIX ((bf16_t*)(wsp + WS_MIX))
#define U ((bf16_t*)(wsp + WS_U))
#define ACT ((bf16_t*)(wsp + WS_ACT))
#define PA ((size_t)MTOK * 384)
#define pR ((bf16_t*)(wsp + WS_PREP))
#define pK (pR + PA)
#define pV (pR + 2 * PA)
#define pKK (pR + 3 * PA)
#define pB (pR + 4 * PA)
#define pLD (pR + 5 * PA)
    const long gsize = (long)G * (NWAVES * 64);
    const int NGW = G * NWAVES;

#define MK_W() sk::RwkvW W{args.in[I_MU] + l * 1280, args.in[I_MUV], args.in[I_W0] + l * 384, args.in[I_W2] + l * 32 * 384, args.in[I_A0] + l * 384, args.in[I_A2] + l * 32 * 384, args.in[I_V0], args.in[I_V2], args.in[I_G2] + l * 64 * 384, args.in[I_KK] + l * 384, args.in[I_KA] + l * 384, args.in[I_RK] + l * 384, args.in[I_LNW] + l * 384, args.in[I_LNB] + l * 384};
#define MK_CBUF() const rw::ChunkBufs cbuf{(bf16_t*)(wsp + WS_PT), (bf16_t*)(wsp + WS_G), (float*)(wsp + WS_Z), (bf16_t*)(wsp + WS_YV), (bf16_t*)(wsp + WS_S0), (bf16_t*)(wsp + WS_VF), (float*)(wsp + WS_DOT), (const bf16_t*)(wsp + WS_SMALL + SM_W2T + l * SM_LORA_L), (const bf16_t*)(wsp + WS_SMALL + SM_A2T + l * SM_LORA_L), (const bf16_t*)(wsp + WS_SMALL + SM_V2T + l * SM_LORA_L), (const bf16_t*)(wsp + WS_SMALL + SM_G2T + l * SM_LORA_L)};
    for (int l = 0; l < 2; ++l) {
        const float* xin = l == 0 ? args.in[I_X] : out;
        if (l == 0) {
        PH_BEGIN
            REPEAT(0) {
            const int I_IN = 16 * 68, I_KV = 16 * 16, NIT = 2 * (I_IN + I_KV);
            for (int it = gw; it < NIT; it += NGW) {
                int r = it; const int ll = r >= I_IN + I_KV ? 1 : 0; r -= ll * (I_IN + I_KV);
                bf16_t* win = (bf16_t*)(wsp + (ll == 0 ? WS_WT + WT_IN : WS_WIN1)); bf16_t* wkv = (bf16_t*)(wsp + (ll == 0 ? WS_WT + WT_MKV : WS_WIN1 + 4718592));
                if (r < I_IN) transpose_item<2>(args.in[I_WIN] + (size_t)ll * 1024 * 2176, args.in[I_MIXG] + ll * 1024, 1024, 2176, win, scr, r, lane);
                else transpose_item<0>(args.in[I_WMKV] + (size_t)ll * 1024 * 512, args.in[I_MEMG] + ll * 1024, 1024, 512, wkv, scr, r - I_IN, lane);
            }
            for (long i = gtid; i < 2 * 128 * 1024; i += gsize) { const int ll = (int)(i >> 17), n = (int)(i >> 10) & 127, k = (int)(i & 1023); float v = 0.f;
                if (ll > 0 && n < 16) v = args.in[I_WINV][k * 16 + n] * args.in[I_MIXG][1024 + k];
                ((bf16_t*)(wsp + (ll == 0 ? WS_WT + WT_IN : WS_WIN1)))[(size_t)(n < 64 ? 1920 + n : 2176 + n) * 1024 + k] = f2bf(v); }
            for (long i = gtid; i < 2 * RP_SIZE; i += gsize) { const int ll = (int)(i / RP_SIZE), r = (int)(i % RP_SIZE); float v;
                if (r < RP_MUV) v = args.in[I_MU][ll * 1280 + r]; else if (r < RP_W0) v = args.in[I_MUV][r - RP_MUV]; else if (r < RP_A0) v = args.in[I_W0][ll * 384 + r - RP_W0];
                else if (r < RP_V0) v = args.in[I_A0][ll * 384 + r - RP_A0]; else if (r < RP_KK) v = args.in[I_V0][r - RP_V0]; else if (r < RP_KA) v = args.in[I_KK][ll * 384 + r - RP_KK];
                else if (r < RP_RK) v = args.in[I_KA][ll * 384 + r - RP_KA]; else if (r < RP_LNW) v = args.in[I_RK][ll * 384 + r - RP_RK]; else if (r < RP_LNB) v = args.in[I_LNW][ll * 384 + r - RP_LNW];
                else v = args.in[I_LNB][ll * 384 + r - RP_LNB];
                ((float*)(wsp + WS_SMALL + SM_RWP + ll * RWP_BYTES))[r] = v; }
            for (long i = gtid; i < 2 * 384 * 160; i += gsize) { const int ll = (int)(i / (384 * 160)), r2 = (int)(i % (384 * 160)), hc = r2 / 160, j = r2 % 160; bf16_t* sm = (bf16_t*)(wsp + WS_SMALL + ll * SM_LORA_L);
                if (j < 32) sm[SM_W2T / 2 + hc * 32 + j] = f2bf(args.in[I_W2][(size_t)ll * 32 * 384 + j * 384 + hc]);
                else if (j < 64) sm[SM_A2T / 2 + hc * 32 + (j - 32)] = f2bf(args.in[I_A2][(size_t)ll * 32 * 384 + (j - 32) * 384 + hc]);
                else if (j < 96) sm[SM_V2T / 2 + hc * 32 + (j - 64)] = f2bf((j - 64) < 16 ? args.in[I_V2][(j - 64) * 384 + hc] : 0.f);
                else sm[SM_G2T / 2 + hc * 64 + (j - 96)] = f2bf(args.in[I_G2][(size_t)ll * 64 * 384 + (j - 96) * 384 + hc]); }
            if (MTOK % (4 * NGW) == 0) { for (long m = gw; m < MTOK; m += 4L * NGW) rows_to_bf16<4>(args.in[I_X], XB, SSQ_A, m, NGW, lane); }
            else { for (int m = gw; m < MTOK; m += NGW) row_to_bf16(args.in[I_X] + (size_t)m * DM, XB + (size_t)m * DM, SSQ_A + m, lane); }
            for (int m = gw; m < 512; m += NGW) row_to_bf16(args.in[I_MEM] + (size_t)m * DM, MEMB + (size_t)m * DM, ssqm + m, lane);
            sk::d_biastab(args.in[I_RELB], biastab, gtid, gsize);
            }
        PH_END
        }
        PH_BEGIN
            REPEAT(1)
            { pg8::Gemm g{XB, Wt_in, MTOK, 2048, 1024}; pg8::StaticOrder S; S.init(MTOK, 2048, G, (int)blockIdx.x);
              pg8::EpiScaleBf16 E{PROJ, LDP, SSQ_A + (size_t)l * MTOK};
              pg8::gemm_phase<pg8::EpiScaleBf16, pg8::StaticOrder, true, true>(L, g, S, E, tid); }
        PH_END
        PH_BEGIN
            MK_W(); MK_CBUF(); (void)cbuf;
#if !FAST_ATTN
            sk::d_qknorm(PROJ, MTOK, LDP, args.in[I_AQN] + l * 64, args.in[I_AKN] + l * 64, args.in[I_MQN] + l * 64, 0, gtid, gsize);
            sk::d_qknorm(MKV, 512, 512, nullptr, nullptr, args.in[I_MKN] + l * 64, 1, gtid, gsize);
#endif
#if FAST_RWKV
            {
              const bool t8 = blockIdx.x < 64;
              const pg8::Gemm g = t8 ? pg8::Gemm{XB, Wt_in + (size_t)2048 * 1024, MTOK, 256, 1024} : pg8::Gemm{MEMB, Wt_mkv, 512, 512, 1024};
              pg8::StaticOrder S; if (t8) S.init(MTOK, 256, G, (int)blockIdx.x); else S.init(512, 512, G, (int)((blockIdx.x + 192) % G));
              const pg8::EpiScaleBf16 E = t8 ? pg8::EpiScaleBf16{PROJ + 2048, LDP, SSQ_A + (size_t)l * MTOK} : pg8::EpiScaleBf16{MKV, 512, ssqm};
              pg8::gemm_phase<pg8::EpiScaleBf16, pg8::StaticOrder, true, true>(L, g, S, E, tid); }
            { unsigned* qc = (unsigned*)(ctl + CW_CHQ + 64 * l);
              int q = rw::chunk_phase(L, wsp, l, tid, qc, MISC + 21);
              const int I_OUT = 16 * 32, I_UP = 16 * 176, I_DN = 44 * 32, NIT = I_OUT + I_UP + I_DN;
              for (;;) { const int it = (q - rw::NITEMS) * NWAVES + wave;
                  if ((q - rw::NITEMS) * NWAVES >= NIT) break;
                  if (it < NIT) { int r = it;
                      if (r < I_OUT) transpose_item<0>(args.in[I_WOUT] + (size_t)l * 1024 * 1024, nullptr, 1024, 1024, Wt_out, scr, r, lane);
                      else if (r < I_OUT + I_UP) transpose_item<1>(args.in[I_WUP] + (size_t)l * 1024 * 5632, args.in[I_FFNG] + l * 1024, 1024, 5632, Wt_up, scr, r - I_OUT, lane);
                      else transpose_item<0>(args.in[I_WDOWN] + (size_t)l * 2816 * 1024, nullptr, 2816, 1024, Wt_down, scr, r - I_OUT - I_UP, lane); }
                  __syncthreads(); if (tid == 0) MISC[21] = atomicAdd(qc, 1u); __syncthreads(); q = (int)MISC[21]; __syncthreads(); } }
#else
            sk::d_rwkv_prep(PROJ, W, l, VF, pR, pK, pV, pKK, pB, pLD, gtid, gsize);
#endif
        PH_END
        PH_BEGIN
            MK_CBUF(); (void)cbuf;
            const int sx = (int)blockIdx.x & 7, sq = (int)blockIdx.x >> 3;
            if (sx < 6 && sq < 8) {
#if FAST_RWKV
                REPEAT(3) { __syncthreads(); if (tid < 8) MISC[16 + tid] = 0u; __syncthreads();
                  const int sbh = 2 * sx + (sq >> 2), stj = sq & 3;
                  if (wave == 0) rw::scan_compute(L, cbuf, sbh, stj, lane, MISC + 16); else if (wave < 4) rw::scan_loader(L, cbuf, sbh, stj, wave - 1, lane, MISC + 16);
 }
#endif
            } else {
#if FAST_ATTN
                const at::AttnArgs A{PROJ, MKV, MIX, biastab, args.in[I_SINK] + l * 6, args.in[I_AQN] + l * 64, args.in[I_AKN] + l * 64, args.in[I_MQN] + l * 64, args.in[I_MKN] + l * 64};
                at::attn_phase(L, A, (unsigned*)(ctl + CW_ATTQ + 64 * l), MISC + 20, tid);
#else
                const long gt2 = (long)(blockIdx.x - BATCH * 6) * (NWAVES * 64) + tid, gs2 = (long)(G - BATCH * 6) * (NWAVES * 64);
                REPEAT(7) sk::d_swa(PROJ, MIX, biastab, args.in[I_SINK] + l * 6, gt2, gs2);
                REPEAT(8) sk::d_memattn(PROJ, MKV, MIX, gt2, gs2);
#endif
            }
        PH_END
        PH_BEGIN
            MK_W(); MK_CBUF(); (void)cbuf;
#if FAST_RWKV
            REPEAT(4) rw::out_phase(L, wsp, l, tid, (int)blockIdx.x, G);
#else
            sk::d_rwkv_fin(PROJ, W, pR, pK, pV, MIX, gtid, gsize);
#endif
        PH_END
        PH_BEGIN
            if ((PROF_PH) == 31) { pg8::Gemm g2{MIX, Wt_out, MTOK, 1024, 1024}; pg8::StaticOrder S2; S2.init(MTOK, 1024, G, (int)blockIdx.x); pg8::EpiScaleBf16 E2{PROJ, 1024, SSQ_A}; pg8::gemm_phase<pg8::EpiScaleBf16, pg8::StaticOrder, true, true>(L, g2, S2, E2, tid); }
            pg8::Gemm g{MIX, Wt_out, MTOK, 1024, 1024}; pg8::StaticOrder S; S.init(MTOK, 1024, G, (int)blockIdx.x);
            pg8::EpiResid<false> E{out, XB, SSQ_B + (size_t)l * MTOK, 1024};
            pg8::gemm_phase<pg8::EpiResid<false>, pg8::StaticOrder, true, true>(L, g, S, E, tid);
        PH_END
        PH_BEGIN
            REPEAT(5) {
            pg8::Gemm g{XB, Wt_up, 66 * 256, 5632, 1024}; pg8::StaticOrder S; S.init(66 * 256, 5632, G, (int)blockIdx.x);
            pg8::EpiConvAct E{ACT, SSQ_B + (size_t)l * MTOK, args.in[I_CW] + (size_t)l * 3 * 5632, args.in[I_CB] + (size_t)l * 5632};
            pg8::gemm_phase<pg8::EpiConvAct, pg8::StaticOrder, true, true>(L, g, S, E, tid); }
        PH_END
        PH_BEGIN
            if ((PROF_PH) == 32) { pg8::Gemm g2{ACT, Wt_down, MTOK, 1024, 2816}; pg8::StaticOrder S2; S2.init(MTOK, 1024, G, (int)blockIdx.x); pg8::EpiScaleBf16 E2{PROJ, 1024, SSQ_A}; pg8::gemm_phase<pg8::EpiScaleBf16, pg8::StaticOrder, true, true>(L, g2, S2, E2, tid); }
            pg8::Gemm g{ACT, Wt_down, MTOK, 1024, 2816}; pg8::StaticOrder S; S.init(MTOK, 1024, G, (int)blockIdx.x);
            if (l == 0) { pg8::EpiResid<false> E{out, XB, SSQ_A + (size_t)(l + 1) * MTOK, 1024}; pg8::gemm_phase<pg8::EpiResid<false>, pg8::StaticOrder, true, true>(L, g, S, E, tid); }
            else { pg8::EpiResid<true> E{out, XB, nullptr, 1024}; pg8::gemm_phase<pg8::EpiResid<true>, pg8::StaticOrder, true, true>(L, g, S, E, tid); }
        PH_END
    }
    if ((PROF_TA) >= 0 && blockIdx.x == 0 && tid0 == 0) {
        MISC[24 + ph] = (unsigned)__builtin_amdgcn_s_memrealtime();
        const unsigned ta = MISC[24 + (PROF_TA) + 1] - MISC[24 + (PROF_TA)], tb = (PROF_TB) >= 0 ? MISC[24 + (PROF_TB) + 1] - MISC[24 + (PROF_TB)] : 0u;
        const unsigned long long extra = (unsigned long long)ta + 1000ull * (unsigned long long)(((tb + 50u) / 100u) * 100u);
        const unsigned long long t0 = __builtin_amdgcn_s_memrealtime(); while (__builtin_amdgcn_s_memrealtime() - t0 < extra) __builtin_amdgcn_s_sleep(32);
    }
#undef PH_BEGIN
#undef PH_END
}
constexpr int N_PHASES = 1 + 2 * 7;
}

#ifndef MK_PER_PHASE
#define MK_PER_PHASE 0
#endif
extern "C" void kernel_launch(void* const* d_in, const int* in_sizes, int n_in, void* d_out, int out_size, void* d_ws, size_t ws_size, hipStream_t stream) {
    static int grid = 0;
    if (grid == 0) {
        if (n_in != N_IN || out_size != MTOK * DM || ws_size < mk::WS_END) { fprintf(stderr, "kernel_launch: unexpected shapes (n_in %d out %d ws %zu)\n", n_in, out_size, ws_size); grid = -1; return; }
        int dev = 0, cus = 0, per_cu = 0;
        if (hipGetDevice(&dev) != hipSuccess || hipDeviceGetAttribute(&cus, hipDeviceAttributeMultiprocessorCount, dev) != hipSuccess) { grid = -1; return; }
        if (hipFuncSetAttribute((const void*)mk::mk_fwd, hipFuncAttributeMaxDynamicSharedMemorySize, mk::LDS_BYTES) != hipSuccess) { fprintf(stderr, "kernel_launch: hipFuncSetAttribute failed\n"); grid = -1; return; }
        if (hipOccupancyMaxActiveBlocksPerMultiprocessor(&per_cu, (const void*)mk::mk_fwd, NWAVES * 64, mk::LDS_BYTES) != hipSuccess || per_cu < 1) { fprintf(stderr, "kernel_launch: occupancy query says %d blocks per CU\n", per_cu); }
        (void)hipGetLastError();
        grid = cus;
    }
    if (grid < 0) return;
    if (hipMemsetAsync((char*)d_ws + mk::WS_CTL, 0, mk::CTL_ZERO_BYTES, stream) != hipSuccess) return;
    mk::Args a{};
    for (int i = 0; i < N_IN; ++i) a.in[i] = (const float*)d_in[i];
    a.out = (float*)d_out; a.ws = (unsigned char*)d_ws;
#if MK_PER_PHASE
    for (int p = 0; p < mk::N_PHASES; ++p) { a.ph_lo = p; a.ph_hi = p + 1; hipLaunchKernelGGL(mk::mk_fwd, dim3(grid), dim3(NWAVES * 64), mk::LDS_BYTES, stream, a); }
#else
    a.ph_lo = 0; a.ph_hi = mk::N_PHASES;
    hipLaunchKernelGGL(mk::mk_fwd, dim3(grid), dim3(NWAVES * 64), mk::LDS_BYTES, stream, a);
#endif
}
```
